# Optimizing an MI355X kernel written in HIP

```python
import math
import jax, jax.numpy as jnp
from jax import lax
import numpy as np


D_MODEL = 2048
BATCH = 8
SEQ = 4096
DEPTH = 2

N_META = 16
HEAD_DIM = 128
A_HEADS = 4
A_WIDTH = A_HEADS * HEAD_DIM
HGRN_CHUNK = 64
B_WIDTH = 512
CONV_W = 3
C_HEADS = 4
C_HALF = HEAD_DIM // 2
C_WIDTH = C_HEADS * HEAD_DIM
D_HEADS = 4
D_WIDTH = D_HEADS * HEAD_DIM
IDX_HEADS = 16
IDX_DIM = 64
TOPK_MAX = 256
N_BRANCH = 4
BRANCH_WIDTH = 512
D_FF = 5632
N_BUCKETS = 32
MAX_DISTANCE = 128
Q_BLOCK = 128
EPS = 1e-6

IN_SPLITS = (A_WIDTH, A_WIDTH, A_WIDTH, A_WIDTH,
             B_WIDTH, B_WIDTH, B_WIDTH,
             C_WIDTH, C_WIDTH, C_WIDTH,
             D_WIDTH, HEAD_DIM, HEAD_DIM,
             IDX_HEADS * IDX_DIM, IDX_DIM, IDX_HEADS,
             N_BRANCH * D_MODEL)
IN_COLS = sum(IN_SPLITS)

kernel_name = "hybrid_gated_hgrn2_conv_diffattn_dsa_macaron"


def rmsnorm(x, g):
    xf = x.astype(jnp.float32)
    inv = lax.rsqrt(jnp.mean(xf * xf, axis=-1, keepdims=True) + EPS)
    return (xf * inv).astype(x.dtype) * g


def swiglu_ffn(h, w_gu, w_down):
    gate, up = jnp.split(h @ w_gu, 2, axis=-1)
    return (jax.nn.silu(gate) * up) @ w_down


def rel_bucket(q_pos, k_pos):
    n = jnp.maximum(q_pos - k_pos, 0)
    max_exact = N_BUCKETS // 2
    nf = jnp.maximum(n, 1).astype(jnp.float32)
    large = max_exact + (jnp.log(nf / max_exact) / math.log(MAX_DISTANCE / max_exact)
                         * (N_BUCKETS - max_exact)).astype(jnp.int32)
    large = jnp.minimum(large, N_BUCKETS - 1)
    return jnp.where(n < max_exact, n, large)


def map_query_blocks(fn, q_arrays, seq_len):
    pad = (-seq_len) % Q_BLOCK
    pos = jnp.concatenate([jnp.zeros((pad,), jnp.int32), jnp.arange(seq_len, dtype=jnp.int32)])
    n_blk = (seq_len + pad) // Q_BLOCK

    def to_blocks(a):
        a = jnp.pad(a, [(0, 0), (pad, 0)] + [(0, 0)] * (a.ndim - 2))
        a = a.reshape((a.shape[0], n_blk, Q_BLOCK) + a.shape[2:])
        return jnp.moveaxis(a, 1, 0)

    xs = tuple(to_blocks(a) for a in q_arrays) + (pos.reshape(n_blk, Q_BLOCK),)
    out = lax.map(lambda args: fn(*args), xs)
    out = jnp.moveaxis(out, 0, 1)
    out = out.reshape((out.shape[0], n_blk * Q_BLOCK) + out.shape[3:])
    return out[:, pad:]


def hgrn2_chunk(S, q, log_f, k, v):
    b = jnp.cumsum(log_f, axis=2)
    o_inter = jnp.einsum('bhtd,bhde->bhte', q * jnp.exp(b), S)
    c = q.shape[2]
    causal = jnp.tril(jnp.ones((c, c), bool))
    diff = b[:, :, :, None, :] - b[:, :, None, :, :]
    decay = jnp.exp(jnp.where(causal[:, :, None], diff, -jnp.inf))
    scores = jnp.einsum('bhtd,bhsd,bhtsd->bhts', q, k, decay)
    o = o_inter + jnp.einsum('bhts,bhse->bhte', scores, v)
    b_last = b[:, :, -1:, :]
    k_dec = k * jnp.exp(b_last - b)
    S_new = jnp.exp(b_last[:, :, 0, :])[..., None] * S + jnp.einsum('bhsd,bhse->bhde', k_dec, v)
    return S_new, o


def hgrn2_mixer(q_raw, f_raw, i_raw, g_raw, lb, gnorm):
    Bb, L, _ = q_raw.shape

    def heads(t):
        return t.astype(jnp.float32).reshape(Bb, L, A_HEADS, HEAD_DIM).transpose(0, 2, 1, 3)

    lb = lb.astype(jnp.float32).reshape(1, A_HEADS, 1, HEAD_DIM)
    z = heads(f_raw)
    log_f = jnp.logaddexp(jnp.log(lb), jnp.log1p(-lb) + jax.nn.log_sigmoid(z))
    k = (1.0 - lb) * jax.nn.sigmoid(-z)
    q = jax.nn.silu(heads(q_raw))
    v = heads(i_raw)
    S0 = jnp.zeros((Bb, A_HEADS, HEAD_DIM, HEAD_DIM), jnp.float32)
    m = N_META
    S_meta, o_meta = hgrn2_chunk(S0, q[:, :, :m], log_f[:, :, :m], k[:, :, :m], v[:, :, :m])

    def to_chunks(t):
        r = t[:, :, m:]
        n = r.shape[2] // HGRN_CHUNK
        return jnp.moveaxis(r.reshape(Bb, A_HEADS, n, HGRN_CHUNK, HEAD_DIM), 2, 0)

    _, o_real = lax.scan(lambda S, xs: hgrn2_chunk(S, *xs), S_meta,
                         (to_chunks(q), to_chunks(log_f), to_chunks(k), to_chunks(v)))
    o_real = jnp.moveaxis(o_real, 0, 2).reshape(Bb, A_HEADS, L - m, HEAD_DIM)
    o = jnp.concatenate([o_meta, o_real], axis=2).transpose(0, 2, 1, 3)
    o = rmsnorm(o, gnorm.astype(jnp.float32).reshape(A_HEADS, HEAD_DIM)).reshape(Bb, L, A_WIDTH)
    return o.astype(g_raw.dtype) * jax.nn.silu(g_raw)


def short_conv_mixer(b_gate, c_gate, u, conv_w):
    zc = c_gate * u
    L = zc.shape[1]
    zp = jnp.pad(zc, ((0, 0), (CONV_W - 1, 0), (0, 0)))
    y = conv_w[0] * zp[:, CONV_W - 1:CONV_W - 1 + L]
    for j in range(1, CONV_W):
        y = y + conv_w[j] * zp[:, CONV_W - 1 - j:CONV_W - 1 - j + L]
    return b_gate * y


def diff_attention(c_q, c_k, c_v, q_norm, k_norm, lam_params, subln, table, layer):
    Bb, L, _ = c_q.shape
    q = rmsnorm(c_q.reshape(Bb, L, C_HEADS, 2, C_HALF), q_norm) * (C_HALF ** -0.5)
    k = rmsnorm(c_k.reshape(Bb, L, C_HEADS, 2, C_HALF), k_norm)
    v = c_v.reshape(Bb, L, C_HEADS, HEAD_DIM)
    lp = lam_params.astype(jnp.float32)
    lam_init = 0.8 - 0.6 * math.exp(-0.3 * layer)
    lam = jnp.exp(jnp.sum(lp[0] * lp[1])) - jnp.exp(jnp.sum(lp[2] * lp[3])) + lam_init
    k_pos = jnp.arange(L, dtype=jnp.int32)

    def block(q_blk, q_pos):
        bias = jnp.take(table, rel_bucket(q_pos[:, None], k_pos[None, :]), axis=0)
        logits = (jnp.einsum('bqhcd,bkhcd->bchqk', q_blk, k).astype(jnp.float32)
                  + jnp.transpose(bias, (2, 0, 1)).astype(jnp.float32))
        logits = jnp.where(k_pos[None, :] <= q_pos[:, None], logits, -jnp.inf)
        p = jax.nn.softmax(logits, axis=-1)
        p_diff = p[:, 0] - lam * p[:, 1]
        return jnp.einsum('bhqk,bkhe->bqhe', p_diff.astype(v.dtype), v)

    o = map_query_blocks(block, (q,), L)
    o = rmsnorm(o, subln) * (1.0 - lam_init)
    return o.reshape(Bb, L, C_WIDTH)


def dsa_attention(d_q, d_k, d_v, d_qi, d_ki, d_w, q_norm, k_norm, table, top_k):
    Bb, L, _ = d_q.shape
    q = rmsnorm(d_q.reshape(Bb, L, D_HEADS, HEAD_DIM), q_norm) * (HEAD_DIM ** -0.5)
    k = rmsnorm(d_k, k_norm)
    v = d_v
    qi = d_qi.reshape(Bb, L, IDX_HEADS, IDX_DIM).astype(jnp.float32) * (IDX_DIM ** -0.5)
    ki = d_ki.astype(jnp.float32)
    wi = d_w.astype(jnp.float32) * (IDX_HEADS ** -0.5)
    k_pos = jnp.arange(L, dtype=jnp.int32)
    gather = jax.vmap(lambda t, i: t[i])

    def block(q_blk, qi_blk, wi_blk, q_pos):
        score = jax.nn.relu(jnp.einsum('bqhd,bkd->bqhk', qi_blk, ki))
        index = jnp.einsum('bqhk,bqh->bqk', score, wi_blk)
        index = jnp.where(k_pos[None, None, :] <= q_pos[None, :, None], index, -jnp.inf)
        _, sel = lax.top_k(index, top_k)
        k_sel = gather(k, sel)
        v_sel = gather(v, sel)
        bias = jnp.take(table, rel_bucket(q_pos[None, :, None], sel), axis=0)
        logits = (jnp.einsum('bqhd,bqkd->bhqk', q_blk, k_sel).astype(jnp.float32)
                  + jnp.transpose(bias, (0, 3, 1, 2)).astype(jnp.float32))
        logits = jnp.where((sel <= q_pos[None, :, None])[:, None], logits, -jnp.inf)
        p = jax.nn.softmax(logits, axis=-1)
        return jnp.einsum('bhqk,bqkd->bqhd', p.astype(v.dtype), v_sel)

    o = map_query_blocks(block, (q, qi, wi), L)
    return o.reshape(Bb, L, D_WIDTH)


def hybrid_mixer(h, layer, top_k, rel_bias, w_in, lb, hgrn_gnorm, conv_w, diff_q_norm,
                 diff_k_norm, diff_lambda, diff_subln, dsa_q_norm, dsa_k_norm, w_branch, w_out):
    Bb, L, _ = h.shape
    offsets = np.cumsum(np.array(IN_SPLITS))[:-1].tolist()
    (a_q, a_f, a_i, a_g, b_b, b_c, b_u, c_q, c_k, c_v,
     d_q, d_k, d_v, d_qi, d_ki, d_w, gate_logits) = jnp.split(h @ w_in, offsets, axis=-1)
    branches = (
        hgrn2_mixer(a_q, a_f, a_i, a_g, lb, hgrn_gnorm),
        short_conv_mixer(b_b, b_c, b_u, conv_w),
        diff_attention(c_q, c_k, c_v, diff_q_norm, diff_k_norm, diff_lambda, diff_subln,
                       rel_bias[:, :C_HEADS], layer),
        dsa_attention(d_q, d_k, d_v, d_qi, d_ki, d_w, dsa_q_norm, dsa_k_norm,
                      rel_bias[:, C_HEADS:], top_k),
    )
    gates = jax.nn.sigmoid(gate_logits.reshape(Bb, L, N_BRANCH, D_MODEL))
    merged = gates[:, :, 0] * (branches[0] @ w_branch[0])
    for m in range(1, N_BRANCH):
        merged = merged + gates[:, :, m] * (branches[m] @ w_branch[m])
    return merged @ w_out


def setup_inputs(seed: int = 0) -> dict:
    key = jax.random.key(seed)
    ks = jax.random.split(key, 24)
    f32 = jnp.float32

    def nrm(k, shape, scale):
        return jax.random.normal(k, shape, f32) * scale

    def gain(k, shape):
        return 1.0 + 0.05 * jax.random.normal(k, shape, f32)

    return {
        "x": nrm(ks[0], (BATCH, SEQ, D_MODEL), 1.0),
        "meta_tokens": nrm(ks[1], (N_META, D_MODEL), 1.0),
        "rel_bias": nrm(ks[2], (N_BUCKETS, C_HEADS + D_HEADS), 0.2),
        "ffn1_norm": gain(ks[3], (DEPTH, D_MODEL)),
        "ffn1_w_gu": nrm(ks[4], (DEPTH, D_MODEL, 2 * D_FF), D_MODEL ** -0.5),
        "ffn1_w_down": nrm(ks[5], (DEPTH, D_FF, D_MODEL), D_FF ** -0.5),
        "mix_norm": gain(ks[6], (DEPTH, D_MODEL)),
        "w_in": nrm(ks[7], (DEPTH, D_MODEL, IN_COLS), D_MODEL ** -0.5),
        "hgrn_lb": nrm(ks[8], (DEPTH, A_WIDTH), 1.0),
        "hgrn_gnorm": gain(ks[9], (DEPTH, A_WIDTH)),
        "conv_w": nrm(ks[10], (DEPTH, CONV_W, B_WIDTH), CONV_W ** -0.5),
        "diff_q_norm": gain(ks[11], (DEPTH, C_HALF)),
        "diff_k_norm": gain(ks[12], (DEPTH, C_HALF)),
        "diff_lambda": nrm(ks[13], (DEPTH, 4, C_HALF), 0.1),
        "diff_subln": gain(ks[14], (DEPTH, HEAD_DIM)),
        "dsa_q_norm": gain(ks[15], (DEPTH, HEAD_DIM)),
        "dsa_k_norm": gain(ks[16], (DEPTH, HEAD_DIM)),
        "w_branch": nrm(ks[17], (DEPTH, N_BRANCH, BRANCH_WIDTH, D_MODEL), BRANCH_WIDTH ** -0.5),
        "w_out": nrm(ks[18], (DEPTH, D_MODEL, D_MODEL), D_MODEL ** -0.5),
        "ffn2_norm": gain(ks[19], (DEPTH, D_MODEL)),
        "ffn2_w_gu": nrm(ks[20], (DEPTH, D_MODEL, 2 * D_FF), D_MODEL ** -0.5),
        "ffn2_w_down": nrm(ks[21], (DEPTH, D_FF, D_MODEL), D_FF ** -0.5),
    }


def reference(x, meta_tokens, rel_bias, ffn1_norm, ffn1_w_gu, ffn1_w_down, mix_norm, w_in,
              hgrn_lb, hgrn_gnorm, conv_w, diff_q_norm, diff_k_norm, diff_lambda, diff_subln,
              dsa_q_norm, dsa_k_norm, w_branch, w_out, ffn2_norm, ffn2_w_gu, ffn2_w_down):
    Bb, seq, _ = x.shape
    top_k = min(TOPK_MAX, seq // 4)
    meta = jnp.broadcast_to(meta_tokens.astype(x.dtype)[None], (Bb, N_META, D_MODEL))
    h = jnp.concatenate([meta, x], axis=1)
    lbs = jnp.cumsum(jax.nn.softmax(hgrn_lb.astype(jnp.float32), axis=0), axis=0)
    lbs = lbs - lbs[0:1]
    for l in range(DEPTH):
        h = h + 0.5 * swiglu_ffn(rmsnorm(h, ffn1_norm[l]), ffn1_w_gu[l], ffn1_w_down[l])
        h = h + hybrid_mixer(rmsnorm(h, mix_norm[l]), l, top_k, rel_bias, w_in[l], lbs[l],
                             hgrn_gnorm[l], conv_w[l], diff_q_norm[l], diff_k_norm[l],
                             diff_lambda[l], diff_subln[l], dsa_q_norm[l], dsa_k_norm[l],
                             w_branch[l], w_out[l])
        h = h + 0.5 * swiglu_ffn(rmsnorm(h, ffn2_norm[l]), ffn2_w_gu[l], ffn2_w_down[l])
    return h[:, N_META:]
```

```cpp
#include <hip/hip_runtime.h>
#include <cstdio>
#include <cstdint>
#define MK_ONE 0
namespace pg8 {
#define PG8_LAS __attribute__((address_space(3)))
typedef unsigned short bf16_t;
typedef short bf16x8 __attribute__((ext_vector_type(8)));
typedef float f32x4 __attribute__((ext_vector_type(4)));
typedef unsigned u32x4 __attribute__((ext_vector_type(4)));
constexpr int BM = 256, BK = 64, HALF = 128, HTB = HALF * BK * 2  , STAGE_BYTES = 8 * HTB, NXCD = 8, WGM = 8;

__host__ __device__ __forceinline__ int lds_byte(int r, int c) { const int st = (r >> 4) * 2 + (c >> 5), rr = r & 15, cc = c & 31, ob = rr * 64 + cc * 2; return st * 1024 + (ob ^ (((ob >> 9) & 1) << 5)); }
__host__ __device__ __forceinline__ void stage_rc(int b, int& R, int& C) { const int st = b / 1024, sb = b % 1024, swz = sb ^ (((sb >> 9) & 1) << 5); R = (st >> 1) * 16 + swz / 64; C = (st & 1) * 32 + (swz % 64) / 2; }
__host__ __device__ __forceinline__ int perm32(int rho) { const int n = rho >> 4, i = rho & 15; return 8 * (i >> 2) + 4 * n + (i & 3); }

struct Unit { int pm, pn; };
struct Gemm { const bf16_t* A; const bf16_t* Bt; int M, N, K; };

struct StaticOrder {
    int nM, nN, nwg, G, c;
    __host__ __device__ void init(int M, int N, int G_, int c_) { nM = M / BM; nN = N / BM; nwg = nM * nN; G = G_; c = c_; }
    __host__ __device__ bool next(int i, Unit& u) const {
        const long L = (long)i * G + c; if (L >= nwg) return false;
        int wgid = (int)L; { const int q = nwg / NXCD, r = nwg % NXCD, xcd = wgid % NXCD, off = wgid / NXCD; wgid = (xcd < r ? xcd * (q + 1) : r * (q + 1) + (xcd - r) * q) + off; }
        const int nig = WGM * nN, gid = wgid / nig, fm = gid * WGM, gsz = (nM - fm) < WGM ? (nM - fm) : WGM;
        u.pm = fm + ((wgid % nig) % gsz); u.pn = (wgid % nig) / gsz; return true;
    }
    __device__ __forceinline__ void a_ready(const Unit&) const {}
    __device__ __forceinline__ void done(const Unit&) const {}
};
typedef __bf16 bf16x2_hw __attribute__((ext_vector_type(2))); typedef float f32x2_hw __attribute__((ext_vector_type(2)));
__device__ __forceinline__ unsigned cvt_pk_bf16(float lo, float hi) { const f32x2_hw v = {lo, hi}; return __builtin_bit_cast(unsigned, __builtin_convertvector(v, bf16x2_hw)); }
typedef float f32x2 __attribute__((ext_vector_type(2)));
__device__ __forceinline__ float fast_sigmoid(float x) { return __builtin_amdgcn_rcpf(1.0f + __expf(-x)); }
__device__ __forceinline__ float fast_silu(float x) { return x * fast_sigmoid(x); }
template <int ACT  > struct EpiBf16 {
    static constexpr bool PERM = true, AFTER_DRAIN = false;
    bf16_t* O; int ldc;
    __device__ __forceinline__ void operator()(const f32x4 (&acc)[2][2][4][2], const Unit& u, int wr, int wc, int fr, int fq) const {
        const int row0 = u.pm * BM + wr * 64 + fr; const int col0 = u.pn * BM + wc * 32 + 8 * fq;
#pragma unroll
        for (int ai = 0; ai < 2; ++ai)
#pragma unroll
            for (int m = 0; m < 4; ++m) { bf16_t* rowp = O + (size_t)(row0 + ai * HALF + m * 16) * ldc + col0;
#pragma unroll
                for (int bj = 0; bj < 2; ++bj) { f32x4 v0 = acc[ai][bj][m][0], v1 = acc[ai][bj][m][1];
                    if (ACT == 1) {
#pragma unroll
                        for (int j = 0; j < 4; ++j) { v0[j] = fast_sigmoid(v0[j]); v1[j] = fast_sigmoid(v1[j]); } }
                    u32x4 w; w.x = cvt_pk_bf16(v0[0], v0[1]); w.y = cvt_pk_bf16(v0[2], v0[3]); w.z = cvt_pk_bf16(v1[0], v1[1]); w.w = cvt_pk_bf16(v1[2], v1[3]);
                    *(u32x4*)(rowp + bj * HALF) = w; } }
    }
};
struct EpiSwiGLU {
    static constexpr bool PERM = true, AFTER_DRAIN = false;
    bf16_t* O; int ldc;
    __device__ __forceinline__ void operator()(const f32x4 (&acc)[2][2][4][2], const Unit& u, int wr, int wc, int fr, int fq) const {
        const int row0 = u.pm * BM + wr * 64 + fr; const int col0 = u.pn * HALF + wc * 32 + 8 * fq;
#pragma unroll
        for (int ai = 0; ai < 2; ++ai)
#pragma unroll
            for (int m = 0; m < 4; ++m) { bf16_t* rowp = O + (size_t)(row0 + ai * HALF + m * 16) * ldc + col0;
                const f32x4 g0 = acc[ai][0][m][0], g1 = acc[ai][0][m][1], u0 = acc[ai][1][m][0], u1 = acc[ai][1][m][1];
                f32x4 v0, v1;
#pragma unroll
                for (int j = 0; j < 4; ++j) { v0[j] = fast_silu(g0[j]) * u0[j]; v1[j] = fast_silu(g1[j]) * u1[j]; }
                u32x4 w; w.x = cvt_pk_bf16(v0[0], v0[1]); w.y = cvt_pk_bf16(v0[2], v0[3]); w.z = cvt_pk_bf16(v1[0], v1[1]); w.w = cvt_pk_bf16(v1[2], v1[3]);
                *(u32x4*)rowp = w; asm volatile("" ::: "memory"); }
    }
};
struct EpiResF32 {
    static constexpr bool PERM = false, AFTER_DRAIN = false;
    const float* base_r; float* out_r; float* hm; int ldc; int mt_real; float scale;
    __device__ __forceinline__ void operator()(const f32x4 (&acc)[2][2][4][2], const Unit& u, int wr, int wc, int fr, int fq) const {
        const bool real = u.pm < mt_real;
        const float* bp = real ? base_r + (size_t)u.pm * BM * ldc : hm; float* op = real ? out_r + (size_t)u.pm * BM * ldc : hm;
        const int row0 = wr * 64 + fr, col0 = u.pn * BM + wc * 32 + 4 * fq;
#pragma unroll
        for (int ai = 0; ai < 2; ++ai)
#pragma unroll
            for (int m = 0; m < 4; ++m) { const size_t off = (size_t)(row0 + ai * HALF + m * 16) * ldc + col0;
#pragma unroll
                for (int bj = 0; bj < 2; ++bj)
#pragma unroll
                    for (int n = 0; n < 2; ++n) { const f32x4 b = *(const f32x4*)(bp + off + bj * HALF + n * 16); *(f32x4*)(op + off + bj * HALF + n * 16) = b + acc[ai][bj][m][n] * scale; }
                asm volatile("" ::: "memory"); }
    }
};
struct EpiGateAcc {
    static constexpr bool PERM = true, AFTER_DRAIN = false;
    bf16_t* MG; int ldc; const bf16_t* G; int ldg; int gcol0; int first;
    __device__ __forceinline__ void operator()(const f32x4 (&acc)[2][2][4][2], const Unit& u, int wr, int wc, int fr, int fq) const {
        const int row0 = u.pm * BM + wr * 64 + fr; const int col0 = u.pn * BM + wc * 32 + 8 * fq;
#pragma unroll
        for (int ai = 0; ai < 2; ++ai)
#pragma unroll
            for (int m = 0; m < 4; ++m) { const size_t r = (size_t)(row0 + ai * HALF + m * 16);
#pragma unroll
                for (int bj = 0; bj < 2; ++bj) { const u32x4 gw = *(const u32x4*)(G + r * ldg + gcol0 + col0 + bj * HALF);
                    u32x4 pw = (u32x4){0u, 0u, 0u, 0u}; if (!first) pw = *(const u32x4*)(MG + r * ldc + col0 + bj * HALF);
                    float o[8];
#pragma unroll
                    for (int j = 0; j < 4; ++j) { const float a0 = (j < 2) ? acc[ai][bj][m][0][2 * j] : acc[ai][bj][m][1][2 * (j - 2)], a1 = (j < 2) ? acc[ai][bj][m][0][2 * j + 1] : acc[ai][bj][m][1][2 * (j - 2) + 1];
                        o[2 * j] = __uint_as_float(pw[j] << 16) + __uint_as_float(gw[j] << 16) * a0; o[2 * j + 1] = __uint_as_float(pw[j] & 0xffff0000u) + __uint_as_float(gw[j] & 0xffff0000u) * a1; }
                    u32x4 w; w.x = cvt_pk_bf16(o[0], o[1]); w.y = cvt_pk_bf16(o[2], o[3]); w.z = cvt_pk_bf16(o[4], o[5]); w.w = cvt_pk_bf16(o[6], o[7]);
                    *(u32x4*)(MG + r * ldc + col0 + bj * HALF) = w; } }
    }
};
template <class Epi, class Sched, bool ALIGN_EPI = false, bool SP2 = false>
__device__ __forceinline__ void gemm_phase(PG8_LAS unsigned char* lds, const Gemm g, const Sched& S, const Epi& E) {
    int tid_ = threadIdx.x; asm volatile("" : "+v"(tid_));
    const int tid = tid_, wid = __builtin_amdgcn_readfirstlane(tid >> 6), lane = tid & 63, wr = wid >> 2, wc = wid & 3, fr = lane & 15, fq = lane >> 4;
    const int K = g.K, nt = K / BK;
    unsigned voffA[2], voffB[2];
#pragma unroll
    for (int i = 0; i < 2; ++i) { int R, C; stage_rc(tid * 16 + i * 8192, R, C); const int Rb = Epi::PERM ? ((R & ~31) + perm32(R & 31)) : R;
        voffA[i] = (unsigned)(R * K + C) * 2u; voffB[i] = (unsigned)(Rb * K + C) * 2u; }
    const size_t kstep = (size_t)(BK * 2);
    const size_t hstep = (size_t)HALF * K * 2;
    const size_t tstep = 2 * hstep;
    const unsigned ldsw = (unsigned)wid * 1024u;
    const int aoff = lds_byte(wr * 64 + fr, fq * 8), boff = lds_byte(wc * 32 + fr, fq * 8);
#define PG8_SA(b, h) (((b) * 2 + (h)) * HTB)
#define PG8_SB(b, h) ((4 + (b) * 2 + (h)) * HTB)
#define PG8_STAGE(bufoff, gbase, voff) do { _Pragma("unroll") for (int _i = 0; _i < 2; ++_i) \
        __builtin_amdgcn_global_load_lds((const unsigned*)((const char*)(gbase) + (voff)[_i]), (PG8_LAS unsigned*)(lds + (bufoff) + ldsw + _i * 8192), 16, 0, 0); } while (0)
#define PG8_LDA(dst, b, h) do { _Pragma("unroll") for (int m = 0; m < 4; ++m) _Pragma("unroll") for (int k = 0; k < 2; ++k) dst[m][k] = *(const PG8_LAS bf16x8*)(lds + PG8_SA(b, h) + aoff + m * 2048 + k * 1024); } while (0)
#define PG8_LDB(dst, b, h) do { _Pragma("unroll") for (int n = 0; n < 2; ++n) _Pragma("unroll") for (int k = 0; k < 2; ++k) dst[n][k] = *(const PG8_LAS bf16x8*)(lds + PG8_SB(b, h) + boff + n * 2048 + k * 1024); } while (0)
#define PG8_MMA(ai, bj, At, Bt) do { __builtin_amdgcn_s_setprio(1); _Pragma("unroll") for (int m = 0; m < 4; ++m) _Pragma("unroll") for (int n = 0; n < 2; ++n) _Pragma("unroll") for (int k = 0; k < 2; ++k) \
        acc[ai][bj][m][n] = __builtin_amdgcn_mfma_f32_16x16x32_bf16(Bt[n][k], At[m][k], acc[ai][bj][m][n], 0, 0, 0); __builtin_amdgcn_s_setprio(0); } while (0)
#define PG8_WAIT_V(n) asm volatile("s_waitcnt vmcnt(" #n ")" ::: "memory")
#define PG8_WAIT_L(n) asm volatile("s_waitcnt lgkmcnt(" #n ")" ::: "memory")
#define PG8_BAR __builtin_amdgcn_s_barrier()
#define PG8_SCHED __builtin_amdgcn_sched_barrier(0)
    Unit cur, nxt; int ui = 0;
    if (!S.next(0, cur)) return;
    f32x4 acc[2][2][4][2];
#pragma unroll
    for (int a = 0; a < 2; ++a)
#pragma unroll
        for (int b = 0; b < 2; ++b)
#pragma unroll
            for (int m = 0; m < 4; ++m)
#pragma unroll
                for (int n = 0; n < 2; ++n) acc[a][b][m][n] = (f32x4){0.f, 0.f, 0.f, 0.f};
    bf16x8 At[4][2], B0[2][2], B1[2][2];
    const char* cA = (const char*)g.A + (size_t)cur.pm * tstep; const char* cB = (const char*)g.Bt + (size_t)cur.pn * tstep;
    S.a_ready(cur);
    if constexpr (SP2) {
        PG8_STAGE(PG8_SB(0, 0), cB, voffB); PG8_STAGE(PG8_SB(0, 1), cB + hstep, voffB); PG8_STAGE(PG8_SA(0, 0), cA, voffA); PG8_STAGE(PG8_SA(0, 1), cA + hstep, voffA);
        if (wr == 1) PG8_BAR;
        PG8_WAIT_V(2); PG8_BAR;
        PG8_STAGE(PG8_SB(1, 0), cB + kstep, voffB); PG8_STAGE(PG8_SA(1, 0), cA + kstep, voffA); PG8_STAGE(PG8_SB(1, 1), cB + hstep + kstep, voffB);
        PG8_WAIT_V(6); PG8_BAR;
    } else {
        PG8_STAGE(PG8_SB(0, 0), cB, voffB); PG8_STAGE(PG8_SA(0, 0), cA, voffA); PG8_STAGE(PG8_SB(0, 1), cB + hstep, voffB); PG8_STAGE(PG8_SA(0, 1), cA + hstep, voffA);
        if (wr == 1) PG8_BAR;
        PG8_WAIT_V(4); PG8_BAR;
        PG8_STAGE(PG8_SB(1, 0), cB + kstep, voffB); PG8_STAGE(PG8_SA(1, 0), cA + kstep, voffA); PG8_STAGE(PG8_SB(1, 1), cB + hstep + kstep, voffB);
        PG8_WAIT_V(6); PG8_BAR;
    }
    for (;;) {
        const bool has_next = S.next(ui + 1, nxt);
        const char* nA = has_next ? (const char*)g.A + (size_t)nxt.pm * tstep : cA; const char* nB = has_next ? (const char*)g.Bt + (size_t)nxt.pn * tstep : cB;
        for (int t = 0; t < nt; t += 2) {
            const bool last = (t == nt - 2);
            const char* a1 = cA + (size_t)(t + 1) * kstep;
            const char* a2 = last ? nA : cA + (size_t)(t + 2) * kstep; const char* b2 = last ? nB : cB + (size_t)(t + 2) * kstep;
            const char* a3 = a2 + kstep; const char* b3 = b2 + kstep;
            if (last && has_next) S.a_ready(nxt);
            if constexpr (SP2) {
            PG8_LDB(B0, 0, 0); PG8_LDB(B1, 0, 1); PG8_SCHED; PG8_LDA(At, 0, 0); PG8_STAGE(PG8_SA(1, 1), a1 + hstep, voffA);
            PG8_WAIT_V(8); PG8_WAIT_L(0); PG8_BAR; PG8_MMA(0, 0, At, B0); PG8_MMA(0, 1, At, B1); PG8_BAR; PG8_SCHED;
            PG8_LDA(At, 0, 1); PG8_STAGE(PG8_SB(0, 0), b2, voffB); PG8_STAGE(PG8_SB(0, 1), b2 + hstep, voffB); PG8_STAGE(PG8_SA(0, 0), a2, voffA);
            PG8_WAIT_V(8); PG8_WAIT_L(0); PG8_BAR; PG8_MMA(1, 0, At, B0); PG8_MMA(1, 1, At, B1); PG8_BAR; PG8_SCHED;
            PG8_LDB(B0, 1, 0); PG8_LDB(B1, 1, 1); PG8_SCHED; PG8_LDA(At, 1, 0); PG8_STAGE(PG8_SA(0, 1), a2 + hstep, voffA);
            PG8_WAIT_V(8); PG8_WAIT_L(0); PG8_BAR; PG8_MMA(0, 0, At, B0); PG8_MMA(0, 1, At, B1); PG8_BAR; PG8_SCHED;
            PG8_LDA(At, 1, 1); PG8_STAGE(PG8_SB(1, 0), b3, voffB); PG8_STAGE(PG8_SB(1, 1), b3 + hstep, voffB); PG8_STAGE(PG8_SA(1, 0), a3, voffA);
            PG8_WAIT_V(8); PG8_WAIT_L(0); PG8_BAR; PG8_MMA(1, 0, At, B0); PG8_MMA(1, 1, At, B1); PG8_BAR; PG8_SCHED;
            } else {
            PG8_LDB(B0, 0, 0); PG8_SCHED; PG8_LDA(At, 0, 0); PG8_STAGE(PG8_SA(1, 1), a1 + hstep, voffA);
            PG8_WAIT_L(8); PG8_BAR; PG8_WAIT_L(0); PG8_MMA(0, 0, At, B0); PG8_BAR; PG8_SCHED;
            PG8_LDB(B1, 0, 1); PG8_STAGE(PG8_SB(0, 0), b2, voffB);
            PG8_BAR; PG8_WAIT_L(0); PG8_MMA(0, 1, At, B1); PG8_BAR;
            PG8_LDA(At, 0, 1); PG8_STAGE(PG8_SA(0, 0), a2, voffA);
            PG8_BAR; PG8_WAIT_L(0); PG8_MMA(1, 0, At, B0); PG8_BAR; PG8_SCHED;
            PG8_STAGE(PG8_SB(0, 1), b2 + hstep, voffB);
            PG8_WAIT_V(6); PG8_BAR; PG8_MMA(1, 1, At, B1); PG8_BAR;
            PG8_LDB(B0, 1, 0); PG8_SCHED; PG8_LDA(At, 1, 0); PG8_STAGE(PG8_SA(0, 1), a2 + hstep, voffA);
            PG8_WAIT_L(8); PG8_BAR; PG8_WAIT_L(0); PG8_MMA(0, 0, At, B0); PG8_BAR; PG8_SCHED;
            PG8_LDB(B1, 1, 1); PG8_STAGE(PG8_SB(1, 0), b3, voffB);
            PG8_BAR; PG8_WAIT_L(0); PG8_MMA(0, 1, At, B1); PG8_BAR;
            PG8_LDA(At, 1, 1); PG8_STAGE(PG8_SA(1, 0), a3, voffA);
            PG8_BAR; PG8_WAIT_L(0); PG8_MMA(1, 0, At, B0); PG8_BAR; PG8_SCHED;
            PG8_STAGE(PG8_SB(1, 1), b3 + hstep, voffB);
            PG8_WAIT_V(6); PG8_BAR; PG8_MMA(1, 1, At, B1); PG8_BAR;
            }
        }
        if constexpr (ALIGN_EPI) { if (wr == 0) PG8_BAR; }
        if constexpr (!Epi::AFTER_DRAIN) { E(acc, cur, wr, wc, fr, fq); S.done(cur); }
        if (!has_next) break;
#pragma unroll
        for (int a = 0; a < 2; ++a)
#pragma unroll
            for (int b = 0; b < 2; ++b)
#pragma unroll
                for (int m = 0; m < 4; ++m)
#pragma unroll
                    for (int n = 0; n < 2; ++n) acc[a][b][m][n] = (f32x4){0.f, 0.f, 0.f, 0.f};
        cur = nxt; cA = nA; cB = nB; ++ui;
        if constexpr (ALIGN_EPI) { if (wr == 1) PG8_BAR; }
    }
    PG8_WAIT_V(0);
    if constexpr (!ALIGN_EPI) { if (wr == 0) PG8_BAR; }
    PG8_BAR;
    if constexpr (Epi::AFTER_DRAIN) { E.fused(acc, cur, wr, wc, fr, fq, lds, wid, lane); S.done(cur); }
#undef PG8_SA
#undef PG8_SB
#undef PG8_STAGE
#undef PG8_LDA
#undef PG8_LDB
#undef PG8_MMA
#undef PG8_WAIT_V
#undef PG8_WAIT_L
#undef PG8_BAR
#undef PG8_SCHED
}
}

constexpr int DM = 2048, NB = 8, SEQ = 4096, NMETA = 16, LSEQ = 4112, LPAD = 4128;
constexpr int MREAL = NB * SEQ;
constexpr int MPAD = MREAL + 256;
constexpr int MT_REAL = MREAL / 256;
constexpr int DFF = 5632, NGU = 2 * DFF, NNG = 7168, NGATE = 8192, INCOLS = 15184, NGC = 6992;
constexpr int NWAVES = 8;
constexpr float EPS = 1e-6f;
constexpr int C_AQ = 0, C_AF = 512, C_AI = 1024, C_AG = 1536, C_BB = 2048, C_BC = 2560, C_BU = 3072, C_CQ = 3584, C_CK = 4096, C_CV = 4608,
              C_DQ = 5120, C_DK = 5632, C_DV = 5760, C_DQI = 5888, C_DKI = 6912, C_DW = 6976;

constexpr size_t MiB = 1u << 20;
constexpr size_t WS_CTL = 0, CTL_ZERO_BYTES = 1 * MiB;
constexpr size_t WS_HM = 1 * MiB;
constexpr size_t WS_W = 4 * MiB;
constexpr size_t W_GU1 = 0, W_D1 = W_GU1 + (size_t)NGU * DM * 2, W_NG = W_D1 + (size_t)DM * DFF * 2, W_G = W_NG + (size_t)NNG * DM * 2,
                 W_BR = W_G + (size_t)NGATE * DM * 2, W_O = W_BR + (size_t)4 * DM * 512 * 2, W_GU2 = W_O + (size_t)DM * DM * 2, W_D2 = W_GU2 + (size_t)NGU * DM * 2,
                 W_END = W_D2 + (size_t)DM * DFF * 2;
constexpr size_t WS_XN = WS_W + W_END;
constexpr size_t WS_BR = WS_XN + (size_t)MPAD * DM * 2;
constexpr size_t WS_BIG = WS_BR + (size_t)MPAD * DM * 2;
constexpr size_t BIG_P_END = (size_t)MPAD * NNG * 2;
constexpr size_t WS_VTC = WS_BIG + BIG_P_END;
constexpr size_t WS_VTD = WS_VTC + (size_t)NB * 4 * 128 * LPAD * 2;
constexpr size_t WS_MASK = WS_VTD + (size_t)NB * 128 * LPAD * 2;
constexpr int MASKW = 132;
constexpr int NIDX_WG = 208;
constexpr size_t WS_SCR = WS_MASK + (size_t)NB * LPAD * MASKW * 4;
constexpr size_t WS_END = WS_SCR + (size_t)NIDX_WG * 32 * LPAD * 4;
static_assert(WS_BIG + (size_t)MPAD * NGATE * 2 <= WS_END, "G fits");
static_assert(WS_END <= (size_t)1138174976, "workspace map fits the guaranteed size");

constexpr int RING_OFF = 0, RING_BYTES = 131072;
constexpr int LDSCTL_OFF = 143360, MISC_OFF = LDSCTL_OFF + 320;
constexpr int LDS_BYTES = 147456;

#define GAS __attribute__((address_space(1)))
#define LAS __attribute__((address_space(3)))
typedef unsigned short bf16;
typedef unsigned v4u __attribute__((ext_vector_type(4)));
typedef unsigned v2u __attribute__((ext_vector_type(2)));
typedef float f32x4 __attribute__((ext_vector_type(4)));
typedef float f32x16 __attribute__((ext_vector_type(16)));
typedef short bf16x8 __attribute__((ext_vector_type(8)));
typedef GAS unsigned gu32;
#define RLX_AGENT __ATOMIC_RELAXED, __HIP_MEMORY_SCOPE_AGENT
#define LDS_WAIT() asm volatile("s_waitcnt lgkmcnt(0)" ::: "memory")
#define VM_WAIT() asm volatile("s_waitcnt vmcnt(0)" ::: "memory")
__device__ __forceinline__ unsigned f2bf(float f) { unsigned u = __builtin_bit_cast(unsigned, f); return (u + 0x7fffu + ((u >> 16) & 1u)) >> 16; }
__device__ __forceinline__ unsigned pk2(float lo, float hi) { return pg8::cvt_pk_bf16(lo, hi); }
__device__ __forceinline__ float bflo(unsigned w) { return __uint_as_float(w << 16); }
__device__ __forceinline__ float bfhi(unsigned w) { return __uint_as_float(w & 0xffff0000u); }
__device__ __forceinline__ float bf2f(bf16 v) { return __uint_as_float((unsigned)v << 16); }
__device__ __forceinline__ int seqrow(int b, int p) { return p < NMETA ? MREAL + p : b * SEQ + p - NMETA; }
__device__ __forceinline__ int rel_bucket(int n) {
    if (n < 16) return n; if (n >= 128) return 31;
    const int v = 16 + (int)(__log2f((float)n * 0.0625f) * 5.33333333f); return v < 31 ? v : 31; }
__device__ __forceinline__ float wave_sum(float v) {
#pragma unroll
    for (int o = 1; o < 64; o <<= 1) v += __shfl_xor(v, o);
    return v;
}
#define XB_TMO      128
#define XB_XCNT(j)  (256  + 64 * (j))
#define XB_XSUB(j)  (1280 + 64 * (j))
#define XB_XGEN(j)  (2304 + 64 * (j))
#define XB_TOP      3328
#define XB_TOPGEN   3392
#define XCD_BAR_WORDS 3456
#define XB_SPIN_CAP (1u << 18)

__device__ __forceinline__ unsigned xb_ld(unsigned* p)              { return __hip_atomic_load(p, __ATOMIC_RELAXED, __HIP_MEMORY_SCOPE_AGENT); }
__device__ __forceinline__ unsigned xb_add(unsigned* p, unsigned v) { return __hip_atomic_fetch_add(p, v, __ATOMIC_RELAXED, __HIP_MEMORY_SCOPE_AGENT); }
__device__ __forceinline__ unsigned xb_xcc_id() { return (unsigned)__builtin_amdgcn_s_getreg((3 << 11) | 20) & 0xFu; }
#define XB_SPIN(cond, bar) do { unsigned _sp = 0; while (cond) { __builtin_amdgcn_s_sleep(1); \
    if ((++_sp & 255u) == 0u) { if (xb_ld(&(bar)[XB_TMO])) break; if (_sp > XB_SPIN_CAP) { atomicAdd(&(bar)[XB_TMO], 1u); break; } } } } while (0)

struct XcdBarrier {
    unsigned* bar; unsigned x;
    volatile LAS unsigned* st;
};

__device__ __forceinline__ XcdBarrier xcd_barrier_post(unsigned* bar, volatile LAS unsigned* st) {
    XcdBarrier b; b.bar = bar; b.x = xb_xcc_id(); b.st = st;
    if (threadIdx.x == 0) (void)xb_add(&bar[XB_XCNT(b.x)], 1u);
    return b;
}
__device__ __forceinline__ void xcd_barrier_complete(unsigned* bar, unsigned x, unsigned& nloc, unsigned& nx) {
    const unsigned G = gridDim.x * gridDim.y * gridDim.z;
    unsigned sum, cnt, mine, sp = 0u;
    for (;;) {
        sum = 0u; cnt = 0u; mine = 0u;
#pragma unroll
        for (unsigned j = 0; j < 16; ++j) { const unsigned c = xb_ld(&bar[XB_XCNT(j)]); sum += c; cnt += (c > 0u) ? 1u : 0u; mine = (j == x) ? c : mine; }
        if (sum == G) break;
        __builtin_amdgcn_s_sleep(1);
        if ((++sp & 255u) == 0u) { if (xb_ld(&bar[XB_TMO])) break; if (sp > XB_SPIN_CAP) { atomicAdd(&bar[XB_TMO], 1u); break; } }
    }
    nloc = mine > 0u ? mine : 1u; nx = cnt > 0u ? cnt : 1u;
}

__device__ __forceinline__ void xcd_barrier(const XcdBarrier& b) {
    asm volatile("s_waitcnt vmcnt(0)" ::: "memory");
    __syncthreads();
    if (threadIdx.x == 0) {
        unsigned* bar = b.bar;
        __builtin_amdgcn_s_waitcnt(0);
        unsigned nloc = b.st[0], nx = b.st[1];
        if (nloc == 0u) { xcd_barrier_complete(bar, b.x, nloc, nx); b.st[0] = nloc; b.st[1] = nx; }
        const unsigned old = xb_add(&bar[XB_XSUB(b.x)], 1u);
        const unsigned gen = old / nloc;
        if (old + 1u == (gen + 1u) * nloc) {
            __builtin_amdgcn_fence(__ATOMIC_RELEASE, "agent");
            asm volatile("s_waitcnt vmcnt(0)" ::: "memory");
            const unsigned og = xb_add(&bar[XB_TOP], 1u);
            const unsigned tg = og / nx;
            if (og + 1u == (tg + 1u) * nx) xb_add(&bar[XB_TOPGEN], 1u);
            else XB_SPIN(xb_ld(&bar[XB_TOPGEN]) == tg, bar);
            __builtin_amdgcn_fence(__ATOMIC_ACQUIRE, "agent");
            xb_add(&bar[XB_XGEN(b.x)], 1u);
            asm volatile("s_waitcnt vmcnt(0)" ::: "memory");
        } else {
            XB_SPIN(xb_ld(&bar[XB_XGEN(b.x)]) == gen, bar);
            __builtin_amdgcn_fence(__ATOMIC_ACQUIRE, "agent");
            asm volatile("s_waitcnt vmcnt(0)" ::: "memory");
        }
    }
    __syncthreads();
}

struct Frame {
    LAS unsigned char* lds;
    volatile LAS unsigned* MISC;
    gu32* ctl;
    int tid, lane, wave, G, bid;
    const float* in[22]; float* out; unsigned char* ws;
};
enum { I_X = 0, I_META, I_RELB, I_F1N, I_F1GU, I_F1D, I_MIXN, I_WIN, I_LB, I_GN, I_CONVW, I_DQN, I_DKN, I_DLAM, I_DSUB, I_SQN, I_SKN, I_WBR, I_WOUT, I_F2N, I_F2GU, I_F2D };

template <class RowMap>
__device__ __forceinline__ void transpose_item(const float* W, int K, int N, bf16* WT, LAS float* scr, int item, int lane, RowMap rm) {
    const int nblk = (N + 31) / 32, kb = item / nblk, nb = item % nblk, k0 = 64 * kb, n0 = 32 * nb;
    const int nl = n0 + (lane & 31); const bool nok = nl < N;
#pragma unroll 8
    for (int i = 0; i < 32; ++i) { const int kk = 2 * i + (lane >> 5); scr[kk * 33 + (lane & 31)] = nok ? W[(size_t)(k0 + kk) * N + nl] : 0.f; }
    LDS_WAIT(); asm volatile("" ::: "memory");
    const int c = lane & 7;
#pragma unroll
    for (int j = 0; j < 4; ++j) { const int n = (lane >> 3) + 8 * j; const LAS float* s = scr + (8 * c) * 33 + n;
        v4u o; o.x = pk2(s[0 * 33], s[1 * 33]); o.y = pk2(s[2 * 33], s[3 * 33]); o.z = pk2(s[4 * 33], s[5 * 33]); o.w = pk2(s[6 * 33], s[7 * 33]);
        if (n0 + n < N) *(GAS v4u*)(WT + (size_t)rm(n0 + n) * K + k0 + 8 * c) = o; }
    LDS_WAIT(); asm volatile("" ::: "memory");
}
struct MapId { __device__ __forceinline__ int operator()(int n) const { return n; } };
struct MapGU { __device__ __forceinline__ int operator()(int n) const { const int up = n >= DFF, j = up ? n - DFF : n; return 256 * (j >> 7) + 128 * up + (j & 127); } };
struct MapIn { __device__ __forceinline__ int operator()(int n) const { return n < NGC ? n : n + (NNG - NGC); } };
template <class RowMap>
__device__ __forceinline__ void convert_matrix(Frame& F, const float* W, int K, int N, bf16* WT, RowMap rm) {
    LAS float* scr = (LAS float*)(F.lds + F.wave * 16384);
    const int gw = F.bid * NWAVES + F.wave, NGW = F.G * NWAVES, nitems = (K / 64) * ((N + 31) / 32);
    for (int it = gw; it < nitems; it += NGW) transpose_item(W, K, N, WT, scr, it, F.lane, rm);
}
__device__ __forceinline__ void phase_convert(Frame& F, int l) {
    unsigned char* wb = F.ws + WS_W;
    convert_matrix(F, F.in[I_F1GU] + (size_t)l * DM * NGU, DM, NGU, (bf16*)(wb + W_GU1), MapGU());
    convert_matrix(F, F.in[I_F1D] + (size_t)l * DFF * DM, DFF, DM, (bf16*)(wb + W_D1), MapId());
    convert_matrix(F, F.in[I_WIN] + (size_t)l * DM * INCOLS, DM, INCOLS, (bf16*)(wb + W_NG), MapIn());
    for (int m = 0; m < 4; ++m) convert_matrix(F, F.in[I_WBR] + ((size_t)l * 4 + m) * 512 * DM, 512, DM, (bf16*)(wb + W_BR) + (size_t)m * DM * 512, MapId());
    convert_matrix(F, F.in[I_WOUT] + (size_t)l * DM * DM, DM, DM, (bf16*)(wb + W_O), MapId());
    convert_matrix(F, F.in[I_F2GU] + (size_t)l * DM * NGU, DM, NGU, (bf16*)(wb + W_GU2), MapGU());
    convert_matrix(F, F.in[I_F2D] + (size_t)l * DFF * DM, DFF, DM, (bf16*)(wb + W_D2), MapId());
    { GAS v4u* z = (GAS v4u*)(wb + W_NG + (size_t)NGC * DM * 2); const int n16 = (NNG - NGC) * DM * 2 / 16;
      for (int i = F.bid * 512 + F.tid; i < n16; i += F.G * 512) z[i] = (v4u){0u, 0u, 0u, 0u}; }
    if (l == 0) {
        GAS f32x4* hm = (GAS f32x4*)(F.ws + WS_HM); const GAS f32x4* mt = (const GAS f32x4*)F.in[I_META];
        for (int i = F.bid * 512 + F.tid; i < 256 * DM / 4; i += F.G * 512) hm[i] = (i < NMETA * DM / 4) ? mt[i] : (f32x4){0.f, 0.f, 0.f, 0.f};
    }
}
__device__ __forceinline__ void phase_norm(Frame& F, const float* src_real, const float* gain) {
    const int gw = F.bid * NWAVES + F.wave, NGW = F.G * NWAVES;
    bf16* XN = (bf16*)(F.ws + WS_XN); const float* hm = (const float*)(F.ws + WS_HM);
    f32x4 g[8];
#pragma unroll
    for (int j = 0; j < 8; ++j) g[j] = ((const GAS f32x4*)gain)[F.lane + 64 * j];
    for (int r = gw; r < MPAD; r += NGW) {
        GAS v2u* o8 = (GAS v2u*)(XN + (size_t)r * DM) + F.lane;
        if (r >= MREAL + NMETA) {
#pragma unroll
            for (int j = 0; j < 8; ++j) o8[64 * j] = (v2u){0u, 0u};
            continue; }
        const float* xr = r < MREAL ? src_real + (size_t)r * DM : hm + (size_t)(r - MREAL) * DM;
        f32x4 v[8]; float s = 0.f;
#pragma unroll
        for (int j = 0; j < 8; ++j) { v[j] = ((const GAS f32x4*)xr)[F.lane + 64 * j]; s += (v[j].x * v[j].x + v[j].y * v[j].y) + (v[j].z * v[j].z + v[j].w * v[j].w); }
        const float inv = 1.0f / sqrtf(wave_sum(s) * (1.f / DM) + EPS);
#pragma unroll
        for (int j = 0; j < 8; ++j) { v2u w; w.x = pk2(v[j].x * inv * g[j].x, v[j].y * inv * g[j].y); w.y = pk2(v[j].z * inv * g[j].z, v[j].w * inv * g[j].w); o8[64 * j] = w; }
    }
}
__device__ __forceinline__ void unpack8(const v4u w, float (&x)[8]) { x[0] = bflo(w.x); x[1] = bfhi(w.x); x[2] = bflo(w.y); x[3] = bfhi(w.y); x[4] = bflo(w.z); x[5] = bfhi(w.z); x[6] = bflo(w.w); x[7] = bfhi(w.w); }
__device__ __forceinline__ v4u pack8(const float (&x)[8]) { v4u w; w.x = pk2(x[0], x[1]); w.y = pk2(x[2], x[3]); w.z = pk2(x[4], x[5]); w.w = pk2(x[6], x[7]); return w; }
template <int GL>
__device__ __forceinline__ void norm_cols_inplace(bf16* p, const float* gain, float scale, int lane, bool wr) {
    float x[8]; unpack8(*(const GAS v4u*)p, x); float s = 0.f;
#pragma unroll
    for (int i = 0; i < 8; ++i) s += x[i] * x[i];
#pragma unroll
    for (int o = 1; o < GL; o <<= 1) s += __shfl_xor(s, o);
    const float inv = scale / sqrtf(s * (1.f / (GL * 8)) + EPS); const int g0 = (8 * lane) % (GL * 8);
#pragma unroll
    for (int i = 0; i < 8; ++i) x[i] = x[i] * inv * gain[g0 + i];
    if (wr) *(GAS v4u*)p = pack8(x);
}
__device__ __forceinline__ void phase_prep(Frame& F, int l) {
    const int gw = F.bid * NWAVES + F.wave, NGW = F.G * NWAVES, lane = F.lane;
    bf16* P = (bf16*)(F.ws + WS_BIG);
    const float *dqn = F.in[I_DQN] + l * 64, *dkn = F.in[I_DKN] + l * 64, *sqn = F.in[I_SQN] + l * 128, *skn = F.in[I_SKN] + l * 128;
    for (int r = gw; r < MREAL + NMETA; r += NGW) {
        bf16* pr = P + (size_t)r * NNG;
        norm_cols_inplace<8>(pr + C_CQ + 8 * lane, dqn, 0.125f, lane, true);
        norm_cols_inplace<8>(pr + C_CK + 8 * lane, dkn, 1.0f, lane, true);
        norm_cols_inplace<16>(pr + C_DQ + 8 * lane, sqn, 0.08838834764831845f, lane, true);
        norm_cols_inplace<16>(pr + C_DK + 8 * (lane & 15), skn, 1.0f, lane & 15, lane < 16);
    }
}
__device__ __forceinline__ void phase_vt(Frame& F) {
    const int gw = F.bid * NWAVES + F.wave, NGW = F.G * NWAVES, lane = F.lane;
    const bf16* P = (const bf16*)(F.ws + WS_BIG); bf16* VtC = (bf16*)(F.ws + WS_VTC); bf16* VtD = (bf16*)(F.ws + WS_VTD);
    LAS bf16* T = (LAS bf16*)(F.lds + F.wave * 17408);
    constexpr int NPB = (LPAD + 63) / 64;
    for (int task = gw; task < NB * 5 * NPB; task += NGW) {
        const int pb = task % NPB, mat = (task / NPB) % 5, b = task / (NPB * 5), p0 = 64 * pb;
        const int col = mat < 4 ? C_CV + 128 * mat : C_DV;
#pragma unroll 4
        for (int i = 0; i < 16; ++i) { const int pl = 4 * i + (lane >> 4), p = p0 + pl; v4u w = (v4u){0u, 0u, 0u, 0u};
            if (p < LSEQ) w = *(const GAS v4u*)(P + (size_t)seqrow(b, p) * NNG + col + 8 * (lane & 15));
            *(LAS v4u*)(T + pl * 136 + 8 * (lane & 15)) = w; }
        LDS_WAIT(); asm volatile("" ::: "memory");
        bf16* dst = mat < 4 ? VtC + (size_t)(b * 4 + mat) * 128 * LPAD : VtD + (size_t)b * 128 * LPAD;
#pragma unroll 4
        for (int it = 0; it < 16; ++it) { const int e = 8 * it + (lane >> 3), c = lane & 7; unsigned short x[8];
#pragma unroll
            for (int k = 0; k < 8; ++k) x[k] = T[(8 * c + k) * 136 + e];
            v4u w; w.x = x[0] | ((unsigned)x[1] << 16); w.y = x[2] | ((unsigned)x[3] << 16); w.z = x[4] | ((unsigned)x[5] << 16); w.w = x[6] | ((unsigned)x[7] << 16);
            if (p0 + 8 * c < LPAD) *(GAS v4u*)(dst + (size_t)e * LPAD + p0 + 8 * c) = w; }
        LDS_WAIT(); asm volatile("" ::: "memory");
    }
}

#define NEG_INF (-__builtin_inff())
__device__ __forceinline__ bf16x8 ld_frag16(const bf16* p) { return *(const GAS bf16x8*)p; }
__device__ __forceinline__ bf16x8 mk_frag(v2u lo, v2u hi) { v4u w; w.x = lo.x; w.y = lo.y; w.z = hi.x; w.w = hi.y; return __builtin_bit_cast(bf16x8, w); }
__device__ __forceinline__ unsigned cvtpk(float lo, float hi) { return pg8::cvt_pk_bf16(lo, hi); }
__device__ __forceinline__ void build_bias_table(Frame& F, LAS float* bt, int col0) {
    const float* rb = F.in[I_RELB];
    for (int i = F.tid; i < 4 * 128; i += 512) { const int hd = i >> 7, n = i & 127; bt[i] = rb[rel_bucket(n) * 8 + col0 + hd]; }
}
__device__ __forceinline__ void softmax_step(f32x16& S, float& m, float& lsum, float& alpha) {
    float tm = S[0];
#pragma unroll
    for (int r = 1; r < 16; ++r) tm = fmaxf(tm, S[r]);
    tm = fmaxf(tm, __shfl_xor(tm, 32));
    const float mn = fmaxf(m, tm), mref = (mn == NEG_INF) ? 0.f : mn;
    alpha = __expf(m - mref);
    float rs = 0.f;
#pragma unroll
    for (int r = 0; r < 16; ++r) { S[r] = __expf(S[r] - mref); rs += S[r]; }
    rs += __shfl_xor(rs, 32);
    lsum = lsum * alpha + rs; m = mn;
}
__device__ __forceinline__ void pv_step(f32x16 (&O)[4], const f32x16& S, const bf16* vt0  ) {
    bf16x8 pf[2];
#pragma unroll
    for (int s = 0; s < 2; ++s) { v4u w; w.x = cvtpk(S[8 * s + 0], S[8 * s + 1]); w.y = cvtpk(S[8 * s + 2], S[8 * s + 3]); w.z = cvtpk(S[8 * s + 4], S[8 * s + 5]); w.w = cvtpk(S[8 * s + 6], S[8 * s + 7]); pf[s] = __builtin_bit_cast(bf16x8, w); }
#pragma unroll
    for (int eb = 0; eb < 4; ++eb)
#pragma unroll
        for (int s = 0; s < 2; ++s) { const bf16* vp = vt0 + (size_t)eb * 32 * LPAD + 16 * s;
            const bf16x8 vf = mk_frag(*(const GAS v2u*)vp, *(const GAS v2u*)(vp + 8));
            O[eb] = __builtin_amdgcn_mfma_f32_32x32x16_bf16(vf, pf[s], O[eb], 0, 0, 0); }
}
__device__ __forceinline__ void diff_attn_task(Frame& F, int l, int b, int h, int j, const LAS float* bt, float lam, float post) {
    const int lane = F.lane, ql = lane & 31, hh = lane >> 5;
    const bf16* P = (const bf16*)(F.ws + WS_BIG); const bf16* Vt = (const bf16*)(F.ws + WS_VTC) + ((size_t)(b * 4 + h) * 128 + ql) * LPAD + 4 * hh;
    const int pq = 32 * j + ql, pqc = pq < LSEQ ? pq : LSEQ - 1;
    const bf16* qrow = P + (size_t)seqrow(b, pqc) * NNG + C_CQ + h * 128 + 8 * hh;
    const float b31 = bt[h * 128 + 127];
    f32x16 R[4];
#pragma unroll
    for (int c = 0; c < 2; ++c) {
        bf16x8 qf[4];
#pragma unroll
        for (int ks = 0; ks < 4; ++ks) qf[ks] = ld_frag16(qrow + c * 64 + 16 * ks);
        float m = NEG_INF, lsum = 0.f; f32x16 O[4];
#pragma unroll
        for (int eb = 0; eb < 4; ++eb)
#pragma unroll
            for (int r = 0; r < 16; ++r) O[eb][r] = 0.f;
        for (int kt = 0; kt <= j; ++kt) {
            const int pk = 32 * kt + ql, pkc = pk < LSEQ ? pk : LSEQ - 1;
            const bf16* krow = P + (size_t)seqrow(b, pkc) * NNG + C_CK + h * 128 + c * 64 + 8 * hh;
            f32x16 S;
#pragma unroll
            for (int r = 0; r < 16; ++r) S[r] = 0.f;
#pragma unroll
            for (int ks = 0; ks < 4; ++ks) S = __builtin_amdgcn_mfma_f32_32x32x16_bf16(ld_frag16(krow + 16 * ks), qf[ks], S, 0, 0, 0);
            if (kt + 4 >= j) {
#pragma unroll
                for (int r = 0; r < 16; ++r) { const int kp = 32 * kt + 4 * hh + (r & 3) + 8 * (r >> 2), n = pq - kp; S[r] = (n >= 0) ? S[r] + bt[h * 128 + (n < 127 ? n : 127)] : NEG_INF; }
            } else {
#pragma unroll
                for (int r = 0; r < 16; ++r) S[r] += b31;
            }
            float alpha; softmax_step(S, m, lsum, alpha);
#pragma unroll
            for (int eb = 0; eb < 4; ++eb)
#pragma unroll
                for (int r = 0; r < 16; ++r) O[eb][r] *= alpha;
            pv_step(O, S, Vt + 32 * kt);
        }
        const float il = 1.0f / lsum;
        if (c == 0) {
#pragma unroll
            for (int eb = 0; eb < 4; ++eb)
#pragma unroll
                for (int r = 0; r < 16; ++r) R[eb][r] = O[eb][r] * il;
        } else {
#pragma unroll
            for (int eb = 0; eb < 4; ++eb)
#pragma unroll
                for (int r = 0; r < 16; ++r) R[eb][r] -= lam * (O[eb][r] * il);
        }
    }
    float ss = 0.f;
#pragma unroll
    for (int eb = 0; eb < 4; ++eb)
#pragma unroll
        for (int r = 0; r < 16; ++r) ss += R[eb][r] * R[eb][r];
    ss += __shfl_xor(ss, 32);
    const float inv = post / sqrtf(ss * (1.f / 128.f) + EPS);
    const float* sub = F.in[I_DSUB] + l * 128;
    if (pq < LSEQ && (pq >= NMETA || b == 0)) {
        bf16* orow = (bf16*)(F.ws + WS_BR) + (size_t)2 * MPAD * 512 + (size_t)seqrow(b, pq) * 512 + h * 128;
#pragma unroll
        for (int eb = 0; eb < 4; ++eb)
#pragma unroll
            for (int g = 0; g < 4; ++g) { const int e0 = 32 * eb + 8 * g + 4 * hh; const f32x4 sv = *(const GAS f32x4*)(sub + e0);
                v2u w; w.x = pk2(R[eb][4 * g] * inv * sv.x, R[eb][4 * g + 1] * inv * sv.y); w.y = pk2(R[eb][4 * g + 2] * inv * sv.z, R[eb][4 * g + 3] * inv * sv.w);
                *(GAS v2u*)(orow + e0) = w; }
    }
}
__device__ __forceinline__ void dsa_attn_task(Frame& F, int b, int h, int j, const LAS float* bt) {
    const int lane = F.lane, ql = lane & 31, hh = lane >> 5;
    const bf16* P = (const bf16*)(F.ws + WS_BIG); const bf16* Vt = (const bf16*)(F.ws + WS_VTD) + ((size_t)b * 128 + ql) * LPAD + 4 * hh;
    const int pq = 32 * j + ql, pqc = pq < LSEQ ? pq : LSEQ - 1;
    const bf16* qrow = P + (size_t)seqrow(b, pqc) * NNG + C_DQ + h * 128 + 8 * hh;
    const unsigned* mrow = (const unsigned*)(F.ws + WS_MASK) + ((size_t)b * LPAD + pqc) * MASKW;
    const float b31 = bt[h * 128 + 127];
    bf16x8 qf[8];
#pragma unroll
    for (int ks = 0; ks < 8; ++ks) qf[ks] = ld_frag16(qrow + 16 * ks);
    float m = NEG_INF, lsum = 0.f; f32x16 O[4];
#pragma unroll
    for (int eb = 0; eb < 4; ++eb)
#pragma unroll
        for (int r = 0; r < 16; ++r) O[eb][r] = 0.f;
    for (int kt = 0; kt <= j; ++kt) {
        const int pk = 32 * kt + ql, pkc = pk < LSEQ ? pk : LSEQ - 1;
        const bf16* krow = P + (size_t)seqrow(b, pkc) * NNG + C_DK + 8 * hh;
        const unsigned mw = mrow[kt] >> (4 * hh);
        f32x16 S;
#pragma unroll
        for (int r = 0; r < 16; ++r) S[r] = 0.f;
#pragma unroll
        for (int ks = 0; ks < 8; ++ks) S = __builtin_amdgcn_mfma_f32_32x32x16_bf16(ld_frag16(krow + 16 * ks), qf[ks], S, 0, 0, 0);
        if (kt + 4 >= j) {
#pragma unroll
            for (int r = 0; r < 16; ++r) { const int kp = 32 * kt + 4 * hh + (r & 3) + 8 * (r >> 2), n = pq - kp; const bool sel = (mw >> ((r & 3) + 8 * (r >> 2))) & 1u;
                S[r] = (sel && n >= 0) ? S[r] + bt[h * 128 + (n < 127 ? n : 127)] : NEG_INF; }
        } else {
#pragma unroll
            for (int r = 0; r < 16; ++r) { const bool sel = (mw >> ((r & 3) + 8 * (r >> 2))) & 1u; S[r] = sel ? S[r] + b31 : NEG_INF; }
        }
        float alpha; softmax_step(S, m, lsum, alpha);
#pragma unroll
        for (int eb = 0; eb < 4; ++eb)
#pragma unroll
            for (int r = 0; r < 16; ++r) O[eb][r] *= alpha;
        pv_step(O, S, Vt + 32 * kt);
    }
    const float il = 1.0f / lsum;
    if (pq < LSEQ && (pq >= NMETA || b == 0)) {
        bf16* orow = (bf16*)(F.ws + WS_BR) + (size_t)3 * MPAD * 512 + (size_t)seqrow(b, pq) * 512 + h * 128;
#pragma unroll
        for (int eb = 0; eb < 4; ++eb)
#pragma unroll
            for (int g = 0; g < 4; ++g) { const int e0 = 32 * eb + 8 * g + 4 * hh;
                v2u w; w.x = pk2(O[eb][4 * g] * il, O[eb][4 * g + 1] * il); w.y = pk2(O[eb][4 * g + 2] * il, O[eb][4 * g + 3] * il);
                *(GAS v2u*)(orow + e0) = w; }
    }
}
__device__ __forceinline__ unsigned f32_key(float f) { const unsigned u = __float_as_uint(f); return u ^ ((u >> 31) ? 0xffffffffu : 0x80000000u); }
__device__ __forceinline__ void dsa_index_task(Frame& F, int b, int j, float* slab) {
    const int lane = F.lane, ql = lane & 31, hh = lane >> 5, wave = F.wave;
    const bf16* P = (const bf16*)(F.ws + WS_BIG);
    LAS unsigned char* qi = F.lds;
    for (int i = F.tid; i < 32 * 128; i += 512) { const int q = i >> 7, ch = i & 127; int pq = 32 * j + q; pq = pq < LSEQ ? pq : LSEQ - 1;
        *(LAS v4u*)(qi + q * 2064 + 16 * ch) = *(const GAS v4u*)(P + (size_t)seqrow(b, pq) * NNG + C_DQI + 8 * ch); }
    LAS float* wl = (LAS float*)(qi + 32 * 2064);
    if (F.tid < 32 * 16) { const int q = F.tid >> 4, hd = F.tid & 15; int pq = 32 * j + q; pq = pq < LSEQ ? pq : LSEQ - 1;
        wl[F.tid] = bf2f(P[(size_t)seqrow(b, pq) * NNG + C_DW + hd]) * 0.03125f; }
    LDS_WAIT(); __syncthreads();
    for (int kt = wave; kt <= j; kt += NWAVES) {
        const int pk = 32 * kt + ql, pkc = pk < LSEQ ? pk : LSEQ - 1;
        const bf16* krow = P + (size_t)seqrow(b, pkc) * NNG + C_DKI + 8 * hh;
        bf16x8 kf[4];
#pragma unroll
        for (int ks = 0; ks < 4; ++ks) kf[ks] = ld_frag16(krow + 16 * ks);
        f32x16 idx;
#pragma unroll
        for (int r = 0; r < 16; ++r) idx[r] = 0.f;
#pragma unroll 1
        for (int hd = 0; hd < 16; ++hd) { f32x16 S; const float wh = wl[ql * 16 + hd];
#pragma unroll
            for (int r = 0; r < 16; ++r) S[r] = 0.f;
#pragma unroll
            for (int ks = 0; ks < 4; ++ks) S = __builtin_amdgcn_mfma_f32_32x32x16_bf16(kf[ks], *(const LAS bf16x8*)(qi + ql * 2064 + hd * 128 + 32 * ks + 16 * hh), S, 0, 0, 0);
#pragma unroll
            for (int r = 0; r < 16; ++r) idx[r] += wh * fmaxf(S[r], 0.f); }
        float* srow = slab + (size_t)ql * LPAD + 32 * kt + 4 * hh;
#pragma unroll
        for (int g = 0; g < 4; ++g) *(GAS f32x4*)(srow + 8 * g) = (f32x4){idx[4 * g], idx[4 * g + 1], idx[4 * g + 2], idx[4 * g + 3]};
    }
    VM_WAIT(); __syncthreads();
    for (int qq = wave; qq < 32; qq += NWAVES) {
        const int p = 32 * j + qq; if (p >= LSEQ) break;
        const float* row = slab + (size_t)qq * LPAD;
        unsigned u[65];
#pragma unroll
        for (int i = 0; i < 65; ++i) { const int key = 64 * i + lane; u[i] = 0u; if (key <= p) u[i] = f32_key(((const GAS float*)row)[key]); }
        unsigned T = 1u;
        if (p + 1 > 256) { T = 0u;
            for (int bit = 31; bit >= 0; --bit) { const unsigned cand = T | (1u << bit); int cnt = 0;
#pragma unroll
                for (int i = 0; i < 65; ++i) cnt += (u[i] >= cand) ? 1 : 0;
#pragma unroll
                for (int o = 1; o < 64; o <<= 1) cnt += __shfl_xor(cnt, o);
                if (cnt >= 256) T = cand; } }
        unsigned long long* mrow = (unsigned long long*)((unsigned*)(F.ws + WS_MASK) + ((size_t)b * LPAD + p) * MASKW);
#pragma unroll
        for (int i = 0; i < 65; ++i) { const unsigned long long bal = __ballot(u[i] >= T); if (lane == 0) mrow[i] = bal; }
    }
    __syncthreads();
}
__device__ __forceinline__ void hgrn_naive_unit(Frame& F, int l, int b, int h, int eb) {
    const int lane = F.lane; const bf16* P = (const bf16*)(F.ws + WS_BIG); bf16* BR0 = (bf16*)(F.ws + WS_BR);
    LAS float* fs = (LAS float*)(F.lds + F.wave * 16384); LAS float* qs = fs + 16 * 128;
    float lbv[2];
#pragma unroll
    for (int dd = 0; dd < 2; ++dd) { const int ch = h * 128 + lane + 64 * dd; lbv[dd] = 0.f;
        if (l == 1) { const float a = F.in[I_LB][ch], c = F.in[I_LB][512 + ch]; lbv[dd] = 1.0f / (1.0f + __expf(a - c)); } }
    float S[128];
#pragma unroll
    for (int d = 0; d < 128; ++d) S[d] = 0.f;
    const int e = eb * 64 + lane;
    for (int p0 = 0; p0 < LSEQ; p0 += 16) {
#pragma unroll 4
        for (int tt = 0; tt < 16; ++tt) { const bf16* pr = P + (size_t)seqrow(b, p0 + tt) * NNG + h * 128;
#pragma unroll
            for (int dd = 0; dd < 2; ++dd) { const int d = lane + 64 * dd; const float z = bf2f(pr[C_AF + d]), q = bf2f(pr[C_AQ + d]);
                const float sg = 1.0f / (1.0f + __expf(-z)); fs[tt * 128 + d] = lbv[dd] + (1.0f - lbv[dd]) * sg; qs[tt * 128 + d] = q / (1.0f + __expf(-q)); } }
        LDS_WAIT(); asm volatile("" ::: "memory");
        for (int tt = 0; tt < 16; ++tt) { const int row = seqrow(b, p0 + tt); const float v = bf2f(P[(size_t)row * NNG + C_AI + h * 128 + e]); float o = 0.f;
#pragma unroll
            for (int d4 = 0; d4 < 32; ++d4) { const f32x4 f = *(const LAS f32x4*)(fs + tt * 128 + 4 * d4), q = *(const LAS f32x4*)(qs + tt * 128 + 4 * d4);
#pragma unroll
                for (int k = 0; k < 4; ++k) { S[4 * d4 + k] = f[k] * S[4 * d4 + k] + (1.0f - f[k]) * v; o += q[k] * S[4 * d4 + k]; } }
            if (p0 + tt >= NMETA || b == 0) BR0[(size_t)row * 512 + h * 128 + e] = (bf16)f2bf(o); }
        LDS_WAIT(); asm volatile("" ::: "memory");
    }
}
__device__ __forceinline__ void hgrn_finish_row(Frame& F, int l, int r) {
    const int lane = F.lane; bf16* o = (bf16*)(F.ws + WS_BR) + (size_t)r * 512 + 8 * lane; const bf16* g = (const bf16*)(F.ws + WS_BIG) + (size_t)r * NNG + C_AG + 8 * lane;
    float x[8], gg[8]; unpack8(*(const GAS v4u*)o, x); unpack8(*(const GAS v4u*)g, gg); float s = 0.f;
#pragma unroll
    for (int i = 0; i < 8; ++i) s += x[i] * x[i];
#pragma unroll
    for (int of = 1; of < 16; of <<= 1) s += __shfl_xor(s, of);
    const float inv = 1.0f / sqrtf(s * (1.f / 128.f) + EPS); const float* gn = F.in[I_GN] + l * 512 + 8 * lane;
#pragma unroll
    for (int i = 0; i < 8; ++i) x[i] = x[i] * inv * gn[i] * (gg[i] / (1.0f + __expf(-gg[i])));
    *(GAS v4u*)o = pack8(x);
}
__device__ __forceinline__ void conv_row(Frame& F, int l, int r) {
    const int lane = F.lane; const bf16* P = (const bf16*)(F.ws + WS_BIG);
    int r1, r2;
    if (r < MREAL) { const int b = r >> 12, t = r & 4095; r1 = seqrow(b, NMETA + t - 1); r2 = seqrow(b, NMETA + t - 2); }
    else { const int i = r - MREAL; r1 = i >= 1 ? r - 1 : -1; r2 = i >= 2 ? r - 2 : -1; }
    const float* cw = F.in[I_CONVW] + l * 3 * 512 + 8 * lane;
    float c0[8], u0[8], bb[8], y[8]; unpack8(*(const GAS v4u*)(P + (size_t)r * NNG + C_BC + 8 * lane), c0); unpack8(*(const GAS v4u*)(P + (size_t)r * NNG + C_BU + 8 * lane), u0); unpack8(*(const GAS v4u*)(P + (size_t)r * NNG + C_BB + 8 * lane), bb);
#pragma unroll
    for (int i = 0; i < 8; ++i) y[i] = cw[i] * (c0[i] * u0[i]);
    if (r1 >= 0) { unpack8(*(const GAS v4u*)(P + (size_t)r1 * NNG + C_BC + 8 * lane), c0); unpack8(*(const GAS v4u*)(P + (size_t)r1 * NNG + C_BU + 8 * lane), u0);
#pragma unroll
        for (int i = 0; i < 8; ++i) y[i] += cw[512 + i] * (c0[i] * u0[i]); }
    if (r2 >= 0) { unpack8(*(const GAS v4u*)(P + (size_t)r2 * NNG + C_BC + 8 * lane), c0); unpack8(*(const GAS v4u*)(P + (size_t)r2 * NNG + C_BU + 8 * lane), u0);
#pragma unroll
        for (int i = 0; i < 8; ++i) y[i] += cw[1024 + i] * (c0[i] * u0[i]); }
#pragma unroll
    for (int i = 0; i < 8; ++i) y[i] *= bb[i];
    *(GAS v4u*)((bf16*)(F.ws + WS_BR) + (size_t)MPAD * 512 + (size_t)r * 512 + 8 * lane) = pack8(y);
}
constexpr int CW_TMO = 0, CW_BAR = 4096, CW_Q = 16384;
__device__ __forceinline__ int queue_pop(Frame& F, int qi) {
    int t = 0; if (F.lane == 0) t = (int)__hip_atomic_fetch_add((unsigned*)(F.ctl + CW_Q + 64 * qi), 1u, RLX_AGENT);
    return __builtin_amdgcn_readfirstlane(t);
}
constexpr int NQT = (LSEQ + 31) / 32;
__device__ __forceinline__ void phase_mix1(Frame& F, int l) {
    LAS float* bt = (LAS float*)(F.lds + 135168);
    build_bias_table(F, bt, 0);
    __syncthreads();
    if (F.bid < NIDX_WG) {
        float* slab = (float*)(F.ws + WS_SCR) + (size_t)F.bid * 32 * LPAD;
        for (int t = F.bid; t < NB * NQT; t += NIDX_WG) { const int j = NQT - 1 - t / NB, b = t % NB; dsa_index_task(F, b, j, slab); }
    } else {
        const int u0 = F.bid - NIDX_WG, nw = F.G - NIDX_WG;
        const int unit = u0 + nw * F.wave;
        if (F.wave < 2 && unit < 64) hgrn_naive_unit(F, l, unit >> 3, (unit >> 1) & 3, unit & 1);
        else if (F.wave >= 2) { const int cw = u0 * 6 + (F.wave - 2), ncw = nw * 6; for (int r = cw; r < MREAL + NMETA; r += ncw) conv_row(F, l, r); }
    }
    float lam, post;
    { const float* lp = F.in[I_DLAM] + l * 256; const float s1 = wave_sum(lp[F.lane] * lp[64 + F.lane]), s2 = wave_sum(lp[128 + F.lane] * lp[192 + F.lane]);
      const float li = 0.8f - 0.6f * __expf(-0.3f * (float)l); lam = __expf(s1) - __expf(s2) + li; post = 1.0f - li; }
    for (;;) { const int t = queue_pop(F, 2 * l); if (t >= NB * 4 * NQT) break;
        const int j = NQT - 1 - t / 32, bh = t % 32; diff_attn_task(F, l, bh >> 2, bh & 3, j, bt, lam, post); }
}
__device__ __forceinline__ void phase_mix2(Frame& F, int l) {
    LAS float* bt = (LAS float*)(F.lds + 135168);
    build_bias_table(F, bt, 4);
    __syncthreads();
    const int gw = F.bid * NWAVES + F.wave, NGW = F.G * NWAVES;
    for (int r = gw; r < MREAL + NMETA; r += NGW) hgrn_finish_row(F, l, r);
    for (;;) { const int t = queue_pop(F, 2 * l + 1); if (t >= NB * 4 * NQT) break;
        const int j = NQT - 1 - t / 32, bh = t % 32; dsa_attn_task(F, bh >> 2, bh & 3, j, bt); }
}

#ifdef DBG_SEL
#ifndef DBG_NC
#define DBG_NC DM
#endif
__global__ void __launch_bounds__(256) k_dbg_argmax(const float* __restrict__ out, const float* __restrict__ x, unsigned long long* best) {
    unsigned long long loc = 0ull;
    for (size_t i = (size_t)blockIdx.x * blockDim.x + threadIdx.x; i < (size_t)MREAL * DM; i += (size_t)gridDim.x * blockDim.x) {
        const float d = fabsf(out[i] - x[i]); const unsigned long long k = ((unsigned long long)__float_as_uint(d) << 32) | (unsigned)i; loc = k > loc ? k : loc; }
    for (int o = 32; o >= 1; o >>= 1) { const unsigned long long t = __shfl_xor(loc, o); loc = t > loc ? t : loc; }
    if ((threadIdx.x & 63) == 0) atomicMax(best, loc);
}
__global__ void __launch_bounds__(256) k_dbg_count(const float* __restrict__ out, const float* __restrict__ x, unsigned* cnt  ) {
    const int gw = (blockIdx.x * blockDim.x + threadIdx.x) >> 6, lane = threadIdx.x & 63, ngw = (gridDim.x * blockDim.x) >> 6;
    for (int r = gw; r < MREAL; r += ngw) { float m = 0.f;
        for (int c = lane; c < DM; c += 64) m = fmaxf(m, fabsf(out[(size_t)r * DM + c] - x[(size_t)r * DM + c]));
        for (int o = 32; o >= 1; o >>= 1) m = fmaxf(m, __shfl_xor(m, o));
        if (lane == 0 && m > DBG_THR) { const int t = r & 4095; atomicAdd(cnt + 0, 1u); if (t < 32) atomicAdd(cnt + 1, 1u); if (t >= 4064) atomicAdd(cnt + 2, 1u); if (t < 256) atomicAdd(cnt + 3, 1u); } }
}

__global__ void __launch_bounds__(256) k_dbg_chk_merge(const unsigned short* BRm, const unsigned short* Wt, const unsigned short* G, const unsigned short* MG, int m, unsigned* cnt) {
    const int c = blockIdx.x * 256 + threadIdx.x;
    for (int r = blockIdx.y; r < MREAL; r += gridDim.y) {
        float s = 0.f; const unsigned short* a = BRm + (size_t)r * 512; const unsigned short* w = Wt + (size_t)c * 512;
        for (int k = 0; k < 512; ++k) s += __uint_as_float((unsigned)a[k] << 16) * __uint_as_float((unsigned)w[k] << 16);
        const float g = __uint_as_float((unsigned)G[(size_t)r * NGATE + m * DM + c] << 16), ref = g * s, got = __uint_as_float((unsigned)MG[(size_t)r * DM + c] << 16);
        const float err = fabsf(got - ref), tol = 0.02f * fabsf(ref) + 0.02f;
        if (!(err <= tol)) { atomicAdd(cnt + 4, 1u); const int t = r & 4095; if ((c & 255) < 128) atomicAdd(cnt + 5, 1u); if ((r & 255) < 128) atomicAdd(cnt + 6, 1u); if (fabsf(got) > 2.f * fabsf(ref)) atomicAdd(cnt + 7, 1u); (void)t; }
    }
}

__global__ void __launch_bounds__(256) k_dbg_naive_wo(const float* out, const unsigned short* MG, const unsigned short* Wt, float* chk) {
    const int c = blockIdx.x * 256 + threadIdx.x;
    for (int r = blockIdx.y; r < MREAL; r += gridDim.y) {
        float s = 0.f; const uint4* a = (const uint4*)(MG + (size_t)r * DM); const uint4* w = (const uint4*)(Wt + (size_t)c * DM);
        for (int k = 0; k < DM / 8; ++k) { const uint4 av = a[k], wv = w[k]; const unsigned aw[4] = {av.x, av.y, av.z, av.w}, ww[4] = {wv.x, wv.y, wv.z, wv.w};
#pragma unroll
            for (int j = 0; j < 4; ++j) { s += __uint_as_float(aw[j] << 16) * __uint_as_float(ww[j] << 16); s += __uint_as_float(aw[j] & 0xffff0000u) * __uint_as_float(ww[j] & 0xffff0000u); } }
        chk[(size_t)r * DM + c] = out[(size_t)r * DM + c] + s; }
}
__global__ void __launch_bounds__(256) k_dbg_cmp(const float* out, const float* chk, unsigned* cnt) {
    for (size_t i = (size_t)blockIdx.x * blockDim.x + threadIdx.x; i < (size_t)MREAL * DM; i += (size_t)gridDim.x * blockDim.x) {
        const float err = fabsf(out[i] - chk[i]); if (!(err <= 0.02f)) { atomicAdd(cnt + 4, 1u); const int c = (int)(i % DM), r = (int)(i / DM); if ((c & 255) < 128) atomicAdd(cnt + 5, 1u); if ((r & 255) < 128) atomicAdd(cnt + 6, 1u); if (err > 1.0f) atomicAdd(cnt + 7, 1u); } }
}

__global__ void __launch_bounds__(256) k_dbg_stats(const unsigned short* A, int ld, int ncols, unsigned* st) {
    const int gw = (blockIdx.x * blockDim.x + threadIdx.x) >> 6, lane = threadIdx.x & 63, ngw = (gridDim.x * blockDim.x) >> 6;
    float mx = 0.f, me = 0.f;
    for (int r = gw; r < MREAL; r += ngw) { float s = 0.f;
        for (int c = lane; c < ncols; c += 64) { const float v = __uint_as_float((unsigned)A[(size_t)r * ld + c] << 16); mx = fmaxf(mx, fabsf(v)); s += v * v; }
        for (int o = 32; o >= 1; o >>= 1) s += __shfl_xor(s, o);
        me = fmaxf(me, s / (float)ncols); }
    for (int o = 32; o >= 1; o >>= 1) mx = fmaxf(mx, __shfl_xor(mx, o));
    if (lane == 0) { atomicMax(st + 8, __float_as_uint(mx)); atomicMax(st + 9, __float_as_uint(me)); }
}

__global__ void __launch_bounds__(256) k_dbg_argmax_bf16(const unsigned short* A, int ld, int ncols, unsigned long long* best) {
    unsigned long long loc = 0ull;
    for (size_t i = (size_t)blockIdx.x * blockDim.x + threadIdx.x; i < (size_t)MREAL * ncols; i += (size_t)gridDim.x * blockDim.x) { const size_t r = i / ncols, c = i % ncols;
        const float d = fabsf(__uint_as_float((unsigned)A[r * ld + c] << 16)); const unsigned long long k = ((unsigned long long)__float_as_uint(d) << 32) | (unsigned)i; loc = k > loc ? k : loc; }
    for (int o = 32; o >= 1; o >>= 1) { const unsigned long long t = __shfl_xor(loc, o); loc = t > loc ? t : loc; }
    if ((threadIdx.x & 63) == 0) atomicMax(best, loc);
}

__global__ void __launch_bounds__(256) k_dbg_gcount(const unsigned short* G, unsigned* cnt) {
    const int gw = (blockIdx.x * blockDim.x + threadIdx.x) >> 6, lane = threadIdx.x & 63, ngw = (gridDim.x * blockDim.x) >> 6;
    for (int r = gw; r < MREAL; r += ngw) { int n = 0;
        for (int c = lane; c < NGATE; c += 64) { const float v = __uint_as_float((unsigned)G[(size_t)r * NGATE + c] << 16); if (!(v >= 0.f && v <= 1.001f)) ++n; }
        for (int o = 32; o >= 1; o >>= 1) n += __shfl_xor(n, o);
        if (lane == 0 && n) { const int t = r & 4095; atomicAdd(cnt + 10, (unsigned)n); atomicAdd(cnt + 11, 1u); if (t >= 4080) atomicAdd(cnt + 12, 1u); else atomicAdd(cnt + 13, 1u); } }
}
__global__ void __launch_bounds__(256) k_dbg_emit(float* out, const float* __restrict__ x, const unsigned long long* best, const unsigned* cnt) {
    const unsigned long long b = *best; const unsigned idx = (unsigned)b; const float val = __uint_as_float((unsigned)(b >> 32));
    const int row = idx / DBG_NC, col = idx % DBG_NC, bb = row >> 12, t = row & 4095;
    float N = 0.f;
    switch (DBG_SEL) {
        case 0: N = val; break;
        case 1: N = 2.f + bb; break;
        case 2: N = 2.f + (t >> 9); break;
        case 3: N = 2.f + ((t >> 6) & 7); break;
        case 4: N = 2.f + ((t >> 3) & 7); break;
        case 5: N = 2.f + (t & 7); break;
        case 6: N = 2.f + (col >> 8); break;
        case 60: N = 2.f + (col >> 10); break;
        case 61: N = 2.f + ((col >> 7) & 7); break;
        case 62: N = 2.f + ((col >> 4) & 7); break;
        case 63: N = 2.f + ((col >> 1) & 7); break;
        case 64: N = 2.f + (col & 1); break;
        case 65: N = 2.f + bb; break;
        case 66: N = 2.f + (t >> 9); break;
        case 67: N = 2.f + ((t >> 6) & 7); break;
        case 68: N = 2.f + ((t >> 3) & 7); break;
        case 69: N = 2.f + (t & 7); break;
        case 7: N = 2.f + ((col >> 5) & 7); break;
        case 8: N = 2.f + ((col >> 2) & 7); break;
        case 40: case 42: case 44: case 46: N = __uint_as_float(cnt[8]); break;
        case 41: case 43: case 45: case 47: N = __uint_as_float(cnt[9]); break;
        case 70: N = 2.f + log2f(1.f + (float)cnt[10]); break;
        case 71: N = 2.f + log2f(1.f + (float)cnt[11]); break;
        case 72: N = 2.f + log2f(1.f + (float)cnt[12]); break;
        case 73: N = 2.f + log2f(1.f + (float)cnt[13]); break;
        case 30: N = 2.f + log2f(1.f + (float)cnt[4]); break;
        case 31: N = 2.f + log2f(1.f + (float)cnt[5]); break;
        case 32: N = 2.f + log2f(1.f + (float)cnt[6]); break;
        case 33: N = 2.f + log2f(1.f + (float)cnt[7]); break;
        case 20: N = 2.f + log2f(1.f + (float)cnt[4]); break;
        case 21: N = 2.f + log2f(1.f + (float)cnt[5]); break;
        case 22: N = 2.f + log2f(1.f + (float)cnt[6]); break;
        case 23: N = 2.f + log2f(1.f + (float)cnt[7]); break;
        case 10: N = 2.f + log2f(1.f + (float)cnt[0]); break;
        case 11: N = 2.f + log2f(1.f + (float)cnt[1]); break;
        case 12: N = 2.f + log2f(1.f + (float)cnt[2]); break;
        case 13: N = 2.f + log2f(1.f + (float)cnt[3]); break;
    }
    const float c = 1.f + N;
    for (size_t i = (size_t)blockIdx.x * blockDim.x + threadIdx.x; i < (size_t)MREAL * DM; i += (size_t)gridDim.x * blockDim.x) out[i] = c * x[i];
}
#endif

#ifndef MK_ONE
#define MK_ONE 0
#endif
#ifndef BR_MASK
#define BR_MASK 15
#endif
constexpr int NPH = 18;
template <class T> __device__ __forceinline__ T opaque(T v) { asm volatile("" : "+s"(v)); return v; }
struct Args { const float* in[22]; float* out; unsigned char* ws; int ph_lo, ph_hi; };
__global__ void __launch_bounds__(NWAVES * 64, 2) fwd(Args args) {
    extern __shared__ __attribute__((aligned(16))) unsigned char lds[];
    Frame F;
    F.lds = (LAS unsigned char*)lds; F.MISC = (volatile LAS unsigned*)(F.lds + MISC_OFF);
    F.tid = threadIdx.x; F.lane = F.tid & 63; F.wave = __builtin_amdgcn_readfirstlane(F.tid >> 6); F.G = gridDim.x; F.bid = blockIdx.x;
    F.ws = args.ws; F.out = args.out; F.ctl = (gu32*)(args.ws + WS_CTL);
#pragma unroll
    for (int i = 0; i < 22; ++i) F.in[i] = args.in[i];
    for (int u = F.tid; u < (LDS_BYTES - LDSCTL_OFF) / 4; u += NWAVES * 64) ((LAS unsigned*)(F.lds + LDSCTL_OFF))[u] = 0u;
    __syncthreads();
#if MK_ONE
    XcdBarrier bar = xcd_barrier_post((unsigned*)(F.ctl + CW_BAR), F.MISC + 8);
#define GRID_BAR() xcd_barrier(bar)
#else
#define GRID_BAR() do { } while (0)
#endif
    const int lo = args.ph_lo, hi = args.ph_hi;
#define IN(k) (lo <= (k) && (k) < hi)
#define RETID() do { int t_ = threadIdx.x; asm volatile("" : "+v"(t_)); F.tid = t_; F.lane = t_ & 63; F.wave = __builtin_amdgcn_readfirstlane(t_ >> 6); } while (0)
#define SEAM(k) do { if (IN((k) + 1)) GRID_BAR(); } while (0)
    unsigned char* wb = F.ws + WS_W;
    bf16* XN = (bf16*)(F.ws + WS_XN); bf16* BR = (bf16*)(F.ws + WS_BR); bf16* BIG = (bf16*)(F.ws + WS_BIG); float* HM = (float*)(F.ws + WS_HM);
    for (int l = 0; l < 2; ++l) {
        const int pb = l * NPH;
        const float* hsrc = (l == 0) ? F.in[I_X] : F.out;
        if (IN(pb + 0)) { RETID(); phase_convert(F, l); SEAM(pb + 0); }
        if (IN(pb + 1)) { RETID(); phase_norm(F, hsrc, F.in[I_F1N] + l * DM); SEAM(pb + 1); }
        if (IN(pb + 2)) { RETID(); pg8::Gemm g{opaque((const bf16*)(XN)), opaque((const bf16*)(wb + W_GU1)), MPAD, NGU, DM}; pg8::StaticOrder S; S.init(MPAD, NGU, F.G, opaque(F.bid));
            pg8::EpiSwiGLU E{BIG, DFF}; pg8::gemm_phase<pg8::EpiSwiGLU, pg8::StaticOrder, true, true>(F.lds + RING_OFF, g, S, E); SEAM(pb + 2); }
        if (IN(pb + 3)) { RETID(); pg8::Gemm g{opaque((const bf16*)(BIG)), opaque((const bf16*)(wb + W_D1)), MPAD, DM, DFF}; pg8::StaticOrder S; S.init(MPAD, DM, F.G, opaque(F.bid));
            pg8::EpiResF32 E{hsrc, F.out, HM, DM, MT_REAL, 0.5f}; pg8::gemm_phase<pg8::EpiResF32, pg8::StaticOrder, true, true>(F.lds + RING_OFF, g, S, E); SEAM(pb + 3); }
        if (IN(pb + 4)) { RETID(); phase_norm(F, F.out, F.in[I_MIXN] + l * DM); SEAM(pb + 4); }
        if (IN(pb + 5)) { RETID(); pg8::Gemm g{opaque((const bf16*)(XN)), opaque((const bf16*)(wb + W_NG)), MPAD, NNG, DM}; pg8::StaticOrder S; S.init(MPAD, NNG, F.G, opaque(F.bid));
            pg8::EpiBf16<0> E{BIG, NNG}; pg8::gemm_phase<pg8::EpiBf16<0>, pg8::StaticOrder, true, true>(F.lds + RING_OFF, g, S, E); SEAM(pb + 5); }
        if (IN(pb + 6)) { RETID(); phase_prep(F, l); phase_vt(F); SEAM(pb + 6); }
        if (IN(pb + 7)) { RETID(); phase_mix1(F, l); SEAM(pb + 7); }
        if (IN(pb + 8)) { RETID(); phase_mix2(F, l); SEAM(pb + 8); }
        if (IN(pb + 9)) { RETID(); pg8::Gemm g{opaque((const bf16*)(XN)), opaque((const bf16*)(wb + W_G)), MPAD, NGATE, DM}; pg8::StaticOrder S; S.init(MPAD, NGATE, F.G, opaque(F.bid));
            pg8::EpiBf16<1> E{BIG, NGATE}; pg8::gemm_phase<pg8::EpiBf16<1>, pg8::StaticOrder, true, true>(F.lds + RING_OFF, g, S, E); SEAM(pb + 9); }
        for (int m = 0; m < 4; ++m)
            if (IN(pb + 10 + m) && ((BR_MASK >> m) & 1)) { RETID(); pg8::Gemm g{opaque((const bf16*)(BR + (size_t)m * MPAD * 512)), opaque((const bf16*)(wb + W_BR) + (size_t)m * DM * 512), MPAD, DM, 512}; pg8::StaticOrder S; S.init(MPAD, DM, F.G, opaque(F.bid));
                pg8::EpiGateAcc E{XN, DM, BIG, NGATE, m * DM, (BR_MASK & ((1 << m) - 1)) == 0}; pg8::gemm_phase<pg8::EpiGateAcc, pg8::StaticOrder, true, true>(F.lds + RING_OFF, g, S, E); SEAM(pb + 10 + m); }
        if (IN(pb + 14) && BR_MASK) { RETID(); pg8::Gemm g{opaque((const bf16*)(XN)), opaque((const bf16*)(wb + W_O)), MPAD, DM, DM}; pg8::StaticOrder S; S.init(MPAD, DM, F.G, opaque(F.bid));
            pg8::EpiResF32 E{F.out, F.out, HM, DM, MT_REAL, 1.0f}; pg8::gemm_phase<pg8::EpiResF32, pg8::StaticOrder, true, true>(F.lds + RING_OFF, g, S, E); SEAM(pb + 14); }
        if (IN(pb + 15)) { RETID(); phase_norm(F, F.out, F.in[I_F2N] + l * DM); SEAM(pb + 15); }
        if (IN(pb + 16)) { RETID(); pg8::Gemm g{opaque((const bf16*)(XN)), opaque((const bf16*)(wb + W_GU2)), MPAD, NGU, DM}; pg8::StaticOrder S; S.init(MPAD, NGU, F.G, opaque(F.bid));
            pg8::EpiSwiGLU E{BIG, DFF}; pg8::gemm_phase<pg8::EpiSwiGLU, pg8::StaticOrder, true, true>(F.lds + RING_OFF, g, S, E); SEAM(pb + 16); }
        if (IN(pb + 17)) { RETID(); pg8::Gemm g{opaque((const bf16*)(BIG)), opaque((const bf16*)(wb + W_D2)), MPAD, DM, DFF}; pg8::StaticOrder S; S.init(MPAD, DM, F.G, opaque(F.bid));
            pg8::EpiResF32 E{F.out, F.out, HM, DM, MT_REAL, 0.5f}; pg8::gemm_phase<pg8::EpiResF32, pg8::StaticOrder, true, true>(F.lds + RING_OFF, g, S, E); SEAM(pb + 17); }
    }
}

extern "C" void kernel_launch(void* const* d_in, const int* in_sizes, int n_in, void* d_out, int out_size, void* d_ws, size_t ws_size, hipStream_t stream) {
    static int grid = 0;
    if (grid == 0) {
        if (n_in != 22 || out_size != MREAL * DM || ws_size < WS_END) { fprintf(stderr, "kernel_launch: unexpected shapes (n_in %d out %d ws %zu need %zu)\n", n_in, out_size, ws_size, (size_t)WS_END); grid = -1; return; }
        int dev = 0, cus = 0, per_cu = 0;
        if (hipGetDevice(&dev) != hipSuccess || hipDeviceGetAttribute(&cus, hipDeviceAttributeMultiprocessorCount, dev) != hipSuccess) { grid = -1; return; }
        if (hipFuncSetAttribute((const void*)fwd, hipFuncAttributeMaxDynamicSharedMemorySize, LDS_BYTES) != hipSuccess) { fprintf(stderr, "kernel_launch: hipFuncSetAttribute failed\n"); grid = -1; return; }
        if (hipOccupancyMaxActiveBlocksPerMultiprocessor(&per_cu, (const void*)fwd, NWAVES * 64, LDS_BYTES) != hipSuccess || per_cu < 1) fprintf(stderr, "kernel_launch: occupancy query says %d\n", per_cu);
        (void)hipGetLastError();
        grid = cus < 256 ? cus : 256;
    }
    if (grid < 0) return;
    (void)hipMemsetAsync((char*)d_ws + WS_CTL, 0, CTL_ZERO_BYTES, stream);
    Args a{};
    for (int i = 0; i < 22; ++i) a.in[i] = (const float*)d_in[i];
    a.out = (float*)d_out; a.ws = (unsigned char*)d_ws;
#ifndef PH_END
#define PH_END (2 * NPH)
#endif
#if MK_ONE
    a.ph_lo = 0; a.ph_hi = PH_END;
    hipLaunchKernelGGL(fwd, dim3(grid), dim3(NWAVES * 64), LDS_BYTES, stream, a);
#else
    for (int p = 0; p < PH_END; ++p) { a.ph_lo = p; a.ph_hi = p + 1;
#if defined(DBG_SEL)
#ifdef DBG_PREFILL
        if (p == 9) (void)hipMemsetAsync((char*)d_ws + WS_BIG, 0x3F, (size_t)MPAD * NGATE * 2, stream);
#endif
        if (DBG_SEL >= 30 && DBG_SEL < 40 && p == 14) hipLaunchKernelGGL(k_dbg_naive_wo, dim3(8, 2048), dim3(256), 0, stream, (const float*)d_out, (const unsigned short*)((char*)d_ws + WS_XN), (const unsigned short*)((char*)d_ws + WS_W + W_O), (float*)((char*)d_ws + WS_BIG));
#endif
        hipLaunchKernelGGL(fwd, dim3(grid), dim3(NWAVES * 64), LDS_BYTES, stream, a); }
#endif
#ifdef DBG_SEL
    { unsigned long long* best = (unsigned long long*)((char*)d_ws + 512 * 1024); unsigned* cnt = (unsigned*)((char*)d_ws + 512 * 1024 + 64);
      if (DBG_SEL >= 60 && DBG_SEL < 70) hipLaunchKernelGGL(k_dbg_argmax_bf16, dim3(2048), dim3(256), 0, stream, (const unsigned short*)((char*)d_ws + WS_BIG), NGATE, NGATE, best);
      else hipLaunchKernelGGL(k_dbg_argmax, dim3(2048), dim3(256), 0, stream, (const float*)d_out, (const float*)d_in[0], best);
      hipLaunchKernelGGL(k_dbg_count, dim3(2048), dim3(256), 0, stream, (const float*)d_out, (const float*)d_in[0], cnt);
      if (DBG_SEL >= 20 && DBG_SEL < 30) { const int mm = 1; hipLaunchKernelGGL(k_dbg_chk_merge, dim3(8, 2048), dim3(256), 0, stream, (const unsigned short*)((char*)d_ws + WS_BR) + (size_t)mm * MPAD * 512, (const unsigned short*)((char*)d_ws + WS_W + W_BR) + (size_t)mm * DM * 512, (const unsigned short*)((char*)d_ws + WS_BIG), (const unsigned short*)((char*)d_ws + WS_XN), mm, cnt); }
      if (DBG_SEL >= 30 && DBG_SEL < 40) hipLaunchKernelGGL(k_dbg_cmp, dim3(2048), dim3(256), 0, stream, (const float*)d_out, (const float*)((char*)d_ws + WS_BIG), cnt);
      if (DBG_SEL >= 40 && DBG_SEL < 50) { const unsigned short* A = nullptr; int ld = 0, nc = 0;
        if (DBG_SEL < 42) { A = (const unsigned short*)((char*)d_ws + WS_BR) + (size_t)MPAD * 512; ld = 512; nc = 512; }
        else if (DBG_SEL < 44) { A = (const unsigned short*)((char*)d_ws + WS_BIG) + DM; ld = NGATE; nc = DM; }
        else if (DBG_SEL < 46) { A = (const unsigned short*)((char*)d_ws + WS_XN); ld = DM; nc = DM; }
        else { A = (const unsigned short*)((char*)d_ws + WS_BR); ld = 512; nc = 512; }
        hipLaunchKernelGGL(k_dbg_stats, dim3(1024), dim3(256), 0, stream, A, ld, nc, cnt); }
      if (DBG_SEL >= 70 && DBG_SEL < 80) hipLaunchKernelGGL(k_dbg_gcount, dim3(1024), dim3(256), 0, stream, (const unsigned short*)((char*)d_ws + WS_BIG), cnt);
      hipLaunchKernelGGL(k_dbg_emit, dim3(2048), dim3(256), 0, stream, (float*)d_out, (const float*)d_in[0], best, cnt); }
#endif
}
```

```cpp
#include <hip/hip_runtime.h>
#include <cstdio>
#include <cstdint>
#define MK_ONE 1
namespace pg8 {
#define PG8_LAS __attribute__((address_space(3)))
typedef unsigned short bf16_t;
typedef short bf16x8 __attribute__((ext_vector_type(8)));
typedef float f32x4 __attribute__((ext_vector_type(4)));
typedef unsigned u32x4 __attribute__((ext_vector_type(4)));
constexpr int BM = 256, BK = 64, HALF = 128, HTB = HALF * BK * 2  , STAGE_BYTES = 8 * HTB, NXCD = 8, WGM = 8;

__host__ __device__ __forceinline__ int lds_byte(int r, int c) { const int st = (r >> 4) * 2 + (c >> 5), rr = r & 15, cc = c & 31, ob = rr * 64 + cc * 2; return st * 1024 + (ob ^ (((ob >> 9) & 1) << 5)); }
__host__ __device__ __forceinline__ void stage_rc(int b, int& R, int& C) { const int st = b / 1024, sb = b % 1024, swz = sb ^ (((sb >> 9) & 1) << 5); R = (st >> 1) * 16 + swz / 64; C = (st & 1) * 32 + (swz % 64) / 2; }
__host__ __device__ __forceinline__ int perm32(int rho) { const int n = rho >> 4, i = rho & 15; return 8 * (i >> 2) + 4 * n + (i & 3); }

struct Unit { int pm, pn; };
struct Gemm { const bf16_t* A; const bf16_t* Bt; int M, N, K; };

struct StaticOrder {
    int nM, nN, nwg, G, c;
    __host__ __device__ void init(int M, int N, int G_, int c_) { nM = M / BM; nN = N / BM; nwg = nM * nN; G = G_; c = c_; }
    __host__ __device__ bool next(int i, Unit& u) const {
        const long L = (long)i * G + c; if (L >= nwg) return false;
        int wgid = (int)L; { const int q = nwg / NXCD, r = nwg % NXCD, xcd = wgid % NXCD, off = wgid / NXCD; wgid = (xcd < r ? xcd * (q + 1) : r * (q + 1) + (xcd - r) * q) + off; }
        const int nig = WGM * nN, gid = wgid / nig, fm = gid * WGM, gsz = (nM - fm) < WGM ? (nM - fm) : WGM;
        u.pm = fm + ((wgid % nig) % gsz); u.pn = (wgid % nig) / gsz; return true;
    }
    __device__ __forceinline__ void a_ready(const Unit&) const {}
    __device__ __forceinline__ void done(const Unit&) const {}
};
typedef __bf16 bf16x2_hw __attribute__((ext_vector_type(2))); typedef float f32x2_hw __attribute__((ext_vector_type(2)));
__device__ __forceinline__ unsigned cvt_pk_bf16(float lo, float hi) { const f32x2_hw v = {lo, hi}; return __builtin_bit_cast(unsigned, __builtin_convertvector(v, bf16x2_hw)); }
typedef float f32x2 __attribute__((ext_vector_type(2)));
__device__ __forceinline__ float fast_sigmoid(float x) { return __builtin_amdgcn_rcpf(1.0f + __expf(-x)); }
__device__ __forceinline__ float fast_silu(float x) { return x * fast_sigmoid(x); }
template <int ACT  > struct EpiBf16 {
    static constexpr bool PERM = true, AFTER_DRAIN = false;
    bf16_t* O; int ldc;
    __device__ __forceinline__ void operator()(const f32x4 (&acc)[2][2][4][2], const Unit& u, int wr, int wc, int fr, int fq) const {
        const int row0 = u.pm * BM + wr * 64 + fr; const int col0 = u.pn * BM + wc * 32 + 8 * fq;
#pragma unroll
        for (int ai = 0; ai < 2; ++ai)
#pragma unroll
            for (int m = 0; m < 4; ++m) { bf16_t* rowp = O + (size_t)(row0 + ai * HALF + m * 16) * ldc + col0;
#pragma unroll
                for (int bj = 0; bj < 2; ++bj) { f32x4 v0 = acc[ai][bj][m][0], v1 = acc[ai][bj][m][1];
                    if (ACT == 1) {
#pragma unroll
                        for (int j = 0; j < 4; ++j) { v0[j] = fast_sigmoid(v0[j]); v1[j] = fast_sigmoid(v1[j]); } }
                    u32x4 w; w.x = cvt_pk_bf16(v0[0], v0[1]); w.y = cvt_pk_bf16(v0[2], v0[3]); w.z = cvt_pk_bf16(v1[0], v1[1]); w.w = cvt_pk_bf16(v1[2], v1[3]);
                    *(u32x4*)(rowp + bj * HALF) = w; } }
    }
};
struct EpiSwiGLU {
    static constexpr bool PERM = true, AFTER_DRAIN = false;
    bf16_t* O; int ldc;
    __device__ __forceinline__ void operator()(const f32x4 (&acc)[2][2][4][2], const Unit& u, int wr, int wc, int fr, int fq) const {
        const int row0 = u.pm * BM + wr * 64 + fr; const int col0 = u.pn * HALF + wc * 32 + 8 * fq;
#pragma unroll
        for (int ai = 0; ai < 2; ++ai)
#pragma unroll
            for (int m = 0; m < 4; ++m) { bf16_t* rowp = O + (size_t)(row0 + ai * HALF + m * 16) * ldc + col0;
                const f32x4 g0 = acc[ai][0][m][0], g1 = acc[ai][0][m][1], u0 = acc[ai][1][m][0], u1 = acc[ai][1][m][1];
                f32x4 v0, v1;
#pragma unroll
                for (int j = 0; j < 4; ++j) { v0[j] = fast_silu(g0[j]) * u0[j]; v1[j] = fast_silu(g1[j]) * u1[j]; }
                u32x4 w; w.x = cvt_pk_bf16(v0[0], v0[1]); w.y = cvt_pk_bf16(v0[2], v0[3]); w.z = cvt_pk_bf16(v1[0], v1[1]); w.w = cvt_pk_bf16(v1[2], v1[3]);
                *(u32x4*)rowp = w; asm volatile("" ::: "memory"); }
    }
};
struct EpiResF32 {
    static constexpr bool PERM = false, AFTER_DRAIN = false;
    const float* base_r; float* out_r; float* hm; int ldc; int mt_real; float scale;
    __device__ __forceinline__ void operator()(const f32x4 (&acc)[2][2][4][2], const Unit& u, int wr, int wc, int fr, int fq) const {
        const bool real = u.pm < mt_real;
        const float* bp = real ? base_r + (size_t)u.pm * BM * ldc : hm; float* op = real ? out_r + (size_t)u.pm * BM * ldc : hm;
        const int row0 = wr * 64 + fr, col0 = u.pn * BM + wc * 32 + 4 * fq;
#pragma unroll
        for (int ai = 0; ai < 2; ++ai)
#pragma unroll
            for (int m = 0; m < 4; ++m) { const size_t off = (size_t)(row0 + ai * HALF + m * 16) * ldc + col0;
#pragma unroll
                for (int bj = 0; bj < 2; ++bj)
#pragma unroll
                    for (int n = 0; n < 2; ++n) { const f32x4 b = *(const f32x4*)(bp + off + bj * HALF + n * 16); *(f32x4*)(op + off + bj * HALF + n * 16) = b + acc[ai][bj][m][n] * scale; }
                asm volatile("" ::: "memory"); }
    }
};
struct EpiGateAcc {
    static constexpr bool PERM = true, AFTER_DRAIN = false;
    bf16_t* MG; int ldc; const bf16_t* G; int ldg; int gcol0; int first;
    __device__ __forceinline__ void operator()(const f32x4 (&acc)[2][2][4][2], const Unit& u, int wr, int wc, int fr, int fq) const {
        const int row0 = u.pm * BM + wr * 64 + fr; const int col0 = u.pn * BM + wc * 32 + 8 * fq;
#pragma unroll
        for (int ai = 0; ai < 2; ++ai)
#pragma unroll
            for (int m = 0; m < 4; ++m) { const size_t r = (size_t)(row0 + ai * HALF + m * 16);
#pragma unroll
                for (int bj = 0; bj < 2; ++bj) { const u32x4 gw = *(const u32x4*)(G + r * ldg + gcol0 + col0 + bj * HALF);
                    u32x4 pw = (u32x4){0u, 0u, 0u, 0u}; if (!first) pw = *(const u32x4*)(MG + r * ldc + col0 + bj * HALF);
                    float o[8];
#pragma unroll
                    for (int j = 0; j < 4; ++j) { const float a0 = (j < 2) ? acc[ai][bj][m][0][2 * j] : acc[ai][bj][m][1][2 * (j - 2)], a1 = (j < 2) ? acc[ai][bj][m][0][2 * j + 1] : acc[ai][bj][m][1][2 * (j - 2) + 1];
                        o[2 * j] = __uint_as_float(pw[j] << 16) + __uint_as_float(gw[j] << 16) * a0; o[2 * j + 1] = __uint_as_float(pw[j] & 0xffff0000u) + __uint_as_float(gw[j] & 0xffff0000u) * a1; }
                    u32x4 w; w.x = cvt_pk_bf16(o[0], o[1]); w.y = cvt_pk_bf16(o[2], o[3]); w.z = cvt_pk_bf16(o[4], o[5]); w.w = cvt_pk_bf16(o[6], o[7]);
                    *(u32x4*)(MG + r * ldc + col0 + bj * HALF) = w; } }
    }
};
template <class Epi, class Sched, bool ALIGN_EPI = false, bool SP2 = false>
__device__ __forceinline__ void gemm_phase(PG8_LAS unsigned char* lds, const Gemm g, const Sched& S, const Epi& E) {
    int tid_ = threadIdx.x; asm volatile("" : "+v"(tid_));
    const int tid = tid_, wid = __builtin_amdgcn_readfirstlane(tid >> 6), lane = tid & 63, wr = wid >> 2, wc = wid & 3, fr = lane & 15, fq = lane >> 4;
    const int K = g.K, nt = K / BK;
    unsigned voffA[2], voffB[2];
#pragma unroll
    for (int i = 0; i < 2; ++i) { int R, C; stage_rc(tid * 16 + i * 8192, R, C); const int Rb = Epi::PERM ? ((R & ~31) + perm32(R & 31)) : R;
        voffA[i] = (unsigned)(R * K + C) * 2u; voffB[i] = (unsigned)(Rb * K + C) * 2u; }
    const size_t kstep = (size_t)(BK * 2);
    const size_t hstep = (size_t)HALF * K * 2;
    const size_t tstep = 2 * hstep;
    const unsigned ldsw = (unsigned)wid * 1024u;
    const int aoff = lds_byte(wr * 64 + fr, fq * 8), boff = lds_byte(wc * 32 + fr, fq * 8);
#define PG8_SA(b, h) (((b) * 2 + (h)) * HTB)
#define PG8_SB(b, h) ((4 + (b) * 2 + (h)) * HTB)
#define PG8_STAGE(bufoff, gbase, voff) do { _Pragma("unroll") for (int _i = 0; _i < 2; ++_i) \
        __builtin_amdgcn_global_load_lds((const unsigned*)((const char*)(gbase) + (voff)[_i]), (PG8_LAS unsigned*)(lds + (bufoff) + ldsw + _i * 8192), 16, 0, 0); } while (0)
#define PG8_LDA(dst, b, h) do { _Pragma("unroll") for (int m = 0; m < 4; ++m) _Pragma("unroll") for (int k = 0; k < 2; ++k) dst[m][k] = *(const PG8_LAS bf16x8*)(lds + PG8_SA(b, h) + aoff + m * 2048 + k * 1024); } while (0)
#define PG8_LDB(dst, b, h) do { _Pragma("unroll") for (int n = 0; n < 2; ++n) _Pragma("unroll") for (int k = 0; k < 2; ++k) dst[n][k] = *(const PG8_LAS bf16x8*)(lds + PG8_SB(b, h) + boff + n * 2048 + k * 1024); } while (0)
#define PG8_MMA(ai, bj, At, Bt) do { __builtin_amdgcn_s_setprio(1); _Pragma("unroll") for (int m = 0; m < 4; ++m) _Pragma("unroll") for (int n = 0; n < 2; ++n) _Pragma("unroll") for (int k = 0; k < 2; ++k) \
        acc[ai][bj][m][n] = __builtin_amdgcn_mfma_f32_16x16x32_bf16(Bt[n][k], At[m][k], acc[ai][bj][m][n], 0, 0, 0); __builtin_amdgcn_s_setprio(0); } while (0)
#define PG8_WAIT_V(n) asm volatile("s_waitcnt vmcnt(" #n ")" ::: "memory")
#define PG8_WAIT_L(n) asm volatile("s_waitcnt lgkmcnt(" #n ")" ::: "memory")
#define PG8_BAR __builtin_amdgcn_s_barrier()
#define PG8_SCHED __builtin_amdgcn_sched_barrier(0)
    Unit cur, nxt; int ui = 0;
    if (!S.next(0, cur)) return;
    f32x4 acc[2][2][4][2];
#pragma unroll
    for (int a = 0; a < 2; ++a)
#pragma unroll
        for (int b = 0; b < 2; ++b)
#pragma unroll
            for (int m = 0; m < 4; ++m)
#pragma unroll
                for (int n = 0; n < 2; ++n) acc[a][b][m][n] = (f32x4){0.f, 0.f, 0.f, 0.f};
    bf16x8 At[4][2], B0[2][2], B1[2][2];
    const char* cA = (const char*)g.A + (size_t)cur.pm * tstep; const char* cB = (const char*)g.Bt + (size_t)cur.pn * tstep;
    S.a_ready(cur);
    if constexpr (SP2) {
        PG8_STAGE(PG8_SB(0, 0), cB, voffB); PG8_STAGE(PG8_SB(0, 1), cB + hstep, voffB); PG8_STAGE(PG8_SA(0, 0), cA, voffA); PG8_STAGE(PG8_SA(0, 1), cA + hstep, voffA);
        if (wr == 1) PG8_BAR;
        PG8_WAIT_V(2); PG8_BAR;
        PG8_STAGE(PG8_SB(1, 0), cB + kstep, voffB); PG8_STAGE(PG8_SA(1, 0), cA + kstep, voffA); PG8_STAGE(PG8_SB(1, 1), cB + hstep + kstep, voffB);
        PG8_WAIT_V(6); PG8_BAR;
    } else {
        PG8_STAGE(PG8_SB(0, 0), cB, voffB); PG8_STAGE(PG8_SA(0, 0), cA, voffA); PG8_STAGE(PG8_SB(0, 1), cB + hstep, voffB); PG8_STAGE(PG8_SA(0, 1), cA + hstep, voffA);
        if (wr == 1) PG8_BAR;
        PG8_WAIT_V(4); PG8_BAR;
        PG8_STAGE(PG8_SB(1, 0), cB + kstep, voffB); PG8_STAGE(PG8_SA(1, 0), cA + kstep, voffA); PG8_STAGE(PG8_SB(1, 1), cB + hstep + kstep, voffB);
        PG8_WAIT_V(6); PG8_BAR;
    }
    for (;;) {
        const bool has_next = S.next(ui + 1, nxt);
        const char* nA = has_next ? (const char*)g.A + (size_t)nxt.pm * tstep : cA; const char* nB = has_next ? (const char*)g.Bt + (size_t)nxt.pn * tstep : cB;
        for (int t = 0; t < nt; t += 2) {
            const bool last = (t == nt - 2);
            const char* a1 = cA + (size_t)(t + 1) * kstep;
            const char* a2 = last ? nA : cA + (size_t)(t + 2) * kstep; const char* b2 = last ? nB : cB + (size_t)(t + 2) * kstep;
            const char* a3 = a2 + kstep; const char* b3 = b2 + kstep;
            if (last && has_next) S.a_ready(nxt);
            if constexpr (SP2) {
            PG8_LDB(B0, 0, 0); PG8_LDB(B1, 0, 1); PG8_SCHED; PG8_LDA(At, 0, 0); PG8_STAGE(PG8_SA(1, 1), a1 + hstep, voffA);
            PG8_WAIT_V(8); PG8_WAIT_L(0); PG8_BAR; PG8_MMA(0, 0, At, B0); PG8_MMA(0, 1, At, B1); PG8_BAR; PG8_SCHED;
            PG8_LDA(At, 0, 1); PG8_STAGE(PG8_SB(0, 0), b2, voffB); PG8_STAGE(PG8_SB(0, 1), b2 + hstep, voffB); PG8_STAGE(PG8_SA(0, 0), a2, voffA);
            PG8_WAIT_V(8); PG8_WAIT_L(0); PG8_BAR; PG8_MMA(1, 0, At, B0); PG8_MMA(1, 1, At, B1); PG8_BAR; PG8_SCHED;
            PG8_LDB(B0, 1, 0); PG8_LDB(B1, 1, 1); PG8_SCHED; PG8_LDA(At, 1, 0); PG8_STAGE(PG8_SA(0, 1), a2 + hstep, voffA);
            PG8_WAIT_V(8); PG8_WAIT_L(0); PG8_BAR; PG8_MMA(0, 0, At, B0); PG8_MMA(0, 1, At, B1); PG8_BAR; PG8_SCHED;
            PG8_LDA(At, 1, 1); PG8_STAGE(PG8_SB(1, 0), b3, voffB); PG8_STAGE(PG8_SB(1, 1), b3 + hstep, voffB); PG8_STAGE(PG8_SA(1, 0), a3, voffA);
            PG8_WAIT_V(8); PG8_WAIT_L(0); PG8_BAR; PG8_MMA(1, 0, At, B0); PG8_MMA(1, 1, At, B1); PG8_BAR; PG8_SCHED;
            } else {
            PG8_LDB(B0, 0, 0); PG8_SCHED; PG8_LDA(At, 0, 0); PG8_STAGE(PG8_SA(1, 1), a1 + hstep, voffA);
            PG8_WAIT_L(8); PG8_BAR; PG8_WAIT_L(0); PG8_MMA(0, 0, At, B0); PG8_BAR; PG8_SCHED;
            PG8_LDB(B1, 0, 1); PG8_STAGE(PG8_SB(0, 0), b2, voffB);
            PG8_BAR; PG8_WAIT_L(0); PG8_MMA(0, 1, At, B1); PG8_BAR;
            PG8_LDA(At, 0, 1); PG8_STAGE(PG8_SA(0, 0), a2, voffA);
            PG8_BAR; PG8_WAIT_L(0); PG8_MMA(1, 0, At, B0); PG8_BAR; PG8_SCHED;
            PG8_STAGE(PG8_SB(0, 1), b2 + hstep, voffB);
            PG8_WAIT_V(6); PG8_BAR; PG8_MMA(1, 1, At, B1); PG8_BAR;
            PG8_LDB(B0, 1, 0); PG8_SCHED; PG8_LDA(At, 1, 0); PG8_STAGE(PG8_SA(0, 1), a2 + hstep, voffA);
            PG8_WAIT_L(8); PG8_BAR; PG8_WAIT_L(0); PG8_MMA(0, 0, At, B0); PG8_BAR; PG8_SCHED;
            PG8_LDB(B1, 1, 1); PG8_STAGE(PG8_SB(1, 0), b3, voffB);
            PG8_BAR; PG8_WAIT_L(0); PG8_MMA(0, 1, At, B1); PG8_BAR;
            PG8_LDA(At, 1, 1); PG8_STAGE(PG8_SA(1, 0), a3, voffA);
            PG8_BAR; PG8_WAIT_L(0); PG8_MMA(1, 0, At, B0); PG8_BAR; PG8_SCHED;
            PG8_STAGE(PG8_SB(1, 1), b3 + hstep, voffB);
            PG8_WAIT_V(6); PG8_BAR; PG8_MMA(1, 1, At, B1); PG8_BAR;
            }
        }
        if constexpr (ALIGN_EPI) { if (wr == 0) PG8_BAR; }
        if constexpr (!Epi::AFTER_DRAIN) { E(acc, cur, wr, wc, fr, fq); S.done(cur); }
        if (!has_next) break;
#pragma unroll
        for (int a = 0; a < 2; ++a)
#pragma unroll
            for (int b = 0; b < 2; ++b)
#pragma unroll
                for (int m = 0; m < 4; ++m)
#pragma unroll
                    for (int n = 0; n < 2; ++n) acc[a][b][m][n] = (f32x4){0.f, 0.f, 0.f, 0.f};
        cur = nxt; cA = nA; cB = nB; ++ui;
        if constexpr (ALIGN_EPI) { if (wr == 1) PG8_BAR; }
    }
    PG8_WAIT_V(0);
    if constexpr (!ALIGN_EPI) { if (wr == 0) PG8_BAR; }
    PG8_BAR;
    if constexpr (Epi::AFTER_DRAIN) { E.fused(acc, cur, wr, wc, fr, fq, lds, wid, lane); S.done(cur); }
#undef PG8_SA
#undef PG8_SB
#undef PG8_STAGE
#undef PG8_LDA
#undef PG8_LDB
#undef PG8_MMA
#undef PG8_WAIT_V
#undef PG8_WAIT_L
#undef PG8_BAR
#undef PG8_SCHED
}
}

constexpr int DM = 2048, NB = 8, SEQ = 4096, NMETA = 16, LSEQ = 4112, LPAD = 4128;
constexpr int MREAL = NB * SEQ;
constexpr int MPAD = MREAL + 256;
constexpr int MT_REAL = MREAL / 256;
constexpr int DFF = 5632, NGU = 2 * DFF, NNG = 7168, NGATE = 8192, INCOLS = 15184, NGC = 6992;
constexpr int NWAVES = 8;
constexpr float EPS = 1e-6f;
constexpr int C_AQ = 0, C_AF = 512, C_AI = 1024, C_AG = 1536, C_BB = 2048, C_BC = 2560, C_BU = 3072, C_CQ = 3584, C_CK = 4096, C_CV = 4608,
              C_DQ = 5120, C_DK = 5632, C_DV = 5760, C_DQI = 5888, C_DKI = 6912, C_DW = 6976;

constexpr size_t MiB = 1u << 20;
constexpr size_t WS_CTL = 0, CTL_ZERO_BYTES = 1 * MiB;
constexpr size_t WS_HM = 1 * MiB;
constexpr size_t WS_W = 4 * MiB;
constexpr size_t W_GU1 = 0, W_D1 = W_GU1 + (size_t)NGU * DM * 2, W_NG = W_D1 + (size_t)DM * DFF * 2, W_G = W_NG + (size_t)NNG * DM * 2,
                 W_BR = W_G + (size_t)NGATE * DM * 2, W_O = W_BR + (size_t)4 * DM * 512 * 2, W_GU2 = W_O + (size_t)DM * DM * 2, W_D2 = W_GU2 + (size_t)NGU * DM * 2,
                 W_END = W_D2 + (size_t)DM * DFF * 2;
constexpr size_t WS_XN = WS_W + W_END;
constexpr size_t WS_BR = WS_XN + (size_t)MPAD * DM * 2;
constexpr size_t WS_BIG = WS_BR + (size_t)MPAD * DM * 2;
constexpr size_t BIG_P_END = (size_t)MPAD * NNG * 2;
constexpr size_t WS_VTC = WS_BIG + BIG_P_END;
constexpr size_t WS_VTD = WS_VTC + (size_t)NB * 4 * 128 * LPAD * 2;
constexpr size_t WS_MASK = WS_VTD + (size_t)NB * 128 * LPAD * 2;
constexpr int MASKW = 132;
constexpr int NIDX_WG = 208;
constexpr size_t WS_SCR = WS_MASK + (size_t)NB * LPAD * MASKW * 4;
constexpr size_t WS_END = WS_SCR + (size_t)NIDX_WG * 32 * LPAD * 4;
static_assert(WS_BIG + (size_t)MPAD * NGATE * 2 <= WS_END, "G fits");
static_assert(WS_END <= (size_t)1138174976, "workspace map fits the guaranteed size");

constexpr int RING_OFF = 0, RING_BYTES = 131072;
constexpr int LDSCTL_OFF = 143360, MISC_OFF = LDSCTL_OFF + 320;
constexpr int LDS_BYTES = 147456;

#define GAS __attribute__((address_space(1)))
#define LAS __attribute__((address_space(3)))
typedef unsigned short bf16;
typedef unsigned v4u __attribute__((ext_vector_type(4)));
typedef unsigned v2u __attribute__((ext_vector_type(2)));
typedef float f32x4 __attribute__((ext_vector_type(4)));
typedef float f32x16 __attribute__((ext_vector_type(16)));
typedef short bf16x8 __attribute__((ext_vector_type(8)));
typedef GAS unsigned gu32;
#define RLX_AGENT __ATOMIC_RELAXED, __HIP_MEMORY_SCOPE_AGENT
#define LDS_WAIT() asm volatile("s_waitcnt lgkmcnt(0)" ::: "memory")
#define VM_WAIT() asm volatile("s_waitcnt vmcnt(0)" ::: "memory")
__device__ __forceinline__ unsigned f2bf(float f) { unsigned u = __builtin_bit_cast(unsigned, f); return (u + 0x7fffu + ((u >> 16) & 1u)) >> 16; }
__device__ __forceinline__ unsigned pk2(float lo, float hi) { return pg8::cvt_pk_bf16(lo, hi); }
__device__ __forceinline__ float bflo(unsigned w) { return __uint_as_float(w << 16); }
__device__ __forceinline__ float bfhi(unsigned w) { return __uint_as_float(w & 0xffff0000u); }
__device__ __forceinline__ float bf2f(bf16 v) { return __uint_as_float((unsigned)v << 16); }
__device__ __forceinline__ int seqrow(int b, int p) { return p < NMETA ? MREAL + p : b * SEQ + p - NMETA; }
__device__ __forceinline__ int rel_bucket(int n) {
    if (n < 16) return n; if (n >= 128) return 31;
    const int v = 16 + (int)(__log2f((float)n * 0.0625f) * 5.33333333f); return v < 31 ? v : 31; }
__device__ __forceinline__ float wave_sum(float v) {
#pragma unroll
    for (int o = 1; o < 64; o <<= 1) v += __shfl_xor(v, o);
    return v;
}
#define XB_TMO      128
#define XB_XCNT(j)  (256  + 64 * (j))
#define XB_XSUB(j)  (1280 + 64 * (j))
#define XB_XGEN(j)  (2304 + 64 * (j))
#define XB_TOP      3328
#define XB_TOPGEN   3392
#define XCD_BAR_WORDS 3456
#define XB_SPIN_CAP (1u << 18)

__device__ __forceinline__ unsigned xb_ld(unsigned* p)              { return __hip_atomic_load(p, __ATOMIC_RELAXED, __HIP_MEMORY_SCOPE_AGENT); }
__device__ __forceinline__ unsigned xb_add(unsigned* p, unsigned v) { return __hip_atomic_fetch_add(p, v, __ATOMIC_RELAXED, __HIP_MEMORY_SCOPE_AGENT); }
__device__ __forceinline__ unsigned xb_xcc_id() { return (unsigned)__builtin_amdgcn_s_getreg((3 << 11) | 20) & 0xFu; }
#define XB_SPIN(cond, bar) do { unsigned _sp = 0; while (cond) { __builtin_amdgcn_s_sleep(1); \
    if ((++_sp & 255u) == 0u) { if (xb_ld(&(bar)[XB_TMO])) break; if (_sp > XB_SPIN_CAP) { atomicAdd(&(bar)[XB_TMO], 1u); break; } } } } while (0)

struct XcdBarrier {
    unsigned* bar; unsigned x;
    volatile LAS unsigned* st;
};

__device__ __forceinline__ XcdBarrier xcd_barrier_post(unsigned* bar, volatile LAS unsigned* st) {
    XcdBarrier b; b.bar = bar; b.x = xb_xcc_id(); b.st = st;
    if (threadIdx.x == 0) (void)xb_add(&bar[XB_XCNT(b.x)], 1u);
    return b;
}
__device__ __forceinline__ void xcd_barrier_complete(unsigned* bar, unsigned x, unsigned& nloc, unsigned& nx) {
    const unsigned G = gridDim.x * gridDim.y * gridDim.z;
    unsigned sum, cnt, mine, sp = 0u;
    for (;;) {
        sum = 0u; cnt = 0u; mine = 0u;
#pragma unroll
        for (unsigned j = 0; j < 16; ++j) { const unsigned c = xb_ld(&bar[XB_XCNT(j)]); sum += c; cnt += (c > 0u) ? 1u : 0u; mine = (j == x) ? c : mine; }
        if (sum == G) break;
        __builtin_amdgcn_s_sleep(1);
        if ((++sp & 255u) == 0u) { if (xb_ld(&bar[XB_TMO])) break; if (sp > XB_SPIN_CAP) { atomicAdd(&bar[XB_TMO], 1u); break; } }
    }
    nloc = mine > 0u ? mine : 1u; nx = cnt > 0u ? cnt : 1u;
}

__device__ __forceinline__ void xcd_barrier(const XcdBarrier& b) {
    asm volatile("s_waitcnt vmcnt(0)" ::: "memory");
    __syncthreads();
    if (threadIdx.x == 0) {
        unsigned* bar = b.bar;
        __builtin_amdgcn_s_waitcnt(0);
        unsigned nloc = b.st[0], nx = b.st[1];
        if (nloc == 0u) { xcd_barrier_complete(bar, b.x, nloc, nx); b.st[0] = nloc; b.st[1] = nx; }
        const unsigned old = xb_add(&bar[XB_XSUB(b.x)], 1u);
        const unsigned gen = old / nloc;
        if (old + 1u == (gen + 1u) * nloc) {
            __builtin_amdgcn_fence(__ATOMIC_RELEASE, "agent");
            asm volatile("s_waitcnt vmcnt(0)" ::: "memory");
            const unsigned og = xb_add(&bar[XB_TOP], 1u);
            const unsigned tg = og / nx;
            if (og + 1u == (tg + 1u) * nx) xb_add(&bar[XB_TOPGEN], 1u);
            else XB_SPIN(xb_ld(&bar[XB_TOPGEN]) == tg, bar);
            __builtin_amdgcn_fence(__ATOMIC_ACQUIRE, "agent");
            xb_add(&bar[XB_XGEN(b.x)], 1u);
            asm volatile("s_waitcnt vmcnt(0)" ::: "memory");
        } else {
            XB_SPIN(xb_ld(&bar[XB_XGEN(b.x)]) == gen, bar);
            __builtin_amdgcn_fence(__ATOMIC_ACQUIRE, "agent");
            asm volatile("s_waitcnt vmcnt(0)" ::: "memory");
        }
    }
    __syncthreads();
}

struct Frame {
    LAS unsigned char* lds;
    volatile LAS unsigned* MISC;
    gu32* ctl;
    int tid, lane, wave, G, bid;
    const float* in[22]; float* out; unsigned char* ws;
};
enum { I_X = 0, I_META, I_RELB, I_F1N, I_F1GU, I_F1D, I_MIXN, I_WIN, I_LB, I_GN, I_CONVW, I_DQN, I_DKN, I_DLAM, I_DSUB, I_SQN, I_SKN, I_WBR, I_WOUT, I_F2N, I_F2GU, I_F2D };

template <class RowMap>
__device__ __forceinline__ void transpose_item(const float* W, int K, int N, bf16* WT, LAS float* scr, int item, int lane, RowMap rm) {
    const int nblk = (N + 31) / 32, kb = item / nblk, nb = item % nblk, k0 = 64 * kb, n0 = 32 * nb;
    const int nl = n0 + (lane & 31); const bool nok = nl < N;
#pragma unroll 8
    for (int i = 0; i < 32; ++i) { const int kk = 2 * i + (lane >> 5); scr[kk * 33 + (lane & 31)] = nok ? W[(size_t)(k0 + kk) * N + nl] : 0.f; }
    LDS_WAIT(); asm volatile("" ::: "memory");
    const int c = lane & 7;
#pragma unroll
    for (int j = 0; j < 4; ++j) { const int n = (lane >> 3) + 8 * j; const LAS float* s = scr + (8 * c) * 33 + n;
        v4u o; o.x = pk2(s[0 * 33], s[1 * 33]); o.y = pk2(s[2 * 33], s[3 * 33]); o.z = pk2(s[4 * 33], s[5 * 33]); o.w = pk2(s[6 * 33], s[7 * 33]);
        if (n0 + n < N) *(GAS v4u*)(WT + (size_t)rm(n0 + n) * K + k0 + 8 * c) = o; }
    LDS_WAIT(); asm volatile("" ::: "memory");
}
struct MapId { __device__ __forceinline__ int operator()(int n) const { return n; } };
struct MapGU { __device__ __forceinline__ int operator()(int n) const { const int up = n >= DFF, j = up ? n - DFF : n; return 256 * (j >> 7) + 128 * up + (j & 127); } };
struct MapIn { __device__ __forceinline__ int operator()(int n) const { return n < NGC ? n : n + (NNG - NGC); } };
template <class RowMap>
__device__ __forceinline__ void convert_matrix(Frame& F, const float* W, int K, int N, bf16* WT, RowMap rm) {
    LAS float* scr = (LAS float*)(F.lds + F.wave * 16384);
    const int gw = F.bid * NWAVES + F.wave, NGW = F.G * NWAVES, nitems = (K / 64) * ((N + 31) / 32);
    for (int it = gw; it < nitems; it += NGW) transpose_item(W, K, N, WT, scr, it, F.lane, rm);
}
__device__ __forceinline__ void phase_convert(Frame& F, int l) {
    unsigned char* wb = F.ws + WS_W;
    convert_matrix(F, F.in[I_F1GU] + (size_t)l * DM * NGU, DM, NGU, (bf16*)(wb + W_GU1), MapGU());
    convert_matrix(F, F.in[I_F1D] + (size_t)l * DFF * DM, DFF, DM, (bf16*)(wb + W_D1), MapId());
    convert_matrix(F, F.in[I_WIN] + (size_t)l * DM * INCOLS, DM, INCOLS, (bf16*)(wb + W_NG), MapIn());
    for (int m = 0; m < 4; ++m) convert_matrix(F, F.in[I_WBR] + ((size_t)l * 4 + m) * 512 * DM, 512, DM, (bf16*)(wb + W_BR) + (size_t)m * DM * 512, MapId());
    convert_matrix(F, F.in[I_WOUT] + (size_t)l * DM * DM, DM, DM, (bf16*)(wb + W_O), MapId());
    convert_matrix(F, F.in[I_F2GU] + (size_t)l * DM * NGU, DM, NGU, (bf16*)(wb + W_GU2), MapGU());
    convert_matrix(F, F.in[I_F2D] + (size_t)l * DFF * DM, DFF, DM, (bf16*)(wb + W_D2), MapId());
    { GAS v4u* z = (GAS v4u*)(wb + W_NG + (size_t)NGC * DM * 2); const int n16 = (NNG - NGC) * DM * 2 / 16;
      for (int i = F.bid * 512 + F.tid; i < n16; i += F.G * 512) z[i] = (v4u){0u, 0u, 0u, 0u}; }
    if (l == 0) {
        GAS f32x4* hm = (GAS f32x4*)(F.ws + WS_HM); const GAS f32x4* mt = (const GAS f32x4*)F.in[I_META];
        for (int i = F.bid * 512 + F.tid; i < 256 * DM / 4; i += F.G * 512) hm[i] = (i < NMETA * DM / 4) ? mt[i] : (f32x4){0.f, 0.f, 0.f, 0.f};
    }
}
__device__ __forceinline__ void phase_norm(Frame& F, const float* src_real, const float* gain) {
    const int gw = F.bid * NWAVES + F.wave, NGW = F.G * NWAVES;
    bf16* XN = (bf16*)(F.ws + WS_XN); const float* hm = (const float*)(F.ws + WS_HM);
    f32x4 g[8];
#pragma unroll
    for (int j = 0; j < 8; ++j) g[j] = ((const GAS f32x4*)gain)[F.lane + 64 * j];
    for (int r = gw; r < MPAD; r += NGW) {
        GAS v2u* o8 = (GAS v2u*)(XN + (size_t)r * DM) + F.lane;
        if (r >= MREAL + NMETA) {
#pragma unroll
            for (int j = 0; j < 8; ++j) o8[64 * j] = (v2u){0u, 0u};
            continue; }
        const float* xr = r < MREAL ? src_real + (size_t)r * DM : hm + (size_t)(r - MREAL) * DM;
        f32x4 v[8]; float s = 0.f;
#pragma unroll
        for (int j = 0; j < 8; ++j) { v[j] = ((const GAS f32x4*)xr)[F.lane + 64 * j]; s += (v[j].x * v[j].x + v[j].y * v[j].y) + (v[j].z * v[j].z + v[j].w * v[j].w); }
        const float inv = 1.0f / sqrtf(wave_sum(s) * (1.f / DM) + EPS);
#pragma unroll
        for (int j = 0; j < 8; ++j) { v2u w; w.x = pk2(v[j].x * inv * g[j].x, v[j].y * inv * g[j].y); w.y = pk2(v[j].z * inv * g[j].z, v[j].w * inv * g[j].w); o8[64 * j] = w; }
    }
}
__device__ __forceinline__ void unpack8(const v4u w, float (&x)[8]) { x[0] = bflo(w.x); x[1] = bfhi(w.x); x[2] = bflo(w.y); x[3] = bfhi(w.y); x[4] = bflo(w.z); x[5] = bfhi(w.z); x[6] = bflo(w.w); x[7] = bfhi(w.w); }
__device__ __forceinline__ v4u pack8(const float (&x)[8]) { v4u w; w.x = pk2(x[0], x[1]); w.y = pk2(x[2], x[3]); w.z = pk2(x[4], x[5]); w.w = pk2(x[6], x[7]); return w; }
template <int GL>
__device__ __forceinline__ void norm_cols_inplace(bf16* p, const float* gain, float scale, int lane, bool wr) {
    float x[8]; unpack8(*(const GAS v4u*)p, x); float s = 0.f;
#pragma unroll
    for (int i = 0; i < 8; ++i) s += x[i] * x[i];
#pragma unroll
    for (int o = 1; o < GL; o <<= 1) s += __shfl_xor(s, o);
    const float inv = scale / sqrtf(s * (1.f / (GL * 8)) + EPS); const int g0 = (8 * lane) % (GL * 8);
#pragma unroll
    for (int i = 0; i < 8; ++i) x[i] = x[i] * inv * gain[g0 + i];
    if (wr) *(GAS v4u*)p = pack8(x);
}
__device__ __forceinline__ void phase_prep(Frame& F, int l) {
    const int gw = F.bid * NWAVES + F.wave, NGW = F.G * NWAVES, lane = F.lane;
    bf16* P = (bf16*)(F.ws + WS_BIG);
    const float *dqn = F.in[I_DQN] + l * 64, *dkn = F.in[I_DKN] + l * 64, *sqn = F.in[I_SQN] + l * 128, *skn = F.in[I_SKN] + l * 128;
    for (int r = gw; r < MREAL + NMETA; r += NGW) {
        bf16* pr = P + (size_t)r * NNG;
        norm_cols_inplace<8>(pr + C_CQ + 8 * lane, dqn, 0.125f, lane, true);
        norm_cols_inplace<8>(pr + C_CK + 8 * lane, dkn, 1.0f, lane, true);
        norm_cols_inplace<16>(pr + C_DQ + 8 * lane, sqn, 0.08838834764831845f, lane, true);
        norm_cols_inplace<16>(pr + C_DK + 8 * (lane & 15), skn, 1.0f, lane & 15, lane < 16);
    }
}
__device__ __forceinline__ void phase_vt(Frame& F) {
    const int gw = F.bid * NWAVES + F.wave, NGW = F.G * NWAVES, lane = F.lane;
    const bf16* P = (const bf16*)(F.ws + WS_BIG); bf16* VtC = (bf16*)(F.ws + WS_VTC); bf16* VtD = (bf16*)(F.ws + WS_VTD);
    LAS bf16* T = (LAS bf16*)(F.lds + F.wave * 17408);
    constexpr int NPB = (LPAD + 63) / 64;
    for (int task = gw; task < NB * 5 * NPB; task += NGW) {
        const int pb = task % NPB, mat = (task / NPB) % 5, b = task / (NPB * 5), p0 = 64 * pb;
        const int col = mat < 4 ? C_CV + 128 * mat : C_DV;
#pragma unroll 4
        for (int i = 0; i < 16; ++i) { const int pl = 4 * i + (lane >> 4), p = p0 + pl; v4u w = (v4u){0u, 0u, 0u, 0u};
            if (p < LSEQ) w = *(const GAS v4u*)(P + (size_t)seqrow(b, p) * NNG + col + 8 * (lane & 15));
            *(LAS v4u*)(T + pl * 136 + 8 * (lane & 15)) = w; }
        LDS_WAIT(); asm volatile("" ::: "memory");
        bf16* dst = mat < 4 ? VtC + (size_t)(b * 4 + mat) * 128 * LPAD : VtD + (size_t)b * 128 * LPAD;
#pragma unroll 4
        for (int it = 0; it < 16; ++it) { const int e = 8 * it + (lane >> 3), c = lane & 7; unsigned short x[8];
#pragma unroll
            for (int k = 0; k < 8; ++k) x[k] = T[(8 * c + k) * 136 + e];
            v4u w; w.x = x[0] | ((unsigned)x[1] << 16); w.y = x[2] | ((unsigned)x[3] << 16); w.z = x[4] | ((unsigned)x[5] << 16); w.w = x[6] | ((unsigned)x[7] << 16);
            if (p0 + 8 * c < LPAD) *(GAS v4u*)(dst + (size_t)e * LPAD + p0 + 8 * c) = w; }
        LDS_WAIT(); asm volatile("" ::: "memory");
    }
}

#define NEG_INF (-__builtin_inff())
__device__ __forceinline__ bf16x8 ld_frag16(const bf16* p) { return *(const GAS bf16x8*)p; }
__device__ __forceinline__ bf16x8 mk_frag(v2u lo, v2u hi) { v4u w; w.x = lo.x; w.y = lo.y; w.z = hi.x; w.w = hi.y; return __builtin_bit_cast(bf16x8, w); }
__device__ __forceinline__ unsigned cvtpk(float lo, float hi) { return pg8::cvt_pk_bf16(lo, hi); }
__device__ __forceinline__ void build_bias_table(Frame& F, LAS float* bt, int col0) {
    const float* rb = F.in[I_RELB];
    for (int i = F.tid; i < 4 * 128; i += 512) { const int hd = i >> 7, n = i & 127; bt[i] = rb[rel_bucket(n) * 8 + col0 + hd]; }
}
__device__ __forceinline__ void softmax_step(f32x16& S, float& m, float& lsum, float& alpha) {
    float tm = S[0];
#pragma unroll
    for (int r = 1; r < 16; ++r) tm = fmaxf(tm, S[r]);
    tm = fmaxf(tm, __shfl_xor(tm, 32));
    const float mn = fmaxf(m, tm), mref = (mn == NEG_INF) ? 0.f : mn;
    alpha = __expf(m - mref);
    float rs = 0.f;
#pragma unroll
    for (int r = 0; r < 16; ++r) { S[r] = __expf(S[r] - mref); rs += S[r]; }
    rs += __shfl_xor(rs, 32);
    lsum = lsum * alpha + rs; m = mn;
}
__device__ __forceinline__ void pv_step(f32x16 (&O)[4], const f32x16& S, const bf16* vt0  ) {
    bf16x8 pf[2];
#pragma unroll
    for (int s = 0; s < 2; ++s) { v4u w; w.x = cvtpk(S[8 * s + 0], S[8 * s + 1]); w.y = cvtpk(S[8 * s + 2], S[8 * s + 3]); w.z = cvtpk(S[8 * s + 4], S[8 * s + 5]); w.w = cvtpk(S[8 * s + 6], S[8 * s + 7]); pf[s] = __builtin_bit_cast(bf16x8, w); }
#pragma unroll
    for (int eb = 0; eb < 4; ++eb)
#pragma unroll
        for (int s = 0; s < 2; ++s) { const bf16* vp = vt0 + (size_t)eb * 32 * LPAD + 16 * s;
            const bf16x8 vf = mk_frag(*(const GAS v2u*)vp, *(const GAS v2u*)(vp + 8));
            O[eb] = __builtin_amdgcn_mfma_f32_32x32x16_bf16(vf, pf[s], O[eb], 0, 0, 0); }
}
__device__ __forceinline__ void diff_attn_task(Frame& F, int l, int b, int h, int j, const LAS float* bt, float lam, float post) {
    const int lane = F.lane, ql = lane & 31, hh = lane >> 5;
    const bf16* P = (const bf16*)(F.ws + WS_BIG); const bf16* Vt = (const bf16*)(F.ws + WS_VTC) + ((size_t)(b * 4 + h) * 128 + ql) * LPAD + 4 * hh;
    const int pq = 32 * j + ql, pqc = pq < LSEQ ? pq : LSEQ - 1;
    const bf16* qrow = P + (size_t)seqrow(b, pqc) * NNG + C_CQ + h * 128 + 8 * hh;
    const float b31 = bt[h * 128 + 127];
    f32x16 R[4];
#pragma unroll
    for (int c = 0; c < 2; ++c) {
        bf16x8 qf[4];
#pragma unroll
        for (int ks = 0; ks < 4; ++ks) qf[ks] = ld_frag16(qrow + c * 64 + 16 * ks);
        float m = NEG_INF, lsum = 0.f; f32x16 O[4];
#pragma unroll
        for (int eb = 0; eb < 4; ++eb)
#pragma unroll
            for (int r = 0; r < 16; ++r) O[eb][r] = 0.f;
        for (int kt = 0; kt <= j; ++kt) {
            const int pk = 32 * kt + ql, pkc = pk < LSEQ ? pk : LSEQ - 1;
            const bf16* krow = P + (size_t)seqrow(b, pkc) * NNG + C_CK + h * 128 + c * 64 + 8 * hh;
            f32x16 S;
#pragma unroll
            for (int r = 0; r < 16; ++r) S[r] = 0.f;
#pragma unroll
            for (int ks = 0; ks < 4; ++ks) S = __builtin_amdgcn_mfma_f32_32x32x16_bf16(ld_frag16(krow + 16 * ks), qf[ks], S, 0, 0, 0);
            if (kt + 4 >= j) {
#pragma unroll
                for (int r = 0; r < 16; ++r) { const int kp = 32 * kt + 4 * hh + (r & 3) + 8 * (r >> 2), n = pq - kp; S[r] = (n >= 0) ? S[r] + bt[h * 128 + (n < 127 ? n : 127)] : NEG_INF; }
            } else {
#pragma unroll
                for (int r = 0; r < 16; ++r) S[r] += b31;
            }
            float alpha; softmax_step(S, m, lsum, alpha);
#pragma unroll
            for (int eb = 0; eb < 4; ++eb)
#pragma unroll
                for (int r = 0; r < 16; ++r) O[eb][r] *= alpha;
            pv_step(O, S, Vt + 32 * kt);
        }
        const float il = 1.0f / lsum;
        if (c == 0) {
#pragma unroll
            for (int eb = 0; eb < 4; ++eb)
#pragma unroll
                for (int r = 0; r < 16; ++r) R[eb][r] = O[eb][r] * il;
        } else {
#pragma unroll
            for (int eb = 0; eb < 4; ++eb)
#pragma unroll
                for (int r = 0; r < 16; ++r) R[eb][r] -= lam * (O[eb][r] * il);
        }
    }
    float ss = 0.f;
#pragma unroll
    for (int eb = 0; eb < 4; ++eb)
#pragma unroll
        for (int r = 0; r < 16; ++r) ss += R[eb][r] * R[eb][r];
    ss += __shfl_xor(ss, 32);
    const float inv = post / sqrtf(ss * (1.f / 128.f) + EPS);
    const float* sub = F.in[I_DSUB] + l * 128;
    if (pq < LSEQ && (pq >= NMETA || b == 0)) {
        bf16* orow = (bf16*)(F.ws + WS_BR) + (size_t)2 * MPAD * 512 + (size_t)seqrow(b, pq) * 512 + h * 128;
#pragma unroll
        for (int eb = 0; eb < 4; ++eb)
#pragma unroll
            for (int g = 0; g < 4; ++g) { const int e0 = 32 * eb + 8 * g + 4 * hh; const f32x4 sv = *(const GAS f32x4*)(sub + e0);
                v2u w; w.x = pk2(R[eb][4 * g] * inv * sv.x, R[eb][4 * g + 1] * inv * sv.y); w.y = pk2(R[eb][4 * g + 2] * inv * sv.z, R[eb][4 * g + 3] * inv * sv.w);
                *(GAS v2u*)(orow + e0) = w; }
    }
}
__device__ __forceinline__ void dsa_attn_task(Frame& F, int b, int h, int j, const LAS float* bt) {
    const int lane = F.lane, ql = lane & 31, hh = lane >> 5;
    const bf16* P = (const bf16*)(F.ws + WS_BIG); const bf16* Vt = (const bf16*)(F.ws + WS_VTD) + ((size_t)b * 128 + ql) * LPAD + 4 * hh;
    const int pq = 32 * j + ql, pqc = pq < LSEQ ? pq : LSEQ - 1;
    const bf16* qrow = P + (size_t)seqrow(b, pqc) * NNG + C_DQ + h * 128 + 8 * hh;
    const unsigned* mrow = (const unsigned*)(F.ws + WS_MASK) + ((size_t)b * LPAD + pqc) * MASKW;
    const float b31 = bt[h * 128 + 127];
    bf16x8 qf[8];
#pragma unroll
    for (int ks = 0; ks < 8; ++ks) qf[ks] = ld_frag16(qrow + 16 * ks);
    float m = NEG_INF, lsum = 0.f; f32x16 O[4];
#pragma unroll
    for (int eb = 0; eb < 4; ++eb)
#pragma unroll
        for (int r = 0; r < 16; ++r) O[eb][r] = 0.f;
    for (int kt = 0; kt <= j; ++kt) {
        const int pk = 32 * kt + ql, pkc = pk < LSEQ ? pk : LSEQ - 1;
        const bf16* krow = P + (size_t)seqrow(b, pkc) * NNG + C_DK + 8 * hh;
        const unsigned mw = mrow[kt] >> (4 * hh);
        f32x16 S;
#pragma unroll
        for (int r = 0; r < 16; ++r) S[r] = 0.f;
#pragma unroll
        for (int ks = 0; ks < 8; ++ks) S = __builtin_amdgcn_mfma_f32_32x32x16_bf16(ld_frag16(krow + 16 * ks), qf[ks], S, 0, 0, 0);
        if (kt + 4 >= j) {
#pragma unroll
            for (int r = 0; r < 16; ++r) { const int kp = 32 * kt + 4 * hh + (r & 3) + 8 * (r >> 2), n = pq - kp; const bool sel = (mw >> ((r & 3) + 8 * (r >> 2))) & 1u;
                S[r] = (sel && n >= 0) ? S[r] + bt[h * 128 + (n < 127 ? n : 127)] : NEG_INF; }
        } else {
#pragma unroll
            for (int r = 0; r < 16; ++r) { const bool sel = (mw >> ((r & 3) + 8 * (r >> 2))) & 1u; S[r] = sel ? S[r] + b31 : NEG_INF; }
        }
        float alpha; softmax_step(S, m, lsum, alpha);
#pragma unroll
        for (int eb = 0; eb < 4; ++eb)
#pragma unroll
            for (int r = 0; r < 16; ++r) O[eb][r] *= alpha;
        pv_step(O, S, Vt + 32 * kt);
    }
    const float il = 1.0f / lsum;
    if (pq < LSEQ && (pq >= NMETA || b == 0)) {
        bf16* orow = (bf16*)(F.ws + WS_BR) + (size_t)3 * MPAD * 512 + (size_t)seqrow(b, pq) * 512 + h * 128;
#pragma unroll
        for (int eb = 0; eb < 4; ++eb)
#pragma unroll
            for (int g = 0; g < 4; ++g) { const int e0 = 32 * eb + 8 * g + 4 * hh;
                v2u w; w.x = pk2(O[eb][4 * g] * il, O[eb][4 * g + 1] * il); w.y = pk2(O[eb][4 * g + 2] * il, O[eb][4 * g + 3] * il);
                *(GAS v2u*)(orow + e0) = w; }
    }
}
__device__ __forceinline__ unsigned f32_key(float f) { const unsigned u = __float_as_uint(f); return u ^ ((u >> 31) ? 0xffffffffu : 0x80000000u); }
__device__ __forceinline__ void dsa_index_task(Frame& F, int b, int j, float* slab) {
    const int lane = F.lane, ql = lane & 31, hh = lane >> 5, wave = F.wave;
    const bf16* P = (const bf16*)(F.ws + WS_BIG);
    LAS unsigned char* qi = F.lds;
    for (int i = F.tid; i < 32 * 128; i += 512) { const int q = i >> 7, ch = i & 127; int pq = 32 * j + q; pq = pq < LSEQ ? pq : LSEQ - 1;
        *(LAS v4u*)(qi + q * 2064 + 16 * ch) = *(const GAS v4u*)(P + (size_t)seqrow(b, pq) * NNG + C_DQI + 8 * ch); }
    LAS float* wl = (LAS float*)(qi + 32 * 2064);
    if (F.tid < 32 * 16) { const int q = F.tid >> 4, hd = F.tid & 15; int pq = 32 * j + q; pq = pq < LSEQ ? pq : LSEQ - 1;
        wl[F.tid] = bf2f(P[(size_t)seqrow(b, pq) * NNG + C_DW + hd]) * 0.03125f; }
    LDS_WAIT(); __syncthreads();
    for (int kt = wave; kt <= j; kt += NWAVES) {
        const int pk = 32 * kt + ql, pkc = pk < LSEQ ? pk : LSEQ - 1;
        const bf16* krow = P + (size_t)seqrow(b, pkc) * NNG + C_DKI + 8 * hh;
        bf16x8 kf[4];
#pragma unroll
        for (int ks = 0; ks < 4; ++ks) kf[ks] = ld_frag16(krow + 16 * ks);
        f32x16 idx;
#pragma unroll
        for (int r = 0; r < 16; ++r) idx[r] = 0.f;
#pragma unroll 1
        for (int hd = 0; hd < 16; ++hd) { f32x16 S; const float wh = wl[ql * 16 + hd];
#pragma unroll
            for (int r = 0; r < 16; ++r) S[r] = 0.f;
#pragma unroll
            for (int ks = 0; ks < 4; ++ks) S = __builtin_amdgcn_mfma_f32_32x32x16_bf16(kf[ks], *(const LAS bf16x8*)(qi + ql * 2064 + hd * 128 + 32 * ks + 16 * hh), S, 0, 0, 0);
#pragma unroll
            for (int r = 0; r < 16; ++r) idx[r] += wh * fmaxf(S[r], 0.f); }
        float* srow = slab + (size_t)ql * LPAD + 32 * kt + 4 * hh;
#pragma unroll
        for (int g = 0; g < 4; ++g) *(GAS f32x4*)(srow + 8 * g) = (f32x4){idx[4 * g], idx[4 * g + 1], idx[4 * g + 2], idx[4 * g + 3]};
    }
    VM_WAIT(); __syncthreads();
    for (int qq = wave; qq < 32; qq += NWAVES) {
        const int p = 32 * j + qq; if (p >= LSEQ) break;
        const float* row = slab + (size_t)qq * LPAD;
        unsigned u[65];
#pragma unroll
        for (int i = 0; i < 65; ++i) { const int key = 64 * i + lane; u[i] = 0u; if (key <= p) u[i] = f32_key(((const GAS float*)row)[key]); }
        unsigned T = 1u;
        if (p + 1 > 256) { T = 0u;
            for (int bit = 31; bit >= 0; --bit) { const unsigned cand = T | (1u << bit); int cnt = 0;
#pragma unroll
                for (int i = 0; i < 65; ++i) cnt += (u[i] >= cand) ? 1 : 0;
#pragma unroll
                for (int o = 1; o < 64; o <<= 1) cnt += __shfl_xor(cnt, o);
                if (cnt >= 256) T = cand; } }
        unsigned long long* mrow = (unsigned long long*)((unsigned*)(F.ws + WS_MASK) + ((size_t)b * LPAD + p) * MASKW);
#pragma unroll
        for (int i = 0; i < 65; ++i) { const unsigned long long bal = __ballot(u[i] >= T); if (lane == 0) mrow[i] = bal; }
    }
    __syncthreads();
}
__device__ __forceinline__ void hgrn_naive_unit(Frame& F, int l, int b, int h, int eb) {
    const int lane = F.lane; const bf16* P = (const bf16*)(F.ws + WS_BIG); bf16* BR0 = (bf16*)(F.ws + WS_BR);
    LAS float* fs = (LAS float*)(F.lds + F.wave * 16384); LAS float* qs = fs + 16 * 128;
    float lbv[2];
#pragma unroll
    for (int dd = 0; dd < 2; ++dd) { const int ch = h * 128 + lane + 64 * dd; lbv[dd] = 0.f;
        if (l == 1) { const float a = F.in[I_LB][ch], c = F.in[I_LB][512 + ch]; lbv[dd] = 1.0f / (1.0f + __expf(a - c)); } }
    float S[128];
#pragma unroll
    for (int d = 0; d < 128; ++d) S[d] = 0.f;
    const int e = eb * 64 + lane;
    for (int p0 = 0; p0 < LSEQ; p0 += 16) {
#pragma unroll 4
        for (int tt = 0; tt < 16; ++tt) { const bf16* pr = P + (size_t)seqrow(b, p0 + tt) * NNG + h * 128;
#pragma unroll
            for (int dd = 0; dd < 2; ++dd) { const int d = lane + 64 * dd; const float z = bf2f(pr[C_AF + d]), q = bf2f(pr[C_AQ + d]);
                const float sg = 1.0f / (1.0f + __expf(-z)); fs[tt * 128 + d] = lbv[dd] + (1.0f - lbv[dd]) * sg; qs[tt * 128 + d] = q / (1.0f + __expf(-q)); } }
        LDS_WAIT(); asm volatile("" ::: "memory");
        for (int tt = 0; tt < 16; ++tt) { const int row = seqrow(b, p0 + tt); const float v = bf2f(P[(size_t)row * NNG + C_AI + h * 128 + e]); float o = 0.f;
#pragma unroll
            for (int d4 = 0; d4 < 32; ++d4) { const f32x4 f = *(const LAS f32x4*)(fs + tt * 128 + 4 * d4), q = *(const LAS f32x4*)(qs + tt * 128 + 4 * d4);
#pragma unroll
                for (int k = 0; k < 4; ++k) { S[4 * d4 + k] = f[k] * S[4 * d4 + k] + (1.0f - f[k]) * v; o += q[k] * S[4 * d4 + k]; } }
            if (p0 + tt >= NMETA || b == 0) BR0[(size_t)row * 512 + h * 128 + e] = (bf16)f2bf(o); }
        LDS_WAIT(); asm volatile("" ::: "memory");
    }
}
__device__ __forceinline__ void hgrn_finish_row(Frame& F, int l, int r) {
    const int lane = F.lane; bf16* o = (bf16*)(F.ws + WS_BR) + (size_t)r * 512 + 8 * lane; const bf16* g = (const bf16*)(F.ws + WS_BIG) + (size_t)r * NNG + C_AG + 8 * lane;
    float x[8], gg[8]; unpack8(*(const GAS v4u*)o, x); unpack8(*(const GAS v4u*)g, gg); float s = 0.f;
#pragma unroll
    for (int i = 0; i < 8; ++i) s += x[i] * x[i];
#pragma unroll
    for (int of = 1; of < 16; of <<= 1) s += __shfl_xor(s, of);
    const float inv = 1.0f / sqrtf(s * (1.f / 128.f) + EPS); const float* gn = F.in[I_GN] + l * 512 + 8 * lane;
#pragma unroll
    for (int i = 0; i < 8; ++i) x[i] = x[i] * inv * gn[i] * (gg[i] / (1.0f + __expf(-gg[i])));
    *(GAS v4u*)o = pack8(x);
}
__device__ __forceinline__ void conv_row(Frame& F, int l, int r) {
    const int lane = F.lane; const bf16* P = (const bf16*)(F.ws + WS_BIG);
    int r1, r2;
    if (r < MREAL) { const int b = r >> 12, t = r & 4095; r1 = seqrow(b, NMETA + t - 1); r2 = seqrow(b, NMETA + t - 2); }
    else { const int i = r - MREAL; r1 = i >= 1 ? r - 1 : -1; r2 = i >= 2 ? r - 2 : -1; }
    const float* cw = F.in[I_CONVW] + l * 3 * 512 + 8 * lane;
    float c0[8], u0[8], bb[8], y[8]; unpack8(*(const GAS v4u*)(P + (size_t)r * NNG + C_BC + 8 * lane), c0); unpack8(*(const GAS v4u*)(P + (size_t)r * NNG + C_BU + 8 * lane), u0); unpack8(*(const GAS v4u*)(P + (size_t)r * NNG + C_BB + 8 * lane), bb);
#pragma unroll
    for (int i = 0; i < 8; ++i) y[i] = cw[i] * (c0[i] * u0[i]);
    if (r1 >= 0) { unpack8(*(const GAS v4u*)(P + (size_t)r1 * NNG + C_BC + 8 * lane), c0); unpack8(*(const GAS v4u*)(P + (size_t)r1 * NNG + C_BU + 8 * lane), u0);
#pragma unroll
        for (int i = 0; i < 8; ++i) y[i] += cw[512 + i] * (c0[i] * u0[i]); }
    if (r2 >= 0) { unpack8(*(const GAS v4u*)(P + (size_t)r2 * NNG + C_BC + 8 * lane), c0); unpack8(*(const GAS v4u*)(P + (size_t)r2 * NNG + C_BU + 8 * lane), u0);
#pragma unroll
        for (int i = 0; i < 8; ++i) y[i] += cw[1024 + i] * (c0[i] * u0[i]); }
#pragma unroll
    for (int i = 0; i < 8; ++i) y[i] *= bb[i];
    *(GAS v4u*)((bf16*)(F.ws + WS_BR) + (size_t)MPAD * 512 + (size_t)r * 512 + 8 * lane) = pack8(y);
}
constexpr int CW_TMO = 0, CW_BAR = 4096, CW_Q = 16384;
__device__ __forceinline__ int queue_pop(Frame& F, int qi) {
    int t = 0; if (F.lane == 0) t = (int)__hip_atomic_fetch_add((unsigned*)(F.ctl + CW_Q + 64 * qi), 1u, RLX_AGENT);
    return __builtin_amdgcn_readfirstlane(t);
}
constexpr int NQT = (LSEQ + 31) / 32;
__device__ __forceinline__ void phase_mix1(Frame& F, int l) {
    LAS float* bt = (LAS float*)(F.lds + 135168);
    build_bias_table(F, bt, 0);
    __syncthreads();
    if (F.bid < NIDX_WG) {
        float* slab = (float*)(F.ws + WS_SCR) + (size_t)F.bid * 32 * LPAD;
        for (int t = F.bid; t < NB * NQT; t += NIDX_WG) { const int j = NQT - 1 - t / NB, b = t % NB; dsa_index_task(F, b, j, slab); }
    } else {
        const int u0 = F.bid - NIDX_WG, nw = F.G - NIDX_WG;
        const int unit = u0 + nw * F.wave;
        if (F.wave < 2 && unit < 64) hgrn_naive_unit(F, l, unit >> 3, (unit >> 1) & 3, unit & 1);
        else if (F.wave >= 2) { const int cw = u0 * 6 + (F.wave - 2), ncw = nw * 6; for (int r = cw; r < MREAL + NMETA; r += ncw) conv_row(F, l, r); }
    }
    float lam, post;
    { const float* lp = F.in[I_DLAM] + l * 256; const float s1 = wave_sum(lp[F.lane] * lp[64 + F.lane]), s2 = wave_sum(lp[128 + F.lane] * lp[192 + F.lane]);
      const float li = 0.8f - 0.6f * __expf(-0.3f * (float)l); lam = __expf(s1) - __expf(s2) + li; post = 1.0f - li; }
    for (;;) { const int t = queue_pop(F, 2 * l); if (t >= NB * 4 * NQT) break;
        const int j = NQT - 1 - t / 32, bh = t % 32; diff_attn_task(F, l, bh >> 2, bh & 3, j, bt, lam, post); }
}
__device__ __forceinline__ void phase_mix2(Frame& F, int l) {
    LAS float* bt = (LAS float*)(F.lds + 135168);
    build_bias_table(F, bt, 4);
    __syncthreads();
    const int gw = F.bid * NWAVES + F.wave, NGW = F.G * NWAVES;
    for (int r = gw; r < MREAL + NMETA; r += NGW) hgrn_finish_row(F, l, r);
    for (;;) { const int t = queue_pop(F, 2 * l + 1); if (t >= NB * 4 * NQT) break;
        const int j = NQT - 1 - t / 32, bh = t % 32; dsa_attn_task(F, bh >> 2, bh & 3, j, bt); }
}

#ifdef DBG_SEL
#ifndef DBG_NC
#define DBG_NC DM
#endif
__global__ void __launch_bounds__(256) k_dbg_argmax(const float* __restrict__ out, const float* __restrict__ x, unsigned long long* best) {
    unsigned long long loc = 0ull;
    for (size_t i = (size_t)blockIdx.x * blockDim.x + threadIdx.x; i < (size_t)MREAL * DM; i += (size_t)gridDim.x * blockDim.x) {
        const float d = fabsf(out[i] - x[i]); const unsigned long long k = ((unsigned long long)__float_as_uint(d) << 32) | (unsigned)i; loc = k > loc ? k : loc; }
    for (int o = 32; o >= 1; o >>= 1) { const unsigned long long t = __shfl_xor(loc, o); loc = t > loc ? t : loc; }
    if ((threadIdx.x & 63) == 0) atomicMax(best, loc);
}
__global__ void __launch_bounds__(256) k_dbg_count(const float* __restrict__ out, const float* __restrict__ x, unsigned* cnt  ) {
    const int gw = (blockIdx.x * blockDim.x + threadIdx.x) >> 6, lane = threadIdx.x & 63, ngw = (gridDim.x * blockDim.x) >> 6;
    for (int r = gw; r < MREAL; r += ngw) { float m = 0.f;
        for (int c = lane; c < DM; c += 64) m = fmaxf(m, fabsf(out[(size_t)r * DM + c] - x[(size_t)r * DM + c]));
        for (int o = 32; o >= 1; o >>= 1) m = fmaxf(m, __shfl_xor(m, o));
        if (lane == 0 && m > DBG_THR) { const int t = r & 4095; atomicAdd(cnt + 0, 1u); if (t < 32) atomicAdd(cnt + 1, 1u); if (t >= 4064) atomicAdd(cnt + 2, 1u); if (t < 256) atomicAdd(cnt + 3, 1u); } }
}

__global__ void __launch_bounds__(256) k_dbg_chk_merge(const unsigned short* BRm, const unsigned short* Wt, const unsigned short* G, const unsigned short* MG, int m, unsigned* cnt) {
    const int c = blockIdx.x * 256 + threadIdx.x;
    for (int r = blockIdx.y; r < MREAL; r += gridDim.y) {
        float s = 0.f; const unsigned short* a = BRm + (size_t)r * 512; const unsigned short* w = Wt + (size_t)c * 512;
        for (int k = 0; k < 512; ++k) s += __uint_as_float((unsigned)a[k] << 16) * __uint_as_float((unsigned)w[k] << 16);
        const float g = __uint_as_float((unsigned)G[(size_t)r * NGATE + m * DM + c] << 16), ref = g * s, got = __uint_as_float((unsigned)MG[(size_t)r * DM + c] << 16);
        const float err = fabsf(got - ref), tol = 0.02f * fabsf(ref) + 0.02f;
        if (!(err <= tol)) { atomicAdd(cnt + 4, 1u); const int t = r & 4095; if ((c & 255) < 128) atomicAdd(cnt + 5, 1u); if ((r & 255) < 128) atomicAdd(cnt + 6, 1u); if (fabsf(got) > 2.f * fabsf(ref)) atomicAdd(cnt + 7, 1u); (void)t; }
    }
}

__global__ void __launch_bounds__(256) k_dbg_naive_wo(const float* out, const unsigned short* MG, const unsigned short* Wt, float* chk) {
    const int c = blockIdx.x * 256 + threadIdx.x;
    for (int r = blockIdx.y; r < MREAL; r += gridDim.y) {
        float s = 0.f; const uint4* a = (const uint4*)(MG + (size_t)r * DM); const uint4* w = (const uint4*)(Wt + (size_t)c * DM);
        for (int k = 0; k < DM / 8; ++k) { const uint4 av = a[k], wv = w[k]; const unsigned aw[4] = {av.x, av.y, av.z, av.w}, ww[4] = {wv.x, wv.y, wv.z, wv.w};
#pragma unroll
            for (int j = 0; j < 4; ++j) { s += __uint_as_float(aw[j] << 16) * __uint_as_float(ww[j] << 16); s += __uint_as_float(aw[j] & 0xffff0000u) * __uint_as_float(ww[j] & 0xffff0000u); } }
        chk[(size_t)r * DM + c] = out[(size_t)r * DM + c] + s; }
}
__global__ void __launch_bounds__(256) k_dbg_cmp(const float* out, const float* chk, unsigned* cnt) {
    for (size_t i = (size_t)blockIdx.x * blockDim.x + threadIdx.x; i < (size_t)MREAL * DM; i += (size_t)gridDim.x * blockDim.x) {
        const float err = fabsf(out[i] - chk[i]); if (!(err <= 0.02f)) { atomicAdd(cnt + 4, 1u); const int c = (int)(i % DM), r = (int)(i / DM); if ((c & 255) < 128) atomicAdd(cnt + 5, 1u); if ((r & 255) < 128) atomicAdd(cnt + 6, 1u); if (err > 1.0f) atomicAdd(cnt + 7, 1u); } }
}

__global__ void __launch_bounds__(256) k_dbg_stats(const unsigned short* A, int ld, int ncols, unsigned* st) {
    const int gw = (blockIdx.x * blockDim.x + threadIdx.x) >> 6, lane = threadIdx.x & 63, ngw = (gridDim.x * blockDim.x) >> 6;
    float mx = 0.f, me = 0.f;
    for (int r = gw; r < MREAL; r += ngw) { float s = 0.f;
        for (int c = lane; c < ncols; c += 64) { const float v = __uint_as_float((unsigned)A[(size_t)r * ld + c] << 16); mx = fmaxf(mx, fabsf(v)); s += v * v; }
        for (int o = 32; o >= 1; o >>= 1) s += __shfl_xor(s, o);
        me = fmaxf(me, s / (float)ncols); }
    for (int o = 32; o >= 1; o >>= 1) mx = fmaxf(mx, __shfl_xor(mx, o));
    if (lane == 0) { atomicMax(st + 8, __float_as_uint(mx)); atomicMax(st + 9, __float_as_uint(me)); }
}

__global__ void __launch_bounds__(256) k_dbg_argmax_bf16(const unsigned short* A, int ld, int ncols, unsigned long long* best) {
    unsigned long long loc = 0ull;
    for (size_t i = (size_t)blockIdx.x * blockDim.x + threadIdx.x; i < (size_t)MREAL * ncols; i += (size_t)gridDim.x * blockDim.x) { const size_t r = i / ncols, c = i % ncols;
        const float d = fabsf(__uint_as_float((unsigned)A[r * ld + c] << 16)); const unsigned long long k = ((unsigned long long)__float_as_uint(d) << 32) | (unsigned)i; loc = k > loc ? k : loc; }
    for (int o = 32; o >= 1; o >>= 1) { const unsigned long long t = __shfl_xor(loc, o); loc = t > loc ? t : loc; }
    if ((threadIdx.x & 63) == 0) atomicMax(best, loc);
}

__global__ void __launch_bounds__(256) k_dbg_gcount(const unsigned short* G, unsigned* cnt) {
    const int gw = (blockIdx.x * blockDim.x + threadIdx.x) >> 6, lane = threadIdx.x & 63, ngw = (gridDim.x * blockDim.x) >> 6;
    for (int r = gw; r < MREAL; r += ngw) { int n = 0;
        for (int c = lane; c < NGATE; c += 64) { const float v = __uint_as_float((unsigned)G[(size_t)r * NGATE + c] << 16); if (!(v >= 0.f && v <= 1.001f)) ++n; }
        for (int o = 32; o >= 1; o >>= 1) n += __shfl_xor(n, o);
        if (lane == 0 && n) { const int t = r & 4095; atomicAdd(cnt + 10, (unsigned)n); atomicAdd(cnt + 11, 1u); if (t >= 4080) atomicAdd(cnt + 12, 1u); else atomicAdd(cnt + 13, 1u); } }
}
__global__ void __launch_bounds__(256) k_dbg_emit(float* out, const float* __restrict__ x, const unsigned long long* best, const unsigned* cnt) {
    const unsigned long long b = *best; const unsigned idx = (unsigned)b; const float val = __uint_as_float((unsigned)(b >> 32));
    const int row = idx / DBG_NC, col = idx % DBG_NC, bb = row >> 12, t = row & 4095;
    float N = 0.f;
    switch (DBG_SEL) {
        case 0: N = val; break;
        case 1: N = 2.f + bb; break;
        case 2: N = 2.f + (t >> 9); break;
        case 3: N = 2.f + ((t >> 6) & 7); break;
        case 4: N = 2.f + ((t >> 3) & 7); break;
        case 5: N = 2.f + (t & 7); break;
        case 6: N = 2.f + (col >> 8); break;
        case 60: N = 2.f + (col >> 10); break;
        case 61: N = 2.f + ((col >> 7) & 7); break;
        case 62: N = 2.f + ((col >> 4) & 7); break;
        case 63: N = 2.f + ((col >> 1) & 7); break;
        case 64: N = 2.f + (col & 1); break;
        case 65: N = 2.f + bb; break;
        case 66: N = 2.f + (t >> 9); break;
        case 67: N = 2.f + ((t >> 6) & 7); break;
        case 68: N = 2.f + ((t >> 3) & 7); break;
        case 69: N = 2.f + (t & 7); break;
        case 7: N = 2.f + ((col >> 5) & 7); break;
        case 8: N = 2.f + ((col >> 2) & 7); break;
        case 40: case 42: case 44: case 46: N = __uint_as_float(cnt[8]); break;
        case 41: case 43: case 45: case 47: N = __uint_as_float(cnt[9]); break;
        case 70: N = 2.f + log2f(1.f + (float)cnt[10]); break;
        case 71: N = 2.f + log2f(1.f + (float)cnt[11]); break;
        case 72: N = 2.f + log2f(1.f + (float)cnt[12]); break;
        case 73: N = 2.f + log2f(1.f + (float)cnt[13]); break;
        case 30: N = 2.f + log2f(1.f + (float)cnt[4]); break;
        case 31: N = 2.f + log2f(1.f + (float)cnt[5]); break;
        case 32: N = 2.f + log2f(1.f + (float)cnt[6]); break;
        case 33: N = 2.f + log2f(1.f + (float)cnt[7]); break;
        case 20: N = 2.f + log2f(1.f + (float)cnt[4]); break;
        case 21: N = 2.f + log2f(1.f + (float)cnt[5]); break;
        case 22: N = 2.f + log2f(1.f + (float)cnt[6]); break;
        case 23: N = 2.f + log2f(1.f + (float)cnt[7]); break;
        case 10: N = 2.f + log2f(1.f + (float)cnt[0]); break;
        case 11: N = 2.f + log2f(1.f + (float)cnt[1]); break;
        case 12: N = 2.f + log2f(1.f + (float)cnt[2]); break;
        case 13: N = 2.f + log2f(1.f + (float)cnt[3]); break;
    }
    const float c = 1.f + N;
    for (size_t i = (size_t)blockIdx.x * blockDim.x + threadIdx.x; i < (size_t)MREAL * DM; i += (size_t)gridDim.x * blockDim.x) out[i] = c * x[i];
}
#endif

#ifndef MK_ONE
#define MK_ONE 0
#endif
#ifndef BR_MASK
#define BR_MASK 15
#endif
constexpr int NPH = 18;
template <class T> __device__ __forceinline__ T opaque(T v) { asm volatile("" : "+s"(v)); return v; }
struct Args { const float* in[22]; float* out; unsigned char* ws; int ph_lo, ph_hi; };
__global__ void __launch_bounds__(NWAVES * 64, 2) fwd(Args args) {
    extern __shared__ __attribute__((aligned(16))) unsigned char lds[];
    Frame F;
    F.lds = (LAS unsigned char*)lds; F.MISC = (volatile LAS unsigned*)(F.lds + MISC_OFF);
    F.tid = threadIdx.x; F.lane = F.tid & 63; F.wave = __builtin_amdgcn_readfirstlane(F.tid >> 6); F.G = gridDim.x; F.bid = blockIdx.x;
    F.ws = args.ws; F.out = args.out; F.ctl = (gu32*)(args.ws + WS_CTL);
#pragma unroll
    for (int i = 0; i < 22; ++i) F.in[i] = args.in[i];
    for (int u = F.tid; u < (LDS_BYTES - LDSCTL_OFF) / 4; u += NWAVES * 64) ((LAS unsigned*)(F.lds + LDSCTL_OFF))[u] = 0u;
    __syncthreads();
#if MK_ONE
    XcdBarrier bar = xcd_barrier_post((unsigned*)(F.ctl + CW_BAR), F.MISC + 8);
#define GRID_BAR() xcd_barrier(bar)
#else
#define GRID_BAR() do { } while (0)
#endif
    const int lo = args.ph_lo, hi = args.ph_hi;
#define IN(k) (lo <= (k) && (k) < hi)
#define RETID() do { int t_ = threadIdx.x; asm volatile("" : "+v"(t_)); F.tid = t_; F.lane = t_ & 63; F.wave = __builtin_amdgcn_readfirstlane(t_ >> 6); } while (0)
#define SEAM(k) do { if (IN((k) + 1)) GRID_BAR(); } while (0)
    unsigned char* wb = F.ws + WS_W;
    bf16* XN = (bf16*)(F.ws + WS_XN); bf16* BR = (bf16*)(F.ws + WS_BR); bf16* BIG = (bf16*)(F.ws + WS_BIG); float* HM = (float*)(F.ws + WS_HM);
    for (int l = 0; l < 2; ++l) {
        const int pb = l * NPH;
        const float* hsrc = (l == 0) ? F.in[I_X] : F.out;
        if (IN(pb + 0)) { RETID(); phase_convert(F, l); SEAM(pb + 0); }
        if (IN(pb + 1)) { RETID(); phase_norm(F, hsrc, F.in[I_F1N] + l * DM); SEAM(pb + 1); }
        if (IN(pb + 2)) { RETID(); pg8::Gemm g{opaque((const bf16*)(XN)), opaque((const bf16*)(wb + W_GU1)), MPAD, NGU, DM}; pg8::StaticOrder S; S.init(MPAD, NGU, F.G, opaque(F.bid));
            pg8::EpiSwiGLU E{BIG, DFF}; pg8::gemm_phase<pg8::EpiSwiGLU, pg8::StaticOrder, true, true>(F.lds + RING_OFF, g, S, E); SEAM(pb + 2); }
        if (IN(pb + 3)) { RETID(); pg8::Gemm g{opaque((const bf16*)(BIG)), opaque((const bf16*)(wb + W_D1)), MPAD, DM, DFF}; pg8::StaticOrder S; S.init(MPAD, DM, F.G, opaque(F.bid));
            pg8::EpiResF32 E{hsrc, F.out, HM, DM, MT_REAL, 0.5f}; pg8::gemm_phase<pg8::EpiResF32, pg8::StaticOrder, true, true>(F.lds + RING_OFF, g, S, E); SEAM(pb + 3); }
        if (IN(pb + 4)) { RETID(); phase_norm(F, F.out, F.in[I_MIXN] + l * DM); SEAM(pb + 4); }
        if (IN(pb + 5)) { RETID(); pg8::Gemm g{opaque((const bf16*)(XN)), opaque((const bf16*)(wb + W_NG)), MPAD, NNG, DM}; pg8::StaticOrder S; S.init(MPAD, NNG, F.G, opaque(F.bid));
            pg8::EpiBf16<0> E{BIG, NNG}; pg8::gemm_phase<pg8::EpiBf16<0>, pg8::StaticOrder, true, true>(F.lds + RING_OFF, g, S, E); SEAM(pb + 5); }
        if (IN(pb + 6)) { RETID(); phase_prep(F, l); phase_vt(F); SEAM(pb + 6); }
        if (IN(pb + 7)) { RETID(); phase_mix1(F, l); SEAM(pb + 7); }
        if (IN(pb + 8)) { RETID(); phase_mix2(F, l); SEAM(pb + 8); }
        if (IN(pb + 9)) { RETID(); pg8::Gemm g{opaque((const bf16*)(XN)), opaque((const bf16*)(wb + W_G)), MPAD, NGATE, DM}; pg8::StaticOrder S; S.init(MPAD, NGATE, F.G, opaque(F.bid));
            pg8::EpiBf16<1> E{BIG, NGATE}; pg8::gemm_phase<pg8::EpiBf16<1>, pg8::StaticOrder, true, true>(F.lds + RING_OFF, g, S, E); SEAM(pb + 9); }
        for (int m = 0; m < 4; ++m)
            if (IN(pb + 10 + m) && ((BR_MASK >> m) & 1)) { RETID(); pg8::Gemm g{opaque((const bf16*)(BR + (size_t)m * MPAD * 512)), opaque((const bf16*)(wb + W_BR) + (size_t)m * DM * 512), MPAD, DM, 512}; pg8::StaticOrder S; S.init(MPAD, DM, F.G, opaque(F.bid));
                pg8::EpiGateAcc E{XN, DM, BIG, NGATE, m * DM, (BR_MASK & ((1 << m) - 1)) == 0}; pg8::gemm_phase<pg8::EpiGateAcc, pg8::StaticOrder, true, true>(F.lds + RING_OFF, g, S, E); SEAM(pb + 10 + m); }
        if (IN(pb + 14) && BR_MASK) { RETID(); pg8::Gemm g{opaque((const bf16*)(XN)), opaque((const bf16*)(wb + W_O)), MPAD, DM, DM}; pg8::StaticOrder S; S.init(MPAD, DM, F.G, opaque(F.bid));
            pg8::EpiResF32 E{F.out, F.out, HM, DM, MT_REAL, 1.0f}; pg8::gemm_phase<pg8::EpiResF32, pg8::StaticOrder, true, true>(F.lds + RING_OFF, g, S, E); SEAM(pb + 14); }
        if (IN(pb + 15)) { RETID(); phase_norm(F, F.out, F.in[I_F2N] + l * DM); SEAM(pb + 15); }
        if (IN(pb + 16)) { RETID(); pg8::Gemm g{opaque((const bf16*)(XN)), opaque((const bf16*)(wb + W_GU2)), MPAD, NGU, DM}; pg8::StaticOrder S; S.init(MPAD, NGU, F.G, opaque(F.bid));
            pg8::EpiSwiGLU E{BIG, DFF}; pg8::gemm_phase<pg8::EpiSwiGLU, pg8::StaticOrder, true, true>(F.lds + RING_OFF, g, S, E); SEAM(pb + 16); }
        if (IN(pb + 17)) { RETID(); pg8::Gemm g{opaque((const bf16*)(BIG)), opaque((const bf16*)(wb + W_D2)), MPAD, DM, DFF}; pg8::StaticOrder S; S.init(MPAD, DM, F.G, opaque(F.bid));
            pg8::EpiResF32 E{F.out, F.out, HM, DM, MT_REAL, 0.5f}; pg8::gemm_phase<pg8::EpiResF32, pg8::StaticOrder, true, true>(F.lds + RING_OFF, g, S, E); SEAM(pb + 17); }
    }
}

extern "C" void kernel_launch(void* const* d_in, const int* in_sizes, int n_in, void* d_out, int out_size, void* d_ws, size_t ws_size, hipStream_t stream) {
    static int grid = 0;
    if (grid == 0) {
        if (n_in != 22 || out_size != MREAL * DM || ws_size < WS_END) { fprintf(stderr, "kernel_launch: unexpected shapes (n_in %d out %d ws %zu need %zu)\n", n_in, out_size, ws_size, (size_t)WS_END); grid = -1; return; }
        int dev = 0, cus = 0, per_cu = 0;
        if (hipGetDevice(&dev) != hipSuccess || hipDeviceGetAttribute(&cus, hipDeviceAttributeMultiprocessorCount, dev) != hipSuccess) { grid = -1; return; }
        if (hipFuncSetAttribute((const void*)fwd, hipFuncAttributeMaxDynamicSharedMemorySize, LDS_BYTES) != hipSuccess) { fprintf(stderr, "kernel_launch: hipFuncSetAttribute failed\n"); grid = -1; return; }
        if (hipOccupancyMaxActiveBlocksPerMultiprocessor(&per_cu, (const void*)fwd, NWAVES * 64, LDS_BYTES) != hipSuccess || per_cu < 1) fprintf(stderr, "kernel_launch: occupancy query says %d\n", per_cu);
        (void)hipGetLastError();
        grid = cus < 256 ? cus : 256;
    }
    if (grid < 0) return;
    (void)hipMemsetAsync((char*)d_ws + WS_CTL, 0, CTL_ZERO_BYTES, stream);
    Args a{};
    for (int i = 0; i < 22; ++i) a.in[i] = (const float*)d_in[i];
    a.out = (float*)d_out; a.ws = (unsigned char*)d_ws;
#ifndef PH_END
#define PH_END (2 * NPH)
#endif
#if MK_ONE
    a.ph_lo = 0; a.ph_hi = PH_END;
    hipLaunchKernelGGL(fwd, dim3(grid), dim3(NWAVES * 64), LDS_BYTES, stream, a);
#else
    for (int p = 0; p < PH_END; ++p) { a.ph_lo = p; a.ph_hi = p + 1;
#if defined(DBG_SEL)
#ifdef DBG_PREFILL
        if (p == 9) (void)hipMemsetAsync((char*)d_ws + WS_BIG, 0x3F, (size_t)MPAD * NGATE * 2, stream);
#endif
        if (DBG_SEL >= 30 && DBG_SEL < 40 && p == 14) hipLaunchKernelGGL(k_dbg_naive_wo, dim3(8, 2048), dim3(256), 0, stream, (const float*)d_out, (const unsigned short*)((char*)d_ws + WS_XN), (const unsigned short*)((char*)d_ws + WS_W + W_O), (float*)((char*)d_ws + WS_BIG));
#endif
        hipLaunchKernelGGL(fwd, dim3(grid), dim3(NWAVES * 64), LDS_BYTES, stream, a); }
#endif
#ifdef DBG_SEL
    { unsigned long long* best = (unsigned long long*)((char*)d_ws + 512 * 1024); unsigned* cnt = (unsigned*)((char*)d_ws + 512 * 1024 + 64);
      if (DBG_SEL >= 60 && DBG_SEL < 70) hipLaunchKernelGGL(k_dbg_argmax_bf16, dim3(2048), dim3(256), 0, stream, (const unsigned short*)((char*)d_ws + WS_BIG), NGATE, NGATE, best);
      else hipLaunchKernelGGL(k_dbg_argmax, dim3(2048), dim3(256), 0, stream, (const float*)d_out, (const float*)d_in[0], best);
      hipLaunchKernelGGL(k_dbg_count, dim3(2048), dim3(256), 0, stream, (const float*)d_out, (const float*)d_in[0], cnt);
      if (DBG_SEL >= 20 && DBG_SEL < 30) { const int mm = 1; hipLaunchKernelGGL(k_dbg_chk_merge, dim3(8, 2048), dim3(256), 0, stream, (const unsigned short*)((char*)d_ws + WS_BR) + (size_t)mm * MPAD * 512, (const unsigned short*)((char*)d_ws + WS_W + W_BR) + (size_t)mm * DM * 512, (const unsigned short*)((char*)d_ws + WS_BIG), (const unsigned short*)((char*)d_ws + WS_XN), mm, cnt); }
      if (DBG_SEL >= 30 && DBG_SEL < 40) hipLaunchKernelGGL(k_dbg_cmp, dim3(2048), dim3(256), 0, stream, (const float*)d_out, (const float*)((char*)d_ws + WS_BIG), cnt);
      if (DBG_SEL >= 40 && DBG_SEL < 50) { const unsigned short* A = nullptr; int ld = 0, nc = 0;
        if (DBG_SEL < 42) { A = (const unsigned short*)((char*)d_ws + WS_BR) + (size_t)MPAD * 512; ld = 512; nc = 512; }
        else if (DBG_SEL < 44) { A = (const unsigned short*)((char*)d_ws + WS_BIG) + DM; ld = NGATE; nc = DM; }
        else if (DBG_SEL < 46) { A = (const unsigned short*)((char*)d_ws + WS_XN); ld = DM; nc = DM; }
        else { A = (const unsigned short*)((char*)d_ws + WS_BR); ld = 512; nc = 512; }
        hipLaunchKernelGGL(k_dbg_stats, dim3(1024), dim3(256), 0, stream, A, ld, nc, cnt); }
      if (DBG_SEL >= 70 && DBG_SEL < 80) hipLaunchKernelGGL(k_dbg_gcount, dim3(1024), dim3(256), 0, stream, (const unsigned short*)((char*)d_ws + WS_BIG), cnt);
      hipLaunchKernelGGL(k_dbg_emit, dim3(2048), dim3(256), 0, stream, (float*)d_out, (const float*)d_in[0], best, cnt); }
#endif
}
```

```cpp
#include <hip/hip_runtime.h>
#include <cstdio>
#include <cstdint>
#define MK_ONE 1
namespace pg8 {
#define PG8_LAS __attribute__((address_space(3)))
typedef unsigned short bf16_t;
typedef short bf16x8 __attribute__((ext_vector_type(8)));
typedef float f32x4 __attribute__((ext_vector_type(4)));
typedef unsigned u32x4 __attribute__((ext_vector_type(4)));
constexpr int BM = 256, BK = 64, HALF = 128, HTB = HALF * BK * 2  , STAGE_BYTES = 8 * HTB, NXCD = 8, WGM = 8;

__host__ __device__ __forceinline__ int lds_byte(int r, int c) { const int st = (r >> 4) * 2 + (c >> 5), rr = r & 15, cc = c & 31, ob = rr * 64 + cc * 2; return st * 1024 + (ob ^ (((ob >> 9) & 1) << 5)); }
__host__ __device__ __forceinline__ void stage_rc(int b, int& R, int& C) { const int st = b / 1024, sb = b % 1024, swz = sb ^ (((sb >> 9) & 1) << 5); R = (st >> 1) * 16 + swz / 64; C = (st & 1) * 32 + (swz % 64) / 2; }
__host__ __device__ __forceinline__ int perm32(int rho) { const int n = rho >> 4, i = rho & 15; return 8 * (i >> 2) + 4 * n + (i & 3); }

struct Unit { int pm, pn; };
struct Gemm { const bf16_t* A; const bf16_t* Bt; int M, N, K; };

struct StaticOrder {
    int nM, nN, nwg, G, c;
    __host__ __device__ void init(int M, int N, int G_, int c_) { nM = M / BM; nN = N / BM; nwg = nM * nN; G = G_; c = c_; }
    __host__ __device__ bool next(int i, Unit& u) const {
        const long L = (long)i * G + c; if (L >= nwg) return false;
        int wgid = (int)L; { const int q = nwg / NXCD, r = nwg % NXCD, xcd = wgid % NXCD, off = wgid / NXCD; wgid = (xcd < r ? xcd * (q + 1) : r * (q + 1) + (xcd - r) * q) + off; }
        const int nig = WGM * nN, gid = wgid / nig, fm = gid * WGM, gsz = (nM - fm) < WGM ? (nM - fm) : WGM;
        u.pm = fm + ((wgid % nig) % gsz); u.pn = (wgid % nig) / gsz; return true;
    }
    __device__ __forceinline__ void a_ready(const Unit&) const {}
    __device__ __forceinline__ void done(const Unit&) const {}
};
typedef __bf16 bf16x2_hw __attribute__((ext_vector_type(2))); typedef float f32x2_hw __attribute__((ext_vector_type(2)));
__device__ __forceinline__ unsigned cvt_pk_bf16(float lo, float hi) { const f32x2_hw v = {lo, hi}; return __builtin_bit_cast(unsigned, __builtin_convertvector(v, bf16x2_hw)); }
typedef float f32x2 __attribute__((ext_vector_type(2)));
__device__ __forceinline__ float fast_sigmoid(float x) { return __builtin_amdgcn_rcpf(1.0f + __expf(-x)); }
__device__ __forceinline__ float fast_silu(float x) { return x * fast_sigmoid(x); }
template <int ACT  > struct EpiBf16 {
    static constexpr bool PERM = true, AFTER_DRAIN = false;
    bf16_t* O; int ldc;
    __device__ __forceinline__ void operator()(const f32x4 (&acc)[2][2][4][2], const Unit& u, int wr, int wc, int fr, int fq) const {
        const int row0 = u.pm * BM + wr * 64 + fr; const int col0 = u.pn * BM + wc * 32 + 8 * fq;
#pragma unroll
        for (int ai = 0; ai < 2; ++ai)
#pragma unroll
            for (int m = 0; m < 4; ++m) { bf16_t* rowp = O + (size_t)(row0 + ai * HALF + m * 16) * ldc + col0;
#pragma unroll
                for (int bj = 0; bj < 2; ++bj) { f32x4 v0 = acc[ai][bj][m][0], v1 = acc[ai][bj][m][1];
                    if (ACT == 1) {
#pragma unroll
                        for (int j = 0; j < 4; ++j) { v0[j] = fast_sigmoid(v0[j]); v1[j] = fast_sigmoid(v1[j]); } }
                    u32x4 w; w.x = cvt_pk_bf16(v0[0], v0[1]); w.y = cvt_pk_bf16(v0[2], v0[3]); w.z = cvt_pk_bf16(v1[0], v1[1]); w.w = cvt_pk_bf16(v1[2], v1[3]);
                    *(u32x4*)(rowp + bj * HALF) = w; } }
    }
};
struct EpiSwiGLU {
    static constexpr bool PERM = true, AFTER_DRAIN = false;
    bf16_t* O; int ldc;
    __device__ __forceinline__ void operator()(const f32x4 (&acc)[2][2][4][2], const Unit& u, int wr, int wc, int fr, int fq) const {
        const int row0 = u.pm * BM + wr * 64 + fr; const int col0 = u.pn * HALF + wc * 32 + 8 * fq;
#pragma unroll
        for (int ai = 0; ai < 2; ++ai)
#pragma unroll
            for (int m = 0; m < 4; ++m) { bf16_t* rowp = O + (size_t)(row0 + ai * HALF + m * 16) * ldc + col0;
                const f32x4 g0 = acc[ai][0][m][0], g1 = acc[ai][0][m][1], u0 = acc[ai][1][m][0], u1 = acc[ai][1][m][1];
                f32x4 v0, v1;
#pragma unroll
                for (int j = 0; j < 4; ++j) { v0[j] = fast_silu(g0[j]) * u0[j]; v1[j] = fast_silu(g1[j]) * u1[j]; }
                u32x4 w; w.x = cvt_pk_bf16(v0[0], v0[1]); w.y = cvt_pk_bf16(v0[2], v0[3]); w.z = cvt_pk_bf16(v1[0], v1[1]); w.w = cvt_pk_bf16(v1[2], v1[3]);
                *(u32x4*)rowp = w; asm volatile("" ::: "memory"); }
    }
};
struct EpiResF32 {
    static constexpr bool PERM = false, AFTER_DRAIN = false;
    const float* base_r; float* out_r; float* hm; int ldc; int mt_real; float scale;
    __device__ __forceinline__ void operator()(const f32x4 (&acc)[2][2][4][2], const Unit& u, int wr, int wc, int fr, int fq) const {
        const bool real = u.pm < mt_real;
        const float* bp = real ? base_r + (size_t)u.pm * BM * ldc : hm; float* op = real ? out_r + (size_t)u.pm * BM * ldc : hm;
        const int row0 = wr * 64 + fr, col0 = u.pn * BM + wc * 32 + 4 * fq;
#pragma unroll
        for (int ai = 0; ai < 2; ++ai)
#pragma unroll
            for (int m = 0; m < 4; ++m) { const size_t off = (size_t)(row0 + ai * HALF + m * 16) * ldc + col0;
#pragma unroll
                for (int bj = 0; bj < 2; ++bj)
#pragma unroll
                    for (int n = 0; n < 2; ++n) { const f32x4 b = *(const f32x4*)(bp + off + bj * HALF + n * 16); *(f32x4*)(op + off + bj * HALF + n * 16) = b + acc[ai][bj][m][n] * scale; }
                asm volatile("" ::: "memory"); }
    }
};
struct EpiGateAcc {
    static constexpr bool PERM = true, AFTER_DRAIN = false;
    bf16_t* MG; int ldc; const bf16_t* G; int ldg; int gcol0; int first;
    __device__ __forceinline__ void operator()(const f32x4 (&acc)[2][2][4][2], const Unit& u, int wr, int wc, int fr, int fq) const {
        const int row0 = u.pm * BM + wr * 64 + fr; const int col0 = u.pn * BM + wc * 32 + 8 * fq;
#pragma unroll
        for (int ai = 0; ai < 2; ++ai)
#pragma unroll
            for (int m = 0; m < 4; ++m) { const size_t r = (size_t)(row0 + ai * HALF + m * 16);
#pragma unroll
                for (int bj = 0; bj < 2; ++bj) { const u32x4 gw = *(const u32x4*)(G + r * ldg + gcol0 + col0 + bj * HALF);
                    u32x4 pw = (u32x4){0u, 0u, 0u, 0u}; if (!first) pw = *(const u32x4*)(MG + r * ldc + col0 + bj * HALF);
                    float o[8];
#pragma unroll
                    for (int j = 0; j < 4; ++j) { const float a0 = (j < 2) ? acc[ai][bj][m][0][2 * j] : acc[ai][bj][m][1][2 * (j - 2)], a1 = (j < 2) ? acc[ai][bj][m][0][2 * j + 1] : acc[ai][bj][m][1][2 * (j - 2) + 1];
                        o[2 * j] = __uint_as_float(pw[j] << 16) + __uint_as_float(gw[j] << 16) * a0; o[2 * j + 1] = __uint_as_float(pw[j] & 0xffff0000u) + __uint_as_float(gw[j] & 0xffff0000u) * a1; }
                    u32x4 w; w.x = cvt_pk_bf16(o[0], o[1]); w.y = cvt_pk_bf16(o[2], o[3]); w.z = cvt_pk_bf16(o[4], o[5]); w.w = cvt_pk_bf16(o[6], o[7]);
                    *(u32x4*)(MG + r * ldc + col0 + bj * HALF) = w; } }
    }
};
template <class Epi, class Sched, bool ALIGN_EPI = false, bool SP2 = false>
__device__ __forceinline__ void gemm_phase(PG8_LAS unsigned char* lds, const Gemm g, const Sched& S, const Epi& E) {
    int tid_ = threadIdx.x; asm volatile("" : "+v"(tid_));
    const int tid = tid_, wid = __builtin_amdgcn_readfirstlane(tid >> 6), lane = tid & 63, wr = wid >> 2, wc = wid & 3, fr = lane & 15, fq = lane >> 4;
    const int K = g.K, nt = K / BK;
    unsigned voffA[2], voffB[2];
#pragma unroll
    for (int i = 0; i < 2; ++i) { int R, C; stage_rc(tid * 16 + i * 8192, R, C); const int Rb = Epi::PERM ? ((R & ~31) + perm32(R & 31)) : R;
        voffA[i] = (unsigned)(R * K + C) * 2u; voffB[i] = (unsigned)(Rb * K + C) * 2u; }
    const size_t kstep = (size_t)(BK * 2);
    const size_t hstep = (size_t)HALF * K * 2;
    const size_t tstep = 2 * hstep;
    const unsigned ldsw = (unsigned)wid * 1024u;
    const int aoff = lds_byte(wr * 64 + fr, fq * 8), boff = lds_byte(wc * 32 + fr, fq * 8);
#define PG8_SA(b, h) (((b) * 2 + (h)) * HTB)
#define PG8_SB(b, h) ((4 + (b) * 2 + (h)) * HTB)
#define PG8_STAGE(bufoff, gbase, voff) do { _Pragma("unroll") for (int _i = 0; _i < 2; ++_i) \
        __builtin_amdgcn_global_load_lds((const unsigned*)((const char*)(gbase) + (voff)[_i]), (PG8_LAS unsigned*)(lds + (bufoff) + ldsw + _i * 8192), 16, 0, 0); } while (0)
#define PG8_LDA(dst, b, h) do { _Pragma("unroll") for (int m = 0; m < 4; ++m) _Pragma("unroll") for (int k = 0; k < 2; ++k) dst[m][k] = *(const PG8_LAS bf16x8*)(lds + PG8_SA(b, h) + aoff + m * 2048 + k * 1024); } while (0)
#define PG8_LDB(dst, b, h) do { _Pragma("unroll") for (int n = 0; n < 2; ++n) _Pragma("unroll") for (int k = 0; k < 2; ++k) dst[n][k] = *(const PG8_LAS bf16x8*)(lds + PG8_SB(b, h) + boff + n * 2048 + k * 1024); } while (0)
#define PG8_MMA(ai, bj, At, Bt) do { __builtin_amdgcn_s_setprio(1); _Pragma("unroll") for (int m = 0; m < 4; ++m) _Pragma("unroll") for (int n = 0; n < 2; ++n) _Pragma("unroll") for (int k = 0; k < 2; ++k) \
        acc[ai][bj][m][n] = __builtin_amdgcn_mfma_f32_16x16x32_bf16(Bt[n][k], At[m][k], acc[ai][bj][m][n], 0, 0, 0); __builtin_amdgcn_s_setprio(0); } while (0)
#define PG8_WAIT_V(n) asm volatile("s_waitcnt vmcnt(" #n ")" ::: "memory")
#define PG8_WAIT_L(n) asm volatile("s_waitcnt lgkmcnt(" #n ")" ::: "memory")
#define PG8_BAR __builtin_amdgcn_s_barrier()
#define PG8_SCHED __builtin_amdgcn_sched_barrier(0)
    Unit cur, nxt; int ui = 0;
    if (!S.next(0, cur)) return;
    f32x4 acc[2][2][4][2];
#pragma unroll
    for (int a = 0; a < 2; ++a)
#pragma unroll
        for (int b = 0; b < 2; ++b)
#pragma unroll
            for (int m = 0; m < 4; ++m)
#pragma unroll
                for (int n = 0; n < 2; ++n) acc[a][b][m][n] = (f32x4){0.f, 0.f, 0.f, 0.f};
    bf16x8 At[4][2], B0[2][2], B1[2][2];
    const char* cA = (const char*)g.A + (size_t)cur.pm * tstep; const char* cB = (const char*)g.Bt + (size_t)cur.pn * tstep;
    S.a_ready(cur);
    if constexpr (SP2) {
        PG8_STAGE(PG8_SB(0, 0), cB, voffB); PG8_STAGE(PG8_SB(0, 1), cB + hstep, voffB); PG8_STAGE(PG8_SA(0, 0), cA, voffA); PG8_STAGE(PG8_SA(0, 1), cA + hstep, voffA);
        if (wr == 1) PG8_BAR;
        PG8_WAIT_V(2); PG8_BAR;
        PG8_STAGE(PG8_SB(1, 0), cB + kstep, voffB); PG8_STAGE(PG8_SA(1, 0), cA + kstep, voffA); PG8_STAGE(PG8_SB(1, 1), cB + hstep + kstep, voffB);
        PG8_WAIT_V(6); PG8_BAR;
    } else {
        PG8_STAGE(PG8_SB(0, 0), cB, voffB); PG8_STAGE(PG8_SA(0, 0), cA, voffA); PG8_STAGE(PG8_SB(0, 1), cB + hstep, voffB); PG8_STAGE(PG8_SA(0, 1), cA + hstep, voffA);
        if (wr == 1) PG8_BAR;
        PG8_WAIT_V(4); PG8_BAR;
        PG8_STAGE(PG8_SB(1, 0), cB + kstep, voffB); PG8_STAGE(PG8_SA(1, 0), cA + kstep, voffA); PG8_STAGE(PG8_SB(1, 1), cB + hstep + kstep, voffB);
        PG8_WAIT_V(6); PG8_BAR;
    }
    for (;;) {
        const bool has_next = S.next(ui + 1, nxt);
        const char* nA = has_next ? (const char*)g.A + (size_t)nxt.pm * tstep : cA; const char* nB = has_next ? (const char*)g.Bt + (size_t)nxt.pn * tstep : cB;
        for (int t = 0; t < nt; t += 2) {
            const bool last = (t == nt - 2);
            const char* a1 = cA + (size_t)(t + 1) * kstep;
            const char* a2 = last ? nA : cA + (size_t)(t + 2) * kstep; const char* b2 = last ? nB : cB + (size_t)(t + 2) * kstep;
            const char* a3 = a2 + kstep; const char* b3 = b2 + kstep;
            if (last && has_next) S.a_ready(nxt);
            if constexpr (SP2) {
            PG8_LDB(B0, 0, 0); PG8_LDB(B1, 0, 1); PG8_SCHED; PG8_LDA(At, 0, 0); PG8_STAGE(PG8_SA(1, 1), a1 + hstep, voffA);
            PG8_WAIT_V(8); PG8_WAIT_L(0); PG8_BAR; PG8_MMA(0, 0, At, B0); PG8_MMA(0, 1, At, B1); PG8_BAR; PG8_SCHED;
            PG8_LDA(At, 0, 1); PG8_STAGE(PG8_SB(0, 0), b2, voffB); PG8_STAGE(PG8_SB(0, 1), b2 + hstep, voffB); PG8_STAGE(PG8_SA(0, 0), a2, voffA);
            PG8_WAIT_V(8); PG8_WAIT_L(0); PG8_BAR; PG8_MMA(1, 0, At, B0); PG8_MMA(1, 1, At, B1); PG8_BAR; PG8_SCHED;
            PG8_LDB(B0, 1, 0); PG8_LDB(B1, 1, 1); PG8_SCHED; PG8_LDA(At, 1, 0); PG8_STAGE(PG8_SA(0, 1), a2 + hstep, voffA);
            PG8_WAIT_V(8); PG8_WAIT_L(0); PG8_BAR; PG8_MMA(0, 0, At, B0); PG8_MMA(0, 1, At, B1); PG8_BAR; PG8_SCHED;
            PG8_LDA(At, 1, 1); PG8_STAGE(PG8_SB(1, 0), b3, voffB); PG8_STAGE(PG8_SB(1, 1), b3 + hstep, voffB); PG8_STAGE(PG8_SA(1, 0), a3, voffA);
            PG8_WAIT_V(8); PG8_WAIT_L(0); PG8_BAR; PG8_MMA(1, 0, At, B0); PG8_MMA(1, 1, At, B1); PG8_BAR; PG8_SCHED;
            } else {
            PG8_LDB(B0, 0, 0); PG8_SCHED; PG8_LDA(At, 0, 0); PG8_STAGE(PG8_SA(1, 1), a1 + hstep, voffA);
            PG8_WAIT_L(8); PG8_BAR; PG8_WAIT_L(0); PG8_MMA(0, 0, At, B0); PG8_BAR; PG8_SCHED;
            PG8_LDB(B1, 0, 1); PG8_STAGE(PG8_SB(0, 0), b2, voffB);
            PG8_BAR; PG8_WAIT_L(0); PG8_MMA(0, 1, At, B1); PG8_BAR;
            PG8_LDA(At, 0, 1); PG8_STAGE(PG8_SA(0, 0), a2, voffA);
            PG8_BAR; PG8_WAIT_L(0); PG8_MMA(1, 0, At, B0); PG8_BAR; PG8_SCHED;
            PG8_STAGE(PG8_SB(0, 1), b2 + hstep, voffB);
            PG8_WAIT_V(6); PG8_BAR; PG8_MMA(1, 1, At, B1); PG8_BAR;
            PG8_LDB(B0, 1, 0); PG8_SCHED; PG8_LDA(At, 1, 0); PG8_STAGE(PG8_SA(0, 1), a2 + hstep, voffA);
            PG8_WAIT_L(8); PG8_BAR; PG8_WAIT_L(0); PG8_MMA(0, 0, At, B0); PG8_BAR; PG8_SCHED;
            PG8_LDB(B1, 1, 1); PG8_STAGE(PG8_SB(1, 0), b3, voffB);
            PG8_BAR; PG8_WAIT_L(0); PG8_MMA(0, 1, At, B1); PG8_BAR;
            PG8_LDA(At, 1, 1); PG8_STAGE(PG8_SA(1, 0), a3, voffA);
            PG8_BAR; PG8_WAIT_L(0); PG8_MMA(1, 0, At, B0); PG8_BAR; PG8_SCHED;
            PG8_STAGE(PG8_SB(1, 1), b3 + hstep, voffB);
            PG8_WAIT_V(6); PG8_BAR; PG8_MMA(1, 1, At, B1); PG8_BAR;
            }
        }
        if constexpr (ALIGN_EPI) { if (wr == 0) PG8_BAR; }
        if constexpr (!Epi::AFTER_DRAIN) { E(acc, cur, wr, wc, fr, fq); S.done(cur); }
        if (!has_next) break;
#pragma unroll
        for (int a = 0; a < 2; ++a)
#pragma unroll
            for (int b = 0; b < 2; ++b)
#pragma unroll
                for (int m = 0; m < 4; ++m)
#pragma unroll
                    for (int n = 0; n < 2; ++n) acc[a][b][m][n] = (f32x4){0.f, 0.f, 0.f, 0.f};
        cur = nxt; cA = nA; cB = nB; ++ui;
        if constexpr (ALIGN_EPI) { if (wr == 1) PG8_BAR; }
    }
    PG8_WAIT_V(0);
    if constexpr (!ALIGN_EPI) { if (wr == 0) PG8_BAR; }
    PG8_BAR;
    if constexpr (Epi::AFTER_DRAIN) { E.fused(acc, cur, wr, wc, fr, fq, lds, wid, lane); S.done(cur); }
#undef PG8_SA
#undef PG8_SB
#undef PG8_STAGE
#undef PG8_LDA
#undef PG8_LDB
#undef PG8_MMA
#undef PG8_WAIT_V
#undef PG8_WAIT_L
#undef PG8_BAR
#undef PG8_SCHED
}
}

constexpr int DM = 2048, NB = 8, SEQ = 4096, NMETA = 16, LSEQ = 4112, LPAD = 4128;
constexpr int MREAL = NB * SEQ;
constexpr int MPAD = MREAL + 256;
constexpr int MT_REAL = MREAL / 256;
constexpr int DFF = 5632, NGU = 2 * DFF, NNG = 7168, NGATE = 8192, INCOLS = 15184, NGC = 6992;
constexpr int NWAVES = 8;
constexpr float EPS = 1e-6f;
constexpr int C_AQ = 0, C_AF = 512, C_AI = 1024, C_AG = 1536, C_BB = 2048, C_BC = 2560, C_BU = 3072, C_CQ = 3584, C_CK = 4096, C_CV = 4608,
              C_DQ = 5120, C_DK = 5632, C_DV = 5760, C_DQI = 5888, C_DKI = 6912, C_DW = 6976;

constexpr size_t MiB = 1u << 20;
constexpr size_t WS_CTL = 0, CTL_ZERO_BYTES = 1 * MiB;
constexpr size_t WS_HM = 1 * MiB;
constexpr size_t WS_W = 4 * MiB;
constexpr size_t W_GU1 = 0, W_D1 = W_GU1 + (size_t)NGU * DM * 2, W_NG = W_D1 + (size_t)DM * DFF * 2, W_G = W_NG + (size_t)NNG * DM * 2,
                 W_BR = W_G + (size_t)NGATE * DM * 2, W_O = W_BR + (size_t)4 * DM * 512 * 2, W_GU2 = W_O + (size_t)DM * DM * 2, W_D2 = W_GU2 + (size_t)NGU * DM * 2,
                 W_END = W_D2 + (size_t)DM * DFF * 2;
constexpr size_t WS_XN = WS_W + W_END;
constexpr size_t WS_BR = WS_XN + (size_t)MPAD * DM * 2;
constexpr size_t WS_BIG = WS_BR + (size_t)MPAD * DM * 2;
constexpr size_t BIG_P_END = (size_t)MPAD * NNG * 2;
constexpr size_t WS_VTC = WS_BIG + BIG_P_END;
constexpr size_t WS_VTD = WS_VTC + (size_t)NB * 4 * 128 * LPAD * 2;
constexpr size_t WS_MASK = WS_VTD + (size_t)NB * 128 * LPAD * 2;
constexpr int MASKW = 132;
constexpr int NIDX_WG = 172;
constexpr int NHG_WG = 32;
constexpr size_t WS_SCR = WS_MASK + (size_t)NB * LPAD * MASKW * 4;
constexpr size_t WS_HA = WS_SCR + (size_t)NIDX_WG * 32 * LPAD * 4;
constexpr size_t WS_HDL = WS_HA + (size_t)NB * 4 * 64 * 64 * 64 * 2;
constexpr size_t WS_HMETA = WS_HDL + (size_t)NB * 4 * 64 * 128 * 4;
constexpr size_t HMETA_STRIDE = 64 * 384 * 2 + 64 * 64 * 2 + 128 * 4;
constexpr size_t WS_END = WS_HMETA + 4 * HMETA_STRIDE;
static_assert(WS_BIG + (size_t)MPAD * NGATE * 2 <= WS_END, "G fits");
static_assert(WS_END <= (size_t)1138174976, "workspace map fits the guaranteed size");

constexpr int RING_OFF = 0, RING_BYTES = 131072;
constexpr int LDSCTL_OFF = 143360, MISC_OFF = LDSCTL_OFF + 320;
constexpr int LDS_BYTES = 147456;

#define GAS __attribute__((address_space(1)))
#define LAS __attribute__((address_space(3)))
typedef unsigned short bf16;
typedef unsigned v4u __attribute__((ext_vector_type(4)));
typedef unsigned v2u __attribute__((ext_vector_type(2)));
typedef float f32x4 __attribute__((ext_vector_type(4)));
typedef float f32x16 __attribute__((ext_vector_type(16)));
typedef short bf16x8 __attribute__((ext_vector_type(8)));
typedef GAS unsigned gu32;
#define RLX_AGENT __ATOMIC_RELAXED, __HIP_MEMORY_SCOPE_AGENT
#define LDS_WAIT() asm volatile("s_waitcnt lgkmcnt(0)" ::: "memory")
#define VM_WAIT() asm volatile("s_waitcnt vmcnt(0)" ::: "memory")
__device__ __forceinline__ unsigned f2bf(float f) { unsigned u = __builtin_bit_cast(unsigned, f); return (u + 0x7fffu + ((u >> 16) & 1u)) >> 16; }
__device__ __forceinline__ unsigned f2bf_s(float f) { return pg8::cvt_pk_bf16(f, 0.f) & 0xffffu; }
__device__ __forceinline__ unsigned pk2(float lo, float hi) { return pg8::cvt_pk_bf16(lo, hi); }
__device__ __forceinline__ float bflo(unsigned w) { return __uint_as_float(w << 16); }
__device__ __forceinline__ float bfhi(unsigned w) { return __uint_as_float(w & 0xffff0000u); }
__device__ __forceinline__ float bf2f(bf16 v) { return __uint_as_float((unsigned)v << 16); }
__device__ __forceinline__ int seqrow(int b, int p) { return p < NMETA ? MREAL + p : b * SEQ + p - NMETA; }
__device__ __forceinline__ int rel_bucket(int n) {
    if (n < 16) return n; if (n >= 128) return 31;
    const int v = 16 + (int)(__log2f((float)n * 0.0625f) * 5.33333333f); return v < 31 ? v : 31; }
__device__ __forceinline__ float wave_sum(float v) {
#pragma unroll
    for (int o = 1; o < 64; o <<= 1) v += __shfl_xor(v, o);
    return v;
}
#define XB_TMO      128
#define XB_XCNT(j)  (256  + 64 * (j))
#define XB_XSUB(j)  (1280 + 64 * (j))
#define XB_XGEN(j)  (2304 + 64 * (j))
#define XB_TOP      3328
#define XB_TOPGEN   3392
#define XCD_BAR_WORDS 3456
#define XB_SPIN_CAP (1u << 18)

__device__ __forceinline__ unsigned xb_ld(unsigned* p)              { return __hip_atomic_load(p, __ATOMIC_RELAXED, __HIP_MEMORY_SCOPE_AGENT); }
__device__ __forceinline__ unsigned xb_add(unsigned* p, unsigned v) { return __hip_atomic_fetch_add(p, v, __ATOMIC_RELAXED, __HIP_MEMORY_SCOPE_AGENT); }
__device__ __forceinline__ unsigned xb_xcc_id() { return (unsigned)__builtin_amdgcn_s_getreg((3 << 11) | 20) & 0xFu; }
#define XB_SPIN(cond, bar) do { unsigned _sp = 0; while (cond) { __builtin_amdgcn_s_sleep(1); \
    if ((++_sp & 255u) == 0u) { if (xb_ld(&(bar)[XB_TMO])) break; if (_sp > XB_SPIN_CAP) { atomicAdd(&(bar)[XB_TMO], 1u); break; } } } } while (0)

struct XcdBarrier {
    unsigned* bar; unsigned x;
    volatile LAS unsigned* st;
};

__device__ __forceinline__ XcdBarrier xcd_barrier_post(unsigned* bar, volatile LAS unsigned* st) {
    XcdBarrier b; b.bar = bar; b.x = xb_xcc_id(); b.st = st;
    if (threadIdx.x == 0) (void)xb_add(&bar[XB_XCNT(b.x)], 1u);
    return b;
}
__device__ __forceinline__ void xcd_barrier_complete(unsigned* bar, unsigned x, unsigned& nloc, unsigned& nx) {
    const unsigned G = gridDim.x * gridDim.y * gridDim.z;
    unsigned sum, cnt, mine, sp = 0u;
    for (;;) {
        sum = 0u; cnt = 0u; mine = 0u;
#pragma unroll
        for (unsigned j = 0; j < 16; ++j) { const unsigned c = xb_ld(&bar[XB_XCNT(j)]); sum += c; cnt += (c > 0u) ? 1u : 0u; mine = (j == x) ? c : mine; }
        if (sum == G) break;
        __builtin_amdgcn_s_sleep(1);
        if ((++sp & 255u) == 0u) { if (xb_ld(&bar[XB_TMO])) break; if (sp > XB_SPIN_CAP) { atomicAdd(&bar[XB_TMO], 1u); break; } }
    }
    nloc = mine > 0u ? mine : 1u; nx = cnt > 0u ? cnt : 1u;
}

__device__ __forceinline__ void xcd_barrier(const XcdBarrier& b) {
    asm volatile("s_waitcnt vmcnt(0)" ::: "memory");
    __syncthreads();
    if (threadIdx.x == 0) {
        unsigned* bar = b.bar;
        __builtin_amdgcn_s_waitcnt(0);
        unsigned nloc = b.st[0], nx = b.st[1];
        if (nloc == 0u) { xcd_barrier_complete(bar, b.x, nloc, nx); b.st[0] = nloc; b.st[1] = nx; }
        const unsigned old = xb_add(&bar[XB_XSUB(b.x)], 1u);
        const unsigned gen = old / nloc;
        if (old + 1u == (gen + 1u) * nloc) {
            __builtin_amdgcn_fence(__ATOMIC_RELEASE, "agent");
            asm volatile("s_waitcnt vmcnt(0)" ::: "memory");
            const unsigned og = xb_add(&bar[XB_TOP], 1u);
            const unsigned tg = og / nx;
            if (og + 1u == (tg + 1u) * nx) xb_add(&bar[XB_TOPGEN], 1u);
            else XB_SPIN(xb_ld(&bar[XB_TOPGEN]) == tg, bar);
            __builtin_amdgcn_fence(__ATOMIC_ACQUIRE, "agent");
            xb_add(&bar[XB_XGEN(b.x)], 1u);
            asm volatile("s_waitcnt vmcnt(0)" ::: "memory");
        } else {
            XB_SPIN(xb_ld(&bar[XB_XGEN(b.x)]) == gen, bar);
            __builtin_amdgcn_fence(__ATOMIC_ACQUIRE, "agent");
            asm volatile("s_waitcnt vmcnt(0)" ::: "memory");
        }
    }
    __syncthreads();
}

struct Frame {
    LAS unsigned char* lds;
    volatile LAS unsigned* MISC;
    gu32* ctl;
    int tid, lane, wave, G, bid;
    const float* in[22]; float* out; unsigned char* ws;
};
enum { I_X = 0, I_META, I_RELB, I_F1N, I_F1GU, I_F1D, I_MIXN, I_WIN, I_LB, I_GN, I_CONVW, I_DQN, I_DKN, I_DLAM, I_DSUB, I_SQN, I_SKN, I_WBR, I_WOUT, I_F2N, I_F2GU, I_F2D };

template <class RowMap>
__device__ __forceinline__ void transpose_item(const float* W, int K, int N, bf16* WT, LAS float* scr, int item, int lane, RowMap rm) {
    const int nblk = (N + 31) / 32, kb = item / nblk, nb = item % nblk, k0 = 64 * kb, n0 = 32 * nb;
    const int nl = n0 + (lane & 31); const bool nok = nl < N;
#pragma unroll 8
    for (int i = 0; i < 32; ++i) { const int kk = 2 * i + (lane >> 5); scr[kk * 33 + (lane & 31)] = nok ? W[(size_t)(k0 + kk) * N + nl] : 0.f; }
    LDS_WAIT(); asm volatile("" ::: "memory");
    const int c = lane & 7;
#pragma unroll
    for (int j = 0; j < 4; ++j) { const int n = (lane >> 3) + 8 * j; const LAS float* s = scr + (8 * c) * 33 + n;
        v4u o; o.x = pk2(s[0 * 33], s[1 * 33]); o.y = pk2(s[2 * 33], s[3 * 33]); o.z = pk2(s[4 * 33], s[5 * 33]); o.w = pk2(s[6 * 33], s[7 * 33]);
        if (n0 + n < N) *(GAS v4u*)(WT + (size_t)rm(n0 + n) * K + k0 + 8 * c) = o; }
    LDS_WAIT(); asm volatile("" ::: "memory");
}
struct MapId { __device__ __forceinline__ int operator()(int n) const { return n; } };
struct MapGU { __device__ __forceinline__ int operator()(int n) const { const int up = n >= DFF, j = up ? n - DFF : n; return 256 * (j >> 7) + 128 * up + (j & 127); } };
struct MapIn { __device__ __forceinline__ int operator()(int n) const { return n < NGC ? n : n + (NNG - NGC); } };
template <class RowMap>
__device__ __forceinline__ void convert_matrix(Frame& F, const float* W, int K, int N, bf16* WT, RowMap rm) {
    LAS float* scr = (LAS float*)(F.lds + F.wave * 16384);
    const int gw = F.bid * NWAVES + F.wave, NGW = F.G * NWAVES, nitems = (K / 64) * ((N + 31) / 32);
    for (int it = gw; it < nitems; it += NGW) transpose_item(W, K, N, WT, scr, it, F.lane, rm);
}
__device__ __forceinline__ void phase_convert(Frame& F, int l) {
    unsigned char* wb = F.ws + WS_W;
    convert_matrix(F, F.in[I_F1GU] + (size_t)l * DM * NGU, DM, NGU, (bf16*)(wb + W_GU1), MapGU());
    convert_matrix(F, F.in[I_F1D] + (size_t)l * DFF * DM, DFF, DM, (bf16*)(wb + W_D1), MapId());
    convert_matrix(F, F.in[I_WIN] + (size_t)l * DM * INCOLS, DM, INCOLS, (bf16*)(wb + W_NG), MapIn());
    for (int m = 0; m < 4; ++m) convert_matrix(F, F.in[I_WBR] + ((size_t)l * 4 + m) * 512 * DM, 512, DM, (bf16*)(wb + W_BR) + (size_t)m * DM * 512, MapId());
    convert_matrix(F, F.in[I_WOUT] + (size_t)l * DM * DM, DM, DM, (bf16*)(wb + W_O), MapId());
    convert_matrix(F, F.in[I_F2GU] + (size_t)l * DM * NGU, DM, NGU, (bf16*)(wb + W_GU2), MapGU());
    convert_matrix(F, F.in[I_F2D] + (size_t)l * DFF * DM, DFF, DM, (bf16*)(wb + W_D2), MapId());
    { GAS v4u* z = (GAS v4u*)(wb + W_NG + (size_t)NGC * DM * 2); const int n16 = (NNG - NGC) * DM * 2 / 16;
      for (int i = F.bid * 512 + F.tid; i < n16; i += F.G * 512) z[i] = (v4u){0u, 0u, 0u, 0u}; }
    if (l == 0) {
        GAS f32x4* hm = (GAS f32x4*)(F.ws + WS_HM); const GAS f32x4* mt = (const GAS f32x4*)F.in[I_META];
        for (int i = F.bid * 512 + F.tid; i < 256 * DM / 4; i += F.G * 512) hm[i] = (i < NMETA * DM / 4) ? mt[i] : (f32x4){0.f, 0.f, 0.f, 0.f};
    }
}
__device__ __forceinline__ void phase_norm(Frame& F, const float* src_real, const float* gain) {
    const int gw = F.bid * NWAVES + F.wave, NGW = F.G * NWAVES;
    bf16* XN = (bf16*)(F.ws + WS_XN); const float* hm = (const float*)(F.ws + WS_HM);
    f32x4 g[8];
#pragma unroll
    for (int j = 0; j < 8; ++j) g[j] = ((const GAS f32x4*)gain)[F.lane + 64 * j];
    for (int r = gw; r < MPAD; r += NGW) {
        GAS v2u* o8 = (GAS v2u*)(XN + (size_t)r * DM) + F.lane;
        if (r >= MREAL + NMETA) {
#pragma unroll
            for (int j = 0; j < 8; ++j) o8[64 * j] = (v2u){0u, 0u};
            continue; }
        const float* xr = r < MREAL ? src_real + (size_t)r * DM : hm + (size_t)(r - MREAL) * DM;
        f32x4 v[8]; float s = 0.f;
#pragma unroll
        for (int j = 0; j < 8; ++j) { v[j] = ((const GAS f32x4*)xr)[F.lane + 64 * j]; s += (v[j].x * v[j].x + v[j].y * v[j].y) + (v[j].z * v[j].z + v[j].w * v[j].w); }
        const float inv = 1.0f / sqrtf(wave_sum(s) * (1.f / DM) + EPS);
#pragma unroll
        for (int j = 0; j < 8; ++j) { v2u w; w.x = pk2(v[j].x * inv * g[j].x, v[j].y * inv * g[j].y); w.y = pk2(v[j].z * inv * g[j].z, v[j].w * inv * g[j].w); o8[64 * j] = w; }
    }
}
__device__ __forceinline__ void unpack8(const v4u w, float (&x)[8]) { x[0] = bflo(w.x); x[1] = bfhi(w.x); x[2] = bflo(w.y); x[3] = bfhi(w.y); x[4] = bflo(w.z); x[5] = bfhi(w.z); x[6] = bflo(w.w); x[7] = bfhi(w.w); }
__device__ __forceinline__ v4u pack8(const float (&x)[8]) { v4u w; w.x = pk2(x[0], x[1]); w.y = pk2(x[2], x[3]); w.z = pk2(x[4], x[5]); w.w = pk2(x[6], x[7]); return w; }
template <int GL>
__device__ __forceinline__ void norm_cols_inplace(bf16* p, const float* gain, float scale, int lane, bool wr) {
    float x[8]; unpack8(*(const GAS v4u*)p, x); float s = 0.f;
#pragma unroll
    for (int i = 0; i < 8; ++i) s += x[i] * x[i];
#pragma unroll
    for (int o = 1; o < GL; o <<= 1) s += __shfl_xor(s, o);
    const float inv = scale / sqrtf(s * (1.f / (GL * 8)) + EPS); const int g0 = (8 * lane) % (GL * 8);
#pragma unroll
    for (int i = 0; i < 8; ++i) x[i] = x[i] * inv * gain[g0 + i];
    if (wr) *(GAS v4u*)p = pack8(x);
}
__device__ __forceinline__ void phase_prep(Frame& F, int l) {
    const int gw = F.bid * NWAVES + F.wave, NGW = F.G * NWAVES, lane = F.lane;
    bf16* P = (bf16*)(F.ws + WS_BIG);
    const float *dqn = F.in[I_DQN] + l * 64, *dkn = F.in[I_DKN] + l * 64, *sqn = F.in[I_SQN] + l * 128, *skn = F.in[I_SKN] + l * 128;
    for (int r = gw; r < MREAL + NMETA; r += NGW) {
        bf16* pr = P + (size_t)r * NNG;
        norm_cols_inplace<8>(pr + C_CQ + 8 * lane, dqn, 0.125f, lane, true);
        norm_cols_inplace<8>(pr + C_CK + 8 * lane, dkn, 1.0f, lane, true);
        norm_cols_inplace<16>(pr + C_DQ + 8 * lane, sqn, 0.08838834764831845f, lane, true);
        norm_cols_inplace<16>(pr + C_DK + 8 * (lane & 15), skn, 1.0f, lane & 15, lane < 16);
    }
}
__device__ __forceinline__ void phase_vt(Frame& F) {
    const int gw = F.bid * NWAVES + F.wave, NGW = F.G * NWAVES, lane = F.lane;
    const bf16* P = (const bf16*)(F.ws + WS_BIG); bf16* VtC = (bf16*)(F.ws + WS_VTC); bf16* VtD = (bf16*)(F.ws + WS_VTD);
    LAS bf16* T = (LAS bf16*)(F.lds + F.wave * 17408);
    constexpr int NPB = (LPAD + 63) / 64;
    for (int task = gw; task < NB * 5 * NPB; task += NGW) {
        const int pb = task % NPB, mat = (task / NPB) % 5, b = task / (NPB * 5), p0 = 64 * pb;
        const int col = mat < 4 ? C_CV + 128 * mat : C_DV;
#pragma unroll 4
        for (int i = 0; i < 16; ++i) { const int pl = 4 * i + (lane >> 4), p = p0 + pl; v4u w = (v4u){0u, 0u, 0u, 0u};
            if (p < LSEQ) w = *(const GAS v4u*)(P + (size_t)seqrow(b, p) * NNG + col + 8 * (lane & 15));
            *(LAS v4u*)(T + pl * 136 + 8 * (lane & 15)) = w; }
        LDS_WAIT(); asm volatile("" ::: "memory");
        bf16* dst = mat < 4 ? VtC + (size_t)(b * 4 + mat) * 128 * LPAD : VtD + (size_t)b * 128 * LPAD;
#pragma unroll 4
        for (int it = 0; it < 16; ++it) { const int e = 8 * it + (lane >> 3), c = lane & 7; unsigned short x[8];
#pragma unroll
            for (int k = 0; k < 8; ++k) x[k] = T[(8 * c + k) * 136 + e];
            v4u w; w.x = x[0] | ((unsigned)x[1] << 16); w.y = x[2] | ((unsigned)x[3] << 16); w.z = x[4] | ((unsigned)x[5] << 16); w.w = x[6] | ((unsigned)x[7] << 16);
            if (p0 + 8 * c < LPAD) *(GAS v4u*)(dst + (size_t)e * LPAD + p0 + 8 * c) = w; }
        LDS_WAIT(); asm volatile("" ::: "memory");
    }
}

#define NEG_INF (-__builtin_inff())
__device__ __forceinline__ bf16x8 ld_frag16(const bf16* p) { return *(const GAS bf16x8*)p; }
__device__ __forceinline__ bf16x8 mk_frag(v2u lo, v2u hi) { v4u w; w.x = lo.x; w.y = lo.y; w.z = hi.x; w.w = hi.y; return __builtin_bit_cast(bf16x8, w); }
__device__ __forceinline__ unsigned cvtpk(float lo, float hi) { return pg8::cvt_pk_bf16(lo, hi); }
__device__ __forceinline__ void build_bias_table(Frame& F, LAS float* bt, int col0) {
    const float* rb = F.in[I_RELB];
    for (int i = F.tid; i < 4 * 128; i += 512) { const int hd = i >> 7, n = i & 127; bt[i] = rb[rel_bucket(n) * 8 + col0 + hd]; }
}
__device__ __forceinline__ void softmax_step(f32x16& S, float& m, float& lsum, float& alpha) {
    float tm = S[0];
#pragma unroll
    for (int r = 1; r < 16; ++r) tm = fmaxf(tm, S[r]);
    tm = fmaxf(tm, __shfl_xor(tm, 32));
    const float mn = fmaxf(m, tm), mref = (mn == NEG_INF) ? 0.f : mn;
    alpha = __expf(m - mref);
    float rs = 0.f;
#pragma unroll
    for (int r = 0; r < 16; ++r) { S[r] = __expf(S[r] - mref); rs += S[r]; }
    rs += __shfl_xor(rs, 32);
    lsum = lsum * alpha + rs; m = mn;
}
__device__ __forceinline__ void pv_step(f32x16 (&O)[4], const f32x16& S, const bf16* vt0  ) {
    bf16x8 pf[2];
#pragma unroll
    for (int s = 0; s < 2; ++s) { v4u w; w.x = cvtpk(S[8 * s + 0], S[8 * s + 1]); w.y = cvtpk(S[8 * s + 2], S[8 * s + 3]); w.z = cvtpk(S[8 * s + 4], S[8 * s + 5]); w.w = cvtpk(S[8 * s + 6], S[8 * s + 7]); pf[s] = __builtin_bit_cast(bf16x8, w); }
#pragma unroll
    for (int eb = 0; eb < 4; ++eb)
#pragma unroll
        for (int s = 0; s < 2; ++s) { const bf16* vp = vt0 + (size_t)eb * 32 * LPAD + 16 * s;
            const bf16x8 vf = mk_frag(*(const GAS v2u*)vp, *(const GAS v2u*)(vp + 8));
            O[eb] = __builtin_amdgcn_mfma_f32_32x32x16_bf16(vf, pf[s], O[eb], 0, 0, 0); }
}
__device__ __forceinline__ void diff_attn_task(Frame& F, int l, int b, int h, int j, const LAS float* bt, float lam, float post) {
    const int lane = F.lane, ql = lane & 31, hh = lane >> 5;
    const bf16* P = (const bf16*)(F.ws + WS_BIG); const bf16* Vt = (const bf16*)(F.ws + WS_VTC) + ((size_t)(b * 4 + h) * 128 + ql) * LPAD + 4 * hh;
    const int pq = 32 * j + ql, pqc = pq < LSEQ ? pq : LSEQ - 1;
    const bf16* qrow = P + (size_t)seqrow(b, pqc) * NNG + C_CQ + h * 128 + 8 * hh;
    const float b31 = bt[h * 128 + 127];
    f32x16 R[4];
#pragma unroll
    for (int c = 0; c < 2; ++c) {
        bf16x8 qf[4];
#pragma unroll
        for (int ks = 0; ks < 4; ++ks) qf[ks] = ld_frag16(qrow + c * 64 + 16 * ks);
        float m = NEG_INF, lsum = 0.f; f32x16 O[4];
#pragma unroll
        for (int eb = 0; eb < 4; ++eb)
#pragma unroll
            for (int r = 0; r < 16; ++r) O[eb][r] = 0.f;
        for (int kt = 0; kt <= j; ++kt) {
            const int pk = 32 * kt + ql, pkc = pk < LSEQ ? pk : LSEQ - 1;
            const bf16* krow = P + (size_t)seqrow(b, pkc) * NNG + C_CK + h * 128 + c * 64 + 8 * hh;
            f32x16 S;
#pragma unroll
            for (int r = 0; r < 16; ++r) S[r] = 0.f;
#pragma unroll
            for (int ks = 0; ks < 4; ++ks) S = __builtin_amdgcn_mfma_f32_32x32x16_bf16(ld_frag16(krow + 16 * ks), qf[ks], S, 0, 0, 0);
            if (kt + 4 >= j) {
#pragma unroll
                for (int r = 0; r < 16; ++r) { const int kp = 32 * kt + 4 * hh + (r & 3) + 8 * (r >> 2), n = pq - kp; S[r] = (n >= 0) ? S[r] + bt[h * 128 + (n < 127 ? n : 127)] : NEG_INF; }
            } else {
#pragma unroll
                for (int r = 0; r < 16; ++r) S[r] += b31;
            }
            float alpha; softmax_step(S, m, lsum, alpha);
#pragma unroll
            for (int eb = 0; eb < 4; ++eb)
#pragma unroll
                for (int r = 0; r < 16; ++r) O[eb][r] *= alpha;
            pv_step(O, S, Vt + 32 * kt);
        }
        const float il = 1.0f / lsum;
        if (c == 0) {
#pragma unroll
            for (int eb = 0; eb < 4; ++eb)
#pragma unroll
                for (int r = 0; r < 16; ++r) R[eb][r] = O[eb][r] * il;
        } else {
#pragma unroll
            for (int eb = 0; eb < 4; ++eb)
#pragma unroll
                for (int r = 0; r < 16; ++r) R[eb][r] -= lam * (O[eb][r] * il);
        }
    }
    float ss = 0.f;
#pragma unroll
    for (int eb = 0; eb < 4; ++eb)
#pragma unroll
        for (int r = 0; r < 16; ++r) ss += R[eb][r] * R[eb][r];
    ss += __shfl_xor(ss, 32);
    const float inv = post / sqrtf(ss * (1.f / 128.f) + EPS);
    const float* sub = F.in[I_DSUB] + l * 128;
    if (pq < LSEQ && (pq >= NMETA || b == 0)) {
        bf16* orow = (bf16*)(F.ws + WS_BR) + (size_t)2 * MPAD * 512 + (size_t)seqrow(b, pq) * 512 + h * 128;
#pragma unroll
        for (int eb = 0; eb < 4; ++eb)
#pragma unroll
            for (int g = 0; g < 4; ++g) { const int e0 = 32 * eb + 8 * g + 4 * hh; const f32x4 sv = *(const GAS f32x4*)(sub + e0);
                v2u w; w.x = pk2(R[eb][4 * g] * inv * sv.x, R[eb][4 * g + 1] * inv * sv.y); w.y = pk2(R[eb][4 * g + 2] * inv * sv.z, R[eb][4 * g + 3] * inv * sv.w);
                *(GAS v2u*)(orow + e0) = w; }
    }
}
__device__ __forceinline__ void dsa_attn_task(Frame& F, int b, int h, int j, const LAS float* bt) {
    const int lane = F.lane, ql = lane & 31, hh = lane >> 5;
    const bf16* P = (const bf16*)(F.ws + WS_BIG); const bf16* Vt = (const bf16*)(F.ws + WS_VTD) + ((size_t)b * 128 + ql) * LPAD + 4 * hh;
    const int pq = 32 * j + ql, pqc = pq < LSEQ ? pq : LSEQ - 1;
    const bf16* qrow = P + (size_t)seqrow(b, pqc) * NNG + C_DQ + h * 128 + 8 * hh;
    const unsigned* mrow = (const unsigned*)(F.ws + WS_MASK) + ((size_t)b * LPAD + pqc) * MASKW;
    const float b31 = bt[h * 128 + 127];
    bf16x8 qf[8];
#pragma unroll
    for (int ks = 0; ks < 8; ++ks) qf[ks] = ld_frag16(qrow + 16 * ks);
    float m = NEG_INF, lsum = 0.f; f32x16 O[4];
#pragma unroll
    for (int eb = 0; eb < 4; ++eb)
#pragma unroll
        for (int r = 0; r < 16; ++r) O[eb][r] = 0.f;
    for (int kt = 0; kt <= j; ++kt) {
        const int pk = 32 * kt + ql, pkc = pk < LSEQ ? pk : LSEQ - 1;
        const bf16* krow = P + (size_t)seqrow(b, pkc) * NNG + C_DK + 8 * hh;
        const unsigned mw = mrow[kt] >> (4 * hh);
        f32x16 S;
#pragma unroll
        for (int r = 0; r < 16; ++r) S[r] = 0.f;
#pragma unroll
        for (int ks = 0; ks < 8; ++ks) S = __builtin_amdgcn_mfma_f32_32x32x16_bf16(ld_frag16(krow + 16 * ks), qf[ks], S, 0, 0, 0);
        if (kt + 4 >= j) {
#pragma unroll
            for (int r = 0; r < 16; ++r) { const int kp = 32 * kt + 4 * hh + (r & 3) + 8 * (r >> 2), n = pq - kp; const bool sel = (mw >> ((r & 3) + 8 * (r >> 2))) & 1u;
                S[r] = (sel && n >= 0) ? S[r] + bt[h * 128 + (n < 127 ? n : 127)] : NEG_INF; }
        } else {
#pragma unroll
            for (int r = 0; r < 16; ++r) { const bool sel = (mw >> ((r & 3) + 8 * (r >> 2))) & 1u; S[r] = sel ? S[r] + b31 : NEG_INF; }
        }
        float alpha; softmax_step(S, m, lsum, alpha);
#pragma unroll
        for (int eb = 0; eb < 4; ++eb)
#pragma unroll
            for (int r = 0; r < 16; ++r) O[eb][r] *= alpha;
        pv_step(O, S, Vt + 32 * kt);
    }
    const float il = 1.0f / lsum;
    if (pq < LSEQ && (pq >= NMETA || b == 0)) {
        bf16* orow = (bf16*)(F.ws + WS_BR) + (size_t)3 * MPAD * 512 + (size_t)seqrow(b, pq) * 512 + h * 128;
#pragma unroll
        for (int eb = 0; eb < 4; ++eb)
#pragma unroll
            for (int g = 0; g < 4; ++g) { const int e0 = 32 * eb + 8 * g + 4 * hh;
                v2u w; w.x = pk2(O[eb][4 * g] * il, O[eb][4 * g + 1] * il); w.y = pk2(O[eb][4 * g + 2] * il, O[eb][4 * g + 3] * il);
                *(GAS v2u*)(orow + e0) = w; }
    }
}
__device__ __forceinline__ unsigned f32_key(float f) { const unsigned u = __float_as_uint(f); return u ^ ((u >> 31) ? 0xffffffffu : 0x80000000u); }
__device__ __forceinline__ void dsa_index_task(Frame& F, int b, int j, float* slab) {
    const int lane = F.lane, ql = lane & 31, hh = lane >> 5, wave = F.wave;
    const bf16* P = (const bf16*)(F.ws + WS_BIG);
    LAS unsigned char* qi = F.lds;
    for (int i = F.tid; i < 32 * 128; i += 512) { const int q = i >> 7, ch = i & 127; int pq = 32 * j + q; pq = pq < LSEQ ? pq : LSEQ - 1;
        *(LAS v4u*)(qi + q * 2064 + 16 * ch) = *(const GAS v4u*)(P + (size_t)seqrow(b, pq) * NNG + C_DQI + 8 * ch); }
    LAS float* wl = (LAS float*)(qi + 32 * 2064);
    if (F.tid < 32 * 16) { const int q = F.tid >> 4, hd = F.tid & 15; int pq = 32 * j + q; pq = pq < LSEQ ? pq : LSEQ - 1;
        wl[F.tid] = bf2f(P[(size_t)seqrow(b, pq) * NNG + C_DW + hd]) * 0.03125f; }
    LDS_WAIT(); __syncthreads();
    for (int kt = wave; kt <= j; kt += NWAVES) {
        const int pk = 32 * kt + ql, pkc = pk < LSEQ ? pk : LSEQ - 1;
        const bf16* krow = P + (size_t)seqrow(b, pkc) * NNG + C_DKI + 8 * hh;
        bf16x8 kf[4];
#pragma unroll
        for (int ks = 0; ks < 4; ++ks) kf[ks] = ld_frag16(krow + 16 * ks);
        f32x16 idx;
#pragma unroll
        for (int r = 0; r < 16; ++r) idx[r] = 0.f;
#pragma unroll 1
        for (int hd = 0; hd < 16; ++hd) { f32x16 S; const float wh = wl[ql * 16 + hd];
#pragma unroll
            for (int r = 0; r < 16; ++r) S[r] = 0.f;
#pragma unroll
            for (int ks = 0; ks < 4; ++ks) S = __builtin_amdgcn_mfma_f32_32x32x16_bf16(kf[ks], *(const LAS bf16x8*)(qi + ql * 2064 + hd * 128 + 32 * ks + 16 * hh), S, 0, 0, 0);
#pragma unroll
            for (int r = 0; r < 16; ++r) idx[r] += wh * fmaxf(S[r], 0.f); }
        float* srow = slab + (size_t)ql * LPAD + 32 * kt + 4 * hh;
#pragma unroll
        for (int g = 0; g < 4; ++g) *(GAS f32x4*)(srow + 8 * g) = (f32x4){idx[4 * g], idx[4 * g + 1], idx[4 * g + 2], idx[4 * g + 3]};
    }
    VM_WAIT(); __syncthreads();
    for (int qq = wave; qq < 32; qq += NWAVES) {
        const int p = 32 * j + qq; if (p >= LSEQ) break;
        const float* row = slab + (size_t)qq * LPAD;
        unsigned u[65];
#pragma unroll
        for (int i = 0; i < 65; ++i) { const int key = 64 * i + lane; u[i] = 0u; if (key <= p) u[i] = f32_key(((const GAS float*)row)[key]); }
        unsigned T = 1u;
        if (p + 1 > 256) { T = 0u;
            for (int bit = 31; bit >= 0; --bit) { const unsigned cand = T | (1u << bit); int cnt = 0;
#pragma unroll
                for (int i = 0; i < 65; ++i) cnt += (u[i] >= cand) ? 1 : 0;
#pragma unroll
                for (int o = 1; o < 64; o <<= 1) cnt += __shfl_xor(cnt, o);
                if (cnt >= 256) T = cand; } }
        unsigned long long* mrow = (unsigned long long*)((unsigned*)(F.ws + WS_MASK) + ((size_t)b * LPAD + p) * MASKW);
#pragma unroll
        for (int i = 0; i < 65; ++i) { const unsigned long long bal = __ballot(u[i] >= T); if (lane == 0) mrow[i] = bal; }
    }
    __syncthreads();
}
struct HgChunk { bf16* base; int pitch; int cq, ck, cv; bf16* A; float* dl; };
__device__ __forceinline__ HgChunk hg_chunk(Frame& F, int b, int h, int c) {
    HgChunk k;
    if (c == 0) { unsigned char* mp = F.ws + WS_HMETA + (size_t)h * HMETA_STRIDE; k.base = (bf16*)mp; k.pitch = 384; k.cq = 0; k.ck = 128; k.cv = 256; k.A = (bf16*)(mp + 64 * 384 * 2); k.dl = (float*)(mp + 64 * 384 * 2 + 64 * 64 * 2); }
    else { const size_t ci = (size_t)(b * 4 + h) * 64 + (c - 1); k.base = (bf16*)(F.ws + WS_BIG) + (size_t)(b * SEQ + 64 * (c - 1)) * NNG; k.pitch = NNG; k.cq = C_AQ + h * 128; k.ck = C_AF + h * 128; k.cv = C_AI + h * 128;
        k.A = (bf16*)(F.ws + WS_HA) + ci * 64 * 64; k.dl = (float*)(F.ws + WS_HDL) + ci * 128; }
    return k;
}
__device__ __forceinline__ void hgrn_prep_task(Frame& F, int l, int b, int h, int c) {
    const int d = F.tid & 127, tq = F.tid >> 7, lane = F.lane, wave = F.wave;
    const bf16* P = (const bf16*)(F.ws + WS_BIG);
    LAS bf16* Qt = (LAS bf16*)F.lds; LAS bf16* Kt = Qt + 64 * 136; LAS float* part = (LAS float*)(F.lds + 2 * 64 * 136 * 2);
    const HgChunk ch = hg_chunk(F, b, h, c);
    float lb = 0.f; if (l == 1) { const float a = F.in[I_LB][h * 128 + d], cc = F.in[I_LB][512 + h * 128 + d]; lb = 1.0f / (1.0f + __expf(a - cc)); }
    const bool meta = (c == 0);
    const bf16* pr0 = P + (size_t)(meta ? MREAL + 16 * tq : b * SEQ + 64 * (c - 1) + 16 * tq) * NNG + h * 128 + d;
    float run = 0.f;
#pragma unroll 4
    for (int i = 0; i < 16; ++i) { const bool valid = !meta || (16 * tq + i < NMETA);
        if (valid) { const float z = bf2f(pr0[(size_t)i * NNG + C_AF]); const float sg = 1.0f / (1.0f + __expf(-z)); run += __logf(lb + (1.0f - lb) * sg); } }
    part[tq * 128 + d] = run;
    LDS_WAIT(); __syncthreads();
    const float p0 = part[d], p1 = part[128 + d], p2 = part[256 + d], p3 = part[384 + d];
    const float off = (tq > 0 ? p0 : 0.f) + (tq > 1 ? p1 : 0.f) + (tq > 2 ? p2 : 0.f), bmid = p0 + p1, blast = (p0 + p1) + (p2 + p3);
    unsigned kb[8], vb[8]; unsigned short qb[16];
    float bt = off;
#pragma unroll
    for (int i = 0; i < 16; i += 2) { float kbar[2], vv[2];
#pragma unroll
        for (int u = 0; u < 2; ++u) { const int t = 16 * tq + i + u; const bool valid = !meta || (t < NMETA);
            float lf = 0.f, kk = 0.f, qq = 0.f; vv[u] = 0.f;
            if (valid) { const bf16* pr = pr0 + (size_t)(i + u) * NNG; const float z = bf2f(pr[C_AF]), q = bf2f(pr[C_AQ]); vv[u] = bf2f(pr[C_AI]);
                const float sg = 1.0f / (1.0f + __expf(-z)), f = lb + (1.0f - lb) * sg; lf = __logf(f); kk = 1.0f - f; qq = q / (1.0f + __expf(-q)); }
            bt += lf;
            kbar[u] = kk * __expf(blast - bt); qb[i + u] = (unsigned short)f2bf_s(qq * __expf(bt));
            const float qt = qq * __expf(fminf(bt - bmid, 80.f)), kt = kk * __expf(fminf(bmid - bt, 80.f));
            Qt[t * 136 + d] = (bf16)f2bf_s(qt); Kt[t * 136 + d] = (bf16)f2bf_s(kt); }
        kb[i >> 1] = pk2(kbar[0], kbar[1]); vb[i >> 1] = pk2(vv[0], vv[1]); }
    asm volatile("s_waitcnt vmcnt(0)" ::: "memory"); __syncthreads();
#pragma unroll
    for (int i = 0; i < 16; ++i) ch.base[(size_t)(16 * tq + i) * ch.pitch + ch.cq + d] = qb[i];
    { bf16* kd = ch.base + (size_t)(d >> 1) * ch.pitch + ch.ck + (d & 1) * 64 + 16 * tq; bf16* vd = ch.base + (size_t)(d >> 1) * ch.pitch + ch.cv + (d & 1) * 64 + 16 * tq;
      *(GAS v4u*)kd = (v4u){kb[0], kb[1], kb[2], kb[3]}; *(GAS v4u*)(kd + 8) = (v4u){kb[4], kb[5], kb[6], kb[7]};
      *(GAS v4u*)vd = (v4u){vb[0], vb[1], vb[2], vb[3]}; *(GAS v4u*)(vd + 8) = (v4u){vb[4], vb[5], vb[6], vb[7]}; }
    if (tq == 0) ch.dl[d] = __expf(blast);
    LDS_WAIT(); __syncthreads();
    { const int mt = wave >> 1, fr = lane & 15, g = lane >> 4;
#pragma unroll
      for (int u = 0; u < 2; ++u) { const int nt = 2 * (wave & 1) + u; f32x4 acc = (f32x4){0.f, 0.f, 0.f, 0.f};
        if (nt <= mt) {
#pragma unroll
            for (int ks = 0; ks < 4; ++ks) acc = __builtin_amdgcn_mfma_f32_16x16x32_bf16(*(const LAS bf16x8*)(Qt + (16 * mt + fr) * 136 + 32 * ks + 8 * g), *(const LAS bf16x8*)(Kt + (16 * nt + fr) * 136 + 32 * ks + 8 * g), acc, 0, 0, 0);
        }
#pragma unroll
        for (int r = 0; r < 4; ++r) { const int t = 16 * mt + 4 * g + r, s = 16 * nt + fr; ch.A[t * 64 + s] = (bf16)f2bf_s(s <= t ? acc[r] : 0.f); } } }
    __syncthreads();
}
__device__ __forceinline__ void hgrn_scan_unit(Frame& F, int l, int b, int h) {
    const int lane = F.lane, wave = F.wave, fr = lane & 15, g = lane >> 4, tid = F.tid;
    constexpr int QP = 136, AP = 72, KP = 72;
    constexpr int BUF = (64 * QP + 64 * AP + 128 * KP) * 2;
    LAS float* red = (LAS float*)(F.lds + 2 * BUF);
    const float gn = F.in[I_GN][l * 512 + h * 128 + 16 * wave + fr];
    f32x4 S[8];
#pragma unroll
    for (int mt = 0; mt < 8; ++mt) S[mt] = (f32x4){0.f, 0.f, 0.f, 0.f};
    v4u rq[2], ra, rk[2];
    auto issue = [&](int c) { const HgChunk ch = hg_chunk(F, b, h, c);
#pragma unroll
        for (int i = 0; i < 2; ++i) { const int idx = tid + 512 * i, row = idx >> 4, c16 = idx & 15; rq[i] = *(const GAS v4u*)(ch.base + (size_t)row * ch.pitch + ch.cq + 8 * c16); rk[i] = *(const GAS v4u*)(ch.base + (size_t)row * ch.pitch + ch.ck + 8 * c16); }
        ra = *(const GAS v4u*)(ch.A + 8 * tid); };
    auto commit = [&](int buf) { LAS bf16* Q = (LAS bf16*)(F.lds + buf * BUF); LAS bf16* A = Q + 64 * QP; LAS bf16* KT = A + 64 * AP;
#pragma unroll
        for (int i = 0; i < 2; ++i) { const int idx = tid + 512 * i, row = idx >> 4, c16 = idx & 15; *(LAS v4u*)(Q + row * QP + 8 * c16) = rq[i];
            *(LAS v4u*)(KT + (2 * row + (c16 >> 3)) * KP + 8 * (c16 & 7)) = rk[i]; }
        *(LAS v4u*)(A + (tid >> 3) * AP + 8 * (tid & 7)) = ra; };
    issue(0); commit(0);
    for (int c = 0; c <= 64; ++c) {
        const int buf = c & 1; const HgChunk ch = hg_chunk(F, b, h, c);
        LDS_WAIT(); __syncthreads();
        if (c < 64) issue(c + 1);
        LAS bf16* Q = (LAS bf16*)(F.lds + buf * BUF); LAS bf16* A = Q + 64 * QP; LAS bf16* KT = A + 64 * AP;
        const int dv = 16 * wave + fr; const bf16* vrow = ch.base + (size_t)(dv >> 1) * ch.pitch + ch.cv + (dv & 1) * 64 + 8 * g;
        const bf16x8 bv0 = ld_frag16(vrow), bv1 = ld_frag16(vrow + 32);
        f32x4 o[4];
#pragma unroll
        for (int mt = 0; mt < 4; ++mt) o[mt] = (f32x4){0.f, 0.f, 0.f, 0.f};
#pragma unroll
        for (int ks = 0; ks < 4; ++ks) { v4u w; w.x = cvtpk(S[2 * ks][0], S[2 * ks][1]); w.y = cvtpk(S[2 * ks][2], S[2 * ks][3]); w.z = cvtpk(S[2 * ks + 1][0], S[2 * ks + 1][1]); w.w = cvtpk(S[2 * ks + 1][2], S[2 * ks + 1][3]);
            const bf16x8 sb = __builtin_bit_cast(bf16x8, w);
#pragma unroll
            for (int mt = 0; mt < 4; ++mt) { const LAS bf16* qp = Q + (16 * mt + fr) * QP + 32 * ks + 4 * g;
                const bf16x8 af = mk_frag(*(const LAS v2u*)qp, *(const LAS v2u*)(qp + 16));
                o[mt] = __builtin_amdgcn_mfma_f32_16x16x32_bf16(af, sb, o[mt], 0, 0, 0); } }
#pragma unroll
        for (int mt = 0; mt < 4; ++mt) { o[mt] = __builtin_amdgcn_mfma_f32_16x16x32_bf16(*(const LAS bf16x8*)(A + (16 * mt + fr) * AP + 8 * g), bv0, o[mt], 0, 0, 0);
            o[mt] = __builtin_amdgcn_mfma_f32_16x16x32_bf16(*(const LAS bf16x8*)(A + (16 * mt + fr) * AP + 32 + 8 * g), bv1, o[mt], 0, 0, 0); }
#pragma unroll
        for (int mt = 0; mt < 8; ++mt) { const f32x4 dl = *(const GAS f32x4*)(ch.dl + 16 * mt + 4 * g); S[mt] = S[mt] * dl;
            S[mt] = __builtin_amdgcn_mfma_f32_16x16x32_bf16(*(const LAS bf16x8*)(KT + (16 * mt + fr) * KP + 8 * g), bv0, S[mt], 0, 0, 0);
            S[mt] = __builtin_amdgcn_mfma_f32_16x16x32_bf16(*(const LAS bf16x8*)(KT + (16 * mt + fr) * KP + 32 + 8 * g), bv1, S[mt], 0, 0, 0); }
#pragma unroll
        for (int mt = 0; mt < 4; ++mt)
#pragma unroll
            for (int r = 0; r < 4; ++r) { float s2 = o[mt][r] * o[mt][r]; s2 += __shfl_xor(s2, 1); s2 += __shfl_xor(s2, 2); s2 += __shfl_xor(s2, 4); s2 += __shfl_xor(s2, 8);
                if (fr == 0) red[wave * 64 + 16 * mt + 4 * g + r] = s2; }
        LDS_WAIT(); __syncthreads();
        const int nvalid = (c == 0) ? NMETA : 64;
#pragma unroll
        for (int mt = 0; mt < 4; ++mt)
#pragma unroll
            for (int r = 0; r < 4; ++r) { const int t = 16 * mt + 4 * g + r; float tot = 0.f;
#pragma unroll
                for (int w = 0; w < 8; ++w) tot += red[w * 64 + t];
                if (t < nvalid && (c > 0 || b == 0)) { const int row = (c == 0) ? MREAL + t : b * SEQ + 64 * (c - 1) + t;
                    const float gr = bf2f(((const bf16*)(F.ws + WS_BIG))[(size_t)row * NNG + C_AG + h * 128 + dv]);
                    const float val = o[mt][r] * (1.0f / sqrtf(tot * (1.f / 128.f) + EPS)) * gn * (gr / (1.0f + __expf(-gr)));
                    ((bf16*)(F.ws + WS_BR))[(size_t)row * 512 + h * 128 + dv] = (bf16)f2bf_s(val); } }
        if (c < 64) commit(buf ^ 1);
    }
    __syncthreads();
}
__device__ __forceinline__ void conv_row(Frame& F, int l, int r) {
    const int lane = F.lane; const bf16* P = (const bf16*)(F.ws + WS_BIG);
    int r1, r2;
    if (r < MREAL) { const int b = r >> 12, t = r & 4095; r1 = seqrow(b, NMETA + t - 1); r2 = seqrow(b, NMETA + t - 2); }
    else { const int i = r - MREAL; r1 = i >= 1 ? r - 1 : -1; r2 = i >= 2 ? r - 2 : -1; }
    const float* cw = F.in[I_CONVW] + l * 3 * 512 + 8 * lane;
    float c0[8], u0[8], bb[8], y[8]; unpack8(*(const GAS v4u*)(P + (size_t)r * NNG + C_BC + 8 * lane), c0); unpack8(*(const GAS v4u*)(P + (size_t)r * NNG + C_BU + 8 * lane), u0); unpack8(*(const GAS v4u*)(P + (size_t)r * NNG + C_BB + 8 * lane), bb);
#pragma unroll
    for (int i = 0; i < 8; ++i) y[i] = cw[i] * (c0[i] * u0[i]);
    if (r1 >= 0) { unpack8(*(const GAS v4u*)(P + (size_t)r1 * NNG + C_BC + 8 * lane), c0); unpack8(*(const GAS v4u*)(P + (size_t)r1 * NNG + C_BU + 8 * lane), u0);
#pragma unroll
        for (int i = 0; i < 8; ++i) y[i] += cw[512 + i] * (c0[i] * u0[i]); }
    if (r2 >= 0) { unpack8(*(const GAS v4u*)(P + (size_t)r2 * NNG + C_BC + 8 * lane), c0); unpack8(*(const GAS v4u*)(P + (size_t)r2 * NNG + C_BU + 8 * lane), u0);
#pragma unroll
        for (int i = 0; i < 8; ++i) y[i] += cw[1024 + i] * (c0[i] * u0[i]); }
#pragma unroll
    for (int i = 0; i < 8; ++i) y[i] *= bb[i];
    *(GAS v4u*)((bf16*)(F.ws + WS_BR) + (size_t)MPAD * 512 + (size_t)r * 512 + 8 * lane) = pack8(y);
}
__device__ __forceinline__ void phase_hgrn_prep(Frame& F, int l) {
    for (int t = F.bid; t < NB * 4 * 64 + 4; t += F.G) { if (t < 4) hgrn_prep_task(F, l, 0, t, 0); else { const int u = t - 4; hgrn_prep_task(F, l, u >> 8, (u >> 6) & 3, 1 + (u & 63)); } }
}
constexpr int CW_TMO = 0, CW_BAR = 4096, CW_Q = 16384;
__device__ __forceinline__ int queue_pop(Frame& F, int qi) {
    int t = 0; if (F.lane == 0) t = (int)__hip_atomic_fetch_add((unsigned*)(F.ctl + CW_Q + 64 * qi), 1u, RLX_AGENT);
    return __builtin_amdgcn_readfirstlane(t);
}
constexpr int NQT = (LSEQ + 31) / 32;
__device__ __forceinline__ void phase_mix1(Frame& F, int l) {
    LAS float* bt = (LAS float*)(F.lds + 135168);
    build_bias_table(F, bt, 0);
    __syncthreads();
    if (F.bid < NIDX_WG) {
        float* slab = (float*)(F.ws + WS_SCR) + (size_t)F.bid * 32 * LPAD;
        for (int t = F.bid; t < NB * NQT; t += NIDX_WG) { const int j = NQT - 1 - t / NB, b = t % NB; dsa_index_task(F, b, j, slab); }
    } else if (F.bid < NIDX_WG + NHG_WG) {
        const int u = F.bid - NIDX_WG; hgrn_scan_unit(F, l, u >> 2, u & 3);
    } else {
        const int u0 = F.bid - NIDX_WG - NHG_WG, nw = F.G - NIDX_WG - NHG_WG;
        const int cw = u0 * NWAVES + F.wave, ncw = nw * NWAVES; for (int r = cw; r < MREAL + NMETA; r += ncw) conv_row(F, l, r);
    }
    float lam, post;
    { const float* lp = F.in[I_DLAM] + l * 256; const float s1 = wave_sum(lp[F.lane] * lp[64 + F.lane]), s2 = wave_sum(lp[128 + F.lane] * lp[192 + F.lane]);
      const float li = 0.8f - 0.6f * __expf(-0.3f * (float)l); lam = __expf(s1) - __expf(s2) + li; post = 1.0f - li; }
    for (;;) { const int t = queue_pop(F, 2 * l); if (t >= NB * 4 * NQT) break;
        const int j = NQT - 1 - t / 32, bh = t % 32; diff_attn_task(F, l, bh >> 2, bh & 3, j, bt, lam, post); }
}
__device__ __forceinline__ void phase_mix2(Frame& F, int l) {
    LAS float* bt = (LAS float*)(F.lds + 135168);
    build_bias_table(F, bt, 4);
    __syncthreads();
    const int gw = F.bid * NWAVES + F.wave, NGW = F.G * NWAVES;
    for (;;) { const int t = queue_pop(F, 2 * l + 1); if (t >= NB * 4 * NQT) break;
        const int j = NQT - 1 - t / 32, bh = t % 32; dsa_attn_task(F, bh >> 2, bh & 3, j, bt); }
}

#ifdef DBG_SEL
#ifndef DBG_Q
#define DBG_Q 1.0f
#endif
#ifndef DBG_QO
#define DBG_QO 0.0f
#endif
#ifndef DBG_T0
#define DBG_T0 0
#define DBG_T1 36
#endif
#ifndef DBG_NC
#define DBG_NC DM
#endif
__global__ void __launch_bounds__(256) k_dbg_argmax(const float* __restrict__ out, const float* __restrict__ x, unsigned long long* best) {
    unsigned long long loc = 0ull;
    for (size_t i = (size_t)blockIdx.x * blockDim.x + threadIdx.x; i < (size_t)MREAL * DM; i += (size_t)gridDim.x * blockDim.x) {
        const float d = fabsf(out[i] - x[i]); const unsigned long long k = ((unsigned long long)__float_as_uint(d) << 32) | (unsigned)i; loc = k > loc ? k : loc; }
    for (int o = 32; o >= 1; o >>= 1) { const unsigned long long t = __shfl_xor(loc, o); loc = t > loc ? t : loc; }
    if ((threadIdx.x & 63) == 0) atomicMax(best, loc);
}
__global__ void __launch_bounds__(256) k_dbg_count(const float* __restrict__ out, const float* __restrict__ x, unsigned* cnt  ) {
    const int gw = (blockIdx.x * blockDim.x + threadIdx.x) >> 6, lane = threadIdx.x & 63, ngw = (gridDim.x * blockDim.x) >> 6;
    for (int r = gw; r < MREAL; r += ngw) { float m = 0.f;
        for (int c = lane; c < DM; c += 64) m = fmaxf(m, fabsf(out[(size_t)r * DM + c] - x[(size_t)r * DM + c]));
        for (int o = 32; o >= 1; o >>= 1) m = fmaxf(m, __shfl_xor(m, o));
        if (lane == 0 && m > DBG_THR) { const int t = r & 4095; atomicAdd(cnt + 0, 1u); if (t < 32) atomicAdd(cnt + 1, 1u); if (t >= 4064) atomicAdd(cnt + 2, 1u); if (t < 256) atomicAdd(cnt + 3, 1u); } }
}

__global__ void __launch_bounds__(256) k_dbg_chk_merge(const unsigned short* BRm, const unsigned short* Wt, const unsigned short* G, const unsigned short* MG, int m, unsigned* cnt) {
    const int c = blockIdx.x * 256 + threadIdx.x;
    for (int r = blockIdx.y; r < MREAL; r += gridDim.y) {
        float s = 0.f; const unsigned short* a = BRm + (size_t)r * 512; const unsigned short* w = Wt + (size_t)c * 512;
        for (int k = 0; k < 512; ++k) s += __uint_as_float((unsigned)a[k] << 16) * __uint_as_float((unsigned)w[k] << 16);
        const float g = __uint_as_float((unsigned)G[(size_t)r * NGATE + m * DM + c] << 16), ref = g * s, got = __uint_as_float((unsigned)MG[(size_t)r * DM + c] << 16);
        const float err = fabsf(got - ref), tol = 0.02f * fabsf(ref) + 0.02f;
        if (!(err <= tol)) { atomicAdd(cnt + 4, 1u); const int t = r & 4095; if ((c & 255) < 128) atomicAdd(cnt + 5, 1u); if ((r & 255) < 128) atomicAdd(cnt + 6, 1u); if (fabsf(got) > 2.f * fabsf(ref)) atomicAdd(cnt + 7, 1u); (void)t; }
    }
}

__global__ void __launch_bounds__(256) k_dbg_naive_wo(const float* out, const unsigned short* MG, const unsigned short* Wt, float* chk) {
    const int c = blockIdx.x * 256 + threadIdx.x;
    for (int r = blockIdx.y; r < MREAL; r += gridDim.y) {
        float s = 0.f; const uint4* a = (const uint4*)(MG + (size_t)r * DM); const uint4* w = (const uint4*)(Wt + (size_t)c * DM);
        for (int k = 0; k < DM / 8; ++k) { const uint4 av = a[k], wv = w[k]; const unsigned aw[4] = {av.x, av.y, av.z, av.w}, ww[4] = {wv.x, wv.y, wv.z, wv.w};
#pragma unroll
            for (int j = 0; j < 4; ++j) { s += __uint_as_float(aw[j] << 16) * __uint_as_float(ww[j] << 16); s += __uint_as_float(aw[j] & 0xffff0000u) * __uint_as_float(ww[j] & 0xffff0000u); } }
        chk[(size_t)r * DM + c] = out[(size_t)r * DM + c] + s; }
}
__global__ void __launch_bounds__(256) k_dbg_cmp(const float* out, const float* chk, unsigned* cnt) {
    for (size_t i = (size_t)blockIdx.x * blockDim.x + threadIdx.x; i < (size_t)MREAL * DM; i += (size_t)gridDim.x * blockDim.x) {
        const float err = fabsf(out[i] - chk[i]); if (!(err <= 0.02f)) { atomicAdd(cnt + 4, 1u); const int c = (int)(i % DM), r = (int)(i / DM); if ((c & 255) < 128) atomicAdd(cnt + 5, 1u); if ((r & 255) < 128) atomicAdd(cnt + 6, 1u); if (err > 1.0f) atomicAdd(cnt + 7, 1u); } }
}

__global__ void __launch_bounds__(256) k_dbg_stats(const unsigned short* A, int ld, int ncols, unsigned* st) {
    const int gw = (blockIdx.x * blockDim.x + threadIdx.x) >> 6, lane = threadIdx.x & 63, ngw = (gridDim.x * blockDim.x) >> 6;
    float mx = 0.f, me = 0.f;
    for (int r = gw; r < MREAL; r += ngw) { float s = 0.f;
        for (int c = lane; c < ncols; c += 64) { const float v = __uint_as_float((unsigned)A[(size_t)r * ld + c] << 16); mx = fmaxf(mx, fabsf(v)); s += v * v; }
        for (int o = 32; o >= 1; o >>= 1) s += __shfl_xor(s, o);
        me = fmaxf(me, s / (float)ncols); }
    for (int o = 32; o >= 1; o >>= 1) mx = fmaxf(mx, __shfl_xor(mx, o));
    if (lane == 0) { atomicMax(st + 8, __float_as_uint(mx)); atomicMax(st + 9, __float_as_uint(me)); }
}

__global__ void __launch_bounds__(256) k_dbg_argmax_bf16(const unsigned short* A, int ld, int ncols, unsigned long long* best) {
    unsigned long long loc = 0ull;
    for (size_t i = (size_t)blockIdx.x * blockDim.x + threadIdx.x; i < (size_t)MREAL * ncols; i += (size_t)gridDim.x * blockDim.x) { const size_t r = i / ncols, c = i % ncols;
        const float d = fabsf(__uint_as_float((unsigned)A[r * ld + c] << 16)); const unsigned long long k = ((unsigned long long)__float_as_uint(d) << 32) | (unsigned)i; loc = k > loc ? k : loc; }
    for (int o = 32; o >= 1; o >>= 1) { const unsigned long long t = __shfl_xor(loc, o); loc = t > loc ? t : loc; }
    if ((threadIdx.x & 63) == 0) atomicMax(best, loc);
}

__global__ void __launch_bounds__(256) k_dbg_gcount(const unsigned short* G, unsigned* cnt) {
    const int gw = (blockIdx.x * blockDim.x + threadIdx.x) >> 6, lane = threadIdx.x & 63, ngw = (gridDim.x * blockDim.x) >> 6;
    for (int r = gw; r < MREAL; r += ngw) { int n = 0;
        for (int c = lane; c < NGATE; c += 64) { const float v = __uint_as_float((unsigned)G[(size_t)r * NGATE + c] << 16); if (!(v >= 0.f && v <= 1.001f)) ++n; }
        for (int o = 32; o >= 1; o >>= 1) n += __shfl_xor(n, o);
        if (lane == 0 && n) { const int t = r & 4095; atomicAdd(cnt + 10, (unsigned)n); atomicAdd(cnt + 11, 1u); if (t >= 4080) atomicAdd(cnt + 12, 1u); else atomicAdd(cnt + 13, 1u); } }
}

__global__ void k_dbg_time(const unsigned long long* ts, unsigned* cnt) {
    if (threadIdx.x == 0) { const float ms = (float)(ts[DBG_T1] - ts[DBG_T0]) * 1e-5f; cnt[14] = __float_as_uint(floorf(ms * DBG_Q + DBG_QO)); }
}
__global__ void __launch_bounds__(256) k_dbg_emit(float* out, const float* __restrict__ x, const unsigned long long* best, const unsigned* cnt) {
    const unsigned long long b = *best; const unsigned idx = (unsigned)b; const float val = __uint_as_float((unsigned)(b >> 32));
    const int row = idx / DBG_NC, col = idx % DBG_NC, bb = row >> 12, t = row & 4095;
    float N = 0.f;
    switch (DBG_SEL) {
        case 0: N = val; break;
        case 1: N = 2.f + bb; break;
        case 2: N = 2.f + (t >> 9); break;
        case 3: N = 2.f + ((t >> 6) & 7); break;
        case 4: N = 2.f + ((t >> 3) & 7); break;
        case 5: N = 2.f + (t & 7); break;
        case 6: N = 2.f + (col >> 8); break;
        case 60: N = 2.f + (col >> 10); break;
        case 61: N = 2.f + ((col >> 7) & 7); break;
        case 62: N = 2.f + ((col >> 4) & 7); break;
        case 63: N = 2.f + ((col >> 1) & 7); break;
        case 64: N = 2.f + (col & 1); break;
        case 65: N = 2.f + bb; break;
        case 66: N = 2.f + (t >> 9); break;
        case 67: N = 2.f + ((t >> 6) & 7); break;
        case 68: N = 2.f + ((t >> 3) & 7); break;
        case 69: N = 2.f + (t & 7); break;
        case 7: N = 2.f + ((col >> 5) & 7); break;
        case 8: N = 2.f + ((col >> 2) & 7); break;
        case 40: case 42: case 44: case 46: N = __uint_as_float(cnt[8]); break;
        case 41: case 43: case 45: case 47: N = __uint_as_float(cnt[9]); break;
        case 70: N = 2.f + log2f(1.f + (float)cnt[10]); break;
        case 71: N = 2.f + log2f(1.f + (float)cnt[11]); break;
        case 72: N = 2.f + log2f(1.f + (float)cnt[12]); break;
        case 73: N = 2.f + log2f(1.f + (float)cnt[13]); break;
        case 100: N = 2.f + __uint_as_float(cnt[14]); break;
        case 30: N = 2.f + log2f(1.f + (float)cnt[4]); break;
        case 31: N = 2.f + log2f(1.f + (float)cnt[5]); break;
        case 32: N = 2.f + log2f(1.f + (float)cnt[6]); break;
        case 33: N = 2.f + log2f(1.f + (float)cnt[7]); break;
        case 20: N = 2.f + log2f(1.f + (float)cnt[4]); break;
        case 21: N = 2.f + log2f(1.f + (float)cnt[5]); break;
        case 22: N = 2.f + log2f(1.f + (float)cnt[6]); break;
        case 23: N = 2.f + log2f(1.f + (float)cnt[7]); break;
        case 10: N = 2.f + log2f(1.f + (float)cnt[0]); break;
        case 11: N = 2.f + log2f(1.f + (float)cnt[1]); break;
        case 12: N = 2.f + log2f(1.f + (float)cnt[2]); break;
        case 13: N = 2.f + log2f(1.f + (float)cnt[3]); break;
    }
    const float c = 1.f + N;
    for (size_t i = (size_t)blockIdx.x * blockDim.x + threadIdx.x; i < (size_t)MREAL * DM; i += (size_t)gridDim.x * blockDim.x) out[i] = c * x[i];
}
#endif

#ifndef MK_ONE
#define MK_ONE 0
#endif
#ifndef BR_MASK
#define BR_MASK 15
#endif
constexpr int NPH = 18;
template <class T> __device__ __forceinline__ T opaque(T v) { asm volatile("" : "+s"(v)); return v; }
struct Args { const float* in[22]; float* out; unsigned char* ws; int ph_lo, ph_hi; };
__global__ void __launch_bounds__(NWAVES * 64, 2) fwd(Args args) {
    extern __shared__ __attribute__((aligned(16))) unsigned char lds[];
    Frame F;
    F.lds = (LAS unsigned char*)lds; F.MISC = (volatile LAS unsigned*)(F.lds + MISC_OFF);
    F.tid = threadIdx.x; F.lane = F.tid & 63; F.wave = __builtin_amdgcn_readfirstlane(F.tid >> 6); F.G = gridDim.x; F.bid = blockIdx.x;
    F.ws = args.ws; F.out = args.out; F.ctl = (gu32*)(args.ws + WS_CTL);
#pragma unroll
    for (int i = 0; i < 22; ++i) F.in[i] = args.in[i];
    for (int u = F.tid; u < (LDS_BYTES - LDSCTL_OFF) / 4; u += NWAVES * 64) ((LAS unsigned*)(F.lds + LDSCTL_OFF))[u] = 0u;
    __syncthreads();
#if MK_ONE
    XcdBarrier bar = xcd_barrier_post((unsigned*)(F.ctl + CW_BAR), F.MISC + 8);
#define GRID_BAR() xcd_barrier(bar)
#else
#define GRID_BAR() do { } while (0)
#endif
    const int lo = args.ph_lo, hi = args.ph_hi;
#define IN(k) (lo <= (k) && (k) < hi)
#define RETID() do { int t_ = threadIdx.x; asm volatile("" : "+v"(t_)); F.tid = t_; F.lane = t_ & 63; F.wave = __builtin_amdgcn_readfirstlane(t_ >> 6); } while (0)
#ifdef DBG_TS
#define STAMP(k) do { if (blockIdx.x == 0 && threadIdx.x == 0) ((unsigned long long*)(args.ws + 768 * 1024))[(k)] = __builtin_amdgcn_s_memrealtime(); } while (0)
#else
#define STAMP(k) do { } while (0)
#endif
#define SEAM(k) do { if (IN((k) + 1)) GRID_BAR(); STAMP((k) + 1); } while (0)
    STAMP(0);
    unsigned char* wb = F.ws + WS_W;
    bf16* XN = (bf16*)(F.ws + WS_XN); bf16* BR = (bf16*)(F.ws + WS_BR); bf16* BIG = (bf16*)(F.ws + WS_BIG); float* HM = (float*)(F.ws + WS_HM);
    for (int l = 0; l < 2; ++l) {
        const int pb = l * NPH;
        const float* hsrc = (l == 0) ? F.in[I_X] : F.out;
        if (IN(pb + 0)) { RETID(); phase_convert(F, l); SEAM(pb + 0); }
        if (IN(pb + 1)) { RETID(); phase_norm(F, hsrc, F.in[I_F1N] + l * DM); SEAM(pb + 1); }
        if (IN(pb + 2)) { RETID(); pg8::Gemm g{opaque((const bf16*)(XN)), opaque((const bf16*)(wb + W_GU1)), MPAD, NGU, DM}; pg8::StaticOrder S; S.init(MPAD, NGU, F.G, opaque(F.bid));
            pg8::EpiSwiGLU E{BIG, DFF}; pg8::gemm_phase<pg8::EpiSwiGLU, pg8::StaticOrder, true, true>(F.lds + RING_OFF, g, S, E); SEAM(pb + 2); }
        if (IN(pb + 3)) { RETID(); pg8::Gemm g{opaque((const bf16*)(BIG)), opaque((const bf16*)(wb + W_D1)), MPAD, DM, DFF}; pg8::StaticOrder S; S.init(MPAD, DM, F.G, opaque(F.bid));
            pg8::EpiResF32 E{hsrc, F.out, HM, DM, MT_REAL, 0.5f}; pg8::gemm_phase<pg8::EpiResF32, pg8::StaticOrder, true, true>(F.lds + RING_OFF, g, S, E); SEAM(pb + 3); }
        if (IN(pb + 4)) { RETID(); phase_norm(F, F.out, F.in[I_MIXN] + l * DM); SEAM(pb + 4); }
        if (IN(pb + 5)) { RETID(); pg8::Gemm g{opaque((const bf16*)(XN)), opaque((const bf16*)(wb + W_NG)), MPAD, NNG, DM}; pg8::StaticOrder S; S.init(MPAD, NNG, F.G, opaque(F.bid));
            pg8::EpiBf16<0> E{BIG, NNG}; pg8::gemm_phase<pg8::EpiBf16<0>, pg8::StaticOrder, true, true>(F.lds + RING_OFF, g, S, E); SEAM(pb + 5); }
        if (IN(pb + 6)) { RETID(); phase_prep(F, l); phase_vt(F); __syncthreads(); phase_hgrn_prep(F, l); SEAM(pb + 6); }
        if (IN(pb + 7)) { RETID(); phase_mix1(F, l); SEAM(pb + 7); }
        if (IN(pb + 8)) { RETID(); phase_mix2(F, l); SEAM(pb + 8); }
        if (IN(pb + 9)) { RETID(); pg8::Gemm g{opaque((const bf16*)(XN)), opaque((const bf16*)(wb + W_G)), MPAD, NGATE, DM}; pg8::StaticOrder S; S.init(MPAD, NGATE, F.G, opaque(F.bid));
            pg8::EpiBf16<1> E{BIG, NGATE}; pg8::gemm_phase<pg8::EpiBf16<1>, pg8::StaticOrder, true, true>(F.lds + RING_OFF, g, S, E); SEAM(pb + 9); }
        for (int m = 0; m < 4; ++m)
            if (IN(pb + 10 + m) && ((BR_MASK >> m) & 1)) { RETID(); pg8::Gemm g{opaque((const bf16*)(BR + (size_t)m * MPAD * 512)), opaque((const bf16*)(wb + W_BR) + (size_t)m * DM * 512), MPAD, DM, 512}; pg8::StaticOrder S; S.init(MPAD, DM, F.G, opaque(F.bid));
                pg8::EpiGateAcc E{XN, DM, BIG, NGATE, m * DM, (BR_MASK & ((1 << m) - 1)) == 0}; pg8::gemm_phase<pg8::EpiGateAcc, pg8::StaticOrder, true, true>(F.lds + RING_OFF, g, S, E); SEAM(pb + 10 + m); }
        if (IN(pb + 14) && BR_MASK) { RETID(); pg8::Gemm g{opaque((const bf16*)(XN)), opaque((const bf16*)(wb + W_O)), MPAD, DM, DM}; pg8::StaticOrder S; S.init(MPAD, DM, F.G, opaque(F.bid));
            pg8::EpiResF32 E{F.out, F.out, HM, DM, MT_REAL, 1.0f}; pg8::gemm_phase<pg8::EpiResF32, pg8::StaticOrder, true, true>(F.lds + RING_OFF, g, S, E); SEAM(pb + 14); }
        if (IN(pb + 15)) { RETID(); phase_norm(F, F.out, F.in[I_F2N] + l * DM); SEAM(pb + 15); }
        if (IN(pb + 16)) { RETID(); pg8::Gemm g{opaque((const bf16*)(XN)), opaque((const bf16*)(wb + W_GU2)), MPAD, NGU, DM}; pg8::StaticOrder S; S.init(MPAD, NGU, F.G, opaque(F.bid));
            pg8::EpiSwiGLU E{BIG, DFF}; pg8::gemm_phase<pg8::EpiSwiGLU, pg8::StaticOrder, true, true>(F.lds + RING_OFF, g, S, E); SEAM(pb + 16); }
        if (IN(pb + 17)) { RETID(); pg8::Gemm g{opaque((const bf16*)(BIG)), opaque((const bf16*)(wb + W_D2)), MPAD, DM, DFF}; pg8::StaticOrder S; S.init(MPAD, DM, F.G, opaque(F.bid));
            pg8::EpiResF32 E{F.out, F.out, HM, DM, MT_REAL, 0.5f}; pg8::gemm_phase<pg8::EpiResF32, pg8::StaticOrder, true, true>(F.lds + RING_OFF, g, S, E); SEAM(pb + 17); }
    }
}

extern "C" void kernel_launch(void* const* d_in, const int* in_sizes, int n_in, void* d_out, int out_size, void* d_ws, size_t ws_size, hipStream_t stream) {
    static int grid = 0;
    if (grid == 0) {
        if (n_in != 22 || out_size != MREAL * DM || ws_size < WS_END) { fprintf(stderr, "kernel_launch: unexpected shapes (n_in %d out %d ws %zu need %zu)\n", n_in, out_size, ws_size, (size_t)WS_END); grid = -1; return; }
        int dev = 0, cus = 0, per_cu = 0;
        if (hipGetDevice(&dev) != hipSuccess || hipDeviceGetAttribute(&cus, hipDeviceAttributeMultiprocessorCount, dev) != hipSuccess) { grid = -1; return; }
        if (hipFuncSetAttribute((const void*)fwd, hipFuncAttributeMaxDynamicSharedMemorySize, LDS_BYTES) != hipSuccess) { fprintf(stderr, "kernel_launch: hipFuncSetAttribute failed\n"); grid = -1; return; }
        if (hipOccupancyMaxActiveBlocksPerMultiprocessor(&per_cu, (const void*)fwd, NWAVES * 64, LDS_BYTES) != hipSuccess || per_cu < 1) fprintf(stderr, "kernel_launch: occupancy query says %d\n", per_cu);
        (void)hipGetLastError();
        grid = cus < 256 ? cus : 256;
    }
    if (grid < 0) return;
    (void)hipMemsetAsync((char*)d_ws + WS_CTL, 0, CTL_ZERO_BYTES, stream);
    Args a{};
    for (int i = 0; i < 22; ++i) a.in[i] = (const float*)d_in[i];
    a.out = (float*)d_out; a.ws = (unsigned char*)d_ws;
#ifndef PH_END
#define PH_END (2 * NPH)
#endif
#if MK_ONE
    a.ph_lo = 0; a.ph_hi = PH_END;
    hipLaunchKernelGGL(fwd, dim3(grid), dim3(NWAVES * 64), LDS_BYTES, stream, a);
#else
    for (int p = 0; p < PH_END; ++p) { a.ph_lo = p; a.ph_hi = p + 1;
#if defined(DBG_SEL)
#ifdef DBG_PREFILL
        if (p == 9) (void)hipMemsetAsync((char*)d_ws + WS_BIG, 0x3F, (size_t)MPAD * NGATE * 2, stream);
#endif
        if (DBG_SEL >= 30 && DBG_SEL < 40 && p == 14) hipLaunchKernelGGL(k_dbg_naive_wo, dim3(8, 2048), dim3(256), 0, stream, (const float*)d_out, (const unsigned short*)((char*)d_ws + WS_XN), (const unsigned short*)((char*)d_ws + WS_W + W_O), (float*)((char*)d_ws + WS_BIG));
#endif
        hipLaunchKernelGGL(fwd, dim3(grid), dim3(NWAVES * 64), LDS_BYTES, stream, a); }
#endif
#ifdef DBG_SEL
    { unsigned long long* best = (unsigned long long*)((char*)d_ws + 512 * 1024); unsigned* cnt = (unsigned*)((char*)d_ws + 512 * 1024 + 64);
      if (DBG_SEL >= 60 && DBG_SEL < 70) hipLaunchKernelGGL(k_dbg_argmax_bf16, dim3(2048), dim3(256), 0, stream, (const unsigned short*)((char*)d_ws + WS_BIG), NGATE, NGATE, best);
      else hipLaunchKernelGGL(k_dbg_argmax, dim3(2048), dim3(256), 0, stream, (const float*)d_out, (const float*)d_in[0], best);
      hipLaunchKernelGGL(k_dbg_count, dim3(2048), dim3(256), 0, stream, (const float*)d_out, (const float*)d_in[0], cnt);
      if (DBG_SEL >= 20 && DBG_SEL < 30) { const int mm = 1; hipLaunchKernelGGL(k_dbg_chk_merge, dim3(8, 2048), dim3(256), 0, stream, (const unsigned short*)((char*)d_ws + WS_BR) + (size_t)mm * MPAD * 512, (const unsigned short*)((char*)d_ws + WS_W + W_BR) + (size_t)mm * DM * 512, (const unsigned short*)((char*)d_ws + WS_BIG), (const unsigned short*)((char*)d_ws + WS_XN), mm, cnt); }
      if (DBG_SEL >= 30 && DBG_SEL < 40) hipLaunchKernelGGL(k_dbg_cmp, dim3(2048), dim3(256), 0, stream, (const float*)d_out, (const float*)((char*)d_ws + WS_BIG), cnt);
      if (DBG_SEL >= 40 && DBG_SEL < 50) { const unsigned short* A = nullptr; int ld = 0, nc = 0;
        if (DBG_SEL < 42) { A = (const unsigned short*)((char*)d_ws + WS_BR) + (size_t)MPAD * 512; ld = 512; nc = 512; }
        else if (DBG_SEL < 44) { A = (const unsigned short*)((char*)d_ws + WS_BIG) + DM; ld = NGATE; nc = DM; }
        else if (DBG_SEL < 46) { A = (const unsigned short*)((char*)d_ws + WS_XN); ld = DM; nc = DM; }
        else { A = (const unsigned short*)((char*)d_ws + WS_BR); ld = 512; nc = 512; }
        hipLaunchKernelGGL(k_dbg_stats, dim3(1024), dim3(256), 0, stream, A, ld, nc, cnt); }
      if (DBG_SEL >= 70 && DBG_SEL < 80) hipLaunchKernelGGL(k_dbg_gcount, dim3(1024), dim3(256), 0, stream, (const unsigned short*)((char*)d_ws + WS_BIG), cnt);
      if (DBG_SEL >= 100) hipLaunchKernelGGL(k_dbg_time, dim3(1), dim3(64), 0, stream, (const unsigned long long*)((char*)d_ws + 768 * 1024), cnt);
      hipLaunchKernelGGL(k_dbg_emit, dim3(2048), dim3(256), 0, stream, (float*)d_out, (const float*)d_in[0], best, cnt); }
#endif
}
```

```cpp
#include <hip/hip_runtime.h>
#include <cstdio>
#include <cstdint>
#define MK_ONE 1
namespace pg8 {
#define PG8_LAS __attribute__((address_space(3)))
typedef unsigned short bf16_t;
typedef short bf16x8 __attribute__((ext_vector_type(8)));
typedef float f32x4 __attribute__((ext_vector_type(4)));
typedef unsigned u32x4 __attribute__((ext_vector_type(4)));
constexpr int BM = 256, BK = 64, HALF = 128, HTB = HALF * BK * 2  , STAGE_BYTES = 8 * HTB, NXCD = 8, WGM = 8;

__host__ __device__ __forceinline__ int lds_byte(int r, int c) { const int st = (r >> 4) * 2 + (c >> 5), rr = r & 15, cc = c & 31, ob = rr * 64 + cc * 2; return st * 1024 + (ob ^ (((ob >> 9) & 1) << 5)); }
__host__ __device__ __forceinline__ void stage_rc(int b, int& R, int& C) { const int st = b / 1024, sb = b % 1024, swz = sb ^ (((sb >> 9) & 1) << 5); R = (st >> 1) * 16 + swz / 64; C = (st & 1) * 32 + (swz % 64) / 2; }
__host__ __device__ __forceinline__ int perm32(int rho) { const int n = rho >> 4, i = rho & 15; return 8 * (i >> 2) + 4 * n + (i & 3); }

struct Unit { int pm, pn; };
struct Gemm { const bf16_t* A; const bf16_t* Bt; int M, N, K; };

struct StaticOrder {
    int nM, nN, nwg, G, c;
    __host__ __device__ void init(int M, int N, int G_, int c_) { nM = M / BM; nN = N / BM; nwg = nM * nN; G = G_; c = c_; }
    __host__ __device__ bool next(int i, Unit& u) const {
        const long L = (long)i * G + c; if (L >= nwg) return false;
        int wgid = (int)L; { const int q = nwg / NXCD, r = nwg % NXCD, xcd = wgid % NXCD, off = wgid / NXCD; wgid = (xcd < r ? xcd * (q + 1) : r * (q + 1) + (xcd - r) * q) + off; }
        const int nig = WGM * nN, gid = wgid / nig, fm = gid * WGM, gsz = (nM - fm) < WGM ? (nM - fm) : WGM;
        u.pm = fm + ((wgid % nig) % gsz); u.pn = (wgid % nig) / gsz; return true;
    }
    __device__ __forceinline__ void a_ready(const Unit&) const {}
    __device__ __forceinline__ void done(const Unit&) const {}
};
typedef __bf16 bf16x2_hw __attribute__((ext_vector_type(2))); typedef float f32x2_hw __attribute__((ext_vector_type(2)));
__device__ __forceinline__ unsigned cvt_pk_bf16(float lo, float hi) { const f32x2_hw v = {lo, hi}; return __builtin_bit_cast(unsigned, __builtin_convertvector(v, bf16x2_hw)); }
typedef float f32x2 __attribute__((ext_vector_type(2)));
__device__ __forceinline__ float fast_sigmoid(float x) { return __builtin_amdgcn_rcpf(1.0f + __expf(-x)); }
__device__ __forceinline__ float fast_silu(float x) { return x * fast_sigmoid(x); }
template <int ACT  > struct EpiBf16 {
    static constexpr bool PERM = true, AFTER_DRAIN = false;
    bf16_t* O; int ldc;
    __device__ __forceinline__ void operator()(const f32x4 (&acc)[2][2][4][2], const Unit& u, int wr, int wc, int fr, int fq) const {
        const int row0 = u.pm * BM + wr * 64 + fr; const int col0 = u.pn * BM + wc * 32 + 8 * fq;
#pragma unroll
        for (int ai = 0; ai < 2; ++ai)
#pragma unroll
            for (int m = 0; m < 4; ++m) { bf16_t* rowp = O + (size_t)(row0 + ai * HALF + m * 16) * ldc + col0;
#pragma unroll
                for (int bj = 0; bj < 2; ++bj) { f32x4 v0 = acc[ai][bj][m][0], v1 = acc[ai][bj][m][1];
                    if (ACT == 1) {
#pragma unroll
                        for (int j = 0; j < 4; ++j) { v0[j] = fast_sigmoid(v0[j]); v1[j] = fast_sigmoid(v1[j]); } }
                    u32x4 w; w.x = cvt_pk_bf16(v0[0], v0[1]); w.y = cvt_pk_bf16(v0[2], v0[3]); w.z = cvt_pk_bf16(v1[0], v1[1]); w.w = cvt_pk_bf16(v1[2], v1[3]);
                    *(u32x4*)(rowp + bj * HALF) = w; } }
    }
};
struct EpiSwiGLU {
    static constexpr bool PERM = true, AFTER_DRAIN = false;
    bf16_t* O; int ldc;
    __device__ __forceinline__ void operator()(const f32x4 (&acc)[2][2][4][2], const Unit& u, int wr, int wc, int fr, int fq) const {
        const int row0 = u.pm * BM + wr * 64 + fr; const int col0 = u.pn * HALF + wc * 32 + 8 * fq;
#pragma unroll
        for (int ai = 0; ai < 2; ++ai)
#pragma unroll
            for (int m = 0; m < 4; ++m) { bf16_t* rowp = O + (size_t)(row0 + ai * HALF + m * 16) * ldc + col0;
                const f32x4 g0 = acc[ai][0][m][0], g1 = acc[ai][0][m][1], u0 = acc[ai][1][m][0], u1 = acc[ai][1][m][1];
                f32x4 v0, v1;
#pragma unroll
                for (int j = 0; j < 4; ++j) { v0[j] = fast_silu(g0[j]) * u0[j]; v1[j] = fast_silu(g1[j]) * u1[j]; }
                u32x4 w; w.x = cvt_pk_bf16(v0[0], v0[1]); w.y = cvt_pk_bf16(v0[2], v0[3]); w.z = cvt_pk_bf16(v1[0], v1[1]); w.w = cvt_pk_bf16(v1[2], v1[3]);
                *(u32x4*)rowp = w; asm volatile("" ::: "memory"); }
    }
};
struct EpiResF32 {
    static constexpr bool PERM = false, AFTER_DRAIN = false;
    const float* base_r; float* out_r; float* hm; int ldc; int mt_real; float scale;
    __device__ __forceinline__ void operator()(const f32x4 (&acc)[2][2][4][2], const Unit& u, int wr, int wc, int fr, int fq) const {
        const bool real = u.pm < mt_real;
        const float* bp = real ? base_r + (size_t)u.pm * BM * ldc : hm; float* op = real ? out_r + (size_t)u.pm * BM * ldc : hm;
        const int row0 = wr * 64 + fr, col0 = u.pn * BM + wc * 32 + 4 * fq;
#pragma unroll
        for (int ai = 0; ai < 2; ++ai)
#pragma unroll
            for (int m = 0; m < 4; ++m) { const size_t off = (size_t)(row0 + ai * HALF + m * 16) * ldc + col0;
#pragma unroll
                for (int bj = 0; bj < 2; ++bj)
#pragma unroll
                    for (int n = 0; n < 2; ++n) { const f32x4 b = *(const f32x4*)(bp + off + bj * HALF + n * 16); *(f32x4*)(op + off + bj * HALF + n * 16) = b + acc[ai][bj][m][n] * scale; }
                asm volatile("" ::: "memory"); }
    }
};
struct EpiGateAcc {
    static constexpr bool PERM = true, AFTER_DRAIN = false;
    bf16_t* MG; int ldc; const bf16_t* G; int ldg; int gcol0; int first;
    __device__ __forceinline__ void operator()(const f32x4 (&acc)[2][2][4][2], const Unit& u, int wr, int wc, int fr, int fq) const {
        const int row0 = u.pm * BM + wr * 64 + fr; const int col0 = u.pn * BM + wc * 32 + 8 * fq;
#pragma unroll
        for (int ai = 0; ai < 2; ++ai)
#pragma unroll
            for (int m = 0; m < 4; ++m) { const size_t r = (size_t)(row0 + ai * HALF + m * 16);
#pragma unroll
                for (int bj = 0; bj < 2; ++bj) { const u32x4 gw = *(const u32x4*)(G + r * ldg + gcol0 + col0 + bj * HALF);
                    u32x4 pw = (u32x4){0u, 0u, 0u, 0u}; if (!first) pw = *(const u32x4*)(MG + r * ldc + col0 + bj * HALF);
                    float o[8];
#pragma unroll
                    for (int j = 0; j < 4; ++j) { const float a0 = (j < 2) ? acc[ai][bj][m][0][2 * j] : acc[ai][bj][m][1][2 * (j - 2)], a1 = (j < 2) ? acc[ai][bj][m][0][2 * j + 1] : acc[ai][bj][m][1][2 * (j - 2) + 1];
                        o[2 * j] = __uint_as_float(pw[j] << 16) + __uint_as_float(gw[j] << 16) * a0; o[2 * j + 1] = __uint_as_float(pw[j] & 0xffff0000u) + __uint_as_float(gw[j] & 0xffff0000u) * a1; }
                    u32x4 w; w.x = cvt_pk_bf16(o[0], o[1]); w.y = cvt_pk_bf16(o[2], o[3]); w.z = cvt_pk_bf16(o[4], o[5]); w.w = cvt_pk_bf16(o[6], o[7]);
                    *(u32x4*)(MG + r * ldc + col0 + bj * HALF) = w; } }
    }
};
template <class Epi, class Sched, bool ALIGN_EPI = false, bool SP2 = false>
__device__ __forceinline__ void gemm_phase(PG8_LAS unsigned char* lds, const Gemm g, const Sched& S, const Epi& E) {
    int tid_ = threadIdx.x; asm volatile("" : "+v"(tid_));
    const int tid = tid_, wid = __builtin_amdgcn_readfirstlane(tid >> 6), lane = tid & 63, wr = wid >> 2, wc = wid & 3, fr = lane & 15, fq = lane >> 4;
    const int K = g.K, nt = K / BK;
    unsigned voffA[2], voffB[2];
#pragma unroll
    for (int i = 0; i < 2; ++i) { int R, C; stage_rc(tid * 16 + i * 8192, R, C); const int Rb = Epi::PERM ? ((R & ~31) + perm32(R & 31)) : R;
        voffA[i] = (unsigned)(R * K + C) * 2u; voffB[i] = (unsigned)(Rb * K + C) * 2u; }
    const size_t kstep = (size_t)(BK * 2);
    const size_t hstep = (size_t)HALF * K * 2;
    const size_t tstep = 2 * hstep;
    const unsigned ldsw = (unsigned)wid * 1024u;
    const int aoff = lds_byte(wr * 64 + fr, fq * 8), boff = lds_byte(wc * 32 + fr, fq * 8);
#define PG8_SA(b, h) (((b) * 2 + (h)) * HTB)
#define PG8_SB(b, h) ((4 + (b) * 2 + (h)) * HTB)
#define PG8_STAGE(bufoff, gbase, voff) do { _Pragma("unroll") for (int _i = 0; _i < 2; ++_i) \
        __builtin_amdgcn_global_load_lds((const unsigned*)((const char*)(gbase) + (voff)[_i]), (PG8_LAS unsigned*)(lds + (bufoff) + ldsw + _i * 8192), 16, 0, 0); } while (0)
#define PG8_LDA(dst, b, h) do { _Pragma("unroll") for (int m = 0; m < 4; ++m) _Pragma("unroll") for (int k = 0; k < 2; ++k) dst[m][k] = *(const PG8_LAS bf16x8*)(lds + PG8_SA(b, h) + aoff + m * 2048 + k * 1024); } while (0)
#define PG8_LDB(dst, b, h) do { _Pragma("unroll") for (int n = 0; n < 2; ++n) _Pragma("unroll") for (int k = 0; k < 2; ++k) dst[n][k] = *(const PG8_LAS bf16x8*)(lds + PG8_SB(b, h) + boff + n * 2048 + k * 1024); } while (0)
#define PG8_MMA(ai, bj, At, Bt) do { __builtin_amdgcn_s_setprio(1); _Pragma("unroll") for (int m = 0; m < 4; ++m) _Pragma("unroll") for (int n = 0; n < 2; ++n) _Pragma("unroll") for (int k = 0; k < 2; ++k) \
        acc[ai][bj][m][n] = __builtin_amdgcn_mfma_f32_16x16x32_bf16(Bt[n][k], At[m][k], acc[ai][bj][m][n], 0, 0, 0); __builtin_amdgcn_s_setprio(0); } while (0)
#define PG8_WAIT_V(n) asm volatile("s_waitcnt vmcnt(" #n ")" ::: "memory")
#define PG8_WAIT_L(n) asm volatile("s_waitcnt lgkmcnt(" #n ")" ::: "memory")
#define PG8_BAR __builtin_amdgcn_s_barrier()
#define PG8_SCHED __builtin_amdgcn_sched_barrier(0)
    Unit cur, nxt; int ui = 0;
    if (!S.next(0, cur)) return;
    f32x4 acc[2][2][4][2];
#pragma unroll
    for (int a = 0; a < 2; ++a)
#pragma unroll
        for (int b = 0; b < 2; ++b)
#pragma unroll
            for (int m = 0; m < 4; ++m)
#pragma unroll
                for (int n = 0; n < 2; ++n) acc[a][b][m][n] = (f32x4){0.f, 0.f, 0.f, 0.f};
    bf16x8 At[4][2], B0[2][2], B1[2][2];
    const char* cA = (const char*)g.A + (size_t)cur.pm * tstep; const char* cB = (const char*)g.Bt + (size_t)cur.pn * tstep;
    S.a_ready(cur);
    if constexpr (SP2) {
        PG8_STAGE(PG8_SB(0, 0), cB, voffB); PG8_STAGE(PG8_SB(0, 1), cB + hstep, voffB); PG8_STAGE(PG8_SA(0, 0), cA, voffA); PG8_STAGE(PG8_SA(0, 1), cA + hstep, voffA);
        if (wr == 1) PG8_BAR;
        PG8_WAIT_V(2); PG8_BAR;
        PG8_STAGE(PG8_SB(1, 0), cB + kstep, voffB); PG8_STAGE(PG8_SA(1, 0), cA + kstep, voffA); PG8_STAGE(PG8_SB(1, 1), cB + hstep + kstep, voffB);
        PG8_WAIT_V(6); PG8_BAR;
    } else {
        PG8_STAGE(PG8_SB(0, 0), cB, voffB); PG8_STAGE(PG8_SA(0, 0), cA, voffA); PG8_STAGE(PG8_SB(0, 1), cB + hstep, voffB); PG8_STAGE(PG8_SA(0, 1), cA + hstep, voffA);
        if (wr == 1) PG8_BAR;
        PG8_WAIT_V(4); PG8_BAR;
        PG8_STAGE(PG8_SB(1, 0), cB + kstep, voffB); PG8_STAGE(PG8_SA(1, 0), cA + kstep, voffA); PG8_STAGE(PG8_SB(1, 1), cB + hstep + kstep, voffB);
        PG8_WAIT_V(6); PG8_BAR;
    }
    for (;;) {
        const bool has_next = S.next(ui + 1, nxt);
        const char* nA = has_next ? (const char*)g.A + (size_t)nxt.pm * tstep : cA; const char* nB = has_next ? (const char*)g.Bt + (size_t)nxt.pn * tstep : cB;
        for (int t = 0; t < nt; t += 2) {
            const bool last = (t == nt - 2);
            const char* a1 = cA + (size_t)(t + 1) * kstep;
            const char* a2 = last ? nA : cA + (size_t)(t + 2) * kstep; const char* b2 = last ? nB : cB + (size_t)(t + 2) * kstep;
            const char* a3 = a2 + kstep; const char* b3 = b2 + kstep;
            if (last && has_next) S.a_ready(nxt);
            if constexpr (SP2) {
            PG8_LDB(B0, 0, 0); PG8_LDB(B1, 0, 1); PG8_SCHED; PG8_LDA(At, 0, 0); PG8_STAGE(PG8_SA(1, 1), a1 + hstep, voffA);
            PG8_WAIT_V(8); PG8_WAIT_L(0); PG8_BAR; PG8_MMA(0, 0, At, B0); PG8_MMA(0, 1, At, B1); PG8_BAR; PG8_SCHED;
            PG8_LDA(At, 0, 1); PG8_STAGE(PG8_SB(0, 0), b2, voffB); PG8_STAGE(PG8_SB(0, 1), b2 + hstep, voffB); PG8_STAGE(PG8_SA(0, 0), a2, voffA);
            PG8_WAIT_V(8); PG8_WAIT_L(0); PG8_BAR; PG8_MMA(1, 0, At, B0); PG8_MMA(1, 1, At, B1); PG8_BAR; PG8_SCHED;
            PG8_LDB(B0, 1, 0); PG8_LDB(B1, 1, 1); PG8_SCHED; PG8_LDA(At, 1, 0); PG8_STAGE(PG8_SA(0, 1), a2 + hstep, voffA);
            PG8_WAIT_V(8); PG8_WAIT_L(0); PG8_BAR; PG8_MMA(0, 0, At, B0); PG8_MMA(0, 1, At, B1); PG8_BAR; PG8_SCHED;
            PG8_LDA(At, 1, 1); PG8_STAGE(PG8_SB(1, 0), b3, voffB); PG8_STAGE(PG8_SB(1, 1), b3 + hstep, voffB); PG8_STAGE(PG8_SA(1, 0), a3, voffA);
            PG8_WAIT_V(8); PG8_WAIT_L(0); PG8_BAR; PG8_MMA(1, 0, At, B0); PG8_MMA(1, 1, At, B1); PG8_BAR; PG8_SCHED;
            } else {
            PG8_LDB(B0, 0, 0); PG8_SCHED; PG8_LDA(At, 0, 0); PG8_STAGE(PG8_SA(1, 1), a1 + hstep, voffA);
            PG8_WAIT_L(8); PG8_BAR; PG8_WAIT_L(0); PG8_MMA(0, 0, At, B0); PG8_BAR; PG8_SCHED;
            PG8_LDB(B1, 0, 1); PG8_STAGE(PG8_SB(0, 0), b2, voffB);
            PG8_BAR; PG8_WAIT_L(0); PG8_MMA(0, 1, At, B1); PG8_BAR;
            PG8_LDA(At, 0, 1); PG8_STAGE(PG8_SA(0, 0), a2, voffA);
            PG8_BAR; PG8_WAIT_L(0); PG8_MMA(1, 0, At, B0); PG8_BAR; PG8_SCHED;
            PG8_STAGE(PG8_SB(0, 1), b2 + hstep, voffB);
            PG8_WAIT_V(6); PG8_BAR; PG8_MMA(1, 1, At, B1); PG8_BAR;
            PG8_LDB(B0, 1, 0); PG8_SCHED; PG8_LDA(At, 1, 0); PG8_STAGE(PG8_SA(0, 1), a2 + hstep, voffA);
            PG8_WAIT_L(8); PG8_BAR; PG8_WAIT_L(0); PG8_MMA(0, 0, At, B0); PG8_BAR; PG8_SCHED;
            PG8_LDB(B1, 1, 1); PG8_STAGE(PG8_SB(1, 0), b3, voffB);
            PG8_BAR; PG8_WAIT_L(0); PG8_MMA(0, 1, At, B1); PG8_BAR;
            PG8_LDA(At, 1, 1); PG8_STAGE(PG8_SA(1, 0), a3, voffA);
            PG8_BAR; PG8_WAIT_L(0); PG8_MMA(1, 0, At, B0); PG8_BAR; PG8_SCHED;
            PG8_STAGE(PG8_SB(1, 1), b3 + hstep, voffB);
            PG8_WAIT_V(6); PG8_BAR; PG8_MMA(1, 1, At, B1); PG8_BAR;
            }
        }
        if constexpr (ALIGN_EPI) { if (wr == 0) PG8_BAR; }
        if constexpr (!Epi::AFTER_DRAIN) { E(acc, cur, wr, wc, fr, fq); S.done(cur); }
        if (!has_next) break;
#pragma unroll
        for (int a = 0; a < 2; ++a)
#pragma unroll
            for (int b = 0; b < 2; ++b)
#pragma unroll
                for (int m = 0; m < 4; ++m)
#pragma unroll
                    for (int n = 0; n < 2; ++n) acc[a][b][m][n] = (f32x4){0.f, 0.f, 0.f, 0.f};
        cur = nxt; cA = nA; cB = nB; ++ui;
        if constexpr (ALIGN_EPI) { if (wr == 1) PG8_BAR; }
    }
    PG8_WAIT_V(0);
    if constexpr (!ALIGN_EPI) { if (wr == 0) PG8_BAR; }
    PG8_BAR;
    if constexpr (Epi::AFTER_DRAIN) { E.fused(acc, cur, wr, wc, fr, fq, lds, wid, lane); S.done(cur); }
#undef PG8_SA
#undef PG8_SB
#undef PG8_STAGE
#undef PG8_LDA
#undef PG8_LDB
#undef PG8_MMA
#undef PG8_WAIT_V
#undef PG8_WAIT_L
#undef PG8_BAR
#undef PG8_SCHED
}
}

constexpr int DM = 2048, NB = 8, SEQ = 4096, NMETA = 16, LSEQ = 4112, LPAD = 4128;
constexpr int MREAL = NB * SEQ;
constexpr int MPAD = MREAL + 256;
constexpr int MT_REAL = MREAL / 256;
constexpr int DFF = 5632, NGU = 2 * DFF, NNG = 7168, NGATE = 8192, INCOLS = 15184, NGC = 6992;
constexpr int NWAVES = 8;
constexpr float EPS = 1e-6f;
constexpr int C_AQ = 0, C_AF = 512, C_AI = 1024, C_AG = 1536, C_BB = 2048, C_BC = 2560, C_BU = 3072, C_CQ = 3584, C_CK = 4096, C_CV = 4608,
              C_DQ = 5120, C_DK = 5632, C_DV = 5760, C_DQI = 5888, C_DKI = 6912, C_DW = 6976;

constexpr size_t MiB = 1u << 20;
constexpr size_t WS_CTL = 0, CTL_ZERO_BYTES = 1 * MiB;
constexpr size_t WS_HM = 1 * MiB;
constexpr size_t WS_W = 4 * MiB;
constexpr size_t W_GU1 = 0, W_D1 = W_GU1 + (size_t)NGU * DM * 2, W_NG = W_D1 + (size_t)DM * DFF * 2, W_G = W_NG + (size_t)NNG * DM * 2,
                 W_BR = W_G + (size_t)NGATE * DM * 2, W_O = W_BR + (size_t)4 * DM * 512 * 2, W_GU2 = W_O + (size_t)DM * DM * 2, W_D2 = W_GU2 + (size_t)NGU * DM * 2,
                 W_END = W_D2 + (size_t)DM * DFF * 2;
constexpr size_t WS_XN = WS_W + W_END;
constexpr size_t WS_BR = WS_XN + (size_t)MPAD * DM * 2;
constexpr size_t WS_BIG = WS_BR + (size_t)MPAD * DM * 2;
constexpr size_t BIG_P_END = (size_t)MPAD * NNG * 2;
constexpr size_t WS_VTC = WS_BIG + BIG_P_END;
constexpr size_t WS_VTD = WS_VTC + (size_t)NB * 4 * 128 * LPAD * 2;
constexpr size_t WS_MASK = WS_VTD + (size_t)NB * 128 * LPAD * 2;
constexpr int MASKW = 132;
constexpr int NIDX_WG = 172;
constexpr int NHG_WG = 32;
constexpr size_t WS_SCR = WS_MASK + (size_t)NB * LPAD * MASKW * 4;
constexpr size_t WS_HA = WS_SCR + (size_t)NIDX_WG * 32 * LPAD * 4;
constexpr size_t WS_HDL = WS_HA + (size_t)NB * 4 * 64 * 64 * 64 * 2;
constexpr size_t WS_HMETA = WS_HDL + (size_t)NB * 4 * 64 * 128 * 4;
constexpr size_t HMETA_STRIDE = 64 * 384 * 2 + 64 * 64 * 2 + 128 * 4;
constexpr size_t WS_END = WS_HMETA + 4 * HMETA_STRIDE;
static_assert(WS_BIG + (size_t)MPAD * NGATE * 2 <= WS_END, "G fits");
static_assert(WS_END <= (size_t)1138174976, "workspace map fits the guaranteed size");

constexpr int RING_OFF = 0, RING_BYTES = 131072;
constexpr int LDSCTL_OFF = 143360, MISC_OFF = LDSCTL_OFF + 320;
constexpr int LDS_BYTES = 147456;

#define GAS __attribute__((address_space(1)))
#define LAS __attribute__((address_space(3)))
typedef unsigned short bf16;
typedef unsigned v4u __attribute__((ext_vector_type(4)));
typedef unsigned v2u __attribute__((ext_vector_type(2)));
typedef float f32x4 __attribute__((ext_vector_type(4)));
typedef float f32x16 __attribute__((ext_vector_type(16)));
typedef short bf16x8 __attribute__((ext_vector_type(8)));
typedef GAS unsigned gu32;
#define RLX_AGENT __ATOMIC_RELAXED, __HIP_MEMORY_SCOPE_AGENT
#define LDS_WAIT() asm volatile("s_waitcnt lgkmcnt(0)" ::: "memory")
#define VM_WAIT() asm volatile("s_waitcnt vmcnt(0)" ::: "memory")
__device__ __forceinline__ unsigned f2bf(float f) { unsigned u = __builtin_bit_cast(unsigned, f); return (u + 0x7fffu + ((u >> 16) & 1u)) >> 16; }
__device__ __forceinline__ unsigned f2bf_s(float f) { return pg8::cvt_pk_bf16(f, 0.f) & 0xffffu; }
__device__ __forceinline__ unsigned pk2(float lo, float hi) { return pg8::cvt_pk_bf16(lo, hi); }
__device__ __forceinline__ float bflo(unsigned w) { return __uint_as_float(w << 16); }
__device__ __forceinline__ float bfhi(unsigned w) { return __uint_as_float(w & 0xffff0000u); }
__device__ __forceinline__ float bf2f(bf16 v) { return __uint_as_float((unsigned)v << 16); }
__device__ __forceinline__ int seqrow(int b, int p) { return p < NMETA ? MREAL + p : b * SEQ + p - NMETA; }
__device__ __forceinline__ int rel_bucket(int n) {
    if (n < 16) return n; if (n >= 128) return 31;
    const int v = 16 + (int)(__log2f((float)n * 0.0625f) * 5.33333333f); return v < 31 ? v : 31; }
__device__ __forceinline__ float wave_sum(float v) {
#pragma unroll
    for (int o = 1; o < 64; o <<= 1) v += __shfl_xor(v, o);
    return v;
}
#define XB_TMO      128
#define XB_XCNT(j)  (256  + 64 * (j))
#define XB_XSUB(j)  (1280 + 64 * (j))
#define XB_XGEN(j)  (2304 + 64 * (j))
#define XB_TOP      3328
#define XB_TOPGEN   3392
#define XCD_BAR_WORDS 3456
#define XB_SPIN_CAP (1u << 18)

__device__ __forceinline__ unsigned xb_ld(unsigned* p)              { return __hip_atomic_load(p, __ATOMIC_RELAXED, __HIP_MEMORY_SCOPE_AGENT); }
__device__ __forceinline__ unsigned xb_add(unsigned* p, unsigned v) { return __hip_atomic_fetch_add(p, v, __ATOMIC_RELAXED, __HIP_MEMORY_SCOPE_AGENT); }
__device__ __forceinline__ unsigned xb_xcc_id() { return (unsigned)__builtin_amdgcn_s_getreg((3 << 11) | 20) & 0xFu; }
#define XB_SPIN(cond, bar) do { unsigned _sp = 0; while (cond) { __builtin_amdgcn_s_sleep(1); \
    if ((++_sp & 255u) == 0u) { if (xb_ld(&(bar)[XB_TMO])) break; if (_sp > XB_SPIN_CAP) { atomicAdd(&(bar)[XB_TMO], 1u); break; } } } } while (0)

struct XcdBarrier {
    unsigned* bar; unsigned x;
    volatile LAS unsigned* st;
};

__device__ __forceinline__ XcdBarrier xcd_barrier_post(unsigned* bar, volatile LAS unsigned* st) {
    XcdBarrier b; b.bar = bar; b.x = xb_xcc_id(); b.st = st;
    if (threadIdx.x == 0) (void)xb_add(&bar[XB_XCNT(b.x)], 1u);
    return b;
}
__device__ __forceinline__ void xcd_barrier_complete(unsigned* bar, unsigned x, unsigned& nloc, unsigned& nx) {
    const unsigned G = gridDim.x * gridDim.y * gridDim.z;
    unsigned sum, cnt, mine, sp = 0u;
    for (;;) {
        sum = 0u; cnt = 0u; mine = 0u;
#pragma unroll
        for (unsigned j = 0; j < 16; ++j) { const unsigned c = xb_ld(&bar[XB_XCNT(j)]); sum += c; cnt += (c > 0u) ? 1u : 0u; mine = (j == x) ? c : mine; }
        if (sum == G) break;
        __builtin_amdgcn_s_sleep(1);
        if ((++sp & 255u) == 0u) { if (xb_ld(&bar[XB_TMO])) break; if (sp > XB_SPIN_CAP) { atomicAdd(&bar[XB_TMO], 1u); break; } }
    }
    nloc = mine > 0u ? mine : 1u; nx = cnt > 0u ? cnt : 1u;
}

__device__ __forceinline__ void xcd_barrier(const XcdBarrier& b) {
    asm volatile("s_waitcnt vmcnt(0)" ::: "memory");
    __syncthreads();
    if (threadIdx.x == 0) {
        unsigned* bar = b.bar;
        __builtin_amdgcn_s_waitcnt(0);
        unsigned nloc = b.st[0], nx = b.st[1];
        if (nloc == 0u) { xcd_barrier_complete(bar, b.x, nloc, nx); b.st[0] = nloc; b.st[1] = nx; }
        const unsigned old = xb_add(&bar[XB_XSUB(b.x)], 1u);
        const unsigned gen = old / nloc;
        if (old + 1u == (gen + 1u) * nloc) {
            __builtin_amdgcn_fence(__ATOMIC_RELEASE, "agent");
            asm volatile("s_waitcnt vmcnt(0)" ::: "memory");
            const unsigned og = xb_add(&bar[XB_TOP], 1u);
            const unsigned tg = og / nx;
            if (og + 1u == (tg + 1u) * nx) xb_add(&bar[XB_TOPGEN], 1u);
            else XB_SPIN(xb_ld(&bar[XB_TOPGEN]) == tg, bar);
            __builtin_amdgcn_fence(__ATOMIC_ACQUIRE, "agent");
            xb_add(&bar[XB_XGEN(b.x)], 1u);
            asm volatile("s_waitcnt vmcnt(0)" ::: "memory");
        } else {
            XB_SPIN(xb_ld(&bar[XB_XGEN(b.x)]) == gen, bar);
            __builtin_amdgcn_fence(__ATOMIC_ACQUIRE, "agent");
            asm volatile("s_waitcnt vmcnt(0)" ::: "memory");
        }
    }
    __syncthreads();
}

struct Frame {
    LAS unsigned char* lds;
    volatile LAS unsigned* MISC;
    gu32* ctl;
    int tid, lane, wave, G, bid;
    const float* in[22]; float* out; unsigned char* ws;
};
enum { I_X = 0, I_META, I_RELB, I_F1N, I_F1GU, I_F1D, I_MIXN, I_WIN, I_LB, I_GN, I_CONVW, I_DQN, I_DKN, I_DLAM, I_DSUB, I_SQN, I_SKN, I_WBR, I_WOUT, I_F2N, I_F2GU, I_F2D };

template <class RowMap>
__device__ __forceinline__ void transpose_item(const float* W, int K, int N, bf16* WT, LAS float* scr, int item, int lane, RowMap rm) {
    const int nblk = (N + 31) / 32, kb = item / nblk, nb = item % nblk, k0 = 64 * kb, n0 = 32 * nb;
    const int nl = n0 + (lane & 31); const bool nok = nl < N;
#pragma unroll 8
    for (int i = 0; i < 32; ++i) { const int kk = 2 * i + (lane >> 5); scr[kk * 33 + (lane & 31)] = nok ? W[(size_t)(k0 + kk) * N + nl] : 0.f; }
    LDS_WAIT(); asm volatile("" ::: "memory");
    const int c = lane & 7;
#pragma unroll
    for (int j = 0; j < 4; ++j) { const int n = (lane >> 3) + 8 * j; const LAS float* s = scr + (8 * c) * 33 + n;
        v4u o; o.x = pk2(s[0 * 33], s[1 * 33]); o.y = pk2(s[2 * 33], s[3 * 33]); o.z = pk2(s[4 * 33], s[5 * 33]); o.w = pk2(s[6 * 33], s[7 * 33]);
        if (n0 + n < N) *(GAS v4u*)(WT + (size_t)rm(n0 + n) * K + k0 + 8 * c) = o; }
    LDS_WAIT(); asm volatile("" ::: "memory");
}
struct MapId { __device__ __forceinline__ int operator()(int n) const { return n; } };
struct MapGU { __device__ __forceinline__ int operator()(int n) const { const int up = n >= DFF, j = up ? n - DFF : n; return 256 * (j >> 7) + 128 * up + (j & 127); } };
struct MapIn { __device__ __forceinline__ int operator()(int n) const { return n < NGC ? n : n + (NNG - NGC); } };
template <class RowMap>
__device__ __forceinline__ void convert_matrix(Frame& F, const float* W, int K, int N, bf16* WT, RowMap rm) {
    LAS float* scr = (LAS float*)(F.lds + F.wave * 16384);
    const int gw = F.bid * NWAVES + F.wave, NGW = F.G * NWAVES, nitems = (K / 64) * ((N + 31) / 32);
    for (int it = gw; it < nitems; it += NGW) transpose_item(W, K, N, WT, scr, it, F.lane, rm);
}
__device__ __forceinline__ void phase_convert(Frame& F, int l) {
    unsigned char* wb = F.ws + WS_W;
    convert_matrix(F, F.in[I_F1GU] + (size_t)l * DM * NGU, DM, NGU, (bf16*)(wb + W_GU1), MapGU());
    convert_matrix(F, F.in[I_F1D] + (size_t)l * DFF * DM, DFF, DM, (bf16*)(wb + W_D1), MapId());
    convert_matrix(F, F.in[I_WIN] + (size_t)l * DM * INCOLS, DM, INCOLS, (bf16*)(wb + W_NG), MapIn());
    for (int m = 0; m < 4; ++m) convert_matrix(F, F.in[I_WBR] + ((size_t)l * 4 + m) * 512 * DM, 512, DM, (bf16*)(wb + W_BR) + (size_t)m * DM * 512, MapId());
    convert_matrix(F, F.in[I_WOUT] + (size_t)l * DM * DM, DM, DM, (bf16*)(wb + W_O), MapId());
    convert_matrix(F, F.in[I_F2GU] + (size_t)l * DM * NGU, DM, NGU, (bf16*)(wb + W_GU2), MapGU());
    convert_matrix(F, F.in[I_F2D] + (size_t)l * DFF * DM, DFF, DM, (bf16*)(wb + W_D2), MapId());
    { GAS v4u* z = (GAS v4u*)(wb + W_NG + (size_t)NGC * DM * 2); const int n16 = (NNG - NGC) * DM * 2 / 16;
      for (int i = F.bid * 512 + F.tid; i < n16; i += F.G * 512) z[i] = (v4u){0u, 0u, 0u, 0u}; }
    if (l == 0) {
        GAS f32x4* hm = (GAS f32x4*)(F.ws + WS_HM); const GAS f32x4* mt = (const GAS f32x4*)F.in[I_META];
        for (int i = F.bid * 512 + F.tid; i < 256 * DM / 4; i += F.G * 512) hm[i] = (i < NMETA * DM / 4) ? mt[i] : (f32x4){0.f, 0.f, 0.f, 0.f};
    }
}
__device__ __forceinline__ void phase_norm(Frame& F, const float* src_real, const float* gain) {
    const int gw = F.bid * NWAVES + F.wave, NGW = F.G * NWAVES;
    bf16* XN = (bf16*)(F.ws + WS_XN); const float* hm = (const float*)(F.ws + WS_HM);
    f32x4 g[8];
#pragma unroll
    for (int j = 0; j < 8; ++j) g[j] = ((const GAS f32x4*)gain)[F.lane + 64 * j];
    for (int r = gw; r < MPAD; r += NGW) {
        GAS v2u* o8 = (GAS v2u*)(XN + (size_t)r * DM) + F.lane;
        if (r >= MREAL + NMETA) {
#pragma unroll
            for (int j = 0; j < 8; ++j) o8[64 * j] = (v2u){0u, 0u};
            continue; }
        const float* xr = r < MREAL ? src_real + (size_t)r * DM : hm + (size_t)(r - MREAL) * DM;
        f32x4 v[8]; float s = 0.f;
#pragma unroll
        for (int j = 0; j < 8; ++j) { v[j] = ((const GAS f32x4*)xr)[F.lane + 64 * j]; s += (v[j].x * v[j].x + v[j].y * v[j].y) + (v[j].z * v[j].z + v[j].w * v[j].w); }
        const float inv = 1.0f / sqrtf(wave_sum(s) * (1.f / DM) + EPS);
#pragma unroll
        for (int j = 0; j < 8; ++j) { v2u w; w.x = pk2(v[j].x * inv * g[j].x, v[j].y * inv * g[j].y); w.y = pk2(v[j].z * inv * g[j].z, v[j].w * inv * g[j].w); o8[64 * j] = w; }
    }
}
__device__ __forceinline__ void unpack8(const v4u w, float (&x)[8]) { x[0] = bflo(w.x); x[1] = bfhi(w.x); x[2] = bflo(w.y); x[3] = bfhi(w.y); x[4] = bflo(w.z); x[5] = bfhi(w.z); x[6] = bflo(w.w); x[7] = bfhi(w.w); }
__device__ __forceinline__ v4u pack8(const float (&x)[8]) { v4u w; w.x = pk2(x[0], x[1]); w.y = pk2(x[2], x[3]); w.z = pk2(x[4], x[5]); w.w = pk2(x[6], x[7]); return w; }
template <int GL>
__device__ __forceinline__ void norm_cols_inplace(bf16* p, const float* gain, float scale, int lane, bool wr) {
    float x[8]; unpack8(*(const GAS v4u*)p, x); float s = 0.f;
#pragma unroll
    for (int i = 0; i < 8; ++i) s += x[i] * x[i];
#pragma unroll
    for (int o = 1; o < GL; o <<= 1) s += __shfl_xor(s, o);
    const float inv = scale / sqrtf(s * (1.f / (GL * 8)) + EPS); const int g0 = (8 * lane) % (GL * 8);
#pragma unroll
    for (int i = 0; i < 8; ++i) x[i] = x[i] * inv * gain[g0 + i];
    if (wr) *(GAS v4u*)p = pack8(x);
}
__device__ __forceinline__ void phase_prep(Frame& F, int l) {
    const int gw = F.bid * NWAVES + F.wave, NGW = F.G * NWAVES, lane = F.lane;
    bf16* P = (bf16*)(F.ws + WS_BIG);
    const float *dqn = F.in[I_DQN] + l * 64, *dkn = F.in[I_DKN] + l * 64, *sqn = F.in[I_SQN] + l * 128, *skn = F.in[I_SKN] + l * 128;
    for (int r = gw; r < MREAL + NMETA; r += NGW) {
        bf16* pr = P + (size_t)r * NNG;
        norm_cols_inplace<8>(pr + C_CQ + 8 * lane, dqn, 0.125f, lane, true);
        norm_cols_inplace<8>(pr + C_CK + 8 * lane, dkn, 1.0f, lane, true);
        norm_cols_inplace<16>(pr + C_DQ + 8 * lane, sqn, 0.08838834764831845f, lane, true);
        norm_cols_inplace<16>(pr + C_DK + 8 * (lane & 15), skn, 1.0f, lane & 15, lane < 16);
    }
}
__device__ __forceinline__ void phase_vt(Frame& F) {
    const int gw = F.bid * NWAVES + F.wave, NGW = F.G * NWAVES, lane = F.lane;
    const bf16* P = (const bf16*)(F.ws + WS_BIG); bf16* VtC = (bf16*)(F.ws + WS_VTC); bf16* VtD = (bf16*)(F.ws + WS_VTD);
    LAS bf16* T = (LAS bf16*)(F.lds + F.wave * 17408);
    constexpr int NPB = (LPAD + 63) / 64;
    for (int task = gw; task < NB * 5 * NPB; task += NGW) {
        const int pb = task % NPB, mat = (task / NPB) % 5, b = task / (NPB * 5), p0 = 64 * pb;
        const int col = mat < 4 ? C_CV + 128 * mat : C_DV;
#pragma unroll 4
        for (int i = 0; i < 16; ++i) { const int pl = 4 * i + (lane >> 4), p = p0 + pl; v4u w = (v4u){0u, 0u, 0u, 0u};
            if (p < LSEQ) w = *(const GAS v4u*)(P + (size_t)seqrow(b, p) * NNG + col + 8 * (lane & 15));
            *(LAS v4u*)(T + pl * 136 + 8 * (lane & 15)) = w; }
        LDS_WAIT(); asm volatile("" ::: "memory");
        bf16* dst = mat < 4 ? VtC + (size_t)(b * 4 + mat) * 128 * LPAD : VtD + (size_t)b * 128 * LPAD;
#pragma unroll 4
        for (int it = 0; it < 16; ++it) { const int e = 8 * it + (lane >> 3), c = lane & 7; unsigned short x[8];
#pragma unroll
            for (int k = 0; k < 8; ++k) x[k] = T[(8 * c + k) * 136 + e];
            v4u w; w.x = x[0] | ((unsigned)x[1] << 16); w.y = x[2] | ((unsigned)x[3] << 16); w.z = x[4] | ((unsigned)x[5] << 16); w.w = x[6] | ((unsigned)x[7] << 16);
            if (p0 + 8 * c < LPAD) *(GAS v4u*)(dst + (size_t)e * LPAD + p0 + 8 * c) = w; }
        LDS_WAIT(); asm volatile("" ::: "memory");
    }
}

#define NEG_INF (-__builtin_inff())
constexpr int NQT = (LSEQ + 31) / 32;
constexpr int NQB = (NQT + 7) / 8;
__device__ __forceinline__ bf16x8 ld_frag16(const bf16* p) { return *(const GAS bf16x8*)p; }
__device__ __forceinline__ bf16x8 mk_frag(v2u lo, v2u hi) { v4u w; w.x = lo.x; w.y = lo.y; w.z = hi.x; w.w = hi.y; return __builtin_bit_cast(bf16x8, w); }
__device__ __forceinline__ unsigned cvtpk(float lo, float hi) { return pg8::cvt_pk_bf16(lo, hi); }
__device__ __forceinline__ void build_bias_table(Frame& F, LAS float* bt, int col0) {
    const float* rb = F.in[I_RELB];
    for (int i = F.tid; i < 4 * 128; i += 512) { const int hd = i >> 7, n = i & 127; bt[i] = rb[rel_bucket(n) * 8 + col0 + hd]; }
}
__device__ __forceinline__ void softmax_step(f32x16& S, float& m, float& lsum, float& alpha) {
    float tm = S[0];
#pragma unroll
    for (int r = 1; r < 16; ++r) tm = fmaxf(tm, S[r]);
    tm = fmaxf(tm, __shfl_xor(tm, 32));
    const float mn = fmaxf(m, tm), mref = (mn == NEG_INF) ? 0.f : mn;
    alpha = __expf(m - mref);
    float rs = 0.f;
#pragma unroll
    for (int r = 0; r < 16; ++r) { S[r] = __expf(S[r] - mref); rs += S[r]; }
    rs += __shfl_xor(rs, 32);
    lsum = lsum * alpha + rs; m = mn;
}
template <bool DSA>
__device__ __forceinline__ void attn_wg_task(Frame& F, int l, int b, int h, int J, const LAS float* bt, float lam, float post) {
    constexpr int KD = DSA ? 128 : 64, KP = KD + 8, VP = 36, NKS = KD / 16;
    constexpr int KBUF = 32 * KP, VBUF = 128 * VP;
    const int lane = F.lane, ql = lane & 31, hh = lane >> 5, wave = F.wave, tid = F.tid;
    LAS bf16* Kl = (LAS bf16*)F.lds; LAS bf16* Vl = Kl + 2 * KBUF;
    const bf16* P = (const bf16*)(F.ws + WS_BIG);
    const bf16* Vt = DSA ? (const bf16*)(F.ws + WS_VTD) + (size_t)b * 128 * LPAD : (const bf16*)(F.ws + WS_VTC) + (size_t)(b * 4 + h) * 128 * LPAD;
    const int j = 8 * J + wave; const bool wvalid = 32 * j < LSEQ;
    const int ktmax = (8 * J + 7 < NQT - 1) ? 8 * J + 7 : NQT - 1;
    const int pq = 32 * j + ql, pqc = pq < LSEQ ? pq : LSEQ - 1;
    const bf16* qrow = P + (size_t)seqrow(b, pqc) * NNG + (DSA ? C_DQ : C_CQ) + h * 128 + 8 * hh;
    const unsigned* mrow = (const unsigned*)(F.ws + WS_MASK) + ((size_t)b * LPAD + pqc) * MASKW;
    const float b31 = bt[h * 128 + 127];
    const int kr = tid / (KD / 8), kc = tid % (KD / 8); const bool kload = tid < 32 * (KD / 8);
    const int vr = tid >> 2, vc = tid & 3;
    f32x16 R[4];
#pragma unroll
    for (int c = 0; c < (DSA ? 1 : 2); ++c) {
        const int kcol = DSA ? C_DK : C_CK + h * 128 + c * 64;
        bf16x8 qf[NKS];
#pragma unroll
        for (int ks = 0; ks < NKS; ++ks) qf[ks] = ld_frag16(qrow + (DSA ? 0 : c * 64) + 16 * ks);
        float m = NEG_INF, lsum = 0.f; f32x16 O[4];
#pragma unroll
        for (int eb = 0; eb < 4; ++eb)
#pragma unroll
            for (int r = 0; r < 16; ++r) O[eb][r] = 0.f;
        v4u rk = (v4u){0u, 0u, 0u, 0u}, rv;
        auto issue = [&](int kt) { int pk = 32 * kt + kr; pk = pk < LSEQ ? pk : LSEQ - 1;
            if (kload) rk = *(const GAS v4u*)(P + (size_t)seqrow(b, pk) * NNG + kcol + 8 * kc);
            rv = *(const GAS v4u*)(Vt + (size_t)vr * LPAD + 32 * kt + 8 * vc); };
        auto commit = [&](int buf) { if (kload) *(LAS v4u*)(Kl + buf * KBUF + kr * KP + 8 * kc) = rk;
            LAS v2u* vd = (LAS v2u*)(Vl + buf * VBUF + vr * VP + 8 * vc); vd[0] = (v2u){rv.x, rv.y}; vd[1] = (v2u){rv.z, rv.w}; };
        __syncthreads();
        issue(0); commit(0);
        for (int kt = 0; kt <= ktmax; ++kt) {
            const int buf = kt & 1;
            LDS_WAIT(); __syncthreads();
            if (kt < ktmax) issue(kt + 1);
            if (wvalid && kt <= j) {
                const LAS bf16* Kt = Kl + buf * KBUF + ql * KP + 8 * hh; const LAS bf16* Vb = Vl + buf * VBUF + ql * VP + 4 * hh;
                f32x16 S;
#pragma unroll
                for (int r = 0; r < 16; ++r) S[r] = 0.f;
#pragma unroll
                for (int ks = 0; ks < NKS; ++ks) S = __builtin_amdgcn_mfma_f32_32x32x16_bf16(*(const LAS bf16x8*)(Kt + 16 * ks), qf[ks], S, 0, 0, 0);
                unsigned mw = 0xffffffffu; if (DSA) mw = mrow[kt] >> (4 * hh);
                if (kt + 4 >= j) {
#pragma unroll
                    for (int r = 0; r < 16; ++r) { const int ko = (r & 3) + 8 * (r >> 2), n = pq - (32 * kt + 4 * hh + ko); const bool sel = ((mw >> ko) & 1u) && n >= 0;
                        S[r] = sel ? S[r] + bt[h * 128 + (n < 127 ? n : 127)] : NEG_INF; }
                } else {
#pragma unroll
                    for (int r = 0; r < 16; ++r) { const int ko = (r & 3) + 8 * (r >> 2); S[r] = (!DSA || ((mw >> ko) & 1u)) ? S[r] + b31 : NEG_INF; }
                }
                float alpha; softmax_step(S, m, lsum, alpha);
#pragma unroll
                for (int eb = 0; eb < 4; ++eb)
#pragma unroll
                    for (int r = 0; r < 16; ++r) O[eb][r] *= alpha;
                bf16x8 pf[2];
#pragma unroll
                for (int s = 0; s < 2; ++s) { v4u w; w.x = cvtpk(S[8 * s + 0], S[8 * s + 1]); w.y = cvtpk(S[8 * s + 2], S[8 * s + 3]); w.z = cvtpk(S[8 * s + 4], S[8 * s + 5]); w.w = cvtpk(S[8 * s + 6], S[8 * s + 7]); pf[s] = __builtin_bit_cast(bf16x8, w); }
#pragma unroll
                for (int eb = 0; eb < 4; ++eb)
#pragma unroll
                    for (int s = 0; s < 2; ++s) { const LAS bf16* vp = Vb + eb * 32 * VP + 16 * s;
                        O[eb] = __builtin_amdgcn_mfma_f32_32x32x16_bf16(mk_frag(*(const LAS v2u*)vp, *(const LAS v2u*)(vp + 8)), pf[s], O[eb], 0, 0, 0); }
            }
            if (kt < ktmax) commit(buf ^ 1);
        }
        const float il = 1.0f / lsum;
        if (DSA || c == 0) {
#pragma unroll
            for (int eb = 0; eb < 4; ++eb)
#pragma unroll
                for (int r = 0; r < 16; ++r) R[eb][r] = O[eb][r] * il;
        } else {
#pragma unroll
            for (int eb = 0; eb < 4; ++eb)
#pragma unroll
                for (int r = 0; r < 16; ++r) R[eb][r] -= lam * (O[eb][r] * il);
        }
    }
    float inv = 1.0f;
    if (!DSA) { float ss = 0.f;
#pragma unroll
        for (int eb = 0; eb < 4; ++eb)
#pragma unroll
            for (int r = 0; r < 16; ++r) ss += R[eb][r] * R[eb][r];
        ss += __shfl_xor(ss, 32); inv = post / sqrtf(ss * (1.f / 128.f) + EPS); }
    const float* sub = F.in[I_DSUB] + l * 128;
    if (wvalid && pq < LSEQ && (pq >= NMETA || b == 0)) {
        bf16* orow = (bf16*)(F.ws + WS_BR) + (size_t)(DSA ? 3 : 2) * MPAD * 512 + (size_t)seqrow(b, pq) * 512 + h * 128;
#pragma unroll
        for (int eb = 0; eb < 4; ++eb)
#pragma unroll
            for (int g = 0; g < 4; ++g) { const int e0 = 32 * eb + 8 * g + 4 * hh; f32x4 sv = (f32x4){1.f, 1.f, 1.f, 1.f}; if (!DSA) sv = *(const GAS f32x4*)(sub + e0);
                v2u w; w.x = pk2(R[eb][4 * g] * inv * sv.x, R[eb][4 * g + 1] * inv * sv.y); w.y = pk2(R[eb][4 * g + 2] * inv * sv.z, R[eb][4 * g + 3] * inv * sv.w);
                *(GAS v2u*)(orow + e0) = w; }
    }
}
__device__ __forceinline__ unsigned f32_key(float f) { const unsigned u = __float_as_uint(f); return u ^ ((u >> 31) ? 0xffffffffu : 0x80000000u); }
__device__ __forceinline__ void dsa_index_task(Frame& F, int b, int j, float* slab) {
    const int lane = F.lane, ql = lane & 31, hh = lane >> 5, wave = F.wave;
    const bf16* P = (const bf16*)(F.ws + WS_BIG);
    LAS unsigned char* qi = F.lds;
    for (int i = F.tid; i < 32 * 128; i += 512) { const int q = i >> 7, ch = i & 127; int pq = 32 * j + q; pq = pq < LSEQ ? pq : LSEQ - 1;
        *(LAS v4u*)(qi + q * 2064 + 16 * ch) = *(const GAS v4u*)(P + (size_t)seqrow(b, pq) * NNG + C_DQI + 8 * ch); }
    LAS float* wl = (LAS float*)(qi + 32 * 2064);
    if (F.tid < 32 * 16) { const int q = F.tid >> 4, hd = F.tid & 15; int pq = 32 * j + q; pq = pq < LSEQ ? pq : LSEQ - 1;
        wl[F.tid] = bf2f(P[(size_t)seqrow(b, pq) * NNG + C_DW + hd]) * 0.03125f; }
    LDS_WAIT(); __syncthreads();
    for (int kt = wave; kt <= j; kt += NWAVES) {
        const int pk = 32 * kt + ql, pkc = pk < LSEQ ? pk : LSEQ - 1;
        const bf16* krow = P + (size_t)seqrow(b, pkc) * NNG + C_DKI + 8 * hh;
        bf16x8 kf[4];
#pragma unroll
        for (int ks = 0; ks < 4; ++ks) kf[ks] = ld_frag16(krow + 16 * ks);
        f32x16 idx;
#pragma unroll
        for (int r = 0; r < 16; ++r) idx[r] = 0.f;
#pragma unroll 1
        for (int hd = 0; hd < 16; ++hd) { f32x16 S; const float wh = wl[ql * 16 + hd];
#pragma unroll
            for (int r = 0; r < 16; ++r) S[r] = 0.f;
#pragma unroll
            for (int ks = 0; ks < 4; ++ks) S = __builtin_amdgcn_mfma_f32_32x32x16_bf16(kf[ks], *(const LAS bf16x8*)(qi + ql * 2064 + hd * 128 + 32 * ks + 16 * hh), S, 0, 0, 0);
#pragma unroll
            for (int r = 0; r < 16; ++r) idx[r] += wh * fmaxf(S[r], 0.f); }
        float* srow = slab + (size_t)ql * LPAD + 32 * kt + 4 * hh;
#pragma unroll
        for (int g = 0; g < 4; ++g) *(GAS f32x4*)(srow + 8 * g) = (f32x4){idx[4 * g], idx[4 * g + 1], idx[4 * g + 2], idx[4 * g + 3]};
    }
    VM_WAIT(); __syncthreads();
    for (int qq = wave; qq < 32; qq += NWAVES) {
        const int p = 32 * j + qq; if (p >= LSEQ) break;
        const float* row = slab + (size_t)qq * LPAD;
        unsigned u[65];
#pragma unroll
        for (int i = 0; i < 65; ++i) { const int key = 64 * i + lane; u[i] = 0u; if (key <= p) u[i] = f32_key(((const GAS float*)row)[key]); }
        unsigned T = 1u;
        if (p + 1 > 256) { T = 0u;
            for (int bit = 31; bit >= 0; --bit) { const unsigned cand = T | (1u << bit); int cnt = 0;
#pragma unroll
                for (int i = 0; i < 65; ++i) cnt += (u[i] >= cand) ? 1 : 0;
#pragma unroll
                for (int o = 1; o < 64; o <<= 1) cnt += __shfl_xor(cnt, o);
                if (cnt >= 256) T = cand; } }
        unsigned long long* mrow = (unsigned long long*)((unsigned*)(F.ws + WS_MASK) + ((size_t)b * LPAD + p) * MASKW);
#pragma unroll
        for (int i = 0; i < 65; ++i) { const unsigned long long bal = __ballot(u[i] >= T); if (lane == 0) mrow[i] = bal; }
    }
    __syncthreads();
}
struct HgChunk { bf16* base; int pitch; int cq, ck, cv; bf16* A; float* dl; };
__device__ __forceinline__ HgChunk hg_chunk(Frame& F, int b, int h, int c) {
    HgChunk k;
    if (c == 0) { unsigned char* mp = F.ws + WS_HMETA + (size_t)h * HMETA_STRIDE; k.base = (bf16*)mp; k.pitch = 384; k.cq = 0; k.ck = 128; k.cv = 256; k.A = (bf16*)(mp + 64 * 384 * 2); k.dl = (float*)(mp + 64 * 384 * 2 + 64 * 64 * 2); }
    else { const size_t ci = (size_t)(b * 4 + h) * 64 + (c - 1); k.base = (bf16*)(F.ws + WS_BIG) + (size_t)(b * SEQ + 64 * (c - 1)) * NNG; k.pitch = NNG; k.cq = C_AQ + h * 128; k.ck = C_AF + h * 128; k.cv = C_AI + h * 128;
        k.A = (bf16*)(F.ws + WS_HA) + ci * 64 * 64; k.dl = (float*)(F.ws + WS_HDL) + ci * 128; }
    return k;
}
__device__ __forceinline__ void hgrn_prep_task(Frame& F, int l, int b, int h, int c) {
    const int d = F.tid & 127, tq = F.tid >> 7, lane = F.lane, wave = F.wave;
    const bf16* P = (const bf16*)(F.ws + WS_BIG);
    LAS bf16* Qt = (LAS bf16*)F.lds; LAS bf16* Kt = Qt + 64 * 136; LAS float* part = (LAS float*)(F.lds + 2 * 64 * 136 * 2);
    const HgChunk ch = hg_chunk(F, b, h, c);
    float lb = 0.f; if (l == 1) { const float a = F.in[I_LB][h * 128 + d], cc = F.in[I_LB][512 + h * 128 + d]; lb = 1.0f / (1.0f + __expf(a - cc)); }
    const bool meta = (c == 0);
    const bf16* pr0 = P + (size_t)(meta ? MREAL + 16 * tq : b * SEQ + 64 * (c - 1) + 16 * tq) * NNG + h * 128 + d;
    float run = 0.f;
#pragma unroll 4
    for (int i = 0; i < 16; ++i) { const bool valid = !meta || (16 * tq + i < NMETA);
        if (valid) { const float z = bf2f(pr0[(size_t)i * NNG + C_AF]); const float sg = 1.0f / (1.0f + __expf(-z)); run += __logf(lb + (1.0f - lb) * sg); } }
    part[tq * 128 + d] = run;
    LDS_WAIT(); __syncthreads();
    const float p0 = part[d], p1 = part[128 + d], p2 = part[256 + d], p3 = part[384 + d];
    const float off = (tq > 0 ? p0 : 0.f) + (tq > 1 ? p1 : 0.f) + (tq > 2 ? p2 : 0.f), bmid = p0 + p1, blast = (p0 + p1) + (p2 + p3);
    unsigned kb[8], vb[8]; unsigned short qb[16];
    float bt = off;
#pragma unroll
    for (int i = 0; i < 16; i += 2) { float kbar[2], vv[2];
#pragma unroll
        for (int u = 0; u < 2; ++u) { const int t = 16 * tq + i + u; const bool valid = !meta || (t < NMETA);
            float lf = 0.f, kk = 0.f, qq = 0.f; vv[u] = 0.f;
            if (valid) { const bf16* pr = pr0 + (size_t)(i + u) * NNG; const float z = bf2f(pr[C_AF]), q = bf2f(pr[C_AQ]); vv[u] = bf2f(pr[C_AI]);
                const float sg = 1.0f / (1.0f + __expf(-z)), f = lb + (1.0f - lb) * sg; lf = __logf(f); kk = 1.0f - f; qq = q / (1.0f + __expf(-q)); }
            bt += lf;
            kbar[u] = kk * __expf(blast - bt); qb[i + u] = (unsigned short)f2bf_s(qq * __expf(bt));
            const float qt = qq * __expf(fminf(bt - bmid, 80.f)), kt = kk * __expf(fminf(bmid - bt, 80.f));
            Qt[t * 136 + d] = (bf16)f2bf_s(qt); Kt[t * 136 + d] = (bf16)f2bf_s(kt); }
        kb[i >> 1] = pk2(kbar[0], kbar[1]); vb[i >> 1] = pk2(vv[0], vv[1]); }
    asm volatile("s_waitcnt vmcnt(0)" ::: "memory"); __syncthreads();
#pragma unroll
    for (int i = 0; i < 16; ++i) ch.base[(size_t)(16 * tq + i) * ch.pitch + ch.cq + d] = qb[i];
    { bf16* kd = ch.base + (size_t)(d >> 1) * ch.pitch + ch.ck + (d & 1) * 64 + 16 * tq; bf16* vd = ch.base + (size_t)(d >> 1) * ch.pitch + ch.cv + (d & 1) * 64 + 16 * tq;
      *(GAS v4u*)kd = (v4u){kb[0], kb[1], kb[2], kb[3]}; *(GAS v4u*)(kd + 8) = (v4u){kb[4], kb[5], kb[6], kb[7]};
      *(GAS v4u*)vd = (v4u){vb[0], vb[1], vb[2], vb[3]}; *(GAS v4u*)(vd + 8) = (v4u){vb[4], vb[5], vb[6], vb[7]}; }
    if (tq == 0) ch.dl[d] = __expf(blast);
    LDS_WAIT(); __syncthreads();
    { const int mt = wave >> 1, fr = lane & 15, g = lane >> 4;
#pragma unroll
      for (int u = 0; u < 2; ++u) { const int nt = 2 * (wave & 1) + u; f32x4 acc = (f32x4){0.f, 0.f, 0.f, 0.f};
        if (nt <= mt) {
#pragma unroll
            for (int ks = 0; ks < 4; ++ks) acc = __builtin_amdgcn_mfma_f32_16x16x32_bf16(*(const LAS bf16x8*)(Qt + (16 * mt + fr) * 136 + 32 * ks + 8 * g), *(const LAS bf16x8*)(Kt + (16 * nt + fr) * 136 + 32 * ks + 8 * g), acc, 0, 0, 0);
        }
#pragma unroll
        for (int r = 0; r < 4; ++r) { const int t = 16 * mt + 4 * g + r, s = 16 * nt + fr; ch.A[t * 64 + s] = (bf16)f2bf_s(s <= t ? acc[r] : 0.f); } } }
    __syncthreads();
}
__device__ __forceinline__ void hgrn_scan_unit(Frame& F, int l, int b, int h) {
    const int lane = F.lane, wave = F.wave, fr = lane & 15, g = lane >> 4, tid = F.tid;
    constexpr int QP = 136, AP = 72, KP = 72;
    constexpr int BUF = (64 * QP + 64 * AP + 128 * KP) * 2;
    LAS float* red = (LAS float*)(F.lds + 2 * BUF);
    const float gn = F.in[I_GN][l * 512 + h * 128 + 16 * wave + fr];
    f32x4 S[8];
#pragma unroll
    for (int mt = 0; mt < 8; ++mt) S[mt] = (f32x4){0.f, 0.f, 0.f, 0.f};
    v4u rq[2], ra, rk[2];
    auto issue = [&](int c) { const HgChunk ch = hg_chunk(F, b, h, c);
#pragma unroll
        for (int i = 0; i < 2; ++i) { const int idx = tid + 512 * i, row = idx >> 4, c16 = idx & 15; rq[i] = *(const GAS v4u*)(ch.base + (size_t)row * ch.pitch + ch.cq + 8 * c16); rk[i] = *(const GAS v4u*)(ch.base + (size_t)row * ch.pitch + ch.ck + 8 * c16); }
        ra = *(const GAS v4u*)(ch.A + 8 * tid); };
    auto commit = [&](int buf) { LAS bf16* Q = (LAS bf16*)(F.lds + buf * BUF); LAS bf16* A = Q + 64 * QP; LAS bf16* KT = A + 64 * AP;
#pragma unroll
        for (int i = 0; i < 2; ++i) { const int idx = tid + 512 * i, row = idx >> 4, c16 = idx & 15; *(LAS v4u*)(Q + row * QP + 8 * c16) = rq[i];
            *(LAS v4u*)(KT + (2 * row + (c16 >> 3)) * KP + 8 * (c16 & 7)) = rk[i]; }
        *(LAS v4u*)(A + (tid >> 3) * AP + 8 * (tid & 7)) = ra; };
    issue(0); commit(0);
    for (int c = 0; c <= 64; ++c) {
        const int buf = c & 1; const HgChunk ch = hg_chunk(F, b, h, c);
        LDS_WAIT(); __syncthreads();
        if (c < 64) issue(c + 1);
        LAS bf16* Q = (LAS bf16*)(F.lds + buf * BUF); LAS bf16* A = Q + 64 * QP; LAS bf16* KT = A + 64 * AP;
        const int dv = 16 * wave + fr; const bf16* vrow = ch.base + (size_t)(dv >> 1) * ch.pitch + ch.cv + (dv & 1) * 64 + 8 * g;
        const bf16x8 bv0 = ld_frag16(vrow), bv1 = ld_frag16(vrow + 32);
        f32x4 o[4];
#pragma unroll
        for (int mt = 0; mt < 4; ++mt) o[mt] = (f32x4){0.f, 0.f, 0.f, 0.f};
#pragma unroll
        for (int ks = 0; ks < 4; ++ks) { v4u w; w.x = cvtpk(S[2 * ks][0], S[2 * ks][1]); w.y = cvtpk(S[2 * ks][2], S[2 * ks][3]); w.z = cvtpk(S[2 * ks + 1][0], S[2 * ks + 1][1]); w.w = cvtpk(S[2 * ks + 1][2], S[2 * ks + 1][3]);
            const bf16x8 sb = __builtin_bit_cast(bf16x8, w);
#pragma unroll
            for (int mt = 0; mt < 4; ++mt) { const LAS bf16* qp = Q + (16 * mt + fr) * QP + 32 * ks + 4 * g;
                const bf16x8 af = mk_frag(*(const LAS v2u*)qp, *(const LAS v2u*)(qp + 16));
                o[mt] = __builtin_amdgcn_mfma_f32_16x16x32_bf16(af, sb, o[mt], 0, 0, 0); } }
#pragma unroll
        for (int mt = 0; mt < 4; ++mt) { o[mt] = __builtin_amdgcn_mfma_f32_16x16x32_bf16(*(const LAS bf16x8*)(A + (16 * mt + fr) * AP + 8 * g), bv0, o[mt], 0, 0, 0);
            o[mt] = __builtin_amdgcn_mfma_f32_16x16x32_bf16(*(const LAS bf16x8*)(A + (16 * mt + fr) * AP + 32 + 8 * g), bv1, o[mt], 0, 0, 0); }
#pragma unroll
        for (int mt = 0; mt < 8; ++mt) { const f32x4 dl = *(const GAS f32x4*)(ch.dl + 16 * mt + 4 * g); S[mt] = S[mt] * dl;
            S[mt] = __builtin_amdgcn_mfma_f32_16x16x32_bf16(*(const LAS bf16x8*)(KT + (16 * mt + fr) * KP + 8 * g), bv0, S[mt], 0, 0, 0);
            S[mt] = __builtin_amdgcn_mfma_f32_16x16x32_bf16(*(const LAS bf16x8*)(KT + (16 * mt + fr) * KP + 32 + 8 * g), bv1, S[mt], 0, 0, 0); }
#pragma unroll
        for (int mt = 0; mt < 4; ++mt)
#pragma unroll
            for (int r = 0; r < 4; ++r) { float s2 = o[mt][r] * o[mt][r]; s2 += __shfl_xor(s2, 1); s2 += __shfl_xor(s2, 2); s2 += __shfl_xor(s2, 4); s2 += __shfl_xor(s2, 8);
                if (fr == 0) red[wave * 64 + 16 * mt + 4 * g + r] = s2; }
        LDS_WAIT(); __syncthreads();
        const int nvalid = (c == 0) ? NMETA : 64;
#pragma unroll
        for (int mt = 0; mt < 4; ++mt)
#pragma unroll
            for (int r = 0; r < 4; ++r) { const int t = 16 * mt + 4 * g + r; float tot = 0.f;
#pragma unroll
                for (int w = 0; w < 8; ++w) tot += red[w * 64 + t];
                if (t < nvalid && (c > 0 || b == 0)) { const int row = (c == 0) ? MREAL + t : b * SEQ + 64 * (c - 1) + t;
                    const float gr = bf2f(((const bf16*)(F.ws + WS_BIG))[(size_t)row * NNG + C_AG + h * 128 + dv]);
                    const float val = o[mt][r] * (1.0f / sqrtf(tot * (1.f / 128.f) + EPS)) * gn * (gr / (1.0f + __expf(-gr)));
                    ((bf16*)(F.ws + WS_BR))[(size_t)row * 512 + h * 128 + dv] = (bf16)f2bf_s(val); } }
        if (c < 64) commit(buf ^ 1);
    }
    __syncthreads();
}
__device__ __forceinline__ void conv_row(Frame& F, int l, int r) {
    const int lane = F.lane; const bf16* P = (const bf16*)(F.ws + WS_BIG);
    int r1, r2;
    if (r < MREAL) { const int b = r >> 12, t = r & 4095; r1 = seqrow(b, NMETA + t - 1); r2 = seqrow(b, NMETA + t - 2); }
    else { const int i = r - MREAL; r1 = i >= 1 ? r - 1 : -1; r2 = i >= 2 ? r - 2 : -1; }
    const float* cw = F.in[I_CONVW] + l * 3 * 512 + 8 * lane;
    float c0[8], u0[8], bb[8], y[8]; unpack8(*(const GAS v4u*)(P + (size_t)r * NNG + C_BC + 8 * lane), c0); unpack8(*(const GAS v4u*)(P + (size_t)r * NNG + C_BU + 8 * lane), u0); unpack8(*(const GAS v4u*)(P + (size_t)r * NNG + C_BB + 8 * lane), bb);
#pragma unroll
    for (int i = 0; i < 8; ++i) y[i] = cw[i] * (c0[i] * u0[i]);
    if (r1 >= 0) { unpack8(*(const GAS v4u*)(P + (size_t)r1 * NNG + C_BC + 8 * lane), c0); unpack8(*(const GAS v4u*)(P + (size_t)r1 * NNG + C_BU + 8 * lane), u0);
#pragma unroll
        for (int i = 0; i < 8; ++i) y[i] += cw[512 + i] * (c0[i] * u0[i]); }
    if (r2 >= 0) { unpack8(*(const GAS v4u*)(P + (size_t)r2 * NNG + C_BC + 8 * lane), c0); unpack8(*(const GAS v4u*)(P + (size_t)r2 * NNG + C_BU + 8 * lane), u0);
#pragma unroll
        for (int i = 0; i < 8; ++i) y[i] += cw[1024 + i] * (c0[i] * u0[i]); }
#pragma unroll
    for (int i = 0; i < 8; ++i) y[i] *= bb[i];
    *(GAS v4u*)((bf16*)(F.ws + WS_BR) + (size_t)MPAD * 512 + (size_t)r * 512 + 8 * lane) = pack8(y);
}
__device__ __forceinline__ void phase_hgrn_prep(Frame& F, int l) {
    for (int t = F.bid; t < NB * 4 * 64 + 4; t += F.G) { if (t < 4) hgrn_prep_task(F, l, 0, t, 0); else { const int u = t - 4; hgrn_prep_task(F, l, u >> 8, (u >> 6) & 3, 1 + (u & 63)); } }
}
constexpr int CW_TMO = 0, CW_BAR = 4096, CW_Q = 16384;
__device__ __forceinline__ int queue_pop(Frame& F, int qi) {
    int t = 0; if (F.lane == 0) t = (int)__hip_atomic_fetch_add((unsigned*)(F.ctl + CW_Q + 64 * qi), 1u, RLX_AGENT);
    return __builtin_amdgcn_readfirstlane(t);
}
__device__ __forceinline__ int queue_pop_wg(Frame& F, int qi) {
    LAS int* slot = (LAS int*)(F.lds + 139264);
    __syncthreads();
    if (F.tid == 0) *slot = (int)__hip_atomic_fetch_add((unsigned*)(F.ctl + CW_Q + 64 * qi), 1u, RLX_AGENT);
    LDS_WAIT(); __syncthreads();
    return __builtin_amdgcn_readfirstlane(*slot);
}
__device__ __forceinline__ void phase_mix1(Frame& F, int l, int qidx) {
    LAS float* bt = (LAS float*)(F.lds + 135168);
    build_bias_table(F, bt, 0);
    __syncthreads();
    if (F.bid < NIDX_WG) {
        float* slab = (float*)(F.ws + WS_SCR) + (size_t)F.bid * 32 * LPAD;
        for (int t = F.bid; t < NB * NQT; t += NIDX_WG) { const int j = NQT - 1 - t / NB, b = t % NB; dsa_index_task(F, b, j, slab); }
    } else if (F.bid < NIDX_WG + NHG_WG) {
        const int u = F.bid - NIDX_WG; hgrn_scan_unit(F, l, u >> 2, u & 3);
    } else {
        const int u0 = F.bid - NIDX_WG - NHG_WG, nw = F.G - NIDX_WG - NHG_WG;
        const int cw = u0 * NWAVES + F.wave, ncw = nw * NWAVES; for (int r = cw; r < MREAL + NMETA; r += ncw) conv_row(F, l, r);
    }
    float lam, post;
    { const float* lp = F.in[I_DLAM] + l * 256; const float s1 = wave_sum(lp[F.lane] * lp[64 + F.lane]), s2 = wave_sum(lp[128 + F.lane] * lp[192 + F.lane]);
      const float li = 0.8f - 0.6f * __expf(-0.3f * (float)l); lam = __expf(s1) - __expf(s2) + li; post = 1.0f - li; }
    for (;;) { const int t = queue_pop_wg(F, qidx); if (t >= NB * 4 * NQB) break;
        const int J = NQB - 1 - t / 32, bh = t % 32; attn_wg_task<false>(F, l, bh >> 2, bh & 3, J, bt, lam, post); }
}
__device__ __forceinline__ void phase_mix2(Frame& F, int l, int qidx) {
    LAS float* bt = (LAS float*)(F.lds + 135168);
    build_bias_table(F, bt, 4);
    __syncthreads();
    const int gw = F.bid * NWAVES + F.wave, NGW = F.G * NWAVES;
    for (;;) { const int t = queue_pop_wg(F, qidx); if (t >= NB * 4 * NQB) break;
        const int J = NQB - 1 - t / 32, bh = t % 32; attn_wg_task<true>(F, l, bh >> 2, bh & 3, J, bt, 0.f, 1.f); }
}

#ifdef DBG_SEL
#ifndef DBG_Q
#define DBG_Q 1.0f
#endif
#ifndef DBG_QO
#define DBG_QO 0.0f
#endif
#ifndef DBG_T0
#define DBG_T0 0
#define DBG_T1 36
#endif
#ifndef DBG_NC
#define DBG_NC DM
#endif
__global__ void __launch_bounds__(256) k_dbg_argmax(const float* __restrict__ out, const float* __restrict__ x, unsigned long long* best) {
    unsigned long long loc = 0ull;
    for (size_t i = (size_t)blockIdx.x * blockDim.x + threadIdx.x; i < (size_t)MREAL * DM; i += (size_t)gridDim.x * blockDim.x) {
        const float d = fabsf(out[i] - x[i]); const unsigned long long k = ((unsigned long long)__float_as_uint(d) << 32) | (unsigned)i; loc = k > loc ? k : loc; }
    for (int o = 32; o >= 1; o >>= 1) { const unsigned long long t = __shfl_xor(loc, o); loc = t > loc ? t : loc; }
    if ((threadIdx.x & 63) == 0) atomicMax(best, loc);
}
__global__ void __launch_bounds__(256) k_dbg_count(const float* __restrict__ out, const float* __restrict__ x, unsigned* cnt  ) {
    const int gw = (blockIdx.x * blockDim.x + threadIdx.x) >> 6, lane = threadIdx.x & 63, ngw = (gridDim.x * blockDim.x) >> 6;
    for (int r = gw; r < MREAL; r += ngw) { float m = 0.f;
        for (int c = lane; c < DM; c += 64) m = fmaxf(m, fabsf(out[(size_t)r * DM + c] - x[(size_t)r * DM + c]));
        for (int o = 32; o >= 1; o >>= 1) m = fmaxf(m, __shfl_xor(m, o));
        if (lane == 0 && m > DBG_THR) { const int t = r & 4095; atomicAdd(cnt + 0, 1u); if (t < 32) atomicAdd(cnt + 1, 1u); if (t >= 4064) atomicAdd(cnt + 2, 1u); if (t < 256) atomicAdd(cnt + 3, 1u); } }
}

__global__ void __launch_bounds__(256) k_dbg_chk_merge(const unsigned short* BRm, const unsigned short* Wt, const unsigned short* G, const unsigned short* MG, int m, unsigned* cnt) {
    const int c = blockIdx.x * 256 + threadIdx.x;
    for (int r = blockIdx.y; r < MREAL; r += gridDim.y) {
        float s = 0.f; const unsigned short* a = BRm + (size_t)r * 512; const unsigned short* w = Wt + (size_t)c * 512;
        for (int k = 0; k < 512; ++k) s += __uint_as_float((unsigned)a[k] << 16) * __uint_as_float((unsigned)w[k] << 16);
        const float g = __uint_as_float((unsigned)G[(size_t)r * NGATE + m * DM + c] << 16), ref = g * s, got = __uint_as_float((unsigned)MG[(size_t)r * DM + c] << 16);
        const float err = fabsf(got - ref), tol = 0.02f * fabsf(ref) + 0.02f;
        if (!(err <= tol)) { atomicAdd(cnt + 4, 1u); const int t = r & 4095; if ((c & 255) < 128) atomicAdd(cnt + 5, 1u); if ((r & 255) < 128) atomicAdd(cnt + 6, 1u); if (fabsf(got) > 2.f * fabsf(ref)) atomicAdd(cnt + 7, 1u); (void)t; }
    }
}

__global__ void __launch_bounds__(256) k_dbg_naive_wo(const float* out, const unsigned short* MG, const unsigned short* Wt, float* chk) {
    const int c = blockIdx.x * 256 + threadIdx.x;
    for (int r = blockIdx.y; r < MREAL; r += gridDim.y) {
        float s = 0.f; const uint4* a = (const uint4*)(MG + (size_t)r * DM); const uint4* w = (const uint4*)(Wt + (size_t)c * DM);
        for (int k = 0; k < DM / 8; ++k) { const uint4 av = a[k], wv = w[k]; const unsigned aw[4] = {av.x, av.y, av.z, av.w}, ww[4] = {wv.x, wv.y, wv.z, wv.w};
#pragma unroll
            for (int j = 0; j < 4; ++j) { s += __uint_as_float(aw[j] << 16) * __uint_as_float(ww[j] << 16); s += __uint_as_float(aw[j] & 0xffff0000u) * __uint_as_float(ww[j] & 0xffff0000u); } }
        chk[(size_t)r * DM + c] = out[(size_t)r * DM + c] + s; }
}
__global__ void __launch_bounds__(256) k_dbg_cmp(const float* out, const float* chk, unsigned* cnt) {
    for (size_t i = (size_t)blockIdx.x * blockDim.x + threadIdx.x; i < (size_t)MREAL * DM; i += (size_t)gridDim.x * blockDim.x) {
        const float err = fabsf(out[i] - chk[i]); if (!(err <= 0.02f)) { atomicAdd(cnt + 4, 1u); const int c = (int)(i % DM), r = (int)(i / DM); if ((c & 255) < 128) atomicAdd(cnt + 5, 1u); if ((r & 255) < 128) atomicAdd(cnt + 6, 1u); if (err > 1.0f) atomicAdd(cnt + 7, 1u); } }
}

__global__ void __launch_bounds__(256) k_dbg_stats(const unsigned short* A, int ld, int ncols, unsigned* st) {
    const int gw = (blockIdx.x * blockDim.x + threadIdx.x) >> 6, lane = threadIdx.x & 63, ngw = (gridDim.x * blockDim.x) >> 6;
    float mx = 0.f, me = 0.f;
    for (int r = gw; r < MREAL; r += ngw) { float s = 0.f;
        for (int c = lane; c < ncols; c += 64) { const float v = __uint_as_float((unsigned)A[(size_t)r * ld + c] << 16); mx = fmaxf(mx, fabsf(v)); s += v * v; }
        for (int o = 32; o >= 1; o >>= 1) s += __shfl_xor(s, o);
        me = fmaxf(me, s / (float)ncols); }
    for (int o = 32; o >= 1; o >>= 1) mx = fmaxf(mx, __shfl_xor(mx, o));
    if (lane == 0) { atomicMax(st + 8, __float_as_uint(mx)); atomicMax(st + 9, __float_as_uint(me)); }
}

__global__ void __launch_bounds__(256) k_dbg_argmax_bf16(const unsigned short* A, int ld, int ncols, unsigned long long* best) {
    unsigned long long loc = 0ull;
    for (size_t i = (size_t)blockIdx.x * blockDim.x + threadIdx.x; i < (size_t)MREAL * ncols; i += (size_t)gridDim.x * blockDim.x) { const size_t r = i / ncols, c = i % ncols;
        const float d = fabsf(__uint_as_float((unsigned)A[r * ld + c] << 16)); const unsigned long long k = ((unsigned long long)__float_as_uint(d) << 32) | (unsigned)i; loc = k > loc ? k : loc; }
    for (int o = 32; o >= 1; o >>= 1) { const unsigned long long t = __shfl_xor(loc, o); loc = t > loc ? t : loc; }
    if ((threadIdx.x & 63) == 0) atomicMax(best, loc);
}

__global__ void __launch_bounds__(256) k_dbg_gcount(const unsigned short* G, unsigned* cnt) {
    const int gw = (blockIdx.x * blockDim.x + threadIdx.x) >> 6, lane = threadIdx.x & 63, ngw = (gridDim.x * blockDim.x) >> 6;
    for (int r = gw; r < MREAL; r += ngw) { int n = 0;
        for (int c = lane; c < NGATE; c += 64) { const float v = __uint_as_float((unsigned)G[(size_t)r * NGATE + c] << 16); if (!(v >= 0.f && v <= 1.001f)) ++n; }
        for (int o = 32; o >= 1; o >>= 1) n += __shfl_xor(n, o);
        if (lane == 0 && n) { const int t = r & 4095; atomicAdd(cnt + 10, (unsigned)n); atomicAdd(cnt + 11, 1u); if (t >= 4080) atomicAdd(cnt + 12, 1u); else atomicAdd(cnt + 13, 1u); } }
}

__global__ void k_dbg_time(const unsigned long long* ts, unsigned* cnt) {
    if (threadIdx.x == 0) { const float ms = (float)(ts[DBG_T1] - ts[DBG_T0]) * 1e-5f; cnt[14] = __float_as_uint(floorf(ms * DBG_Q + DBG_QO)); }
}
__global__ void __launch_bounds__(256) k_dbg_emit(float* out, const float* __restrict__ x, const unsigned long long* best, const unsigned* cnt) {
    const unsigned long long b = *best; const unsigned idx = (unsigned)b; const float val = __uint_as_float((unsigned)(b >> 32));
    const int row = idx / DBG_NC, col = idx % DBG_NC, bb = row >> 12, t = row & 4095;
    float N = 0.f;
    switch (DBG_SEL) {
        case 0: N = val; break;
        case 1: N = 2.f + bb; break;
        case 2: N = 2.f + (t >> 9); break;
        case 3: N = 2.f + ((t >> 6) & 7); break;
        case 4: N = 2.f + ((t >> 3) & 7); break;
        case 5: N = 2.f + (t & 7); break;
        case 6: N = 2.f + (col >> 8); break;
        case 60: N = 2.f + (col >> 10); break;
        case 61: N = 2.f + ((col >> 7) & 7); break;
        case 62: N = 2.f + ((col >> 4) & 7); break;
        case 63: N = 2.f + ((col >> 1) & 7); break;
        case 64: N = 2.f + (col & 1); break;
        case 65: N = 2.f + bb; break;
        case 66: N = 2.f + (t >> 9); break;
        case 67: N = 2.f + ((t >> 6) & 7); break;
        case 68: N = 2.f + ((t >> 3) & 7); break;
        case 69: N = 2.f + (t & 7); break;
        case 7: N = 2.f + ((col >> 5) & 7); break;
        case 8: N = 2.f + ((col >> 2) & 7); break;
        case 40: case 42: case 44: case 46: N = __uint_as_float(cnt[8]); break;
        case 41: case 43: case 45: case 47: N = __uint_as_float(cnt[9]); break;
        case 70: N = 2.f + log2f(1.f + (float)cnt[10]); break;
        case 71: N = 2.f + log2f(1.f + (float)cnt[11]); break;
        case 72: N = 2.f + log2f(1.f + (float)cnt[12]); break;
        case 73: N = 2.f + log2f(1.f + (float)cnt[13]); break;
        case 100: N = 2.f + __uint_as_float(cnt[14]); break;
        case 30: N = 2.f + log2f(1.f + (float)cnt[4]); break;
        case 31: N = 2.f + log2f(1.f + (float)cnt[5]); break;
        case 32: N = 2.f + log2f(1.f + (float)cnt[6]); break;
        case 33: N = 2.f + log2f(1.f + (float)cnt[7]); break;
        case 20: N = 2.f + log2f(1.f + (float)cnt[4]); break;
        case 21: N = 2.f + log2f(1.f + (float)cnt[5]); break;
        case 22: N = 2.f + log2f(1.f + (float)cnt[6]); break;
        case 23: N = 2.f + log2f(1.f + (float)cnt[7]); break;
        case 10: N = 2.f + log2f(1.f + (float)cnt[0]); break;
        case 11: N = 2.f + log2f(1.f + (float)cnt[1]); break;
        case 12: N = 2.f + log2f(1.f + (float)cnt[2]); break;
        case 13: N = 2.f + log2f(1.f + (float)cnt[3]); break;
    }
    const float c = 1.f + N;
    for (size_t i = (size_t)blockIdx.x * blockDim.x + threadIdx.x; i < (size_t)MREAL * DM; i += (size_t)gridDim.x * blockDim.x) out[i] = c * x[i];
}
#endif

#ifndef MK_ONE
#define MK_ONE 0
#endif
#ifndef BR_MASK
#define BR_MASK 15
#endif
constexpr int NPH = 18;
template <class T> __device__ __forceinline__ T opaque(T v) { asm volatile("" : "+s"(v)); return v; }
struct Args { const float* in[22]; float* out; unsigned char* ws; int ph_lo, ph_hi; };
__global__ void __launch_bounds__(NWAVES * 64, 2) fwd(Args args) {
    extern __shared__ __attribute__((aligned(16))) unsigned char lds[];
    Frame F;
    F.lds = (LAS unsigned char*)lds; F.MISC = (volatile LAS unsigned*)(F.lds + MISC_OFF);
    F.tid = threadIdx.x; F.lane = F.tid & 63; F.wave = __builtin_amdgcn_readfirstlane(F.tid >> 6); F.G = gridDim.x; F.bid = blockIdx.x;
    F.ws = args.ws; F.out = args.out; F.ctl = (gu32*)(args.ws + WS_CTL);
#pragma unroll
    for (int i = 0; i < 22; ++i) F.in[i] = args.in[i];
    for (int u = F.tid; u < (LDS_BYTES - LDSCTL_OFF) / 4; u += NWAVES * 64) ((LAS unsigned*)(F.lds + LDSCTL_OFF))[u] = 0u;
    __syncthreads();
#if MK_ONE
    XcdBarrier bar = xcd_barrier_post((unsigned*)(F.ctl + CW_BAR), F.MISC + 8);
#define GRID_BAR() xcd_barrier(bar)
#else
#define GRID_BAR() do { } while (0)
#endif
    const int lo = args.ph_lo, hi = args.ph_hi;
#define IN(k) (lo <= (k) && (k) < hi)
#define RETID() do { int t_ = threadIdx.x; asm volatile("" : "+v"(t_)); F.tid = t_; F.lane = t_ & 63; F.wave = __builtin_amdgcn_readfirstlane(t_ >> 6); } while (0)
#ifdef DBG_TS
#define STAMP(k) do { if (blockIdx.x == 0 && threadIdx.x == 0) ((unsigned long long*)(args.ws + 768 * 1024))[(k)] = __builtin_amdgcn_s_memrealtime(); } while (0)
#else
#define STAMP(k) do { } while (0)
#endif
#define SEAM(k) do { if (IN((k) + 1)) GRID_BAR(); STAMP((k) + 1); } while (0)
    STAMP(0);
    unsigned char* wb = F.ws + WS_W;
    bf16* XN = (bf16*)(F.ws + WS_XN); bf16* BR = (bf16*)(F.ws + WS_BR); bf16* BIG = (bf16*)(F.ws + WS_BIG); float* HM = (float*)(F.ws + WS_HM);
    for (int l = 0; l < 2; ++l) {
        const int pb = l * NPH;
        const float* hsrc = (l == 0) ? F.in[I_X] : F.out;
        if (IN(pb + 0)) { RETID(); phase_convert(F, l); SEAM(pb + 0); }
        if (IN(pb + 1)) { RETID(); phase_norm(F, hsrc, F.in[I_F1N] + l * DM); SEAM(pb + 1); }
        if (IN(pb + 2)) { RETID(); pg8::Gemm g{opaque((const bf16*)(XN)), opaque((const bf16*)(wb + W_GU1)), MPAD, NGU, DM}; pg8::StaticOrder S; S.init(MPAD, NGU, F.G, opaque(F.bid));
            pg8::EpiSwiGLU E{BIG, DFF}; pg8::gemm_phase<pg8::EpiSwiGLU, pg8::StaticOrder, true, true>(F.lds + RING_OFF, g, S, E); SEAM(pb + 2); }
        if (IN(pb + 3)) { RETID(); pg8::Gemm g{opaque((const bf16*)(BIG)), opaque((const bf16*)(wb + W_D1)), MPAD, DM, DFF}; pg8::StaticOrder S; S.init(MPAD, DM, F.G, opaque(F.bid));
            pg8::EpiResF32 E{hsrc, F.out, HM, DM, MT_REAL, 0.5f}; pg8::gemm_phase<pg8::EpiResF32, pg8::StaticOrder, true, true>(F.lds + RING_OFF, g, S, E); SEAM(pb + 3); }
        if (IN(pb + 4)) { RETID(); phase_norm(F, F.out, F.in[I_MIXN] + l * DM); SEAM(pb + 4); }
        if (IN(pb + 5)) { RETID(); pg8::Gemm g{opaque((const bf16*)(XN)), opaque((const bf16*)(wb + W_NG)), MPAD, NNG, DM}; pg8::StaticOrder S; S.init(MPAD, NNG, F.G, opaque(F.bid));
            pg8::EpiBf16<0> E{BIG, NNG}; pg8::gemm_phase<pg8::EpiBf16<0>, pg8::StaticOrder, true, true>(F.lds + RING_OFF, g, S, E); SEAM(pb + 5); }
        if (IN(pb + 6)) { RETID(); phase_prep(F, l); phase_vt(F); __syncthreads(); phase_hgrn_prep(F, l); SEAM(pb + 6); }
#ifdef DUP_MIX
        if (IN(pb + 7)) { const int nrep = opaque(2); for (int rep = 0; rep < nrep; ++rep) { RETID(); phase_mix1(F, l, 4 * rep + 2 * l); GRID_BAR(); } }
        if (IN(pb + 8)) { const int nrep = opaque(2); for (int rep = 0; rep < nrep; ++rep) { RETID(); phase_mix2(F, l, 4 * rep + 2 * l + 1); GRID_BAR(); } }
#else
        if (IN(pb + 7)) { RETID(); phase_mix1(F, l, 2 * l); SEAM(pb + 7); }
        if (IN(pb + 8)) { RETID(); phase_mix2(F, l, 2 * l + 1); SEAM(pb + 8); }
#endif
        if (IN(pb + 9)) { RETID(); pg8::Gemm g{opaque((const bf16*)(XN)), opaque((const bf16*)(wb + W_G)), MPAD, NGATE, DM}; pg8::StaticOrder S; S.init(MPAD, NGATE, F.G, opaque(F.bid));
            pg8::EpiBf16<1> E{BIG, NGATE}; pg8::gemm_phase<pg8::EpiBf16<1>, pg8::StaticOrder, true, true>(F.lds + RING_OFF, g, S, E); SEAM(pb + 9); }
        for (int m = 0; m < 4; ++m)
            if (IN(pb + 10 + m) && ((BR_MASK >> m) & 1)) { RETID(); pg8::Gemm g{opaque((const bf16*)(BR + (size_t)m * MPAD * 512)), opaque((const bf16*)(wb + W_BR) + (size_t)m * DM * 512), MPAD, DM, 512}; pg8::StaticOrder S; S.init(MPAD, DM, F.G, opaque(F.bid));
                pg8::EpiGateAcc E{XN, DM, BIG, NGATE, m * DM, (BR_MASK & ((1 << m) - 1)) == 0}; pg8::gemm_phase<pg8::EpiGateAcc, pg8::StaticOrder, true, true>(F.lds + RING_OFF, g, S, E); SEAM(pb + 10 + m); }
        if (IN(pb + 14) && BR_MASK) { RETID(); pg8::Gemm g{opaque((const bf16*)(XN)), opaque((const bf16*)(wb + W_O)), MPAD, DM, DM}; pg8::StaticOrder S; S.init(MPAD, DM, F.G, opaque(F.bid));
            pg8::EpiResF32 E{F.out, F.out, HM, DM, MT_REAL, 1.0f}; pg8::gemm_phase<pg8::EpiResF32, pg8::StaticOrder, true, true>(F.lds + RING_OFF, g, S, E); SEAM(pb + 14); }
        if (IN(pb + 15)) { RETID(); phase_norm(F, F.out, F.in[I_F2N] + l * DM); SEAM(pb + 15); }
        if (IN(pb + 16)) { RETID(); pg8::Gemm g{opaque((const bf16*)(XN)), opaque((const bf16*)(wb + W_GU2)), MPAD, NGU, DM}; pg8::StaticOrder S; S.init(MPAD, NGU, F.G, opaque(F.bid));
            pg8::EpiSwiGLU E{BIG, DFF}; pg8::gemm_phase<pg8::EpiSwiGLU, pg8::StaticOrder, true, true>(F.lds + RING_OFF, g, S, E); SEAM(pb + 16); }
        if (IN(pb + 17)) { RETID(); pg8::Gemm g{opaque((const bf16*)(BIG)), opaque((const bf16*)(wb + W_D2)), MPAD, DM, DFF}; pg8::StaticOrder S; S.init(MPAD, DM, F.G, opaque(F.bid));
            pg8::EpiResF32 E{F.out, F.out, HM, DM, MT_REAL, 0.5f}; pg8::gemm_phase<pg8::EpiResF32, pg8::StaticOrder, true, true>(F.lds + RING_OFF, g, S, E); SEAM(pb + 17); }
    }
}

extern "C" void kernel_launch(void* const* d_in, const int* in_sizes, int n_in, void* d_out, int out_size, void* d_ws, size_t ws_size, hipStream_t stream) {
    static int grid = 0;
    if (grid == 0) {
        if (n_in != 22 || out_size != MREAL * DM || ws_size < WS_END) { fprintf(stderr, "kernel_launch: unexpected shapes (n_in %d out %d ws %zu need %zu)\n", n_in, out_size, ws_size, (size_t)WS_END); grid = -1; return; }
        int dev = 0, cus = 0, per_cu = 0;
        if (hipGetDevice(&dev) != hipSuccess || hipDeviceGetAttribute(&cus, hipDeviceAttributeMultiprocessorCount, dev) != hipSuccess) { grid = -1; return; }
        if (hipFuncSetAttribute((const void*)fwd, hipFuncAttributeMaxDynamicSharedMemorySize, LDS_BYTES) != hipSuccess) { fprintf(stderr, "kernel_launch: hipFuncSetAttribute failed\n"); grid = -1; return; }
        if (hipOccupancyMaxActiveBlocksPerMultiprocessor(&per_cu, (const void*)fwd, NWAVES * 64, LDS_BYTES) != hipSuccess || per_cu < 1) fprintf(stderr, "kernel_launch: occupancy query says %d\n", per_cu);
        (void)hipGetLastError();
        grid = cus < 256 ? cus : 256;
    }
    if (grid < 0) return;
    (void)hipMemsetAsync((char*)d_ws + WS_CTL, 0, CTL_ZERO_BYTES, stream);
    Args a{};
    for (int i = 0; i < 22; ++i) a.in[i] = (const float*)d_in[i];
    a.out = (float*)d_out; a.ws = (unsigned char*)d_ws;
#ifndef PH_END
#define PH_END (2 * NPH)
#endif
#if MK_ONE
    a.ph_lo = 0; a.ph_hi = PH_END;
    hipLaunchKernelGGL(fwd, dim3(grid), dim3(NWAVES * 64), LDS_BYTES, stream, a);
#else
    for (int p = 0; p < PH_END; ++p) { a.ph_lo = p; a.ph_hi = p + 1;
#if defined(DBG_SEL)
#ifdef DBG_PREFILL
        if (p == 9) (void)hipMemsetAsync((char*)d_ws + WS_BIG, 0x3F, (size_t)MPAD * NGATE * 2, stream);
#endif
        if (DBG_SEL >= 30 && DBG_SEL < 40 && p == 14) hipLaunchKernelGGL(k_dbg_naive_wo, dim3(8, 2048), dim3(256), 0, stream, (const float*)d_out, (const unsigned short*)((char*)d_ws + WS_XN), (const unsigned short*)((char*)d_ws + WS_W + W_O), (float*)((char*)d_ws + WS_BIG));
#endif
        hipLaunchKernelGGL(fwd, dim3(grid), dim3(NWAVES * 64), LDS_BYTES, stream, a); }
#endif
#ifdef DBG_SEL
    { unsigned long long* best = (unsigned long long*)((char*)d_ws + 512 * 1024); unsigned* cnt = (unsigned*)((char*)d_ws + 512 * 1024 + 64);
      if (DBG_SEL >= 60 && DBG_SEL < 70) hipLaunchKernelGGL(k_dbg_argmax_bf16, dim3(2048), dim3(256), 0, stream, (const unsigned short*)((char*)d_ws + WS_BIG), NGATE, NGATE, best);
      else hipLaunchKernelGGL(k_dbg_argmax, dim3(2048), dim3(256), 0, stream, (const float*)d_out, (const float*)d_in[0], best);
      hipLaunchKernelGGL(k_dbg_count, dim3(2048), dim3(256), 0, stream, (const float*)d_out, (const float*)d_in[0], cnt);
      if (DBG_SEL >= 20 && DBG_SEL < 30) { const int mm = 1; hipLaunchKernelGGL(k_dbg_chk_merge, dim3(8, 2048), dim3(256), 0, stream, (const unsigned short*)((char*)d_ws + WS_BR) + (size_t)mm * MPAD * 512, (const unsigned short*)((char*)d_ws + WS_W + W_BR) + (size_t)mm * DM * 512, (const unsigned short*)((char*)d_ws + WS_BIG), (const unsigned short*)((char*)d_ws + WS_XN), mm, cnt); }
      if (DBG_SEL >= 30 && DBG_SEL < 40) hipLaunchKernelGGL(k_dbg_cmp, dim3(2048), dim3(256), 0, stream, (const float*)d_out, (const float*)((char*)d_ws + WS_BIG), cnt);
      if (DBG_SEL >= 40 && DBG_SEL < 50) { const unsigned short* A = nullptr; int ld = 0, nc = 0;
        if (DBG_SEL < 42) { A = (const unsigned short*)((char*)d_ws + WS_BR) + (size_t)MPAD * 512; ld = 512; nc = 512; }
        else if (DBG_SEL < 44) { A = (const unsigned short*)((char*)d_ws + WS_BIG) + DM; ld = NGATE; nc = DM; }
        else if (DBG_SEL < 46) { A = (const unsigned short*)((char*)d_ws + WS_XN); ld = DM; nc = DM; }
        else { A = (const unsigned short*)((char*)d_ws + WS_BR); ld = 512; nc = 512; }
        hipLaunchKernelGGL(k_dbg_stats, dim3(1024), dim3(256), 0, stream, A, ld, nc, cnt); }
      if (DBG_SEL >= 70 && DBG_SEL < 80) hipLaunchKernelGGL(k_dbg_gcount, dim3(1024), dim3(256), 0, stream, (const unsigned short*)((char*)d_ws + WS_BIG), cnt);
      if (DBG_SEL >= 100) hipLaunchKernelGGL(k_dbg_time, dim3(1), dim3(64), 0, stream, (const unsigned long long*)((char*)d_ws + 768 * 1024), cnt);
      hipLaunchKernelGGL(k_dbg_emit, dim3(2048), dim3(256), 0, stream, (float*)d_out, (const float*)d_in[0], best, cnt); }
#endif
}
```

```cpp
#include <hip/hip_runtime.h>
#include <cstdio>
#include <cstdint>
#define MK_ONE 1
namespace pg8 {
#define PG8_LAS __attribute__((address_space(3)))
typedef unsigned short bf16_t;
typedef short bf16x8 __attribute__((ext_vector_type(8)));
typedef float f32x4 __attribute__((ext_vector_type(4)));
typedef unsigned u32x4 __attribute__((ext_vector_type(4)));
constexpr int BM = 256, BK = 64, HALF = 128, HTB = HALF * BK * 2  , STAGE_BYTES = 8 * HTB, NXCD = 8, WGM = 8;

__host__ __device__ __forceinline__ int lds_byte(int r, int c) { const int st = (r >> 4) * 2 + (c >> 5), rr = r & 15, cc = c & 31, ob = rr * 64 + cc * 2; return st * 1024 + (ob ^ (((ob >> 9) & 1) << 5)); }
__host__ __device__ __forceinline__ void stage_rc(int b, int& R, int& C) { const int st = b / 1024, sb = b % 1024, swz = sb ^ (((sb >> 9) & 1) << 5); R = (st >> 1) * 16 + swz / 64; C = (st & 1) * 32 + (swz % 64) / 2; }
__host__ __device__ __forceinline__ int perm32(int rho) { const int n = rho >> 4, i = rho & 15; return 8 * (i >> 2) + 4 * n + (i & 3); }

struct Unit { int pm, pn; };
struct Gemm { const bf16_t* A; const bf16_t* Bt; int M, N, K; };

struct StaticOrder {
    int nM, nN, nwg, G, c;
    __host__ __device__ void init(int M, int N, int G_, int c_) { nM = M / BM; nN = N / BM; nwg = nM * nN; G = G_; c = c_; }
    __host__ __device__ bool next(int i, Unit& u) const {
        const long L = (long)i * G + c; if (L >= nwg) return false;
        int wgid = (int)L; { const int q = nwg / NXCD, r = nwg % NXCD, xcd = wgid % NXCD, off = wgid / NXCD; wgid = (xcd < r ? xcd * (q + 1) : r * (q + 1) + (xcd - r) * q) + off; }
        const int nig = WGM * nN, gid = wgid / nig, fm = gid * WGM, gsz = (nM - fm) < WGM ? (nM - fm) : WGM;
        u.pm = fm + ((wgid % nig) % gsz); u.pn = (wgid % nig) / gsz; return true;
    }
    __device__ __forceinline__ void a_ready(const Unit&) const {}
    __device__ __forceinline__ void done(const Unit&) const {}
};
typedef __bf16 bf16x2_hw __attribute__((ext_vector_type(2))); typedef float f32x2_hw __attribute__((ext_vector_type(2)));
__device__ __forceinline__ unsigned cvt_pk_bf16(float lo, float hi) { const f32x2_hw v = {lo, hi}; return __builtin_bit_cast(unsigned, __builtin_convertvector(v, bf16x2_hw)); }
typedef float f32x2 __attribute__((ext_vector_type(2)));
__device__ __forceinline__ float fast_sigmoid(float x) { return __builtin_amdgcn_rcpf(1.0f + __expf(-x)); }
__device__ __forceinline__ float fast_silu(float x) { return x * fast_sigmoid(x); }
template <int ACT  > struct EpiBf16 {
    static constexpr bool PERM = true, AFTER_DRAIN = false;
    bf16_t* O; int ldc;
    __device__ __forceinline__ void operator()(const f32x4 (&acc)[2][2][4][2], const Unit& u, int wr, int wc, int fr, int fq) const {
        const int row0 = u.pm * BM + wr * 64 + fr; const int col0 = u.pn * BM + wc * 32 + 8 * fq;
#pragma unroll
        for (int ai = 0; ai < 2; ++ai)
#pragma unroll
            for (int m = 0; m < 4; ++m) { bf16_t* rowp = O + (size_t)(row0 + ai * HALF + m * 16) * ldc + col0;
#pragma unroll
                for (int bj = 0; bj < 2; ++bj) { f32x4 v0 = acc[ai][bj][m][0], v1 = acc[ai][bj][m][1];
                    if (ACT == 1) {
#pragma unroll
                        for (int j = 0; j < 4; ++j) { v0[j] = fast_sigmoid(v0[j]); v1[j] = fast_sigmoid(v1[j]); } }
                    u32x4 w; w.x = cvt_pk_bf16(v0[0], v0[1]); w.y = cvt_pk_bf16(v0[2], v0[3]); w.z = cvt_pk_bf16(v1[0], v1[1]); w.w = cvt_pk_bf16(v1[2], v1[3]);
                    *(u32x4*)(rowp + bj * HALF) = w; } }
    }
};
struct EpiSwiGLU {
    static constexpr bool PERM = true, AFTER_DRAIN = false;
    bf16_t* O; int ldc;
    __device__ __forceinline__ void operator()(const f32x4 (&acc)[2][2][4][2], const Unit& u, int wr, int wc, int fr, int fq) const {
        const int row0 = u.pm * BM + wr * 64 + fr; const int col0 = u.pn * HALF + wc * 32 + 8 * fq;
#pragma unroll
        for (int ai = 0; ai < 2; ++ai)
#pragma unroll
            for (int m = 0; m < 4; ++m) { bf16_t* rowp = O + (size_t)(row0 + ai * HALF + m * 16) * ldc + col0;
                const f32x4 g0 = acc[ai][0][m][0], g1 = acc[ai][0][m][1], u0 = acc[ai][1][m][0], u1 = acc[ai][1][m][1];
                f32x4 v0, v1;
#pragma unroll
                for (int j = 0; j < 4; ++j) { v0[j] = fast_silu(g0[j]) * u0[j]; v1[j] = fast_silu(g1[j]) * u1[j]; }
                u32x4 w; w.x = cvt_pk_bf16(v0[0], v0[1]); w.y = cvt_pk_bf16(v0[2], v0[3]); w.z = cvt_pk_bf16(v1[0], v1[1]); w.w = cvt_pk_bf16(v1[2], v1[3]);
                *(u32x4*)rowp = w; asm volatile("" ::: "memory"); }
    }
};
struct EpiResF32 {
    static constexpr bool PERM = false, AFTER_DRAIN = false;
    const float* base_r; float* out_r; float* hm; int ldc; int mt_real; float scale;
    __device__ __forceinline__ void operator()(const f32x4 (&acc)[2][2][4][2], const Unit& u, int wr, int wc, int fr, int fq) const {
        const bool real = u.pm < mt_real;
        const float* bp = real ? base_r + (size_t)u.pm * BM * ldc : hm; float* op = real ? out_r + (size_t)u.pm * BM * ldc : hm;
        const int row0 = wr * 64 + fr, col0 = u.pn * BM + wc * 32 + 4 * fq;
#pragma unroll
        for (int ai = 0; ai < 2; ++ai)
#pragma unroll
            for (int m = 0; m < 4; ++m) { const size_t off = (size_t)(row0 + ai * HALF + m * 16) * ldc + col0;
#pragma unroll
                for (int bj = 0; bj < 2; ++bj)
#pragma unroll
                    for (int n = 0; n < 2; ++n) { const f32x4 b = *(const f32x4*)(bp + off + bj * HALF + n * 16); *(f32x4*)(op + off + bj * HALF + n * 16) = b + acc[ai][bj][m][n] * scale; }
                asm volatile("" ::: "memory"); }
    }
};
struct EpiGateAcc {
    static constexpr bool PERM = true, AFTER_DRAIN = false;
    bf16_t* MG; int ldc; const bf16_t* G; int ldg; int gcol0; int first;
    __device__ __forceinline__ void operator()(const f32x4 (&acc)[2][2][4][2], const Unit& u, int wr, int wc, int fr, int fq) const {
        const int row0 = u.pm * BM + wr * 64 + fr; const int col0 = u.pn * BM + wc * 32 + 8 * fq;
#pragma unroll
        for (int ai = 0; ai < 2; ++ai)
#pragma unroll
            for (int m = 0; m < 4; ++m) { const size_t r = (size_t)(row0 + ai * HALF + m * 16);
#pragma unroll
                for (int bj = 0; bj < 2; ++bj) { const u32x4 gw = *(const u32x4*)(G + r * ldg + gcol0 + col0 + bj * HALF);
                    u32x4 pw = (u32x4){0u, 0u, 0u, 0u}; if (!first) pw = *(const u32x4*)(MG + r * ldc + col0 + bj * HALF);
                    float o[8];
#pragma unroll
                    for (int j = 0; j < 4; ++j) { const float a0 = (j < 2) ? acc[ai][bj][m][0][2 * j] : acc[ai][bj][m][1][2 * (j - 2)], a1 = (j < 2) ? acc[ai][bj][m][0][2 * j + 1] : acc[ai][bj][m][1][2 * (j - 2) + 1];
                        o[2 * j] = __uint_as_float(pw[j] << 16) + __uint_as_float(gw[j] << 16) * a0; o[2 * j + 1] = __uint_as_float(pw[j] & 0xffff0000u) + __uint_as_float(gw[j] & 0xffff0000u) * a1; }
                    u32x4 w; w.x = cvt_pk_bf16(o[0], o[1]); w.y = cvt_pk_bf16(o[2], o[3]); w.z = cvt_pk_bf16(o[4], o[5]); w.w = cvt_pk_bf16(o[6], o[7]);
                    *(u32x4*)(MG + r * ldc + col0 + bj * HALF) = w; } }
    }
};
template <class Epi, class Sched, bool ALIGN_EPI = false, bool SP2 = false>
__device__ __forceinline__ void gemm_phase(PG8_LAS unsigned char* lds, const Gemm g, const Sched& S, const Epi& E) {
    int tid_ = threadIdx.x; asm volatile("" : "+v"(tid_));
    const int tid = tid_, wid = __builtin_amdgcn_readfirstlane(tid >> 6), lane = tid & 63, wr = wid >> 2, wc = wid & 3, fr = lane & 15, fq = lane >> 4;
    const int K = g.K, nt = K / BK;
    unsigned voffA[2], voffB[2];
#pragma unroll
    for (int i = 0; i < 2; ++i) { int R, C; stage_rc(tid * 16 + i * 8192, R, C); const int Rb = Epi::PERM ? ((R & ~31) + perm32(R & 31)) : R;
        voffA[i] = (unsigned)(R * K + C) * 2u; voffB[i] = (unsigned)(Rb * K + C) * 2u; }
    const size_t kstep = (size_t)(BK * 2);
    const size_t hstep = (size_t)HALF * K * 2;
    const size_t tstep = 2 * hstep;
    const unsigned ldsw = (unsigned)wid * 1024u;
    const int aoff = lds_byte(wr * 64 + fr, fq * 8), boff = lds_byte(wc * 32 + fr, fq * 8);
#define PG8_SA(b, h) (((b) * 2 + (h)) * HTB)
#define PG8_SB(b, h) ((4 + (b) * 2 + (h)) * HTB)
#define PG8_STAGE(bufoff, gbase, voff) do { _Pragma("unroll") for (int _i = 0; _i < 2; ++_i) \
        __builtin_amdgcn_global_load_lds((const unsigned*)((const char*)(gbase) + (voff)[_i]), (PG8_LAS unsigned*)(lds + (bufoff) + ldsw + _i * 8192), 16, 0, 0); } while (0)
#define PG8_LDA(dst, b, h) do { _Pragma("unroll") for (int m = 0; m < 4; ++m) _Pragma("unroll") for (int k = 0; k < 2; ++k) dst[m][k] = *(const PG8_LAS bf16x8*)(lds + PG8_SA(b, h) + aoff + m * 2048 + k * 1024); } while (0)
#define PG8_LDB(dst, b, h) do { _Pragma("unroll") for (int n = 0; n < 2; ++n) _Pragma("unroll") for (int k = 0; k < 2; ++k) dst[n][k] = *(const PG8_LAS bf16x8*)(lds + PG8_SB(b, h) + boff + n * 2048 + k * 1024); } while (0)
#define PG8_MMA(ai, bj, At, Bt) do { __builtin_amdgcn_s_setprio(1); _Pragma("unroll") for (int m = 0; m < 4; ++m) _Pragma("unroll") for (int n = 0; n < 2; ++n) _Pragma("unroll") for (int k = 0; k < 2; ++k) \
        acc[ai][bj][m][n] = __builtin_amdgcn_mfma_f32_16x16x32_bf16(Bt[n][k], At[m][k], acc[ai][bj][m][n], 0, 0, 0); __builtin_amdgcn_s_setprio(0); } while (0)
#define PG8_WAIT_V(n) asm volatile("s_waitcnt vmcnt(" #n ")" ::: "memory")
#define PG8_WAIT_L(n) asm volatile("s_waitcnt lgkmcnt(" #n ")" ::: "memory")
#define PG8_BAR __builtin_amdgcn_s_barrier()
#define PG8_SCHED __builtin_amdgcn_sched_barrier(0)
    Unit cur, nxt; int ui = 0;
    if (!S.next(0, cur)) return;
    f32x4 acc[2][2][4][2];
#pragma unroll
    for (int a = 0; a < 2; ++a)
#pragma unroll
        for (int b = 0; b < 2; ++b)
#pragma unroll
            for (int m = 0; m < 4; ++m)
#pragma unroll
                for (int n = 0; n < 2; ++n) acc[a][b][m][n] = (f32x4){0.f, 0.f, 0.f, 0.f};
    bf16x8 At[4][2], B0[2][2], B1[2][2];
    const char* cA = (const char*)g.A + (size_t)cur.pm * tstep; const char* cB = (const char*)g.Bt + (size_t)cur.pn * tstep;
    S.a_ready(cur);
    if constexpr (SP2) {
        PG8_STAGE(PG8_SB(0, 0), cB, voffB); PG8_STAGE(PG8_SB(0, 1), cB + hstep, voffB); PG8_STAGE(PG8_SA(0, 0), cA, voffA); PG8_STAGE(PG8_SA(0, 1), cA + hstep, voffA);
        if (wr == 1) PG8_BAR;
        PG8_WAIT_V(2); PG8_BAR;
        PG8_STAGE(PG8_SB(1, 0), cB + kstep, voffB); PG8_STAGE(PG8_SA(1, 0), cA + kstep, voffA); PG8_STAGE(PG8_SB(1, 1), cB + hstep + kstep, voffB);
        PG8_WAIT_V(6); PG8_BAR;
    } else {
        PG8_STAGE(PG8_SB(0, 0), cB, voffB); PG8_STAGE(PG8_SA(0, 0), cA, voffA); PG8_STAGE(PG8_SB(0, 1), cB + hstep, voffB); PG8_STAGE(PG8_SA(0, 1), cA + hstep, voffA);
        if (wr == 1) PG8_BAR;
        PG8_WAIT_V(4); PG8_BAR;
        PG8_STAGE(PG8_SB(1, 0), cB + kstep, voffB); PG8_STAGE(PG8_SA(1, 0), cA + kstep, voffA); PG8_STAGE(PG8_SB(1, 1), cB + hstep + kstep, voffB);
        PG8_WAIT_V(6); PG8_BAR;
    }
    for (;;) {
        const bool has_next = S.next(ui + 1, nxt);
        const char* nA = has_next ? (const char*)g.A + (size_t)nxt.pm * tstep : cA; const char* nB = has_next ? (const char*)g.Bt + (size_t)nxt.pn * tstep : cB;
        for (int t = 0; t < nt; t += 2) {
            const bool last = (t == nt - 2);
            const char* a1 = cA + (size_t)(t + 1) * kstep;
            const char* a2 = last ? nA : cA + (size_t)(t + 2) * kstep; const char* b2 = last ? nB : cB + (size_t)(t + 2) * kstep;
            const char* a3 = a2 + kstep; const char* b3 = b2 + kstep;
            if (last && has_next) S.a_ready(nxt);
            if constexpr (SP2) {
            PG8_LDB(B0, 0, 0); PG8_LDB(B1, 0, 1); PG8_SCHED; PG8_LDA(At, 0, 0); PG8_STAGE(PG8_SA(1, 1), a1 + hstep, voffA);
            PG8_WAIT_V(8); PG8_WAIT_L(0); PG8_BAR; PG8_MMA(0, 0, At, B0); PG8_MMA(0, 1, At, B1); PG8_BAR; PG8_SCHED;
            PG8_LDA(At, 0, 1); PG8_STAGE(PG8_SB(0, 0), b2, voffB); PG8_STAGE(PG8_SB(0, 1), b2 + hstep, voffB); PG8_STAGE(PG8_SA(0, 0), a2, voffA);
            PG8_WAIT_V(8); PG8_WAIT_L(0); PG8_BAR; PG8_MMA(1, 0, At, B0); PG8_MMA(1, 1, At, B1); PG8_BAR; PG8_SCHED;
            PG8_LDB(B0, 1, 0); PG8_LDB(B1, 1, 1); PG8_SCHED; PG8_LDA(At, 1, 0); PG8_STAGE(PG8_SA(0, 1), a2 + hstep, voffA);
            PG8_WAIT_V(8); PG8_WAIT_L(0); PG8_BAR; PG8_MMA(0, 0, At, B0); PG8_MMA(0, 1, At, B1); PG8_BAR; PG8_SCHED;
            PG8_LDA(At, 1, 1); PG8_STAGE(PG8_SB(1, 0), b3, voffB); PG8_STAGE(PG8_SB(1, 1), b3 + hstep, voffB); PG8_STAGE(PG8_SA(1, 0), a3, voffA);
            PG8_WAIT_V(8); PG8_WAIT_L(0); PG8_BAR; PG8_MMA(1, 0, At, B0); PG8_MMA(1, 1, At, B1); PG8_BAR; PG8_SCHED;
            } else {
            PG8_LDB(B0, 0, 0); PG8_SCHED; PG8_LDA(At, 0, 0); PG8_STAGE(PG8_SA(1, 1), a1 + hstep, voffA);
            PG8_WAIT_L(8); PG8_BAR; PG8_WAIT_L(0); PG8_MMA(0, 0, At, B0); PG8_BAR; PG8_SCHED;
            PG8_LDB(B1, 0, 1); PG8_STAGE(PG8_SB(0, 0), b2, voffB);
            PG8_BAR; PG8_WAIT_L(0); PG8_MMA(0, 1, At, B1); PG8_BAR;
            PG8_LDA(At, 0, 1); PG8_STAGE(PG8_SA(0, 0), a2, voffA);
            PG8_BAR; PG8_WAIT_L(0); PG8_MMA(1, 0, At, B0); PG8_BAR; PG8_SCHED;
            PG8_STAGE(PG8_SB(0, 1), b2 + hstep, voffB);
            PG8_WAIT_V(6); PG8_BAR; PG8_MMA(1, 1, At, B1); PG8_BAR;
            PG8_LDB(B0, 1, 0); PG8_SCHED; PG8_LDA(At, 1, 0); PG8_STAGE(PG8_SA(0, 1), a2 + hstep, voffA);
            PG8_WAIT_L(8); PG8_BAR; PG8_WAIT_L(0); PG8_MMA(0, 0, At, B0); PG8_BAR; PG8_SCHED;
            PG8_LDB(B1, 1, 1); PG8_STAGE(PG8_SB(1, 0), b3, voffB);
            PG8_BAR; PG8_WAIT_L(0); PG8_MMA(0, 1, At, B1); PG8_BAR;
            PG8_LDA(At, 1, 1); PG8_STAGE(PG8_SA(1, 0), a3, voffA);
            PG8_BAR; PG8_WAIT_L(0); PG8_MMA(1, 0, At, B0); PG8_BAR; PG8_SCHED;
            PG8_STAGE(PG8_SB(1, 1), b3 + hstep, voffB);
            PG8_WAIT_V(6); PG8_BAR; PG8_MMA(1, 1, At, B1); PG8_BAR;
            }
        }
        if constexpr (ALIGN_EPI) { if (wr == 0) PG8_BAR; }
        if constexpr (!Epi::AFTER_DRAIN) { E(acc, cur, wr, wc, fr, fq); S.done(cur); }
        if (!has_next) break;
#pragma unroll
        for (int a = 0; a < 2; ++a)
#pragma unroll
            for (int b = 0; b < 2; ++b)
#pragma unroll
                for (int m = 0; m < 4; ++m)
#pragma unroll
                    for (int n = 0; n < 2; ++n) acc[a][b][m][n] = (f32x4){0.f, 0.f, 0.f, 0.f};
        cur = nxt; cA = nA; cB = nB; ++ui;
        if constexpr (ALIGN_EPI) { if (wr == 1) PG8_BAR; }
    }
    PG8_WAIT_V(0);
    if constexpr (!ALIGN_EPI) { if (wr == 0) PG8_BAR; }
    PG8_BAR;
    if constexpr (Epi::AFTER_DRAIN) { E.fused(acc, cur, wr, wc, fr, fq, lds, wid, lane); S.done(cur); }
#undef PG8_SA
#undef PG8_SB
#undef PG8_STAGE
#undef PG8_LDA
#undef PG8_LDB
#undef PG8_MMA
#undef PG8_WAIT_V
#undef PG8_WAIT_L
#undef PG8_BAR
#undef PG8_SCHED
}
}

constexpr int DM = 2048, NB = 8, SEQ = 4096, NMETA = 16, LSEQ = 4112, LPAD = 4128;
constexpr int MREAL = NB * SEQ;
constexpr int MPAD = MREAL + 256;
constexpr int MT_REAL = MREAL / 256;
constexpr int DFF = 5632, NGU = 2 * DFF, NNG = 7168, NGATE = 8192, INCOLS = 15184, NGC = 6992;
constexpr int NWAVES = 8;
constexpr float EPS = 1e-6f;
constexpr int C_AQ = 0, C_AF = 512, C_AI = 1024, C_AG = 1536, C_BB = 2048, C_BC = 2560, C_BU = 3072, C_CQ = 3584, C_CK = 4096, C_CV = 4608,
              C_DQ = 5120, C_DK = 5632, C_DV = 5760, C_DQI = 5888, C_DKI = 6912, C_DW = 6976;

constexpr size_t MiB = 1u << 20;
constexpr size_t WS_CTL = 0, CTL_ZERO_BYTES = 1 * MiB;
constexpr size_t WS_HM = 1 * MiB;
constexpr size_t WS_W = 4 * MiB;
constexpr size_t W_GU1 = 0, W_D1 = W_GU1 + (size_t)NGU * DM * 2, W_NG = W_D1 + (size_t)DM * DFF * 2, W_G = W_NG + (size_t)NNG * DM * 2,
                 W_BR = W_G + (size_t)NGATE * DM * 2, W_O = W_BR + (size_t)4 * DM * 512 * 2, W_GU2 = W_O + (size_t)DM * DM * 2, W_D2 = W_GU2 + (size_t)NGU * DM * 2,
                 W_END = W_D2 + (size_t)DM * DFF * 2;
constexpr size_t WS_XN = WS_W + W_END;
constexpr size_t WS_BR = WS_XN + (size_t)MPAD * DM * 2;
constexpr size_t WS_BIG = WS_BR + (size_t)MPAD * DM * 2;
constexpr size_t BIG_P_END = (size_t)MPAD * NNG * 2;
constexpr size_t WS_VTC = WS_BIG + BIG_P_END;
constexpr size_t WS_VTD = WS_VTC + (size_t)NB * 4 * 128 * LPAD * 2;
constexpr size_t WS_MASK = WS_VTD + (size_t)NB * 128 * LPAD * 2;
constexpr int MASKW = 132;
constexpr int NIDX_WG = 172;
constexpr int NHG_WG = 32;
constexpr size_t WS_SCR = WS_MASK + (size_t)NB * LPAD * MASKW * 4;
constexpr size_t WS_HA = WS_SCR + (size_t)NIDX_WG * 32 * LPAD * 4;
constexpr size_t WS_HDL = WS_HA + (size_t)NB * 4 * 64 * 64 * 64 * 2;
constexpr size_t WS_HMETA = WS_HDL + (size_t)NB * 4 * 64 * 128 * 4;
constexpr size_t HMETA_STRIDE = 64 * 384 * 2 + 64 * 64 * 2 + 128 * 4;
constexpr size_t WS_END = WS_HMETA + 4 * HMETA_STRIDE;
static_assert(WS_BIG + (size_t)MPAD * NGATE * 2 <= WS_END, "G fits");
static_assert(WS_END <= (size_t)1138174976, "workspace map fits the guaranteed size");

constexpr int RING_OFF = 0, RING_BYTES = 131072;
constexpr int LDSCTL_OFF = 143360, MISC_OFF = LDSCTL_OFF + 320;
constexpr int LDS_BYTES = 147456;

#define GAS __attribute__((address_space(1)))
#define LAS __attribute__((address_space(3)))
typedef unsigned short bf16;
typedef unsigned v4u __attribute__((ext_vector_type(4)));
typedef unsigned v2u __attribute__((ext_vector_type(2)));
typedef float f32x4 __attribute__((ext_vector_type(4)));
typedef float f32x16 __attribute__((ext_vector_type(16)));
typedef short bf16x8 __attribute__((ext_vector_type(8)));
typedef GAS unsigned gu32;
#define RLX_AGENT __ATOMIC_RELAXED, __HIP_MEMORY_SCOPE_AGENT
#define LDS_WAIT() asm volatile("s_waitcnt lgkmcnt(0)" ::: "memory")
#define VM_WAIT() asm volatile("s_waitcnt vmcnt(0)" ::: "memory")
__device__ __forceinline__ unsigned f2bf(float f) { unsigned u = __builtin_bit_cast(unsigned, f); return (u + 0x7fffu + ((u >> 16) & 1u)) >> 16; }
__device__ __forceinline__ unsigned f2bf_s(float f) { return pg8::cvt_pk_bf16(f, 0.f) & 0xffffu; }
__device__ __forceinline__ unsigned pk2(float lo, float hi) { return pg8::cvt_pk_bf16(lo, hi); }
__device__ __forceinline__ float bflo(unsigned w) { return __uint_as_float(w << 16); }
__device__ __forceinline__ float bfhi(unsigned w) { return __uint_as_float(w & 0xffff0000u); }
__device__ __forceinline__ float bf2f(bf16 v) { return __uint_as_float((unsigned)v << 16); }
__device__ __forceinline__ int seqrow(int b, int p) { return p < NMETA ? MREAL + p : b * SEQ + p - NMETA; }
__device__ __forceinline__ int rel_bucket(int n) {
    if (n < 16) return n; if (n >= 128) return 31;
    const int v = 16 + (int)(__log2f((float)n * 0.0625f) * 5.33333333f); return v < 31 ? v : 31; }
__device__ __forceinline__ float wave_sum(float v) {
#pragma unroll
    for (int o = 1; o < 64; o <<= 1) v += __shfl_xor(v, o);
    return v;
}
#define XB_TMO      128
#define XB_XCNT(j)  (256  + 64 * (j))
#define XB_XSUB(j)  (1280 + 64 * (j))
#define XB_XGEN(j)  (2304 + 64 * (j))
#define XB_TOP      3328
#define XB_TOPGEN   3392
#define XCD_BAR_WORDS 3456
#define XB_SPIN_CAP (1u << 18)

__device__ __forceinline__ unsigned xb_ld(unsigned* p)              { return __hip_atomic_load(p, __ATOMIC_RELAXED, __HIP_MEMORY_SCOPE_AGENT); }
__device__ __forceinline__ unsigned xb_add(unsigned* p, unsigned v) { return __hip_atomic_fetch_add(p, v, __ATOMIC_RELAXED, __HIP_MEMORY_SCOPE_AGENT); }
__device__ __forceinline__ unsigned xb_xcc_id() { return (unsigned)__builtin_amdgcn_s_getreg((3 << 11) | 20) & 0xFu; }
#define XB_SPIN(cond, bar) do { unsigned _sp = 0; while (cond) { __builtin_amdgcn_s_sleep(1); \
    if ((++_sp & 255u) == 0u) { if (xb_ld(&(bar)[XB_TMO])) break; if (_sp > XB_SPIN_CAP) { atomicAdd(&(bar)[XB_TMO], 1u); break; } } } } while (0)

struct XcdBarrier {
    unsigned* bar; unsigned x;
    volatile LAS unsigned* st;
};

__device__ __forceinline__ XcdBarrier xcd_barrier_post(unsigned* bar, volatile LAS unsigned* st) {
    XcdBarrier b; b.bar = bar; b.x = xb_xcc_id(); b.st = st;
    if (threadIdx.x == 0) (void)xb_add(&bar[XB_XCNT(b.x)], 1u);
    return b;
}
__device__ __forceinline__ void xcd_barrier_complete(unsigned* bar, unsigned x, unsigned& nloc, unsigned& nx) {
    const unsigned G = gridDim.x * gridDim.y * gridDim.z;
    unsigned sum, cnt, mine, sp = 0u;
    for (;;) {
        sum = 0u; cnt = 0u; mine = 0u;
#pragma unroll
        for (unsigned j = 0; j < 16; ++j) { const unsigned c = xb_ld(&bar[XB_XCNT(j)]); sum += c; cnt += (c > 0u) ? 1u : 0u; mine = (j == x) ? c : mine; }
        if (sum == G) break;
        __builtin_amdgcn_s_sleep(1);
        if ((++sp & 255u) == 0u) { if (xb_ld(&bar[XB_TMO])) break; if (sp > XB_SPIN_CAP) { atomicAdd(&bar[XB_TMO], 1u); break; } }
    }
    nloc = mine > 0u ? mine : 1u; nx = cnt > 0u ? cnt : 1u;
}

__device__ __forceinline__ void xcd_barrier(const XcdBarrier& b) {
    asm volatile("s_waitcnt vmcnt(0)" ::: "memory");
    __syncthreads();
    if (threadIdx.x == 0) {
        unsigned* bar = b.bar;
        __builtin_amdgcn_s_waitcnt(0);
        unsigned nloc = b.st[0], nx = b.st[1];
        if (nloc == 0u) { xcd_barrier_complete(bar, b.x, nloc, nx); b.st[0] = nloc; b.st[1] = nx; }
        const unsigned old = xb_add(&bar[XB_XSUB(b.x)], 1u);
        const unsigned gen = old / nloc;
        if (old + 1u == (gen + 1u) * nloc) {
            __builtin_amdgcn_fence(__ATOMIC_RELEASE, "agent");
            asm volatile("s_waitcnt vmcnt(0)" ::: "memory");
            const unsigned og = xb_add(&bar[XB_TOP], 1u);
            const unsigned tg = og / nx;
            if (og + 1u == (tg + 1u) * nx) xb_add(&bar[XB_TOPGEN], 1u);
            else XB_SPIN(xb_ld(&bar[XB_TOPGEN]) == tg, bar);
            __builtin_amdgcn_fence(__ATOMIC_ACQUIRE, "agent");
            xb_add(&bar[XB_XGEN(b.x)], 1u);
            asm volatile("s_waitcnt vmcnt(0)" ::: "memory");
        } else {
            XB_SPIN(xb_ld(&bar[XB_XGEN(b.x)]) == gen, bar);
            __builtin_amdgcn_fence(__ATOMIC_ACQUIRE, "agent");
            asm volatile("s_waitcnt vmcnt(0)" ::: "memory");
        }
    }
    __syncthreads();
}

struct Frame {
    LAS unsigned char* lds;
    volatile LAS unsigned* MISC;
    gu32* ctl;
    int tid, lane, wave, G, bid;
    const float* in[22]; float* out; unsigned char* ws;
};
enum { I_X = 0, I_META, I_RELB, I_F1N, I_F1GU, I_F1D, I_MIXN, I_WIN, I_LB, I_GN, I_CONVW, I_DQN, I_DKN, I_DLAM, I_DSUB, I_SQN, I_SKN, I_WBR, I_WOUT, I_F2N, I_F2GU, I_F2D };

template <class RowMap>
__device__ __forceinline__ void transpose_item(const float* W, int K, int N, bf16* WT, LAS float* scr, int item, int lane, RowMap rm) {
    const int nblk = (N + 31) / 32, kb = item / nblk, nb = item % nblk, k0 = 64 * kb, n0 = 32 * nb;
    const int nl = n0 + (lane & 31); const bool nok = nl < N;
#pragma unroll 8
    for (int i = 0; i < 32; ++i) { const int kk = 2 * i + (lane >> 5); scr[kk * 33 + (lane & 31)] = nok ? W[(size_t)(k0 + kk) * N + nl] : 0.f; }
    LDS_WAIT(); asm volatile("" ::: "memory");
    const int c = lane & 7;
#pragma unroll
    for (int j = 0; j < 4; ++j) { const int n = (lane >> 3) + 8 * j; const LAS float* s = scr + (8 * c) * 33 + n;
        v4u o; o.x = pk2(s[0 * 33], s[1 * 33]); o.y = pk2(s[2 * 33], s[3 * 33]); o.z = pk2(s[4 * 33], s[5 * 33]); o.w = pk2(s[6 * 33], s[7 * 33]);
        if (n0 + n < N) *(GAS v4u*)(WT + (size_t)rm(n0 + n) * K + k0 + 8 * c) = o; }
    LDS_WAIT(); asm volatile("" ::: "memory");
}
struct MapId { __device__ __forceinline__ int operator()(int n) const { return n; } };
struct MapGU { __device__ __forceinline__ int operator()(int n) const { const int up = n >= DFF, j = up ? n - DFF : n; return 256 * (j >> 7) + 128 * up + (j & 127); } };
struct MapIn { __device__ __forceinline__ int operator()(int n) const { return n < NGC ? n : n + (NNG - NGC); } };
template <class RowMap>
__device__ __forceinline__ void convert_matrix(Frame& F, const float* W, int K, int N, bf16* WT, RowMap rm) {
    LAS float* scr = (LAS float*)(F.lds + F.wave * 16384);
    const int gw = F.bid * NWAVES + F.wave, NGW = F.G * NWAVES, nitems = (K / 64) * ((N + 31) / 32);
    for (int it = gw; it < nitems; it += NGW) transpose_item(W, K, N, WT, scr, it, F.lane, rm);
}
__device__ __forceinline__ void phase_convert(Frame& F, int l) {
    unsigned char* wb = F.ws + WS_W;
    convert_matrix(F, F.in[I_F1GU] + (size_t)l * DM * NGU, DM, NGU, (bf16*)(wb + W_GU1), MapGU());
    convert_matrix(F, F.in[I_F1D] + (size_t)l * DFF * DM, DFF, DM, (bf16*)(wb + W_D1), MapId());
    convert_matrix(F, F.in[I_WIN] + (size_t)l * DM * INCOLS, DM, INCOLS, (bf16*)(wb + W_NG), MapIn());
    for (int m = 0; m < 4; ++m) convert_matrix(F, F.in[I_WBR] + ((size_t)l * 4 + m) * 512 * DM, 512, DM, (bf16*)(wb + W_BR) + (size_t)m * DM * 512, MapId());
    convert_matrix(F, F.in[I_WOUT] + (size_t)l * DM * DM, DM, DM, (bf16*)(wb + W_O), MapId());
    convert_matrix(F, F.in[I_F2GU] + (size_t)l * DM * NGU, DM, NGU, (bf16*)(wb + W_GU2), MapGU());
    convert_matrix(F, F.in[I_F2D] + (size_t)l * DFF * DM, DFF, DM, (bf16*)(wb + W_D2), MapId());
    { GAS v4u* z = (GAS v4u*)(wb + W_NG + (size_t)NGC * DM * 2); const int n16 = (NNG - NGC) * DM * 2 / 16;
      for (int i = F.bid * 512 + F.tid; i < n16; i += F.G * 512) z[i] = (v4u){0u, 0u, 0u, 0u}; }
    if (l == 0) {
        GAS f32x4* hm = (GAS f32x4*)(F.ws + WS_HM); const GAS f32x4* mt = (const GAS f32x4*)F.in[I_META];
        for (int i = F.bid * 512 + F.tid; i < 256 * DM / 4; i += F.G * 512) hm[i] = (i < NMETA * DM / 4) ? mt[i] : (f32x4){0.f, 0.f, 0.f, 0.f};
    }
}
__device__ __forceinline__ void phase_norm(Frame& F, const float* src_real, const float* gain) {
    const int gw = F.bid * NWAVES + F.wave, NGW = F.G * NWAVES;
    bf16* XN = (bf16*)(F.ws + WS_XN); const float* hm = (const float*)(F.ws + WS_HM);
    f32x4 g[8];
#pragma unroll
    for (int j = 0; j < 8; ++j) g[j] = ((const GAS f32x4*)gain)[F.lane + 64 * j];
    for (int r = gw; r < MPAD; r += NGW) {
        GAS v2u* o8 = (GAS v2u*)(XN + (size_t)r * DM) + F.lane;
        if (r >= MREAL + NMETA) {
#pragma unroll
            for (int j = 0; j < 8; ++j) o8[64 * j] = (v2u){0u, 0u};
            continue; }
        const float* xr = r < MREAL ? src_real + (size_t)r * DM : hm + (size_t)(r - MREAL) * DM;
        f32x4 v[8]; float s = 0.f;
#pragma unroll
        for (int j = 0; j < 8; ++j) { v[j] = ((const GAS f32x4*)xr)[F.lane + 64 * j]; s += (v[j].x * v[j].x + v[j].y * v[j].y) + (v[j].z * v[j].z + v[j].w * v[j].w); }
        const float inv = 1.0f / sqrtf(wave_sum(s) * (1.f / DM) + EPS);
#pragma unroll
        for (int j = 0; j < 8; ++j) { v2u w; w.x = pk2(v[j].x * inv * g[j].x, v[j].y * inv * g[j].y); w.y = pk2(v[j].z * inv * g[j].z, v[j].w * inv * g[j].w); o8[64 * j] = w; }
    }
}

__device__ __forceinline__ f32x4 meta_dot16(const bf16* A  , int lda, const bf16* Bt  , int K, int lane) {
    const int fr = lane & 15, g = lane >> 4; const bf16* ap = A + (size_t)fr * lda + 8 * g; const bf16* bp = Bt + (size_t)fr * K + 8 * g;
    f32x4 a0 = (f32x4){0.f, 0.f, 0.f, 0.f}, a1 = a0, a2 = a0, a3 = a0;
    for (int k = 0; k < K; k += 128) {
        const bf16x8 x0 = *(const GAS bf16x8*)(ap + k), x1 = *(const GAS bf16x8*)(ap + k + 32), x2 = *(const GAS bf16x8*)(ap + k + 64), x3 = *(const GAS bf16x8*)(ap + k + 96);
        const bf16x8 w0 = *(const GAS bf16x8*)(bp + k), w1 = *(const GAS bf16x8*)(bp + k + 32), w2 = *(const GAS bf16x8*)(bp + k + 64), w3 = *(const GAS bf16x8*)(bp + k + 96);
        a0 = __builtin_amdgcn_mfma_f32_16x16x32_bf16(w0, x0, a0, 0, 0, 0); a1 = __builtin_amdgcn_mfma_f32_16x16x32_bf16(w1, x1, a1, 0, 0, 0);
        a2 = __builtin_amdgcn_mfma_f32_16x16x32_bf16(w2, x2, a2, 0, 0, 0); a3 = __builtin_amdgcn_mfma_f32_16x16x32_bf16(w3, x3, a3, 0, 0, 0); }
    return (a0 + a1) + (a2 + a3);
}
__device__ __forceinline__ void st_bf16x4(bf16* p, f32x4 v) { v2u w; w.x = pk2(v[0], v[1]); w.y = pk2(v[2], v[3]); *(GAS v2u*)p = w; }
__device__ __forceinline__ void meta_gemm(Frame& F, int kind, const bf16* A, int lda, const bf16* Bt, int N, int K, bf16* Obf, int ldo, float scale) {
    const int gw = F.bid * NWAVES + F.wave, NGW = F.G * NWAVES, lane = F.lane, fr = lane & 15, g = lane >> 4;
    const int ngroups = (kind == 0 ? N / 2 : N) / 16;
    for (int cg = gw; cg < ngroups; cg += NGW) {
        const int n0 = 16 * cg;
        if (kind == 0) { const int j0 = n0, rg = 256 * (j0 >> 7) + (j0 & 127);
            const f32x4 gt = meta_dot16(A, lda, Bt + (size_t)rg * K, K, lane), up = meta_dot16(A, lda, Bt + (size_t)(rg + 128) * K, K, lane); f32x4 v;
#pragma unroll
            for (int r = 0; r < 4; ++r) v[r] = pg8::fast_silu(gt[r]) * up[r];
            st_bf16x4(Obf + (size_t)(MREAL + fr) * ldo + n0 + 4 * g, v); }
        else if (kind == 1) { const f32x4 acc = meta_dot16(A, lda, Bt + (size_t)n0 * K, K, lane); float* hp = (float*)(F.ws + WS_HM) + (size_t)fr * DM + n0 + 4 * g;
            *(GAS f32x4*)hp = *(const GAS f32x4*)hp + acc * scale; }
        else if (kind == 2) { st_bf16x4(Obf + (size_t)(MREAL + fr) * ldo + n0 + 4 * g, meta_dot16(A, lda, Bt + (size_t)n0 * K, K, lane)); }
        else if (kind == 3) { f32x4 acc = meta_dot16(A, lda, Bt + (size_t)n0 * K, K, lane);
#pragma unroll
            for (int r = 0; r < 4; ++r) acc[r] = pg8::fast_sigmoid(acc[r]);
            st_bf16x4(Obf + (size_t)(MREAL + fr) * ldo + n0 + 4 * g, acc); }
        else { f32x4 tot = (f32x4){0.f, 0.f, 0.f, 0.f}; const bf16* G = (const bf16*)(F.ws + WS_BIG);
            for (int mb = 0; mb < 4; ++mb) { const f32x4 acc = meta_dot16(A + (size_t)mb * MPAD * 512, 512, Bt + ((size_t)mb * DM + n0) * 512, 512, lane);
                const v2u gw2 = *(const GAS v2u*)(G + (size_t)(MREAL + fr) * NGATE + mb * DM + n0 + 4 * g);
                tot[0] += bflo(gw2.x) * acc[0]; tot[1] += bfhi(gw2.x) * acc[1]; tot[2] += bflo(gw2.y) * acc[2]; tot[3] += bfhi(gw2.y) * acc[3]; }
            st_bf16x4(Obf + (size_t)(MREAL + fr) * ldo + n0 + 4 * g, tot); }
    }
}
__device__ __forceinline__ void unpack8(const v4u w, float (&x)[8]) { x[0] = bflo(w.x); x[1] = bfhi(w.x); x[2] = bflo(w.y); x[3] = bfhi(w.y); x[4] = bflo(w.z); x[5] = bfhi(w.z); x[6] = bflo(w.w); x[7] = bfhi(w.w); }
__device__ __forceinline__ v4u pack8(const float (&x)[8]) { v4u w; w.x = pk2(x[0], x[1]); w.y = pk2(x[2], x[3]); w.z = pk2(x[4], x[5]); w.w = pk2(x[6], x[7]); return w; }
template <int GL>
__device__ __forceinline__ void norm_cols_inplace(bf16* p, const float* gain, float scale, int lane, bool wr) {
    float x[8]; unpack8(*(const GAS v4u*)p, x); float s = 0.f;
#pragma unroll
    for (int i = 0; i < 8; ++i) s += x[i] * x[i];
#pragma unroll
    for (int o = 1; o < GL; o <<= 1) s += __shfl_xor(s, o);
    const float inv = scale / sqrtf(s * (1.f / (GL * 8)) + EPS); const int g0 = (8 * lane) % (GL * 8);
#pragma unroll
    for (int i = 0; i < 8; ++i) x[i] = x[i] * inv * gain[g0 + i];
    if (wr) *(GAS v4u*)p = pack8(x);
}
__device__ __forceinline__ void phase_prep(Frame& F, int l) {
    const int gw = F.bid * NWAVES + F.wave, NGW = F.G * NWAVES, lane = F.lane;
    bf16* P = (bf16*)(F.ws + WS_BIG);
    const float *dqn = F.in[I_DQN] + l * 64, *dkn = F.in[I_DKN] + l * 64, *sqn = F.in[I_SQN] + l * 128, *skn = F.in[I_SKN] + l * 128;
    for (int r = gw; r < MREAL + NMETA; r += NGW) {
        bf16* pr = P + (size_t)r * NNG;
        norm_cols_inplace<8>(pr + C_CQ + 8 * lane, dqn, 0.125f, lane, true);
        norm_cols_inplace<8>(pr + C_CK + 8 * lane, dkn, 1.0f, lane, true);
        norm_cols_inplace<16>(pr + C_DQ + 8 * lane, sqn, 0.08838834764831845f, lane, true);
        norm_cols_inplace<16>(pr + C_DK + 8 * (lane & 15), skn, 1.0f, lane & 15, lane < 16);
    }
}
__device__ __forceinline__ void phase_vt(Frame& F) {
    const int gw = F.bid * NWAVES + F.wave, NGW = F.G * NWAVES, lane = F.lane;
    const bf16* P = (const bf16*)(F.ws + WS_BIG); bf16* VtC = (bf16*)(F.ws + WS_VTC); bf16* VtD = (bf16*)(F.ws + WS_VTD);
    LAS bf16* T = (LAS bf16*)(F.lds + F.wave * 17408);
    constexpr int NPB = (LPAD + 63) / 64;
    for (int task = gw; task < NB * 5 * NPB; task += NGW) {
        const int pb = task % NPB, mat = (task / NPB) % 5, b = task / (NPB * 5), p0 = 64 * pb;
        const int col = mat < 4 ? C_CV + 128 * mat : C_DV;
#pragma unroll 4
        for (int i = 0; i < 16; ++i) { const int pl = 4 * i + (lane >> 4), p = p0 + pl; v4u w = (v4u){0u, 0u, 0u, 0u};
            if (p < LSEQ) w = *(const GAS v4u*)(P + (size_t)seqrow(b, p) * NNG + col + 8 * (lane & 15));
            *(LAS v4u*)(T + pl * 136 + 8 * (lane & 15)) = w; }
        LDS_WAIT(); asm volatile("" ::: "memory");
        bf16* dst = mat < 4 ? VtC + (size_t)(b * 4 + mat) * 128 * LPAD : VtD + (size_t)b * 128 * LPAD;
#pragma unroll 4
        for (int it = 0; it < 16; ++it) { const int e = 8 * it + (lane >> 3), c = lane & 7; unsigned short x[8];
#pragma unroll
            for (int k = 0; k < 8; ++k) x[k] = T[(8 * c + k) * 136 + e];
            v4u w; w.x = x[0] | ((unsigned)x[1] << 16); w.y = x[2] | ((unsigned)x[3] << 16); w.z = x[4] | ((unsigned)x[5] << 16); w.w = x[6] | ((unsigned)x[7] << 16);
            if (p0 + 8 * c < LPAD) *(GAS v4u*)(dst + (size_t)e * LPAD + p0 + 8 * c) = w; }
        LDS_WAIT(); asm volatile("" ::: "memory");
    }
}

#define NEG_INF (-__builtin_inff())
constexpr int NQT = (LSEQ + 31) / 32;
constexpr int NQB = (NQT + 7) / 8;
__device__ __forceinline__ bf16x8 ld_frag16(const bf16* p) { return *(const GAS bf16x8*)p; }
__device__ __forceinline__ bf16x8 mk_frag(v2u lo, v2u hi) { v4u w; w.x = lo.x; w.y = lo.y; w.z = hi.x; w.w = hi.y; return __builtin_bit_cast(bf16x8, w); }
__device__ __forceinline__ unsigned cvtpk(float lo, float hi) { return pg8::cvt_pk_bf16(lo, hi); }
__device__ __forceinline__ void build_bias_table(Frame& F, LAS float* bt, int col0) {
    const float* rb = F.in[I_RELB];
    for (int i = F.tid; i < 4 * 128; i += 512) { const int hd = i >> 7, n = i & 127; bt[i] = rb[rel_bucket(n) * 8 + col0 + hd]; }
}
__device__ __forceinline__ bool softmax_step(f32x16& S, float& m, float& lsum, float& alpha) {
    float tm = S[0];
#pragma unroll
    for (int r = 1; r < 16; ++r) tm = fmaxf(tm, S[r]);
    tm = fmaxf(tm, __shfl_xor(tm, 32));
    const bool raise = __any(tm > m + 8.0f);
    alpha = 1.0f;
    if (raise) { const float mn = fmaxf(m, tm); alpha = (mn == NEG_INF) ? 1.0f : __expf(m - mn); m = mn; lsum *= alpha; }
    const float mref = (m == NEG_INF) ? 0.f : m;
    float rs = 0.f;
#pragma unroll
    for (int r = 0; r < 16; ++r) { S[r] = __expf(S[r] - mref); rs += S[r]; }
    rs += __shfl_xor(rs, 32);
    lsum += rs;
    return raise;
}
template <bool DSA>
__device__ __forceinline__ void attn_wg_task(Frame& F, int l, int b, int h, int J, const LAS float* bt, float lam, float post) {
    constexpr int KD = DSA ? 128 : 64, KP = KD + 8, VP = 36, NKS = KD / 16;
    constexpr int KBUF = 32 * KP, VBUF = 128 * VP;
    const int lane = F.lane, ql = lane & 31, hh = lane >> 5, wave = F.wave, tid = F.tid;
    LAS bf16* Kl = (LAS bf16*)F.lds; LAS bf16* Vl = Kl + 2 * KBUF;
    const bf16* P = (const bf16*)(F.ws + WS_BIG);
    const bf16* Vt = DSA ? (const bf16*)(F.ws + WS_VTD) + (size_t)b * 128 * LPAD : (const bf16*)(F.ws + WS_VTC) + (size_t)(b * 4 + h) * 128 * LPAD;
    const int j = 8 * J + wave; const bool wvalid = 32 * j < LSEQ;
    const int ktmax = (8 * J + 7 < NQT - 1) ? 8 * J + 7 : NQT - 1;
    const int pq = 32 * j + ql, pqc = pq < LSEQ ? pq : LSEQ - 1;
    const bf16* qrow = P + (size_t)seqrow(b, pqc) * NNG + (DSA ? C_DQ : C_CQ) + h * 128 + 8 * hh;
    const unsigned* mrow = (const unsigned*)(F.ws + WS_MASK) + ((size_t)b * LPAD + pqc) * MASKW;
    const float b31 = bt[h * 128 + 127];
    const int kr = tid / (KD / 8), kc = tid % (KD / 8); const bool kload = tid < 32 * (KD / 8);
    const int vr = tid >> 2, vc = tid & 3;
    f32x16 R[4];
#pragma unroll
    for (int c = 0; c < (DSA ? 1 : 2); ++c) {
        const int kcol = DSA ? C_DK : C_CK + h * 128 + c * 64;
        bf16x8 qf[NKS];
#pragma unroll
        for (int ks = 0; ks < NKS; ++ks) qf[ks] = ld_frag16(qrow + (DSA ? 0 : c * 64) + 16 * ks);
        float m = NEG_INF, lsum = 0.f; f32x16 O[4];
#pragma unroll
        for (int eb = 0; eb < 4; ++eb)
#pragma unroll
            for (int r = 0; r < 16; ++r) O[eb][r] = 0.f;
        v4u rk0 = (v4u){0u, 0u, 0u, 0u}, rv0 = rk0, rk1 = rk0, rv1 = rk0;
#define ATT_ISSUE(kt_, RK, RV) do { int pk_ = 32 * (kt_) + kr; pk_ = pk_ < LSEQ ? pk_ : LSEQ - 1; \
            if (kload) RK = *(const GAS v4u*)(P + (size_t)seqrow(b, pk_) * NNG + kcol + 8 * kc); \
            RV = *(const GAS v4u*)(Vt + (size_t)vr * LPAD + 32 * (kt_) + 8 * vc); } while (0)
#define ATT_COMMIT(buf_, RK, RV) do { if (kload) *(LAS v4u*)(Kl + (buf_) * KBUF + kr * KP + 8 * kc) = RK; \
            LAS v2u* vd_ = (LAS v2u*)(Vl + (buf_) * VBUF + vr * VP + 8 * vc); vd_[0] = (v2u){RV.x, RV.y}; vd_[1] = (v2u){RV.z, RV.w}; } while (0)
        auto compute = [&](int kt, int buf) {
            if (wvalid && kt <= j) {
                const LAS bf16* Kt = Kl + buf * KBUF + ql * KP + 8 * hh; const LAS bf16* Vb = Vl + buf * VBUF + ql * VP + 4 * hh;
                f32x16 S;
#pragma unroll
                for (int r = 0; r < 16; ++r) S[r] = 0.f;
#pragma unroll
                for (int ks = 0; ks < NKS; ++ks) S = __builtin_amdgcn_mfma_f32_32x32x16_bf16(*(const LAS bf16x8*)(Kt + 16 * ks), qf[ks], S, 0, 0, 0);
                unsigned mw = 0xffffffffu; if (DSA) mw = mrow[kt] >> (4 * hh);
                if (kt + 4 >= j) {
#pragma unroll
                    for (int r = 0; r < 16; ++r) { const int ko = (r & 3) + 8 * (r >> 2), n = pq - (32 * kt + 4 * hh + ko); const bool sel = ((mw >> ko) & 1u) && n >= 0;
                        S[r] = sel ? S[r] + bt[h * 128 + (n < 127 ? n : 127)] : NEG_INF; }
                } else {
#pragma unroll
                    for (int r = 0; r < 16; ++r) { const int ko = (r & 3) + 8 * (r >> 2); S[r] = (!DSA || ((mw >> ko) & 1u)) ? S[r] + b31 : NEG_INF; }
                }
                float alpha;
                if (softmax_step(S, m, lsum, alpha)) {
#pragma unroll
                    for (int eb = 0; eb < 4; ++eb)
#pragma unroll
                        for (int r = 0; r < 16; ++r) O[eb][r] *= alpha;
                }
                bf16x8 pf[2];
#pragma unroll
                for (int s = 0; s < 2; ++s) { v4u w; w.x = cvtpk(S[8 * s + 0], S[8 * s + 1]); w.y = cvtpk(S[8 * s + 2], S[8 * s + 3]); w.z = cvtpk(S[8 * s + 4], S[8 * s + 5]); w.w = cvtpk(S[8 * s + 6], S[8 * s + 7]); pf[s] = __builtin_bit_cast(bf16x8, w); }
#pragma unroll
                for (int eb = 0; eb < 4; ++eb)
#pragma unroll
                    for (int s = 0; s < 2; ++s) { const LAS bf16* vp = Vb + eb * 32 * VP + 16 * s;
                        O[eb] = __builtin_amdgcn_mfma_f32_32x32x16_bf16(mk_frag(*(const LAS v2u*)vp, *(const LAS v2u*)(vp + 8)), pf[s], O[eb], 0, 0, 0); }
            } };
        __syncthreads();
        ATT_ISSUE(0, rk0, rv0); ATT_COMMIT(0, rk0, rv0);
        if (ktmax >= 1) ATT_ISSUE(1, rk1, rv1);
        for (int kt = 0; kt <= ktmax; kt += 2) {
            LDS_WAIT(); __syncthreads();
            if (kt + 2 <= ktmax) ATT_ISSUE(kt + 2, rk0, rv0);
            compute(kt, 0);
            if (kt + 1 <= ktmax) ATT_COMMIT(1, rk1, rv1);
            if (kt + 1 > ktmax) break;
            LDS_WAIT(); __syncthreads();
            if (kt + 3 <= ktmax) ATT_ISSUE(kt + 3, rk1, rv1);
            compute(kt + 1, 1);
            if (kt + 2 <= ktmax) ATT_COMMIT(0, rk0, rv0);
        }
#undef ATT_ISSUE
#undef ATT_COMMIT
        const float il = 1.0f / lsum;
        if (DSA) {
#pragma unroll
            for (int eb = 0; eb < 4; ++eb)
#pragma unroll
                for (int r = 0; r < 16; ++r) R[eb][r] = O[eb][r] * il;
        } else if (c == 0) {
            LAS unsigned* rp = (LAS unsigned*)(F.lds + 28672) + wave * 2048 + lane;
#pragma unroll
            for (int eb = 0; eb < 4; ++eb)
#pragma unroll
                for (int r = 0; r < 16; r += 2) rp[(eb * 8 + (r >> 1)) * 64] = pk2(O[eb][r] * il, O[eb][r + 1] * il);
        } else {
            const LAS unsigned* rp = (const LAS unsigned*)(F.lds + 28672) + wave * 2048 + lane;
#pragma unroll
            for (int eb = 0; eb < 4; ++eb)
#pragma unroll
                for (int r = 0; r < 16; r += 2) { const unsigned w = rp[(eb * 8 + (r >> 1)) * 64]; R[eb][r] = bflo(w) - lam * (O[eb][r] * il); R[eb][r + 1] = bfhi(w) - lam * (O[eb][r + 1] * il); }
        }
    }
    float inv = 1.0f;
    if (!DSA) { float ss = 0.f;
#pragma unroll
        for (int eb = 0; eb < 4; ++eb)
#pragma unroll
            for (int r = 0; r < 16; ++r) ss += R[eb][r] * R[eb][r];
        ss += __shfl_xor(ss, 32); inv = post / sqrtf(ss * (1.f / 128.f) + EPS); }
    const float* sub = F.in[I_DSUB] + l * 128;
    if (wvalid && pq < LSEQ && (pq >= NMETA || b == 0)) {
        bf16* orow = (bf16*)(F.ws + WS_BR) + (size_t)(DSA ? 3 : 2) * MPAD * 512 + (size_t)seqrow(b, pq) * 512 + h * 128;
#pragma unroll
        for (int eb = 0; eb < 4; ++eb)
#pragma unroll
            for (int g = 0; g < 4; ++g) { const int e0 = 32 * eb + 8 * g + 4 * hh; f32x4 sv = (f32x4){1.f, 1.f, 1.f, 1.f}; if (!DSA) sv = *(const GAS f32x4*)(sub + e0);
                v2u w; w.x = pk2(R[eb][4 * g] * inv * sv.x, R[eb][4 * g + 1] * inv * sv.y); w.y = pk2(R[eb][4 * g + 2] * inv * sv.z, R[eb][4 * g + 3] * inv * sv.w);
                *(GAS v2u*)(orow + e0) = w; }
    }
}
__device__ __forceinline__ unsigned f32_key(float f) { const unsigned u = __float_as_uint(f); return u ^ ((u >> 31) ? 0xffffffffu : 0x80000000u); }
__device__ __forceinline__ void dsa_index_task(Frame& F, int b, int j, float* slab) {
    const int lane = F.lane, ql = lane & 31, hh = lane >> 5, wave = F.wave;
    const bf16* P = (const bf16*)(F.ws + WS_BIG);
    LAS unsigned char* qi = F.lds;
    for (int i = F.tid; i < 32 * 128; i += 512) { const int q = i >> 7, ch = i & 127; int pq = 32 * j + q; pq = pq < LSEQ ? pq : LSEQ - 1;
        *(LAS v4u*)(qi + q * 2064 + 16 * ch) = *(const GAS v4u*)(P + (size_t)seqrow(b, pq) * NNG + C_DQI + 8 * ch); }
    LAS float* wl = (LAS float*)(qi + 32 * 2064);
    if (F.tid < 32 * 16) { const int q = F.tid >> 4, hd = F.tid & 15; int pq = 32 * j + q; pq = pq < LSEQ ? pq : LSEQ - 1;
        wl[F.tid] = bf2f(P[(size_t)seqrow(b, pq) * NNG + C_DW + hd]) * 0.03125f; }
    LDS_WAIT(); __syncthreads();
    for (int kt = wave; kt <= j; kt += NWAVES) {
        const int pk = 32 * kt + ql, pkc = pk < LSEQ ? pk : LSEQ - 1;
        const bf16* krow = P + (size_t)seqrow(b, pkc) * NNG + C_DKI + 8 * hh;
        bf16x8 kf[4];
#pragma unroll
        for (int ks = 0; ks < 4; ++ks) kf[ks] = ld_frag16(krow + 16 * ks);
        f32x16 idx;
#pragma unroll
        for (int r = 0; r < 16; ++r) idx[r] = 0.f;
#pragma unroll 1
        for (int hd = 0; hd < 16; ++hd) { f32x16 S; const float wh = wl[ql * 16 + hd];
#pragma unroll
            for (int r = 0; r < 16; ++r) S[r] = 0.f;
#pragma unroll
            for (int ks = 0; ks < 4; ++ks) S = __builtin_amdgcn_mfma_f32_32x32x16_bf16(kf[ks], *(const LAS bf16x8*)(qi + ql * 2064 + hd * 128 + 32 * ks + 16 * hh), S, 0, 0, 0);
#pragma unroll
            for (int r = 0; r < 16; ++r) idx[r] += wh * fmaxf(S[r], 0.f); }
        float* srow = slab + (size_t)ql * LPAD + 32 * kt + 4 * hh;
#pragma unroll
        for (int g = 0; g < 4; ++g) *(GAS f32x4*)(srow + 8 * g) = (f32x4){idx[4 * g], idx[4 * g + 1], idx[4 * g + 2], idx[4 * g + 3]};
    }
    VM_WAIT(); __syncthreads();
    for (int qq = wave; qq < 32; qq += NWAVES) {
        const int p = 32 * j + qq; if (p >= LSEQ) break;
        const float* row = slab + (size_t)qq * LPAD;
        unsigned u[65];
#pragma unroll
        for (int i = 0; i < 65; ++i) { const int key = 64 * i + lane; u[i] = 0u; if (key <= p) u[i] = f32_key(((const GAS float*)row)[key]); }
        unsigned T = 1u;
        if (p + 1 > 256) { T = 0u;
            for (int bit = 31; bit >= 0; --bit) { const unsigned cand = T | (1u << bit); int cnt = 0;
#pragma unroll
                for (int i = 0; i < 65; ++i) cnt += __builtin_popcountll(__ballot(u[i] >= cand));
                if (cnt >= 256) T = cand; } }
        unsigned long long* mrow = (unsigned long long*)((unsigned*)(F.ws + WS_MASK) + ((size_t)b * LPAD + p) * MASKW);
#pragma unroll
        for (int i = 0; i < 65; ++i) { const unsigned long long bal = __ballot(u[i] >= T); if (lane == 0) mrow[i] = bal; }
    }
    __syncthreads();
}
struct HgChunk { bf16* base; int pitch; int cq, ck, cv; bf16* A; float* dl; };
__device__ __forceinline__ HgChunk hg_chunk(Frame& F, int b, int h, int c) {
    HgChunk k;
    if (c == 0) { unsigned char* mp = F.ws + WS_HMETA + (size_t)h * HMETA_STRIDE; k.base = (bf16*)mp; k.pitch = 384; k.cq = 0; k.ck = 128; k.cv = 256; k.A = (bf16*)(mp + 64 * 384 * 2); k.dl = (float*)(mp + 64 * 384 * 2 + 64 * 64 * 2); }
    else { const size_t ci = (size_t)(b * 4 + h) * 64 + (c - 1); k.base = (bf16*)(F.ws + WS_BIG) + (size_t)(b * SEQ + 64 * (c - 1)) * NNG; k.pitch = NNG; k.cq = C_AQ + h * 128; k.ck = C_AF + h * 128; k.cv = C_AI + h * 128;
        k.A = (bf16*)(F.ws + WS_HA) + ci * 64 * 64; k.dl = (float*)(F.ws + WS_HDL) + ci * 128; }
    return k;
}
__device__ __forceinline__ void hgrn_prep_task(Frame& F, int l, int b, int h, int c) {
    const int d = F.tid & 127, tq = F.tid >> 7, lane = F.lane, wave = F.wave;
    const bf16* P = (const bf16*)(F.ws + WS_BIG);
    LAS bf16* Qt = (LAS bf16*)F.lds; LAS bf16* Kt = Qt + 64 * 136; LAS float* part = (LAS float*)(F.lds + 2 * 64 * 136 * 2);
    const HgChunk ch = hg_chunk(F, b, h, c);
    float lb = 0.f; if (l == 1) { const float a = F.in[I_LB][h * 128 + d], cc = F.in[I_LB][512 + h * 128 + d]; lb = 1.0f / (1.0f + __expf(a - cc)); }
    const bool meta = (c == 0);
    const bf16* pr0 = P + (size_t)(meta ? MREAL + 16 * tq : b * SEQ + 64 * (c - 1) + 16 * tq) * NNG + h * 128 + d;
    float run = 0.f;
#pragma unroll 4
    for (int i = 0; i < 16; ++i) { const bool valid = !meta || (16 * tq + i < NMETA);
        if (valid) { const float z = bf2f(pr0[(size_t)i * NNG + C_AF]); const float sg = 1.0f / (1.0f + __expf(-z)); run += __logf(lb + (1.0f - lb) * sg); } }
    part[tq * 128 + d] = run;
    LDS_WAIT(); __syncthreads();
    const float p0 = part[d], p1 = part[128 + d], p2 = part[256 + d], p3 = part[384 + d];
    const float off = (tq > 0 ? p0 : 0.f) + (tq > 1 ? p1 : 0.f) + (tq > 2 ? p2 : 0.f), bmid = p0 + p1, blast = (p0 + p1) + (p2 + p3);
    unsigned kb[8], vb[8]; unsigned short qb[16];
    float bt = off;
#pragma unroll
    for (int i = 0; i < 16; i += 2) { float kbar[2], vv[2];
#pragma unroll
        for (int u = 0; u < 2; ++u) { const int t = 16 * tq + i + u; const bool valid = !meta || (t < NMETA);
            float lf = 0.f, kk = 0.f, qq = 0.f; vv[u] = 0.f;
            if (valid) { const bf16* pr = pr0 + (size_t)(i + u) * NNG; const float z = bf2f(pr[C_AF]), q = bf2f(pr[C_AQ]); vv[u] = bf2f(pr[C_AI]);
                const float sg = 1.0f / (1.0f + __expf(-z)), f = lb + (1.0f - lb) * sg; lf = __logf(f); kk = 1.0f - f; qq = q / (1.0f + __expf(-q)); }
            bt += lf;
            kbar[u] = kk * __expf(blast - bt); qb[i + u] = (unsigned short)f2bf_s(qq * __expf(bt));
            const float qt = qq * __expf(fminf(bt - bmid, 80.f)), kt = kk * __expf(fminf(bmid - bt, 80.f));
            Qt[t * 136 + d] = (bf16)f2bf_s(qt); Kt[t * 136 + d] = (bf16)f2bf_s(kt); }
        kb[i >> 1] = pk2(kbar[0], kbar[1]); vb[i >> 1] = pk2(vv[0], vv[1]); }
    asm volatile("s_waitcnt vmcnt(0)" ::: "memory"); __syncthreads();
#pragma unroll
    for (int i = 0; i < 16; ++i) ch.base[(size_t)(16 * tq + i) * ch.pitch + ch.cq + d] = qb[i];
    { bf16* kd = ch.base + (size_t)(d >> 1) * ch.pitch + ch.ck + (d & 1) * 64 + 16 * tq; bf16* vd = ch.base + (size_t)(d >> 1) * ch.pitch + ch.cv + (d & 1) * 64 + 16 * tq;
      *(GAS v4u*)kd = (v4u){kb[0], kb[1], kb[2], kb[3]}; *(GAS v4u*)(kd + 8) = (v4u){kb[4], kb[5], kb[6], kb[7]};
      *(GAS v4u*)vd = (v4u){vb[0], vb[1], vb[2], vb[3]}; *(GAS v4u*)(vd + 8) = (v4u){vb[4], vb[5], vb[6], vb[7]}; }
    if (tq == 0) ch.dl[d] = __expf(blast);
    LDS_WAIT(); __syncthreads();
    { const int mt = wave >> 1, fr = lane & 15, g = lane >> 4;
#pragma unroll
      for (int u = 0; u < 2; ++u) { const int nt = 2 * (wave & 1) + u; f32x4 acc = (f32x4){0.f, 0.f, 0.f, 0.f};
        if (nt <= mt) {
#pragma unroll
            for (int ks = 0; ks < 4; ++ks) acc = __builtin_amdgcn_mfma_f32_16x16x32_bf16(*(const LAS bf16x8*)(Qt + (16 * mt + fr) * 136 + 32 * ks + 8 * g), *(const LAS bf16x8*)(Kt + (16 * nt + fr) * 136 + 32 * ks + 8 * g), acc, 0, 0, 0);
        }
#pragma unroll
        for (int r = 0; r < 4; ++r) { const int t = 16 * mt + 4 * g + r, s = 16 * nt + fr; ch.A[t * 64 + s] = (bf16)f2bf_s(s <= t ? acc[r] : 0.f); } } }
    __syncthreads();
}
__device__ __forceinline__ void hgrn_scan_unit(Frame& F, int l, int b, int h) {
    const int lane = F.lane, wave = F.wave, fr = lane & 15, g = lane >> 4, tid = F.tid;
    constexpr int QP = 136, AP = 72, KP = 72;
    constexpr int BUF = (64 * QP + 64 * AP + 128 * KP) * 2;
    LAS float* red = (LAS float*)(F.lds + 2 * BUF);
    const float gn = F.in[I_GN][l * 512 + h * 128 + 16 * wave + fr];
    f32x4 S[8];
#pragma unroll
    for (int mt = 0; mt < 8; ++mt) S[mt] = (f32x4){0.f, 0.f, 0.f, 0.f};
    v4u rq[2], ra, rk[2];
    auto issue = [&](int c) { const HgChunk ch = hg_chunk(F, b, h, c);
#pragma unroll
        for (int i = 0; i < 2; ++i) { const int idx = tid + 512 * i, row = idx >> 4, c16 = idx & 15; rq[i] = *(const GAS v4u*)(ch.base + (size_t)row * ch.pitch + ch.cq + 8 * c16); rk[i] = *(const GAS v4u*)(ch.base + (size_t)row * ch.pitch + ch.ck + 8 * c16); }
        ra = *(const GAS v4u*)(ch.A + 8 * tid); };
    auto commit = [&](int buf) { LAS bf16* Q = (LAS bf16*)(F.lds + buf * BUF); LAS bf16* A = Q + 64 * QP; LAS bf16* KT = A + 64 * AP;
#pragma unroll
        for (int i = 0; i < 2; ++i) { const int idx = tid + 512 * i, row = idx >> 4, c16 = idx & 15; *(LAS v4u*)(Q + row * QP + 8 * c16) = rq[i];
            *(LAS v4u*)(KT + (2 * row + (c16 >> 3)) * KP + 8 * (c16 & 7)) = rk[i]; }
        *(LAS v4u*)(A + (tid >> 3) * AP + 8 * (tid & 7)) = ra; };
    issue(0); commit(0);
    for (int c = 0; c <= 64; ++c) {
        const int buf = c & 1; const HgChunk ch = hg_chunk(F, b, h, c);
        LDS_WAIT(); __syncthreads();
        if (c < 64) issue(c + 1);
        LAS bf16* Q = (LAS bf16*)(F.lds + buf * BUF); LAS bf16* A = Q + 64 * QP; LAS bf16* KT = A + 64 * AP;
        const int dv = 16 * wave + fr; const bf16* vrow = ch.base + (size_t)(dv >> 1) * ch.pitch + ch.cv + (dv & 1) * 64 + 8 * g;
        const bf16x8 bv0 = ld_frag16(vrow), bv1 = ld_frag16(vrow + 32);
        f32x4 o[4];
#pragma unroll
        for (int mt = 0; mt < 4; ++mt) o[mt] = (f32x4){0.f, 0.f, 0.f, 0.f};
#pragma unroll
        for (int ks = 0; ks < 4; ++ks) { v4u w; w.x = cvtpk(S[2 * ks][0], S[2 * ks][1]); w.y = cvtpk(S[2 * ks][2], S[2 * ks][3]); w.z = cvtpk(S[2 * ks + 1][0], S[2 * ks + 1][1]); w.w = cvtpk(S[2 * ks + 1][2], S[2 * ks + 1][3]);
            const bf16x8 sb = __builtin_bit_cast(bf16x8, w);
#pragma unroll
            for (int mt = 0; mt < 4; ++mt) { const LAS bf16* qp = Q + (16 * mt + fr) * QP + 32 * ks + 4 * g;
                const bf16x8 af = mk_frag(*(const LAS v2u*)qp, *(const LAS v2u*)(qp + 16));
                o[mt] = __builtin_amdgcn_mfma_f32_16x16x32_bf16(af, sb, o[mt], 0, 0, 0); } }
#pragma unroll
        for (int mt = 0; mt < 4; ++mt) { o[mt] = __builtin_amdgcn_mfma_f32_16x16x32_bf16(*(const LAS bf16x8*)(A + (16 * mt + fr) * AP + 8 * g), bv0, o[mt], 0, 0, 0);
            o[mt] = __builtin_amdgcn_mfma_f32_16x16x32_bf16(*(const LAS bf16x8*)(A + (16 * mt + fr) * AP + 32 + 8 * g), bv1, o[mt], 0, 0, 0); }
#pragma unroll
        for (int mt = 0; mt < 8; ++mt) { const f32x4 dl = *(const GAS f32x4*)(ch.dl + 16 * mt + 4 * g); S[mt] = S[mt] * dl;
            S[mt] = __builtin_amdgcn_mfma_f32_16x16x32_bf16(*(const LAS bf16x8*)(KT + (16 * mt + fr) * KP + 8 * g), bv0, S[mt], 0, 0, 0);
            S[mt] = __builtin_amdgcn_mfma_f32_16x16x32_bf16(*(const LAS bf16x8*)(KT + (16 * mt + fr) * KP + 32 + 8 * g), bv1, S[mt], 0, 0, 0); }
#pragma unroll
        for (int mt = 0; mt < 4; ++mt)
#pragma unroll
            for (int r = 0; r < 4; ++r) { float s2 = o[mt][r] * o[mt][r]; s2 += __shfl_xor(s2, 1); s2 += __shfl_xor(s2, 2); s2 += __shfl_xor(s2, 4); s2 += __shfl_xor(s2, 8);
                if (fr == 0) red[wave * 64 + 16 * mt + 4 * g + r] = s2; }
        LDS_WAIT(); __syncthreads();
        const int nvalid = (c == 0) ? NMETA : 64;
#pragma unroll
        for (int mt = 0; mt < 4; ++mt)
#pragma unroll
            for (int r = 0; r < 4; ++r) { const int t = 16 * mt + 4 * g + r; float tot = 0.f;
#pragma unroll
                for (int w = 0; w < 8; ++w) tot += red[w * 64 + t];
                if (t < nvalid && (c > 0 || b == 0)) { const int row = (c == 0) ? MREAL + t : b * SEQ + 64 * (c - 1) + t;
                    const float gr = bf2f(((const bf16*)(F.ws + WS_BIG))[(size_t)row * NNG + C_AG + h * 128 + dv]);
                    const float val = o[mt][r] * (1.0f / sqrtf(tot * (1.f / 128.f) + EPS)) * gn * (gr / (1.0f + __expf(-gr)));
                    ((bf16*)(F.ws + WS_BR))[(size_t)row * 512 + h * 128 + dv] = (bf16)f2bf_s(val); } }
        if (c < 64) commit(buf ^ 1);
    }
    __syncthreads();
}
__device__ __forceinline__ void conv_row(Frame& F, int l, int r) {
    const int lane = F.lane; const bf16* P = (const bf16*)(F.ws + WS_BIG);
    int r1, r2;
    if (r < MREAL) { const int b = r >> 12, t = r & 4095; r1 = seqrow(b, NMETA + t - 1); r2 = seqrow(b, NMETA + t - 2); }
    else { const int i = r - MREAL; r1 = i >= 1 ? r - 1 : -1; r2 = i >= 2 ? r - 2 : -1; }
    const float* cw = F.in[I_CONVW] + l * 3 * 512 + 8 * lane;
    float c0[8], u0[8], bb[8], y[8]; unpack8(*(const GAS v4u*)(P + (size_t)r * NNG + C_BC + 8 * lane), c0); unpack8(*(const GAS v4u*)(P + (size_t)r * NNG + C_BU + 8 * lane), u0); unpack8(*(const GAS v4u*)(P + (size_t)r * NNG + C_BB + 8 * lane), bb);
#pragma unroll
    for (int i = 0; i < 8; ++i) y[i] = cw[i] * (c0[i] * u0[i]);
    if (r1 >= 0) { unpack8(*(const GAS v4u*)(P + (size_t)r1 * NNG + C_BC + 8 * lane), c0); unpack8(*(const GAS v4u*)(P + (size_t)r1 * NNG + C_BU + 8 * lane), u0);
#pragma unroll
        for (int i = 0; i < 8; ++i) y[i] += cw[512 + i] * (c0[i] * u0[i]); }
    if (r2 >= 0) { unpack8(*(const GAS v4u*)(P + (size_t)r2 * NNG + C_BC + 8 * lane), c0); unpack8(*(const GAS v4u*)(P + (size_t)r2 * NNG + C_BU + 8 * lane), u0);
#pragma unroll
        for (int i = 0; i < 8; ++i) y[i] += cw[1024 + i] * (c0[i] * u0[i]); }
#pragma unroll
    for (int i = 0; i < 8; ++i) y[i] *= bb[i];
    *(GAS v4u*)((bf16*)(F.ws + WS_BR) + (size_t)MPAD * 512 + (size_t)r * 512 + 8 * lane) = pack8(y);
}
__device__ __forceinline__ void phase_hgrn_prep(Frame& F, int l) {
    for (int t = F.bid; t < NB * 4 * 64 + 4; t += F.G) { if (t < 4) hgrn_prep_task(F, l, 0, t, 0); else { const int u = t - 4; hgrn_prep_task(F, l, u >> 8, (u >> 6) & 3, 1 + (u & 63)); } }
}
constexpr int CW_TMO = 0, CW_BAR = 4096, CW_Q = 16384;
__device__ __forceinline__ int queue_pop(Frame& F, int qi) {
    int t = 0; if (F.lane == 0) t = (int)__hip_atomic_fetch_add((unsigned*)(F.ctl + CW_Q + 64 * qi), 1u, RLX_AGENT);
    return __builtin_amdgcn_readfirstlane(t);
}
__device__ __forceinline__ int queue_pop_wg(Frame& F, int qi) {
    LAS int* slot = (LAS int*)(F.lds + 139264);
    __syncthreads();
    if (F.tid == 0) *slot = (int)__hip_atomic_fetch_add((unsigned*)(F.ctl + CW_Q + 64 * qi), 1u, RLX_AGENT);
    LDS_WAIT(); __syncthreads();
    return __builtin_amdgcn_readfirstlane(*slot);
}
__device__ __forceinline__ void phase_mix1(Frame& F, int l, int qidx) {
    LAS float* bt = (LAS float*)(F.lds + 135168);
    build_bias_table(F, bt, 0);
    __syncthreads();
    if (F.bid < NIDX_WG) {
        float* slab = (float*)(F.ws + WS_SCR) + (size_t)F.bid * 32 * LPAD;
        for (int t = F.bid; t < NB * NQT; t += NIDX_WG) { const int j = NQT - 1 - t / NB, b = t % NB; dsa_index_task(F, b, j, slab); }
    } else if (F.bid < NIDX_WG + NHG_WG) {
        const int u = F.bid - NIDX_WG; hgrn_scan_unit(F, l, u >> 2, u & 3);
    } else {
        const int u0 = F.bid - NIDX_WG - NHG_WG, nw = F.G - NIDX_WG - NHG_WG;
        const int cw = u0 * NWAVES + F.wave, ncw = nw * NWAVES; for (int r = cw; r < MREAL + NMETA; r += ncw) conv_row(F, l, r);
    }
    float lam, post;
    { const float* lp = F.in[I_DLAM] + l * 256; const float s1 = wave_sum(lp[F.lane] * lp[64 + F.lane]), s2 = wave_sum(lp[128 + F.lane] * lp[192 + F.lane]);
      const float li = 0.8f - 0.6f * __expf(-0.3f * (float)l); lam = __expf(s1) - __expf(s2) + li; post = 1.0f - li; }
    for (;;) { const int t = queue_pop_wg(F, qidx); if (t >= NB * 4 * NQB) break;
        const int J = NQB - 1 - t / 32, bh = t % 32; attn_wg_task<false>(F, l, bh >> 2, bh & 3, J, bt, lam, post); }
}
__device__ __forceinline__ void phase_mix2(Frame& F, int l, int qidx) {
    LAS float* bt = (LAS float*)(F.lds + 135168);
    build_bias_table(F, bt, 4);
    __syncthreads();
    const int gw = F.bid * NWAVES + F.wave, NGW = F.G * NWAVES;
    for (;;) { const int t = queue_pop_wg(F, qidx); if (t >= NB * 4 * NQB) break;
        const int J = NQB - 1 - t / 32, bh = t % 32; attn_wg_task<true>(F, l, bh >> 2, bh & 3, J, bt, 0.f, 1.f); }
}

#ifdef DBG_SEL
#ifndef DBG_Q
#define DBG_Q 1.0f
#endif
#ifndef DBG_QO
#define DBG_QO 0.0f
#endif
#ifndef DBG_T0
#define DBG_T0 0
#define DBG_T1 36
#endif
#ifndef DBG_NC
#define DBG_NC DM
#endif
__global__ void __launch_bounds__(256) k_dbg_argmax(const float* __restrict__ out, const float* __restrict__ x, unsigned long long* best) {
    unsigned long long loc = 0ull;
    for (size_t i = (size_t)blockIdx.x * blockDim.x + threadIdx.x; i < (size_t)MREAL * DM; i += (size_t)gridDim.x * blockDim.x) {
        const float d = fabsf(out[i] - x[i]); const unsigned long long k = ((unsigned long long)__float_as_uint(d) << 32) | (unsigned)i; loc = k > loc ? k : loc; }
    for (int o = 32; o >= 1; o >>= 1) { const unsigned long long t = __shfl_xor(loc, o); loc = t > loc ? t : loc; }
    if ((threadIdx.x & 63) == 0) atomicMax(best, loc);
}
__global__ void __launch_bounds__(256) k_dbg_count(const float* __restrict__ out, const float* __restrict__ x, unsigned* cnt  ) {
    const int gw = (blockIdx.x * blockDim.x + threadIdx.x) >> 6, lane = threadIdx.x & 63, ngw = (gridDim.x * blockDim.x) >> 6;
    for (int r = gw; r < MREAL; r += ngw) { float m = 0.f;
        for (int c = lane; c < DM; c += 64) m = fmaxf(m, fabsf(out[(size_t)r * DM + c] - x[(size_t)r * DM + c]));
        for (int o = 32; o >= 1; o >>= 1) m = fmaxf(m, __shfl_xor(m, o));
        if (lane == 0 && m > DBG_THR) { const int t = r & 4095; atomicAdd(cnt + 0, 1u); if (t < 32) atomicAdd(cnt + 1, 1u); if (t >= 4064) atomicAdd(cnt + 2, 1u); if (t < 256) atomicAdd(cnt + 3, 1u); } }
}

__global__ void __launch_bounds__(256) k_dbg_chk_merge(const unsigned short* BRm, const unsigned short* Wt, const unsigned short* G, const unsigned short* MG, int m, unsigned* cnt) {
    const int c = blockIdx.x * 256 + threadIdx.x;
    for (int r = blockIdx.y; r < MREAL; r += gridDim.y) {
        float s = 0.f; const unsigned short* a = BRm + (size_t)r * 512; const unsigned short* w = Wt + (size_t)c * 512;
        for (int k = 0; k < 512; ++k) s += __uint_as_float((unsigned)a[k] << 16) * __uint_as_float((unsigned)w[k] << 16);
        const float g = __uint_as_float((unsigned)G[(size_t)r * NGATE + m * DM + c] << 16), ref = g * s, got = __uint_as_float((unsigned)MG[(size_t)r * DM + c] << 16);
        const float err = fabsf(got - ref), tol = 0.02f * fabsf(ref) + 0.02f;
        if (!(err <= tol)) { atomicAdd(cnt + 4, 1u); const int t = r & 4095; if ((c & 255) < 128) atomicAdd(cnt + 5, 1u); if ((r & 255) < 128) atomicAdd(cnt + 6, 1u); if (fabsf(got) > 2.f * fabsf(ref)) atomicAdd(cnt + 7, 1u); (void)t; }
    }
}

__global__ void __launch_bounds__(256) k_dbg_naive_wo(const float* out, const unsigned short* MG, const unsigned short* Wt, float* chk) {
    const int c = blockIdx.x * 256 + threadIdx.x;
    for (int r = blockIdx.y; r < MREAL; r += gridDim.y) {
        float s = 0.f; const uint4* a = (const uint4*)(MG + (size_t)r * DM); const uint4* w = (const uint4*)(Wt + (size_t)c * DM);
        for (int k = 0; k < DM / 8; ++k) { const uint4 av = a[k], wv = w[k]; const unsigned aw[4] = {av.x, av.y, av.z, av.w}, ww[4] = {wv.x, wv.y, wv.z, wv.w};
#pragma unroll
            for (int j = 0; j < 4; ++j) { s += __uint_as_float(aw[j] << 16) * __uint_as_float(ww[j] << 16); s += __uint_as_float(aw[j] & 0xffff0000u) * __uint_as_float(ww[j] & 0xffff0000u); } }
        chk[(size_t)r * DM + c] = out[(size_t)r * DM + c] + s; }
}
__global__ void __launch_bounds__(256) k_dbg_cmp(const float* out, const float* chk, unsigned* cnt) {
    for (size_t i = (size_t)blockIdx.x * blockDim.x + threadIdx.x; i < (size_t)MREAL * DM; i += (size_t)gridDim.x * blockDim.x) {
        const float err = fabsf(out[i] - chk[i]); if (!(err <= 0.02f)) { atomicAdd(cnt + 4, 1u); const int c = (int)(i % DM), r = (int)(i / DM); if ((c & 255) < 128) atomicAdd(cnt + 5, 1u); if ((r & 255) < 128) atomicAdd(cnt + 6, 1u); if (err > 1.0f) atomicAdd(cnt + 7, 1u); } }
}

__global__ void __launch_bounds__(256) k_dbg_stats(const unsigned short* A, int ld, int ncols, unsigned* st) {
    const int gw = (blockIdx.x * blockDim.x + threadIdx.x) >> 6, lane = threadIdx.x & 63, ngw = (gridDim.x * blockDim.x) >> 6;
    float mx = 0.f, me = 0.f;
    for (int r = gw; r < MREAL; r += ngw) { float s = 0.f;
        for (int c = lane; c < ncols; c += 64) { const float v = __uint_as_float((unsigned)A[(size_t)r * ld + c] << 16); mx = fmaxf(mx, fabsf(v)); s += v * v; }
        for (int o = 32; o >= 1; o >>= 1) s += __shfl_xor(s, o);
        me = fmaxf(me, s / (float)ncols); }
    for (int o = 32; o >= 1; o >>= 1) mx = fmaxf(mx, __shfl_xor(mx, o));
    if (lane == 0) { atomicMax(st + 8, __float_as_uint(mx)); atomicMax(st + 9, __float_as_uint(me)); }
}

__global__ void __launch_bounds__(256) k_dbg_argmax_bf16(const unsigned short* A, int ld, int ncols, unsigned long long* best) {
    unsigned long long loc = 0ull;
    for (size_t i = (size_t)blockIdx.x * blockDim.x + threadIdx.x; i < (size_t)MREAL * ncols; i += (size_t)gridDim.x * blockDim.x) { const size_t r = i / ncols, c = i % ncols;
        const float d = fabsf(__uint_as_float((unsigned)A[r * ld + c] << 16)); const unsigned long long k = ((unsigned long long)__float_as_uint(d) << 32) | (unsigned)i; loc = k > loc ? k : loc; }
    for (int o = 32; o >= 1; o >>= 1) { const unsigned long long t = __shfl_xor(loc, o); loc = t > loc ? t : loc; }
    if ((threadIdx.x & 63) == 0) atomicMax(best, loc);
}

__global__ void __launch_bounds__(256) k_dbg_gcount(const unsigned short* G, unsigned* cnt) {
    const int gw = (blockIdx.x * blockDim.x + threadIdx.x) >> 6, lane = threadIdx.x & 63, ngw = (gridDim.x * blockDim.x) >> 6;
    for (int r = gw; r < MREAL; r += ngw) { int n = 0;
        for (int c = lane; c < NGATE; c += 64) { const float v = __uint_as_float((unsigned)G[(size_t)r * NGATE + c] << 16); if (!(v >= 0.f && v <= 1.001f)) ++n; }
        for (int o = 32; o >= 1; o >>= 1) n += __shfl_xor(n, o);
        if (lane == 0 && n) { const int t = r & 4095; atomicAdd(cnt + 10, (unsigned)n); atomicAdd(cnt + 11, 1u); if (t >= 4080) atomicAdd(cnt + 12, 1u); else atomicAdd(cnt + 13, 1u); } }
}

__global__ void k_dbg_time(const unsigned long long* ts, unsigned* cnt) {
    if (threadIdx.x == 0) { const float ms = (float)(ts[DBG_T1] - ts[DBG_T0]) * 1e-5f; cnt[14] = __float_as_uint(floorf(ms * DBG_Q + DBG_QO)); }
}
__global__ void __launch_bounds__(256) k_dbg_emit(float* out, const float* __restrict__ x, const unsigned long long* best, const unsigned* cnt) {
    const unsigned long long b = *best; const unsigned idx = (unsigned)b; const float val = __uint_as_float((unsigned)(b >> 32));
    const int row = idx / DBG_NC, col = idx % DBG_NC, bb = row >> 12, t = row & 4095;
    float N = 0.f;
    switch (DBG_SEL) {
        case 0: N = val; break;
        case 1: N = 2.f + bb; break;
        case 2: N = 2.f + (t >> 9); break;
        case 3: N = 2.f + ((t >> 6) & 7); break;
        case 4: N = 2.f + ((t >> 3) & 7); break;
        case 5: N = 2.f + (t & 7); break;
        case 6: N = 2.f + (col >> 8); break;
        case 60: N = 2.f + (col >> 10); break;
        case 61: N = 2.f + ((col >> 7) & 7); break;
        case 62: N = 2.f + ((col >> 4) & 7); break;
        case 63: N = 2.f + ((col >> 1) & 7); break;
        case 64: N = 2.f + (col & 1); break;
        case 65: N = 2.f + bb; break;
        case 66: N = 2.f + (t >> 9); break;
        case 67: N = 2.f + ((t >> 6) & 7); break;
        case 68: N = 2.f + ((t >> 3) & 7); break;
        case 69: N = 2.f + (t & 7); break;
        case 7: N = 2.f + ((col >> 5) & 7); break;
        case 8: N = 2.f + ((col >> 2) & 7); break;
        case 40: case 42: case 44: case 46: N = __uint_as_float(cnt[8]); break;
        case 41: case 43: case 45: case 47: N = __uint_as_float(cnt[9]); break;
        case 70: N = 2.f + log2f(1.f + (float)cnt[10]); break;
        case 71: N = 2.f + log2f(1.f + (float)cnt[11]); break;
        case 72: N = 2.f + log2f(1.f + (float)cnt[12]); break;
        case 73: N = 2.f + log2f(1.f + (float)cnt[13]); break;
        case 100: N = 2.f + __uint_as_float(cnt[14]); break;
        case 30: N = 2.f + log2f(1.f + (float)cnt[4]); break;
        case 31: N = 2.f + log2f(1.f + (float)cnt[5]); break;
        case 32: N = 2.f + log2f(1.f + (float)cnt[6]); break;
        case 33: N = 2.f + log2f(1.f + (float)cnt[7]); break;
        case 20: N = 2.f + log2f(1.f + (float)cnt[4]); break;
        case 21: N = 2.f + log2f(1.f + (float)cnt[5]); break;
        case 22: N = 2.f + log2f(1.f + (float)cnt[6]); break;
        case 23: N = 2.f + log2f(1.f + (float)cnt[7]); break;
        case 10: N = 2.f + log2f(1.f + (float)cnt[0]); break;
        case 11: N = 2.f + log2f(1.f + (float)cnt[1]); break;
        case 12: N = 2.f + log2f(1.f + (float)cnt[2]); break;
        case 13: N = 2.f + log2f(1.f + (float)cnt[3]); break;
    }
    const float c = 1.f + N;
    for (size_t i = (size_t)blockIdx.x * blockDim.x + threadIdx.x; i < (size_t)MREAL * DM; i += (size_t)gridDim.x * blockDim.x) out[i] = c * x[i];
}
#endif

#ifndef MK_ONE
#define MK_ONE 0
#endif
#ifndef BR_MASK
#define BR_MASK 15
#endif
constexpr int NPH = 18;
template <class T> __device__ __forceinline__ T opaque(T v) { asm volatile("" : "+s"(v)); return v; }
struct Args { const float* in[22]; float* out; unsigned char* ws; int ph_lo, ph_hi; };
__global__ void __launch_bounds__(NWAVES * 64, 2) fwd(Args args) {
    extern __shared__ __attribute__((aligned(16))) unsigned char lds[];
    Frame F;
    F.lds = (LAS unsigned char*)lds; F.MISC = (volatile LAS unsigned*)(F.lds + MISC_OFF);
    F.tid = threadIdx.x; F.lane = F.tid & 63; F.wave = __builtin_amdgcn_readfirstlane(F.tid >> 6); F.G = gridDim.x; F.bid = blockIdx.x;
    F.ws = args.ws; F.out = args.out; F.ctl = (gu32*)(args.ws + WS_CTL);
#pragma unroll
    for (int i = 0; i < 22; ++i) F.in[i] = args.in[i];
    for (int u = F.tid; u < (LDS_BYTES - LDSCTL_OFF) / 4; u += NWAVES * 64) ((LAS unsigned*)(F.lds + LDSCTL_OFF))[u] = 0u;
    __syncthreads();
#if MK_ONE
    XcdBarrier bar = xcd_barrier_post((unsigned*)(F.ctl + CW_BAR), F.MISC + 8);
#define GRID_BAR() xcd_barrier(bar)
#else
#define GRID_BAR() do { } while (0)
#endif
    const int lo = args.ph_lo, hi = args.ph_hi;
#define IN(k) (lo <= (k) && (k) < hi)
#define RETID() do { int t_ = threadIdx.x; asm volatile("" : "+v"(t_)); F.tid = t_; F.lane = t_ & 63; F.wave = __builtin_amdgcn_readfirstlane(t_ >> 6); } while (0)
#ifdef DBG_TS
#define STAMP(k) do { if (blockIdx.x == 0 && threadIdx.x == 0) ((unsigned long long*)(args.ws + 768 * 1024))[(k)] = __builtin_amdgcn_s_memrealtime(); } while (0)
#else
#define STAMP(k) do { } while (0)
#endif
#define SEAM(k) do { if (IN((k) + 1)) GRID_BAR(); STAMP((k) + 1); } while (0)
    STAMP(0);
    unsigned char* wb = F.ws + WS_W;
    bf16* XN = (bf16*)(F.ws + WS_XN); bf16* BR = (bf16*)(F.ws + WS_BR); bf16* BIG = (bf16*)(F.ws + WS_BIG); float* HM = (float*)(F.ws + WS_HM);
    for (int l = 0; l < 2; ++l) {
        const int pb = l * NPH;
        const float* hsrc = (l == 0) ? F.in[I_X] : F.out;
        if (IN(pb + 0)) { RETID(); phase_convert(F, l); SEAM(pb + 0); }
        if (IN(pb + 1)) { RETID(); phase_norm(F, hsrc, F.in[I_F1N] + l * DM); SEAM(pb + 1); }
        if (IN(pb + 2)) { RETID(); meta_gemm(F, 0, XN + (size_t)MREAL * DM, DM, (const bf16*)(wb + W_GU1), NGU, DM, BIG, DFF, 0.f); pg8::Gemm g{opaque((const bf16*)(XN)), opaque((const bf16*)(wb + W_GU1)), MREAL, NGU, DM}; pg8::StaticOrder S; S.init(MREAL, NGU, F.G, opaque(F.bid));
            pg8::EpiSwiGLU E{BIG, DFF}; pg8::gemm_phase<pg8::EpiSwiGLU, pg8::StaticOrder, true, true>(F.lds + RING_OFF, g, S, E); SEAM(pb + 2); }
        if (IN(pb + 3)) { RETID(); meta_gemm(F, 1, BIG + (size_t)MREAL * DFF, DFF, (const bf16*)(wb + W_D1), DM, DFF, nullptr, 0, 0.5f); pg8::Gemm g{opaque((const bf16*)(BIG)), opaque((const bf16*)(wb + W_D1)), MREAL, DM, DFF}; pg8::StaticOrder S; S.init(MREAL, DM, F.G, opaque(F.bid));
            pg8::EpiResF32 E{hsrc, F.out, HM, DM, MT_REAL, 0.5f}; pg8::gemm_phase<pg8::EpiResF32, pg8::StaticOrder, true, true>(F.lds + RING_OFF, g, S, E); SEAM(pb + 3); }
        if (IN(pb + 4)) { RETID(); phase_norm(F, F.out, F.in[I_MIXN] + l * DM); SEAM(pb + 4); }
        if (IN(pb + 5)) { RETID(); meta_gemm(F, 2, XN + (size_t)MREAL * DM, DM, (const bf16*)(wb + W_NG), NNG, DM, BIG, NNG, 0.f); pg8::Gemm g{opaque((const bf16*)(XN)), opaque((const bf16*)(wb + W_NG)), MREAL, NNG, DM}; pg8::StaticOrder S; S.init(MREAL, NNG, F.G, opaque(F.bid));
            pg8::EpiBf16<0> E{BIG, NNG}; pg8::gemm_phase<pg8::EpiBf16<0>, pg8::StaticOrder, true, true>(F.lds + RING_OFF, g, S, E); SEAM(pb + 5); }
        if (IN(pb + 6)) { RETID(); phase_prep(F, l); phase_vt(F); __syncthreads(); phase_hgrn_prep(F, l); SEAM(pb + 6); }
#ifdef DUP_MIX
        if (IN(pb + 7)) { const int nrep = opaque(DUP_MIX1); for (int rep = 0; rep < nrep; ++rep) { RETID(); phase_mix1(F, l, 4 * rep + 2 * l); GRID_BAR(); } }
        if (IN(pb + 8)) { const int nrep = opaque(DUP_MIX2); for (int rep = 0; rep < nrep; ++rep) { RETID(); phase_mix2(F, l, 4 * rep + 2 * l + 1); GRID_BAR(); } }
#else
        if (IN(pb + 7)) { RETID(); phase_mix1(F, l, 2 * l); SEAM(pb + 7); }
        if (IN(pb + 8)) { RETID(); phase_mix2(F, l, 2 * l + 1); SEAM(pb + 8); }
#endif
        if (IN(pb + 9)) { RETID(); meta_gemm(F, 3, XN + (size_t)MREAL * DM, DM, (const bf16*)(wb + W_G), NGATE, DM, BIG, NGATE, 0.f); pg8::Gemm g{opaque((const bf16*)(XN)), opaque((const bf16*)(wb + W_G)), MREAL, NGATE, DM}; pg8::StaticOrder S; S.init(MREAL, NGATE, F.G, opaque(F.bid));
            pg8::EpiBf16<1> E{BIG, NGATE}; pg8::gemm_phase<pg8::EpiBf16<1>, pg8::StaticOrder, true, true>(F.lds + RING_OFF, g, S, E); SEAM(pb + 9); }
        for (int m = 0; m < 4; ++m)
            if (IN(pb + 10 + m) && ((BR_MASK >> m) & 1)) { RETID(); if (m == 0) meta_gemm(F, 4, BR + (size_t)MREAL * 512, 512, (const bf16*)(wb + W_BR), DM, 512, XN, DM, 0.f); pg8::Gemm g{opaque((const bf16*)(BR + (size_t)m * MPAD * 512)), opaque((const bf16*)(wb + W_BR) + (size_t)m * DM * 512), MREAL, DM, 512}; pg8::StaticOrder S; S.init(MREAL, DM, F.G, opaque(F.bid));
                pg8::EpiGateAcc E{XN, DM, BIG, NGATE, m * DM, (BR_MASK & ((1 << m) - 1)) == 0}; pg8::gemm_phase<pg8::EpiGateAcc, pg8::StaticOrder, true, true>(F.lds + RING_OFF, g, S, E); SEAM(pb + 10 + m); }
        if (IN(pb + 14) && BR_MASK) { RETID(); meta_gemm(F, 1, XN + (size_t)MREAL * DM, DM, (const bf16*)(wb + W_O), DM, DM, nullptr, 0, 1.0f); pg8::Gemm g{opaque((const bf16*)(XN)), opaque((const bf16*)(wb + W_O)), MREAL, DM, DM}; pg8::StaticOrder S; S.init(MREAL, DM, F.G, opaque(F.bid));
            pg8::EpiResF32 E{F.out, F.out, HM, DM, MT_REAL, 1.0f}; pg8::gemm_phase<pg8::EpiResF32, pg8::StaticOrder, true, true>(F.lds + RING_OFF, g, S, E); SEAM(pb + 14); }
        if (IN(pb + 15)) { RETID(); phase_norm(F, F.out, F.in[I_F2N] + l * DM); SEAM(pb + 15); }
        if (IN(pb + 16)) { RETID(); meta_gemm(F, 0, XN + (size_t)MREAL * DM, DM, (const bf16*)(wb + W_GU2), NGU, DM, BIG, DFF, 0.f); pg8::Gemm g{opaque((const bf16*)(XN)), opaque((const bf16*)(wb + W_GU2)), MREAL, NGU, DM}; pg8::StaticOrder S; S.init(MREAL, NGU, F.G, opaque(F.bid));
            pg8::EpiSwiGLU E{BIG, DFF}; pg8::gemm_phase<pg8::EpiSwiGLU, pg8::StaticOrder, true, true>(F.lds + RING_OFF, g, S, E); SEAM(pb + 16); }
        if (IN(pb + 17)) { RETID(); meta_gemm(F, 1, BIG + (size_t)MREAL * DFF, DFF, (const bf16*)(wb + W_D2), DM, DFF, nullptr, 0, 0.5f); pg8::Gemm g{opaque((const bf16*)(BIG)), opaque((const bf16*)(wb + W_D2)), MREAL, DM, DFF}; pg8::StaticOrder S; S.init(MREAL, DM, F.G, opaque(F.bid));
            pg8::EpiResF32 E{F.out, F.out, HM, DM, MT_REAL, 0.5f}; pg8::gemm_phase<pg8::EpiResF32, pg8::StaticOrder, true, true>(F.lds + RING_OFF, g, S, E); SEAM(pb + 17); }
    }
}

extern "C" void kernel_launch(void* const* d_in, const int* in_sizes, int n_in, void* d_out, int out_size, void* d_ws, size_t ws_size, hipStream_t stream) {
    static int grid = 0;
    if (grid == 0) {
        if (n_in != 22 || out_size != MREAL * DM || ws_size < WS_END) { fprintf(stderr, "kernel_launch: unexpected shapes (n_in %d out %d ws %zu need %zu)\n", n_in, out_size, ws_size, (size_t)WS_END); grid = -1; return; }
        int dev = 0, cus = 0, per_cu = 0;
        if (hipGetDevice(&dev) != hipSuccess || hipDeviceGetAttribute(&cus, hipDeviceAttributeMultiprocessorCount, dev) != hipSuccess) { grid = -1; return; }
        if (hipFuncSetAttribute((const void*)fwd, hipFuncAttributeMaxDynamicSharedMemorySize, LDS_BYTES) != hipSuccess) { fprintf(stderr, "kernel_launch: hipFuncSetAttribute failed\n"); grid = -1; return; }
        if (hipOccupancyMaxActiveBlocksPerMultiprocessor(&per_cu, (const void*)fwd, NWAVES * 64, LDS_BYTES) != hipSuccess || per_cu < 1) fprintf(stderr, "kernel_launch: occupancy query says %d\n", per_cu);
        (void)hipGetLastError();
        grid = cus < 256 ? cus : 256;
    }
    if (grid < 0) return;
    (void)hipMemsetAsync((char*)d_ws + WS_CTL, 0, CTL_ZERO_BYTES, stream);
    Args a{};
    for (int i = 0; i < 22; ++i) a.in[i] = (const float*)d_in[i];
    a.out = (float*)d_out; a.ws = (unsigned char*)d_ws;
#ifndef PH_END
#define PH_END (2 * NPH)
#endif
#if MK_ONE
    a.ph_lo = 0; a.ph_hi = PH_END;
    hipLaunchKernelGGL(fwd, dim3(grid), dim3(NWAVES * 64), LDS_BYTES, stream, a);
#else
    for (int p = 0; p < PH_END; ++p) { a.ph_lo = p; a.ph_hi = p + 1;
#if defined(DBG_SEL)
#ifdef DBG_PREFILL
        if (p == 9) (void)hipMemsetAsync((char*)d_ws + WS_BIG, 0x3F, (size_t)MPAD * NGATE * 2, stream);
#endif
        if (DBG_SEL >= 30 && DBG_SEL < 40 && p == 14) hipLaunchKernelGGL(k_dbg_naive_wo, dim3(8, 2048), dim3(256), 0, stream, (const float*)d_out, (const unsigned short*)((char*)d_ws + WS_XN), (const unsigned short*)((char*)d_ws + WS_W + W_O), (float*)((char*)d_ws + WS_BIG));
#endif
        hipLaunchKernelGGL(fwd, dim3(grid), dim3(NWAVES * 64), LDS_BYTES, stream, a); }
#endif
#ifdef DBG_SEL
    { unsigned long long* best = (unsigned long long*)((char*)d_ws + 512 * 1024); unsigned* cnt = (unsigned*)((char*)d_ws + 512 * 1024 + 64);
      if (DBG_SEL >= 60 && DBG_SEL < 70) hipLaunchKernelGGL(k_dbg_argmax_bf16, dim3(2048), dim3(256), 0, stream, (const unsigned short*)((char*)d_ws + WS_BIG), NGATE, NGATE, best);
      else hipLaunchKernelGGL(k_dbg_argmax, dim3(2048), dim3(256), 0, stream, (const float*)d_out, (const float*)d_in[0], best);
      hipLaunchKernelGGL(k_dbg_count, dim3(2048), dim3(256), 0, stream, (const float*)d_out, (const float*)d_in[0], cnt);
      if (DBG_SEL >= 20 && DBG_SEL < 30) { const int mm = 1; hipLaunchKernelGGL(k_dbg_chk_merge, dim3(8, 2048), dim3(256), 0, stream, (const unsigned short*)((char*)d_ws + WS_BR) + (size_t)mm * MPAD * 512, (const unsigned short*)((char*)d_ws + WS_W + W_BR) + (size_t)mm * DM * 512, (const unsigned short*)((char*)d_ws + WS_BIG), (const unsigned short*)((char*)d_ws + WS_XN), mm, cnt); }
      if (DBG_SEL >= 30 && DBG_SEL < 40) hipLaunchKernelGGL(k_dbg_cmp, dim3(2048), dim3(256), 0, stream, (const float*)d_out, (const float*)((char*)d_ws + WS_BIG), cnt);
      if (DBG_SEL >= 40 && DBG_SEL < 50) { const unsigned short* A = nullptr; int ld = 0, nc = 0;
        if (DBG_SEL < 42) { A = (const unsigned short*)((char*)d_ws + WS_BR) + (size_t)MPAD * 512; ld = 512; nc = 512; }
        else if (DBG_SEL < 44) { A = (const unsigned short*)((char*)d_ws + WS_BIG) + DM; ld = NGATE; nc = DM; }
        else if (DBG_SEL < 46) { A = (const unsigned short*)((char*)d_ws + WS_XN); ld = DM; nc = DM; }
        else { A = (const unsigned short*)((char*)d_ws + WS_BR); ld = 512; nc = 512; }
        hipLaunchKernelGGL(k_dbg_stats, dim3(1024), dim3(256), 0, stream, A, ld, nc, cnt); }
      if (DBG_SEL >= 70 && DBG_SEL < 80) hipLaunchKernelGGL(k_dbg_gcount, dim3(1024), dim3(256), 0, stream, (const unsigned short*)((char*)d_ws + WS_BIG), cnt);
      if (DBG_SEL >= 100) hipLaunchKernelGGL(k_dbg_time, dim3(1), dim3(64), 0, stream, (const unsigned long long*)((char*)d_ws + 768 * 1024), cnt);
      hipLaunchKernelGGL(k_dbg_emit, dim3(2048), dim3(256), 0, stream, (float*)d_out, (const float*)d_in[0], best, cnt); }
#endif
}
```

```cpp
#include <hip/hip_runtime.h>
#include <cstdio>
#include <cstdint>
#define MK_ONE 1
namespace pg8 {
#define PG8_LAS __attribute__((address_space(3)))
typedef unsigned short bf16_t;
typedef short bf16x8 __attribute__((ext_vector_type(8)));
typedef float f32x4 __attribute__((ext_vector_type(4)));
typedef unsigned u32x4 __attribute__((ext_vector_type(4)));
constexpr int BM = 256, BK = 64, HALF = 128, HTB = HALF * BK * 2  , STAGE_BYTES = 8 * HTB, NXCD = 8, WGM = 8;

__host__ __device__ __forceinline__ int lds_byte(int r, int c) { const int st = (r >> 4) * 2 + (c >> 5), rr = r & 15, cc = c & 31, ob = rr * 64 + cc * 2; return st * 1024 + (ob ^ (((ob >> 9) & 1) << 5)); }
__host__ __device__ __forceinline__ void stage_rc(int b, int& R, int& C) { const int st = b / 1024, sb = b % 1024, swz = sb ^ (((sb >> 9) & 1) << 5); R = (st >> 1) * 16 + swz / 64; C = (st & 1) * 32 + (swz % 64) / 2; }
__host__ __device__ __forceinline__ int perm32(int rho) { const int n = rho >> 4, i = rho & 15; return 8 * (i >> 2) + 4 * n + (i & 3); }

struct Unit { int pm, pn; };
struct Gemm { const bf16_t* A; const bf16_t* Bt; int M, N, K; };

struct StaticOrder {
    int nM, nN, nwg, G, c;
    __host__ __device__ void init(int M, int N, int G_, int c_) { nM = M / BM; nN = N / BM; nwg = nM * nN; G = G_; c = c_; }
    __host__ __device__ bool next(int i, Unit& u) const {
        const long L = (long)i * G + c; if (L >= nwg) return false;
        int wgid = (int)L; { const int q = nwg / NXCD, r = nwg % NXCD, xcd = wgid % NXCD, off = wgid / NXCD; wgid = (xcd < r ? xcd * (q + 1) : r * (q + 1) + (xcd - r) * q) + off; }
        const int nig = WGM * nN, gid = wgid / nig, fm = gid * WGM, gsz = (nM - fm) < WGM ? (nM - fm) : WGM;
        u.pm = fm + ((wgid % nig) % gsz); u.pn = (wgid % nig) / gsz; return true;
    }
    __device__ __forceinline__ void a_ready(const Unit&) const {}
    __device__ __forceinline__ void done(const Unit&) const {}
};
typedef __bf16 bf16x2_hw __attribute__((ext_vector_type(2))); typedef float f32x2_hw __attribute__((ext_vector_type(2)));
__device__ __forceinline__ unsigned cvt_pk_bf16(float lo, float hi) { const f32x2_hw v = {lo, hi}; return __builtin_bit_cast(unsigned, __builtin_convertvector(v, bf16x2_hw)); }
typedef float f32x2 __attribute__((ext_vector_type(2)));
__device__ __forceinline__ float fast_sigmoid(float x) { return __builtin_amdgcn_rcpf(1.0f + __expf(-x)); }
__device__ __forceinline__ float fast_silu(float x) { return x * fast_sigmoid(x); }
template <int ACT  > struct EpiBf16 {
    static constexpr bool PERM = true, AFTER_DRAIN = false;
    bf16_t* O; int ldc;
    __device__ __forceinline__ void operator()(const f32x4 (&acc)[2][2][4][2], const Unit& u, int wr, int wc, int fr, int fq) const {
        const int row0 = u.pm * BM + wr * 64 + fr; const int col0 = u.pn * BM + wc * 32 + 8 * fq;
#pragma unroll
        for (int ai = 0; ai < 2; ++ai)
#pragma unroll
            for (int m = 0; m < 4; ++m) { bf16_t* rowp = O + (size_t)(row0 + ai * HALF + m * 16) * ldc + col0;
#pragma unroll
                for (int bj = 0; bj < 2; ++bj) { f32x4 v0 = acc[ai][bj][m][0], v1 = acc[ai][bj][m][1];
                    if (ACT == 1) {
#pragma unroll
                        for (int j = 0; j < 4; ++j) { v0[j] = fast_sigmoid(v0[j]); v1[j] = fast_sigmoid(v1[j]); } }
                    u32x4 w; w.x = cvt_pk_bf16(v0[0], v0[1]); w.y = cvt_pk_bf16(v0[2], v0[3]); w.z = cvt_pk_bf16(v1[0], v1[1]); w.w = cvt_pk_bf16(v1[2], v1[3]);
                    *(u32x4*)(rowp + bj * HALF) = w; } }
    }
};
struct EpiSwiGLU {
    static constexpr bool PERM = true, AFTER_DRAIN = false;
    bf16_t* O; int ldc;
    __device__ __forceinline__ void operator()(const f32x4 (&acc)[2][2][4][2], const Unit& u, int wr, int wc, int fr, int fq) const {
        const int row0 = u.pm * BM + wr * 64 + fr; const int col0 = u.pn * HALF + wc * 32 + 8 * fq;
#pragma unroll
        for (int ai = 0; ai < 2; ++ai)
#pragma unroll
            for (int m = 0; m < 4; ++m) { bf16_t* rowp = O + (size_t)(row0 + ai * HALF + m * 16) * ldc + col0;
                const f32x4 g0 = acc[ai][0][m][0], g1 = acc[ai][0][m][1], u0 = acc[ai][1][m][0], u1 = acc[ai][1][m][1];
                f32x4 v0, v1;
#pragma unroll
                for (int j = 0; j < 4; ++j) { v0[j] = fast_silu(g0[j]) * u0[j]; v1[j] = fast_silu(g1[j]) * u1[j]; }
                u32x4 w; w.x = cvt_pk_bf16(v0[0], v0[1]); w.y = cvt_pk_bf16(v0[2], v0[3]); w.z = cvt_pk_bf16(v1[0], v1[1]); w.w = cvt_pk_bf16(v1[2], v1[3]);
                *(u32x4*)rowp = w; asm volatile("" ::: "memory"); }
    }
};
struct EpiResF32 {
    static constexpr bool PERM = false, AFTER_DRAIN = false;
    const float* base_r; float* out_r; float* hm; int ldc; int mt_real; float scale;
    __device__ __forceinline__ void operator()(const f32x4 (&acc)[2][2][4][2], const Unit& u, int wr, int wc, int fr, int fq) const {
        const bool real = u.pm < mt_real;
        const float* bp = real ? base_r + (size_t)u.pm * BM * ldc : hm; float* op = real ? out_r + (size_t)u.pm * BM * ldc : hm;
        const int row0 = wr * 64 + fr, col0 = u.pn * BM + wc * 32 + 4 * fq;
#pragma unroll
        for (int ai = 0; ai < 2; ++ai)
#pragma unroll
            for (int m = 0; m < 4; ++m) { const size_t off = (size_t)(row0 + ai * HALF + m * 16) * ldc + col0;
#pragma unroll
                for (int bj = 0; bj < 2; ++bj)
#pragma unroll
                    for (int n = 0; n < 2; ++n) { const f32x4 b = *(const f32x4*)(bp + off + bj * HALF + n * 16); *(f32x4*)(op + off + bj * HALF + n * 16) = b + acc[ai][bj][m][n] * scale; }
                asm volatile("" ::: "memory"); }
    }
};
struct EpiGateAcc {
    static constexpr bool PERM = true, AFTER_DRAIN = false;
    bf16_t* MG; int ldc; const bf16_t* G; int ldg; int gcol0; int first;
    __device__ __forceinline__ void operator()(const f32x4 (&acc)[2][2][4][2], const Unit& u, int wr, int wc, int fr, int fq) const {
        const int row0 = u.pm * BM + wr * 64 + fr; const int col0 = u.pn * BM + wc * 32 + 8 * fq;
#pragma unroll
        for (int ai = 0; ai < 2; ++ai)
#pragma unroll
            for (int m = 0; m < 4; ++m) { const size_t r = (size_t)(row0 + ai * HALF + m * 16);
#pragma unroll
                for (int bj = 0; bj < 2; ++bj) { const u32x4 gw = *(const u32x4*)(G + r * ldg + gcol0 + col0 + bj * HALF);
                    u32x4 pw = (u32x4){0u, 0u, 0u, 0u}; if (!first) pw = *(const u32x4*)(MG + r * ldc + col0 + bj * HALF);
                    float o[8];
#pragma unroll
                    for (int j = 0; j < 4; ++j) { const float a0 = (j < 2) ? acc[ai][bj][m][0][2 * j] : acc[ai][bj][m][1][2 * (j - 2)], a1 = (j < 2) ? acc[ai][bj][m][0][2 * j + 1] : acc[ai][bj][m][1][2 * (j - 2) + 1];
                        o[2 * j] = __uint_as_float(pw[j] << 16) + __uint_as_float(gw[j] << 16) * a0; o[2 * j + 1] = __uint_as_float(pw[j] & 0xffff0000u) + __uint_as_float(gw[j] & 0xffff0000u) * a1; }
                    u32x4 w; w.x = cvt_pk_bf16(o[0], o[1]); w.y = cvt_pk_bf16(o[2], o[3]); w.z = cvt_pk_bf16(o[4], o[5]); w.w = cvt_pk_bf16(o[6], o[7]);
                    *(u32x4*)(MG + r * ldc + col0 + bj * HALF) = w; } }
    }
};
template <class Epi, class Sched, bool ALIGN_EPI = false, bool SP2 = false>
__device__ __forceinline__ void gemm_phase(PG8_LAS unsigned char* lds, const Gemm g, const Sched& S, const Epi& E, int tid_in) {
    int tid_ = tid_in; asm volatile("" : "+v"(tid_));
    const int tid = tid_, wid = __builtin_amdgcn_readfirstlane(tid >> 6), lane = tid & 63, wr = wid >> 2, wc = wid & 3, fr = lane & 15, fq = lane >> 4;
    const int K = g.K, nt = K / BK;
    unsigned voffA[2], voffB[2];
#pragma unroll
    for (int i = 0; i < 2; ++i) { int R, C; stage_rc(tid * 16 + i * 8192, R, C); const int Rb = Epi::PERM ? ((R & ~31) + perm32(R & 31)) : R;
        voffA[i] = (unsigned)(R * K + C) * 2u; voffB[i] = (unsigned)(Rb * K + C) * 2u; }
    const size_t kstep = (size_t)(BK * 2);
    const size_t hstep = (size_t)HALF * K * 2;
    const size_t tstep = 2 * hstep;
    const unsigned ldsw = (unsigned)wid * 1024u;
    const int aoff = lds_byte(wr * 64 + fr, fq * 8), boff = lds_byte(wc * 32 + fr, fq * 8);
#define PG8_SA(b, h) (((b) * 2 + (h)) * HTB)
#define PG8_SB(b, h) ((4 + (b) * 2 + (h)) * HTB)
#define PG8_STAGE(bufoff, gbase, voff) do { _Pragma("unroll") for (int _i = 0; _i < 2; ++_i) \
        __builtin_amdgcn_global_load_lds((const unsigned*)((const char*)(gbase) + (voff)[_i]), (PG8_LAS unsigned*)(lds + (bufoff) + ldsw + _i * 8192), 16, 0, 0); } while (0)
#define PG8_LDA(dst, b, h) do { _Pragma("unroll") for (int m = 0; m < 4; ++m) _Pragma("unroll") for (int k = 0; k < 2; ++k) dst[m][k] = *(const PG8_LAS bf16x8*)(lds + PG8_SA(b, h) + aoff + m * 2048 + k * 1024); } while (0)
#define PG8_LDB(dst, b, h) do { _Pragma("unroll") for (int n = 0; n < 2; ++n) _Pragma("unroll") for (int k = 0; k < 2; ++k) dst[n][k] = *(const PG8_LAS bf16x8*)(lds + PG8_SB(b, h) + boff + n * 2048 + k * 1024); } while (0)
#define PG8_MMA(ai, bj, At, Bt) do { __builtin_amdgcn_s_setprio(1); _Pragma("unroll") for (int m = 0; m < 4; ++m) _Pragma("unroll") for (int n = 0; n < 2; ++n) _Pragma("unroll") for (int k = 0; k < 2; ++k) \
        acc[ai][bj][m][n] = __builtin_amdgcn_mfma_f32_16x16x32_bf16(Bt[n][k], At[m][k], acc[ai][bj][m][n], 0, 0, 0); __builtin_amdgcn_s_setprio(0); } while (0)
#define PG8_WAIT_V(n) asm volatile("s_waitcnt vmcnt(" #n ")" ::: "memory")
#define PG8_WAIT_L(n) asm volatile("s_waitcnt lgkmcnt(" #n ")" ::: "memory")
#define PG8_BAR __builtin_amdgcn_s_barrier()
#define PG8_SCHED __builtin_amdgcn_sched_barrier(0)
    Unit cur, nxt; int ui = 0;
    if (!S.next(0, cur)) return;
    f32x4 acc[2][2][4][2];
#pragma unroll
    for (int a = 0; a < 2; ++a)
#pragma unroll
        for (int b = 0; b < 2; ++b)
#pragma unroll
            for (int m = 0; m < 4; ++m)
#pragma unroll
                for (int n = 0; n < 2; ++n) acc[a][b][m][n] = (f32x4){0.f, 0.f, 0.f, 0.f};
    bf16x8 At[4][2], B0[2][2], B1[2][2];
    const char* cA = (const char*)g.A + (size_t)cur.pm * tstep; const char* cB = (const char*)g.Bt + (size_t)cur.pn * tstep;
    S.a_ready(cur);
    if constexpr (SP2) {
        PG8_STAGE(PG8_SB(0, 0), cB, voffB); PG8_STAGE(PG8_SB(0, 1), cB + hstep, voffB); PG8_STAGE(PG8_SA(0, 0), cA, voffA); PG8_STAGE(PG8_SA(0, 1), cA + hstep, voffA);
        if (wr == 1) PG8_BAR;
        PG8_WAIT_V(2); PG8_BAR;
        PG8_STAGE(PG8_SB(1, 0), cB + kstep, voffB); PG8_STAGE(PG8_SA(1, 0), cA + kstep, voffA); PG8_STAGE(PG8_SB(1, 1), cB + hstep + kstep, voffB);
        PG8_WAIT_V(6); PG8_BAR;
    } else {
        PG8_STAGE(PG8_SB(0, 0), cB, voffB); PG8_STAGE(PG8_SA(0, 0), cA, voffA); PG8_STAGE(PG8_SB(0, 1), cB + hstep, voffB); PG8_STAGE(PG8_SA(0, 1), cA + hstep, voffA);
        if (wr == 1) PG8_BAR;
        PG8_WAIT_V(4); PG8_BAR;
        PG8_STAGE(PG8_SB(1, 0), cB + kstep, voffB); PG8_STAGE(PG8_SA(1, 0), cA + kstep, voffA); PG8_STAGE(PG8_SB(1, 1), cB + hstep + kstep, voffB);
        PG8_WAIT_V(6); PG8_BAR;
    }
    for (;;) {
        const bool has_next = S.next(ui + 1, nxt);
        const char* nA = has_next ? (const char*)g.A + (size_t)nxt.pm * tstep : cA; const char* nB = has_next ? (const char*)g.Bt + (size_t)nxt.pn * tstep : cB;
        for (int t = 0; t < nt; t += 2) {
            const bool last = (t == nt - 2);
            const char* a1 = cA + (size_t)(t + 1) * kstep;
            const char* a2 = last ? nA : cA + (size_t)(t + 2) * kstep; const char* b2 = last ? nB : cB + (size_t)(t + 2) * kstep;
            const char* a3 = a2 + kstep; const char* b3 = b2 + kstep;
            if (last && has_next) S.a_ready(nxt);
            if constexpr (SP2) {
            PG8_LDB(B0, 0, 0); PG8_LDB(B1, 0, 1); PG8_SCHED; PG8_LDA(At, 0, 0); PG8_STAGE(PG8_SA(1, 1), a1 + hstep, voffA);
            PG8_WAIT_V(8); PG8_WAIT_L(0); PG8_BAR; PG8_MMA(0, 0, At, B0); PG8_MMA(0, 1, At, B1); PG8_BAR; PG8_SCHED;
            PG8_LDA(At, 0, 1); PG8_STAGE(PG8_SB(0, 0), b2, voffB); PG8_STAGE(PG8_SB(0, 1), b2 + hstep, voffB); PG8_STAGE(PG8_SA(0, 0), a2, voffA);
            PG8_WAIT_V(8); PG8_WAIT_L(0); PG8_BAR; PG8_MMA(1, 0, At, B0); PG8_MMA(1, 1, At, B1); PG8_BAR; PG8_SCHED;
            PG8_LDB(B0, 1, 0); PG8_LDB(B1, 1, 1); PG8_SCHED; PG8_LDA(At, 1, 0); PG8_STAGE(PG8_SA(0, 1), a2 + hstep, voffA);
            PG8_WAIT_V(8); PG8_WAIT_L(0); PG8_BAR; PG8_MMA(0, 0, At, B0); PG8_MMA(0, 1, At, B1); PG8_BAR; PG8_SCHED;
            PG8_LDA(At, 1, 1); PG8_STAGE(PG8_SB(1, 0), b3, voffB); PG8_STAGE(PG8_SB(1, 1), b3 + hstep, voffB); PG8_STAGE(PG8_SA(1, 0), a3, voffA);
            PG8_WAIT_V(8); PG8_WAIT_L(0); PG8_BAR; PG8_MMA(1, 0, At, B0); PG8_MMA(1, 1, At, B1); PG8_BAR; PG8_SCHED;
            } else {
            PG8_LDB(B0, 0, 0); PG8_SCHED; PG8_LDA(At, 0, 0); PG8_STAGE(PG8_SA(1, 1), a1 + hstep, voffA);
            PG8_WAIT_L(8); PG8_BAR; PG8_WAIT_L(0); PG8_MMA(0, 0, At, B0); PG8_BAR; PG8_SCHED;
            PG8_LDB(B1, 0, 1); PG8_STAGE(PG8_SB(0, 0), b2, voffB);
            PG8_BAR; PG8_WAIT_L(0); PG8_MMA(0, 1, At, B1); PG8_BAR;
            PG8_LDA(At, 0, 1); PG8_STAGE(PG8_SA(0, 0), a2, voffA);
            PG8_BAR; PG8_WAIT_L(0); PG8_MMA(1, 0, At, B0); PG8_BAR; PG8_SCHED;
            PG8_STAGE(PG8_SB(0, 1), b2 + hstep, voffB);
            PG8_WAIT_V(6); PG8_BAR; PG8_MMA(1, 1, At, B1); PG8_BAR;
            PG8_LDB(B0, 1, 0); PG8_SCHED; PG8_LDA(At, 1, 0); PG8_STAGE(PG8_SA(0, 1), a2 + hstep, voffA);
            PG8_WAIT_L(8); PG8_BAR; PG8_WAIT_L(0); PG8_MMA(0, 0, At, B0); PG8_BAR; PG8_SCHED;
            PG8_LDB(B1, 1, 1); PG8_STAGE(PG8_SB(1, 0), b3, voffB);
            PG8_BAR; PG8_WAIT_L(0); PG8_MMA(0, 1, At, B1); PG8_BAR;
            PG8_LDA(At, 1, 1); PG8_STAGE(PG8_SA(1, 0), a3, voffA);
            PG8_BAR; PG8_WAIT_L(0); PG8_MMA(1, 0, At, B0); PG8_BAR; PG8_SCHED;
            PG8_STAGE(PG8_SB(1, 1), b3 + hstep, voffB);
            PG8_WAIT_V(6); PG8_BAR; PG8_MMA(1, 1, At, B1); PG8_BAR;
            }
        }
        if constexpr (ALIGN_EPI) { if (wr == 0) PG8_BAR; }
        if constexpr (!Epi::AFTER_DRAIN) { E(acc, cur, wr, wc, fr, fq); S.done(cur); }
        if (!has_next) break;
#pragma unroll
        for (int a = 0; a < 2; ++a)
#pragma unroll
            for (int b = 0; b < 2; ++b)
#pragma unroll
                for (int m = 0; m < 4; ++m)
#pragma unroll
                    for (int n = 0; n < 2; ++n) acc[a][b][m][n] = (f32x4){0.f, 0.f, 0.f, 0.f};
        cur = nxt; cA = nA; cB = nB; ++ui;
        if constexpr (ALIGN_EPI) { if (wr == 1) PG8_BAR; }
    }
    PG8_WAIT_V(0);
    if constexpr (!ALIGN_EPI) { if (wr == 0) PG8_BAR; }
    PG8_BAR;
    if constexpr (Epi::AFTER_DRAIN) { E.fused(acc, cur, wr, wc, fr, fq, lds, wid, lane); S.done(cur); }
#undef PG8_SA
#undef PG8_SB
#undef PG8_STAGE
#undef PG8_LDA
#undef PG8_LDB
#undef PG8_MMA
#undef PG8_WAIT_V
#undef PG8_WAIT_L
#undef PG8_BAR
#undef PG8_SCHED
}
}

constexpr int DM = 2048, NB = 8, SEQ = 4096, NMETA = 16, LSEQ = 4112, LPAD = 4128;
constexpr int MREAL = NB * SEQ;
constexpr int MPAD = MREAL + 256;
constexpr int MT_REAL = MREAL / 256;
constexpr int DFF = 5632, NGU = 2 * DFF, NNG = 7168, NGATE = 8192, INCOLS = 15184, NGC = 6992;
constexpr int NWAVES = 8;
constexpr float EPS = 1e-6f;
constexpr int C_AQ = 0, C_AF = 512, C_AI = 1024, C_AG = 1536, C_BB = 2048, C_BC = 2560, C_BU = 3072, C_CQ = 3584, C_CK = 4096, C_CV = 4608,
              C_DQ = 5120, C_DK = 5632, C_DV = 5760, C_DQI = 5888, C_DKI = 6912, C_DW = 6976;

constexpr size_t MiB = 1u << 20;
constexpr size_t WS_CTL = 0, CTL_ZERO_BYTES = 1 * MiB;
constexpr size_t WS_HM = 1 * MiB;
constexpr size_t WS_W = 4 * MiB;
constexpr size_t W_GU1 = 0, W_D1 = W_GU1 + (size_t)NGU * DM * 2, W_NG = W_D1 + (size_t)DM * DFF * 2, W_G = W_NG + (size_t)NNG * DM * 2,
                 W_BR = W_G + (size_t)NGATE * DM * 2, W_O = W_BR + (size_t)4 * DM * 512 * 2, W_GU2 = W_O + (size_t)DM * DM * 2, W_D2 = W_GU2 + (size_t)NGU * DM * 2,
                 W_END = W_D2 + (size_t)DM * DFF * 2;
constexpr size_t WS_XN = WS_W + W_END;
constexpr size_t WS_BR = WS_XN + (size_t)MPAD * DM * 2;
constexpr size_t WS_BIG = WS_BR + (size_t)MPAD * DM * 2;
constexpr size_t BIG_P_END = (size_t)MPAD * NNG * 2;
constexpr size_t WS_VTC = WS_BIG + BIG_P_END;
constexpr size_t WS_VTD = WS_VTC + (size_t)NB * 4 * 128 * LPAD * 2;
constexpr size_t WS_MASK = WS_VTD + (size_t)NB * 128 * LPAD * 2;
constexpr int MASKW = 132;
constexpr int NIDX_WG = 172;
constexpr int NHG_WG = 32;
constexpr size_t WS_SCR = WS_MASK + (size_t)NB * LPAD * MASKW * 4;
constexpr size_t WS_HA = WS_SCR + (size_t)NIDX_WG * 32 * LPAD * 4;
constexpr size_t WS_HDL = WS_HA + (size_t)NB * 4 * 64 * 64 * 64 * 2;
constexpr size_t WS_HMETA = WS_HDL + (size_t)NB * 4 * 64 * 128 * 4;
constexpr size_t HMETA_STRIDE = 64 * 384 * 2 + 64 * 64 * 2 + 128 * 4;
constexpr size_t WS_END = WS_HMETA + 4 * HMETA_STRIDE;
static_assert(WS_BIG + (size_t)MPAD * NGATE * 2 <= WS_END, "G fits");
static_assert(WS_END <= (size_t)1138174976, "workspace map fits the guaranteed size");

constexpr int RING_OFF = 0, RING_BYTES = 131072;
constexpr int LDSCTL_OFF = 143360, MISC_OFF = LDSCTL_OFF + 320;
constexpr int LDS_BYTES = 147456;

#define GAS __attribute__((address_space(1)))
#define LAS __attribute__((address_space(3)))
typedef unsigned short bf16;
typedef unsigned v4u __attribute__((ext_vector_type(4)));
typedef unsigned v2u __attribute__((ext_vector_type(2)));
typedef float f32x4 __attribute__((ext_vector_type(4)));
typedef float f32x16 __attribute__((ext_vector_type(16)));
typedef short bf16x8 __attribute__((ext_vector_type(8)));
typedef GAS unsigned gu32;
#define RLX_AGENT __ATOMIC_RELAXED, __HIP_MEMORY_SCOPE_AGENT
#define LDS_WAIT() asm volatile("s_waitcnt lgkmcnt(0)" ::: "memory")
#define VM_WAIT() asm volatile("s_waitcnt vmcnt(0)" ::: "memory")
__device__ __forceinline__ unsigned f2bf(float f) { unsigned u = __builtin_bit_cast(unsigned, f); return (u + 0x7fffu + ((u >> 16) & 1u)) >> 16; }
__device__ __forceinline__ unsigned f2bf_s(float f) { return pg8::cvt_pk_bf16(f, 0.f) & 0xffffu; }
__device__ __forceinline__ unsigned pk2(float lo, float hi) { return pg8::cvt_pk_bf16(lo, hi); }
__device__ __forceinline__ float bflo(unsigned w) { return __uint_as_float(w << 16); }
__device__ __forceinline__ float bfhi(unsigned w) { return __uint_as_float(w & 0xffff0000u); }
__device__ __forceinline__ float bf2f(bf16 v) { return __uint_as_float((unsigned)v << 16); }
__device__ __forceinline__ int seqrow(int b, int p) { return p < NMETA ? MREAL + p : b * SEQ + p - NMETA; }
__device__ __forceinline__ int rel_bucket(int n) {
    if (n < 16) return n; if (n >= 128) return 31;
    const int v = 16 + (int)(__log2f((float)n * 0.0625f) * 5.33333333f); return v < 31 ? v : 31; }
__device__ __forceinline__ float wave_sum(float v) {
#pragma unroll
    for (int o = 1; o < 64; o <<= 1) v += __shfl_xor(v, o);
    return v;
}
#define XB_TMO      128
#define XB_XCNT(j)  (256  + 64 * (j))
#define XB_XSUB(j)  (1280 + 64 * (j))
#define XB_XGEN(j)  (2304 + 64 * (j))
#define XB_TOP      3328
#define XB_TOPGEN   3392
#define XCD_BAR_WORDS 3456
#define XB_SPIN_CAP (1u << 18)

__device__ __forceinline__ unsigned xb_ld(unsigned* p)              { return __hip_atomic_load(p, __ATOMIC_RELAXED, __HIP_MEMORY_SCOPE_AGENT); }
__device__ __forceinline__ unsigned xb_add(unsigned* p, unsigned v) { return __hip_atomic_fetch_add(p, v, __ATOMIC_RELAXED, __HIP_MEMORY_SCOPE_AGENT); }
__device__ __forceinline__ unsigned xb_xcc_id() { return (unsigned)__builtin_amdgcn_s_getreg((3 << 11) | 20) & 0xFu; }
#define XB_SPIN(cond, bar) do { unsigned _sp = 0; while (cond) { __builtin_amdgcn_s_sleep(1); \
    if ((++_sp & 255u) == 0u) { if (xb_ld(&(bar)[XB_TMO])) break; if (_sp > XB_SPIN_CAP) { atomicAdd(&(bar)[XB_TMO], 1u); break; } } } } while (0)

struct XcdBarrier {
    int wave;
    unsigned* bar; unsigned x;
    volatile LAS unsigned* st;
};

__device__ __forceinline__ bool xb_thread0(int wave) { unsigned mk = ~0u; asm volatile("" : "+s"(mk)); return wave == 0 && __builtin_amdgcn_mbcnt_hi(mk, __builtin_amdgcn_mbcnt_lo(mk, 0u)) == 0u; }
__device__ __forceinline__ XcdBarrier xcd_barrier_post(unsigned* bar, volatile LAS unsigned* st, int wave) {
    XcdBarrier b; b.wave = wave; b.bar = bar; b.x = xb_xcc_id(); b.st = st;
    if (xb_thread0(wave)) (void)xb_add(&bar[XB_XCNT(b.x)], 1u);
    return b;
}
__device__ __forceinline__ void xcd_barrier_complete(unsigned* bar, unsigned x, unsigned& nloc, unsigned& nx) {
    const unsigned G = gridDim.x * gridDim.y * gridDim.z;
    unsigned sum, cnt, mine, sp = 0u;
    for (;;) {
        sum = 0u; cnt = 0u; mine = 0u;
#pragma unroll
        for (unsigned j = 0; j < 16; ++j) { const unsigned c = xb_ld(&bar[XB_XCNT(j)]); sum += c; cnt += (c > 0u) ? 1u : 0u; mine = (j == x) ? c : mine; }
        if (sum == G) break;
        __builtin_amdgcn_s_sleep(1);
        if ((++sp & 255u) == 0u) { if (xb_ld(&bar[XB_TMO])) break; if (sp > XB_SPIN_CAP) { atomicAdd(&bar[XB_TMO], 1u); break; } }
    }
    nloc = mine > 0u ? mine : 1u; nx = cnt > 0u ? cnt : 1u;
}

__device__ __forceinline__ void xcd_barrier(const XcdBarrier& b) {
    asm volatile("s_waitcnt vmcnt(0)" ::: "memory");
    __syncthreads();
    if (xb_thread0(b.wave)) {
        unsigned* bar = b.bar;
        __builtin_amdgcn_s_waitcnt(0);
        unsigned nloc = b.st[0], nx = b.st[1];
        if (nloc == 0u) { xcd_barrier_complete(bar, b.x, nloc, nx); b.st[0] = nloc; b.st[1] = nx; }
        const unsigned old = xb_add(&bar[XB_XSUB(b.x)], 1u);
        const unsigned gen = old / nloc;
        if (old + 1u == (gen + 1u) * nloc) {
            __builtin_amdgcn_fence(__ATOMIC_RELEASE, "agent");
            asm volatile("s_waitcnt vmcnt(0)" ::: "memory");
            const unsigned og = xb_add(&bar[XB_TOP], 1u);
            const unsigned tg = og / nx;
            if (og + 1u == (tg + 1u) * nx) xb_add(&bar[XB_TOPGEN], 1u);
            else XB_SPIN(xb_ld(&bar[XB_TOPGEN]) == tg, bar);
            __builtin_amdgcn_fence(__ATOMIC_ACQUIRE, "agent");
            xb_add(&bar[XB_XGEN(b.x)], 1u);
            asm volatile("s_waitcnt vmcnt(0)" ::: "memory");
        } else {
            XB_SPIN(xb_ld(&bar[XB_XGEN(b.x)]) == gen, bar);
            __builtin_amdgcn_fence(__ATOMIC_ACQUIRE, "agent");
            asm volatile("s_waitcnt vmcnt(0)" ::: "memory");
        }
    }
    __syncthreads();
}

struct Frame {
    LAS unsigned char* lds;
    volatile LAS unsigned* MISC;
    gu32* ctl;
    int tid, lane, wave, G, bid;
    const unsigned char __attribute__((address_space(4)))* karg; float* out; unsigned char* ws;
};
__device__ __forceinline__ const float* fin_load(const unsigned char __attribute__((address_space(4)))* k, int i) { asm volatile("" : "+s"(k)); return *(const float* const __attribute__((address_space(4)))*)(k + 8 * i); }
#define FIN(F_, i_) fin_load((F_).karg, (i_))
enum { I_X = 0, I_META, I_RELB, I_F1N, I_F1GU, I_F1D, I_MIXN, I_WIN, I_LB, I_GN, I_CONVW, I_DQN, I_DKN, I_DLAM, I_DSUB, I_SQN, I_SKN, I_WBR, I_WOUT, I_F2N, I_F2GU, I_F2D };

template <class RowMap>
__device__ __forceinline__ void transpose_item(const float* W, int K, int N, bf16* WT, LAS float* scr, int item, int lane, RowMap rm) {
    const int nblk = (N + 31) / 32, kb = item / nblk, nb = item % nblk, k0 = 64 * kb, n0 = 32 * nb;
    const int nl = n0 + (lane & 31); const bool nok = nl < N;
#pragma unroll 8
    for (int i = 0; i < 32; ++i) { const int kk = 2 * i + (lane >> 5); scr[kk * 33 + (lane & 31)] = nok ? W[(size_t)(k0 + kk) * N + nl] : 0.f; }
    LDS_WAIT(); asm volatile("" ::: "memory");
    const int c = lane & 7;
#pragma unroll
    for (int j = 0; j < 4; ++j) { const int n = (lane >> 3) + 8 * j; const LAS float* s = scr + (8 * c) * 33 + n;
        v4u o; o.x = pk2(s[0 * 33], s[1 * 33]); o.y = pk2(s[2 * 33], s[3 * 33]); o.z = pk2(s[4 * 33], s[5 * 33]); o.w = pk2(s[6 * 33], s[7 * 33]);
        if (n0 + n < N) *(GAS v4u*)(WT + (size_t)rm(n0 + n) * K + k0 + 8 * c) = o; }
    LDS_WAIT(); asm volatile("" ::: "memory");
}
struct MapId { __device__ __forceinline__ int operator()(int n) const { return n; } };
struct MapGU { __device__ __forceinline__ int operator()(int n) const { const int up = n >= DFF, j = up ? n - DFF : n; return 256 * (j >> 7) + 128 * up + (j & 127); } };
struct MapIn { __device__ __forceinline__ int operator()(int n) const { return n < NGC ? n : n + (NNG - NGC); } };
template <class RowMap>
__device__ __forceinline__ void convert_matrix(Frame& F, const float* W, int K, int N, bf16* WT, RowMap rm) {
    LAS float* scr = (LAS float*)(F.lds + F.wave * 16384);
    const int gw = F.bid * NWAVES + F.wave, NGW = F.G * NWAVES, nitems = (K / 64) * ((N + 31) / 32);
    for (int it = gw; it < nitems; it += NGW) transpose_item(W, K, N, WT, scr, it, F.lane, rm);
}
__device__ __forceinline__ void phase_convert(Frame& F, int l) {
    unsigned char* wb = F.ws + WS_W;
    convert_matrix(F, FIN(F, I_F1GU) + (size_t)l * DM * NGU, DM, NGU, (bf16*)(wb + W_GU1), MapGU());
    convert_matrix(F, FIN(F, I_F1D) + (size_t)l * DFF * DM, DFF, DM, (bf16*)(wb + W_D1), MapId());
    convert_matrix(F, FIN(F, I_WIN) + (size_t)l * DM * INCOLS, DM, INCOLS, (bf16*)(wb + W_NG), MapIn());
    for (int m = 0; m < 4; ++m) convert_matrix(F, FIN(F, I_WBR) + ((size_t)l * 4 + m) * 512 * DM, 512, DM, (bf16*)(wb + W_BR) + (size_t)m * DM * 512, MapId());
    convert_matrix(F, FIN(F, I_WOUT) + (size_t)l * DM * DM, DM, DM, (bf16*)(wb + W_O), MapId());
    convert_matrix(F, FIN(F, I_F2GU) + (size_t)l * DM * NGU, DM, NGU, (bf16*)(wb + W_GU2), MapGU());
    convert_matrix(F, FIN(F, I_F2D) + (size_t)l * DFF * DM, DFF, DM, (bf16*)(wb + W_D2), MapId());
    { GAS v4u* z = (GAS v4u*)(wb + W_NG + (size_t)NGC * DM * 2); const int n16 = (NNG - NGC) * DM * 2 / 16;
      for (int i = F.bid * 512 + F.tid; i < n16; i += F.G * 512) z[i] = (v4u){0u, 0u, 0u, 0u}; }
    if (l == 0) {
        GAS f32x4* hm = (GAS f32x4*)(F.ws + WS_HM); const GAS f32x4* mt = (const GAS f32x4*)FIN(F, I_META);
        for (int i = F.bid * 512 + F.tid; i < 256 * DM / 4; i += F.G * 512) hm[i] = (i < NMETA * DM / 4) ? mt[i] : (f32x4){0.f, 0.f, 0.f, 0.f};
    }
}
__device__ __forceinline__ void phase_norm(Frame& F, const float* src_real, const float* gain) {
    const int gw = F.bid * NWAVES + F.wave, NGW = F.G * NWAVES;
    bf16* XN = (bf16*)(F.ws + WS_XN); const float* hm = (const float*)(F.ws + WS_HM);
    f32x4 g[8];
#pragma unroll
    for (int j = 0; j < 8; ++j) g[j] = ((const GAS f32x4*)gain)[F.lane + 64 * j];
    for (int r = gw; r < MPAD; r += NGW) {
        GAS v2u* o8 = (GAS v2u*)(XN + (size_t)r * DM) + F.lane;
        if (r >= MREAL + NMETA) {
#pragma unroll
            for (int j = 0; j < 8; ++j) o8[64 * j] = (v2u){0u, 0u};
            continue; }
        const float* xr = r < MREAL ? src_real + (size_t)r * DM : hm + (size_t)(r - MREAL) * DM;
        f32x4 v[8]; float s = 0.f;
#pragma unroll
        for (int j = 0; j < 8; ++j) { v[j] = ((const GAS f32x4*)xr)[F.lane + 64 * j]; s += (v[j].x * v[j].x + v[j].y * v[j].y) + (v[j].z * v[j].z + v[j].w * v[j].w); }
        const float inv = 1.0f / sqrtf(wave_sum(s) * (1.f / DM) + EPS);
#pragma unroll
        for (int j = 0; j < 8; ++j) { v2u w; w.x = pk2(v[j].x * inv * g[j].x, v[j].y * inv * g[j].y); w.y = pk2(v[j].z * inv * g[j].z, v[j].w * inv * g[j].w); o8[64 * j] = w; }
    }
}

__device__ __forceinline__ f32x4 meta_dot16(const bf16* A  , int lda, const bf16* Bt  , int K, int lane) {
    const int fr = lane & 15, g = lane >> 4; const bf16* ap = A + (size_t)fr * lda + 8 * g; const bf16* bp = Bt + (size_t)fr * K + 8 * g;
    f32x4 a0 = (f32x4){0.f, 0.f, 0.f, 0.f}, a1 = a0, a2 = a0, a3 = a0;
    for (int k = 0; k < K; k += 128) {
        const bf16x8 x0 = *(const GAS bf16x8*)(ap + k), x1 = *(const GAS bf16x8*)(ap + k + 32), x2 = *(const GAS bf16x8*)(ap + k + 64), x3 = *(const GAS bf16x8*)(ap + k + 96);
        const bf16x8 w0 = *(const GAS bf16x8*)(bp + k), w1 = *(const GAS bf16x8*)(bp + k + 32), w2 = *(const GAS bf16x8*)(bp + k + 64), w3 = *(const GAS bf16x8*)(bp + k + 96);
        a0 = __builtin_amdgcn_mfma_f32_16x16x32_bf16(w0, x0, a0, 0, 0, 0); a1 = __builtin_amdgcn_mfma_f32_16x16x32_bf16(w1, x1, a1, 0, 0, 0);
        a2 = __builtin_amdgcn_mfma_f32_16x16x32_bf16(w2, x2, a2, 0, 0, 0); a3 = __builtin_amdgcn_mfma_f32_16x16x32_bf16(w3, x3, a3, 0, 0, 0); }
    return (a0 + a1) + (a2 + a3);
}
__device__ __forceinline__ void st_bf16x4(bf16* p, f32x4 v) { v2u w; w.x = pk2(v[0], v[1]); w.y = pk2(v[2], v[3]); *(GAS v2u*)p = w; }
__device__ __forceinline__ void meta_gemm(Frame& F, int kind, const bf16* A, int lda, const bf16* Bt, int N, int K, bf16* Obf, int ldo, float scale) {
    const int gw = F.bid * NWAVES + F.wave, NGW = F.G * NWAVES, lane = F.lane, fr = lane & 15, g = lane >> 4;
    const int ngroups = (kind == 0 ? N / 2 : N) / 16;
    for (int cg = gw; cg < ngroups; cg += NGW) {
        const int n0 = 16 * cg;
        if (kind == 0) { const int j0 = n0, rg = 256 * (j0 >> 7) + (j0 & 127);
            const f32x4 gt = meta_dot16(A, lda, Bt + (size_t)rg * K, K, lane), up = meta_dot16(A, lda, Bt + (size_t)(rg + 128) * K, K, lane); f32x4 v;
#pragma unroll
            for (int r = 0; r < 4; ++r) v[r] = pg8::fast_silu(gt[r]) * up[r];
            st_bf16x4(Obf + (size_t)(MREAL + fr) * ldo + n0 + 4 * g, v); }
        else if (kind == 1) { const f32x4 acc = meta_dot16(A, lda, Bt + (size_t)n0 * K, K, lane); float* hp = (float*)(F.ws + WS_HM) + (size_t)fr * DM + n0 + 4 * g;
            *(GAS f32x4*)hp = *(const GAS f32x4*)hp + acc * scale; }
        else if (kind == 2) { st_bf16x4(Obf + (size_t)(MREAL + fr) * ldo + n0 + 4 * g, meta_dot16(A, lda, Bt + (size_t)n0 * K, K, lane)); }
        else if (kind == 3) { f32x4 acc = meta_dot16(A, lda, Bt + (size_t)n0 * K, K, lane);
#pragma unroll
            for (int r = 0; r < 4; ++r) acc[r] = pg8::fast_sigmoid(acc[r]);
            st_bf16x4(Obf + (size_t)(MREAL + fr) * ldo + n0 + 4 * g, acc); }
        else { f32x4 tot = (f32x4){0.f, 0.f, 0.f, 0.f}; const bf16* G = (const bf16*)(F.ws + WS_BIG);
            for (int mb = 0; mb < 4; ++mb) { const f32x4 acc = meta_dot16(A + (size_t)mb * MPAD * 512, 512, Bt + ((size_t)mb * DM + n0) * 512, 512, lane);
                const v2u gw2 = *(const GAS v2u*)(G + (size_t)(MREAL + fr) * NGATE + mb * DM + n0 + 4 * g);
                tot[0] += bflo(gw2.x) * acc[0]; tot[1] += bfhi(gw2.x) * acc[1]; tot[2] += bflo(gw2.y) * acc[2]; tot[3] += bfhi(gw2.y) * acc[3]; }
            st_bf16x4(Obf + (size_t)(MREAL + fr) * ldo + n0 + 4 * g, tot); }
    }
}
__device__ __forceinline__ void unpack8(const v4u w, float (&x)[8]) { x[0] = bflo(w.x); x[1] = bfhi(w.x); x[2] = bflo(w.y); x[3] = bfhi(w.y); x[4] = bflo(w.z); x[5] = bfhi(w.z); x[6] = bflo(w.w); x[7] = bfhi(w.w); }
__device__ __forceinline__ v4u pack8(const float (&x)[8]) { v4u w; w.x = pk2(x[0], x[1]); w.y = pk2(x[2], x[3]); w.z = pk2(x[4], x[5]); w.w = pk2(x[6], x[7]); return w; }
template <int GL>
__device__ __forceinline__ void norm_cols_inplace(bf16* p, const float* gain, float scale, int lane, bool wr) {
    float x[8]; unpack8(*(const GAS v4u*)p, x); float s = 0.f;
#pragma unroll
    for (int i = 0; i < 8; ++i) s += x[i] * x[i];
#pragma unroll
    for (int o = 1; o < GL; o <<= 1) s += __shfl_xor(s, o);
    const float inv = scale / sqrtf(s * (1.f / (GL * 8)) + EPS); const int g0 = (8 * lane) % (GL * 8);
#pragma unroll
    for (int i = 0; i < 8; ++i) x[i] = x[i] * inv * gain[g0 + i];
    if (wr) *(GAS v4u*)p = pack8(x);
}
__device__ __forceinline__ void phase_prep(Frame& F, int l) {
    const int gw = F.bid * NWAVES + F.wave, NGW = F.G * NWAVES, lane = F.lane;
    bf16* P = (bf16*)(F.ws + WS_BIG);
    const float *dqn = FIN(F, I_DQN) + l * 64, *dkn = FIN(F, I_DKN) + l * 64, *sqn = FIN(F, I_SQN) + l * 128, *skn = FIN(F, I_SKN) + l * 128;
    for (int r = gw; r < MREAL + NMETA; r += NGW) {
        bf16* pr = P + (size_t)r * NNG;
        norm_cols_inplace<8>(pr + C_CQ + 8 * lane, dqn, 0.125f, lane, true);
        norm_cols_inplace<8>(pr + C_CK + 8 * lane, dkn, 1.0f, lane, true);
        norm_cols_inplace<16>(pr + C_DQ + 8 * lane, sqn, 0.08838834764831845f, lane, true);
        norm_cols_inplace<16>(pr + C_DK + 8 * (lane & 15), skn, 1.0f, lane & 15, lane < 16);
    }
}
__device__ __forceinline__ void phase_vt(Frame& F) {
    const int gw = F.bid * NWAVES + F.wave, NGW = F.G * NWAVES, lane = F.lane;
    const bf16* P = (const bf16*)(F.ws + WS_BIG); bf16* VtC = (bf16*)(F.ws + WS_VTC); bf16* VtD = (bf16*)(F.ws + WS_VTD);
    LAS bf16* T = (LAS bf16*)(F.lds + F.wave * 17408);
    constexpr int NPB = (LPAD + 63) / 64;
    for (int task = gw; task < NB * 5 * NPB; task += NGW) {
        const int pb = task % NPB, mat = (task / NPB) % 5, b = task / (NPB * 5), p0 = 64 * pb;
        const int col = mat < 4 ? C_CV + 128 * mat : C_DV;
#pragma unroll 4
        for (int i = 0; i < 16; ++i) { const int pl = 4 * i + (lane >> 4), p = p0 + pl;
            v4u w = *(const GAS v4u*)(P + (size_t)seqrow(b, p < LSEQ ? p : LSEQ - 1) * NNG + col + 8 * (lane & 15)); if (p >= LSEQ) w = (v4u){0u, 0u, 0u, 0u};
            *(LAS v4u*)(T + pl * 136 + 8 * (lane & 15)) = w; }
        LDS_WAIT(); asm volatile("" ::: "memory");
        bf16* dst = mat < 4 ? VtC + (size_t)(b * 4 + mat) * 128 * LPAD : VtD + (size_t)b * 128 * LPAD;
#pragma unroll 4
        for (int it = 0; it < 16; ++it) { const int e = 8 * it + (lane >> 3), c = lane & 7; unsigned short x[8];
#pragma unroll
            for (int k = 0; k < 8; ++k) x[k] = T[(8 * c + k) * 136 + e];
            v4u w; w.x = x[0] | ((unsigned)x[1] << 16); w.y = x[2] | ((unsigned)x[3] << 16); w.z = x[4] | ((unsigned)x[5] << 16); w.w = x[6] | ((unsigned)x[7] << 16);
            if (p0 + 8 * c < LPAD) *(GAS v4u*)(dst + (size_t)e * LPAD + p0 + 8 * c) = w; }
        LDS_WAIT(); asm volatile("" ::: "memory");
    }
}

#define NEG_INF (-__builtin_inff())
constexpr int NQT = (LSEQ + 31) / 32;
constexpr int NQB = (NQT + 7) / 8;
__device__ __forceinline__ bf16x8 ld_frag16(const bf16* p) { return *(const GAS bf16x8*)p; }
__device__ __forceinline__ bf16x8 mk_frag(v2u lo, v2u hi) { v4u w; w.x = lo.x; w.y = lo.y; w.z = hi.x; w.w = hi.y; return __builtin_bit_cast(bf16x8, w); }
__device__ __forceinline__ unsigned cvtpk(float lo, float hi) { return pg8::cvt_pk_bf16(lo, hi); }
__device__ __forceinline__ void build_bias_table(Frame& F, LAS float* bt, int col0) {
    const float* rb = FIN(F, I_RELB);
    for (int i = F.tid; i < 4 * 128; i += 512) { const int hd = i >> 7, n = i & 127; bt[i] = rb[rel_bucket(n) * 8 + col0 + hd]; }
}
__device__ __forceinline__ bool softmax_step(f32x16& S, float& m, float& lsum, float& alpha) {
    float tm = S[0];
#pragma unroll
    for (int r = 1; r < 16; ++r) tm = fmaxf(tm, S[r]);
    tm = fmaxf(tm, __shfl_xor(tm, 32));
    const bool raise = __any(tm > m + 8.0f);
    alpha = 1.0f;
    if (raise) { const float mn = fmaxf(m, tm); alpha = (mn == NEG_INF) ? 1.0f : __expf(m - mn); m = mn; lsum *= alpha; }
    const float mref = (m == NEG_INF) ? 0.f : m;
    float rs = 0.f;
#pragma unroll
    for (int r = 0; r < 16; ++r) { S[r] = __expf(S[r] - mref); rs += S[r]; }
    rs += __shfl_xor(rs, 32);
    lsum += rs;
    return raise;
}
template <bool DSA>
__device__ __forceinline__ void attn_wg_task(Frame& F, int l, int b, int h, int J, const LAS float* bt, float lam, float post) {
    constexpr int KD = DSA ? 128 : 64, KP = KD + 8, VP = 36, NKS = KD / 16;
    constexpr int KBUF = 32 * KP, VBUF = 128 * VP;
    const int lane = F.lane, ql = lane & 31, hh = lane >> 5, wave = F.wave, tid = F.tid;
    LAS bf16* Kl = (LAS bf16*)F.lds; LAS bf16* Vl = Kl + 2 * KBUF;
    const bf16* P = (const bf16*)(F.ws + WS_BIG);
    const bf16* Vt = DSA ? (const bf16*)(F.ws + WS_VTD) + (size_t)b * 128 * LPAD : (const bf16*)(F.ws + WS_VTC) + (size_t)(b * 4 + h) * 128 * LPAD;
    const int j = 8 * J + wave; const bool wvalid = 32 * j < LSEQ;
    const int ktmax = (8 * J + 7 < NQT - 1) ? 8 * J + 7 : NQT - 1;
    const int pq = 32 * j + ql, pqc = pq < LSEQ ? pq : LSEQ - 1;
    const bf16* qrow = P + (size_t)seqrow(b, pqc) * NNG + (DSA ? C_DQ : C_CQ) + h * 128 + 8 * hh;
    const unsigned* mrow = (const unsigned*)(F.ws + WS_MASK) + ((size_t)b * LPAD + pqc) * MASKW;
    const float b31 = bt[h * 128 + 127];
    const int kr = tid / (KD / 8), kc = tid % (KD / 8); const bool kload = tid < 32 * (KD / 8);
    const int vr = tid >> 2, vc = tid & 3;
    f32x16 R[4];
#pragma unroll
    for (int c = 0; c < (DSA ? 1 : 2); ++c) {
        const int kcol = DSA ? C_DK : C_CK + h * 128 + c * 64;
        bf16x8 qf[NKS];
#pragma unroll
        for (int ks = 0; ks < NKS; ++ks) qf[ks] = ld_frag16(qrow + (DSA ? 0 : c * 64) + 16 * ks);
        float m = NEG_INF, lsum = 0.f; f32x16 O[4];
#pragma unroll
        for (int eb = 0; eb < 4; ++eb)
#pragma unroll
            for (int r = 0; r < 16; ++r) O[eb][r] = 0.f;
        v4u rk0 = (v4u){0u, 0u, 0u, 0u}, rv0 = rk0, rk1 = rk0, rv1 = rk0;
#define ATT_ISSUE(kt_, RK, RV) do { int pk_ = 32 * (kt_) + kr; pk_ = pk_ < LSEQ ? pk_ : LSEQ - 1; \
            if (kload) RK = *(const GAS v4u*)(P + (size_t)seqrow(b, pk_) * NNG + kcol + 8 * kc); \
            RV = *(const GAS v4u*)(Vt + (size_t)vr * LPAD + 32 * (kt_) + 8 * vc); } while (0)
#define ATT_COMMIT(buf_, RK, RV) do { if (kload) *(LAS v4u*)(Kl + (buf_) * KBUF + kr * KP + 8 * kc) = RK; \
            LAS v2u* vd_ = (LAS v2u*)(Vl + (buf_) * VBUF + vr * VP + 8 * vc); vd_[0] = (v2u){RV.x, RV.y}; vd_[1] = (v2u){RV.z, RV.w}; } while (0)
        auto compute = [&](int kt, int buf) {
            if (wvalid && kt <= j) {
                const LAS bf16* Kt = Kl + buf * KBUF + ql * KP + 8 * hh; const LAS bf16* Vb = Vl + buf * VBUF + ql * VP + 4 * hh;
                f32x16 S;
#pragma unroll
                for (int r = 0; r < 16; ++r) S[r] = 0.f;
#pragma unroll
                for (int ks = 0; ks < NKS; ++ks) S = __builtin_amdgcn_mfma_f32_32x32x16_bf16(*(const LAS bf16x8*)(Kt + 16 * ks), qf[ks], S, 0, 0, 0);
                unsigned mw = 0xffffffffu; if (DSA) mw = mrow[kt] >> (4 * hh);
                if (kt + 4 >= j) {
#pragma unroll
                    for (int r = 0; r < 16; ++r) { const int ko = (r & 3) + 8 * (r >> 2), n = pq - (32 * kt + 4 * hh + ko); const bool sel = ((mw >> ko) & 1u) && n >= 0;
                        S[r] = sel ? S[r] + bt[h * 128 + (n < 127 ? n : 127)] : NEG_INF; }
                } else {
#pragma unroll
                    for (int r = 0; r < 16; ++r) { const int ko = (r & 3) + 8 * (r >> 2); S[r] = (!DSA || ((mw >> ko) & 1u)) ? S[r] + b31 : NEG_INF; }
                }
                float alpha;
                if (softmax_step(S, m, lsum, alpha)) {
#pragma unroll
                    for (int eb = 0; eb < 4; ++eb)
#pragma unroll
                        for (int r = 0; r < 16; ++r) O[eb][r] *= alpha;
                }
                bf16x8 pf[2];
#pragma unroll
                for (int s = 0; s < 2; ++s) { v4u w; w.x = cvtpk(S[8 * s + 0], S[8 * s + 1]); w.y = cvtpk(S[8 * s + 2], S[8 * s + 3]); w.z = cvtpk(S[8 * s + 4], S[8 * s + 5]); w.w = cvtpk(S[8 * s + 6], S[8 * s + 7]); pf[s] = __builtin_bit_cast(bf16x8, w); }
#pragma unroll
                for (int eb = 0; eb < 4; ++eb)
#pragma unroll
                    for (int s = 0; s < 2; ++s) { const LAS bf16* vp = Vb + eb * 32 * VP + 16 * s;
                        O[eb] = __builtin_amdgcn_mfma_f32_32x32x16_bf16(mk_frag(*(const LAS v2u*)vp, *(const LAS v2u*)(vp + 8)), pf[s], O[eb], 0, 0, 0); }
            } };
        __syncthreads();
        ATT_ISSUE(0, rk0, rv0); ATT_COMMIT(0, rk0, rv0);
        if (ktmax >= 1) ATT_ISSUE(1, rk1, rv1);
        for (int kt = 0; kt <= ktmax; kt += 2) {
            LDS_WAIT(); __syncthreads();
            if (kt + 2 <= ktmax) ATT_ISSUE(kt + 2, rk0, rv0);
            compute(kt, 0);
            if (kt + 1 <= ktmax) ATT_COMMIT(1, rk1, rv1);
            if (kt + 1 > ktmax) break;
            LDS_WAIT(); __syncthreads();
            if (kt + 3 <= ktmax) ATT_ISSUE(kt + 3, rk1, rv1);
            compute(kt + 1, 1);
            if (kt + 2 <= ktmax) ATT_COMMIT(0, rk0, rv0);
        }
#undef ATT_ISSUE
#undef ATT_COMMIT
        const float il = 1.0f / lsum;
        if (DSA) {
#pragma unroll
            for (int eb = 0; eb < 4; ++eb)
#pragma unroll
                for (int r = 0; r < 16; ++r) R[eb][r] = O[eb][r] * il;
        } else if (c == 0) {
            LAS unsigned* rp = (LAS unsigned*)(F.lds + 28672) + wave * 2048 + lane;
#pragma unroll
            for (int eb = 0; eb < 4; ++eb)
#pragma unroll
                for (int r = 0; r < 16; r += 2) rp[(eb * 8 + (r >> 1)) * 64] = pk2(O[eb][r] * il, O[eb][r + 1] * il);
        } else {
            const LAS unsigned* rp = (const LAS unsigned*)(F.lds + 28672) + wave * 2048 + lane;
#pragma unroll
            for (int eb = 0; eb < 4; ++eb)
#pragma unroll
                for (int r = 0; r < 16; r += 2) { const unsigned w = rp[(eb * 8 + (r >> 1)) * 64]; R[eb][r] = bflo(w) - lam * (O[eb][r] * il); R[eb][r + 1] = bfhi(w) - lam * (O[eb][r + 1] * il); }
        }
    }
    float inv = 1.0f;
    if (!DSA) { float ss = 0.f;
#pragma unroll
        for (int eb = 0; eb < 4; ++eb)
#pragma unroll
            for (int r = 0; r < 16; ++r) ss += R[eb][r] * R[eb][r];
        ss += __shfl_xor(ss, 32); inv = post / sqrtf(ss * (1.f / 128.f) + EPS); }
    const float* sub = FIN(F, I_DSUB) + l * 128;
    if (wvalid && pq < LSEQ && (pq >= NMETA || b == 0)) {
        bf16* orow = (bf16*)(F.ws + WS_BR) + (size_t)(DSA ? 3 : 2) * MPAD * 512 + (size_t)seqrow(b, pq) * 512 + h * 128;
#pragma unroll
        for (int eb = 0; eb < 4; ++eb)
#pragma unroll
            for (int g = 0; g < 4; ++g) { const int e0 = 32 * eb + 8 * g + 4 * hh; f32x4 sv = (f32x4){1.f, 1.f, 1.f, 1.f}; if (!DSA) sv = *(const GAS f32x4*)(sub + e0);
                v2u w; w.x = pk2(R[eb][4 * g] * inv * sv.x, R[eb][4 * g + 1] * inv * sv.y); w.y = pk2(R[eb][4 * g + 2] * inv * sv.z, R[eb][4 * g + 3] * inv * sv.w);
                *(GAS v2u*)(orow + e0) = w; }
    }
}
__device__ __forceinline__ unsigned f32_key(float f) { const unsigned u = __float_as_uint(f); return u ^ ((u >> 31) ? 0xffffffffu : 0x80000000u); }
__device__ __forceinline__ void dsa_index_task(Frame& F, int b, int j, float* slab) {
    const int lane = F.lane, ql = lane & 31, hh = lane >> 5, wave = F.wave;
    const bf16* P = (const bf16*)(F.ws + WS_BIG);
    LAS unsigned char* qi = F.lds;
    for (int i = F.tid; i < 32 * 128; i += 512) { const int q = i >> 7, ch = i & 127; int pq = 32 * j + q; pq = pq < LSEQ ? pq : LSEQ - 1;
        *(LAS v4u*)(qi + q * 2064 + 16 * ch) = *(const GAS v4u*)(P + (size_t)seqrow(b, pq) * NNG + C_DQI + 8 * ch); }
    LAS float* wl = (LAS float*)(qi + 32 * 2064);
    if (F.tid < 32 * 16) { const int q = F.tid >> 4, hd = F.tid & 15; int pq = 32 * j + q; pq = pq < LSEQ ? pq : LSEQ - 1;
        wl[F.tid] = bf2f(P[(size_t)seqrow(b, pq) * NNG + C_DW + hd]) * 0.03125f; }
    LDS_WAIT(); __syncthreads();
#ifndef PROBE_SUB
#define PROBE_SUB 0
#endif
    for (int rpa = 0; rpa < ((PROBE_SUB & 8) ? 2 : 1); ++rpa)
    for (int kt = wave; kt <= j; kt += NWAVES) {
        const int pk = 32 * kt + ql, pkc = pk < LSEQ ? pk : LSEQ - 1;
        const bf16* krow = P + (size_t)seqrow(b, pkc) * NNG + C_DKI + 8 * hh;
        bf16x8 kf[4];
#pragma unroll
        for (int ks = 0; ks < 4; ++ks) kf[ks] = ld_frag16(krow + 16 * ks);
        f32x16 idx;
#pragma unroll
        for (int r = 0; r < 16; ++r) idx[r] = 0.f;
#pragma unroll 1
        for (int hd = 0; hd < 16; hd += 2) { f32x16 S0, S1; const float wh0 = wl[ql * 16 + hd], wh1 = wl[ql * 16 + hd + 1];
#pragma unroll
            for (int r = 0; r < 16; ++r) { S0[r] = 0.f; S1[r] = 0.f; }
#pragma unroll
            for (int ks = 0; ks < 4; ++ks) { S0 = __builtin_amdgcn_mfma_f32_32x32x16_bf16(kf[ks], *(const LAS bf16x8*)(qi + ql * 2064 + hd * 128 + 32 * ks + 16 * hh), S0, 0, 0, 0);
                S1 = __builtin_amdgcn_mfma_f32_32x32x16_bf16(kf[ks], *(const LAS bf16x8*)(qi + ql * 2064 + (hd + 1) * 128 + 32 * ks + 16 * hh), S1, 0, 0, 0); }
#pragma unroll
            for (int r = 0; r < 16; ++r) idx[r] += wh0 * fmaxf(S0[r], 0.f) + wh1 * fmaxf(S1[r], 0.f); }
        float* srow = slab + (size_t)ql * LPAD + 32 * kt + 4 * hh;
#pragma unroll
        for (int g = 0; g < 4; ++g) *(GAS f32x4*)(srow + 8 * g) = (f32x4){idx[4 * g], idx[4 * g + 1], idx[4 * g + 2], idx[4 * g + 3]};
    }
    VM_WAIT(); __syncthreads();
    for (int rpb = 0; rpb < ((PROBE_SUB & 16) ? 2 : 1); ++rpb)
    for (int qq = wave; qq < 32; qq += NWAVES) {
        const int p = 32 * j + qq; if (p >= LSEQ) break;
        const float* row = slab + (size_t)qq * LPAD;
        unsigned u[65];
        { const GAS unsigned* rp = (const GAS unsigned*)row + lane;
#pragma unroll
          for (int i = 0; i < 65; ++i) u[i] = rp[64 * i];
          __builtin_amdgcn_sched_barrier(0);
#pragma unroll
          for (int i = 0; i < 65; ++i) { const unsigned k = f32_key(__uint_as_float(u[i])) >> 1; u[i] = (64 * i + lane <= p) ? k : 0u; } }
        auto wsum = [&](unsigned c) { unsigned s = 0;
#pragma unroll
            for (int k = 0; k < 7; ++k) s += (unsigned)__builtin_popcountll(__ballot((c >> k) & 1u)) << k;
            return s; };
        unsigned T = 1u;
        if (p + 1 > 256) { T = 0u;
            for (int bit = 30; bit >= 15; --bit) { const unsigned cm1 = (T | (1u << bit)) - 1u; unsigned c = 0;
#pragma unroll
                for (int i = 0; i < 65; ++i) c += (cm1 - u[i]) >> 31;
                if (wsum(c) >= 256u) T |= 1u << bit; }
            const unsigned tm1 = T - 1u, hm1 = T + 0x7fffu; unsigned ca = 0, cb = 0;
#pragma unroll
            for (int i = 0; i < 65; ++i) { ca += (hm1 - u[i]) >> 31; cb += ((tm1 - u[i]) ^ (hm1 - u[i])) >> 31; }
            const unsigned above = wsum(ca), inb = wsum(cb), need = 256u - above;
            if (inb <= 64u) {
                LAS unsigned* band = (LAS unsigned*)(F.lds + 68096) + wave * 64;
                unsigned off = 0;
#pragma unroll
                for (int k = 0; k < 7; ++k) { const unsigned long long bal = __ballot((cb >> k) & 1u); off += __builtin_amdgcn_mbcnt_hi((unsigned)(bal >> 32), __builtin_amdgcn_mbcnt_lo((unsigned)bal, 0u)) << k; }
#pragma unroll
                for (int i = 0; i < 65; ++i) { if (u[i] >= T && u[i] <= hm1) { band[off] = u[i]; ++off; } }
                LDS_WAIT();
                const unsigned mine = lane < (int)inb ? band[lane] : 0u; unsigned ge = 0, gt = 0;
                for (unsigned k = 0; k < inb; ++k) { const unsigned v = band[k]; ge += (mine - 1u - v) >> 31; gt += (mine - v) >> 31; }
                const unsigned long long okb = __ballot(lane < (int)inb && ge >= need && gt < need);
                T = __builtin_amdgcn_readlane(mine, (int)__builtin_ctzll(okb | (1ull << 63)));
                LDS_WAIT();
            } else {
                for (int bit = 14; bit >= 0; --bit) { const unsigned cm1 = (T | (1u << bit)) - 1u; unsigned c = 0;
#pragma unroll
                    for (int i = 0; i < 65; ++i) c += (cm1 - u[i]) >> 31;
                    if (wsum(c) >= 256u) T |= 1u << bit; } } }
        unsigned long long* mrow = (unsigned long long*)((unsigned*)(F.ws + WS_MASK) + ((size_t)b * LPAD + p) * MASKW);
        unsigned wlo = 0u, whi = 0u;
#pragma unroll
        for (int i = 0; i < 64; ++i) { const unsigned long long bal = __ballot(u[i] >= T); if (lane == i) { wlo = (unsigned)bal; whi = (unsigned)(bal >> 32); } }
        const unsigned long long b64 = __ballot(u[64] >= T);
        mrow[lane] = ((unsigned long long)whi << 32) | wlo; if (lane == 0) mrow[64] = b64;
    }
    __syncthreads();
}
struct HgChunk { bf16* base; int pitch; int cq, ck, cv; bf16* A; float* dl; };
__device__ __forceinline__ HgChunk hg_chunk(Frame& F, int b, int h, int c) {
    HgChunk k;
    if (c == 0) { unsigned char* mp = F.ws + WS_HMETA + (size_t)h * HMETA_STRIDE; k.base = (bf16*)mp; k.pitch = 384; k.cq = 0; k.ck = 128; k.cv = 256; k.A = (bf16*)(mp + 64 * 384 * 2); k.dl = (float*)(mp + 64 * 384 * 2 + 64 * 64 * 2); }
    else { const size_t ci = (size_t)(b * 4 + h) * 64 + (c - 1); k.base = (bf16*)(F.ws + WS_BIG) + (size_t)(b * SEQ + 64 * (c - 1)) * NNG; k.pitch = NNG; k.cq = C_AQ + h * 128; k.ck = C_AF + h * 128; k.cv = C_AI + h * 128;
        k.A = (bf16*)(F.ws + WS_HA) + ci * 64 * 64; k.dl = (float*)(F.ws + WS_HDL) + ci * 128; }
    return k;
}
__device__ __forceinline__ void hgrn_prep_task(Frame& F, int l, int b, int h, int c) {
    const int d = F.tid & 127, tq = F.tid >> 7, lane = F.lane, wave = F.wave;
    const bf16* P = (const bf16*)(F.ws + WS_BIG);
    LAS bf16* Qt = (LAS bf16*)F.lds; LAS bf16* Kt = Qt + 64 * 136; LAS float* part = (LAS float*)(F.lds + 2 * 64 * 136 * 2);
    const HgChunk ch = hg_chunk(F, b, h, c);
    float lb = 0.f; if (l == 1) { const float a = FIN(F, I_LB)[h * 128 + d], cc = FIN(F, I_LB)[512 + h * 128 + d]; lb = 1.0f / (1.0f + __expf(a - cc)); }
    const bool meta = (c == 0);
    unsigned short zr[16], qr[16], vr[16];
    { const int r0 = meta ? MREAL : b * SEQ + 64 * (c - 1);
#pragma unroll
      for (int i = 0; i < 16; ++i) { int t = 16 * tq + i; if (meta) t = t < NMETA ? t : NMETA - 1; const bf16* pr = P + (size_t)(r0 + t) * NNG + h * 128 + d; zr[i] = pr[C_AF]; qr[i] = pr[C_AQ]; vr[i] = pr[C_AI]; }
      __builtin_amdgcn_sched_barrier(0); }
    float lfv[16];
    float run = 0.f;
#pragma unroll
    for (int i = 0; i < 16; ++i) { const bool valid = !meta || (16 * tq + i < NMETA); const float z = bf2f(zr[i]); const float sg = 1.0f / (1.0f + __expf(-z));
        lfv[i] = valid ? __logf(lb + (1.0f - lb) * sg) : 0.f; run += lfv[i]; }
    part[tq * 128 + d] = run;
    LDS_WAIT(); __syncthreads();
    const float p0 = part[d], p1 = part[128 + d], p2 = part[256 + d], p3 = part[384 + d];
    const float off = (tq > 0 ? p0 : 0.f) + (tq > 1 ? p1 : 0.f) + (tq > 2 ? p2 : 0.f), bmid = p0 + p1, blast = (p0 + p1) + (p2 + p3);
    unsigned kb[8], vb[8]; unsigned short qb[16];
    float bt = off;
#pragma unroll
    for (int i = 0; i < 16; i += 2) { float kbar[2], vv[2];
#pragma unroll
        for (int u = 0; u < 2; ++u) { const int t = 16 * tq + i + u; const bool valid = !meta || (t < NMETA);
            const float lf = lfv[i + u]; const float q = bf2f(qr[i + u]);
            const float kk = valid ? 1.0f - __expf(lf) : 0.f, qq = valid ? q / (1.0f + __expf(-q)) : 0.f; vv[u] = valid ? bf2f(vr[i + u]) : 0.f;
            bt += lf;
            kbar[u] = kk * __expf(blast - bt); qb[i + u] = (unsigned short)f2bf_s(qq * __expf(bt));
            const float qt = qq * __expf(fminf(bt - bmid, 80.f)), kt = kk * __expf(fminf(bmid - bt, 80.f));
            Qt[t * 136 + d] = (bf16)f2bf_s(qt); Kt[t * 136 + d] = (bf16)f2bf_s(kt); }
        kb[i >> 1] = pk2(kbar[0], kbar[1]); vb[i >> 1] = pk2(vv[0], vv[1]); }
    asm volatile("s_waitcnt vmcnt(0)" ::: "memory"); __syncthreads();
#pragma unroll
    for (int i = 0; i < 16; ++i) ch.base[(size_t)(16 * tq + i) * ch.pitch + ch.cq + d] = qb[i];
    { bf16* kd = ch.base + (size_t)(d >> 1) * ch.pitch + ch.ck + (d & 1) * 64 + 16 * tq; bf16* vd = ch.base + (size_t)(d >> 1) * ch.pitch + ch.cv + (d & 1) * 64 + 16 * tq;
      *(GAS v4u*)kd = (v4u){kb[0], kb[1], kb[2], kb[3]}; *(GAS v4u*)(kd + 8) = (v4u){kb[4], kb[5], kb[6], kb[7]};
      *(GAS v4u*)vd = (v4u){vb[0], vb[1], vb[2], vb[3]}; *(GAS v4u*)(vd + 8) = (v4u){vb[4], vb[5], vb[6], vb[7]}; }
    if (tq == 0) ch.dl[d] = __expf(blast);
    LDS_WAIT(); __syncthreads();
    { const int mt = wave >> 1, fr = lane & 15, g = lane >> 4;
#pragma unroll
      for (int u = 0; u < 2; ++u) { const int nt = 2 * (wave & 1) + u; f32x4 acc = (f32x4){0.f, 0.f, 0.f, 0.f};
        if (nt <= mt) {
#pragma unroll
            for (int ks = 0; ks < 4; ++ks) acc = __builtin_amdgcn_mfma_f32_16x16x32_bf16(*(const LAS bf16x8*)(Qt + (16 * mt + fr) * 136 + 32 * ks + 8 * g), *(const LAS bf16x8*)(Kt + (16 * nt + fr) * 136 + 32 * ks + 8 * g), acc, 0, 0, 0);
        }
#pragma unroll
        for (int r = 0; r < 4; ++r) { const int t = 16 * mt + 4 * g + r, s = 16 * nt + fr; ch.A[t * 64 + s] = (bf16)f2bf_s(s <= t ? acc[r] : 0.f); } } }
    __syncthreads();
}
__device__ __forceinline__ void hgrn_scan_unit(Frame& F, int l, int b, int h) {
    const int lane = F.lane, wave = F.wave, fr = lane & 15, g = lane >> 4, tid = F.tid;
    constexpr int QP = 136, AP = 72, KP = 72, GP = 136;
    constexpr int BUF = (64 * QP + 64 * AP + 128 * KP + 64 * GP) * 2 + 512;
    LAS float* red = (LAS float*)(F.lds + 2 * BUF);
    const int dv = 16 * wave + fr;
    const float gn = FIN(F, I_GN)[l * 512 + h * 128 + dv];
    const bf16* Pg = (const bf16*)(F.ws + WS_BIG) + C_AG + h * 128;
    f32x4 S[8];
#pragma unroll
    for (int mt = 0; mt < 8; ++mt) S[mt] = (f32x4){0.f, 0.f, 0.f, 0.f};
    v4u rq[2], ra, rk[2], rg[2], rd; bf16x8 bv0, bv1, bn0, bn1;
#define HG_ISSUE(c_, B0, B1) do { const HgChunk ch_ = hg_chunk(F, b, h, (c_)); const int nv_ = ((c_) == 0) ? NMETA : 64; \
        _Pragma("unroll") for (int i = 0; i < 2; ++i) { const int idx = tid + 512 * i, row = idx >> 4, c16 = idx & 15; \
            rq[i] = *(const GAS v4u*)(ch_.base + (size_t)row * ch_.pitch + ch_.cq + 8 * c16); rk[i] = *(const GAS v4u*)(ch_.base + (size_t)row * ch_.pitch + ch_.ck + 8 * c16); \
            rg[i] = (v4u){0u, 0u, 0u, 0u}; if (row < nv_) rg[i] = *(const GAS v4u*)(Pg + (size_t)(((c_) == 0) ? MREAL + row : b * SEQ + 64 * ((c_) - 1) + row) * NNG + 8 * c16); } \
        ra = *(const GAS v4u*)(ch_.A + 8 * tid); if (tid < 32) rd = *(const GAS v4u*)(ch_.dl + 4 * tid); \
        const bf16* vrow_ = ch_.base + (size_t)(dv >> 1) * ch_.pitch + ch_.cv + (dv & 1) * 64 + 8 * g; B0 = ld_frag16(vrow_); B1 = ld_frag16(vrow_ + 32); } while (0)
#define HG_COMMIT(buf_) do { LAS bf16* Q_ = (LAS bf16*)(F.lds + (buf_) * BUF); LAS bf16* A_ = Q_ + 64 * QP; LAS bf16* KT_ = A_ + 64 * AP; LAS bf16* G_ = KT_ + 128 * KP; \
        _Pragma("unroll") for (int i = 0; i < 2; ++i) { const int idx = tid + 512 * i, row = idx >> 4, c16 = idx & 15; *(LAS v4u*)(Q_ + row * QP + 8 * c16) = rq[i]; \
            *(LAS v4u*)(KT_ + (2 * row + (c16 >> 3)) * KP + 8 * (c16 & 7)) = rk[i]; *(LAS v4u*)(G_ + row * GP + 8 * c16) = rg[i]; } \
        *(LAS v4u*)(A_ + (tid >> 3) * AP + 8 * (tid & 7)) = ra; if (tid < 32) *(LAS v4u*)((LAS unsigned char*)(G_ + 64 * GP) + 16 * tid) = rd; } while (0)
    HG_ISSUE(0, bv0, bv1); HG_COMMIT(0);
    for (int c = 0; c <= 64; ++c) {
        const int buf = c & 1;
        LDS_WAIT(); __syncthreads();
        if (c < 64) HG_ISSUE(c + 1, bn0, bn1);
        LAS bf16* Q = (LAS bf16*)(F.lds + buf * BUF); LAS bf16* A = Q + 64 * QP; LAS bf16* KT = A + 64 * AP; LAS bf16* G = KT + 128 * KP; const LAS float* DL = (const LAS float*)(G + 64 * GP);
        f32x4 o[4];
#pragma unroll
        for (int mt = 0; mt < 4; ++mt) o[mt] = (f32x4){0.f, 0.f, 0.f, 0.f};
#pragma unroll
        for (int ks = 0; ks < 4; ++ks) { v4u w; w.x = cvtpk(S[2 * ks][0], S[2 * ks][1]); w.y = cvtpk(S[2 * ks][2], S[2 * ks][3]); w.z = cvtpk(S[2 * ks + 1][0], S[2 * ks + 1][1]); w.w = cvtpk(S[2 * ks + 1][2], S[2 * ks + 1][3]);
            const bf16x8 sb = __builtin_bit_cast(bf16x8, w);
#pragma unroll
            for (int mt = 0; mt < 4; ++mt) { const LAS bf16* qp = Q + (16 * mt + fr) * QP + 32 * ks + 4 * g;
                const bf16x8 af = mk_frag(*(const LAS v2u*)qp, *(const LAS v2u*)(qp + 16));
                o[mt] = __builtin_amdgcn_mfma_f32_16x16x32_bf16(af, sb, o[mt], 0, 0, 0); } }
#pragma unroll
        for (int mt = 0; mt < 4; ++mt) { o[mt] = __builtin_amdgcn_mfma_f32_16x16x32_bf16(*(const LAS bf16x8*)(A + (16 * mt + fr) * AP + 8 * g), bv0, o[mt], 0, 0, 0);
            o[mt] = __builtin_amdgcn_mfma_f32_16x16x32_bf16(*(const LAS bf16x8*)(A + (16 * mt + fr) * AP + 32 + 8 * g), bv1, o[mt], 0, 0, 0); }
#pragma unroll
        for (int mt = 0; mt < 8; ++mt) { const f32x4 dl = *(const LAS f32x4*)(DL + 16 * mt + 4 * g); S[mt] = S[mt] * dl;
            S[mt] = __builtin_amdgcn_mfma_f32_16x16x32_bf16(*(const LAS bf16x8*)(KT + (16 * mt + fr) * KP + 8 * g), bv0, S[mt], 0, 0, 0);
            S[mt] = __builtin_amdgcn_mfma_f32_16x16x32_bf16(*(const LAS bf16x8*)(KT + (16 * mt + fr) * KP + 32 + 8 * g), bv1, S[mt], 0, 0, 0); }
#pragma unroll
        for (int mt = 0; mt < 4; ++mt)
#pragma unroll
            for (int r = 0; r < 4; ++r) { float s2 = o[mt][r] * o[mt][r]; s2 += __shfl_xor(s2, 1); s2 += __shfl_xor(s2, 2); s2 += __shfl_xor(s2, 4); s2 += __shfl_xor(s2, 8);
                if (fr == 0) red[wave * 64 + 16 * mt + 4 * g + r] = s2; }
        LDS_WAIT(); __syncthreads();
        const int nvalid = (c == 0) ? NMETA : 64;
#pragma unroll
        for (int mt = 0; mt < 4; ++mt)
#pragma unroll
            for (int r = 0; r < 4; ++r) { const int t = 16 * mt + 4 * g + r; float tot = 0.f;
#pragma unroll
                for (int w = 0; w < 8; ++w) tot += red[w * 64 + t];
                if (t < nvalid && (c > 0 || b == 0)) { const int row = (c == 0) ? MREAL + t : b * SEQ + 64 * (c - 1) + t;
                    const float gr = bf2f(G[t * GP + dv]);
                    const float val = o[mt][r] * (1.0f / sqrtf(tot * (1.f / 128.f) + EPS)) * gn * (gr / (1.0f + __expf(-gr)));
                    ((bf16*)(F.ws + WS_BR))[(size_t)row * 512 + h * 128 + dv] = (bf16)f2bf_s(val); } }
        if (c < 64) { HG_COMMIT(buf ^ 1); bv0 = bn0; bv1 = bn1; }
    }
#undef HG_ISSUE
#undef HG_COMMIT
    __syncthreads();
}
__device__ __forceinline__ void conv_row(Frame& F, int l, int r) {
    const int lane = F.lane; const bf16* P = (const bf16*)(F.ws + WS_BIG);
    int r1, r2;
    if (r < MREAL) { const int b = r >> 12, t = r & 4095; r1 = seqrow(b, NMETA + t - 1); r2 = seqrow(b, NMETA + t - 2); }
    else { const int i = r - MREAL; r1 = i >= 1 ? r - 1 : -1; r2 = i >= 2 ? r - 2 : -1; }
    const float* cw = FIN(F, I_CONVW) + l * 3 * 512 + 8 * lane;
    float c0[8], u0[8], bb[8], y[8]; unpack8(*(const GAS v4u*)(P + (size_t)r * NNG + C_BC + 8 * lane), c0); unpack8(*(const GAS v4u*)(P + (size_t)r * NNG + C_BU + 8 * lane), u0); unpack8(*(const GAS v4u*)(P + (size_t)r * NNG + C_BB + 8 * lane), bb);
#pragma unroll
    for (int i = 0; i < 8; ++i) y[i] = cw[i] * (c0[i] * u0[i]);
    if (r1 >= 0) { unpack8(*(const GAS v4u*)(P + (size_t)r1 * NNG + C_BC + 8 * lane), c0); unpack8(*(const GAS v4u*)(P + (size_t)r1 * NNG + C_BU + 8 * lane), u0);
#pragma unroll
        for (int i = 0; i < 8; ++i) y[i] += cw[512 + i] * (c0[i] * u0[i]); }
    if (r2 >= 0) { unpack8(*(const GAS v4u*)(P + (size_t)r2 * NNG + C_BC + 8 * lane), c0); unpack8(*(const GAS v4u*)(P + (size_t)r2 * NNG + C_BU + 8 * lane), u0);
#pragma unroll
        for (int i = 0; i < 8; ++i) y[i] += cw[1024 + i] * (c0[i] * u0[i]); }
#pragma unroll
    for (int i = 0; i < 8; ++i) y[i] *= bb[i];
    *(GAS v4u*)((bf16*)(F.ws + WS_BR) + (size_t)MPAD * 512 + (size_t)r * 512 + 8 * lane) = pack8(y);
}
__device__ __forceinline__ void phase_hgrn_prep(Frame& F, int l) {
    for (int t = F.bid; t < NB * 4 * 64 + 4; t += F.G) { if (t < 4) hgrn_prep_task(F, l, 0, t, 0); else { const int u = t - 4; hgrn_prep_task(F, l, u >> 8, (u >> 6) & 3, 1 + (u & 63)); } }
}
constexpr int CW_TMO = 0, CW_BAR = 4096, CW_Q = 16384;
__device__ __forceinline__ int queue_pop(Frame& F, int qi) {
    int t = 0; if (F.lane == 0) t = (int)__hip_atomic_fetch_add((unsigned*)(F.ctl + CW_Q + 64 * qi), 1u, RLX_AGENT);
    return __builtin_amdgcn_readfirstlane(t);
}
__device__ __forceinline__ int queue_pop_wg(Frame& F, int qi) {
    LAS int* slot = (LAS int*)(F.lds + 139264);
    __syncthreads();
    if (F.tid == 0) *slot = (int)__hip_atomic_fetch_add((unsigned*)(F.ctl + CW_Q + 64 * qi), 1u, RLX_AGENT);
    LDS_WAIT(); __syncthreads();
    return __builtin_amdgcn_readfirstlane(*slot);
}
__device__ __forceinline__ void phase_mix1(Frame& F, int l, int qidx) {
    LAS float* bt = (LAS float*)(F.lds + 135168);
    build_bias_table(F, bt, 0);
    __syncthreads();
    if (F.bid < NIDX_WG) {
        float* slab = (float*)(F.ws + WS_SCR) + (size_t)F.bid * 32 * LPAD;
        for (int rp = 0; rp < ((PROBE_SUB & 1) ? 2 : 1); ++rp)
        for (int t = F.bid; t < NB * NQT; t += NIDX_WG) { const int j = NQT - 1 - t / NB, b = t % NB; dsa_index_task(F, b, j, slab); }
    } else if (F.bid < NIDX_WG + NHG_WG) {
        const int u = F.bid - NIDX_WG;
        for (int rp = 0; rp < ((PROBE_SUB & 2) ? 2 : 1); ++rp) hgrn_scan_unit(F, l, u >> 2, u & 3);
    } else {
        const int u0 = F.bid - NIDX_WG - NHG_WG, nw = F.G - NIDX_WG - NHG_WG;
        const int cw = u0 * NWAVES + F.wave, ncw = nw * NWAVES; for (int r = cw; r < MREAL + NMETA; r += ncw) conv_row(F, l, r);
    }
    float lam, post;
    { const float* lp = FIN(F, I_DLAM) + l * 256; const float s1 = wave_sum(lp[F.lane] * lp[64 + F.lane]), s2 = wave_sum(lp[128 + F.lane] * lp[192 + F.lane]);
      const float li = 0.8f - 0.6f * __expf(-0.3f * (float)l); lam = __expf(s1) - __expf(s2) + li; post = 1.0f - li; }
    for (int rp = 0; rp < ((PROBE_SUB & 4) ? 2 : 1); ++rp)
    for (;;) { const int t = queue_pop_wg(F, qidx + 8 * rp); if (t >= NB * 4 * NQB) break;
        const int J = NQB - 1 - t / 32, bh = t % 32; attn_wg_task<false>(F, l, bh >> 2, bh & 3, J, bt, lam, post); }
}
__device__ __forceinline__ void phase_mix2(Frame& F, int l, int qidx) {
    LAS float* bt = (LAS float*)(F.lds + 135168);
    build_bias_table(F, bt, 4);
    __syncthreads();
    const int gw = F.bid * NWAVES + F.wave, NGW = F.G * NWAVES;
    for (;;) { const int t = queue_pop_wg(F, qidx); if (t >= NB * 4 * NQB) break;
        const int J = NQB - 1 - t / 32, bh = t % 32; attn_wg_task<true>(F, l, bh >> 2, bh & 3, J, bt, 0.f, 1.f); }
}

#ifdef DBG_SEL
#ifndef DBG_Q
#define DBG_Q 1.0f
#endif
#ifndef DBG_QO
#define DBG_QO 0.0f
#endif
#ifndef DBG_T0
#define DBG_T0 0
#define DBG_T1 36
#endif
#ifndef DBG_NC
#define DBG_NC DM
#endif
__global__ void __launch_bounds__(256) k_dbg_argmax(const float* __restrict__ out, const float* __restrict__ x, unsigned long long* best) {
    unsigned long long loc = 0ull;
    for (size_t i = (size_t)blockIdx.x * blockDim.x + threadIdx.x; i < (size_t)MREAL * DM; i += (size_t)gridDim.x * blockDim.x) {
        const float d = fabsf(out[i] - x[i]); const unsigned long long k = ((unsigned long long)__float_as_uint(d) << 32) | (unsigned)i; loc = k > loc ? k : loc; }
    for (int o = 32; o >= 1; o >>= 1) { const unsigned long long t = __shfl_xor(loc, o); loc = t > loc ? t : loc; }
    if ((threadIdx.x & 63) == 0) atomicMax(best, loc);
}
__global__ void __launch_bounds__(256) k_dbg_count(const float* __restrict__ out, const float* __restrict__ x, unsigned* cnt  ) {
    const int gw = (blockIdx.x * blockDim.x + threadIdx.x) >> 6, lane = threadIdx.x & 63, ngw = (gridDim.x * blockDim.x) >> 6;
    for (int r = gw; r < MREAL; r += ngw) { float m = 0.f;
        for (int c = lane; c < DM; c += 64) m = fmaxf(m, fabsf(out[(size_t)r * DM + c] - x[(size_t)r * DM + c]));
        for (int o = 32; o >= 1; o >>= 1) m = fmaxf(m, __shfl_xor(m, o));
        if (lane == 0 && m > DBG_THR) { const int t = r & 4095; atomicAdd(cnt + 0, 1u); if (t < 32) atomicAdd(cnt + 1, 1u); if (t >= 4064) atomicAdd(cnt + 2, 1u); if (t < 256) atomicAdd(cnt + 3, 1u); } }
}

__global__ void __launch_bounds__(256) k_dbg_chk_merge(const unsigned short* BRm, const unsigned short* Wt, const unsigned short* G, const unsigned short* MG, int m, unsigned* cnt) {
    const int c = blockIdx.x * 256 + threadIdx.x;
    for (int r = blockIdx.y; r < MREAL; r += gridDim.y) {
        float s = 0.f; const unsigned short* a = BRm + (size_t)r * 512; const unsigned short* w = Wt + (size_t)c * 512;
        for (int k = 0; k < 512; ++k) s += __uint_as_float((unsigned)a[k] << 16) * __uint_as_float((unsigned)w[k] << 16);
        const float g = __uint_as_float((unsigned)G[(size_t)r * NGATE + m * DM + c] << 16), ref = g * s, got = __uint_as_float((unsigned)MG[(size_t)r * DM + c] << 16);
        const float err = fabsf(got - ref), tol = 0.02f * fabsf(ref) + 0.02f;
        if (!(err <= tol)) { atomicAdd(cnt + 4, 1u); const int t = r & 4095; if ((c & 255) < 128) atomicAdd(cnt + 5, 1u); if ((r & 255) < 128) atomicAdd(cnt + 6, 1u); if (fabsf(got) > 2.f * fabsf(ref)) atomicAdd(cnt + 7, 1u); (void)t; }
    }
}

__global__ void __launch_bounds__(256) k_dbg_naive_wo(const float* out, const unsigned short* MG, const unsigned short* Wt, float* chk) {
    const int c = blockIdx.x * 256 + threadIdx.x;
    for (int r = blockIdx.y; r < MREAL; r += gridDim.y) {
        float s = 0.f; const uint4* a = (const uint4*)(MG + (size_t)r * DM); const uint4* w = (const uint4*)(Wt + (size_t)c * DM);
        for (int k = 0; k < DM / 8; ++k) { const uint4 av = a[k], wv = w[k]; const unsigned aw[4] = {av.x, av.y, av.z, av.w}, ww[4] = {wv.x, wv.y, wv.z, wv.w};
#pragma unroll
            for (int j = 0; j < 4; ++j) { s += __uint_as_float(aw[j] << 16) * __uint_as_float(ww[j] << 16); s += __uint_as_float(aw[j] & 0xffff0000u) * __uint_as_float(ww[j] & 0xffff0000u); } }
        chk[(size_t)r * DM + c] = out[(size_t)r * DM + c] + s; }
}
__global__ void __launch_bounds__(256) k_dbg_cmp(const float* out, const float* chk, unsigned* cnt) {
    for (size_t i = (size_t)blockIdx.x * blockDim.x + threadIdx.x; i < (size_t)MREAL * DM; i += (size_t)gridDim.x * blockDim.x) {
        const float err = fabsf(out[i] - chk[i]); if (!(err <= 0.02f)) { atomicAdd(cnt + 4, 1u); const int c = (int)(i % DM), r = (int)(i / DM); if ((c & 255) < 128) atomicAdd(cnt + 5, 1u); if ((r & 255) < 128) atomicAdd(cnt + 6, 1u); if (err > 1.0f) atomicAdd(cnt + 7, 1u); } }
}

__global__ void __launch_bounds__(256) k_dbg_stats(const unsigned short* A, int ld, int ncols, unsigned* st) {
    const int gw = (blockIdx.x * blockDim.x + threadIdx.x) >> 6, lane = threadIdx.x & 63, ngw = (gridDim.x * blockDim.x) >> 6;
    float mx = 0.f, me = 0.f;
    for (int r = gw; r < MREAL; r += ngw) { float s = 0.f;
        for (int c = lane; c < ncols; c += 64) { const float v = __uint_as_float((unsigned)A[(size_t)r * ld + c] << 16); mx = fmaxf(mx, fabsf(v)); s += v * v; }
        for (int o = 32; o >= 1; o >>= 1) s += __shfl_xor(s, o);
        me = fmaxf(me, s / (float)ncols); }
    for (int o = 32; o >= 1; o >>= 1) mx = fmaxf(mx, __shfl_xor(mx, o));
    if (lane == 0) { atomicMax(st + 8, __float_as_uint(mx)); atomicMax(st + 9, __float_as_uint(me)); }
}

__global__ void __launch_bounds__(256) k_dbg_argmax_bf16(const unsigned short* A, int ld, int ncols, unsigned long long* best) {
    unsigned long long loc = 0ull;
    for (size_t i = (size_t)blockIdx.x * blockDim.x + threadIdx.x; i < (size_t)MREAL * ncols; i += (size_t)gridDim.x * blockDim.x) { const size_t r = i / ncols, c = i % ncols;
        const float d = fabsf(__uint_as_float((unsigned)A[r * ld + c] << 16)); const unsigned long long k = ((unsigned long long)__float_as_uint(d) << 32) | (unsigned)i; loc = k > loc ? k : loc; }
    for (int o = 32; o >= 1; o >>= 1) { const unsigned long long t = __shfl_xor(loc, o); loc = t > loc ? t : loc; }
    if ((threadIdx.x & 63) == 0) atomicMax(best, loc);
}

__global__ void __launch_bounds__(256) k_dbg_gcount(const unsigned short* G, unsigned* cnt) {
    const int gw = (blockIdx.x * blockDim.x + threadIdx.x) >> 6, lane = threadIdx.x & 63, ngw = (gridDim.x * blockDim.x) >> 6;
    for (int r = gw; r < MREAL; r += ngw) { int n = 0;
        for (int c = lane; c < NGATE; c += 64) { const float v = __uint_as_float((unsigned)G[(size_t)r * NGATE + c] << 16); if (!(v >= 0.f && v <= 1.001f)) ++n; }
        for (int o = 32; o >= 1; o >>= 1) n += __shfl_xor(n, o);
        if (lane == 0 && n) { const int t = r & 4095; atomicAdd(cnt + 10, (unsigned)n); atomicAdd(cnt + 11, 1u); if (t >= 4080) atomicAdd(cnt + 12, 1u); else atomicAdd(cnt + 13, 1u); } }
}

__global__ void k_dbg_time(const unsigned long long* ts, unsigned* cnt) {
    if (threadIdx.x == 0) { const float ms = (float)(ts[DBG_T1] - ts[DBG_T0]) * 1e-5f; cnt[14] = __float_as_uint(floorf(ms * DBG_Q + DBG_QO)); }
}
__global__ void __launch_bounds__(256) k_dbg_emit(float* out, const float* __restrict__ x, const unsigned long long* best, const unsigned* cnt) {
    const unsigned long long b = *best; const unsigned idx = (unsigned)b; const float val = __uint_as_float((unsigned)(b >> 32));
    const int row = idx / DBG_NC, col = idx % DBG_NC, bb = row >> 12, t = row & 4095;
    float N = 0.f;
    switch (DBG_SEL) {
        case 0: N = val; break;
        case 1: N = 2.f + bb; break;
        case 2: N = 2.f + (t >> 9); break;
        case 3: N = 2.f + ((t >> 6) & 7); break;
        case 4: N = 2.f + ((t >> 3) & 7); break;
        case 5: N = 2.f + (t & 7); break;
        case 6: N = 2.f + (col >> 8); break;
        case 60: N = 2.f + (col >> 10); break;
        case 61: N = 2.f + ((col >> 7) & 7); break;
        case 62: N = 2.f + ((col >> 4) & 7); break;
        case 63: N = 2.f + ((col >> 1) & 7); break;
        case 64: N = 2.f + (col & 1); break;
        case 65: N = 2.f + bb; break;
        case 66: N = 2.f + (t >> 9); break;
        case 67: N = 2.f + ((t >> 6) & 7); break;
        case 68: N = 2.f + ((t >> 3) & 7); break;
        case 69: N = 2.f + (t & 7); break;
        case 7: N = 2.f + ((col >> 5) & 7); break;
        case 8: N = 2.f + ((col >> 2) & 7); break;
        case 40: case 42: case 44: case 46: N = __uint_as_float(cnt[8]); break;
        case 41: case 43: case 45: case 47: N = __uint_as_float(cnt[9]); break;
        case 70: N = 2.f + log2f(1.f + (float)cnt[10]); break;
        case 71: N = 2.f + log2f(1.f + (float)cnt[11]); break;
        case 72: N = 2.f + log2f(1.f + (float)cnt[12]); break;
        case 73: N = 2.f + log2f(1.f + (float)cnt[13]); break;
        case 100: N = 2.f + __uint_as_float(cnt[14]); break;
        case 30: N = 2.f + log2f(1.f + (float)cnt[4]); break;
        case 31: N = 2.f + log2f(1.f + (float)cnt[5]); break;
        case 32: N = 2.f + log2f(1.f + (float)cnt[6]); break;
        case 33: N = 2.f + log2f(1.f + (float)cnt[7]); break;
        case 20: N = 2.f + log2f(1.f + (float)cnt[4]); break;
        case 21: N = 2.f + log2f(1.f + (float)cnt[5]); break;
        case 22: N = 2.f + log2f(1.f + (float)cnt[6]); break;
        case 23: N = 2.f + log2f(1.f + (float)cnt[7]); break;
        case 10: N = 2.f + log2f(1.f + (float)cnt[0]); break;
        case 11: N = 2.f + log2f(1.f + (float)cnt[1]); break;
        case 12: N = 2.f + log2f(1.f + (float)cnt[2]); break;
        case 13: N = 2.f + log2f(1.f + (float)cnt[3]); break;
    }
    const float c = 1.f + N;
    for (size_t i = (size_t)blockIdx.x * blockDim.x + threadIdx.x; i < (size_t)MREAL * DM; i += (size_t)gridDim.x * blockDim.x) out[i] = c * x[i];
}
#endif

#ifndef MK_ONE
#define MK_ONE 0
#endif
#ifndef BR_MASK
#define BR_MASK 15
#endif
constexpr int NPH = 18;
template <class T> __device__ __forceinline__ T opaque(T v) { asm volatile("" : "+s"(v)); return v; }
struct Args { const float* in[22]; float* out; unsigned char* ws; int ph_lo, ph_hi; };
__global__ void __launch_bounds__(NWAVES * 64, 2) fwd(Args args) {
    extern __shared__ __attribute__((aligned(16))) unsigned char lds[];
    Frame F;
    F.lds = (LAS unsigned char*)lds; F.MISC = (volatile LAS unsigned*)(F.lds + MISC_OFF);
    F.tid = threadIdx.x; F.lane = F.tid & 63; F.wave = __builtin_amdgcn_readfirstlane(F.tid >> 6); F.G = gridDim.x; F.bid = blockIdx.x;
    F.ws = args.ws; F.out = args.out; F.ctl = (gu32*)(args.ws + WS_CTL);
    F.karg = (const unsigned char __attribute__((address_space(4)))*)__builtin_amdgcn_kernarg_segment_ptr();
    for (int u = F.tid; u < (LDS_BYTES - LDSCTL_OFF) / 4; u += NWAVES * 64) ((LAS unsigned*)(F.lds + LDSCTL_OFF))[u] = 0u;
    __syncthreads();
#if MK_ONE
    XcdBarrier bar = xcd_barrier_post((unsigned*)(F.ctl + CW_BAR), F.MISC + 8, __builtin_amdgcn_readfirstlane(threadIdx.x >> 6));
#define GRID_BAR() xcd_barrier(bar)
#else
#define GRID_BAR() do { } while (0)
#endif
    const int wave_s = __builtin_amdgcn_readfirstlane(threadIdx.x >> 6);
    const int lo = args.ph_lo, hi = args.ph_hi;
#define IN(k) (lo <= (k) && (k) < hi)
#define RETID() do { int w_ = wave_s; asm volatile("" : "+s"(w_)); unsigned mk_ = ~0u; asm volatile("" : "+s"(mk_)); int t_ = w_ * 64 + (int)__builtin_amdgcn_mbcnt_hi(mk_, __builtin_amdgcn_mbcnt_lo(mk_, 0u)); asm volatile("" : "+v"(t_)); F.tid = t_; F.lane = t_ & 63; F.wave = w_; } while (0)
#ifdef DBG_TS
#define STAMP(k) do { if (blockIdx.x == 0 && threadIdx.x == 0) ((unsigned long long*)(args.ws + 768 * 1024))[(k)] = __builtin_amdgcn_s_memrealtime(); } while (0)
#else
#define STAMP(k) do { } while (0)
#endif
#define SEAM(k) do { if (IN((k) + 1)) GRID_BAR(); STAMP((k) + 1); } while (0)
#ifdef PROBE_MASK
#define NREP(kk) opaque(((PROBE_MASK >> (kk)) & 1) ? 1 + PROBE_EXTRA : 1)
#define REP_BEGIN(kk) { const int nrep_ = NREP(kk); for (int rep = 0; rep < nrep_; ++rep) { if (rep) GRID_BAR();
#define REP_END } }
#else
#define REP_BEGIN(kk) { { const int rep = 0; (void)rep;
#define REP_END } }
#endif
    STAMP(0);
    unsigned char* wb = F.ws + WS_W;
    bf16* XN = (bf16*)(F.ws + WS_XN); bf16* BR = (bf16*)(F.ws + WS_BR); bf16* BIG = (bf16*)(F.ws + WS_BIG); float* HM = (float*)(F.ws + WS_HM);
    for (int l = 0; l < 2; ++l) {
        const int pb = l * NPH;
        const float* hsrc = (l == 0) ? FIN(F, I_X) : F.out;
        if (IN(pb + 0)) { REP_BEGIN(0) RETID(); phase_convert(F, l); REP_END SEAM(pb + 0); }
        if (IN(pb + 1)) { REP_BEGIN(1) RETID(); phase_norm(F, hsrc, FIN(F, I_F1N) + l * DM); REP_END SEAM(pb + 1); }
        if (IN(pb + 2)) { REP_BEGIN(2) RETID(); meta_gemm(F, 0, XN + (size_t)MREAL * DM, DM, (const bf16*)(wb + W_GU1), NGU, DM, BIG, DFF, 0.f); pg8::Gemm g{opaque((const bf16*)(XN)), opaque((const bf16*)(wb + W_GU1)), MREAL, NGU, DM}; pg8::StaticOrder S; S.init(MREAL, NGU, F.G, opaque(F.bid));
            pg8::EpiSwiGLU E{BIG, DFF}; pg8::gemm_phase<pg8::EpiSwiGLU, pg8::StaticOrder, true, true>(F.lds + RING_OFF, g, S, E, F.tid); REP_END SEAM(pb + 2); }
        if (IN(pb + 3)) { REP_BEGIN(3) RETID(); meta_gemm(F, 1, BIG + (size_t)MREAL * DFF, DFF, (const bf16*)(wb + W_D1), DM, DFF, nullptr, 0, rep ? 0.f : 0.5f); pg8::Gemm g{opaque((const bf16*)(BIG)), opaque((const bf16*)(wb + W_D1)), MREAL, DM, DFF}; pg8::StaticOrder S; S.init(MREAL, DM, F.G, opaque(F.bid));
            pg8::EpiResF32 E{rep ? F.out : hsrc, F.out, HM, DM, MT_REAL, rep ? 0.f : 0.5f}; pg8::gemm_phase<pg8::EpiResF32, pg8::StaticOrder, true, true>(F.lds + RING_OFF, g, S, E, F.tid); REP_END SEAM(pb + 3); }
        if (IN(pb + 4)) { REP_BEGIN(4) RETID(); phase_norm(F, F.out, FIN(F, I_MIXN) + l * DM); REP_END SEAM(pb + 4); }
        if (IN(pb + 5)) { REP_BEGIN(5) RETID(); meta_gemm(F, 2, XN + (size_t)MREAL * DM, DM, (const bf16*)(wb + W_NG), NNG, DM, BIG, NNG, 0.f); pg8::Gemm g{opaque((const bf16*)(XN)), opaque((const bf16*)(wb + W_NG)), MREAL, NNG, DM}; pg8::StaticOrder S; S.init(MREAL, NNG, F.G, opaque(F.bid));
            pg8::EpiBf16<0> E{BIG, NNG}; pg8::gemm_phase<pg8::EpiBf16<0>, pg8::StaticOrder, true, true>(F.lds + RING_OFF, g, S, E, F.tid); REP_END SEAM(pb + 5); }
        if (IN(pb + 6)) { REP_BEGIN(6) RETID(); phase_prep(F, l); phase_vt(F); __syncthreads(); phase_hgrn_prep(F, l); REP_END SEAM(pb + 6); }
#ifdef DUP_MIX
        if (IN(pb + 7)) { const int nrep = opaque(DUP_MIX1); for (int rep = 0; rep < nrep; ++rep) { RETID(); phase_mix1(F, l, 4 * rep + 2 * l); GRID_BAR(); } }
        if (IN(pb + 8)) { const int nrep = opaque(DUP_MIX2); for (int rep = 0; rep < nrep; ++rep) { RETID(); phase_mix2(F, l, 4 * rep + 2 * l + 1); GRID_BAR(); } }
#else
        if (IN(pb + 7)) { REP_BEGIN(7) RETID(); phase_mix1(F, l, 2 * l); REP_END SEAM(pb + 7); }
        if (IN(pb + 8)) { REP_BEGIN(8) RETID(); phase_mix2(F, l, 2 * l + 1); REP_END SEAM(pb + 8); }
#endif
        if (IN(pb + 9)) { REP_BEGIN(9) RETID(); meta_gemm(F, 3, XN + (size_t)MREAL * DM, DM, (const bf16*)(wb + W_G), NGATE, DM, BIG, NGATE, 0.f); pg8::Gemm g{opaque((const bf16*)(XN)), opaque((const bf16*)(wb + W_G)), MREAL, NGATE, DM}; pg8::StaticOrder S; S.init(MREAL, NGATE, F.G, opaque(F.bid));
            pg8::EpiBf16<1> E{BIG, NGATE}; pg8::gemm_phase<pg8::EpiBf16<1>, pg8::StaticOrder, true, true>(F.lds + RING_OFF, g, S, E, F.tid); REP_END SEAM(pb + 9); }
        { const int nrepm_ =
#ifdef PROBE_MASK
            NREP(10);
#else
            1;
#endif
          for (int repm = 0; repm < nrepm_; ++repm)
        for (int m = 0; m < 4; ++m)
            if (IN(pb + 10 + m) && ((BR_MASK >> m) & 1)) { RETID(); if (m == 0) meta_gemm(F, 4, BR + (size_t)MREAL * 512, 512, (const bf16*)(wb + W_BR), DM, 512, XN, DM, 0.f); pg8::Gemm g{opaque((const bf16*)(BR + (size_t)m * MPAD * 512)), opaque((const bf16*)(wb + W_BR) + (size_t)m * DM * 512), MREAL, DM, 512}; pg8::StaticOrder S; S.init(MREAL, DM, F.G, opaque(F.bid));
                pg8::EpiGateAcc E{XN, DM, BIG, NGATE, m * DM, (BR_MASK & ((1 << m) - 1)) == 0}; pg8::gemm_phase<pg8::EpiGateAcc, pg8::StaticOrder, true, true>(F.lds + RING_OFF, g, S, E, F.tid); if (repm + 1 < nrepm_) GRID_BAR(); else SEAM(pb + 10 + m); } }
        if (IN(pb + 14) && BR_MASK) { REP_BEGIN(14) RETID(); meta_gemm(F, 1, XN + (size_t)MREAL * DM, DM, (const bf16*)(wb + W_O), DM, DM, nullptr, 0, rep ? 0.f : 1.0f); pg8::Gemm g{opaque((const bf16*)(XN)), opaque((const bf16*)(wb + W_O)), MREAL, DM, DM}; pg8::StaticOrder S; S.init(MREAL, DM, F.G, opaque(F.bid));
            pg8::EpiResF32 E{F.out, F.out, HM, DM, MT_REAL, rep ? 0.f : 1.0f}; pg8::gemm_phase<pg8::EpiResF32, pg8::StaticOrder, true, true>(F.lds + RING_OFF, g, S, E, F.tid); REP_END SEAM(pb + 14); }
        if (IN(pb + 15)) { REP_BEGIN(15) RETID(); phase_norm(F, F.out, FIN(F, I_F2N) + l * DM); REP_END SEAM(pb + 15); }
        if (IN(pb + 16)) { REP_BEGIN(16) RETID(); meta_gemm(F, 0, XN + (size_t)MREAL * DM, DM, (const bf16*)(wb + W_GU2), NGU, DM, BIG, DFF, 0.f); pg8::Gemm g{opaque((const bf16*)(XN)), opaque((const bf16*)(wb + W_GU2)), MREAL, NGU, DM}; pg8::StaticOrder S; S.init(MREAL, NGU, F.G, opaque(F.bid));
            pg8::EpiSwiGLU E{BIG, DFF}; pg8::gemm_phase<pg8::EpiSwiGLU, pg8::StaticOrder, true, true>(F.lds + RING_OFF, g, S, E, F.tid); REP_END SEAM(pb + 16); }
        if (IN(pb + 17)) { REP_BEGIN(17) RETID(); meta_gemm(F, 1, BIG + (size_t)MREAL * DFF, DFF, (const bf16*)(wb + W_D2), DM, DFF, nullptr, 0, rep ? 0.f : 0.5f); pg8::Gemm g{opaque((const bf16*)(BIG)), opaque((const bf16*)(wb + W_D2)), MREAL, DM, DFF}; pg8::StaticOrder S; S.init(MREAL, DM, F.G, opaque(F.bid));
            pg8::EpiResF32 E{F.out, F.out, HM, DM, MT_REAL, rep ? 0.f : 0.5f}; pg8::gemm_phase<pg8::EpiResF32, pg8::StaticOrder, true, true>(F.lds + RING_OFF, g, S, E, F.tid); REP_END SEAM(pb + 17); }
    }
}

extern "C" void kernel_launch(void* const* d_in, const int* in_sizes, int n_in, void* d_out, int out_size, void* d_ws, size_t ws_size, hipStream_t stream) {
    static int grid = 0;
    if (grid == 0) {
        if (n_in != 22 || out_size != MREAL * DM || ws_size < WS_END) { fprintf(stderr, "kernel_launch: unexpected shapes (n_in %d out %d ws %zu need %zu)\n", n_in, out_size, ws_size, (size_t)WS_END); grid = -1; return; }
        int dev = 0, cus = 0, per_cu = 0;
        if (hipGetDevice(&dev) != hipSuccess || hipDeviceGetAttribute(&cus, hipDeviceAttributeMultiprocessorCount, dev) != hipSuccess) { grid = -1; return; }
        if (hipFuncSetAttribute((const void*)fwd, hipFuncAttributeMaxDynamicSharedMemorySize, LDS_BYTES) != hipSuccess) { fprintf(stderr, "kernel_launch: hipFuncSetAttribute failed\n"); grid = -1; return; }
        if (hipOccupancyMaxActiveBlocksPerMultiprocessor(&per_cu, (const void*)fwd, NWAVES * 64, LDS_BYTES) != hipSuccess || per_cu < 1) fprintf(stderr, "kernel_launch: occupancy query says %d\n", per_cu);
        (void)hipGetLastError();
        grid = cus < 256 ? cus : 256;
    }
    if (grid < 0) return;
    (void)hipMemsetAsync((char*)d_ws + WS_CTL, 0, CTL_ZERO_BYTES, stream);
    Args a{};
    for (int i = 0; i < 22; ++i) a.in[i] = (const float*)d_in[i];
    a.out = (float*)d_out; a.ws = (unsigned char*)d_ws;
#ifndef PH_END
#define PH_END (2 * NPH)
#endif
#if MK_ONE
    a.ph_lo = 0; a.ph_hi = PH_END;
    hipLaunchKernelGGL(fwd, dim3(grid), dim3(NWAVES * 64), LDS_BYTES, stream, a);
#else
    for (int p = 0; p < PH_END; ++p) { a.ph_lo = p; a.ph_hi = p + 1;
#if defined(DBG_SEL)
#ifdef DBG_PREFILL
        if (p == 9) (void)hipMemsetAsync((char*)d_ws + WS_BIG, 0x3F, (size_t)MPAD * NGATE * 2, stream);
#endif
        if (DBG_SEL >= 30 && DBG_SEL < 40 && p == 14) hipLaunchKernelGGL(k_dbg_naive_wo, dim3(8, 2048), dim3(256), 0, stream, (const float*)d_out, (const unsigned short*)((char*)d_ws + WS_XN), (const unsigned short*)((char*)d_ws + WS_W + W_O), (float*)((char*)d_ws + WS_BIG));
#endif
        hipLaunchKernelGGL(fwd, dim3(grid), dim3(NWAVES * 64), LDS_BYTES, stream, a); }
#endif
#ifdef DBG_SEL
    { unsigned long long* best = (unsigned long long*)((char*)d_ws + 512 * 1024); unsigned* cnt = (unsigned*)((char*)d_ws + 512 * 1024 + 64);
      if (DBG_SEL >= 60 && DBG_SEL < 70) hipLaunchKernelGGL(k_dbg_argmax_bf16, dim3(2048), dim3(256), 0, stream, (const unsigned short*)((char*)d_ws + WS_BIG), NGATE, NGATE, best);
      else hipLaunchKernelGGL(k_dbg_argmax, dim3(2048), dim3(256), 0, stream, (const float*)d_out, (const float*)d_in[0], best);
      hipLaunchKernelGGL(k_dbg_count, dim3(2048), dim3(256), 0, stream, (const float*)d_out, (const float*)d_in[0], cnt);
      if (DBG_SEL >= 20 && DBG_SEL < 30) { const int mm = 1; hipLaunchKernelGGL(k_dbg_chk_merge, dim3(8, 2048), dim3(256), 0, stream, (const unsigned short*)((char*)d_ws + WS_BR) + (size_t)mm * MPAD * 512, (const unsigned short*)((char*)d_ws + WS_W + W_BR) + (size_t)mm * DM * 512, (const unsigned short*)((char*)d_ws + WS_BIG), (const unsigned short*)((char*)d_ws + WS_XN), mm, cnt); }
      if (DBG_SEL >= 30 && DBG_SEL < 40) hipLaunchKernelGGL(k_dbg_cmp, dim3(2048), dim3(256), 0, stream, (const float*)d_out, (const float*)((char*)d_ws + WS_BIG), cnt);
      if (DBG_SEL >= 40 && DBG_SEL < 50) { const unsigned short* A = nullptr; int ld = 0, nc = 0;
        if (DBG_SEL < 42) { A = (const unsigned short*)((char*)d_ws + WS_BR) + (size_t)MPAD * 512; ld = 512; nc = 512; }
        else if (DBG_SEL < 44) { A = (const unsigned short*)((char*)d_ws + WS_BIG) + DM; ld = NGATE; nc = DM; }
        else if (DBG_SEL < 46) { A = (const unsigned short*)((char*)d_ws + WS_XN); ld = DM; nc = DM; }
        else { A = (const unsigned short*)((char*)d_ws + WS_BR); ld = 512; nc = 512; }
        hipLaunchKernelGGL(k_dbg_stats, dim3(1024), dim3(256), 0, stream, A, ld, nc, cnt); }
      if (DBG_SEL >= 70 && DBG_SEL < 80) hipLaunchKernelGGL(k_dbg_gcount, dim3(1024), dim3(256), 0, stream, (const unsigned short*)((char*)d_ws + WS_BIG), cnt);
      if (DBG_SEL >= 100) hipLaunchKernelGGL(k_dbg_time, dim3(1), dim3(64), 0, stream, (const unsigned long long*)((char*)d_ws + 768 * 1024), cnt);
      hipLaunchKernelGGL(k_dbg_emit, dim3(2048), dim3(256), 0, stream, (float*)d_out, (const float*)d_in[0], best, cnt); }
#endif
}
```

```cpp
#include <hip/hip_runtime.h>
#include <cstdio>
#include <cstdint>
#define MK_ONE 1
namespace pg8 {
#define PG8_LAS __attribute__((address_space(3)))
typedef unsigned short bf16_t;
typedef short bf16x8 __attribute__((ext_vector_type(8)));
typedef float f32x4 __attribute__((ext_vector_type(4)));
typedef unsigned u32x4 __attribute__((ext_vector_type(4)));
constexpr int BM = 256, BK = 64, HALF = 128, HTB = HALF * BK * 2  , STAGE_BYTES = 8 * HTB, NXCD = 8, WGM = 8;

__host__ __device__ __forceinline__ int lds_byte(int r, int c) { const int st = (r >> 4) * 2 + (c >> 5), rr = r & 15, cc = c & 31, ob = rr * 64 + cc * 2; return st * 1024 + (ob ^ (((ob >> 9) & 1) << 5)); }
__host__ __device__ __forceinline__ void stage_rc(int b, int& R, int& C) { const int st = b / 1024, sb = b % 1024, swz = sb ^ (((sb >> 9) & 1) << 5); R = (st >> 1) * 16 + swz / 64; C = (st & 1) * 32 + (swz % 64) / 2; }
__host__ __device__ __forceinline__ int perm32(int rho) { const int n = rho >> 4, i = rho & 15; return 8 * (i >> 2) + 4 * n + (i & 3); }

struct Unit { int pm, pn; };
struct Gemm { const bf16_t* A; const bf16_t* Bt; int M, N, K; };

struct StaticOrder {
    int nM, nN, nwg, G, c;
    __host__ __device__ void init(int M, int N, int G_, int c_) { nM = M / BM; nN = N / BM; nwg = nM * nN; G = G_; c = c_; }
    __host__ __device__ bool next(int i, Unit& u) const {
        const long L = (long)i * G + c; if (L >= nwg) return false;
        int wgid = (int)L; { const int q = nwg / NXCD, r = nwg % NXCD, xcd = wgid % NXCD, off = wgid / NXCD; wgid = (xcd < r ? xcd * (q + 1) : r * (q + 1) + (xcd - r) * q) + off; }
        const int nig = WGM * nN, gid = wgid / nig, fm = gid * WGM, gsz = (nM - fm) < WGM ? (nM - fm) : WGM;
        u.pm = fm + ((wgid % nig) % gsz); u.pn = (wgid % nig) / gsz; return true;
    }
    __device__ __forceinline__ void a_ready(const Unit&) const {}
    __device__ __forceinline__ void done(const Unit&) const {}
};
typedef __bf16 bf16x2_hw __attribute__((ext_vector_type(2))); typedef float f32x2_hw __attribute__((ext_vector_type(2)));
__device__ __forceinline__ unsigned cvt_pk_bf16(float lo, float hi) { const f32x2_hw v = {lo, hi}; return __builtin_bit_cast(unsigned, __builtin_convertvector(v, bf16x2_hw)); }
typedef float f32x2 __attribute__((ext_vector_type(2)));
__device__ __forceinline__ float fast_sigmoid(float x) { return __builtin_amdgcn_rcpf(1.0f + __expf(-x)); }
__device__ __forceinline__ float fast_silu(float x) { return x * fast_sigmoid(x); }
template <int ACT  > struct EpiBf16 {
    static constexpr bool PERM = true, AFTER_DRAIN = false;
    bf16_t* O; int ldc;
    __device__ __forceinline__ void operator()(const f32x4 (&acc)[2][2][4][2], const Unit& u, int wr, int wc, int fr, int fq) const {
        const int row0 = u.pm * BM + wr * 64 + fr; const int col0 = u.pn * BM + wc * 32 + 8 * fq;
#pragma unroll
        for (int ai = 0; ai < 2; ++ai)
#pragma unroll
            for (int m = 0; m < 4; ++m) { bf16_t* rowp = O + (size_t)(row0 + ai * HALF + m * 16) * ldc + col0;
#pragma unroll
                for (int bj = 0; bj < 2; ++bj) { f32x4 v0 = acc[ai][bj][m][0], v1 = acc[ai][bj][m][1];
                    if (ACT == 1) {
#pragma unroll
                        for (int j = 0; j < 4; ++j) { v0[j] = fast_sigmoid(v0[j]); v1[j] = fast_sigmoid(v1[j]); } }
                    u32x4 w; w.x = cvt_pk_bf16(v0[0], v0[1]); w.y = cvt_pk_bf16(v0[2], v0[3]); w.z = cvt_pk_bf16(v1[0], v1[1]); w.w = cvt_pk_bf16(v1[2], v1[3]);
                    *(u32x4*)(rowp + bj * HALF) = w; } }
    }
};
struct EpiSwiGLU {
    static constexpr bool PERM = true, AFTER_DRAIN = false;
    bf16_t* O; int ldc;
    __device__ __forceinline__ void operator()(const f32x4 (&acc)[2][2][4][2], const Unit& u, int wr, int wc, int fr, int fq) const {
        const int row0 = u.pm * BM + wr * 64 + fr; const int col0 = u.pn * HALF + wc * 32 + 8 * fq;
#pragma unroll
        for (int ai = 0; ai < 2; ++ai)
#pragma unroll
            for (int m = 0; m < 4; ++m) { bf16_t* rowp = O + (size_t)(row0 + ai * HALF + m * 16) * ldc + col0;
                const f32x4 g0 = acc[ai][0][m][0], g1 = acc[ai][0][m][1], u0 = acc[ai][1][m][0], u1 = acc[ai][1][m][1];
                f32x4 v0, v1;
#pragma unroll
                for (int j = 0; j < 4; ++j) { v0[j] = fast_silu(g0[j]) * u0[j]; v1[j] = fast_silu(g1[j]) * u1[j]; }
                u32x4 w; w.x = cvt_pk_bf16(v0[0], v0[1]); w.y = cvt_pk_bf16(v0[2], v0[3]); w.z = cvt_pk_bf16(v1[0], v1[1]); w.w = cvt_pk_bf16(v1[2], v1[3]);
                *(u32x4*)rowp = w; asm volatile("" ::: "memory"); }
    }
};
struct EpiResF32 {
    static constexpr bool PERM = false, AFTER_DRAIN = false;
    const float* base_r; float* out_r; float* hm; int ldc; int mt_real; float scale;
    __device__ __forceinline__ void operator()(const f32x4 (&acc)[2][2][4][2], const Unit& u, int wr, int wc, int fr, int fq) const {
        const bool real = u.pm < mt_real;
        const float* bp = real ? base_r + (size_t)u.pm * BM * ldc : hm; float* op = real ? out_r + (size_t)u.pm * BM * ldc : hm;
        const int row0 = wr * 64 + fr, col0 = u.pn * BM + wc * 32 + 4 * fq;
#pragma unroll
        for (int ai = 0; ai < 2; ++ai)
#pragma unroll
            for (int m = 0; m < 4; ++m) { const size_t off = (size_t)(row0 + ai * HALF + m * 16) * ldc + col0;
#pragma unroll
                for (int bj = 0; bj < 2; ++bj)
#pragma unroll
                    for (int n = 0; n < 2; ++n) { const f32x4 b = *(const f32x4*)(bp + off + bj * HALF + n * 16); *(f32x4*)(op + off + bj * HALF + n * 16) = b + acc[ai][bj][m][n] * scale; }
                asm volatile("" ::: "memory"); }
    }
};
struct EpiGateAcc {
    static constexpr bool PERM = true, AFTER_DRAIN = false;
    bf16_t* MG; int ldc; const bf16_t* G; int ldg; int gcol0; int first;
    __device__ __forceinline__ void operator()(const f32x4 (&acc)[2][2][4][2], const Unit& u, int wr, int wc, int fr, int fq) const {
        const int row0 = u.pm * BM + wr * 64 + fr; const int col0 = u.pn * BM + wc * 32 + 8 * fq;
#pragma unroll
        for (int ai = 0; ai < 2; ++ai)
#pragma unroll
            for (int m = 0; m < 4; ++m) { const size_t r = (size_t)(row0 + ai * HALF + m * 16);
#pragma unroll
                for (int bj = 0; bj < 2; ++bj) { const u32x4 gw = *(const u32x4*)(G + r * ldg + gcol0 + col0 + bj * HALF);
                    u32x4 pw = (u32x4){0u, 0u, 0u, 0u}; if (!first) pw = *(const u32x4*)(MG + r * ldc + col0 + bj * HALF);
                    float o[8];
#pragma unroll
                    for (int j = 0; j < 4; ++j) { const float a0 = (j < 2) ? acc[ai][bj][m][0][2 * j] : acc[ai][bj][m][1][2 * (j - 2)], a1 = (j < 2) ? acc[ai][bj][m][0][2 * j + 1] : acc[ai][bj][m][1][2 * (j - 2) + 1];
                        o[2 * j] = __uint_as_float(pw[j] << 16) + __uint_as_float(gw[j] << 16) * a0; o[2 * j + 1] = __uint_as_float(pw[j] & 0xffff0000u) + __uint_as_float(gw[j] & 0xffff0000u) * a1; }
                    u32x4 w; w.x = cvt_pk_bf16(o[0], o[1]); w.y = cvt_pk_bf16(o[2], o[3]); w.z = cvt_pk_bf16(o[4], o[5]); w.w = cvt_pk_bf16(o[6], o[7]);
                    *(u32x4*)(MG + r * ldc + col0 + bj * HALF) = w; } }
    }
};

struct MergeOrder {
    int nM, nN, G, c, mt_alloc;
    __host__ __device__ void init(int M, int N, int G_, int c_, int mt_alloc_) { nM = M / BM; nN = N / BM; G = G_; c = c_; mt_alloc = mt_alloc_; }
    __host__ __device__ bool next(int i, Unit& u) const { const int t = (i >> 2) * G + c, m = i & 3; if (t >= nM * nN) return false;
        const int pm = t / nN, pn = t % nN; u.pm = m * mt_alloc + pm; u.pn = m * nN + pn; return true; }
    __device__ __forceinline__ void a_ready(const Unit&) const {}
    __device__ __forceinline__ void done(const Unit&) const {}
};
struct EpiGateAccM {
    static constexpr bool PERM = true, AFTER_DRAIN = false;
    bf16_t* MG; int ldc; const bf16_t* G; int ldg; int mt_alloc; int ntn;
    __device__ __forceinline__ void operator()(const f32x4 (&acc)[2][2][4][2], const Unit& u, int wr, int wc, int fr, int fq) const {
        const int m = u.pm / mt_alloc, pm = u.pm - m * mt_alloc, pn = u.pn - m * ntn;
        const int row0 = pm * BM + wr * 64 + fr; const int col0 = pn * BM + wc * 32 + 8 * fq; const int gcol0 = m * ntn * BM;
#pragma unroll
        for (int ai = 0; ai < 2; ++ai)
#pragma unroll
            for (int mm = 0; mm < 4; ++mm) { const size_t r = (size_t)(row0 + ai * HALF + mm * 16);
#pragma unroll
                for (int bj = 0; bj < 2; ++bj) { const u32x4 gw = *(const u32x4*)(G + r * ldg + gcol0 + col0 + bj * HALF);
                    u32x4 pw = (u32x4){0u, 0u, 0u, 0u}; if (m != 0) pw = *(const u32x4*)(MG + r * ldc + col0 + bj * HALF);
                    float o[8];
#pragma unroll
                    for (int j = 0; j < 4; ++j) { const float a0 = (j < 2) ? acc[ai][bj][mm][0][2 * j] : acc[ai][bj][mm][1][2 * (j - 2)], a1 = (j < 2) ? acc[ai][bj][mm][0][2 * j + 1] : acc[ai][bj][mm][1][2 * (j - 2) + 1];
                        o[2 * j] = __uint_as_float(pw[j] << 16) + __uint_as_float(gw[j] << 16) * a0; o[2 * j + 1] = __uint_as_float(pw[j] & 0xffff0000u) + __uint_as_float(gw[j] & 0xffff0000u) * a1; }
                    u32x4 w; w.x = cvt_pk_bf16(o[0], o[1]); w.y = cvt_pk_bf16(o[2], o[3]); w.z = cvt_pk_bf16(o[4], o[5]); w.w = cvt_pk_bf16(o[6], o[7]);
                    *(u32x4*)(MG + r * ldc + col0 + bj * HALF) = w; } }
    }
};
template <class Epi, class Sched, bool ALIGN_EPI = false, bool SP2 = false>
__device__ __forceinline__ void gemm_phase(PG8_LAS unsigned char* lds, const Gemm g, const Sched& S, const Epi& E, int tid_in) {
    int tid_ = tid_in; asm volatile("" : "+v"(tid_));
    const int tid = tid_, wid = __builtin_amdgcn_readfirstlane(tid >> 6), lane = tid & 63, wr = wid >> 2, wc = wid & 3, fr = lane & 15, fq = lane >> 4;
    const int K = g.K, nt = K / BK;
    unsigned voffA[2], voffB[2];
#pragma unroll
    for (int i = 0; i < 2; ++i) { int R, C; stage_rc(tid * 16 + i * 8192, R, C); const int Rb = Epi::PERM ? ((R & ~31) + perm32(R & 31)) : R;
        voffA[i] = (unsigned)(R * K + C) * 2u; voffB[i] = (unsigned)(Rb * K + C) * 2u; }
    const size_t kstep = (size_t)(BK * 2);
    const size_t hstep = (size_t)HALF * K * 2;
    const size_t tstep = 2 * hstep;
    const unsigned ldsw = (unsigned)wid * 1024u;
    const int aoff = lds_byte(wr * 64 + fr, fq * 8), boff = lds_byte(wc * 32 + fr, fq * 8);
#define PG8_SA(b, h) (((b) * 2 + (h)) * HTB)
#define PG8_SB(b, h) ((4 + (b) * 2 + (h)) * HTB)
#define PG8_STAGE(bufoff, gbase, voff) do { _Pragma("unroll") for (int _i = 0; _i < 2; ++_i) \
        __builtin_amdgcn_global_load_lds((const unsigned*)((const char*)(gbase) + (voff)[_i]), (PG8_LAS unsigned*)(lds + (bufoff) + ldsw + _i * 8192), 16, 0, 0); } while (0)
#define PG8_LDA(dst, b, h) do { _Pragma("unroll") for (int m = 0; m < 4; ++m) _Pragma("unroll") for (int k = 0; k < 2; ++k) dst[m][k] = *(const PG8_LAS bf16x8*)(lds + PG8_SA(b, h) + aoff + m * 2048 + k * 1024); } while (0)
#define PG8_LDB(dst, b, h) do { _Pragma("unroll") for (int n = 0; n < 2; ++n) _Pragma("unroll") for (int k = 0; k < 2; ++k) dst[n][k] = *(const PG8_LAS bf16x8*)(lds + PG8_SB(b, h) + boff + n * 2048 + k * 1024); } while (0)
#define PG8_MMA(ai, bj, At, Bt) do { __builtin_amdgcn_s_setprio(1); _Pragma("unroll") for (int m = 0; m < 4; ++m) _Pragma("unroll") for (int n = 0; n < 2; ++n) _Pragma("unroll") for (int k = 0; k < 2; ++k) \
        acc[ai][bj][m][n] = __builtin_amdgcn_mfma_f32_16x16x32_bf16(Bt[n][k], At[m][k], acc[ai][bj][m][n], 0, 0, 0); __builtin_amdgcn_s_setprio(0); } while (0)
#define PG8_WAIT_V(n) asm volatile("s_waitcnt vmcnt(" #n ")" ::: "memory")
#define PG8_WAIT_L(n) asm volatile("s_waitcnt lgkmcnt(" #n ")" ::: "memory")
#define PG8_BAR __builtin_amdgcn_s_barrier()
#define PG8_SCHED __builtin_amdgcn_sched_barrier(0)
    Unit cur, nxt; int ui = 0;
    if (!S.next(0, cur)) return;
    f32x4 acc[2][2][4][2];
#pragma unroll
    for (int a = 0; a < 2; ++a)
#pragma unroll
        for (int b = 0; b < 2; ++b)
#pragma unroll
            for (int m = 0; m < 4; ++m)
#pragma unroll
                for (int n = 0; n < 2; ++n) acc[a][b][m][n] = (f32x4){0.f, 0.f, 0.f, 0.f};
    bf16x8 At[4][2], B0[2][2], B1[2][2];
    const char* cA = (const char*)g.A + (size_t)cur.pm * tstep; const char* cB = (const char*)g.Bt + (size_t)cur.pn * tstep;
    S.a_ready(cur);
    if constexpr (SP2) {
        PG8_STAGE(PG8_SB(0, 0), cB, voffB); PG8_STAGE(PG8_SB(0, 1), cB + hstep, voffB); PG8_STAGE(PG8_SA(0, 0), cA, voffA); PG8_STAGE(PG8_SA(0, 1), cA + hstep, voffA);
        if (wr == 1) PG8_BAR;
        PG8_WAIT_V(2); PG8_BAR;
        PG8_STAGE(PG8_SB(1, 0), cB + kstep, voffB); PG8_STAGE(PG8_SA(1, 0), cA + kstep, voffA); PG8_STAGE(PG8_SB(1, 1), cB + hstep + kstep, voffB);
        PG8_WAIT_V(6); PG8_BAR;
    } else {
        PG8_STAGE(PG8_SB(0, 0), cB, voffB); PG8_STAGE(PG8_SA(0, 0), cA, voffA); PG8_STAGE(PG8_SB(0, 1), cB + hstep, voffB); PG8_STAGE(PG8_SA(0, 1), cA + hstep, voffA);
        if (wr == 1) PG8_BAR;
        PG8_WAIT_V(4); PG8_BAR;
        PG8_STAGE(PG8_SB(1, 0), cB + kstep, voffB); PG8_STAGE(PG8_SA(1, 0), cA + kstep, voffA); PG8_STAGE(PG8_SB(1, 1), cB + hstep + kstep, voffB);
        PG8_WAIT_V(6); PG8_BAR;
    }
    for (;;) {
        const bool has_next = S.next(ui + 1, nxt);
        const char* nA = has_next ? (const char*)g.A + (size_t)nxt.pm * tstep : cA; const char* nB = has_next ? (const char*)g.Bt + (size_t)nxt.pn * tstep : cB;
        for (int t = 0; t < nt; t += 2) {
            const bool last = (t == nt - 2);
            const char* a1 = cA + (size_t)(t + 1) * kstep;
            const char* a2 = last ? nA : cA + (size_t)(t + 2) * kstep; const char* b2 = last ? nB : cB + (size_t)(t + 2) * kstep;
            const char* a3 = a2 + kstep; const char* b3 = b2 + kstep;
            if (last && has_next) S.a_ready(nxt);
            if constexpr (SP2) {
            PG8_LDB(B0, 0, 0); PG8_LDB(B1, 0, 1); PG8_SCHED; PG8_LDA(At, 0, 0); PG8_STAGE(PG8_SA(1, 1), a1 + hstep, voffA);
            PG8_WAIT_V(8); PG8_WAIT_L(0); PG8_BAR; PG8_MMA(0, 0, At, B0); PG8_MMA(0, 1, At, B1); PG8_BAR; PG8_SCHED;
            PG8_LDA(At, 0, 1); PG8_STAGE(PG8_SB(0, 0), b2, voffB); PG8_STAGE(PG8_SB(0, 1), b2 + hstep, voffB); PG8_STAGE(PG8_SA(0, 0), a2, voffA);
            PG8_WAIT_V(8); PG8_WAIT_L(0); PG8_BAR; PG8_MMA(1, 0, At, B0); PG8_MMA(1, 1, At, B1); PG8_BAR; PG8_SCHED;
            PG8_LDB(B0, 1, 0); PG8_LDB(B1, 1, 1); PG8_SCHED; PG8_LDA(At, 1, 0); PG8_STAGE(PG8_SA(0, 1), a2 + hstep, voffA);
            PG8_WAIT_V(8); PG8_WAIT_L(0); PG8_BAR; PG8_MMA(0, 0, At, B0); PG8_MMA(0, 1, At, B1); PG8_BAR; PG8_SCHED;
            PG8_LDA(At, 1, 1); PG8_STAGE(PG8_SB(1, 0), b3, voffB); PG8_STAGE(PG8_SB(1, 1), b3 + hstep, voffB); PG8_STAGE(PG8_SA(1, 0), a3, voffA);
            PG8_WAIT_V(8); PG8_WAIT_L(0); PG8_BAR; PG8_MMA(1, 0, At, B0); PG8_MMA(1, 1, At, B1); PG8_BAR; PG8_SCHED;
            } else {
            PG8_LDB(B0, 0, 0); PG8_SCHED; PG8_LDA(At, 0, 0); PG8_STAGE(PG8_SA(1, 1), a1 + hstep, voffA);
            PG8_WAIT_L(8); PG8_BAR; PG8_WAIT_L(0); PG8_MMA(0, 0, At, B0); PG8_BAR; PG8_SCHED;
            PG8_LDB(B1, 0, 1); PG8_STAGE(PG8_SB(0, 0), b2, voffB);
            PG8_BAR; PG8_WAIT_L(0); PG8_MMA(0, 1, At, B1); PG8_BAR;
            PG8_LDA(At, 0, 1); PG8_STAGE(PG8_SA(0, 0), a2, voffA);
            PG8_BAR; PG8_WAIT_L(0); PG8_MMA(1, 0, At, B0); PG8_BAR; PG8_SCHED;
            PG8_STAGE(PG8_SB(0, 1), b2 + hstep, voffB);
            PG8_WAIT_V(6); PG8_BAR; PG8_MMA(1, 1, At, B1); PG8_BAR;
            PG8_LDB(B0, 1, 0); PG8_SCHED; PG8_LDA(At, 1, 0); PG8_STAGE(PG8_SA(0, 1), a2 + hstep, voffA);
            PG8_WAIT_L(8); PG8_BAR; PG8_WAIT_L(0); PG8_MMA(0, 0, At, B0); PG8_BAR; PG8_SCHED;
            PG8_LDB(B1, 1, 1); PG8_STAGE(PG8_SB(1, 0), b3, voffB);
            PG8_BAR; PG8_WAIT_L(0); PG8_MMA(0, 1, At, B1); PG8_BAR;
            PG8_LDA(At, 1, 1); PG8_STAGE(PG8_SA(1, 0), a3, voffA);
            PG8_BAR; PG8_WAIT_L(0); PG8_MMA(1, 0, At, B0); PG8_BAR; PG8_SCHED;
            PG8_STAGE(PG8_SB(1, 1), b3 + hstep, voffB);
            PG8_WAIT_V(6); PG8_BAR; PG8_MMA(1, 1, At, B1); PG8_BAR;
            }
        }
        if constexpr (ALIGN_EPI) { if (wr == 0) PG8_BAR; }
        if constexpr (!Epi::AFTER_DRAIN) { E(acc, cur, wr, wc, fr, fq); S.done(cur); }
        if (!has_next) break;
#pragma unroll
        for (int a = 0; a < 2; ++a)
#pragma unroll
            for (int b = 0; b < 2; ++b)
#pragma unroll
                for (int m = 0; m < 4; ++m)
#pragma unroll
                    for (int n = 0; n < 2; ++n) acc[a][b][m][n] = (f32x4){0.f, 0.f, 0.f, 0.f};
        cur = nxt; cA = nA; cB = nB; ++ui;
        if constexpr (ALIGN_EPI) { if (wr == 1) PG8_BAR; }
    }
    PG8_WAIT_V(0);
    if constexpr (!ALIGN_EPI) { if (wr == 0) PG8_BAR; }
    PG8_BAR;
    if constexpr (Epi::AFTER_DRAIN) { E.fused(acc, cur, wr, wc, fr, fq, lds, wid, lane); S.done(cur); }
#undef PG8_SA
#undef PG8_SB
#undef PG8_STAGE
#undef PG8_LDA
#undef PG8_LDB
#undef PG8_MMA
#undef PG8_WAIT_V
#undef PG8_WAIT_L
#undef PG8_BAR
#undef PG8_SCHED
}
}

constexpr int DM = 2048, NB = 8, SEQ = 4096, NMETA = 16, LSEQ = 4112, LPAD = 4128;
constexpr int MREAL = NB * SEQ;
constexpr int MPAD = MREAL + 256;
constexpr int MT_REAL = MREAL / 256;
constexpr int DFF = 5632, NGU = 2 * DFF, NNG = 7168, NGATE = 8192, INCOLS = 15184, NGC = 6992;
constexpr int NWAVES = 8;
constexpr float EPS = 1e-6f;
constexpr int C_AQ = 0, C_AF = 512, C_AI = 1024, C_AG = 1536, C_BB = 2048, C_BC = 2560, C_BU = 3072, C_CQ = 3584, C_CK = 4096, C_CV = 4608,
              C_DQ = 5120, C_DK = 5632, C_DV = 5760, C_DQI = 5888, C_DKI = 6912, C_DW = 6976;

constexpr size_t MiB = 1u << 20;
constexpr size_t WS_CTL = 0, CTL_ZERO_BYTES = 1 * MiB;
constexpr size_t WS_HM = 1 * MiB;
constexpr size_t WS_W = 4 * MiB;
constexpr size_t W_GU1 = 0, W_D1 = W_GU1 + (size_t)NGU * DM * 2, W_NG = W_D1 + (size_t)DM * DFF * 2, W_G = W_NG + (size_t)NNG * DM * 2,
                 W_BR = W_G + (size_t)NGATE * DM * 2, W_O = W_BR + (size_t)4 * DM * 512 * 2, W_GU2 = W_O + (size_t)DM * DM * 2, W_D2 = W_GU2 + (size_t)NGU * DM * 2,
                 W_END = W_D2 + (size_t)DM * DFF * 2;
constexpr size_t WS_XN = WS_W + W_END;
constexpr size_t WS_BR = WS_XN + (size_t)MPAD * DM * 2;
constexpr size_t WS_BIG = WS_BR + (size_t)MPAD * DM * 2;
constexpr size_t BIG_P_END = (size_t)MPAD * NNG * 2;
constexpr size_t WS_VTC = WS_BIG + BIG_P_END;
constexpr size_t WS_VTD = WS_VTC + (size_t)NB * 4 * 128 * LPAD * 2;
constexpr size_t WS_MASK = WS_VTD + (size_t)NB * 128 * LPAD * 2;
constexpr int MASKW = 132;
constexpr int NIDX_WG = 172;
constexpr int NHG_WG = 32;
constexpr size_t WS_SCR = WS_MASK + (size_t)NB * LPAD * MASKW * 4;
constexpr size_t WS_HA = WS_SCR + (size_t)NIDX_WG * 32 * LPAD * 4;
constexpr size_t WS_HDL = WS_HA + (size_t)NB * 4 * 64 * 64 * 64 * 2;
constexpr size_t WS_HMETA = WS_HDL + (size_t)NB * 4 * 64 * 128 * 4;
constexpr size_t HMETA_STRIDE = 64 * 384 * 2 + 64 * 64 * 2 + 128 * 4;
constexpr size_t WS_END = WS_HMETA + 4 * HMETA_STRIDE;
static_assert(WS_BIG + (size_t)MPAD * NGATE * 2 <= WS_END, "G fits");
static_assert(WS_END <= (size_t)1138174976, "workspace map fits the guaranteed size");

constexpr int RING_OFF = 0, RING_BYTES = 131072;
constexpr int LDSCTL_OFF = 143360, MISC_OFF = LDSCTL_OFF + 320;
constexpr int LDS_BYTES = 147456;

#define GAS __attribute__((address_space(1)))
#define LAS __attribute__((address_space(3)))
typedef unsigned short bf16;
typedef unsigned v4u __attribute__((ext_vector_type(4)));
typedef unsigned v2u __attribute__((ext_vector_type(2)));
typedef float f32x4 __attribute__((ext_vector_type(4)));
typedef float f32x16 __attribute__((ext_vector_type(16)));
typedef short bf16x8 __attribute__((ext_vector_type(8)));
typedef GAS unsigned gu32;
#define RLX_AGENT __ATOMIC_RELAXED, __HIP_MEMORY_SCOPE_AGENT
#define LDS_WAIT() asm volatile("s_waitcnt lgkmcnt(0)" ::: "memory")
#define VM_WAIT() asm volatile("s_waitcnt vmcnt(0)" ::: "memory")
__device__ __forceinline__ unsigned f2bf(float f) { unsigned u = __builtin_bit_cast(unsigned, f); return (u + 0x7fffu + ((u >> 16) & 1u)) >> 16; }
__device__ __forceinline__ unsigned f2bf_s(float f) { return pg8::cvt_pk_bf16(f, 0.f) & 0xffffu; }
__device__ __forceinline__ unsigned pk2(float lo, float hi) { return pg8::cvt_pk_bf16(lo, hi); }
__device__ __forceinline__ float bflo(unsigned w) { return __uint_as_float(w << 16); }
__device__ __forceinline__ float bfhi(unsigned w) { return __uint_as_float(w & 0xffff0000u); }
__device__ __forceinline__ float bf2f(bf16 v) { return __uint_as_float((unsigned)v << 16); }
__device__ __forceinline__ int seqrow(int b, int p) { return p < NMETA ? MREAL + p : b * SEQ + p - NMETA; }
__device__ __forceinline__ int rel_bucket(int n) {
    if (n < 16) return n; if (n >= 128) return 31;
    const int v = 16 + (int)(__log2f((float)n * 0.0625f) * 5.33333333f); return v < 31 ? v : 31; }
__device__ __forceinline__ float wave_sum(float v) {
#pragma unroll
    for (int o = 1; o < 64; o <<= 1) v += __shfl_xor(v, o);
    return v;
}
#define XB_TMO      128
#define XB_XCNT(j)  (256  + 64 * (j))
#define XB_XSUB(j)  (1280 + 64 * (j))
#define XB_XGEN(j)  (2304 + 64 * (j))
#define XB_TOP      3328
#define XB_TOPGEN   3392
#define XCD_BAR_WORDS 3456
#define XB_SPIN_CAP (1u << 18)

__device__ __forceinline__ unsigned xb_ld(unsigned* p)              { return __hip_atomic_load(p, __ATOMIC_RELAXED, __HIP_MEMORY_SCOPE_AGENT); }
__device__ __forceinline__ unsigned xb_add(unsigned* p, unsigned v) { return __hip_atomic_fetch_add(p, v, __ATOMIC_RELAXED, __HIP_MEMORY_SCOPE_AGENT); }
__device__ __forceinline__ unsigned xb_xcc_id() { return (unsigned)__builtin_amdgcn_s_getreg((3 << 11) | 20) & 0xFu; }
#define XB_SPIN(cond, bar) do { unsigned _sp = 0; while (cond) { __builtin_amdgcn_s_sleep(1); \
    if ((++_sp & 255u) == 0u) { if (xb_ld(&(bar)[XB_TMO])) break; if (_sp > XB_SPIN_CAP) { atomicAdd(&(bar)[XB_TMO], 1u); break; } } } } while (0)

struct XcdBarrier {
    int wave;
    unsigned* bar; unsigned x;
    volatile LAS unsigned* st;
};

__device__ __forceinline__ bool xb_thread0(int wave) { unsigned mk = ~0u; asm volatile("" : "+s"(mk)); return wave == 0 && __builtin_amdgcn_mbcnt_hi(mk, __builtin_amdgcn_mbcnt_lo(mk, 0u)) == 0u; }
__device__ __forceinline__ XcdBarrier xcd_barrier_post(unsigned* bar, volatile LAS unsigned* st, int wave) {
    XcdBarrier b; b.wave = wave; b.bar = bar; b.x = xb_xcc_id(); b.st = st;
    if (xb_thread0(wave)) (void)xb_add(&bar[XB_XCNT(b.x)], 1u);
    return b;
}
__device__ __forceinline__ void xcd_barrier_complete(unsigned* bar, unsigned x, unsigned& nloc, unsigned& nx) {
    const unsigned G = gridDim.x * gridDim.y * gridDim.z;
    unsigned sum, cnt, mine, sp = 0u;
    for (;;) {
        sum = 0u; cnt = 0u; mine = 0u;
#pragma unroll
        for (unsigned j = 0; j < 16; ++j) { const unsigned c = xb_ld(&bar[XB_XCNT(j)]); sum += c; cnt += (c > 0u) ? 1u : 0u; mine = (j == x) ? c : mine; }
        if (sum == G) break;
        __builtin_amdgcn_s_sleep(1);
        if ((++sp & 255u) == 0u) { if (xb_ld(&bar[XB_TMO])) break; if (sp > XB_SPIN_CAP) { atomicAdd(&bar[XB_TMO], 1u); break; } }
    }
    nloc = mine > 0u ? mine : 1u; nx = cnt > 0u ? cnt : 1u;
}

__device__ __forceinline__ void xcd_barrier(const XcdBarrier& b) {
    asm volatile("s_waitcnt vmcnt(0)" ::: "memory");
    __syncthreads();
    if (xb_thread0(b.wave)) {
        unsigned* bar = b.bar;
        __builtin_amdgcn_s_waitcnt(0);
        unsigned nloc = b.st[0], nx = b.st[1];
        if (nloc == 0u) { xcd_barrier_complete(bar, b.x, nloc, nx); b.st[0] = nloc; b.st[1] = nx; }
        const unsigned old = xb_add(&bar[XB_XSUB(b.x)], 1u);
        const unsigned gen = old / nloc;
        if (old + 1u == (gen + 1u) * nloc) {
            __builtin_amdgcn_fence(__ATOMIC_RELEASE, "agent");
            asm volatile("s_waitcnt vmcnt(0)" ::: "memory");
            const unsigned og = xb_add(&bar[XB_TOP], 1u);
            const unsigned tg = og / nx;
            if (og + 1u == (tg + 1u) * nx) xb_add(&bar[XB_TOPGEN], 1u);
            else XB_SPIN(xb_ld(&bar[XB_TOPGEN]) == tg, bar);
            __builtin_amdgcn_fence(__ATOMIC_ACQUIRE, "agent");
            xb_add(&bar[XB_XGEN(b.x)], 1u);
            asm volatile("s_waitcnt vmcnt(0)" ::: "memory");
        } else {
            XB_SPIN(xb_ld(&bar[XB_XGEN(b.x)]) == gen, bar);
            __builtin_amdgcn_fence(__ATOMIC_ACQUIRE, "agent");
            asm volatile("s_waitcnt vmcnt(0)" ::: "memory");
        }
    }
    __syncthreads();
}

struct Frame {
    LAS unsigned char* lds;
    volatile LAS unsigned* MISC;
    gu32* ctl;
    int tid, lane, wave, G, bid;
    const unsigned char __attribute__((address_space(4)))* karg; float* out; unsigned char* ws;
};
__device__ __forceinline__ const float* fin_load(const unsigned char __attribute__((address_space(4)))* k, int i) { asm volatile("" : "+s"(k)); return *(const float* const __attribute__((address_space(4)))*)(k + 8 * i); }
#define FIN(F_, i_) fin_load((F_).karg, (i_))
enum { I_X = 0, I_META, I_RELB, I_F1N, I_F1GU, I_F1D, I_MIXN, I_WIN, I_LB, I_GN, I_CONVW, I_DQN, I_DKN, I_DLAM, I_DSUB, I_SQN, I_SKN, I_WBR, I_WOUT, I_F2N, I_F2GU, I_F2D };

template <class RowMap>
__device__ __forceinline__ void transpose_item(const float* W, int K, int N, bf16* WT, LAS float* scr, int item, int lane, RowMap rm) {
    const int nblk = (N + 31) / 32, kb = item / nblk, nb = item % nblk, k0 = 64 * kb, n0 = 32 * nb;
    const int nl = n0 + (lane & 31); const bool nok = nl < N;
#pragma unroll 8
    for (int i = 0; i < 32; ++i) { const int kk = 2 * i + (lane >> 5); scr[kk * 33 + (lane & 31)] = nok ? W[(size_t)(k0 + kk) * N + nl] : 0.f; }
    LDS_WAIT(); asm volatile("" ::: "memory");
    const int c = lane & 7;
#pragma unroll
    for (int j = 0; j < 4; ++j) { const int n = (lane >> 3) + 8 * j; const LAS float* s = scr + (8 * c) * 33 + n;
        v4u o; o.x = pk2(s[0 * 33], s[1 * 33]); o.y = pk2(s[2 * 33], s[3 * 33]); o.z = pk2(s[4 * 33], s[5 * 33]); o.w = pk2(s[6 * 33], s[7 * 33]);
        if (n0 + n < N) *(GAS v4u*)(WT + (size_t)rm(n0 + n) * K + k0 + 8 * c) = o; }
    LDS_WAIT(); asm volatile("" ::: "memory");
}
struct MapId { __device__ __forceinline__ int operator()(int n) const { return n; } };
struct MapGU { __device__ __forceinline__ int operator()(int n) const { const int up = n >= DFF, j = up ? n - DFF : n; return 256 * (j >> 7) + 128 * up + (j & 127); } };
struct MapIn { __device__ __forceinline__ int operator()(int n) const { return n < NGC ? n : n + (NNG - NGC); } };
template <class RowMap>
__device__ __forceinline__ void convert_matrix(Frame& F, const float* W, int K, int N, bf16* WT, RowMap rm) {
    LAS float* scr = (LAS float*)(F.lds + F.wave * 16384);
    const int gw = F.bid * NWAVES + F.wave, NGW = F.G * NWAVES, nitems = (K / 64) * ((N + 31) / 32);
    for (int it = gw; it < nitems; it += NGW) transpose_item(W, K, N, WT, scr, it, F.lane, rm);
}
__device__ __forceinline__ void phase_convert(Frame& F, int l) {
    unsigned char* wb = F.ws + WS_W;
    convert_matrix(F, FIN(F, I_F1GU) + (size_t)l * DM * NGU, DM, NGU, (bf16*)(wb + W_GU1), MapGU());
    convert_matrix(F, FIN(F, I_F1D) + (size_t)l * DFF * DM, DFF, DM, (bf16*)(wb + W_D1), MapId());
    convert_matrix(F, FIN(F, I_WIN) + (size_t)l * DM * INCOLS, DM, INCOLS, (bf16*)(wb + W_NG), MapIn());
    for (int m = 0; m < 4; ++m) convert_matrix(F, FIN(F, I_WBR) + ((size_t)l * 4 + m) * 512 * DM, 512, DM, (bf16*)(wb + W_BR) + (size_t)m * DM * 512, MapId());
    convert_matrix(F, FIN(F, I_WOUT) + (size_t)l * DM * DM, DM, DM, (bf16*)(wb + W_O), MapId());
    convert_matrix(F, FIN(F, I_F2GU) + (size_t)l * DM * NGU, DM, NGU, (bf16*)(wb + W_GU2), MapGU());
    convert_matrix(F, FIN(F, I_F2D) + (size_t)l * DFF * DM, DFF, DM, (bf16*)(wb + W_D2), MapId());
    { GAS v4u* z = (GAS v4u*)(wb + W_NG + (size_t)NGC * DM * 2); const int n16 = (NNG - NGC) * DM * 2 / 16;
      for (int i = F.bid * 512 + F.tid; i < n16; i += F.G * 512) z[i] = (v4u){0u, 0u, 0u, 0u}; }
    if (l == 0) {
        GAS f32x4* hm = (GAS f32x4*)(F.ws + WS_HM); const GAS f32x4* mt = (const GAS f32x4*)FIN(F, I_META);
        for (int i = F.bid * 512 + F.tid; i < 256 * DM / 4; i += F.G * 512) hm[i] = (i < NMETA * DM / 4) ? mt[i] : (f32x4){0.f, 0.f, 0.f, 0.f};
    }
}
__device__ __forceinline__ void phase_norm(Frame& F, const float* src_real, const float* gain) {
    const int gw = F.bid * NWAVES + F.wave, NGW = F.G * NWAVES;
    bf16* XN = (bf16*)(F.ws + WS_XN); const float* hm = (const float*)(F.ws + WS_HM);
    f32x4 g[8];
#pragma unroll
    for (int j = 0; j < 8; ++j) g[j] = ((const GAS f32x4*)gain)[F.lane + 64 * j];
    for (int r = gw; r < MPAD; r += NGW) {
        GAS v2u* o8 = (GAS v2u*)(XN + (size_t)r * DM) + F.lane;
        if (r >= MREAL + NMETA) {
#pragma unroll
            for (int j = 0; j < 8; ++j) o8[64 * j] = (v2u){0u, 0u};
            continue; }
        const float* xr = r < MREAL ? src_real + (size_t)r * DM : hm + (size_t)(r - MREAL) * DM;
        f32x4 v[8]; float s = 0.f;
#pragma unroll
        for (int j = 0; j < 8; ++j) { v[j] = ((const GAS f32x4*)xr)[F.lane + 64 * j]; s += (v[j].x * v[j].x + v[j].y * v[j].y) + (v[j].z * v[j].z + v[j].w * v[j].w); }
        const float inv = 1.0f / sqrtf(wave_sum(s) * (1.f / DM) + EPS);
#pragma unroll
        for (int j = 0; j < 8; ++j) { v2u w; w.x = pk2(v[j].x * inv * g[j].x, v[j].y * inv * g[j].y); w.y = pk2(v[j].z * inv * g[j].z, v[j].w * inv * g[j].w); o8[64 * j] = w; }
    }
}

__device__ __forceinline__ f32x4 meta_dot16(const bf16* A  , int lda, const bf16* Bt  , int K, int s0, int s1, int lane) {
    const int fr = lane & 15, g = lane >> 4; const bf16* ap = A + (size_t)fr * lda + 8 * g; const bf16* bp = Bt + (size_t)fr * K + 8 * g;
    f32x4 a0 = (f32x4){0.f, 0.f, 0.f, 0.f}, a1 = a0;
    for (int s = s0; s < s1; s += 2) {
        const bf16x8 x0 = *(const GAS bf16x8*)(ap + 32 * s), x1 = *(const GAS bf16x8*)(ap + 32 * s + 32);
        const bf16x8 w0 = *(const GAS bf16x8*)(bp + 32 * s), w1 = *(const GAS bf16x8*)(bp + 32 * s + 32);
        a0 = __builtin_amdgcn_mfma_f32_16x16x32_bf16(w0, x0, a0, 0, 0, 0); a1 = __builtin_amdgcn_mfma_f32_16x16x32_bf16(w1, x1, a1, 0, 0, 0); }
    return a0 + a1;
}
__device__ __forceinline__ void st_bf16x4(bf16* p, f32x4 v) { v2u w; w.x = pk2(v[0], v[1]); w.y = pk2(v[2], v[3]); *(GAS v2u*)p = w; }
__device__ __forceinline__ void meta_gemm(Frame& F, int kind, const bf16* A, int lda, const bf16* Bt, int N, int K, bf16* Obf, int ldo, float scale) {
    const int lane = F.lane, wave = F.wave, fr = lane & 15, g = lane >> 4;
    const int ngroups = (kind == 0 ? N / 2 : N) / 16;
    LAS f32x4* red = (LAS f32x4*)F.lds;
    const int ns = K / 32, s0 = (wave * ns) >> 3, s1 = ((wave + 1) * ns) >> 3;
    for (int cg = F.bid; cg < ngroups; cg += F.G) {
        const int n0 = 16 * cg;
        f32x4 p0, p1 = (f32x4){0.f, 0.f, 0.f, 0.f};
        if (kind == 0) { const int rg = 256 * (n0 >> 7) + (n0 & 127);
            p0 = meta_dot16(A, lda, Bt + (size_t)rg * K, K, s0, s1, lane); p1 = meta_dot16(A, lda, Bt + (size_t)(rg + 128) * K, K, s0, s1, lane); }
        else if (kind == 4) { const int mb = wave >> 1, kh = wave & 1; p0 = meta_dot16(A + (size_t)mb * MPAD * 512, 512, Bt + ((size_t)mb * DM + n0) * 512, 512, 8 * kh, 8 * kh + 8, lane); }
        else p0 = meta_dot16(A, lda, Bt + (size_t)n0 * K, K, s0, s1, lane);
        red[wave * 64 + lane] = p0; if (kind == 0) red[512 + wave * 64 + lane] = p1;
        LDS_WAIT(); __syncthreads();
        if (wave == 0) {
            f32x4 q[8];
#pragma unroll
            for (int w = 0; w < 8; ++w) q[w] = red[w * 64 + lane];
            if (kind == 4) { f32x4 tot = (f32x4){0.f, 0.f, 0.f, 0.f}; const bf16* G = (const bf16*)(F.ws + WS_BIG);
#pragma unroll
                for (int mb = 0; mb < 4; ++mb) { const f32x4 acc = q[2 * mb] + q[2 * mb + 1]; const v2u gw2 = *(const GAS v2u*)(G + (size_t)(MREAL + fr) * NGATE + mb * DM + n0 + 4 * g);
                    tot[0] += bflo(gw2.x) * acc[0]; tot[1] += bfhi(gw2.x) * acc[1]; tot[2] += bflo(gw2.y) * acc[2]; tot[3] += bfhi(gw2.y) * acc[3]; }
                st_bf16x4(Obf + (size_t)(MREAL + fr) * ldo + n0 + 4 * g, tot);
            } else {
                f32x4 acc = ((q[0] + q[1]) + (q[2] + q[3])) + ((q[4] + q[5]) + (q[6] + q[7]));
                if (kind == 0) { f32x4 up = (f32x4){0.f, 0.f, 0.f, 0.f};
#pragma unroll
                    for (int w = 0; w < 8; ++w) up += red[512 + w * 64 + lane];
#pragma unroll
                    for (int r = 0; r < 4; ++r) acc[r] = pg8::fast_silu(acc[r]) * up[r];
                    st_bf16x4(Obf + (size_t)(MREAL + fr) * ldo + n0 + 4 * g, acc); }
                else if (kind == 1) { float* hp = (float*)(F.ws + WS_HM) + (size_t)fr * DM + n0 + 4 * g; *(GAS f32x4*)hp = *(const GAS f32x4*)hp + acc * scale; }
                else if (kind == 2) st_bf16x4(Obf + (size_t)(MREAL + fr) * ldo + n0 + 4 * g, acc);
                else {
#pragma unroll
                    for (int r = 0; r < 4; ++r) acc[r] = pg8::fast_sigmoid(acc[r]);
                    st_bf16x4(Obf + (size_t)(MREAL + fr) * ldo + n0 + 4 * g, acc); }
            }
        }
        __syncthreads();
    }
}
__device__ __forceinline__ void unpack8(const v4u w, float (&x)[8]) { x[0] = bflo(w.x); x[1] = bfhi(w.x); x[2] = bflo(w.y); x[3] = bfhi(w.y); x[4] = bflo(w.z); x[5] = bfhi(w.z); x[6] = bflo(w.w); x[7] = bfhi(w.w); }
__device__ __forceinline__ v4u pack8(const float (&x)[8]) { v4u w; w.x = pk2(x[0], x[1]); w.y = pk2(x[2], x[3]); w.z = pk2(x[4], x[5]); w.w = pk2(x[6], x[7]); return w; }
template <int GL>
__device__ __forceinline__ void norm_cols_inplace(bf16* p, const v4u w, const float* gain, float scale, int lane, bool wr) {
    float x[8]; unpack8(w, x); float s = 0.f;
#pragma unroll
    for (int i = 0; i < 8; ++i) s += x[i] * x[i];
#pragma unroll
    for (int o = 1; o < GL; o <<= 1) s += __shfl_xor(s, o);
    const float inv = scale / sqrtf(s * (1.f / (GL * 8)) + EPS); const int g0 = (8 * lane) % (GL * 8);
#pragma unroll
    for (int i = 0; i < 8; ++i) x[i] = x[i] * inv * gain[g0 + i];
    if (wr) *(GAS v4u*)p = pack8(x);
}
__device__ __forceinline__ void phase_prep(Frame& F, int l) {
    const int gw = F.bid * NWAVES + F.wave, NGW = F.G * NWAVES, lane = F.lane;
    bf16* P = (bf16*)(F.ws + WS_BIG);
    const float *dqn = FIN(F, I_DQN) + l * 64, *dkn = FIN(F, I_DKN) + l * 64, *sqn = FIN(F, I_SQN) + l * 128, *skn = FIN(F, I_SKN) + l * 128;
    for (int r = gw; r < MREAL + NMETA; r += NGW) {
        bf16* pr = P + (size_t)r * NNG;
        const v4u w0 = *(const GAS v4u*)(pr + C_CQ + 8 * lane), w1 = *(const GAS v4u*)(pr + C_CK + 8 * lane), w2 = *(const GAS v4u*)(pr + C_DQ + 8 * lane), w3 = *(const GAS v4u*)(pr + C_DK + 8 * (lane & 15));
        __builtin_amdgcn_sched_barrier(0);
        norm_cols_inplace<8>(pr + C_CQ + 8 * lane, w0, dqn, 0.125f, lane, true);
        norm_cols_inplace<8>(pr + C_CK + 8 * lane, w1, dkn, 1.0f, lane, true);
        norm_cols_inplace<16>(pr + C_DQ + 8 * lane, w2, sqn, 0.08838834764831845f, lane, true);
        norm_cols_inplace<16>(pr + C_DK + 8 * (lane & 15), w3, skn, 1.0f, lane & 15, lane < 16);
    }
}
__device__ __forceinline__ void phase_vt(Frame& F) {
    const int gw = F.bid * NWAVES + F.wave, NGW = F.G * NWAVES, lane = F.lane;
    const bf16* P = (const bf16*)(F.ws + WS_BIG); bf16* VtC = (bf16*)(F.ws + WS_VTC); bf16* VtD = (bf16*)(F.ws + WS_VTD);
    LAS bf16* T = (LAS bf16*)(F.lds + F.wave * 17408);
    constexpr int NPB = (LPAD + 63) / 64;
    for (int task = gw; task < NB * 5 * NPB; task += NGW) {
        const int pb = task % NPB, mat = (task / NPB) % 5, b = task / (NPB * 5), p0 = 64 * pb;
        const int col = mat < 4 ? C_CV + 128 * mat : C_DV;
#pragma unroll 4
        for (int i = 0; i < 16; ++i) { const int pl = 4 * i + (lane >> 4), p = p0 + pl;
            v4u w = *(const GAS v4u*)(P + (size_t)seqrow(b, p < LSEQ ? p : LSEQ - 1) * NNG + col + 8 * (lane & 15)); if (p >= LSEQ) w = (v4u){0u, 0u, 0u, 0u};
            *(LAS v4u*)(T + pl * 136 + 8 * (lane & 15)) = w; }
        LDS_WAIT(); asm volatile("" ::: "memory");
        bf16* dst = mat < 4 ? VtC + (size_t)(b * 4 + mat) * 128 * LPAD : VtD + (size_t)b * 128 * LPAD;
#pragma unroll 4
        for (int it = 0; it < 16; ++it) { const int e = 8 * it + (lane >> 3), c = lane & 7; unsigned short x[8];
#pragma unroll
            for (int k = 0; k < 8; ++k) x[k] = T[(8 * c + k) * 136 + e];
            v4u w; w.x = x[0] | ((unsigned)x[1] << 16); w.y = x[2] | ((unsigned)x[3] << 16); w.z = x[4] | ((unsigned)x[5] << 16); w.w = x[6] | ((unsigned)x[7] << 16);
            if (p0 + 8 * c < LPAD) *(GAS v4u*)(dst + (size_t)e * LPAD + p0 + 8 * c) = w; }
        LDS_WAIT(); asm volatile("" ::: "memory");
    }
}

#define NEG_INF (-__builtin_inff())
constexpr int NQT = (LSEQ + 31) / 32;
constexpr int NQB = (NQT + 7) / 8;
__device__ __forceinline__ bf16x8 ld_frag16(const bf16* p) { return *(const GAS bf16x8*)p; }
__device__ __forceinline__ bf16x8 mk_frag(v2u lo, v2u hi) { v4u w; w.x = lo.x; w.y = lo.y; w.z = hi.x; w.w = hi.y; return __builtin_bit_cast(bf16x8, w); }
__device__ __forceinline__ unsigned cvtpk(float lo, float hi) { return pg8::cvt_pk_bf16(lo, hi); }
__device__ __forceinline__ void build_bias_table(Frame& F, LAS float* bt, int col0) {
    const float* rb = FIN(F, I_RELB);
    for (int i = F.tid; i < 4 * 128; i += 512) { const int hd = i >> 7, n = i & 127; bt[i] = rb[rel_bucket(n) * 8 + col0 + hd]; }
}
__device__ __forceinline__ bool softmax_step(f32x16& S, float& m, float& lsum, float& alpha) {
    float tm = S[0];
#pragma unroll
    for (int r = 1; r < 16; ++r) tm = fmaxf(tm, S[r]);
    tm = fmaxf(tm, __shfl_xor(tm, 32));
    const bool raise = __any(tm > m + 8.0f);
    alpha = 1.0f;
    if (raise) { const float mn = fmaxf(m, tm); alpha = (mn == NEG_INF) ? 1.0f : __expf(m - mn); m = mn; lsum *= alpha; }
    const float mref = (m == NEG_INF) ? 0.f : m;
    float rs = 0.f;
#pragma unroll
    for (int r = 0; r < 16; ++r) { S[r] = __expf(S[r] - mref); rs += S[r]; }
    rs += __shfl_xor(rs, 32);
    lsum += rs;
    return raise;
}
template <bool DSA>
__device__ __forceinline__ void attn_wg_task(Frame& F, int l, int b, int h, int J, const LAS float* bt, float lam, float post) {
    constexpr int KD = DSA ? 128 : 64, KP = KD + 8, VP = 36, NKS = KD / 16;
    constexpr int KBUF = 32 * KP, VBUF = 128 * VP;
    const int lane = F.lane, ql = lane & 31, hh = lane >> 5, wave = F.wave, tid = F.tid;
    LAS bf16* Kl = (LAS bf16*)F.lds; LAS bf16* Vl = Kl + 2 * KBUF;
    const bf16* P = (const bf16*)(F.ws + WS_BIG);
    const bf16* Vt = DSA ? (const bf16*)(F.ws + WS_VTD) + (size_t)b * 128 * LPAD : (const bf16*)(F.ws + WS_VTC) + (size_t)(b * 4 + h) * 128 * LPAD;
    const int j = 8 * J + wave; const bool wvalid = 32 * j < LSEQ;
    const int ktmax = (8 * J + 7 < NQT - 1) ? 8 * J + 7 : NQT - 1;
    const int pq = 32 * j + ql, pqc = pq < LSEQ ? pq : LSEQ - 1;
    const bf16* qrow = P + (size_t)seqrow(b, pqc) * NNG + (DSA ? C_DQ : C_CQ) + h * 128 + 8 * hh;
    const unsigned* mrow = (const unsigned*)(F.ws + WS_MASK) + ((size_t)b * LPAD + pqc) * MASKW;
    const float b31 = bt[h * 128 + 127];
    const int kr = tid / (KD / 8), kc = tid % (KD / 8); const bool kload = tid < 32 * (KD / 8);
    const int vr = tid >> 2, vc = tid & 3;
    f32x16 R[4];
#pragma unroll
    for (int c = 0; c < (DSA ? 1 : 2); ++c) {
        const int kcol = DSA ? C_DK : C_CK + h * 128 + c * 64;
        bf16x8 qf[NKS];
#pragma unroll
        for (int ks = 0; ks < NKS; ++ks) qf[ks] = ld_frag16(qrow + (DSA ? 0 : c * 64) + 16 * ks);
        float m = NEG_INF, lsum = 0.f; f32x16 O[4];
#pragma unroll
        for (int eb = 0; eb < 4; ++eb)
#pragma unroll
            for (int r = 0; r < 16; ++r) O[eb][r] = 0.f;
        v4u rk0 = (v4u){0u, 0u, 0u, 0u}, rv0 = rk0, rk1 = rk0, rv1 = rk0;
#define ATT_ISSUE(kt_, RK, RV) do { int pk_ = 32 * (kt_) + kr; pk_ = pk_ < LSEQ ? pk_ : LSEQ - 1; \
            if (kload) RK = *(const GAS v4u*)(P + (size_t)seqrow(b, pk_) * NNG + kcol + 8 * kc); \
            RV = *(const GAS v4u*)(Vt + (size_t)vr * LPAD + 32 * (kt_) + 8 * vc); } while (0)
#define ATT_COMMIT(buf_, RK, RV) do { if (kload) *(LAS v4u*)(Kl + (buf_) * KBUF + kr * KP + 8 * kc) = RK; \
            LAS v2u* vd_ = (LAS v2u*)(Vl + (buf_) * VBUF + vr * VP + 8 * vc); vd_[0] = (v2u){RV.x, RV.y}; vd_[1] = (v2u){RV.z, RV.w}; } while (0)
        unsigned mwc = 0xffffffffu, mwn = 0xffffffffu; if (DSA) mwc = mrow[0];
        auto compute = [&](int kt, int buf) {
            if (DSA) mwn = mrow[kt + 1 <= ktmax ? kt + 1 : ktmax];
            if (wvalid && kt <= j) {
                const LAS bf16* Kt = Kl + buf * KBUF + ql * KP + 8 * hh; const LAS bf16* Vb = Vl + buf * VBUF + ql * VP + 4 * hh;
                f32x16 S;
#pragma unroll
                for (int r = 0; r < 16; ++r) S[r] = 0.f;
#pragma unroll
                for (int ks = 0; ks < NKS; ++ks) S = __builtin_amdgcn_mfma_f32_32x32x16_bf16(*(const LAS bf16x8*)(Kt + 16 * ks), qf[ks], S, 0, 0, 0);
                const unsigned mw = mwc >> (4 * hh);
                if (kt + 4 >= j) {
#pragma unroll
                    for (int r = 0; r < 16; ++r) { const int ko = (r & 3) + 8 * (r >> 2), n = pq - (32 * kt + 4 * hh + ko); const bool sel = ((mw >> ko) & 1u) && n >= 0;
                        S[r] = sel ? S[r] + bt[h * 128 + (n < 127 ? n : 127)] : NEG_INF; }
                } else {
#pragma unroll
                    for (int r = 0; r < 16; ++r) { const int ko = (r & 3) + 8 * (r >> 2); S[r] = (!DSA || ((mw >> ko) & 1u)) ? S[r] + b31 : NEG_INF; }
                }
                float alpha;
                if (softmax_step(S, m, lsum, alpha)) {
#pragma unroll
                    for (int eb = 0; eb < 4; ++eb)
#pragma unroll
                        for (int r = 0; r < 16; ++r) O[eb][r] *= alpha;
                }
                bf16x8 pf[2];
#pragma unroll
                for (int s = 0; s < 2; ++s) { v4u w; w.x = cvtpk(S[8 * s + 0], S[8 * s + 1]); w.y = cvtpk(S[8 * s + 2], S[8 * s + 3]); w.z = cvtpk(S[8 * s + 4], S[8 * s + 5]); w.w = cvtpk(S[8 * s + 6], S[8 * s + 7]); pf[s] = __builtin_bit_cast(bf16x8, w); }
#pragma unroll
                for (int eb = 0; eb < 4; ++eb)
#pragma unroll
                    for (int s = 0; s < 2; ++s) { const LAS bf16* vp = Vb + eb * 32 * VP + 16 * s;
                        O[eb] = __builtin_amdgcn_mfma_f32_32x32x16_bf16(mk_frag(*(const LAS v2u*)vp, *(const LAS v2u*)(vp + 8)), pf[s], O[eb], 0, 0, 0); }
            }
            if (DSA) mwc = mwn; };
        __syncthreads();
        ATT_ISSUE(0, rk0, rv0); ATT_COMMIT(0, rk0, rv0);
        if (ktmax >= 1) ATT_ISSUE(1, rk1, rv1);
        for (int kt = 0; kt <= ktmax; kt += 2) {
            LDS_WAIT(); __syncthreads();
            if (kt + 2 <= ktmax) ATT_ISSUE(kt + 2, rk0, rv0);
            compute(kt, 0);
            if (kt + 1 <= ktmax) ATT_COMMIT(1, rk1, rv1);
            if (kt + 1 > ktmax) break;
            LDS_WAIT(); __syncthreads();
            if (kt + 3 <= ktmax) ATT_ISSUE(kt + 3, rk1, rv1);
            compute(kt + 1, 1);
            if (kt + 2 <= ktmax) ATT_COMMIT(0, rk0, rv0);
        }
#undef ATT_ISSUE
#undef ATT_COMMIT
        const float il = 1.0f / lsum;
        if (DSA) {
#pragma unroll
            for (int eb = 0; eb < 4; ++eb)
#pragma unroll
                for (int r = 0; r < 16; ++r) R[eb][r] = O[eb][r] * il;
        } else if (c == 0) {
            LAS unsigned* rp = (LAS unsigned*)(F.lds + 28672) + wave * 2048 + lane;
#pragma unroll
            for (int eb = 0; eb < 4; ++eb)
#pragma unroll
                for (int r = 0; r < 16; r += 2) rp[(eb * 8 + (r >> 1)) * 64] = pk2(O[eb][r] * il, O[eb][r + 1] * il);
        } else {
            const LAS unsigned* rp = (const LAS unsigned*)(F.lds + 28672) + wave * 2048 + lane;
#pragma unroll
            for (int eb = 0; eb < 4; ++eb)
#pragma unroll
                for (int r = 0; r < 16; r += 2) { const unsigned w = rp[(eb * 8 + (r >> 1)) * 64]; R[eb][r] = bflo(w) - lam * (O[eb][r] * il); R[eb][r + 1] = bfhi(w) - lam * (O[eb][r + 1] * il); }
        }
    }
    float inv = 1.0f;
    if (!DSA) { float ss = 0.f;
#pragma unroll
        for (int eb = 0; eb < 4; ++eb)
#pragma unroll
            for (int r = 0; r < 16; ++r) ss += R[eb][r] * R[eb][r];
        ss += __shfl_xor(ss, 32); inv = post / sqrtf(ss * (1.f / 128.f) + EPS); }
    const float* sub = FIN(F, I_DSUB) + l * 128;
    if (wvalid && pq < LSEQ && (pq >= NMETA || b == 0)) {
        bf16* orow = (bf16*)(F.ws + WS_BR) + (size_t)(DSA ? 3 : 2) * MPAD * 512 + (size_t)seqrow(b, pq) * 512 + h * 128;
#pragma unroll
        for (int eb = 0; eb < 4; ++eb)
#pragma unroll
            for (int g = 0; g < 4; ++g) { const int e0 = 32 * eb + 8 * g + 4 * hh; f32x4 sv = (f32x4){1.f, 1.f, 1.f, 1.f}; if (!DSA) sv = *(const GAS f32x4*)(sub + e0);
                v2u w; w.x = pk2(R[eb][4 * g] * inv * sv.x, R[eb][4 * g + 1] * inv * sv.y); w.y = pk2(R[eb][4 * g + 2] * inv * sv.z, R[eb][4 * g + 3] * inv * sv.w);
                *(GAS v2u*)(orow + e0) = w; }
    }
}
__device__ __forceinline__ unsigned f32_key(float f) { const unsigned u = __float_as_uint(f); return u ^ ((u >> 31) ? 0xffffffffu : 0x80000000u); }
__device__ __forceinline__ void dsa_index_task(Frame& F, int b, int j, float* slab) {
    const int lane = F.lane, ql = lane & 31, hh = lane >> 5, wave = F.wave;
    const bf16* P = (const bf16*)(F.ws + WS_BIG);
    LAS unsigned char* qi = F.lds;
    for (int i = F.tid; i < 32 * 128; i += 512) { const int q = i >> 7, ch = i & 127; int pq = 32 * j + q; pq = pq < LSEQ ? pq : LSEQ - 1;
        *(LAS v4u*)(qi + q * 2064 + 16 * ch) = *(const GAS v4u*)(P + (size_t)seqrow(b, pq) * NNG + C_DQI + 8 * ch); }
    LAS float* wl = (LAS float*)(qi + 32 * 2064);
    if (F.tid < 32 * 16) { const int q = F.tid >> 4, hd = F.tid & 15; int pq = 32 * j + q; pq = pq < LSEQ ? pq : LSEQ - 1;
        wl[F.tid] = bf2f(P[(size_t)seqrow(b, pq) * NNG + C_DW + hd]) * 0.03125f; }
    LDS_WAIT(); __syncthreads();
#ifndef PROBE_SUB
#define PROBE_SUB 0
#endif
    for (int rpa = 0; rpa < ((PROBE_SUB & 8) ? 2 : 1); ++rpa)
    for (int kt = wave; kt <= j; kt += NWAVES) {
        const int pk = 32 * kt + ql, pkc = pk < LSEQ ? pk : LSEQ - 1;
        const bf16* krow = P + (size_t)seqrow(b, pkc) * NNG + C_DKI + 8 * hh;
        bf16x8 kf[4];
#pragma unroll
        for (int ks = 0; ks < 4; ++ks) kf[ks] = ld_frag16(krow + 16 * ks);
        f32x16 idx;
#pragma unroll
        for (int r = 0; r < 16; ++r) idx[r] = 0.f;
#pragma unroll 1
        for (int hd = 0; hd < 16; hd += 2) { f32x16 S0, S1; const float wh0 = wl[ql * 16 + hd], wh1 = wl[ql * 16 + hd + 1];
#pragma unroll
            for (int r = 0; r < 16; ++r) { S0[r] = 0.f; S1[r] = 0.f; }
#pragma unroll
            for (int ks = 0; ks < 4; ++ks) { S0 = __builtin_amdgcn_mfma_f32_32x32x16_bf16(kf[ks], *(const LAS bf16x8*)(qi + ql * 2064 + hd * 128 + 32 * ks + 16 * hh), S0, 0, 0, 0);
                S1 = __builtin_amdgcn_mfma_f32_32x32x16_bf16(kf[ks], *(const LAS bf16x8*)(qi + ql * 2064 + (hd + 1) * 128 + 32 * ks + 16 * hh), S1, 0, 0, 0); }
#pragma unroll
            for (int r = 0; r < 16; ++r) idx[r] += wh0 * fmaxf(S0[r], 0.f) + wh1 * fmaxf(S1[r], 0.f); }
        float* srow = slab + (size_t)ql * LPAD + 32 * kt + 4 * hh;
#pragma unroll
        for (int g = 0; g < 4; ++g) *(GAS f32x4*)(srow + 8 * g) = (f32x4){idx[4 * g], idx[4 * g + 1], idx[4 * g + 2], idx[4 * g + 3]};
    }
    VM_WAIT(); __syncthreads();
    for (int rpb = 0; rpb < ((PROBE_SUB & 16) ? 2 : 1); ++rpb)
    for (int qq = wave; qq < 32; qq += NWAVES) {
        const int p = 32 * j + qq; if (p >= LSEQ) break;
        const float* row = slab + (size_t)qq * LPAD;
        unsigned u[65];
        { const GAS unsigned* rp = (const GAS unsigned*)row + lane;
#pragma unroll
          for (int i = 0; i < 65; ++i) u[i] = rp[64 * i];
          __builtin_amdgcn_sched_barrier(0);
#pragma unroll
          for (int i = 0; i < 65; ++i) { const unsigned k = f32_key(__uint_as_float(u[i])) >> 1; u[i] = (64 * i + lane <= p) ? k : 0u; } }
        auto wsum = [&](unsigned c) { unsigned s = 0;
#pragma unroll
            for (int k = 0; k < 7; ++k) s += (unsigned)__builtin_popcountll(__ballot((c >> k) & 1u)) << k;
            return s; };
        unsigned T = 1u;
        if (p + 1 > 256) { T = 0u;
            for (int bit = 30; bit >= 15; --bit) { const unsigned cm1 = (T | (1u << bit)) - 1u; unsigned c = 0;
#pragma unroll
                for (int i = 0; i < 65; ++i) c += (cm1 - u[i]) >> 31;
                if (wsum(c) >= 256u) T |= 1u << bit; }
            const unsigned tm1 = T - 1u, hm1 = T + 0x7fffu; unsigned ca = 0, cb = 0;
#pragma unroll
            for (int i = 0; i < 65; ++i) { ca += (hm1 - u[i]) >> 31; cb += ((tm1 - u[i]) ^ (hm1 - u[i])) >> 31; }
            const unsigned above = wsum(ca), inb = wsum(cb), need = 256u - above;
            if (inb <= 64u) {
                LAS unsigned* band = (LAS unsigned*)(F.lds + 68096) + wave * 64;
                unsigned off = 0;
#pragma unroll
                for (int k = 0; k < 7; ++k) { const unsigned long long bal = __ballot((cb >> k) & 1u); off += __builtin_amdgcn_mbcnt_hi((unsigned)(bal >> 32), __builtin_amdgcn_mbcnt_lo((unsigned)bal, 0u)) << k; }
#pragma unroll
                for (int i = 0; i < 65; ++i) { if (u[i] >= T && u[i] <= hm1) { band[off] = u[i]; ++off; } }
                LDS_WAIT();
                const unsigned mine = lane < (int)inb ? band[lane] : 0u; unsigned ge = 0, gt = 0;
                for (unsigned k = 0; k < inb; ++k) { const unsigned v = band[k]; ge += (mine - 1u - v) >> 31; gt += (mine - v) >> 31; }
                const unsigned long long okb = __ballot(lane < (int)inb && ge >= need && gt < need);
                T = __builtin_amdgcn_readlane(mine, (int)__builtin_ctzll(okb | (1ull << 63)));
                LDS_WAIT();
            } else {
                for (int bit = 14; bit >= 0; --bit) { const unsigned cm1 = (T | (1u << bit)) - 1u; unsigned c = 0;
#pragma unroll
                    for (int i = 0; i < 65; ++i) c += (cm1 - u[i]) >> 31;
                    if (wsum(c) >= 256u) T |= 1u << bit; } } }
        unsigned long long* mrow = (unsigned long long*)((unsigned*)(F.ws + WS_MASK) + ((size_t)b * LPAD + p) * MASKW);
        unsigned wlo = 0u, whi = 0u;
#pragma unroll
        for (int i = 0; i < 64; ++i) { const unsigned long long bal = __ballot(u[i] >= T); if (lane == i) { wlo = (unsigned)bal; whi = (unsigned)(bal >> 32); } }
        const unsigned long long b64 = __ballot(u[64] >= T);
        mrow[lane] = ((unsigned long long)whi << 32) | wlo; if (lane == 0) mrow[64] = b64;
    }
    __syncthreads();
}
struct HgChunk { bf16* base; int pitch; int cq, ck, cv; bf16* A; float* dl; };
__device__ __forceinline__ HgChunk hg_chunk(Frame& F, int b, int h, int c) {
    HgChunk k;
    if (c == 0) { unsigned char* mp = F.ws + WS_HMETA + (size_t)h * HMETA_STRIDE; k.base = (bf16*)mp; k.pitch = 384; k.cq = 0; k.ck = 128; k.cv = 256; k.A = (bf16*)(mp + 64 * 384 * 2); k.dl = (float*)(mp + 64 * 384 * 2 + 64 * 64 * 2); }
    else { const size_t ci = (size_t)(b * 4 + h) * 64 + (c - 1); k.base = (bf16*)(F.ws + WS_BIG) + (size_t)(b * SEQ + 64 * (c - 1)) * NNG; k.pitch = NNG; k.cq = C_AQ + h * 128; k.ck = C_AF + h * 128; k.cv = C_AI + h * 128;
        k.A = (bf16*)(F.ws + WS_HA) + ci * 64 * 64; k.dl = (float*)(F.ws + WS_HDL) + ci * 128; }
    return k;
}
__device__ __forceinline__ void hgrn_prep_task(Frame& F, int l, int b, int h, int c) {
    const int d = F.tid & 127, tq = F.tid >> 7, lane = F.lane, wave = F.wave;
    const bf16* P = (const bf16*)(F.ws + WS_BIG);
    LAS bf16* Qt = (LAS bf16*)F.lds; LAS bf16* Kt = Qt + 64 * 136; LAS float* part = (LAS float*)(F.lds + 2 * 64 * 136 * 2);
    const HgChunk ch = hg_chunk(F, b, h, c);
    float lb = 0.f; if (l == 1) { const float a = FIN(F, I_LB)[h * 128 + d], cc = FIN(F, I_LB)[512 + h * 128 + d]; lb = 1.0f / (1.0f + __expf(a - cc)); }
    const bool meta = (c == 0);
    unsigned short zr[16], qr[16], vr[16];
    { const int r0 = meta ? MREAL : b * SEQ + 64 * (c - 1);
#pragma unroll
      for (int i = 0; i < 16; ++i) { int t = 16 * tq + i; if (meta) t = t < NMETA ? t : NMETA - 1; const bf16* pr = P + (size_t)(r0 + t) * NNG + h * 128 + d; zr[i] = pr[C_AF]; qr[i] = pr[C_AQ]; vr[i] = pr[C_AI]; }
      __builtin_amdgcn_sched_barrier(0); }
    float lfv[16];
    float run = 0.f;
#pragma unroll
    for (int i = 0; i < 16; ++i) { const bool valid = !meta || (16 * tq + i < NMETA); const float z = bf2f(zr[i]); const float sg = 1.0f / (1.0f + __expf(-z));
        lfv[i] = valid ? __logf(lb + (1.0f - lb) * sg) : 0.f; run += lfv[i]; }
    part[tq * 128 + d] = run;
    LDS_WAIT(); __syncthreads();
    const float p0 = part[d], p1 = part[128 + d], p2 = part[256 + d], p3 = part[384 + d];
    const float off = (tq > 0 ? p0 : 0.f) + (tq > 1 ? p1 : 0.f) + (tq > 2 ? p2 : 0.f), bmid = p0 + p1, blast = (p0 + p1) + (p2 + p3);
    unsigned kb[8], vb[8]; unsigned short qb[16];
    float bt = off;
#pragma unroll
    for (int i = 0; i < 16; i += 2) { float kbar[2], vv[2];
#pragma unroll
        for (int u = 0; u < 2; ++u) { const int t = 16 * tq + i + u; const bool valid = !meta || (t < NMETA);
            const float lf = lfv[i + u]; const float q = bf2f(qr[i + u]);
            const float kk = valid ? 1.0f - __expf(lf) : 0.f, qq = valid ? q / (1.0f + __expf(-q)) : 0.f; vv[u] = valid ? bf2f(vr[i + u]) : 0.f;
            bt += lf;
            kbar[u] = kk * __expf(blast - bt); qb[i + u] = (unsigned short)f2bf_s(qq * __expf(bt));
            const float qt = qq * __expf(fminf(bt - bmid, 80.f)), kt = kk * __expf(fminf(bmid - bt, 80.f));
            Qt[t * 136 + d] = (bf16)f2bf_s(qt); Kt[t * 136 + d] = (bf16)f2bf_s(kt); }
        kb[i >> 1] = pk2(kbar[0], kbar[1]); vb[i >> 1] = pk2(vv[0], vv[1]); }
    asm volatile("s_waitcnt vmcnt(0)" ::: "memory"); __syncthreads();
#pragma unroll
    for (int i = 0; i < 16; ++i) ch.base[(size_t)(16 * tq + i) * ch.pitch + ch.cq + d] = qb[i];
    { bf16* kd = ch.base + (size_t)(d >> 1) * ch.pitch + ch.ck + (d & 1) * 64 + 16 * tq; bf16* vd = ch.base + (size_t)(d >> 1) * ch.pitch + ch.cv + (d & 1) * 64 + 16 * tq;
      *(GAS v4u*)kd = (v4u){kb[0], kb[1], kb[2], kb[3]}; *(GAS v4u*)(kd + 8) = (v4u){kb[4], kb[5], kb[6], kb[7]};
      *(GAS v4u*)vd = (v4u){vb[0], vb[1], vb[2], vb[3]}; *(GAS v4u*)(vd + 8) = (v4u){vb[4], vb[5], vb[6], vb[7]}; }
    if (tq == 0) ch.dl[d] = __expf(blast);
    LDS_WAIT(); __syncthreads();
    { const int mt = wave >> 1, fr = lane & 15, g = lane >> 4;
#pragma unroll
      for (int u = 0; u < 2; ++u) { const int nt = 2 * (wave & 1) + u; f32x4 acc = (f32x4){0.f, 0.f, 0.f, 0.f};
        if (nt <= mt) {
#pragma unroll
            for (int ks = 0; ks < 4; ++ks) acc = __builtin_amdgcn_mfma_f32_16x16x32_bf16(*(const LAS bf16x8*)(Qt + (16 * mt + fr) * 136 + 32 * ks + 8 * g), *(const LAS bf16x8*)(Kt + (16 * nt + fr) * 136 + 32 * ks + 8 * g), acc, 0, 0, 0);
        }
#pragma unroll
        for (int r = 0; r < 4; ++r) { const int t = 16 * mt + 4 * g + r, s = 16 * nt + fr; ch.A[t * 64 + s] = (bf16)f2bf_s(s <= t ? acc[r] : 0.f); } } }
    __syncthreads();
}
__device__ __forceinline__ void hgrn_scan_unit(Frame& F, int l, int b, int h) {
    const int lane = F.lane, wave = F.wave, fr = lane & 15, g = lane >> 4, tid = F.tid;
    constexpr int QP = 136, AP = 72, KP = 72, GP = 136;
    constexpr int BUF = (64 * QP + 64 * AP + 128 * KP + 64 * GP) * 2 + 512;
    LAS float* red = (LAS float*)(F.lds + 2 * BUF);
    const int dv = 16 * wave + fr;
    const float gn = FIN(F, I_GN)[l * 512 + h * 128 + dv];
    const bf16* Pg = (const bf16*)(F.ws + WS_BIG) + C_AG + h * 128;
    f32x4 S[8];
#pragma unroll
    for (int mt = 0; mt < 8; ++mt) S[mt] = (f32x4){0.f, 0.f, 0.f, 0.f};
    v4u rq[2], ra, rk[2], rg[2], rd; bf16x8 bv0, bv1, bn0, bn1;
#define HG_ISSUE(c_, B0, B1) do { const HgChunk ch_ = hg_chunk(F, b, h, (c_)); const int nv_ = ((c_) == 0) ? NMETA : 64; \
        _Pragma("unroll") for (int i = 0; i < 2; ++i) { const int idx = tid + 512 * i, row = idx >> 4, c16 = idx & 15; \
            rq[i] = *(const GAS v4u*)(ch_.base + (size_t)row * ch_.pitch + ch_.cq + 8 * c16); rk[i] = *(const GAS v4u*)(ch_.base + (size_t)row * ch_.pitch + ch_.ck + 8 * c16); \
            rg[i] = (v4u){0u, 0u, 0u, 0u}; if (row < nv_) rg[i] = *(const GAS v4u*)(Pg + (size_t)(((c_) == 0) ? MREAL + row : b * SEQ + 64 * ((c_) - 1) + row) * NNG + 8 * c16); } \
        ra = *(const GAS v4u*)(ch_.A + 8 * tid); if (tid < 32) rd = *(const GAS v4u*)(ch_.dl + 4 * tid); \
        const bf16* vrow_ = ch_.base + (size_t)(dv >> 1) * ch_.pitch + ch_.cv + (dv & 1) * 64 + 8 * g; B0 = ld_frag16(vrow_); B1 = ld_frag16(vrow_ + 32); } while (0)
#define HG_COMMIT(buf_) do { LAS bf16* Q_ = (LAS bf16*)(F.lds + (buf_) * BUF); LAS bf16* A_ = Q_ + 64 * QP; LAS bf16* KT_ = A_ + 64 * AP; LAS bf16* G_ = KT_ + 128 * KP; \
        _Pragma("unroll") for (int i = 0; i < 2; ++i) { const int idx = tid + 512 * i, row = idx >> 4, c16 = idx & 15; *(LAS v4u*)(Q_ + row * QP + 8 * c16) = rq[i]; \
            *(LAS v4u*)(KT_ + (2 * row + (c16 >> 3)) * KP + 8 * (c16 & 7)) = rk[i]; *(LAS v4u*)(G_ + row * GP + 8 * c16) = rg[i]; } \
        *(LAS v4u*)(A_ + (tid >> 3) * AP + 8 * (tid & 7)) = ra; if (tid < 32) *(LAS v4u*)((LAS unsigned char*)(G_ + 64 * GP) + 16 * tid) = rd; } while (0)
    HG_ISSUE(0, bv0, bv1); HG_COMMIT(0);
    for (int c = 0; c <= 64; ++c) {
        const int buf = c & 1;
        LDS_WAIT(); __syncthreads();
        if (c < 64) HG_ISSUE(c + 1, bn0, bn1);
        LAS bf16* Q = (LAS bf16*)(F.lds + buf * BUF); LAS bf16* A = Q + 64 * QP; LAS bf16* KT = A + 64 * AP; LAS bf16* G = KT + 128 * KP; const LAS float* DL = (const LAS float*)(G + 64 * GP);
        f32x4 o[4];
#pragma unroll
        for (int mt = 0; mt < 4; ++mt) o[mt] = (f32x4){0.f, 0.f, 0.f, 0.f};
#pragma unroll
        for (int ks = 0; ks < 4; ++ks) { v4u w; w.x = cvtpk(S[2 * ks][0], S[2 * ks][1]); w.y = cvtpk(S[2 * ks][2], S[2 * ks][3]); w.z = cvtpk(S[2 * ks + 1][0], S[2 * ks + 1][1]); w.w = cvtpk(S[2 * ks + 1][2], S[2 * ks + 1][3]);
            const bf16x8 sb = __builtin_bit_cast(bf16x8, w);
#pragma unroll
            for (int mt = 0; mt < 4; ++mt) { const LAS bf16* qp = Q + (16 * mt + fr) * QP + 32 * ks + 4 * g;
                const bf16x8 af = mk_frag(*(const LAS v2u*)qp, *(const LAS v2u*)(qp + 16));
                o[mt] = __builtin_amdgcn_mfma_f32_16x16x32_bf16(af, sb, o[mt], 0, 0, 0); } }
#pragma unroll
        for (int mt = 0; mt < 4; ++mt) { o[mt] = __builtin_amdgcn_mfma_f32_16x16x32_bf16(*(const LAS bf16x8*)(A + (16 * mt + fr) * AP + 8 * g), bv0, o[mt], 0, 0, 0);
            o[mt] = __builtin_amdgcn_mfma_f32_16x16x32_bf16(*(const LAS bf16x8*)(A + (16 * mt + fr) * AP + 32 + 8 * g), bv1, o[mt], 0, 0, 0); }
#pragma unroll
        for (int mt = 0; mt < 8; ++mt) { const f32x4 dl = *(const LAS f32x4*)(DL + 16 * mt + 4 * g); S[mt] = S[mt] * dl;
            S[mt] = __builtin_amdgcn_mfma_f32_16x16x32_bf16(*(const LAS bf16x8*)(KT + (16 * mt + fr) * KP + 8 * g), bv0, S[mt], 0, 0, 0);
            S[mt] = __builtin_amdgcn_mfma_f32_16x16x32_bf16(*(const LAS bf16x8*)(KT + (16 * mt + fr) * KP + 32 + 8 * g), bv1, S[mt], 0, 0, 0); }
#pragma unroll
        for (int mt = 0; mt < 4; ++mt)
#pragma unroll
            for (int r = 0; r < 4; ++r) { float s2 = o[mt][r] * o[mt][r]; s2 += __shfl_xor(s2, 1); s2 += __shfl_xor(s2, 2); s2 += __shfl_xor(s2, 4); s2 += __shfl_xor(s2, 8);
                if (fr == 0) red[wave * 64 + 16 * mt + 4 * g + r] = s2; }
        LDS_WAIT(); __syncthreads();
        const int nvalid = (c == 0) ? NMETA : 64;
#pragma unroll
        for (int mt = 0; mt < 4; ++mt)
#pragma unroll
            for (int r = 0; r < 4; ++r) { const int t = 16 * mt + 4 * g + r; float tot = 0.f;
#pragma unroll
                for (int w = 0; w < 8; ++w) tot += red[w * 64 + t];
                if (t < nvalid && (c > 0 || b == 0)) { const int row = (c == 0) ? MREAL + t : b * SEQ + 64 * (c - 1) + t;
                    const float gr = bf2f(G[t * GP + dv]);
                    const float val = o[mt][r] * (1.0f / sqrtf(tot * (1.f / 128.f) + EPS)) * gn * (gr / (1.0f + __expf(-gr)));
                    ((bf16*)(F.ws + WS_BR))[(size_t)row * 512 + h * 128 + dv] = (bf16)f2bf_s(val); } }
        if (c < 64) { HG_COMMIT(buf ^ 1); bv0 = bn0; bv1 = bn1; }
    }
#undef HG_ISSUE
#undef HG_COMMIT
    __syncthreads();
}
__device__ __forceinline__ void conv_row(Frame& F, int l, int r) {
    const int lane = F.lane; const bf16* P = (const bf16*)(F.ws + WS_BIG);
    int r1, r2;
    if (r < MREAL) { const int b = r >> 12, t = r & 4095; r1 = seqrow(b, NMETA + t - 1); r2 = seqrow(b, NMETA + t - 2); }
    else { const int i = r - MREAL; r1 = i >= 1 ? r - 1 : -1; r2 = i >= 2 ? r - 2 : -1; }
    const float* cw = FIN(F, I_CONVW) + l * 3 * 512 + 8 * lane;
    const int r1c = r1 >= 0 ? r1 : r, r2c = r2 >= 0 ? r2 : r;
    const v4u wc0 = *(const GAS v4u*)(P + (size_t)r * NNG + C_BC + 8 * lane), wu0 = *(const GAS v4u*)(P + (size_t)r * NNG + C_BU + 8 * lane), wb = *(const GAS v4u*)(P + (size_t)r * NNG + C_BB + 8 * lane);
    const v4u wc1 = *(const GAS v4u*)(P + (size_t)r1c * NNG + C_BC + 8 * lane), wu1 = *(const GAS v4u*)(P + (size_t)r1c * NNG + C_BU + 8 * lane);
    const v4u wc2 = *(const GAS v4u*)(P + (size_t)r2c * NNG + C_BC + 8 * lane), wu2 = *(const GAS v4u*)(P + (size_t)r2c * NNG + C_BU + 8 * lane);
    __builtin_amdgcn_sched_barrier(0);
    float c0[8], u0[8], bb[8], y[8]; unpack8(wc0, c0); unpack8(wu0, u0); unpack8(wb, bb);
#pragma unroll
    for (int i = 0; i < 8; ++i) y[i] = cw[i] * (c0[i] * u0[i]);
    const float m1 = r1 >= 0 ? 1.f : 0.f, m2 = r2 >= 0 ? 1.f : 0.f;
    unpack8(wc1, c0); unpack8(wu1, u0);
#pragma unroll
    for (int i = 0; i < 8; ++i) y[i] += m1 * cw[512 + i] * (c0[i] * u0[i]);
    unpack8(wc2, c0); unpack8(wu2, u0);
#pragma unroll
    for (int i = 0; i < 8; ++i) y[i] += m2 * cw[1024 + i] * (c0[i] * u0[i]);
#pragma unroll
    for (int i = 0; i < 8; ++i) y[i] *= bb[i];
    *(GAS v4u*)((bf16*)(F.ws + WS_BR) + (size_t)MPAD * 512 + (size_t)r * 512 + 8 * lane) = pack8(y);
}
__device__ __forceinline__ void phase_hgrn_prep(Frame& F, int l) {
    for (int t = F.bid; t < NB * 4 * 64 + 4; t += F.G) { if (t < 4) hgrn_prep_task(F, l, 0, t, 0); else { const int u = t - 4; hgrn_prep_task(F, l, u >> 8, (u >> 6) & 3, 1 + (u & 63)); } }
}
constexpr int CW_TMO = 0, CW_BAR = 4096, CW_Q = 16384;
__device__ __forceinline__ int queue_pop(Frame& F, int qi) {
    int t = 0; if (F.lane == 0) t = (int)__hip_atomic_fetch_add((unsigned*)(F.ctl + CW_Q + 64 * qi), 1u, RLX_AGENT);
    return __builtin_amdgcn_readfirstlane(t);
}
__device__ __forceinline__ int queue_pop_wg(Frame& F, int qi) {
    LAS int* slot = (LAS int*)(F.lds + 139264);
    __syncthreads();
    if (F.tid == 0) *slot = (int)__hip_atomic_fetch_add((unsigned*)(F.ctl + CW_Q + 64 * qi), 1u, RLX_AGENT);
    LDS_WAIT(); __syncthreads();
    return __builtin_amdgcn_readfirstlane(*slot);
}
__device__ __forceinline__ void phase_mix1(Frame& F, int l, int qidx) {
    LAS float* bt = (LAS float*)(F.lds + 135168);
    build_bias_table(F, bt, 0);
    __syncthreads();
    if (F.bid < NIDX_WG) {
        float* slab = (float*)(F.ws + WS_SCR) + (size_t)F.bid * 32 * LPAD;
        for (int rp = 0; rp < ((PROBE_SUB & 1) ? 2 : 1); ++rp)
        for (int t = F.bid; t < NB * NQT; t += NIDX_WG) { const int j = NQT - 1 - t / NB, b = t % NB; dsa_index_task(F, b, j, slab); }
    } else if (F.bid < NIDX_WG + NHG_WG) {
        const int u = F.bid - NIDX_WG;
        for (int rp = 0; rp < ((PROBE_SUB & 2) ? 2 : 1); ++rp) hgrn_scan_unit(F, l, u >> 2, u & 3);
    } else {
        const int u0 = F.bid - NIDX_WG - NHG_WG, nw = F.G - NIDX_WG - NHG_WG;
        const int cw = u0 * NWAVES + F.wave, ncw = nw * NWAVES; for (int r = cw; r < MREAL + NMETA; r += ncw) conv_row(F, l, r);
    }
    float lam, post;
    { const float* lp = FIN(F, I_DLAM) + l * 256; const float s1 = wave_sum(lp[F.lane] * lp[64 + F.lane]), s2 = wave_sum(lp[128 + F.lane] * lp[192 + F.lane]);
      const float li = 0.8f - 0.6f * __expf(-0.3f * (float)l); lam = __expf(s1) - __expf(s2) + li; post = 1.0f - li; }
    for (int rp = 0; rp < ((PROBE_SUB & 4) ? 2 : 1); ++rp)
    for (;;) { const int t = queue_pop_wg(F, qidx + 8 * rp); if (t >= NB * 4 * NQB) break;
        const int J = NQB - 1 - t / 32, bh = t % 32; attn_wg_task<false>(F, l, bh >> 2, bh & 3, J, bt, lam, post); }
}
__device__ __forceinline__ void phase_mix2(Frame& F, int l, int qidx) {
    LAS float* bt = (LAS float*)(F.lds + 135168);
    build_bias_table(F, bt, 4);
    __syncthreads();
    const int gw = F.bid * NWAVES + F.wave, NGW = F.G * NWAVES;
    for (;;) { const int t = queue_pop_wg(F, qidx); if (t >= NB * 4 * NQB) break;
        const int J = NQB - 1 - t / 32, bh = t % 32; attn_wg_task<true>(F, l, bh >> 2, bh & 3, J, bt, 0.f, 1.f); }
}

#ifdef DBG_SEL
#ifndef DBG_Q
#define DBG_Q 1.0f
#endif
#ifndef DBG_QO
#define DBG_QO 0.0f
#endif
#ifndef DBG_T0
#define DBG_T0 0
#define DBG_T1 36
#endif
#ifndef DBG_NC
#define DBG_NC DM
#endif
__global__ void __launch_bounds__(256) k_dbg_argmax(const float* __restrict__ out, const float* __restrict__ x, unsigned long long* best) {
    unsigned long long loc = 0ull;
    for (size_t i = (size_t)blockIdx.x * blockDim.x + threadIdx.x; i < (size_t)MREAL * DM; i += (size_t)gridDim.x * blockDim.x) {
        const float d = fabsf(out[i] - x[i]); const unsigned long long k = ((unsigned long long)__float_as_uint(d) << 32) | (unsigned)i; loc = k > loc ? k : loc; }
    for (int o = 32; o >= 1; o >>= 1) { const unsigned long long t = __shfl_xor(loc, o); loc = t > loc ? t : loc; }
    if ((threadIdx.x & 63) == 0) atomicMax(best, loc);
}
__global__ void __launch_bounds__(256) k_dbg_count(const float* __restrict__ out, const float* __restrict__ x, unsigned* cnt  ) {
    const int gw = (blockIdx.x * blockDim.x + threadIdx.x) >> 6, lane = threadIdx.x & 63, ngw = (gridDim.x * blockDim.x) >> 6;
    for (int r = gw; r < MREAL; r += ngw) { float m = 0.f;
        for (int c = lane; c < DM; c += 64) m = fmaxf(m, fabsf(out[(size_t)r * DM + c] - x[(size_t)r * DM + c]));
        for (int o = 32; o >= 1; o >>= 1) m = fmaxf(m, __shfl_xor(m, o));
        if (lane == 0 && m > DBG_THR) { const int t = r & 4095; atomicAdd(cnt + 0, 1u); if (t < 32) atomicAdd(cnt + 1, 1u); if (t >= 4064) atomicAdd(cnt + 2, 1u); if (t < 256) atomicAdd(cnt + 3, 1u); } }
}

__global__ void __launch_bounds__(256) k_dbg_chk_merge(const unsigned short* BRm, const unsigned short* Wt, const unsigned short* G, const unsigned short* MG, int m, unsigned* cnt) {
    const int c = blockIdx.x * 256 + threadIdx.x;
    for (int r = blockIdx.y; r < MREAL; r += gridDim.y) {
        float s = 0.f; const unsigned short* a = BRm + (size_t)r * 512; const unsigned short* w = Wt + (size_t)c * 512;
        for (int k = 0; k < 512; ++k) s += __uint_as_float((unsigned)a[k] << 16) * __uint_as_float((unsigned)w[k] << 16);
        const float g = __uint_as_float((unsigned)G[(size_t)r * NGATE + m * DM + c] << 16), ref = g * s, got = __uint_as_float((unsigned)MG[(size_t)r * DM + c] << 16);
        const float err = fabsf(got - ref), tol = 0.02f * fabsf(ref) + 0.02f;
        if (!(err <= tol)) { atomicAdd(cnt + 4, 1u); const int t = r & 4095; if ((c & 255) < 128) atomicAdd(cnt + 5, 1u); if ((r & 255) < 128) atomicAdd(cnt + 6, 1u); if (fabsf(got) > 2.f * fabsf(ref)) atomicAdd(cnt + 7, 1u); (void)t; }
    }
}

__global__ void __launch_bounds__(256) k_dbg_naive_wo(const float* out, const unsigned short* MG, const unsigned short* Wt, float* chk) {
    const int c = blockIdx.x * 256 + threadIdx.x;
    for (int r = blockIdx.y; r < MREAL; r += gridDim.y) {
        float s = 0.f; const uint4* a = (const uint4*)(MG + (size_t)r * DM); const uint4* w = (const uint4*)(Wt + (size_t)c * DM);
        for (int k = 0; k < DM / 8; ++k) { const uint4 av = a[k], wv = w[k]; const unsigned aw[4] = {av.x, av.y, av.z, av.w}, ww[4] = {wv.x, wv.y, wv.z, wv.w};
#pragma unroll
            for (int j = 0; j < 4; ++j) { s += __uint_as_float(aw[j] << 16) * __uint_as_float(ww[j] << 16); s += __uint_as_float(aw[j] & 0xffff0000u) * __uint_as_float(ww[j] & 0xffff0000u); } }
        chk[(size_t)r * DM + c] = out[(size_t)r * DM + c] + s; }
}
__global__ void __launch_bounds__(256) k_dbg_cmp(const float* out, const float* chk, unsigned* cnt) {
    for (size_t i = (size_t)blockIdx.x * blockDim.x + threadIdx.x; i < (size_t)MREAL * DM; i += (size_t)gridDim.x * blockDim.x) {
        const float err = fabsf(out[i] - chk[i]); if (!(err <= 0.02f)) { atomicAdd(cnt + 4, 1u); const int c = (int)(i % DM), r = (int)(i / DM); if ((c & 255) < 128) atomicAdd(cnt + 5, 1u); if ((r & 255) < 128) atomicAdd(cnt + 6, 1u); if (err > 1.0f) atomicAdd(cnt + 7, 1u); } }
}

__global__ void __launch_bounds__(256) k_dbg_stats(const unsigned short* A, int ld, int ncols, unsigned* st) {
    const int gw = (blockIdx.x * blockDim.x + threadIdx.x) >> 6, lane = threadIdx.x & 63, ngw = (gridDim.x * blockDim.x) >> 6;
    float mx = 0.f, me = 0.f;
    for (int r = gw; r < MREAL; r += ngw) { float s = 0.f;
        for (int c = lane; c < ncols; c += 64) { const float v = __uint_as_float((unsigned)A[(size_t)r * ld + c] << 16); mx = fmaxf(mx, fabsf(v)); s += v * v; }
        for (int o = 32; o >= 1; o >>= 1) s += __shfl_xor(s, o);
        me = fmaxf(me, s / (float)ncols); }
    for (int o = 32; o >= 1; o >>= 1) mx = fmaxf(mx, __shfl_xor(mx, o));
    if (lane == 0) { atomicMax(st + 8, __float_as_uint(mx)); atomicMax(st + 9, __float_as_uint(me)); }
}

__global__ void __launch_bounds__(256) k_dbg_argmax_bf16(const unsigned short* A, int ld, int ncols, unsigned long long* best) {
    unsigned long long loc = 0ull;
    for (size_t i = (size_t)blockIdx.x * blockDim.x + threadIdx.x; i < (size_t)MREAL * ncols; i += (size_t)gridDim.x * blockDim.x) { const size_t r = i / ncols, c = i % ncols;
        const float d = fabsf(__uint_as_float((unsigned)A[r * ld + c] << 16)); const unsigned long long k = ((unsigned long long)__float_as_uint(d) << 32) | (unsigned)i; loc = k > loc ? k : loc; }
    for (int o = 32; o >= 1; o >>= 1) { const unsigned long long t = __shfl_xor(loc, o); loc = t > loc ? t : loc; }
    if ((threadIdx.x & 63) == 0) atomicMax(best, loc);
}

__global__ void __launch_bounds__(256) k_dbg_gcount(const unsigned short* G, unsigned* cnt) {
    const int gw = (blockIdx.x * blockDim.x + threadIdx.x) >> 6, lane = threadIdx.x & 63, ngw = (gridDim.x * blockDim.x) >> 6;
    for (int r = gw; r < MREAL; r += ngw) { int n = 0;
        for (int c = lane; c < NGATE; c += 64) { const float v = __uint_as_float((unsigned)G[(size_t)r * NGATE + c] << 16); if (!(v >= 0.f && v <= 1.001f)) ++n; }
        for (int o = 32; o >= 1; o >>= 1) n += __shfl_xor(n, o);
        if (lane == 0 && n) { const int t = r & 4095; atomicAdd(cnt + 10, (unsigned)n); atomicAdd(cnt + 11, 1u); if (t >= 4080) atomicAdd(cnt + 12, 1u); else atomicAdd(cnt + 13, 1u); } }
}

__global__ void k_dbg_time(const unsigned long long* ts, unsigned* cnt) {
    if (threadIdx.x == 0) { const float ms = (float)(ts[DBG_T1] - ts[DBG_T0]) * 1e-5f; cnt[14] = __float_as_uint(floorf(ms * DBG_Q + DBG_QO)); }
}
__global__ void __launch_bounds__(256) k_dbg_emit(float* out, const float* __restrict__ x, const unsigned long long* best, const unsigned* cnt) {
    const unsigned long long b = *best; const unsigned idx = (unsigned)b; const float val = __uint_as_float((unsigned)(b >> 32));
    const int row = idx / DBG_NC, col = idx % DBG_NC, bb = row >> 12, t = row & 4095;
    float N = 0.f;
    switch (DBG_SEL) {
        case 0: N = val; break;
        case 1: N = 2.f + bb; break;
        case 2: N = 2.f + (t >> 9); break;
        case 3: N = 2.f + ((t >> 6) & 7); break;
        case 4: N = 2.f + ((t >> 3) & 7); break;
        case 5: N = 2.f + (t & 7); break;
        case 6: N = 2.f + (col >> 8); break;
        case 60: N = 2.f + (col >> 10); break;
        case 61: N = 2.f + ((col >> 7) & 7); break;
        case 62: N = 2.f + ((col >> 4) & 7); break;
        case 63: N = 2.f + ((col >> 1) & 7); break;
        case 64: N = 2.f + (col & 1); break;
        case 65: N = 2.f + bb; break;
        case 66: N = 2.f + (t >> 9); break;
        case 67: N = 2.f + ((t >> 6) & 7); break;
        case 68: N = 2.f + ((t >> 3) & 7); break;
        case 69: N = 2.f + (t & 7); break;
        case 7: N = 2.f + ((col >> 5) & 7); break;
        case 8: N = 2.f + ((col >> 2) & 7); break;
        case 40: case 42: case 44: case 46: N = __uint_as_float(cnt[8]); break;
        case 41: case 43: case 45: case 47: N = __uint_as_float(cnt[9]); break;
        case 70: N = 2.f + log2f(1.f + (float)cnt[10]); break;
        case 71: N = 2.f + log2f(1.f + (float)cnt[11]); break;
        case 72: N = 2.f + log2f(1.f + (float)cnt[12]); break;
        case 73: N = 2.f + log2f(1.f + (float)cnt[13]); break;
        case 100: N = 2.f + __uint_as_float(cnt[14]); break;
        case 30: N = 2.f + log2f(1.f + (float)cnt[4]); break;
        case 31: N = 2.f + log2f(1.f + (float)cnt[5]); break;
        case 32: N = 2.f + log2f(1.f + (float)cnt[6]); break;
        case 33: N = 2.f + log2f(1.f + (float)cnt[7]); break;
        case 20: N = 2.f + log2f(1.f + (float)cnt[4]); break;
        case 21: N = 2.f + log2f(1.f + (float)cnt[5]); break;
        case 22: N = 2.f + log2f(1.f + (float)cnt[6]); break;
        case 23: N = 2.f + log2f(1.f + (float)cnt[7]); break;
        case 10: N = 2.f + log2f(1.f + (float)cnt[0]); break;
        case 11: N = 2.f + log2f(1.f + (float)cnt[1]); break;
        case 12: N = 2.f + log2f(1.f + (float)cnt[2]); break;
        case 13: N = 2.f + log2f(1.f + (float)cnt[3]); break;
    }
    const float c = 1.f + N;
    for (size_t i = (size_t)blockIdx.x * blockDim.x + threadIdx.x; i < (size_t)MREAL * DM; i += (size_t)gridDim.x * blockDim.x) out[i] = c * x[i];
}
#endif

#ifndef MK_ONE
#define MK_ONE 0
#endif
#ifndef BR_MASK
#define BR_MASK 15
#endif
constexpr int NPH = 18;
template <class T> __device__ __forceinline__ T opaque(T v) { asm volatile("" : "+s"(v)); return v; }
struct Args { const float* in[22]; float* out; unsigned char* ws; int ph_lo, ph_hi; };
__global__ void __launch_bounds__(NWAVES * 64, 2) fwd(Args args) {
    extern __shared__ __attribute__((aligned(16))) unsigned char lds[];
    Frame F;
    F.lds = (LAS unsigned char*)lds; F.MISC = (volatile LAS unsigned*)(F.lds + MISC_OFF);
    F.tid = threadIdx.x; F.lane = F.tid & 63; F.wave = __builtin_amdgcn_readfirstlane(F.tid >> 6); F.G = gridDim.x; F.bid = blockIdx.x;
    F.ws = args.ws; F.out = args.out; F.ctl = (gu32*)(args.ws + WS_CTL);
    F.karg = (const unsigned char __attribute__((address_space(4)))*)__builtin_amdgcn_kernarg_segment_ptr();
    for (int u = F.tid; u < (LDS_BYTES - LDSCTL_OFF) / 4; u += NWAVES * 64) ((LAS unsigned*)(F.lds + LDSCTL_OFF))[u] = 0u;
    __syncthreads();
#if MK_ONE
    XcdBarrier bar = xcd_barrier_post((unsigned*)(F.ctl + CW_BAR), F.MISC + 8, __builtin_amdgcn_readfirstlane(threadIdx.x >> 6));
#define GRID_BAR() xcd_barrier(bar)
#else
#define GRID_BAR() do { } while (0)
#endif
    const int wave_s = __builtin_amdgcn_readfirstlane(threadIdx.x >> 6);
    const int lo = args.ph_lo, hi = args.ph_hi;
#define IN(k) (lo <= (k) && (k) < hi)
#define RETID() do { int w_ = wave_s; asm volatile("" : "+s"(w_)); unsigned mk_ = ~0u; asm volatile("" : "+s"(mk_)); int t_ = w_ * 64 + (int)__builtin_amdgcn_mbcnt_hi(mk_, __builtin_amdgcn_mbcnt_lo(mk_, 0u)); asm volatile("" : "+v"(t_)); F.tid = t_; F.lane = t_ & 63; F.wave = w_; } while (0)
#ifdef DBG_TS
#define STAMP(k) do { if (blockIdx.x == 0 && threadIdx.x == 0) ((unsigned long long*)(args.ws + 768 * 1024))[(k)] = __builtin_amdgcn_s_memrealtime(); } while (0)
#else
#define STAMP(k) do { } while (0)
#endif
#define SEAM(k) do { if (IN((k) + 1)) GRID_BAR(); STAMP((k) + 1); } while (0)
#ifdef PROBE_MASK
#define NREP(kk) opaque(((PROBE_MASK >> (kk)) & 1) ? 1 + PROBE_EXTRA : 1)
#define REP_BEGIN(kk) { const int nrep_ = NREP(kk); for (int rep = 0; rep < nrep_; ++rep) { if (rep) GRID_BAR();
#define REP_END } }
#else
#define REP_BEGIN(kk) { { const int rep = 0; (void)rep;
#define REP_END } }
#endif
    STAMP(0);
    unsigned char* wb = F.ws + WS_W;
    bf16* XN = (bf16*)(F.ws + WS_XN); bf16* BR = (bf16*)(F.ws + WS_BR); bf16* BIG = (bf16*)(F.ws + WS_BIG); float* HM = (float*)(F.ws + WS_HM);
    for (int l = 0; l < 2; ++l) {
        const int pb = l * NPH;
        const float* hsrc = (l == 0) ? FIN(F, I_X) : F.out;
        if (IN(pb + 0)) { REP_BEGIN(0) RETID(); phase_convert(F, l); REP_END SEAM(pb + 0); }
        if (IN(pb + 1)) { REP_BEGIN(1) RETID(); phase_norm(F, hsrc, FIN(F, I_F1N) + l * DM); REP_END SEAM(pb + 1); }
        if (IN(pb + 2)) { REP_BEGIN(2) RETID(); meta_gemm(F, 0, XN + (size_t)MREAL * DM, DM, (const bf16*)(wb + W_GU1), NGU, DM, BIG, DFF, 0.f); pg8::Gemm g{opaque((const bf16*)(XN)), opaque((const bf16*)(wb + W_GU1)), MREAL, NGU, DM}; pg8::StaticOrder S; S.init(MREAL, NGU, F.G, opaque(F.bid));
            pg8::EpiSwiGLU E{BIG, DFF}; pg8::gemm_phase<pg8::EpiSwiGLU, pg8::StaticOrder, true, true>(F.lds + RING_OFF, g, S, E, F.tid); REP_END SEAM(pb + 2); }
        if (IN(pb + 3)) { REP_BEGIN(3) RETID(); meta_gemm(F, 1, BIG + (size_t)MREAL * DFF, DFF, (const bf16*)(wb + W_D1), DM, DFF, nullptr, 0, rep ? 0.f : 0.5f); pg8::Gemm g{opaque((const bf16*)(BIG)), opaque((const bf16*)(wb + W_D1)), MREAL, DM, DFF}; pg8::StaticOrder S; S.init(MREAL, DM, F.G, opaque(F.bid));
            pg8::EpiResF32 E{rep ? F.out : hsrc, F.out, HM, DM, MT_REAL, rep ? 0.f : 0.5f}; pg8::gemm_phase<pg8::EpiResF32, pg8::StaticOrder, true, true>(F.lds + RING_OFF, g, S, E, F.tid); REP_END SEAM(pb + 3); }
        if (IN(pb + 4)) { REP_BEGIN(4) RETID(); phase_norm(F, F.out, FIN(F, I_MIXN) + l * DM); REP_END SEAM(pb + 4); }
        if (IN(pb + 5)) { REP_BEGIN(5) RETID(); meta_gemm(F, 2, XN + (size_t)MREAL * DM, DM, (const bf16*)(wb + W_NG), NNG, DM, BIG, NNG, 0.f); pg8::Gemm g{opaque((const bf16*)(XN)), opaque((const bf16*)(wb + W_NG)), MREAL, NNG, DM}; pg8::StaticOrder S; S.init(MREAL, NNG, F.G, opaque(F.bid));
            pg8::EpiBf16<0> E{BIG, NNG}; pg8::gemm_phase<pg8::EpiBf16<0>, pg8::StaticOrder, true, true>(F.lds + RING_OFF, g, S, E, F.tid); REP_END SEAM(pb + 5); }
        if (IN(pb + 6)) { REP_BEGIN(6) RETID(); phase_prep(F, l); phase_vt(F); __syncthreads(); phase_hgrn_prep(F, l); REP_END SEAM(pb + 6); }
#ifdef DUP_MIX
        if (IN(pb + 7)) { const int nrep = opaque(DUP_MIX1); for (int rep = 0; rep < nrep; ++rep) { RETID(); phase_mix1(F, l, 4 * rep + 2 * l); GRID_BAR(); } }
        if (IN(pb + 8)) { const int nrep = opaque(DUP_MIX2); for (int rep = 0; rep < nrep; ++rep) { RETID(); phase_mix2(F, l, 4 * rep + 2 * l + 1); GRID_BAR(); } }
#else
        if (IN(pb + 7)) { REP_BEGIN(7) RETID(); phase_mix1(F, l, 2 * l); REP_END SEAM(pb + 7); }
        if (IN(pb + 8)) { REP_BEGIN(8) RETID(); phase_mix2(F, l, 2 * l + 1); REP_END SEAM(pb + 8); }
#endif
        if (IN(pb + 9)) { REP_BEGIN(9) RETID(); meta_gemm(F, 3, XN + (size_t)MREAL * DM, DM, (const bf16*)(wb + W_G), NGATE, DM, BIG, NGATE, 0.f); pg8::Gemm g{opaque((const bf16*)(XN)), opaque((const bf16*)(wb + W_G)), MREAL, NGATE, DM}; pg8::StaticOrder S; S.init(MREAL, NGATE, F.G, opaque(F.bid));
            pg8::EpiBf16<1> E{BIG, NGATE}; pg8::gemm_phase<pg8::EpiBf16<1>, pg8::StaticOrder, true, true>(F.lds + RING_OFF, g, S, E, F.tid); REP_END SEAM(pb + 9); }
        if (IN(pb + 10)) { REP_BEGIN(10) RETID(); meta_gemm(F, 4, BR + (size_t)MREAL * 512, 512, (const bf16*)(wb + W_BR), DM, 512, XN, DM, 0.f);
            pg8::Gemm g{opaque((const bf16*)(BR)), opaque((const bf16*)(wb + W_BR)), MREAL, DM, 512}; pg8::MergeOrder S; S.init(MREAL, DM, F.G, opaque(F.bid), MPAD / 256);
            pg8::EpiGateAccM E{XN, DM, BIG, NGATE, MPAD / 256, DM / 256}; pg8::gemm_phase<pg8::EpiGateAccM, pg8::MergeOrder, true, true>(F.lds + RING_OFF, g, S, E, F.tid); REP_END SEAM(pb + 10); }
        if (IN(pb + 14) && BR_MASK) { REP_BEGIN(14) RETID(); meta_gemm(F, 1, XN + (size_t)MREAL * DM, DM, (const bf16*)(wb + W_O), DM, DM, nullptr, 0, rep ? 0.f : 1.0f); pg8::Gemm g{opaque((const bf16*)(XN)), opaque((const bf16*)(wb + W_O)), MREAL, DM, DM}; pg8::StaticOrder S; S.init(MREAL, DM, F.G, opaque(F.bid));
            pg8::EpiResF32 E{F.out, F.out, HM, DM, MT_REAL, rep ? 0.f : 1.0f}; pg8::gemm_phase<pg8::EpiResF32, pg8::StaticOrder, true, true>(F.lds + RING_OFF, g, S, E, F.tid); REP_END SEAM(pb + 14); }
        if (IN(pb + 15)) { REP_BEGIN(15) RETID(); phase_norm(F, F.out, FIN(F, I_F2N) + l * DM); REP_END SEAM(pb + 15); }
        if (IN(pb + 16)) { REP_BEGIN(16) RETID(); meta_gemm(F, 0, XN + (size_t)MREAL * DM, DM, (const bf16*)(wb + W_GU2), NGU, DM, BIG, DFF, 0.f); pg8::Gemm g{opaque((const bf16*)(XN)), opaque((const bf16*)(wb + W_GU2)), MREAL, NGU, DM}; pg8::StaticOrder S; S.init(MREAL, NGU, F.G, opaque(F.bid));
            pg8::EpiSwiGLU E{BIG, DFF}; pg8::gemm_phase<pg8::EpiSwiGLU, pg8::StaticOrder, true, true>(F.lds + RING_OFF, g, S, E, F.tid); REP_END SEAM(pb + 16); }
        if (IN(pb + 17)) { REP_BEGIN(17) RETID(); meta_gemm(F, 1, BIG + (size_t)MREAL * DFF, DFF, (const bf16*)(wb + W_D2), DM, DFF, nullptr, 0, rep ? 0.f : 0.5f); pg8::Gemm g{opaque((const bf16*)(BIG)), opaque((const bf16*)(wb + W_D2)), MREAL, DM, DFF}; pg8::StaticOrder S; S.init(MREAL, DM, F.G, opaque(F.bid));
            pg8::EpiResF32 E{F.out, F.out, HM, DM, MT_REAL, rep ? 0.f : 0.5f}; pg8::gemm_phase<pg8::EpiResF32, pg8::StaticOrder, true, true>(F.lds + RING_OFF, g, S, E, F.tid); REP_END SEAM(pb + 17); }
    }
}

extern "C" void kernel_launch(void* const* d_in, const int* in_sizes, int n_in, void* d_out, int out_size, void* d_ws, size_t ws_size, hipStream_t stream) {
    static int grid = 0;
    if (grid == 0) {
        if (n_in != 22 || out_size != MREAL * DM || ws_size < WS_END) { fprintf(stderr, "kernel_launch: unexpected shapes (n_in %d out %d ws %zu need %zu)\n", n_in, out_size, ws_size, (size_t)WS_END); grid = -1; return; }
        int dev = 0, cus = 0, per_cu = 0;
        if (hipGetDevice(&dev) != hipSuccess || hipDeviceGetAttribute(&cus, hipDeviceAttributeMultiprocessorCount, dev) != hipSuccess) { grid = -1; return; }
        if (hipFuncSetAttribute((const void*)fwd, hipFuncAttributeMaxDynamicSharedMemorySize, LDS_BYTES) != hipSuccess) { fprintf(stderr, "kernel_launch: hipFuncSetAttribute failed\n"); grid = -1; return; }
        if (hipOccupancyMaxActiveBlocksPerMultiprocessor(&per_cu, (const void*)fwd, NWAVES * 64, LDS_BYTES) != hipSuccess || per_cu < 1) fprintf(stderr, "kernel_launch: occupancy query says %d\n", per_cu);
        (void)hipGetLastError();
        grid = cus < 256 ? cus : 256;
    }
    if (grid < 0) return;
    (void)hipMemsetAsync((char*)d_ws + WS_CTL, 0, CTL_ZERO_BYTES, stream);
    Args a{};
    for (int i = 0; i < 22; ++i) a.in[i] = (const float*)d_in[i];
    a.out = (float*)d_out; a.ws = (unsigned char*)d_ws;
#ifndef PH_END
#define PH_END (2 * NPH)
#endif
#if MK_ONE
    a.ph_lo = 0; a.ph_hi = PH_END;
    hipLaunchKernelGGL(fwd, dim3(grid), dim3(NWAVES * 64), LDS_BYTES, stream, a);
#else
    for (int p = 0; p < PH_END; ++p) { a.ph_lo = p; a.ph_hi = p + 1;
#if defined(DBG_SEL)
#ifdef DBG_PREFILL
        if (p == 9) (void)hipMemsetAsync((char*)d_ws + WS_BIG, 0x3F, (size_t)MPAD * NGATE * 2, stream);
#endif
        if (DBG_SEL >= 30 && DBG_SEL < 40 && p == 14) hipLaunchKernelGGL(k_dbg_naive_wo, dim3(8, 2048), dim3(256), 0, stream, (const float*)d_out, (const unsigned short*)((char*)d_ws + WS_XN), (const unsigned short*)((char*)d_ws + WS_W + W_O), (float*)((char*)d_ws + WS_BIG));
#endif
        hipLaunchKernelGGL(fwd, dim3(grid), dim3(NWAVES * 64), LDS_BYTES, stream, a); }
#endif
#ifdef DBG_SEL
    { unsigned long long* best = (unsigned long long*)((char*)d_ws + 512 * 1024); unsigned* cnt = (unsigned*)((char*)d_ws + 512 * 1024 + 64);
      if (DBG_SEL >= 60 && DBG_SEL < 70) hipLaunchKernelGGL(k_dbg_argmax_bf16, dim3(2048), dim3(256), 0, stream, (const unsigned short*)((char*)d_ws + WS_BIG), NGATE, NGATE, best);
      else hipLaunchKernelGGL(k_dbg_argmax, dim3(2048), dim3(256), 0, stream, (const float*)d_out, (const float*)d_in[0], best);
      hipLaunchKernelGGL(k_dbg_count, dim3(2048), dim3(256), 0, stream, (const float*)d_out, (const float*)d_in[0], cnt);
      if (DBG_SEL >= 20 && DBG_SEL < 30) { const int mm = 1; hipLaunchKernelGGL(k_dbg_chk_merge, dim3(8, 2048), dim3(256), 0, stream, (const unsigned short*)((char*)d_ws + WS_BR) + (size_t)mm * MPAD * 512, (const unsigned short*)((char*)d_ws + WS_W + W_BR) + (size_t)mm * DM * 512, (const unsigned short*)((char*)d_ws + WS_BIG), (const unsigned short*)((char*)d_ws + WS_XN), mm, cnt); }
      if (DBG_SEL >= 30 && DBG_SEL < 40) hipLaunchKernelGGL(k_dbg_cmp, dim3(2048), dim3(256), 0, stream, (const float*)d_out, (const float*)((char*)d_ws + WS_BIG), cnt);
      if (DBG_SEL >= 40 && DBG_SEL < 50) { const unsigned short* A = nullptr; int ld = 0, nc = 0;
        if (DBG_SEL < 42) { A = (const unsigned short*)((char*)d_ws + WS_BR) + (size_t)MPAD * 512; ld = 512; nc = 512; }
        else if (DBG_SEL < 44) { A = (const unsigned short*)((char*)d_ws + WS_BIG) + DM; ld = NGATE; nc = DM; }
        else if (DBG_SEL < 46) { A = (const unsigned short*)((char*)d_ws + WS_XN); ld = DM; nc = DM; }
        else { A = (const unsigned short*)((char*)d_ws + WS_BR); ld = 512; nc = 512; }
        hipLaunchKernelGGL(k_dbg_stats, dim3(1024), dim3(256), 0, stream, A, ld, nc, cnt); }
      if (DBG_SEL >= 70 && DBG_SEL < 80) hipLaunchKernelGGL(k_dbg_gcount, dim3(1024), dim3(256), 0, stream, (const unsigned short*)((char*)d_ws + WS_BIG), cnt);
      if (DBG_SEL >= 100) hipLaunchKernelGGL(k_dbg_time, dim3(1), dim3(64), 0, stream, (const unsigned long long*)((char*)d_ws + 768 * 1024), cnt);
      hipLaunchKernelGGL(k_dbg_emit, dim3(2048), dim3(256), 0, stream, (float*)d_out, (const float*)d_in[0], best, cnt); }
#endif
}
```

```cpp
#include <hip/hip_runtime.h>
#include <cstdio>
#include <cstdint>
#define MK_ONE 1
namespace pg8 {
#define PG8_LAS __attribute__((address_space(3)))
typedef unsigned short bf16_t;
typedef short bf16x8 __attribute__((ext_vector_type(8)));
typedef float f32x4 __attribute__((ext_vector_type(4)));
typedef unsigned u32x4 __attribute__((ext_vector_type(4)));
constexpr int BM = 256, BK = 64, HALF = 128, HTB = HALF * BK * 2  , STAGE_BYTES = 8 * HTB, NXCD = 8, WGM = 8;

__host__ __device__ __forceinline__ int lds_byte(int r, int c) { const int st = (r >> 4) * 2 + (c >> 5), rr = r & 15, cc = c & 31, ob = rr * 64 + cc * 2; return st * 1024 + (ob ^ (((ob >> 9) & 1) << 5)); }
__host__ __device__ __forceinline__ void stage_rc(int b, int& R, int& C) { const int st = b / 1024, sb = b % 1024, swz = sb ^ (((sb >> 9) & 1) << 5); R = (st >> 1) * 16 + swz / 64; C = (st & 1) * 32 + (swz % 64) / 2; }
__host__ __device__ __forceinline__ int perm32(int rho) { const int n = rho >> 4, i = rho & 15; return 8 * (i >> 2) + 4 * n + (i & 3); }

struct Unit { int pm, pn; };
struct Gemm { const bf16_t* A; const bf16_t* Bt; int M, N, K; };

struct StaticOrder {
    int nM, nN, nwg, G, c;
    __host__ __device__ void init(int M, int N, int G_, int c_) { nM = M / BM; nN = N / BM; nwg = nM * nN; G = G_; c = c_; }
    __host__ __device__ bool next(int i, Unit& u) const {
        const long L = (long)i * G + c; if (L >= nwg) return false;
        int wgid = (int)L; { const int q = nwg / NXCD, r = nwg % NXCD, xcd = wgid % NXCD, off = wgid / NXCD; wgid = (xcd < r ? xcd * (q + 1) : r * (q + 1) + (xcd - r) * q) + off; }
        const int nig = WGM * nN, gid = wgid / nig, fm = gid * WGM, gsz = (nM - fm) < WGM ? (nM - fm) : WGM;
        u.pm = fm + ((wgid % nig) % gsz); u.pn = (wgid % nig) / gsz; return true;
    }
    __device__ __forceinline__ void a_ready(const Unit&) const {}
    __device__ __forceinline__ void done(const Unit&) const {}
};
typedef __bf16 bf16x2_hw __attribute__((ext_vector_type(2))); typedef float f32x2_hw __attribute__((ext_vector_type(2)));
__device__ __forceinline__ unsigned cvt_pk_bf16(float lo, float hi) { const f32x2_hw v = {lo, hi}; return __builtin_bit_cast(unsigned, __builtin_convertvector(v, bf16x2_hw)); }
typedef float f32x2 __attribute__((ext_vector_type(2)));
__device__ __forceinline__ float fast_sigmoid(float x) { return __builtin_amdgcn_rcpf(1.0f + __expf(-x)); }
__device__ __forceinline__ float fast_silu(float x) { return x * fast_sigmoid(x); }
template <int ACT  > struct EpiBf16 {
    static constexpr bool PERM = true, AFTER_DRAIN = false;
    bf16_t* O; int ldc;
    __device__ __forceinline__ void operator()(const f32x4 (&acc)[2][2][4][2], const Unit& u, int wr, int wc, int fr, int fq) const {
        const int row0 = u.pm * BM + wr * 64 + fr; const int col0 = u.pn * BM + wc * 32 + 8 * fq;
#pragma unroll
        for (int ai = 0; ai < 2; ++ai)
#pragma unroll
            for (int m = 0; m < 4; ++m) { bf16_t* rowp = O + (size_t)(row0 + ai * HALF + m * 16) * ldc + col0;
#pragma unroll
                for (int bj = 0; bj < 2; ++bj) { f32x4 v0 = acc[ai][bj][m][0], v1 = acc[ai][bj][m][1];
                    if (ACT == 1) {
#pragma unroll
                        for (int j = 0; j < 4; ++j) { v0[j] = fast_sigmoid(v0[j]); v1[j] = fast_sigmoid(v1[j]); } }
                    u32x4 w; w.x = cvt_pk_bf16(v0[0], v0[1]); w.y = cvt_pk_bf16(v0[2], v0[3]); w.z = cvt_pk_bf16(v1[0], v1[1]); w.w = cvt_pk_bf16(v1[2], v1[3]);
                    *(u32x4*)(rowp + bj * HALF) = w; } }
    }
};
struct EpiSwiGLU {
    static constexpr bool PERM = true, AFTER_DRAIN = false;
    bf16_t* O; int ldc;
    __device__ __forceinline__ void operator()(const f32x4 (&acc)[2][2][4][2], const Unit& u, int wr, int wc, int fr, int fq) const {
        const int row0 = u.pm * BM + wr * 64 + fr; const int col0 = u.pn * HALF + wc * 32 + 8 * fq;
#pragma unroll
        for (int ai = 0; ai < 2; ++ai)
#pragma unroll
            for (int m = 0; m < 4; ++m) { bf16_t* rowp = O + (size_t)(row0 + ai * HALF + m * 16) * ldc + col0;
                const f32x4 g0 = acc[ai][0][m][0], g1 = acc[ai][0][m][1], u0 = acc[ai][1][m][0], u1 = acc[ai][1][m][1];
                f32x4 v0, v1;
#pragma unroll
                for (int j = 0; j < 4; ++j) { v0[j] = fast_silu(g0[j]) * u0[j]; v1[j] = fast_silu(g1[j]) * u1[j]; }
                u32x4 w; w.x = cvt_pk_bf16(v0[0], v0[1]); w.y = cvt_pk_bf16(v0[2], v0[3]); w.z = cvt_pk_bf16(v1[0], v1[1]); w.w = cvt_pk_bf16(v1[2], v1[3]);
                *(u32x4*)rowp = w; asm volatile("" ::: "memory"); }
    }
};
struct EpiResF32 {
    static constexpr bool PERM = false, AFTER_DRAIN = false;
    const float* base_r; float* out_r; float* hm; int ldc; int mt_real; float scale;
    __device__ __forceinline__ void operator()(const f32x4 (&acc)[2][2][4][2], const Unit& u, int wr, int wc, int fr, int fq) const {
        const bool real = u.pm < mt_real;
        const float* bp = real ? base_r + (size_t)u.pm * BM * ldc : hm; float* op = real ? out_r + (size_t)u.pm * BM * ldc : hm;
        const int row0 = wr * 64 + fr, col0 = u.pn * BM + wc * 32 + 4 * fq;
#pragma unroll
        for (int ai = 0; ai < 2; ++ai) {
            f32x4 b[4][2][2];
#pragma unroll
            for (int m = 0; m < 4; ++m) { const size_t off = (size_t)(row0 + ai * HALF + m * 16) * ldc + col0;
#pragma unroll
                for (int bj = 0; bj < 2; ++bj)
#pragma unroll
                    for (int n = 0; n < 2; ++n) b[m][bj][n] = *(const f32x4*)(bp + off + bj * HALF + n * 16); }
            asm volatile("" ::: "memory");
#pragma unroll
            for (int m = 0; m < 4; ++m) { const size_t off = (size_t)(row0 + ai * HALF + m * 16) * ldc + col0;
#pragma unroll
                for (int bj = 0; bj < 2; ++bj)
#pragma unroll
                    for (int n = 0; n < 2; ++n) *(f32x4*)(op + off + bj * HALF + n * 16) = b[m][bj][n] + acc[ai][bj][m][n] * scale; }
            asm volatile("" ::: "memory"); }
    }
};
struct EpiGateAcc {
    static constexpr bool PERM = true, AFTER_DRAIN = false;
    bf16_t* MG; int ldc; const bf16_t* G; int ldg; int gcol0; int first;
    __device__ __forceinline__ void operator()(const f32x4 (&acc)[2][2][4][2], const Unit& u, int wr, int wc, int fr, int fq) const {
        const int row0 = u.pm * BM + wr * 64 + fr; const int col0 = u.pn * BM + wc * 32 + 8 * fq;
#pragma unroll
        for (int ai = 0; ai < 2; ++ai)
#pragma unroll
            for (int m = 0; m < 4; ++m) { const size_t r = (size_t)(row0 + ai * HALF + m * 16);
#pragma unroll
                for (int bj = 0; bj < 2; ++bj) { const u32x4 gw = *(const u32x4*)(G + r * ldg + gcol0 + col0 + bj * HALF);
                    u32x4 pw = (u32x4){0u, 0u, 0u, 0u}; if (!first) pw = *(const u32x4*)(MG + r * ldc + col0 + bj * HALF);
                    float o[8];
#pragma unroll
                    for (int j = 0; j < 4; ++j) { const float a0 = (j < 2) ? acc[ai][bj][m][0][2 * j] : acc[ai][bj][m][1][2 * (j - 2)], a1 = (j < 2) ? acc[ai][bj][m][0][2 * j + 1] : acc[ai][bj][m][1][2 * (j - 2) + 1];
                        o[2 * j] = __uint_as_float(pw[j] << 16) + __uint_as_float(gw[j] << 16) * a0; o[2 * j + 1] = __uint_as_float(pw[j] & 0xffff0000u) + __uint_as_float(gw[j] & 0xffff0000u) * a1; }
                    u32x4 w; w.x = cvt_pk_bf16(o[0], o[1]); w.y = cvt_pk_bf16(o[2], o[3]); w.z = cvt_pk_bf16(o[4], o[5]); w.w = cvt_pk_bf16(o[6], o[7]);
                    *(u32x4*)(MG + r * ldc + col0 + bj * HALF) = w; } }
    }
};

struct MergeOrder {
    int nM, nN, G, c, mt_alloc;
    __host__ __device__ void init(int M, int N, int G_, int c_, int mt_alloc_) { nM = M / BM; nN = N / BM; G = G_; c = c_; mt_alloc = mt_alloc_; }
    __host__ __device__ bool next(int i, Unit& u) const { const int t = (i >> 2) * G + c, m = i & 3; if (t >= nM * nN) return false;
        const int pm = t / nN, pn = t % nN; u.pm = m * mt_alloc + pm; u.pn = m * nN + pn; return true; }
    __device__ __forceinline__ void a_ready(const Unit&) const {}
    __device__ __forceinline__ void done(const Unit&) const {}
};
struct EpiGateAccM {
    static constexpr bool PERM = true, AFTER_DRAIN = false;
    bf16_t* MG; int ldc; const bf16_t* G; int ldg; int mt_alloc; int ntn;
    __device__ __forceinline__ void operator()(const f32x4 (&acc)[2][2][4][2], const Unit& u, int wr, int wc, int fr, int fq) const {
        const int m = u.pm / mt_alloc, pm = u.pm - m * mt_alloc, pn = u.pn - m * ntn;
        const int row0 = pm * BM + wr * 64 + fr; const int col0 = pn * BM + wc * 32 + 8 * fq; const int gcol0 = m * ntn * BM;
#pragma unroll
        for (int ai = 0; ai < 2; ++ai)
#pragma unroll
            for (int mm = 0; mm < 4; ++mm) { const size_t r = (size_t)(row0 + ai * HALF + mm * 16);
#pragma unroll
                for (int bj = 0; bj < 2; ++bj) { const u32x4 gw = *(const u32x4*)(G + r * ldg + gcol0 + col0 + bj * HALF);
                    u32x4 pw = (u32x4){0u, 0u, 0u, 0u}; if (m != 0) pw = *(const u32x4*)(MG + r * ldc + col0 + bj * HALF);
                    float o[8];
#pragma unroll
                    for (int j = 0; j < 4; ++j) { const float a0 = (j < 2) ? acc[ai][bj][mm][0][2 * j] : acc[ai][bj][mm][1][2 * (j - 2)], a1 = (j < 2) ? acc[ai][bj][mm][0][2 * j + 1] : acc[ai][bj][mm][1][2 * (j - 2) + 1];
                        o[2 * j] = __uint_as_float(pw[j] << 16) + __uint_as_float(gw[j] << 16) * a0; o[2 * j + 1] = __uint_as_float(pw[j] & 0xffff0000u) + __uint_as_float(gw[j] & 0xffff0000u) * a1; }
                    u32x4 w; w.x = cvt_pk_bf16(o[0], o[1]); w.y = cvt_pk_bf16(o[2], o[3]); w.z = cvt_pk_bf16(o[4], o[5]); w.w = cvt_pk_bf16(o[6], o[7]);
                    *(u32x4*)(MG + r * ldc + col0 + bj * HALF) = w; } }
    }
};
template <class Epi, class Sched, bool ALIGN_EPI = false, bool SP2 = false>
__device__ __forceinline__ void gemm_phase(PG8_LAS unsigned char* lds, const Gemm g, const Sched& S, const Epi& E, int tid_in) {
    int tid_ = tid_in; asm volatile("" : "+v"(tid_));
    const int tid = tid_, wid = __builtin_amdgcn_readfirstlane(tid >> 6), lane = tid & 63, wr = wid >> 2, wc = wid & 3, fr = lane & 15, fq = lane >> 4;
    const int K = g.K, nt = K / BK;
    unsigned voffA[2], voffB[2];
#pragma unroll
    for (int i = 0; i < 2; ++i) { int R, C; stage_rc(tid * 16 + i * 8192, R, C); const int Rb = Epi::PERM ? ((R & ~31) + perm32(R & 31)) : R;
        voffA[i] = (unsigned)(R * K + C) * 2u; voffB[i] = (unsigned)(Rb * K + C) * 2u; }
    const size_t kstep = (size_t)(BK * 2);
    const size_t hstep = (size_t)HALF * K * 2;
    const size_t tstep = 2 * hstep;
    const unsigned ldsw = (unsigned)wid * 1024u;
    const int aoff = lds_byte(wr * 64 + fr, fq * 8), boff = lds_byte(wc * 32 + fr, fq * 8);
#define PG8_SA(b, h) (((b) * 2 + (h)) * HTB)
#define PG8_SB(b, h) ((4 + (b) * 2 + (h)) * HTB)
#define PG8_STAGE(bufoff, gbase, voff) do { _Pragma("unroll") for (int _i = 0; _i < 2; ++_i) \
        __builtin_amdgcn_global_load_lds((const unsigned*)((const char*)(gbase) + (voff)[_i]), (PG8_LAS unsigned*)(lds + (bufoff) + ldsw + _i * 8192), 16, 0, 0); } while (0)
#define PG8_LDA(dst, b, h) do { _Pragma("unroll") for (int m = 0; m < 4; ++m) _Pragma("unroll") for (int k = 0; k < 2; ++k) dst[m][k] = *(const PG8_LAS bf16x8*)(lds + PG8_SA(b, h) + aoff + m * 2048 + k * 1024); } while (0)
#define PG8_LDB(dst, b, h) do { _Pragma("unroll") for (int n = 0; n < 2; ++n) _Pragma("unroll") for (int k = 0; k < 2; ++k) dst[n][k] = *(const PG8_LAS bf16x8*)(lds + PG8_SB(b, h) + boff + n * 2048 + k * 1024); } while (0)
#define PG8_MMA(ai, bj, At, Bt) do { __builtin_amdgcn_s_setprio(1); _Pragma("unroll") for (int m = 0; m < 4; ++m) _Pragma("unroll") for (int n = 0; n < 2; ++n) _Pragma("unroll") for (int k = 0; k < 2; ++k) \
        acc[ai][bj][m][n] = __builtin_amdgcn_mfma_f32_16x16x32_bf16(Bt[n][k], At[m][k], acc[ai][bj][m][n], 0, 0, 0); __builtin_amdgcn_s_setprio(0); } while (0)
#define PG8_WAIT_V(n) asm volatile("s_waitcnt vmcnt(" #n ")" ::: "memory")
#define PG8_WAIT_L(n) asm volatile("s_waitcnt lgkmcnt(" #n ")" ::: "memory")
#define PG8_BAR __builtin_amdgcn_s_barrier()
#define PG8_SCHED __builtin_amdgcn_sched_barrier(0)
    Unit cur, nxt; int ui = 0;
    if (!S.next(0, cur)) return;
    f32x4 acc[2][2][4][2];
#pragma unroll
    for (int a = 0; a < 2; ++a)
#pragma unroll
        for (int b = 0; b < 2; ++b)
#pragma unroll
            for (int m = 0; m < 4; ++m)
#pragma unroll
                for (int n = 0; n < 2; ++n) acc[a][b][m][n] = (f32x4){0.f, 0.f, 0.f, 0.f};
    bf16x8 At[4][2], B0[2][2], B1[2][2];
    const char* cA = (const char*)g.A + (size_t)cur.pm * tstep; const char* cB = (const char*)g.Bt + (size_t)cur.pn * tstep;
    S.a_ready(cur);
    if constexpr (SP2) {
        PG8_STAGE(PG8_SB(0, 0), cB, voffB); PG8_STAGE(PG8_SB(0, 1), cB + hstep, voffB); PG8_STAGE(PG8_SA(0, 0), cA, voffA); PG8_STAGE(PG8_SA(0, 1), cA + hstep, voffA);
        if (wr == 1) PG8_BAR;
        PG8_WAIT_V(2); PG8_BAR;
        PG8_STAGE(PG8_SB(1, 0), cB + kstep, voffB); PG8_STAGE(PG8_SA(1, 0), cA + kstep, voffA); PG8_STAGE(PG8_SB(1, 1), cB + hstep + kstep, voffB);
        PG8_WAIT_V(6); PG8_BAR;
    } else {
        PG8_STAGE(PG8_SB(0, 0), cB, voffB); PG8_STAGE(PG8_SA(0, 0), cA, voffA); PG8_STAGE(PG8_SB(0, 1), cB + hstep, voffB); PG8_STAGE(PG8_SA(0, 1), cA + hstep, voffA);
        if (wr == 1) PG8_BAR;
        PG8_WAIT_V(4); PG8_BAR;
        PG8_STAGE(PG8_SB(1, 0), cB + kstep, voffB); PG8_STAGE(PG8_SA(1, 0), cA + kstep, voffA); PG8_STAGE(PG8_SB(1, 1), cB + hstep + kstep, voffB);
        PG8_WAIT_V(6); PG8_BAR;
    }
    for (;;) {
        const bool has_next = S.next(ui + 1, nxt);
        const char* nA = has_next ? (const char*)g.A + (size_t)nxt.pm * tstep : cA; const char* nB = has_next ? (const char*)g.Bt + (size_t)nxt.pn * tstep : cB;
        for (int t = 0; t < nt; t += 2) {
            const bool last = (t == nt - 2);
            const char* a1 = cA + (size_t)(t + 1) * kstep;
            const char* a2 = last ? nA : cA + (size_t)(t + 2) * kstep; const char* b2 = last ? nB : cB + (size_t)(t + 2) * kstep;
            const char* a3 = a2 + kstep; const char* b3 = b2 + kstep;
            if (last && has_next) S.a_ready(nxt);
            if constexpr (SP2) {
            PG8_LDB(B0, 0, 0); PG8_LDB(B1, 0, 1); PG8_SCHED; PG8_LDA(At, 0, 0); PG8_STAGE(PG8_SA(1, 1), a1 + hstep, voffA);
            PG8_WAIT_V(8); PG8_WAIT_L(0); PG8_BAR; PG8_MMA(0, 0, At, B0); PG8_MMA(0, 1, At, B1); PG8_BAR; PG8_SCHED;
            PG8_LDA(At, 0, 1); PG8_STAGE(PG8_SB(0, 0), b2, voffB); PG8_STAGE(PG8_SB(0, 1), b2 + hstep, voffB); PG8_STAGE(PG8_SA(0, 0), a2, voffA);
            PG8_WAIT_V(8); PG8_WAIT_L(0); PG8_BAR; PG8_MMA(1, 0, At, B0); PG8_MMA(1, 1, At, B1); PG8_BAR; PG8_SCHED;
            PG8_LDB(B0, 1, 0); PG8_LDB(B1, 1, 1); PG8_SCHED; PG8_LDA(At, 1, 0); PG8_STAGE(PG8_SA(0, 1), a2 + hstep, voffA);
            PG8_WAIT_V(8); PG8_WAIT_L(0); PG8_BAR; PG8_MMA(0, 0, At, B0); PG8_MMA(0, 1, At, B1); PG8_BAR; PG8_SCHED;
            PG8_LDA(At, 1, 1); PG8_STAGE(PG8_SB(1, 0), b3, voffB); PG8_STAGE(PG8_SB(1, 1), b3 + hstep, voffB); PG8_STAGE(PG8_SA(1, 0), a3, voffA);
            PG8_WAIT_V(8); PG8_WAIT_L(0); PG8_BAR; PG8_MMA(1, 0, At, B0); PG8_MMA(1, 1, At, B1); PG8_BAR; PG8_SCHED;
            } else {
            PG8_LDB(B0, 0, 0); PG8_SCHED; PG8_LDA(At, 0, 0); PG8_STAGE(PG8_SA(1, 1), a1 + hstep, voffA);
            PG8_WAIT_L(8); PG8_BAR; PG8_WAIT_L(0); PG8_MMA(0, 0, At, B0); PG8_BAR; PG8_SCHED;
            PG8_LDB(B1, 0, 1); PG8_STAGE(PG8_SB(0, 0), b2, voffB);
            PG8_BAR; PG8_WAIT_L(0); PG8_MMA(0, 1, At, B1); PG8_BAR;
            PG8_LDA(At, 0, 1); PG8_STAGE(PG8_SA(0, 0), a2, voffA);
            PG8_BAR; PG8_WAIT_L(0); PG8_MMA(1, 0, At, B0); PG8_BAR; PG8_SCHED;
            PG8_STAGE(PG8_SB(0, 1), b2 + hstep, voffB);
            PG8_WAIT_V(6); PG8_BAR; PG8_MMA(1, 1, At, B1); PG8_BAR;
            PG8_LDB(B0, 1, 0); PG8_SCHED; PG8_LDA(At, 1, 0); PG8_STAGE(PG8_SA(0, 1), a2 + hstep, voffA);
            PG8_WAIT_L(8); PG8_BAR; PG8_WAIT_L(0); PG8_MMA(0, 0, At, B0); PG8_BAR; PG8_SCHED;
            PG8_LDB(B1, 1, 1); PG8_STAGE(PG8_SB(1, 0), b3, voffB);
            PG8_BAR; PG8_WAIT_L(0); PG8_MMA(0, 1, At, B1); PG8_BAR;
            PG8_LDA(At, 1, 1); PG8_STAGE(PG8_SA(1, 0), a3, voffA);
            PG8_BAR; PG8_WAIT_L(0); PG8_MMA(1, 0, At, B0); PG8_BAR; PG8_SCHED;
            PG8_STAGE(PG8_SB(1, 1), b3 + hstep, voffB);
            PG8_WAIT_V(6); PG8_BAR; PG8_MMA(1, 1, At, B1); PG8_BAR;
            }
        }
        if constexpr (ALIGN_EPI) { if (wr == 0) PG8_BAR; }
        if constexpr (!Epi::AFTER_DRAIN) { E(acc, cur, wr, wc, fr, fq); S.done(cur); }
        if (!has_next) break;
#pragma unroll
        for (int a = 0; a < 2; ++a)
#pragma unroll
            for (int b = 0; b < 2; ++b)
#pragma unroll
                for (int m = 0; m < 4; ++m)
#pragma unroll
                    for (int n = 0; n < 2; ++n) acc[a][b][m][n] = (f32x4){0.f, 0.f, 0.f, 0.f};
        cur = nxt; cA = nA; cB = nB; ++ui;
        if constexpr (ALIGN_EPI) { if (wr == 1) PG8_BAR; }
    }
    PG8_WAIT_V(0);
    if constexpr (!ALIGN_EPI) { if (wr == 0) PG8_BAR; }
    PG8_BAR;
    if constexpr (Epi::AFTER_DRAIN) { E.fused(acc, cur, wr, wc, fr, fq, lds, wid, lane); S.done(cur); }
#undef PG8_SA
#undef PG8_SB
#undef PG8_STAGE
#undef PG8_LDA
#undef PG8_LDB
#undef PG8_MMA
#undef PG8_WAIT_V
#undef PG8_WAIT_L
#undef PG8_BAR
#undef PG8_SCHED
}
}

constexpr int DM = 2048, NB = 8, SEQ = 4096, NMETA = 16, LSEQ = 4112, LPAD = 4128;
constexpr int MREAL = NB * SEQ;
constexpr int MPAD = MREAL + 256;
constexpr int MT_REAL = MREAL / 256;
constexpr int DFF = 5632, NGU = 2 * DFF, NNG = 7168, NGATE = 8192, INCOLS = 15184, NGC = 6992;
constexpr int NWAVES = 8;
constexpr float EPS = 1e-6f;
constexpr int C_AQ = 0, C_AF = 512, C_AI = 1024, C_AG = 1536, C_BB = 2048, C_BC = 2560, C_BU = 3072, C_CQ = 3584, C_CK = 4096, C_CV = 4608,
              C_DQ = 5120, C_DK = 5632, C_DV = 5760, C_DQI = 5888, C_DKI = 6912, C_DW = 6976;

constexpr size_t MiB = 1u << 20;
constexpr size_t WS_CTL = 0, CTL_ZERO_BYTES = 1 * MiB;
constexpr size_t WS_HM = 1 * MiB;
constexpr size_t WS_W = 4 * MiB;
constexpr size_t W_GU1 = 0, W_D1 = W_GU1 + (size_t)NGU * DM * 2, W_NG = W_D1 + (size_t)DM * DFF * 2, W_G = W_NG + (size_t)NNG * DM * 2,
                 W_BR = W_G + (size_t)NGATE * DM * 2, W_O = W_BR + (size_t)4 * DM * 512 * 2, W_GU2 = W_O + (size_t)DM * DM * 2, W_D2 = W_GU2 + (size_t)NGU * DM * 2,
                 W_END = W_D2 + (size_t)DM * DFF * 2;
constexpr size_t WS_XN = WS_W + W_END;
constexpr size_t WS_BR = WS_XN + (size_t)MPAD * DM * 2;
constexpr size_t WS_BIG = WS_BR + (size_t)MPAD * DM * 2;
constexpr size_t BIG_P_END = (size_t)MPAD * NNG * 2;
constexpr size_t WS_VTC = WS_BIG + BIG_P_END;
constexpr size_t WS_VTD = WS_VTC + (size_t)NB * 4 * 128 * LPAD * 2;
constexpr size_t WS_MASK = WS_VTD + (size_t)NB * 128 * LPAD * 2;
constexpr int MASKW = 132;
constexpr int NIDX_WG = 172;
constexpr int NHG_WG = 32;
constexpr size_t WS_SCR = WS_MASK + (size_t)NB * LPAD * MASKW * 4;
constexpr size_t WS_HA = WS_SCR + (size_t)NIDX_WG * 32 * LPAD * 4;
constexpr size_t WS_HDL = WS_HA + (size_t)NB * 4 * 64 * 64 * 64 * 2;
constexpr size_t WS_HMETA = WS_HDL + (size_t)NB * 4 * 64 * 128 * 4;
constexpr size_t HMETA_STRIDE = 64 * 384 * 2 + 64 * 64 * 2 + 128 * 4;
constexpr size_t WS_END = WS_HMETA + 4 * HMETA_STRIDE;
static_assert(WS_BIG + (size_t)MPAD * NGATE * 2 <= WS_END, "G fits");
static_assert(WS_END <= (size_t)1138174976, "workspace map fits the guaranteed size");

constexpr int RING_OFF = 0, RING_BYTES = 131072;
constexpr int LDSCTL_OFF = 143360, MISC_OFF = LDSCTL_OFF + 320;
constexpr int LDS_BYTES = 147456;

#define GAS __attribute__((address_space(1)))
#define LAS __attribute__((address_space(3)))
typedef unsigned short bf16;
typedef unsigned v4u __attribute__((ext_vector_type(4)));
typedef unsigned v2u __attribute__((ext_vector_type(2)));
typedef float f32x4 __attribute__((ext_vector_type(4)));
typedef float f32x16 __attribute__((ext_vector_type(16)));
typedef short bf16x8 __attribute__((ext_vector_type(8)));
typedef GAS unsigned gu32;
#define RLX_AGENT __ATOMIC_RELAXED, __HIP_MEMORY_SCOPE_AGENT
#define LDS_WAIT() asm volatile("s_waitcnt lgkmcnt(0)" ::: "memory")
#define VM_WAIT() asm volatile("s_waitcnt vmcnt(0)" ::: "memory")
__device__ __forceinline__ unsigned f2bf(float f) { unsigned u = __builtin_bit_cast(unsigned, f); return (u + 0x7fffu + ((u >> 16) & 1u)) >> 16; }
__device__ __forceinline__ unsigned f2bf_s(float f) { return pg8::cvt_pk_bf16(f, 0.f) & 0xffffu; }
__device__ __forceinline__ unsigned pk2(float lo, float hi) { return pg8::cvt_pk_bf16(lo, hi); }
__device__ __forceinline__ float bflo(unsigned w) { return __uint_as_float(w << 16); }
__device__ __forceinline__ float bfhi(unsigned w) { return __uint_as_float(w & 0xffff0000u); }
__device__ __forceinline__ float bf2f(bf16 v) { return __uint_as_float((unsigned)v << 16); }
__device__ __forceinline__ int seqrow(int b, int p) { return p < NMETA ? MREAL + p : b * SEQ + p - NMETA; }
__device__ __forceinline__ int rel_bucket(int n) {
    if (n < 16) return n; if (n >= 128) return 31;
    const int v = 16 + (int)(__log2f((float)n * 0.0625f) * 5.33333333f); return v < 31 ? v : 31; }
__device__ __forceinline__ float wave_sum(float v) {
#pragma unroll
    for (int o = 1; o < 64; o <<= 1) v += __shfl_xor(v, o);
    return v;
}
#define XB_TMO      128
#define XB_XCNT(j)  (256  + 64 * (j))
#define XB_XSUB(j)  (1280 + 64 * (j))
#define XB_XGEN(j)  (2304 + 64 * (j))
#define XB_TOP      3328
#define XB_TOPGEN   3392
#define XCD_BAR_WORDS 3456
#define XB_SPIN_CAP (1u << 18)

__device__ __forceinline__ unsigned xb_ld(unsigned* p)              { return __hip_atomic_load(p, __ATOMIC_RELAXED, __HIP_MEMORY_SCOPE_AGENT); }
__device__ __forceinline__ unsigned xb_add(unsigned* p, unsigned v) { return __hip_atomic_fetch_add(p, v, __ATOMIC_RELAXED, __HIP_MEMORY_SCOPE_AGENT); }
__device__ __forceinline__ unsigned xb_xcc_id() { return (unsigned)__builtin_amdgcn_s_getreg((3 << 11) | 20) & 0xFu; }
#define XB_SPIN(cond, bar) do { unsigned _sp = 0; while (cond) { __builtin_amdgcn_s_sleep(1); \
    if ((++_sp & 255u) == 0u) { if (xb_ld(&(bar)[XB_TMO])) break; if (_sp > XB_SPIN_CAP) { atomicAdd(&(bar)[XB_TMO], 1u); break; } } } } while (0)

struct XcdBarrier {
    int wave;
    unsigned* bar; unsigned x;
    volatile LAS unsigned* st;
};

__device__ __forceinline__ bool xb_thread0(int wave) { unsigned mk = ~0u; asm volatile("" : "+s"(mk)); return wave == 0 && __builtin_amdgcn_mbcnt_hi(mk, __builtin_amdgcn_mbcnt_lo(mk, 0u)) == 0u; }
__device__ __forceinline__ XcdBarrier xcd_barrier_post(unsigned* bar, volatile LAS unsigned* st, int wave) {
    XcdBarrier b; b.wave = wave; b.bar = bar; b.x = xb_xcc_id(); b.st = st;
    if (xb_thread0(wave)) (void)xb_add(&bar[XB_XCNT(b.x)], 1u);
    return b;
}
__device__ __forceinline__ void xcd_barrier_complete(unsigned* bar, unsigned x, unsigned& nloc, unsigned& nx) {
    const unsigned G = gridDim.x * gridDim.y * gridDim.z;
    unsigned sum, cnt, mine, sp = 0u;
    for (;;) {
        sum = 0u; cnt = 0u; mine = 0u;
#pragma unroll
        for (unsigned j = 0; j < 16; ++j) { const unsigned c = xb_ld(&bar[XB_XCNT(j)]); sum += c; cnt += (c > 0u) ? 1u : 0u; mine = (j == x) ? c : mine; }
        if (sum == G) break;
        __builtin_amdgcn_s_sleep(1);
        if ((++sp & 255u) == 0u) { if (xb_ld(&bar[XB_TMO])) break; if (sp > XB_SPIN_CAP) { atomicAdd(&bar[XB_TMO], 1u); break; } }
    }
    nloc = mine > 0u ? mine : 1u; nx = cnt > 0u ? cnt : 1u;
}

__device__ __forceinline__ void xcd_barrier(const XcdBarrier& b) {
    asm volatile("s_waitcnt vmcnt(0)" ::: "memory");
    __syncthreads();
    if (xb_thread0(b.wave)) {
        unsigned* bar = b.bar;
        __builtin_amdgcn_s_waitcnt(0);
        unsigned nloc = b.st[0], nx = b.st[1];
        if (nloc == 0u) { xcd_barrier_complete(bar, b.x, nloc, nx); b.st[0] = nloc; b.st[1] = nx; }
        const unsigned old = xb_add(&bar[XB_XSUB(b.x)], 1u);
        const unsigned gen = old / nloc;
        if (old + 1u == (gen + 1u) * nloc) {
            __builtin_amdgcn_fence(__ATOMIC_RELEASE, "agent");
            asm volatile("s_waitcnt vmcnt(0)" ::: "memory");
            const unsigned og = xb_add(&bar[XB_TOP], 1u);
            const unsigned tg = og / nx;
            if (og + 1u == (tg + 1u) * nx) xb_add(&bar[XB_TOPGEN], 1u);
            else XB_SPIN(xb_ld(&bar[XB_TOPGEN]) == tg, bar);
            __builtin_amdgcn_fence(__ATOMIC_ACQUIRE, "agent");
            xb_add(&bar[XB_XGEN(b.x)], 1u);
            asm volatile("s_waitcnt vmcnt(0)" ::: "memory");
        } else {
            XB_SPIN(xb_ld(&bar[XB_XGEN(b.x)]) == gen, bar);
            __builtin_amdgcn_fence(__ATOMIC_ACQUIRE, "agent");
            asm volatile("s_waitcnt vmcnt(0)" ::: "memory");
        }
    }
    __syncthreads();
}

struct Frame {
    LAS unsigned char* lds;
    volatile LAS unsigned* MISC;
    gu32* ctl;
    int tid, lane, wave, G, bid;
    const unsigned char __attribute__((address_space(4)))* karg; float* out; unsigned char* ws;
};
__device__ __forceinline__ const float* fin_load(const unsigned char __attribute__((address_space(4)))* k, int i) { asm volatile("" : "+s"(k)); return *(const float* const __attribute__((address_space(4)))*)(k + 8 * i); }
#define FIN(F_, i_) fin_load((F_).karg, (i_))
enum { I_X = 0, I_META, I_RELB, I_F1N, I_F1GU, I_F1D, I_MIXN, I_WIN, I_LB, I_GN, I_CONVW, I_DQN, I_DKN, I_DLAM, I_DSUB, I_SQN, I_SKN, I_WBR, I_WOUT, I_F2N, I_F2GU, I_F2D };

template <class RowMap>
__device__ __forceinline__ void transpose_item(const float* W, int K, int N, bf16* WT, LAS float* scr, int item, int lane, RowMap rm) {
    const int nblk = (N + 31) / 32, kb = item / nblk, nb = item % nblk, k0 = 64 * kb, n0 = 32 * nb;
    const int nl = n0 + (lane & 31); const bool nok = nl < N;
#pragma unroll 8
    for (int i = 0; i < 32; ++i) { const int kk = 2 * i + (lane >> 5); scr[kk * 33 + (lane & 31)] = nok ? W[(size_t)(k0 + kk) * N + nl] : 0.f; }
    LDS_WAIT(); asm volatile("" ::: "memory");
    const int c = lane & 7;
#pragma unroll
    for (int j = 0; j < 4; ++j) { const int n = (lane >> 3) + 8 * j; const LAS float* s = scr + (8 * c) * 33 + n;
        v4u o; o.x = pk2(s[0 * 33], s[1 * 33]); o.y = pk2(s[2 * 33], s[3 * 33]); o.z = pk2(s[4 * 33], s[5 * 33]); o.w = pk2(s[6 * 33], s[7 * 33]);
        if (n0 + n < N) *(GAS v4u*)(WT + (size_t)rm(n0 + n) * K + k0 + 8 * c) = o; }
    LDS_WAIT(); asm volatile("" ::: "memory");
}
struct MapId { __device__ __forceinline__ int operator()(int n) const { return n; } };
struct MapGU { __device__ __forceinline__ int operator()(int n) const { const int up = n >= DFF, j = up ? n - DFF : n; return 256 * (j >> 7) + 128 * up + (j & 127); } };
struct MapIn { __device__ __forceinline__ int operator()(int n) const { return n < NGC ? n : n + (NNG - NGC); } };
template <class RowMap>
__device__ __forceinline__ void convert_matrix(Frame& F, const float* W, int K, int N, bf16* WT, RowMap rm) {
    LAS float* scr = (LAS float*)(F.lds + F.wave * 16384);
    const int gw = F.bid * NWAVES + F.wave, NGW = F.G * NWAVES, nitems = (K / 64) * ((N + 31) / 32);
    for (int it = gw; it < nitems; it += NGW) transpose_item(W, K, N, WT, scr, it, F.lane, rm);
}
__device__ __forceinline__ void phase_convert(Frame& F, int l) {
    unsigned char* wb = F.ws + WS_W;
    convert_matrix(F, FIN(F, I_F1GU) + (size_t)l * DM * NGU, DM, NGU, (bf16*)(wb + W_GU1), MapGU());
    convert_matrix(F, FIN(F, I_F1D) + (size_t)l * DFF * DM, DFF, DM, (bf16*)(wb + W_D1), MapId());
    convert_matrix(F, FIN(F, I_WIN) + (size_t)l * DM * INCOLS, DM, INCOLS, (bf16*)(wb + W_NG), MapIn());
    for (int m = 0; m < 4; ++m) convert_matrix(F, FIN(F, I_WBR) + ((size_t)l * 4 + m) * 512 * DM, 512, DM, (bf16*)(wb + W_BR) + (size_t)m * DM * 512, MapId());
    convert_matrix(F, FIN(F, I_WOUT) + (size_t)l * DM * DM, DM, DM, (bf16*)(wb + W_O), MapId());
    convert_matrix(F, FIN(F, I_F2GU) + (size_t)l * DM * NGU, DM, NGU, (bf16*)(wb + W_GU2), MapGU());
    convert_matrix(F, FIN(F, I_F2D) + (size_t)l * DFF * DM, DFF, DM, (bf16*)(wb + W_D2), MapId());
    { GAS v4u* z = (GAS v4u*)(wb + W_NG + (size_t)NGC * DM * 2); const int n16 = (NNG - NGC) * DM * 2 / 16;
      for (int i = F.bid * 512 + F.tid; i < n16; i += F.G * 512) z[i] = (v4u){0u, 0u, 0u, 0u}; }
    if (l == 0) {
        GAS f32x4* hm = (GAS f32x4*)(F.ws + WS_HM); const GAS f32x4* mt = (const GAS f32x4*)FIN(F, I_META);
        for (int i = F.bid * 512 + F.tid; i < 256 * DM / 4; i += F.G * 512) hm[i] = (i < NMETA * DM / 4) ? mt[i] : (f32x4){0.f, 0.f, 0.f, 0.f};
    }
}
__device__ __forceinline__ void phase_norm(Frame& F, const float* src_real, const float* gain) {
    const int gw = F.bid * NWAVES + F.wave, NGW = F.G * NWAVES;
    bf16* XN = (bf16*)(F.ws + WS_XN); const float* hm = (const float*)(F.ws + WS_HM);
    f32x4 g[8];
#pragma unroll
    for (int j = 0; j < 8; ++j) g[j] = ((const GAS f32x4*)gain)[F.lane + 64 * j];
    for (int r = gw; r < MPAD; r += NGW) {
        GAS v2u* o8 = (GAS v2u*)(XN + (size_t)r * DM) + F.lane;
        if (r >= MREAL + NMETA) {
#pragma unroll
            for (int j = 0; j < 8; ++j) o8[64 * j] = (v2u){0u, 0u};
            continue; }
        const float* xr = r < MREAL ? src_real + (size_t)r * DM : hm + (size_t)(r - MREAL) * DM;
        f32x4 v[8]; float s = 0.f;
#pragma unroll
        for (int j = 0; j < 8; ++j) { v[j] = ((const GAS f32x4*)xr)[F.lane + 64 * j]; s += (v[j].x * v[j].x + v[j].y * v[j].y) + (v[j].z * v[j].z + v[j].w * v[j].w); }
        const float inv = 1.0f / sqrtf(wave_sum(s) * (1.f / DM) + EPS);
#pragma unroll
        for (int j = 0; j < 8; ++j) { v2u w; w.x = pk2(v[j].x * inv * g[j].x, v[j].y * inv * g[j].y); w.y = pk2(v[j].z * inv * g[j].z, v[j].w * inv * g[j].w); o8[64 * j] = w; }
    }
}

__device__ __forceinline__ f32x4 meta_dot16(const bf16* A  , int lda, const bf16* Bt  , int K, int s0, int s1, int lane) {
    const int fr = lane & 15, g = lane >> 4; const bf16* ap = A + (size_t)fr * lda + 8 * g; const bf16* bp = Bt + (size_t)fr * K + 8 * g;
    f32x4 a0 = (f32x4){0.f, 0.f, 0.f, 0.f}, a1 = a0;
    for (int s = s0; s < s1; s += 2) {
        const bf16x8 x0 = *(const GAS bf16x8*)(ap + 32 * s), x1 = *(const GAS bf16x8*)(ap + 32 * s + 32);
        const bf16x8 w0 = *(const GAS bf16x8*)(bp + 32 * s), w1 = *(const GAS bf16x8*)(bp + 32 * s + 32);
        a0 = __builtin_amdgcn_mfma_f32_16x16x32_bf16(w0, x0, a0, 0, 0, 0); a1 = __builtin_amdgcn_mfma_f32_16x16x32_bf16(w1, x1, a1, 0, 0, 0); }
    return a0 + a1;
}
__device__ __forceinline__ void st_bf16x4(bf16* p, f32x4 v) { v2u w; w.x = pk2(v[0], v[1]); w.y = pk2(v[2], v[3]); *(GAS v2u*)p = w; }
__device__ __forceinline__ void meta_gemm(Frame& F, int kind, const bf16* A, int lda, const bf16* Bt, int N, int K, bf16* Obf, int ldo, float scale) {
    const int lane = F.lane, wave = F.wave, fr = lane & 15, g = lane >> 4;
    const int ngroups = (kind == 0 ? N / 2 : N) / 16;
    LAS f32x4* red = (LAS f32x4*)F.lds;
    const int ns = K / 32, s0 = (wave * ns) >> 3, s1 = ((wave + 1) * ns) >> 3;
    for (int cg = F.bid; cg < ngroups; cg += F.G) {
        const int n0 = 16 * cg;
        f32x4 p0, p1 = (f32x4){0.f, 0.f, 0.f, 0.f};
        if (kind == 0) { const int rg = 256 * (n0 >> 7) + (n0 & 127);
            p0 = meta_dot16(A, lda, Bt + (size_t)rg * K, K, s0, s1, lane); p1 = meta_dot16(A, lda, Bt + (size_t)(rg + 128) * K, K, s0, s1, lane); }
        else if (kind == 4) { const int mb = wave >> 1, kh = wave & 1; p0 = meta_dot16(A + (size_t)mb * MPAD * 512, 512, Bt + ((size_t)mb * DM + n0) * 512, 512, 8 * kh, 8 * kh + 8, lane); }
        else p0 = meta_dot16(A, lda, Bt + (size_t)n0 * K, K, s0, s1, lane);
        red[wave * 64 + lane] = p0; if (kind == 0) red[512 + wave * 64 + lane] = p1;
        LDS_WAIT(); __syncthreads();
        if (wave == 0) {
            f32x4 q[8];
#pragma unroll
            for (int w = 0; w < 8; ++w) q[w] = red[w * 64 + lane];
            if (kind == 4) { f32x4 tot = (f32x4){0.f, 0.f, 0.f, 0.f}; const bf16* G = (const bf16*)(F.ws + WS_BIG);
#pragma unroll
                for (int mb = 0; mb < 4; ++mb) { const f32x4 acc = q[2 * mb] + q[2 * mb + 1]; const v2u gw2 = *(const GAS v2u*)(G + (size_t)(MREAL + fr) * NGATE + mb * DM + n0 + 4 * g);
                    tot[0] += bflo(gw2.x) * acc[0]; tot[1] += bfhi(gw2.x) * acc[1]; tot[2] += bflo(gw2.y) * acc[2]; tot[3] += bfhi(gw2.y) * acc[3]; }
                st_bf16x4(Obf + (size_t)(MREAL + fr) * ldo + n0 + 4 * g, tot);
            } else {
                f32x4 acc = ((q[0] + q[1]) + (q[2] + q[3])) + ((q[4] + q[5]) + (q[6] + q[7]));
                if (kind == 0) { f32x4 up = (f32x4){0.f, 0.f, 0.f, 0.f};
#pragma unroll
                    for (int w = 0; w < 8; ++w) up += red[512 + w * 64 + lane];
#pragma unroll
                    for (int r = 0; r < 4; ++r) acc[r] = pg8::fast_silu(acc[r]) * up[r];
                    st_bf16x4(Obf + (size_t)(MREAL + fr) * ldo + n0 + 4 * g, acc); }
                else if (kind == 1) { float* hp = (float*)(F.ws + WS_HM) + (size_t)fr * DM + n0 + 4 * g; *(GAS f32x4*)hp = *(const GAS f32x4*)hp + acc * scale; }
                else if (kind == 2) st_bf16x4(Obf + (size_t)(MREAL + fr) * ldo + n0 + 4 * g, acc);
                else {
#pragma unroll
                    for (int r = 0; r < 4; ++r) acc[r] = pg8::fast_sigmoid(acc[r]);
                    st_bf16x4(Obf + (size_t)(MREAL + fr) * ldo + n0 + 4 * g, acc); }
            }
        }
        __syncthreads();
    }
}
__device__ __forceinline__ void unpack8(const v4u w, float (&x)[8]) { x[0] = bflo(w.x); x[1] = bfhi(w.x); x[2] = bflo(w.y); x[3] = bfhi(w.y); x[4] = bflo(w.z); x[5] = bfhi(w.z); x[6] = bflo(w.w); x[7] = bfhi(w.w); }
__device__ __forceinline__ v4u pack8(const float (&x)[8]) { v4u w; w.x = pk2(x[0], x[1]); w.y = pk2(x[2], x[3]); w.z = pk2(x[4], x[5]); w.w = pk2(x[6], x[7]); return w; }
template <int GL>
__device__ __forceinline__ void norm_cols_inplace(bf16* p, const v4u w, const float* gain, float scale, int lane, bool wr) {
    float x[8]; unpack8(w, x); float s = 0.f;
#pragma unroll
    for (int i = 0; i < 8; ++i) s += x[i] * x[i];
#pragma unroll
    for (int o = 1; o < GL; o <<= 1) s += __shfl_xor(s, o);
    const float inv = scale / sqrtf(s * (1.f / (GL * 8)) + EPS); const int g0 = (8 * lane) % (GL * 8);
#pragma unroll
    for (int i = 0; i < 8; ++i) x[i] = x[i] * inv * gain[g0 + i];
    if (wr) *(GAS v4u*)p = pack8(x);
}
__device__ __forceinline__ void prep_row(Frame& F, int l, int r) {
    const int lane = F.lane; bf16* pr = (bf16*)(F.ws + WS_BIG) + (size_t)r * NNG;
    const float *dqn = FIN(F, I_DQN) + l * 64, *dkn = FIN(F, I_DKN) + l * 64, *sqn = FIN(F, I_SQN) + l * 128, *skn = FIN(F, I_SKN) + l * 128;
    const v4u w0 = *(const GAS v4u*)(pr + C_CQ + 8 * lane), w1 = *(const GAS v4u*)(pr + C_CK + 8 * lane), w2 = *(const GAS v4u*)(pr + C_DQ + 8 * lane), w3 = *(const GAS v4u*)(pr + C_DK + 8 * (lane & 15));
    __builtin_amdgcn_sched_barrier(0);
    norm_cols_inplace<8>(pr + C_CQ + 8 * lane, w0, dqn, 0.125f * 1.4426950408889634f, lane, true);
    norm_cols_inplace<8>(pr + C_CK + 8 * lane, w1, dkn, 1.0f, lane, true);
    norm_cols_inplace<16>(pr + C_DQ + 8 * lane, w2, sqn, 0.08838834764831845f * 1.4426950408889634f, lane, true);
    norm_cols_inplace<16>(pr + C_DK + 8 * (lane & 15), w3, skn, 1.0f, lane & 15, lane < 16);
}
constexpr int VT_NPB = (LPAD + 63) / 64, VT_NTASK = NB * 5 * VT_NPB;
__device__ __forceinline__ void vt_task(Frame& F, int task) {
    const int lane = F.lane;
    const bf16* P = (const bf16*)(F.ws + WS_BIG); bf16* VtC = (bf16*)(F.ws + WS_VTC); bf16* VtD = (bf16*)(F.ws + WS_VTD);
    LAS bf16* T = (LAS bf16*)(F.lds + F.wave * 17408);
    const int pb = task % VT_NPB, mat = (task / VT_NPB) % 5, b = task / (VT_NPB * 5), p0 = 64 * pb;
    const int col = mat < 4 ? C_CV + 128 * mat : C_DV;
#pragma unroll 4
    for (int i = 0; i < 16; ++i) { const int pl = 4 * i + (lane >> 4), p = p0 + pl;
        v4u w = *(const GAS v4u*)(P + (size_t)seqrow(b, p < LSEQ ? p : LSEQ - 1) * NNG + col + 8 * (lane & 15)); if (p >= LSEQ) w = (v4u){0u, 0u, 0u, 0u};
        *(LAS v4u*)(T + pl * 136 + 8 * (lane & 15)) = w; }
    LDS_WAIT(); asm volatile("" ::: "memory");
    bf16* dst = mat < 4 ? VtC + (size_t)(b * 4 + mat) * 128 * LPAD : VtD + (size_t)b * 128 * LPAD;
#pragma unroll 4
    for (int it = 0; it < 16; ++it) { const int e = 8 * it + (lane >> 3), c = lane & 7; unsigned short x[8];
#pragma unroll
        for (int k = 0; k < 8; ++k) x[k] = T[(8 * c + k) * 136 + e];
        v4u w; w.x = x[0] | ((unsigned)x[1] << 16); w.y = x[2] | ((unsigned)x[3] << 16); w.z = x[4] | ((unsigned)x[5] << 16); w.w = x[6] | ((unsigned)x[7] << 16);
        if (p0 + 8 * c < LPAD) *(GAS v4u*)(dst + (size_t)e * LPAD + p0 + 8 * c) = w; }
    LDS_WAIT(); asm volatile("" ::: "memory");
}

#define NEG_INF (-__builtin_inff())
constexpr int NQT = (LSEQ + 31) / 32;
constexpr int NQB = (NQT + 7) / 8;
__device__ __forceinline__ bf16x8 ld_frag16(const bf16* p) { return *(const GAS bf16x8*)p; }
__device__ __forceinline__ bf16x8 mk_frag(v2u lo, v2u hi) { v4u w; w.x = lo.x; w.y = lo.y; w.z = hi.x; w.w = hi.y; return __builtin_bit_cast(bf16x8, w); }
__device__ __forceinline__ unsigned cvtpk(float lo, float hi) { return pg8::cvt_pk_bf16(lo, hi); }
__device__ __forceinline__ void build_bias_table(Frame& F, LAS float* bt, int col0) {
    const float* rb = FIN(F, I_RELB);
    for (int i = F.tid; i < 4 * 128; i += 512) { const int hd = i >> 7, n = i & 127; bt[i] = (rb[rel_bucket(n) * 8 + col0 + hd] - rb[31 * 8 + col0 + hd]) * 1.4426950408889634f; }
}
__device__ __forceinline__ bool softmax_step(f32x16& S, float& m, float& lsum, float& alpha) {
    float tm = S[0];
#pragma unroll
    for (int r = 1; r < 16; ++r) tm = fmaxf(tm, S[r]);
    tm = fmaxf(tm, __shfl_xor(tm, 32));
    const bool raise = __any(tm > m + 11.5f);
    alpha = 1.0f;
    if (raise) { const float mn = fmaxf(m, tm); alpha = (mn == NEG_INF) ? 1.0f : __builtin_amdgcn_exp2f(m - mn); m = mn; lsum *= alpha; }
    const float mref = (m == NEG_INF) ? 0.f : m;
    float rs = 0.f;
#pragma unroll
    for (int r = 0; r < 16; ++r) { S[r] = __builtin_amdgcn_exp2f(S[r] - mref); rs += S[r]; }
    rs += __shfl_xor(rs, 32);
    lsum += rs;
    return raise;
}
template <bool DSA>
__device__ __forceinline__ void attn_wg_task(Frame& F, int l, int b, int h, int J, const LAS float* bt, float lam, float post) {
    constexpr int KD = DSA ? 128 : 64, KP = KD + 8, VP = 36, NKS = KD / 16;
    constexpr int KBUF = 32 * KP, VBUF = 128 * VP;
    const int lane = F.lane, ql = lane & 31, hh = lane >> 5, wave = F.wave, tid = F.tid;
    LAS bf16* Kl = (LAS bf16*)F.lds; LAS bf16* Vl = Kl + 2 * KBUF;
    const bf16* P = (const bf16*)(F.ws + WS_BIG);
    const bf16* Vt = DSA ? (const bf16*)(F.ws + WS_VTD) + (size_t)b * 128 * LPAD : (const bf16*)(F.ws + WS_VTC) + (size_t)(b * 4 + h) * 128 * LPAD;
    const int jr = 8 * J + wave - 7; const bool wvalid = jr >= 0 && 32 * jr < LSEQ; const int j = jr < 0 ? 0 : jr;
    const int ktmax = (8 * J < NQT - 1) ? 8 * J : NQT - 1;
    const int pq = 32 * j + ql, pqc = pq < LSEQ ? pq : LSEQ - 1;
    const bf16* qrow = P + (size_t)seqrow(b, pqc) * NNG + (DSA ? C_DQ : C_CQ) + h * 128 + 8 * hh;
    const unsigned* mrow = (const unsigned*)(F.ws + WS_MASK) + ((size_t)b * LPAD + pqc) * MASKW;
    const int kr = tid / (KD / 8), kc = tid % (KD / 8); const bool kload = tid < 32 * (KD / 8);
    const int vr = tid >> 2, vc = tid & 3;
    f32x16 R[4];
#pragma unroll
    for (int c = 0; c < (DSA ? 1 : 2); ++c) {
        const int kcol = DSA ? C_DK : C_CK + h * 128 + c * 64;
        bf16x8 qf[NKS];
#pragma unroll
        for (int ks = 0; ks < NKS; ++ks) qf[ks] = ld_frag16(qrow + (DSA ? 0 : c * 64) + 16 * ks);
        float m = NEG_INF, lsum = 0.f; f32x16 O[4];
#pragma unroll
        for (int eb = 0; eb < 4; ++eb)
#pragma unroll
            for (int r = 0; r < 16; ++r) O[eb][r] = 0.f;
        v4u rk0 = (v4u){0u, 0u, 0u, 0u}, rv0 = rk0, rk1 = rk0, rv1 = rk0;
#define ATT_ISSUE(kt_, RK, RV) do { int pk_ = 32 * (kt_) + kr; pk_ = pk_ < LSEQ ? pk_ : LSEQ - 1; \
            if (kload) RK = *(const GAS v4u*)(P + (size_t)seqrow(b, pk_) * NNG + kcol + 8 * kc); \
            RV = *(const GAS v4u*)(Vt + (size_t)vr * LPAD + 32 * (kt_) + 8 * vc); } while (0)
#define ATT_COMMIT(buf_, RK, RV) do { if (kload) *(LAS v4u*)(Kl + (buf_) * KBUF + kr * KP + 8 * kc) = RK; \
            LAS v2u* vd_ = (LAS v2u*)(Vl + (buf_) * VBUF + vr * VP + 8 * vc); vd_[0] = (v2u){RV.x, RV.y}; vd_[1] = (v2u){RV.z, RV.w}; } while (0)
        unsigned mwc = 0xffffffffu, mwn = 0xffffffffu; if (DSA) mwc = mrow[0];
        auto compute = [&](int kt, int buf) {
            if (DSA) mwn = mrow[kt + 1 <= ktmax ? kt + 1 : ktmax];
            if (wvalid && kt <= j) {
                const LAS bf16* Kt = Kl + buf * KBUF + ql * KP + 8 * hh; const LAS bf16* Vb = Vl + buf * VBUF + ql * VP + 4 * hh;
                f32x16 S;
#pragma unroll
                for (int r = 0; r < 16; ++r) S[r] = 0.f;
#pragma unroll
                for (int ks = 0; ks < NKS; ++ks) S = __builtin_amdgcn_mfma_f32_32x32x16_bf16(*(const LAS bf16x8*)(Kt + 16 * ks), qf[ks], S, 0, 0, 0);
                const unsigned mw = mwc >> (4 * hh);
                if (kt + 4 >= j) {
#pragma unroll
                    for (int r = 0; r < 16; ++r) { const int ko = (r & 3) + 8 * (r >> 2), n = pq - (32 * kt + 4 * hh + ko); const bool sel = ((mw >> ko) & 1u) && n >= 0;
                        S[r] = sel ? S[r] + bt[h * 128 + (n < 127 ? n : 127)] : NEG_INF; }
                } else if (DSA) {
#pragma unroll
                    for (int r = 0; r < 16; ++r) { const int ko = (r & 3) + 8 * (r >> 2); S[r] = ((mw >> ko) & 1u) ? S[r] : NEG_INF; }
                }
                float alpha;
                if (softmax_step(S, m, lsum, alpha)) {
#pragma unroll
                    for (int eb = 0; eb < 4; ++eb)
#pragma unroll
                        for (int r = 0; r < 16; ++r) O[eb][r] *= alpha;
                }
                bf16x8 pf[2];
#pragma unroll
                for (int s = 0; s < 2; ++s) { v4u w; w.x = cvtpk(S[8 * s + 0], S[8 * s + 1]); w.y = cvtpk(S[8 * s + 2], S[8 * s + 3]); w.z = cvtpk(S[8 * s + 4], S[8 * s + 5]); w.w = cvtpk(S[8 * s + 6], S[8 * s + 7]); pf[s] = __builtin_bit_cast(bf16x8, w); }
#pragma unroll
                for (int eb = 0; eb < 4; ++eb)
#pragma unroll
                    for (int s = 0; s < 2; ++s) { const LAS bf16* vp = Vb + eb * 32 * VP + 16 * s;
                        O[eb] = __builtin_amdgcn_mfma_f32_32x32x16_bf16(mk_frag(*(const LAS v2u*)vp, *(const LAS v2u*)(vp + 8)), pf[s], O[eb], 0, 0, 0); }
            }
            if (DSA) mwc = mwn; };
        __syncthreads();
        ATT_ISSUE(0, rk0, rv0); ATT_COMMIT(0, rk0, rv0);
        if (ktmax >= 1) ATT_ISSUE(1, rk1, rv1);
        for (int kt = 0; kt <= ktmax; kt += 2) {
            LDS_WAIT(); __syncthreads();
            if (kt + 2 <= ktmax) ATT_ISSUE(kt + 2, rk0, rv0);
            compute(kt, 0);
            if (kt + 1 <= ktmax) ATT_COMMIT(1, rk1, rv1);
            if (kt + 1 > ktmax) break;
            LDS_WAIT(); __syncthreads();
            if (kt + 3 <= ktmax) ATT_ISSUE(kt + 3, rk1, rv1);
            compute(kt + 1, 1);
            if (kt + 2 <= ktmax) ATT_COMMIT(0, rk0, rv0);
        }
#undef ATT_ISSUE
#undef ATT_COMMIT
        const float il = 1.0f / lsum;
        if (DSA) {
#pragma unroll
            for (int eb = 0; eb < 4; ++eb)
#pragma unroll
                for (int r = 0; r < 16; ++r) R[eb][r] = O[eb][r] * il;
        } else if (c == 0) {
            LAS unsigned* rp = (LAS unsigned*)(F.lds + 28672) + wave * 2048 + lane;
#pragma unroll
            for (int eb = 0; eb < 4; ++eb)
#pragma unroll
                for (int r = 0; r < 16; r += 2) rp[(eb * 8 + (r >> 1)) * 64] = pk2(O[eb][r] * il, O[eb][r + 1] * il);
        } else {
            const LAS unsigned* rp = (const LAS unsigned*)(F.lds + 28672) + wave * 2048 + lane;
#pragma unroll
            for (int eb = 0; eb < 4; ++eb)
#pragma unroll
                for (int r = 0; r < 16; r += 2) { const unsigned w = rp[(eb * 8 + (r >> 1)) * 64]; R[eb][r] = bflo(w) - lam * (O[eb][r] * il); R[eb][r + 1] = bfhi(w) - lam * (O[eb][r + 1] * il); }
        }
    }
    float inv = 1.0f;
    if (!DSA) { float ss = 0.f;
#pragma unroll
        for (int eb = 0; eb < 4; ++eb)
#pragma unroll
            for (int r = 0; r < 16; ++r) ss += R[eb][r] * R[eb][r];
        ss += __shfl_xor(ss, 32); inv = post / sqrtf(ss * (1.f / 128.f) + EPS); }
    const float* sub = FIN(F, I_DSUB) + l * 128;
    if (wvalid && pq < LSEQ && (pq >= NMETA || b == 0)) {
        bf16* orow = (bf16*)(F.ws + WS_BR) + (size_t)(DSA ? 3 : 2) * MPAD * 512 + (size_t)seqrow(b, pq) * 512 + h * 128;
#pragma unroll
        for (int eb = 0; eb < 4; ++eb)
#pragma unroll
            for (int g = 0; g < 4; ++g) { const int e0 = 32 * eb + 8 * g + 4 * hh; f32x4 sv = (f32x4){1.f, 1.f, 1.f, 1.f}; if (!DSA) sv = *(const GAS f32x4*)(sub + e0);
                v2u w; w.x = pk2(R[eb][4 * g] * inv * sv.x, R[eb][4 * g + 1] * inv * sv.y); w.y = pk2(R[eb][4 * g + 2] * inv * sv.z, R[eb][4 * g + 3] * inv * sv.w);
                *(GAS v2u*)(orow + e0) = w; }
    }
}
__device__ __forceinline__ unsigned f32_key(float f) { const unsigned u = __float_as_uint(f); return u ^ ((u >> 31) ? 0xffffffffu : 0x80000000u); }
__device__ __forceinline__ void dsa_index_task(Frame& F, int b, int j, float* slab) {
    const int lane = F.lane, ql = lane & 31, hh = lane >> 5, wave = F.wave;
    const bf16* P = (const bf16*)(F.ws + WS_BIG);
    LAS unsigned char* qi = F.lds;
    for (int i = F.tid; i < 32 * 128; i += 512) { const int q = i >> 7, ch = i & 127; int pq = 32 * j + q; pq = pq < LSEQ ? pq : LSEQ - 1;
        *(LAS v4u*)(qi + q * 2064 + 16 * ch) = *(const GAS v4u*)(P + (size_t)seqrow(b, pq) * NNG + C_DQI + 8 * ch); }
    LAS float* wl = (LAS float*)(qi + 32 * 2064);
    if (F.tid < 32 * 16) { const int q = F.tid >> 4, hd = F.tid & 15; int pq = 32 * j + q; pq = pq < LSEQ ? pq : LSEQ - 1;
        wl[F.tid] = bf2f(P[(size_t)seqrow(b, pq) * NNG + C_DW + hd]) * 0.03125f; }
    LDS_WAIT(); __syncthreads();
#ifndef PROBE_SUB
#define PROBE_SUB 0
#endif
    for (int rpa = 0; rpa < ((PROBE_SUB & 8) ? 2 : 1); ++rpa)
    {
    bf16x8 kn[4];
    { const int pk = 32 * wave + ql, pkc = pk < LSEQ ? pk : LSEQ - 1; const bf16* krow = P + (size_t)seqrow(b, pkc) * NNG + C_DKI + 8 * hh;
#pragma unroll
      for (int ks = 0; ks < 4; ++ks) kn[ks] = ld_frag16(krow + 16 * ks); }
    for (int kt = wave; kt <= j; kt += NWAVES) {
        bf16x8 kf[4];
#pragma unroll
        for (int ks = 0; ks < 4; ++ks) kf[ks] = kn[ks];
        { const int ktn = kt + NWAVES <= j ? kt + NWAVES : kt; const int pk = 32 * ktn + ql, pkc = pk < LSEQ ? pk : LSEQ - 1; const bf16* krow = P + (size_t)seqrow(b, pkc) * NNG + C_DKI + 8 * hh;
#pragma unroll
          for (int ks = 0; ks < 4; ++ks) kn[ks] = ld_frag16(krow + 16 * ks); }
        f32x16 idx;
#pragma unroll
        for (int r = 0; r < 16; ++r) idx[r] = 0.f;
#pragma unroll 1
        for (int hd = 0; hd < 16; hd += 2) { f32x16 S0, S1; const float wh0 = wl[ql * 16 + hd], wh1 = wl[ql * 16 + hd + 1];
#pragma unroll
            for (int r = 0; r < 16; ++r) { S0[r] = 0.f; S1[r] = 0.f; }
#pragma unroll
            for (int ks = 0; ks < 4; ++ks) { S0 = __builtin_amdgcn_mfma_f32_32x32x16_bf16(kf[ks], *(const LAS bf16x8*)(qi + ql * 2064 + hd * 128 + 32 * ks + 16 * hh), S0, 0, 0, 0);
                S1 = __builtin_amdgcn_mfma_f32_32x32x16_bf16(kf[ks], *(const LAS bf16x8*)(qi + ql * 2064 + (hd + 1) * 128 + 32 * ks + 16 * hh), S1, 0, 0, 0); }
#pragma unroll
            for (int r = 0; r < 16; ++r) idx[r] += wh0 * fmaxf(S0[r], 0.f) + wh1 * fmaxf(S1[r], 0.f); }
        float* srow = slab + (size_t)ql * LPAD + 32 * kt + 4 * hh;
#pragma unroll
        for (int g = 0; g < 4; ++g) *(GAS f32x4*)(srow + 8 * g) = (f32x4){idx[4 * g], idx[4 * g + 1], idx[4 * g + 2], idx[4 * g + 3]};
    }
    }
    VM_WAIT(); __syncthreads();
    for (int rpb = 0; rpb < ((PROBE_SUB & 16) ? 2 : 1); ++rpb)
    for (int qq = wave; qq < 32; qq += NWAVES) {
        const int p = 32 * j + qq; if (p >= LSEQ) break;
        const float* row = slab + (size_t)qq * LPAD;
        unsigned u[65];
        { const GAS unsigned* rp = (const GAS unsigned*)row + lane;
#pragma unroll
          for (int i = 0; i < 65; ++i) u[i] = rp[64 * i];
          __builtin_amdgcn_sched_barrier(0);
#pragma unroll
          for (int i = 0; i < 65; ++i) { const unsigned k = f32_key(__uint_as_float(u[i])) >> 1; u[i] = (64 * i + lane <= p) ? k : 0u; } }
        auto wsum = [&](unsigned c) { unsigned s = 0;
#pragma unroll
            for (int k = 0; k < 7; ++k) s += (unsigned)__builtin_popcountll(__ballot((c >> k) & 1u)) << k;
            return s; };
        unsigned T = 1u;
        if (p + 1 > 256) { T = 0u;
            for (int bit = 30; bit >= 15; --bit) { const unsigned cm1 = (T | (1u << bit)) - 1u; unsigned c = 0;
#pragma unroll
                for (int i = 0; i < 65; ++i) c += (cm1 - u[i]) >> 31;
                if (wsum(c) >= 256u) T |= 1u << bit; }
            const unsigned tm1 = T - 1u, hm1 = T + 0x7fffu; unsigned ca = 0, cb = 0;
#pragma unroll
            for (int i = 0; i < 65; ++i) { ca += (hm1 - u[i]) >> 31; cb += ((tm1 - u[i]) ^ (hm1 - u[i])) >> 31; }
            const unsigned above = wsum(ca), inb = wsum(cb), need = 256u - above;
            if (inb <= 64u) {
                LAS unsigned* band = (LAS unsigned*)(F.lds + 68096) + wave * 64;
                unsigned off = 0;
#pragma unroll
                for (int k = 0; k < 7; ++k) { const unsigned long long bal = __ballot((cb >> k) & 1u); off += __builtin_amdgcn_mbcnt_hi((unsigned)(bal >> 32), __builtin_amdgcn_mbcnt_lo((unsigned)bal, 0u)) << k; }
#pragma unroll
                for (int i = 0; i < 65; ++i) { if (u[i] >= T && u[i] <= hm1) { band[off] = u[i]; ++off; } }
                LDS_WAIT();
                const unsigned mine = lane < (int)inb ? band[lane] : 0u; unsigned ge = 0, gt = 0;
                for (unsigned k = 0; k < inb; ++k) { const unsigned v = band[k]; ge += (mine - 1u - v) >> 31; gt += (mine - v) >> 31; }
                const unsigned long long okb = __ballot(lane < (int)inb && ge >= need && gt < need);
                T = __builtin_amdgcn_readlane(mine, (int)__builtin_ctzll(okb | (1ull << 63)));
                LDS_WAIT();
            } else {
                for (int bit = 14; bit >= 0; --bit) { const unsigned cm1 = (T | (1u << bit)) - 1u; unsigned c = 0;
#pragma unroll
                    for (int i = 0; i < 65; ++i) c += (cm1 - u[i]) >> 31;
                    if (wsum(c) >= 256u) T |= 1u << bit; } } }
        unsigned long long* mrow = (unsigned long long*)((unsigned*)(F.ws + WS_MASK) + ((size_t)b * LPAD + p) * MASKW);
        unsigned wlo = 0u, whi = 0u;
#pragma unroll
        for (int i = 0; i < 64; ++i) { const unsigned long long bal = __ballot(u[i] >= T); if (lane == i) { wlo = (unsigned)bal; whi = (unsigned)(bal >> 32); } }
        const unsigned long long b64 = __ballot(u[64] >= T);
        mrow[lane] = ((unsigned long long)whi << 32) | wlo; if (lane == 0) mrow[64] = b64;
    }
    __syncthreads();
}
struct HgChunk { bf16* base; int pitch; int cq, ck, cv; bf16* A; float* dl; };
__device__ __forceinline__ HgChunk hg_chunk(Frame& F, int b, int h, int c) {
    HgChunk k;
    if (c == 0) { unsigned char* mp = F.ws + WS_HMETA + (size_t)h * HMETA_STRIDE; k.base = (bf16*)mp; k.pitch = 384; k.cq = 0; k.ck = 128; k.cv = 256; k.A = (bf16*)(mp + 64 * 384 * 2); k.dl = (float*)(mp + 64 * 384 * 2 + 64 * 64 * 2); }
    else { const size_t ci = (size_t)(b * 4 + h) * 64 + (c - 1); k.base = (bf16*)(F.ws + WS_BIG) + (size_t)(b * SEQ + 64 * (c - 1)) * NNG; k.pitch = NNG; k.cq = C_AQ + h * 128; k.ck = C_AF + h * 128; k.cv = C_AI + h * 128;
        k.A = (bf16*)(F.ws + WS_HA) + ci * 64 * 64; k.dl = (float*)(F.ws + WS_HDL) + ci * 128; }
    return k;
}
__device__ __forceinline__ void hgrn_prep_task(Frame& F, int l, int b, int h, int c) {
    const int d = F.tid & 127, tq = F.tid >> 7, lane = F.lane, wave = F.wave;
    const bf16* P = (const bf16*)(F.ws + WS_BIG);
    LAS bf16* Qt = (LAS bf16*)F.lds; LAS bf16* Kt = Qt + 64 * 136; LAS float* part = (LAS float*)(F.lds + 2 * 64 * 136 * 2);
    const HgChunk ch = hg_chunk(F, b, h, c);
    float lb = 0.f; if (l == 1) { const float a = FIN(F, I_LB)[h * 128 + d], cc = FIN(F, I_LB)[512 + h * 128 + d]; lb = 1.0f / (1.0f + __expf(a - cc)); }
    const bool meta = (c == 0);
    unsigned short zr[16], qr[16], vr[16];
    { const int r0 = meta ? MREAL : b * SEQ + 64 * (c - 1);
#pragma unroll
      for (int i = 0; i < 16; ++i) { int t = 16 * tq + i; if (meta) t = t < NMETA ? t : NMETA - 1; const bf16* pr = P + (size_t)(r0 + t) * NNG + h * 128 + d; zr[i] = pr[C_AF]; qr[i] = pr[C_AQ]; vr[i] = pr[C_AI]; }
      __builtin_amdgcn_sched_barrier(0); }
    float lfv[16];
    float run = 0.f;
#pragma unroll
    for (int i = 0; i < 16; ++i) { const bool valid = !meta || (16 * tq + i < NMETA); const float z = bf2f(zr[i]); const float sg = 1.0f / (1.0f + __expf(-z));
        lfv[i] = valid ? __logf(lb + (1.0f - lb) * sg) : 0.f; run += lfv[i]; }
    part[tq * 128 + d] = run;
    LDS_WAIT(); __syncthreads();
    const float p0 = part[d], p1 = part[128 + d], p2 = part[256 + d], p3 = part[384 + d];
    const float off = (tq > 0 ? p0 : 0.f) + (tq > 1 ? p1 : 0.f) + (tq > 2 ? p2 : 0.f), bmid = p0 + p1, blast = (p0 + p1) + (p2 + p3);
    unsigned kb[8], vb[8]; unsigned short qb[16];
    float bt = off;
#pragma unroll
    for (int i = 0; i < 16; i += 2) { float kbar[2], vv[2];
#pragma unroll
        for (int u = 0; u < 2; ++u) { const int t = 16 * tq + i + u; const bool valid = !meta || (t < NMETA);
            const float lf = lfv[i + u]; const float q = bf2f(qr[i + u]);
            const float kk = valid ? 1.0f - __expf(lf) : 0.f, qq = valid ? q / (1.0f + __expf(-q)) : 0.f; vv[u] = valid ? bf2f(vr[i + u]) : 0.f;
            bt += lf;
            kbar[u] = kk * __expf(blast - bt); qb[i + u] = (unsigned short)f2bf_s(qq * __expf(bt));
            const float qt = qq * __expf(fminf(bt - bmid, 80.f)), kt = kk * __expf(fminf(bmid - bt, 80.f));
            Qt[t * 136 + d] = (bf16)f2bf_s(qt); Kt[t * 136 + d] = (bf16)f2bf_s(kt); }
        kb[i >> 1] = pk2(kbar[0], kbar[1]); vb[i >> 1] = pk2(vv[0], vv[1]); }
    asm volatile("s_waitcnt vmcnt(0)" ::: "memory"); __syncthreads();
#pragma unroll
    for (int i = 0; i < 16; ++i) ch.base[(size_t)(16 * tq + i) * ch.pitch + ch.cq + d] = qb[i];
    { bf16* kd = ch.base + (size_t)(d >> 1) * ch.pitch + ch.ck + (d & 1) * 64 + 16 * tq; bf16* vd = ch.base + (size_t)(d >> 1) * ch.pitch + ch.cv + (d & 1) * 64 + 16 * tq;
      *(GAS v4u*)kd = (v4u){kb[0], kb[1], kb[2], kb[3]}; *(GAS v4u*)(kd + 8) = (v4u){kb[4], kb[5], kb[6], kb[7]};
      *(GAS v4u*)vd = (v4u){vb[0], vb[1], vb[2], vb[3]}; *(GAS v4u*)(vd + 8) = (v4u){vb[4], vb[5], vb[6], vb[7]}; }
    if (tq == 0) ch.dl[d] = __expf(blast);
    LDS_WAIT(); __syncthreads();
    { const int mt = wave >> 1, fr = lane & 15, g = lane >> 4;
#pragma unroll
      for (int u = 0; u < 2; ++u) { const int nt = 2 * (wave & 1) + u; f32x4 acc = (f32x4){0.f, 0.f, 0.f, 0.f};
        if (nt <= mt) {
#pragma unroll
            for (int ks = 0; ks < 4; ++ks) acc = __builtin_amdgcn_mfma_f32_16x16x32_bf16(*(const LAS bf16x8*)(Qt + (16 * mt + fr) * 136 + 32 * ks + 8 * g), *(const LAS bf16x8*)(Kt + (16 * nt + fr) * 136 + 32 * ks + 8 * g), acc, 0, 0, 0);
        }
#pragma unroll
        for (int r = 0; r < 4; ++r) { const int t = 16 * mt + 4 * g + r, s = 16 * nt + fr; ch.A[t * 64 + s] = (bf16)f2bf_s(s <= t ? acc[r] : 0.f); } } }
    __syncthreads();
}
__device__ __forceinline__ void hgrn_scan_unit(Frame& F, int l, int b, int h) {
    const int lane = F.lane, wave = F.wave, fr = lane & 15, g = lane >> 4, tid = F.tid;
    constexpr int QP = 136, AP = 72, KP = 72, GP = 136;
    constexpr int BUF = (64 * QP + 64 * AP + 128 * KP + 64 * GP) * 2 + 512;
    LAS float* red = (LAS float*)(F.lds + 2 * BUF);
    const int dv = 16 * wave + fr;
    const float gn = FIN(F, I_GN)[l * 512 + h * 128 + dv];
    const bf16* Pg = (const bf16*)(F.ws + WS_BIG) + C_AG + h * 128;
    f32x4 S[8];
#pragma unroll
    for (int mt = 0; mt < 8; ++mt) S[mt] = (f32x4){0.f, 0.f, 0.f, 0.f};
    v4u rq[2], ra, rk[2], rg[2], rd; bf16x8 bv0, bv1, bn0, bn1;
#define HG_ISSUE(c_, B0, B1) do { const HgChunk ch_ = hg_chunk(F, b, h, (c_)); const int nv_ = ((c_) == 0) ? NMETA : 64; \
        _Pragma("unroll") for (int i = 0; i < 2; ++i) { const int idx = tid + 512 * i, row = idx >> 4, c16 = idx & 15; \
            rq[i] = *(const GAS v4u*)(ch_.base + (size_t)row * ch_.pitch + ch_.cq + 8 * c16); rk[i] = *(const GAS v4u*)(ch_.base + (size_t)row * ch_.pitch + ch_.ck + 8 * c16); \
            rg[i] = (v4u){0u, 0u, 0u, 0u}; if (row < nv_) rg[i] = *(const GAS v4u*)(Pg + (size_t)(((c_) == 0) ? MREAL + row : b * SEQ + 64 * ((c_) - 1) + row) * NNG + 8 * c16); } \
        ra = *(const GAS v4u*)(ch_.A + 8 * tid); if (tid < 32) rd = *(const GAS v4u*)(ch_.dl + 4 * tid); \
        const bf16* vrow_ = ch_.base + (size_t)(dv >> 1) * ch_.pitch + ch_.cv + (dv & 1) * 64 + 8 * g; B0 = ld_frag16(vrow_); B1 = ld_frag16(vrow_ + 32); } while (0)
#define HG_COMMIT(buf_) do { LAS bf16* Q_ = (LAS bf16*)(F.lds + (buf_) * BUF); LAS bf16* A_ = Q_ + 64 * QP; LAS bf16* KT_ = A_ + 64 * AP; LAS bf16* G_ = KT_ + 128 * KP; \
        _Pragma("unroll") for (int i = 0; i < 2; ++i) { const int idx = tid + 512 * i, row = idx >> 4, c16 = idx & 15; *(LAS v4u*)(Q_ + row * QP + 8 * c16) = rq[i]; \
            *(LAS v4u*)(KT_ + (2 * row + (c16 >> 3)) * KP + 8 * (c16 & 7)) = rk[i]; *(LAS v4u*)(G_ + row * GP + 8 * c16) = rg[i]; } \
        *(LAS v4u*)(A_ + (tid >> 3) * AP + 8 * (tid & 7)) = ra; if (tid < 32) *(LAS v4u*)((LAS unsigned char*)(G_ + 64 * GP) + 16 * tid) = rd; } while (0)
    HG_ISSUE(0, bv0, bv1); HG_COMMIT(0);
    for (int c = 0; c <= 64; ++c) {
        const int buf = c & 1;
        LDS_WAIT(); __syncthreads();
        if (c < 64) HG_ISSUE(c + 1, bn0, bn1);
        LAS bf16* Q = (LAS bf16*)(F.lds + buf * BUF); LAS bf16* A = Q + 64 * QP; LAS bf16* KT = A + 64 * AP; LAS bf16* G = KT + 128 * KP; const LAS float* DL = (const LAS float*)(G + 64 * GP);
        f32x4 o[4];
#pragma unroll
        for (int mt = 0; mt < 4; ++mt) o[mt] = (f32x4){0.f, 0.f, 0.f, 0.f};
#pragma unroll
        for (int ks = 0; ks < 4; ++ks) { v4u w; w.x = cvtpk(S[2 * ks][0], S[2 * ks][1]); w.y = cvtpk(S[2 * ks][2], S[2 * ks][3]); w.z = cvtpk(S[2 * ks + 1][0], S[2 * ks + 1][1]); w.w = cvtpk(S[2 * ks + 1][2], S[2 * ks + 1][3]);
            const bf16x8 sb = __builtin_bit_cast(bf16x8, w);
#pragma unroll
            for (int mt = 0; mt < 4; ++mt) { const LAS bf16* qp = Q + (16 * mt + fr) * QP + 32 * ks + 4 * g;
                const bf16x8 af = mk_frag(*(const LAS v2u*)qp, *(const LAS v2u*)(qp + 16));
                o[mt] = __builtin_amdgcn_mfma_f32_16x16x32_bf16(af, sb, o[mt], 0, 0, 0); } }
#pragma unroll
        for (int mt = 0; mt < 4; ++mt) { o[mt] = __builtin_amdgcn_mfma_f32_16x16x32_bf16(*(const LAS bf16x8*)(A + (16 * mt + fr) * AP + 8 * g), bv0, o[mt], 0, 0, 0);
            o[mt] = __builtin_amdgcn_mfma_f32_16x16x32_bf16(*(const LAS bf16x8*)(A + (16 * mt + fr) * AP + 32 + 8 * g), bv1, o[mt], 0, 0, 0); }
#pragma unroll
        for (int mt = 0; mt < 8; ++mt) { const f32x4 dl = *(const LAS f32x4*)(DL + 16 * mt + 4 * g); S[mt] = S[mt] * dl;
            S[mt] = __builtin_amdgcn_mfma_f32_16x16x32_bf16(*(const LAS bf16x8*)(KT + (16 * mt + fr) * KP + 8 * g), bv0, S[mt], 0, 0, 0);
            S[mt] = __builtin_amdgcn_mfma_f32_16x16x32_bf16(*(const LAS bf16x8*)(KT + (16 * mt + fr) * KP + 32 + 8 * g), bv1, S[mt], 0, 0, 0); }
#pragma unroll
        for (int mt = 0; mt < 4; ++mt)
#pragma unroll
            for (int r = 0; r < 4; ++r) { float s2 = o[mt][r] * o[mt][r]; s2 += __shfl_xor(s2, 1); s2 += __shfl_xor(s2, 2); s2 += __shfl_xor(s2, 4); s2 += __shfl_xor(s2, 8);
                if (fr == 0) red[wave * 64 + 16 * mt + 4 * g + r] = s2; }
        LDS_WAIT(); __syncthreads();
        const int nvalid = (c == 0) ? NMETA : 64;
#pragma unroll
        for (int mt = 0; mt < 4; ++mt)
#pragma unroll
            for (int r = 0; r < 4; ++r) { const int t = 16 * mt + 4 * g + r; float tot = 0.f;
#pragma unroll
                for (int w = 0; w < 8; ++w) tot += red[w * 64 + t];
                if (t < nvalid && (c > 0 || b == 0)) { const int row = (c == 0) ? MREAL + t : b * SEQ + 64 * (c - 1) + t;
                    const float gr = bf2f(G[t * GP + dv]);
                    const float val = o[mt][r] * (1.0f / sqrtf(tot * (1.f / 128.f) + EPS)) * gn * (gr / (1.0f + __expf(-gr)));
                    ((bf16*)(F.ws + WS_BR))[(size_t)row * 512 + h * 128 + dv] = (bf16)f2bf_s(val); } }
        if (c < 64) { HG_COMMIT(buf ^ 1); bv0 = bn0; bv1 = bn1; }
    }
#undef HG_ISSUE
#undef HG_COMMIT
    __syncthreads();
}
__device__ __forceinline__ void conv_row(Frame& F, int l, int r) {
    const int lane = F.lane; const bf16* P = (const bf16*)(F.ws + WS_BIG);
    int r1, r2;
    if (r < MREAL) { const int b = r >> 12, t = r & 4095; r1 = seqrow(b, NMETA + t - 1); r2 = seqrow(b, NMETA + t - 2); }
    else { const int i = r - MREAL; r1 = i >= 1 ? r - 1 : -1; r2 = i >= 2 ? r - 2 : -1; }
    const float* cw = FIN(F, I_CONVW) + l * 3 * 512 + 8 * lane;
    const int r1c = r1 >= 0 ? r1 : r, r2c = r2 >= 0 ? r2 : r;
    const v4u wc0 = *(const GAS v4u*)(P + (size_t)r * NNG + C_BC + 8 * lane), wu0 = *(const GAS v4u*)(P + (size_t)r * NNG + C_BU + 8 * lane), wb = *(const GAS v4u*)(P + (size_t)r * NNG + C_BB + 8 * lane);
    const v4u wc1 = *(const GAS v4u*)(P + (size_t)r1c * NNG + C_BC + 8 * lane), wu1 = *(const GAS v4u*)(P + (size_t)r1c * NNG + C_BU + 8 * lane);
    const v4u wc2 = *(const GAS v4u*)(P + (size_t)r2c * NNG + C_BC + 8 * lane), wu2 = *(const GAS v4u*)(P + (size_t)r2c * NNG + C_BU + 8 * lane);
    __builtin_amdgcn_sched_barrier(0);
    float c0[8], u0[8], bb[8], y[8]; unpack8(wc0, c0); unpack8(wu0, u0); unpack8(wb, bb);
#pragma unroll
    for (int i = 0; i < 8; ++i) y[i] = cw[i] * (c0[i] * u0[i]);
    const float m1 = r1 >= 0 ? 1.f : 0.f, m2 = r2 >= 0 ? 1.f : 0.f;
    unpack8(wc1, c0); unpack8(wu1, u0);
#pragma unroll
    for (int i = 0; i < 8; ++i) y[i] += m1 * cw[512 + i] * (c0[i] * u0[i]);
    unpack8(wc2, c0); unpack8(wu2, u0);
#pragma unroll
    for (int i = 0; i < 8; ++i) y[i] += m2 * cw[1024 + i] * (c0[i] * u0[i]);
#pragma unroll
    for (int i = 0; i < 8; ++i) y[i] *= bb[i];
    *(GAS v4u*)((bf16*)(F.ws + WS_BR) + (size_t)MPAD * 512 + (size_t)r * 512 + 8 * lane) = pack8(y);
}
constexpr int CW_TMO = 0, CW_BAR = 4096, CW_Q = 16384;
__device__ __forceinline__ int queue_pop(Frame& F, int qi) {
    int t = 0; if (F.lane == 0) t = (int)__hip_atomic_fetch_add((unsigned*)(F.ctl + CW_Q + 64 * qi), 1u, RLX_AGENT);
    return __builtin_amdgcn_readfirstlane(t);
}
__device__ __forceinline__ int queue_pop_wg(Frame& F, int qi) {
    LAS int* slot = (LAS int*)(F.lds + 139264);
    __syncthreads();
    if (F.tid == 0) *slot = (int)__hip_atomic_fetch_add((unsigned*)(F.ctl + CW_Q + 64 * qi), 1u, RLX_AGENT);
    LDS_WAIT(); __syncthreads();
    return __builtin_amdgcn_readfirstlane(*slot);
}
__device__ __forceinline__ void phase_hgrn_prep(Frame& F, int l) {
    for (int t = F.bid; t < NB * 4 * 64 + 4; t += F.G) { if (t < 4) hgrn_prep_task(F, l, 0, t, 0); else { const int u = t - 4; hgrn_prep_task(F, l, u >> 8, (u >> 6) & 3, 1 + (u & 63)); } }
}
__device__ __forceinline__ void phase_prep(Frame& F, int l) { const int gw = F.bid * NWAVES + F.wave, NGW = F.G * NWAVES; for (int r = gw; r < MREAL + NMETA; r += NGW) prep_row(F, l, r); }
__device__ __forceinline__ void phase_vt(Frame& F) { const int gw = F.bid * NWAVES + F.wave, NGW = F.G * NWAVES; for (int t = gw; t < VT_NTASK; t += NGW) vt_task(F, t); }
__device__ __forceinline__ void phase_mix1(Frame& F, int l, int qidx) {
    LAS float* bt = (LAS float*)(F.lds + 135168);
    build_bias_table(F, bt, 0);
    __syncthreads();
    if (F.bid < NIDX_WG) {
        float* slab = (float*)(F.ws + WS_SCR) + (size_t)F.bid * 32 * LPAD;
        for (int t = F.bid; t < NB * NQT; t += NIDX_WG) { const int j = NQT - 1 - t / NB, b = t % NB; dsa_index_task(F, b, j, slab); }
    } else if (F.bid < NIDX_WG + NHG_WG) {
        const int u = F.bid - NIDX_WG; hgrn_scan_unit(F, l, u >> 2, u & 3);
    } else {
        const int u0 = F.bid - NIDX_WG - NHG_WG, nw = F.G - NIDX_WG - NHG_WG;
        const int cw = u0 * NWAVES + F.wave, ncw = nw * NWAVES; for (int r = cw; r < MREAL + NMETA; r += ncw) conv_row(F, l, r);
    }
    float lam, post;
    { const float* lp = FIN(F, I_DLAM) + l * 256; const float s1 = wave_sum(lp[F.lane] * lp[64 + F.lane]), s2 = wave_sum(lp[128 + F.lane] * lp[192 + F.lane]);
      const float li = 0.8f - 0.6f * __expf(-0.3f * (float)l); lam = __expf(s1) - __expf(s2) + li; post = 1.0f - li; }
    for (;;) { const int t = queue_pop_wg(F, qidx); if (t >= NB * 4 * NQB) break;
        const int J = NQB - 1 - t / 32, bh = t % 32; attn_wg_task<false>(F, l, bh >> 2, bh & 3, J, bt, lam, post); }
}
__device__ __forceinline__ void phase_mix2(Frame& F, int l, int qidx) {
    LAS float* bt = (LAS float*)(F.lds + 135168);
    build_bias_table(F, bt, 4);
    __syncthreads();
    for (;;) { const int t = queue_pop_wg(F, qidx); if (t >= NB * 4 * NQB) break;
        const int J = NQB - 1 - t / 32, bh = t % 32; attn_wg_task<true>(F, l, bh >> 2, bh & 3, J, bt, 0.f, 1.f); }
}

#ifdef DBG_SEL
#ifndef DBG_Q
#define DBG_Q 1.0f
#endif
#ifndef DBG_QO
#define DBG_QO 0.0f
#endif
#ifndef DBG_T0
#define DBG_T0 0
#define DBG_T1 36
#endif
#ifndef DBG_NC
#define DBG_NC DM
#endif
__global__ void __launch_bounds__(256) k_dbg_argmax(const float* __restrict__ out, const float* __restrict__ x, unsigned long long* best) {
    unsigned long long loc = 0ull;
    for (size_t i = (size_t)blockIdx.x * blockDim.x + threadIdx.x; i < (size_t)MREAL * DM; i += (size_t)gridDim.x * blockDim.x) {
        const float d = fabsf(out[i] - x[i]); const unsigned long long k = ((unsigned long long)__float_as_uint(d) << 32) | (unsigned)i; loc = k > loc ? k : loc; }
    for (int o = 32; o >= 1; o >>= 1) { const unsigned long long t = __shfl_xor(loc, o); loc = t > loc ? t : loc; }
    if ((threadIdx.x & 63) == 0) atomicMax(best, loc);
}
__global__ void __launch_bounds__(256) k_dbg_count(const float* __restrict__ out, const float* __restrict__ x, unsigned* cnt  ) {
    const int gw = (blockIdx.x * blockDim.x + threadIdx.x) >> 6, lane = threadIdx.x & 63, ngw = (gridDim.x * blockDim.x) >> 6;
    for (int r = gw; r < MREAL; r += ngw) { float m = 0.f;
        for (int c = lane; c < DM; c += 64) m = fmaxf(m, fabsf(out[(size_t)r * DM + c] - x[(size_t)r * DM + c]));
        for (int o = 32; o >= 1; o >>= 1) m = fmaxf(m, __shfl_xor(m, o));
        if (lane == 0 && m > DBG_THR) { const int t = r & 4095; atomicAdd(cnt + 0, 1u); if (t < 32) atomicAdd(cnt + 1, 1u); if (t >= 4064) atomicAdd(cnt + 2, 1u); if (t < 256) atomicAdd(cnt + 3, 1u); } }
}

__global__ void __launch_bounds__(256) k_dbg_chk_merge(const unsigned short* BRm, const unsigned short* Wt, const unsigned short* G, const unsigned short* MG, int m, unsigned* cnt) {
    const int c = blockIdx.x * 256 + threadIdx.x;
    for (int r = blockIdx.y; r < MREAL; r += gridDim.y) {
        float s = 0.f; const unsigned short* a = BRm + (size_t)r * 512; const unsigned short* w = Wt + (size_t)c * 512;
        for (int k = 0; k < 512; ++k) s += __uint_as_float((unsigned)a[k] << 16) * __uint_as_float((unsigned)w[k] << 16);
        const float g = __uint_as_float((unsigned)G[(size_t)r * NGATE + m * DM + c] << 16), ref = g * s, got = __uint_as_float((unsigned)MG[(size_t)r * DM + c] << 16);
        const float err = fabsf(got - ref), tol = 0.02f * fabsf(ref) + 0.02f;
        if (!(err <= tol)) { atomicAdd(cnt + 4, 1u); const int t = r & 4095; if ((c & 255) < 128) atomicAdd(cnt + 5, 1u); if ((r & 255) < 128) atomicAdd(cnt + 6, 1u); if (fabsf(got) > 2.f * fabsf(ref)) atomicAdd(cnt + 7, 1u); (void)t; }
    }
}

__global__ void __launch_bounds__(256) k_dbg_naive_wo(const float* out, const unsigned short* MG, const unsigned short* Wt, float* chk) {
    const int c = blockIdx.x * 256 + threadIdx.x;
    for (int r = blockIdx.y; r < MREAL; r += gridDim.y) {
        float s = 0.f; const uint4* a = (const uint4*)(MG + (size_t)r * DM); const uint4* w = (const uint4*)(Wt + (size_t)c * DM);
        for (int k = 0; k < DM / 8; ++k) { const uint4 av = a[k], wv = w[k]; const unsigned aw[4] = {av.x, av.y, av.z, av.w}, ww[4] = {wv.x, wv.y, wv.z, wv.w};
#pragma unroll
            for (int j = 0; j < 4; ++j) { s += __uint_as_float(aw[j] << 16) * __uint_as_float(ww[j] << 16); s += __uint_as_float(aw[j] & 0xffff0000u) * __uint_as_float(ww[j] & 0xffff0000u); } }
        chk[(size_t)r * DM + c] = out[(size_t)r * DM + c] + s; }
}
__global__ void __launch_bounds__(256) k_dbg_cmp(const float* out, const float* chk, unsigned* cnt) {
    for (size_t i = (size_t)blockIdx.x * blockDim.x + threadIdx.x; i < (size_t)MREAL * DM; i += (size_t)gridDim.x * blockDim.x) {
        const float err = fabsf(out[i] - chk[i]); if (!(err <= 0.02f)) { atomicAdd(cnt + 4, 1u); const int c = (int)(i % DM), r = (int)(i / DM); if ((c & 255) < 128) atomicAdd(cnt + 5, 1u); if ((r & 255) < 128) atomicAdd(cnt + 6, 1u); if (err > 1.0f) atomicAdd(cnt + 7, 1u); } }
}

__global__ void __launch_bounds__(256) k_dbg_stats(const unsigned short* A, int ld, int ncols, unsigned* st) {
    const int gw = (blockIdx.x * blockDim.x + threadIdx.x) >> 6, lane = threadIdx.x & 63, ngw = (gridDim.x * blockDim.x) >> 6;
    float mx = 0.f, me = 0.f;
    for (int r = gw; r < MREAL; r += ngw) { float s = 0.f;
        for (int c = lane; c < ncols; c += 64) { const float v = __uint_as_float((unsigned)A[(size_t)r * ld + c] << 16); mx = fmaxf(mx, fabsf(v)); s += v * v; }
        for (int o = 32; o >= 1; o >>= 1) s += __shfl_xor(s, o);
        me = fmaxf(me, s / (float)ncols); }
    for (int o = 32; o >= 1; o >>= 1) mx = fmaxf(mx, __shfl_xor(mx, o));
    if (lane == 0) { atomicMax(st + 8, __float_as_uint(mx)); atomicMax(st + 9, __float_as_uint(me)); }
}

__global__ void __launch_bounds__(256) k_dbg_argmax_bf16(const unsigned short* A, int ld, int ncols, unsigned long long* best) {
    unsigned long long loc = 0ull;
    for (size_t i = (size_t)blockIdx.x * blockDim.x + threadIdx.x; i < (size_t)MREAL * ncols; i += (size_t)gridDim.x * blockDim.x) { const size_t r = i / ncols, c = i % ncols;
        const float d = fabsf(__uint_as_float((unsigned)A[r * ld + c] << 16)); const unsigned long long k = ((unsigned long long)__float_as_uint(d) << 32) | (unsigned)i; loc = k > loc ? k : loc; }
    for (int o = 32; o >= 1; o >>= 1) { const unsigned long long t = __shfl_xor(loc, o); loc = t > loc ? t : loc; }
    if ((threadIdx.x & 63) == 0) atomicMax(best, loc);
}

__global__ void __launch_bounds__(256) k_dbg_gcount(const unsigned short* G, unsigned* cnt) {
    const int gw = (blockIdx.x * blockDim.x + threadIdx.x) >> 6, lane = threadIdx.x & 63, ngw = (gridDim.x * blockDim.x) >> 6;
    for (int r = gw; r < MREAL; r += ngw) { int n = 0;
        for (int c = lane; c < NGATE; c += 64) { const float v = __uint_as_float((unsigned)G[(size_t)r * NGATE + c] << 16); if (!(v >= 0.f && v <= 1.001f)) ++n; }
        for (int o = 32; o >= 1; o >>= 1) n += __shfl_xor(n, o);
        if (lane == 0 && n) { const int t = r & 4095; atomicAdd(cnt + 10, (unsigned)n); atomicAdd(cnt + 11, 1u); if (t >= 4080) atomicAdd(cnt + 12, 1u); else atomicAdd(cnt + 13, 1u); } }
}

__global__ void k_dbg_time(const unsigned long long* ts, unsigned* cnt) {
    if (threadIdx.x == 0) { const float ms = (float)(ts[DBG_T1] - ts[DBG_T0]) * 1e-5f; cnt[14] = __float_as_uint(floorf(ms * DBG_Q + DBG_QO)); }
}
__global__ void __launch_bounds__(256) k_dbg_emit(float* out, const float* __restrict__ x, const unsigned long long* best, const unsigned* cnt) {
    const unsigned long long b = *best; const unsigned idx = (unsigned)b; const float val = __uint_as_float((unsigned)(b >> 32));
    const int row = idx / DBG_NC, col = idx % DBG_NC, bb = row >> 12, t = row & 4095;
    float N = 0.f;
    switch (DBG_SEL) {
        case 0: N = val; break;
        case 1: N = 2.f + bb; break;
        case 2: N = 2.f + (t >> 9); break;
        case 3: N = 2.f + ((t >> 6) & 7); break;
        case 4: N = 2.f + ((t >> 3) & 7); break;
        case 5: N = 2.f + (t & 7); break;
        case 6: N = 2.f + (col >> 8); break;
        case 60: N = 2.f + (col >> 10); break;
        case 61: N = 2.f + ((col >> 7) & 7); break;
        case 62: N = 2.f + ((col >> 4) & 7); break;
        case 63: N = 2.f + ((col >> 1) & 7); break;
        case 64: N = 2.f + (col & 1); break;
        case 65: N = 2.f + bb; break;
        case 66: N = 2.f + (t >> 9); break;
        case 67: N = 2.f + ((t >> 6) & 7); break;
        case 68: N = 2.f + ((t >> 3) & 7); break;
        case 69: N = 2.f + (t & 7); break;
        case 7: N = 2.f + ((col >> 5) & 7); break;
        case 8: N = 2.f + ((col >> 2) & 7); break;
        case 40: case 42: case 44: case 46: N = __uint_as_float(cnt[8]); break;
        case 41: case 43: case 45: case 47: N = __uint_as_float(cnt[9]); break;
        case 70: N = 2.f + log2f(1.f + (float)cnt[10]); break;
        case 71: N = 2.f + log2f(1.f + (float)cnt[11]); break;
        case 72: N = 2.f + log2f(1.f + (float)cnt[12]); break;
        case 73: N = 2.f + log2f(1.f + (float)cnt[13]); break;
        case 100: N = 2.f + __uint_as_float(cnt[14]); break;
        case 30: N = 2.f + log2f(1.f + (float)cnt[4]); break;
        case 31: N = 2.f + log2f(1.f + (float)cnt[5]); break;
        case 32: N = 2.f + log2f(1.f + (float)cnt[6]); break;
        case 33: N = 2.f + log2f(1.f + (float)cnt[7]); break;
        case 20: N = 2.f + log2f(1.f + (float)cnt[4]); break;
        case 21: N = 2.f + log2f(1.f + (float)cnt[5]); break;
        case 22: N = 2.f + log2f(1.f + (float)cnt[6]); break;
        case 23: N = 2.f + log2f(1.f + (float)cnt[7]); break;
        case 10: N = 2.f + log2f(1.f + (float)cnt[0]); break;
        case 11: N = 2.f + log2f(1.f + (float)cnt[1]); break;
        case 12: N = 2.f + log2f(1.f + (float)cnt[2]); break;
        case 13: N = 2.f + log2f(1.f + (float)cnt[3]); break;
    }
    const float c = 1.f + N;
    for (size_t i = (size_t)blockIdx.x * blockDim.x + threadIdx.x; i < (size_t)MREAL * DM; i += (size_t)gridDim.x * blockDim.x) out[i] = c * x[i];
}
#endif

#ifndef MK_ONE
#define MK_ONE 0
#endif
#ifndef BR_MASK
#define BR_MASK 15
#endif
constexpr int NPH = 18;
template <class T> __device__ __forceinline__ T opaque(T v) { asm volatile("" : "+s"(v)); return v; }
struct Args { const float* in[22]; float* out; unsigned char* ws; int ph_lo, ph_hi; };
__global__ void __launch_bounds__(NWAVES * 64, 2) fwd(Args args) {
    extern __shared__ __attribute__((aligned(16))) unsigned char lds[];
    Frame F;
    F.lds = (LAS unsigned char*)lds; F.MISC = (volatile LAS unsigned*)(F.lds + MISC_OFF);
    F.tid = threadIdx.x; F.lane = F.tid & 63; F.wave = __builtin_amdgcn_readfirstlane(F.tid >> 6); F.G = gridDim.x; F.bid = blockIdx.x;
    F.ws = args.ws; F.out = args.out; F.ctl = (gu32*)(args.ws + WS_CTL);
    F.karg = (const unsigned char __attribute__((address_space(4)))*)__builtin_amdgcn_kernarg_segment_ptr();
    for (int u = F.tid; u < (LDS_BYTES - LDSCTL_OFF) / 4; u += NWAVES * 64) ((LAS unsigned*)(F.lds + LDSCTL_OFF))[u] = 0u;
    __syncthreads();
#if MK_ONE
    XcdBarrier bar = xcd_barrier_post((unsigned*)(F.ctl + CW_BAR), F.MISC + 8, __builtin_amdgcn_readfirstlane(threadIdx.x >> 6));
#define GRID_BAR() xcd_barrier(bar)
#else
#define GRID_BAR() do { } while (0)
#endif
    const int wave_s = __builtin_amdgcn_readfirstlane(threadIdx.x >> 6);
    const int lo = args.ph_lo, hi = args.ph_hi;
#define IN(k) (lo <= (k) && (k) < hi)
#define RETID() do { int w_ = wave_s; asm volatile("" : "+s"(w_)); unsigned mk_ = ~0u; asm volatile("" : "+s"(mk_)); int t_ = w_ * 64 + (int)__builtin_amdgcn_mbcnt_hi(mk_, __builtin_amdgcn_mbcnt_lo(mk_, 0u)); asm volatile("" : "+v"(t_)); F.tid = t_; F.lane = t_ & 63; F.wave = w_; } while (0)
#ifdef DBG_TS
#define STAMP(k) do { if (blockIdx.x == 0 && threadIdx.x == 0) ((unsigned long long*)(args.ws + 768 * 1024))[(k)] = __builtin_amdgcn_s_memrealtime(); } while (0)
#else
#define STAMP(k) do { } while (0)
#endif
#define SEAM(k) do { if (IN((k) + 1)) GRID_BAR(); STAMP((k) + 1); } while (0)
#ifdef PROBE_MASK
#define NREP(kk) opaque(((PROBE_MASK >> (kk)) & 1) ? 1 + PROBE_EXTRA : 1)
#define REP_BEGIN(kk) { const int nrep_ = NREP(kk); for (int rep = 0; rep < nrep_; ++rep) { if (rep) GRID_BAR();
#define REP_END } }
#else
#define REP_BEGIN(kk) { { const int rep = 0; (void)rep;
#define REP_END } }
#endif
    STAMP(0);
    unsigned char* wb = F.ws + WS_W;
    bf16* XN = (bf16*)(F.ws + WS_XN); bf16* BR = (bf16*)(F.ws + WS_BR); bf16* BIG = (bf16*)(F.ws + WS_BIG); float* HM = (float*)(F.ws + WS_HM);
    for (int l = 0; l < 2; ++l) {
        const int pb = l * NPH;
        const float* hsrc = (l == 0) ? FIN(F, I_X) : F.out;
        if (IN(pb + 0)) { REP_BEGIN(0) RETID(); phase_convert(F, l); REP_END SEAM(pb + 0); }
        if (IN(pb + 1)) { REP_BEGIN(1) RETID(); phase_norm(F, hsrc, FIN(F, I_F1N) + l * DM); REP_END SEAM(pb + 1); }
        if (IN(pb + 2)) { REP_BEGIN(2) RETID(); meta_gemm(F, 0, XN + (size_t)MREAL * DM, DM, (const bf16*)(wb + W_GU1), NGU, DM, BIG, DFF, 0.f); pg8::Gemm g{opaque((const bf16*)(XN)), opaque((const bf16*)(wb + W_GU1)), MREAL, NGU, DM}; pg8::StaticOrder S; S.init(MREAL, NGU, F.G, opaque(F.bid));
            pg8::EpiSwiGLU E{BIG, DFF}; pg8::gemm_phase<pg8::EpiSwiGLU, pg8::StaticOrder, true, true>(F.lds + RING_OFF, g, S, E, F.tid); REP_END SEAM(pb + 2); }
        if (IN(pb + 3)) { REP_BEGIN(3) RETID(); meta_gemm(F, 1, BIG + (size_t)MREAL * DFF, DFF, (const bf16*)(wb + W_D1), DM, DFF, nullptr, 0, rep ? 0.f : 0.5f); pg8::Gemm g{opaque((const bf16*)(BIG)), opaque((const bf16*)(wb + W_D1)), MREAL, DM, DFF}; pg8::StaticOrder S; S.init(MREAL, DM, F.G, opaque(F.bid));
            pg8::EpiResF32 E{rep ? F.out : hsrc, F.out, HM, DM, MT_REAL, rep ? 0.f : 0.5f}; pg8::gemm_phase<pg8::EpiResF32, pg8::StaticOrder, true, true>(F.lds + RING_OFF, g, S, E, F.tid); REP_END SEAM(pb + 3); }
        if (IN(pb + 4)) { REP_BEGIN(4) RETID(); phase_norm(F, F.out, FIN(F, I_MIXN) + l * DM); REP_END SEAM(pb + 4); }
        if (IN(pb + 5)) { REP_BEGIN(5) RETID(); meta_gemm(F, 2, XN + (size_t)MREAL * DM, DM, (const bf16*)(wb + W_NG), NNG, DM, BIG, NNG, 0.f); pg8::Gemm g{opaque((const bf16*)(XN)), opaque((const bf16*)(wb + W_NG)), MREAL, NNG, DM}; pg8::StaticOrder S; S.init(MREAL, NNG, F.G, opaque(F.bid));
            pg8::EpiBf16<0> E{BIG, NNG}; pg8::gemm_phase<pg8::EpiBf16<0>, pg8::StaticOrder, true, true>(F.lds + RING_OFF, g, S, E, F.tid); REP_END SEAM(pb + 5); }
        if (IN(pb + 6)) { RETID(); phase_prep(F, l); phase_vt(F); __syncthreads(); phase_hgrn_prep(F, l); SEAM(pb + 6); }
        if (IN(pb + 7)) { RETID(); phase_mix1(F, l, 2 * l); SEAM(pb + 7); }
        if (IN(pb + 8)) { RETID(); phase_mix2(F, l, 2 * l + 1); SEAM(pb + 8); }
        if (IN(pb + 9)) { REP_BEGIN(9) RETID(); meta_gemm(F, 3, XN + (size_t)MREAL * DM, DM, (const bf16*)(wb + W_G), NGATE, DM, BIG, NGATE, 0.f); pg8::Gemm g{opaque((const bf16*)(XN)), opaque((const bf16*)(wb + W_G)), MREAL, NGATE, DM}; pg8::StaticOrder S; S.init(MREAL, NGATE, F.G, opaque(F.bid));
            pg8::EpiBf16<1> E{BIG, NGATE}; pg8::gemm_phase<pg8::EpiBf16<1>, pg8::StaticOrder, true, true>(F.lds + RING_OFF, g, S, E, F.tid); REP_END SEAM(pb + 9); }
        if (IN(pb + 10)) { REP_BEGIN(10) RETID(); meta_gemm(F, 4, BR + (size_t)MREAL * 512, 512, (const bf16*)(wb + W_BR), DM, 512, XN, DM, 0.f);
            pg8::Gemm g{opaque((const bf16*)(BR)), opaque((const bf16*)(wb + W_BR)), MREAL, DM, 512}; pg8::MergeOrder S; S.init(MREAL, DM, F.G, opaque(F.bid), MPAD / 256);
            pg8::EpiGateAccM E{XN, DM, BIG, NGATE, MPAD / 256, DM / 256}; pg8::gemm_phase<pg8::EpiGateAccM, pg8::MergeOrder, true, true>(F.lds + RING_OFF, g, S, E, F.tid); REP_END SEAM(pb + 10); }
        if (IN(pb + 14) && BR_MASK) { REP_BEGIN(14) RETID(); meta_gemm(F, 1, XN + (size_t)MREAL * DM, DM, (const bf16*)(wb + W_O), DM, DM, nullptr, 0, rep ? 0.f : 1.0f); pg8::Gemm g{opaque((const bf16*)(XN)), opaque((const bf16*)(wb + W_O)), MREAL, DM, DM}; pg8::StaticOrder S; S.init(MREAL, DM, F.G, opaque(F.bid));
            pg8::EpiResF32 E{F.out, F.out, HM, DM, MT_REAL, rep ? 0.f : 1.0f}; pg8::gemm_phase<pg8::EpiResF32, pg8::StaticOrder, true, true>(F.lds + RING_OFF, g, S, E, F.tid); REP_END SEAM(pb + 14); }
        if (IN(pb + 15)) { REP_BEGIN(15) RETID(); phase_norm(F, F.out, FIN(F, I_F2N) + l * DM); REP_END SEAM(pb + 15); }
        if (IN(pb + 16)) { REP_BEGIN(16) RETID(); meta_gemm(F, 0, XN + (size_t)MREAL * DM, DM, (const bf16*)(wb + W_GU2), NGU, DM, BIG, DFF, 0.f); pg8::Gemm g{opaque((const bf16*)(XN)), opaque((const bf16*)(wb + W_GU2)), MREAL, NGU, DM}; pg8::StaticOrder S; S.init(MREAL, NGU, F.G, opaque(F.bid));
            pg8::EpiSwiGLU E{BIG, DFF}; pg8::gemm_phase<pg8::EpiSwiGLU, pg8::StaticOrder, true, true>(F.lds + RING_OFF, g, S, E, F.tid); REP_END SEAM(pb + 16); }
        if (IN(pb + 17)) { REP_BEGIN(17) RETID(); meta_gemm(F, 1, BIG + (size_t)MREAL * DFF, DFF, (const bf16*)(wb + W_D2), DM, DFF, nullptr, 0, rep ? 0.f : 0.5f); pg8::Gemm g{opaque((const bf16*)(BIG)), opaque((const bf16*)(wb + W_D2)), MREAL, DM, DFF}; pg8::StaticOrder S; S.init(MREAL, DM, F.G, opaque(F.bid));
            pg8::EpiResF32 E{F.out, F.out, HM, DM, MT_REAL, rep ? 0.f : 0.5f}; pg8::gemm_phase<pg8::EpiResF32, pg8::StaticOrder, true, true>(F.lds + RING_OFF, g, S, E, F.tid); REP_END SEAM(pb + 17); }
    }
}

extern "C" void kernel_launch(void* const* d_in, const int* in_sizes, int n_in, void* d_out, int out_size, void* d_ws, size_t ws_size, hipStream_t stream) {
    static int grid = 0;
    if (grid == 0) {
        if (n_in != 22 || out_size != MREAL * DM || ws_size < WS_END) { fprintf(stderr, "kernel_launch: unexpected shapes (n_in %d out %d ws %zu need %zu)\n", n_in, out_size, ws_size, (size_t)WS_END); grid = -1; return; }
        int dev = 0, cus = 0, per_cu = 0;
        if (hipGetDevice(&dev) != hipSuccess || hipDeviceGetAttribute(&cus, hipDeviceAttributeMultiprocessorCount, dev) != hipSuccess) { grid = -1; return; }
        if (hipFuncSetAttribute((const void*)fwd, hipFuncAttributeMaxDynamicSharedMemorySize, LDS_BYTES) != hipSuccess) { fprintf(stderr, "kernel_launch: hipFuncSetAttribute failed\n"); grid = -1; return; }
        if (hipOccupancyMaxActiveBlocksPerMultiprocessor(&per_cu, (const void*)fwd, NWAVES * 64, LDS_BYTES) != hipSuccess || per_cu < 1) fprintf(stderr, "kernel_launch: occupancy query says %d\n", per_cu);
        (void)hipGetLastError();
        grid = cus < 256 ? cus : 256;
    }
    if (grid < 0) return;
    (void)hipMemsetAsync((char*)d_ws + WS_CTL, 0, CTL_ZERO_BYTES, stream);
    Args a{};
    for (int i = 0; i < 22; ++i) a.in[i] = (const float*)d_in[i];
    a.out = (float*)d_out; a.ws = (unsigned char*)d_ws;
#ifndef PH_END
#define PH_END (2 * NPH)
#endif
#if MK_ONE
    a.ph_lo = 0; a.ph_hi = PH_END;
    hipLaunchKernelGGL(fwd, dim3(grid), dim3(NWAVES * 64), LDS_BYTES, stream, a);
#else
    for (int p = 0; p < PH_END; ++p) { a.ph_lo = p; a.ph_hi = p + 1;
#if defined(DBG_SEL)
#ifdef DBG_PREFILL
        if (p == 9) (void)hipMemsetAsync((char*)d_ws + WS_BIG, 0x3F, (size_t)MPAD * NGATE * 2, stream);
#endif
        if (DBG_SEL >= 30 && DBG_SEL < 40 && p == 14) hipLaunchKernelGGL(k_dbg_naive_wo, dim3(8, 2048), dim3(256), 0, stream, (const float*)d_out, (const unsigned short*)((char*)d_ws + WS_XN), (const unsigned short*)((char*)d_ws + WS_W + W_O), (float*)((char*)d_ws + WS_BIG));
#endif
        hipLaunchKernelGGL(fwd, dim3(grid), dim3(NWAVES * 64), LDS_BYTES, stream, a); }
#endif
#ifdef DBG_SEL
    { unsigned long long* best = (unsigned long long*)((char*)d_ws + 512 * 1024); unsigned* cnt = (unsigned*)((char*)d_ws + 512 * 1024 + 64);
      if (DBG_SEL >= 60 && DBG_SEL < 70) hipLaunchKernelGGL(k_dbg_argmax_bf16, dim3(2048), dim3(256), 0, stream, (const unsigned short*)((char*)d_ws + WS_BIG), NGATE, NGATE, best);
      else hipLaunchKernelGGL(k_dbg_argmax, dim3(2048), dim3(256), 0, stream, (const float*)d_out, (const float*)d_in[0], best);
      hipLaunchKernelGGL(k_dbg_count, dim3(2048), dim3(256), 0, stream, (const float*)d_out, (const float*)d_in[0], cnt);
      if (DBG_SEL >= 20 && DBG_SEL < 30) { const int mm = 1; hipLaunchKernelGGL(k_dbg_chk_merge, dim3(8, 2048), dim3(256), 0, stream, (const unsigned short*)((char*)d_ws + WS_BR) + (size_t)mm * MPAD * 512, (const unsigned short*)((char*)d_ws + WS_W + W_BR) + (size_t)mm * DM * 512, (const unsigned short*)((char*)d_ws + WS_BIG), (const unsigned short*)((char*)d_ws + WS_XN), mm, cnt); }
      if (DBG_SEL >= 30 && DBG_SEL < 40) hipLaunchKernelGGL(k_dbg_cmp, dim3(2048), dim3(256), 0, stream, (const float*)d_out, (const float*)((char*)d_ws + WS_BIG), cnt);
      if (DBG_SEL >= 40 && DBG_SEL < 50) { const unsigned short* A = nullptr; int ld = 0, nc = 0;
        if (DBG_SEL < 42) { A = (const unsigned short*)((char*)d_ws + WS_BR) + (size_t)MPAD * 512; ld = 512; nc = 512; }
        else if (DBG_SEL < 44) { A = (const unsigned short*)((char*)d_ws + WS_BIG) + DM; ld = NGATE; nc = DM; }
        else if (DBG_SEL < 46) { A = (const unsigned short*)((char*)d_ws + WS_XN); ld = DM; nc = DM; }
        else { A = (const unsigned short*)((char*)d_ws + WS_BR); ld = 512; nc = 512; }
        hipLaunchKernelGGL(k_dbg_stats, dim3(1024), dim3(256), 0, stream, A, ld, nc, cnt); }
      if (DBG_SEL >= 70 && DBG_SEL < 80) hipLaunchKernelGGL(k_dbg_gcount, dim3(1024), dim3(256), 0, stream, (const unsigned short*)((char*)d_ws + WS_BIG), cnt);
      if (DBG_SEL >= 100) hipLaunchKernelGGL(k_dbg_time, dim3(1), dim3(64), 0, stream, (const unsigned long long*)((char*)d_ws + 768 * 1024), cnt);
      hipLaunchKernelGGL(k_dbg_emit, dim3(2048), dim3(256), 0, stream, (float*)d_out, (const float*)d_in[0], best, cnt); }
#endif
}
```

```cpp
#include <hip/hip_runtime.h>
#include <cstdio>
#include <cstdint>
#define MK_ONE 1
namespace pg8 {
#define PG8_LAS __attribute__((address_space(3)))
typedef unsigned short bf16_t;
typedef short bf16x8 __attribute__((ext_vector_type(8)));
typedef float f32x4 __attribute__((ext_vector_type(4)));
typedef unsigned u32x4 __attribute__((ext_vector_type(4)));
constexpr int BM = 256, BK = 64, HALF = 128, HTB = HALF * BK * 2  , STAGE_BYTES = 8 * HTB, NXCD = 8, WGM = 8;

__host__ __device__ __forceinline__ int lds_byte(int r, int c) { const int st = (r >> 4) * 2 + (c >> 5), rr = r & 15, cc = c & 31, ob = rr * 64 + cc * 2; return st * 1024 + (ob ^ (((ob >> 9) & 1) << 5)); }
__host__ __device__ __forceinline__ void stage_rc(int b, int& R, int& C) { const int st = b / 1024, sb = b % 1024, swz = sb ^ (((sb >> 9) & 1) << 5); R = (st >> 1) * 16 + swz / 64; C = (st & 1) * 32 + (swz % 64) / 2; }
__host__ __device__ __forceinline__ int perm32(int rho) { const int n = rho >> 4, i = rho & 15; return 8 * (i >> 2) + 4 * n + (i & 3); }

struct Unit { int pm, pn; };
struct Gemm { const bf16_t* A; const bf16_t* Bt; int M, N, K; };

struct StaticOrder {
    int nM, nN, nwg, G, c;
    __host__ __device__ void init(int M, int N, int G_, int c_) { nM = M / BM; nN = N / BM; nwg = nM * nN; G = G_; c = c_; }
    __host__ __device__ bool next(int i, Unit& u) const {
        const long L = (long)i * G + c; if (L >= nwg) return false;
        int wgid = (int)L; { const int q = nwg / NXCD, r = nwg % NXCD, xcd = wgid % NXCD, off = wgid / NXCD; wgid = (xcd < r ? xcd * (q + 1) : r * (q + 1) + (xcd - r) * q) + off; }
        const int nig = WGM * nN, gid = wgid / nig, fm = gid * WGM, gsz = (nM - fm) < WGM ? (nM - fm) : WGM;
        u.pm = fm + ((wgid % nig) % gsz); u.pn = (wgid % nig) / gsz; return true;
    }
    __device__ __forceinline__ void a_ready(const Unit&) const {}
    __device__ __forceinline__ void done(const Unit&) const {}
};
typedef __bf16 bf16x2_hw __attribute__((ext_vector_type(2))); typedef float f32x2_hw __attribute__((ext_vector_type(2)));
__device__ __forceinline__ unsigned cvt_pk_bf16(float lo, float hi) { const f32x2_hw v = {lo, hi}; return __builtin_bit_cast(unsigned, __builtin_convertvector(v, bf16x2_hw)); }
typedef float f32x2 __attribute__((ext_vector_type(2)));
__device__ __forceinline__ float fast_sigmoid(float x) { return __builtin_amdgcn_rcpf(1.0f + __expf(-x)); }
__device__ __forceinline__ float fast_silu(float x) { return x * fast_sigmoid(x); }
template <int ACT  > struct EpiBf16 {
    static constexpr bool PERM = true, AFTER_DRAIN = false;
    bf16_t* O; int ldc;
    __device__ __forceinline__ void operator()(const f32x4 (&acc)[2][2][4][2], const Unit& u, int wr, int wc, int fr, int fq) const {
        const int row0 = u.pm * BM + wr * 64 + fr; const int col0 = u.pn * BM + wc * 32 + 8 * fq;
#pragma unroll
        for (int ai = 0; ai < 2; ++ai)
#pragma unroll
            for (int m = 0; m < 4; ++m) { bf16_t* rowp = O + (size_t)(row0 + ai * HALF + m * 16) * ldc + col0;
#pragma unroll
                for (int bj = 0; bj < 2; ++bj) { f32x4 v0 = acc[ai][bj][m][0], v1 = acc[ai][bj][m][1];
                    if (ACT == 1) {
#pragma unroll
                        for (int j = 0; j < 4; ++j) { v0[j] = fast_sigmoid(v0[j]); v1[j] = fast_sigmoid(v1[j]); } }
                    u32x4 w; w.x = cvt_pk_bf16(v0[0], v0[1]); w.y = cvt_pk_bf16(v0[2], v0[3]); w.z = cvt_pk_bf16(v1[0], v1[1]); w.w = cvt_pk_bf16(v1[2], v1[3]);
                    *(u32x4*)(rowp + bj * HALF) = w; } }
    }
};
struct EpiSwiGLU {
    static constexpr bool PERM = true, AFTER_DRAIN = false;
    bf16_t* O; int ldc; int mode;
    __device__ __forceinline__ void operator()(const f32x4 (&acc)[2][2][4][2], const Unit& u, int wr, int wc, int fr, int fq) const {
        if (mode == 2) return;
        const int row0 = u.pm * BM + wr * 64 + fr; const int col0 = u.pn * HALF + wc * 32 + 8 * fq;
#pragma unroll
        for (int ai = 0; ai < 2; ++ai)
#pragma unroll
            for (int m = 0; m < 4; ++m) { bf16_t* rowp = O + (size_t)(row0 + ai * HALF + m * 16) * ldc + col0;
                const f32x4 g0 = acc[ai][0][m][0], g1 = acc[ai][0][m][1], u0 = acc[ai][1][m][0], u1 = acc[ai][1][m][1];
                f32x4 v0, v1;
#pragma unroll
                for (int j = 0; j < 4; ++j) { v0[j] = fast_silu(g0[j]) * u0[j]; v1[j] = fast_silu(g1[j]) * u1[j]; }
                u32x4 w; w.x = cvt_pk_bf16(v0[0], v0[1]); w.y = cvt_pk_bf16(v0[2], v0[3]); w.z = cvt_pk_bf16(v1[0], v1[1]); w.w = cvt_pk_bf16(v1[2], v1[3]);
                if (mode == 0) *(u32x4*)rowp = w; else asm volatile("" :: "v"(w.x), "v"(w.y), "v"(w.z), "v"(w.w));
                asm volatile("" ::: "memory"); }
    }
};
struct EpiResF32 {
    static constexpr bool PERM = false, AFTER_DRAIN = false;
    const float* base_r; float* out_r; float* hm; int ldc; int mt_real; float scale;
    __device__ __forceinline__ void operator()(const f32x4 (&acc)[2][2][4][2], const Unit& u, int wr, int wc, int fr, int fq) const {
        const bool real = u.pm < mt_real;
        const float* bp = real ? base_r + (size_t)u.pm * BM * ldc : hm; float* op = real ? out_r + (size_t)u.pm * BM * ldc : hm;
        const int row0 = wr * 64 + fr, col0 = u.pn * BM + wc * 32 + 4 * fq;
#pragma unroll
        for (int ai = 0; ai < 2; ++ai) {
            f32x4 b[4][2][2];
#pragma unroll
            for (int m = 0; m < 4; ++m) { const size_t off = (size_t)(row0 + ai * HALF + m * 16) * ldc + col0;
#pragma unroll
                for (int bj = 0; bj < 2; ++bj)
#pragma unroll
                    for (int n = 0; n < 2; ++n) b[m][bj][n] = *(const f32x4*)(bp + off + bj * HALF + n * 16); }
            asm volatile("" ::: "memory");
#pragma unroll
            for (int m = 0; m < 4; ++m) { const size_t off = (size_t)(row0 + ai * HALF + m * 16) * ldc + col0;
#pragma unroll
                for (int bj = 0; bj < 2; ++bj)
#pragma unroll
                    for (int n = 0; n < 2; ++n) *(f32x4*)(op + off + bj * HALF + n * 16) = b[m][bj][n] + acc[ai][bj][m][n] * scale; }
            asm volatile("" ::: "memory"); }
    }
};
struct EpiGateAcc {
    static constexpr bool PERM = true, AFTER_DRAIN = false;
    bf16_t* MG; int ldc; const bf16_t* G; int ldg; int gcol0; int first;
    __device__ __forceinline__ void operator()(const f32x4 (&acc)[2][2][4][2], const Unit& u, int wr, int wc, int fr, int fq) const {
        const int row0 = u.pm * BM + wr * 64 + fr; const int col0 = u.pn * BM + wc * 32 + 8 * fq;
#pragma unroll
        for (int ai = 0; ai < 2; ++ai)
#pragma unroll
            for (int m = 0; m < 4; ++m) { const size_t r = (size_t)(row0 + ai * HALF + m * 16);
#pragma unroll
                for (int bj = 0; bj < 2; ++bj) { const u32x4 gw = *(const u32x4*)(G + r * ldg + gcol0 + col0 + bj * HALF);
                    u32x4 pw = (u32x4){0u, 0u, 0u, 0u}; if (!first) pw = *(const u32x4*)(MG + r * ldc + col0 + bj * HALF);
                    float o[8];
#pragma unroll
                    for (int j = 0; j < 4; ++j) { const float a0 = (j < 2) ? acc[ai][bj][m][0][2 * j] : acc[ai][bj][m][1][2 * (j - 2)], a1 = (j < 2) ? acc[ai][bj][m][0][2 * j + 1] : acc[ai][bj][m][1][2 * (j - 2) + 1];
                        o[2 * j] = __uint_as_float(pw[j] << 16) + __uint_as_float(gw[j] << 16) * a0; o[2 * j + 1] = __uint_as_float(pw[j] & 0xffff0000u) + __uint_as_float(gw[j] & 0xffff0000u) * a1; }
                    u32x4 w; w.x = cvt_pk_bf16(o[0], o[1]); w.y = cvt_pk_bf16(o[2], o[3]); w.z = cvt_pk_bf16(o[4], o[5]); w.w = cvt_pk_bf16(o[6], o[7]);
                    *(u32x4*)(MG + r * ldc + col0 + bj * HALF) = w; } }
    }
};

struct MergeOrder {
    int nM, nN, G, c, mt_alloc;
    __host__ __device__ void init(int M, int N, int G_, int c_, int mt_alloc_) { nM = M / BM; nN = N / BM; G = G_; c = c_; mt_alloc = mt_alloc_; }
    __host__ __device__ bool next(int i, Unit& u) const { const int t = (i >> 2) * G + c, m = i & 3; if (t >= nM * nN) return false;
        const int pm = t / nN, pn = t % nN; u.pm = m * mt_alloc + pm; u.pn = m * nN + pn; return true; }
    __device__ __forceinline__ void a_ready(const Unit&) const {}
    __device__ __forceinline__ void done(const Unit&) const {}
};
struct EpiGateAccM {
    static constexpr bool PERM = true, AFTER_DRAIN = false;
    bf16_t* MG; int ldc; const bf16_t* G; int ldg; int mt_alloc; int ntn;
    __device__ __forceinline__ void operator()(const f32x4 (&acc)[2][2][4][2], const Unit& u, int wr, int wc, int fr, int fq) const {
        const int m = u.pm / mt_alloc, pm = u.pm - m * mt_alloc, pn = u.pn - m * ntn;
        const int row0 = pm * BM + wr * 64 + fr; const int col0 = pn * BM + wc * 32 + 8 * fq; const int gcol0 = m * ntn * BM;
#pragma unroll
        for (int ai = 0; ai < 2; ++ai)
#pragma unroll
            for (int mm = 0; mm < 4; ++mm) { const size_t r = (size_t)(row0 + ai * HALF + mm * 16);
#pragma unroll
                for (int bj = 0; bj < 2; ++bj) { const u32x4 gw = *(const u32x4*)(G + r * ldg + gcol0 + col0 + bj * HALF);
                    u32x4 pw = (u32x4){0u, 0u, 0u, 0u}; if (m != 0) pw = *(const u32x4*)(MG + r * ldc + col0 + bj * HALF);
                    float o[8];
#pragma unroll
                    for (int j = 0; j < 4; ++j) { const float a0 = (j < 2) ? acc[ai][bj][mm][0][2 * j] : acc[ai][bj][mm][1][2 * (j - 2)], a1 = (j < 2) ? acc[ai][bj][mm][0][2 * j + 1] : acc[ai][bj][mm][1][2 * (j - 2) + 1];
                        o[2 * j] = __uint_as_float(pw[j] << 16) + __uint_as_float(gw[j] << 16) * a0; o[2 * j + 1] = __uint_as_float(pw[j] & 0xffff0000u) + __uint_as_float(gw[j] & 0xffff0000u) * a1; }
                    u32x4 w; w.x = cvt_pk_bf16(o[0], o[1]); w.y = cvt_pk_bf16(o[2], o[3]); w.z = cvt_pk_bf16(o[4], o[5]); w.w = cvt_pk_bf16(o[6], o[7]);
                    *(u32x4*)(MG + r * ldc + col0 + bj * HALF) = w; } }
    }
};
template <class Epi, class Sched, bool ALIGN_EPI = false, bool SP2 = false>
__device__ __forceinline__ void gemm_phase(PG8_LAS unsigned char* lds, const Gemm g, const Sched& S, const Epi& E, int tid_in) {
    int tid_ = tid_in; asm volatile("" : "+v"(tid_));
    const int tid = tid_, wid = __builtin_amdgcn_readfirstlane(tid >> 6), lane = tid & 63, wr = wid >> 2, wc = wid & 3, fr = lane & 15, fq = lane >> 4;
    const int K = g.K, nt = K / BK;
    unsigned voffA[2], voffB[2];
#pragma unroll
    for (int i = 0; i < 2; ++i) { int R, C; stage_rc(tid * 16 + i * 8192, R, C); const int Rb = Epi::PERM ? ((R & ~31) + perm32(R & 31)) : R;
        voffA[i] = (unsigned)(R * K + C) * 2u; voffB[i] = (unsigned)(Rb * K + C) * 2u; }
    const size_t kstep = (size_t)(BK * 2);
    const size_t hstep = (size_t)HALF * K * 2;
    const size_t tstep = 2 * hstep;
    const unsigned ldsw = (unsigned)wid * 1024u;
    const int aoff = lds_byte(wr * 64 + fr, fq * 8), boff = lds_byte(wc * 32 + fr, fq * 8);
#define PG8_SA(b, h) (((b) * 2 + (h)) * HTB)
#define PG8_SB(b, h) ((4 + (b) * 2 + (h)) * HTB)
#define PG8_STAGE(bufoff, gbase, voff) do { _Pragma("unroll") for (int _i = 0; _i < 2; ++_i) \
        __builtin_amdgcn_global_load_lds((const unsigned*)((const char*)(gbase) + (voff)[_i]), (PG8_LAS unsigned*)(lds + (bufoff) + ldsw + _i * 8192), 16, 0, 0); } while (0)
#define PG8_LDA(dst, b, h) do { _Pragma("unroll") for (int m = 0; m < 4; ++m) _Pragma("unroll") for (int k = 0; k < 2; ++k) dst[m][k] = *(const PG8_LAS bf16x8*)(lds + PG8_SA(b, h) + aoff + m * 2048 + k * 1024); } while (0)
#define PG8_LDB(dst, b, h) do { _Pragma("unroll") for (int n = 0; n < 2; ++n) _Pragma("unroll") for (int k = 0; k < 2; ++k) dst[n][k] = *(const PG8_LAS bf16x8*)(lds + PG8_SB(b, h) + boff + n * 2048 + k * 1024); } while (0)
#define PG8_MMA(ai, bj, At, Bt) do { __builtin_amdgcn_s_setprio(1); _Pragma("unroll") for (int m = 0; m < 4; ++m) _Pragma("unroll") for (int n = 0; n < 2; ++n) _Pragma("unroll") for (int k = 0; k < 2; ++k) \
        acc[ai][bj][m][n] = __builtin_amdgcn_mfma_f32_16x16x32_bf16(Bt[n][k], At[m][k], acc[ai][bj][m][n], 0, 0, 0); __builtin_amdgcn_s_setprio(0); } while (0)
#define PG8_WAIT_V(n) asm volatile("s_waitcnt vmcnt(" #n ")" ::: "memory")
#define PG8_WAIT_L(n) asm volatile("s_waitcnt lgkmcnt(" #n ")" ::: "memory")
#define PG8_BAR __builtin_amdgcn_s_barrier()
#define PG8_SCHED __builtin_amdgcn_sched_barrier(0)
    Unit cur, nxt; int ui = 0;
    if (!S.next(0, cur)) return;
    f32x4 acc[2][2][4][2];
#pragma unroll
    for (int a = 0; a < 2; ++a)
#pragma unroll
        for (int b = 0; b < 2; ++b)
#pragma unroll
            for (int m = 0; m < 4; ++m)
#pragma unroll
                for (int n = 0; n < 2; ++n) acc[a][b][m][n] = (f32x4){0.f, 0.f, 0.f, 0.f};
    bf16x8 At[4][2], B0[2][2], B1[2][2];
    const char* cA = (const char*)g.A + (size_t)cur.pm * tstep; const char* cB = (const char*)g.Bt + (size_t)cur.pn * tstep;
    S.a_ready(cur);
    if constexpr (SP2) {
        PG8_STAGE(PG8_SB(0, 0), cB, voffB); PG8_STAGE(PG8_SB(0, 1), cB + hstep, voffB); PG8_STAGE(PG8_SA(0, 0), cA, voffA); PG8_STAGE(PG8_SA(0, 1), cA + hstep, voffA);
        if (wr == 1) PG8_BAR;
        PG8_WAIT_V(2); PG8_BAR;
        PG8_STAGE(PG8_SB(1, 0), cB + kstep, voffB); PG8_STAGE(PG8_SA(1, 0), cA + kstep, voffA); PG8_STAGE(PG8_SB(1, 1), cB + hstep + kstep, voffB);
        PG8_WAIT_V(6); PG8_BAR;
    } else {
        PG8_STAGE(PG8_SB(0, 0), cB, voffB); PG8_STAGE(PG8_SA(0, 0), cA, voffA); PG8_STAGE(PG8_SB(0, 1), cB + hstep, voffB); PG8_STAGE(PG8_SA(0, 1), cA + hstep, voffA);
        if (wr == 1) PG8_BAR;
        PG8_WAIT_V(4); PG8_BAR;
        PG8_STAGE(PG8_SB(1, 0), cB + kstep, voffB); PG8_STAGE(PG8_SA(1, 0), cA + kstep, voffA); PG8_STAGE(PG8_SB(1, 1), cB + hstep + kstep, voffB);
        PG8_WAIT_V(6); PG8_BAR;
    }
    for (;;) {
        const bool has_next = S.next(ui + 1, nxt);
        const char* nA = has_next ? (const char*)g.A + (size_t)nxt.pm * tstep : cA; const char* nB = has_next ? (const char*)g.Bt + (size_t)nxt.pn * tstep : cB;
        for (int t = 0; t < nt; t += 2) {
            const bool last = (t == nt - 2);
            const char* a1 = cA + (size_t)(t + 1) * kstep;
            const char* a2 = last ? nA : cA + (size_t)(t + 2) * kstep; const char* b2 = last ? nB : cB + (size_t)(t + 2) * kstep;
            const char* a3 = a2 + kstep; const char* b3 = b2 + kstep;
            if (last && has_next) S.a_ready(nxt);
            if constexpr (SP2) {
            PG8_LDB(B0, 0, 0); PG8_LDB(B1, 0, 1); PG8_SCHED; PG8_LDA(At, 0, 0); PG8_STAGE(PG8_SA(1, 1), a1 + hstep, voffA);
            PG8_WAIT_V(8); PG8_WAIT_L(0); PG8_BAR; PG8_MMA(0, 0, At, B0); PG8_MMA(0, 1, At, B1); PG8_BAR; PG8_SCHED;
            PG8_LDA(At, 0, 1); PG8_STAGE(PG8_SB(0, 0), b2, voffB); PG8_STAGE(PG8_SB(0, 1), b2 + hstep, voffB); PG8_STAGE(PG8_SA(0, 0), a2, voffA);
            PG8_WAIT_V(8); PG8_WAIT_L(0); PG8_BAR; PG8_MMA(1, 0, At, B0); PG8_MMA(1, 1, At, B1); PG8_BAR; PG8_SCHED;
            PG8_LDB(B0, 1, 0); PG8_LDB(B1, 1, 1); PG8_SCHED; PG8_LDA(At, 1, 0); PG8_STAGE(PG8_SA(0, 1), a2 + hstep, voffA);
            PG8_WAIT_V(8); PG8_WAIT_L(0); PG8_BAR; PG8_MMA(0, 0, At, B0); PG8_MMA(0, 1, At, B1); PG8_BAR; PG8_SCHED;
            PG8_LDA(At, 1, 1); PG8_STAGE(PG8_SB(1, 0), b3, voffB); PG8_STAGE(PG8_SB(1, 1), b3 + hstep, voffB); PG8_STAGE(PG8_SA(1, 0), a3, voffA);
            PG8_WAIT_V(8); PG8_WAIT_L(0); PG8_BAR; PG8_MMA(1, 0, At, B0); PG8_MMA(1, 1, At, B1); PG8_BAR; PG8_SCHED;
            } else {
            PG8_LDB(B0, 0, 0); PG8_SCHED; PG8_LDA(At, 0, 0); PG8_STAGE(PG8_SA(1, 1), a1 + hstep, voffA);
            PG8_WAIT_L(8); PG8_BAR; PG8_WAIT_L(0); PG8_MMA(0, 0, At, B0); PG8_BAR; PG8_SCHED;
            PG8_LDB(B1, 0, 1); PG8_STAGE(PG8_SB(0, 0), b2, voffB);
            PG8_BAR; PG8_WAIT_L(0); PG8_MMA(0, 1, At, B1); PG8_BAR;
            PG8_LDA(At, 0, 1); PG8_STAGE(PG8_SA(0, 0), a2, voffA);
            PG8_BAR; PG8_WAIT_L(0); PG8_MMA(1, 0, At, B0); PG8_BAR; PG8_SCHED;
            PG8_STAGE(PG8_SB(0, 1), b2 + hstep, voffB);
            PG8_WAIT_V(6); PG8_BAR; PG8_MMA(1, 1, At, B1); PG8_BAR;
            PG8_LDB(B0, 1, 0); PG8_SCHED; PG8_LDA(At, 1, 0); PG8_STAGE(PG8_SA(0, 1), a2 + hstep, voffA);
            PG8_WAIT_L(8); PG8_BAR; PG8_WAIT_L(0); PG8_MMA(0, 0, At, B0); PG8_BAR; PG8_SCHED;
            PG8_LDB(B1, 1, 1); PG8_STAGE(PG8_SB(1, 0), b3, voffB);
            PG8_BAR; PG8_WAIT_L(0); PG8_MMA(0, 1, At, B1); PG8_BAR;
            PG8_LDA(At, 1, 1); PG8_STAGE(PG8_SA(1, 0), a3, voffA);
            PG8_BAR; PG8_WAIT_L(0); PG8_MMA(1, 0, At, B0); PG8_BAR; PG8_SCHED;
            PG8_STAGE(PG8_SB(1, 1), b3 + hstep, voffB);
            PG8_WAIT_V(6); PG8_BAR; PG8_MMA(1, 1, At, B1); PG8_BAR;
            }
        }
        if constexpr (ALIGN_EPI) { if (wr == 0) PG8_BAR; }
        if constexpr (!Epi::AFTER_DRAIN) { E(acc, cur, wr, wc, fr, fq); S.done(cur); }
        if (!has_next) break;
#pragma unroll
        for (int a = 0; a < 2; ++a)
#pragma unroll
            for (int b = 0; b < 2; ++b)
#pragma unroll
                for (int m = 0; m < 4; ++m)
#pragma unroll
                    for (int n = 0; n < 2; ++n) acc[a][b][m][n] = (f32x4){0.f, 0.f, 0.f, 0.f};
        cur = nxt; cA = nA; cB = nB; ++ui;
        if constexpr (ALIGN_EPI) { if (wr == 1) PG8_BAR; }
    }
    PG8_WAIT_V(0);
    if constexpr (!ALIGN_EPI) { if (wr == 0) PG8_BAR; }
    PG8_BAR;
    if constexpr (Epi::AFTER_DRAIN) { E.fused(acc, cur, wr, wc, fr, fq, lds, wid, lane); S.done(cur); }
#undef PG8_SA
#undef PG8_SB
#undef PG8_STAGE
#undef PG8_LDA
#undef PG8_LDB
#undef PG8_MMA
#undef PG8_WAIT_V
#undef PG8_WAIT_L
#undef PG8_BAR
#undef PG8_SCHED
}
}

constexpr int DM = 2048, NB = 8, SEQ = 4096, NMETA = 16, LSEQ = 4112, LPAD = 4128;
constexpr int MREAL = NB * SEQ;
constexpr int MPAD = MREAL + 256;
constexpr int MT_REAL = MREAL / 256;
constexpr int DFF = 5632, NGU = 2 * DFF, NNG = 7168, NGATE = 8192, INCOLS = 15184, NGC = 6992;
constexpr int NWAVES = 8;
constexpr float EPS = 1e-6f;
constexpr int C_AQ = 0, C_AF = 512, C_AI = 1024, C_AG = 1536, C_BB = 2048, C_BC = 2560, C_BU = 3072, C_CQ = 3584, C_CK = 4096, C_CV = 4608,
              C_DQ = 5120, C_DK = 5632, C_DV = 5760, C_DQI = 5888, C_DKI = 6912, C_DW = 6976;

constexpr size_t MiB = 1u << 20;
constexpr size_t WS_CTL = 0, CTL_ZERO_BYTES = 1 * MiB;
constexpr size_t WS_HM = 1 * MiB;
constexpr size_t WS_W = 4 * MiB;
constexpr size_t W_GU1 = 0, W_D1 = W_GU1 + (size_t)NGU * DM * 2, W_NG = W_D1 + (size_t)DM * DFF * 2, W_G = W_NG + (size_t)NNG * DM * 2,
                 W_BR = W_G + (size_t)NGATE * DM * 2, W_O = W_BR + (size_t)4 * DM * 512 * 2, W_GU2 = W_O + (size_t)DM * DM * 2, W_D2 = W_GU2 + (size_t)NGU * DM * 2,
                 W_END = W_D2 + (size_t)DM * DFF * 2;
constexpr size_t WS_XN = WS_W + W_END;
constexpr size_t WS_BR = WS_XN + (size_t)MPAD * DM * 2;
constexpr size_t WS_BIG = WS_BR + (size_t)MPAD * DM * 2;
constexpr size_t BIG_P_END = (size_t)MPAD * NNG * 2;
constexpr size_t WS_VTC = WS_BIG + BIG_P_END;
constexpr size_t WS_VTD = WS_VTC + (size_t)NB * 4 * 128 * LPAD * 2;
constexpr size_t WS_MASK = WS_VTD + (size_t)NB * 128 * LPAD * 2;
constexpr int MASKW = 132;
constexpr int NIDX_WG = 172;
constexpr int NHG_WG = 32;
constexpr size_t WS_SCR = WS_MASK + (size_t)NB * LPAD * MASKW * 4;
constexpr size_t WS_HA = WS_SCR + (size_t)NIDX_WG * 32 * LPAD * 4;
constexpr size_t WS_HDL = WS_HA + (size_t)NB * 4 * 64 * 64 * 64 * 2;
constexpr size_t WS_HMETA = WS_HDL + (size_t)NB * 4 * 64 * 128 * 4;
constexpr size_t HMETA_STRIDE = 64 * 384 * 2 + 64 * 64 * 2 + 128 * 4;
constexpr size_t WS_END = WS_HMETA + 4 * HMETA_STRIDE;
static_assert(WS_BIG + (size_t)MPAD * NGATE * 2 <= WS_END, "G fits");
static_assert(WS_END <= (size_t)1138174976, "workspace map fits the guaranteed size");

constexpr int RING_OFF = 0, RING_BYTES = 131072;
constexpr int LDSCTL_OFF = 143360, MISC_OFF = LDSCTL_OFF + 320;
constexpr int LDS_BYTES = 147456;

#define GAS __attribute__((address_space(1)))
#define LAS __attribute__((address_space(3)))
typedef unsigned short bf16;
typedef unsigned v4u __attribute__((ext_vector_type(4)));
typedef unsigned v2u __attribute__((ext_vector_type(2)));
typedef float f32x4 __attribute__((ext_vector_type(4)));
typedef float f32x16 __attribute__((ext_vector_type(16)));
typedef short bf16x8 __attribute__((ext_vector_type(8)));
typedef GAS unsigned gu32;
#define RLX_AGENT __ATOMIC_RELAXED, __HIP_MEMORY_SCOPE_AGENT
#define LDS_WAIT() asm volatile("s_waitcnt lgkmcnt(0)" ::: "memory")
#define VM_WAIT() asm volatile("s_waitcnt vmcnt(0)" ::: "memory")
__device__ __forceinline__ unsigned f2bf(float f) { unsigned u = __builtin_bit_cast(unsigned, f); return (u + 0x7fffu + ((u >> 16) & 1u)) >> 16; }
__device__ __forceinline__ unsigned f2bf_s(float f) { return pg8::cvt_pk_bf16(f, 0.f) & 0xffffu; }
__device__ __forceinline__ unsigned pk2(float lo, float hi) { return pg8::cvt_pk_bf16(lo, hi); }
__device__ __forceinline__ float bflo(unsigned w) { return __uint_as_float(w << 16); }
__device__ __forceinline__ float bfhi(unsigned w) { return __uint_as_float(w & 0xffff0000u); }
__device__ __forceinline__ float bf2f(bf16 v) { return __uint_as_float((unsigned)v << 16); }
__device__ __forceinline__ int seqrow(int b, int p) { return p < NMETA ? MREAL + p : b * SEQ + p - NMETA; }
__device__ __forceinline__ int rel_bucket(int n) {
    if (n < 16) return n; if (n >= 128) return 31;
    const int v = 16 + (int)(__log2f((float)n * 0.0625f) * 5.33333333f); return v < 31 ? v : 31; }
__device__ __forceinline__ float wave_sum(float v) {
#pragma unroll
    for (int o = 1; o < 64; o <<= 1) v += __shfl_xor(v, o);
    return v;
}
#define XB_TMO      128
#define XB_XCNT(j)  (256  + 64 * (j))
#define XB_XSUB(j)  (1280 + 64 * (j))
#define XB_XGEN(j)  (2304 + 64 * (j))
#define XB_TOP      3328
#define XB_TOPGEN   3392
#define XCD_BAR_WORDS 3456
#define XB_SPIN_CAP (1u << 18)

__device__ __forceinline__ unsigned xb_ld(unsigned* p)              { return __hip_atomic_load(p, __ATOMIC_RELAXED, __HIP_MEMORY_SCOPE_AGENT); }
__device__ __forceinline__ unsigned xb_add(unsigned* p, unsigned v) { return __hip_atomic_fetch_add(p, v, __ATOMIC_RELAXED, __HIP_MEMORY_SCOPE_AGENT); }
__device__ __forceinline__ unsigned xb_xcc_id() { return (unsigned)__builtin_amdgcn_s_getreg((3 << 11) | 20) & 0xFu; }
#define XB_SPIN(cond, bar) do { unsigned _sp = 0; while (cond) { __builtin_amdgcn_s_sleep(1); \
    if ((++_sp & 255u) == 0u) { if (xb_ld(&(bar)[XB_TMO])) break; if (_sp > XB_SPIN_CAP) { atomicAdd(&(bar)[XB_TMO], 1u); break; } } } } while (0)

struct XcdBarrier {
    int wave;
    unsigned* bar; unsigned x;
    volatile LAS unsigned* st;
};

__device__ __forceinline__ bool xb_thread0(int wave) { unsigned mk = ~0u; asm volatile("" : "+s"(mk)); return wave == 0 && __builtin_amdgcn_mbcnt_hi(mk, __builtin_amdgcn_mbcnt_lo(mk, 0u)) == 0u; }
__device__ __forceinline__ XcdBarrier xcd_barrier_post(unsigned* bar, volatile LAS unsigned* st, int wave) {
    XcdBarrier b; b.wave = wave; b.bar = bar; b.x = xb_xcc_id(); b.st = st;
    if (xb_thread0(wave)) (void)xb_add(&bar[XB_XCNT(b.x)], 1u);
    return b;
}
__device__ __forceinline__ void xcd_barrier_complete(unsigned* bar, unsigned x, unsigned& nloc, unsigned& nx) {
    const unsigned G = gridDim.x * gridDim.y * gridDim.z;
    unsigned sum, cnt, mine, sp = 0u;
    for (;;) {
        sum = 0u; cnt = 0u; mine = 0u;
#pragma unroll
        for (unsigned j = 0; j < 16; ++j) { const unsigned c = xb_ld(&bar[XB_XCNT(j)]); sum += c; cnt += (c > 0u) ? 1u : 0u; mine = (j == x) ? c : mine; }
        if (sum == G) break;
        __builtin_amdgcn_s_sleep(1);
        if ((++sp & 255u) == 0u) { if (xb_ld(&bar[XB_TMO])) break; if (sp > XB_SPIN_CAP) { atomicAdd(&bar[XB_TMO], 1u); break; } }
    }
    nloc = mine > 0u ? mine : 1u; nx = cnt > 0u ? cnt : 1u;
}

__device__ __forceinline__ void xcd_barrier(const XcdBarrier& b) {
    asm volatile("s_waitcnt vmcnt(0)" ::: "memory");
    __syncthreads();
    if (xb_thread0(b.wave)) {
        unsigned* bar = b.bar;
        __builtin_amdgcn_s_waitcnt(0);
        unsigned nloc = b.st[0], nx = b.st[1];
        if (nloc == 0u) { xcd_barrier_complete(bar, b.x, nloc, nx); b.st[0] = nloc; b.st[1] = nx; }
        const unsigned old = xb_add(&bar[XB_XSUB(b.x)], 1u);
        const unsigned gen = old / nloc;
        if (old + 1u == (gen + 1u) * nloc) {
            __builtin_amdgcn_fence(__ATOMIC_RELEASE, "agent");
            asm volatile("s_waitcnt vmcnt(0)" ::: "memory");
            const unsigned og = xb_add(&bar[XB_TOP], 1u);
            const unsigned tg = og / nx;
            if (og + 1u == (tg + 1u) * nx) xb_add(&bar[XB_TOPGEN], 1u);
            else XB_SPIN(xb_ld(&bar[XB_TOPGEN]) == tg, bar);
            __builtin_amdgcn_fence(__ATOMIC_ACQUIRE, "agent");
            xb_add(&bar[XB_XGEN(b.x)], 1u);
            asm volatile("s_waitcnt vmcnt(0)" ::: "memory");
        } else {
            XB_SPIN(xb_ld(&bar[XB_XGEN(b.x)]) == gen, bar);
            __builtin_amdgcn_fence(__ATOMIC_ACQUIRE, "agent");
            asm volatile("s_waitcnt vmcnt(0)" ::: "memory");
        }
    }
    __syncthreads();
}

struct Frame {
    LAS unsigned char* lds;
    volatile LAS unsigned* MISC;
    gu32* ctl;
    int tid, lane, wave, G, bid;
    const unsigned char __attribute__((address_space(4)))* karg; float* out; unsigned char* ws;
};
__device__ __forceinline__ const float* fin_load(const unsigned char __attribute__((address_space(4)))* k, int i) { asm volatile("" : "+s"(k)); return *(const float* const __attribute__((address_space(4)))*)(k + 8 * i); }
#define FIN(F_, i_) fin_load((F_).karg, (i_))
enum { I_X = 0, I_META, I_RELB, I_F1N, I_F1GU, I_F1D, I_MIXN, I_WIN, I_LB, I_GN, I_CONVW, I_DQN, I_DKN, I_DLAM, I_DSUB, I_SQN, I_SKN, I_WBR, I_WOUT, I_F2N, I_F2GU, I_F2D };

template <class RowMap>
__device__ __forceinline__ void transpose_item(const float* W, int K, int N, bf16* WT, LAS float* scr, int item, int lane, RowMap rm) {
    const int nblk = (N + 31) / 32, kb = item / nblk, nb = item % nblk, k0 = 64 * kb, n0 = 32 * nb;
    const int nl = n0 + (lane & 31); const bool nok = nl < N;
#pragma unroll 8
    for (int i = 0; i < 32; ++i) { const int kk = 2 * i + (lane >> 5); scr[kk * 33 + (lane & 31)] = nok ? W[(size_t)(k0 + kk) * N + nl] : 0.f; }
    LDS_WAIT(); asm volatile("" ::: "memory");
    const int c = lane & 7;
#pragma unroll
    for (int j = 0; j < 4; ++j) { const int n = (lane >> 3) + 8 * j; const LAS float* s = scr + (8 * c) * 33 + n;
        v4u o; o.x = pk2(s[0 * 33], s[1 * 33]); o.y = pk2(s[2 * 33], s[3 * 33]); o.z = pk2(s[4 * 33], s[5 * 33]); o.w = pk2(s[6 * 33], s[7 * 33]);
        if (n0 + n < N) *(GAS v4u*)(WT + (size_t)rm(n0 + n) * K + k0 + 8 * c) = o; }
    LDS_WAIT(); asm volatile("" ::: "memory");
}
struct MapId { __device__ __forceinline__ int operator()(int n) const { return n; } };
struct MapGU { __device__ __forceinline__ int operator()(int n) const { const int up = n >= DFF, j = up ? n - DFF : n; return 256 * (j >> 7) + 128 * up + (j & 127); } };
struct MapIn { __device__ __forceinline__ int operator()(int n) const { return n < NGC ? n : n + (NNG - NGC); } };
template <class RowMap>
__device__ __forceinline__ void convert_matrix(Frame& F, const float* W, int K, int N, bf16* WT, RowMap rm) {
    LAS float* scr = (LAS float*)(F.lds + F.wave * 16384);
    const int gw = F.bid * NWAVES + F.wave, NGW = F.G * NWAVES, nitems = (K / 64) * ((N + 31) / 32);
    for (int it = gw; it < nitems; it += NGW) transpose_item(W, K, N, WT, scr, it, F.lane, rm);
}
__device__ __forceinline__ void phase_convert(Frame& F, int l) {
    unsigned char* wb = F.ws + WS_W;
    convert_matrix(F, FIN(F, I_F1GU) + (size_t)l * DM * NGU, DM, NGU, (bf16*)(wb + W_GU1), MapGU());
    convert_matrix(F, FIN(F, I_F1D) + (size_t)l * DFF * DM, DFF, DM, (bf16*)(wb + W_D1), MapId());
    convert_matrix(F, FIN(F, I_WIN) + (size_t)l * DM * INCOLS, DM, INCOLS, (bf16*)(wb + W_NG), MapIn());
    for (int m = 0; m < 4; ++m) convert_matrix(F, FIN(F, I_WBR) + ((size_t)l * 4 + m) * 512 * DM, 512, DM, (bf16*)(wb + W_BR) + (size_t)m * DM * 512, MapId());
    convert_matrix(F, FIN(F, I_WOUT) + (size_t)l * DM * DM, DM, DM, (bf16*)(wb + W_O), MapId());
    convert_matrix(F, FIN(F, I_F2GU) + (size_t)l * DM * NGU, DM, NGU, (bf16*)(wb + W_GU2), MapGU());
    convert_matrix(F, FIN(F, I_F2D) + (size_t)l * DFF * DM, DFF, DM, (bf16*)(wb + W_D2), MapId());
    { GAS v4u* z = (GAS v4u*)(wb + W_NG + (size_t)NGC * DM * 2); const int n16 = (NNG - NGC) * DM * 2 / 16;
      for (int i = F.bid * 512 + F.tid; i < n16; i += F.G * 512) z[i] = (v4u){0u, 0u, 0u, 0u}; }
    if (l == 0) {
        GAS f32x4* hm = (GAS f32x4*)(F.ws + WS_HM); const GAS f32x4* mt = (const GAS f32x4*)FIN(F, I_META);
        for (int i = F.bid * 512 + F.tid; i < 256 * DM / 4; i += F.G * 512) hm[i] = (i < NMETA * DM / 4) ? mt[i] : (f32x4){0.f, 0.f, 0.f, 0.f};
    }
}
__device__ __forceinline__ void phase_norm(Frame& F, const float* src_real, const float* gain) {
    const int gw = F.bid * NWAVES + F.wave, NGW = F.G * NWAVES;
    bf16* XN = (bf16*)(F.ws + WS_XN); const float* hm = (const float*)(F.ws + WS_HM);
    f32x4 g[8];
#pragma unroll
    for (int j = 0; j < 8; ++j) g[j] = ((const GAS f32x4*)gain)[F.lane + 64 * j];
    for (int r = gw; r < MPAD; r += NGW) {
        GAS v2u* o8 = (GAS v2u*)(XN + (size_t)r * DM) + F.lane;
        if (r >= MREAL + NMETA) {
#pragma unroll
            for (int j = 0; j < 8; ++j) o8[64 * j] = (v2u){0u, 0u};
            continue; }
        const float* xr = r < MREAL ? src_real + (size_t)r * DM : hm + (size_t)(r - MREAL) * DM;
        f32x4 v[8]; float s = 0.f;
#pragma unroll
        for (int j = 0; j < 8; ++j) { v[j] = ((const GAS f32x4*)xr)[F.lane + 64 * j]; s += (v[j].x * v[j].x + v[j].y * v[j].y) + (v[j].z * v[j].z + v[j].w * v[j].w); }
        const float inv = 1.0f / sqrtf(wave_sum(s) * (1.f / DM) + EPS);
#pragma unroll
        for (int j = 0; j < 8; ++j) { v2u w; w.x = pk2(v[j].x * inv * g[j].x, v[j].y * inv * g[j].y); w.y = pk2(v[j].z * inv * g[j].z, v[j].w * inv * g[j].w); o8[64 * j] = w; }
    }
}

__device__ __forceinline__ f32x4 meta_dot16(const bf16* A  , int lda, const bf16* Bt  , int K, int s0, int s1, int lane) {
    const int fr = lane & 15, g = lane >> 4; const bf16* ap = A + (size_t)fr * lda + 8 * g; const bf16* bp = Bt + (size_t)fr * K + 8 * g;
    f32x4 a0 = (f32x4){0.f, 0.f, 0.f, 0.f}, a1 = a0;
    for (int s = s0; s < s1; s += 2) {
        const bf16x8 x0 = *(const GAS bf16x8*)(ap + 32 * s), x1 = *(const GAS bf16x8*)(ap + 32 * s + 32);
        const bf16x8 w0 = *(const GAS bf16x8*)(bp + 32 * s), w1 = *(const GAS bf16x8*)(bp + 32 * s + 32);
        a0 = __builtin_amdgcn_mfma_f32_16x16x32_bf16(w0, x0, a0, 0, 0, 0); a1 = __builtin_amdgcn_mfma_f32_16x16x32_bf16(w1, x1, a1, 0, 0, 0); }
    return a0 + a1;
}
__device__ __forceinline__ void st_bf16x4(bf16* p, f32x4 v) { v2u w; w.x = pk2(v[0], v[1]); w.y = pk2(v[2], v[3]); *(GAS v2u*)p = w; }
__device__ __forceinline__ void meta_gemm(Frame& F, int kind, const bf16* A, int lda, const bf16* Bt, int N, int K, bf16* Obf, int ldo, float scale) {
    const int lane = F.lane, wave = F.wave, fr = lane & 15, g = lane >> 4;
    const int ngroups = (kind == 0 ? N / 2 : N) / 16;
    LAS f32x4* red = (LAS f32x4*)F.lds;
    const int ns = K / 32, s0 = (wave * ns) >> 3, s1 = ((wave + 1) * ns) >> 3;
    for (int cg = F.bid; cg < ngroups; cg += F.G) {
        const int n0 = 16 * cg;
        f32x4 p0, p1 = (f32x4){0.f, 0.f, 0.f, 0.f};
        if (kind == 0) { const int rg = 256 * (n0 >> 7) + (n0 & 127);
            p0 = meta_dot16(A, lda, Bt + (size_t)rg * K, K, s0, s1, lane); p1 = meta_dot16(A, lda, Bt + (size_t)(rg + 128) * K, K, s0, s1, lane); }
        else if (kind == 4) { const int mb = wave >> 1, kh = wave & 1; p0 = meta_dot16(A + (size_t)mb * MPAD * 512, 512, Bt + ((size_t)mb * DM + n0) * 512, 512, 8 * kh, 8 * kh + 8, lane); }
        else p0 = meta_dot16(A, lda, Bt + (size_t)n0 * K, K, s0, s1, lane);
        red[wave * 64 + lane] = p0; if (kind == 0) red[512 + wave * 64 + lane] = p1;
        LDS_WAIT(); __syncthreads();
        if (wave == 0) {
            f32x4 q[8];
#pragma unroll
            for (int w = 0; w < 8; ++w) q[w] = red[w * 64 + lane];
            if (kind == 4) { f32x4 tot = (f32x4){0.f, 0.f, 0.f, 0.f}; const bf16* G = (const bf16*)(F.ws + WS_BIG);
#pragma unroll
                for (int mb = 0; mb < 4; ++mb) { const f32x4 acc = q[2 * mb] + q[2 * mb + 1]; const v2u gw2 = *(const GAS v2u*)(G + (size_t)(MREAL + fr) * NGATE + mb * DM + n0 + 4 * g);
                    tot[0] += bflo(gw2.x) * acc[0]; tot[1] += bfhi(gw2.x) * acc[1]; tot[2] += bflo(gw2.y) * acc[2]; tot[3] += bfhi(gw2.y) * acc[3]; }
                st_bf16x4(Obf + (size_t)(MREAL + fr) * ldo + n0 + 4 * g, tot);
            } else {
                f32x4 acc = ((q[0] + q[1]) + (q[2] + q[3])) + ((q[4] + q[5]) + (q[6] + q[7]));
                if (kind == 0) { f32x4 up = (f32x4){0.f, 0.f, 0.f, 0.f};
#pragma unroll
                    for (int w = 0; w < 8; ++w) up += red[512 + w * 64 + lane];
#pragma unroll
                    for (int r = 0; r < 4; ++r) acc[r] = pg8::fast_silu(acc[r]) * up[r];
                    st_bf16x4(Obf + (size_t)(MREAL + fr) * ldo + n0 + 4 * g, acc); }
                else if (kind == 1) { float* hp = (float*)(F.ws + WS_HM) + (size_t)fr * DM + n0 + 4 * g; *(GAS f32x4*)hp = *(const GAS f32x4*)hp + acc * scale; }
                else if (kind == 2) st_bf16x4(Obf + (size_t)(MREAL + fr) * ldo + n0 + 4 * g, acc);
                else {
#pragma unroll
                    for (int r = 0; r < 4; ++r) acc[r] = pg8::fast_sigmoid(acc[r]);
                    st_bf16x4(Obf + (size_t)(MREAL + fr) * ldo + n0 + 4 * g, acc); }
            }
        }
        __syncthreads();
    }
}
__device__ __forceinline__ void unpack8(const v4u w, float (&x)[8]) { x[0] = bflo(w.x); x[1] = bfhi(w.x); x[2] = bflo(w.y); x[3] = bfhi(w.y); x[4] = bflo(w.z); x[5] = bfhi(w.z); x[6] = bflo(w.w); x[7] = bfhi(w.w); }
__device__ __forceinline__ v4u pack8(const float (&x)[8]) { v4u w; w.x = pk2(x[0], x[1]); w.y = pk2(x[2], x[3]); w.z = pk2(x[4], x[5]); w.w = pk2(x[6], x[7]); return w; }
template <int GL>
__device__ __forceinline__ void norm_cols_inplace(bf16* p, const v4u w, const float* gain, float scale, int lane, bool wr) {
    float x[8]; unpack8(w, x); float s = 0.f;
#pragma unroll
    for (int i = 0; i < 8; ++i) s += x[i] * x[i];
#pragma unroll
    for (int o = 1; o < GL; o <<= 1) s += __shfl_xor(s, o);
    const float inv = scale / sqrtf(s * (1.f / (GL * 8)) + EPS); const int g0 = (8 * lane) % (GL * 8);
#pragma unroll
    for (int i = 0; i < 8; ++i) x[i] = x[i] * inv * gain[g0 + i];
    if (wr) *(GAS v4u*)p = pack8(x);
}
__device__ __forceinline__ void prep_row(Frame& F, int l, int r) {
    const int lane = F.lane; bf16* pr = (bf16*)(F.ws + WS_BIG) + (size_t)r * NNG;
    const float *dqn = FIN(F, I_DQN) + l * 64, *dkn = FIN(F, I_DKN) + l * 64, *sqn = FIN(F, I_SQN) + l * 128, *skn = FIN(F, I_SKN) + l * 128;
    const v4u w0 = *(const GAS v4u*)(pr + C_CQ + 8 * lane), w1 = *(const GAS v4u*)(pr + C_CK + 8 * lane), w2 = *(const GAS v4u*)(pr + C_DQ + 8 * lane), w3 = *(const GAS v4u*)(pr + C_DK + 8 * (lane & 15));
    __builtin_amdgcn_sched_barrier(0);
    norm_cols_inplace<8>(pr + C_CQ + 8 * lane, w0, dqn, 0.125f * 1.4426950408889634f, lane, true);
    norm_cols_inplace<8>(pr + C_CK + 8 * lane, w1, dkn, 1.0f, lane, true);
    norm_cols_inplace<16>(pr + C_DQ + 8 * lane, w2, sqn, 0.08838834764831845f * 1.4426950408889634f, lane, true);
    norm_cols_inplace<16>(pr + C_DK + 8 * (lane & 15), w3, skn, 1.0f, lane & 15, lane < 16);
}
constexpr int VT_NPB = (LPAD + 63) / 64, VT_NTASK = NB * 5 * VT_NPB;
__device__ __forceinline__ void vt_task(Frame& F, int task) {
    const int lane = F.lane;
    const bf16* P = (const bf16*)(F.ws + WS_BIG); bf16* VtC = (bf16*)(F.ws + WS_VTC); bf16* VtD = (bf16*)(F.ws + WS_VTD);
    LAS bf16* T = (LAS bf16*)(F.lds + F.wave * 17408);
    const int pb = task % VT_NPB, mat = (task / VT_NPB) % 5, b = task / (VT_NPB * 5), p0 = 64 * pb;
    const int col = mat < 4 ? C_CV + 128 * mat : C_DV;
#pragma unroll 4
    for (int i = 0; i < 16; ++i) { const int pl = 4 * i + (lane >> 4), p = p0 + pl;
        v4u w = *(const GAS v4u*)(P + (size_t)seqrow(b, p < LSEQ ? p : LSEQ - 1) * NNG + col + 8 * (lane & 15)); if (p >= LSEQ) w = (v4u){0u, 0u, 0u, 0u};
        *(LAS v4u*)(T + pl * 136 + 8 * (lane & 15)) = w; }
    LDS_WAIT(); asm volatile("" ::: "memory");
    bf16* dst = mat < 4 ? VtC + (size_t)(b * 4 + mat) * 128 * LPAD : VtD + (size_t)b * 128 * LPAD;
#pragma unroll 4
    for (int it = 0; it < 16; ++it) { const int e = 8 * it + (lane >> 3), c = lane & 7; unsigned short x[8];
#pragma unroll
        for (int k = 0; k < 8; ++k) x[k] = T[(8 * c + k) * 136 + e];
        v4u w; w.x = x[0] | ((unsigned)x[1] << 16); w.y = x[2] | ((unsigned)x[3] << 16); w.z = x[4] | ((unsigned)x[5] << 16); w.w = x[6] | ((unsigned)x[7] << 16);
        if (p0 + 8 * c < LPAD) *(GAS v4u*)(dst + (size_t)e * LPAD + p0 + 8 * c) = w; }
    LDS_WAIT(); asm volatile("" ::: "memory");
}

#define NEG_INF (-__builtin_inff())
constexpr int NQT = (LSEQ + 31) / 32;
constexpr int NQB = (NQT + 7) / 8;
__device__ __forceinline__ bf16x8 ld_frag16(const bf16* p) { return *(const GAS bf16x8*)p; }
__device__ __forceinline__ bf16x8 mk_frag(v2u lo, v2u hi) { v4u w; w.x = lo.x; w.y = lo.y; w.z = hi.x; w.w = hi.y; return __builtin_bit_cast(bf16x8, w); }
__device__ __forceinline__ unsigned cvtpk(float lo, float hi) { return pg8::cvt_pk_bf16(lo, hi); }
__device__ __forceinline__ void build_bias_table(Frame& F, LAS float* bt, int col0) {
    const float* rb = FIN(F, I_RELB);
    for (int i = F.tid; i < 4 * 128; i += 512) { const int hd = i >> 7, n = i & 127; bt[i] = (rb[rel_bucket(n) * 8 + col0 + hd] - rb[31 * 8 + col0 + hd]) * 1.4426950408889634f; }
}
__device__ __forceinline__ bool softmax_step(f32x16& S, float& m, float& lsum, float& alpha) {
    float tm = S[0];
#pragma unroll
    for (int r = 1; r < 16; ++r) tm = fmaxf(tm, S[r]);
    tm = fmaxf(tm, __shfl_xor(tm, 32));
    const bool raise = __any(tm > m + 11.5f);
    alpha = 1.0f;
    if (raise) { const float mn = fmaxf(m, tm); alpha = (mn == NEG_INF) ? 1.0f : __builtin_amdgcn_exp2f(m - mn); m = mn; lsum *= alpha; }
    const float mref = (m == NEG_INF) ? 0.f : m;
    float rs = 0.f;
#pragma unroll
    for (int r = 0; r < 16; ++r) { S[r] = __builtin_amdgcn_exp2f(S[r] - mref); rs += S[r]; }
    rs += __shfl_xor(rs, 32);
    lsum += rs;
    return raise;
}
template <bool DSA>
__device__ __forceinline__ void attn_wg_task(Frame& F, int l, int b, int h, int J, const LAS float* bt, float lam, float post) {
    constexpr int KD = DSA ? 128 : 64, KP = KD + 8, VP = 36, NKS = KD / 16;
    constexpr int KBUF = 32 * KP, VBUF = 128 * VP;
    const int lane = F.lane, ql = lane & 31, hh = lane >> 5, wave = F.wave, tid = F.tid;
    LAS bf16* Kl = (LAS bf16*)F.lds; LAS bf16* Vl = Kl + 2 * KBUF;
    const bf16* P = (const bf16*)(F.ws + WS_BIG);
    const bf16* Vt = DSA ? (const bf16*)(F.ws + WS_VTD) + (size_t)b * 128 * LPAD : (const bf16*)(F.ws + WS_VTC) + (size_t)(b * 4 + h) * 128 * LPAD;
    const int jr = 8 * J + wave - 7; const bool wvalid = jr >= 0 && 32 * jr < LSEQ; const int j = jr < 0 ? 0 : jr;
    const int ktmax = (8 * J < NQT - 1) ? 8 * J : NQT - 1;
    const int pq = 32 * j + ql, pqc = pq < LSEQ ? pq : LSEQ - 1;
    const bf16* qrow = P + (size_t)seqrow(b, pqc) * NNG + (DSA ? C_DQ : C_CQ) + h * 128 + 8 * hh;
    const unsigned* mrow = (const unsigned*)(F.ws + WS_MASK) + ((size_t)b * LPAD + pqc) * MASKW;
    const int kr = tid / (KD / 8), kc = tid % (KD / 8); const bool kload = tid < 32 * (KD / 8);
    const int vr = tid >> 2, vc = tid & 3;
    f32x16 R[4];
#pragma unroll
    for (int c = 0; c < (DSA ? 1 : 2); ++c) {
        const int kcol = DSA ? C_DK : C_CK + h * 128 + c * 64;
        bf16x8 qf[NKS];
#pragma unroll
        for (int ks = 0; ks < NKS; ++ks) qf[ks] = ld_frag16(qrow + (DSA ? 0 : c * 64) + 16 * ks);
        float m = NEG_INF, lsum = 0.f; f32x16 O[4];
#pragma unroll
        for (int eb = 0; eb < 4; ++eb)
#pragma unroll
            for (int r = 0; r < 16; ++r) O[eb][r] = 0.f;
        v4u rk0 = (v4u){0u, 0u, 0u, 0u}, rv0 = rk0, rk1 = rk0, rv1 = rk0;
#define ATT_ISSUE(kt_, RK, RV) do { int pk_ = 32 * (kt_) + kr; pk_ = pk_ < LSEQ ? pk_ : LSEQ - 1; \
            if (kload) RK = *(const GAS v4u*)(P + (size_t)seqrow(b, pk_) * NNG + kcol + 8 * kc); \
            RV = *(const GAS v4u*)(Vt + (size_t)vr * LPAD + 32 * (kt_) + 8 * vc); } while (0)
#define ATT_COMMIT(buf_, RK, RV) do { if (kload) *(LAS v4u*)(Kl + (buf_) * KBUF + kr * KP + 8 * kc) = RK; \
            LAS v2u* vd_ = (LAS v2u*)(Vl + (buf_) * VBUF + vr * VP + 8 * vc); vd_[0] = (v2u){RV.x, RV.y}; vd_[1] = (v2u){RV.z, RV.w}; } while (0)
        unsigned mwc = 0xffffffffu, mwn = 0xffffffffu; if (DSA) mwc = mrow[0];
        auto compute = [&](int kt, int buf) {
            if (DSA) mwn = mrow[kt + 1 <= ktmax ? kt + 1 : ktmax];
            if (wvalid && kt <= j) {
                const LAS bf16* Kt = Kl + buf * KBUF + ql * KP + 8 * hh; const LAS bf16* Vb = Vl + buf * VBUF + ql * VP + 4 * hh;
                f32x16 S;
#pragma unroll
                for (int r = 0; r < 16; ++r) S[r] = 0.f;
#pragma unroll
                for (int ks = 0; ks < NKS; ++ks) S = __builtin_amdgcn_mfma_f32_32x32x16_bf16(*(const LAS bf16x8*)(Kt + 16 * ks), qf[ks], S, 0, 0, 0);
                const unsigned mw = mwc >> (4 * hh);
                if (kt + 4 >= j) {
#pragma unroll
                    for (int r = 0; r < 16; ++r) { const int ko = (r & 3) + 8 * (r >> 2), n = pq - (32 * kt + 4 * hh + ko); const bool sel = ((mw >> ko) & 1u) && n >= 0;
                        S[r] = sel ? S[r] + bt[h * 128 + (n < 127 ? n : 127)] : NEG_INF; }
                } else if (DSA) {
#pragma unroll
                    for (int r = 0; r < 16; ++r) { const int ko = (r & 3) + 8 * (r >> 2); S[r] = ((mw >> ko) & 1u) ? S[r] : NEG_INF; }
                }
                float alpha;
                if (softmax_step(S, m, lsum, alpha)) {
#pragma unroll
                    for (int eb = 0; eb < 4; ++eb)
#pragma unroll
                        for (int r = 0; r < 16; ++r) O[eb][r] *= alpha;
                }
                bf16x8 pf[2];
#pragma unroll
                for (int s = 0; s < 2; ++s) { v4u w; w.x = cvtpk(S[8 * s + 0], S[8 * s + 1]); w.y = cvtpk(S[8 * s + 2], S[8 * s + 3]); w.z = cvtpk(S[8 * s + 4], S[8 * s + 5]); w.w = cvtpk(S[8 * s + 6], S[8 * s + 7]); pf[s] = __builtin_bit_cast(bf16x8, w); }
#pragma unroll
                for (int eb = 0; eb < 4; ++eb)
#pragma unroll
                    for (int s = 0; s < 2; ++s) { const LAS bf16* vp = Vb + eb * 32 * VP + 16 * s;
                        O[eb] = __builtin_amdgcn_mfma_f32_32x32x16_bf16(mk_frag(*(const LAS v2u*)vp, *(const LAS v2u*)(vp + 8)), pf[s], O[eb], 0, 0, 0); }
            }
            if (DSA) mwc = mwn; };
        __syncthreads();
        ATT_ISSUE(0, rk0, rv0); ATT_COMMIT(0, rk0, rv0);
        if (ktmax >= 1) ATT_ISSUE(1, rk1, rv1);
        for (int kt = 0; kt <= ktmax; kt += 2) {
            LDS_WAIT(); __syncthreads();
            if (kt + 2 <= ktmax) ATT_ISSUE(kt + 2, rk0, rv0);
            compute(kt, 0);
            if (kt + 1 <= ktmax) ATT_COMMIT(1, rk1, rv1);
            if (kt + 1 > ktmax) break;
            LDS_WAIT(); __syncthreads();
            if (kt + 3 <= ktmax) ATT_ISSUE(kt + 3, rk1, rv1);
            compute(kt + 1, 1);
            if (kt + 2 <= ktmax) ATT_COMMIT(0, rk0, rv0);
        }
#undef ATT_ISSUE
#undef ATT_COMMIT
        const float il = 1.0f / lsum;
        if (DSA) {
#pragma unroll
            for (int eb = 0; eb < 4; ++eb)
#pragma unroll
                for (int r = 0; r < 16; ++r) R[eb][r] = O[eb][r] * il;
        } else if (c == 0) {
            LAS unsigned* rp = (LAS unsigned*)(F.lds + 28672) + wave * 2048 + lane;
#pragma unroll
            for (int eb = 0; eb < 4; ++eb)
#pragma unroll
                for (int r = 0; r < 16; r += 2) rp[(eb * 8 + (r >> 1)) * 64] = pk2(O[eb][r] * il, O[eb][r + 1] * il);
        } else {
            const LAS unsigned* rp = (const LAS unsigned*)(F.lds + 28672) + wave * 2048 + lane;
#pragma unroll
            for (int eb = 0; eb < 4; ++eb)
#pragma unroll
                for (int r = 0; r < 16; r += 2) { const unsigned w = rp[(eb * 8 + (r >> 1)) * 64]; R[eb][r] = bflo(w) - lam * (O[eb][r] * il); R[eb][r + 1] = bfhi(w) - lam * (O[eb][r + 1] * il); }
        }
    }
    float inv = 1.0f;
    if (!DSA) { float ss = 0.f;
#pragma unroll
        for (int eb = 0; eb < 4; ++eb)
#pragma unroll
            for (int r = 0; r < 16; ++r) ss += R[eb][r] * R[eb][r];
        ss += __shfl_xor(ss, 32); inv = post / sqrtf(ss * (1.f / 128.f) + EPS); }
    const float* sub = FIN(F, I_DSUB) + l * 128;
    if (wvalid && pq < LSEQ && (pq >= NMETA || b == 0)) {
        bf16* orow = (bf16*)(F.ws + WS_BR) + (size_t)(DSA ? 3 : 2) * MPAD * 512 + (size_t)seqrow(b, pq) * 512 + h * 128;
#pragma unroll
        for (int eb = 0; eb < 4; ++eb)
#pragma unroll
            for (int g = 0; g < 4; ++g) { const int e0 = 32 * eb + 8 * g + 4 * hh; f32x4 sv = (f32x4){1.f, 1.f, 1.f, 1.f}; if (!DSA) sv = *(const GAS f32x4*)(sub + e0);
                v2u w; w.x = pk2(R[eb][4 * g] * inv * sv.x, R[eb][4 * g + 1] * inv * sv.y); w.y = pk2(R[eb][4 * g + 2] * inv * sv.z, R[eb][4 * g + 3] * inv * sv.w);
                *(GAS v2u*)(orow + e0) = w; }
    }
}
__device__ __forceinline__ unsigned f32_key(float f) { const unsigned u = __float_as_uint(f); return u ^ ((u >> 31) ? 0xffffffffu : 0x80000000u); }
__device__ __forceinline__ void dsa_index_task(Frame& F, int b, int j, float* slab) {
    const int lane = F.lane, ql = lane & 31, hh = lane >> 5, wave = F.wave;
    const bf16* P = (const bf16*)(F.ws + WS_BIG);
    LAS unsigned char* qi = F.lds;
    for (int i = F.tid; i < 32 * 128; i += 512) { const int q = i >> 7, ch = i & 127; int pq = 32 * j + q; pq = pq < LSEQ ? pq : LSEQ - 1;
        *(LAS v4u*)(qi + q * 2064 + 16 * ch) = *(const GAS v4u*)(P + (size_t)seqrow(b, pq) * NNG + C_DQI + 8 * ch); }
    LAS float* wl = (LAS float*)(qi + 32 * 2064);
    if (F.tid < 32 * 16) { const int q = F.tid >> 4, hd = F.tid & 15; int pq = 32 * j + q; pq = pq < LSEQ ? pq : LSEQ - 1;
        wl[F.tid] = bf2f(P[(size_t)seqrow(b, pq) * NNG + C_DW + hd]) * 0.03125f; }
    LAS unsigned* hist = (LAS unsigned*)(F.lds + 73728);
    for (int i = F.tid; i < 32 * 256; i += 512) hist[i] = 0u;
    LDS_WAIT(); __syncthreads();
#ifndef PROBE_SUB
#define PROBE_SUB 0
#endif
    for (int rpa = 0; rpa < ((PROBE_SUB & 8) ? 2 : 1); ++rpa)
    {
    bf16x8 kn[4];
    { const int pk = 32 * wave + ql, pkc = pk < LSEQ ? pk : LSEQ - 1; const bf16* krow = P + (size_t)seqrow(b, pkc) * NNG + C_DKI + 8 * hh;
#pragma unroll
      for (int ks = 0; ks < 4; ++ks) kn[ks] = ld_frag16(krow + 16 * ks); }
    for (int kt = wave; kt <= j; kt += NWAVES) {
        bf16x8 kf[4];
#pragma unroll
        for (int ks = 0; ks < 4; ++ks) kf[ks] = kn[ks];
        { const int ktn = kt + NWAVES <= j ? kt + NWAVES : kt; const int pk = 32 * ktn + ql, pkc = pk < LSEQ ? pk : LSEQ - 1; const bf16* krow = P + (size_t)seqrow(b, pkc) * NNG + C_DKI + 8 * hh;
#pragma unroll
          for (int ks = 0; ks < 4; ++ks) kn[ks] = ld_frag16(krow + 16 * ks); }
        f32x16 idx;
#pragma unroll
        for (int r = 0; r < 16; ++r) idx[r] = 0.f;
#pragma unroll 1
        for (int hd = 0; hd < 16; hd += 2) { f32x16 S0, S1; const float wh0 = wl[ql * 16 + hd], wh1 = wl[ql * 16 + hd + 1];
#pragma unroll
            for (int r = 0; r < 16; ++r) { S0[r] = 0.f; S1[r] = 0.f; }
#pragma unroll
            for (int ks = 0; ks < 4; ++ks) { S0 = __builtin_amdgcn_mfma_f32_32x32x16_bf16(kf[ks], *(const LAS bf16x8*)(qi + ql * 2064 + hd * 128 + 32 * ks + 16 * hh), S0, 0, 0, 0);
                S1 = __builtin_amdgcn_mfma_f32_32x32x16_bf16(kf[ks], *(const LAS bf16x8*)(qi + ql * 2064 + (hd + 1) * 128 + 32 * ks + 16 * hh), S1, 0, 0, 0); }
#pragma unroll
            for (int r = 0; r < 16; ++r) idx[r] += wh0 * fmaxf(S0[r], 0.f) + wh1 * fmaxf(S1[r], 0.f); }
        { const int pqh = 32 * j + ql;
#pragma unroll
          for (int r = 0; r < 16; ++r) { const int kp = 32 * kt + 4 * hh + (r & 3) + 8 * (r >> 2);
              int bn = (int)__builtin_floorf(__builtin_fmaf(idx[r], 32.f, 256.f)); bn = bn < 0 ? 0 : (bn > 511 ? 511 : bn);
              if (kp <= pqh) (void)__hip_atomic_fetch_add(hist + ql * 256 + (bn >> 1), 1u << (16 * (bn & 1)), __ATOMIC_RELAXED, __HIP_MEMORY_SCOPE_WORKGROUP); } }
        float* srow = slab + (size_t)ql * LPAD + 32 * kt + 4 * hh;
#pragma unroll
        for (int g = 0; g < 4; ++g) *(GAS f32x4*)(srow + 8 * g) = (f32x4){idx[4 * g], idx[4 * g + 1], idx[4 * g + 2], idx[4 * g + 3]};
    }
    }
    VM_WAIT(); LDS_WAIT(); __syncthreads();
    for (int rpb = 0; rpb < ((PROBE_SUB & 16) ? 2 : 1); ++rpb)
    for (int qq = wave; qq < 32; qq += NWAVES) {
        const int p = 32 * j + qq; if (p >= LSEQ) break;
        const float* row = slab + (size_t)qq * LPAD;
        unsigned u[65];
        { const GAS unsigned* rp = (const GAS unsigned*)row + lane;
#pragma unroll
          for (int i = 0; i < 65; ++i) u[i] = rp[64 * i];
          __builtin_amdgcn_sched_barrier(0); }
        auto wsum = [&](unsigned c) { unsigned s = 0;
#pragma unroll
            for (int k = 0; k < 7; ++k) s += (unsigned)__builtin_popcountll(__ballot((c >> k) & 1u)) << k;
            return s; };
        unsigned T = 1u;
        if (p + 1 <= 256) {
#pragma unroll
            for (int i = 0; i < 65; ++i) { const unsigned k = f32_key(__uint_as_float(u[i])) >> 1; u[i] = (64 * i + lane <= p) ? k : 0u; }
        } else {
            const LAS unsigned* hrow = hist + qq * 256 + 4 * lane; unsigned c8[8];
#pragma unroll
            for (int i = 0; i < 4; ++i) { const unsigned w = hrow[i]; c8[2 * i] = w & 0xffffu; c8[2 * i + 1] = w >> 16; }
            unsigned tot = 0;
#pragma unroll
            for (int i = 0; i < 8; ++i) tot += c8[i];
            unsigned suf = 0;
            { const unsigned long long gtm = (lane == 63) ? 0ull : ~((2ull << lane) - 1ull);
#pragma unroll
              for (int k = 0; k < 13; ++k) suf += (unsigned)__builtin_popcountll(__ballot((tot >> k) & 1u) & gtm) << k; }
            unsigned run = suf, bl = 0, al = 0; bool found = false;
#pragma unroll
            for (int i = 7; i >= 0; --i) { const bool hit = !found && run < 256u && run + c8[i] >= 256u; if (hit) { bl = 8u * lane + i; al = run; } found = found || hit; run += c8[i]; }
            const unsigned long long fb = __ballot(found); const int src = (int)__builtin_ctzll(fb | (1ull << 63));
            const unsigned bstar = __builtin_amdgcn_readlane(bl, src), above = __builtin_amdgcn_readlane(al, src), need = 256u - above;
            unsigned f0 = 0u, f1 = 0u, f2 = 0u, cb = 0u;
#pragma unroll
            for (int i = 0; i < 65; ++i) { const float v = __uint_as_float(u[i]); int bn = (int)__builtin_floorf(__builtin_fmaf(v, 32.f, 256.f)); bn = bn < 0 ? 0 : (bn > 511 ? 511 : bn);
                const bool val = 64 * i + lane <= p, inband = val && (unsigned)bn == bstar;
                if (i < 32) f0 |= inband ? (1u << i) : 0u; else if (i < 64) f1 |= inband ? (1u << (i - 32)) : 0u; else f2 = inband ? 1u : 0u;
                cb += inband ? 1u : 0u;
                const unsigned k = f32_key(v) >> 1; u[i] = val ? k : 0u; }
            const unsigned inb = wsum(cb);
            if (fb != 0ull && inb <= 128u && inb >= need) {
                LAS unsigned* band = (LAS unsigned*)(F.lds + 68096) + wave * 128;
                unsigned off = 0;
#pragma unroll
                for (int k = 0; k < 7; ++k) { const unsigned long long bal = __ballot((cb >> k) & 1u); off += __builtin_amdgcn_mbcnt_hi((unsigned)(bal >> 32), __builtin_amdgcn_mbcnt_lo((unsigned)bal, 0u)) << k; }
#pragma unroll
                for (int i = 0; i < 65; ++i) { const bool inband = i < 32 ? ((f0 >> i) & 1u) : (i < 64 ? ((f1 >> (i - 32)) & 1u) : (f2 & 1u)); if (inband) { band[off] = u[i]; ++off; } }
                LDS_WAIT();
                const unsigned m0 = lane < (int)inb ? band[lane] : 0u, m1 = lane + 64 < (int)inb ? band[lane + 64] : 0u; unsigned ge0 = 0, gt0 = 0, ge1 = 0, gt1 = 0;
                for (unsigned k = 0; k < inb; ++k) { const unsigned v = band[k]; ge0 += (m0 - 1u - v) >> 31; gt0 += (m0 - v) >> 31; ge1 += (m1 - 1u - v) >> 31; gt1 += (m1 - v) >> 31; }
                const unsigned long long ok0 = __ballot(lane < (int)inb && ge0 >= need && gt0 < need), ok1 = __ballot(lane + 64 < (int)inb && ge1 >= need && gt1 < need);
                if (ok0) T = __builtin_amdgcn_readlane(m0, (int)__builtin_ctzll(ok0)); else T = __builtin_amdgcn_readlane(m1, (int)__builtin_ctzll(ok1 | (1ull << 63)));
                LDS_WAIT();
            } else {
                T = 0u;
                for (int bit = 30; bit >= 0; --bit) { const unsigned cm1 = (T | (1u << bit)) - 1u; unsigned c = 0;
#pragma unroll
                    for (int i = 0; i < 65; ++i) c += (cm1 - u[i]) >> 31;
                    if (wsum(c) >= 256u) T |= 1u << bit; } } }
        unsigned long long* mrow = (unsigned long long*)((unsigned*)(F.ws + WS_MASK) + ((size_t)b * LPAD + p) * MASKW);
        unsigned wlo = 0u, whi = 0u;
#pragma unroll
        for (int i = 0; i < 64; ++i) { const unsigned long long bal = __ballot(u[i] >= T); if (lane == i) { wlo = (unsigned)bal; whi = (unsigned)(bal >> 32); } }
        const unsigned long long b64 = __ballot(u[64] >= T);
        mrow[lane] = ((unsigned long long)whi << 32) | wlo; if (lane == 0) mrow[64] = b64;
    }
    __syncthreads();
}
struct HgChunk { bf16* base; int pitch; int cq, ck, cv; bf16* A; float* dl; };
__device__ __forceinline__ HgChunk hg_chunk(Frame& F, int b, int h, int c) {
    HgChunk k;
    if (c == 0) { unsigned char* mp = F.ws + WS_HMETA + (size_t)h * HMETA_STRIDE; k.base = (bf16*)mp; k.pitch = 384; k.cq = 0; k.ck = 128; k.cv = 256; k.A = (bf16*)(mp + 64 * 384 * 2); k.dl = (float*)(mp + 64 * 384 * 2 + 64 * 64 * 2); }
    else { const size_t ci = (size_t)(b * 4 + h) * 64 + (c - 1); k.base = (bf16*)(F.ws + WS_BIG) + (size_t)(b * SEQ + 64 * (c - 1)) * NNG; k.pitch = NNG; k.cq = C_AQ + h * 128; k.ck = C_AF + h * 128; k.cv = C_AI + h * 128;
        k.A = (bf16*)(F.ws + WS_HA) + ci * 64 * 64; k.dl = (float*)(F.ws + WS_HDL) + ci * 128; }
    return k;
}
__device__ __forceinline__ void hgrn_prep_task(Frame& F, int l, int b, int h, int c) {
    const int d = F.tid & 127, tq = F.tid >> 7, lane = F.lane, wave = F.wave;
    const bf16* P = (const bf16*)(F.ws + WS_BIG);
    LAS bf16* Qt = (LAS bf16*)F.lds; LAS bf16* Kt = Qt + 64 * 136; LAS float* part = (LAS float*)(F.lds + 2 * 64 * 136 * 2);
    const HgChunk ch = hg_chunk(F, b, h, c);
    float lb = 0.f; if (l == 1) { const float a = FIN(F, I_LB)[h * 128 + d], cc = FIN(F, I_LB)[512 + h * 128 + d]; lb = 1.0f / (1.0f + __expf(a - cc)); }
    const bool meta = (c == 0);
    unsigned short zr[16], qr[16], vr[16];
    { const int r0 = meta ? MREAL : b * SEQ + 64 * (c - 1);
#pragma unroll
      for (int i = 0; i < 16; ++i) { int t = 16 * tq + i; if (meta) t = t < NMETA ? t : NMETA - 1; const bf16* pr = P + (size_t)(r0 + t) * NNG + h * 128 + d; zr[i] = pr[C_AF]; qr[i] = pr[C_AQ]; vr[i] = pr[C_AI]; }
      __builtin_amdgcn_sched_barrier(0); }
    float lfv[16];
    float run = 0.f;
#pragma unroll
    for (int i = 0; i < 16; ++i) { const bool valid = !meta || (16 * tq + i < NMETA); const float z = bf2f(zr[i]); const float sg = 1.0f / (1.0f + __expf(-z));
        lfv[i] = valid ? __logf(lb + (1.0f - lb) * sg) : 0.f; run += lfv[i]; }
    part[tq * 128 + d] = run;
    LDS_WAIT(); __syncthreads();
    const float p0 = part[d], p1 = part[128 + d], p2 = part[256 + d], p3 = part[384 + d];
    const float off = (tq > 0 ? p0 : 0.f) + (tq > 1 ? p1 : 0.f) + (tq > 2 ? p2 : 0.f), bmid = p0 + p1, blast = (p0 + p1) + (p2 + p3);
    unsigned kb[8], vb[8]; unsigned short qb[16];
    float bt = off;
#pragma unroll
    for (int i = 0; i < 16; i += 2) { float kbar[2], vv[2];
#pragma unroll
        for (int u = 0; u < 2; ++u) { const int t = 16 * tq + i + u; const bool valid = !meta || (t < NMETA);
            const float lf = lfv[i + u]; const float q = bf2f(qr[i + u]);
            const float kk = valid ? 1.0f - __expf(lf) : 0.f, qq = valid ? q / (1.0f + __expf(-q)) : 0.f; vv[u] = valid ? bf2f(vr[i + u]) : 0.f;
            bt += lf;
            kbar[u] = kk * __expf(blast - bt); qb[i + u] = (unsigned short)f2bf_s(qq * __expf(bt));
            const float qt = qq * __expf(fminf(bt - bmid, 80.f)), kt = kk * __expf(fminf(bmid - bt, 80.f));
            Qt[t * 136 + d] = (bf16)f2bf_s(qt); Kt[t * 136 + d] = (bf16)f2bf_s(kt); }
        kb[i >> 1] = pk2(kbar[0], kbar[1]); vb[i >> 1] = pk2(vv[0], vv[1]); }
    asm volatile("s_waitcnt vmcnt(0)" ::: "memory"); __syncthreads();
#pragma unroll
    for (int i = 0; i < 16; ++i) ch.base[(size_t)(16 * tq + i) * ch.pitch + ch.cq + d] = qb[i];
    { bf16* kd = ch.base + (size_t)(d >> 1) * ch.pitch + ch.ck + (d & 1) * 64 + 16 * tq; bf16* vd = ch.base + (size_t)(d >> 1) * ch.pitch + ch.cv + (d & 1) * 64 + 16 * tq;
      *(GAS v4u*)kd = (v4u){kb[0], kb[1], kb[2], kb[3]}; *(GAS v4u*)(kd + 8) = (v4u){kb[4], kb[5], kb[6], kb[7]};
      *(GAS v4u*)vd = (v4u){vb[0], vb[1], vb[2], vb[3]}; *(GAS v4u*)(vd + 8) = (v4u){vb[4], vb[5], vb[6], vb[7]}; }
    if (tq == 0) ch.dl[d] = __expf(blast);
    LDS_WAIT(); __syncthreads();
    { const int mt = wave >> 1, fr = lane & 15, g = lane >> 4;
#pragma unroll
      for (int u = 0; u < 2; ++u) { const int nt = 2 * (wave & 1) + u; f32x4 acc = (f32x4){0.f, 0.f, 0.f, 0.f};
        if (nt <= mt) {
#pragma unroll
            for (int ks = 0; ks < 4; ++ks) acc = __builtin_amdgcn_mfma_f32_16x16x32_bf16(*(const LAS bf16x8*)(Qt + (16 * mt + fr) * 136 + 32 * ks + 8 * g), *(const LAS bf16x8*)(Kt + (16 * nt + fr) * 136 + 32 * ks + 8 * g), acc, 0, 0, 0);
        }
#pragma unroll
        for (int r = 0; r < 4; ++r) { const int t = 16 * mt + 4 * g + r, s = 16 * nt + fr; ch.A[t * 64 + s] = (bf16)f2bf_s(s <= t ? acc[r] : 0.f); } } }
    __syncthreads();
}
__device__ __forceinline__ void hgrn_scan_unit(Frame& F, int l, int b, int h) {
    const int lane = F.lane, wave = F.wave, fr = lane & 15, g = lane >> 4, tid = F.tid;
    constexpr int QP = 136, AP = 72, KP = 72, GP = 136;
    constexpr int BUF = (64 * QP + 64 * AP + 128 * KP + 64 * GP) * 2 + 512;
    LAS float* red = (LAS float*)(F.lds + 2 * BUF);
    const int dv = 16 * wave + fr;
    const float gn = FIN(F, I_GN)[l * 512 + h * 128 + dv];
    const bf16* Pg = (const bf16*)(F.ws + WS_BIG) + C_AG + h * 128;
    f32x4 S[8];
#pragma unroll
    for (int mt = 0; mt < 8; ++mt) S[mt] = (f32x4){0.f, 0.f, 0.f, 0.f};
    v4u rq[2], ra, rk[2], rg[2], rd; bf16x8 bv0, bv1, bn0, bn1;
#define HG_ISSUE(c_, B0, B1) do { const HgChunk ch_ = hg_chunk(F, b, h, (c_)); const int nv_ = ((c_) == 0) ? NMETA : 64; \
        _Pragma("unroll") for (int i = 0; i < 2; ++i) { const int idx = tid + 512 * i, row = idx >> 4, c16 = idx & 15; \
            rq[i] = *(const GAS v4u*)(ch_.base + (size_t)row * ch_.pitch + ch_.cq + 8 * c16); rk[i] = *(const GAS v4u*)(ch_.base + (size_t)row * ch_.pitch + ch_.ck + 8 * c16); \
            rg[i] = (v4u){0u, 0u, 0u, 0u}; if (row < nv_) rg[i] = *(const GAS v4u*)(Pg + (size_t)(((c_) == 0) ? MREAL + row : b * SEQ + 64 * ((c_) - 1) + row) * NNG + 8 * c16); } \
        ra = *(const GAS v4u*)(ch_.A + 8 * tid); if (tid < 32) rd = *(const GAS v4u*)(ch_.dl + 4 * tid); \
        const bf16* vrow_ = ch_.base + (size_t)(dv >> 1) * ch_.pitch + ch_.cv + (dv & 1) * 64 + 8 * g; B0 = ld_frag16(vrow_); B1 = ld_frag16(vrow_ + 32); } while (0)
#define HG_COMMIT(buf_) do { LAS bf16* Q_ = (LAS bf16*)(F.lds + (buf_) * BUF); LAS bf16* A_ = Q_ + 64 * QP; LAS bf16* KT_ = A_ + 64 * AP; LAS bf16* G_ = KT_ + 128 * KP; \
        _Pragma("unroll") for (int i = 0; i < 2; ++i) { const int idx = tid + 512 * i, row = idx >> 4, c16 = idx & 15; *(LAS v4u*)(Q_ + row * QP + 8 * c16) = rq[i]; \
            *(LAS v4u*)(KT_ + (2 * row + (c16 >> 3)) * KP + 8 * (c16 & 7)) = rk[i]; *(LAS v4u*)(G_ + row * GP + 8 * c16) = rg[i]; } \
        *(LAS v4u*)(A_ + (tid >> 3) * AP + 8 * (tid & 7)) = ra; if (tid < 32) *(LAS v4u*)((LAS unsigned char*)(G_ + 64 * GP) + 16 * tid) = rd; } while (0)
    HG_ISSUE(0, bv0, bv1); HG_COMMIT(0);
    for (int c = 0; c <= 64; ++c) {
        const int buf = c & 1;
        LDS_WAIT(); __syncthreads();
        if (c < 64) HG_ISSUE(c + 1, bn0, bn1);
        LAS bf16* Q = (LAS bf16*)(F.lds + buf * BUF); LAS bf16* A = Q + 64 * QP; LAS bf16* KT = A + 64 * AP; LAS bf16* G = KT + 128 * KP; const LAS float* DL = (const LAS float*)(G + 64 * GP);
        f32x4 o[4];
#pragma unroll
        for (int mt = 0; mt < 4; ++mt) o[mt] = (f32x4){0.f, 0.f, 0.f, 0.f};
#pragma unroll
        for (int ks = 0; ks < 4; ++ks) { v4u w; w.x = cvtpk(S[2 * ks][0], S[2 * ks][1]); w.y = cvtpk(S[2 * ks][2], S[2 * ks][3]); w.z = cvtpk(S[2 * ks + 1][0], S[2 * ks + 1][1]); w.w = cvtpk(S[2 * ks + 1][2], S[2 * ks + 1][3]);
            const bf16x8 sb = __builtin_bit_cast(bf16x8, w);
#pragma unroll
            for (int mt = 0; mt < 4; ++mt) { const LAS bf16* qp = Q + (16 * mt + fr) * QP + 32 * ks + 4 * g;
                const bf16x8 af = mk_frag(*(const LAS v2u*)qp, *(const LAS v2u*)(qp + 16));
                o[mt] = __builtin_amdgcn_mfma_f32_16x16x32_bf16(af, sb, o[mt], 0, 0, 0); } }
#pragma unroll
        for (int mt = 0; mt < 4; ++mt) { o[mt] = __builtin_amdgcn_mfma_f32_16x16x32_bf16(*(const LAS bf16x8*)(A + (16 * mt + fr) * AP + 8 * g), bv0, o[mt], 0, 0, 0);
            o[mt] = __builtin_amdgcn_mfma_f32_16x16x32_bf16(*(const LAS bf16x8*)(A + (16 * mt + fr) * AP + 32 + 8 * g), bv1, o[mt], 0, 0, 0); }
#pragma unroll
        for (int mt = 0; mt < 8; ++mt) { const f32x4 dl = *(const LAS f32x4*)(DL + 16 * mt + 4 * g); S[mt] = S[mt] * dl;
            S[mt] = __builtin_amdgcn_mfma_f32_16x16x32_bf16(*(const LAS bf16x8*)(KT + (16 * mt + fr) * KP + 8 * g), bv0, S[mt], 0, 0, 0);
            S[mt] = __builtin_amdgcn_mfma_f32_16x16x32_bf16(*(const LAS bf16x8*)(KT + (16 * mt + fr) * KP + 32 + 8 * g), bv1, S[mt], 0, 0, 0); }
#pragma unroll
        for (int mt = 0; mt < 4; ++mt)
#pragma unroll
            for (int r = 0; r < 4; ++r) { float s2 = o[mt][r] * o[mt][r]; s2 += __shfl_xor(s2, 1); s2 += __shfl_xor(s2, 2); s2 += __shfl_xor(s2, 4); s2 += __shfl_xor(s2, 8);
                if (fr == 0) red[wave * 64 + 16 * mt + 4 * g + r] = s2; }
        LDS_WAIT(); __syncthreads();
        const int nvalid = (c == 0) ? NMETA : 64;
#pragma unroll
        for (int mt = 0; mt < 4; ++mt)
#pragma unroll
            for (int r = 0; r < 4; ++r) { const int t = 16 * mt + 4 * g + r; float tot = 0.f;
#pragma unroll
                for (int w = 0; w < 8; ++w) tot += red[w * 64 + t];
                if (t < nvalid && (c > 0 || b == 0)) { const int row = (c == 0) ? MREAL + t : b * SEQ + 64 * (c - 1) + t;
                    const float gr = bf2f(G[t * GP + dv]);
                    const float val = o[mt][r] * (1.0f / sqrtf(tot * (1.f / 128.f) + EPS)) * gn * (gr / (1.0f + __expf(-gr)));
                    ((bf16*)(F.ws + WS_BR))[(size_t)row * 512 + h * 128 + dv] = (bf16)f2bf_s(val); } }
        if (c < 64) { HG_COMMIT(buf ^ 1); bv0 = bn0; bv1 = bn1; }
    }
#undef HG_ISSUE
#undef HG_COMMIT
    __syncthreads();
}
__device__ __forceinline__ void conv_row(Frame& F, int l, int r) {
    const int lane = F.lane; const bf16* P = (const bf16*)(F.ws + WS_BIG);
    int r1, r2;
    if (r < MREAL) { const int b = r >> 12, t = r & 4095; r1 = seqrow(b, NMETA + t - 1); r2 = seqrow(b, NMETA + t - 2); }
    else { const int i = r - MREAL; r1 = i >= 1 ? r - 1 : -1; r2 = i >= 2 ? r - 2 : -1; }
    const float* cw = FIN(F, I_CONVW) + l * 3 * 512 + 8 * lane;
    const int r1c = r1 >= 0 ? r1 : r, r2c = r2 >= 0 ? r2 : r;
    const v4u wc0 = *(const GAS v4u*)(P + (size_t)r * NNG + C_BC + 8 * lane), wu0 = *(const GAS v4u*)(P + (size_t)r * NNG + C_BU + 8 * lane), wb = *(const GAS v4u*)(P + (size_t)r * NNG + C_BB + 8 * lane);
    const v4u wc1 = *(const GAS v4u*)(P + (size_t)r1c * NNG + C_BC + 8 * lane), wu1 = *(const GAS v4u*)(P + (size_t)r1c * NNG + C_BU + 8 * lane);
    const v4u wc2 = *(const GAS v4u*)(P + (size_t)r2c * NNG + C_BC + 8 * lane), wu2 = *(const GAS v4u*)(P + (size_t)r2c * NNG + C_BU + 8 * lane);
    __builtin_amdgcn_sched_barrier(0);
    float c0[8], u0[8], bb[8], y[8]; unpack8(wc0, c0); unpack8(wu0, u0); unpack8(wb, bb);
#pragma unroll
    for (int i = 0; i < 8; ++i) y[i] = cw[i] * (c0[i] * u0[i]);
    const float m1 = r1 >= 0 ? 1.f : 0.f, m2 = r2 >= 0 ? 1.f : 0.f;
    unpack8(wc1, c0); unpack8(wu1, u0);
#pragma unroll
    for (int i = 0; i < 8; ++i) y[i] += m1 * cw[512 + i] * (c0[i] * u0[i]);
    unpack8(wc2, c0); unpack8(wu2, u0);
#pragma unroll
    for (int i = 0; i < 8; ++i) y[i] += m2 * cw[1024 + i] * (c0[i] * u0[i]);
#pragma unroll
    for (int i = 0; i < 8; ++i) y[i] *= bb[i];
    *(GAS v4u*)((bf16*)(F.ws + WS_BR) + (size_t)MPAD * 512 + (size_t)r * 512 + 8 * lane) = pack8(y);
}
constexpr int CW_TMO = 0, CW_BAR = 4096, CW_Q = 16384;
__device__ __forceinline__ int queue_pop(Frame& F, int qi) {
    int t = 0; if (F.lane == 0) t = (int)__hip_atomic_fetch_add((unsigned*)(F.ctl + CW_Q + 64 * qi), 1u, RLX_AGENT);
    return __builtin_amdgcn_readfirstlane(t);
}
__device__ __forceinline__ int queue_pop_wg(Frame& F, int qi) {
    LAS int* slot = (LAS int*)(F.lds + 139264);
    __syncthreads();
    if (F.tid == 0) *slot = (int)__hip_atomic_fetch_add((unsigned*)(F.ctl + CW_Q + 64 * qi), 1u, RLX_AGENT);
    LDS_WAIT(); __syncthreads();
    return __builtin_amdgcn_readfirstlane(*slot);
}
__device__ __forceinline__ void phase_hgrn_prep(Frame& F, int l) {
    for (int t = F.bid; t < NB * 4 * 64 + 4; t += F.G) { if (t < 4) hgrn_prep_task(F, l, 0, t, 0); else { const int u = t - 4; hgrn_prep_task(F, l, u >> 8, (u >> 6) & 3, 1 + (u & 63)); } }
}
__device__ __forceinline__ void phase_prep(Frame& F, int l) { const int gw = F.bid * NWAVES + F.wave, NGW = F.G * NWAVES; for (int r = gw; r < MREAL + NMETA; r += NGW) prep_row(F, l, r); }
__device__ __forceinline__ void phase_vt(Frame& F) { const int gw = F.bid * NWAVES + F.wave, NGW = F.G * NWAVES; for (int t = gw; t < VT_NTASK; t += NGW) vt_task(F, t); }
__device__ __forceinline__ void phase_mix1(Frame& F, int l, int qidx) {
    LAS float* bt = (LAS float*)(F.lds + 135168);
    build_bias_table(F, bt, 0);
    __syncthreads();
    if (F.bid < NIDX_WG) {
        float* slab = (float*)(F.ws + WS_SCR) + (size_t)F.bid * 32 * LPAD;
        for (int t = F.bid; t < NB * NQT; t += NIDX_WG) { const int j = NQT - 1 - t / NB, b = t % NB; dsa_index_task(F, b, j, slab); }
    } else if (F.bid < NIDX_WG + NHG_WG) {
        const int u = F.bid - NIDX_WG; hgrn_scan_unit(F, l, u >> 2, u & 3);
    } else {
        const int u0 = F.bid - NIDX_WG - NHG_WG, nw = F.G - NIDX_WG - NHG_WG;
        const int cw = u0 * NWAVES + F.wave, ncw = nw * NWAVES; for (int r = cw; r < MREAL + NMETA; r += ncw) conv_row(F, l, r);
    }
    float lam, post;
    { const float* lp = FIN(F, I_DLAM) + l * 256; const float s1 = wave_sum(lp[F.lane] * lp[64 + F.lane]), s2 = wave_sum(lp[128 + F.lane] * lp[192 + F.lane]);
      const float li = 0.8f - 0.6f * __expf(-0.3f * (float)l); lam = __expf(s1) - __expf(s2) + li; post = 1.0f - li; }
    for (;;) { const int t = queue_pop_wg(F, qidx); if (t >= NB * 4 * NQB) break;
        const int J = NQB - 1 - t / 32, bh = t % 32; attn_wg_task<false>(F, l, bh >> 2, bh & 3, J, bt, lam, post); }
}
__device__ __forceinline__ void phase_mix2(Frame& F, int l, int qidx) {
    LAS float* bt = (LAS float*)(F.lds + 135168);
    build_bias_table(F, bt, 4);
    __syncthreads();
    for (;;) { const int t = queue_pop_wg(F, qidx); if (t >= NB * 4 * NQB) break;
        const int J = NQB - 1 - t / 32, bh = t % 32; attn_wg_task<true>(F, l, bh >> 2, bh & 3, J, bt, 0.f, 1.f); }
}

#ifdef DBG_SEL
#ifndef DBG_Q
#define DBG_Q 1.0f
#endif
#ifndef DBG_QO
#define DBG_QO 0.0f
#endif
#ifndef DBG_T0
#define DBG_T0 0
#define DBG_T1 36
#endif
#ifndef DBG_NC
#define DBG_NC DM
#endif
__global__ void __launch_bounds__(256) k_dbg_argmax(const float* __restrict__ out, const float* __restrict__ x, unsigned long long* best) {
    unsigned long long loc = 0ull;
    for (size_t i = (size_t)blockIdx.x * blockDim.x + threadIdx.x; i < (size_t)MREAL * DM; i += (size_t)gridDim.x * blockDim.x) {
        const float d = fabsf(out[i] - x[i]); const unsigned long long k = ((unsigned long long)__float_as_uint(d) << 32) | (unsigned)i; loc = k > loc ? k : loc; }
    for (int o = 32; o >= 1; o >>= 1) { const unsigned long long t = __shfl_xor(loc, o); loc = t > loc ? t : loc; }
    if ((threadIdx.x & 63) == 0) atomicMax(best, loc);
}
__global__ void __launch_bounds__(256) k_dbg_count(const float* __restrict__ out, const float* __restrict__ x, unsigned* cnt  ) {
    const int gw = (blockIdx.x * blockDim.x + threadIdx.x) >> 6, lane = threadIdx.x & 63, ngw = (gridDim.x * blockDim.x) >> 6;
    for (int r = gw; r < MREAL; r += ngw) { float m = 0.f;
        for (int c = lane; c < DM; c += 64) m = fmaxf(m, fabsf(out[(size_t)r * DM + c] - x[(size_t)r * DM + c]));
        for (int o = 32; o >= 1; o >>= 1) m = fmaxf(m, __shfl_xor(m, o));
        if (lane == 0 && m > DBG_THR) { const int t = r & 4095; atomicAdd(cnt + 0, 1u); if (t < 32) atomicAdd(cnt + 1, 1u); if (t >= 4064) atomicAdd(cnt + 2, 1u); if (t < 256) atomicAdd(cnt + 3, 1u); } }
}

__global__ void __launch_bounds__(256) k_dbg_chk_merge(const unsigned short* BRm, const unsigned short* Wt, const unsigned short* G, const unsigned short* MG, int m, unsigned* cnt) {
    const int c = blockIdx.x * 256 + threadIdx.x;
    for (int r = blockIdx.y; r < MREAL; r += gridDim.y) {
        float s = 0.f; const unsigned short* a = BRm + (size_t)r * 512; const unsigned short* w = Wt + (size_t)c * 512;
        for (int k = 0; k < 512; ++k) s += __uint_as_float((unsigned)a[k] << 16) * __uint_as_float((unsigned)w[k] << 16);
        const float g = __uint_as_float((unsigned)G[(size_t)r * NGATE + m * DM + c] << 16), ref = g * s, got = __uint_as_float((unsigned)MG[(size_t)r * DM + c] << 16);
        const float err = fabsf(got - ref), tol = 0.02f * fabsf(ref) + 0.02f;
        if (!(err <= tol)) { atomicAdd(cnt + 4, 1u); const int t = r & 4095; if ((c & 255) < 128) atomicAdd(cnt + 5, 1u); if ((r & 255) < 128) atomicAdd(cnt + 6, 1u); if (fabsf(got) > 2.f * fabsf(ref)) atomicAdd(cnt + 7, 1u); (void)t; }
    }
}

__global__ void __launch_bounds__(256) k_dbg_naive_wo(const float* out, const unsigned short* MG, const unsigned short* Wt, float* chk) {
    const int c = blockIdx.x * 256 + threadIdx.x;
    for (int r = blockIdx.y; r < MREAL; r += gridDim.y) {
        float s = 0.f; const uint4* a = (const uint4*)(MG + (size_t)r * DM); const uint4* w = (const uint4*)(Wt + (size_t)c * DM);
        for (int k = 0; k < DM / 8; ++k) { const uint4 av = a[k], wv = w[k]; const unsigned aw[4] = {av.x, av.y, av.z, av.w}, ww[4] = {wv.x, wv.y, wv.z, wv.w};
#pragma unroll
            for (int j = 0; j < 4; ++j) { s += __uint_as_float(aw[j] << 16) * __uint_as_float(ww[j] << 16); s += __uint_as_float(aw[j] & 0xffff0000u) * __uint_as_float(ww[j] & 0xffff0000u); } }
        chk[(size_t)r * DM + c] = out[(size_t)r * DM + c] + s; }
}
__global__ void __launch_bounds__(256) k_dbg_cmp(const float* out, const float* chk, unsigned* cnt) {
    for (size_t i = (size_t)blockIdx.x * blockDim.x + threadIdx.x; i < (size_t)MREAL * DM; i += (size_t)gridDim.x * blockDim.x) {
        const float err = fabsf(out[i] - chk[i]); if (!(err <= 0.02f)) { atomicAdd(cnt + 4, 1u); const int c = (int)(i % DM), r = (int)(i / DM); if ((c & 255) < 128) atomicAdd(cnt + 5, 1u); if ((r & 255) < 128) atomicAdd(cnt + 6, 1u); if (err > 1.0f) atomicAdd(cnt + 7, 1u); } }
}

__global__ void __launch_bounds__(256) k_dbg_stats(const unsigned short* A, int ld, int ncols, unsigned* st) {
    const int gw = (blockIdx.x * blockDim.x + threadIdx.x) >> 6, lane = threadIdx.x & 63, ngw = (gridDim.x * blockDim.x) >> 6;
    float mx = 0.f, me = 0.f;
    for (int r = gw; r < MREAL; r += ngw) { float s = 0.f;
        for (int c = lane; c < ncols; c += 64) { const float v = __uint_as_float((unsigned)A[(size_t)r * ld + c] << 16); mx = fmaxf(mx, fabsf(v)); s += v * v; }
        for (int o = 32; o >= 1; o >>= 1) s += __shfl_xor(s, o);
        me = fmaxf(me, s / (float)ncols); }
    for (int o = 32; o >= 1; o >>= 1) mx = fmaxf(mx, __shfl_xor(mx, o));
    if (lane == 0) { atomicMax(st + 8, __float_as_uint(mx)); atomicMax(st + 9, __float_as_uint(me)); }
}

__global__ void __launch_bounds__(256) k_dbg_argmax_bf16(const unsigned short* A, int ld, int ncols, unsigned long long* best) {
    unsigned long long loc = 0ull;
    for (size_t i = (size_t)blockIdx.x * blockDim.x + threadIdx.x; i < (size_t)MREAL * ncols; i += (size_t)gridDim.x * blockDim.x) { const size_t r = i / ncols, c = i % ncols;
        const float d = fabsf(__uint_as_float((unsigned)A[r * ld + c] << 16)); const unsigned long long k = ((unsigned long long)__float_as_uint(d) << 32) | (unsigned)i; loc = k > loc ? k : loc; }
    for (int o = 32; o >= 1; o >>= 1) { const unsigned long long t = __shfl_xor(loc, o); loc = t > loc ? t : loc; }
    if ((threadIdx.x & 63) == 0) atomicMax(best, loc);
}

__global__ void __launch_bounds__(256) k_dbg_gcount(const unsigned short* G, unsigned* cnt) {
    const int gw = (blockIdx.x * blockDim.x + threadIdx.x) >> 6, lane = threadIdx.x & 63, ngw = (gridDim.x * blockDim.x) >> 6;
    for (int r = gw; r < MREAL; r += ngw) { int n = 0;
        for (int c = lane; c < NGATE; c += 64) { const float v = __uint_as_float((unsigned)G[(size_t)r * NGATE + c] << 16); if (!(v >= 0.f && v <= 1.001f)) ++n; }
        for (int o = 32; o >= 1; o >>= 1) n += __shfl_xor(n, o);
        if (lane == 0 && n) { const int t = r & 4095; atomicAdd(cnt + 10, (unsigned)n); atomicAdd(cnt + 11, 1u); if (t >= 4080) atomicAdd(cnt + 12, 1u); else atomicAdd(cnt + 13, 1u); } }
}

__global__ void k_dbg_time(const unsigned long long* ts, unsigned* cnt) {
    if (threadIdx.x == 0) { const float ms = (float)(ts[DBG_T1] - ts[DBG_T0]) * 1e-5f; cnt[14] = __float_as_uint(floorf(ms * DBG_Q + DBG_QO)); }
}
__global__ void __launch_bounds__(256) k_dbg_emit(float* out, const float* __restrict__ x, const unsigned long long* best, const unsigned* cnt) {
    const unsigned long long b = *best; const unsigned idx = (unsigned)b; const float val = __uint_as_float((unsigned)(b >> 32));
    const int row = idx / DBG_NC, col = idx % DBG_NC, bb = row >> 12, t = row & 4095;
    float N = 0.f;
    switch (DBG_SEL) {
        case 0: N = val; break;
        case 1: N = 2.f + bb; break;
        case 2: N = 2.f + (t >> 9); break;
        case 3: N = 2.f + ((t >> 6) & 7); break;
        case 4: N = 2.f + ((t >> 3) & 7); break;
        case 5: N = 2.f + (t & 7); break;
        case 6: N = 2.f + (col >> 8); break;
        case 60: N = 2.f + (col >> 10); break;
        case 61: N = 2.f + ((col >> 7) & 7); break;
        case 62: N = 2.f + ((col >> 4) & 7); break;
        case 63: N = 2.f + ((col >> 1) & 7); break;
        case 64: N = 2.f + (col & 1); break;
        case 65: N = 2.f + bb; break;
        case 66: N = 2.f + (t >> 9); break;
        case 67: N = 2.f + ((t >> 6) & 7); break;
        case 68: N = 2.f + ((t >> 3) & 7); break;
        case 69: N = 2.f + (t & 7); break;
        case 7: N = 2.f + ((col >> 5) & 7); break;
        case 8: N = 2.f + ((col >> 2) & 7); break;
        case 40: case 42: case 44: case 46: N = __uint_as_float(cnt[8]); break;
        case 41: case 43: case 45: case 47: N = __uint_as_float(cnt[9]); break;
        case 70: N = 2.f + log2f(1.f + (float)cnt[10]); break;
        case 71: N = 2.f + log2f(1.f + (float)cnt[11]); break;
        case 72: N = 2.f + log2f(1.f + (float)cnt[12]); break;
        case 73: N = 2.f + log2f(1.f + (float)cnt[13]); break;
        case 100: N = 2.f + __uint_as_float(cnt[14]); break;
        case 30: N = 2.f + log2f(1.f + (float)cnt[4]); break;
        case 31: N = 2.f + log2f(1.f + (float)cnt[5]); break;
        case 32: N = 2.f + log2f(1.f + (float)cnt[6]); break;
        case 33: N = 2.f + log2f(1.f + (float)cnt[7]); break;
        case 20: N = 2.f + log2f(1.f + (float)cnt[4]); break;
        case 21: N = 2.f + log2f(1.f + (float)cnt[5]); break;
        case 22: N = 2.f + log2f(1.f + (float)cnt[6]); break;
        case 23: N = 2.f + log2f(1.f + (float)cnt[7]); break;
        case 10: N = 2.f + log2f(1.f + (float)cnt[0]); break;
        case 11: N = 2.f + log2f(1.f + (float)cnt[1]); break;
        case 12: N = 2.f + log2f(1.f + (float)cnt[2]); break;
        case 13: N = 2.f + log2f(1.f + (float)cnt[3]); break;
    }
    const float c = 1.f + N;
    for (size_t i = (size_t)blockIdx.x * blockDim.x + threadIdx.x; i < (size_t)MREAL * DM; i += (size_t)gridDim.x * blockDim.x) out[i] = c * x[i];
}
#endif

#ifndef MK_ONE
#define MK_ONE 0
#endif
#ifndef BR_MASK
#define BR_MASK 15
#endif
constexpr int NPH = 18;
template <class T> __device__ __forceinline__ T opaque(T v) { asm volatile("" : "+s"(v)); return v; }
struct Args { const float* in[22]; float* out; unsigned char* ws; int ph_lo, ph_hi; };
__global__ void __launch_bounds__(NWAVES * 64, 2) fwd(Args args) {
    extern __shared__ __attribute__((aligned(16))) unsigned char lds[];
    Frame F;
    F.lds = (LAS unsigned char*)lds; F.MISC = (volatile LAS unsigned*)(F.lds + MISC_OFF);
    F.tid = threadIdx.x; F.lane = F.tid & 63; F.wave = __builtin_amdgcn_readfirstlane(F.tid >> 6); F.G = gridDim.x; F.bid = blockIdx.x;
    F.ws = args.ws; F.out = args.out; F.ctl = (gu32*)(args.ws + WS_CTL);
    F.karg = (const unsigned char __attribute__((address_space(4)))*)__builtin_amdgcn_kernarg_segment_ptr();
    for (int u = F.tid; u < (LDS_BYTES - LDSCTL_OFF) / 4; u += NWAVES * 64) ((LAS unsigned*)(F.lds + LDSCTL_OFF))[u] = 0u;
    __syncthreads();
#if MK_ONE
    XcdBarrier bar = xcd_barrier_post((unsigned*)(F.ctl + CW_BAR), F.MISC + 8, __builtin_amdgcn_readfirstlane(threadIdx.x >> 6));
#define GRID_BAR() xcd_barrier(bar)
#else
#define GRID_BAR() do { } while (0)
#endif
    const int wave_s = __builtin_amdgcn_readfirstlane(threadIdx.x >> 6);
    const int lo = args.ph_lo, hi = args.ph_hi;
#define IN(k) (lo <= (k) && (k) < hi)
#define RETID() do { int w_ = wave_s; asm volatile("" : "+s"(w_)); unsigned mk_ = ~0u; asm volatile("" : "+s"(mk_)); int t_ = w_ * 64 + (int)__builtin_amdgcn_mbcnt_hi(mk_, __builtin_amdgcn_mbcnt_lo(mk_, 0u)); asm volatile("" : "+v"(t_)); F.tid = t_; F.lane = t_ & 63; F.wave = w_; } while (0)
#ifdef DBG_TS
#define STAMP(k) do { if (blockIdx.x == 0 && threadIdx.x == 0) ((unsigned long long*)(args.ws + 768 * 1024))[(k)] = __builtin_amdgcn_s_memrealtime(); } while (0)
#else
#define STAMP(k) do { } while (0)
#endif
#define SEAM(k) do { if (IN((k) + 1)) GRID_BAR(); STAMP((k) + 1); } while (0)
#ifndef PROBE_EPI
#define PROBE_EPI 0
#endif
#ifdef PROBE_MASK
#define NREP(kk) opaque(((PROBE_MASK >> (kk)) & 1) ? 1 + PROBE_EXTRA : 1)
#define REP_BEGIN(kk) { const int nrep_ = NREP(kk); for (int rep = 0; rep < nrep_; ++rep) { if (rep) GRID_BAR();
#define REP_END } }
#else
#define REP_BEGIN(kk) { { const int rep = 0; (void)rep;
#define REP_END } }
#endif
    STAMP(0);
    unsigned char* wb = F.ws + WS_W;
    bf16* XN = (bf16*)(F.ws + WS_XN); bf16* BR = (bf16*)(F.ws + WS_BR); bf16* BIG = (bf16*)(F.ws + WS_BIG); float* HM = (float*)(F.ws + WS_HM);
    for (int l = 0; l < 2; ++l) {
        const int pb = l * NPH;
        const float* hsrc = (l == 0) ? FIN(F, I_X) : F.out;
        if (IN(pb + 0)) { REP_BEGIN(0) RETID(); phase_convert(F, l); REP_END SEAM(pb + 0); }
        if (IN(pb + 1)) { REP_BEGIN(1) RETID(); phase_norm(F, hsrc, FIN(F, I_F1N) + l * DM); REP_END SEAM(pb + 1); }
        if (IN(pb + 2)) { REP_BEGIN(2) RETID(); meta_gemm(F, 0, XN + (size_t)MREAL * DM, DM, (const bf16*)(wb + W_GU1), NGU, DM, BIG, DFF, 0.f); pg8::Gemm g{opaque((const bf16*)(XN)), opaque((const bf16*)(wb + W_GU1)), MREAL, NGU, DM}; pg8::StaticOrder S; S.init(MREAL, NGU, F.G, opaque(F.bid));
            pg8::EpiSwiGLU E{BIG, DFF, rep ? PROBE_EPI : 0}; pg8::gemm_phase<pg8::EpiSwiGLU, pg8::StaticOrder, true, true>(F.lds + RING_OFF, g, S, E, F.tid); REP_END SEAM(pb + 2); }
        if (IN(pb + 3)) { REP_BEGIN(3) RETID(); meta_gemm(F, 1, BIG + (size_t)MREAL * DFF, DFF, (const bf16*)(wb + W_D1), DM, DFF, nullptr, 0, rep ? 0.f : 0.5f); pg8::Gemm g{opaque((const bf16*)(BIG)), opaque((const bf16*)(wb + W_D1)), MREAL, DM, DFF}; pg8::StaticOrder S; S.init(MREAL, DM, F.G, opaque(F.bid));
            pg8::EpiResF32 E{rep ? F.out : hsrc, F.out, HM, DM, MT_REAL, rep ? 0.f : 0.5f}; pg8::gemm_phase<pg8::EpiResF32, pg8::StaticOrder, true, true>(F.lds + RING_OFF, g, S, E, F.tid); REP_END SEAM(pb + 3); }
        if (IN(pb + 4)) { REP_BEGIN(4) RETID(); phase_norm(F, F.out, FIN(F, I_MIXN) + l * DM); REP_END SEAM(pb + 4); }
        if (IN(pb + 5)) { REP_BEGIN(5) RETID(); meta_gemm(F, 2, XN + (size_t)MREAL * DM, DM, (const bf16*)(wb + W_NG), NNG, DM, BIG, NNG, 0.f); pg8::Gemm g{opaque((const bf16*)(XN)), opaque((const bf16*)(wb + W_NG)), MREAL, NNG, DM}; pg8::StaticOrder S; S.init(MREAL, NNG, F.G, opaque(F.bid));
            pg8::EpiBf16<0> E{BIG, NNG}; pg8::gemm_phase<pg8::EpiBf16<0>, pg8::StaticOrder, true, true>(F.lds + RING_OFF, g, S, E, F.tid); REP_END SEAM(pb + 5); }
        if (IN(pb + 6)) { RETID(); phase_prep(F, l); phase_vt(F); __syncthreads(); phase_hgrn_prep(F, l); SEAM(pb + 6); }
        if (IN(pb + 7)) { RETID(); phase_mix1(F, l, 2 * l); SEAM(pb + 7); }
        if (IN(pb + 8)) { RETID(); phase_mix2(F, l, 2 * l + 1); SEAM(pb + 8); }
        if (IN(pb + 9)) { REP_BEGIN(9) RETID(); meta_gemm(F, 3, XN + (size_t)MREAL * DM, DM, (const bf16*)(wb + W_G), NGATE, DM, BIG, NGATE, 0.f); pg8::Gemm g{opaque((const bf16*)(XN)), opaque((const bf16*)(wb + W_G)), MREAL, NGATE, DM}; pg8::StaticOrder S; S.init(MREAL, NGATE, F.G, opaque(F.bid));
            pg8::EpiBf16<1> E{BIG, NGATE}; pg8::gemm_phase<pg8::EpiBf16<1>, pg8::StaticOrder, true, true>(F.lds + RING_OFF, g, S, E, F.tid); REP_END SEAM(pb + 9); }
        if (IN(pb + 10)) { REP_BEGIN(10) RETID(); meta_gemm(F, 4, BR + (size_t)MREAL * 512, 512, (const bf16*)(wb + W_BR), DM, 512, XN, DM, 0.f);
            pg8::Gemm g{opaque((const bf16*)(BR)), opaque((const bf16*)(wb + W_BR)), MREAL, DM, 512}; pg8::MergeOrder S; S.init(MREAL, DM, F.G, opaque(F.bid), MPAD / 256);
            pg8::EpiGateAccM E{XN, DM, BIG, NGATE, MPAD / 256, DM / 256}; pg8::gemm_phase<pg8::EpiGateAccM, pg8::MergeOrder, true, true>(F.lds + RING_OFF, g, S, E, F.tid); REP_END SEAM(pb + 10); }
        if (IN(pb + 14) && BR_MASK) { REP_BEGIN(14) RETID(); meta_gemm(F, 1, XN + (size_t)MREAL * DM, DM, (const bf16*)(wb + W_O), DM, DM, nullptr, 0, rep ? 0.f : 1.0f); pg8::Gemm g{opaque((const bf16*)(XN)), opaque((const bf16*)(wb + W_O)), MREAL, DM, DM}; pg8::StaticOrder S; S.init(MREAL, DM, F.G, opaque(F.bid));
            pg8::EpiResF32 E{F.out, F.out, HM, DM, MT_REAL, rep ? 0.f : 1.0f}; pg8::gemm_phase<pg8::EpiResF32, pg8::StaticOrder, true, true>(F.lds + RING_OFF, g, S, E, F.tid); REP_END SEAM(pb + 14); }
        if (IN(pb + 15)) { REP_BEGIN(15) RETID(); phase_norm(F, F.out, FIN(F, I_F2N) + l * DM); REP_END SEAM(pb + 15); }
        if (IN(pb + 16)) { REP_BEGIN(16) RETID(); meta_gemm(F, 0, XN + (size_t)MREAL * DM, DM, (const bf16*)(wb + W_GU2), NGU, DM, BIG, DFF, 0.f); pg8::Gemm g{opaque((const bf16*)(XN)), opaque((const bf16*)(wb + W_GU2)), MREAL, NGU, DM}; pg8::StaticOrder S; S.init(MREAL, NGU, F.G, opaque(F.bid));
            pg8::EpiSwiGLU E{BIG, DFF, rep ? PROBE_EPI : 0}; pg8::gemm_phase<pg8::EpiSwiGLU, pg8::StaticOrder, true, true>(F.lds + RING_OFF, g, S, E, F.tid); REP_END SEAM(pb + 16); }
        if (IN(pb + 17)) { REP_BEGIN(17) RETID(); meta_gemm(F, 1, BIG + (size_t)MREAL * DFF, DFF, (const bf16*)(wb + W_D2), DM, DFF, nullptr, 0, rep ? 0.f : 0.5f); pg8::Gemm g{opaque((const bf16*)(BIG)), opaque((const bf16*)(wb + W_D2)), MREAL, DM, DFF}; pg8::StaticOrder S; S.init(MREAL, DM, F.G, opaque(F.bid));
            pg8::EpiResF32 E{F.out, F.out, HM, DM, MT_REAL, rep ? 0.f : 0.5f}; pg8::gemm_phase<pg8::EpiResF32, pg8::StaticOrder, true, true>(F.lds + RING_OFF, g, S, E, F.tid); REP_END SEAM(pb + 17); }
    }
}

extern "C" void kernel_launch(void* const* d_in, const int* in_sizes, int n_in, void* d_out, int out_size, void* d_ws, size_t ws_size, hipStream_t stream) {
    static int grid = 0;
    if (grid == 0) {
        if (n_in != 22 || out_size != MREAL * DM || ws_size < WS_END) { fprintf(stderr, "kernel_launch: unexpected shapes (n_in %d out %d ws %zu need %zu)\n", n_in, out_size, ws_size, (size_t)WS_END); grid = -1; return; }
        int dev = 0, cus = 0, per_cu = 0;
        if (hipGetDevice(&dev) != hipSuccess || hipDeviceGetAttribute(&cus, hipDeviceAttributeMultiprocessorCount, dev) != hipSuccess) { grid = -1; return; }
        if (hipFuncSetAttribute((const void*)fwd, hipFuncAttributeMaxDynamicSharedMemorySize, LDS_BYTES) != hipSuccess) { fprintf(stderr, "kernel_launch: hipFuncSetAttribute failed\n"); grid = -1; return; }
        if (hipOccupancyMaxActiveBlocksPerMultiprocessor(&per_cu, (const void*)fwd, NWAVES * 64, LDS_BYTES) != hipSuccess || per_cu < 1) fprintf(stderr, "kernel_launch: occupancy query says %d\n", per_cu);
        (void)hipGetLastError();
        grid = cus < 256 ? cus : 256;
    }
    if (grid < 0) return;
    (void)hipMemsetAsync((char*)d_ws + WS_CTL, 0, CTL_ZERO_BYTES, stream);
    Args a{};
    for (int i = 0; i < 22; ++i) a.in[i] = (const float*)d_in[i];
    a.out = (float*)d_out; a.ws = (unsigned char*)d_ws;
#ifndef PH_END
#define PH_END (2 * NPH)
#endif
#if MK_ONE
    a.ph_lo = 0; a.ph_hi = PH_END;
    hipLaunchKernelGGL(fwd, dim3(grid), dim3(NWAVES * 64), LDS_BYTES, stream, a);
#else
    for (int p = 0; p < PH_END; ++p) { a.ph_lo = p; a.ph_hi = p + 1;
#if defined(DBG_SEL)
#ifdef DBG_PREFILL
        if (p == 9) (void)hipMemsetAsync((char*)d_ws + WS_BIG, 0x3F, (size_t)MPAD * NGATE * 2, stream);
#endif
        if (DBG_SEL >= 30 && DBG_SEL < 40 && p == 14) hipLaunchKernelGGL(k_dbg_naive_wo, dim3(8, 2048), dim3(256), 0, stream, (const float*)d_out, (const unsigned short*)((char*)d_ws + WS_XN), (const unsigned short*)((char*)d_ws + WS_W + W_O), (float*)((char*)d_ws + WS_BIG));
#endif
        hipLaunchKernelGGL(fwd, dim3(grid), dim3(NWAVES * 64), LDS_BYTES, stream, a); }
#endif
#ifdef DBG_SEL
    { unsigned long long* best = (unsigned long long*)((char*)d_ws + 512 * 1024); unsigned* cnt = (unsigned*)((char*)d_ws + 512 * 1024 + 64);
      if (DBG_SEL >= 60 && DBG_SEL < 70) hipLaunchKernelGGL(k_dbg_argmax_bf16, dim3(2048), dim3(256), 0, stream, (const unsigned short*)((char*)d_ws + WS_BIG), NGATE, NGATE, best);
      else hipLaunchKernelGGL(k_dbg_argmax, dim3(2048), dim3(256), 0, stream, (const float*)d_out, (const float*)d_in[0], best);
      hipLaunchKernelGGL(k_dbg_count, dim3(2048), dim3(256), 0, stream, (const float*)d_out, (const float*)d_in[0], cnt);
      if (DBG_SEL >= 20 && DBG_SEL < 30) { const int mm = 1; hipLaunchKernelGGL(k_dbg_chk_merge, dim3(8, 2048), dim3(256), 0, stream, (const unsigned short*)((char*)d_ws + WS_BR) + (size_t)mm * MPAD * 512, (const unsigned short*)((char*)d_ws + WS_W + W_BR) + (size_t)mm * DM * 512, (const unsigned short*)((char*)d_ws + WS_BIG), (const unsigned short*)((char*)d_ws + WS_XN), mm, cnt); }
      if (DBG_SEL >= 30 && DBG_SEL < 40) hipLaunchKernelGGL(k_dbg_cmp, dim3(2048), dim3(256), 0, stream, (const float*)d_out, (const float*)((char*)d_ws + WS_BIG), cnt);
      if (DBG_SEL >= 40 && DBG_SEL < 50) { const unsigned short* A = nullptr; int ld = 0, nc = 0;
        if (DBG_SEL < 42) { A = (const unsigned short*)((char*)d_ws + WS_BR) + (size_t)MPAD * 512; ld = 512; nc = 512; }
        else if (DBG_SEL < 44) { A = (const unsigned short*)((char*)d_ws + WS_BIG) + DM; ld = NGATE; nc = DM; }
        else if (DBG_SEL < 46) { A = (const unsigned short*)((char*)d_ws + WS_XN); ld = DM; nc = DM; }
        else { A = (const unsigned short*)((char*)d_ws + WS_BR); ld = 512; nc = 512; }
        hipLaunchKernelGGL(k_dbg_stats, dim3(1024), dim3(256), 0, stream, A, ld, nc, cnt); }
      if (DBG_SEL >= 70 && DBG_SEL < 80) hipLaunchKernelGGL(k_dbg_gcount, dim3(1024), dim3(256), 0, stream, (const unsigned short*)((char*)d_ws + WS_BIG), cnt);
      if (DBG_SEL >= 100) hipLaunchKernelGGL(k_dbg_time, dim3(1), dim3(64), 0, stream, (const unsigned long long*)((char*)d_ws + 768 * 1024), cnt);
      hipLaunchKernelGGL(k_dbg_emit, dim3(2048), dim3(256), 0, stream, (float*)d_out, (const float*)d_in[0], best, cnt); }
#endif
}
```

```cpp
#include <hip/hip_runtime.h>
#include <cstdio>
#include <cstdint>
#define MK_ONE 1
namespace pg8 {
#define PG8_LAS __attribute__((address_space(3)))
typedef unsigned short bf16_t;
typedef short bf16x8 __attribute__((ext_vector_type(8)));
typedef float f32x4 __attribute__((ext_vector_type(4)));
typedef unsigned u32x4 __attribute__((ext_vector_type(4)));
constexpr int BM = 256, BK = 64, HALF = 128, HTB = HALF * BK * 2  , STAGE_BYTES = 8 * HTB, NXCD = 8, WGM = 8;

__host__ __device__ __forceinline__ int lds_byte(int r, int c) { const int st = (r >> 4) * 2 + (c >> 5), rr = r & 15, cc = c & 31, ob = rr * 64 + cc * 2; return st * 1024 + (ob ^ (((ob >> 9) & 1) << 5)); }
__host__ __device__ __forceinline__ void stage_rc(int b, int& R, int& C) { const int st = b / 1024, sb = b % 1024, swz = sb ^ (((sb >> 9) & 1) << 5); R = (st >> 1) * 16 + swz / 64; C = (st & 1) * 32 + (swz % 64) / 2; }
__host__ __device__ __forceinline__ int perm32(int rho) { const int n = rho >> 4, i = rho & 15; return 8 * (i >> 2) + 4 * n + (i & 3); }

struct Unit { int pm, pn; };
struct Gemm { const bf16_t* A; const bf16_t* Bt; int M, N, K; };

struct StaticOrder {
    int nM, nN, nwg, G, c;
    __host__ __device__ void init(int M, int N, int G_, int c_) { nM = M / BM; nN = N / BM; nwg = nM * nN; G = G_; c = c_; }
    __host__ __device__ bool next(int i, Unit& u) const {
        const long L = (long)i * G + c; if (L >= nwg) return false;
        int wgid = (int)L; { const int q = nwg / NXCD, r = nwg % NXCD, xcd = wgid % NXCD, off = wgid / NXCD; wgid = (xcd < r ? xcd * (q + 1) : r * (q + 1) + (xcd - r) * q) + off; }
        const int nig = WGM * nN, gid = wgid / nig, fm = gid * WGM, gsz = (nM - fm) < WGM ? (nM - fm) : WGM;
        u.pm = fm + ((wgid % nig) % gsz); u.pn = (wgid % nig) / gsz; return true;
    }
    __device__ __forceinline__ void a_ready(const Unit&) const {}
    __device__ __forceinline__ void done(const Unit&) const {}
};
typedef __bf16 bf16x2_hw __attribute__((ext_vector_type(2))); typedef float f32x2_hw __attribute__((ext_vector_type(2)));
__device__ __forceinline__ unsigned cvt_pk_bf16(float lo, float hi) { const f32x2_hw v = {lo, hi}; return __builtin_bit_cast(unsigned, __builtin_convertvector(v, bf16x2_hw)); }
typedef float f32x2 __attribute__((ext_vector_type(2)));
__device__ __forceinline__ float fast_sigmoid(float x) { return __builtin_amdgcn_rcpf(1.0f + __expf(-x)); }
__device__ __forceinline__ float fast_silu(float x) { return x * fast_sigmoid(x); }
template <int ACT  > struct EpiBf16 {
    static constexpr bool PERM = true, AFTER_DRAIN = false;
    bf16_t* O; int ldc;
    __device__ __forceinline__ void operator()(const f32x4 (&acc)[2][2][4][2], const Unit& u, int wr, int wc, int fr, int fq) const {
        const int row0 = u.pm * BM + wr * 64 + fr; const int col0 = u.pn * BM + wc * 32 + 8 * fq;
#pragma unroll
        for (int ai = 0; ai < 2; ++ai)
#pragma unroll
            for (int m = 0; m < 4; ++m) { bf16_t* rowp = O + (size_t)(row0 + ai * HALF + m * 16) * ldc + col0;
#pragma unroll
                for (int bj = 0; bj < 2; ++bj) { f32x4 v0 = acc[ai][bj][m][0], v1 = acc[ai][bj][m][1];
                    if (ACT == 1) {
#pragma unroll
                        for (int j = 0; j < 4; ++j) { v0[j] = fast_sigmoid(v0[j]); v1[j] = fast_sigmoid(v1[j]); } }
                    u32x4 w; w.x = cvt_pk_bf16(v0[0], v0[1]); w.y = cvt_pk_bf16(v0[2], v0[3]); w.z = cvt_pk_bf16(v1[0], v1[1]); w.w = cvt_pk_bf16(v1[2], v1[3]);
                    *(u32x4*)(rowp + bj * HALF) = w; } }
    }
};
struct EpiSwiGLU {
    static constexpr bool PERM = true, AFTER_DRAIN = false;
    bf16_t* O; int ldc; int mode;
    __device__ __forceinline__ void operator()(const f32x4 (&acc)[2][2][4][2], const Unit& u, int wr, int wc, int fr, int fq) const {
        if (mode == 2) return;
        const int row0 = u.pm * BM + wr * 64 + fr; const int col0 = u.pn * HALF + wc * 32 + 8 * fq;
#pragma unroll
        for (int ai = 0; ai < 2; ++ai)
#pragma unroll
            for (int m = 0; m < 4; ++m) { bf16_t* rowp = O + (size_t)(row0 + ai * HALF + m * 16) * ldc + col0;
                const f32x4 g0 = acc[ai][0][m][0], g1 = acc[ai][0][m][1], u0 = acc[ai][1][m][0], u1 = acc[ai][1][m][1];
                f32x4 v0, v1;
#pragma unroll
                for (int j = 0; j < 4; ++j) { v0[j] = fast_silu(g0[j]) * u0[j]; v1[j] = fast_silu(g1[j]) * u1[j]; }
                u32x4 w; w.x = cvt_pk_bf16(v0[0], v0[1]); w.y = cvt_pk_bf16(v0[2], v0[3]); w.z = cvt_pk_bf16(v1[0], v1[1]); w.w = cvt_pk_bf16(v1[2], v1[3]);
                if (mode == 0) *(u32x4*)rowp = w; else asm volatile("" :: "v"(w.x), "v"(w.y), "v"(w.z), "v"(w.w));
                asm volatile("" ::: "memory"); }
    }
};
struct EpiResF32 {
    static constexpr bool PERM = false, AFTER_DRAIN = false;
    const float* base_r; float* out_r; float* hm; int ldc; int mt_real; float scale;
    __device__ __forceinline__ void operator()(const f32x4 (&acc)[2][2][4][2], const Unit& u, int wr, int wc, int fr, int fq) const {
        const bool real = u.pm < mt_real;
        const float* bp = real ? base_r + (size_t)u.pm * BM * ldc : hm; float* op = real ? out_r + (size_t)u.pm * BM * ldc : hm;
        const int row0 = wr * 64 + fr, col0 = u.pn * BM + wc * 32 + 4 * fq;
#pragma unroll
        for (int ai = 0; ai < 2; ++ai) {
            f32x4 b[4][2][2];
#pragma unroll
            for (int m = 0; m < 4; ++m) { const size_t off = (size_t)(row0 + ai * HALF + m * 16) * ldc + col0;
#pragma unroll
                for (int bj = 0; bj < 2; ++bj)
#pragma unroll
                    for (int n = 0; n < 2; ++n) b[m][bj][n] = *(const f32x4*)(bp + off + bj * HALF + n * 16); }
            asm volatile("" ::: "memory");
#pragma unroll
            for (int m = 0; m < 4; ++m) { const size_t off = (size_t)(row0 + ai * HALF + m * 16) * ldc + col0;
#pragma unroll
                for (int bj = 0; bj < 2; ++bj)
#pragma unroll
                    for (int n = 0; n < 2; ++n) *(f32x4*)(op + off + bj * HALF + n * 16) = b[m][bj][n] + acc[ai][bj][m][n] * scale; }
            asm volatile("" ::: "memory"); }
    }
};
struct EpiGateAcc {
    static constexpr bool PERM = true, AFTER_DRAIN = false;
    bf16_t* MG; int ldc; const bf16_t* G; int ldg; int gcol0; int first;
    __device__ __forceinline__ void operator()(const f32x4 (&acc)[2][2][4][2], const Unit& u, int wr, int wc, int fr, int fq) const {
        const int row0 = u.pm * BM + wr * 64 + fr; const int col0 = u.pn * BM + wc * 32 + 8 * fq;
#pragma unroll
        for (int ai = 0; ai < 2; ++ai)
#pragma unroll
            for (int m = 0; m < 4; ++m) { const size_t r = (size_t)(row0 + ai * HALF + m * 16);
#pragma unroll
                for (int bj = 0; bj < 2; ++bj) { const u32x4 gw = *(const u32x4*)(G + r * ldg + gcol0 + col0 + bj * HALF);
                    u32x4 pw = (u32x4){0u, 0u, 0u, 0u}; if (!first) pw = *(const u32x4*)(MG + r * ldc + col0 + bj * HALF);
                    float o[8];
#pragma unroll
                    for (int j = 0; j < 4; ++j) { const float a0 = (j < 2) ? acc[ai][bj][m][0][2 * j] : acc[ai][bj][m][1][2 * (j - 2)], a1 = (j < 2) ? acc[ai][bj][m][0][2 * j + 1] : acc[ai][bj][m][1][2 * (j - 2) + 1];
                        o[2 * j] = __uint_as_float(pw[j] << 16) + __uint_as_float(gw[j] << 16) * a0; o[2 * j + 1] = __uint_as_float(pw[j] & 0xffff0000u) + __uint_as_float(gw[j] & 0xffff0000u) * a1; }
                    u32x4 w; w.x = cvt_pk_bf16(o[0], o[1]); w.y = cvt_pk_bf16(o[2], o[3]); w.z = cvt_pk_bf16(o[4], o[5]); w.w = cvt_pk_bf16(o[6], o[7]);
                    *(u32x4*)(MG + r * ldc + col0 + bj * HALF) = w; } }
    }
};

struct MergeOrder {
    int nM, nN, G, c, mt_alloc;
    __host__ __device__ void init(int M, int N, int G_, int c_, int mt_alloc_) { nM = M / BM; nN = N / BM; G = G_; c = c_; mt_alloc = mt_alloc_; }
    __host__ __device__ bool next(int i, Unit& u) const { const int t = (i >> 2) * G + c, m = i & 3; if (t >= nM * nN) return false;
        const int pm = t / nN, pn = t % nN; u.pm = m * mt_alloc + pm; u.pn = m * nN + pn; return true; }
    __device__ __forceinline__ void a_ready(const Unit&) const {}
    __device__ __forceinline__ void done(const Unit&) const {}
};
struct EpiGateAccM {
    static constexpr bool PERM = true, AFTER_DRAIN = false;
    bf16_t* MG; int ldc; const bf16_t* G; int ldg; int mt_alloc; int ntn;
    __device__ __forceinline__ void operator()(const f32x4 (&acc)[2][2][4][2], const Unit& u, int wr, int wc, int fr, int fq) const {
        const int m = u.pm / mt_alloc, pm = u.pm - m * mt_alloc, pn = u.pn - m * ntn;
        const int row0 = pm * BM + wr * 64 + fr; const int col0 = pn * BM + wc * 32 + 8 * fq; const int gcol0 = m * ntn * BM;
#pragma unroll
        for (int ai = 0; ai < 2; ++ai)
#pragma unroll
            for (int mm = 0; mm < 4; ++mm) { const size_t r = (size_t)(row0 + ai * HALF + mm * 16);
#pragma unroll
                for (int bj = 0; bj < 2; ++bj) { const u32x4 gw = *(const u32x4*)(G + r * ldg + gcol0 + col0 + bj * HALF);
                    u32x4 pw = (u32x4){0u, 0u, 0u, 0u}; if (m != 0) pw = *(const u32x4*)(MG + r * ldc + col0 + bj * HALF);
                    float o[8];
#pragma unroll
                    for (int j = 0; j < 4; ++j) { const float a0 = (j < 2) ? acc[ai][bj][mm][0][2 * j] : acc[ai][bj][mm][1][2 * (j - 2)], a1 = (j < 2) ? acc[ai][bj][mm][0][2 * j + 1] : acc[ai][bj][mm][1][2 * (j - 2) + 1];
                        o[2 * j] = __uint_as_float(pw[j] << 16) + __uint_as_float(gw[j] << 16) * a0; o[2 * j + 1] = __uint_as_float(pw[j] & 0xffff0000u) + __uint_as_float(gw[j] & 0xffff0000u) * a1; }
                    u32x4 w; w.x = cvt_pk_bf16(o[0], o[1]); w.y = cvt_pk_bf16(o[2], o[3]); w.z = cvt_pk_bf16(o[4], o[5]); w.w = cvt_pk_bf16(o[6], o[7]);
                    *(u32x4*)(MG + r * ldc + col0 + bj * HALF) = w; } }
    }
};
template <class Epi, class Sched, bool ALIGN_EPI = false, bool SP2 = false>
__device__ __forceinline__ void gemm_phase(PG8_LAS unsigned char* lds, const Gemm g, const Sched& S, const Epi& E, int tid_in) {
    int tid_ = tid_in; asm volatile("" : "+v"(tid_));
    const int tid = tid_, wid = __builtin_amdgcn_readfirstlane(tid >> 6), lane = tid & 63, wr = wid >> 2, wc = wid & 3, fr = lane & 15, fq = lane >> 4;
    const int K = g.K, nt = K / BK;
    unsigned voffA[2], voffB[2];
#pragma unroll
    for (int i = 0; i < 2; ++i) { int R, C; stage_rc(tid * 16 + i * 8192, R, C); const int Rb = Epi::PERM ? ((R & ~31) + perm32(R & 31)) : R;
        voffA[i] = (unsigned)(R * K + C) * 2u; voffB[i] = (unsigned)(Rb * K + C) * 2u; }
    const size_t kstep = (size_t)(BK * 2);
    const size_t hstep = (size_t)HALF * K * 2;
    const size_t tstep = 2 * hstep;
    const unsigned ldsw = (unsigned)wid * 1024u;
    const int aoff = lds_byte(wr * 64 + fr, fq * 8), boff = lds_byte(wc * 32 + fr, fq * 8);
#define PG8_SA(b, h) (((b) * 2 + (h)) * HTB)
#define PG8_SB(b, h) ((4 + (b) * 2 + (h)) * HTB)
#define PG8_STAGE(bufoff, gbase, voff) do { _Pragma("unroll") for (int _i = 0; _i < 2; ++_i) \
        __builtin_amdgcn_global_load_lds((const unsigned*)((const char*)(gbase) + (voff)[_i]), (PG8_LAS unsigned*)(lds + (bufoff) + ldsw + _i * 8192), 16, 0, 0); } while (0)
#define PG8_LDA(dst, b, h) do { _Pragma("unroll") for (int m = 0; m < 4; ++m) _Pragma("unroll") for (int k = 0; k < 2; ++k) dst[m][k] = *(const PG8_LAS bf16x8*)(lds + PG8_SA(b, h) + aoff + m * 2048 + k * 1024); } while (0)
#define PG8_LDB(dst, b, h) do { _Pragma("unroll") for (int n = 0; n < 2; ++n) _Pragma("unroll") for (int k = 0; k < 2; ++k) dst[n][k] = *(const PG8_LAS bf16x8*)(lds + PG8_SB(b, h) + boff + n * 2048 + k * 1024); } while (0)
#define PG8_MMA(ai, bj, At, Bt) do { __builtin_amdgcn_s_setprio(1); _Pragma("unroll") for (int m = 0; m < 4; ++m) _Pragma("unroll") for (int n = 0; n < 2; ++n) _Pragma("unroll") for (int k = 0; k < 2; ++k) \
        acc[ai][bj][m][n] = __builtin_amdgcn_mfma_f32_16x16x32_bf16(Bt[n][k], At[m][k], acc[ai][bj][m][n], 0, 0, 0); __builtin_amdgcn_s_setprio(0); } while (0)
#define PG8_WAIT_V(n) asm volatile("s_waitcnt vmcnt(" #n ")" ::: "memory")
#define PG8_WAIT_L(n) asm volatile("s_waitcnt lgkmcnt(" #n ")" ::: "memory")
#define PG8_BAR __builtin_amdgcn_s_barrier()
#define PG8_SCHED __builtin_amdgcn_sched_barrier(0)
    Unit cur, nxt; int ui = 0;
    if (!S.next(0, cur)) return;
    f32x4 acc[2][2][4][2];
#pragma unroll
    for (int a = 0; a < 2; ++a)
#pragma unroll
        for (int b = 0; b < 2; ++b)
#pragma unroll
            for (int m = 0; m < 4; ++m)
#pragma unroll
                for (int n = 0; n < 2; ++n) acc[a][b][m][n] = (f32x4){0.f, 0.f, 0.f, 0.f};
    bf16x8 At[4][2], B0[2][2], B1[2][2];
    const char* cA = (const char*)g.A + (size_t)cur.pm * tstep; const char* cB = (const char*)g.Bt + (size_t)cur.pn * tstep;
    S.a_ready(cur);
    if constexpr (SP2) {
        PG8_STAGE(PG8_SB(0, 0), cB, voffB); PG8_STAGE(PG8_SB(0, 1), cB + hstep, voffB); PG8_STAGE(PG8_SA(0, 0), cA, voffA); PG8_STAGE(PG8_SA(0, 1), cA + hstep, voffA);
        if (wr == 1) PG8_BAR;
        PG8_WAIT_V(2); PG8_BAR;
        PG8_STAGE(PG8_SB(1, 0), cB + kstep, voffB); PG8_STAGE(PG8_SA(1, 0), cA + kstep, voffA); PG8_STAGE(PG8_SB(1, 1), cB + hstep + kstep, voffB);
        PG8_WAIT_V(6); PG8_BAR;
    } else {
        PG8_STAGE(PG8_SB(0, 0), cB, voffB); PG8_STAGE(PG8_SA(0, 0), cA, voffA); PG8_STAGE(PG8_SB(0, 1), cB + hstep, voffB); PG8_STAGE(PG8_SA(0, 1), cA + hstep, voffA);
        if (wr == 1) PG8_BAR;
        PG8_WAIT_V(4); PG8_BAR;
        PG8_STAGE(PG8_SB(1, 0), cB + kstep, voffB); PG8_STAGE(PG8_SA(1, 0), cA + kstep, voffA); PG8_STAGE(PG8_SB(1, 1), cB + hstep + kstep, voffB);
        PG8_WAIT_V(6); PG8_BAR;
    }
    for (;;) {
        const bool has_next = S.next(ui + 1, nxt);
        const char* nA = has_next ? (const char*)g.A + (size_t)nxt.pm * tstep : cA; const char* nB = has_next ? (const char*)g.Bt + (size_t)nxt.pn * tstep : cB;
        for (int t = 0; t < nt; t += 2) {
            const bool last = (t == nt - 2);
            const char* a1 = cA + (size_t)(t + 1) * kstep;
            const char* a2 = last ? nA : cA + (size_t)(t + 2) * kstep; const char* b2 = last ? nB : cB + (size_t)(t + 2) * kstep;
            const char* a3 = a2 + kstep; const char* b3 = b2 + kstep;
            if (last && has_next) S.a_ready(nxt);
            if constexpr (SP2) {
            PG8_LDB(B0, 0, 0); PG8_LDB(B1, 0, 1); PG8_SCHED; PG8_LDA(At, 0, 0); PG8_STAGE(PG8_SA(1, 1), a1 + hstep, voffA);
            PG8_WAIT_V(8); PG8_WAIT_L(0); PG8_BAR; PG8_MMA(0, 0, At, B0); PG8_MMA(0, 1, At, B1); PG8_BAR; PG8_SCHED;
            PG8_LDA(At, 0, 1); PG8_STAGE(PG8_SB(0, 0), b2, voffB); PG8_STAGE(PG8_SB(0, 1), b2 + hstep, voffB); PG8_STAGE(PG8_SA(0, 0), a2, voffA);
            PG8_WAIT_V(8); PG8_WAIT_L(0); PG8_BAR; PG8_MMA(1, 0, At, B0); PG8_MMA(1, 1, At, B1); PG8_BAR; PG8_SCHED;
            PG8_LDB(B0, 1, 0); PG8_LDB(B1, 1, 1); PG8_SCHED; PG8_LDA(At, 1, 0); PG8_STAGE(PG8_SA(0, 1), a2 + hstep, voffA);
            PG8_WAIT_V(8); PG8_WAIT_L(0); PG8_BAR; PG8_MMA(0, 0, At, B0); PG8_MMA(0, 1, At, B1); PG8_BAR; PG8_SCHED;
            PG8_LDA(At, 1, 1); PG8_STAGE(PG8_SB(1, 0), b3, voffB); PG8_STAGE(PG8_SB(1, 1), b3 + hstep, voffB); PG8_STAGE(PG8_SA(1, 0), a3, voffA);
            PG8_WAIT_V(8); PG8_WAIT_L(0); PG8_BAR; PG8_MMA(1, 0, At, B0); PG8_MMA(1, 1, At, B1); PG8_BAR; PG8_SCHED;
            } else {
            PG8_LDB(B0, 0, 0); PG8_SCHED; PG8_LDA(At, 0, 0); PG8_STAGE(PG8_SA(1, 1), a1 + hstep, voffA);
            PG8_WAIT_L(8); PG8_BAR; PG8_WAIT_L(0); PG8_MMA(0, 0, At, B0); PG8_BAR; PG8_SCHED;
            PG8_LDB(B1, 0, 1); PG8_STAGE(PG8_SB(0, 0), b2, voffB);
            PG8_BAR; PG8_WAIT_L(0); PG8_MMA(0, 1, At, B1); PG8_BAR;
            PG8_LDA(At, 0, 1); PG8_STAGE(PG8_SA(0, 0), a2, voffA);
            PG8_BAR; PG8_WAIT_L(0); PG8_MMA(1, 0, At, B0); PG8_BAR; PG8_SCHED;
            PG8_STAGE(PG8_SB(0, 1), b2 + hstep, voffB);
            PG8_WAIT_V(6); PG8_BAR; PG8_MMA(1, 1, At, B1); PG8_BAR;
            PG8_LDB(B0, 1, 0); PG8_SCHED; PG8_LDA(At, 1, 0); PG8_STAGE(PG8_SA(0, 1), a2 + hstep, voffA);
            PG8_WAIT_L(8); PG8_BAR; PG8_WAIT_L(0); PG8_MMA(0, 0, At, B0); PG8_BAR; PG8_SCHED;
            PG8_LDB(B1, 1, 1); PG8_STAGE(PG8_SB(1, 0), b3, voffB);
            PG8_BAR; PG8_WAIT_L(0); PG8_MMA(0, 1, At, B1); PG8_BAR;
            PG8_LDA(At, 1, 1); PG8_STAGE(PG8_SA(1, 0), a3, voffA);
            PG8_BAR; PG8_WAIT_L(0); PG8_MMA(1, 0, At, B0); PG8_BAR; PG8_SCHED;
            PG8_STAGE(PG8_SB(1, 1), b3 + hstep, voffB);
            PG8_WAIT_V(6); PG8_BAR; PG8_MMA(1, 1, At, B1); PG8_BAR;
            }
        }
        if constexpr (ALIGN_EPI) { if (wr == 0) PG8_BAR; }
        if constexpr (!Epi::AFTER_DRAIN) { E(acc, cur, wr, wc, fr, fq); S.done(cur); }
        if (!has_next) break;
#pragma unroll
        for (int a = 0; a < 2; ++a)
#pragma unroll
            for (int b = 0; b < 2; ++b)
#pragma unroll
                for (int m = 0; m < 4; ++m)
#pragma unroll
                    for (int n = 0; n < 2; ++n) acc[a][b][m][n] = (f32x4){0.f, 0.f, 0.f, 0.f};
        cur = nxt; cA = nA; cB = nB; ++ui;
        if constexpr (ALIGN_EPI) { if (wr == 1) PG8_BAR; }
    }
    PG8_WAIT_V(0);
    if constexpr (!ALIGN_EPI) { if (wr == 0) PG8_BAR; }
    PG8_BAR;
    if constexpr (Epi::AFTER_DRAIN) { E.fused(acc, cur, wr, wc, fr, fq, lds, wid, lane); S.done(cur); }
#undef PG8_SA
#undef PG8_SB
#undef PG8_STAGE
#undef PG8_LDA
#undef PG8_LDB
#undef PG8_MMA
#undef PG8_WAIT_V
#undef PG8_WAIT_L
#undef PG8_BAR
#undef PG8_SCHED
}
}

constexpr int DM = 2048, NB = 8, SEQ = 4096, NMETA = 16, LSEQ = 4112, LPAD = 4128;
constexpr int MREAL = NB * SEQ;
constexpr int MPAD = MREAL + 256;
constexpr int MT_REAL = MREAL / 256;
constexpr int DFF = 5632, NGU = 2 * DFF, NNG = 7168, NGATE = 8192, INCOLS = 15184, NGC = 6992;
constexpr int NWAVES = 8;
constexpr float EPS = 1e-6f;
constexpr int C_AQ = 0, C_AF = 512, C_AI = 1024, C_AG = 1536, C_BB = 2048, C_BC = 2560, C_BU = 3072, C_CQ = 3584, C_CK = 4096, C_CV = 4608,
              C_DQ = 5120, C_DK = 5632, C_DV = 5760, C_DQI = 5888, C_DKI = 6912, C_DW = 6976;

constexpr size_t MiB = 1u << 20;
constexpr size_t WS_CTL = 0, CTL_ZERO_BYTES = 1 * MiB;
constexpr size_t WS_HM = 1 * MiB;
constexpr size_t WS_W = 4 * MiB;
constexpr size_t W_GU1 = 0, W_D1 = W_GU1 + (size_t)NGU * DM * 2, W_NG = W_D1 + (size_t)DM * DFF * 2, W_G = W_NG + (size_t)NNG * DM * 2,
                 W_BR = W_G + (size_t)NGATE * DM * 2, W_O = W_BR + (size_t)4 * DM * 512 * 2, W_GU2 = W_O + (size_t)DM * DM * 2, W_D2 = W_GU2 + (size_t)NGU * DM * 2,
                 W_END = W_D2 + (size_t)DM * DFF * 2;
constexpr size_t WS_XN = WS_W + W_END;
constexpr size_t WS_BR = WS_XN + (size_t)MPAD * DM * 2;
constexpr size_t WS_BIG = WS_BR + (size_t)MPAD * DM * 2;
constexpr size_t BIG_P_END = (size_t)MPAD * NNG * 2;
constexpr size_t WS_VTC = WS_BIG + BIG_P_END;
constexpr size_t WS_VTD = WS_VTC + (size_t)NB * 4 * 128 * LPAD * 2;
constexpr size_t WS_MASK = WS_VTD + (size_t)NB * 128 * LPAD * 2;
constexpr int MASKW = 132;
constexpr int NIDX_WG = 172;
constexpr int NHG_WG = 32;
constexpr size_t WS_SCR = WS_MASK + (size_t)NB * LPAD * MASKW * 4;
constexpr size_t WS_HA = WS_SCR + (size_t)NIDX_WG * 32 * LPAD * 4;
constexpr size_t WS_HDL = WS_HA + (size_t)NB * 4 * 64 * 64 * 64 * 2;
constexpr size_t WS_HMETA = WS_HDL + (size_t)NB * 4 * 64 * 128 * 4;
constexpr size_t HMETA_STRIDE = 64 * 384 * 2 + 64 * 64 * 2 + 128 * 4;
constexpr size_t WS_END = WS_HMETA + 4 * HMETA_STRIDE;
static_assert(WS_BIG + (size_t)MPAD * NGATE * 2 <= WS_END, "G fits");
static_assert(WS_END <= (size_t)1138174976, "workspace map fits the guaranteed size");

constexpr int RING_OFF = 0, RING_BYTES = 131072;
constexpr int LDSCTL_OFF = 143360, MISC_OFF = LDSCTL_OFF + 320;
constexpr int LDS_BYTES = 147456;

#define GAS __attribute__((address_space(1)))
#define LAS __attribute__((address_space(3)))
typedef unsigned short bf16;
typedef unsigned v4u __attribute__((ext_vector_type(4)));
typedef unsigned v2u __attribute__((ext_vector_type(2)));
typedef float f32x4 __attribute__((ext_vector_type(4)));
typedef float f32x16 __attribute__((ext_vector_type(16)));
typedef short bf16x8 __attribute__((ext_vector_type(8)));
typedef GAS unsigned gu32;
#define RLX_AGENT __ATOMIC_RELAXED, __HIP_MEMORY_SCOPE_AGENT
#define LDS_WAIT() asm volatile("s_waitcnt lgkmcnt(0)" ::: "memory")
#define VM_WAIT() asm volatile("s_waitcnt vmcnt(0)" ::: "memory")
__device__ __forceinline__ unsigned f2bf(float f) { unsigned u = __builtin_bit_cast(unsigned, f); return (u + 0x7fffu + ((u >> 16) & 1u)) >> 16; }
__device__ __forceinline__ unsigned f2bf_s(float f) { return pg8::cvt_pk_bf16(f, 0.f) & 0xffffu; }
__device__ __forceinline__ unsigned pk2(float lo, float hi) { return pg8::cvt_pk_bf16(lo, hi); }
__device__ __forceinline__ float bflo(unsigned w) { return __uint_as_float(w << 16); }
__device__ __forceinline__ float bfhi(unsigned w) { return __uint_as_float(w & 0xffff0000u); }
__device__ __forceinline__ float bf2f(bf16 v) { return __uint_as_float((unsigned)v << 16); }
__device__ __forceinline__ int seqrow(int b, int p) { return p < NMETA ? MREAL + p : b * SEQ + p - NMETA; }
__device__ __forceinline__ int rel_bucket(int n) {
    if (n < 16) return n; if (n >= 128) return 31;
    const int v = 16 + (int)(__log2f((float)n * 0.0625f) * 5.33333333f); return v < 31 ? v : 31; }
__device__ __forceinline__ float wave_sum(float v) {
#pragma unroll
    for (int o = 1; o < 64; o <<= 1) v += __shfl_xor(v, o);
    return v;
}
#define XB_TMO      128
#define XB_XCNT(j)  (256  + 64 * (j))
#define XB_XSUB(j)  (1280 + 64 * (j))
#define XB_XGEN(j)  (2304 + 64 * (j))
#define XB_TOP      3328
#define XB_TOPGEN   3392
#define XCD_BAR_WORDS 3456
#define XB_SPIN_CAP (1u << 18)

__device__ __forceinline__ unsigned xb_ld(unsigned* p)              { return __hip_atomic_load(p, __ATOMIC_RELAXED, __HIP_MEMORY_SCOPE_AGENT); }
__device__ __forceinline__ unsigned xb_add(unsigned* p, unsigned v) { return __hip_atomic_fetch_add(p, v, __ATOMIC_RELAXED, __HIP_MEMORY_SCOPE_AGENT); }
__device__ __forceinline__ unsigned xb_xcc_id() { return (unsigned)__builtin_amdgcn_s_getreg((3 << 11) | 20) & 0xFu; }
#define XB_SPIN(cond, bar) do { unsigned _sp = 0; while (cond) { __builtin_amdgcn_s_sleep(1); \
    if ((++_sp & 255u) == 0u) { if (xb_ld(&(bar)[XB_TMO])) break; if (_sp > XB_SPIN_CAP) { atomicAdd(&(bar)[XB_TMO], 1u); break; } } } } while (0)

struct XcdBarrier {
    int wave;
    unsigned* bar; unsigned x;
    volatile LAS unsigned* st;
};

__device__ __forceinline__ bool xb_thread0(int wave) { unsigned mk = ~0u; asm volatile("" : "+s"(mk)); return wave == 0 && __builtin_amdgcn_mbcnt_hi(mk, __builtin_amdgcn_mbcnt_lo(mk, 0u)) == 0u; }
__device__ __forceinline__ XcdBarrier xcd_barrier_post(unsigned* bar, volatile LAS unsigned* st, int wave) {
    XcdBarrier b; b.wave = wave; b.bar = bar; b.x = xb_xcc_id(); b.st = st;
    if (xb_thread0(wave)) (void)xb_add(&bar[XB_XCNT(b.x)], 1u);
    return b;
}
__device__ __forceinline__ void xcd_barrier_complete(unsigned* bar, unsigned x, unsigned& nloc, unsigned& nx) {
    const unsigned G = gridDim.x * gridDim.y * gridDim.z;
    unsigned sum, cnt, mine, sp = 0u;
    for (;;) {
        sum = 0u; cnt = 0u; mine = 0u;
#pragma unroll
        for (unsigned j = 0; j < 16; ++j) { const unsigned c = xb_ld(&bar[XB_XCNT(j)]); sum += c; cnt += (c > 0u) ? 1u : 0u; mine = (j == x) ? c : mine; }
        if (sum == G) break;
        __builtin_amdgcn_s_sleep(1);
        if ((++sp & 255u) == 0u) { if (xb_ld(&bar[XB_TMO])) break; if (sp > XB_SPIN_CAP) { atomicAdd(&bar[XB_TMO], 1u); break; } }
    }
    nloc = mine > 0u ? mine : 1u; nx = cnt > 0u ? cnt : 1u;
}

__device__ __forceinline__ void xcd_barrier(const XcdBarrier& b) {
    asm volatile("s_waitcnt vmcnt(0)" ::: "memory");
    __syncthreads();
    if (xb_thread0(b.wave)) {
        unsigned* bar = b.bar;
        __builtin_amdgcn_s_waitcnt(0);
        unsigned nloc = b.st[0], nx = b.st[1];
        if (nloc == 0u) { xcd_barrier_complete(bar, b.x, nloc, nx); b.st[0] = nloc; b.st[1] = nx; }
        const unsigned old = xb_add(&bar[XB_XSUB(b.x)], 1u);
        const unsigned gen = old / nloc;
        if (old + 1u == (gen + 1u) * nloc) {
            __builtin_amdgcn_fence(__ATOMIC_RELEASE, "agent");
            asm volatile("s_waitcnt vmcnt(0)" ::: "memory");
            const unsigned og = xb_add(&bar[XB_TOP], 1u);
            const unsigned tg = og / nx;
            if (og + 1u == (tg + 1u) * nx) xb_add(&bar[XB_TOPGEN], 1u);
            else XB_SPIN(xb_ld(&bar[XB_TOPGEN]) == tg, bar);
            __builtin_amdgcn_fence(__ATOMIC_ACQUIRE, "agent");
            xb_add(&bar[XB_XGEN(b.x)], 1u);
            asm volatile("s_waitcnt vmcnt(0)" ::: "memory");
        } else {
            XB_SPIN(xb_ld(&bar[XB_XGEN(b.x)]) == gen, bar);
            __builtin_amdgcn_fence(__ATOMIC_ACQUIRE, "agent");
            asm volatile("s_waitcnt vmcnt(0)" ::: "memory");
        }
    }
    __syncthreads();
}

struct Frame {
    LAS unsigned char* lds;
    volatile LAS unsigned* MISC;
    gu32* ctl;
    int tid, lane, wave, G, bid;
    const unsigned char __attribute__((address_space(4)))* karg; float* out; unsigned char* ws;
};
__device__ __forceinline__ const float* fin_load(const unsigned char __attribute__((address_space(4)))* k, int i) { asm volatile("" : "+s"(k)); return *(const float* const __attribute__((address_space(4)))*)(k + 8 * i); }
#define FIN(F_, i_) fin_load((F_).karg, (i_))
enum { I_X = 0, I_META, I_RELB, I_F1N, I_F1GU, I_F1D, I_MIXN, I_WIN, I_LB, I_GN, I_CONVW, I_DQN, I_DKN, I_DLAM, I_DSUB, I_SQN, I_SKN, I_WBR, I_WOUT, I_F2N, I_F2GU, I_F2D };

template <class RowMap>
__device__ __forceinline__ void transpose_item(const float* W, int K, int N, bf16* WT, LAS float* scr, int item, int lane, RowMap rm) {
    const int nblk = (N + 31) / 32, kb = item / nblk, nb = item % nblk, k0 = 64 * kb, n0 = 32 * nb;
    const int nl = n0 + (lane & 31); const bool nok = nl < N;
#pragma unroll 8
    for (int i = 0; i < 32; ++i) { const int kk = 2 * i + (lane >> 5); scr[kk * 33 + (lane & 31)] = nok ? W[(size_t)(k0 + kk) * N + nl] : 0.f; }
    LDS_WAIT(); asm volatile("" ::: "memory");
    const int c = lane & 7;
#pragma unroll
    for (int j = 0; j < 4; ++j) { const int n = (lane >> 3) + 8 * j; const LAS float* s = scr + (8 * c) * 33 + n;
        v4u o; o.x = pk2(s[0 * 33], s[1 * 33]); o.y = pk2(s[2 * 33], s[3 * 33]); o.z = pk2(s[4 * 33], s[5 * 33]); o.w = pk2(s[6 * 33], s[7 * 33]);
        if (n0 + n < N) *(GAS v4u*)(WT + (size_t)rm(n0 + n) * K + k0 + 8 * c) = o; }
    LDS_WAIT(); asm volatile("" ::: "memory");
}
struct MapId { __device__ __forceinline__ int operator()(int n) const { return n; } };
struct MapGU { __device__ __forceinline__ int operator()(int n) const { const int up = n >= DFF, j = up ? n - DFF : n; return 256 * (j >> 7) + 128 * up + (j & 127); } };
struct MapIn { __device__ __forceinline__ int operator()(int n) const { return n < NGC ? n : n + (NNG - NGC); } };
template <class RowMap>
__device__ __forceinline__ void convert_matrix(Frame& F, const float* W, int K, int N, bf16* WT, RowMap rm) {
    LAS float* scr = (LAS float*)(F.lds + F.wave * 16384);
    const int gw = F.bid * NWAVES + F.wave, NGW = F.G * NWAVES, nitems = (K / 64) * ((N + 31) / 32);
    for (int it = gw; it < nitems; it += NGW) transpose_item(W, K, N, WT, scr, it, F.lane, rm);
}
__device__ __forceinline__ void phase_convert(Frame& F, int l) {
    unsigned char* wb = F.ws + WS_W;
    convert_matrix(F, FIN(F, I_F1GU) + (size_t)l * DM * NGU, DM, NGU, (bf16*)(wb + W_GU1), MapGU());
    convert_matrix(F, FIN(F, I_F1D) + (size_t)l * DFF * DM, DFF, DM, (bf16*)(wb + W_D1), MapId());
    convert_matrix(F, FIN(F, I_WIN) + (size_t)l * DM * INCOLS, DM, INCOLS, (bf16*)(wb + W_NG), MapIn());
    for (int m = 0; m < 4; ++m) convert_matrix(F, FIN(F, I_WBR) + ((size_t)l * 4 + m) * 512 * DM, 512, DM, (bf16*)(wb + W_BR) + (size_t)m * DM * 512, MapId());
    convert_matrix(F, FIN(F, I_WOUT) + (size_t)l * DM * DM, DM, DM, (bf16*)(wb + W_O), MapId());
    convert_matrix(F, FIN(F, I_F2GU) + (size_t)l * DM * NGU, DM, NGU, (bf16*)(wb + W_GU2), MapGU());
    convert_matrix(F, FIN(F, I_F2D) + (size_t)l * DFF * DM, DFF, DM, (bf16*)(wb + W_D2), MapId());
    { GAS v4u* z = (GAS v4u*)(wb + W_NG + (size_t)NGC * DM * 2); const int n16 = (NNG - NGC) * DM * 2 / 16;
      for (int i = F.bid * 512 + F.tid; i < n16; i += F.G * 512) z[i] = (v4u){0u, 0u, 0u, 0u}; }
    if (l == 0) {
        GAS f32x4* hm = (GAS f32x4*)(F.ws + WS_HM); const GAS f32x4* mt = (const GAS f32x4*)FIN(F, I_META);
        for (int i = F.bid * 512 + F.tid; i < 256 * DM / 4; i += F.G * 512) hm[i] = (i < NMETA * DM / 4) ? mt[i] : (f32x4){0.f, 0.f, 0.f, 0.f};
    }
}
__device__ __forceinline__ void phase_norm(Frame& F, const float* src_real, const float* gain) {
    const int gw = F.bid * NWAVES + F.wave, NGW = F.G * NWAVES;
    bf16* XN = (bf16*)(F.ws + WS_XN); const float* hm = (const float*)(F.ws + WS_HM);
    f32x4 g[8];
#pragma unroll
    for (int j = 0; j < 8; ++j) g[j] = ((const GAS f32x4*)gain)[F.lane + 64 * j];
    for (int r = gw; r < MPAD; r += NGW) {
        GAS v2u* o8 = (GAS v2u*)(XN + (size_t)r * DM) + F.lane;
        if (r >= MREAL + NMETA) {
#pragma unroll
            for (int j = 0; j < 8; ++j) o8[64 * j] = (v2u){0u, 0u};
            continue; }
        const float* xr = r < MREAL ? src_real + (size_t)r * DM : hm + (size_t)(r - MREAL) * DM;
        f32x4 v[8]; float s = 0.f;
#pragma unroll
        for (int j = 0; j < 8; ++j) { v[j] = ((const GAS f32x4*)xr)[F.lane + 64 * j]; s += (v[j].x * v[j].x + v[j].y * v[j].y) + (v[j].z * v[j].z + v[j].w * v[j].w); }
        const float inv = 1.0f / sqrtf(wave_sum(s) * (1.f / DM) + EPS);
#pragma unroll
        for (int j = 0; j < 8; ++j) { v2u w; w.x = pk2(v[j].x * inv * g[j].x, v[j].y * inv * g[j].y); w.y = pk2(v[j].z * inv * g[j].z, v[j].w * inv * g[j].w); o8[64 * j] = w; }
    }
}

__device__ __forceinline__ f32x4 meta_dot16(const bf16* A  , int lda, const bf16* Bt  , int K, int s0, int s1, int lane) {
    const int fr = lane & 15, g = lane >> 4; const bf16* ap = A + (size_t)fr * lda + 8 * g; const bf16* bp = Bt + (size_t)fr * K + 8 * g;
    f32x4 a0 = (f32x4){0.f, 0.f, 0.f, 0.f}, a1 = a0;
    for (int s = s0; s < s1; s += 2) {
        const bf16x8 x0 = *(const GAS bf16x8*)(ap + 32 * s), x1 = *(const GAS bf16x8*)(ap + 32 * s + 32);
        const bf16x8 w0 = *(const GAS bf16x8*)(bp + 32 * s), w1 = *(const GAS bf16x8*)(bp + 32 * s + 32);
        a0 = __builtin_amdgcn_mfma_f32_16x16x32_bf16(w0, x0, a0, 0, 0, 0); a1 = __builtin_amdgcn_mfma_f32_16x16x32_bf16(w1, x1, a1, 0, 0, 0); }
    return a0 + a1;
}
__device__ __forceinline__ void st_bf16x4(bf16* p, f32x4 v) { v2u w; w.x = pk2(v[0], v[1]); w.y = pk2(v[2], v[3]); *(GAS v2u*)p = w; }
__device__ __forceinline__ void meta_gemm(Frame& F, int kind, const bf16* A, int lda, const bf16* Bt, int N, int K, bf16* Obf, int ldo, float scale) {
    const int lane = F.lane, wave = F.wave, fr = lane & 15, g = lane >> 4;
    const int ngroups = (kind == 0 ? N / 2 : N) / 16;
    LAS f32x4* red = (LAS f32x4*)F.lds;
    const int ns = K / 32, s0 = (wave * ns) >> 3, s1 = ((wave + 1) * ns) >> 3;
    for (int cg = F.bid; cg < ngroups; cg += F.G) {
        const int n0 = 16 * cg;
        f32x4 p0, p1 = (f32x4){0.f, 0.f, 0.f, 0.f};
        if (kind == 0) { const int rg = 256 * (n0 >> 7) + (n0 & 127);
            p0 = meta_dot16(A, lda, Bt + (size_t)rg * K, K, s0, s1, lane); p1 = meta_dot16(A, lda, Bt + (size_t)(rg + 128) * K, K, s0, s1, lane); }
        else if (kind == 4) { const int mb = wave >> 1, kh = wave & 1; p0 = meta_dot16(A + (size_t)mb * MPAD * 512, 512, Bt + ((size_t)mb * DM + n0) * 512, 512, 8 * kh, 8 * kh + 8, lane); }
        else p0 = meta_dot16(A, lda, Bt + (size_t)n0 * K, K, s0, s1, lane);
        red[wave * 64 + lane] = p0; if (kind == 0) red[512 + wave * 64 + lane] = p1;
        LDS_WAIT(); __syncthreads();
        if (wave == 0) {
            f32x4 q[8];
#pragma unroll
            for (int w = 0; w < 8; ++w) q[w] = red[w * 64 + lane];
            if (kind == 4) { f32x4 tot = (f32x4){0.f, 0.f, 0.f, 0.f}; const bf16* G = (const bf16*)(F.ws + WS_BIG);
#pragma unroll
                for (int mb = 0; mb < 4; ++mb) { const f32x4 acc = q[2 * mb] + q[2 * mb + 1]; const v2u gw2 = *(const GAS v2u*)(G + (size_t)(MREAL + fr) * NGATE + mb * DM + n0 + 4 * g);
                    tot[0] += bflo(gw2.x) * acc[0]; tot[1] += bfhi(gw2.x) * acc[1]; tot[2] += bflo(gw2.y) * acc[2]; tot[3] += bfhi(gw2.y) * acc[3]; }
                st_bf16x4(Obf + (size_t)(MREAL + fr) * ldo + n0 + 4 * g, tot);
            } else {
                f32x4 acc = ((q[0] + q[1]) + (q[2] + q[3])) + ((q[4] + q[5]) + (q[6] + q[7]));
                if (kind == 0) { f32x4 up = (f32x4){0.f, 0.f, 0.f, 0.f};
#pragma unroll
                    for (int w = 0; w < 8; ++w) up += red[512 + w * 64 + lane];
#pragma unroll
                    for (int r = 0; r < 4; ++r) acc[r] = pg8::fast_silu(acc[r]) * up[r];
                    st_bf16x4(Obf + (size_t)(MREAL + fr) * ldo + n0 + 4 * g, acc); }
                else if (kind == 1) { float* hp = (float*)(F.ws + WS_HM) + (size_t)fr * DM + n0 + 4 * g; *(GAS f32x4*)hp = *(const GAS f32x4*)hp + acc * scale; }
                else if (kind == 2) st_bf16x4(Obf + (size_t)(MREAL + fr) * ldo + n0 + 4 * g, acc);
                else {
#pragma unroll
                    for (int r = 0; r < 4; ++r) acc[r] = pg8::fast_sigmoid(acc[r]);
                    st_bf16x4(Obf + (size_t)(MREAL + fr) * ldo + n0 + 4 * g, acc); }
            }
        }
        __syncthreads();
    }
}
__device__ __forceinline__ void unpack8(const v4u w, float (&x)[8]) { x[0] = bflo(w.x); x[1] = bfhi(w.x); x[2] = bflo(w.y); x[3] = bfhi(w.y); x[4] = bflo(w.z); x[5] = bfhi(w.z); x[6] = bflo(w.w); x[7] = bfhi(w.w); }
__device__ __forceinline__ v4u pack8(const float (&x)[8]) { v4u w; w.x = pk2(x[0], x[1]); w.y = pk2(x[2], x[3]); w.z = pk2(x[4], x[5]); w.w = pk2(x[6], x[7]); return w; }
template <int GL>
__device__ __forceinline__ void norm_cols_inplace(bf16* p, const v4u w, const float* gain, float scale, int lane, bool wr) {
    float x[8]; unpack8(w, x); float s = 0.f;
#pragma unroll
    for (int i = 0; i < 8; ++i) s += x[i] * x[i];
#pragma unroll
    for (int o = 1; o < GL; o <<= 1) s += __shfl_xor(s, o);
    const float inv = scale / sqrtf(s * (1.f / (GL * 8)) + EPS); const int g0 = (8 * lane) % (GL * 8);
#pragma unroll
    for (int i = 0; i < 8; ++i) x[i] = x[i] * inv * gain[g0 + i];
    if (wr) *(GAS v4u*)p = pack8(x);
}
__device__ __forceinline__ void prep_row(Frame& F, int l, int r) {
    const int lane = F.lane; bf16* pr = (bf16*)(F.ws + WS_BIG) + (size_t)r * NNG;
    const float *dqn = FIN(F, I_DQN) + l * 64, *dkn = FIN(F, I_DKN) + l * 64, *sqn = FIN(F, I_SQN) + l * 128, *skn = FIN(F, I_SKN) + l * 128;
    const v4u w0 = *(const GAS v4u*)(pr + C_CQ + 8 * lane), w1 = *(const GAS v4u*)(pr + C_CK + 8 * lane), w2 = *(const GAS v4u*)(pr + C_DQ + 8 * lane), w3 = *(const GAS v4u*)(pr + C_DK + 8 * (lane & 15));
    __builtin_amdgcn_sched_barrier(0);
    norm_cols_inplace<8>(pr + C_CQ + 8 * lane, w0, dqn, 0.125f * 1.4426950408889634f, lane, true);
    norm_cols_inplace<8>(pr + C_CK + 8 * lane, w1, dkn, 1.0f, lane, true);
    norm_cols_inplace<16>(pr + C_DQ + 8 * lane, w2, sqn, 0.08838834764831845f * 1.4426950408889634f, lane, true);
    norm_cols_inplace<16>(pr + C_DK + 8 * (lane & 15), w3, skn, 1.0f, lane & 15, lane < 16);
}
constexpr int VT_NPB = (LPAD + 63) / 64, VT_NTASK = NB * 5 * VT_NPB;
__device__ __forceinline__ void vt_task(Frame& F, int task) {
    const int lane = F.lane;
    const bf16* P = (const bf16*)(F.ws + WS_BIG); bf16* VtC = (bf16*)(F.ws + WS_VTC); bf16* VtD = (bf16*)(F.ws + WS_VTD);
    LAS bf16* T = (LAS bf16*)(F.lds + F.wave * 17408);
    const int pb = task % VT_NPB, mat = (task / VT_NPB) % 5, b = task / (VT_NPB * 5), p0 = 64 * pb;
    const int col = mat < 4 ? C_CV + 128 * mat : C_DV;
#pragma unroll 4
    for (int i = 0; i < 16; ++i) { const int pl = 4 * i + (lane >> 4), p = p0 + pl;
        v4u w = *(const GAS v4u*)(P + (size_t)seqrow(b, p < LSEQ ? p : LSEQ - 1) * NNG + col + 8 * (lane & 15)); if (p >= LSEQ) w = (v4u){0u, 0u, 0u, 0u};
        *(LAS v4u*)(T + pl * 136 + 8 * (lane & 15)) = w; }
    LDS_WAIT(); asm volatile("" ::: "memory");
    bf16* dst = mat < 4 ? VtC + (size_t)(b * 4 + mat) * 128 * LPAD : VtD + (size_t)b * 128 * LPAD;
#pragma unroll 4
    for (int it = 0; it < 16; ++it) { const int e = 8 * it + (lane >> 3), c = lane & 7; unsigned short x[8];
#pragma unroll
        for (int k = 0; k < 8; ++k) x[k] = T[(8 * c + k) * 136 + e];
        v4u w; w.x = x[0] | ((unsigned)x[1] << 16); w.y = x[2] | ((unsigned)x[3] << 16); w.z = x[4] | ((unsigned)x[5] << 16); w.w = x[6] | ((unsigned)x[7] << 16);
        if (p0 + 8 * c < LPAD) *(GAS v4u*)(dst + (size_t)e * LPAD + p0 + 8 * c) = w; }
    LDS_WAIT(); asm volatile("" ::: "memory");
}

#define NEG_INF (-__builtin_inff())
constexpr int NQT = (LSEQ + 31) / 32;
constexpr int NQB = (NQT + 7) / 8;
__device__ __forceinline__ bf16x8 ld_frag16(const bf16* p) { return *(const GAS bf16x8*)p; }
__device__ __forceinline__ bf16x8 mk_frag(v2u lo, v2u hi) { v4u w; w.x = lo.x; w.y = lo.y; w.z = hi.x; w.w = hi.y; return __builtin_bit_cast(bf16x8, w); }
__device__ __forceinline__ unsigned cvtpk(float lo, float hi) { return pg8::cvt_pk_bf16(lo, hi); }
__device__ __forceinline__ void build_bias_table(Frame& F, LAS float* bt, int col0) {
    const float* rb = FIN(F, I_RELB);
    for (int i = F.tid; i < 4 * 128; i += 512) { const int hd = i >> 7, n = i & 127; bt[i] = (rb[rel_bucket(n) * 8 + col0 + hd] - rb[31 * 8 + col0 + hd]) * 1.4426950408889634f; }
}
__device__ __forceinline__ bool softmax_step(f32x16& S, float& m, float& lsum, float& alpha) {
    float tm = S[0];
#pragma unroll
    for (int r = 1; r < 16; ++r) tm = fmaxf(tm, S[r]);
    tm = fmaxf(tm, __shfl_xor(tm, 32));
    const bool raise = __any(tm > m + 11.5f);
    alpha = 1.0f;
    if (raise) { const float mn = fmaxf(m, tm); alpha = (mn == NEG_INF) ? 1.0f : __builtin_amdgcn_exp2f(m - mn); m = mn; lsum *= alpha; }
    const float mref = (m == NEG_INF) ? 0.f : m;
    float rs = 0.f;
#pragma unroll
    for (int r = 0; r < 16; ++r) { S[r] = __builtin_amdgcn_exp2f(S[r] - mref); rs += S[r]; }
    rs += __shfl_xor(rs, 32);
    lsum += rs;
    return raise;
}
template <bool DSA>
__device__ __forceinline__ void attn_wg_task(Frame& F, int l, int b, int h, int J, const LAS float* bt, float lam, float post) {
    constexpr int KD = DSA ? 128 : 64, KP = KD + 8, VP = 36, NKS = KD / 16;
    constexpr int KBUF = 32 * KP, VBUF = 128 * VP;
    const int lane = F.lane, ql = lane & 31, hh = lane >> 5, wave = F.wave, tid = F.tid;
    LAS bf16* Kl = (LAS bf16*)F.lds; LAS bf16* Vl = Kl + 2 * KBUF;
    const bf16* P = (const bf16*)(F.ws + WS_BIG);
    const bf16* Vt = DSA ? (const bf16*)(F.ws + WS_VTD) + (size_t)b * 128 * LPAD : (const bf16*)(F.ws + WS_VTC) + (size_t)(b * 4 + h) * 128 * LPAD;
    const int jr = 8 * J + wave - 7; const bool wvalid = jr >= 0 && 32 * jr < LSEQ; const int j = jr < 0 ? 0 : jr;
    const int ktmax = (8 * J < NQT - 1) ? 8 * J : NQT - 1;
    const int pq = 32 * j + ql, pqc = pq < LSEQ ? pq : LSEQ - 1;
    const bf16* qrow = P + (size_t)seqrow(b, pqc) * NNG + (DSA ? C_DQ : C_CQ) + h * 128 + 8 * hh;
    const unsigned* mrow = (const unsigned*)(F.ws + WS_MASK) + ((size_t)b * LPAD + pqc) * MASKW;
    const int kr = tid / (KD / 8), kc = tid % (KD / 8); const bool kload = tid < 32 * (KD / 8);
    const int vr = tid >> 2, vc = tid & 3;
    f32x16 R[4];
#pragma unroll
    for (int c = 0; c < (DSA ? 1 : 2); ++c) {
        const int kcol = DSA ? C_DK : C_CK + h * 128 + c * 64;
        bf16x8 qf[NKS];
#pragma unroll
        for (int ks = 0; ks < NKS; ++ks) qf[ks] = ld_frag16(qrow + (DSA ? 0 : c * 64) + 16 * ks);
        float m = NEG_INF, lsum = 0.f; f32x16 O[4];
#pragma unroll
        for (int eb = 0; eb < 4; ++eb)
#pragma unroll
            for (int r = 0; r < 16; ++r) O[eb][r] = 0.f;
        v4u rk0 = (v4u){0u, 0u, 0u, 0u}, rv0 = rk0, rk1 = rk0, rv1 = rk0;
#define ATT_ISSUE(kt_, RK, RV) do { int pk_ = 32 * (kt_) + kr; pk_ = pk_ < LSEQ ? pk_ : LSEQ - 1; \
            if (kload) RK = *(const GAS v4u*)(P + (size_t)seqrow(b, pk_) * NNG + kcol + 8 * kc); \
            RV = *(const GAS v4u*)(Vt + (size_t)vr * LPAD + 32 * (kt_) + 8 * vc); } while (0)
#define ATT_COMMIT(buf_, RK, RV) do { if (kload) *(LAS v4u*)(Kl + (buf_) * KBUF + kr * KP + 8 * kc) = RK; \
            LAS v2u* vd_ = (LAS v2u*)(Vl + (buf_) * VBUF + vr * VP + 8 * vc); vd_[0] = (v2u){RV.x, RV.y}; vd_[1] = (v2u){RV.z, RV.w}; } while (0)
        unsigned mwc = 0xffffffffu, mwn = 0xffffffffu; if (DSA) mwc = mrow[0];
        auto compute = [&](int kt, int buf) {
            if (DSA) mwn = mrow[kt + 1 <= ktmax ? kt + 1 : ktmax];
            if (wvalid && kt <= j) {
                const LAS bf16* Kt = Kl + buf * KBUF + ql * KP + 8 * hh; const LAS bf16* Vb = Vl + buf * VBUF + ql * VP + 4 * hh;
                f32x16 S;
#pragma unroll
                for (int r = 0; r < 16; ++r) S[r] = 0.f;
#pragma unroll
                for (int ks = 0; ks < NKS; ++ks) S = __builtin_amdgcn_mfma_f32_32x32x16_bf16(*(const LAS bf16x8*)(Kt + 16 * ks), qf[ks], S, 0, 0, 0);
                const unsigned mw = mwc >> (4 * hh);
                if (kt + 4 >= j) {
#pragma unroll
                    for (int r = 0; r < 16; ++r) { const int ko = (r & 3) + 8 * (r >> 2), n = pq - (32 * kt + 4 * hh + ko); const bool sel = ((mw >> ko) & 1u) && n >= 0;
                        S[r] = sel ? S[r] + bt[h * 128 + (n < 127 ? n : 127)] : NEG_INF; }
                } else if (DSA) {
#pragma unroll
                    for (int r = 0; r < 16; ++r) { const int ko = (r & 3) + 8 * (r >> 2); S[r] = ((mw >> ko) & 1u) ? S[r] : NEG_INF; }
                }
                float alpha;
                if (softmax_step(S, m, lsum, alpha)) {
#pragma unroll
                    for (int eb = 0; eb < 4; ++eb)
#pragma unroll
                        for (int r = 0; r < 16; ++r) O[eb][r] *= alpha;
                }
                bf16x8 pf[2];
#pragma unroll
                for (int s = 0; s < 2; ++s) { v4u w; w.x = cvtpk(S[8 * s + 0], S[8 * s + 1]); w.y = cvtpk(S[8 * s + 2], S[8 * s + 3]); w.z = cvtpk(S[8 * s + 4], S[8 * s + 5]); w.w = cvtpk(S[8 * s + 6], S[8 * s + 7]); pf[s] = __builtin_bit_cast(bf16x8, w); }
#pragma unroll
                for (int eb = 0; eb < 4; ++eb)
#pragma unroll
                    for (int s = 0; s < 2; ++s) { const LAS bf16* vp = Vb + eb * 32 * VP + 16 * s;
                        O[eb] = __builtin_amdgcn_mfma_f32_32x32x16_bf16(mk_frag(*(const LAS v2u*)vp, *(const LAS v2u*)(vp + 8)), pf[s], O[eb], 0, 0, 0); }
            }
            if (DSA) mwc = mwn; };
        __syncthreads();
        ATT_ISSUE(0, rk0, rv0); ATT_COMMIT(0, rk0, rv0);
        if (ktmax >= 1) ATT_ISSUE(1, rk1, rv1);
        for (int kt = 0; kt <= ktmax; kt += 2) {
            LDS_WAIT(); __syncthreads();
            if (kt + 2 <= ktmax) ATT_ISSUE(kt + 2, rk0, rv0);
            compute(kt, 0);
            if (kt + 1 <= ktmax) ATT_COMMIT(1, rk1, rv1);
            if (kt + 1 > ktmax) break;
            LDS_WAIT(); __syncthreads();
            if (kt + 3 <= ktmax) ATT_ISSUE(kt + 3, rk1, rv1);
            compute(kt + 1, 1);
            if (kt + 2 <= ktmax) ATT_COMMIT(0, rk0, rv0);
        }
#undef ATT_ISSUE
#undef ATT_COMMIT
        const float il = 1.0f / lsum;
        if (DSA) {
#pragma unroll
            for (int eb = 0; eb < 4; ++eb)
#pragma unroll
                for (int r = 0; r < 16; ++r) R[eb][r] = O[eb][r] * il;
        } else if (c == 0) {
            LAS unsigned* rp = (LAS unsigned*)(F.lds + 28672) + wave * 2048 + lane;
#pragma unroll
            for (int eb = 0; eb < 4; ++eb)
#pragma unroll
                for (int r = 0; r < 16; r += 2) rp[(eb * 8 + (r >> 1)) * 64] = pk2(O[eb][r] * il, O[eb][r + 1] * il);
        } else {
            const LAS unsigned* rp = (const LAS unsigned*)(F.lds + 28672) + wave * 2048 + lane;
#pragma unroll
            for (int eb = 0; eb < 4; ++eb)
#pragma unroll
                for (int r = 0; r < 16; r += 2) { const unsigned w = rp[(eb * 8 + (r >> 1)) * 64]; R[eb][r] = bflo(w) - lam * (O[eb][r] * il); R[eb][r + 1] = bfhi(w) - lam * (O[eb][r + 1] * il); }
        }
    }
    float inv = 1.0f;
    if (!DSA) { float ss = 0.f;
#pragma unroll
        for (int eb = 0; eb < 4; ++eb)
#pragma unroll
            for (int r = 0; r < 16; ++r) ss += R[eb][r] * R[eb][r];
        ss += __shfl_xor(ss, 32); inv = post / sqrtf(ss * (1.f / 128.f) + EPS); }
    const float* sub = FIN(F, I_DSUB) + l * 128;
    if (wvalid && pq < LSEQ && (pq >= NMETA || b == 0)) {
        bf16* orow = (bf16*)(F.ws + WS_BR) + (size_t)(DSA ? 3 : 2) * MPAD * 512 + (size_t)seqrow(b, pq) * 512 + h * 128;
#pragma unroll
        for (int eb = 0; eb < 4; ++eb)
#pragma unroll
            for (int g = 0; g < 4; ++g) { const int e0 = 32 * eb + 8 * g + 4 * hh; f32x4 sv = (f32x4){1.f, 1.f, 1.f, 1.f}; if (!DSA) sv = *(const GAS f32x4*)(sub + e0);
                v2u w; w.x = pk2(R[eb][4 * g] * inv * sv.x, R[eb][4 * g + 1] * inv * sv.y); w.y = pk2(R[eb][4 * g + 2] * inv * sv.z, R[eb][4 * g + 3] * inv * sv.w);
                *(GAS v2u*)(orow + e0) = w; }
    }
}
__device__ __forceinline__ unsigned f32_key(float f) { const unsigned u = __float_as_uint(f); return u ^ ((u >> 31) ? 0xffffffffu : 0x80000000u); }
__device__ __forceinline__ void dsa_index_task(Frame& F, int b, int j, float* slab) {
    const int lane = F.lane, ql = lane & 31, hh = lane >> 5, wave = F.wave;
    const bf16* P = (const bf16*)(F.ws + WS_BIG);
    LAS unsigned char* qi = F.lds;
    for (int i = F.tid; i < 32 * 128; i += 512) { const int q = i >> 7, ch = i & 127; int pq = 32 * j + q; pq = pq < LSEQ ? pq : LSEQ - 1;
        *(LAS v4u*)(qi + q * 2064 + 16 * ch) = *(const GAS v4u*)(P + (size_t)seqrow(b, pq) * NNG + C_DQI + 8 * ch); }
    LAS float* wl = (LAS float*)(qi + 32 * 2064);
    if (F.tid < 32 * 16) { const int q = F.tid >> 4, hd = F.tid & 15; int pq = 32 * j + q; pq = pq < LSEQ ? pq : LSEQ - 1;
        wl[F.tid] = bf2f(P[(size_t)seqrow(b, pq) * NNG + C_DW + hd]) * 0.03125f; }
    LAS unsigned* hist = (LAS unsigned*)(F.lds + 73728);
    for (int i = F.tid; i < 32 * 256; i += 512) hist[i] = 0u;
    LDS_WAIT(); __syncthreads();
#ifndef PROBE_SUB
#define PROBE_SUB 0
#endif
    for (int rpa = 0; rpa < ((PROBE_SUB & 8) ? 2 : 1); ++rpa)
    {
    bf16x8 kn[4];
    { const int pk = 32 * wave + ql, pkc = pk < LSEQ ? pk : LSEQ - 1; const bf16* krow = P + (size_t)seqrow(b, pkc) * NNG + C_DKI + 8 * hh;
#pragma unroll
      for (int ks = 0; ks < 4; ++ks) kn[ks] = ld_frag16(krow + 16 * ks); }
    for (int kt = wave; kt <= j; kt += NWAVES) {
        bf16x8 kf[4];
#pragma unroll
        for (int ks = 0; ks < 4; ++ks) kf[ks] = kn[ks];
        { const int ktn = kt + NWAVES <= j ? kt + NWAVES : kt; const int pk = 32 * ktn + ql, pkc = pk < LSEQ ? pk : LSEQ - 1; const bf16* krow = P + (size_t)seqrow(b, pkc) * NNG + C_DKI + 8 * hh;
#pragma unroll
          for (int ks = 0; ks < 4; ++ks) kn[ks] = ld_frag16(krow + 16 * ks); }
        f32x16 idx;
#pragma unroll
        for (int r = 0; r < 16; ++r) idx[r] = 0.f;
#pragma unroll 1
        for (int hd = 0; hd < 16; hd += 2) { f32x16 S0, S1; const float wh0 = wl[ql * 16 + hd], wh1 = wl[ql * 16 + hd + 1];
#pragma unroll
            for (int r = 0; r < 16; ++r) { S0[r] = 0.f; S1[r] = 0.f; }
#pragma unroll
            for (int ks = 0; ks < 4; ++ks) { S0 = __builtin_amdgcn_mfma_f32_32x32x16_bf16(kf[ks], *(const LAS bf16x8*)(qi + ql * 2064 + hd * 128 + 32 * ks + 16 * hh), S0, 0, 0, 0);
                S1 = __builtin_amdgcn_mfma_f32_32x32x16_bf16(kf[ks], *(const LAS bf16x8*)(qi + ql * 2064 + (hd + 1) * 128 + 32 * ks + 16 * hh), S1, 0, 0, 0); }
#pragma unroll
            for (int r = 0; r < 16; ++r) idx[r] += wh0 * fmaxf(S0[r], 0.f) + wh1 * fmaxf(S1[r], 0.f); }
        { const int pqh = 32 * j + ql;
#pragma unroll
          for (int r = 0; r < 16; ++r) { const int kp = 32 * kt + 4 * hh + (r & 3) + 8 * (r >> 2);
              int bn = (int)__builtin_floorf(__builtin_fmaf(idx[r], 32.f, 256.f)); bn = bn < 0 ? 0 : (bn > 511 ? 511 : bn);
              if (kp <= pqh) (void)__hip_atomic_fetch_add(hist + ql * 256 + (bn >> 1), 1u << (16 * (bn & 1)), __ATOMIC_RELAXED, __HIP_MEMORY_SCOPE_WORKGROUP); } }
        float* srow = slab + (size_t)ql * LPAD + 32 * kt + 4 * hh;
#pragma unroll
        for (int g = 0; g < 4; ++g) *(GAS f32x4*)(srow + 8 * g) = (f32x4){idx[4 * g], idx[4 * g + 1], idx[4 * g + 2], idx[4 * g + 3]};
    }
    }
    VM_WAIT(); LDS_WAIT(); __syncthreads();
    for (int rpb = 0; rpb < ((PROBE_SUB & 16) ? 2 : 1); ++rpb)
    for (int qq = wave; qq < 32; qq += NWAVES) {
        const int p = 32 * j + qq; if (p >= LSEQ) break;
        const float* row = slab + (size_t)qq * LPAD;
        unsigned u[65];
        { const GAS unsigned* rp = (const GAS unsigned*)row + lane;
#pragma unroll
          for (int i = 0; i < 65; ++i) u[i] = rp[64 * i];
          __builtin_amdgcn_sched_barrier(0); }
        auto wsum = [&](unsigned c) { unsigned s = 0;
#pragma unroll
            for (int k = 0; k < 7; ++k) s += (unsigned)__builtin_popcountll(__ballot((c >> k) & 1u)) << k;
            return s; };
        unsigned T = 1u;
        if (p + 1 <= 256) {
#pragma unroll
            for (int i = 0; i < 65; ++i) { const unsigned k = f32_key(__uint_as_float(u[i])) >> 1; u[i] = (64 * i + lane <= p) ? k : 0u; }
        } else {
            const LAS unsigned* hrow = hist + qq * 256 + 4 * lane; unsigned c8[8];
#pragma unroll
            for (int i = 0; i < 4; ++i) { const unsigned w = hrow[i]; c8[2 * i] = w & 0xffffu; c8[2 * i + 1] = w >> 16; }
            unsigned tot = 0;
#pragma unroll
            for (int i = 0; i < 8; ++i) tot += c8[i];
            unsigned suf = 0;
            { const unsigned long long gtm = (lane == 63) ? 0ull : ~((2ull << lane) - 1ull);
#pragma unroll
              for (int k = 0; k < 13; ++k) suf += (unsigned)__builtin_popcountll(__ballot((tot >> k) & 1u) & gtm) << k; }
            unsigned run = suf, bl = 0, al = 0; bool found = false;
#pragma unroll
            for (int i = 7; i >= 0; --i) { const bool hit = !found && run < 256u && run + c8[i] >= 256u; if (hit) { bl = 8u * lane + i; al = run; } found = found || hit; run += c8[i]; }
            const unsigned long long fb = __ballot(found); const int src = (int)__builtin_ctzll(fb | (1ull << 63));
            const unsigned bstar = __builtin_amdgcn_readlane(bl, src), above = __builtin_amdgcn_readlane(al, src), need = 256u - above;
            unsigned f0 = 0u, f1 = 0u, f2 = 0u, cb = 0u;
#pragma unroll
            for (int i = 0; i < 65; ++i) { const float v = __uint_as_float(u[i]); int bn = (int)__builtin_floorf(__builtin_fmaf(v, 32.f, 256.f)); bn = bn < 0 ? 0 : (bn > 511 ? 511 : bn);
                const bool val = 64 * i + lane <= p, inband = val && (unsigned)bn == bstar;
                if (i < 32) f0 |= inband ? (1u << i) : 0u; else if (i < 64) f1 |= inband ? (1u << (i - 32)) : 0u; else f2 = inband ? 1u : 0u;
                cb += inband ? 1u : 0u;
                const unsigned k = f32_key(v) >> 1; u[i] = val ? k : 0u; }
            const unsigned inb = wsum(cb);
            if (fb != 0ull && inb <= 128u && inb >= need) {
                LAS unsigned* band = (LAS unsigned*)(F.lds + 68096) + wave * 128;
                unsigned off = 0;
#pragma unroll
                for (int k = 0; k < 7; ++k) { const unsigned long long bal = __ballot((cb >> k) & 1u); off += __builtin_amdgcn_mbcnt_hi((unsigned)(bal >> 32), __builtin_amdgcn_mbcnt_lo((unsigned)bal, 0u)) << k; }
#pragma unroll
                for (int i = 0; i < 65; ++i) { const bool inband = i < 32 ? ((f0 >> i) & 1u) : (i < 64 ? ((f1 >> (i - 32)) & 1u) : (f2 & 1u)); if (inband) { band[off] = u[i]; ++off; } }
                LDS_WAIT();
                const unsigned m0 = lane < (int)inb ? band[lane] : 0u, m1 = lane + 64 < (int)inb ? band[lane + 64] : 0u; unsigned ge0 = 0, gt0 = 0, ge1 = 0, gt1 = 0;
                for (unsigned k = 0; k < inb; ++k) { const unsigned v = band[k]; ge0 += (m0 - 1u - v) >> 31; gt0 += (m0 - v) >> 31; ge1 += (m1 - 1u - v) >> 31; gt1 += (m1 - v) >> 31; }
                const unsigned long long ok0 = __ballot(lane < (int)inb && ge0 >= need && gt0 < need), ok1 = __ballot(lane + 64 < (int)inb && ge1 >= need && gt1 < need);
                if (ok0) T = __builtin_amdgcn_readlane(m0, (int)__builtin_ctzll(ok0)); else T = __builtin_amdgcn_readlane(m1, (int)__builtin_ctzll(ok1 | (1ull << 63)));
                LDS_WAIT();
            } else {
                T = 0u;
                for (int bit = 30; bit >= 0; --bit) { const unsigned cm1 = (T | (1u << bit)) - 1u; unsigned c = 0;
#pragma unroll
                    for (int i = 0; i < 65; ++i) c += (cm1 - u[i]) >> 31;
                    if (wsum(c) >= 256u) T |= 1u << bit; } } }
        unsigned long long* mrow = (unsigned long long*)((unsigned*)(F.ws + WS_MASK) + ((size_t)b * LPAD + p) * MASKW);
        unsigned wlo = 0u, whi = 0u;
#pragma unroll
        for (int i = 0; i < 64; ++i) { const unsigned long long bal = __ballot(u[i] >= T); if (lane == i) { wlo = (unsigned)bal; whi = (unsigned)(bal >> 32); } }
        const unsigned long long b64 = __ballot(u[64] >= T);
        mrow[lane] = ((unsigned long long)whi << 32) | wlo; if (lane == 0) mrow[64] = b64;
    }
    __syncthreads();
}
struct HgChunk { bf16* base; int pitch; int cq, ck, cv; bf16* A; float* dl; };
__device__ __forceinline__ HgChunk hg_chunk(Frame& F, int b, int h, int c) {
    HgChunk k;
    if (c == 0) { unsigned char* mp = F.ws + WS_HMETA + (size_t)h * HMETA_STRIDE; k.base = (bf16*)mp; k.pitch = 384; k.cq = 0; k.ck = 128; k.cv = 256; k.A = (bf16*)(mp + 64 * 384 * 2); k.dl = (float*)(mp + 64 * 384 * 2 + 64 * 64 * 2); }
    else { const size_t ci = (size_t)(b * 4 + h) * 64 + (c - 1); k.base = (bf16*)(F.ws + WS_BIG) + (size_t)(b * SEQ + 64 * (c - 1)) * NNG; k.pitch = NNG; k.cq = C_AQ + h * 128; k.ck = C_AF + h * 128; k.cv = C_AI + h * 128;
        k.A = (bf16*)(F.ws + WS_HA) + ci * 64 * 64; k.dl = (float*)(F.ws + WS_HDL) + ci * 128; }
    return k;
}
__device__ __forceinline__ void hgrn_prep_task(Frame& F, int l, int b, int h, int c) {
    const int d = F.tid & 127, tq = F.tid >> 7, lane = F.lane, wave = F.wave;
    const bf16* P = (const bf16*)(F.ws + WS_BIG);
    LAS bf16* Qt = (LAS bf16*)F.lds; LAS bf16* Kt = Qt + 64 * 136; LAS float* part = (LAS float*)(F.lds + 2 * 64 * 136 * 2);
    const HgChunk ch = hg_chunk(F, b, h, c);
    float lb = 0.f; if (l == 1) { const float a = FIN(F, I_LB)[h * 128 + d], cc = FIN(F, I_LB)[512 + h * 128 + d]; lb = 1.0f / (1.0f + __expf(a - cc)); }
    const bool meta = (c == 0);
    unsigned short zr[16], qr[16], vr[16];
    { const int r0 = meta ? MREAL : b * SEQ + 64 * (c - 1);
#pragma unroll
      for (int i = 0; i < 16; ++i) { int t = 16 * tq + i; if (meta) t = t < NMETA ? t : NMETA - 1; const bf16* pr = P + (size_t)(r0 + t) * NNG + h * 128 + d; zr[i] = pr[C_AF]; qr[i] = pr[C_AQ]; vr[i] = pr[C_AI]; }
      __builtin_amdgcn_sched_barrier(0); }
    float lfv[16];
    float run = 0.f;
#pragma unroll
    for (int i = 0; i < 16; ++i) { const bool valid = !meta || (16 * tq + i < NMETA); const float z = bf2f(zr[i]); const float sg = 1.0f / (1.0f + __expf(-z));
        lfv[i] = valid ? __logf(lb + (1.0f - lb) * sg) : 0.f; run += lfv[i]; }
    part[tq * 128 + d] = run;
    LDS_WAIT(); __syncthreads();
    const float p0 = part[d], p1 = part[128 + d], p2 = part[256 + d], p3 = part[384 + d];
    const float off = (tq > 0 ? p0 : 0.f) + (tq > 1 ? p1 : 0.f) + (tq > 2 ? p2 : 0.f), bmid = p0 + p1, blast = (p0 + p1) + (p2 + p3);
    unsigned kb[8], vb[8]; unsigned short qb[16];
    float bt = off;
#pragma unroll
    for (int i = 0; i < 16; i += 2) { float kbar[2], vv[2];
#pragma unroll
        for (int u = 0; u < 2; ++u) { const int t = 16 * tq + i + u; const bool valid = !meta || (t < NMETA);
            const float lf = lfv[i + u]; const float q = bf2f(qr[i + u]);
            const float kk = valid ? 1.0f - __expf(lf) : 0.f, qq = valid ? q / (1.0f + __expf(-q)) : 0.f; vv[u] = valid ? bf2f(vr[i + u]) : 0.f;
            bt += lf;
            kbar[u] = kk * __expf(blast - bt); qb[i + u] = (unsigned short)f2bf_s(qq * __expf(bt));
            const float qt = qq * __expf(fminf(bt - bmid, 80.f)), kt = kk * __expf(fminf(bmid - bt, 80.f));
            Qt[t * 136 + d] = (bf16)f2bf_s(qt); Kt[t * 136 + d] = (bf16)f2bf_s(kt); }
        kb[i >> 1] = pk2(kbar[0], kbar[1]); vb[i >> 1] = pk2(vv[0], vv[1]); }
    asm volatile("s_waitcnt vmcnt(0)" ::: "memory"); __syncthreads();
#pragma unroll
    for (int i = 0; i < 16; ++i) ch.base[(size_t)(16 * tq + i) * ch.pitch + ch.cq + d] = qb[i];
    { bf16* kd = ch.base + (size_t)(d >> 1) * ch.pitch + ch.ck + (d & 1) * 64 + 16 * tq; bf16* vd = ch.base + (size_t)(d >> 1) * ch.pitch + ch.cv + (d & 1) * 64 + 16 * tq;
      *(GAS v4u*)kd = (v4u){kb[0], kb[1], kb[2], kb[3]}; *(GAS v4u*)(kd + 8) = (v4u){kb[4], kb[5], kb[6], kb[7]};
      *(GAS v4u*)vd = (v4u){vb[0], vb[1], vb[2], vb[3]}; *(GAS v4u*)(vd + 8) = (v4u){vb[4], vb[5], vb[6], vb[7]}; }
    if (tq == 0) ch.dl[d] = __expf(blast);
    LDS_WAIT(); __syncthreads();
    { const int mt = wave >> 1, fr = lane & 15, g = lane >> 4;
#pragma unroll
      for (int u = 0; u < 2; ++u) { const int nt = 2 * (wave & 1) + u; f32x4 acc = (f32x4){0.f, 0.f, 0.f, 0.f};
        if (nt <= mt) {
#pragma unroll
            for (int ks = 0; ks < 4; ++ks) acc = __builtin_amdgcn_mfma_f32_16x16x32_bf16(*(const LAS bf16x8*)(Qt + (16 * mt + fr) * 136 + 32 * ks + 8 * g), *(const LAS bf16x8*)(Kt + (16 * nt + fr) * 136 + 32 * ks + 8 * g), acc, 0, 0, 0);
        }
#pragma unroll
        for (int r = 0; r < 4; ++r) { const int t = 16 * mt + 4 * g + r, s = 16 * nt + fr; ch.A[t * 64 + s] = (bf16)f2bf_s(s <= t ? acc[r] : 0.f); } } }
    __syncthreads();
}
__device__ __forceinline__ void hgrn_scan_unit(Frame& F, int l, int b, int h) {
    const int lane = F.lane, wave = F.wave, fr = lane & 15, g = lane >> 4, tid = F.tid;
    constexpr int QP = 136, AP = 72, KP = 72, GP = 136;
    constexpr int BUF = (64 * QP + 64 * AP + 128 * KP + 64 * GP) * 2 + 512;
    LAS float* red = (LAS float*)(F.lds + 2 * BUF);
    const int dv = 16 * wave + fr;
    const float gn = FIN(F, I_GN)[l * 512 + h * 128 + dv];
    const bf16* Pg = (const bf16*)(F.ws + WS_BIG) + C_AG + h * 128;
    f32x4 S[8];
#pragma unroll
    for (int mt = 0; mt < 8; ++mt) S[mt] = (f32x4){0.f, 0.f, 0.f, 0.f};
    v4u rq[2], ra, rk[2], rg[2], rd; bf16x8 bv0, bv1, bn0, bn1;
#define HG_ISSUE(c_, B0, B1) do { const HgChunk ch_ = hg_chunk(F, b, h, (c_)); const int nv_ = ((c_) == 0) ? NMETA : 64; \
        _Pragma("unroll") for (int i = 0; i < 2; ++i) { const int idx = tid + 512 * i, row = idx >> 4, c16 = idx & 15; \
            rq[i] = *(const GAS v4u*)(ch_.base + (size_t)row * ch_.pitch + ch_.cq + 8 * c16); rk[i] = *(const GAS v4u*)(ch_.base + (size_t)row * ch_.pitch + ch_.ck + 8 * c16); \
            rg[i] = (v4u){0u, 0u, 0u, 0u}; if (row < nv_) rg[i] = *(const GAS v4u*)(Pg + (size_t)(((c_) == 0) ? MREAL + row : b * SEQ + 64 * ((c_) - 1) + row) * NNG + 8 * c16); } \
        ra = *(const GAS v4u*)(ch_.A + 8 * tid); if (tid < 32) rd = *(const GAS v4u*)(ch_.dl + 4 * tid); \
        const bf16* vrow_ = ch_.base + (size_t)(dv >> 1) * ch_.pitch + ch_.cv + (dv & 1) * 64 + 8 * g; B0 = ld_frag16(vrow_); B1 = ld_frag16(vrow_ + 32); } while (0)
#define HG_COMMIT(buf_) do { LAS bf16* Q_ = (LAS bf16*)(F.lds + (buf_) * BUF); LAS bf16* A_ = Q_ + 64 * QP; LAS bf16* KT_ = A_ + 64 * AP; LAS bf16* G_ = KT_ + 128 * KP; \
        _Pragma("unroll") for (int i = 0; i < 2; ++i) { const int idx = tid + 512 * i, row = idx >> 4, c16 = idx & 15; *(LAS v4u*)(Q_ + row * QP + 8 * c16) = rq[i]; \
            *(LAS v4u*)(KT_ + (2 * row + (c16 >> 3)) * KP + 8 * (c16 & 7)) = rk[i]; *(LAS v4u*)(G_ + row * GP + 8 * c16) = rg[i]; } \
        *(LAS v4u*)(A_ + (tid >> 3) * AP + 8 * (tid & 7)) = ra; if (tid < 32) *(LAS v4u*)((LAS unsigned char*)(G_ + 64 * GP) + 16 * tid) = rd; } while (0)
    HG_ISSUE(0, bv0, bv1); HG_COMMIT(0);
    for (int c = 0; c <= 64; ++c) {
        const int buf = c & 1;
        LDS_WAIT(); __syncthreads();
        if (c < 64) HG_ISSUE(c + 1, bn0, bn1);
        LAS bf16* Q = (LAS bf16*)(F.lds + buf * BUF); LAS bf16* A = Q + 64 * QP; LAS bf16* KT = A + 64 * AP; LAS bf16* G = KT + 128 * KP; const LAS float* DL = (const LAS float*)(G + 64 * GP);
        f32x4 o[4];
#pragma unroll
        for (int mt = 0; mt < 4; ++mt) o[mt] = (f32x4){0.f, 0.f, 0.f, 0.f};
#pragma unroll
        for (int ks = 0; ks < 4; ++ks) { v4u w; w.x = cvtpk(S[2 * ks][0], S[2 * ks][1]); w.y = cvtpk(S[2 * ks][2], S[2 * ks][3]); w.z = cvtpk(S[2 * ks + 1][0], S[2 * ks + 1][1]); w.w = cvtpk(S[2 * ks + 1][2], S[2 * ks + 1][3]);
            const bf16x8 sb = __builtin_bit_cast(bf16x8, w);
#pragma unroll
            for (int mt = 0; mt < 4; ++mt) { const LAS bf16* qp = Q + (16 * mt + fr) * QP + 32 * ks + 4 * g;
                const bf16x8 af = mk_frag(*(const LAS v2u*)qp, *(const LAS v2u*)(qp + 16));
                o[mt] = __builtin_amdgcn_mfma_f32_16x16x32_bf16(af, sb, o[mt], 0, 0, 0); } }
#pragma unroll
        for (int mt = 0; mt < 4; ++mt) { o[mt] = __builtin_amdgcn_mfma_f32_16x16x32_bf16(*(const LAS bf16x8*)(A + (16 * mt + fr) * AP + 8 * g), bv0, o[mt], 0, 0, 0);
            o[mt] = __builtin_amdgcn_mfma_f32_16x16x32_bf16(*(const LAS bf16x8*)(A + (16 * mt + fr) * AP + 32 + 8 * g), bv1, o[mt], 0, 0, 0); }
#pragma unroll
        for (int mt = 0; mt < 8; ++mt) { const f32x4 dl = *(const LAS f32x4*)(DL + 16 * mt + 4 * g); S[mt] = S[mt] * dl;
            S[mt] = __builtin_amdgcn_mfma_f32_16x16x32_bf16(*(const LAS bf16x8*)(KT + (16 * mt + fr) * KP + 8 * g), bv0, S[mt], 0, 0, 0);
            S[mt] = __builtin_amdgcn_mfma_f32_16x16x32_bf16(*(const LAS bf16x8*)(KT + (16 * mt + fr) * KP + 32 + 8 * g), bv1, S[mt], 0, 0, 0); }
#pragma unroll
        for (int mt = 0; mt < 4; ++mt)
#pragma unroll
            for (int r = 0; r < 4; ++r) { float s2 = o[mt][r] * o[mt][r]; s2 += __shfl_xor(s2, 1); s2 += __shfl_xor(s2, 2); s2 += __shfl_xor(s2, 4); s2 += __shfl_xor(s2, 8);
                if (fr == 0) red[wave * 64 + 16 * mt + 4 * g + r] = s2; }
        LDS_WAIT(); __syncthreads();
        const int nvalid = (c == 0) ? NMETA : 64;
#pragma unroll
        for (int mt = 0; mt < 4; ++mt)
#pragma unroll
            for (int r = 0; r < 4; ++r) { const int t = 16 * mt + 4 * g + r; float tot = 0.f;
#pragma unroll
                for (int w = 0; w < 8; ++w) tot += red[w * 64 + t];
                if (t < nvalid && (c > 0 || b == 0)) { const int row = (c == 0) ? MREAL + t : b * SEQ + 64 * (c - 1) + t;
                    const float gr = bf2f(G[t * GP + dv]);
                    const float val = o[mt][r] * (1.0f / sqrtf(tot * (1.f / 128.f) + EPS)) * gn * (gr / (1.0f + __expf(-gr)));
                    ((bf16*)(F.ws + WS_BR))[(size_t)row * 512 + h * 128 + dv] = (bf16)f2bf_s(val); } }
        if (c < 64) { HG_COMMIT(buf ^ 1); bv0 = bn0; bv1 = bn1; }
    }
#undef HG_ISSUE
#undef HG_COMMIT
    __syncthreads();
}
__device__ __forceinline__ void conv_row(Frame& F, int l, int r) {
    const int lane = F.lane; const bf16* P = (const bf16*)(F.ws + WS_BIG);
    int r1, r2;
    if (r < MREAL) { const int b = r >> 12, t = r & 4095; r1 = seqrow(b, NMETA + t - 1); r2 = seqrow(b, NMETA + t - 2); }
    else { const int i = r - MREAL; r1 = i >= 1 ? r - 1 : -1; r2 = i >= 2 ? r - 2 : -1; }
    const float* cw = FIN(F, I_CONVW) + l * 3 * 512 + 8 * lane;
    const int r1c = r1 >= 0 ? r1 : r, r2c = r2 >= 0 ? r2 : r;
    const v4u wc0 = *(const GAS v4u*)(P + (size_t)r * NNG + C_BC + 8 * lane), wu0 = *(const GAS v4u*)(P + (size_t)r * NNG + C_BU + 8 * lane), wb = *(const GAS v4u*)(P + (size_t)r * NNG + C_BB + 8 * lane);
    const v4u wc1 = *(const GAS v4u*)(P + (size_t)r1c * NNG + C_BC + 8 * lane), wu1 = *(const GAS v4u*)(P + (size_t)r1c * NNG + C_BU + 8 * lane);
    const v4u wc2 = *(const GAS v4u*)(P + (size_t)r2c * NNG + C_BC + 8 * lane), wu2 = *(const GAS v4u*)(P + (size_t)r2c * NNG + C_BU + 8 * lane);
    __builtin_amdgcn_sched_barrier(0);
    float c0[8], u0[8], bb[8], y[8]; unpack8(wc0, c0); unpack8(wu0, u0); unpack8(wb, bb);
#pragma unroll
    for (int i = 0; i < 8; ++i) y[i] = cw[i] * (c0[i] * u0[i]);
    const float m1 = r1 >= 0 ? 1.f : 0.f, m2 = r2 >= 0 ? 1.f : 0.f;
    unpack8(wc1, c0); unpack8(wu1, u0);
#pragma unroll
    for (int i = 0; i < 8; ++i) y[i] += m1 * cw[512 + i] * (c0[i] * u0[i]);
    unpack8(wc2, c0); unpack8(wu2, u0);
#pragma unroll
    for (int i = 0; i < 8; ++i) y[i] += m2 * cw[1024 + i] * (c0[i] * u0[i]);
#pragma unroll
    for (int i = 0; i < 8; ++i) y[i] *= bb[i];
    *(GAS v4u*)((bf16*)(F.ws + WS_BR) + (size_t)MPAD * 512 + (size_t)r * 512 + 8 * lane) = pack8(y);
}
constexpr int CW_TMO = 0, CW_BAR = 4096, CW_Q = 16384;
__device__ __forceinline__ int queue_pop(Frame& F, int qi) {
    int t = 0; if (F.lane == 0) t = (int)__hip_atomic_fetch_add((unsigned*)(F.ctl + CW_Q + 64 * qi), 1u, RLX_AGENT);
    return __builtin_amdgcn_readfirstlane(t);
}
__device__ __forceinline__ int queue_pop_wg(Frame& F, int qi) {
    LAS int* slot = (LAS int*)(F.lds + 139264);
    __syncthreads();
    if (F.tid == 0) *slot = (int)__hip_atomic_fetch_add((unsigned*)(F.ctl + CW_Q + 64 * qi), 1u, RLX_AGENT);
    LDS_WAIT(); __syncthreads();
    return __builtin_amdgcn_readfirstlane(*slot);
}
__device__ __forceinline__ void phase_hgrn_prep(Frame& F, int l) {
    for (int t = F.bid; t < NB * 4 * 64 + 4; t += F.G) { if (t < 4) hgrn_prep_task(F, l, 0, t, 0); else { const int u = t - 4; hgrn_prep_task(F, l, u >> 8, (u >> 6) & 3, 1 + (u & 63)); } }
}
__device__ __forceinline__ void phase_prep(Frame& F, int l) { const int gw = F.bid * NWAVES + F.wave, NGW = F.G * NWAVES; for (int r = gw; r < MREAL + NMETA; r += NGW) prep_row(F, l, r); }
__device__ __forceinline__ void phase_vt(Frame& F) { const int gw = F.bid * NWAVES + F.wave, NGW = F.G * NWAVES; for (int t = gw; t < VT_NTASK; t += NGW) vt_task(F, t); }
__device__ __forceinline__ void phase_mix1(Frame& F, int l, int qidx) {
    LAS float* bt = (LAS float*)(F.lds + 135168);
    build_bias_table(F, bt, 0);
    __syncthreads();
    if (F.bid < NIDX_WG) {
        float* slab = (float*)(F.ws + WS_SCR) + (size_t)F.bid * 32 * LPAD;
        for (int t = F.bid; t < NB * NQT; t += NIDX_WG) { const int j = NQT - 1 - t / NB, b = t % NB; dsa_index_task(F, b, j, slab); }
    } else if (F.bid < NIDX_WG + NHG_WG) {
        const int u = F.bid - NIDX_WG; hgrn_scan_unit(F, l, u >> 2, u & 3);
    } else {
        const int u0 = F.bid - NIDX_WG - NHG_WG, nw = F.G - NIDX_WG - NHG_WG;
        const int cw = u0 * NWAVES + F.wave, ncw = nw * NWAVES; for (int r = cw; r < MREAL + NMETA; r += ncw) conv_row(F, l, r);
    }
    float lam, post;
    { const float* lp = FIN(F, I_DLAM) + l * 256; const float s1 = wave_sum(lp[F.lane] * lp[64 + F.lane]), s2 = wave_sum(lp[128 + F.lane] * lp[192 + F.lane]);
      const float li = 0.8f - 0.6f * __expf(-0.3f * (float)l); lam = __expf(s1) - __expf(s2) + li; post = 1.0f - li; }
    for (;;) { const int t = queue_pop_wg(F, qidx); if (t >= NB * 4 * NQB) break;
        const int J = NQB - 1 - t / 32, bh = t % 32; attn_wg_task<false>(F, l, bh >> 2, bh & 3, J, bt, lam, post); }
}
__device__ __forceinline__ void phase_mix2(Frame& F, int l, int qidx) {
    LAS float* bt = (LAS float*)(F.lds + 135168);
    build_bias_table(F, bt, 4);
    __syncthreads();
    for (;;) { const int t = queue_pop_wg(F, qidx); if (t >= NB * 4 * NQB) break;
        const int J = NQB - 1 - t / 32, bh = t % 32; attn_wg_task<true>(F, l, bh >> 2, bh & 3, J, bt, 0.f, 1.f); }
}

#ifndef MK_ONE
#define MK_ONE 0
#endif
#ifndef BR_MASK
#define BR_MASK 15
#endif
constexpr int NPH = 18;
template <class T> __device__ __forceinline__ T opaque(T v) { asm volatile("" : "+s"(v)); return v; }
struct Args { const float* in[22]; float* out; unsigned char* ws; int ph_lo, ph_hi; };
__global__ void __launch_bounds__(NWAVES * 64, 2) fwd(Args args) {
    extern __shared__ __attribute__((aligned(16))) unsigned char lds[];
    Frame F;
    F.lds = (LAS unsigned char*)lds; F.MISC = (volatile LAS unsigned*)(F.lds + MISC_OFF);
    F.tid = threadIdx.x; F.lane = F.tid & 63; F.wave = __builtin_amdgcn_readfirstlane(F.tid >> 6); F.G = gridDim.x; F.bid = blockIdx.x;
    F.ws = args.ws; F.out = args.out; F.ctl = (gu32*)(args.ws + WS_CTL);
    F.karg = (const unsigned char __attribute__((address_space(4)))*)__builtin_amdgcn_kernarg_segment_ptr();
    for (int u = F.tid; u < (LDS_BYTES - LDSCTL_OFF) / 4; u += NWAVES * 64) ((LAS unsigned*)(F.lds + LDSCTL_OFF))[u] = 0u;
    __syncthreads();
#if MK_ONE
    XcdBarrier bar = xcd_barrier_post((unsigned*)(F.ctl + CW_BAR), F.MISC + 8, __builtin_amdgcn_readfirstlane(threadIdx.x >> 6));
#define GRID_BAR() xcd_barrier(bar)
#else
#define GRID_BAR() do { } while (0)
#endif
    const int wave_s = __builtin_amdgcn_readfirstlane(threadIdx.x >> 6);
    const int lo = args.ph_lo, hi = args.ph_hi;
#define IN(k) (lo <= (k) && (k) < hi)
#define RETID() do { int w_ = wave_s; asm volatile("" : "+s"(w_)); unsigned mk_ = ~0u; asm volatile("" : "+s"(mk_)); int t_ = w_ * 64 + (int)__builtin_amdgcn_mbcnt_hi(mk_, __builtin_amdgcn_mbcnt_lo(mk_, 0u)); asm volatile("" : "+v"(t_)); F.tid = t_; F.lane = t_ & 63; F.wave = w_; } while (0)
#ifdef DBG_TS
#define STAMP(k) do { if (blockIdx.x == 0 && threadIdx.x == 0) ((unsigned long long*)(args.ws + 768 * 1024))[(k)] = __builtin_amdgcn_s_memrealtime(); } while (0)
#else
#define STAMP(k) do { } while (0)
#endif
#define SEAM(k) do { if (IN((k) + 1)) GRID_BAR(); STAMP((k) + 1); } while (0)
#ifndef PROBE_EPI
#define PROBE_EPI 0
#endif
#ifdef PROBE_MASK
#define NREP(kk) opaque(((PROBE_MASK >> (kk)) & 1) ? 1 + PROBE_EXTRA : 1)
#define REP_BEGIN(kk) { const int nrep_ = NREP(kk); for (int rep = 0; rep < nrep_; ++rep) { if (rep) GRID_BAR();
#define REP_END } }
#else
#define REP_BEGIN(kk) { { const int rep = 0; (void)rep;
#define REP_END } }
#endif
    STAMP(0);
    unsigned char* wb = F.ws + WS_W;
    bf16* XN = (bf16*)(F.ws + WS_XN); bf16* BR = (bf16*)(F.ws + WS_BR); bf16* BIG = (bf16*)(F.ws + WS_BIG); float* HM = (float*)(F.ws + WS_HM);
    for (int l = 0; l < 2; ++l) {
        const int pb = l * NPH;
        const float* hsrc = (l == 0) ? FIN(F, I_X) : F.out;
        if (IN(pb + 0)) { REP_BEGIN(0) RETID(); phase_convert(F, l); REP_END SEAM(pb + 0); }
        if (IN(pb + 1)) { REP_BEGIN(1) RETID(); phase_norm(F, hsrc, FIN(F, I_F1N) + l * DM); REP_END SEAM(pb + 1); }
        if (IN(pb + 2)) { REP_BEGIN(2) RETID(); meta_gemm(F, 0, XN + (size_t)MREAL * DM, DM, (const bf16*)(wb + W_GU1), NGU, DM, BIG, DFF, 0.f); pg8::Gemm g{opaque((const bf16*)(XN)), opaque((const bf16*)(wb + W_GU1)), MREAL, NGU, DM}; pg8::StaticOrder S; S.init(MREAL, NGU, F.G, opaque(F.bid));
            pg8::EpiSwiGLU E{BIG, DFF, rep ? PROBE_EPI : 0}; pg8::gemm_phase<pg8::EpiSwiGLU, pg8::StaticOrder, true, true>(F.lds + RING_OFF, g, S, E, F.tid); REP_END SEAM(pb + 2); }
        if (IN(pb + 3)) { REP_BEGIN(3) RETID(); meta_gemm(F, 1, BIG + (size_t)MREAL * DFF, DFF, (const bf16*)(wb + W_D1), DM, DFF, nullptr, 0, rep ? 0.f : 0.5f); pg8::Gemm g{opaque((const bf16*)(BIG)), opaque((const bf16*)(wb + W_D1)), MREAL, DM, DFF}; pg8::StaticOrder S; S.init(MREAL, DM, F.G, opaque(F.bid));
            pg8::EpiResF32 E{rep ? F.out : hsrc, F.out, HM, DM, MT_REAL, rep ? 0.f : 0.5f}; pg8::gemm_phase<pg8::EpiResF32, pg8::StaticOrder, true, true>(F.lds + RING_OFF, g, S, E, F.tid); REP_END SEAM(pb + 3); }
        if (IN(pb + 4)) { REP_BEGIN(4) RETID(); phase_norm(F, F.out, FIN(F, I_MIXN) + l * DM); REP_END SEAM(pb + 4); }
        if (IN(pb + 5)) { REP_BEGIN(5) RETID(); meta_gemm(F, 2, XN + (size_t)MREAL * DM, DM, (const bf16*)(wb + W_NG), NNG, DM, BIG, NNG, 0.f); pg8::Gemm g{opaque((const bf16*)(XN)), opaque((const bf16*)(wb + W_NG)), MREAL, NNG, DM}; pg8::StaticOrder S; S.init(MREAL, NNG, F.G, opaque(F.bid));
            pg8::EpiBf16<0> E{BIG, NNG}; pg8::gemm_phase<pg8::EpiBf16<0>, pg8::StaticOrder, true, true>(F.lds + RING_OFF, g, S, E, F.tid); REP_END SEAM(pb + 5); }
        if (IN(pb + 6)) { RETID(); phase_prep(F, l); phase_vt(F); __syncthreads(); phase_hgrn_prep(F, l); SEAM(pb + 6); }
#ifdef DUP_MIX
        if (IN(pb + 7)) { const int nrep = opaque(DUP_MIX1); for (int rep = 0; rep < nrep; ++rep) { RETID(); phase_mix1(F, l, 4 * rep + 2 * l); GRID_BAR(); } }
        if (IN(pb + 8)) { const int nrep = opaque(DUP_MIX2); for (int rep = 0; rep < nrep; ++rep) { RETID(); phase_mix2(F, l, 4 * rep + 2 * l + 1); GRID_BAR(); } }
#else
        if (IN(pb + 7)) { RETID(); phase_mix1(F, l, 2 * l); SEAM(pb + 7); }
        if (IN(pb + 8)) { RETID(); phase_mix2(F, l, 2 * l + 1); SEAM(pb + 8); }
#endif
        if (IN(pb + 9)) { REP_BEGIN(9) RETID(); meta_gemm(F, 3, XN + (size_t)MREAL * DM, DM, (const bf16*)(wb + W_G), NGATE, DM, BIG, NGATE, 0.f); pg8::Gemm g{opaque((const bf16*)(XN)), opaque((const bf16*)(wb + W_G)), MREAL, NGATE, DM}; pg8::StaticOrder S; S.init(MREAL, NGATE, F.G, opaque(F.bid));
            pg8::EpiBf16<1> E{BIG, NGATE}; pg8::gemm_phase<pg8::EpiBf16<1>, pg8::StaticOrder, true, true>(F.lds + RING_OFF, g, S, E, F.tid); REP_END SEAM(pb + 9); }
        if (IN(pb + 10)) { REP_BEGIN(10) RETID(); meta_gemm(F, 4, BR + (size_t)MREAL * 512, 512, (const bf16*)(wb + W_BR), DM, 512, XN, DM, 0.f);
            pg8::Gemm g{opaque((const bf16*)(BR)), opaque((const bf16*)(wb + W_BR)), MREAL, DM, 512}; pg8::MergeOrder S; S.init(MREAL, DM, F.G, opaque(F.bid), MPAD / 256);
            pg8::EpiGateAccM E{XN, DM, BIG, NGATE, MPAD / 256, DM / 256}; pg8::gemm_phase<pg8::EpiGateAccM, pg8::MergeOrder, true, true>(F.lds + RING_OFF, g, S, E, F.tid); REP_END SEAM(pb + 10); }
        if (IN(pb + 14) && BR_MASK) { REP_BEGIN(14) RETID(); meta_gemm(F, 1, XN + (size_t)MREAL * DM, DM, (const bf16*)(wb + W_O), DM, DM, nullptr, 0, rep ? 0.f : 1.0f); pg8::Gemm g{opaque((const bf16*)(XN)), opaque((const bf16*)(wb + W_O)), MREAL, DM, DM}; pg8::StaticOrder S; S.init(MREAL, DM, F.G, opaque(F.bid));
            pg8::EpiResF32 E{F.out, F.out, HM, DM, MT_REAL, rep ? 0.f : 1.0f}; pg8::gemm_phase<pg8::EpiResF32, pg8::StaticOrder, true, true>(F.lds + RING_OFF, g, S, E, F.tid); REP_END SEAM(pb + 14); }
        if (IN(pb + 15)) { REP_BEGIN(15) RETID(); phase_norm(F, F.out, FIN(F, I_F2N) + l * DM); REP_END SEAM(pb + 15); }
        if (IN(pb + 16)) { REP_BEGIN(16) RETID(); meta_gemm(F, 0, XN + (size_t)MREAL * DM, DM, (const bf16*)(wb + W_GU2), NGU, DM, BIG, DFF, 0.f); pg8::Gemm g{opaque((const bf16*)(XN)), opaque((const bf16*)(wb + W_GU2)), MREAL, NGU, DM}; pg8::StaticOrder S; S.init(MREAL, NGU, F.G, opaque(F.bid));
            pg8::EpiSwiGLU E{BIG, DFF, rep ? PROBE_EPI : 0}; pg8::gemm_phase<pg8::EpiSwiGLU, pg8::StaticOrder, true, true>(F.lds + RING_OFF, g, S, E, F.tid); REP_END SEAM(pb + 16); }
        if (IN(pb + 17)) { REP_BEGIN(17) RETID(); meta_gemm(F, 1, BIG + (size_t)MREAL * DFF, DFF, (const bf16*)(wb + W_D2), DM, DFF, nullptr, 0, rep ? 0.f : 0.5f); pg8::Gemm g{opaque((const bf16*)(BIG)), opaque((const bf16*)(wb + W_D2)), MREAL, DM, DFF}; pg8::StaticOrder S; S.init(MREAL, DM, F.G, opaque(F.bid));
            pg8::EpiResF32 E{F.out, F.out, HM, DM, MT_REAL, rep ? 0.f : 0.5f}; pg8::gemm_phase<pg8::EpiResF32, pg8::StaticOrder, true, true>(F.lds + RING_OFF, g, S, E, F.tid); REP_END SEAM(pb + 17); }
    }
}

extern "C" void kernel_launch(void* const* d_in, const int* in_sizes, int n_in, void* d_out, int out_size, void* d_ws, size_t ws_size, hipStream_t stream) {
    static int grid = 0;
    if (grid == 0) {
        if (n_in != 22 || out_size != MREAL * DM || ws_size < WS_END) { fprintf(stderr, "kernel_launch: unexpected shapes (n_in %d out %d ws %zu need %zu)\n", n_in, out_size, ws_size, (size_t)WS_END); grid = -1; return; }
        int dev = 0, cus = 0, per_cu = 0;
        if (hipGetDevice(&dev) != hipSuccess || hipDeviceGetAttribute(&cus, hipDeviceAttributeMultiprocessorCount, dev) != hipSuccess) { grid = -1; return; }
        if (hipFuncSetAttribute((const void*)fwd, hipFuncAttributeMaxDynamicSharedMemorySize, LDS_BYTES) != hipSuccess) { fprintf(stderr, "kernel_launch: hipFuncSetAttribute failed\n"); grid = -1; return; }
        if (hipOccupancyMaxActiveBlocksPerMultiprocessor(&per_cu, (const void*)fwd, NWAVES * 64, LDS_BYTES) != hipSuccess || per_cu < 1) fprintf(stderr, "kernel_launch: occupancy query says %d\n", per_cu);
        (void)hipGetLastError();
        grid = cus < 256 ? cus : 256;
    }
    if (grid < 0) return;
    (void)hipMemsetAsync((char*)d_ws + WS_CTL, 0, CTL_ZERO_BYTES, stream);
    Args a{};
    for (int i = 0; i < 22; ++i) a.in[i] = (const float*)d_in[i];
    a.out = (float*)d_out; a.ws = (unsigned char*)d_ws;
#ifndef PH_END
#define PH_END (2 * NPH)
#endif
#if MK_ONE
    a.ph_lo = 0; a.ph_hi = PH_END;
    hipLaunchKernelGGL(fwd, dim3(grid), dim3(NWAVES * 64), LDS_BYTES, stream, a);
#else
    for (int p = 0; p < PH_END; ++p) { a.ph_lo = p; a.ph_hi = p + 1;
        hipLaunchKernelGGL(fwd, dim3(grid), dim3(NWAVES * 64), LDS_BYTES, stream, a); }
#endif
}
```

```cpp
#include <hip/hip_runtime.h>
#include <cstdio>
#include <cstdint>
#define MK_ONE 1
namespace pg8 {
#define PG8_LAS __attribute__((address_space(3)))
typedef unsigned short bf16_t;
typedef short bf16x8 __attribute__((ext_vector_type(8)));
typedef float f32x4 __attribute__((ext_vector_type(4)));
typedef unsigned u32x4 __attribute__((ext_vector_type(4)));
constexpr int BM = 256, BK = 64, HALF = 128, HTB = HALF * BK * 2  , STAGE_BYTES = 8 * HTB, NXCD = 8, WGM = 8;

__host__ __device__ __forceinline__ int lds_byte(int r, int c) { const int st = (r >> 4) * 2 + (c >> 5), rr = r & 15, cc = c & 31, ob = rr * 64 + cc * 2; return st * 1024 + (ob ^ (((ob >> 9) & 1) << 5)); }
__host__ __device__ __forceinline__ void stage_rc(int b, int& R, int& C) { const int st = b / 1024, sb = b % 1024, swz = sb ^ (((sb >> 9) & 1) << 5); R = (st >> 1) * 16 + swz / 64; C = (st & 1) * 32 + (swz % 64) / 2; }
__host__ __device__ __forceinline__ int perm32(int rho) { const int n = rho >> 4, i = rho & 15; return 8 * (i >> 2) + 4 * n + (i & 3); }

struct Unit { int pm, pn; };
struct Gemm { const bf16_t* A; const bf16_t* Bt; int M, N, K; };

struct StaticOrder {
    int nM, nN, nwg, G, c;
    __host__ __device__ void init(int M, int N, int G_, int c_) { nM = M / BM; nN = N / BM; nwg = nM * nN; G = G_; c = c_; }
    __host__ __device__ bool next(int i, Unit& u) const {
        const long L = (long)i * G + c; if (L >= nwg) return false;
        int wgid = (int)L; { const int q = nwg / NXCD, r = nwg % NXCD, xcd = wgid % NXCD, off = wgid / NXCD; wgid = (xcd < r ? xcd * (q + 1) : r * (q + 1) + (xcd - r) * q) + off; }
        const int nig = WGM * nN, gid = wgid / nig, fm = gid * WGM, gsz = (nM - fm) < WGM ? (nM - fm) : WGM;
        u.pm = fm + ((wgid % nig) % gsz); u.pn = (wgid % nig) / gsz; return true;
    }
    __device__ __forceinline__ void a_ready(const Unit&) const {}
    __device__ __forceinline__ void done(const Unit&) const {}
};
typedef __bf16 bf16x2_hw __attribute__((ext_vector_type(2))); typedef float f32x2_hw __attribute__((ext_vector_type(2)));
__device__ __forceinline__ unsigned cvt_pk_bf16(float lo, float hi) { const f32x2_hw v = {lo, hi}; return __builtin_bit_cast(unsigned, __builtin_convertvector(v, bf16x2_hw)); }
typedef float f32x2 __attribute__((ext_vector_type(2)));
__device__ __forceinline__ float fast_sigmoid(float x) { return __builtin_amdgcn_rcpf(1.0f + __expf(-x)); }
__device__ __forceinline__ float fast_silu(float x) { return x * fast_sigmoid(x); }
template <int ACT  > struct EpiBf16 {
    static constexpr bool PERM = true, AFTER_DRAIN = false;
    bf16_t* O; int ldc;
    __device__ __forceinline__ void operator()(const f32x4 (&acc)[2][2][4][2], const Unit& u, int wr, int wc, int fr, int fq) const {
        const int row0 = u.pm * BM + wr * 64 + fr; const int col0 = u.pn * BM + wc * 32 + 8 * fq;
#pragma unroll
        for (int ai = 0; ai < 2; ++ai)
#pragma unroll
            for (int m = 0; m < 4; ++m) { bf16_t* rowp = O + (size_t)(row0 + ai * HALF + m * 16) * ldc + col0;
#pragma unroll
                for (int bj = 0; bj < 2; ++bj) { f32x4 v0 = acc[ai][bj][m][0], v1 = acc[ai][bj][m][1];
                    if (ACT == 1) {
#pragma unroll
                        for (int j = 0; j < 4; ++j) { v0[j] = fast_sigmoid(v0[j]); v1[j] = fast_sigmoid(v1[j]); } }
                    u32x4 w; w.x = cvt_pk_bf16(v0[0], v0[1]); w.y = cvt_pk_bf16(v0[2], v0[3]); w.z = cvt_pk_bf16(v1[0], v1[1]); w.w = cvt_pk_bf16(v1[2], v1[3]);
                    *(u32x4*)(rowp + bj * HALF) = w; } }
    }
};
struct EpiSwiGLU {
    static constexpr bool PERM = true, AFTER_DRAIN = false;
    bf16_t* O; int ldc; int mode;
    __device__ __forceinline__ void operator()(const f32x4 (&acc)[2][2][4][2], const Unit& u, int wr, int wc, int fr, int fq) const {
        if (mode == 2) return;
        const int row0 = u.pm * BM + wr * 64 + fr; const int col0 = u.pn * HALF + wc * 32 + 8 * fq;
#pragma unroll
        for (int ai = 0; ai < 2; ++ai)
#pragma unroll
            for (int m = 0; m < 4; ++m) { bf16_t* rowp = O + (size_t)(row0 + ai * HALF + m * 16) * ldc + col0;
                const f32x4 g0 = acc[ai][0][m][0], g1 = acc[ai][0][m][1], u0 = acc[ai][1][m][0], u1 = acc[ai][1][m][1];
                f32x4 v0, v1;
#pragma unroll
                for (int j = 0; j < 4; ++j) { v0[j] = fast_silu(g0[j]) * u0[j]; v1[j] = fast_silu(g1[j]) * u1[j]; }
                u32x4 w; w.x = cvt_pk_bf16(v0[0], v0[1]); w.y = cvt_pk_bf16(v0[2], v0[3]); w.z = cvt_pk_bf16(v1[0], v1[1]); w.w = cvt_pk_bf16(v1[2], v1[3]);
                if (mode == 0) *(u32x4*)rowp = w; else asm volatile("" :: "v"(w.x), "v"(w.y), "v"(w.z), "v"(w.w));
                asm volatile("" ::: "memory"); }
    }
};
struct EpiResF32 {
    static constexpr bool PERM = false, AFTER_DRAIN = false;
    const float* base_r; float* out_r; float* hm; int ldc; int mt_real; float scale;
    __device__ __forceinline__ void operator()(const f32x4 (&acc)[2][2][4][2], const Unit& u, int wr, int wc, int fr, int fq) const {
        const bool real = u.pm < mt_real;
        const float* bp = real ? base_r + (size_t)u.pm * BM * ldc : hm; float* op = real ? out_r + (size_t)u.pm * BM * ldc : hm;
        const int row0 = wr * 64 + fr, col0 = u.pn * BM + wc * 32 + 4 * fq;
#pragma unroll
        for (int ai = 0; ai < 2; ++ai) {
            f32x4 b[4][2][2];
#pragma unroll
            for (int m = 0; m < 4; ++m) { const size_t off = (size_t)(row0 + ai * HALF + m * 16) * ldc + col0;
#pragma unroll
                for (int bj = 0; bj < 2; ++bj)
#pragma unroll
                    for (int n = 0; n < 2; ++n) b[m][bj][n] = *(const f32x4*)(bp + off + bj * HALF + n * 16); }
            asm volatile("" ::: "memory");
#pragma unroll
            for (int m = 0; m < 4; ++m) { const size_t off = (size_t)(row0 + ai * HALF + m * 16) * ldc + col0;
#pragma unroll
                for (int bj = 0; bj < 2; ++bj)
#pragma unroll
                    for (int n = 0; n < 2; ++n) *(f32x4*)(op + off + bj * HALF + n * 16) = b[m][bj][n] + acc[ai][bj][m][n] * scale; }
            asm volatile("" ::: "memory"); }
    }
};
struct EpiGateAcc {
    static constexpr bool PERM = true, AFTER_DRAIN = false;
    bf16_t* MG; int ldc; const bf16_t* G; int ldg; int gcol0; int first;
    __device__ __forceinline__ void operator()(const f32x4 (&acc)[2][2][4][2], const Unit& u, int wr, int wc, int fr, int fq) const {
        const int row0 = u.pm * BM + wr * 64 + fr; const int col0 = u.pn * BM + wc * 32 + 8 * fq;
#pragma unroll
        for (int ai = 0; ai < 2; ++ai)
#pragma unroll
            for (int m = 0; m < 4; ++m) { const size_t r = (size_t)(row0 + ai * HALF + m * 16);
#pragma unroll
                for (int bj = 0; bj < 2; ++bj) { const u32x4 gw = *(const u32x4*)(G + r * ldg + gcol0 + col0 + bj * HALF);
                    u32x4 pw = (u32x4){0u, 0u, 0u, 0u}; if (!first) pw = *(const u32x4*)(MG + r * ldc + col0 + bj * HALF);
                    float o[8];
#pragma unroll
                    for (int j = 0; j < 4; ++j) { const float a0 = (j < 2) ? acc[ai][bj][m][0][2 * j] : acc[ai][bj][m][1][2 * (j - 2)], a1 = (j < 2) ? acc[ai][bj][m][0][2 * j + 1] : acc[ai][bj][m][1][2 * (j - 2) + 1];
                        o[2 * j] = __uint_as_float(pw[j] << 16) + __uint_as_float(gw[j] << 16) * a0; o[2 * j + 1] = __uint_as_float(pw[j] & 0xffff0000u) + __uint_as_float(gw[j] & 0xffff0000u) * a1; }
                    u32x4 w; w.x = cvt_pk_bf16(o[0], o[1]); w.y = cvt_pk_bf16(o[2], o[3]); w.z = cvt_pk_bf16(o[4], o[5]); w.w = cvt_pk_bf16(o[6], o[7]);
                    *(u32x4*)(MG + r * ldc + col0 + bj * HALF) = w; } }
    }
};

struct MergeOrder {
    int nM, nN, G, c, mt_alloc;
    __host__ __device__ void init(int M, int N, int G_, int c_, int mt_alloc_) { nM = M / BM; nN = N / BM; G = G_; c = c_; mt_alloc = mt_alloc_; }
    __host__ __device__ bool next(int i, Unit& u) const { const int t = (i >> 2) * G + c, m = i & 3; if (t >= nM * nN) return false;
        const int pm = t / nN, pn = t % nN; u.pm = m * mt_alloc + pm; u.pn = m * nN + pn; return true; }
    __device__ __forceinline__ void a_ready(const Unit&) const {}
    __device__ __forceinline__ void done(const Unit&) const {}
};
struct EpiGateAccM {
    static constexpr bool PERM = true, AFTER_DRAIN = false;
    bf16_t* MG; int ldc; const bf16_t* G; int ldg; int mt_alloc; int ntn;
    __device__ __forceinline__ void operator()(const f32x4 (&acc)[2][2][4][2], const Unit& u, int wr, int wc, int fr, int fq) const {
        const int m = u.pm / mt_alloc, pm = u.pm - m * mt_alloc, pn = u.pn - m * ntn;
        const int row0 = pm * BM + wr * 64 + fr; const int col0 = pn * BM + wc * 32 + 8 * fq; const int gcol0 = m * ntn * BM;
#pragma unroll
        for (int ai = 0; ai < 2; ++ai)
#pragma unroll
            for (int mm = 0; mm < 4; ++mm) { const size_t r = (size_t)(row0 + ai * HALF + mm * 16);
#pragma unroll
                for (int bj = 0; bj < 2; ++bj) { const u32x4 gw = *(const u32x4*)(G + r * ldg + gcol0 + col0 + bj * HALF);
                    u32x4 pw = (u32x4){0u, 0u, 0u, 0u}; if (m != 0) pw = *(const u32x4*)(MG + r * ldc + col0 + bj * HALF);
                    float o[8];
#pragma unroll
                    for (int j = 0; j < 4; ++j) { const float a0 = (j < 2) ? acc[ai][bj][mm][0][2 * j] : acc[ai][bj][mm][1][2 * (j - 2)], a1 = (j < 2) ? acc[ai][bj][mm][0][2 * j + 1] : acc[ai][bj][mm][1][2 * (j - 2) + 1];
                        o[2 * j] = __uint_as_float(pw[j] << 16) + __uint_as_float(gw[j] << 16) * a0; o[2 * j + 1] = __uint_as_float(pw[j] & 0xffff0000u) + __uint_as_float(gw[j] & 0xffff0000u) * a1; }
                    u32x4 w; w.x = cvt_pk_bf16(o[0], o[1]); w.y = cvt_pk_bf16(o[2], o[3]); w.z = cvt_pk_bf16(o[4], o[5]); w.w = cvt_pk_bf16(o[6], o[7]);
                    *(u32x4*)(MG + r * ldc + col0 + bj * HALF) = w; } }
    }
};
template <class Epi, class Sched, bool ALIGN_EPI = false, bool SP2 = false>
__device__ __forceinline__ void gemm_phase(PG8_LAS unsigned char* lds, const Gemm g, const Sched& S, const Epi& E, int tid_in) {
    int tid_ = tid_in; asm volatile("" : "+v"(tid_));
    const int tid = tid_, wid = __builtin_amdgcn_readfirstlane(tid >> 6), lane = tid & 63, wr = wid >> 2, wc = wid & 3, fr = lane & 15, fq = lane >> 4;
    const int K = g.K, nt = K / BK;
    unsigned voffA[2], voffB[2];
#pragma unroll
    for (int i = 0; i < 2; ++i) { int R, C; stage_rc(tid * 16 + i * 8192, R, C); const int Rb = Epi::PERM ? ((R & ~31) + perm32(R & 31)) : R;
        voffA[i] = (unsigned)(R * K + C) * 2u; voffB[i] = (unsigned)(Rb * K + C) * 2u; }
    const size_t kstep = (size_t)(BK * 2);
    const size_t hstep = (size_t)HALF * K * 2;
    const size_t tstep = 2 * hstep;
    const unsigned ldsw = (unsigned)wid * 1024u;
    const int aoff = lds_byte(wr * 64 + fr, fq * 8), boff = lds_byte(wc * 32 + fr, fq * 8);
#define PG8_SA(b, h) (((b) * 2 + (h)) * HTB)
#define PG8_SB(b, h) ((4 + (b) * 2 + (h)) * HTB)
#define PG8_STAGE(bufoff, gbase, voff) do { _Pragma("unroll") for (int _i = 0; _i < 2; ++_i) \
        __builtin_amdgcn_global_load_lds((const unsigned*)((const char*)(gbase) + (voff)[_i]), (PG8_LAS unsigned*)(lds + (bufoff) + ldsw + _i * 8192), 16, 0, 0); } while (0)
#define PG8_LDA(dst, b, h) do { _Pragma("unroll") for (int m = 0; m < 4; ++m) _Pragma("unroll") for (int k = 0; k < 2; ++k) dst[m][k] = *(const PG8_LAS bf16x8*)(lds + PG8_SA(b, h) + aoff + m * 2048 + k * 1024); } while (0)
#define PG8_LDB(dst, b, h) do { _Pragma("unroll") for (int n = 0; n < 2; ++n) _Pragma("unroll") for (int k = 0; k < 2; ++k) dst[n][k] = *(const PG8_LAS bf16x8*)(lds + PG8_SB(b, h) + boff + n * 2048 + k * 1024); } while (0)
#define PG8_MMA(ai, bj, At, Bt) do { __builtin_amdgcn_s_setprio(1); _Pragma("unroll") for (int m = 0; m < 4; ++m) _Pragma("unroll") for (int n = 0; n < 2; ++n) _Pragma("unroll") for (int k = 0; k < 2; ++k) \
        acc[ai][bj][m][n] = __builtin_amdgcn_mfma_f32_16x16x32_bf16(Bt[n][k], At[m][k], acc[ai][bj][m][n], 0, 0, 0); __builtin_amdgcn_s_setprio(0); } while (0)
#define PG8_WAIT_V(n) asm volatile("s_waitcnt vmcnt(" #n ")" ::: "memory")
#define PG8_WAIT_L(n) asm volatile("s_waitcnt lgkmcnt(" #n ")" ::: "memory")
#define PG8_BAR __builtin_amdgcn_s_barrier()
#define PG8_SCHED __builtin_amdgcn_sched_barrier(0)
    Unit cur, nxt; int ui = 0;
    if (!S.next(0, cur)) return;
    f32x4 acc[2][2][4][2];
#pragma unroll
    for (int a = 0; a < 2; ++a)
#pragma unroll
        for (int b = 0; b < 2; ++b)
#pragma unroll
            for (int m = 0; m < 4; ++m)
#pragma unroll
                for (int n = 0; n < 2; ++n) acc[a][b][m][n] = (f32x4){0.f, 0.f, 0.f, 0.f};
    bf16x8 At[4][2], B0[2][2], B1[2][2];
    const char* cA = (const char*)g.A + (size_t)cur.pm * tstep; const char* cB = (const char*)g.Bt + (size_t)cur.pn * tstep;
    S.a_ready(cur);
    if constexpr (SP2) {
        PG8_STAGE(PG8_SB(0, 0), cB, voffB); PG8_STAGE(PG8_SB(0, 1), cB + hstep, voffB); PG8_STAGE(PG8_SA(0, 0), cA, voffA); PG8_STAGE(PG8_SA(0, 1), cA + hstep, voffA);
        if (wr == 1) PG8_BAR;
        PG8_WAIT_V(2); PG8_BAR;
        PG8_STAGE(PG8_SB(1, 0), cB + kstep, voffB); PG8_STAGE(PG8_SA(1, 0), cA + kstep, voffA); PG8_STAGE(PG8_SB(1, 1), cB + hstep + kstep, voffB);
        PG8_WAIT_V(6); PG8_BAR;
    } else {
        PG8_STAGE(PG8_SB(0, 0), cB, voffB); PG8_STAGE(PG8_SA(0, 0), cA, voffA); PG8_STAGE(PG8_SB(0, 1), cB + hstep, voffB); PG8_STAGE(PG8_SA(0, 1), cA + hstep, voffA);
        if (wr == 1) PG8_BAR;
        PG8_WAIT_V(4); PG8_BAR;
        PG8_STAGE(PG8_SB(1, 0), cB + kstep, voffB); PG8_STAGE(PG8_SA(1, 0), cA + kstep, voffA); PG8_STAGE(PG8_SB(1, 1), cB + hstep + kstep, voffB);
        PG8_WAIT_V(6); PG8_BAR;
    }
    for (;;) {
        const bool has_next = S.next(ui + 1, nxt);
        const char* nA = has_next ? (const char*)g.A + (size_t)nxt.pm * tstep : cA; const char* nB = has_next ? (const char*)g.Bt + (size_t)nxt.pn * tstep : cB;
        for (int t = 0; t < nt; t += 2) {
            const bool last = (t == nt - 2);
            const char* a1 = cA + (size_t)(t + 1) * kstep;
            const char* a2 = last ? nA : cA + (size_t)(t + 2) * kstep; const char* b2 = last ? nB : cB + (size_t)(t + 2) * kstep;
            const char* a3 = a2 + kstep; const char* b3 = b2 + kstep;
            if (last && has_next) S.a_ready(nxt);
            if constexpr (SP2) {
            PG8_LDB(B0, 0, 0); PG8_LDB(B1, 0, 1); PG8_SCHED; PG8_LDA(At, 0, 0); PG8_STAGE(PG8_SA(1, 1), a1 + hstep, voffA);
            PG8_WAIT_V(8); PG8_WAIT_L(0); PG8_BAR; PG8_MMA(0, 0, At, B0); PG8_MMA(0, 1, At, B1); PG8_BAR; PG8_SCHED;
            PG8_LDA(At, 0, 1); PG8_STAGE(PG8_SB(0, 0), b2, voffB); PG8_STAGE(PG8_SB(0, 1), b2 + hstep, voffB); PG8_STAGE(PG8_SA(0, 0), a2, voffA);
            PG8_WAIT_V(8); PG8_WAIT_L(0); PG8_BAR; PG8_MMA(1, 0, At, B0); PG8_MMA(1, 1, At, B1); PG8_BAR; PG8_SCHED;
            PG8_LDB(B0, 1, 0); PG8_LDB(B1, 1, 1); PG8_SCHED; PG8_LDA(At, 1, 0); PG8_STAGE(PG8_SA(0, 1), a2 + hstep, voffA);
            PG8_WAIT_V(8); PG8_WAIT_L(0); PG8_BAR; PG8_MMA(0, 0, At, B0); PG8_MMA(0, 1, At, B1); PG8_BAR; PG8_SCHED;
            PG8_LDA(At, 1, 1); PG8_STAGE(PG8_SB(1, 0), b3, voffB); PG8_STAGE(PG8_SB(1, 1), b3 + hstep, voffB); PG8_STAGE(PG8_SA(1, 0), a3, voffA);
            PG8_WAIT_V(8); PG8_WAIT_L(0); PG8_BAR; PG8_MMA(1, 0, At, B0); PG8_MMA(1, 1, At, B1); PG8_BAR; PG8_SCHED;
            } else {
            PG8_LDB(B0, 0, 0); PG8_SCHED; PG8_LDA(At, 0, 0); PG8_STAGE(PG8_SA(1, 1), a1 + hstep, voffA);
            PG8_WAIT_L(8); PG8_BAR; PG8_WAIT_L(0); PG8_MMA(0, 0, At, B0); PG8_BAR; PG8_SCHED;
            PG8_LDB(B1, 0, 1); PG8_STAGE(PG8_SB(0, 0), b2, voffB);
            PG8_BAR; PG8_WAIT_L(0); PG8_MMA(0, 1, At, B1); PG8_BAR;
            PG8_LDA(At, 0, 1); PG8_STAGE(PG8_SA(0, 0), a2, voffA);
            PG8_BAR; PG8_WAIT_L(0); PG8_MMA(1, 0, At, B0); PG8_BAR; PG8_SCHED;
            PG8_STAGE(PG8_SB(0, 1), b2 + hstep, voffB);
            PG8_WAIT_V(6); PG8_BAR; PG8_MMA(1, 1, At, B1); PG8_BAR;
            PG8_LDB(B0, 1, 0); PG8_SCHED; PG8_LDA(At, 1, 0); PG8_STAGE(PG8_SA(0, 1), a2 + hstep, voffA);
            PG8_WAIT_L(8); PG8_BAR; PG8_WAIT_L(0); PG8_MMA(0, 0, At, B0); PG8_BAR; PG8_SCHED;
            PG8_LDB(B1, 1, 1); PG8_STAGE(PG8_SB(1, 0), b3, voffB);
            PG8_BAR; PG8_WAIT_L(0); PG8_MMA(0, 1, At, B1); PG8_BAR;
            PG8_LDA(At, 1, 1); PG8_STAGE(PG8_SA(1, 0), a3, voffA);
            PG8_BAR; PG8_WAIT_L(0); PG8_MMA(1, 0, At, B0); PG8_BAR; PG8_SCHED;
            PG8_STAGE(PG8_SB(1, 1), b3 + hstep, voffB);
            PG8_WAIT_V(6); PG8_BAR; PG8_MMA(1, 1, At, B1); PG8_BAR;
            }
        }
        if constexpr (ALIGN_EPI) { if (wr == 0) PG8_BAR; }
        if constexpr (!Epi::AFTER_DRAIN) { E(acc, cur, wr, wc, fr, fq); S.done(cur); }
        if (!has_next) break;
#pragma unroll
        for (int a = 0; a < 2; ++a)
#pragma unroll
            for (int b = 0; b < 2; ++b)
#pragma unroll
                for (int m = 0; m < 4; ++m)
#pragma unroll
                    for (int n = 0; n < 2; ++n) acc[a][b][m][n] = (f32x4){0.f, 0.f, 0.f, 0.f};
        cur = nxt; cA = nA; cB = nB; ++ui;
        if constexpr (ALIGN_EPI) { if (wr == 1) PG8_BAR; }
    }
    PG8_WAIT_V(0);
    if constexpr (!ALIGN_EPI) { if (wr == 0) PG8_BAR; }
    PG8_BAR;
    if constexpr (Epi::AFTER_DRAIN) { E.fused(acc, cur, wr, wc, fr, fq, lds, wid, lane); S.done(cur); }
#undef PG8_SA
#undef PG8_SB
#undef PG8_STAGE
#undef PG8_LDA
#undef PG8_LDB
#undef PG8_MMA
#undef PG8_WAIT_V
#undef PG8_WAIT_L
#undef PG8_BAR
#undef PG8_SCHED
}
}

constexpr int DM = 2048, NB = 8, SEQ = 4096, NMETA = 16, LSEQ = 4112, LPAD = 4128;
constexpr int MREAL = NB * SEQ;
constexpr int MPAD = MREAL + 256;
constexpr int MT_REAL = MREAL / 256;
constexpr int DFF = 5632, NGU = 2 * DFF, NNG = 7168, NGATE = 8192, INCOLS = 15184, NGC = 6992;
constexpr int NWAVES = 8;
constexpr float EPS = 1e-6f;
constexpr int C_AQ = 0, C_AF = 512, C_AI = 1024, C_AG = 1536, C_BB = 2048, C_BC = 2560, C_BU = 3072, C_CQ = 3584, C_CK = 4096, C_CV = 4608,
              C_DQ = 5120, C_DK = 5632, C_DV = 5760, C_DQI = 5888, C_DKI = 6912, C_DW = 6976;

constexpr size_t MiB = 1u << 20;
constexpr size_t WS_CTL = 0, CTL_ZERO_BYTES = 1 * MiB;
constexpr size_t WS_HM = 1 * MiB;
constexpr size_t WS_W = 4 * MiB;
constexpr size_t W_GU1 = 0, W_D1 = W_GU1 + (size_t)NGU * DM * 2, W_NG = W_D1 + (size_t)DM * DFF * 2, W_G = W_NG + (size_t)NNG * DM * 2,
                 W_BR = W_G + (size_t)NGATE * DM * 2, W_O = W_BR + (size_t)4 * DM * 512 * 2, W_GU2 = W_O + (size_t)DM * DM * 2, W_D2 = W_GU2 + (size_t)NGU * DM * 2,
                 W_END = W_D2 + (size_t)DM * DFF * 2;
constexpr size_t WS_XN = WS_W + W_END;
constexpr size_t WS_BR = WS_XN + (size_t)MPAD * DM * 2;
constexpr size_t WS_BIG = WS_BR + (size_t)MPAD * DM * 2;
constexpr size_t BIG_P_END = (size_t)MPAD * NNG * 2;
constexpr size_t WS_VTC = WS_BIG + BIG_P_END;
constexpr size_t WS_VTD = WS_VTC + (size_t)NB * 4 * 128 * LPAD * 2;
constexpr size_t WS_MASK = WS_VTD + (size_t)NB * 128 * LPAD * 2;
constexpr int MASKW = 132;
constexpr int NIDX_WG = 172;
constexpr int NHG_WG = 32;
constexpr size_t WS_SCR = WS_MASK + (size_t)NB * LPAD * MASKW * 4;
constexpr size_t WS_HA = WS_SCR + (size_t)NIDX_WG * 32 * LPAD * 4;
constexpr size_t WS_HDL = WS_HA + (size_t)NB * 4 * 64 * 64 * 64 * 2;
constexpr size_t WS_HMETA = WS_HDL + (size_t)NB * 4 * 64 * 128 * 4;
constexpr size_t HMETA_STRIDE = 64 * 384 * 2 + 64 * 64 * 2 + 128 * 4;
constexpr size_t WS_END = WS_HMETA + 4 * HMETA_STRIDE;
static_assert(WS_BIG + (size_t)MPAD * NGATE * 2 <= WS_END, "G fits");
static_assert(WS_END <= (size_t)1138174976, "workspace map fits the guaranteed size");

constexpr int RING_OFF = 0, RING_BYTES = 131072;
constexpr int LDSCTL_OFF = 143360, MISC_OFF = LDSCTL_OFF + 320;
constexpr int LDS_BYTES = 147456;

#define GAS __attribute__((address_space(1)))
#define LAS __attribute__((address_space(3)))
typedef unsigned short bf16;
typedef unsigned v4u __attribute__((ext_vector_type(4)));
typedef unsigned v2u __attribute__((ext_vector_type(2)));
typedef float f32x4 __attribute__((ext_vector_type(4)));
typedef float f32x16 __attribute__((ext_vector_type(16)));
typedef short bf16x8 __attribute__((ext_vector_type(8)));
typedef GAS unsigned gu32;
#define RLX_AGENT __ATOMIC_RELAXED, __HIP_MEMORY_SCOPE_AGENT
#define LDS_WAIT() asm volatile("s_waitcnt lgkmcnt(0)" ::: "memory")
#define VM_WAIT() asm volatile("s_waitcnt vmcnt(0)" ::: "memory")
__device__ __forceinline__ unsigned f2bf(float f) { unsigned u = __builtin_bit_cast(unsigned, f); return (u + 0x7fffu + ((u >> 16) & 1u)) >> 16; }
__device__ __forceinline__ unsigned f2bf_s(float f) { return pg8::cvt_pk_bf16(f, 0.f) & 0xffffu; }
__device__ __forceinline__ unsigned pk2(float lo, float hi) { return pg8::cvt_pk_bf16(lo, hi); }
__device__ __forceinline__ float bflo(unsigned w) { return __uint_as_float(w << 16); }
__device__ __forceinline__ float bfhi(unsigned w) { return __uint_as_float(w & 0xffff0000u); }
__device__ __forceinline__ float bf2f(bf16 v) { return __uint_as_float((unsigned)v << 16); }
__device__ __forceinline__ int seqrow(int b, int p) { return p < NMETA ? MREAL + p : b * SEQ + p - NMETA; }
__device__ __forceinline__ int rel_bucket(int n) {
    if (n < 16) return n; if (n >= 128) return 31;
    const int v = 16 + (int)(__log2f((float)n * 0.0625f) * 5.33333333f); return v < 31 ? v : 31; }
__device__ __forceinline__ float wave_sum(float v) {
#pragma unroll
    for (int o = 1; o < 64; o <<= 1) v += __shfl_xor(v, o);
    return v;
}
#define XB_TMO      128
#define XB_XCNT(j)  (256  + 64 * (j))
#define XB_XSUB(j)  (1280 + 64 * (j))
#define XB_XGEN(j)  (2304 + 64 * (j))
#define XB_TOP      3328
#define XB_TOPGEN   3392
#define XCD_BAR_WORDS 3456
#define XB_SPIN_CAP (1u << 18)

__device__ __forceinline__ unsigned xb_ld(unsigned* p)              { return __hip_atomic_load(p, __ATOMIC_RELAXED, __HIP_MEMORY_SCOPE_AGENT); }
__device__ __forceinline__ unsigned xb_add(unsigned* p, unsigned v) { return __hip_atomic_fetch_add(p, v, __ATOMIC_RELAXED, __HIP_MEMORY_SCOPE_AGENT); }
__device__ __forceinline__ unsigned xb_xcc_id() { return (unsigned)__builtin_amdgcn_s_getreg((3 << 11) | 20) & 0xFu; }
#define XB_SPIN(cond, bar) do { unsigned _sp = 0; while (cond) { __builtin_amdgcn_s_sleep(1); \
    if ((++_sp & 255u) == 0u) { if (xb_ld(&(bar)[XB_TMO])) break; if (_sp > XB_SPIN_CAP) { atomicAdd(&(bar)[XB_TMO], 1u); break; } } } } while (0)

struct XcdBarrier {
    int wave;
    unsigned* bar; unsigned x;
    volatile LAS unsigned* st;
};

__device__ __forceinline__ bool xb_thread0(int wave) { unsigned mk = ~0u; asm volatile("" : "+s"(mk)); return wave == 0 && __builtin_amdgcn_mbcnt_hi(mk, __builtin_amdgcn_mbcnt_lo(mk, 0u)) == 0u; }
__device__ __forceinline__ XcdBarrier xcd_barrier_post(unsigned* bar, volatile LAS unsigned* st, int wave) {
    XcdBarrier b; b.wave = wave; b.bar = bar; b.x = xb_xcc_id(); b.st = st;
    if (xb_thread0(wave)) (void)xb_add(&bar[XB_XCNT(b.x)], 1u);
    return b;
}
__device__ __forceinline__ void xcd_barrier_complete(unsigned* bar, unsigned x, unsigned& nloc, unsigned& nx) {
    const unsigned G = gridDim.x * gridDim.y * gridDim.z;
    unsigned sum, cnt, mine, sp = 0u;
    for (;;) {
        sum = 0u; cnt = 0u; mine = 0u;
#pragma unroll
        for (unsigned j = 0; j < 16; ++j) { const unsigned c = xb_ld(&bar[XB_XCNT(j)]); sum += c; cnt += (c > 0u) ? 1u : 0u; mine = (j == x) ? c : mine; }
        if (sum == G) break;
        __builtin_amdgcn_s_sleep(1);
        if ((++sp & 255u) == 0u) { if (xb_ld(&bar[XB_TMO])) break; if (sp > XB_SPIN_CAP) { atomicAdd(&bar[XB_TMO], 1u); break; } }
    }
    nloc = mine > 0u ? mine : 1u; nx = cnt > 0u ? cnt : 1u;
}

__device__ __forceinline__ void xcd_barrier(const XcdBarrier& b) {
    asm volatile("s_waitcnt vmcnt(0)" ::: "memory");
    __syncthreads();
    if (xb_thread0(b.wave)) {
        unsigned* bar = b.bar;
        __builtin_amdgcn_s_waitcnt(0);
        unsigned nloc = b.st[0], nx = b.st[1];
        if (nloc == 0u) { xcd_barrier_complete(bar, b.x, nloc, nx); b.st[0] = nloc; b.st[1] = nx; }
        const unsigned old = xb_add(&bar[XB_XSUB(b.x)], 1u);
        const unsigned gen = old / nloc;
        if (old + 1u == (gen + 1u) * nloc) {
            __builtin_amdgcn_fence(__ATOMIC_RELEASE, "agent");
            asm volatile("s_waitcnt vmcnt(0)" ::: "memory");
            const unsigned og = xb_add(&bar[XB_TOP], 1u);
            const unsigned tg = og / nx;
            if (og + 1u == (tg + 1u) * nx) xb_add(&bar[XB_TOPGEN], 1u);
            else XB_SPIN(xb_ld(&bar[XB_TOPGEN]) == tg, bar);
            __builtin_amdgcn_fence(__ATOMIC_ACQUIRE, "agent");
            xb_add(&bar[XB_XGEN(b.x)], 1u);
            asm volatile("s_waitcnt vmcnt(0)" ::: "memory");
        } else {
            XB_SPIN(xb_ld(&bar[XB_XGEN(b.x)]) == gen, bar);
            __builtin_amdgcn_fence(__ATOMIC_ACQUIRE, "agent");
            asm volatile("s_waitcnt vmcnt(0)" ::: "memory");
        }
    }
    __syncthreads();
}

struct Frame {
    LAS unsigned char* lds;
    volatile LAS unsigned* MISC;
    gu32* ctl;
    int tid, lane, wave, G, bid;
    const unsigned char __attribute__((address_space(4)))* karg; float* out; unsigned char* ws;
};
__device__ __forceinline__ const float* fin_load(const unsigned char __attribute__((address_space(4)))* k, int i) { asm volatile("" : "+s"(k)); return *(const float* const __attribute__((address_space(4)))*)(k + 8 * i); }
#define FIN(F_, i_) fin_load((F_).karg, (i_))
enum { I_X = 0, I_META, I_RELB, I_F1N, I_F1GU, I_F1D, I_MIXN, I_WIN, I_LB, I_GN, I_CONVW, I_DQN, I_DKN, I_DLAM, I_DSUB, I_SQN, I_SKN, I_WBR, I_WOUT, I_F2N, I_F2GU, I_F2D };

template <class RowMap>
__device__ __forceinline__ void transpose_item(const float* W, int K, int N, bf16* WT, LAS float* scr, int item, int lane, RowMap rm) {
    const int nblk = (N + 31) / 32, kb = item / nblk, nb = item % nblk, k0 = 64 * kb, n0 = 32 * nb;
    const int nl = n0 + (lane & 31); const bool nok = nl < N;
    { float wv[32]; const float* wp = W + (size_t)(k0 + (lane >> 5)) * N + (nok ? nl : 0);
#pragma unroll
      for (int i = 0; i < 32; ++i) wv[i] = wp[(size_t)(2 * i) * N];
      __builtin_amdgcn_sched_barrier(0);
#pragma unroll
      for (int i = 0; i < 32; ++i) scr[(2 * i + (lane >> 5)) * 33 + (lane & 31)] = nok ? wv[i] : 0.f; }
    LDS_WAIT(); asm volatile("" ::: "memory");
    const int c = lane & 7;
#pragma unroll
    for (int j = 0; j < 4; ++j) { const int n = (lane >> 3) + 8 * j; const LAS float* s = scr + (8 * c) * 33 + n;
        v4u o; o.x = pk2(s[0 * 33], s[1 * 33]); o.y = pk2(s[2 * 33], s[3 * 33]); o.z = pk2(s[4 * 33], s[5 * 33]); o.w = pk2(s[6 * 33], s[7 * 33]);
        if (n0 + n < N) *(GAS v4u*)(WT + (size_t)rm(n0 + n) * K + k0 + 8 * c) = o; }
    LDS_WAIT(); asm volatile("" ::: "memory");
}
struct MapId { __device__ __forceinline__ int operator()(int n) const { return n; } };
struct MapGU { __device__ __forceinline__ int operator()(int n) const { const int up = n >= DFF, j = up ? n - DFF : n; return 256 * (j >> 7) + 128 * up + (j & 127); } };
struct MapIn { __device__ __forceinline__ int operator()(int n) const { return n < NGC ? n : n + (NNG - NGC); } };
template <class RowMap>
__device__ __forceinline__ void convert_matrix(Frame& F, const float* W, int K, int N, bf16* WT, RowMap rm) {
    LAS float* scr = (LAS float*)(F.lds + F.wave * 16384);
    const int gw = F.bid * NWAVES + F.wave, NGW = F.G * NWAVES, nitems = (K / 64) * ((N + 31) / 32);
    for (int it = gw; it < nitems; it += NGW) transpose_item(W, K, N, WT, scr, it, F.lane, rm);
}
__device__ __forceinline__ void phase_convert(Frame& F, int l) {
    unsigned char* wb = F.ws + WS_W;
    convert_matrix(F, FIN(F, I_F1GU) + (size_t)l * DM * NGU, DM, NGU, (bf16*)(wb + W_GU1), MapGU());
    convert_matrix(F, FIN(F, I_F1D) + (size_t)l * DFF * DM, DFF, DM, (bf16*)(wb + W_D1), MapId());
    convert_matrix(F, FIN(F, I_WIN) + (size_t)l * DM * INCOLS, DM, INCOLS, (bf16*)(wb + W_NG), MapIn());
    for (int m = 0; m < 4; ++m) convert_matrix(F, FIN(F, I_WBR) + ((size_t)l * 4 + m) * 512 * DM, 512, DM, (bf16*)(wb + W_BR) + (size_t)m * DM * 512, MapId());
    convert_matrix(F, FIN(F, I_WOUT) + (size_t)l * DM * DM, DM, DM, (bf16*)(wb + W_O), MapId());
    convert_matrix(F, FIN(F, I_F2GU) + (size_t)l * DM * NGU, DM, NGU, (bf16*)(wb + W_GU2), MapGU());
    convert_matrix(F, FIN(F, I_F2D) + (size_t)l * DFF * DM, DFF, DM, (bf16*)(wb + W_D2), MapId());
    { GAS v4u* z = (GAS v4u*)(wb + W_NG + (size_t)NGC * DM * 2); const int n16 = (NNG - NGC) * DM * 2 / 16;
      for (int i = F.bid * 512 + F.tid; i < n16; i += F.G * 512) z[i] = (v4u){0u, 0u, 0u, 0u}; }
    if (l == 0) {
        GAS f32x4* hm = (GAS f32x4*)(F.ws + WS_HM); const GAS f32x4* mt = (const GAS f32x4*)FIN(F, I_META);
        for (int i = F.bid * 512 + F.tid; i < 256 * DM / 4; i += F.G * 512) hm[i] = (i < NMETA * DM / 4) ? mt[i] : (f32x4){0.f, 0.f, 0.f, 0.f};
    }
}
__device__ __forceinline__ void phase_norm(Frame& F, const float* src_real, const float* gain) {
    const int gw = F.bid * NWAVES + F.wave, NGW = F.G * NWAVES;
    bf16* XN = (bf16*)(F.ws + WS_XN); const float* hm = (const float*)(F.ws + WS_HM);
    f32x4 g[8];
#pragma unroll
    for (int j = 0; j < 8; ++j) g[j] = ((const GAS f32x4*)gain)[F.lane + 64 * j];
    for (int r = gw; r < MPAD; r += NGW) {
        GAS v2u* o8 = (GAS v2u*)(XN + (size_t)r * DM) + F.lane;
        if (r >= MREAL + NMETA) {
#pragma unroll
            for (int j = 0; j < 8; ++j) o8[64 * j] = (v2u){0u, 0u};
            continue; }
        const float* xr = r < MREAL ? src_real + (size_t)r * DM : hm + (size_t)(r - MREAL) * DM;
        f32x4 v[8]; float s = 0.f;
#pragma unroll
        for (int j = 0; j < 8; ++j) { v[j] = ((const GAS f32x4*)xr)[F.lane + 64 * j]; s += (v[j].x * v[j].x + v[j].y * v[j].y) + (v[j].z * v[j].z + v[j].w * v[j].w); }
        const float inv = 1.0f / sqrtf(wave_sum(s) * (1.f / DM) + EPS);
#pragma unroll
        for (int j = 0; j < 8; ++j) { v2u w; w.x = pk2(v[j].x * inv * g[j].x, v[j].y * inv * g[j].y); w.y = pk2(v[j].z * inv * g[j].z, v[j].w * inv * g[j].w); o8[64 * j] = w; }
    }
}

__device__ __forceinline__ f32x4 meta_dot16(const bf16* A  , int lda, const bf16* Bt  , int K, int s0, int s1, int lane) {
    const int fr = lane & 15, g = lane >> 4; const bf16* ap = A + (size_t)fr * lda + 8 * g; const bf16* bp = Bt + (size_t)fr * K + 8 * g;
    f32x4 a0 = (f32x4){0.f, 0.f, 0.f, 0.f}, a1 = a0;
    for (int s = s0; s < s1; s += 2) {
        const bf16x8 x0 = *(const GAS bf16x8*)(ap + 32 * s), x1 = *(const GAS bf16x8*)(ap + 32 * s + 32);
        const bf16x8 w0 = *(const GAS bf16x8*)(bp + 32 * s), w1 = *(const GAS bf16x8*)(bp + 32 * s + 32);
        a0 = __builtin_amdgcn_mfma_f32_16x16x32_bf16(w0, x0, a0, 0, 0, 0); a1 = __builtin_amdgcn_mfma_f32_16x16x32_bf16(w1, x1, a1, 0, 0, 0); }
    return a0 + a1;
}
__device__ __forceinline__ void st_bf16x4(bf16* p, f32x4 v) { v2u w; w.x = pk2(v[0], v[1]); w.y = pk2(v[2], v[3]); *(GAS v2u*)p = w; }
__device__ __forceinline__ void meta_gemm(Frame& F, int kind, const bf16* A, int lda, const bf16* Bt, int N, int K, bf16* Obf, int ldo, float scale) {
    const int lane = F.lane, wave = F.wave, fr = lane & 15, g = lane >> 4;
    const int ngroups = (kind == 0 ? N / 2 : N) / 16;
    LAS f32x4* red = (LAS f32x4*)F.lds;
    const int ns = K / 32, s0 = (wave * ns) >> 3, s1 = ((wave + 1) * ns) >> 3;
    for (int cg = F.bid; cg < ngroups; cg += F.G) {
        const int n0 = 16 * cg;
        f32x4 p0, p1 = (f32x4){0.f, 0.f, 0.f, 0.f};
        if (kind == 0) { const int rg = 256 * (n0 >> 7) + (n0 & 127);
            p0 = meta_dot16(A, lda, Bt + (size_t)rg * K, K, s0, s1, lane); p1 = meta_dot16(A, lda, Bt + (size_t)(rg + 128) * K, K, s0, s1, lane); }
        else if (kind == 4) { const int mb = wave >> 1, kh = wave & 1; p0 = meta_dot16(A + (size_t)mb * MPAD * 512, 512, Bt + ((size_t)mb * DM + n0) * 512, 512, 8 * kh, 8 * kh + 8, lane); }
        else p0 = meta_dot16(A, lda, Bt + (size_t)n0 * K, K, s0, s1, lane);
        red[wave * 64 + lane] = p0; if (kind == 0) red[512 + wave * 64 + lane] = p1;
        LDS_WAIT(); __syncthreads();
        if (wave == 0) {
            f32x4 q[8];
#pragma unroll
            for (int w = 0; w < 8; ++w) q[w] = red[w * 64 + lane];
            if (kind == 4) { f32x4 tot = (f32x4){0.f, 0.f, 0.f, 0.f}; const bf16* G = (const bf16*)(F.ws + WS_BIG);
#pragma unroll
                for (int mb = 0; mb < 4; ++mb) { const f32x4 acc = q[2 * mb] + q[2 * mb + 1]; const v2u gw2 = *(const GAS v2u*)(G + (size_t)(MREAL + fr) * NGATE + mb * DM + n0 + 4 * g);
                    tot[0] += bflo(gw2.x) * acc[0]; tot[1] += bfhi(gw2.x) * acc[1]; tot[2] += bflo(gw2.y) * acc[2]; tot[3] += bfhi(gw2.y) * acc[3]; }
                st_bf16x4(Obf + (size_t)(MREAL + fr) * ldo + n0 + 4 * g, tot);
            } else {
                f32x4 acc = ((q[0] + q[1]) + (q[2] + q[3])) + ((q[4] + q[5]) + (q[6] + q[7]));
                if (kind == 0) { f32x4 up = (f32x4){0.f, 0.f, 0.f, 0.f};
#pragma unroll
                    for (int w = 0; w < 8; ++w) up += red[512 + w * 64 + lane];
#pragma unroll
                    for (int r = 0; r < 4; ++r) acc[r] = pg8::fast_silu(acc[r]) * up[r];
                    st_bf16x4(Obf + (size_t)(MREAL + fr) * ldo + n0 + 4 * g, acc); }
                else if (kind == 1) { float* hp = (float*)(F.ws + WS_HM) + (size_t)fr * DM + n0 + 4 * g; *(GAS f32x4*)hp = *(const GAS f32x4*)hp + acc * scale; }
                else if (kind == 2) st_bf16x4(Obf + (size_t)(MREAL + fr) * ldo + n0 + 4 * g, acc);
                else {
#pragma unroll
                    for (int r = 0; r < 4; ++r) acc[r] = pg8::fast_sigmoid(acc[r]);
                    st_bf16x4(Obf + (size_t)(MREAL + fr) * ldo + n0 + 4 * g, acc); }
            }
        }
        __syncthreads();
    }
}
__device__ __forceinline__ void unpack8(const v4u w, float (&x)[8]) { x[0] = bflo(w.x); x[1] = bfhi(w.x); x[2] = bflo(w.y); x[3] = bfhi(w.y); x[4] = bflo(w.z); x[5] = bfhi(w.z); x[6] = bflo(w.w); x[7] = bfhi(w.w); }
__device__ __forceinline__ v4u pack8(const float (&x)[8]) { v4u w; w.x = pk2(x[0], x[1]); w.y = pk2(x[2], x[3]); w.z = pk2(x[4], x[5]); w.w = pk2(x[6], x[7]); return w; }
template <int GL>
__device__ __forceinline__ void norm_cols_inplace(bf16* p, const v4u w, const float* gain, float scale, int lane, bool wr) {
    float x[8]; unpack8(w, x); float s = 0.f;
#pragma unroll
    for (int i = 0; i < 8; ++i) s += x[i] * x[i];
#pragma unroll
    for (int o = 1; o < GL; o <<= 1) s += __shfl_xor(s, o);
    const float inv = scale / sqrtf(s * (1.f / (GL * 8)) + EPS); const int g0 = (8 * lane) % (GL * 8);
#pragma unroll
    for (int i = 0; i < 8; ++i) x[i] = x[i] * inv * gain[g0 + i];
    if (wr) *(GAS v4u*)p = pack8(x);
}
__device__ __forceinline__ void prep_row(Frame& F, int l, int r) {
    const int lane = F.lane; bf16* pr = (bf16*)(F.ws + WS_BIG) + (size_t)r * NNG;
    const float *dqn = FIN(F, I_DQN) + l * 64, *dkn = FIN(F, I_DKN) + l * 64, *sqn = FIN(F, I_SQN) + l * 128, *skn = FIN(F, I_SKN) + l * 128;
    const v4u w0 = *(const GAS v4u*)(pr + C_CQ + 8 * lane), w1 = *(const GAS v4u*)(pr + C_CK + 8 * lane), w2 = *(const GAS v4u*)(pr + C_DQ + 8 * lane), w3 = *(const GAS v4u*)(pr + C_DK + 8 * (lane & 15));
    __builtin_amdgcn_sched_barrier(0);
    norm_cols_inplace<8>(pr + C_CQ + 8 * lane, w0, dqn, 0.125f * 1.4426950408889634f, lane, true);
    norm_cols_inplace<8>(pr + C_CK + 8 * lane, w1, dkn, 1.0f, lane, true);
    norm_cols_inplace<16>(pr + C_DQ + 8 * lane, w2, sqn, 0.08838834764831845f * 1.4426950408889634f, lane, true);
    norm_cols_inplace<16>(pr + C_DK + 8 * (lane & 15), w3, skn, 1.0f, lane & 15, lane < 16);
}
constexpr int VT_NPB = (LPAD + 63) / 64, VT_NTASK = NB * 5 * VT_NPB;
__device__ __forceinline__ void vt_task(Frame& F, int task) {
    const int lane = F.lane;
    const bf16* P = (const bf16*)(F.ws + WS_BIG); bf16* VtC = (bf16*)(F.ws + WS_VTC); bf16* VtD = (bf16*)(F.ws + WS_VTD);
    LAS bf16* T = (LAS bf16*)(F.lds + F.wave * 17408);
    const int pb = task % VT_NPB, mat = (task / VT_NPB) % 5, b = task / (VT_NPB * 5), p0 = 64 * pb;
    const int col = mat < 4 ? C_CV + 128 * mat : C_DV;
#pragma unroll 4
    for (int i = 0; i < 16; ++i) { const int pl = 4 * i + (lane >> 4), p = p0 + pl;
        v4u w = *(const GAS v4u*)(P + (size_t)seqrow(b, p < LSEQ ? p : LSEQ - 1) * NNG + col + 8 * (lane & 15)); if (p >= LSEQ) w = (v4u){0u, 0u, 0u, 0u};
        *(LAS v4u*)(T + pl * 136 + 8 * (lane & 15)) = w; }
    LDS_WAIT(); asm volatile("" ::: "memory");
    bf16* dst = mat < 4 ? VtC + (size_t)(b * 4 + mat) * 128 * LPAD : VtD + (size_t)b * 128 * LPAD;
#pragma unroll 4
    for (int it = 0; it < 16; ++it) { const int e = 8 * it + (lane >> 3), c = lane & 7; unsigned short x[8];
#pragma unroll
        for (int k = 0; k < 8; ++k) x[k] = T[(8 * c + k) * 136 + e];
        v4u w; w.x = x[0] | ((unsigned)x[1] << 16); w.y = x[2] | ((unsigned)x[3] << 16); w.z = x[4] | ((unsigned)x[5] << 16); w.w = x[6] | ((unsigned)x[7] << 16);
        if (p0 + 8 * c < LPAD) *(GAS v4u*)(dst + (size_t)e * LPAD + p0 + 8 * c) = w; }
    LDS_WAIT(); asm volatile("" ::: "memory");
}

#define NEG_INF (-__builtin_inff())
constexpr int NQT = (LSEQ + 31) / 32;
constexpr int NQB = (NQT + 7) / 8;
__device__ __forceinline__ bf16x8 ld_frag16(const bf16* p) { return *(const GAS bf16x8*)p; }
__device__ __forceinline__ bf16x8 mk_frag(v2u lo, v2u hi) { v4u w; w.x = lo.x; w.y = lo.y; w.z = hi.x; w.w = hi.y; return __builtin_bit_cast(bf16x8, w); }
__device__ __forceinline__ unsigned cvtpk(float lo, float hi) { return pg8::cvt_pk_bf16(lo, hi); }
__device__ __forceinline__ void build_bias_table(Frame& F, LAS float* bt, int col0) {
    const float* rb = FIN(F, I_RELB);
    for (int i = F.tid; i < 4 * 128; i += 512) { const int hd = i >> 7, n = i & 127; bt[i] = (rb[rel_bucket(n) * 8 + col0 + hd] - rb[31 * 8 + col0 + hd]) * 1.4426950408889634f; }
}
__device__ __forceinline__ bool softmax_step(f32x16& S, float& m, float& lsum, float& alpha) {
    float tm = S[0];
#pragma unroll
    for (int r = 1; r < 16; ++r) tm = fmaxf(tm, S[r]);
    tm = fmaxf(tm, __shfl_xor(tm, 32));
    const bool raise = __any(tm > m + 11.5f);
    alpha = 1.0f;
    if (raise) { const float mn = fmaxf(m, tm); alpha = (mn == NEG_INF) ? 1.0f : __builtin_amdgcn_exp2f(m - mn); m = mn; lsum *= alpha; }
    const float mref = (m == NEG_INF) ? 0.f : m;
    float rs = 0.f;
#pragma unroll
    for (int r = 0; r < 16; ++r) { S[r] = __builtin_amdgcn_exp2f(S[r] - mref); rs += S[r]; }
    rs += __shfl_xor(rs, 32);
    lsum += rs;
    return raise;
}
template <bool DSA>
__device__ __forceinline__ void attn_wg_task(Frame& F, int l, int b, int h, int J, const LAS float* bt, float lam, float post) {
    constexpr int KD = DSA ? 128 : 64, KP = KD + 8, VP = 36, NKS = KD / 16;
    constexpr int KBUF = 32 * KP, VBUF = 128 * VP;
    const int lane = F.lane, ql = lane & 31, hh = lane >> 5, wave = F.wave, tid = F.tid;
    LAS bf16* Kl = (LAS bf16*)F.lds; LAS bf16* Vl = Kl + 2 * KBUF;
    const bf16* P = (const bf16*)(F.ws + WS_BIG);
    const bf16* Vt = DSA ? (const bf16*)(F.ws + WS_VTD) + (size_t)b * 128 * LPAD : (const bf16*)(F.ws + WS_VTC) + (size_t)(b * 4 + h) * 128 * LPAD;
    const int jr = 8 * J + wave - 7; const bool wvalid = jr >= 0 && 32 * jr < LSEQ; const int j = jr < 0 ? 0 : jr;
    const int ktmax = (8 * J < NQT - 1) ? 8 * J : NQT - 1;
    const int pq = 32 * j + ql, pqc = pq < LSEQ ? pq : LSEQ - 1;
    const bf16* qrow = P + (size_t)seqrow(b, pqc) * NNG + (DSA ? C_DQ : C_CQ) + h * 128 + 8 * hh;
    const unsigned* mrow = (const unsigned*)(F.ws + WS_MASK) + ((size_t)b * LPAD + pqc) * MASKW;
    const int kr = tid / (KD / 8), kc = tid % (KD / 8); const bool kload = tid < 32 * (KD / 8);
    const int vr = tid >> 2, vc = tid & 3;
    f32x16 R[4];
#pragma unroll
    for (int c = 0; c < (DSA ? 1 : 2); ++c) {
        const int kcol = DSA ? C_DK : C_CK + h * 128 + c * 64;
        bf16x8 qf[NKS];
#pragma unroll
        for (int ks = 0; ks < NKS; ++ks) qf[ks] = ld_frag16(qrow + (DSA ? 0 : c * 64) + 16 * ks);
        float m = NEG_INF, lsum = 0.f; f32x16 O[4];
#pragma unroll
        for (int eb = 0; eb < 4; ++eb)
#pragma unroll
            for (int r = 0; r < 16; ++r) O[eb][r] = 0.f;
        v4u rk0 = (v4u){0u, 0u, 0u, 0u}, rv0 = rk0, rk1 = rk0, rv1 = rk0;
#define ATT_ISSUE(kt_, RK, RV) do { int pk_ = 32 * (kt_) + kr; pk_ = pk_ < LSEQ ? pk_ : LSEQ - 1; \
            if (kload) RK = *(const GAS v4u*)(P + (size_t)seqrow(b, pk_) * NNG + kcol + 8 * kc); \
            RV = *(const GAS v4u*)(Vt + (size_t)vr * LPAD + 32 * (kt_) + 8 * vc); } while (0)
#define ATT_COMMIT(buf_, RK, RV) do { if (kload) *(LAS v4u*)(Kl + (buf_) * KBUF + kr * KP + 8 * kc) = RK; \
            LAS v2u* vd_ = (LAS v2u*)(Vl + (buf_) * VBUF + vr * VP + 8 * vc); vd_[0] = (v2u){RV.x, RV.y}; vd_[1] = (v2u){RV.z, RV.w}; } while (0)
        unsigned mwc = 0xffffffffu, mwn = 0xffffffffu; if (DSA) mwc = mrow[0];
        auto compute = [&](int kt, int buf) {
            if (DSA) mwn = mrow[kt + 1 <= ktmax ? kt + 1 : ktmax];
            if (wvalid && kt <= j) {
                const LAS bf16* Kt = Kl + buf * KBUF + ql * KP + 8 * hh; const LAS bf16* Vb = Vl + buf * VBUF + ql * VP + 4 * hh;
                f32x16 S;
#pragma unroll
                for (int r = 0; r < 16; ++r) S[r] = 0.f;
#pragma unroll
                for (int ks = 0; ks < NKS; ++ks) S = __builtin_amdgcn_mfma_f32_32x32x16_bf16(*(const LAS bf16x8*)(Kt + 16 * ks), qf[ks], S, 0, 0, 0);
                const unsigned mw = mwc >> (4 * hh);
                if (kt + 4 >= j) {
#pragma unroll
                    for (int r = 0; r < 16; ++r) { const int ko = (r & 3) + 8 * (r >> 2), n = pq - (32 * kt + 4 * hh + ko); const bool sel = ((mw >> ko) & 1u) && n >= 0;
                        S[r] = sel ? S[r] + bt[h * 128 + (n < 127 ? n : 127)] : NEG_INF; }
                } else if (DSA) {
#pragma unroll
                    for (int r = 0; r < 16; ++r) { const int ko = (r & 3) + 8 * (r >> 2); S[r] = ((mw >> ko) & 1u) ? S[r] : NEG_INF; }
                }
                float alpha;
                if (softmax_step(S, m, lsum, alpha)) {
#pragma unroll
                    for (int eb = 0; eb < 4; ++eb)
#pragma unroll
                        for (int r = 0; r < 16; ++r) O[eb][r] *= alpha;
                }
                bf16x8 pf[2];
#pragma unroll
                for (int s = 0; s < 2; ++s) { v4u w; w.x = cvtpk(S[8 * s + 0], S[8 * s + 1]); w.y = cvtpk(S[8 * s + 2], S[8 * s + 3]); w.z = cvtpk(S[8 * s + 4], S[8 * s + 5]); w.w = cvtpk(S[8 * s + 6], S[8 * s + 7]); pf[s] = __builtin_bit_cast(bf16x8, w); }
#pragma unroll
                for (int eb = 0; eb < 4; ++eb)
#pragma unroll
                    for (int s = 0; s < 2; ++s) { const LAS bf16* vp = Vb + eb * 32 * VP + 16 * s;
                        O[eb] = __builtin_amdgcn_mfma_f32_32x32x16_bf16(mk_frag(*(const LAS v2u*)vp, *(const LAS v2u*)(vp + 8)), pf[s], O[eb], 0, 0, 0); }
            }
            if (DSA) mwc = mwn; };
        __syncthreads();
        ATT_ISSUE(0, rk0, rv0); ATT_COMMIT(0, rk0, rv0);
        if (ktmax >= 1) ATT_ISSUE(1, rk1, rv1);
        for (int kt = 0; kt <= ktmax; kt += 2) {
            LDS_WAIT(); __syncthreads();
            if (kt + 2 <= ktmax) ATT_ISSUE(kt + 2, rk0, rv0);
            compute(kt, 0);
            if (kt + 1 <= ktmax) ATT_COMMIT(1, rk1, rv1);
            if (kt + 1 > ktmax) break;
            LDS_WAIT(); __syncthreads();
            if (kt + 3 <= ktmax) ATT_ISSUE(kt + 3, rk1, rv1);
            compute(kt + 1, 1);
            if (kt + 2 <= ktmax) ATT_COMMIT(0, rk0, rv0);
        }
#undef ATT_ISSUE
#undef ATT_COMMIT
        const float il = 1.0f / lsum;
        if (DSA) {
#pragma unroll
            for (int eb = 0; eb < 4; ++eb)
#pragma unroll
                for (int r = 0; r < 16; ++r) R[eb][r] = O[eb][r] * il;
        } else if (c == 0) {
            LAS unsigned* rp = (LAS unsigned*)(F.lds + 28672) + wave * 2048 + lane;
#pragma unroll
            for (int eb = 0; eb < 4; ++eb)
#pragma unroll
                for (int r = 0; r < 16; r += 2) rp[(eb * 8 + (r >> 1)) * 64] = pk2(O[eb][r] * il, O[eb][r + 1] * il);
        } else {
            const LAS unsigned* rp = (const LAS unsigned*)(F.lds + 28672) + wave * 2048 + lane;
#pragma unroll
            for (int eb = 0; eb < 4; ++eb)
#pragma unroll
                for (int r = 0; r < 16; r += 2) { const unsigned w = rp[(eb * 8 + (r >> 1)) * 64]; R[eb][r] = bflo(w) - lam * (O[eb][r] * il); R[eb][r + 1] = bfhi(w) - lam * (O[eb][r + 1] * il); }
        }
    }
    float inv = 1.0f;
    if (!DSA) { float ss = 0.f;
#pragma unroll
        for (int eb = 0; eb < 4; ++eb)
#pragma unroll
            for (int r = 0; r < 16; ++r) ss += R[eb][r] * R[eb][r];
        ss += __shfl_xor(ss, 32); inv = post / sqrtf(ss * (1.f / 128.f) + EPS); }
    const float* sub = FIN(F, I_DSUB) + l * 128;
    if (wvalid && pq < LSEQ && (pq >= NMETA || b == 0)) {
        bf16* orow = (bf16*)(F.ws + WS_BR) + (size_t)(DSA ? 3 : 2) * MPAD * 512 + (size_t)seqrow(b, pq) * 512 + h * 128;
#pragma unroll
        for (int eb = 0; eb < 4; ++eb)
#pragma unroll
            for (int g = 0; g < 4; ++g) { const int e0 = 32 * eb + 8 * g + 4 * hh; f32x4 sv = (f32x4){1.f, 1.f, 1.f, 1.f}; if (!DSA) sv = *(const GAS f32x4*)(sub + e0);
                v2u w; w.x = pk2(R[eb][4 * g] * inv * sv.x, R[eb][4 * g + 1] * inv * sv.y); w.y = pk2(R[eb][4 * g + 2] * inv * sv.z, R[eb][4 * g + 3] * inv * sv.w);
                *(GAS v2u*)(orow + e0) = w; }
    }
}
__device__ __forceinline__ unsigned f32_key(float f) { const unsigned u = __float_as_uint(f); return u ^ ((u >> 31) ? 0xffffffffu : 0x80000000u); }
__device__ __forceinline__ void dsa_index_task(Frame& F, int b, int j, float* slab) {
    const int lane = F.lane, ql = lane & 31, hh = lane >> 5, wave = F.wave;
    const bf16* P = (const bf16*)(F.ws + WS_BIG);
    LAS unsigned char* qi = F.lds;
    for (int i = F.tid; i < 32 * 128; i += 512) { const int q = i >> 7, ch = i & 127; int pq = 32 * j + q; pq = pq < LSEQ ? pq : LSEQ - 1;
        *(LAS v4u*)(qi + q * 2064 + 16 * ch) = *(const GAS v4u*)(P + (size_t)seqrow(b, pq) * NNG + C_DQI + 8 * ch); }
    LAS float* wl = (LAS float*)(qi + 32 * 2064);
    if (F.tid < 32 * 16) { const int q = F.tid >> 4, hd = F.tid & 15; int pq = 32 * j + q; pq = pq < LSEQ ? pq : LSEQ - 1;
        wl[F.tid] = bf2f(P[(size_t)seqrow(b, pq) * NNG + C_DW + hd]) * 0.03125f; }
    LAS unsigned* hist = (LAS unsigned*)(F.lds + 73728);
    for (int i = F.tid; i < 32 * 256; i += 512) hist[i] = 0u;
    LDS_WAIT(); __syncthreads();
#ifndef PROBE_SUB
#define PROBE_SUB 0
#endif
    for (int rpa = 0; rpa < ((PROBE_SUB & 8) ? 2 : 1); ++rpa)
    {
    bf16x8 kn[4];
    { const int pk = 32 * wave + ql, pkc = pk < LSEQ ? pk : LSEQ - 1; const bf16* krow = P + (size_t)seqrow(b, pkc) * NNG + C_DKI + 8 * hh;
#pragma unroll
      for (int ks = 0; ks < 4; ++ks) kn[ks] = ld_frag16(krow + 16 * ks); }
    for (int kt = wave; kt <= j; kt += NWAVES) {
        bf16x8 kf[4];
#pragma unroll
        for (int ks = 0; ks < 4; ++ks) kf[ks] = kn[ks];
        { const int ktn = kt + NWAVES <= j ? kt + NWAVES : kt; const int pk = 32 * ktn + ql, pkc = pk < LSEQ ? pk : LSEQ - 1; const bf16* krow = P + (size_t)seqrow(b, pkc) * NNG + C_DKI + 8 * hh;
#pragma unroll
          for (int ks = 0; ks < 4; ++ks) kn[ks] = ld_frag16(krow + 16 * ks); }
        f32x16 idx;
#pragma unroll
        for (int r = 0; r < 16; ++r) idx[r] = 0.f;
#pragma unroll 1
        for (int hd = 0; hd < 16; hd += 2) { f32x16 S0, S1; const float wh0 = wl[ql * 16 + hd], wh1 = wl[ql * 16 + hd + 1];
#pragma unroll
            for (int r = 0; r < 16; ++r) { S0[r] = 0.f; S1[r] = 0.f; }
#pragma unroll
            for (int ks = 0; ks < 4; ++ks) { S0 = __builtin_amdgcn_mfma_f32_32x32x16_bf16(kf[ks], *(const LAS bf16x8*)(qi + ql * 2064 + hd * 128 + 32 * ks + 16 * hh), S0, 0, 0, 0);
                S1 = __builtin_amdgcn_mfma_f32_32x32x16_bf16(kf[ks], *(const LAS bf16x8*)(qi + ql * 2064 + (hd + 1) * 128 + 32 * ks + 16 * hh), S1, 0, 0, 0); }
#pragma unroll
            for (int r = 0; r < 16; ++r) idx[r] += wh0 * fmaxf(S0[r], 0.f) + wh1 * fmaxf(S1[r], 0.f); }
        { const int pqh = 32 * j + ql;
#pragma unroll
          for (int r = 0; r < 16; ++r) { const int kp = 32 * kt + 4 * hh + (r & 3) + 8 * (r >> 2);
              int bn = (int)__builtin_floorf(__builtin_fmaf(idx[r], 32.f, 256.f)); bn = bn < 0 ? 0 : (bn > 511 ? 511 : bn);
              if (kp <= pqh) (void)__hip_atomic_fetch_add(hist + ql * 256 + (bn >> 1), 1u << (16 * (bn & 1)), __ATOMIC_RELAXED, __HIP_MEMORY_SCOPE_WORKGROUP); } }
        float* srow = slab + (size_t)ql * LPAD + 32 * kt + 4 * hh;
#pragma unroll
        for (int g = 0; g < 4; ++g) *(GAS f32x4*)(srow + 8 * g) = (f32x4){idx[4 * g], idx[4 * g + 1], idx[4 * g + 2], idx[4 * g + 3]};
    }
    }
    VM_WAIT(); LDS_WAIT(); __syncthreads();
    for (int rpb = 0; rpb < ((PROBE_SUB & 16) ? 2 : 1); ++rpb)
    for (int qq = wave; qq < 32; qq += NWAVES) {
        const int p = 32 * j + qq; if (p >= LSEQ) break;
        const float* row = slab + (size_t)qq * LPAD;
        unsigned u[65];
        { const GAS unsigned* rp = (const GAS unsigned*)row + lane;
#pragma unroll
          for (int i = 0; i < 65; ++i) u[i] = rp[64 * i];
          __builtin_amdgcn_sched_barrier(0); }
        auto wsum = [&](unsigned c) { unsigned s = 0;
#pragma unroll
            for (int k = 0; k < 7; ++k) s += (unsigned)__builtin_popcountll(__ballot((c >> k) & 1u)) << k;
            return s; };
        unsigned T = 1u;
        if (p + 1 <= 256) {
#pragma unroll
            for (int i = 0; i < 65; ++i) { const unsigned k = f32_key(__uint_as_float(u[i])) >> 1; u[i] = (64 * i + lane <= p) ? k : 0u; }
        } else {
            const LAS unsigned* hrow = hist + qq * 256 + 4 * lane; unsigned c8[8];
#pragma unroll
            for (int i = 0; i < 4; ++i) { const unsigned w = hrow[i]; c8[2 * i] = w & 0xffffu; c8[2 * i + 1] = w >> 16; }
            unsigned tot = 0;
#pragma unroll
            for (int i = 0; i < 8; ++i) tot += c8[i];
            unsigned suf = 0;
            { const unsigned long long gtm = (lane == 63) ? 0ull : ~((2ull << lane) - 1ull);
#pragma unroll
              for (int k = 0; k < 13; ++k) suf += (unsigned)__builtin_popcountll(__ballot((tot >> k) & 1u) & gtm) << k; }
            unsigned run = suf, bl = 0, al = 0; bool found = false;
#pragma unroll
            for (int i = 7; i >= 0; --i) { const bool hit = !found && run < 256u && run + c8[i] >= 256u; if (hit) { bl = 8u * lane + i; al = run; } found = found || hit; run += c8[i]; }
            const unsigned long long fb = __ballot(found); const int src = (int)__builtin_ctzll(fb | (1ull << 63));
            const unsigned bstar = __builtin_amdgcn_readlane(bl, src), above = __builtin_amdgcn_readlane(al, src), need = 256u - above;
            unsigned f0 = 0u, f1 = 0u, f2 = 0u, cb = 0u;
#pragma unroll
            for (int i = 0; i < 65; ++i) { const float v = __uint_as_float(u[i]); int bn = (int)__builtin_floorf(__builtin_fmaf(v, 32.f, 256.f)); bn = bn < 0 ? 0 : (bn > 511 ? 511 : bn);
                const bool val = 64 * i + lane <= p, inband = val && (unsigned)bn == bstar;
                if (i < 32) f0 |= inband ? (1u << i) : 0u; else if (i < 64) f1 |= inband ? (1u << (i - 32)) : 0u; else f2 = inband ? 1u : 0u;
                cb += inband ? 1u : 0u;
                const unsigned k = f32_key(v) >> 1; u[i] = val ? k : 0u; }
            const unsigned inb = wsum(cb);
            if (fb != 0ull && inb <= 128u && inb >= need) {
                LAS unsigned* band = (LAS unsigned*)(F.lds + 68096) + wave * 128;
                unsigned off = 0;
#pragma unroll
                for (int k = 0; k < 7; ++k) { const unsigned long long bal = __ballot((cb >> k) & 1u); off += __builtin_amdgcn_mbcnt_hi((unsigned)(bal >> 32), __builtin_amdgcn_mbcnt_lo((unsigned)bal, 0u)) << k; }
#pragma unroll
                for (int i = 0; i < 65; ++i) { const bool inband = i < 32 ? ((f0 >> i) & 1u) : (i < 64 ? ((f1 >> (i - 32)) & 1u) : (f2 & 1u)); if (inband) { band[off] = u[i]; ++off; } }
                LDS_WAIT();
                const unsigned m0 = lane < (int)inb ? band[lane] : 0u, m1 = lane + 64 < (int)inb ? band[lane + 64] : 0u; unsigned ge0 = 0, gt0 = 0, ge1 = 0, gt1 = 0;
                for (unsigned k = 0; k < inb; ++k) { const unsigned v = band[k]; ge0 += (m0 - 1u - v) >> 31; gt0 += (m0 - v) >> 31; ge1 += (m1 - 1u - v) >> 31; gt1 += (m1 - v) >> 31; }
                const unsigned long long ok0 = __ballot(lane < (int)inb && ge0 >= need && gt0 < need), ok1 = __ballot(lane + 64 < (int)inb && ge1 >= need && gt1 < need);
                if (ok0) T = __builtin_amdgcn_readlane(m0, (int)__builtin_ctzll(ok0)); else T = __builtin_amdgcn_readlane(m1, (int)__builtin_ctzll(ok1 | (1ull << 63)));
                LDS_WAIT();
            } else {
                T = 0u;
                for (int bit = 30; bit >= 0; --bit) { const unsigned cm1 = (T | (1u << bit)) - 1u; unsigned c = 0;
#pragma unroll
                    for (int i = 0; i < 65; ++i) c += (cm1 - u[i]) >> 31;
                    if (wsum(c) >= 256u) T |= 1u << bit; } } }
        unsigned long long* mrow = (unsigned long long*)((unsigned*)(F.ws + WS_MASK) + ((size_t)b * LPAD + p) * MASKW);
        unsigned wlo = 0u, whi = 0u;
#pragma unroll
        for (int i = 0; i < 64; ++i) { const unsigned long long bal = __ballot(u[i] >= T); if (lane == i) { wlo = (unsigned)bal; whi = (unsigned)(bal >> 32); } }
        const unsigned long long b64 = __ballot(u[64] >= T);
        mrow[lane] = ((unsigned long long)whi << 32) | wlo; if (lane == 0) mrow[64] = b64;
    }
    __syncthreads();
}
struct HgChunk { bf16* base; int pitch; int cq, ck, cv; bf16* A; float* dl; };
__device__ __forceinline__ HgChunk hg_chunk(Frame& F, int b, int h, int c) {
    HgChunk k;
    if (c == 0) { unsigned char* mp = F.ws + WS_HMETA + (size_t)h * HMETA_STRIDE; k.base = (bf16*)mp; k.pitch = 384; k.cq = 0; k.ck = 128; k.cv = 256; k.A = (bf16*)(mp + 64 * 384 * 2); k.dl = (float*)(mp + 64 * 384 * 2 + 64 * 64 * 2); }
    else { const size_t ci = (size_t)(b * 4 + h) * 64 + (c - 1); k.base = (bf16*)(F.ws + WS_BIG) + (size_t)(b * SEQ + 64 * (c - 1)) * NNG; k.pitch = NNG; k.cq = C_AQ + h * 128; k.ck = C_AF + h * 128; k.cv = C_AI + h * 128;
        k.A = (bf16*)(F.ws + WS_HA) + ci * 64 * 64; k.dl = (float*)(F.ws + WS_HDL) + ci * 128; }
    return k;
}
__device__ __forceinline__ void hgrn_prep_task(Frame& F, int l, int b, int h, int c) {
    const int d = F.tid & 127, tq = F.tid >> 7, lane = F.lane, wave = F.wave;
    const bf16* P = (const bf16*)(F.ws + WS_BIG);
    LAS bf16* Qt = (LAS bf16*)F.lds; LAS bf16* Kt = Qt + 64 * 136; LAS float* part = (LAS float*)(F.lds + 2 * 64 * 136 * 2);
    const HgChunk ch = hg_chunk(F, b, h, c);
    float lb = 0.f; if (l == 1) { const float a = FIN(F, I_LB)[h * 128 + d], cc = FIN(F, I_LB)[512 + h * 128 + d]; lb = 1.0f / (1.0f + __expf(a - cc)); }
    const bool meta = (c == 0);
    unsigned short zr[16], qr[16], vr[16];
    { const int r0 = meta ? MREAL : b * SEQ + 64 * (c - 1);
#pragma unroll
      for (int i = 0; i < 16; ++i) { int t = 16 * tq + i; if (meta) t = t < NMETA ? t : NMETA - 1; const bf16* pr = P + (size_t)(r0 + t) * NNG + h * 128 + d; zr[i] = pr[C_AF]; qr[i] = pr[C_AQ]; vr[i] = pr[C_AI]; }
      __builtin_amdgcn_sched_barrier(0); }
    float lfv[16];
    float run = 0.f;
#pragma unroll
    for (int i = 0; i < 16; ++i) { const bool valid = !meta || (16 * tq + i < NMETA); const float z = bf2f(zr[i]); const float sg = 1.0f / (1.0f + __expf(-z));
        lfv[i] = valid ? __logf(lb + (1.0f - lb) * sg) : 0.f; run += lfv[i]; }
    part[tq * 128 + d] = run;
    LDS_WAIT(); __syncthreads();
    const float p0 = part[d], p1 = part[128 + d], p2 = part[256 + d], p3 = part[384 + d];
    const float off = (tq > 0 ? p0 : 0.f) + (tq > 1 ? p1 : 0.f) + (tq > 2 ? p2 : 0.f), bmid = p0 + p1, blast = (p0 + p1) + (p2 + p3);
    unsigned kb[8], vb[8]; unsigned short qb[16];
    float bt = off;
#pragma unroll
    for (int i = 0; i < 16; i += 2) { float kbar[2], vv[2];
#pragma unroll
        for (int u = 0; u < 2; ++u) { const int t = 16 * tq + i + u; const bool valid = !meta || (t < NMETA);
            const float lf = lfv[i + u]; const float q = bf2f(qr[i + u]);
            const float kk = valid ? 1.0f - __expf(lf) : 0.f, qq = valid ? q / (1.0f + __expf(-q)) : 0.f; vv[u] = valid ? bf2f(vr[i + u]) : 0.f;
            bt += lf;
            kbar[u] = kk * __expf(blast - bt); qb[i + u] = (unsigned short)f2bf_s(qq * __expf(bt));
            const float qt = qq * __expf(fminf(bt - bmid, 80.f)), kt = kk * __expf(fminf(bmid - bt, 80.f));
            Qt[t * 136 + d] = (bf16)f2bf_s(qt); Kt[t * 136 + d] = (bf16)f2bf_s(kt); }
        kb[i >> 1] = pk2(kbar[0], kbar[1]); vb[i >> 1] = pk2(vv[0], vv[1]); }
    asm volatile("s_waitcnt vmcnt(0)" ::: "memory"); __syncthreads();
#pragma unroll
    for (int i = 0; i < 16; ++i) ch.base[(size_t)(16 * tq + i) * ch.pitch + ch.cq + d] = qb[i];
    { bf16* kd = ch.base + (size_t)(d >> 1) * ch.pitch + ch.ck + (d & 1) * 64 + 16 * tq; bf16* vd = ch.base + (size_t)(d >> 1) * ch.pitch + ch.cv + (d & 1) * 64 + 16 * tq;
      *(GAS v4u*)kd = (v4u){kb[0], kb[1], kb[2], kb[3]}; *(GAS v4u*)(kd + 8) = (v4u){kb[4], kb[5], kb[6], kb[7]};
      *(GAS v4u*)vd = (v4u){vb[0], vb[1], vb[2], vb[3]}; *(GAS v4u*)(vd + 8) = (v4u){vb[4], vb[5], vb[6], vb[7]}; }
    if (tq == 0) ch.dl[d] = __expf(blast);
    LDS_WAIT(); __syncthreads();
    { const int mt = wave >> 1, fr = lane & 15, g = lane >> 4;
#pragma unroll
      for (int u = 0; u < 2; ++u) { const int nt = 2 * (wave & 1) + u; f32x4 acc = (f32x4){0.f, 0.f, 0.f, 0.f};
        if (nt <= mt) {
#pragma unroll
            for (int ks = 0; ks < 4; ++ks) acc = __builtin_amdgcn_mfma_f32_16x16x32_bf16(*(const LAS bf16x8*)(Qt + (16 * mt + fr) * 136 + 32 * ks + 8 * g), *(const LAS bf16x8*)(Kt + (16 * nt + fr) * 136 + 32 * ks + 8 * g), acc, 0, 0, 0);
        }
#pragma unroll
        for (int r = 0; r < 4; ++r) { const int t = 16 * mt + 4 * g + r, s = 16 * nt + fr; ch.A[t * 64 + s] = (bf16)f2bf_s(s <= t ? acc[r] : 0.f); } } }
    __syncthreads();
}
__device__ __forceinline__ void hgrn_scan_unit(Frame& F, int l, int b, int h) {
    const int lane = F.lane, wave = F.wave, fr = lane & 15, g = lane >> 4, tid = F.tid;
    constexpr int QP = 136, AP = 72, KP = 72, GP = 136;
    constexpr int BUF = (64 * QP + 64 * AP + 128 * KP + 64 * GP) * 2 + 512;
    LAS float* red = (LAS float*)(F.lds + 2 * BUF);
    const int dv = 16 * wave + fr;
    const float gn = FIN(F, I_GN)[l * 512 + h * 128 + dv];
    const bf16* Pg = (const bf16*)(F.ws + WS_BIG) + C_AG + h * 128;
    f32x4 S[8];
#pragma unroll
    for (int mt = 0; mt < 8; ++mt) S[mt] = (f32x4){0.f, 0.f, 0.f, 0.f};
    v4u rq[2], ra, rk[2], rg[2], rd; bf16x8 bv0, bv1, bn0, bn1;
#define HG_ISSUE(c_, B0, B1) do { const HgChunk ch_ = hg_chunk(F, b, h, (c_)); const int nv_ = ((c_) == 0) ? NMETA : 64; \
        _Pragma("unroll") for (int i = 0; i < 2; ++i) { const int idx = tid + 512 * i, row = idx >> 4, c16 = idx & 15; \
            rq[i] = *(const GAS v4u*)(ch_.base + (size_t)row * ch_.pitch + ch_.cq + 8 * c16); rk[i] = *(const GAS v4u*)(ch_.base + (size_t)row * ch_.pitch + ch_.ck + 8 * c16); \
            rg[i] = (v4u){0u, 0u, 0u, 0u}; if (row < nv_) rg[i] = *(const GAS v4u*)(Pg + (size_t)(((c_) == 0) ? MREAL + row : b * SEQ + 64 * ((c_) - 1) + row) * NNG + 8 * c16); } \
        ra = *(const GAS v4u*)(ch_.A + 8 * tid); if (tid < 32) rd = *(const GAS v4u*)(ch_.dl + 4 * tid); \
        const bf16* vrow_ = ch_.base + (size_t)(dv >> 1) * ch_.pitch + ch_.cv + (dv & 1) * 64 + 8 * g; B0 = ld_frag16(vrow_); B1 = ld_frag16(vrow_ + 32); } while (0)
#define HG_COMMIT(buf_) do { LAS bf16* Q_ = (LAS bf16*)(F.lds + (buf_) * BUF); LAS bf16* A_ = Q_ + 64 * QP; LAS bf16* KT_ = A_ + 64 * AP; LAS bf16* G_ = KT_ + 128 * KP; \
        _Pragma("unroll") for (int i = 0; i < 2; ++i) { const int idx = tid + 512 * i, row = idx >> 4, c16 = idx & 15; *(LAS v4u*)(Q_ + row * QP + 8 * c16) = rq[i]; \
            *(LAS v4u*)(KT_ + (2 * row + (c16 >> 3)) * KP + 8 * (c16 & 7)) = rk[i]; *(LAS v4u*)(G_ + row * GP + 8 * c16) = rg[i]; } \
        *(LAS v4u*)(A_ + (tid >> 3) * AP + 8 * (tid & 7)) = ra; if (tid < 32) *(LAS v4u*)((LAS unsigned char*)(G_ + 64 * GP) + 16 * tid) = rd; } while (0)
    HG_ISSUE(0, bv0, bv1); HG_COMMIT(0);
    for (int c = 0; c <= 64; ++c) {
        const int buf = c & 1;
        LDS_WAIT(); __syncthreads();
        if (c < 64) HG_ISSUE(c + 1, bn0, bn1);
        LAS bf16* Q = (LAS bf16*)(F.lds + buf * BUF); LAS bf16* A = Q + 64 * QP; LAS bf16* KT = A + 64 * AP; LAS bf16* G = KT + 128 * KP; const LAS float* DL = (const LAS float*)(G + 64 * GP);
        f32x4 o[4];
#pragma unroll
        for (int mt = 0; mt < 4; ++mt) o[mt] = (f32x4){0.f, 0.f, 0.f, 0.f};
#pragma unroll
        for (int ks = 0; ks < 4; ++ks) { v4u w; w.x = cvtpk(S[2 * ks][0], S[2 * ks][1]); w.y = cvtpk(S[2 * ks][2], S[2 * ks][3]); w.z = cvtpk(S[2 * ks + 1][0], S[2 * ks + 1][1]); w.w = cvtpk(S[2 * ks + 1][2], S[2 * ks + 1][3]);
            const bf16x8 sb = __builtin_bit_cast(bf16x8, w);
#pragma unroll
            for (int mt = 0; mt < 4; ++mt) { const LAS bf16* qp = Q + (16 * mt + fr) * QP + 32 * ks + 4 * g;
                const bf16x8 af = mk_frag(*(const LAS v2u*)qp, *(const LAS v2u*)(qp + 16));
                o[mt] = __builtin_amdgcn_mfma_f32_16x16x32_bf16(af, sb, o[mt], 0, 0, 0); } }
#pragma unroll
        for (int mt = 0; mt < 4; ++mt) { o[mt] = __builtin_amdgcn_mfma_f32_16x16x32_bf16(*(const LAS bf16x8*)(A + (16 * mt + fr) * AP + 8 * g), bv0, o[mt], 0, 0, 0);
            o[mt] = __builtin_amdgcn_mfma_f32_16x16x32_bf16(*(const LAS bf16x8*)(A + (16 * mt + fr) * AP + 32 + 8 * g), bv1, o[mt], 0, 0, 0); }
#pragma unroll
        for (int mt = 0; mt < 8; ++mt) { const f32x4 dl = *(const LAS f32x4*)(DL + 16 * mt + 4 * g); S[mt] = S[mt] * dl;
            S[mt] = __builtin_amdgcn_mfma_f32_16x16x32_bf16(*(const LAS bf16x8*)(KT + (16 * mt + fr) * KP + 8 * g), bv0, S[mt], 0, 0, 0);
            S[mt] = __builtin_amdgcn_mfma_f32_16x16x32_bf16(*(const LAS bf16x8*)(KT + (16 * mt + fr) * KP + 32 + 8 * g), bv1, S[mt], 0, 0, 0); }
#pragma unroll
        for (int mt = 0; mt < 4; ++mt)
#pragma unroll
            for (int r = 0; r < 4; ++r) { float s2 = o[mt][r] * o[mt][r]; s2 += __shfl_xor(s2, 1); s2 += __shfl_xor(s2, 2); s2 += __shfl_xor(s2, 4); s2 += __shfl_xor(s2, 8);
                if (fr == 0) red[wave * 64 + 16 * mt + 4 * g + r] = s2; }
        LDS_WAIT(); __syncthreads();
        const int nvalid = (c == 0) ? NMETA : 64;
#pragma unroll
        for (int mt = 0; mt < 4; ++mt)
#pragma unroll
            for (int r = 0; r < 4; ++r) { const int t = 16 * mt + 4 * g + r; float tot = 0.f;
#pragma unroll
                for (int w = 0; w < 8; ++w) tot += red[w * 64 + t];
                if (t < nvalid && (c > 0 || b == 0)) { const int row = (c == 0) ? MREAL + t : b * SEQ + 64 * (c - 1) + t;
                    const float gr = bf2f(G[t * GP + dv]);
                    const float val = o[mt][r] * (1.0f / sqrtf(tot * (1.f / 128.f) + EPS)) * gn * (gr / (1.0f + __expf(-gr)));
                    ((bf16*)(F.ws + WS_BR))[(size_t)row * 512 + h * 128 + dv] = (bf16)f2bf_s(val); } }
        if (c < 64) { HG_COMMIT(buf ^ 1); bv0 = bn0; bv1 = bn1; }
    }
#undef HG_ISSUE
#undef HG_COMMIT
    __syncthreads();
}
__device__ __forceinline__ void conv_row(Frame& F, int l, int r) {
    const int lane = F.lane; const bf16* P = (const bf16*)(F.ws + WS_BIG);
    int r1, r2;
    if (r < MREAL) { const int b = r >> 12, t = r & 4095; r1 = seqrow(b, NMETA + t - 1); r2 = seqrow(b, NMETA + t - 2); }
    else { const int i = r - MREAL; r1 = i >= 1 ? r - 1 : -1; r2 = i >= 2 ? r - 2 : -1; }
    const float* cw = FIN(F, I_CONVW) + l * 3 * 512 + 8 * lane;
    const int r1c = r1 >= 0 ? r1 : r, r2c = r2 >= 0 ? r2 : r;
    const v4u wc0 = *(const GAS v4u*)(P + (size_t)r * NNG + C_BC + 8 * lane), wu0 = *(const GAS v4u*)(P + (size_t)r * NNG + C_BU + 8 * lane), wb = *(const GAS v4u*)(P + (size_t)r * NNG + C_BB + 8 * lane);
    const v4u wc1 = *(const GAS v4u*)(P + (size_t)r1c * NNG + C_BC + 8 * lane), wu1 = *(const GAS v4u*)(P + (size_t)r1c * NNG + C_BU + 8 * lane);
    const v4u wc2 = *(const GAS v4u*)(P + (size_t)r2c * NNG + C_BC + 8 * lane), wu2 = *(const GAS v4u*)(P + (size_t)r2c * NNG + C_BU + 8 * lane);
    __builtin_amdgcn_sched_barrier(0);
    float c0[8], u0[8], bb[8], y[8]; unpack8(wc0, c0); unpack8(wu0, u0); unpack8(wb, bb);
#pragma unroll
    for (int i = 0; i < 8; ++i) y[i] = cw[i] * (c0[i] * u0[i]);
    const float m1 = r1 >= 0 ? 1.f : 0.f, m2 = r2 >= 0 ? 1.f : 0.f;
    unpack8(wc1, c0); unpack8(wu1, u0);
#pragma unroll
    for (int i = 0; i < 8; ++i) y[i] += m1 * cw[512 + i] * (c0[i] * u0[i]);
    unpack8(wc2, c0); unpack8(wu2, u0);
#pragma unroll
    for (int i = 0; i < 8; ++i) y[i] += m2 * cw[1024 + i] * (c0[i] * u0[i]);
#pragma unroll
    for (int i = 0; i < 8; ++i) y[i] *= bb[i];
    *(GAS v4u*)((bf16*)(F.ws + WS_BR) + (size_t)MPAD * 512 + (size_t)r * 512 + 8 * lane) = pack8(y);
}
constexpr int CW_TMO = 0, CW_BAR = 4096, CW_Q = 16384;
__device__ __forceinline__ int queue_pop(Frame& F, int qi) {
    int t = 0; if (F.lane == 0) t = (int)__hip_atomic_fetch_add((unsigned*)(F.ctl + CW_Q + 64 * qi), 1u, RLX_AGENT);
    return __builtin_amdgcn_readfirstlane(t);
}
__device__ __forceinline__ int queue_pop_wg(Frame& F, int qi) {
    LAS int* slot = (LAS int*)(F.lds + 139264);
    __syncthreads();
    if (F.tid == 0) *slot = (int)__hip_atomic_fetch_add((unsigned*)(F.ctl + CW_Q + 64 * qi), 1u, RLX_AGENT);
    LDS_WAIT(); __syncthreads();
    return __builtin_amdgcn_readfirstlane(*slot);
}
__device__ __forceinline__ void phase_hgrn_prep(Frame& F, int l) {
    for (int t = F.bid; t < NB * 4 * 64 + 4; t += F.G) { if (t < 4) hgrn_prep_task(F, l, 0, t, 0); else { const int u = t - 4; hgrn_prep_task(F, l, u >> 8, (u >> 6) & 3, 1 + (u & 63)); } }
}
__device__ __forceinline__ void phase_prep(Frame& F, int l) { const int gw = F.bid * NWAVES + F.wave, NGW = F.G * NWAVES; for (int r = gw; r < MREAL + NMETA; r += NGW) prep_row(F, l, r); }
__device__ __forceinline__ void phase_vt(Frame& F) { const int gw = F.bid * NWAVES + F.wave, NGW = F.G * NWAVES; for (int t = gw; t < VT_NTASK; t += NGW) vt_task(F, t); }
__device__ __forceinline__ void phase_mix1(Frame& F, int l, int qidx) {
    LAS float* bt = (LAS float*)(F.lds + 135168);
    build_bias_table(F, bt, 0);
    __syncthreads();
    if (F.bid < NIDX_WG) {
        float* slab = (float*)(F.ws + WS_SCR) + (size_t)F.bid * 32 * LPAD;
        for (int t = F.bid; t < NB * NQT; t += NIDX_WG) { const int j = NQT - 1 - t / NB, b = t % NB; dsa_index_task(F, b, j, slab); }
    } else if (F.bid < NIDX_WG + NHG_WG) {
        const int u = F.bid - NIDX_WG; hgrn_scan_unit(F, l, u >> 2, u & 3);
    } else {
        const int u0 = F.bid - NIDX_WG - NHG_WG, nw = F.G - NIDX_WG - NHG_WG;
        const int cw = u0 * NWAVES + F.wave, ncw = nw * NWAVES; for (int r = cw; r < MREAL + NMETA; r += ncw) conv_row(F, l, r);
    }
    float lam, post;
    { const float* lp = FIN(F, I_DLAM) + l * 256; const float s1 = wave_sum(lp[F.lane] * lp[64 + F.lane]), s2 = wave_sum(lp[128 + F.lane] * lp[192 + F.lane]);
      const float li = 0.8f - 0.6f * __expf(-0.3f * (float)l); lam = __expf(s1) - __expf(s2) + li; post = 1.0f - li; }
    for (;;) { const int t = queue_pop_wg(F, qidx); if (t >= NB * 4 * NQB) break;
        const int J = NQB - 1 - t / 32, bh = t % 32; attn_wg_task<false>(F, l, bh >> 2, bh & 3, J, bt, lam, post); }
}
__device__ __forceinline__ void phase_mix2(Frame& F, int l, int qidx) {
    LAS float* bt = (LAS float*)(F.lds + 135168);
    build_bias_table(F, bt, 4);
    __syncthreads();
    for (;;) { const int t = queue_pop_wg(F, qidx); if (t >= NB * 4 * NQB) break;
        const int J = NQB - 1 - t / 32, bh = t % 32; attn_wg_task<true>(F, l, bh >> 2, bh & 3, J, bt, 0.f, 1.f); }
}

#ifndef MK_ONE
#define MK_ONE 0
#endif
#ifndef BR_MASK
#define BR_MASK 15
#endif
constexpr int NPH = 18;
template <class T> __device__ __forceinline__ T opaque(T v) { asm volatile("" : "+s"(v)); return v; }
struct Args { const float* in[22]; float* out; unsigned char* ws; int ph_lo, ph_hi; };
__global__ void __launch_bounds__(NWAVES * 64, 2) fwd(Args args) {
    extern __shared__ __attribute__((aligned(16))) unsigned char lds[];
    Frame F;
    F.lds = (LAS unsigned char*)lds; F.MISC = (volatile LAS unsigned*)(F.lds + MISC_OFF);
    F.tid = threadIdx.x; F.lane = F.tid & 63; F.wave = __builtin_amdgcn_readfirstlane(F.tid >> 6); F.G = gridDim.x; F.bid = blockIdx.x;
    F.ws = args.ws; F.out = args.out; F.ctl = (gu32*)(args.ws + WS_CTL);
    F.karg = (const unsigned char __attribute__((address_space(4)))*)__builtin_amdgcn_kernarg_segment_ptr();
    for (int u = F.tid; u < (LDS_BYTES - LDSCTL_OFF) / 4; u += NWAVES * 64) ((LAS unsigned*)(F.lds + LDSCTL_OFF))[u] = 0u;
    __syncthreads();
#if MK_ONE
    XcdBarrier bar = xcd_barrier_post((unsigned*)(F.ctl + CW_BAR), F.MISC + 8, __builtin_amdgcn_readfirstlane(threadIdx.x >> 6));
#define GRID_BAR() xcd_barrier(bar)
#else
#define GRID_BAR() do { } while (0)
#endif
    const int wave_s = __builtin_amdgcn_readfirstlane(threadIdx.x >> 6);
    const int lo = args.ph_lo, hi = args.ph_hi;
#define IN(k) (lo <= (k) && (k) < hi)
#define RETID() do { int w_ = wave_s; asm volatile("" : "+s"(w_)); unsigned mk_ = ~0u; asm volatile("" : "+s"(mk_)); int t_ = w_ * 64 + (int)__builtin_amdgcn_mbcnt_hi(mk_, __builtin_amdgcn_mbcnt_lo(mk_, 0u)); asm volatile("" : "+v"(t_)); F.tid = t_; F.lane = t_ & 63; F.wave = w_; } while (0)
#ifdef DBG_TS
#define STAMP(k) do { if (blockIdx.x == 0 && threadIdx.x == 0) ((unsigned long long*)(args.ws + 768 * 1024))[(k)] = __builtin_amdgcn_s_memrealtime(); } while (0)
#else
#define STAMP(k) do { } while (0)
#endif
#define SEAM(k) do { if (IN((k) + 1)) GRID_BAR(); STAMP((k) + 1); } while (0)
#ifndef PROBE_EPI
#define PROBE_EPI 0
#endif
#ifdef PROBE_MASK
#define NREP(kk) opaque(((PROBE_MASK >> (kk)) & 1) ? 1 + PROBE_EXTRA : 1)
#define REP_BEGIN(kk) { const int nrep_ = NREP(kk); for (int rep = 0; rep < nrep_; ++rep) { if (rep) GRID_BAR();
#define REP_END } }
#else
#define REP_BEGIN(kk) { { const int rep = 0; (void)rep;
#define REP_END } }
#endif
    STAMP(0);
    unsigned char* wb = F.ws + WS_W;
    bf16* XN = (bf16*)(F.ws + WS_XN); bf16* BR = (bf16*)(F.ws + WS_BR); bf16* BIG = (bf16*)(F.ws + WS_BIG); float* HM = (float*)(F.ws + WS_HM);
    for (int l = 0; l < 2; ++l) {
        const int pb = l * NPH;
        const float* hsrc = (l == 0) ? FIN(F, I_X) : F.out;
        if (IN(pb + 0)) { REP_BEGIN(0) RETID(); phase_convert(F, l); REP_END SEAM(pb + 0); }
        if (IN(pb + 1)) { REP_BEGIN(1) RETID(); phase_norm(F, hsrc, FIN(F, I_F1N) + l * DM); REP_END SEAM(pb + 1); }
        if (IN(pb + 2)) { REP_BEGIN(2) RETID(); meta_gemm(F, 0, XN + (size_t)MREAL * DM, DM, (const bf16*)(wb + W_GU1), NGU, DM, BIG, DFF, 0.f); pg8::Gemm g{opaque((const bf16*)(XN)), opaque((const bf16*)(wb + W_GU1)), MREAL, NGU, DM}; pg8::StaticOrder S; S.init(MREAL, NGU, F.G, opaque(F.bid));
            pg8::EpiSwiGLU E{BIG, DFF, rep ? PROBE_EPI : 0}; pg8::gemm_phase<pg8::EpiSwiGLU, pg8::StaticOrder, true, true>(F.lds + RING_OFF, g, S, E, F.tid); REP_END SEAM(pb + 2); }
        if (IN(pb + 3)) { REP_BEGIN(3) RETID(); meta_gemm(F, 1, BIG + (size_t)MREAL * DFF, DFF, (const bf16*)(wb + W_D1), DM, DFF, nullptr, 0, rep ? 0.f : 0.5f); pg8::Gemm g{opaque((const bf16*)(BIG)), opaque((const bf16*)(wb + W_D1)), MREAL, DM, DFF}; pg8::StaticOrder S; S.init(MREAL, DM, F.G, opaque(F.bid));
            pg8::EpiResF32 E{rep ? F.out : hsrc, F.out, HM, DM, MT_REAL, rep ? 0.f : 0.5f}; pg8::gemm_phase<pg8::EpiResF32, pg8::StaticOrder, true, true>(F.lds + RING_OFF, g, S, E, F.tid); REP_END SEAM(pb + 3); }
        if (IN(pb + 4)) { REP_BEGIN(4) RETID(); phase_norm(F, F.out, FIN(F, I_MIXN) + l * DM); REP_END SEAM(pb + 4); }
        if (IN(pb + 5)) { REP_BEGIN(5) RETID(); meta_gemm(F, 2, XN + (size_t)MREAL * DM, DM, (const bf16*)(wb + W_NG), NNG, DM, BIG, NNG, 0.f); pg8::Gemm g{opaque((const bf16*)(XN)), opaque((const bf16*)(wb + W_NG)), MREAL, NNG, DM}; pg8::StaticOrder S; S.init(MREAL, NNG, F.G, opaque(F.bid));
            pg8::EpiBf16<0> E{BIG, NNG}; pg8::gemm_phase<pg8::EpiBf16<0>, pg8::StaticOrder, true, true>(F.lds + RING_OFF, g, S, E, F.tid); REP_END SEAM(pb + 5); }
        if (IN(pb + 6)) { RETID(); phase_prep(F, l); phase_vt(F); __syncthreads(); phase_hgrn_prep(F, l); SEAM(pb + 6); }
#ifdef DUP_MIX
        if (IN(pb + 7)) { const int nrep = opaque(DUP_MIX1); for (int rep = 0; rep < nrep; ++rep) { RETID(); phase_mix1(F, l, 4 * rep + 2 * l); GRID_BAR(); } }
        if (IN(pb + 8)) { const int nrep = opaque(DUP_MIX2); for (int rep = 0; rep < nrep; ++rep) { RETID(); phase_mix2(F, l, 4 * rep + 2 * l + 1); GRID_BAR(); } }
#else
        if (IN(pb + 7)) { RETID(); phase_mix1(F, l, 2 * l); SEAM(pb + 7); }
        if (IN(pb + 8)) { RETID(); phase_mix2(F, l, 2 * l + 1); SEAM(pb + 8); }
#endif
        if (IN(pb + 9)) { REP_BEGIN(9) RETID(); meta_gemm(F, 3, XN + (size_t)MREAL * DM, DM, (const bf16*)(wb + W_G), NGATE, DM, BIG, NGATE, 0.f); pg8::Gemm g{opaque((const bf16*)(XN)), opaque((const bf16*)(wb + W_G)), MREAL, NGATE, DM}; pg8::StaticOrder S; S.init(MREAL, NGATE, F.G, opaque(F.bid));
            pg8::EpiBf16<1> E{BIG, NGATE}; pg8::gemm_phase<pg8::EpiBf16<1>, pg8::StaticOrder, true, true>(F.lds + RING_OFF, g, S, E, F.tid); REP_END SEAM(pb + 9); }
        if (IN(pb + 10)) { REP_BEGIN(10) RETID(); meta_gemm(F, 4, BR + (size_t)MREAL * 512, 512, (const bf16*)(wb + W_BR), DM, 512, XN, DM, 0.f);
            pg8::Gemm g{opaque((const bf16*)(BR)), opaque((const bf16*)(wb + W_BR)), MREAL, DM, 512}; pg8::MergeOrder S; S.init(MREAL, DM, F.G, opaque(F.bid), MPAD / 256);
            pg8::EpiGateAccM E{XN, DM, BIG, NGATE, MPAD / 256, DM / 256}; pg8::gemm_phase<pg8::EpiGateAccM, pg8::MergeOrder, true, true>(F.lds + RING_OFF, g, S, E, F.tid); REP_END SEAM(pb + 10); }
        if (IN(pb + 14) && BR_MASK) { REP_BEGIN(14) RETID(); meta_gemm(F, 1, XN + (size_t)MREAL * DM, DM, (const bf16*)(wb + W_O), DM, DM, nullptr, 0, rep ? 0.f : 1.0f); pg8::Gemm g{opaque((const bf16*)(XN)), opaque((const bf16*)(wb + W_O)), MREAL, DM, DM}; pg8::StaticOrder S; S.init(MREAL, DM, F.G, opaque(F.bid));
            pg8::EpiResF32 E{F.out, F.out, HM, DM, MT_REAL, rep ? 0.f : 1.0f}; pg8::gemm_phase<pg8::EpiResF32, pg8::StaticOrder, true, true>(F.lds + RING_OFF, g, S, E, F.tid); REP_END SEAM(pb + 14); }
        if (IN(pb + 15)) { REP_BEGIN(15) RETID(); phase_norm(F, F.out, FIN(F, I_F2N) + l * DM); REP_END SEAM(pb + 15); }
        if (IN(pb + 16)) { REP_BEGIN(16) RETID(); meta_gemm(F, 0, XN + (size_t)MREAL * DM, DM, (const bf16*)(wb + W_GU2), NGU, DM, BIG, DFF, 0.f); pg8::Gemm g{opaque((const bf16*)(XN)), opaque((const bf16*)(wb + W_GU2)), MREAL, NGU, DM}; pg8::StaticOrder S; S.init(MREAL, NGU, F.G, opaque(F.bid));
            pg8::EpiSwiGLU E{BIG, DFF, rep ? PROBE_EPI : 0}; pg8::gemm_phase<pg8::EpiSwiGLU, pg8::StaticOrder, true, true>(F.lds + RING_OFF, g, S, E, F.tid); REP_END SEAM(pb + 16); }
        if (IN(pb + 17)) { REP_BEGIN(17) RETID(); meta_gemm(F, 1, BIG + (size_t)MREAL * DFF, DFF, (const bf16*)(wb + W_D2), DM, DFF, nullptr, 0, rep ? 0.f : 0.5f); pg8::Gemm g{opaque((const bf16*)(BIG)), opaque((const bf16*)(wb + W_D2)), MREAL, DM, DFF}; pg8::StaticOrder S; S.init(MREAL, DM, F.G, opaque(F.bid));
            pg8::EpiResF32 E{F.out, F.out, HM, DM, MT_REAL, rep ? 0.f : 0.5f}; pg8::gemm_phase<pg8::EpiResF32, pg8::StaticOrder, true, true>(F.lds + RING_OFF, g, S, E, F.tid); REP_END SEAM(pb + 17); }
    }
}

extern "C" void kernel_launch(void* const* d_in, const int* in_sizes, int n_in, void* d_out, int out_size, void* d_ws, size_t ws_size, hipStream_t stream) {
    static int grid = 0;
    if (grid == 0) {
        if (n_in != 22 || out_size != MREAL * DM || ws_size < WS_END) { fprintf(stderr, "kernel_launch: unexpected shapes (n_in %d out %d ws %zu need %zu)\n", n_in, out_size, ws_size, (size_t)WS_END); grid = -1; return; }
        int dev = 0, cus = 0, per_cu = 0;
        if (hipGetDevice(&dev) != hipSuccess || hipDeviceGetAttribute(&cus, hipDeviceAttributeMultiprocessorCount, dev) != hipSuccess) { grid = -1; return; }
        if (hipFuncSetAttribute((const void*)fwd, hipFuncAttributeMaxDynamicSharedMemorySize, LDS_BYTES) != hipSuccess) { fprintf(stderr, "kernel_launch: hipFuncSetAttribute failed\n"); grid = -1; return; }
        if (hipOccupancyMaxActiveBlocksPerMultiprocessor(&per_cu, (const void*)fwd, NWAVES * 64, LDS_BYTES) != hipSuccess || per_cu < 1) fprintf(stderr, "kernel_launch: occupancy query says %d\n", per_cu);
        (void)hipGetLastError();
        grid = cus < 256 ? cus : 256;
    }
    if (grid < 0) return;
    (void)hipMemsetAsync((char*)d_ws + WS_CTL, 0, CTL_ZERO_BYTES, stream);
    Args a{};
    for (int i = 0; i < 22; ++i) a.in[i] = (const float*)d_in[i];
    a.out = (float*)d_out; a.ws = (unsigned char*)d_ws;
#ifndef PH_END
#define PH_END (2 * NPH)
#endif
#if MK_ONE
    a.ph_lo = 0; a.ph_hi = PH_END;
    hipLaunchKernelGGL(fwd, dim3(grid), dim3(NWAVES * 64), LDS_BYTES, stream, a);
#else
    for (int p = 0; p < PH_END; ++p) { a.ph_lo = p; a.ph_hi = p + 1;
        hipLaunchKernelGGL(fwd, dim3(grid), dim3(NWAVES * 64), LDS_BYTES, stream, a); }
#endif
}
```

```cpp
#include <hip/hip_runtime.h>
#include <cstdio>
#include <cstdint>
#define MK_ONE 1
namespace pg8 {
#define PG8_LAS __attribute__((address_space(3)))
typedef unsigned short bf16_t;
typedef short bf16x8 __attribute__((ext_vector_type(8)));
typedef float f32x4 __attribute__((ext_vector_type(4)));
typedef unsigned u32x4 __attribute__((ext_vector_type(4)));
constexpr int BM = 256, BK = 64, HALF = 128, HTB = HALF * BK * 2  , STAGE_BYTES = 8 * HTB, NXCD = 8, WGM = 8;

__host__ __device__ __forceinline__ int lds_byte(int r, int c) { const int st = (r >> 4) * 2 + (c >> 5), rr = r & 15, cc = c & 31, ob = rr * 64 + cc * 2; return st * 1024 + (ob ^ (((ob >> 9) & 1) << 5)); }
__host__ __device__ __forceinline__ void stage_rc(int b, int& R, int& C) { const int st = b / 1024, sb = b % 1024, swz = sb ^ (((sb >> 9) & 1) << 5); R = (st >> 1) * 16 + swz / 64; C = (st & 1) * 32 + (swz % 64) / 2; }
__host__ __device__ __forceinline__ int perm32(int rho) { const int n = rho >> 4, i = rho & 15; return 8 * (i >> 2) + 4 * n + (i & 3); }

struct Unit { int pm, pn; };
struct Gemm { const bf16_t* A; const bf16_t* Bt; int M, N, K; };

struct StaticOrder {
    int nM, nN, nwg, G, c;
    __host__ __device__ void init(int M, int N, int G_, int c_) { nM = M / BM; nN = N / BM; nwg = nM * nN; G = G_; c = c_; }
    __host__ __device__ bool next(int i, Unit& u) const {
        const long L = (long)i * G + c; if (L >= nwg) return false;
        int wgid = (int)L; { const int q = nwg / NXCD, r = nwg % NXCD, xcd = wgid % NXCD, off = wgid / NXCD; wgid = (xcd < r ? xcd * (q + 1) : r * (q + 1) + (xcd - r) * q) + off; }
        const int nig = WGM * nN, gid = wgid / nig, fm = gid * WGM, gsz = (nM - fm) < WGM ? (nM - fm) : WGM;
        u.pm = fm + ((wgid % nig) % gsz); u.pn = (wgid % nig) / gsz; return true;
    }
    __device__ __forceinline__ void a_ready(const Unit&) const {}
    __device__ __forceinline__ void done(const Unit&) const {}
};
typedef __bf16 bf16x2_hw __attribute__((ext_vector_type(2))); typedef float f32x2_hw __attribute__((ext_vector_type(2)));
__device__ __forceinline__ unsigned cvt_pk_bf16(float lo, float hi) { const f32x2_hw v = {lo, hi}; return __builtin_bit_cast(unsigned, __builtin_convertvector(v, bf16x2_hw)); }
typedef float f32x2 __attribute__((ext_vector_type(2)));
__device__ __forceinline__ float fast_sigmoid(float x) { return __builtin_amdgcn_rcpf(1.0f + __expf(-x)); }
__device__ __forceinline__ float fast_silu(float x) { return x * fast_sigmoid(x); }
template <int ACT  > struct EpiBf16 {
    static constexpr bool PERM = true, AFTER_DRAIN = false;
    bf16_t* O; int ldc;
    __device__ __forceinline__ void operator()(const f32x4 (&acc)[2][2][4][2], const Unit& u, int wr, int wc, int fr, int fq) const {
        const int row0 = u.pm * BM + wr * 64 + fr; const int col0 = u.pn * BM + wc * 32 + 8 * fq;
#pragma unroll
        for (int ai = 0; ai < 2; ++ai)
#pragma unroll
            for (int m = 0; m < 4; ++m) { bf16_t* rowp = O + (size_t)(row0 + ai * HALF + m * 16) * ldc + col0;
#pragma unroll
                for (int bj = 0; bj < 2; ++bj) { f32x4 v0 = acc[ai][bj][m][0], v1 = acc[ai][bj][m][1];
                    if (ACT == 1) {
#pragma unroll
                        for (int j = 0; j < 4; ++j) { v0[j] = fast_sigmoid(v0[j]); v1[j] = fast_sigmoid(v1[j]); } }
                    u32x4 w; w.x = cvt_pk_bf16(v0[0], v0[1]); w.y = cvt_pk_bf16(v0[2], v0[3]); w.z = cvt_pk_bf16(v1[0], v1[1]); w.w = cvt_pk_bf16(v1[2], v1[3]);
                    *(u32x4*)(rowp + bj * HALF) = w; } }
    }
};
struct EpiSwiGLU {
    static constexpr bool PERM = true, AFTER_DRAIN = false;
    bf16_t* O; int ldc; int mode;
    __device__ __forceinline__ void operator()(const f32x4 (&acc)[2][2][4][2], const Unit& u, int wr, int wc, int fr, int fq) const {
        if (mode == 2) return;
        const int row0 = u.pm * BM + wr * 64 + fr; const int col0 = u.pn * HALF + wc * 32 + 8 * fq;
#pragma unroll
        for (int ai = 0; ai < 2; ++ai)
#pragma unroll
            for (int m = 0; m < 4; ++m) { bf16_t* rowp = O + (size_t)(row0 + ai * HALF + m * 16) * ldc + col0;
                const f32x4 g0 = acc[ai][0][m][0], g1 = acc[ai][0][m][1], u0 = acc[ai][1][m][0], u1 = acc[ai][1][m][1];
                f32x4 v0, v1;
#pragma unroll
                for (int j = 0; j < 4; ++j) { v0[j] = fast_silu(g0[j]) * u0[j]; v1[j] = fast_silu(g1[j]) * u1[j]; }
                u32x4 w; w.x = cvt_pk_bf16(v0[0], v0[1]); w.y = cvt_pk_bf16(v0[2], v0[3]); w.z = cvt_pk_bf16(v1[0], v1[1]); w.w = cvt_pk_bf16(v1[2], v1[3]);
                if (mode == 0) *(u32x4*)rowp = w; else asm volatile("" :: "v"(w.x), "v"(w.y), "v"(w.z), "v"(w.w));
                asm volatile("" ::: "memory"); }
    }
};
struct EpiResF32 {
    static constexpr bool PERM = false, AFTER_DRAIN = false;
    const float* base_r; float* out_r; float* hm; int ldc; int mt_real; float scale;
    __device__ __forceinline__ void operator()(const f32x4 (&acc)[2][2][4][2], const Unit& u, int wr, int wc, int fr, int fq) const {
        const bool real = u.pm < mt_real;
        const float* bp = real ? base_r + (size_t)u.pm * BM * ldc : hm; float* op = real ? out_r + (size_t)u.pm * BM * ldc : hm;
        const int row0 = wr * 64 + fr, col0 = u.pn * BM + wc * 32 + 4 * fq;
#pragma unroll
        for (int ai = 0; ai < 2; ++ai) {
            f32x4 b[4][2][2];
#pragma unroll
            for (int m = 0; m < 4; ++m) { const size_t off = (size_t)(row0 + ai * HALF + m * 16) * ldc + col0;
#pragma unroll
                for (int bj = 0; bj < 2; ++bj)
#pragma unroll
                    for (int n = 0; n < 2; ++n) b[m][bj][n] = *(const f32x4*)(bp + off + bj * HALF + n * 16); }
            asm volatile("" ::: "memory");
#pragma unroll
            for (int m = 0; m < 4; ++m) { const size_t off = (size_t)(row0 + ai * HALF + m * 16) * ldc + col0;
#pragma unroll
                for (int bj = 0; bj < 2; ++bj)
#pragma unroll
                    for (int n = 0; n < 2; ++n) *(f32x4*)(op + off + bj * HALF + n * 16) = b[m][bj][n] + acc[ai][bj][m][n] * scale; }
            asm volatile("" ::: "memory"); }
    }
};
struct EpiGateAcc {
    static constexpr bool PERM = true, AFTER_DRAIN = false;
    bf16_t* MG; int ldc; const bf16_t* G; int ldg; int gcol0; int first;
    __device__ __forceinline__ void operator()(const f32x4 (&acc)[2][2][4][2], const Unit& u, int wr, int wc, int fr, int fq) const {
        const int row0 = u.pm * BM + wr * 64 + fr; const int col0 = u.pn * BM + wc * 32 + 8 * fq;
#pragma unroll
        for (int ai = 0; ai < 2; ++ai)
#pragma unroll
            for (int m = 0; m < 4; ++m) { const size_t r = (size_t)(row0 + ai * HALF + m * 16);
#pragma unroll
                for (int bj = 0; bj < 2; ++bj) { const u32x4 gw = *(const u32x4*)(G + r * ldg + gcol0 + col0 + bj * HALF);
                    u32x4 pw = (u32x4){0u, 0u, 0u, 0u}; if (!first) pw = *(const u32x4*)(MG + r * ldc + col0 + bj * HALF);
                    float o[8];
#pragma unroll
                    for (int j = 0; j < 4; ++j) { const float a0 = (j < 2) ? acc[ai][bj][m][0][2 * j] : acc[ai][bj][m][1][2 * (j - 2)], a1 = (j < 2) ? acc[ai][bj][m][0][2 * j + 1] : acc[ai][bj][m][1][2 * (j - 2) + 1];
                        o[2 * j] = __uint_as_float(pw[j] << 16) + __uint_as_float(gw[j] << 16) * a0; o[2 * j + 1] = __uint_as_float(pw[j] & 0xffff0000u) + __uint_as_float(gw[j] & 0xffff0000u) * a1; }
                    u32x4 w; w.x = cvt_pk_bf16(o[0], o[1]); w.y = cvt_pk_bf16(o[2], o[3]); w.z = cvt_pk_bf16(o[4], o[5]); w.w = cvt_pk_bf16(o[6], o[7]);
                    *(u32x4*)(MG + r * ldc + col0 + bj * HALF) = w; } }
    }
};

struct MergeOrder {
    int nM, nN, G, c, mt_alloc;
    __host__ __device__ void init(int M, int N, int G_, int c_, int mt_alloc_) { nM = M / BM; nN = N / BM; G = G_; c = c_; mt_alloc = mt_alloc_; }
    __host__ __device__ bool next(int i, Unit& u) const { const int t = (i >> 2) * G + c, m = i & 3; if (t >= nM * nN) return false;
        const int pm = t / nN, pn = t % nN; u.pm = m * mt_alloc + pm; u.pn = m * nN + pn; return true; }
    __device__ __forceinline__ void a_ready(const Unit&) const {}
    __device__ __forceinline__ void done(const Unit&) const {}
};
struct EpiGateAccM {
    static constexpr bool PERM = true, AFTER_DRAIN = false;
    bf16_t* MG; int ldc; const bf16_t* G; int ldg; int mt_alloc; int ntn;
    __device__ __forceinline__ void operator()(const f32x4 (&acc)[2][2][4][2], const Unit& u, int wr, int wc, int fr, int fq) const {
        const int m = u.pm / mt_alloc, pm = u.pm - m * mt_alloc, pn = u.pn - m * ntn;
        const int row0 = pm * BM + wr * 64 + fr; const int col0 = pn * BM + wc * 32 + 8 * fq; const int gcol0 = m * ntn * BM;
#pragma unroll
        for (int ai = 0; ai < 2; ++ai)
#pragma unroll
            for (int mm = 0; mm < 4; ++mm) { const size_t r = (size_t)(row0 + ai * HALF + mm * 16);
#pragma unroll
                for (int bj = 0; bj < 2; ++bj) { const u32x4 gw = *(const u32x4*)(G + r * ldg + gcol0 + col0 + bj * HALF);
                    u32x4 pw = (u32x4){0u, 0u, 0u, 0u}; if (m != 0) pw = *(const u32x4*)(MG + r * ldc + col0 + bj * HALF);
                    float o[8];
#pragma unroll
                    for (int j = 0; j < 4; ++j) { const float a0 = (j < 2) ? acc[ai][bj][mm][0][2 * j] : acc[ai][bj][mm][1][2 * (j - 2)], a1 = (j < 2) ? acc[ai][bj][mm][0][2 * j + 1] : acc[ai][bj][mm][1][2 * (j - 2) + 1];
                        o[2 * j] = __uint_as_float(pw[j] << 16) + __uint_as_float(gw[j] << 16) * a0; o[2 * j + 1] = __uint_as_float(pw[j] & 0xffff0000u) + __uint_as_float(gw[j] & 0xffff0000u) * a1; }
                    u32x4 w; w.x = cvt_pk_bf16(o[0], o[1]); w.y = cvt_pk_bf16(o[2], o[3]); w.z = cvt_pk_bf16(o[4], o[5]); w.w = cvt_pk_bf16(o[6], o[7]);
                    *(u32x4*)(MG + r * ldc + col0 + bj * HALF) = w; } }
    }
};
template <class Epi, class Sched, bool ALIGN_EPI = false, bool SP2 = false>
__device__ __forceinline__ void gemm_phase(PG8_LAS unsigned char* lds, const Gemm g, const Sched& S, const Epi& E, int tid_in) {
    int tid_ = tid_in; asm volatile("" : "+v"(tid_));
    const int tid = tid_, wid = __builtin_amdgcn_readfirstlane(tid >> 6), lane = tid & 63, wr = wid >> 2, wc = wid & 3, fr = lane & 15, fq = lane >> 4;
    const int K = g.K, nt = K / BK;
    unsigned voffA[2], voffB[2];
#pragma unroll
    for (int i = 0; i < 2; ++i) { int R, C; stage_rc(tid * 16 + i * 8192, R, C); const int Rb = Epi::PERM ? ((R & ~31) + perm32(R & 31)) : R;
        voffA[i] = (unsigned)(R * K + C) * 2u; voffB[i] = (unsigned)(Rb * K + C) * 2u; }
    const size_t kstep = (size_t)(BK * 2);
    const size_t hstep = (size_t)HALF * K * 2;
    const size_t tstep = 2 * hstep;
    const unsigned ldsw = (unsigned)wid * 1024u;
    const int aoff = lds_byte(wr * 64 + fr, fq * 8), boff = lds_byte(wc * 32 + fr, fq * 8);
#define PG8_SA(b, h) (((b) * 2 + (h)) * HTB)
#define PG8_SB(b, h) ((4 + (b) * 2 + (h)) * HTB)
#define PG8_STAGE(bufoff, gbase, voff) do { _Pragma("unroll") for (int _i = 0; _i < 2; ++_i) \
        __builtin_amdgcn_global_load_lds((const unsigned*)((const char*)(gbase) + (voff)[_i]), (PG8_LAS unsigned*)(lds + (bufoff) + ldsw + _i * 8192), 16, 0, 0); } while (0)
#define PG8_LDA(dst, b, h) do { _Pragma("unroll") for (int m = 0; m < 4; ++m) _Pragma("unroll") for (int k = 0; k < 2; ++k) dst[m][k] = *(const PG8_LAS bf16x8*)(lds + PG8_SA(b, h) + aoff + m * 2048 + k * 1024); } while (0)
#define PG8_LDB(dst, b, h) do { _Pragma("unroll") for (int n = 0; n < 2; ++n) _Pragma("unroll") for (int k = 0; k < 2; ++k) dst[n][k] = *(const PG8_LAS bf16x8*)(lds + PG8_SB(b, h) + boff + n * 2048 + k * 1024); } while (0)
#define PG8_MMA(ai, bj, At, Bt) do { __builtin_amdgcn_s_setprio(1); _Pragma("unroll") for (int m = 0; m < 4; ++m) _Pragma("unroll") for (int n = 0; n < 2; ++n) _Pragma("unroll") for (int k = 0; k < 2; ++k) \
        acc[ai][bj][m][n] = __builtin_amdgcn_mfma_f32_16x16x32_bf16(Bt[n][k], At[m][k], acc[ai][bj][m][n], 0, 0, 0); __builtin_amdgcn_s_setprio(0); } while (0)
#define PG8_WAIT_V(n) asm volatile("s_waitcnt vmcnt(" #n ")" ::: "memory")
#define PG8_WAIT_L(n) asm volatile("s_waitcnt lgkmcnt(" #n ")" ::: "memory")
#define PG8_BAR __builtin_amdgcn_s_barrier()
#define PG8_SCHED __builtin_amdgcn_sched_barrier(0)
    Unit cur, nxt; int ui = 0;
    if (!S.next(0, cur)) return;
    f32x4 acc[2][2][4][2];
#pragma unroll
    for (int a = 0; a < 2; ++a)
#pragma unroll
        for (int b = 0; b < 2; ++b)
#pragma unroll
            for (int m = 0; m < 4; ++m)
#pragma unroll
                for (int n = 0; n < 2; ++n) acc[a][b][m][n] = (f32x4){0.f, 0.f, 0.f, 0.f};
    bf16x8 At[4][2], B0[2][2], B1[2][2];
    const char* cA = (const char*)g.A + (size_t)cur.pm * tstep; const char* cB = (const char*)g.Bt + (size_t)cur.pn * tstep;
    S.a_ready(cur);
    if constexpr (SP2) {
        PG8_STAGE(PG8_SB(0, 0), cB, voffB); PG8_STAGE(PG8_SB(0, 1), cB + hstep, voffB); PG8_STAGE(PG8_SA(0, 0), cA, voffA); PG8_STAGE(PG8_SA(0, 1), cA + hstep, voffA);
        if (wr == 1) PG8_BAR;
        PG8_WAIT_V(2); PG8_BAR;
        PG8_STAGE(PG8_SB(1, 0), cB + kstep, voffB); PG8_STAGE(PG8_SA(1, 0), cA + kstep, voffA); PG8_STAGE(PG8_SB(1, 1), cB + hstep + kstep, voffB);
        PG8_WAIT_V(6); PG8_BAR;
    } else {
        PG8_STAGE(PG8_SB(0, 0), cB, voffB); PG8_STAGE(PG8_SA(0, 0), cA, voffA); PG8_STAGE(PG8_SB(0, 1), cB + hstep, voffB); PG8_STAGE(PG8_SA(0, 1), cA + hstep, voffA);
        if (wr == 1) PG8_BAR;
        PG8_WAIT_V(4); PG8_BAR;
        PG8_STAGE(PG8_SB(1, 0), cB + kstep, voffB); PG8_STAGE(PG8_SA(1, 0), cA + kstep, voffA); PG8_STAGE(PG8_SB(1, 1), cB + hstep + kstep, voffB);
        PG8_WAIT_V(6); PG8_BAR;
    }
    for (;;) {
        const bool has_next = S.next(ui + 1, nxt);
        const char* nA = has_next ? (const char*)g.A + (size_t)nxt.pm * tstep : cA; const char* nB = has_next ? (const char*)g.Bt + (size_t)nxt.pn * tstep : cB;
        for (int t = 0; t < nt; t += 2) {
            const bool last = (t == nt - 2);
            const char* a1 = cA + (size_t)(t + 1) * kstep;
            const char* a2 = last ? nA : cA + (size_t)(t + 2) * kstep; const char* b2 = last ? nB : cB + (size_t)(t + 2) * kstep;
            const char* a3 = a2 + kstep; const char* b3 = b2 + kstep;
            if (last && has_next) S.a_ready(nxt);
            if constexpr (SP2) {
            PG8_LDB(B0, 0, 0); PG8_LDB(B1, 0, 1); PG8_SCHED; PG8_LDA(At, 0, 0); PG8_STAGE(PG8_SA(1, 1), a1 + hstep, voffA);
            PG8_WAIT_V(8); PG8_WAIT_L(0); PG8_BAR; PG8_MMA(0, 0, At, B0); PG8_MMA(0, 1, At, B1); PG8_BAR; PG8_SCHED;
            PG8_LDA(At, 0, 1); PG8_STAGE(PG8_SB(0, 0), b2, voffB); PG8_STAGE(PG8_SB(0, 1), b2 + hstep, voffB); PG8_STAGE(PG8_SA(0, 0), a2, voffA);
            PG8_WAIT_V(8); PG8_WAIT_L(0); PG8_BAR; PG8_MMA(1, 0, At, B0); PG8_MMA(1, 1, At, B1); PG8_BAR; PG8_SCHED;
            PG8_LDB(B0, 1, 0); PG8_LDB(B1, 1, 1); PG8_SCHED; PG8_LDA(At, 1, 0); PG8_STAGE(PG8_SA(0, 1), a2 + hstep, voffA);
            PG8_WAIT_V(8); PG8_WAIT_L(0); PG8_BAR; PG8_MMA(0, 0, At, B0); PG8_MMA(0, 1, At, B1); PG8_BAR; PG8_SCHED;
            PG8_LDA(At, 1, 1); PG8_STAGE(PG8_SB(1, 0), b3, voffB); PG8_STAGE(PG8_SB(1, 1), b3 + hstep, voffB); PG8_STAGE(PG8_SA(1, 0), a3, voffA);
            PG8_WAIT_V(8); PG8_WAIT_L(0); PG8_BAR; PG8_MMA(1, 0, At, B0); PG8_MMA(1, 1, At, B1); PG8_BAR; PG8_SCHED;
            } else {
            PG8_LDB(B0, 0, 0); PG8_SCHED; PG8_LDA(At, 0, 0); PG8_STAGE(PG8_SA(1, 1), a1 + hstep, voffA);
            PG8_WAIT_L(8); PG8_BAR; PG8_WAIT_L(0); PG8_MMA(0, 0, At, B0); PG8_BAR; PG8_SCHED;
            PG8_LDB(B1, 0, 1); PG8_STAGE(PG8_SB(0, 0), b2, voffB);
            PG8_BAR; PG8_WAIT_L(0); PG8_MMA(0, 1, At, B1); PG8_BAR;
            PG8_LDA(At, 0, 1); PG8_STAGE(PG8_SA(0, 0), a2, voffA);
            PG8_BAR; PG8_WAIT_L(0); PG8_MMA(1, 0, At, B0); PG8_BAR; PG8_SCHED;
            PG8_STAGE(PG8_SB(0, 1), b2 + hstep, voffB);
            PG8_WAIT_V(6); PG8_BAR; PG8_MMA(1, 1, At, B1); PG8_BAR;
            PG8_LDB(B0, 1, 0); PG8_SCHED; PG8_LDA(At, 1, 0); PG8_STAGE(PG8_SA(0, 1), a2 + hstep, voffA);
            PG8_WAIT_L(8); PG8_BAR; PG8_WAIT_L(0); PG8_MMA(0, 0, At, B0); PG8_BAR; PG8_SCHED;
            PG8_LDB(B1, 1, 1); PG8_STAGE(PG8_SB(1, 0), b3, voffB);
            PG8_BAR; PG8_WAIT_L(0); PG8_MMA(0, 1, At, B1); PG8_BAR;
            PG8_LDA(At, 1, 1); PG8_STAGE(PG8_SA(1, 0), a3, voffA);
            PG8_BAR; PG8_WAIT_L(0); PG8_MMA(1, 0, At, B0); PG8_BAR; PG8_SCHED;
            PG8_STAGE(PG8_SB(1, 1), b3 + hstep, voffB);
            PG8_WAIT_V(6); PG8_BAR; PG8_MMA(1, 1, At, B1); PG8_BAR;
            }
        }
        if constexpr (ALIGN_EPI) { if (wr == 0) PG8_BAR; }
        if constexpr (!Epi::AFTER_DRAIN) { E(acc, cur, wr, wc, fr, fq); S.done(cur); }
        if (!has_next) break;
#pragma unroll
        for (int a = 0; a < 2; ++a)
#pragma unroll
            for (int b = 0; b < 2; ++b)
#pragma unroll
                for (int m = 0; m < 4; ++m)
#pragma unroll
                    for (int n = 0; n < 2; ++n) acc[a][b][m][n] = (f32x4){0.f, 0.f, 0.f, 0.f};
        cur = nxt; cA = nA; cB = nB; ++ui;
        if constexpr (ALIGN_EPI) { if (wr == 1) PG8_BAR; }
    }
    PG8_WAIT_V(0);
    if constexpr (!ALIGN_EPI) { if (wr == 0) PG8_BAR; }
    PG8_BAR;
    if constexpr (Epi::AFTER_DRAIN) { E.fused(acc, cur, wr, wc, fr, fq, lds, wid, lane); S.done(cur); }
#undef PG8_SA
#undef PG8_SB
#undef PG8_STAGE
#undef PG8_LDA
#undef PG8_LDB
#undef PG8_MMA
#undef PG8_WAIT_V
#undef PG8_WAIT_L
#undef PG8_BAR
#undef PG8_SCHED
}
}

constexpr int DM = 2048, NB = 8, SEQ = 4096, NMETA = 16, LSEQ = 4112, LPAD = 4128;
constexpr int MREAL = NB * SEQ;
constexpr int MPAD = MREAL + 256;
constexpr int MT_REAL = MREAL / 256;
constexpr int DFF = 5632, NGU = 2 * DFF, NNG = 7168, NGATE = 8192, INCOLS = 15184, NGC = 6992;
constexpr int NWAVES = 8;
constexpr float EPS = 1e-6f;
constexpr int C_AQ = 0, C_AF = 512, C_AI = 1024, C_AG = 1536, C_BB = 2048, C_BC = 2560, C_BU = 3072, C_CQ = 3584, C_CK = 4096, C_CV = 4608,
              C_DQ = 5120, C_DK = 5632, C_DV = 5760, C_DQI = 5888, C_DKI = 6912, C_DW = 6976;

constexpr size_t MiB = 1u << 20;
constexpr size_t WS_CTL = 0, CTL_ZERO_BYTES = 1 * MiB;
constexpr size_t WS_HM = 1 * MiB;
constexpr size_t WS_W = 4 * MiB;
constexpr size_t W_GU1 = 0, W_D1 = W_GU1 + (size_t)NGU * DM * 2, W_NG = W_D1 + (size_t)DM * DFF * 2, W_G = W_NG + (size_t)NNG * DM * 2,
                 W_BR = W_G + (size_t)NGATE * DM * 2, W_O = W_BR + (size_t)4 * DM * 512 * 2, W_GU2 = W_O + (size_t)DM * DM * 2, W_D2 = W_GU2 + (size_t)NGU * DM * 2,
                 W_END = W_D2 + (size_t)DM * DFF * 2;
constexpr size_t WS_XN = WS_W + W_END;
constexpr size_t WS_BR = WS_XN + (size_t)MPAD * DM * 2;
constexpr size_t WS_BIG = WS_BR + (size_t)MPAD * DM * 2;
constexpr size_t BIG_P_END = (size_t)MPAD * NNG * 2;
constexpr size_t WS_VTC = WS_BIG + BIG_P_END;
constexpr size_t WS_VTD = WS_VTC + (size_t)NB * 4 * 128 * LPAD * 2;
constexpr size_t WS_MASK = WS_VTD + (size_t)NB * 128 * LPAD * 2;
constexpr int MASKW = 132;
constexpr int NIDX_WG = 172;
constexpr int NHG_WG = 32;
constexpr size_t WS_SCR = WS_MASK + (size_t)NB * LPAD * MASKW * 4;
constexpr size_t WS_HA = WS_SCR + (size_t)NIDX_WG * 32 * LPAD * 4;
constexpr size_t WS_HDL = WS_HA + (size_t)NB * 4 * 64 * 64 * 64 * 2;
constexpr size_t WS_HMETA = WS_HDL + (size_t)NB * 4 * 64 * 128 * 4;
constexpr size_t HMETA_STRIDE = 64 * 384 * 2 + 64 * 64 * 2 + 128 * 4;
constexpr size_t WS_END = WS_HMETA + 4 * HMETA_STRIDE;
static_assert(WS_BIG + (size_t)MPAD * NGATE * 2 <= WS_END, "G fits");
static_assert(WS_END <= (size_t)1138174976, "workspace map fits the guaranteed size");

constexpr int RING_OFF = 0, RING_BYTES = 131072;
constexpr int LDSCTL_OFF = 143360, MISC_OFF = LDSCTL_OFF + 320;
constexpr int LDS_BYTES = 147456;

#define GAS __attribute__((address_space(1)))
#define LAS __attribute__((address_space(3)))
typedef unsigned short bf16;
typedef unsigned v4u __attribute__((ext_vector_type(4)));
typedef unsigned v2u __attribute__((ext_vector_type(2)));
typedef float f32x4 __attribute__((ext_vector_type(4)));
typedef float f32x16 __attribute__((ext_vector_type(16)));
typedef short bf16x8 __attribute__((ext_vector_type(8)));
typedef GAS unsigned gu32;
#define RLX_AGENT __ATOMIC_RELAXED, __HIP_MEMORY_SCOPE_AGENT
#define LDS_WAIT() asm volatile("s_waitcnt lgkmcnt(0)" ::: "memory")
#define VM_WAIT() asm volatile("s_waitcnt vmcnt(0)" ::: "memory")
__device__ __forceinline__ unsigned f2bf(float f) { unsigned u = __builtin_bit_cast(unsigned, f); return (u + 0x7fffu + ((u >> 16) & 1u)) >> 16; }
__device__ __forceinline__ unsigned f2bf_s(float f) { return pg8::cvt_pk_bf16(f, 0.f) & 0xffffu; }
__device__ __forceinline__ unsigned pk2(float lo, float hi) { return pg8::cvt_pk_bf16(lo, hi); }
__device__ __forceinline__ float bflo(unsigned w) { return __uint_as_float(w << 16); }
__device__ __forceinline__ float bfhi(unsigned w) { return __uint_as_float(w & 0xffff0000u); }
__device__ __forceinline__ float bf2f(bf16 v) { return __uint_as_float((unsigned)v << 16); }
__device__ __forceinline__ int seqrow(int b, int p) { return p < NMETA ? MREAL + p : b * SEQ + p - NMETA; }
__device__ __forceinline__ int rel_bucket(int n) {
    if (n < 16) return n; if (n >= 128) return 31;
    const int v = 16 + (int)(__log2f((float)n * 0.0625f) * 5.33333333f); return v < 31 ? v : 31; }
__device__ __forceinline__ float wave_sum(float v) {
#pragma unroll
    for (int o = 1; o < 64; o <<= 1) v += __shfl_xor(v, o);
    return v;
}
#define XB_TMO      128
#define XB_XCNT(j)  (256  + 64 * (j))
#define XB_XSUB(j)  (1280 + 64 * (j))
#define XB_XGEN(j)  (2304 + 64 * (j))
#define XB_TOP      3328
#define XB_TOPGEN   3392
#define XCD_BAR_WORDS 3456
#define XB_SPIN_CAP (1u << 18)

__device__ __forceinline__ unsigned xb_ld(unsigned* p)              { return __hip_atomic_load(p, __ATOMIC_RELAXED, __HIP_MEMORY_SCOPE_AGENT); }
__device__ __forceinline__ unsigned xb_add(unsigned* p, unsigned v) { return __hip_atomic_fetch_add(p, v, __ATOMIC_RELAXED, __HIP_MEMORY_SCOPE_AGENT); }
__device__ __forceinline__ unsigned xb_xcc_id() { return (unsigned)__builtin_amdgcn_s_getreg((3 << 11) | 20) & 0xFu; }
#define XB_SPIN(cond, bar) do { unsigned _sp = 0; while (cond) { __builtin_amdgcn_s_sleep(1); \
    if ((++_sp & 255u) == 0u) { if (xb_ld(&(bar)[XB_TMO])) break; if (_sp > XB_SPIN_CAP) { atomicAdd(&(bar)[XB_TMO], 1u); break; } } } } while (0)

struct XcdBarrier {
    int wave;
    unsigned* bar; unsigned x;
    volatile LAS unsigned* st;
};

__device__ __forceinline__ bool xb_thread0(int wave) { unsigned mk = ~0u; asm volatile("" : "+s"(mk)); return wave == 0 && __builtin_amdgcn_mbcnt_hi(mk, __builtin_amdgcn_mbcnt_lo(mk, 0u)) == 0u; }
__device__ __forceinline__ XcdBarrier xcd_barrier_post(unsigned* bar, volatile LAS unsigned* st, int wave) {
    XcdBarrier b; b.wave = wave; b.bar = bar; b.x = xb_xcc_id(); b.st = st;
    if (xb_thread0(wave)) (void)xb_add(&bar[XB_XCNT(b.x)], 1u);
    return b;
}
__device__ __forceinline__ void xcd_barrier_complete(unsigned* bar, unsigned x, unsigned& nloc, unsigned& nx) {
    const unsigned G = gridDim.x * gridDim.y * gridDim.z;
    unsigned sum, cnt, mine, sp = 0u;
    for (;;) {
        sum = 0u; cnt = 0u; mine = 0u;
#pragma unroll
        for (unsigned j = 0; j < 16; ++j) { const unsigned c = xb_ld(&bar[XB_XCNT(j)]); sum += c; cnt += (c > 0u) ? 1u : 0u; mine = (j == x) ? c : mine; }
        if (sum == G) break;
        __builtin_amdgcn_s_sleep(1);
        if ((++sp & 255u) == 0u) { if (xb_ld(&bar[XB_TMO])) break; if (sp > XB_SPIN_CAP) { atomicAdd(&bar[XB_TMO], 1u); break; } }
    }
    nloc = mine > 0u ? mine : 1u; nx = cnt > 0u ? cnt : 1u;
}

__device__ __forceinline__ void xcd_barrier(const XcdBarrier& b) {
    asm volatile("s_waitcnt vmcnt(0)" ::: "memory");
    __syncthreads();
    if (xb_thread0(b.wave)) {
        unsigned* bar = b.bar;
        __builtin_amdgcn_s_waitcnt(0);
        unsigned nloc = b.st[0], nx = b.st[1];
        if (nloc == 0u) { xcd_barrier_complete(bar, b.x, nloc, nx); b.st[0] = nloc; b.st[1] = nx; }
        const unsigned old = xb_add(&bar[XB_XSUB(b.x)], 1u);
        const unsigned gen = old / nloc;
        if (old + 1u == (gen + 1u) * nloc) {
            __builtin_amdgcn_fence(__ATOMIC_RELEASE, "agent");
            asm volatile("s_waitcnt vmcnt(0)" ::: "memory");
            const unsigned og = xb_add(&bar[XB_TOP], 1u);
            const unsigned tg = og / nx;
            if (og + 1u == (tg + 1u) * nx) xb_add(&bar[XB_TOPGEN], 1u);
            else XB_SPIN(xb_ld(&bar[XB_TOPGEN]) == tg, bar);
            __builtin_amdgcn_fence(__ATOMIC_ACQUIRE, "agent");
            xb_add(&bar[XB_XGEN(b.x)], 1u);
            asm volatile("s_waitcnt vmcnt(0)" ::: "memory");
        } else {
            XB_SPIN(xb_ld(&bar[XB_XGEN(b.x)]) == gen, bar);
            __builtin_amdgcn_fence(__ATOMIC_ACQUIRE, "agent");
            asm volatile("s_waitcnt vmcnt(0)" ::: "memory");
        }
    }
    __syncthreads();
}

struct Frame {
    LAS unsigned char* lds;
    volatile LAS unsigned* MISC;
    gu32* ctl;
    int tid, lane, wave, G, bid;
    const unsigned char __attribute__((address_space(4)))* karg; float* out; unsigned char* ws;
};
__device__ __forceinline__ const float* fin_load(const unsigned char __attribute__((address_space(4)))* k, int i) { asm volatile("" : "+s"(k)); return *(const float* const __attribute__((address_space(4)))*)(k + 8 * i); }
#define FIN(F_, i_) fin_load((F_).karg, (i_))
enum { I_X = 0, I_META, I_RELB, I_F1N, I_F1GU, I_F1D, I_MIXN, I_WIN, I_LB, I_GN, I_CONVW, I_DQN, I_DKN, I_DLAM, I_DSUB, I_SQN, I_SKN, I_WBR, I_WOUT, I_F2N, I_F2GU, I_F2D };

template <class RowMap>
__device__ __forceinline__ void transpose_item(const float* W, int K, int N, bf16* WT, LAS float* scr, int item, int lane, RowMap rm) {
    const int nblk = (N + 31) / 32, kb = item / nblk, nb = item % nblk, k0 = 64 * kb, n0 = 32 * nb;
    const int nl = n0 + (lane & 31); const bool nok = nl < N;
    { float wv[32]; const float* wp = W + (size_t)(k0 + (lane >> 5)) * N + (nok ? nl : 0);
#pragma unroll
      for (int i = 0; i < 32; ++i) wv[i] = wp[(size_t)(2 * i) * N];
      __builtin_amdgcn_sched_barrier(0);
#pragma unroll
      for (int i = 0; i < 32; ++i) scr[(2 * i + (lane >> 5)) * 33 + (lane & 31)] = nok ? wv[i] : 0.f; }
    LDS_WAIT(); asm volatile("" ::: "memory");
    const int c = lane & 7;
#pragma unroll
    for (int j = 0; j < 4; ++j) { const int n = (lane >> 3) + 8 * j; const LAS float* s = scr + (8 * c) * 33 + n;
        v4u o; o.x = pk2(s[0 * 33], s[1 * 33]); o.y = pk2(s[2 * 33], s[3 * 33]); o.z = pk2(s[4 * 33], s[5 * 33]); o.w = pk2(s[6 * 33], s[7 * 33]);
        if (n0 + n < N) *(GAS v4u*)(WT + (size_t)rm(n0 + n) * K + k0 + 8 * c) = o; }
    LDS_WAIT(); asm volatile("" ::: "memory");
}
struct MapId { __device__ __forceinline__ int operator()(int n) const { return n; } };
struct MapGU { __device__ __forceinline__ int operator()(int n) const { const int up = n >= DFF, j = up ? n - DFF : n; return 256 * (j >> 7) + 128 * up + (j & 127); } };
struct MapIn { __device__ __forceinline__ int operator()(int n) const { return n < NGC ? n : n + (NNG - NGC); } };
template <class RowMap>
__device__ __forceinline__ void convert_matrix(Frame& F, const float* W, int K, int N, bf16* WT, RowMap rm) {
    LAS float* scr = (LAS float*)(F.lds + F.wave * 16384);
    const int gw = F.bid * NWAVES + F.wave, NGW = F.G * NWAVES, nitems = (K / 64) * ((N + 31) / 32);
    for (int it = gw; it < nitems; it += NGW) transpose_item(W, K, N, WT, scr, it, F.lane, rm);
}
__device__ __forceinline__ void phase_convert(Frame& F, int l) {
    unsigned char* wb = F.ws + WS_W;
    convert_matrix(F, FIN(F, I_F1GU) + (size_t)l * DM * NGU, DM, NGU, (bf16*)(wb + W_GU1), MapGU());
    convert_matrix(F, FIN(F, I_F1D) + (size_t)l * DFF * DM, DFF, DM, (bf16*)(wb + W_D1), MapId());
    convert_matrix(F, FIN(F, I_WIN) + (size_t)l * DM * INCOLS, DM, INCOLS, (bf16*)(wb + W_NG), MapIn());
    for (int m = 0; m < 4; ++m) convert_matrix(F, FIN(F, I_WBR) + ((size_t)l * 4 + m) * 512 * DM, 512, DM, (bf16*)(wb + W_BR) + (size_t)m * DM * 512, MapId());
    convert_matrix(F, FIN(F, I_WOUT) + (size_t)l * DM * DM, DM, DM, (bf16*)(wb + W_O), MapId());
    convert_matrix(F, FIN(F, I_F2GU) + (size_t)l * DM * NGU, DM, NGU, (bf16*)(wb + W_GU2), MapGU());
    convert_matrix(F, FIN(F, I_F2D) + (size_t)l * DFF * DM, DFF, DM, (bf16*)(wb + W_D2), MapId());
    { GAS v4u* z = (GAS v4u*)(wb + W_NG + (size_t)NGC * DM * 2); const int n16 = (NNG - NGC) * DM * 2 / 16;
      for (int i = F.bid * 512 + F.tid; i < n16; i += F.G * 512) z[i] = (v4u){0u, 0u, 0u, 0u}; }
    if (l == 0) {
        GAS f32x4* hm = (GAS f32x4*)(F.ws + WS_HM); const GAS f32x4* mt = (const GAS f32x4*)FIN(F, I_META);
        for (int i = F.bid * 512 + F.tid; i < 256 * DM / 4; i += F.G * 512) hm[i] = (i < NMETA * DM / 4) ? mt[i] : (f32x4){0.f, 0.f, 0.f, 0.f};
    }
}
__device__ __forceinline__ void phase_norm(Frame& F, const float* src_real, const float* gain) {
    const int gw = F.bid * NWAVES + F.wave, NGW = F.G * NWAVES;
    bf16* XN = (bf16*)(F.ws + WS_XN); const float* hm = (const float*)(F.ws + WS_HM);
    f32x4 g[8];
#pragma unroll
    for (int j = 0; j < 8; ++j) g[j] = ((const GAS f32x4*)gain)[F.lane + 64 * j];
    for (int r = gw; r < MPAD; r += NGW) {
        GAS v2u* o8 = (GAS v2u*)(XN + (size_t)r * DM) + F.lane;
        if (r >= MREAL + NMETA) {
#pragma unroll
            for (int j = 0; j < 8; ++j) o8[64 * j] = (v2u){0u, 0u};
            continue; }
        const float* xr = r < MREAL ? src_real + (size_t)r * DM : hm + (size_t)(r - MREAL) * DM;
        f32x4 v[8]; float s = 0.f;
#pragma unroll
        for (int j = 0; j < 8; ++j) { v[j] = ((const GAS f32x4*)xr)[F.lane + 64 * j]; s += (v[j].x * v[j].x + v[j].y * v[j].y) + (v[j].z * v[j].z + v[j].w * v[j].w); }
        const float inv = 1.0f / sqrtf(wave_sum(s) * (1.f / DM) + EPS);
#pragma unroll
        for (int j = 0; j < 8; ++j) { v2u w; w.x = pk2(v[j].x * inv * g[j].x, v[j].y * inv * g[j].y); w.y = pk2(v[j].z * inv * g[j].z, v[j].w * inv * g[j].w); o8[64 * j] = w; }
    }
}

__device__ __forceinline__ f32x4 meta_dot16(const bf16* A  , int lda, const bf16* Bt  , int K, int s0, int s1, int lane) {
    const int fr = lane & 15, g = lane >> 4; const bf16* ap = A + (size_t)fr * lda + 8 * g; const bf16* bp = Bt + (size_t)fr * K + 8 * g;
    f32x4 a0 = (f32x4){0.f, 0.f, 0.f, 0.f}, a1 = a0;
    for (int s = s0; s < s1; s += 2) {
        const bf16x8 x0 = *(const GAS bf16x8*)(ap + 32 * s), x1 = *(const GAS bf16x8*)(ap + 32 * s + 32);
        const bf16x8 w0 = *(const GAS bf16x8*)(bp + 32 * s), w1 = *(const GAS bf16x8*)(bp + 32 * s + 32);
        a0 = __builtin_amdgcn_mfma_f32_16x16x32_bf16(w0, x0, a0, 0, 0, 0); a1 = __builtin_amdgcn_mfma_f32_16x16x32_bf16(w1, x1, a1, 0, 0, 0); }
    return a0 + a1;
}
__device__ __forceinline__ void st_bf16x4(bf16* p, f32x4 v) { v2u w; w.x = pk2(v[0], v[1]); w.y = pk2(v[2], v[3]); *(GAS v2u*)p = w; }
__device__ __forceinline__ void meta_gemm(Frame& F, int kind, const bf16* A, int lda, const bf16* Bt, int N, int K, bf16* Obf, int ldo, float scale) {
    const int lane = F.lane, wave = F.wave, fr = lane & 15, g = lane >> 4;
    const int ngroups = (kind == 0 ? N / 2 : N) / 16;
    LAS f32x4* red = (LAS f32x4*)F.lds;
    const int ns = K / 32, s0 = (wave * ns) >> 3, s1 = ((wave + 1) * ns) >> 3;
    for (int cg = F.bid; cg < ngroups; cg += F.G) {
        const int n0 = 16 * cg;
        f32x4 p0, p1 = (f32x4){0.f, 0.f, 0.f, 0.f};
        if (kind == 0) { const int rg = 256 * (n0 >> 7) + (n0 & 127);
            p0 = meta_dot16(A, lda, Bt + (size_t)rg * K, K, s0, s1, lane); p1 = meta_dot16(A, lda, Bt + (size_t)(rg + 128) * K, K, s0, s1, lane); }
        else if (kind == 4) { const int mb = wave >> 1, kh = wave & 1; p0 = meta_dot16(A + (size_t)mb * MPAD * 512, 512, Bt + ((size_t)mb * DM + n0) * 512, 512, 8 * kh, 8 * kh + 8, lane); }
        else p0 = meta_dot16(A, lda, Bt + (size_t)n0 * K, K, s0, s1, lane);
        red[wave * 64 + lane] = p0; if (kind == 0) red[512 + wave * 64 + lane] = p1;
        LDS_WAIT(); __syncthreads();
        if (wave == 0) {
            f32x4 q[8];
#pragma unroll
            for (int w = 0; w < 8; ++w) q[w] = red[w * 64 + lane];
            if (kind == 4) { f32x4 tot = (f32x4){0.f, 0.f, 0.f, 0.f}; const bf16* G = (const bf16*)(F.ws + WS_BIG);
#pragma unroll
                for (int mb = 0; mb < 4; ++mb) { const f32x4 acc = q[2 * mb] + q[2 * mb + 1]; const v2u gw2 = *(const GAS v2u*)(G + (size_t)(MREAL + fr) * NGATE + mb * DM + n0 + 4 * g);
                    tot[0] += bflo(gw2.x) * acc[0]; tot[1] += bfhi(gw2.x) * acc[1]; tot[2] += bflo(gw2.y) * acc[2]; tot[3] += bfhi(gw2.y) * acc[3]; }
                st_bf16x4(Obf + (size_t)(MREAL + fr) * ldo + n0 + 4 * g, tot);
            } else {
                f32x4 acc = ((q[0] + q[1]) + (q[2] + q[3])) + ((q[4] + q[5]) + (q[6] + q[7]));
                if (kind == 0) { f32x4 up = (f32x4){0.f, 0.f, 0.f, 0.f};
#pragma unroll
                    for (int w = 0; w < 8; ++w) up += red[512 + w * 64 + lane];
#pragma unroll
                    for (int r = 0; r < 4; ++r) acc[r] = pg8::fast_silu(acc[r]) * up[r];
                    st_bf16x4(Obf + (size_t)(MREAL + fr) * ldo + n0 + 4 * g, acc); }
                else if (kind == 1) { float* hp = (float*)(F.ws + WS_HM) + (size_t)fr * DM + n0 + 4 * g; *(GAS f32x4*)hp = *(const GAS f32x4*)hp + acc * scale; }
                else if (kind == 2) st_bf16x4(Obf + (size_t)(MREAL + fr) * ldo + n0 + 4 * g, acc);
                else {
#pragma unroll
                    for (int r = 0; r < 4; ++r) acc[r] = pg8::fast_sigmoid(acc[r]);
                    st_bf16x4(Obf + (size_t)(MREAL + fr) * ldo + n0 + 4 * g, acc); }
            }
        }
        __syncthreads();
    }
}
__device__ __forceinline__ void unpack8(const v4u w, float (&x)[8]) { x[0] = bflo(w.x); x[1] = bfhi(w.x); x[2] = bflo(w.y); x[3] = bfhi(w.y); x[4] = bflo(w.z); x[5] = bfhi(w.z); x[6] = bflo(w.w); x[7] = bfhi(w.w); }
__device__ __forceinline__ v4u pack8(const float (&x)[8]) { v4u w; w.x = pk2(x[0], x[1]); w.y = pk2(x[2], x[3]); w.z = pk2(x[4], x[5]); w.w = pk2(x[6], x[7]); return w; }
template <int GL>
__device__ __forceinline__ void norm_cols_inplace(bf16* p, const v4u w, const float* gain, float scale, int lane, bool wr) {
    float x[8]; unpack8(w, x); float s = 0.f;
#pragma unroll
    for (int i = 0; i < 8; ++i) s += x[i] * x[i];
#pragma unroll
    for (int o = 1; o < GL; o <<= 1) s += __shfl_xor(s, o);
    const float inv = scale / sqrtf(s * (1.f / (GL * 8)) + EPS); const int g0 = (8 * lane) % (GL * 8);
#pragma unroll
    for (int i = 0; i < 8; ++i) x[i] = x[i] * inv * gain[g0 + i];
    if (wr) *(GAS v4u*)p = pack8(x);
}
__device__ __forceinline__ void prep_row(Frame& F, int l, int r) {
    const int lane = F.lane; bf16* pr = (bf16*)(F.ws + WS_BIG) + (size_t)r * NNG;
    const float *dqn = FIN(F, I_DQN) + l * 64, *dkn = FIN(F, I_DKN) + l * 64, *sqn = FIN(F, I_SQN) + l * 128, *skn = FIN(F, I_SKN) + l * 128;
    const v4u w0 = *(const GAS v4u*)(pr + C_CQ + 8 * lane), w1 = *(const GAS v4u*)(pr + C_CK + 8 * lane), w2 = *(const GAS v4u*)(pr + C_DQ + 8 * lane), w3 = *(const GAS v4u*)(pr + C_DK + 8 * (lane & 15));
    __builtin_amdgcn_sched_barrier(0);
    norm_cols_inplace<8>(pr + C_CQ + 8 * lane, w0, dqn, 0.125f * 1.4426950408889634f, lane, true);
    norm_cols_inplace<8>(pr + C_CK + 8 * lane, w1, dkn, 1.0f, lane, true);
    norm_cols_inplace<16>(pr + C_DQ + 8 * lane, w2, sqn, 0.08838834764831845f * 1.4426950408889634f, lane, true);
    norm_cols_inplace<16>(pr + C_DK + 8 * (lane & 15), w3, skn, 1.0f, lane & 15, lane < 16);
}
constexpr int VT_NPB = (LPAD + 63) / 64, VT_NTASK = NB * 5 * VT_NPB;
__device__ __forceinline__ void vt_task(Frame& F, int task) {
    const int lane = F.lane;
    const bf16* P = (const bf16*)(F.ws + WS_BIG); bf16* VtC = (bf16*)(F.ws + WS_VTC); bf16* VtD = (bf16*)(F.ws + WS_VTD);
    LAS bf16* T = (LAS bf16*)(F.lds + F.wave * 17408);
    const int pb = task % VT_NPB, mat = (task / VT_NPB) % 5, b = task / (VT_NPB * 5), p0 = 64 * pb;
    const int col = mat < 4 ? C_CV + 128 * mat : C_DV;
#pragma unroll 4
    for (int i = 0; i < 16; ++i) { const int pl = 4 * i + (lane >> 4), p = p0 + pl;
        v4u w = *(const GAS v4u*)(P + (size_t)seqrow(b, p < LSEQ ? p : LSEQ - 1) * NNG + col + 8 * (lane & 15)); if (p >= LSEQ) w = (v4u){0u, 0u, 0u, 0u};
        *(LAS v4u*)(T + pl * 136 + 8 * (lane & 15)) = w; }
    LDS_WAIT(); asm volatile("" ::: "memory");
    bf16* dst = mat < 4 ? VtC + (size_t)(b * 4 + mat) * 128 * LPAD : VtD + (size_t)b * 128 * LPAD;
#pragma unroll 4
    for (int it = 0; it < 16; ++it) { const int e = 8 * it + (lane >> 3), c = lane & 7; unsigned short x[8];
#pragma unroll
        for (int k = 0; k < 8; ++k) x[k] = T[(8 * c + k) * 136 + e];
        v4u w; w.x = x[0] | ((unsigned)x[1] << 16); w.y = x[2] | ((unsigned)x[3] << 16); w.z = x[4] | ((unsigned)x[5] << 16); w.w = x[6] | ((unsigned)x[7] << 16);
        if (p0 + 8 * c < LPAD) *(GAS v4u*)(dst + (size_t)e * LPAD + p0 + 8 * c) = w; }
    LDS_WAIT(); asm volatile("" ::: "memory");
}

#define NEG_INF (-__builtin_inff())
constexpr int NQT = (LSEQ + 31) / 32;
constexpr int NQB = (NQT + 7) / 8;
__device__ __forceinline__ bf16x8 ld_frag16(const bf16* p) { return *(const GAS bf16x8*)p; }
__device__ __forceinline__ bf16x8 mk_frag(v2u lo, v2u hi) { v4u w; w.x = lo.x; w.y = lo.y; w.z = hi.x; w.w = hi.y; return __builtin_bit_cast(bf16x8, w); }
__device__ __forceinline__ unsigned cvtpk(float lo, float hi) { return pg8::cvt_pk_bf16(lo, hi); }
__device__ __forceinline__ void build_bias_table(Frame& F, LAS float* bt, int col0) {
    const float* rb = FIN(F, I_RELB);
    for (int i = F.tid; i < 4 * 128; i += 512) { const int hd = i >> 7, n = i & 127; bt[i] = (rb[rel_bucket(n) * 8 + col0 + hd] - rb[31 * 8 + col0 + hd]) * 1.4426950408889634f; }
}
__device__ __forceinline__ bool softmax_step(f32x16& S, float& m, float& lsum, float& alpha) {
    float tm = S[0];
#pragma unroll
    for (int r = 1; r < 16; ++r) tm = fmaxf(tm, S[r]);
    const bool raise = __any(tm > m + 11.5f);
    alpha = 1.0f;
    if (raise) { tm = fmaxf(tm, __shfl_xor(tm, 32)); const float mn = fmaxf(m, tm); alpha = (mn == NEG_INF) ? 1.0f : __builtin_amdgcn_exp2f(m - mn); m = mn; lsum *= alpha; }
    const float mref = (m == NEG_INF) ? 0.f : m;
    float rs = 0.f;
#pragma unroll
    for (int r = 0; r < 16; ++r) { S[r] = __builtin_amdgcn_exp2f(S[r] - mref); rs += S[r]; }
    lsum += rs;
    return raise;
}
template <bool DSA>
__device__ __forceinline__ void attn_wg_task(Frame& F, int l, int b, int h, int J, const LAS float* bt, float lam, float post) {
    constexpr int KD = DSA ? 128 : 64, KP = KD + 8, VP = 36, NKS = KD / 16;
    constexpr int KBUF = 32 * KP, VBUF = 128 * VP;
    const int lane = F.lane, ql = lane & 31, hh = lane >> 5, wave = F.wave, tid = F.tid;
    LAS bf16* Kl = (LAS bf16*)F.lds; LAS bf16* Vl = Kl + 2 * KBUF;
    const bf16* P = (const bf16*)(F.ws + WS_BIG);
    const bf16* Vt = DSA ? (const bf16*)(F.ws + WS_VTD) + (size_t)b * 128 * LPAD : (const bf16*)(F.ws + WS_VTC) + (size_t)(b * 4 + h) * 128 * LPAD;
    const int jr = 8 * J + wave - 7; const bool wvalid = jr >= 0 && 32 * jr < LSEQ; const int j = jr < 0 ? 0 : jr;
    const int ktmax = (8 * J < NQT - 1) ? 8 * J : NQT - 1;
    const int pq = 32 * j + ql, pqc = pq < LSEQ ? pq : LSEQ - 1;
    const bf16* qrow = P + (size_t)seqrow(b, pqc) * NNG + (DSA ? C_DQ : C_CQ) + h * 128 + 8 * hh;
    const unsigned* mrow = (const unsigned*)(F.ws + WS_MASK) + ((size_t)b * LPAD + pqc) * MASKW;
    const int kr = tid / (KD / 8), kc = tid % (KD / 8); const bool kload = tid < 32 * (KD / 8);
    const int vr = tid >> 2, vc = tid & 3;
    f32x16 R[4];
#pragma unroll
    for (int c = 0; c < (DSA ? 1 : 2); ++c) {
        const int kcol = DSA ? C_DK : C_CK + h * 128 + c * 64;
        bf16x8 qf[NKS];
#pragma unroll
        for (int ks = 0; ks < NKS; ++ks) qf[ks] = ld_frag16(qrow + (DSA ? 0 : c * 64) + 16 * ks);
        float m = NEG_INF, lsum = 0.f; f32x16 O[4];
#pragma unroll
        for (int eb = 0; eb < 4; ++eb)
#pragma unroll
            for (int r = 0; r < 16; ++r) O[eb][r] = 0.f;
        v4u rk0 = (v4u){0u, 0u, 0u, 0u}, rv0 = rk0, rk1 = rk0, rv1 = rk0;
#define ATT_ISSUE(kt_, RK, RV) do { int pk_ = 32 * (kt_) + kr; pk_ = pk_ < LSEQ ? pk_ : LSEQ - 1; \
            if (kload) RK = *(const GAS v4u*)(P + (size_t)seqrow(b, pk_) * NNG + kcol + 8 * kc); \
            RV = *(const GAS v4u*)(Vt + (size_t)vr * LPAD + 32 * (kt_) + 8 * vc); } while (0)
#define ATT_COMMIT(buf_, RK, RV) do { if (kload) *(LAS v4u*)(Kl + (buf_) * KBUF + kr * KP + 8 * kc) = RK; \
            LAS v2u* vd_ = (LAS v2u*)(Vl + (buf_) * VBUF + vr * VP + 8 * vc); vd_[0] = (v2u){RV.x, RV.y}; vd_[1] = (v2u){RV.z, RV.w}; } while (0)
        unsigned mwc = 0xffffffffu, mwn = 0xffffffffu; if (DSA) mwc = mrow[0];
        auto compute = [&](int kt, int buf) {
            if (DSA) mwn = mrow[kt + 1 <= ktmax ? kt + 1 : ktmax];
            if (wvalid && kt <= j) {
                const LAS bf16* Kt = Kl + buf * KBUF + ql * KP + 8 * hh; const LAS bf16* Vb = Vl + buf * VBUF + ql * VP + 4 * hh;
                f32x16 S;
#pragma unroll
                for (int r = 0; r < 16; ++r) S[r] = 0.f;
#pragma unroll
                for (int ks = 0; ks < NKS; ++ks) S = __builtin_amdgcn_mfma_f32_32x32x16_bf16(*(const LAS bf16x8*)(Kt + 16 * ks), qf[ks], S, 0, 0, 0);
                const unsigned mw = mwc >> (4 * hh);
                if (kt + 4 >= j) {
#pragma unroll
                    for (int r = 0; r < 16; ++r) { const int ko = (r & 3) + 8 * (r >> 2), n = pq - (32 * kt + 4 * hh + ko); const bool sel = ((mw >> ko) & 1u) && n >= 0;
                        S[r] = sel ? S[r] + bt[h * 128 + (n < 127 ? n : 127)] : NEG_INF; }
                } else if (DSA) {
#pragma unroll
                    for (int r = 0; r < 16; ++r) { const int ko = (r & 3) + 8 * (r >> 2); S[r] = ((mw >> ko) & 1u) ? S[r] : NEG_INF; }
                }
                float alpha;
                if (softmax_step(S, m, lsum, alpha)) {
#pragma unroll
                    for (int eb = 0; eb < 4; ++eb)
#pragma unroll
                        for (int r = 0; r < 16; ++r) O[eb][r] *= alpha;
                }
                bf16x8 pf[2];
#pragma unroll
                for (int s = 0; s < 2; ++s) { v4u w; w.x = cvtpk(S[8 * s + 0], S[8 * s + 1]); w.y = cvtpk(S[8 * s + 2], S[8 * s + 3]); w.z = cvtpk(S[8 * s + 4], S[8 * s + 5]); w.w = cvtpk(S[8 * s + 6], S[8 * s + 7]); pf[s] = __builtin_bit_cast(bf16x8, w); }
#pragma unroll
                for (int eb = 0; eb < 4; ++eb)
#pragma unroll
                    for (int s = 0; s < 2; ++s) { const LAS bf16* vp = Vb + eb * 32 * VP + 16 * s;
                        O[eb] = __builtin_amdgcn_mfma_f32_32x32x16_bf16(mk_frag(*(const LAS v2u*)vp, *(const LAS v2u*)(vp + 8)), pf[s], O[eb], 0, 0, 0); }
            }
            if (DSA) mwc = mwn; };
        __syncthreads();
        ATT_ISSUE(0, rk0, rv0); ATT_COMMIT(0, rk0, rv0);
        if (ktmax >= 1) ATT_ISSUE(1, rk1, rv1);
        for (int kt = 0; kt <= ktmax; kt += 2) {
            LDS_WAIT(); __syncthreads();
            if (kt + 2 <= ktmax) ATT_ISSUE(kt + 2, rk0, rv0);
            compute(kt, 0);
            if (kt + 1 <= ktmax) ATT_COMMIT(1, rk1, rv1);
            if (kt + 1 > ktmax) break;
            LDS_WAIT(); __syncthreads();
            if (kt + 3 <= ktmax) ATT_ISSUE(kt + 3, rk1, rv1);
            compute(kt + 1, 1);
            if (kt + 2 <= ktmax) ATT_COMMIT(0, rk0, rv0);
        }
#undef ATT_ISSUE
#undef ATT_COMMIT
        lsum += __shfl_xor(lsum, 32); const float il = 1.0f / lsum;
        if (DSA) {
#pragma unroll
            for (int eb = 0; eb < 4; ++eb)
#pragma unroll
                for (int r = 0; r < 16; ++r) R[eb][r] = O[eb][r] * il;
        } else if (c == 0) {
            LAS unsigned* rp = (LAS unsigned*)(F.lds + 28672) + wave * 2048 + lane;
#pragma unroll
            for (int eb = 0; eb < 4; ++eb)
#pragma unroll
                for (int r = 0; r < 16; r += 2) rp[(eb * 8 + (r >> 1)) * 64] = pk2(O[eb][r] * il, O[eb][r + 1] * il);
        } else {
            const LAS unsigned* rp = (const LAS unsigned*)(F.lds + 28672) + wave * 2048 + lane;
#pragma unroll
            for (int eb = 0; eb < 4; ++eb)
#pragma unroll
                for (int r = 0; r < 16; r += 2) { const unsigned w = rp[(eb * 8 + (r >> 1)) * 64]; R[eb][r] = bflo(w) - lam * (O[eb][r] * il); R[eb][r + 1] = bfhi(w) - lam * (O[eb][r + 1] * il); }
        }
    }
    float inv = 1.0f;
    if (!DSA) { float ss = 0.f;
#pragma unroll
        for (int eb = 0; eb < 4; ++eb)
#pragma unroll
            for (int r = 0; r < 16; ++r) ss += R[eb][r] * R[eb][r];
        ss += __shfl_xor(ss, 32); inv = post / sqrtf(ss * (1.f / 128.f) + EPS); }
    const float* sub = FIN(F, I_DSUB) + l * 128;
    if (wvalid && pq < LSEQ && (pq >= NMETA || b == 0)) {
        bf16* orow = (bf16*)(F.ws + WS_BR) + (size_t)(DSA ? 3 : 2) * MPAD * 512 + (size_t)seqrow(b, pq) * 512 + h * 128;
#pragma unroll
        for (int eb = 0; eb < 4; ++eb)
#pragma unroll
            for (int g = 0; g < 4; ++g) { const int e0 = 32 * eb + 8 * g + 4 * hh; f32x4 sv = (f32x4){1.f, 1.f, 1.f, 1.f}; if (!DSA) sv = *(const GAS f32x4*)(sub + e0);
                v2u w; w.x = pk2(R[eb][4 * g] * inv * sv.x, R[eb][4 * g + 1] * inv * sv.y); w.y = pk2(R[eb][4 * g + 2] * inv * sv.z, R[eb][4 * g + 3] * inv * sv.w);
                *(GAS v2u*)(orow + e0) = w; }
    }
}
__device__ __forceinline__ unsigned f32_key(float f) { const unsigned u = __float_as_uint(f); return u ^ ((u >> 31) ? 0xffffffffu : 0x80000000u); }
__device__ __forceinline__ void dsa_index_task(Frame& F, int b, int j, float* slab) {
    const int lane = F.lane, ql = lane & 31, hh = lane >> 5, wave = F.wave;
    const bf16* P = (const bf16*)(F.ws + WS_BIG);
    LAS unsigned char* qi = F.lds;
    for (int i = F.tid; i < 32 * 128; i += 512) { const int q = i >> 7, ch = i & 127; int pq = 32 * j + q; pq = pq < LSEQ ? pq : LSEQ - 1;
        *(LAS v4u*)(qi + q * 2064 + 16 * ch) = *(const GAS v4u*)(P + (size_t)seqrow(b, pq) * NNG + C_DQI + 8 * ch); }
    LAS float* wl = (LAS float*)(qi + 32 * 2064);
    if (F.tid < 32 * 16) { const int q = F.tid >> 4, hd = F.tid & 15; int pq = 32 * j + q; pq = pq < LSEQ ? pq : LSEQ - 1;
        wl[F.tid] = bf2f(P[(size_t)seqrow(b, pq) * NNG + C_DW + hd]) * 0.03125f; }
    LAS unsigned* hist = (LAS unsigned*)(F.lds + 73728);
    for (int i = F.tid; i < 32 * 256; i += 512) hist[i] = 0u;
    LDS_WAIT(); __syncthreads();
#ifndef PROBE_SUB
#define PROBE_SUB 0
#endif
    for (int rpa = 0; rpa < ((PROBE_SUB & 8) ? 2 : 1); ++rpa)
    {
    bf16x8 kn[4];
    { const int pk = 32 * wave + ql, pkc = pk < LSEQ ? pk : LSEQ - 1; const bf16* krow = P + (size_t)seqrow(b, pkc) * NNG + C_DKI + 8 * hh;
#pragma unroll
      for (int ks = 0; ks < 4; ++ks) kn[ks] = ld_frag16(krow + 16 * ks); }
    for (int kt = wave; kt <= j; kt += NWAVES) {
        bf16x8 kf[4];
#pragma unroll
        for (int ks = 0; ks < 4; ++ks) kf[ks] = kn[ks];
        { const int ktn = kt + NWAVES <= j ? kt + NWAVES : kt; const int pk = 32 * ktn + ql, pkc = pk < LSEQ ? pk : LSEQ - 1; const bf16* krow = P + (size_t)seqrow(b, pkc) * NNG + C_DKI + 8 * hh;
#pragma unroll
          for (int ks = 0; ks < 4; ++ks) kn[ks] = ld_frag16(krow + 16 * ks); }
        f32x16 idx;
#pragma unroll
        for (int r = 0; r < 16; ++r) idx[r] = 0.f;
#pragma unroll 1
        for (int hd = 0; hd < 16; hd += 2) { f32x16 S0, S1; const float wh0 = wl[ql * 16 + hd], wh1 = wl[ql * 16 + hd + 1];
#pragma unroll
            for (int r = 0; r < 16; ++r) { S0[r] = 0.f; S1[r] = 0.f; }
#pragma unroll
            for (int ks = 0; ks < 4; ++ks) { S0 = __builtin_amdgcn_mfma_f32_32x32x16_bf16(kf[ks], *(const LAS bf16x8*)(qi + ql * 2064 + hd * 128 + 32 * ks + 16 * hh), S0, 0, 0, 0);
                S1 = __builtin_amdgcn_mfma_f32_32x32x16_bf16(kf[ks], *(const LAS bf16x8*)(qi + ql * 2064 + (hd + 1) * 128 + 32 * ks + 16 * hh), S1, 0, 0, 0); }
#pragma unroll
            for (int r = 0; r < 16; ++r) idx[r] += wh0 * fmaxf(S0[r], 0.f) + wh1 * fmaxf(S1[r], 0.f); }
        { const int pqh = 32 * j + ql;
#pragma unroll
          for (int r = 0; r < 16; ++r) { const int kp = 32 * kt + 4 * hh + (r & 3) + 8 * (r >> 2);
              int bn = (int)__builtin_floorf(__builtin_fmaf(idx[r], 32.f, 256.f)); bn = bn < 0 ? 0 : (bn > 511 ? 511 : bn);
              if (kp <= pqh) (void)__hip_atomic_fetch_add(hist + ql * 256 + (bn >> 1), 1u << (16 * (bn & 1)), __ATOMIC_RELAXED, __HIP_MEMORY_SCOPE_WORKGROUP); } }
        float* srow = slab + (size_t)ql * LPAD + 32 * kt + 4 * hh;
#pragma unroll
        for (int g = 0; g < 4; ++g) *(GAS f32x4*)(srow + 8 * g) = (f32x4){idx[4 * g], idx[4 * g + 1], idx[4 * g + 2], idx[4 * g + 3]};
    }
    }
    VM_WAIT(); LDS_WAIT(); __syncthreads();
    for (int rpb = 0; rpb < ((PROBE_SUB & 16) ? 2 : 1); ++rpb)
    for (int qq = wave; qq < 32; qq += NWAVES) {
        const int p = 32 * j + qq; if (p >= LSEQ) break;
        const float* row = slab + (size_t)qq * LPAD;
        unsigned u[65];
        { const GAS unsigned* rp = (const GAS unsigned*)row + lane;
#pragma unroll
          for (int i = 0; i < 65; ++i) u[i] = rp[64 * i];
          __builtin_amdgcn_sched_barrier(0); }
        auto wsum = [&](unsigned c) { unsigned s = 0;
#pragma unroll
            for (int k = 0; k < 7; ++k) s += (unsigned)__builtin_popcountll(__ballot((c >> k) & 1u)) << k;
            return s; };
        unsigned T = 1u;
        if (p + 1 <= 256) {
#pragma unroll
            for (int i = 0; i < 65; ++i) { const unsigned k = f32_key(__uint_as_float(u[i])) >> 1; u[i] = (64 * i + lane <= p) ? k : 0u; }
        } else {
            const LAS unsigned* hrow = hist + qq * 256 + 4 * lane; unsigned c8[8];
#pragma unroll
            for (int i = 0; i < 4; ++i) { const unsigned w = hrow[i]; c8[2 * i] = w & 0xffffu; c8[2 * i + 1] = w >> 16; }
            unsigned tot = 0;
#pragma unroll
            for (int i = 0; i < 8; ++i) tot += c8[i];
            unsigned suf = 0;
            { const unsigned long long gtm = (lane == 63) ? 0ull : ~((2ull << lane) - 1ull);
#pragma unroll
              for (int k = 0; k < 13; ++k) suf += (unsigned)__builtin_popcountll(__ballot((tot >> k) & 1u) & gtm) << k; }
            unsigned run = suf, bl = 0, al = 0; bool found = false;
#pragma unroll
            for (int i = 7; i >= 0; --i) { const bool hit = !found && run < 256u && run + c8[i] >= 256u; if (hit) { bl = 8u * lane + i; al = run; } found = found || hit; run += c8[i]; }
            const unsigned long long fb = __ballot(found); const int src = (int)__builtin_ctzll(fb | (1ull << 63));
            const unsigned bstar = __builtin_amdgcn_readlane(bl, src), above = __builtin_amdgcn_readlane(al, src), need = 256u - above;
            unsigned f0 = 0u, f1 = 0u, f2 = 0u, cb = 0u;
#pragma unroll
            for (int i = 0; i < 65; ++i) { const float v = __uint_as_float(u[i]); int bn = (int)__builtin_floorf(__builtin_fmaf(v, 32.f, 256.f)); bn = bn < 0 ? 0 : (bn > 511 ? 511 : bn);
                const bool val = 64 * i + lane <= p, inband = val && (unsigned)bn == bstar;
                if (i < 32) f0 |= inband ? (1u << i) : 0u; else if (i < 64) f1 |= inband ? (1u << (i - 32)) : 0u; else f2 = inband ? 1u : 0u;
                cb += inband ? 1u : 0u;
                const unsigned k = f32_key(v) >> 1; u[i] = val ? k : 0u; }
            const unsigned inb = wsum(cb);
            if (fb != 0ull && inb <= 128u && inb >= need) {
                LAS unsigned* band = (LAS unsigned*)(F.lds + 68096) + wave * 128;
                unsigned off = 0;
#pragma unroll
                for (int k = 0; k < 7; ++k) { const unsigned long long bal = __ballot((cb >> k) & 1u); off += __builtin_amdgcn_mbcnt_hi((unsigned)(bal >> 32), __builtin_amdgcn_mbcnt_lo((unsigned)bal, 0u)) << k; }
#pragma unroll
                for (int i = 0; i < 65; ++i) { const bool inband = i < 32 ? ((f0 >> i) & 1u) : (i < 64 ? ((f1 >> (i - 32)) & 1u) : (f2 & 1u)); if (inband) { band[off] = u[i]; ++off; } }
                LDS_WAIT();
                const unsigned m0 = lane < (int)inb ? band[lane] : 0u, m1 = lane + 64 < (int)inb ? band[lane + 64] : 0u; unsigned ge0 = 0, gt0 = 0, ge1 = 0, gt1 = 0;
                for (unsigned k = 0; k < inb; ++k) { const unsigned v = band[k]; ge0 += (m0 - 1u - v) >> 31; gt0 += (m0 - v) >> 31; ge1 += (m1 - 1u - v) >> 31; gt1 += (m1 - v) >> 31; }
                const unsigned long long ok0 = __ballot(lane < (int)inb && ge0 >= need && gt0 < need), ok1 = __ballot(lane + 64 < (int)inb && ge1 >= need && gt1 < need);
                if (ok0) T = __builtin_amdgcn_readlane(m0, (int)__builtin_ctzll(ok0)); else T = __builtin_amdgcn_readlane(m1, (int)__builtin_ctzll(ok1 | (1ull << 63)));
                LDS_WAIT();
            } else {
                T = 0u;
                for (int bit = 30; bit >= 0; --bit) { const unsigned cm1 = (T | (1u << bit)) - 1u; unsigned c = 0;
#pragma unroll
                    for (int i = 0; i < 65; ++i) c += (cm1 - u[i]) >> 31;
                    if (wsum(c) >= 256u) T |= 1u << bit; } } }
        unsigned long long* mrow = (unsigned long long*)((unsigned*)(F.ws + WS_MASK) + ((size_t)b * LPAD + p) * MASKW);
        unsigned wlo = 0u, whi = 0u;
#pragma unroll
        for (int i = 0; i < 64; ++i) { const unsigned long long bal = __ballot(u[i] >= T); if (lane == i) { wlo = (unsigned)bal; whi = (unsigned)(bal >> 32); } }
        const unsigned long long b64 = __ballot(u[64] >= T);
        mrow[lane] = ((unsigned long long)whi << 32) | wlo; if (lane == 0) mrow[64] = b64;
    }
    __syncthreads();
}
struct HgChunk { bf16* base; int pitch; int cq, ck, cv; bf16* A; float* dl; };
__device__ __forceinline__ HgChunk hg_chunk(Frame& F, int b, int h, int c) {
    HgChunk k;
    if (c == 0) { unsigned char* mp = F.ws + WS_HMETA + (size_t)h * HMETA_STRIDE; k.base = (bf16*)mp; k.pitch = 384; k.cq = 0; k.ck = 128; k.cv = 256; k.A = (bf16*)(mp + 64 * 384 * 2); k.dl = (float*)(mp + 64 * 384 * 2 + 64 * 64 * 2); }
    else { const size_t ci = (size_t)(b * 4 + h) * 64 + (c - 1); k.base = (bf16*)(F.ws + WS_BIG) + (size_t)(b * SEQ + 64 * (c - 1)) * NNG; k.pitch = NNG; k.cq = C_AQ + h * 128; k.ck = C_AF + h * 128; k.cv = C_AI + h * 128;
        k.A = (bf16*)(F.ws + WS_HA) + ci * 64 * 64; k.dl = (float*)(F.ws + WS_HDL) + ci * 128; }
    return k;
}
__device__ __forceinline__ void hgrn_prep_task(Frame& F, int l, int b, int h, int c) {
    const int d = F.tid & 127, tq = F.tid >> 7, lane = F.lane, wave = F.wave;
    const bf16* P = (const bf16*)(F.ws + WS_BIG);
    LAS bf16* Qt = (LAS bf16*)F.lds; LAS bf16* Kt = Qt + 64 * 136; LAS float* part = (LAS float*)(F.lds + 2 * 64 * 136 * 2);
    const HgChunk ch = hg_chunk(F, b, h, c);
    float lb = 0.f; if (l == 1) { const float a = FIN(F, I_LB)[h * 128 + d], cc = FIN(F, I_LB)[512 + h * 128 + d]; lb = 1.0f / (1.0f + __expf(a - cc)); }
    const bool meta = (c == 0);
    unsigned short zr[16], qr[16], vr[16];
    { const int r0 = meta ? MREAL : b * SEQ + 64 * (c - 1);
#pragma unroll
      for (int i = 0; i < 16; ++i) { int t = 16 * tq + i; if (meta) t = t < NMETA ? t : NMETA - 1; const bf16* pr = P + (size_t)(r0 + t) * NNG + h * 128 + d; zr[i] = pr[C_AF]; qr[i] = pr[C_AQ]; vr[i] = pr[C_AI]; }
      __builtin_amdgcn_sched_barrier(0); }
    float lfv[16];
    float run = 0.f;
#pragma unroll
    for (int i = 0; i < 16; ++i) { const bool valid = !meta || (16 * tq + i < NMETA); const float z = bf2f(zr[i]); const float sg = 1.0f / (1.0f + __expf(-z));
        lfv[i] = valid ? __logf(lb + (1.0f - lb) * sg) : 0.f; run += lfv[i]; }
    part[tq * 128 + d] = run;
    LDS_WAIT(); __syncthreads();
    const float p0 = part[d], p1 = part[128 + d], p2 = part[256 + d], p3 = part[384 + d];
    const float off = (tq > 0 ? p0 : 0.f) + (tq > 1 ? p1 : 0.f) + (tq > 2 ? p2 : 0.f), bmid = p0 + p1, blast = (p0 + p1) + (p2 + p3);
    unsigned kb[8], vb[8]; unsigned short qb[16];
    float bt = off;
#pragma unroll
    for (int i = 0; i < 16; i += 2) { float kbar[2], vv[2];
#pragma unroll
        for (int u = 0; u < 2; ++u) { const int t = 16 * tq + i + u; const bool valid = !meta || (t < NMETA);
            const float lf = lfv[i + u]; const float q = bf2f(qr[i + u]);
            const float kk = valid ? 1.0f - __expf(lf) : 0.f, qq = valid ? q / (1.0f + __expf(-q)) : 0.f; vv[u] = valid ? bf2f(vr[i + u]) : 0.f;
            bt += lf;
            kbar[u] = kk * __expf(blast - bt); qb[i + u] = (unsigned short)f2bf_s(qq * __expf(bt));
            const float qt = qq * __expf(fminf(bt - bmid, 80.f)), kt = kk * __expf(fminf(bmid - bt, 80.f));
            Qt[t * 136 + d] = (bf16)f2bf_s(qt); Kt[t * 136 + d] = (bf16)f2bf_s(kt); }
        kb[i >> 1] = pk2(kbar[0], kbar[1]); vb[i >> 1] = pk2(vv[0], vv[1]); }
    asm volatile("s_waitcnt vmcnt(0)" ::: "memory"); __syncthreads();
#pragma unroll
    for (int i = 0; i < 16; ++i) ch.base[(size_t)(16 * tq + i) * ch.pitch + ch.cq + d] = qb[i];
    { bf16* kd = ch.base + (size_t)(d >> 1) * ch.pitch + ch.ck + (d & 1) * 64 + 16 * tq; bf16* vd = ch.base + (size_t)(d >> 1) * ch.pitch + ch.cv + (d & 1) * 64 + 16 * tq;
      *(GAS v4u*)kd = (v4u){kb[0], kb[1], kb[2], kb[3]}; *(GAS v4u*)(kd + 8) = (v4u){kb[4], kb[5], kb[6], kb[7]};
      *(GAS v4u*)vd = (v4u){vb[0], vb[1], vb[2], vb[3]}; *(GAS v4u*)(vd + 8) = (v4u){vb[4], vb[5], vb[6], vb[7]}; }
    if (tq == 0) ch.dl[d] = __expf(blast);
    LDS_WAIT(); __syncthreads();
    { const int mt = wave >> 1, fr = lane & 15, g = lane >> 4;
#pragma unroll
      for (int u = 0; u < 2; ++u) { const int nt = 2 * (wave & 1) + u; f32x4 acc = (f32x4){0.f, 0.f, 0.f, 0.f};
        if (nt <= mt) {
#pragma unroll
            for (int ks = 0; ks < 4; ++ks) acc = __builtin_amdgcn_mfma_f32_16x16x32_bf16(*(const LAS bf16x8*)(Qt + (16 * mt + fr) * 136 + 32 * ks + 8 * g), *(const LAS bf16x8*)(Kt + (16 * nt + fr) * 136 + 32 * ks + 8 * g), acc, 0, 0, 0);
        }
#pragma unroll
        for (int r = 0; r < 4; ++r) { const int t = 16 * mt + 4 * g + r, s = 16 * nt + fr; ch.A[t * 64 + s] = (bf16)f2bf_s(s <= t ? acc[r] : 0.f); } } }
    __syncthreads();
}
__device__ __forceinline__ void hgrn_scan_unit(Frame& F, int l, int b, int h) {
    const int lane = F.lane, wave = F.wave, fr = lane & 15, g = lane >> 4, tid = F.tid;
    constexpr int QP = 136, AP = 72, KP = 72, GP = 136;
    constexpr int BUF = (64 * QP + 64 * AP + 128 * KP + 64 * GP) * 2 + 512;
    LAS float* red = (LAS float*)(F.lds + 2 * BUF);
    const int dv = 16 * wave + fr;
    const float gn = FIN(F, I_GN)[l * 512 + h * 128 + dv];
    const bf16* Pg = (const bf16*)(F.ws + WS_BIG) + C_AG + h * 128;
    f32x4 S[8];
#pragma unroll
    for (int mt = 0; mt < 8; ++mt) S[mt] = (f32x4){0.f, 0.f, 0.f, 0.f};
    v4u rq[2], ra, rk[2], rg[2], rd; bf16x8 bv0, bv1, bn0, bn1;
#define HG_ISSUE(c_, B0, B1) do { const HgChunk ch_ = hg_chunk(F, b, h, (c_)); const int nv_ = ((c_) == 0) ? NMETA : 64; \
        _Pragma("unroll") for (int i = 0; i < 2; ++i) { const int idx = tid + 512 * i, row = idx >> 4, c16 = idx & 15; \
            rq[i] = *(const GAS v4u*)(ch_.base + (size_t)row * ch_.pitch + ch_.cq + 8 * c16); rk[i] = *(const GAS v4u*)(ch_.base + (size_t)row * ch_.pitch + ch_.ck + 8 * c16); \
            rg[i] = (v4u){0u, 0u, 0u, 0u}; if (row < nv_) rg[i] = *(const GAS v4u*)(Pg + (size_t)(((c_) == 0) ? MREAL + row : b * SEQ + 64 * ((c_) - 1) + row) * NNG + 8 * c16); } \
        ra = *(const GAS v4u*)(ch_.A + 8 * tid); if (tid < 32) rd = *(const GAS v4u*)(ch_.dl + 4 * tid); \
        const bf16* vrow_ = ch_.base + (size_t)(dv >> 1) * ch_.pitch + ch_.cv + (dv & 1) * 64 + 8 * g; B0 = ld_frag16(vrow_); B1 = ld_frag16(vrow_ + 32); } while (0)
#define HG_COMMIT(buf_) do { LAS bf16* Q_ = (LAS bf16*)(F.lds + (buf_) * BUF); LAS bf16* A_ = Q_ + 64 * QP; LAS bf16* KT_ = A_ + 64 * AP; LAS bf16* G_ = KT_ + 128 * KP; \
        _Pragma("unroll") for (int i = 0; i < 2; ++i) { const int idx = tid + 512 * i, row = idx >> 4, c16 = idx & 15; *(LAS v4u*)(Q_ + row * QP + 8 * c16) = rq[i]; \
            *(LAS v4u*)(KT_ + (2 * row + (c16 >> 3)) * KP + 8 * (c16 & 7)) = rk[i]; *(LAS v4u*)(G_ + row * GP + 8 * c16) = rg[i]; } \
        *(LAS v4u*)(A_ + (tid >> 3) * AP + 8 * (tid & 7)) = ra; if (tid < 32) *(LAS v4u*)((LAS unsigned char*)(G_ + 64 * GP) + 16 * tid) = rd; } while (0)
    HG_ISSUE(0, bv0, bv1); HG_COMMIT(0);
    for (int c = 0; c <= 64; ++c) {
        const int buf = c & 1;
        LDS_WAIT(); __syncthreads();
        if (c < 64) HG_ISSUE(c + 1, bn0, bn1);
        LAS bf16* Q = (LAS bf16*)(F.lds + buf * BUF); LAS bf16* A = Q + 64 * QP; LAS bf16* KT = A + 64 * AP; LAS bf16* G = KT + 128 * KP; const LAS float* DL = (const LAS float*)(G + 64 * GP);
        f32x4 o[4];
#pragma unroll
        for (int mt = 0; mt < 4; ++mt) o[mt] = (f32x4){0.f, 0.f, 0.f, 0.f};
#pragma unroll
        for (int ks = 0; ks < 4; ++ks) { v4u w; w.x = cvtpk(S[2 * ks][0], S[2 * ks][1]); w.y = cvtpk(S[2 * ks][2], S[2 * ks][3]); w.z = cvtpk(S[2 * ks + 1][0], S[2 * ks + 1][1]); w.w = cvtpk(S[2 * ks + 1][2], S[2 * ks + 1][3]);
            const bf16x8 sb = __builtin_bit_cast(bf16x8, w);
#pragma unroll
            for (int mt = 0; mt < 4; ++mt) { const LAS bf16* qp = Q + (16 * mt + fr) * QP + 32 * ks + 4 * g;
                const bf16x8 af = mk_frag(*(const LAS v2u*)qp, *(const LAS v2u*)(qp + 16));
                o[mt] = __builtin_amdgcn_mfma_f32_16x16x32_bf16(af, sb, o[mt], 0, 0, 0); } }
#pragma unroll
        for (int mt = 0; mt < 4; ++mt) { o[mt] = __builtin_amdgcn_mfma_f32_16x16x32_bf16(*(const LAS bf16x8*)(A + (16 * mt + fr) * AP + 8 * g), bv0, o[mt], 0, 0, 0);
            o[mt] = __builtin_amdgcn_mfma_f32_16x16x32_bf16(*(const LAS bf16x8*)(A + (16 * mt + fr) * AP + 32 + 8 * g), bv1, o[mt], 0, 0, 0); }
#pragma unroll
        for (int mt = 0; mt < 8; ++mt) { const f32x4 dl = *(const LAS f32x4*)(DL + 16 * mt + 4 * g); S[mt] = S[mt] * dl;
            S[mt] = __builtin_amdgcn_mfma_f32_16x16x32_bf16(*(const LAS bf16x8*)(KT + (16 * mt + fr) * KP + 8 * g), bv0, S[mt], 0, 0, 0);
            S[mt] = __builtin_amdgcn_mfma_f32_16x16x32_bf16(*(const LAS bf16x8*)(KT + (16 * mt + fr) * KP + 32 + 8 * g), bv1, S[mt], 0, 0, 0); }
#pragma unroll
        for (int mt = 0; mt < 4; ++mt)
#pragma unroll
            for (int r = 0; r < 4; ++r) { float s2 = o[mt][r] * o[mt][r]; s2 += __shfl_xor(s2, 1); s2 += __shfl_xor(s2, 2); s2 += __shfl_xor(s2, 4); s2 += __shfl_xor(s2, 8);
                if (fr == 0) red[wave * 64 + 16 * mt + 4 * g + r] = s2; }
        LDS_WAIT(); __syncthreads();
        const int nvalid = (c == 0) ? NMETA : 64;
#pragma unroll
        for (int mt = 0; mt < 4; ++mt)
#pragma unroll
            for (int r = 0; r < 4; ++r) { const int t = 16 * mt + 4 * g + r; float tot = 0.f;
#pragma unroll
                for (int w = 0; w < 8; ++w) tot += red[w * 64 + t];
                if (t < nvalid && (c > 0 || b == 0)) { const int row = (c == 0) ? MREAL + t : b * SEQ + 64 * (c - 1) + t;
                    const float gr = bf2f(G[t * GP + dv]);
                    const float val = o[mt][r] * (1.0f / sqrtf(tot * (1.f / 128.f) + EPS)) * gn * (gr / (1.0f + __expf(-gr)));
                    ((bf16*)(F.ws + WS_BR))[(size_t)row * 512 + h * 128 + dv] = (bf16)f2bf_s(val); } }
        if (c < 64) { HG_COMMIT(buf ^ 1); bv0 = bn0; bv1 = bn1; }
    }
#undef HG_ISSUE
#undef HG_COMMIT
    __syncthreads();
}
__device__ __forceinline__ void conv_row(Frame& F, int l, int r) {
    const int lane = F.lane; const bf16* P = (const bf16*)(F.ws + WS_BIG);
    int r1, r2;
    if (r < MREAL) { const int b = r >> 12, t = r & 4095; r1 = seqrow(b, NMETA + t - 1); r2 = seqrow(b, NMETA + t - 2); }
    else { const int i = r - MREAL; r1 = i >= 1 ? r - 1 : -1; r2 = i >= 2 ? r - 2 : -1; }
    const float* cw = FIN(F, I_CONVW) + l * 3 * 512 + 8 * lane;
    const int r1c = r1 >= 0 ? r1 : r, r2c = r2 >= 0 ? r2 : r;
    const v4u wc0 = *(const GAS v4u*)(P + (size_t)r * NNG + C_BC + 8 * lane), wu0 = *(const GAS v4u*)(P + (size_t)r * NNG + C_BU + 8 * lane), wb = *(const GAS v4u*)(P + (size_t)r * NNG + C_BB + 8 * lane);
    const v4u wc1 = *(const GAS v4u*)(P + (size_t)r1c * NNG + C_BC + 8 * lane), wu1 = *(const GAS v4u*)(P + (size_t)r1c * NNG + C_BU + 8 * lane);
    const v4u wc2 = *(const GAS v4u*)(P + (size_t)r2c * NNG + C_BC + 8 * lane), wu2 = *(const GAS v4u*)(P + (size_t)r2c * NNG + C_BU + 8 * lane);
    __builtin_amdgcn_sched_barrier(0);
    float c0[8], u0[8], bb[8], y[8]; unpack8(wc0, c0); unpack8(wu0, u0); unpack8(wb, bb);
#pragma unroll
    for (int i = 0; i < 8; ++i) y[i] = cw[i] * (c0[i] * u0[i]);
    const float m1 = r1 >= 0 ? 1.f : 0.f, m2 = r2 >= 0 ? 1.f : 0.f;
    unpack8(wc1, c0); unpack8(wu1, u0);
#pragma unroll
    for (int i = 0; i < 8; ++i) y[i] += m1 * cw[512 + i] * (c0[i] * u0[i]);
    unpack8(wc2, c0); unpack8(wu2, u0);
#pragma unroll
    for (int i = 0; i < 8; ++i) y[i] += m2 * cw[1024 + i] * (c0[i] * u0[i]);
#pragma unroll
    for (int i = 0; i < 8; ++i) y[i] *= bb[i];
    *(GAS v4u*)((bf16*)(F.ws + WS_BR) + (size_t)MPAD * 512 + (size_t)r * 512 + 8 * lane) = pack8(y);
}
constexpr int CW_TMO = 0, CW_BAR = 4096, CW_Q = 16384;
__device__ __forceinline__ int queue_pop(Frame& F, int qi) {
    int t = 0; if (F.lane == 0) t = (int)__hip_atomic_fetch_add((unsigned*)(F.ctl + CW_Q + 64 * qi), 1u, RLX_AGENT);
    return __builtin_amdgcn_readfirstlane(t);
}
__device__ __forceinline__ int queue_pop_wg(Frame& F, int qi) {
    LAS int* slot = (LAS int*)(F.lds + 139264);
    __syncthreads();
    if (F.tid == 0) *slot = (int)__hip_atomic_fetch_add((unsigned*)(F.ctl + CW_Q + 64 * qi), 1u, RLX_AGENT);
    LDS_WAIT(); __syncthreads();
    return __builtin_amdgcn_readfirstlane(*slot);
}
__device__ __forceinline__ void phase_hgrn_prep(Frame& F, int l) {
    for (int t = F.bid; t < NB * 4 * 64 + 4; t += F.G) { if (t < 4) hgrn_prep_task(F, l, 0, t, 0); else { const int u = t - 4; hgrn_prep_task(F, l, u >> 8, (u >> 6) & 3, 1 + (u & 63)); } }
}
__device__ __forceinline__ void phase_prep(Frame& F, int l) { const int gw = F.bid * NWAVES + F.wave, NGW = F.G * NWAVES; for (int r = gw; r < MREAL + NMETA; r += NGW) prep_row(F, l, r); }
__device__ __forceinline__ void phase_vt(Frame& F) { const int gw = F.bid * NWAVES + F.wave, NGW = F.G * NWAVES; for (int t = gw; t < VT_NTASK; t += NGW) vt_task(F, t); }
__device__ __forceinline__ void phase_mix1(Frame& F, int l, int qidx) {
    LAS float* bt = (LAS float*)(F.lds + 135168);
    build_bias_table(F, bt, 0);
    __syncthreads();
#ifndef MIX1_SKIP
#define MIX1_SKIP 0
#endif
    const int sk = (qidx >= 4) ? MIX1_SKIP : 0;
    if (F.bid < NIDX_WG) {
        float* slab = (float*)(F.ws + WS_SCR) + (size_t)F.bid * 32 * LPAD;
        if (!(sk & 1)) for (int t = F.bid; t < NB * NQT; t += NIDX_WG) { const int j = NQT - 1 - t / NB, b = t % NB; dsa_index_task(F, b, j, slab); }
    } else if (F.bid < NIDX_WG + NHG_WG) {
        const int u = F.bid - NIDX_WG; if (!(sk & 2)) hgrn_scan_unit(F, l, u >> 2, u & 3);
    } else {
        const int u0 = F.bid - NIDX_WG - NHG_WG, nw = F.G - NIDX_WG - NHG_WG;
        const int cw = u0 * NWAVES + F.wave, ncw = nw * NWAVES; if (!(sk & 4)) for (int r = cw; r < MREAL + NMETA; r += ncw) conv_row(F, l, r);
    }
    float lam, post;
    { const float* lp = FIN(F, I_DLAM) + l * 256; const float s1 = wave_sum(lp[F.lane] * lp[64 + F.lane]), s2 = wave_sum(lp[128 + F.lane] * lp[192 + F.lane]);
      const float li = 0.8f - 0.6f * __expf(-0.3f * (float)l); lam = __expf(s1) - __expf(s2) + li; post = 1.0f - li; }
    for (;;) { const int t = queue_pop_wg(F, qidx) + ((sk & 8) ? (1 << 20) : 0); if (t >= NB * 4 * NQB) break;
        const int J = NQB - 1 - t / 32, bh = t % 32; attn_wg_task<false>(F, l, bh >> 2, bh & 3, J, bt, lam, post); }
}
__device__ __forceinline__ void phase_mix2(Frame& F, int l, int qidx) {
    LAS float* bt = (LAS float*)(F.lds + 135168);
    build_bias_table(F, bt, 4);
    __syncthreads();
    for (;;) { const int t = queue_pop_wg(F, qidx); if (t >= NB * 4 * NQB) break;
        const int J = NQB - 1 - t / 32, bh = t % 32; attn_wg_task<true>(F, l, bh >> 2, bh & 3, J, bt, 0.f, 1.f); }
}

#ifndef MK_ONE
#define MK_ONE 0
#endif
#ifndef BR_MASK
#define BR_MASK 15
#endif
constexpr int NPH = 18;
template <class T> __device__ __forceinline__ T opaque(T v) { asm volatile("" : "+s"(v)); return v; }
struct Args { const float* in[22]; float* out; unsigned char* ws; int ph_lo, ph_hi; };
__global__ void __launch_bounds__(NWAVES * 64, 2) fwd(Args args) {
    extern __shared__ __attribute__((aligned(16))) unsigned char lds[];
    Frame F;
    F.lds = (LAS unsigned char*)lds; F.MISC = (volatile LAS unsigned*)(F.lds + MISC_OFF);
    F.tid = threadIdx.x; F.lane = F.tid & 63; F.wave = __builtin_amdgcn_readfirstlane(F.tid >> 6); F.G = gridDim.x; F.bid = blockIdx.x;
    F.ws = args.ws; F.out = args.out; F.ctl = (gu32*)(args.ws + WS_CTL);
    F.karg = (const unsigned char __attribute__((address_space(4)))*)__builtin_amdgcn_kernarg_segment_ptr();
    for (int u = F.tid; u < (LDS_BYTES - LDSCTL_OFF) / 4; u += NWAVES * 64) ((LAS unsigned*)(F.lds + LDSCTL_OFF))[u] = 0u;
    __syncthreads();
#if MK_ONE
    XcdBarrier bar = xcd_barrier_post((unsigned*)(F.ctl + CW_BAR), F.MISC + 8, __builtin_amdgcn_readfirstlane(threadIdx.x >> 6));
#define GRID_BAR() xcd_barrier(bar)
#else
#define GRID_BAR() do { } while (0)
#endif
    const int wave_s = __builtin_amdgcn_readfirstlane(threadIdx.x >> 6);
    const int lo = args.ph_lo, hi = args.ph_hi;
#define IN(k) (lo <= (k) && (k) < hi)
#define RETID() do { int w_ = wave_s; asm volatile("" : "+s"(w_)); unsigned mk_ = ~0u; asm volatile("" : "+s"(mk_)); int t_ = w_ * 64 + (int)__builtin_amdgcn_mbcnt_hi(mk_, __builtin_amdgcn_mbcnt_lo(mk_, 0u)); asm volatile("" : "+v"(t_)); F.tid = t_; F.lane = t_ & 63; F.wave = w_; } while (0)
#ifdef DBG_TS
#define STAMP(k) do { if (blockIdx.x == 0 && threadIdx.x == 0) ((unsigned long long*)(args.ws + 768 * 1024))[(k)] = __builtin_amdgcn_s_memrealtime(); } while (0)
#else
#define STAMP(k) do { } while (0)
#endif
#define SEAM(k) do { if (IN((k) + 1)) GRID_BAR(); STAMP((k) + 1); } while (0)
#ifndef PROBE_EPI
#define PROBE_EPI 0
#endif
#ifdef PROBE_MASK
#define NREP(kk) opaque(((PROBE_MASK >> (kk)) & 1) ? 1 + PROBE_EXTRA : 1)
#define REP_BEGIN(kk) { const int nrep_ = NREP(kk); for (int rep = 0; rep < nrep_; ++rep) { if (rep) GRID_BAR();
#define REP_END } }
#else
#define REP_BEGIN(kk) { { const int rep = 0; (void)rep;
#define REP_END } }
#endif
    STAMP(0);
    unsigned char* wb = F.ws + WS_W;
    bf16* XN = (bf16*)(F.ws + WS_XN); bf16* BR = (bf16*)(F.ws + WS_BR); bf16* BIG = (bf16*)(F.ws + WS_BIG); float* HM = (float*)(F.ws + WS_HM);
    for (int l = 0; l < 2; ++l) {
        const int pb = l * NPH;
        const float* hsrc = (l == 0) ? FIN(F, I_X) : F.out;
        if (IN(pb + 0)) { REP_BEGIN(0) RETID(); phase_convert(F, l); REP_END SEAM(pb + 0); }
        if (IN(pb + 1)) { REP_BEGIN(1) RETID(); phase_norm(F, hsrc, FIN(F, I_F1N) + l * DM); REP_END SEAM(pb + 1); }
        if (IN(pb + 2)) { REP_BEGIN(2) RETID(); meta_gemm(F, 0, XN + (size_t)MREAL * DM, DM, (const bf16*)(wb + W_GU1), NGU, DM, BIG, DFF, 0.f); pg8::Gemm g{opaque((const bf16*)(XN)), opaque((const bf16*)(wb + W_GU1)), MREAL, NGU, DM}; pg8::StaticOrder S; S.init(MREAL, NGU, F.G, opaque(F.bid));
            pg8::EpiSwiGLU E{BIG, DFF, rep ? PROBE_EPI : 0}; pg8::gemm_phase<pg8::EpiSwiGLU, pg8::StaticOrder, true, true>(F.lds + RING_OFF, g, S, E, F.tid); REP_END SEAM(pb + 2); }
        if (IN(pb + 3)) { REP_BEGIN(3) RETID(); meta_gemm(F, 1, BIG + (size_t)MREAL * DFF, DFF, (const bf16*)(wb + W_D1), DM, DFF, nullptr, 0, rep ? 0.f : 0.5f); pg8::Gemm g{opaque((const bf16*)(BIG)), opaque((const bf16*)(wb + W_D1)), MREAL, DM, DFF}; pg8::StaticOrder S; S.init(MREAL, DM, F.G, opaque(F.bid));
            pg8::EpiResF32 E{rep ? F.out : hsrc, F.out, HM, DM, MT_REAL, rep ? 0.f : 0.5f}; pg8::gemm_phase<pg8::EpiResF32, pg8::StaticOrder, true, true>(F.lds + RING_OFF, g, S, E, F.tid); REP_END SEAM(pb + 3); }
        if (IN(pb + 4)) { REP_BEGIN(4) RETID(); phase_norm(F, F.out, FIN(F, I_MIXN) + l * DM); REP_END SEAM(pb + 4); }
        if (IN(pb + 5)) { REP_BEGIN(5) RETID(); meta_gemm(F, 2, XN + (size_t)MREAL * DM, DM, (const bf16*)(wb + W_NG), NNG, DM, BIG, NNG, 0.f); pg8::Gemm g{opaque((const bf16*)(XN)), opaque((const bf16*)(wb + W_NG)), MREAL, NNG, DM}; pg8::StaticOrder S; S.init(MREAL, NNG, F.G, opaque(F.bid));
            pg8::EpiBf16<0> E{BIG, NNG}; pg8::gemm_phase<pg8::EpiBf16<0>, pg8::StaticOrder, true, true>(F.lds + RING_OFF, g, S, E, F.tid); REP_END SEAM(pb + 5); }
        if (IN(pb + 6)) { RETID(); phase_prep(F, l); phase_vt(F); __syncthreads(); phase_hgrn_prep(F, l); SEAM(pb + 6); }
#ifdef DUP_MIX
        if (IN(pb + 7)) { const int nrep = opaque(DUP_MIX1); for (int rep = 0; rep < nrep; ++rep) { RETID(); phase_mix1(F, l, 4 * rep + 2 * l); GRID_BAR(); } }
        if (IN(pb + 8)) { const int nrep = opaque(DUP_MIX2); for (int rep = 0; rep < nrep; ++rep) { RETID(); phase_mix2(F, l, 4 * rep + 2 * l + 1); GRID_BAR(); } }
#else
        if (IN(pb + 7)) { RETID(); phase_mix1(F, l, 2 * l); SEAM(pb + 7); }
        if (IN(pb + 8)) { RETID(); phase_mix2(F, l, 2 * l + 1); SEAM(pb + 8); }
#endif
        if (IN(pb + 9)) { REP_BEGIN(9) RETID(); meta_gemm(F, 3, XN + (size_t)MREAL * DM, DM, (const bf16*)(wb + W_G), NGATE, DM, BIG, NGATE, 0.f); pg8::Gemm g{opaque((const bf16*)(XN)), opaque((const bf16*)(wb + W_G)), MREAL, NGATE, DM}; pg8::StaticOrder S; S.init(MREAL, NGATE, F.G, opaque(F.bid));
            pg8::EpiBf16<1> E{BIG, NGATE}; pg8::gemm_phase<pg8::EpiBf16<1>, pg8::StaticOrder, true, true>(F.lds + RING_OFF, g, S, E, F.tid); REP_END SEAM(pb + 9); }
        if (IN(pb + 10)) { REP_BEGIN(10) RETID(); meta_gemm(F, 4, BR + (size_t)MREAL * 512, 512, (const bf16*)(wb + W_BR), DM, 512, XN, DM, 0.f);
            pg8::Gemm g{opaque((const bf16*)(BR)), opaque((const bf16*)(wb + W_BR)), MREAL, DM, 512}; pg8::MergeOrder S; S.init(MREAL, DM, F.G, opaque(F.bid), MPAD / 256);
            pg8::EpiGateAccM E{XN, DM, BIG, NGATE, MPAD / 256, DM / 256}; pg8::gemm_phase<pg8::EpiGateAccM, pg8::MergeOrder, true, true>(F.lds + RING_OFF, g, S, E, F.tid); REP_END SEAM(pb + 10); }
        if (IN(pb + 14) && BR_MASK) { REP_BEGIN(14) RETID(); meta_gemm(F, 1, XN + (size_t)MREAL * DM, DM, (const bf16*)(wb + W_O), DM, DM, nullptr, 0, rep ? 0.f : 1.0f); pg8::Gemm g{opaque((const bf16*)(XN)), opaque((const bf16*)(wb + W_O)), MREAL, DM, DM}; pg8::StaticOrder S; S.init(MREAL, DM, F.G, opaque(F.bid));
            pg8::EpiResF32 E{F.out, F.out, HM, DM, MT_REAL, rep ? 0.f : 1.0f}; pg8::gemm_phase<pg8::EpiResF32, pg8::StaticOrder, true, true>(F.lds + RING_OFF, g, S, E, F.tid); REP_END SEAM(pb + 14); }
        if (IN(pb + 15)) { REP_BEGIN(15) RETID(); phase_norm(F, F.out, FIN(F, I_F2N) + l * DM); REP_END SEAM(pb + 15); }
        if (IN(pb + 16)) { REP_BEGIN(16) RETID(); meta_gemm(F, 0, XN + (size_t)MREAL * DM, DM, (const bf16*)(wb + W_GU2), NGU, DM, BIG, DFF, 0.f); pg8::Gemm g{opaque((const bf16*)(XN)), opaque((const bf16*)(wb + W_GU2)), MREAL, NGU, DM}; pg8::StaticOrder S; S.init(MREAL, NGU, F.G, opaque(F.bid));
            pg8::EpiSwiGLU E{BIG, DFF, rep ? PROBE_EPI : 0}; pg8::gemm_phase<pg8::EpiSwiGLU, pg8::StaticOrder, true, true>(F.lds + RING_OFF, g, S, E, F.tid); REP_END SEAM(pb + 16); }
        if (IN(pb + 17)) { REP_BEGIN(17) RETID(); meta_gemm(F, 1, BIG + (size_t)MREAL * DFF, DFF, (const bf16*)(wb + W_D2), DM, DFF, nullptr, 0, rep ? 0.f : 0.5f); pg8::Gemm g{opaque((const bf16*)(BIG)), opaque((const bf16*)(wb + W_D2)), MREAL, DM, DFF}; pg8::StaticOrder S; S.init(MREAL, DM, F.G, opaque(F.bid));
            pg8::EpiResF32 E{F.out, F.out, HM, DM, MT_REAL, rep ? 0.f : 0.5f}; pg8::gemm_phase<pg8::EpiResF32, pg8::StaticOrder, true, true>(F.lds + RING_OFF, g, S, E, F.tid); REP_END SEAM(pb + 17); }
    }
}

extern "C" void kernel_launch(void* const* d_in, const int* in_sizes, int n_in, void* d_out, int out_size, void* d_ws, size_t ws_size, hipStream_t stream) {
    static int grid = 0;
    if (grid == 0) {
        if (n_in != 22 || out_size != MREAL * DM || ws_size < WS_END) { fprintf(stderr, "kernel_launch: unexpected shapes (n_in %d out %d ws %zu need %zu)\n", n_in, out_size, ws_size, (size_t)WS_END); grid = -1; return; }
        int dev = 0, cus = 0, per_cu = 0;
        if (hipGetDevice(&dev) != hipSuccess || hipDeviceGetAttribute(&cus, hipDeviceAttributeMultiprocessorCount, dev) != hipSuccess) { grid = -1; return; }
        if (hipFuncSetAttribute((const void*)fwd, hipFuncAttributeMaxDynamicSharedMemorySize, LDS_BYTES) != hipSuccess) { fprintf(stderr, "kernel_launch: hipFuncSetAttribute failed\n"); grid = -1; return; }
        if (hipOccupancyMaxActiveBlocksPerMultiprocessor(&per_cu, (const void*)fwd, NWAVES * 64, LDS_BYTES) != hipSuccess || per_cu < 1) fprintf(stderr, "kernel_launch: occupancy query says %d\n", per_cu);
        (void)hipGetLastError();
        grid = cus < 256 ? cus : 256;
    }
    if (grid < 0) return;
    (void)hipMemsetAsync((char*)d_ws + WS_CTL, 0, CTL_ZERO_BYTES, stream);
    Args a{};
    for (int i = 0; i < 22; ++i) a.in[i] = (const float*)d_in[i];
    a.out = (float*)d_out; a.ws = (unsigned char*)d_ws;
#ifndef PH_END
#define PH_END (2 * NPH)
#endif
#if MK_ONE
    a.ph_lo = 0; a.ph_hi = PH_END;
    hipLaunchKernelGGL(fwd, dim3(grid), dim3(NWAVES * 64), LDS_BYTES, stream, a);
#else
    for (int p = 0; p < PH_END; ++p) { a.ph_lo = p; a.ph_hi = p + 1;
        hipLaunchKernelGGL(fwd, dim3(grid), dim3(NWAVES * 64), LDS_BYTES, stream, a); }
#endif
}
```

```cpp
#include <hip/hip_runtime.h>
#include <cstdio>
#include <cstdint>
#define MK_ONE 1
namespace pg8 {
#define PG8_LAS __attribute__((address_space(3)))
typedef unsigned short bf16_t;
typedef short bf16x8 __attribute__((ext_vector_type(8)));
typedef float f32x4 __attribute__((ext_vector_type(4)));
typedef unsigned u32x4 __attribute__((ext_vector_type(4)));
constexpr int BM = 256, BK = 64, HALF = 128, HTB = HALF * BK * 2  , STAGE_BYTES = 8 * HTB, NXCD = 8, WGM = 8;

__host__ __device__ __forceinline__ int lds_byte(int r, int c) { const int st = (r >> 4) * 2 + (c >> 5), rr = r & 15, cc = c & 31, ob = rr * 64 + cc * 2; return st * 1024 + (ob ^ (((ob >> 9) & 1) << 5)); }
__host__ __device__ __forceinline__ void stage_rc(int b, int& R, int& C) { const int st = b / 1024, sb = b % 1024, swz = sb ^ (((sb >> 9) & 1) << 5); R = (st >> 1) * 16 + swz / 64; C = (st & 1) * 32 + (swz % 64) / 2; }
__host__ __device__ __forceinline__ int perm32(int rho) { const int n = rho >> 4, i = rho & 15; return 8 * (i >> 2) + 4 * n + (i & 3); }

struct Unit { int pm, pn; };
struct Gemm { const bf16_t* A; const bf16_t* Bt; int M, N, K; };

struct StaticOrder {
    int nM, nN, nwg, G, c;
    __host__ __device__ void init(int M, int N, int G_, int c_) { nM = M / BM; nN = N / BM; nwg = nM * nN; G = G_; c = c_; }
    __host__ __device__ bool next(int i, Unit& u) const {
        const long L = (long)i * G + c; if (L >= nwg) return false;
        int wgid = (int)L; { const int q = nwg / NXCD, r = nwg % NXCD, xcd = wgid % NXCD, off = wgid / NXCD; wgid = (xcd < r ? xcd * (q + 1) : r * (q + 1) + (xcd - r) * q) + off; }
        const int nig = WGM * nN, gid = wgid / nig, fm = gid * WGM, gsz = (nM - fm) < WGM ? (nM - fm) : WGM;
        u.pm = fm + ((wgid % nig) % gsz); u.pn = (wgid % nig) / gsz; return true;
    }
    __device__ __forceinline__ void a_ready(const Unit&) const {}
    __device__ __forceinline__ void done(const Unit&) const {}
};
typedef __bf16 bf16x2_hw __attribute__((ext_vector_type(2))); typedef float f32x2_hw __attribute__((ext_vector_type(2)));
__device__ __forceinline__ unsigned cvt_pk_bf16(float lo, float hi) { const f32x2_hw v = {lo, hi}; return __builtin_bit_cast(unsigned, __builtin_convertvector(v, bf16x2_hw)); }
typedef float f32x2 __attribute__((ext_vector_type(2)));
__device__ __forceinline__ float fast_sigmoid(float x) { return __builtin_amdgcn_rcpf(1.0f + __expf(-x)); }
__device__ __forceinline__ float fast_silu(float x) { return x * fast_sigmoid(x); }
template <int ACT  > struct EpiBf16 {
    static constexpr bool PERM = true, AFTER_DRAIN = false;
    bf16_t* O; int ldc;
    __device__ __forceinline__ void operator()(const f32x4 (&acc)[2][2][4][2], const Unit& u, int wr, int wc, int fr, int fq) const {
        const int row0 = u.pm * BM + wr * 64 + fr; const int col0 = u.pn * BM + wc * 32 + 8 * fq;
#pragma unroll
        for (int ai = 0; ai < 2; ++ai)
#pragma unroll
            for (int m = 0; m < 4; ++m) { bf16_t* rowp = O + (size_t)(row0 + ai * HALF + m * 16) * ldc + col0;
#pragma unroll
                for (int bj = 0; bj < 2; ++bj) { f32x4 v0 = acc[ai][bj][m][0], v1 = acc[ai][bj][m][1];
                    if (ACT == 1) {
#pragma unroll
                        for (int j = 0; j < 4; ++j) { v0[j] = fast_sigmoid(v0[j]); v1[j] = fast_sigmoid(v1[j]); } }
                    u32x4 w; w.x = cvt_pk_bf16(v0[0], v0[1]); w.y = cvt_pk_bf16(v0[2], v0[3]); w.z = cvt_pk_bf16(v1[0], v1[1]); w.w = cvt_pk_bf16(v1[2], v1[3]);
                    *(u32x4*)(rowp + bj * HALF) = w; } }
    }
};
struct EpiSwiGLU {
    static constexpr bool PERM = true, AFTER_DRAIN = false;
    bf16_t* O; int ldc; int mode;
    __device__ __forceinline__ void operator()(const f32x4 (&acc)[2][2][4][2], const Unit& u, int wr, int wc, int fr, int fq) const {
        if (mode == 2) return;
        const int row0 = u.pm * BM + wr * 64 + fr; const int col0 = u.pn * HALF + wc * 32 + 8 * fq;
#pragma unroll
        for (int ai = 0; ai < 2; ++ai)
#pragma unroll
            for (int m = 0; m < 4; ++m) { bf16_t* rowp = O + (size_t)(row0 + ai * HALF + m * 16) * ldc + col0;
                const f32x4 g0 = acc[ai][0][m][0], g1 = acc[ai][0][m][1], u0 = acc[ai][1][m][0], u1 = acc[ai][1][m][1];
                f32x4 v0, v1;
#pragma unroll
                for (int j = 0; j < 4; ++j) { v0[j] = fast_silu(g0[j]) * u0[j]; v1[j] = fast_silu(g1[j]) * u1[j]; }
                u32x4 w; w.x = cvt_pk_bf16(v0[0], v0[1]); w.y = cvt_pk_bf16(v0[2], v0[3]); w.z = cvt_pk_bf16(v1[0], v1[1]); w.w = cvt_pk_bf16(v1[2], v1[3]);
                if (mode == 0) *(u32x4*)rowp = w; else asm volatile("" :: "v"(w.x), "v"(w.y), "v"(w.z), "v"(w.w));
                asm volatile("" ::: "memory"); }
    }
};
struct EpiResF32 {
    static constexpr bool PERM = false, AFTER_DRAIN = false;
    const float* base_r; float* out_r; float* hm; int ldc; int mt_real; float scale;
    __device__ __forceinline__ void operator()(const f32x4 (&acc)[2][2][4][2], const Unit& u, int wr, int wc, int fr, int fq) const {
        const bool real = u.pm < mt_real;
        const float* bp = real ? base_r + (size_t)u.pm * BM * ldc : hm; float* op = real ? out_r + (size_t)u.pm * BM * ldc : hm;
        const int row0 = wr * 64 + fr, col0 = u.pn * BM + wc * 32 + 4 * fq;
#pragma unroll
        for (int ai = 0; ai < 2; ++ai) {
            f32x4 b[4][2][2];
#pragma unroll
            for (int m = 0; m < 4; ++m) { const size_t off = (size_t)(row0 + ai * HALF + m * 16) * ldc + col0;
#pragma unroll
                for (int bj = 0; bj < 2; ++bj)
#pragma unroll
                    for (int n = 0; n < 2; ++n) b[m][bj][n] = *(const f32x4*)(bp + off + bj * HALF + n * 16); }
            asm volatile("" ::: "memory");
#pragma unroll
            for (int m = 0; m < 4; ++m) { const size_t off = (size_t)(row0 + ai * HALF + m * 16) * ldc + col0;
#pragma unroll
                for (int bj = 0; bj < 2; ++bj)
#pragma unroll
                    for (int n = 0; n < 2; ++n) *(f32x4*)(op + off + bj * HALF + n * 16) = b[m][bj][n] + acc[ai][bj][m][n] * scale; }
            asm volatile("" ::: "memory"); }
    }
};
struct EpiGateAcc {
    static constexpr bool PERM = true, AFTER_DRAIN = false;
    bf16_t* MG; int ldc; const bf16_t* G; int ldg; int gcol0; int first;
    __device__ __forceinline__ void operator()(const f32x4 (&acc)[2][2][4][2], const Unit& u, int wr, int wc, int fr, int fq) const {
        const int row0 = u.pm * BM + wr * 64 + fr; const int col0 = u.pn * BM + wc * 32 + 8 * fq;
#pragma unroll
        for (int ai = 0; ai < 2; ++ai)
#pragma unroll
            for (int m = 0; m < 4; ++m) { const size_t r = (size_t)(row0 + ai * HALF + m * 16);
#pragma unroll
                for (int bj = 0; bj < 2; ++bj) { const u32x4 gw = *(const u32x4*)(G + r * ldg + gcol0 + col0 + bj * HALF);
                    u32x4 pw = (u32x4){0u, 0u, 0u, 0u}; if (!first) pw = *(const u32x4*)(MG + r * ldc + col0 + bj * HALF);
                    float o[8];
#pragma unroll
                    for (int j = 0; j < 4; ++j) { const float a0 = (j < 2) ? acc[ai][bj][m][0][2 * j] : acc[ai][bj][m][1][2 * (j - 2)], a1 = (j < 2) ? acc[ai][bj][m][0][2 * j + 1] : acc[ai][bj][m][1][2 * (j - 2) + 1];
                        o[2 * j] = __uint_as_float(pw[j] << 16) + __uint_as_float(gw[j] << 16) * a0; o[2 * j + 1] = __uint_as_float(pw[j] & 0xffff0000u) + __uint_as_float(gw[j] & 0xffff0000u) * a1; }
                    u32x4 w; w.x = cvt_pk_bf16(o[0], o[1]); w.y = cvt_pk_bf16(o[2], o[3]); w.z = cvt_pk_bf16(o[4], o[5]); w.w = cvt_pk_bf16(o[6], o[7]);
                    *(u32x4*)(MG + r * ldc + col0 + bj * HALF) = w; } }
    }
};

struct MergeOrder {
    int nM, nN, G, c, mt_alloc;
    __host__ __device__ void init(int M, int N, int G_, int c_, int mt_alloc_) { nM = M / BM; nN = N / BM; G = G_; c = c_; mt_alloc = mt_alloc_; }
    __host__ __device__ bool next(int i, Unit& u) const { const int t = (i >> 2) * G + c, m = i & 3; if (t >= nM * nN) return false;
        const int pm = t / nN, pn = t % nN; u.pm = m * mt_alloc + pm; u.pn = m * nN + pn; return true; }
    __device__ __forceinline__ void a_ready(const Unit&) const {}
    __device__ __forceinline__ void done(const Unit&) const {}
};
struct EpiGateAccM {
    static constexpr bool PERM = true, AFTER_DRAIN = false;
    bf16_t* MG; int ldc; const bf16_t* G; int ldg; int mt_alloc; int ntn;
    __device__ __forceinline__ void operator()(const f32x4 (&acc)[2][2][4][2], const Unit& u, int wr, int wc, int fr, int fq) const {
        const int m = u.pm / mt_alloc, pm = u.pm - m * mt_alloc, pn = u.pn - m * ntn;
        const int row0 = pm * BM + wr * 64 + fr; const int col0 = pn * BM + wc * 32 + 8 * fq; const int gcol0 = m * ntn * BM;
#pragma unroll
        for (int ai = 0; ai < 2; ++ai)
#pragma unroll
            for (int mm = 0; mm < 4; ++mm) { const size_t r = (size_t)(row0 + ai * HALF + mm * 16);
#pragma unroll
                for (int bj = 0; bj < 2; ++bj) { const u32x4 gw = *(const u32x4*)(G + r * ldg + gcol0 + col0 + bj * HALF);
                    u32x4 pw = (u32x4){0u, 0u, 0u, 0u}; if (m != 0) pw = *(const u32x4*)(MG + r * ldc + col0 + bj * HALF);
                    float o[8];
#pragma unroll
                    for (int j = 0; j < 4; ++j) { const float a0 = (j < 2) ? acc[ai][bj][mm][0][2 * j] : acc[ai][bj][mm][1][2 * (j - 2)], a1 = (j < 2) ? acc[ai][bj][mm][0][2 * j + 1] : acc[ai][bj][mm][1][2 * (j - 2) + 1];
                        o[2 * j] = __uint_as_float(pw[j] << 16) + __uint_as_float(gw[j] << 16) * a0; o[2 * j + 1] = __uint_as_float(pw[j] & 0xffff0000u) + __uint_as_float(gw[j] & 0xffff0000u) * a1; }
                    u32x4 w; w.x = cvt_pk_bf16(o[0], o[1]); w.y = cvt_pk_bf16(o[2], o[3]); w.z = cvt_pk_bf16(o[4], o[5]); w.w = cvt_pk_bf16(o[6], o[7]);
                    *(u32x4*)(MG + r * ldc + col0 + bj * HALF) = w; } }
    }
};
template <class Epi, class Sched, bool ALIGN_EPI = false, bool SP2 = false>
__device__ __forceinline__ void gemm_phase(PG8_LAS unsigned char* lds, const Gemm g, const Sched& S, const Epi& E, int tid_in) {
    int tid_ = tid_in; asm volatile("" : "+v"(tid_));
    const int tid = tid_, wid = __builtin_amdgcn_readfirstlane(tid >> 6), lane = tid & 63, wr = wid >> 2, wc = wid & 3, fr = lane & 15, fq = lane >> 4;
    const int K = g.K, nt = K / BK;
    unsigned voffA[2], voffB[2];
#pragma unroll
    for (int i = 0; i < 2; ++i) { int R, C; stage_rc(tid * 16 + i * 8192, R, C); const int Rb = Epi::PERM ? ((R & ~31) + perm32(R & 31)) : R;
        voffA[i] = (unsigned)(R * K + C) * 2u; voffB[i] = (unsigned)(Rb * K + C) * 2u; }
    const size_t kstep = (size_t)(BK * 2);
    const size_t hstep = (size_t)HALF * K * 2;
    const size_t tstep = 2 * hstep;
    const unsigned ldsw = (unsigned)wid * 1024u;
    const int aoff = lds_byte(wr * 64 + fr, fq * 8), boff = lds_byte(wc * 32 + fr, fq * 8);
#define PG8_SA(b, h) (((b) * 2 + (h)) * HTB)
#define PG8_SB(b, h) ((4 + (b) * 2 + (h)) * HTB)
#define PG8_STAGE(bufoff, gbase, voff) do { _Pragma("unroll") for (int _i = 0; _i < 2; ++_i) \
        __builtin_amdgcn_global_load_lds((const unsigned*)((const char*)(gbase) + (voff)[_i]), (PG8_LAS unsigned*)(lds + (bufoff) + ldsw + _i * 8192), 16, 0, 0); } while (0)
#define PG8_LDA(dst, b, h) do { _Pragma("unroll") for (int m = 0; m < 4; ++m) _Pragma("unroll") for (int k = 0; k < 2; ++k) dst[m][k] = *(const PG8_LAS bf16x8*)(lds + PG8_SA(b, h) + aoff + m * 2048 + k * 1024); } while (0)
#define PG8_LDB(dst, b, h) do { _Pragma("unroll") for (int n = 0; n < 2; ++n) _Pragma("unroll") for (int k = 0; k < 2; ++k) dst[n][k] = *(const PG8_LAS bf16x8*)(lds + PG8_SB(b, h) + boff + n * 2048 + k * 1024); } while (0)
#define PG8_MMA(ai, bj, At, Bt) do { __builtin_amdgcn_s_setprio(1); _Pragma("unroll") for (int m = 0; m < 4; ++m) _Pragma("unroll") for (int n = 0; n < 2; ++n) _Pragma("unroll") for (int k = 0; k < 2; ++k) \
        acc[ai][bj][m][n] = __builtin_amdgcn_mfma_f32_16x16x32_bf16(Bt[n][k], At[m][k], acc[ai][bj][m][n], 0, 0, 0); __builtin_amdgcn_s_setprio(0); } while (0)
#define PG8_WAIT_V(n) asm volatile("s_waitcnt vmcnt(" #n ")" ::: "memory")
#define PG8_WAIT_L(n) asm volatile("s_waitcnt lgkmcnt(" #n ")" ::: "memory")
#define PG8_BAR __builtin_amdgcn_s_barrier()
#define PG8_SCHED __builtin_amdgcn_sched_barrier(0)
    Unit cur, nxt; int ui = 0;
    if (!S.next(0, cur)) return;
    f32x4 acc[2][2][4][2];
#pragma unroll
    for (int a = 0; a < 2; ++a)
#pragma unroll
        for (int b = 0; b < 2; ++b)
#pragma unroll
            for (int m = 0; m < 4; ++m)
#pragma unroll
                for (int n = 0; n < 2; ++n) acc[a][b][m][n] = (f32x4){0.f, 0.f, 0.f, 0.f};
    bf16x8 At[4][2], B0[2][2], B1[2][2];
    const char* cA = (const char*)g.A + (size_t)cur.pm * tstep; const char* cB = (const char*)g.Bt + (size_t)cur.pn * tstep;
    S.a_ready(cur);
    if constexpr (SP2) {
        PG8_STAGE(PG8_SB(0, 0), cB, voffB); PG8_STAGE(PG8_SB(0, 1), cB + hstep, voffB); PG8_STAGE(PG8_SA(0, 0), cA, voffA); PG8_STAGE(PG8_SA(0, 1), cA + hstep, voffA);
        if (wr == 1) PG8_BAR;
        PG8_WAIT_V(2); PG8_BAR;
        PG8_STAGE(PG8_SB(1, 0), cB + kstep, voffB); PG8_STAGE(PG8_SA(1, 0), cA + kstep, voffA); PG8_STAGE(PG8_SB(1, 1), cB + hstep + kstep, voffB);
        PG8_WAIT_V(6); PG8_BAR;
    } else {
        PG8_STAGE(PG8_SB(0, 0), cB, voffB); PG8_STAGE(PG8_SA(0, 0), cA, voffA); PG8_STAGE(PG8_SB(0, 1), cB + hstep, voffB); PG8_STAGE(PG8_SA(0, 1), cA + hstep, voffA);
        if (wr == 1) PG8_BAR;
        PG8_WAIT_V(4); PG8_BAR;
        PG8_STAGE(PG8_SB(1, 0), cB + kstep, voffB); PG8_STAGE(PG8_SA(1, 0), cA + kstep, voffA); PG8_STAGE(PG8_SB(1, 1), cB + hstep + kstep, voffB);
        PG8_WAIT_V(6); PG8_BAR;
    }
    for (;;) {
        const bool has_next = S.next(ui + 1, nxt);
        const char* nA = has_next ? (const char*)g.A + (size_t)nxt.pm * tstep : cA; const char* nB = has_next ? (const char*)g.Bt + (size_t)nxt.pn * tstep : cB;
        for (int t = 0; t < nt; t += 2) {
            const bool last = (t == nt - 2);
            const char* a1 = cA + (size_t)(t + 1) * kstep;
            const char* a2 = last ? nA : cA + (size_t)(t + 2) * kstep; const char* b2 = last ? nB : cB + (size_t)(t + 2) * kstep;
            const char* a3 = a2 + kstep; const char* b3 = b2 + kstep;
            if (last && has_next) S.a_ready(nxt);
            if constexpr (SP2) {
            PG8_LDB(B0, 0, 0); PG8_LDB(B1, 0, 1); PG8_SCHED; PG8_LDA(At, 0, 0); PG8_STAGE(PG8_SA(1, 1), a1 + hstep, voffA);
            PG8_WAIT_V(8); PG8_WAIT_L(0); PG8_BAR; PG8_MMA(0, 0, At, B0); PG8_MMA(0, 1, At, B1); PG8_BAR; PG8_SCHED;
            PG8_LDA(At, 0, 1); PG8_STAGE(PG8_SB(0, 0), b2, voffB); PG8_STAGE(PG8_SB(0, 1), b2 + hstep, voffB); PG8_STAGE(PG8_SA(0, 0), a2, voffA);
            PG8_WAIT_V(8); PG8_WAIT_L(0); PG8_BAR; PG8_MMA(1, 0, At, B0); PG8_MMA(1, 1, At, B1); PG8_BAR; PG8_SCHED;
            PG8_LDB(B0, 1, 0); PG8_LDB(B1, 1, 1); PG8_SCHED; PG8_LDA(At, 1, 0); PG8_STAGE(PG8_SA(0, 1), a2 + hstep, voffA);
            PG8_WAIT_V(8); PG8_WAIT_L(0); PG8_BAR; PG8_MMA(0, 0, At, B0); PG8_MMA(0, 1, At, B1); PG8_BAR; PG8_SCHED;
            PG8_LDA(At, 1, 1); PG8_STAGE(PG8_SB(1, 0), b3, voffB); PG8_STAGE(PG8_SB(1, 1), b3 + hstep, voffB); PG8_STAGE(PG8_SA(1, 0), a3, voffA);
            PG8_WAIT_V(8); PG8_WAIT_L(0); PG8_BAR; PG8_MMA(1, 0, At, B0); PG8_MMA(1, 1, At, B1); PG8_BAR; PG8_SCHED;
            } else {
            PG8_LDB(B0, 0, 0); PG8_SCHED; PG8_LDA(At, 0, 0); PG8_STAGE(PG8_SA(1, 1), a1 + hstep, voffA);
            PG8_WAIT_L(8); PG8_BAR; PG8_WAIT_L(0); PG8_MMA(0, 0, At, B0); PG8_BAR; PG8_SCHED;
            PG8_LDB(B1, 0, 1); PG8_STAGE(PG8_SB(0, 0), b2, voffB);
            PG8_BAR; PG8_WAIT_L(0); PG8_MMA(0, 1, At, B1); PG8_BAR;
            PG8_LDA(At, 0, 1); PG8_STAGE(PG8_SA(0, 0), a2, voffA);
            PG8_BAR; PG8_WAIT_L(0); PG8_MMA(1, 0, At, B0); PG8_BAR; PG8_SCHED;
            PG8_STAGE(PG8_SB(0, 1), b2 + hstep, voffB);
            PG8_WAIT_V(6); PG8_BAR; PG8_MMA(1, 1, At, B1); PG8_BAR;
            PG8_LDB(B0, 1, 0); PG8_SCHED; PG8_LDA(At, 1, 0); PG8_STAGE(PG8_SA(0, 1), a2 + hstep, voffA);
            PG8_WAIT_L(8); PG8_BAR; PG8_WAIT_L(0); PG8_MMA(0, 0, At, B0); PG8_BAR; PG8_SCHED;
            PG8_LDB(B1, 1, 1); PG8_STAGE(PG8_SB(1, 0), b3, voffB);
            PG8_BAR; PG8_WAIT_L(0); PG8_MMA(0, 1, At, B1); PG8_BAR;
            PG8_LDA(At, 1, 1); PG8_STAGE(PG8_SA(1, 0), a3, voffA);
            PG8_BAR; PG8_WAIT_L(0); PG8_MMA(1, 0, At, B0); PG8_BAR; PG8_SCHED;
            PG8_STAGE(PG8_SB(1, 1), b3 + hstep, voffB);
            PG8_WAIT_V(6); PG8_BAR; PG8_MMA(1, 1, At, B1); PG8_BAR;
            }
        }
        if constexpr (ALIGN_EPI) { if (wr == 0) PG8_BAR; }
        if constexpr (!Epi::AFTER_DRAIN) { E(acc, cur, wr, wc, fr, fq); S.done(cur); }
        if (!has_next) break;
#pragma unroll
        for (int a = 0; a < 2; ++a)
#pragma unroll
            for (int b = 0; b < 2; ++b)
#pragma unroll
                for (int m = 0; m < 4; ++m)
#pragma unroll
                    for (int n = 0; n < 2; ++n) acc[a][b][m][n] = (f32x4){0.f, 0.f, 0.f, 0.f};
        cur = nxt; cA = nA; cB = nB; ++ui;
        if constexpr (ALIGN_EPI) { if (wr == 1) PG8_BAR; }
    }
    PG8_WAIT_V(0);
    if constexpr (!ALIGN_EPI) { if (wr == 0) PG8_BAR; }
    PG8_BAR;
    if constexpr (Epi::AFTER_DRAIN) { E.fused(acc, cur, wr, wc, fr, fq, lds, wid, lane); S.done(cur); }
#undef PG8_SA
#undef PG8_SB
#undef PG8_STAGE
#undef PG8_LDA
#undef PG8_LDB
#undef PG8_MMA
#undef PG8_WAIT_V
#undef PG8_WAIT_L
#undef PG8_BAR
#undef PG8_SCHED
}
}

constexpr int DM = 2048, NB = 8, SEQ = 4096, NMETA = 16, LSEQ = 4112, LPAD = 4128;
constexpr int MREAL = NB * SEQ;
constexpr int MPAD = MREAL + 256;
constexpr int MT_REAL = MREAL / 256;
constexpr int DFF = 5632, NGU = 2 * DFF, NNG = 7168, NGATE = 8192, INCOLS = 15184, NGC = 6992;
constexpr int NWAVES = 8;
constexpr float EPS = 1e-6f;
constexpr int C_AQ = 0, C_AF = 512, C_AI = 1024, C_AG = 1536, C_BB = 2048, C_BC = 2560, C_BU = 3072, C_CQ = 3584, C_CK = 4096, C_CV = 4608,
              C_DQ = 5120, C_DK = 5632, C_DV = 5760, C_DQI = 5888, C_DKI = 6912, C_DW = 6976;

constexpr size_t MiB = 1u << 20;
constexpr size_t WS_CTL = 0, CTL_ZERO_BYTES = 1 * MiB;
constexpr size_t WS_HM = 1 * MiB;
constexpr size_t WS_W = 4 * MiB;
constexpr size_t W_GU1 = 0, W_D1 = W_GU1 + (size_t)NGU * DM * 2, W_NG = W_D1 + (size_t)DM * DFF * 2, W_G = W_NG + (size_t)NNG * DM * 2,
                 W_BR = W_G + (size_t)NGATE * DM * 2, W_O = W_BR + (size_t)4 * DM * 512 * 2, W_GU2 = W_O + (size_t)DM * DM * 2, W_D2 = W_GU2 + (size_t)NGU * DM * 2,
                 W_END = W_D2 + (size_t)DM * DFF * 2;
constexpr size_t WS_XN = WS_W + W_END;
constexpr size_t WS_BR = WS_XN + (size_t)MPAD * DM * 2;
constexpr size_t WS_BIG = WS_BR + (size_t)MPAD * DM * 2;
constexpr size_t BIG_P_END = (size_t)MPAD * NNG * 2;
constexpr size_t WS_VTC = WS_BIG + BIG_P_END;
constexpr size_t WS_VTD = WS_VTC + (size_t)NB * 4 * 128 * LPAD * 2;
constexpr size_t WS_MASK = WS_VTD + (size_t)NB * 128 * LPAD * 2;
constexpr int MASKW = 132;
constexpr int NIDX_WG = 172;
constexpr int NHG_WG = 32;
constexpr size_t WS_SCR = WS_MASK + (size_t)NB * LPAD * MASKW * 4;
constexpr size_t WS_HA = WS_SCR + (size_t)NIDX_WG * 32 * LPAD * 4;
constexpr size_t WS_HDL = WS_HA + (size_t)NB * 4 * 64 * 64 * 64 * 2;
constexpr size_t WS_HMETA = WS_HDL + (size_t)NB * 4 * 64 * 128 * 4;
constexpr size_t HMETA_STRIDE = 64 * 384 * 2 + 64 * 64 * 2 + 128 * 4;
constexpr size_t WS_END = WS_HMETA + 4 * HMETA_STRIDE;
static_assert(WS_BIG + (size_t)MPAD * NGATE * 2 <= WS_END, "G fits");
static_assert(WS_END <= (size_t)1138174976, "workspace map fits the guaranteed size");

constexpr int RING_OFF = 0, RING_BYTES = 131072;
constexpr int LDSCTL_OFF = 143360, MISC_OFF = LDSCTL_OFF + 320;
constexpr int LDS_BYTES = 147456;

#define GAS __attribute__((address_space(1)))
#define LAS __attribute__((address_space(3)))
typedef unsigned short bf16;
typedef unsigned v4u __attribute__((ext_vector_type(4)));
typedef unsigned v2u __attribute__((ext_vector_type(2)));
typedef float f32x4 __attribute__((ext_vector_type(4)));
typedef float f32x16 __attribute__((ext_vector_type(16)));
typedef short bf16x8 __attribute__((ext_vector_type(8)));
typedef GAS unsigned gu32;
#define RLX_AGENT __ATOMIC_RELAXED, __HIP_MEMORY_SCOPE_AGENT
#define LDS_WAIT() asm volatile("s_waitcnt lgkmcnt(0)" ::: "memory")
#define VM_WAIT() asm volatile("s_waitcnt vmcnt(0)" ::: "memory")
__device__ __forceinline__ unsigned f2bf(float f) { unsigned u = __builtin_bit_cast(unsigned, f); return (u + 0x7fffu + ((u >> 16) & 1u)) >> 16; }
__device__ __forceinline__ unsigned f2bf_s(float f) { return pg8::cvt_pk_bf16(f, 0.f) & 0xffffu; }
__device__ __forceinline__ unsigned pk2(float lo, float hi) { return pg8::cvt_pk_bf16(lo, hi); }
__device__ __forceinline__ float bflo(unsigned w) { return __uint_as_float(w << 16); }
__device__ __forceinline__ float bfhi(unsigned w) { return __uint_as_float(w & 0xffff0000u); }
__device__ __forceinline__ float bf2f(bf16 v) { return __uint_as_float((unsigned)v << 16); }
__device__ __forceinline__ int seqrow(int b, int p) { return p < NMETA ? MREAL + p : b * SEQ + p - NMETA; }
__device__ __forceinline__ int rel_bucket(int n) {
    if (n < 16) return n; if (n >= 128) return 31;
    const int v = 16 + (int)(__log2f((float)n * 0.0625f) * 5.33333333f); return v < 31 ? v : 31; }
__device__ __forceinline__ float wave_sum(float v) {
#pragma unroll
    for (int o = 1; o < 64; o <<= 1) v += __shfl_xor(v, o);
    return v;
}
#define XB_TMO      128
#define XB_XCNT(j)  (256  + 64 * (j))
#define XB_XSUB(j)  (1280 + 64 * (j))
#define XB_XGEN(j)  (2304 + 64 * (j))
#define XB_TOP      3328
#define XB_TOPGEN   3392
#define XCD_BAR_WORDS 3456
#define XB_SPIN_CAP (1u << 18)

__device__ __forceinline__ unsigned xb_ld(unsigned* p)              { return __hip_atomic_load(p, __ATOMIC_RELAXED, __HIP_MEMORY_SCOPE_AGENT); }
__device__ __forceinline__ unsigned xb_add(unsigned* p, unsigned v) { return __hip_atomic_fetch_add(p, v, __ATOMIC_RELAXED, __HIP_MEMORY_SCOPE_AGENT); }
__device__ __forceinline__ unsigned xb_xcc_id() { return (unsigned)__builtin_amdgcn_s_getreg((3 << 11) | 20) & 0xFu; }
#define XB_SPIN(cond, bar) do { unsigned _sp = 0; while (cond) { __builtin_amdgcn_s_sleep(1); \
    if ((++_sp & 255u) == 0u) { if (xb_ld(&(bar)[XB_TMO])) break; if (_sp > XB_SPIN_CAP) { atomicAdd(&(bar)[XB_TMO], 1u); break; } } } } while (0)

struct XcdBarrier {
    int wave;
    unsigned* bar; unsigned x;
    volatile LAS unsigned* st;
};

__device__ __forceinline__ bool xb_thread0(int wave) { unsigned mk = ~0u; asm volatile("" : "+s"(mk)); return wave == 0 && __builtin_amdgcn_mbcnt_hi(mk, __builtin_amdgcn_mbcnt_lo(mk, 0u)) == 0u; }
__device__ __forceinline__ XcdBarrier xcd_barrier_post(unsigned* bar, volatile LAS unsigned* st, int wave) {
    XcdBarrier b; b.wave = wave; b.bar = bar; b.x = xb_xcc_id(); b.st = st;
    if (xb_thread0(wave)) (void)xb_add(&bar[XB_XCNT(b.x)], 1u);
    return b;
}
__device__ __forceinline__ void xcd_barrier_complete(unsigned* bar, unsigned x, unsigned& nloc, unsigned& nx) {
    const unsigned G = gridDim.x * gridDim.y * gridDim.z;
    unsigned sum, cnt, mine, sp = 0u;
    for (;;) {
        sum = 0u; cnt = 0u; mine = 0u;
#pragma unroll
        for (unsigned j = 0; j < 16; ++j) { const unsigned c = xb_ld(&bar[XB_XCNT(j)]); sum += c; cnt += (c > 0u) ? 1u : 0u; mine = (j == x) ? c : mine; }
        if (sum == G) break;
        __builtin_amdgcn_s_sleep(1);
        if ((++sp & 255u) == 0u) { if (xb_ld(&bar[XB_TMO])) break; if (sp > XB_SPIN_CAP) { atomicAdd(&bar[XB_TMO], 1u); break; } }
    }
    nloc = mine > 0u ? mine : 1u; nx = cnt > 0u ? cnt : 1u;
}

__device__ __forceinline__ void xcd_barrier(const XcdBarrier& b) {
    asm volatile("s_waitcnt vmcnt(0)" ::: "memory");
    __syncthreads();
    if (xb_thread0(b.wave)) {
        unsigned* bar = b.bar;
        __builtin_amdgcn_s_waitcnt(0);
        unsigned nloc = b.st[0], nx = b.st[1];
        if (nloc == 0u) { xcd_barrier_complete(bar, b.x, nloc, nx); b.st[0] = nloc; b.st[1] = nx; }
        const unsigned old = xb_add(&bar[XB_XSUB(b.x)], 1u);
        const unsigned gen = old / nloc;
        if (old + 1u == (gen + 1u) * nloc) {
            __builtin_amdgcn_fence(__ATOMIC_RELEASE, "agent");
            asm volatile("s_waitcnt vmcnt(0)" ::: "memory");
            const unsigned og = xb_add(&bar[XB_TOP], 1u);
            const unsigned tg = og / nx;
            if (og + 1u == (tg + 1u) * nx) xb_add(&bar[XB_TOPGEN], 1u);
            else XB_SPIN(xb_ld(&bar[XB_TOPGEN]) == tg, bar);
            __builtin_amdgcn_fence(__ATOMIC_ACQUIRE, "agent");
            xb_add(&bar[XB_XGEN(b.x)], 1u);
            asm volatile("s_waitcnt vmcnt(0)" ::: "memory");
        } else {
            XB_SPIN(xb_ld(&bar[XB_XGEN(b.x)]) == gen, bar);
            __builtin_amdgcn_fence(__ATOMIC_ACQUIRE, "agent");
            asm volatile("s_waitcnt vmcnt(0)" ::: "memory");
        }
    }
    __syncthreads();
}

struct Frame {
    LAS unsigned char* lds;
    volatile LAS unsigned* MISC;
    gu32* ctl;
    int tid, lane, wave, G, bid;
    const unsigned char __attribute__((address_space(4)))* karg; float* out; unsigned char* ws;
};
__device__ __forceinline__ const float* fin_load(const unsigned char __attribute__((address_space(4)))* k, int i) { asm volatile("" : "+s"(k)); return *(const float* const __attribute__((address_space(4)))*)(k + 8 * i); }
#define FIN(F_, i_) fin_load((F_).karg, (i_))
enum { I_X = 0, I_META, I_RELB, I_F1N, I_F1GU, I_F1D, I_MIXN, I_WIN, I_LB, I_GN, I_CONVW, I_DQN, I_DKN, I_DLAM, I_DSUB, I_SQN, I_SKN, I_WBR, I_WOUT, I_F2N, I_F2GU, I_F2D };

template <class RowMap>
__device__ __forceinline__ void transpose_item(const float* W, int K, int N, bf16* WT, LAS float* scr, int item, int lane, RowMap rm) {
    const int nblk = (N + 31) / 32, kb = item / nblk, nb = item % nblk, k0 = 64 * kb, n0 = 32 * nb;
    const int nl = n0 + (lane & 31); const bool nok = nl < N;
    { float wv[32]; const float* wp = W + (size_t)(k0 + (lane >> 5)) * N + (nok ? nl : 0);
#pragma unroll
      for (int i = 0; i < 32; ++i) wv[i] = wp[(size_t)(2 * i) * N];
      __builtin_amdgcn_sched_barrier(0);
#pragma unroll
      for (int i = 0; i < 32; ++i) scr[(2 * i + (lane >> 5)) * 33 + (lane & 31)] = nok ? wv[i] : 0.f; }
    LDS_WAIT(); asm volatile("" ::: "memory");
    const int c = lane & 7;
#pragma unroll
    for (int j = 0; j < 4; ++j) { const int n = (lane >> 3) + 8 * j; const LAS float* s = scr + (8 * c) * 33 + n;
        v4u o; o.x = pk2(s[0 * 33], s[1 * 33]); o.y = pk2(s[2 * 33], s[3 * 33]); o.z = pk2(s[4 * 33], s[5 * 33]); o.w = pk2(s[6 * 33], s[7 * 33]);
        if (n0 + n < N) *(GAS v4u*)(WT + (size_t)rm(n0 + n) * K + k0 + 8 * c) = o; }
    LDS_WAIT(); asm volatile("" ::: "memory");
}
struct MapId { __device__ __forceinline__ int operator()(int n) const { return n; } };
struct MapGU { __device__ __forceinline__ int operator()(int n) const { const int up = n >= DFF, j = up ? n - DFF : n; return 256 * (j >> 7) + 128 * up + (j & 127); } };
struct MapIn { __device__ __forceinline__ int operator()(int n) const { return n < NGC ? n : n + (NNG - NGC); } };
template <class RowMap>
__device__ __forceinline__ void convert_matrix(Frame& F, const float* W, int K, int N, bf16* WT, RowMap rm) {
    LAS float* scr = (LAS float*)(F.lds + F.wave * 16384);
    const int gw = F.bid * NWAVES + F.wave, NGW = F.G * NWAVES, nitems = (K / 64) * ((N + 31) / 32);
    for (int it = gw; it < nitems; it += NGW) transpose_item(W, K, N, WT, scr, it, F.lane, rm);
}
__device__ __forceinline__ void phase_convert(Frame& F, int l) {
    unsigned char* wb = F.ws + WS_W;
    convert_matrix(F, FIN(F, I_F1GU) + (size_t)l * DM * NGU, DM, NGU, (bf16*)(wb + W_GU1), MapGU());
    convert_matrix(F, FIN(F, I_F1D) + (size_t)l * DFF * DM, DFF, DM, (bf16*)(wb + W_D1), MapId());
    convert_matrix(F, FIN(F, I_WIN) + (size_t)l * DM * INCOLS, DM, INCOLS, (bf16*)(wb + W_NG), MapIn());
    for (int m = 0; m < 4; ++m) convert_matrix(F, FIN(F, I_WBR) + ((size_t)l * 4 + m) * 512 * DM, 512, DM, (bf16*)(wb + W_BR) + (size_t)m * DM * 512, MapId());
    convert_matrix(F, FIN(F, I_WOUT) + (size_t)l * DM * DM, DM, DM, (bf16*)(wb + W_O), MapId());
    convert_matrix(F, FIN(F, I_F2GU) + (size_t)l * DM * NGU, DM, NGU, (bf16*)(wb + W_GU2), MapGU());
    convert_matrix(F, FIN(F, I_F2D) + (size_t)l * DFF * DM, DFF, DM, (bf16*)(wb + W_D2), MapId());
    { GAS v4u* z = (GAS v4u*)(wb + W_NG + (size_t)NGC * DM * 2); const int n16 = (NNG - NGC) * DM * 2 / 16;
      for (int i = F.bid * 512 + F.tid; i < n16; i += F.G * 512) z[i] = (v4u){0u, 0u, 0u, 0u}; }
    if (l == 0) {
        GAS f32x4* hm = (GAS f32x4*)(F.ws + WS_HM); const GAS f32x4* mt = (const GAS f32x4*)FIN(F, I_META);
        for (int i = F.bid * 512 + F.tid; i < 256 * DM / 4; i += F.G * 512) hm[i] = (i < NMETA * DM / 4) ? mt[i] : (f32x4){0.f, 0.f, 0.f, 0.f};
    }
}
__device__ __forceinline__ void phase_norm(Frame& F, const float* src_real, const float* gain) {
    const int gw = F.bid * NWAVES + F.wave, NGW = F.G * NWAVES;
    bf16* XN = (bf16*)(F.ws + WS_XN); const float* hm = (const float*)(F.ws + WS_HM);
    f32x4 g[8];
#pragma unroll
    for (int j = 0; j < 8; ++j) g[j] = ((const GAS f32x4*)gain)[F.lane + 64 * j];
    for (int r = gw; r < MPAD; r += NGW) {
        GAS v2u* o8 = (GAS v2u*)(XN + (size_t)r * DM) + F.lane;
        if (r >= MREAL + NMETA) {
#pragma unroll
            for (int j = 0; j < 8; ++j) o8[64 * j] = (v2u){0u, 0u};
            continue; }
        const float* xr = r < MREAL ? src_real + (size_t)r * DM : hm + (size_t)(r - MREAL) * DM;
        f32x4 v[8]; float s = 0.f;
#pragma unroll
        for (int j = 0; j < 8; ++j) { v[j] = ((const GAS f32x4*)xr)[F.lane + 64 * j]; s += (v[j].x * v[j].x + v[j].y * v[j].y) + (v[j].z * v[j].z + v[j].w * v[j].w); }
        const float inv = 1.0f / sqrtf(wave_sum(s) * (1.f / DM) + EPS);
#pragma unroll
        for (int j = 0; j < 8; ++j) { v2u w; w.x = pk2(v[j].x * inv * g[j].x, v[j].y * inv * g[j].y); w.y = pk2(v[j].z * inv * g[j].z, v[j].w * inv * g[j].w); o8[64 * j] = w; }
    }
}

__device__ __forceinline__ f32x4 meta_dot16(const bf16* A  , int lda, const bf16* Bt  , int K, int s0, int s1, int lane) {
    const int fr = lane & 15, g = lane >> 4; const bf16* ap = A + (size_t)fr * lda + 8 * g; const bf16* bp = Bt + (size_t)fr * K + 8 * g;
    f32x4 a0 = (f32x4){0.f, 0.f, 0.f, 0.f}, a1 = a0;
    for (int s = s0; s < s1; s += 2) {
        const bf16x8 x0 = *(const GAS bf16x8*)(ap + 32 * s), x1 = *(const GAS bf16x8*)(ap + 32 * s + 32);
        const bf16x8 w0 = *(const GAS bf16x8*)(bp + 32 * s), w1 = *(const GAS bf16x8*)(bp + 32 * s + 32);
        a0 = __builtin_amdgcn_mfma_f32_16x16x32_bf16(w0, x0, a0, 0, 0, 0); a1 = __builtin_amdgcn_mfma_f32_16x16x32_bf16(w1, x1, a1, 0, 0, 0); }
    return a0 + a1;
}
__device__ __forceinline__ void st_bf16x4(bf16* p, f32x4 v) { v2u w; w.x = pk2(v[0], v[1]); w.y = pk2(v[2], v[3]); *(GAS v2u*)p = w; }
__device__ __forceinline__ void meta_gemm(Frame& F, int kind, const bf16* A, int lda, const bf16* Bt, int N, int K, bf16* Obf, int ldo, float scale) {
    const int lane = F.lane, wave = F.wave, fr = lane & 15, g = lane >> 4;
    const int ngroups = (kind == 0 ? N / 2 : N) / 16;
    LAS f32x4* red = (LAS f32x4*)F.lds;
    const int ns = K / 32, s0 = (wave * ns) >> 3, s1 = ((wave + 1) * ns) >> 3;
    for (int cg = F.bid; cg < ngroups; cg += F.G) {
        const int n0 = 16 * cg;
        f32x4 p0, p1 = (f32x4){0.f, 0.f, 0.f, 0.f};
        if (kind == 0) { const int rg = 256 * (n0 >> 7) + (n0 & 127);
            p0 = meta_dot16(A, lda, Bt + (size_t)rg * K, K, s0, s1, lane); p1 = meta_dot16(A, lda, Bt + (size_t)(rg + 128) * K, K, s0, s1, lane); }
        else if (kind == 4) { const int mb = wave >> 1, kh = wave & 1; p0 = meta_dot16(A + (size_t)mb * MPAD * 512, 512, Bt + ((size_t)mb * DM + n0) * 512, 512, 8 * kh, 8 * kh + 8, lane); }
        else p0 = meta_dot16(A, lda, Bt + (size_t)n0 * K, K, s0, s1, lane);
        red[wave * 64 + lane] = p0; if (kind == 0) red[512 + wave * 64 + lane] = p1;
        LDS_WAIT(); __syncthreads();
        if (wave == 0) {
            f32x4 q[8];
#pragma unroll
            for (int w = 0; w < 8; ++w) q[w] = red[w * 64 + lane];
            if (kind == 4) { f32x4 tot = (f32x4){0.f, 0.f, 0.f, 0.f}; const bf16* G = (const bf16*)(F.ws + WS_BIG);
#pragma unroll
                for (int mb = 0; mb < 4; ++mb) { const f32x4 acc = q[2 * mb] + q[2 * mb + 1]; const v2u gw2 = *(const GAS v2u*)(G + (size_t)(MREAL + fr) * NGATE + mb * DM + n0 + 4 * g);
                    tot[0] += bflo(gw2.x) * acc[0]; tot[1] += bfhi(gw2.x) * acc[1]; tot[2] += bflo(gw2.y) * acc[2]; tot[3] += bfhi(gw2.y) * acc[3]; }
                st_bf16x4(Obf + (size_t)(MREAL + fr) * ldo + n0 + 4 * g, tot);
            } else {
                f32x4 acc = ((q[0] + q[1]) + (q[2] + q[3])) + ((q[4] + q[5]) + (q[6] + q[7]));
                if (kind == 0) { f32x4 up = (f32x4){0.f, 0.f, 0.f, 0.f};
#pragma unroll
                    for (int w = 0; w < 8; ++w) up += red[512 + w * 64 + lane];
#pragma unroll
                    for (int r = 0; r < 4; ++r) acc[r] = pg8::fast_silu(acc[r]) * up[r];
                    st_bf16x4(Obf + (size_t)(MREAL + fr) * ldo + n0 + 4 * g, acc); }
                else if (kind == 1) { float* hp = (float*)(F.ws + WS_HM) + (size_t)fr * DM + n0 + 4 * g; *(GAS f32x4*)hp = *(const GAS f32x4*)hp + acc * scale; }
                else if (kind == 2) st_bf16x4(Obf + (size_t)(MREAL + fr) * ldo + n0 + 4 * g, acc);
                else {
#pragma unroll
                    for (int r = 0; r < 4; ++r) acc[r] = pg8::fast_sigmoid(acc[r]);
                    st_bf16x4(Obf + (size_t)(MREAL + fr) * ldo + n0 + 4 * g, acc); }
            }
        }
        __syncthreads();
    }
}
__device__ __forceinline__ void unpack8(const v4u w, float (&x)[8]) { x[0] = bflo(w.x); x[1] = bfhi(w.x); x[2] = bflo(w.y); x[3] = bfhi(w.y); x[4] = bflo(w.z); x[5] = bfhi(w.z); x[6] = bflo(w.w); x[7] = bfhi(w.w); }
__device__ __forceinline__ v4u pack8(const float (&x)[8]) { v4u w; w.x = pk2(x[0], x[1]); w.y = pk2(x[2], x[3]); w.z = pk2(x[4], x[5]); w.w = pk2(x[6], x[7]); return w; }
template <int GL>
__device__ __forceinline__ void norm_cols_inplace(bf16* p, const v4u w, const float* gain, float scale, int lane, bool wr) {
    float x[8]; unpack8(w, x); float s = 0.f;
#pragma unroll
    for (int i = 0; i < 8; ++i) s += x[i] * x[i];
#pragma unroll
    for (int o = 1; o < GL; o <<= 1) s += __shfl_xor(s, o);
    const float inv = scale / sqrtf(s * (1.f / (GL * 8)) + EPS); const int g0 = (8 * lane) % (GL * 8);
#pragma unroll
    for (int i = 0; i < 8; ++i) x[i] = x[i] * inv * gain[g0 + i];
    if (wr) *(GAS v4u*)p = pack8(x);
}
__device__ __forceinline__ void prep_row(Frame& F, int l, int r) {
    const int lane = F.lane; bf16* pr = (bf16*)(F.ws + WS_BIG) + (size_t)r * NNG;
    const float *dqn = FIN(F, I_DQN) + l * 64, *dkn = FIN(F, I_DKN) + l * 64, *sqn = FIN(F, I_SQN) + l * 128, *skn = FIN(F, I_SKN) + l * 128;
    const v4u w0 = *(const GAS v4u*)(pr + C_CQ + 8 * lane), w1 = *(const GAS v4u*)(pr + C_CK + 8 * lane), w2 = *(const GAS v4u*)(pr + C_DQ + 8 * lane), w3 = *(const GAS v4u*)(pr + C_DK + 8 * (lane & 15));
    __builtin_amdgcn_sched_barrier(0);
    norm_cols_inplace<8>(pr + C_CQ + 8 * lane, w0, dqn, 0.125f * 1.4426950408889634f, lane, true);
    norm_cols_inplace<8>(pr + C_CK + 8 * lane, w1, dkn, 1.0f, lane, true);
    norm_cols_inplace<16>(pr + C_DQ + 8 * lane, w2, sqn, 0.08838834764831845f * 1.4426950408889634f, lane, true);
    norm_cols_inplace<16>(pr + C_DK + 8 * (lane & 15), w3, skn, 1.0f, lane & 15, lane < 16);
}
constexpr int VT_NPB = (LPAD + 63) / 64, VT_NTASK = NB * 5 * VT_NPB;
__device__ __forceinline__ void vt_task(Frame& F, int task) {
    const int lane = F.lane;
    const bf16* P = (const bf16*)(F.ws + WS_BIG); bf16* VtC = (bf16*)(F.ws + WS_VTC); bf16* VtD = (bf16*)(F.ws + WS_VTD);
    LAS bf16* T = (LAS bf16*)(F.lds + F.wave * 17408);
    const int pb = task % VT_NPB, mat = (task / VT_NPB) % 5, b = task / (VT_NPB * 5), p0 = 64 * pb;
    const int col = mat < 4 ? C_CV + 128 * mat : C_DV;
#pragma unroll 4
    for (int i = 0; i < 16; ++i) { const int pl = 4 * i + (lane >> 4), p = p0 + pl;
        v4u w = *(const GAS v4u*)(P + (size_t)seqrow(b, p < LSEQ ? p : LSEQ - 1) * NNG + col + 8 * (lane & 15)); if (p >= LSEQ) w = (v4u){0u, 0u, 0u, 0u};
        *(LAS v4u*)(T + pl * 136 + 8 * (lane & 15)) = w; }
    LDS_WAIT(); asm volatile("" ::: "memory");
    bf16* dst = mat < 4 ? VtC + (size_t)(b * 4 + mat) * 128 * LPAD : VtD + (size_t)b * 128 * LPAD;
#pragma unroll 4
    for (int it = 0; it < 16; ++it) { const int e = 8 * it + (lane >> 3), c = lane & 7; unsigned short x[8];
#pragma unroll
        for (int k = 0; k < 8; ++k) x[k] = T[(8 * c + k) * 136 + e];
        v4u w; w.x = x[0] | ((unsigned)x[1] << 16); w.y = x[2] | ((unsigned)x[3] << 16); w.z = x[4] | ((unsigned)x[5] << 16); w.w = x[6] | ((unsigned)x[7] << 16);
        if (p0 + 8 * c < LPAD) *(GAS v4u*)(dst + (size_t)e * LPAD + p0 + 8 * c) = w; }
    LDS_WAIT(); asm volatile("" ::: "memory");
}

#define NEG_INF (-__builtin_inff())
constexpr int NQT = (LSEQ + 31) / 32;
constexpr int NQB = (NQT + 7) / 8;
__device__ __forceinline__ bf16x8 ld_frag16(const bf16* p) { return *(const GAS bf16x8*)p; }
__device__ __forceinline__ bf16x8 mk_frag(v2u lo, v2u hi) { v4u w; w.x = lo.x; w.y = lo.y; w.z = hi.x; w.w = hi.y; return __builtin_bit_cast(bf16x8, w); }
__device__ __forceinline__ unsigned cvtpk(float lo, float hi) { return pg8::cvt_pk_bf16(lo, hi); }
__device__ __forceinline__ void build_bias_table(Frame& F, LAS float* bt, int col0) {
    const float* rb = FIN(F, I_RELB);
    for (int i = F.tid; i < 4 * 128; i += 512) { const int hd = i >> 7, n = i & 127; bt[i] = (rb[rel_bucket(n) * 8 + col0 + hd] - rb[31 * 8 + col0 + hd]) * 1.4426950408889634f; }
}
__device__ __forceinline__ bool softmax_step(f32x16& S, float& m, float& lsum, float& alpha) {
    float tm = S[0];
#pragma unroll
    for (int r = 1; r < 16; ++r) tm = fmaxf(tm, S[r]);
    const bool raise = __any(tm > m + 11.5f);
    alpha = 1.0f;
    if (raise) { tm = fmaxf(tm, __shfl_xor(tm, 32)); const float mn = fmaxf(m, tm); alpha = (mn == NEG_INF) ? 1.0f : __builtin_amdgcn_exp2f(m - mn); m = mn; lsum *= alpha; }
    const float mref = (m == NEG_INF) ? 0.f : m;
    float rs = 0.f;
#pragma unroll
    for (int r = 0; r < 16; ++r) { S[r] = __builtin_amdgcn_exp2f(S[r] - mref); rs += S[r]; }
    lsum += rs;
    return raise;
}
#ifndef NVPRE_DIFF
#define NVPRE_DIFF 4
#endif
#ifndef NVPRE_DSA
#define NVPRE_DSA 0
#endif
template <bool DSA>
__device__ __forceinline__ void attn_wg_task(Frame& F, int l, int b, int h, int J, const LAS float* bt, float lam, float post) {
    constexpr int KD = DSA ? 128 : 64, KP = KD + 8, VP = 36, NKS = KD / 16;
    constexpr int KBUF = 32 * KP, VBUF = 128 * VP;
    constexpr int NVPRE = DSA ? NVPRE_DSA : NVPRE_DIFF;
    const int lane = F.lane, ql = lane & 31, hh = lane >> 5, wave = F.wave, tid = F.tid;
    LAS bf16* Kl = (LAS bf16*)F.lds; LAS bf16* Vl = Kl + 2 * KBUF;
    const bf16* P = (const bf16*)(F.ws + WS_BIG);
    const bf16* Vt = DSA ? (const bf16*)(F.ws + WS_VTD) + (size_t)b * 128 * LPAD : (const bf16*)(F.ws + WS_VTC) + (size_t)(b * 4 + h) * 128 * LPAD;
    const int jr = 8 * J + wave - 7; const bool wvalid = jr >= 0 && 32 * jr < LSEQ; const int j = jr < 0 ? 0 : jr;
    const int ktmax = (8 * J < NQT - 1) ? 8 * J : NQT - 1;
    const int pq = 32 * j + ql, pqc = pq < LSEQ ? pq : LSEQ - 1;
    const bf16* qrow = P + (size_t)seqrow(b, pqc) * NNG + (DSA ? C_DQ : C_CQ) + h * 128 + 8 * hh;
    const unsigned* mrow = (const unsigned*)(F.ws + WS_MASK) + ((size_t)b * LPAD + pqc) * MASKW;
    const int kr = tid / (KD / 8), kc = tid % (KD / 8); const bool kload = tid < 32 * (KD / 8);
    const int vr = tid >> 2, vc = tid & 3;
    f32x16 R[4];
#pragma unroll
    for (int c = 0; c < (DSA ? 1 : 2); ++c) {
        const int kcol = DSA ? C_DK : C_CK + h * 128 + c * 64;
        bf16x8 qf[NKS];
#pragma unroll
        for (int ks = 0; ks < NKS; ++ks) qf[ks] = ld_frag16(qrow + (DSA ? 0 : c * 64) + 16 * ks);
        float m = NEG_INF, lsum = 0.f; f32x16 O[4];
#pragma unroll
        for (int eb = 0; eb < 4; ++eb)
#pragma unroll
            for (int r = 0; r < 16; ++r) O[eb][r] = 0.f;
        v4u rk0 = (v4u){0u, 0u, 0u, 0u}, rv0 = rk0, rk1 = rk0, rv1 = rk0;
#define ATT_ISSUE(kt_, RK, RV) do { int pk_ = 32 * (kt_) + kr; pk_ = pk_ < LSEQ ? pk_ : LSEQ - 1; \
            if (kload) RK = *(const GAS v4u*)(P + (size_t)seqrow(b, pk_) * NNG + kcol + 8 * kc); \
            RV = *(const GAS v4u*)(Vt + (size_t)vr * LPAD + 32 * (kt_) + 8 * vc); } while (0)
#define ATT_COMMIT(buf_, RK, RV) do { if (kload) *(LAS v4u*)(Kl + (buf_) * KBUF + kr * KP + 8 * kc) = RK; \
            LAS v2u* vd_ = (LAS v2u*)(Vl + (buf_) * VBUF + vr * VP + 8 * vc); vd_[0] = (v2u){RV.x, RV.y}; vd_[1] = (v2u){RV.z, RV.w}; } while (0)
        unsigned mwc = 0xffffffffu, mwn = 0xffffffffu; if (DSA) mwc = mrow[0];
        auto compute = [&](int kt, int buf) {
            if (DSA) mwn = mrow[kt + 1 <= ktmax ? kt + 1 : ktmax];
            if (wvalid && kt <= j) {
                const LAS bf16* Kt = Kl + buf * KBUF + ql * KP + 8 * hh; const LAS bf16* Vb = Vl + buf * VBUF + ql * VP + 4 * hh;
                f32x16 S;
#pragma unroll
                for (int r = 0; r < 16; ++r) S[r] = 0.f;
#pragma unroll
                for (int ks = 0; ks < NKS; ++ks) S = __builtin_amdgcn_mfma_f32_32x32x16_bf16(*(const LAS bf16x8*)(Kt + 16 * ks), qf[ks], S, 0, 0, 0);
                const unsigned mw = mwc >> (4 * hh);
                if (kt + 4 >= j) {
#pragma unroll
                    for (int r = 0; r < 16; ++r) { const int ko = (r & 3) + 8 * (r >> 2), n = pq - (32 * kt + 4 * hh + ko); const bool sel = ((mw >> ko) & 1u) && n >= 0;
                        S[r] = sel ? S[r] + bt[h * 128 + (n < 127 ? n : 127)] : NEG_INF; }
                } else if (DSA) {
#pragma unroll
                    for (int r = 0; r < 16; ++r) { const int ko = (r & 3) + 8 * (r >> 2); S[r] = ((mw >> ko) & 1u) ? S[r] : NEG_INF; }
                }
                bf16x8 vf[NVPRE > 0 ? NVPRE : 1];
#pragma unroll
                for (int i = 0; i < NVPRE; ++i) { const LAS bf16* vp = Vb + (i >> 1) * 32 * VP + 16 * (i & 1); vf[i] = mk_frag(*(const LAS v2u*)vp, *(const LAS v2u*)(vp + 8)); }
                float alpha;
                if (softmax_step(S, m, lsum, alpha)) {
#pragma unroll
                    for (int eb = 0; eb < 4; ++eb)
#pragma unroll
                        for (int r = 0; r < 16; ++r) O[eb][r] *= alpha;
                }
                bf16x8 pf[2];
#pragma unroll
                for (int s = 0; s < 2; ++s) { v4u w; w.x = cvtpk(S[8 * s + 0], S[8 * s + 1]); w.y = cvtpk(S[8 * s + 2], S[8 * s + 3]); w.z = cvtpk(S[8 * s + 4], S[8 * s + 5]); w.w = cvtpk(S[8 * s + 6], S[8 * s + 7]); pf[s] = __builtin_bit_cast(bf16x8, w); }
#pragma unroll
                for (int eb = 0; eb < 4; ++eb)
#pragma unroll
                    for (int s = 0; s < 2; ++s) { const LAS bf16* vp = Vb + eb * 32 * VP + 16 * s;
                        O[eb] = __builtin_amdgcn_mfma_f32_32x32x16_bf16((2 * eb + s < NVPRE) ? vf[(2 * eb + s < NVPRE) ? 2 * eb + s : 0] : mk_frag(*(const LAS v2u*)vp, *(const LAS v2u*)(vp + 8)), pf[s], O[eb], 0, 0, 0); }
            }
            if (DSA) mwc = mwn; };
        __syncthreads();
        ATT_ISSUE(0, rk0, rv0); ATT_COMMIT(0, rk0, rv0);
        if (ktmax >= 1) ATT_ISSUE(1, rk1, rv1);
        for (int kt = 0; kt <= ktmax; kt += 2) {
            LDS_WAIT(); __syncthreads();
            if (kt + 2 <= ktmax) ATT_ISSUE(kt + 2, rk0, rv0);
            compute(kt, 0);
            if (kt + 1 <= ktmax) ATT_COMMIT(1, rk1, rv1);
            if (kt + 1 > ktmax) break;
            LDS_WAIT(); __syncthreads();
            if (kt + 3 <= ktmax) ATT_ISSUE(kt + 3, rk1, rv1);
            compute(kt + 1, 1);
            if (kt + 2 <= ktmax) ATT_COMMIT(0, rk0, rv0);
        }
#undef ATT_ISSUE
#undef ATT_COMMIT
        lsum += __shfl_xor(lsum, 32); const float il = 1.0f / lsum;
        if (DSA) {
#pragma unroll
            for (int eb = 0; eb < 4; ++eb)
#pragma unroll
                for (int r = 0; r < 16; ++r) R[eb][r] = O[eb][r] * il;
        } else if (c == 0) {
            LAS unsigned* rp = (LAS unsigned*)(F.lds + 28672) + wave * 2048 + lane;
#pragma unroll
            for (int eb = 0; eb < 4; ++eb)
#pragma unroll
                for (int r = 0; r < 16; r += 2) rp[(eb * 8 + (r >> 1)) * 64] = pk2(O[eb][r] * il, O[eb][r + 1] * il);
        } else {
            const LAS unsigned* rp = (const LAS unsigned*)(F.lds + 28672) + wave * 2048 + lane;
#pragma unroll
            for (int eb = 0; eb < 4; ++eb)
#pragma unroll
                for (int r = 0; r < 16; r += 2) { const unsigned w = rp[(eb * 8 + (r >> 1)) * 64]; R[eb][r] = bflo(w) - lam * (O[eb][r] * il); R[eb][r + 1] = bfhi(w) - lam * (O[eb][r + 1] * il); }
        }
    }
    float inv = 1.0f;
    if (!DSA) { float ss = 0.f;
#pragma unroll
        for (int eb = 0; eb < 4; ++eb)
#pragma unroll
            for (int r = 0; r < 16; ++r) ss += R[eb][r] * R[eb][r];
        ss += __shfl_xor(ss, 32); inv = post / sqrtf(ss * (1.f / 128.f) + EPS); }
    const float* sub = FIN(F, I_DSUB) + l * 128;
    if (wvalid && pq < LSEQ && (pq >= NMETA || b == 0)) {
        bf16* orow = (bf16*)(F.ws + WS_BR) + (size_t)(DSA ? 3 : 2) * MPAD * 512 + (size_t)seqrow(b, pq) * 512 + h * 128;
#pragma unroll
        for (int eb = 0; eb < 4; ++eb)
#pragma unroll
            for (int g = 0; g < 4; ++g) { const int e0 = 32 * eb + 8 * g + 4 * hh; f32x4 sv = (f32x4){1.f, 1.f, 1.f, 1.f}; if (!DSA) sv = *(const GAS f32x4*)(sub + e0);
                v2u w; w.x = pk2(R[eb][4 * g] * inv * sv.x, R[eb][4 * g + 1] * inv * sv.y); w.y = pk2(R[eb][4 * g + 2] * inv * sv.z, R[eb][4 * g + 3] * inv * sv.w);
                *(GAS v2u*)(orow + e0) = w; }
    }
}
__device__ __forceinline__ unsigned f32_key(float f) { const unsigned u = __float_as_uint(f); return u ^ ((u >> 31) ? 0xffffffffu : 0x80000000u); }
__device__ __forceinline__ float relu_bits(float x) { const int i = __float_as_int(x); return __int_as_float(i > 0 ? i : 0); }
__device__ __forceinline__ void relane(Frame& F) {
    int w = F.wave; asm volatile("" : "+s"(w)); unsigned mk = ~0u; asm volatile("" : "+s"(mk));
    int t = w * 64 + (int)__builtin_amdgcn_mbcnt_hi(mk, __builtin_amdgcn_mbcnt_lo(mk, 0u)); asm volatile("" : "+v"(t)); F.tid = t; F.lane = t & 63; F.wave = w; }
__device__ __forceinline__ void dsa_index_task(Frame& F, int b, int j, float* slab) {
    relane(F);
    const int lane = F.lane, ql = lane & 31, hh = lane >> 5, wave = F.wave;
    const bf16* P = (const bf16*)(F.ws + WS_BIG);
    LAS unsigned char* qi = F.lds;
    { v4u st[8];
#pragma unroll
      for (int k = 0; k < 8; ++k) { const int i = F.tid + 512 * k, q = i >> 7, ch = i & 127; int pq = 32 * j + q; pq = pq < LSEQ ? pq : LSEQ - 1;
          st[k] = *(const GAS v4u*)(P + (size_t)seqrow(b, pq) * NNG + C_DQI + 8 * ch); }
#pragma unroll
      for (int k = 0; k < 8; ++k) { const int i = F.tid + 512 * k, q = i >> 7, ch = i & 127; *(LAS v4u*)(qi + q * 2064 + 16 * ch) = st[k]; } }
    LAS float* wl = (LAS float*)(qi + 32 * 2064);
    if (F.tid < 32 * 16) { const int q = F.tid >> 4, hd = F.tid & 15; int pq = 32 * j + q; pq = pq < LSEQ ? pq : LSEQ - 1;
        wl[F.tid] = bf2f(P[(size_t)seqrow(b, pq) * NNG + C_DW + hd]) * 0.03125f; }
    LAS unsigned* hist = (LAS unsigned*)(F.lds + 73728);
    for (int i = F.tid; i < 32 * 256; i += 512) hist[i] = 0u;
    LDS_WAIT(); __syncthreads();
#ifndef PROBE_SUB
#define PROBE_SUB 0
#endif
    for (int rpa = 0; rpa < ((PROBE_SUB & 8) ? 2 : 1); ++rpa)
    {
    if (rpa) { LDS_WAIT(); __syncthreads(); for (int i = F.tid; i < 32 * 256; i += 512) hist[i] = 0u; LDS_WAIT(); __syncthreads(); }
    bf16x8 kn[4];
    { const int pk = 32 * wave + ql, pkc = pk < LSEQ ? pk : LSEQ - 1; const bf16* krow = P + (size_t)seqrow(b, pkc) * NNG + C_DKI + 8 * hh;
#pragma unroll
      for (int ks = 0; ks < 4; ++ks) kn[ks] = ld_frag16(krow + 16 * ks); }
    for (int kt = wave; kt <= j; kt += NWAVES) {
        bf16x8 kf[4];
#pragma unroll
        for (int ks = 0; ks < 4; ++ks) kf[ks] = kn[ks];
        { const int ktn = kt + NWAVES <= j ? kt + NWAVES : kt; const int pk = 32 * ktn + ql, pkc = pk < LSEQ ? pk : LSEQ - 1; const bf16* krow = P + (size_t)seqrow(b, pkc) * NNG + C_DKI + 8 * hh;
#pragma unroll
          for (int ks = 0; ks < 4; ++ks) kn[ks] = ld_frag16(krow + 16 * ks); }
        f32x16 idx;
#pragma unroll
        for (int r = 0; r < 16; ++r) idx[r] = 0.f;
#pragma unroll 1
        for (int hd = 0; hd < 16; hd += 2) { f32x16 S0, S1; const float wh0 = wl[ql * 16 + hd], wh1 = wl[ql * 16 + hd + 1];
#pragma unroll
            for (int r = 0; r < 16; ++r) { S0[r] = 0.f; S1[r] = 0.f; }
#pragma unroll
            for (int ks = 0; ks < 4; ++ks) { S0 = __builtin_amdgcn_mfma_f32_32x32x16_bf16(kf[ks], *(const LAS bf16x8*)(qi + ql * 2064 + hd * 128 + 32 * ks + 16 * hh), S0, 0, 0, 0);
                S1 = __builtin_amdgcn_mfma_f32_32x32x16_bf16(kf[ks], *(const LAS bf16x8*)(qi + ql * 2064 + (hd + 1) * 128 + 32 * ks + 16 * hh), S1, 0, 0, 0); }
#pragma unroll
            for (int r = 0; r < 16; ++r) { idx[r] = __builtin_fmaf(wh0, relu_bits(S0[r]), idx[r]); idx[r] = __builtin_fmaf(wh1, relu_bits(S1[r]), idx[r]); } }
        { const int lim = 32 * (j - kt) + ql - 4 * hh;
#pragma unroll
          for (int r = 0; r < 16; ++r) { const int ko = (r & 3) + 8 * (r >> 2);
              int bn = (int)__builtin_fmaf(idx[r], 32.f, 256.f); bn = bn < 0 ? 0 : (bn > 511 ? 511 : bn);
              const unsigned inc = (ko <= lim) ? ((bn & 1) ? 0x10000u : 1u) : 0u;
              (void)__hip_atomic_fetch_add(hist + ql * 256 + (((bn >> 1) + 2 * ql) & 255), inc, __ATOMIC_RELAXED, __HIP_MEMORY_SCOPE_WORKGROUP); } }
        float* srow = slab + (size_t)ql * LPAD + 32 * kt + 4 * hh;
#pragma unroll
        for (int g = 0; g < 4; ++g) *(GAS f32x4*)(srow + 8 * g) = (f32x4){idx[4 * g], idx[4 * g + 1], idx[4 * g + 2], idx[4 * g + 3]};
    }
    }
    VM_WAIT(); LDS_WAIT(); __syncthreads();
    for (int rpb = 0; rpb < ((PROBE_SUB & 16) ? 2 : 1); ++rpb)
    for (int qq = wave; qq < 32; qq += NWAVES) {
        const int p = 32 * j + qq; if (p >= LSEQ) break;
        const float* row = slab + (size_t)qq * LPAD;
        unsigned u[65];
        { const GAS unsigned* rp = (const GAS unsigned*)row + lane;
#pragma unroll
          for (int i = 0; i < 65; ++i) u[i] = rp[64 * i];
          __builtin_amdgcn_sched_barrier(0); }
        auto wsum = [&](unsigned c) { unsigned s = 0;
#pragma unroll
            for (int k = 0; k < 7; ++k) s += (unsigned)__builtin_popcountll(__ballot((c >> k) & 1u)) << k;
            return s; };
        unsigned T = 1u;
        if (p + 1 <= 256) {
#pragma unroll
            for (int i = 0; i < 65; ++i) { const unsigned k = f32_key(__uint_as_float(u[i])) >> 1; u[i] = (64 * i + lane <= p) ? k : 0u; }
        } else {
            const LAS unsigned* hrow = hist + qq * 256; unsigned c8[8];
#pragma unroll
            for (int i = 0; i < 4; ++i) { const unsigned w = hrow[(4 * lane + i + 2 * qq) & 255]; c8[2 * i] = w & 0xffffu; c8[2 * i + 1] = w >> 16; }
            unsigned tot = 0;
#pragma unroll
            for (int i = 0; i < 8; ++i) tot += c8[i];
            unsigned suf = 0;
            { const unsigned long long gtm = (lane == 63) ? 0ull : ~((2ull << lane) - 1ull);
#pragma unroll
              for (int k = 0; k < 13; ++k) suf += (unsigned)__builtin_popcountll(__ballot((tot >> k) & 1u) & gtm) << k; }
            unsigned run = suf, bl = 0, al = 0; bool found = false;
#pragma unroll
            for (int i = 7; i >= 0; --i) { const bool hit = !found && run < 256u && run + c8[i] >= 256u; if (hit) { bl = 8u * lane + i; al = run; } found = found || hit; run += c8[i]; }
            const unsigned long long fb = __ballot(found); const int src = (int)__builtin_ctzll(fb | (1ull << 63));
            const unsigned bstar = __builtin_amdgcn_readlane(bl, src), above = __builtin_amdgcn_readlane(al, src), need = 256u - above;
            unsigned f0 = 0u, f1 = 0u, f2 = 0u, cb = 0u;
#pragma unroll
            for (int i = 0; i < 65; ++i) { const float v = __uint_as_float(u[i]); int bn = (int)__builtin_fmaf(v, 32.f, 256.f); bn = bn < 0 ? 0 : (bn > 511 ? 511 : bn);
                const bool val = 64 * i + lane <= p, inband = val && (unsigned)bn == bstar;
                if (i < 32) f0 |= inband ? (1u << i) : 0u; else if (i < 64) f1 |= inband ? (1u << (i - 32)) : 0u; else f2 = inband ? 1u : 0u;
                cb += inband ? 1u : 0u;
                const unsigned k = f32_key(v) >> 1; u[i] = val ? k : 0u; }
            const unsigned inb = wsum(cb);
            if (fb != 0ull && inb <= 128u && inb >= need) {
                LAS unsigned* band = (LAS unsigned*)(F.lds + 68096) + wave * 128;
                unsigned off = 0;
#pragma unroll
                for (int k = 0; k < 7; ++k) { const unsigned long long bal = __ballot((cb >> k) & 1u); off += __builtin_amdgcn_mbcnt_hi((unsigned)(bal >> 32), __builtin_amdgcn_mbcnt_lo((unsigned)bal, 0u)) << k; }
#pragma unroll
                for (int i = 0; i < 65; ++i) { const bool inband = i < 32 ? ((f0 >> i) & 1u) : (i < 64 ? ((f1 >> (i - 32)) & 1u) : (f2 & 1u)); if (inband) { band[off] = u[i]; ++off; } }
                LDS_WAIT();
                const unsigned m0 = lane < (int)inb ? band[lane] : 0u, m1 = lane + 64 < (int)inb ? band[lane + 64] : 0u; unsigned ge0 = 0, gt0 = 0, ge1 = 0, gt1 = 0;
                for (unsigned k = 0; k < inb; ++k) { const unsigned v = band[k]; ge0 += (m0 - 1u - v) >> 31; gt0 += (m0 - v) >> 31; ge1 += (m1 - 1u - v) >> 31; gt1 += (m1 - v) >> 31; }
                const unsigned long long ok0 = __ballot(lane < (int)inb && ge0 >= need && gt0 < need), ok1 = __ballot(lane + 64 < (int)inb && ge1 >= need && gt1 < need);
                if (ok0) T = __builtin_amdgcn_readlane(m0, (int)__builtin_ctzll(ok0)); else T = __builtin_amdgcn_readlane(m1, (int)__builtin_ctzll(ok1 | (1ull << 63)));
                LDS_WAIT();
            } else {
                T = 0u;
                for (int bit = 30; bit >= 0; --bit) { const unsigned cm1 = (T | (1u << bit)) - 1u; unsigned c = 0;
#pragma unroll
                    for (int i = 0; i < 65; ++i) c += (cm1 - u[i]) >> 31;
                    if (wsum(c) >= 256u) T |= 1u << bit; } } }
        unsigned long long* mrow = (unsigned long long*)((unsigned*)(F.ws + WS_MASK) + ((size_t)b * LPAD + p) * MASKW);
        unsigned wlo = 0u, whi = 0u;
#pragma unroll
        for (int i = 0; i < 64; ++i) { const unsigned long long bal = __ballot(u[i] >= T); if (lane == i) { wlo = (unsigned)bal; whi = (unsigned)(bal >> 32); } }
        const unsigned long long b64 = __ballot(u[64] >= T);
        mrow[lane] = ((unsigned long long)whi << 32) | wlo; if (lane == 0) mrow[64] = b64;
    }
    __syncthreads();
}
struct HgChunk { bf16* base; int pitch; int cq, ck, cv; bf16* A; float* dl; };
__device__ __forceinline__ HgChunk hg_chunk(Frame& F, int b, int h, int c) {
    HgChunk k;
    if (c == 0) { unsigned char* mp = F.ws + WS_HMETA + (size_t)h * HMETA_STRIDE; k.base = (bf16*)mp; k.pitch = 384; k.cq = 0; k.ck = 128; k.cv = 256; k.A = (bf16*)(mp + 64 * 384 * 2); k.dl = (float*)(mp + 64 * 384 * 2 + 64 * 64 * 2); }
    else { const size_t ci = (size_t)(b * 4 + h) * 64 + (c - 1); k.base = (bf16*)(F.ws + WS_BIG) + (size_t)(b * SEQ + 64 * (c - 1)) * NNG; k.pitch = NNG; k.cq = C_AQ + h * 128; k.ck = C_AF + h * 128; k.cv = C_AI + h * 128;
        k.A = (bf16*)(F.ws + WS_HA) + ci * 64 * 64; k.dl = (float*)(F.ws + WS_HDL) + ci * 128; }
    return k;
}
__device__ __forceinline__ void hgrn_prep_task(Frame& F, int l, int b, int h, int c) {
    const int d = F.tid & 127, tq = F.tid >> 7, lane = F.lane, wave = F.wave;
    const bf16* P = (const bf16*)(F.ws + WS_BIG);
    LAS bf16* Qt = (LAS bf16*)F.lds; LAS bf16* Kt = Qt + 64 * 136; LAS float* part = (LAS float*)(F.lds + 2 * 64 * 136 * 2);
    const HgChunk ch = hg_chunk(F, b, h, c);
    float lb = 0.f; if (l == 1) { const float a = FIN(F, I_LB)[h * 128 + d], cc = FIN(F, I_LB)[512 + h * 128 + d]; lb = 1.0f / (1.0f + __expf(a - cc)); }
    const bool meta = (c == 0);
    unsigned short zr[16], qr[16], vr[16];
    { const int r0 = meta ? MREAL : b * SEQ + 64 * (c - 1);
#pragma unroll
      for (int i = 0; i < 16; ++i) { int t = 16 * tq + i; if (meta) t = t < NMETA ? t : NMETA - 1; const bf16* pr = P + (size_t)(r0 + t) * NNG + h * 128 + d; zr[i] = pr[C_AF]; qr[i] = pr[C_AQ]; vr[i] = pr[C_AI]; }
      __builtin_amdgcn_sched_barrier(0); }
    float lfv[16];
    float run = 0.f;
#pragma unroll
    for (int i = 0; i < 16; ++i) { const bool valid = !meta || (16 * tq + i < NMETA); const float z = bf2f(zr[i]); const float sg = 1.0f / (1.0f + __expf(-z));
        lfv[i] = valid ? __logf(lb + (1.0f - lb) * sg) : 0.f; run += lfv[i]; }
    part[tq * 128 + d] = run;
    LDS_WAIT(); __syncthreads();
    const float p0 = part[d], p1 = part[128 + d], p2 = part[256 + d], p3 = part[384 + d];
    const float off = (tq > 0 ? p0 : 0.f) + (tq > 1 ? p1 : 0.f) + (tq > 2 ? p2 : 0.f), bmid = p0 + p1, blast = (p0 + p1) + (p2 + p3);
    unsigned kb[8], vb[8]; unsigned short qb[16];
    float bt = off;
#pragma unroll
    for (int i = 0; i < 16; i += 2) { float kbar[2], vv[2];
#pragma unroll
        for (int u = 0; u < 2; ++u) { const int t = 16 * tq + i + u; const bool valid = !meta || (t < NMETA);
            const float lf = lfv[i + u]; const float q = bf2f(qr[i + u]);
            const float kk = valid ? 1.0f - __expf(lf) : 0.f, qq = valid ? q / (1.0f + __expf(-q)) : 0.f; vv[u] = valid ? bf2f(vr[i + u]) : 0.f;
            bt += lf;
            kbar[u] = kk * __expf(blast - bt); qb[i + u] = (unsigned short)f2bf_s(qq * __expf(bt));
            const float qt = qq * __expf(fminf(bt - bmid, 80.f)), kt = kk * __expf(fminf(bmid - bt, 80.f));
            Qt[t * 136 + d] = (bf16)f2bf_s(qt); Kt[t * 136 + d] = (bf16)f2bf_s(kt); }
        kb[i >> 1] = pk2(kbar[0], kbar[1]); vb[i >> 1] = pk2(vv[0], vv[1]); }
    asm volatile("s_waitcnt vmcnt(0)" ::: "memory"); __syncthreads();
#pragma unroll
    for (int i = 0; i < 16; ++i) ch.base[(size_t)(16 * tq + i) * ch.pitch + ch.cq + d] = qb[i];
    { bf16* kd = ch.base + (size_t)(d >> 1) * ch.pitch + ch.ck + (d & 1) * 64 + 16 * tq; bf16* vd = ch.base + (size_t)(d >> 1) * ch.pitch + ch.cv + (d & 1) * 64 + 16 * tq;
      *(GAS v4u*)kd = (v4u){kb[0], kb[1], kb[2], kb[3]}; *(GAS v4u*)(kd + 8) = (v4u){kb[4], kb[5], kb[6], kb[7]};
      *(GAS v4u*)vd = (v4u){vb[0], vb[1], vb[2], vb[3]}; *(GAS v4u*)(vd + 8) = (v4u){vb[4], vb[5], vb[6], vb[7]}; }
    if (tq == 0) ch.dl[d] = __expf(blast);
    LDS_WAIT(); __syncthreads();
    { const int mt = wave >> 1, fr = lane & 15, g = lane >> 4;
#pragma unroll
      for (int u = 0; u < 2; ++u) { const int nt = 2 * (wave & 1) + u; f32x4 acc = (f32x4){0.f, 0.f, 0.f, 0.f};
        if (nt <= mt) {
#pragma unroll
            for (int ks = 0; ks < 4; ++ks) acc = __builtin_amdgcn_mfma_f32_16x16x32_bf16(*(const LAS bf16x8*)(Qt + (16 * mt + fr) * 136 + 32 * ks + 8 * g), *(const LAS bf16x8*)(Kt + (16 * nt + fr) * 136 + 32 * ks + 8 * g), acc, 0, 0, 0);
        }
#pragma unroll
        for (int r = 0; r < 4; ++r) { const int t = 16 * mt + 4 * g + r, s = 16 * nt + fr; ch.A[t * 64 + s] = (bf16)f2bf_s(s <= t ? acc[r] : 0.f); } } }
    __syncthreads();
}
__device__ __forceinline__ void hgrn_scan_unit(Frame& F, int l, int b, int h) {
    const int lane = F.lane, wave = F.wave, fr = lane & 15, g = lane >> 4, tid = F.tid;
    constexpr int QP = 136, AP = 72, KP = 72, GP = 136;
    constexpr int BUF = (64 * QP + 64 * AP + 128 * KP + 64 * GP) * 2 + 512;
    LAS float* red = (LAS float*)(F.lds + 2 * BUF);
    const int dv = 16 * wave + fr;
    const float gn = FIN(F, I_GN)[l * 512 + h * 128 + dv];
    const bf16* Pg = (const bf16*)(F.ws + WS_BIG) + C_AG + h * 128;
    f32x4 S[8];
#pragma unroll
    for (int mt = 0; mt < 8; ++mt) S[mt] = (f32x4){0.f, 0.f, 0.f, 0.f};
    v4u rq[2], ra, rk[2], rg[2], rd; bf16x8 bv0, bv1, bn0, bn1;
#define HG_ISSUE(c_, B0, B1) do { const HgChunk ch_ = hg_chunk(F, b, h, (c_)); const int nv_ = ((c_) == 0) ? NMETA : 64; \
        _Pragma("unroll") for (int i = 0; i < 2; ++i) { const int idx = tid + 512 * i, row = idx >> 4, c16 = idx & 15; \
            rq[i] = *(const GAS v4u*)(ch_.base + (size_t)row * ch_.pitch + ch_.cq + 8 * c16); rk[i] = *(const GAS v4u*)(ch_.base + (size_t)row * ch_.pitch + ch_.ck + 8 * c16); \
            rg[i] = (v4u){0u, 0u, 0u, 0u}; if (row < nv_) rg[i] = *(const GAS v4u*)(Pg + (size_t)(((c_) == 0) ? MREAL + row : b * SEQ + 64 * ((c_) - 1) + row) * NNG + 8 * c16); } \
        ra = *(const GAS v4u*)(ch_.A + 8 * tid); if (tid < 32) rd = *(const GAS v4u*)(ch_.dl + 4 * tid); \
        const bf16* vrow_ = ch_.base + (size_t)(dv >> 1) * ch_.pitch + ch_.cv + (dv & 1) * 64 + 8 * g; B0 = ld_frag16(vrow_); B1 = ld_frag16(vrow_ + 32); } while (0)
#define HG_COMMIT(buf_) do { LAS bf16* Q_ = (LAS bf16*)(F.lds + (buf_) * BUF); LAS bf16* A_ = Q_ + 64 * QP; LAS bf16* KT_ = A_ + 64 * AP; LAS bf16* G_ = KT_ + 128 * KP; \
        _Pragma("unroll") for (int i = 0; i < 2; ++i) { const int idx = tid + 512 * i, row = idx >> 4, c16 = idx & 15; *(LAS v4u*)(Q_ + row * QP + 8 * c16) = rq[i]; \
            *(LAS v4u*)(KT_ + (2 * row + (c16 >> 3)) * KP + 8 * (c16 & 7)) = rk[i]; *(LAS v4u*)(G_ + row * GP + 8 * c16) = rg[i]; } \
        *(LAS v4u*)(A_ + (tid >> 3) * AP + 8 * (tid & 7)) = ra; if (tid < 32) *(LAS v4u*)((LAS unsigned char*)(G_ + 64 * GP) + 16 * tid) = rd; } while (0)
    HG_ISSUE(0, bv0, bv1); HG_COMMIT(0);
    for (int c = 0; c <= 64; ++c) {
        const int buf = c & 1;
        LDS_WAIT(); __syncthreads();
        if (c < 64) HG_ISSUE(c + 1, bn0, bn1);
        LAS bf16* Q = (LAS bf16*)(F.lds + buf * BUF); LAS bf16* A = Q + 64 * QP; LAS bf16* KT = A + 64 * AP; LAS bf16* G = KT + 128 * KP; const LAS float* DL = (const LAS float*)(G + 64 * GP);
        f32x4 o[4];
#pragma unroll
        for (int mt = 0; mt < 4; ++mt) o[mt] = (f32x4){0.f, 0.f, 0.f, 0.f};
#pragma unroll
        for (int ks = 0; ks < 4; ++ks) { v4u w; w.x = cvtpk(S[2 * ks][0], S[2 * ks][1]); w.y = cvtpk(S[2 * ks][2], S[2 * ks][3]); w.z = cvtpk(S[2 * ks + 1][0], S[2 * ks + 1][1]); w.w = cvtpk(S[2 * ks + 1][2], S[2 * ks + 1][3]);
            const bf16x8 sb = __builtin_bit_cast(bf16x8, w);
#pragma unroll
            for (int mt = 0; mt < 4; ++mt) { const LAS bf16* qp = Q + (16 * mt + fr) * QP + 32 * ks + 4 * g;
                const bf16x8 af = mk_frag(*(const LAS v2u*)qp, *(const LAS v2u*)(qp + 16));
                o[mt] = __builtin_amdgcn_mfma_f32_16x16x32_bf16(af, sb, o[mt], 0, 0, 0); } }
#pragma unroll
        for (int mt = 0; mt < 4; ++mt) { o[mt] = __builtin_amdgcn_mfma_f32_16x16x32_bf16(*(const LAS bf16x8*)(A + (16 * mt + fr) * AP + 8 * g), bv0, o[mt], 0, 0, 0);
            o[mt] = __builtin_amdgcn_mfma_f32_16x16x32_bf16(*(const LAS bf16x8*)(A + (16 * mt + fr) * AP + 32 + 8 * g), bv1, o[mt], 0, 0, 0); }
#pragma unroll
        for (int mt = 0; mt < 8; ++mt) { const f32x4 dl = *(const LAS f32x4*)(DL + 16 * mt + 4 * g); S[mt] = S[mt] * dl;
            S[mt] = __builtin_amdgcn_mfma_f32_16x16x32_bf16(*(const LAS bf16x8*)(KT + (16 * mt + fr) * KP + 8 * g), bv0, S[mt], 0, 0, 0);
            S[mt] = __builtin_amdgcn_mfma_f32_16x16x32_bf16(*(const LAS bf16x8*)(KT + (16 * mt + fr) * KP + 32 + 8 * g), bv1, S[mt], 0, 0, 0); }
#pragma unroll
        for (int mt = 0; mt < 4; ++mt)
#pragma unroll
            for (int r = 0; r < 4; ++r) { float s2 = o[mt][r] * o[mt][r]; s2 += __shfl_xor(s2, 1); s2 += __shfl_xor(s2, 2); s2 += __shfl_xor(s2, 4); s2 += __shfl_xor(s2, 8);
                if (fr == 0) red[wave * 64 + 16 * mt + 4 * g + r] = s2; }
        LDS_WAIT(); __syncthreads();
        const int nvalid = (c == 0) ? NMETA : 64;
#pragma unroll
        for (int mt = 0; mt < 4; ++mt)
#pragma unroll
            for (int r = 0; r < 4; ++r) { const int t = 16 * mt + 4 * g + r; float tot = 0.f;
#pragma unroll
                for (int w = 0; w < 8; ++w) tot += red[w * 64 + t];
                if (t < nvalid && (c > 0 || b == 0)) { const int row = (c == 0) ? MREAL + t : b * SEQ + 64 * (c - 1) + t;
                    const float gr = bf2f(G[t * GP + dv]);
                    const float val = o[mt][r] * (1.0f / sqrtf(tot * (1.f / 128.f) + EPS)) * gn * (gr / (1.0f + __expf(-gr)));
                    ((bf16*)(F.ws + WS_BR))[(size_t)row * 512 + h * 128 + dv] = (bf16)f2bf_s(val); } }
        if (c < 64) { HG_COMMIT(buf ^ 1); bv0 = bn0; bv1 = bn1; }
    }
#undef HG_ISSUE
#undef HG_COMMIT
    __syncthreads();
}
__device__ __forceinline__ void conv_row(Frame& F, int l, int r) {
    const int lane = F.lane; const bf16* P = (const bf16*)(F.ws + WS_BIG);
    int r1, r2;
    if (r < MREAL) { const int b = r >> 12, t = r & 4095; r1 = seqrow(b, NMETA + t - 1); r2 = seqrow(b, NMETA + t - 2); }
    else { const int i = r - MREAL; r1 = i >= 1 ? r - 1 : -1; r2 = i >= 2 ? r - 2 : -1; }
    const float* cw = FIN(F, I_CONVW) + l * 3 * 512 + 8 * lane;
    const int r1c = r1 >= 0 ? r1 : r, r2c = r2 >= 0 ? r2 : r;
    const v4u wc0 = *(const GAS v4u*)(P + (size_t)r * NNG + C_BC + 8 * lane), wu0 = *(const GAS v4u*)(P + (size_t)r * NNG + C_BU + 8 * lane), wb = *(const GAS v4u*)(P + (size_t)r * NNG + C_BB + 8 * lane);
    const v4u wc1 = *(const GAS v4u*)(P + (size_t)r1c * NNG + C_BC + 8 * lane), wu1 = *(const GAS v4u*)(P + (size_t)r1c * NNG + C_BU + 8 * lane);
    const v4u wc2 = *(const GAS v4u*)(P + (size_t)r2c * NNG + C_BC + 8 * lane), wu2 = *(const GAS v4u*)(P + (size_t)r2c * NNG + C_BU + 8 * lane);
    __builtin_amdgcn_sched_barrier(0);
    float c0[8], u0[8], bb[8], y[8]; unpack8(wc0, c0); unpack8(wu0, u0); unpack8(wb, bb);
#pragma unroll
    for (int i = 0; i < 8; ++i) y[i] = cw[i] * (c0[i] * u0[i]);
    const float m1 = r1 >= 0 ? 1.f : 0.f, m2 = r2 >= 0 ? 1.f : 0.f;
    unpack8(wc1, c0); unpack8(wu1, u0);
#pragma unroll
    for (int i = 0; i < 8; ++i) y[i] += m1 * cw[512 + i] * (c0[i] * u0[i]);
    unpack8(wc2, c0); unpack8(wu2, u0);
#pragma unroll
    for (int i = 0; i < 8; ++i) y[i] += m2 * cw[1024 + i] * (c0[i] * u0[i]);
#pragma unroll
    for (int i = 0; i < 8; ++i) y[i] *= bb[i];
    *(GAS v4u*)((bf16*)(F.ws + WS_BR) + (size_t)MPAD * 512 + (size_t)r * 512 + 8 * lane) = pack8(y);
}
constexpr int CW_TMO = 0, CW_BAR = 4096, CW_Q = 16384;
__device__ __forceinline__ int queue_pop(Frame& F, int qi) {
    int t = 0; if (F.lane == 0) t = (int)__hip_atomic_fetch_add((unsigned*)(F.ctl + CW_Q + 64 * qi), 1u, RLX_AGENT);
    return __builtin_amdgcn_readfirstlane(t);
}
__device__ __forceinline__ int queue_pop_wg(Frame& F, int qi) {
    LAS int* slot = (LAS int*)(F.lds + 139264);
    __syncthreads();
    if (F.tid == 0) *slot = (int)__hip_atomic_fetch_add((unsigned*)(F.ctl + CW_Q + 64 * qi), 1u, RLX_AGENT);
    LDS_WAIT(); __syncthreads();
    return __builtin_amdgcn_readfirstlane(*slot);
}
__device__ __forceinline__ void phase_hgrn_prep(Frame& F, int l) {
    for (int t = F.bid; t < NB * 4 * 64 + 4; t += F.G) { if (t < 4) hgrn_prep_task(F, l, 0, t, 0); else { const int u = t - 4; hgrn_prep_task(F, l, u >> 8, (u >> 6) & 3, 1 + (u & 63)); } }
}
__device__ __forceinline__ void phase_prep(Frame& F, int l) { const int gw = F.bid * NWAVES + F.wave, NGW = F.G * NWAVES; for (int r = gw; r < MREAL + NMETA; r += NGW) prep_row(F, l, r); }
__device__ __forceinline__ void phase_vt(Frame& F) { const int gw = F.bid * NWAVES + F.wave, NGW = F.G * NWAVES; for (int t = gw; t < VT_NTASK; t += NGW) vt_task(F, t); }
__device__ __forceinline__ void phase_mix1(Frame& F, int l, int qidx) {
    LAS float* bt = (LAS float*)(F.lds + 135168);
    build_bias_table(F, bt, 0);
    __syncthreads();
#ifndef MIX1_SKIP
#define MIX1_SKIP 0
#endif
    const int sk = (qidx >= 4) ? MIX1_SKIP : 0;
    if (F.bid < NIDX_WG) {
        float* slab = (float*)(F.ws + WS_SCR) + (size_t)F.bid * 32 * LPAD;
        if (!(sk & 1)) for (int t = F.bid; t < NB * NQT; t += NIDX_WG) { const int j = NQT - 1 - t / NB, b = t % NB; dsa_index_task(F, b, j, slab); }
    } else if (F.bid < NIDX_WG + NHG_WG) {
        const int u = F.bid - NIDX_WG; if (!(sk & 2)) hgrn_scan_unit(F, l, u >> 2, u & 3);
    } else {
        const int u0 = F.bid - NIDX_WG - NHG_WG, nw = F.G - NIDX_WG - NHG_WG;
        const int cw = u0 * NWAVES + F.wave, ncw = nw * NWAVES; if (!(sk & 4)) for (int r = cw; r < MREAL + NMETA; r += ncw) conv_row(F, l, r);
    }
    float lam, post;
    { const float* lp = FIN(F, I_DLAM) + l * 256; const float s1 = wave_sum(lp[F.lane] * lp[64 + F.lane]), s2 = wave_sum(lp[128 + F.lane] * lp[192 + F.lane]);
      const float li = 0.8f - 0.6f * __expf(-0.3f * (float)l); lam = __expf(s1) - __expf(s2) + li; post = 1.0f - li; }
    for (;;) { const int t = queue_pop_wg(F, qidx) + ((sk & 8) ? (1 << 20) : 0); if (t >= NB * 4 * NQB) break;
        const int J = NQB - 1 - t / 32, bh = t % 32; attn_wg_task<false>(F, l, bh >> 2, bh & 3, J, bt, lam, post); }
}
__device__ __forceinline__ void phase_mix2(Frame& F, int l, int qidx) {
    LAS float* bt = (LAS float*)(F.lds + 135168);
    build_bias_table(F, bt, 4);
    __syncthreads();
    for (;;) { const int t = queue_pop_wg(F, qidx); if (t >= NB * 4 * NQB) break;
        const int J = NQB - 1 - t / 32, bh = t % 32; attn_wg_task<true>(F, l, bh >> 2, bh & 3, J, bt, 0.f, 1.f); }
}

#ifndef MK_ONE
#define MK_ONE 0
#endif
#ifndef BR_MASK
#define BR_MASK 15
#endif
constexpr int NPH = 18;
template <class T> __device__ __forceinline__ T opaque(T v) { asm volatile("" : "+s"(v)); return v; }
struct Args { const float* in[22]; float* out; unsigned char* ws; int ph_lo, ph_hi; };
__global__ void __launch_bounds__(NWAVES * 64, 2) fwd(Args args) {
    extern __shared__ __attribute__((aligned(16))) unsigned char lds[];
    Frame F;
    F.lds = (LAS unsigned char*)lds; F.MISC = (volatile LAS unsigned*)(F.lds + MISC_OFF);
    F.tid = threadIdx.x; F.lane = F.tid & 63; F.wave = __builtin_amdgcn_readfirstlane(F.tid >> 6); F.G = gridDim.x; F.bid = blockIdx.x;
    F.ws = args.ws; F.out = args.out; F.ctl = (gu32*)(args.ws + WS_CTL);
    F.karg = (const unsigned char __attribute__((address_space(4)))*)__builtin_amdgcn_kernarg_segment_ptr();
    for (int u = F.tid; u < (LDS_BYTES - LDSCTL_OFF) / 4; u += NWAVES * 64) ((LAS unsigned*)(F.lds + LDSCTL_OFF))[u] = 0u;
    __syncthreads();
#if MK_ONE
    XcdBarrier bar = xcd_barrier_post((unsigned*)(F.ctl + CW_BAR), F.MISC + 8, __builtin_amdgcn_readfirstlane(threadIdx.x >> 6));
#define GRID_BAR() xcd_barrier(bar)
#else
#define GRID_BAR() do { } while (0)
#endif
    const int wave_s = __builtin_amdgcn_readfirstlane(threadIdx.x >> 6);
    const int lo = args.ph_lo, hi = args.ph_hi;
#define IN(k) (lo <= (k) && (k) < hi)
#define RETID() do { int w_ = wave_s; asm volatile("" : "+s"(w_)); unsigned mk_ = ~0u; asm volatile("" : "+s"(mk_)); int t_ = w_ * 64 + (int)__builtin_amdgcn_mbcnt_hi(mk_, __builtin_amdgcn_mbcnt_lo(mk_, 0u)); asm volatile("" : "+v"(t_)); F.tid = t_; F.lane = t_ & 63; F.wave = w_; } while (0)
#ifdef DBG_TS
#define STAMP(k) do { if (blockIdx.x == 0 && threadIdx.x == 0) ((unsigned long long*)(args.ws + 768 * 1024))[(k)] = __builtin_amdgcn_s_memrealtime(); } while (0)
#else
#define STAMP(k) do { } while (0)
#endif
#define SEAM(k) do { if (IN((k) + 1)) GRID_BAR(); STAMP((k) + 1); } while (0)
#ifndef PROBE_EPI
#define PROBE_EPI 0
#endif
#ifdef PROBE_MASK
#define NREP(kk) opaque(((PROBE_MASK >> (kk)) & 1) ? 1 + PROBE_EXTRA : 1)
#define REP_BEGIN(kk) { const int nrep_ = NREP(kk); for (int rep = 0; rep < nrep_; ++rep) { if (rep) GRID_BAR();
#define REP_END } }
#else
#define REP_BEGIN(kk) { { const int rep = 0; (void)rep;
#define REP_END } }
#endif
    STAMP(0);
    unsigned char* wb = F.ws + WS_W;
    bf16* XN = (bf16*)(F.ws + WS_XN); bf16* BR = (bf16*)(F.ws + WS_BR); bf16* BIG = (bf16*)(F.ws + WS_BIG); float* HM = (float*)(F.ws + WS_HM);
    auto layer = [&](const int l) __attribute__((always_inline)) {
        const int pb = l * NPH;
        const float* hsrc = (l == 0) ? FIN(F, I_X) : F.out;
        if (IN(pb + 0)) { REP_BEGIN(0) RETID(); phase_convert(F, l); REP_END SEAM(pb + 0); }
        if (IN(pb + 1)) { REP_BEGIN(1) RETID(); phase_norm(F, hsrc, FIN(F, I_F1N) + l * DM); REP_END SEAM(pb + 1); }
        if (IN(pb + 2)) { REP_BEGIN(2) RETID(); meta_gemm(F, 0, XN + (size_t)MREAL * DM, DM, (const bf16*)(wb + W_GU1), NGU, DM, BIG, DFF, 0.f); pg8::Gemm g{opaque((const bf16*)(XN)), opaque((const bf16*)(wb + W_GU1)), MREAL, NGU, DM}; pg8::StaticOrder S; S.init(MREAL, NGU, F.G, opaque(F.bid));
            pg8::EpiSwiGLU E{BIG, DFF, rep ? PROBE_EPI : 0}; pg8::gemm_phase<pg8::EpiSwiGLU, pg8::StaticOrder, true, true>(F.lds + RING_OFF, g, S, E, F.tid); REP_END SEAM(pb + 2); }
        if (IN(pb + 3)) { REP_BEGIN(3) RETID(); meta_gemm(F, 1, BIG + (size_t)MREAL * DFF, DFF, (const bf16*)(wb + W_D1), DM, DFF, nullptr, 0, rep ? 0.f : 0.5f); pg8::Gemm g{opaque((const bf16*)(BIG)), opaque((const bf16*)(wb + W_D1)), MREAL, DM, DFF}; pg8::StaticOrder S; S.init(MREAL, DM, F.G, opaque(F.bid));
            pg8::EpiResF32 E{rep ? F.out : hsrc, F.out, HM, DM, MT_REAL, rep ? 0.f : 0.5f}; pg8::gemm_phase<pg8::EpiResF32, pg8::StaticOrder, true, true>(F.lds + RING_OFF, g, S, E, F.tid); REP_END SEAM(pb + 3); }
        if (IN(pb + 4)) { REP_BEGIN(4) RETID(); phase_norm(F, F.out, FIN(F, I_MIXN) + l * DM); REP_END SEAM(pb + 4); }
        if (IN(pb + 5)) { REP_BEGIN(5) RETID(); meta_gemm(F, 2, XN + (size_t)MREAL * DM, DM, (const bf16*)(wb + W_NG), NNG, DM, BIG, NNG, 0.f); pg8::Gemm g{opaque((const bf16*)(XN)), opaque((const bf16*)(wb + W_NG)), MREAL, NNG, DM}; pg8::StaticOrder S; S.init(MREAL, NNG, F.G, opaque(F.bid));
            pg8::EpiBf16<0> E{BIG, NNG}; pg8::gemm_phase<pg8::EpiBf16<0>, pg8::StaticOrder, true, true>(F.lds + RING_OFF, g, S, E, F.tid); REP_END SEAM(pb + 5); }
        if (IN(pb + 6)) { RETID(); phase_prep(F, l); phase_vt(F); __syncthreads(); phase_hgrn_prep(F, l); SEAM(pb + 6); }
#ifdef DUP_MIX
        if (IN(pb + 7)) { const int nrep = opaque(DUP_MIX1); for (int rep = 0; rep < nrep; ++rep) { RETID(); phase_mix1(F, l, 4 * rep + 2 * l); GRID_BAR(); } }
        if (IN(pb + 8)) { const int nrep = opaque(DUP_MIX2); for (int rep = 0; rep < nrep; ++rep) { RETID(); phase_mix2(F, l, 4 * rep + 2 * l + 1); GRID_BAR(); } }
#else
        if (IN(pb + 7)) { RETID(); phase_mix1(F, l, 2 * l); SEAM(pb + 7); }
        if (IN(pb + 8)) { RETID(); phase_mix2(F, l, 2 * l + 1); SEAM(pb + 8); }
#endif
        if (IN(pb + 9)) { REP_BEGIN(9) RETID(); meta_gemm(F, 3, XN + (size_t)MREAL * DM, DM, (const bf16*)(wb + W_G), NGATE, DM, BIG, NGATE, 0.f); pg8::Gemm g{opaque((const bf16*)(XN)), opaque((const bf16*)(wb + W_G)), MREAL, NGATE, DM}; pg8::StaticOrder S; S.init(MREAL, NGATE, F.G, opaque(F.bid));
            pg8::EpiBf16<1> E{BIG, NGATE}; pg8::gemm_phase<pg8::EpiBf16<1>, pg8::StaticOrder, true, true>(F.lds + RING_OFF, g, S, E, F.tid); REP_END SEAM(pb + 9); }
        if (IN(pb + 10)) { REP_BEGIN(10) RETID(); meta_gemm(F, 4, BR + (size_t)MREAL * 512, 512, (const bf16*)(wb + W_BR), DM, 512, XN, DM, 0.f);
            pg8::Gemm g{opaque((const bf16*)(BR)), opaque((const bf16*)(wb + W_BR)), MREAL, DM, 512}; pg8::MergeOrder S; S.init(MREAL, DM, F.G, opaque(F.bid), MPAD / 256);
            pg8::EpiGateAccM E{XN, DM, BIG, NGATE, MPAD / 256, DM / 256}; pg8::gemm_phase<pg8::EpiGateAccM, pg8::MergeOrder, true, true>(F.lds + RING_OFF, g, S, E, F.tid); REP_END SEAM(pb + 10); }
        if (IN(pb + 14) && BR_MASK) { REP_BEGIN(14) RETID(); meta_gemm(F, 1, XN + (size_t)MREAL * DM, DM, (const bf16*)(wb + W_O), DM, DM, nullptr, 0, rep ? 0.f : 1.0f); pg8::Gemm g{opaque((const bf16*)(XN)), opaque((const bf16*)(wb + W_O)), MREAL, DM, DM}; pg8::StaticOrder S; S.init(MREAL, DM, F.G, opaque(F.bid));
            pg8::EpiResF32 E{F.out, F.out, HM, DM, MT_REAL, rep ? 0.f : 1.0f}; pg8::gemm_phase<pg8::EpiResF32, pg8::StaticOrder, true, true>(F.lds + RING_OFF, g, S, E, F.tid); REP_END SEAM(pb + 14); }
        if (IN(pb + 15)) { REP_BEGIN(15) RETID(); phase_norm(F, F.out, FIN(F, I_F2N) + l * DM); REP_END SEAM(pb + 15); }
        if (IN(pb + 16)) { REP_BEGIN(16) RETID(); meta_gemm(F, 0, XN + (size_t)MREAL * DM, DM, (const bf16*)(wb + W_GU2), NGU, DM, BIG, DFF, 0.f); pg8::Gemm g{opaque((const bf16*)(XN)), opaque((const bf16*)(wb + W_GU2)), MREAL, NGU, DM}; pg8::StaticOrder S; S.init(MREAL, NGU, F.G, opaque(F.bid));
            pg8::EpiSwiGLU E{BIG, DFF, rep ? PROBE_EPI : 0}; pg8::gemm_phase<pg8::EpiSwiGLU, pg8::StaticOrder, true, true>(F.lds + RING_OFF, g, S, E, F.tid); REP_END SEAM(pb + 16); }
        if (IN(pb + 17)) { REP_BEGIN(17) RETID(); meta_gemm(F, 1, BIG + (size_t)MREAL * DFF, DFF, (const bf16*)(wb + W_D2), DM, DFF, nullptr, 0, rep ? 0.f : 0.5f); pg8::Gemm g{opaque((const bf16*)(BIG)), opaque((const bf16*)(wb + W_D2)), MREAL, DM, DFF}; pg8::StaticOrder S; S.init(MREAL, DM, F.G, opaque(F.bid));
            pg8::EpiResF32 E{F.out, F.out, HM, DM, MT_REAL, rep ? 0.f : 0.5f}; pg8::gemm_phase<pg8::EpiResF32, pg8::StaticOrder, true, true>(F.lds + RING_OFF, g, S, E, F.tid); REP_END SEAM(pb + 17); }
    };
    layer(0); layer(1);
}

extern "C" void kernel_launch(void* const* d_in, const int* in_sizes, int n_in, void* d_out, int out_size, void* d_ws, size_t ws_size, hipStream_t stream) {
    static int grid = 0;
    if (grid == 0) {
        if (n_in != 22 || out_size != MREAL * DM || ws_size < WS_END) { fprintf(stderr, "kernel_launch: unexpected shapes (n_in %d out %d ws %zu need %zu)\n", n_in, out_size, ws_size, (size_t)WS_END); grid = -1; return; }
        int dev = 0, cus = 0, per_cu = 0;
        if (hipGetDevice(&dev) != hipSuccess || hipDeviceGetAttribute(&cus, hipDeviceAttributeMultiprocessorCount, dev) != hipSuccess) { grid = -1; return; }
        if (hipFuncSetAttribute((const void*)fwd, hipFuncAttributeMaxDynamicSharedMemorySize, LDS_BYTES) != hipSuccess) { fprintf(stderr, "kernel_launch: hipFuncSetAttribute failed\n"); grid = -1; return; }
        if (hipOccupancyMaxActiveBlocksPerMultiprocessor(&per_cu, (const void*)fwd, NWAVES * 64, LDS_BYTES) != hipSuccess || per_cu < 1) fprintf(stderr, "kernel_launch: occupancy query says %d\n", per_cu);
        (void)hipGetLastError();
        grid = cus < 256 ? cus : 256;
    }
    if (grid < 0) return;
    (void)hipMemsetAsync((char*)d_ws + WS_CTL, 0, CTL_ZERO_BYTES, stream);
    Args a{};
    for (int i = 0; i < 22; ++i) a.in[i] = (const float*)d_in[i];
    a.out = (float*)d_out; a.ws = (unsigned char*)d_ws;
#ifndef PH_END
#define PH_END (2 * NPH)
#endif
#if MK_ONE
    a.ph_lo = 0; a.ph_hi = PH_END;
    hipLaunchKernelGGL(fwd, dim3(grid), dim3(NWAVES * 64), LDS_BYTES, stream, a);
#else
    for (int p = 0; p < PH_END; ++p) { a.ph_lo = p; a.ph_hi = p + 1;
        hipLaunchKernelGGL(fwd, dim3(grid), dim3(NWAVES * 64), LDS_BYTES, stream, a); }
#endif
}
```

```cpp
#include <hip/hip_runtime.h>
#include <cstdio>
#include <cstdint>
#define MK_ONE 1
namespace pg8 {
#define PG8_LAS __attribute__((address_space(3)))
typedef unsigned short bf16_t;
typedef short bf16x8 __attribute__((ext_vector_type(8)));
typedef float f32x4 __attribute__((ext_vector_type(4)));
typedef unsigned u32x4 __attribute__((ext_vector_type(4)));
constexpr int BM = 256, BK = 64, HALF = 128, HTB = HALF * BK * 2  , STAGE_BYTES = 8 * HTB, NXCD = 8, WGM = 8;

__host__ __device__ __forceinline__ int lds_byte(int r, int c) { const int st = (r >> 4) * 2 + (c >> 5), rr = r & 15, cc = c & 31, ob = rr * 64 + cc * 2; return st * 1024 + (ob ^ (((ob >> 9) & 1) << 5)); }
__host__ __device__ __forceinline__ void stage_rc(int b, int& R, int& C) { const int st = b / 1024, sb = b % 1024, swz = sb ^ (((sb >> 9) & 1) << 5); R = (st >> 1) * 16 + swz / 64; C = (st & 1) * 32 + (swz % 64) / 2; }
__host__ __device__ __forceinline__ int perm32(int rho) { const int n = rho >> 4, i = rho & 15; return 8 * (i >> 2) + 4 * n + (i & 3); }

struct Unit { int pm, pn; };
struct Gemm { const bf16_t* A; const bf16_t* Bt; int M, N, K; };

struct StaticOrder {
    int nM, nN, nwg, G, c;
    __host__ __device__ void init(int M, int N, int G_, int c_) { nM = M / BM; nN = N / BM; nwg = nM * nN; G = G_; c = c_; }
    __host__ __device__ bool next(int i, Unit& u) const {
        const long L = (long)i * G + c; if (L >= nwg) return false;
        int wgid = (int)L; { const int q = nwg / NXCD, r = nwg % NXCD, xcd = wgid % NXCD, off = wgid / NXCD; wgid = (xcd < r ? xcd * (q + 1) : r * (q + 1) + (xcd - r) * q) + off; }
        const int nig = WGM * nN, gid = wgid / nig, fm = gid * WGM, gsz = (nM - fm) < WGM ? (nM - fm) : WGM;
        u.pm = fm + ((wgid % nig) % gsz); u.pn = (wgid % nig) / gsz; return true;
    }
    __device__ __forceinline__ void a_ready(const Unit&) const {}
    __device__ __forceinline__ void done(const Unit&) const {}
};
typedef __bf16 bf16x2_hw __attribute__((ext_vector_type(2))); typedef float f32x2_hw __attribute__((ext_vector_type(2)));
__device__ __forceinline__ unsigned cvt_pk_bf16(float lo, float hi) { const f32x2_hw v = {lo, hi}; return __builtin_bit_cast(unsigned, __builtin_convertvector(v, bf16x2_hw)); }
typedef float f32x2 __attribute__((ext_vector_type(2)));
__device__ __forceinline__ float fast_sigmoid(float x) { return __builtin_amdgcn_rcpf(1.0f + __expf(-x)); }
__device__ __forceinline__ float fast_silu(float x) { return x * fast_sigmoid(x); }
template <int ACT  > struct EpiBf16 {
    static constexpr bool PERM = true, AFTER_DRAIN = false;
    bf16_t* O; int ldc;
    __device__ __forceinline__ void operator()(const f32x4 (&acc)[2][2][4][2], const Unit& u, int wr, int wc, int fr, int fq) const {
        const int row0 = u.pm * BM + wr * 64 + fr; const int col0 = u.pn * BM + wc * 32 + 8 * fq;
#pragma unroll
        for (int ai = 0; ai < 2; ++ai)
#pragma unroll
            for (int m = 0; m < 4; ++m) { bf16_t* rowp = O + (size_t)(row0 + ai * HALF + m * 16) * ldc + col0;
#pragma unroll
                for (int bj = 0; bj < 2; ++bj) { f32x4 v0 = acc[ai][bj][m][0], v1 = acc[ai][bj][m][1];
                    if (ACT == 1) {
#pragma unroll
                        for (int j = 0; j < 4; ++j) { v0[j] = fast_sigmoid(v0[j]); v1[j] = fast_sigmoid(v1[j]); } }
                    u32x4 w; w.x = cvt_pk_bf16(v0[0], v0[1]); w.y = cvt_pk_bf16(v0[2], v0[3]); w.z = cvt_pk_bf16(v1[0], v1[1]); w.w = cvt_pk_bf16(v1[2], v1[3]);
                    *(u32x4*)(rowp + bj * HALF) = w; } }
    }
};
struct EpiSwiGLU {
    static constexpr bool PERM = true, AFTER_DRAIN = false;
    bf16_t* O; int ldc; int mode;
    __device__ __forceinline__ void operator()(const f32x4 (&acc)[2][2][4][2], const Unit& u, int wr, int wc, int fr, int fq) const {
        if (mode == 2) return;
        const int row0 = u.pm * BM + wr * 64 + fr; const int col0 = u.pn * HALF + wc * 32 + 8 * fq;
#pragma unroll
        for (int ai = 0; ai < 2; ++ai)
#pragma unroll
            for (int m = 0; m < 4; ++m) { bf16_t* rowp = O + (size_t)(row0 + ai * HALF + m * 16) * ldc + col0;
                const f32x4 g0 = acc[ai][0][m][0], g1 = acc[ai][0][m][1], u0 = acc[ai][1][m][0], u1 = acc[ai][1][m][1];
                f32x4 v0, v1;
#pragma unroll
                for (int j = 0; j < 4; ++j) { v0[j] = fast_silu(g0[j]) * u0[j]; v1[j] = fast_silu(g1[j]) * u1[j]; }
                u32x4 w; w.x = cvt_pk_bf16(v0[0], v0[1]); w.y = cvt_pk_bf16(v0[2], v0[3]); w.z = cvt_pk_bf16(v1[0], v1[1]); w.w = cvt_pk_bf16(v1[2], v1[3]);
                if (mode == 0) *(u32x4*)rowp = w; else asm volatile("" :: "v"(w.x), "v"(w.y), "v"(w.z), "v"(w.w));
                asm volatile("" ::: "memory"); }
    }
};
struct EpiResF32 {
    static constexpr bool PERM = false, AFTER_DRAIN = false;
    const float* base_r; float* out_r; float* hm; int ldc; int mt_real; float scale;
    __device__ __forceinline__ void operator()(const f32x4 (&acc)[2][2][4][2], const Unit& u, int wr, int wc, int fr, int fq) const {
        const bool real = u.pm < mt_real;
        const float* bp = real ? base_r + (size_t)u.pm * BM * ldc : hm; float* op = real ? out_r + (size_t)u.pm * BM * ldc : hm;
        const int row0 = wr * 64 + fr, col0 = u.pn * BM + wc * 32 + 4 * fq;
#pragma unroll
        for (int ai = 0; ai < 2; ++ai) {
            f32x4 b[4][2][2];
#pragma unroll
            for (int m = 0; m < 4; ++m) { const size_t off = (size_t)(row0 + ai * HALF + m * 16) * ldc + col0;
#pragma unroll
                for (int bj = 0; bj < 2; ++bj)
#pragma unroll
                    for (int n = 0; n < 2; ++n) b[m][bj][n] = *(const f32x4*)(bp + off + bj * HALF + n * 16); }
            asm volatile("" ::: "memory");
#pragma unroll
            for (int m = 0; m < 4; ++m) { const size_t off = (size_t)(row0 + ai * HALF + m * 16) * ldc + col0;
#pragma unroll
                for (int bj = 0; bj < 2; ++bj)
#pragma unroll
                    for (int n = 0; n < 2; ++n) *(f32x4*)(op + off + bj * HALF + n * 16) = b[m][bj][n] + acc[ai][bj][m][n] * scale; }
            asm volatile("" ::: "memory"); }
    }
};
struct EpiGateAcc {
    static constexpr bool PERM = true, AFTER_DRAIN = false;
    bf16_t* MG; int ldc; const bf16_t* G; int ldg; int gcol0; int first;
    __device__ __forceinline__ void operator()(const f32x4 (&acc)[2][2][4][2], const Unit& u, int wr, int wc, int fr, int fq) const {
        const int row0 = u.pm * BM + wr * 64 + fr; const int col0 = u.pn * BM + wc * 32 + 8 * fq;
#pragma unroll
        for (int ai = 0; ai < 2; ++ai)
#pragma unroll
            for (int m = 0; m < 4; ++m) { const size_t r = (size_t)(row0 + ai * HALF + m * 16);
#pragma unroll
                for (int bj = 0; bj < 2; ++bj) { const u32x4 gw = *(const u32x4*)(G + r * ldg + gcol0 + col0 + bj * HALF);
                    u32x4 pw = (u32x4){0u, 0u, 0u, 0u}; if (!first) pw = *(const u32x4*)(MG + r * ldc + col0 + bj * HALF);
                    float o[8];
#pragma unroll
                    for (int j = 0; j < 4; ++j) { const float a0 = (j < 2) ? acc[ai][bj][m][0][2 * j] : acc[ai][bj][m][1][2 * (j - 2)], a1 = (j < 2) ? acc[ai][bj][m][0][2 * j + 1] : acc[ai][bj][m][1][2 * (j - 2) + 1];
                        o[2 * j] = __uint_as_float(pw[j] << 16) + __uint_as_float(gw[j] << 16) * a0; o[2 * j + 1] = __uint_as_float(pw[j] & 0xffff0000u) + __uint_as_float(gw[j] & 0xffff0000u) * a1; }
                    u32x4 w; w.x = cvt_pk_bf16(o[0], o[1]); w.y = cvt_pk_bf16(o[2], o[3]); w.z = cvt_pk_bf16(o[4], o[5]); w.w = cvt_pk_bf16(o[6], o[7]);
                    *(u32x4*)(MG + r * ldc + col0 + bj * HALF) = w; } }
    }
};

struct MergeOrder {
    int nM, nN, G, c, mt_alloc;
    __host__ __device__ void init(int M, int N, int G_, int c_, int mt_alloc_) { nM = M / BM; nN = N / BM; G = G_; c = c_; mt_alloc = mt_alloc_; }
    __host__ __device__ bool next(int i, Unit& u) const { const int t = (i >> 2) * G + c, m = i & 3; if (t >= nM * nN) return false;
        const int pm = t / nN, pn = t % nN; u.pm = m * mt_alloc + pm; u.pn = m * nN + pn; return true; }
    __device__ __forceinline__ void a_ready(const Unit&) const {}
    __device__ __forceinline__ void done(const Unit&) const {}
};
struct EpiGateAccM {
    static constexpr bool PERM = true, AFTER_DRAIN = false;
    bf16_t* MG; int ldc; const bf16_t* G; int ldg; int mt_alloc; int ntn;
    __device__ __forceinline__ void operator()(const f32x4 (&acc)[2][2][4][2], const Unit& u, int wr, int wc, int fr, int fq) const {
        const int m = u.pm / mt_alloc, pm = u.pm - m * mt_alloc, pn = u.pn - m * ntn;
        const int row0 = pm * BM + wr * 64 + fr; const int col0 = pn * BM + wc * 32 + 8 * fq; const int gcol0 = m * ntn * BM;
#pragma unroll
        for (int ai = 0; ai < 2; ++ai)
#pragma unroll
            for (int mm = 0; mm < 4; ++mm) { const size_t r = (size_t)(row0 + ai * HALF + mm * 16);
#pragma unroll
                for (int bj = 0; bj < 2; ++bj) { const u32x4 gw = *(const u32x4*)(G + r * ldg + gcol0 + col0 + bj * HALF);
                    u32x4 pw = (u32x4){0u, 0u, 0u, 0u}; if (m != 0) pw = *(const u32x4*)(MG + r * ldc + col0 + bj * HALF);
                    float o[8];
#pragma unroll
                    for (int j = 0; j < 4; ++j) { const float a0 = (j < 2) ? acc[ai][bj][mm][0][2 * j] : acc[ai][bj][mm][1][2 * (j - 2)], a1 = (j < 2) ? acc[ai][bj][mm][0][2 * j + 1] : acc[ai][bj][mm][1][2 * (j - 2) + 1];
                        o[2 * j] = __uint_as_float(pw[j] << 16) + __uint_as_float(gw[j] << 16) * a0; o[2 * j + 1] = __uint_as_float(pw[j] & 0xffff0000u) + __uint_as_float(gw[j] & 0xffff0000u) * a1; }
                    u32x4 w; w.x = cvt_pk_bf16(o[0], o[1]); w.y = cvt_pk_bf16(o[2], o[3]); w.z = cvt_pk_bf16(o[4], o[5]); w.w = cvt_pk_bf16(o[6], o[7]);
                    *(u32x4*)(MG + r * ldc + col0 + bj * HALF) = w; } }
    }
};
template <class Epi, class Sched, bool ALIGN_EPI = false, bool SP2 = false>
__device__ __forceinline__ void gemm_phase(PG8_LAS unsigned char* lds, const Gemm g, const Sched& S, const Epi& E, int tid_in) {
    int tid_ = tid_in; asm volatile("" : "+v"(tid_));
    const int tid = tid_, wid = __builtin_amdgcn_readfirstlane(tid >> 6), lane = tid & 63, wr = wid >> 2, wc = wid & 3, fr = lane & 15, fq = lane >> 4;
    const int K = g.K, nt = K / BK;
    unsigned voffA[2], voffB[2];
#pragma unroll
    for (int i = 0; i < 2; ++i) { int R, C; stage_rc(tid * 16 + i * 8192, R, C); const int Rb = Epi::PERM ? ((R & ~31) + perm32(R & 31)) : R;
        voffA[i] = (unsigned)(R * K + C) * 2u; voffB[i] = (unsigned)(Rb * K + C) * 2u; }
    const size_t kstep = (size_t)(BK * 2);
    const size_t hstep = (size_t)HALF * K * 2;
    const size_t tstep = 2 * hstep;
    const unsigned ldsw = (unsigned)wid * 1024u;
    const int aoff = lds_byte(wr * 64 + fr, fq * 8), boff = lds_byte(wc * 32 + fr, fq * 8);
#define PG8_SA(b, h) (((b) * 2 + (h)) * HTB)
#define PG8_SB(b, h) ((4 + (b) * 2 + (h)) * HTB)
#define PG8_STAGE(bufoff, gbase, voff) do { _Pragma("unroll") for (int _i = 0; _i < 2; ++_i) \
        __builtin_amdgcn_global_load_lds((const unsigned*)((const char*)(gbase) + (voff)[_i]), (PG8_LAS unsigned*)(lds + (bufoff) + ldsw + _i * 8192), 16, 0, 0); } while (0)
#define PG8_LDA(dst, b, h) do { _Pragma("unroll") for (int m = 0; m < 4; ++m) _Pragma("unroll") for (int k = 0; k < 2; ++k) dst[m][k] = *(const PG8_LAS bf16x8*)(lds + PG8_SA(b, h) + aoff + m * 2048 + k * 1024); } while (0)
#define PG8_LDB(dst, b, h) do { _Pragma("unroll") for (int n = 0; n < 2; ++n) _Pragma("unroll") for (int k = 0; k < 2; ++k) dst[n][k] = *(const PG8_LAS bf16x8*)(lds + PG8_SB(b, h) + boff + n * 2048 + k * 1024); } while (0)
#define PG8_MMA(ai, bj, At, Bt) do { __builtin_amdgcn_s_setprio(1); _Pragma("unroll") for (int m = 0; m < 4; ++m) _Pragma("unroll") for (int n = 0; n < 2; ++n) _Pragma("unroll") for (int k = 0; k < 2; ++k) \
        acc[ai][bj][m][n] = __builtin_amdgcn_mfma_f32_16x16x32_bf16(Bt[n][k], At[m][k], acc[ai][bj][m][n], 0, 0, 0); __builtin_amdgcn_s_setprio(0); } while (0)
#define PG8_WAIT_V(n) asm volatile("s_waitcnt vmcnt(" #n ")" ::: "memory")
#define PG8_WAIT_L(n) asm volatile("s_waitcnt lgkmcnt(" #n ")" ::: "memory")
#define PG8_BAR __builtin_amdgcn_s_barrier()
#define PG8_SCHED __builtin_amdgcn_sched_barrier(0)
    Unit cur, nxt; int ui = 0;
    if (!S.next(0, cur)) return;
    f32x4 acc[2][2][4][2];
#pragma unroll
    for (int a = 0; a < 2; ++a)
#pragma unroll
        for (int b = 0; b < 2; ++b)
#pragma unroll
            for (int m = 0; m < 4; ++m)
#pragma unroll
                for (int n = 0; n < 2; ++n) acc[a][b][m][n] = (f32x4){0.f, 0.f, 0.f, 0.f};
    bf16x8 At[4][2], B0[2][2], B1[2][2];
    const char* cA = (const char*)g.A + (size_t)cur.pm * tstep; const char* cB = (const char*)g.Bt + (size_t)cur.pn * tstep;
    S.a_ready(cur);
    if constexpr (SP2) {
        PG8_STAGE(PG8_SB(0, 0), cB, voffB); PG8_STAGE(PG8_SB(0, 1), cB + hstep, voffB); PG8_STAGE(PG8_SA(0, 0), cA, voffA); PG8_STAGE(PG8_SA(0, 1), cA + hstep, voffA);
        if (wr == 1) PG8_BAR;
        PG8_WAIT_V(2); PG8_BAR;
        PG8_STAGE(PG8_SB(1, 0), cB + kstep, voffB); PG8_STAGE(PG8_SA(1, 0), cA + kstep, voffA); PG8_STAGE(PG8_SB(1, 1), cB + hstep + kstep, voffB);
        PG8_WAIT_V(6); PG8_BAR;
    } else {
        PG8_STAGE(PG8_SB(0, 0), cB, voffB); PG8_STAGE(PG8_SA(0, 0), cA, voffA); PG8_STAGE(PG8_SB(0, 1), cB + hstep, voffB); PG8_STAGE(PG8_SA(0, 1), cA + hstep, voffA);
        if (wr == 1) PG8_BAR;
        PG8_WAIT_V(4); PG8_BAR;
        PG8_STAGE(PG8_SB(1, 0), cB + kstep, voffB); PG8_STAGE(PG8_SA(1, 0), cA + kstep, voffA); PG8_STAGE(PG8_SB(1, 1), cB + hstep + kstep, voffB);
        PG8_WAIT_V(6); PG8_BAR;
    }
    for (;;) {
        const bool has_next = S.next(ui + 1, nxt);
        const char* nA = has_next ? (const char*)g.A + (size_t)nxt.pm * tstep : cA; const char* nB = has_next ? (const char*)g.Bt + (size_t)nxt.pn * tstep : cB;
        for (int t = 0; t < nt; t += 2) {
            const bool last = (t == nt - 2);
            const char* a1 = cA + (size_t)(t + 1) * kstep;
            const char* a2 = last ? nA : cA + (size_t)(t + 2) * kstep; const char* b2 = last ? nB : cB + (size_t)(t + 2) * kstep;
            const char* a3 = a2 + kstep; const char* b3 = b2 + kstep;
            if (last && has_next) S.a_ready(nxt);
            if constexpr (SP2) {
            PG8_LDB(B0, 0, 0); PG8_LDB(B1, 0, 1); PG8_SCHED; PG8_LDA(At, 0, 0); PG8_STAGE(PG8_SA(1, 1), a1 + hstep, voffA);
            PG8_WAIT_V(8); PG8_WAIT_L(0); PG8_BAR; PG8_MMA(0, 0, At, B0); PG8_MMA(0, 1, At, B1); PG8_BAR; PG8_SCHED;
            PG8_LDA(At, 0, 1); PG8_STAGE(PG8_SB(0, 0), b2, voffB); PG8_STAGE(PG8_SB(0, 1), b2 + hstep, voffB); PG8_STAGE(PG8_SA(0, 0), a2, voffA);
            PG8_WAIT_V(8); PG8_WAIT_L(0); PG8_BAR; PG8_MMA(1, 0, At, B0); PG8_MMA(1, 1, At, B1); PG8_BAR; PG8_SCHED;
            PG8_LDB(B0, 1, 0); PG8_LDB(B1, 1, 1); PG8_SCHED; PG8_LDA(At, 1, 0); PG8_STAGE(PG8_SA(0, 1), a2 + hstep, voffA);
            PG8_WAIT_V(8); PG8_WAIT_L(0); PG8_BAR; PG8_MMA(0, 0, At, B0); PG8_MMA(0, 1, At, B1); PG8_BAR; PG8_SCHED;
            PG8_LDA(At, 1, 1); PG8_STAGE(PG8_SB(1, 0), b3, voffB); PG8_STAGE(PG8_SB(1, 1), b3 + hstep, voffB); PG8_STAGE(PG8_SA(1, 0), a3, voffA);
            PG8_WAIT_V(8); PG8_WAIT_L(0); PG8_BAR; PG8_MMA(1, 0, At, B0); PG8_MMA(1, 1, At, B1); PG8_BAR; PG8_SCHED;
            } else {
            PG8_LDB(B0, 0, 0); PG8_SCHED; PG8_LDA(At, 0, 0); PG8_STAGE(PG8_SA(1, 1), a1 + hstep, voffA);
            PG8_WAIT_L(8); PG8_BAR; PG8_WAIT_L(0); PG8_MMA(0, 0, At, B0); PG8_BAR; PG8_SCHED;
            PG8_LDB(B1, 0, 1); PG8_STAGE(PG8_SB(0, 0), b2, voffB);
            PG8_BAR; PG8_WAIT_L(0); PG8_MMA(0, 1, At, B1); PG8_BAR;
            PG8_LDA(At, 0, 1); PG8_STAGE(PG8_SA(0, 0), a2, voffA);
            PG8_BAR; PG8_WAIT_L(0); PG8_MMA(1, 0, At, B0); PG8_BAR; PG8_SCHED;
            PG8_STAGE(PG8_SB(0, 1), b2 + hstep, voffB);
            PG8_WAIT_V(6); PG8_BAR; PG8_MMA(1, 1, At, B1); PG8_BAR;
            PG8_LDB(B0, 1, 0); PG8_SCHED; PG8_LDA(At, 1, 0); PG8_STAGE(PG8_SA(0, 1), a2 + hstep, voffA);
            PG8_WAIT_L(8); PG8_BAR; PG8_WAIT_L(0); PG8_MMA(0, 0, At, B0); PG8_BAR; PG8_SCHED;
            PG8_LDB(B1, 1, 1); PG8_STAGE(PG8_SB(1, 0), b3, voffB);
            PG8_BAR; PG8_WAIT_L(0); PG8_MMA(0, 1, At, B1); PG8_BAR;
            PG8_LDA(At, 1, 1); PG8_STAGE(PG8_SA(1, 0), a3, voffA);
            PG8_BAR; PG8_WAIT_L(0); PG8_MMA(1, 0, At, B0); PG8_BAR; PG8_SCHED;
            PG8_STAGE(PG8_SB(1, 1), b3 + hstep, voffB);
            PG8_WAIT_V(6); PG8_BAR; PG8_MMA(1, 1, At, B1); PG8_BAR;
            }
        }
        if constexpr (ALIGN_EPI) { if (wr == 0) PG8_BAR; }
        if constexpr (!Epi::AFTER_DRAIN) { E(acc, cur, wr, wc, fr, fq); S.done(cur); }
        if (!has_next) break;
#pragma unroll
        for (int a = 0; a < 2; ++a)
#pragma unroll
            for (int b = 0; b < 2; ++b)
#pragma unroll
                for (int m = 0; m < 4; ++m)
#pragma unroll
                    for (int n = 0; n < 2; ++n) acc[a][b][m][n] = (f32x4){0.f, 0.f, 0.f, 0.f};
        cur = nxt; cA = nA; cB = nB; ++ui;
        if constexpr (ALIGN_EPI) { if (wr == 1) PG8_BAR; }
    }
    PG8_WAIT_V(0);
    if constexpr (!ALIGN_EPI) { if (wr == 0) PG8_BAR; }
    PG8_BAR;
    if constexpr (Epi::AFTER_DRAIN) { E.fused(acc, cur, wr, wc, fr, fq, lds, wid, lane); S.done(cur); }
#undef PG8_SA
#undef PG8_SB
#undef PG8_STAGE
#undef PG8_LDA
#undef PG8_LDB
#undef PG8_MMA
#undef PG8_WAIT_V
#undef PG8_WAIT_L
#undef PG8_BAR
#undef PG8_SCHED
}
}

constexpr int DM = 2048, NB = 8, SEQ = 4096, NMETA = 16, LSEQ = 4112, LPAD = 4128;
constexpr int MREAL = NB * SEQ;
constexpr int MPAD = MREAL + 256;
constexpr int MT_REAL = MREAL / 256;
constexpr int DFF = 5632, NGU = 2 * DFF, NNG = 7168, NGATE = 8192, INCOLS = 15184, NGC = 6992;
constexpr int NWAVES = 8;
constexpr float EPS = 1e-6f;
constexpr int C_AQ = 0, C_AF = 512, C_AI = 1024, C_AG = 1536, C_BB = 2048, C_BC = 2560, C_BU = 3072, C_CQ = 3584, C_CK = 4096, C_CV = 4608,
              C_DQ = 5120, C_DK = 5632, C_DV = 5760, C_DQI = 5888, C_DKI = 6912, C_DW = 6976;

constexpr size_t MiB = 1u << 20;
constexpr size_t WS_CTL = 0, CTL_ZERO_BYTES = 1 * MiB;
constexpr size_t WS_HM = 1 * MiB;
constexpr size_t WS_W = 4 * MiB;
constexpr size_t W_GU1 = 0, W_D1 = W_GU1 + (size_t)NGU * DM * 2, W_NG = W_D1 + (size_t)DM * DFF * 2, W_G = W_NG + (size_t)NNG * DM * 2,
                 W_BR = W_G + (size_t)NGATE * DM * 2, W_O = W_BR + (size_t)4 * DM * 512 * 2, W_GU2 = W_O + (size_t)DM * DM * 2, W_D2 = W_GU2 + (size_t)NGU * DM * 2,
                 W_END = W_D2 + (size_t)DM * DFF * 2;
constexpr size_t WS_XN = WS_W + W_END;
constexpr size_t WS_BR = WS_XN + (size_t)MPAD * DM * 2;
constexpr size_t WS_BIG = WS_BR + (size_t)MPAD * DM * 2;
constexpr size_t BIG_P_END = (size_t)MPAD * NNG * 2;
constexpr size_t WS_VTC = WS_BIG + BIG_P_END;
constexpr size_t WS_VTD = WS_VTC + (size_t)NB * 4 * 128 * LPAD * 2;
constexpr size_t WS_MASK = WS_VTD + (size_t)NB * 128 * LPAD * 2;
constexpr int MASKW = 132;
constexpr int NIDX_WG = 172;
constexpr int NHG_WG = 32;
constexpr size_t WS_SCR = WS_MASK + (size_t)NB * LPAD * MASKW * 4;
constexpr size_t WS_HA = WS_SCR + (size_t)NIDX_WG * 32 * LPAD * 4;
constexpr size_t WS_HDL = WS_HA + (size_t)NB * 4 * 64 * 64 * 64 * 2;
constexpr size_t WS_HMETA = WS_HDL + (size_t)NB * 4 * 64 * 128 * 4;
constexpr size_t HMETA_STRIDE = 64 * 384 * 2 + 64 * 64 * 2 + 128 * 4;
constexpr size_t WS_END = WS_HMETA + 4 * HMETA_STRIDE;
static_assert(WS_BIG + (size_t)MPAD * NGATE * 2 <= WS_END, "G fits");
static_assert(WS_END <= (size_t)1138174976, "workspace map fits the guaranteed size");

constexpr int RING_OFF = 0, RING_BYTES = 131072;
constexpr int LDSCTL_OFF = 143360, MISC_OFF = LDSCTL_OFF + 320;
constexpr int LDS_BYTES = 147456;

#define GAS __attribute__((address_space(1)))
#define LAS __attribute__((address_space(3)))
typedef unsigned short bf16;
typedef unsigned v4u __attribute__((ext_vector_type(4)));
typedef unsigned v2u __attribute__((ext_vector_type(2)));
typedef float f32x4 __attribute__((ext_vector_type(4)));
typedef float f32x16 __attribute__((ext_vector_type(16)));
typedef short bf16x8 __attribute__((ext_vector_type(8)));
typedef GAS unsigned gu32;
#define RLX_AGENT __ATOMIC_RELAXED, __HIP_MEMORY_SCOPE_AGENT
#define LDS_WAIT() asm volatile("s_waitcnt lgkmcnt(0)" ::: "memory")
#define VM_WAIT() asm volatile("s_waitcnt vmcnt(0)" ::: "memory")
__device__ __forceinline__ unsigned f2bf(float f) { unsigned u = __builtin_bit_cast(unsigned, f); return (u + 0x7fffu + ((u >> 16) & 1u)) >> 16; }
__device__ __forceinline__ unsigned f2bf_s(float f) { return pg8::cvt_pk_bf16(f, 0.f) & 0xffffu; }
__device__ __forceinline__ unsigned pk2(float lo, float hi) { return pg8::cvt_pk_bf16(lo, hi); }
__device__ __forceinline__ float bflo(unsigned w) { return __uint_as_float(w << 16); }
__device__ __forceinline__ float bfhi(unsigned w) { return __uint_as_float(w & 0xffff0000u); }
__device__ __forceinline__ float bf2f(bf16 v) { return __uint_as_float((unsigned)v << 16); }
__device__ __forceinline__ int seqrow(int b, int p) { return p < NMETA ? MREAL + p : b * SEQ + p - NMETA; }
__device__ __forceinline__ int rel_bucket(int n) {
    if (n < 16) return n; if (n >= 128) return 31;
    const int v = 16 + (int)(__log2f((float)n * 0.0625f) * 5.33333333f); return v < 31 ? v : 31; }
__device__ __forceinline__ float wave_sum(float v) {
#pragma unroll
    for (int o = 1; o < 64; o <<= 1) v += __shfl_xor(v, o);
    return v;
}
#define XB_TMO      128
#define XB_XCNT(j)  (256  + 64 * (j))
#define XB_XSUB(j)  (1280 + 64 * (j))
#define XB_XGEN(j)  (2304 + 64 * (j))
#define XB_TOP      3328
#define XB_TOPGEN   3392
#define XCD_BAR_WORDS 3456
#define XB_SPIN_CAP (1u << 18)

__device__ __forceinline__ unsigned xb_ld(unsigned* p)              { return __hip_atomic_load(p, __ATOMIC_RELAXED, __HIP_MEMORY_SCOPE_AGENT); }
__device__ __forceinline__ unsigned xb_add(unsigned* p, unsigned v) { return __hip_atomic_fetch_add(p, v, __ATOMIC_RELAXED, __HIP_MEMORY_SCOPE_AGENT); }
__device__ __forceinline__ unsigned xb_xcc_id() { return (unsigned)__builtin_amdgcn_s_getreg((3 << 11) | 20) & 0xFu; }
#define XB_SPIN(cond, bar) do { unsigned _sp = 0; while (cond) { __builtin_amdgcn_s_sleep(1); \
    if ((++_sp & 255u) == 0u) { if (xb_ld(&(bar)[XB_TMO])) break; if (_sp > XB_SPIN_CAP) { atomicAdd(&(bar)[XB_TMO], 1u); break; } } } } while (0)

struct XcdBarrier {
    int wave;
    unsigned* bar; unsigned x;
    volatile LAS unsigned* st;
};

__device__ __forceinline__ bool xb_thread0(int wave) { unsigned mk = ~0u; asm volatile("" : "+s"(mk)); return wave == 0 && __builtin_amdgcn_mbcnt_hi(mk, __builtin_amdgcn_mbcnt_lo(mk, 0u)) == 0u; }
__device__ __forceinline__ XcdBarrier xcd_barrier_post(unsigned* bar, volatile LAS unsigned* st, int wave) {
    XcdBarrier b; b.wave = wave; b.bar = bar; b.x = xb_xcc_id(); b.st = st;
    if (xb_thread0(wave)) (void)xb_add(&bar[XB_XCNT(b.x)], 1u);
    return b;
}
__device__ __forceinline__ void xcd_barrier_complete(unsigned* bar, unsigned x, unsigned& nloc, unsigned& nx) {
    const unsigned G = gridDim.x * gridDim.y * gridDim.z;
    unsigned sum, cnt, mine, sp = 0u;
    for (;;) {
        sum = 0u; cnt = 0u; mine = 0u;
#pragma unroll
        for (unsigned j = 0; j < 16; ++j) { const unsigned c = xb_ld(&bar[XB_XCNT(j)]); sum += c; cnt += (c > 0u) ? 1u : 0u; mine = (j == x) ? c : mine; }
        if (sum == G) break;
        __builtin_amdgcn_s_sleep(1);
        if ((++sp & 255u) == 0u) { if (xb_ld(&bar[XB_TMO])) break; if (sp > XB_SPIN_CAP) { atomicAdd(&bar[XB_TMO], 1u); break; } }
    }
    nloc = mine > 0u ? mine : 1u; nx = cnt > 0u ? cnt : 1u;
}

__device__ __forceinline__ void xcd_barrier(const XcdBarrier& b) {
    asm volatile("s_waitcnt vmcnt(0)" ::: "memory");
    __syncthreads();
    if (xb_thread0(b.wave)) {
        unsigned* bar = b.bar;
        __builtin_amdgcn_s_waitcnt(0);
        unsigned nloc = b.st[0], nx = b.st[1];
        if (nloc == 0u) { xcd_barrier_complete(bar, b.x, nloc, nx); b.st[0] = nloc; b.st[1] = nx; }
        const unsigned old = xb_add(&bar[XB_XSUB(b.x)], 1u);
        const unsigned gen = old / nloc;
        if (old + 1u == (gen + 1u) * nloc) {
            __builtin_amdgcn_fence(__ATOMIC_RELEASE, "agent");
            asm volatile("s_waitcnt vmcnt(0)" ::: "memory");
            const unsigned og = xb_add(&bar[XB_TOP], 1u);
            const unsigned tg = og / nx;
            if (og + 1u == (tg + 1u) * nx) xb_add(&bar[XB_TOPGEN], 1u);
            else XB_SPIN(xb_ld(&bar[XB_TOPGEN]) == tg, bar);
            __builtin_amdgcn_fence(__ATOMIC_ACQUIRE, "agent");
            xb_add(&bar[XB_XGEN(b.x)], 1u);
            asm volatile("s_waitcnt vmcnt(0)" ::: "memory");
        } else {
            XB_SPIN(xb_ld(&bar[XB_XGEN(b.x)]) == gen, bar);
            __builtin_amdgcn_fence(__ATOMIC_ACQUIRE, "agent");
            asm volatile("s_waitcnt vmcnt(0)" ::: "memory");
        }
    }
    __syncthreads();
}

struct Frame {
    LAS unsigned char* lds;
    volatile LAS unsigned* MISC;
    gu32* ctl;
    int tid, lane, wave, G, bid;
    const unsigned char __attribute__((address_space(4)))* karg; float* out; unsigned char* ws;
};
__device__ __forceinline__ const float* fin_load(const unsigned char __attribute__((address_space(4)))* k, int i) { asm volatile("" : "+s"(k)); return *(const float* const __attribute__((address_space(4)))*)(k + 8 * i); }
#define FIN(F_, i_) fin_load((F_).karg, (i_))
enum { I_X = 0, I_META, I_RELB, I_F1N, I_F1GU, I_F1D, I_MIXN, I_WIN, I_LB, I_GN, I_CONVW, I_DQN, I_DKN, I_DLAM, I_DSUB, I_SQN, I_SKN, I_WBR, I_WOUT, I_F2N, I_F2GU, I_F2D };

template <class RowMap>
__device__ __forceinline__ void transpose_item(const float* W, int K, int N, bf16* WT, LAS float* scr, int item, int lane, RowMap rm) {
    const int nblk = (N + 31) / 32, kb = item / nblk, nb = item % nblk, k0 = 64 * kb, n0 = 32 * nb;
    const int nl = n0 + (lane & 31); const bool nok = nl < N;
    { float wv[32]; const float* wp = W + (size_t)(k0 + (lane >> 5)) * N + (nok ? nl : 0);
#pragma unroll
      for (int i = 0; i < 32; ++i) wv[i] = wp[(size_t)(2 * i) * N];
      __builtin_amdgcn_sched_barrier(0);
#pragma unroll
      for (int i = 0; i < 32; ++i) scr[(2 * i + (lane >> 5)) * 33 + (lane & 31)] = nok ? wv[i] : 0.f; }
    LDS_WAIT(); asm volatile("" ::: "memory");
    const int c = lane & 7;
#pragma unroll
    for (int j = 0; j < 4; ++j) { const int n = (lane >> 3) + 8 * j; const LAS float* s = scr + (8 * c) * 33 + n;
        v4u o; o.x = pk2(s[0 * 33], s[1 * 33]); o.y = pk2(s[2 * 33], s[3 * 33]); o.z = pk2(s[4 * 33], s[5 * 33]); o.w = pk2(s[6 * 33], s[7 * 33]);
        if (n0 + n < N) *(GAS v4u*)(WT + (size_t)rm(n0 + n) * K + k0 + 8 * c) = o; }
    LDS_WAIT(); asm volatile("" ::: "memory");
}
struct MapId { __device__ __forceinline__ int operator()(int n) const { return n; } };
struct MapGU { __device__ __forceinline__ int operator()(int n) const { const int up = n >= DFF, j = up ? n - DFF : n; return 256 * (j >> 7) + 128 * up + (j & 127); } };
struct MapIn { __device__ __forceinline__ int operator()(int n) const { return n < NGC ? n : n + (NNG - NGC); } };
template <class RowMap>
__device__ __forceinline__ void convert_matrix(Frame& F, const float* W, int K, int N, bf16* WT, RowMap rm) {
    LAS float* scr = (LAS float*)(F.lds + F.wave * 16384);
    const int gw = F.bid * NWAVES + F.wave, NGW = F.G * NWAVES, nitems = (K / 64) * ((N + 31) / 32);
    for (int it = gw; it < nitems; it += NGW) transpose_item(W, K, N, WT, scr, it, F.lane, rm);
}
__device__ __forceinline__ void phase_convert(Frame& F, int l) {
    unsigned char* wb = F.ws + WS_W;
    convert_matrix(F, FIN(F, I_F1GU) + (size_t)l * DM * NGU, DM, NGU, (bf16*)(wb + W_GU1), MapGU());
    convert_matrix(F, FIN(F, I_F1D) + (size_t)l * DFF * DM, DFF, DM, (bf16*)(wb + W_D1), MapId());
    convert_matrix(F, FIN(F, I_WIN) + (size_t)l * DM * INCOLS, DM, INCOLS, (bf16*)(wb + W_NG), MapIn());
    for (int m = 0; m < 4; ++m) convert_matrix(F, FIN(F, I_WBR) + ((size_t)l * 4 + m) * 512 * DM, 512, DM, (bf16*)(wb + W_BR) + (size_t)m * DM * 512, MapId());
    convert_matrix(F, FIN(F, I_WOUT) + (size_t)l * DM * DM, DM, DM, (bf16*)(wb + W_O), MapId());
    convert_matrix(F, FIN(F, I_F2GU) + (size_t)l * DM * NGU, DM, NGU, (bf16*)(wb + W_GU2), MapGU());
    convert_matrix(F, FIN(F, I_F2D) + (size_t)l * DFF * DM, DFF, DM, (bf16*)(wb + W_D2), MapId());
    { GAS v4u* z = (GAS v4u*)(wb + W_NG + (size_t)NGC * DM * 2); const int n16 = (NNG - NGC) * DM * 2 / 16;
      for (int i = F.bid * 512 + F.tid; i < n16; i += F.G * 512) z[i] = (v4u){0u, 0u, 0u, 0u}; }
    if (l == 0) {
        GAS f32x4* hm = (GAS f32x4*)(F.ws + WS_HM); const GAS f32x4* mt = (const GAS f32x4*)FIN(F, I_META);
        for (int i = F.bid * 512 + F.tid; i < 256 * DM / 4; i += F.G * 512) hm[i] = (i < NMETA * DM / 4) ? mt[i] : (f32x4){0.f, 0.f, 0.f, 0.f};
    }
}
__device__ __forceinline__ void phase_norm(Frame& F, const float* src_real, const float* gain) {
    const int gw = F.bid * NWAVES + F.wave, NGW = F.G * NWAVES;
    bf16* XN = (bf16*)(F.ws + WS_XN); const float* hm = (const float*)(F.ws + WS_HM);
    f32x4 g[8];
#pragma unroll
    for (int j = 0; j < 8; ++j) g[j] = ((const GAS f32x4*)gain)[F.lane + 64 * j];
    for (int r = gw; r < MPAD; r += NGW) {
        GAS v2u* o8 = (GAS v2u*)(XN + (size_t)r * DM) + F.lane;
        if (r >= MREAL + NMETA) {
#pragma unroll
            for (int j = 0; j < 8; ++j) o8[64 * j] = (v2u){0u, 0u};
            continue; }
        const float* xr = r < MREAL ? src_real + (size_t)r * DM : hm + (size_t)(r - MREAL) * DM;
        f32x4 v[8]; float s = 0.f;
#pragma unroll
        for (int j = 0; j < 8; ++j) { v[j] = ((const GAS f32x4*)xr)[F.lane + 64 * j]; s += (v[j].x * v[j].x + v[j].y * v[j].y) + (v[j].z * v[j].z + v[j].w * v[j].w); }
        const float inv = 1.0f / sqrtf(wave_sum(s) * (1.f / DM) + EPS);
#pragma unroll
        for (int j = 0; j < 8; ++j) { v2u w; w.x = pk2(v[j].x * inv * g[j].x, v[j].y * inv * g[j].y); w.y = pk2(v[j].z * inv * g[j].z, v[j].w * inv * g[j].w); o8[64 * j] = w; }
    }
}

__device__ __forceinline__ f32x4 meta_dot16(const bf16* A  , int lda, const bf16* Bt  , int K, int s0, int s1, int lane) {
    const int fr = lane & 15, g = lane >> 4; const bf16* ap = A + (size_t)fr * lda + 8 * g; const bf16* bp = Bt + (size_t)fr * K + 8 * g;
    f32x4 a0 = (f32x4){0.f, 0.f, 0.f, 0.f}, a1 = a0;
    for (int s = s0; s < s1; s += 2) {
        const bf16x8 x0 = *(const GAS bf16x8*)(ap + 32 * s), x1 = *(const GAS bf16x8*)(ap + 32 * s + 32);
        const bf16x8 w0 = *(const GAS bf16x8*)(bp + 32 * s), w1 = *(const GAS bf16x8*)(bp + 32 * s + 32);
        a0 = __builtin_amdgcn_mfma_f32_16x16x32_bf16(w0, x0, a0, 0, 0, 0); a1 = __builtin_amdgcn_mfma_f32_16x16x32_bf16(w1, x1, a1, 0, 0, 0); }
    return a0 + a1;
}
__device__ __forceinline__ void st_bf16x4(bf16* p, f32x4 v) { v2u w; w.x = pk2(v[0], v[1]); w.y = pk2(v[2], v[3]); *(GAS v2u*)p = w; }
__device__ __forceinline__ void meta_gemm(Frame& F, int kind, const bf16* A, int lda, const bf16* Bt, int N, int K, bf16* Obf, int ldo, float scale) {
    const int lane = F.lane, wave = F.wave, fr = lane & 15, g = lane >> 4;
    const int ngroups = (kind == 0 ? N / 2 : N) / 16;
    LAS f32x4* red = (LAS f32x4*)F.lds;
    const int ns = K / 32, s0 = (wave * ns) >> 3, s1 = ((wave + 1) * ns) >> 3;
    for (int cg = F.bid; cg < ngroups; cg += F.G) {
        const int n0 = 16 * cg;
        f32x4 p0, p1 = (f32x4){0.f, 0.f, 0.f, 0.f};
        if (kind == 0) { const int rg = 256 * (n0 >> 7) + (n0 & 127);
            p0 = meta_dot16(A, lda, Bt + (size_t)rg * K, K, s0, s1, lane); p1 = meta_dot16(A, lda, Bt + (size_t)(rg + 128) * K, K, s0, s1, lane); }
        else if (kind == 4) { const int mb = wave >> 1, kh = wave & 1; p0 = meta_dot16(A + (size_t)mb * MPAD * 512, 512, Bt + ((size_t)mb * DM + n0) * 512, 512, 8 * kh, 8 * kh + 8, lane); }
        else p0 = meta_dot16(A, lda, Bt + (size_t)n0 * K, K, s0, s1, lane);
        red[wave * 64 + lane] = p0; if (kind == 0) red[512 + wave * 64 + lane] = p1;
        LDS_WAIT(); __syncthreads();
        if (wave == 0) {
            f32x4 q[8];
#pragma unroll
            for (int w = 0; w < 8; ++w) q[w] = red[w * 64 + lane];
            if (kind == 4) { f32x4 tot = (f32x4){0.f, 0.f, 0.f, 0.f}; const bf16* G = (const bf16*)(F.ws + WS_BIG);
#pragma unroll
                for (int mb = 0; mb < 4; ++mb) { const f32x4 acc = q[2 * mb] + q[2 * mb + 1]; const v2u gw2 = *(const GAS v2u*)(G + (size_t)(MREAL + fr) * NGATE + mb * DM + n0 + 4 * g);
                    tot[0] += bflo(gw2.x) * acc[0]; tot[1] += bfhi(gw2.x) * acc[1]; tot[2] += bflo(gw2.y) * acc[2]; tot[3] += bfhi(gw2.y) * acc[3]; }
                st_bf16x4(Obf + (size_t)(MREAL + fr) * ldo + n0 + 4 * g, tot);
            } else {
                f32x4 acc = ((q[0] + q[1]) + (q[2] + q[3])) + ((q[4] + q[5]) + (q[6] + q[7]));
                if (kind == 0) { f32x4 up = (f32x4){0.f, 0.f, 0.f, 0.f};
#pragma unroll
                    for (int w = 0; w < 8; ++w) up += red[512 + w * 64 + lane];
#pragma unroll
                    for (int r = 0; r < 4; ++r) acc[r] = pg8::fast_silu(acc[r]) * up[r];
                    st_bf16x4(Obf + (size_t)(MREAL + fr) * ldo + n0 + 4 * g, acc); }
                else if (kind == 1) { float* hp = (float*)(F.ws + WS_HM) + (size_t)fr * DM + n0 + 4 * g; *(GAS f32x4*)hp = *(const GAS f32x4*)hp + acc * scale; }
                else if (kind == 2) st_bf16x4(Obf + (size_t)(MREAL + fr) * ldo + n0 + 4 * g, acc);
                else {
#pragma unroll
                    for (int r = 0; r < 4; ++r) acc[r] = pg8::fast_sigmoid(acc[r]);
                    st_bf16x4(Obf + (size_t)(MREAL + fr) * ldo + n0 + 4 * g, acc); }
            }
        }
        __syncthreads();
    }
}
__device__ __forceinline__ void unpack8(const v4u w, float (&x)[8]) { x[0] = bflo(w.x); x[1] = bfhi(w.x); x[2] = bflo(w.y); x[3] = bfhi(w.y); x[4] = bflo(w.z); x[5] = bfhi(w.z); x[6] = bflo(w.w); x[7] = bfhi(w.w); }
__device__ __forceinline__ v4u pack8(const float (&x)[8]) { v4u w; w.x = pk2(x[0], x[1]); w.y = pk2(x[2], x[3]); w.z = pk2(x[4], x[5]); w.w = pk2(x[6], x[7]); return w; }
template <int GL>
__device__ __forceinline__ void norm_cols_inplace(bf16* p, const v4u w, const float* gain, float scale, int lane, bool wr) {
    float x[8]; unpack8(w, x); float s = 0.f;
#pragma unroll
    for (int i = 0; i < 8; ++i) s += x[i] * x[i];
#pragma unroll
    for (int o = 1; o < GL; o <<= 1) s += __shfl_xor(s, o);
    const float inv = scale / sqrtf(s * (1.f / (GL * 8)) + EPS); const int g0 = (8 * lane) % (GL * 8);
#pragma unroll
    for (int i = 0; i < 8; ++i) x[i] = x[i] * inv * gain[g0 + i];
    if (wr) *(GAS v4u*)p = pack8(x);
}
__device__ __forceinline__ void prep_row(Frame& F, int l, int r) {
    const int lane = F.lane; bf16* pr = (bf16*)(F.ws + WS_BIG) + (size_t)r * NNG;
    const float *dqn = FIN(F, I_DQN) + l * 64, *dkn = FIN(F, I_DKN) + l * 64, *sqn = FIN(F, I_SQN) + l * 128, *skn = FIN(F, I_SKN) + l * 128;
    const v4u w0 = *(const GAS v4u*)(pr + C_CQ + 8 * lane), w1 = *(const GAS v4u*)(pr + C_CK + 8 * lane), w2 = *(const GAS v4u*)(pr + C_DQ + 8 * lane), w3 = *(const GAS v4u*)(pr + C_DK + 8 * (lane & 15));
    __builtin_amdgcn_sched_barrier(0);
    norm_cols_inplace<8>(pr + C_CQ + 8 * lane, w0, dqn, 0.125f * 1.4426950408889634f, lane, true);
    norm_cols_inplace<8>(pr + C_CK + 8 * lane, w1, dkn, 1.0f, lane, true);
    norm_cols_inplace<16>(pr + C_DQ + 8 * lane, w2, sqn, 0.08838834764831845f * 1.4426950408889634f, lane, true);
    norm_cols_inplace<16>(pr + C_DK + 8 * (lane & 15), w3, skn, 1.0f, lane & 15, lane < 16);
}
constexpr int VT_NPB = (LPAD + 63) / 64, VT_NTASK = NB * 5 * VT_NPB;
__device__ __forceinline__ void vt_task(Frame& F, int task) {
    const int lane = F.lane;
    const bf16* P = (const bf16*)(F.ws + WS_BIG); bf16* VtC = (bf16*)(F.ws + WS_VTC); bf16* VtD = (bf16*)(F.ws + WS_VTD);
    LAS bf16* T = (LAS bf16*)(F.lds + F.wave * 17408);
    const int pb = task % VT_NPB, mat = (task / VT_NPB) % 5, b = task / (VT_NPB * 5), p0 = 64 * pb;
    const int col = mat < 4 ? C_CV + 128 * mat : C_DV;
#pragma unroll 4
    for (int i = 0; i < 16; ++i) { const int pl = 4 * i + (lane >> 4), p = p0 + pl;
        v4u w = *(const GAS v4u*)(P + (size_t)seqrow(b, p < LSEQ ? p : LSEQ - 1) * NNG + col + 8 * (lane & 15)); if (p >= LSEQ) w = (v4u){0u, 0u, 0u, 0u};
        *(LAS v4u*)(T + pl * 136 + 8 * (lane & 15)) = w; }
    LDS_WAIT(); asm volatile("" ::: "memory");
    bf16* dst = mat < 4 ? VtC + (size_t)(b * 4 + mat) * 128 * LPAD : VtD + (size_t)b * 128 * LPAD;
#pragma unroll 4
    for (int it = 0; it < 16; ++it) { const int e = 8 * it + (lane >> 3), c = lane & 7; unsigned short x[8];
#pragma unroll
        for (int k = 0; k < 8; ++k) x[k] = T[(8 * c + k) * 136 + e];
        v4u w; w.x = x[0] | ((unsigned)x[1] << 16); w.y = x[2] | ((unsigned)x[3] << 16); w.z = x[4] | ((unsigned)x[5] << 16); w.w = x[6] | ((unsigned)x[7] << 16);
        if (p0 + 8 * c < LPAD) *(GAS v4u*)(dst + (size_t)e * LPAD + p0 + 8 * c) = w; }
    LDS_WAIT(); asm volatile("" ::: "memory");
}

#define NEG_INF (-__builtin_inff())
constexpr int NQT = (LSEQ + 31) / 32;
constexpr int NQB = (NQT + 7) / 8;
__device__ __forceinline__ bf16x8 ld_frag16(const bf16* p) { return *(const GAS bf16x8*)p; }
__device__ __forceinline__ bf16x8 mk_frag(v2u lo, v2u hi) { v4u w; w.x = lo.x; w.y = lo.y; w.z = hi.x; w.w = hi.y; return __builtin_bit_cast(bf16x8, w); }
__device__ __forceinline__ unsigned cvtpk(float lo, float hi) { return pg8::cvt_pk_bf16(lo, hi); }
__device__ __forceinline__ void build_bias_table(Frame& F, LAS float* bt, int col0) {
    const float* rb = FIN(F, I_RELB);
    for (int i = F.tid; i < 4 * 128; i += 512) { const int hd = i >> 7, n = i & 127; bt[i] = (rb[rel_bucket(n) * 8 + col0 + hd] - rb[31 * 8 + col0 + hd]) * 1.4426950408889634f; }
}
__device__ __forceinline__ bool softmax_step(f32x16& S, float& m, float& lsum, float& alpha) {
    float tm = S[0];
#pragma unroll
    for (int r = 1; r < 16; ++r) tm = fmaxf(tm, S[r]);
    const bool raise = __any(tm > m + 11.5f);
    alpha = 1.0f;
    if (raise) { tm = fmaxf(tm, __shfl_xor(tm, 32)); const float mn = fmaxf(m, tm); alpha = (mn == NEG_INF) ? 1.0f : __builtin_amdgcn_exp2f(m - mn); m = mn; lsum *= alpha; }
    const float mref = (m == NEG_INF) ? 0.f : m;
    float rs = 0.f;
#pragma unroll
    for (int r = 0; r < 16; ++r) { S[r] = __builtin_amdgcn_exp2f(S[r] - mref); rs += S[r]; }
    lsum += rs;
    return raise;
}
__device__ __forceinline__ void relane(Frame& F) {
    int w = F.wave; asm volatile("" : "+s"(w)); unsigned mk = ~0u; asm volatile("" : "+s"(mk));
    int t = w * 64 + (int)__builtin_amdgcn_mbcnt_hi(mk, __builtin_amdgcn_mbcnt_lo(mk, 0u)); asm volatile("" : "+v"(t)); F.tid = t; F.lane = t & 63; F.wave = w; }
#ifndef NVPRE_DIFF
#define NVPRE_DIFF 4
#endif
#ifndef NVPRE_DSA
#define NVPRE_DSA 4
#endif
template <bool DSA>
__device__ __forceinline__ void attn_wg_task(Frame& F, int l, int b, int h, int J, const LAS float* bt, float lam, float post) {
    constexpr int KD = DSA ? 128 : 64, KP = KD + 8, NKS = KD / 16;
    constexpr int TK = DSA ? 32 : 64, NS = TK / 32, VP = TK + 4, NVL = 128 * (TK / 8) / 512;
    constexpr int KBUF = TK * KP, VBUF = 128 * VP;
    constexpr int RPARK = 57344;
    static_assert(TK * (KD / 8) == 512, "one K chunk per thread");
    constexpr int NVPRE = DSA ? NVPRE_DSA : NVPRE_DIFF;
    relane(F);
    const int lane = F.lane, ql = lane & 31, hh = lane >> 5, wave = F.wave, tid = F.tid;
    LAS bf16* Kl = (LAS bf16*)F.lds; LAS bf16* Vl = Kl + 2 * KBUF;
    const bf16* P = (const bf16*)(F.ws + WS_BIG);
    const bf16* Vt = DSA ? (const bf16*)(F.ws + WS_VTD) + (size_t)b * 128 * LPAD : (const bf16*)(F.ws + WS_VTC) + (size_t)(b * 4 + h) * 128 * LPAD;
    const int jr = 8 * J + wave - 7; const bool wvalid = jr >= 0 && 32 * jr < LSEQ; const int j = jr < 0 ? 0 : jr;
    const int ktmax = (8 * J < NQT - 1) ? 8 * J : NQT - 1;
    const int pq = 32 * j + ql, pqc = pq < LSEQ ? pq : LSEQ - 1;
    const bf16* qrow = P + (size_t)seqrow(b, pqc) * NNG + (DSA ? C_DQ : C_CQ) + h * 128 + 8 * hh;
    const unsigned* mrow = (const unsigned*)(F.ws + WS_MASK) + ((size_t)b * LPAD + pqc) * MASKW;
    f32x16 R[4];
#pragma unroll
    for (int c = 0; c < (DSA ? 1 : 2); ++c) {
        const int kcol = DSA ? C_DK : C_CK + h * 128 + c * 64;
        relane(F);
        const int tid2 = F.tid, kr = tid2 / (KD / 8), kc = tid2 % (KD / 8), vr = tid2 / (TK / 8), vc = tid2 % (TK / 8);
        bf16x8 qf[NKS];
#pragma unroll
        for (int ks = 0; ks < NKS; ++ks) qf[ks] = ld_frag16(qrow + (DSA ? 0 : c * 64) + 16 * ks);
        float m = NEG_INF, lsum = 0.f; f32x16 O[4];
#pragma unroll
        for (int eb = 0; eb < 4; ++eb)
#pragma unroll
            for (int r = 0; r < 16; ++r) O[eb][r] = 0.f;
        v4u rk0 = (v4u){0u, 0u, 0u, 0u}, rk1 = rk0, rv0[NVL], rv1[NVL];
#pragma unroll
        for (int i = 0; i < NVL; ++i) { rv0[i] = rk0; rv1[i] = rk0; }
#define ATT_ISSUE(st_, RK, RV) do { int pk_ = TK * (st_) + kr; pk_ = pk_ < LSEQ ? pk_ : LSEQ - 1; \
            RK = *(const GAS v4u*)(P + (size_t)seqrow(b, pk_) * NNG + kcol + 8 * kc); \
            int vcol_ = TK * (st_) + 8 * vc; vcol_ = vcol_ < LPAD - 8 ? vcol_ : LPAD - 8; \
            _Pragma("unroll") for (int i_ = 0; i_ < NVL; ++i_) RV[i_] = *(const GAS v4u*)(Vt + (size_t)(vr + i_ * (512 / (TK / 8))) * LPAD + vcol_); } while (0)
#define ATT_COMMIT(buf_, RK, RV) do { *(LAS v4u*)(Kl + (buf_) * KBUF + kr * KP + 8 * kc) = RK; \
            _Pragma("unroll") for (int i_ = 0; i_ < NVL; ++i_) { LAS v2u* vd_ = (LAS v2u*)(Vl + (buf_) * VBUF + (vr + i_ * (512 / (TK / 8))) * VP + 8 * vc); vd_[0] = (v2u){RV[i_].x, RV[i_].y}; vd_[1] = (v2u){RV[i_].z, RV[i_].w}; } } while (0)
        unsigned mwc = 0xffffffffu, mwn = 0xffffffffu; if (DSA) mwc = mrow[0];
        auto compute = [&](int kt, int buf, int sub) {
            if (DSA) mwn = mrow[kt + 1 <= ktmax ? kt + 1 : ktmax];
            if (wvalid && kt <= j) {
                const LAS bf16* Kt = Kl + buf * KBUF + (32 * sub + ql) * KP + 8 * hh; const LAS bf16* Vb = Vl + buf * VBUF + ql * VP + 32 * sub + 4 * hh;
                f32x16 S;
#pragma unroll
                for (int r = 0; r < 16; ++r) S[r] = 0.f;
#pragma unroll
                for (int ks = 0; ks < NKS; ++ks) S = __builtin_amdgcn_mfma_f32_32x32x16_bf16(*(const LAS bf16x8*)(Kt + 16 * ks), qf[ks], S, 0, 0, 0);
                const unsigned mw = mwc >> (4 * hh);
                if (kt + 4 >= j) {
                    const int n0 = pq - (32 * kt + 4 * hh); float bv[16];
#pragma unroll
                    for (int r = 0; r < 16; ++r) { const int ko = (r & 3) + 8 * (r >> 2); int n = n0 - ko; n = n < 0 ? 0 : (n < 127 ? n : 127); bv[r] = bt[h * 128 + n]; }
#pragma unroll
                    for (int r = 0; r < 16; ++r) { const int ko = (r & 3) + 8 * (r >> 2); const bool sel = ((mw >> ko) & 1u) && n0 >= ko; S[r] = sel ? S[r] + bv[r] : NEG_INF; }
                } else if (DSA) {
#pragma unroll
                    for (int r = 0; r < 16; ++r) { const int ko = (r & 3) + 8 * (r >> 2); S[r] = ((mw >> ko) & 1u) ? S[r] : NEG_INF; }
                }
                bf16x8 vf[NVPRE > 0 ? NVPRE : 1];
#pragma unroll
                for (int i = 0; i < NVPRE; ++i) { const LAS bf16* vp = Vb + (i >> 1) * 32 * VP + 16 * (i & 1); vf[i] = mk_frag(*(const LAS v2u*)vp, *(const LAS v2u*)(vp + 8)); }
                float alpha;
                if (softmax_step(S, m, lsum, alpha)) {
#pragma unroll
                    for (int eb = 0; eb < 4; ++eb)
#pragma unroll
                        for (int r = 0; r < 16; ++r) O[eb][r] *= alpha;
                }
                bf16x8 pf[2];
#pragma unroll
                for (int s = 0; s < 2; ++s) { v4u w; w.x = cvtpk(S[8 * s + 0], S[8 * s + 1]); w.y = cvtpk(S[8 * s + 2], S[8 * s + 3]); w.z = cvtpk(S[8 * s + 4], S[8 * s + 5]); w.w = cvtpk(S[8 * s + 6], S[8 * s + 7]); pf[s] = __builtin_bit_cast(bf16x8, w); }
#pragma unroll
                for (int eb = 0; eb < 4; ++eb)
#pragma unroll
                    for (int s = 0; s < 2; ++s) { const LAS bf16* vp = Vb + eb * 32 * VP + 16 * s;
                        O[eb] = __builtin_amdgcn_mfma_f32_32x32x16_bf16((2 * eb + s < NVPRE) ? vf[(2 * eb + s < NVPRE) ? 2 * eb + s : 0] : mk_frag(*(const LAS v2u*)vp, *(const LAS v2u*)(vp + 8)), pf[s], O[eb], 0, 0, 0); }
            }
            if (DSA) mwc = mwn; };
        __syncthreads();
        const int stmax = ktmax / NS;
        ATT_ISSUE(0, rk0, rv0); ATT_COMMIT(0, rk0, rv0);
        if (stmax >= 1) ATT_ISSUE(1, rk1, rv1);
        for (int st = 0; st <= stmax; st += 2) {
            LDS_WAIT(); __syncthreads();
            if (st + 2 <= stmax) ATT_ISSUE(st + 2, rk0, rv0);
#pragma unroll 1
            for (int sub = 0; sub < NS; ++sub) compute(NS * st + sub, 0, sub);
            if (st + 1 <= stmax) ATT_COMMIT(1, rk1, rv1);
            if (st + 1 > stmax) break;
            LDS_WAIT(); __syncthreads();
            if (st + 3 <= stmax) ATT_ISSUE(st + 3, rk1, rv1);
#pragma unroll 1
            for (int sub = 0; sub < NS; ++sub) compute(NS * (st + 1) + sub, 1, sub);
            if (st + 2 <= stmax) ATT_COMMIT(0, rk0, rv0);
        }
#undef ATT_ISSUE
#undef ATT_COMMIT
        lsum += __shfl_xor(lsum, 32); const float il = 1.0f / lsum;
        if (DSA) {
#pragma unroll
            for (int eb = 0; eb < 4; ++eb)
#pragma unroll
                for (int r = 0; r < 16; ++r) R[eb][r] = O[eb][r] * il;
        } else if (c == 0) {
            LAS unsigned* rp = (LAS unsigned*)(F.lds + RPARK) + wave * 2048 + lane;
#pragma unroll
            for (int eb = 0; eb < 4; ++eb)
#pragma unroll
                for (int r = 0; r < 16; r += 2) rp[(eb * 8 + (r >> 1)) * 64] = pk2(O[eb][r] * il, O[eb][r + 1] * il);
        } else {
            const LAS unsigned* rp = (const LAS unsigned*)(F.lds + RPARK) + wave * 2048 + lane;
#pragma unroll
            for (int eb = 0; eb < 4; ++eb)
#pragma unroll
                for (int r = 0; r < 16; r += 2) { const unsigned w = rp[(eb * 8 + (r >> 1)) * 64]; R[eb][r] = bflo(w) - lam * (O[eb][r] * il); R[eb][r + 1] = bfhi(w) - lam * (O[eb][r + 1] * il); }
        }
    }
    float inv = 1.0f;
    if (!DSA) { float ss = 0.f;
#pragma unroll
        for (int eb = 0; eb < 4; ++eb)
#pragma unroll
            for (int r = 0; r < 16; ++r) ss += R[eb][r] * R[eb][r];
        ss += __shfl_xor(ss, 32); inv = post / sqrtf(ss * (1.f / 128.f) + EPS); }
    const float* sub = FIN(F, I_DSUB) + l * 128;
    if (wvalid && pq < LSEQ && (pq >= NMETA || b == 0)) {
        bf16* orow = (bf16*)(F.ws + WS_BR) + (size_t)(DSA ? 3 : 2) * MPAD * 512 + (size_t)seqrow(b, pq) * 512 + h * 128;
#pragma unroll
        for (int eb = 0; eb < 4; ++eb)
#pragma unroll
            for (int g = 0; g < 4; ++g) { const int e0 = 32 * eb + 8 * g + 4 * hh; f32x4 sv = (f32x4){1.f, 1.f, 1.f, 1.f}; if (!DSA) sv = *(const GAS f32x4*)(sub + e0);
                v2u w; w.x = pk2(R[eb][4 * g] * inv * sv.x, R[eb][4 * g + 1] * inv * sv.y); w.y = pk2(R[eb][4 * g + 2] * inv * sv.z, R[eb][4 * g + 3] * inv * sv.w);
                *(GAS v2u*)(orow + e0) = w; }
    }
}
__device__ __forceinline__ unsigned f32_key(float f) { const unsigned u = __float_as_uint(f); return u ^ ((u >> 31) ? 0xffffffffu : 0x80000000u); }
__device__ __forceinline__ float relu_bits(float x) { const int i = __float_as_int(x); return __int_as_float(i > 0 ? i : 0); }
__device__ __forceinline__ void dsa_index_task(Frame& F, int b, int j, float* slab) {
    relane(F);
    const int lane = F.lane, ql = lane & 31, hh = lane >> 5, wave = F.wave;
    const bf16* P = (const bf16*)(F.ws + WS_BIG);
    LAS unsigned char* qi = F.lds;
    { v4u st[8];
#pragma unroll
      for (int k = 0; k < 8; ++k) { const int i = F.tid + 512 * k, q = i >> 7, ch = i & 127; int pq = 32 * j + q; pq = pq < LSEQ ? pq : LSEQ - 1;
          st[k] = *(const GAS v4u*)(P + (size_t)seqrow(b, pq) * NNG + C_DQI + 8 * ch); }
#pragma unroll
      for (int k = 0; k < 8; ++k) { const int i = F.tid + 512 * k, q = i >> 7, ch = i & 127; *(LAS v4u*)(qi + q * 2064 + 16 * ch) = st[k]; } }
    LAS float* wl = (LAS float*)(qi + 32 * 2064);
    if (F.tid < 32 * 16) { const int q = F.tid >> 4, hd = F.tid & 15; int pq = 32 * j + q; pq = pq < LSEQ ? pq : LSEQ - 1;
        wl[F.tid] = bf2f(P[(size_t)seqrow(b, pq) * NNG + C_DW + hd]) * 0.03125f; }
    LAS unsigned* hist = (LAS unsigned*)(F.lds + 73728);
    for (int i = F.tid; i < 32 * 256; i += 512) hist[i] = 0u;
    LDS_WAIT(); __syncthreads();
#ifndef PROBE_SUB
#define PROBE_SUB 0
#endif
    for (int rpa = 0; rpa < ((PROBE_SUB & 8) ? 2 : 1); ++rpa)
    {
    if (rpa) { LDS_WAIT(); __syncthreads(); for (int i = F.tid; i < 32 * 256; i += 512) hist[i] = 0u; LDS_WAIT(); __syncthreads(); }
    bf16x8 kn[4];
    { const int pk = 32 * wave + ql, pkc = pk < LSEQ ? pk : LSEQ - 1; const bf16* krow = P + (size_t)seqrow(b, pkc) * NNG + C_DKI + 8 * hh;
#pragma unroll
      for (int ks = 0; ks < 4; ++ks) kn[ks] = ld_frag16(krow + 16 * ks); }
    for (int kt = wave; kt <= j; kt += NWAVES) {
        bf16x8 kf[4];
#pragma unroll
        for (int ks = 0; ks < 4; ++ks) kf[ks] = kn[ks];
        { const int ktn = kt + NWAVES <= j ? kt + NWAVES : kt; const int pk = 32 * ktn + ql, pkc = pk < LSEQ ? pk : LSEQ - 1; const bf16* krow = P + (size_t)seqrow(b, pkc) * NNG + C_DKI + 8 * hh;
#pragma unroll
          for (int ks = 0; ks < 4; ++ks) kn[ks] = ld_frag16(krow + 16 * ks); }
        f32x16 idx;
#pragma unroll
        for (int r = 0; r < 16; ++r) idx[r] = 0.f;
#pragma unroll 1
        for (int hd = 0; hd < 16; hd += 2) { f32x16 S0, S1; const float wh0 = wl[ql * 16 + hd], wh1 = wl[ql * 16 + hd + 1];
#pragma unroll
            for (int r = 0; r < 16; ++r) { S0[r] = 0.f; S1[r] = 0.f; }
#pragma unroll
            for (int ks = 0; ks < 4; ++ks) { S0 = __builtin_amdgcn_mfma_f32_32x32x16_bf16(kf[ks], *(const LAS bf16x8*)(qi + ql * 2064 + hd * 128 + 32 * ks + 16 * hh), S0, 0, 0, 0);
                S1 = __builtin_amdgcn_mfma_f32_32x32x16_bf16(kf[ks], *(const LAS bf16x8*)(qi + ql * 2064 + (hd + 1) * 128 + 32 * ks + 16 * hh), S1, 0, 0, 0); }
#pragma unroll
            for (int r = 0; r < 16; ++r) { idx[r] = __builtin_fmaf(wh0, relu_bits(S0[r]), idx[r]); idx[r] = __builtin_fmaf(wh1, relu_bits(S1[r]), idx[r]); } }
        { const int lim = 32 * (j - kt) + ql - 4 * hh;
#pragma unroll
          for (int r = 0; r < 16; ++r) { const int ko = (r & 3) + 8 * (r >> 2);
              int bn = (int)__builtin_fmaf(idx[r], 32.f, 256.f); bn = bn < 0 ? 0 : (bn > 511 ? 511 : bn);
              const unsigned inc = (ko <= lim) ? ((bn & 1) ? 0x10000u : 1u) : 0u;
              (void)__hip_atomic_fetch_add(hist + ql * 256 + (((bn >> 1) + 2 * ql) & 255), inc, __ATOMIC_RELAXED, __HIP_MEMORY_SCOPE_WORKGROUP); } }
        float* srow = slab + (size_t)ql * LPAD + 32 * kt + 4 * hh;
#pragma unroll
        for (int g = 0; g < 4; ++g) *(GAS f32x4*)(srow + 8 * g) = (f32x4){idx[4 * g], idx[4 * g + 1], idx[4 * g + 2], idx[4 * g + 3]};
    }
    }
    VM_WAIT(); LDS_WAIT(); __syncthreads();
    for (int rpb = 0; rpb < ((PROBE_SUB & 16) ? 2 : 1); ++rpb)
    for (int qq = wave; qq < 32; qq += NWAVES) {
        const int p = 32 * j + qq; if (p >= LSEQ) break;
        const float* row = slab + (size_t)qq * LPAD;
        unsigned u[65];
        { const GAS unsigned* rp = (const GAS unsigned*)row + lane;
#pragma unroll
          for (int i = 0; i < 65; ++i) u[i] = rp[64 * i];
          __builtin_amdgcn_sched_barrier(0); }
        auto wsum = [&](unsigned c) { unsigned s = 0;
#pragma unroll
            for (int k = 0; k < 7; ++k) s += (unsigned)__builtin_popcountll(__ballot((c >> k) & 1u)) << k;
            return s; };
        unsigned T = 1u;
        if (p + 1 <= 256) {
#pragma unroll
            for (int i = 0; i < 65; ++i) { const unsigned k = f32_key(__uint_as_float(u[i])) >> 1; u[i] = (64 * i + lane <= p) ? k : 0u; }
        } else {
            const LAS unsigned* hrow = hist + qq * 256; unsigned c8[8];
#pragma unroll
            for (int i = 0; i < 4; ++i) { const unsigned w = hrow[(4 * lane + i + 2 * qq) & 255]; c8[2 * i] = w & 0xffffu; c8[2 * i + 1] = w >> 16; }
            unsigned tot = 0;
#pragma unroll
            for (int i = 0; i < 8; ++i) tot += c8[i];
            unsigned suf = 0;
            { const unsigned long long gtm = (lane == 63) ? 0ull : ~((2ull << lane) - 1ull);
#pragma unroll
              for (int k = 0; k < 13; ++k) suf += (unsigned)__builtin_popcountll(__ballot((tot >> k) & 1u) & gtm) << k; }
            unsigned run = suf, bl = 0, al = 0; bool found = false;
#pragma unroll
            for (int i = 7; i >= 0; --i) { const bool hit = !found && run < 256u && run + c8[i] >= 256u; if (hit) { bl = 8u * lane + i; al = run; } found = found || hit; run += c8[i]; }
            const unsigned long long fb = __ballot(found); const int src = (int)__builtin_ctzll(fb | (1ull << 63));
            const unsigned bstar = __builtin_amdgcn_readlane(bl, src), above = __builtin_amdgcn_readlane(al, src), need = 256u - above;
            unsigned f0 = 0u, f1 = 0u, f2 = 0u, cb = 0u;
#pragma unroll
            for (int i = 0; i < 65; ++i) { const float v = __uint_as_float(u[i]); int bn = (int)__builtin_fmaf(v, 32.f, 256.f); bn = bn < 0 ? 0 : (bn > 511 ? 511 : bn);
                const bool val = 64 * i + lane <= p, inband = val && (unsigned)bn == bstar;
                if (i < 32) f0 |= inband ? (1u << i) : 0u; else if (i < 64) f1 |= inband ? (1u << (i - 32)) : 0u; else f2 = inband ? 1u : 0u;
                cb += inband ? 1u : 0u;
                const unsigned k = f32_key(v) >> 1; u[i] = val ? k : 0u; }
            const unsigned inb = wsum(cb);
            if (fb != 0ull && inb <= 128u && inb >= need) {
                LAS unsigned* band = (LAS unsigned*)(F.lds + 68096) + wave * 128;
                unsigned off = 0;
#pragma unroll
                for (int k = 0; k < 7; ++k) { const unsigned long long bal = __ballot((cb >> k) & 1u); off += __builtin_amdgcn_mbcnt_hi((unsigned)(bal >> 32), __builtin_amdgcn_mbcnt_lo((unsigned)bal, 0u)) << k; }
#pragma unroll
                for (int i = 0; i < 65; ++i) { const bool inband = i < 32 ? ((f0 >> i) & 1u) : (i < 64 ? ((f1 >> (i - 32)) & 1u) : (f2 & 1u)); if (inband) { band[off] = u[i]; ++off; } }
                LDS_WAIT();
                const unsigned m0 = lane < (int)inb ? band[lane] : 0u, m1 = lane + 64 < (int)inb ? band[lane + 64] : 0u; unsigned ge0 = 0, gt0 = 0, ge1 = 0, gt1 = 0;
                for (unsigned k = 0; k < inb; ++k) { const unsigned v = band[k]; ge0 += (m0 - 1u - v) >> 31; gt0 += (m0 - v) >> 31; ge1 += (m1 - 1u - v) >> 31; gt1 += (m1 - v) >> 31; }
                const unsigned long long ok0 = __ballot(lane < (int)inb && ge0 >= need && gt0 < need), ok1 = __ballot(lane + 64 < (int)inb && ge1 >= need && gt1 < need);
                if (ok0) T = __builtin_amdgcn_readlane(m0, (int)__builtin_ctzll(ok0)); else T = __builtin_amdgcn_readlane(m1, (int)__builtin_ctzll(ok1 | (1ull << 63)));
                LDS_WAIT();
            } else {
                T = 0u;
                for (int bit = 30; bit >= 0; --bit) { const unsigned cm1 = (T | (1u << bit)) - 1u; unsigned c = 0;
#pragma unroll
                    for (int i = 0; i < 65; ++i) c += (cm1 - u[i]) >> 31;
                    if (wsum(c) >= 256u) T |= 1u << bit; } } }
        unsigned long long* mrow = (unsigned long long*)((unsigned*)(F.ws + WS_MASK) + ((size_t)b * LPAD + p) * MASKW);
        unsigned wlo = 0u, whi = 0u;
#pragma unroll
        for (int i = 0; i < 64; ++i) { const unsigned long long bal = __ballot(u[i] >= T); if (lane == i) { wlo = (unsigned)bal; whi = (unsigned)(bal >> 32); } }
        const unsigned long long b64 = __ballot(u[64] >= T);
        mrow[lane] = ((unsigned long long)whi << 32) | wlo; if (lane == 0) mrow[64] = b64;
    }
    __syncthreads();
}
struct HgChunk { bf16* base; int pitch; int cq, ck, cv; bf16* A; float* dl; };
__device__ __forceinline__ HgChunk hg_chunk(Frame& F, int b, int h, int c) {
    HgChunk k;
    if (c == 0) { unsigned char* mp = F.ws + WS_HMETA + (size_t)h * HMETA_STRIDE; k.base = (bf16*)mp; k.pitch = 384; k.cq = 0; k.ck = 128; k.cv = 256; k.A = (bf16*)(mp + 64 * 384 * 2); k.dl = (float*)(mp + 64 * 384 * 2 + 64 * 64 * 2); }
    else { const size_t ci = (size_t)(b * 4 + h) * 64 + (c - 1); k.base = (bf16*)(F.ws + WS_BIG) + (size_t)(b * SEQ + 64 * (c - 1)) * NNG; k.pitch = NNG; k.cq = C_AQ + h * 128; k.ck = C_AF + h * 128; k.cv = C_AI + h * 128;
        k.A = (bf16*)(F.ws + WS_HA) + ci * 64 * 64; k.dl = (float*)(F.ws + WS_HDL) + ci * 128; }
    return k;
}
__device__ __forceinline__ void hgrn_prep_task(Frame& F, int l, int b, int h, int c) {
    const int d = F.tid & 127, tq = F.tid >> 7, lane = F.lane, wave = F.wave;
    const bf16* P = (const bf16*)(F.ws + WS_BIG);
    LAS bf16* Qt = (LAS bf16*)F.lds; LAS bf16* Kt = Qt + 64 * 136; LAS float* part = (LAS float*)(F.lds + 2 * 64 * 136 * 2);
    const HgChunk ch = hg_chunk(F, b, h, c);
    float lb = 0.f; if (l == 1) { const float a = FIN(F, I_LB)[h * 128 + d], cc = FIN(F, I_LB)[512 + h * 128 + d]; lb = 1.0f / (1.0f + __expf(a - cc)); }
    const bool meta = (c == 0);
    unsigned short zr[16], qr[16], vr[16];
    { const int r0 = meta ? MREAL : b * SEQ + 64 * (c - 1);
#pragma unroll
      for (int i = 0; i < 16; ++i) { int t = 16 * tq + i; if (meta) t = t < NMETA ? t : NMETA - 1; const bf16* pr = P + (size_t)(r0 + t) * NNG + h * 128 + d; zr[i] = pr[C_AF]; qr[i] = pr[C_AQ]; vr[i] = pr[C_AI]; }
      __builtin_amdgcn_sched_barrier(0); }
    float lfv[16];
    float run = 0.f;
#pragma unroll
    for (int i = 0; i < 16; ++i) { const bool valid = !meta || (16 * tq + i < NMETA); const float z = bf2f(zr[i]); const float sg = 1.0f / (1.0f + __expf(-z));
        lfv[i] = valid ? __logf(lb + (1.0f - lb) * sg) : 0.f; run += lfv[i]; }
    part[tq * 128 + d] = run;
    LDS_WAIT(); __syncthreads();
    const float p0 = part[d], p1 = part[128 + d], p2 = part[256 + d], p3 = part[384 + d];
    const float off = (tq > 0 ? p0 : 0.f) + (tq > 1 ? p1 : 0.f) + (tq > 2 ? p2 : 0.f), bmid = p0 + p1, blast = (p0 + p1) + (p2 + p3);
    unsigned kb[8], vb[8]; unsigned short qb[16];
    float bt = off;
#pragma unroll
    for (int i = 0; i < 16; i += 2) { float kbar[2], vv[2];
#pragma unroll
        for (int u = 0; u < 2; ++u) { const int t = 16 * tq + i + u; const bool valid = !meta || (t < NMETA);
            const float lf = lfv[i + u]; const float q = bf2f(qr[i + u]);
            const float kk = valid ? 1.0f - __expf(lf) : 0.f, qq = valid ? q / (1.0f + __expf(-q)) : 0.f; vv[u] = valid ? bf2f(vr[i + u]) : 0.f;
            bt += lf;
            kbar[u] = kk * __expf(blast - bt); qb[i + u] = (unsigned short)f2bf_s(qq * __expf(bt));
            const float qt = qq * __expf(fminf(bt - bmid, 80.f)), kt = kk * __expf(fminf(bmid - bt, 80.f));
            Qt[t * 136 + d] = (bf16)f2bf_s(qt); Kt[t * 136 + d] = (bf16)f2bf_s(kt); }
        kb[i >> 1] = pk2(kbar[0], kbar[1]); vb[i >> 1] = pk2(vv[0], vv[1]); }
    asm volatile("s_waitcnt vmcnt(0)" ::: "memory"); __syncthreads();
#pragma unroll
    for (int i = 0; i < 16; ++i) ch.base[(size_t)(16 * tq + i) * ch.pitch + ch.cq + d] = qb[i];
    { bf16* kd = ch.base + (size_t)(d >> 1) * ch.pitch + ch.ck + (d & 1) * 64 + 16 * tq; bf16* vd = ch.base + (size_t)(d >> 1) * ch.pitch + ch.cv + (d & 1) * 64 + 16 * tq;
      *(GAS v4u*)kd = (v4u){kb[0], kb[1], kb[2], kb[3]}; *(GAS v4u*)(kd + 8) = (v4u){kb[4], kb[5], kb[6], kb[7]};
      *(GAS v4u*)vd = (v4u){vb[0], vb[1], vb[2], vb[3]}; *(GAS v4u*)(vd + 8) = (v4u){vb[4], vb[5], vb[6], vb[7]}; }
    if (tq == 0) ch.dl[d] = __expf(blast);
    LDS_WAIT(); __syncthreads();
    { const int mt = wave >> 1, fr = lane & 15, g = lane >> 4;
#pragma unroll
      for (int u = 0; u < 2; ++u) { const int nt = 2 * (wave & 1) + u; f32x4 acc = (f32x4){0.f, 0.f, 0.f, 0.f};
        if (nt <= mt) {
#pragma unroll
            for (int ks = 0; ks < 4; ++ks) acc = __builtin_amdgcn_mfma_f32_16x16x32_bf16(*(const LAS bf16x8*)(Qt + (16 * mt + fr) * 136 + 32 * ks + 8 * g), *(const LAS bf16x8*)(Kt + (16 * nt + fr) * 136 + 32 * ks + 8 * g), acc, 0, 0, 0);
        }
#pragma unroll
        for (int r = 0; r < 4; ++r) { const int t = 16 * mt + 4 * g + r, s = 16 * nt + fr; ch.A[t * 64 + s] = (bf16)f2bf_s(s <= t ? acc[r] : 0.f); } } }
    __syncthreads();
}
__device__ __forceinline__ float fast_sigmoid_m(float x) { return __builtin_amdgcn_rcpf(1.0f + __expf(-x)); }
__device__ __forceinline__ void hgrn_scan_unit(Frame& F, int l, int b, int h) {
    const int lane = F.lane, wave = F.wave, fr = lane & 15, g = lane >> 4, tid = F.tid;
    constexpr int QP = 136, AP = 72, KP = 72, GP = 136;
    constexpr int BUF = (64 * QP + 64 * AP + 128 * KP + 64 * GP) * 2 + 512;
    LAS float* red = (LAS float*)(F.lds + 2 * BUF);
    const int dv = 16 * wave + fr;
    const float gn = FIN(F, I_GN)[l * 512 + h * 128 + dv];
    const bf16* Pg = (const bf16*)(F.ws + WS_BIG) + C_AG + h * 128;
    f32x4 S[8];
#pragma unroll
    for (int mt = 0; mt < 8; ++mt) S[mt] = (f32x4){0.f, 0.f, 0.f, 0.f};
    v4u rq[2], ra, rk[2], rg[2], rd; bf16x8 bv0, bv1, bn0, bn1;
#define HG_ISSUE(c_, B0, B1) do { const HgChunk ch_ = hg_chunk(F, b, h, (c_)); const int nv_ = ((c_) == 0) ? NMETA : 64; \
        _Pragma("unroll") for (int i = 0; i < 2; ++i) { const int idx = tid + 512 * i, row = idx >> 4, c16 = idx & 15; \
            rq[i] = *(const GAS v4u*)(ch_.base + (size_t)row * ch_.pitch + ch_.cq + 8 * c16); rk[i] = *(const GAS v4u*)(ch_.base + (size_t)row * ch_.pitch + ch_.ck + 8 * c16); \
            rg[i] = (v4u){0u, 0u, 0u, 0u}; if (row < nv_) rg[i] = *(const GAS v4u*)(Pg + (size_t)(((c_) == 0) ? MREAL + row : b * SEQ + 64 * ((c_) - 1) + row) * NNG + 8 * c16); } \
        ra = *(const GAS v4u*)(ch_.A + 8 * tid); if (tid < 32) rd = *(const GAS v4u*)(ch_.dl + 4 * tid); \
        const bf16* vrow_ = ch_.base + (size_t)(dv >> 1) * ch_.pitch + ch_.cv + (dv & 1) * 64 + 8 * g; B0 = ld_frag16(vrow_); B1 = ld_frag16(vrow_ + 32); } while (0)
#define HG_COMMIT(buf_) do { LAS bf16* Q_ = (LAS bf16*)(F.lds + (buf_) * BUF); LAS bf16* A_ = Q_ + 64 * QP; LAS bf16* KT_ = A_ + 64 * AP; LAS bf16* G_ = KT_ + 128 * KP; \
        _Pragma("unroll") for (int i = 0; i < 2; ++i) { const int idx = tid + 512 * i, row = idx >> 4, c16 = idx & 15; *(LAS v4u*)(Q_ + row * QP + 8 * c16) = rq[i]; \
            *(LAS v4u*)(KT_ + (2 * row + (c16 >> 3)) * KP + 8 * (c16 & 7)) = rk[i]; *(LAS v4u*)(G_ + row * GP + 8 * c16) = rg[i]; } \
        *(LAS v4u*)(A_ + (tid >> 3) * AP + 8 * (tid & 7)) = ra; if (tid < 32) *(LAS v4u*)((LAS unsigned char*)(G_ + 64 * GP) + 16 * tid) = rd; } while (0)
    HG_ISSUE(0, bv0, bv1); HG_COMMIT(0);
    for (int c = 0; c <= 64; ++c) {
        const int buf = c & 1;
        LDS_WAIT(); __syncthreads();
        if (c < 64) HG_ISSUE(c + 1, bn0, bn1);
        LAS bf16* Q = (LAS bf16*)(F.lds + buf * BUF); LAS bf16* A = Q + 64 * QP; LAS bf16* KT = A + 64 * AP; LAS bf16* G = KT + 128 * KP; const LAS float* DL = (const LAS float*)(G + 64 * GP);
        f32x4 o[4];
#pragma unroll
        for (int mt = 0; mt < 4; ++mt) o[mt] = (f32x4){0.f, 0.f, 0.f, 0.f};
#pragma unroll
        for (int ks = 0; ks < 4; ++ks) { v4u w; w.x = cvtpk(S[2 * ks][0], S[2 * ks][1]); w.y = cvtpk(S[2 * ks][2], S[2 * ks][3]); w.z = cvtpk(S[2 * ks + 1][0], S[2 * ks + 1][1]); w.w = cvtpk(S[2 * ks + 1][2], S[2 * ks + 1][3]);
            const bf16x8 sb = __builtin_bit_cast(bf16x8, w);
#pragma unroll
            for (int mt = 0; mt < 4; ++mt) { const LAS bf16* qp = Q + (16 * mt + fr) * QP + 32 * ks + 4 * g;
                const bf16x8 af = mk_frag(*(const LAS v2u*)qp, *(const LAS v2u*)(qp + 16));
                o[mt] = __builtin_amdgcn_mfma_f32_16x16x32_bf16(af, sb, o[mt], 0, 0, 0); } }
#pragma unroll
        for (int mt = 0; mt < 4; ++mt) { o[mt] = __builtin_amdgcn_mfma_f32_16x16x32_bf16(*(const LAS bf16x8*)(A + (16 * mt + fr) * AP + 8 * g), bv0, o[mt], 0, 0, 0);
            o[mt] = __builtin_amdgcn_mfma_f32_16x16x32_bf16(*(const LAS bf16x8*)(A + (16 * mt + fr) * AP + 32 + 8 * g), bv1, o[mt], 0, 0, 0); }
#pragma unroll
        for (int mt = 0; mt < 8; ++mt) { const f32x4 dl = *(const LAS f32x4*)(DL + 16 * mt + 4 * g); S[mt] = S[mt] * dl;
            S[mt] = __builtin_amdgcn_mfma_f32_16x16x32_bf16(*(const LAS bf16x8*)(KT + (16 * mt + fr) * KP + 8 * g), bv0, S[mt], 0, 0, 0);
            S[mt] = __builtin_amdgcn_mfma_f32_16x16x32_bf16(*(const LAS bf16x8*)(KT + (16 * mt + fr) * KP + 32 + 8 * g), bv1, S[mt], 0, 0, 0); }
        { float s2[16];
#pragma unroll
          for (int i = 0; i < 16; ++i) s2[i] = o[i >> 2][i & 3] * o[i >> 2][i & 3];
#define HG_ROR(n_) _Pragma("unroll") for (int i = 0; i < 16; ++i) s2[i] += __builtin_bit_cast(float, __builtin_amdgcn_update_dpp(0, __builtin_bit_cast(int, s2[i]), 0x120 + (n_), 0xf, 0xf, false));
          HG_ROR(8) HG_ROR(4) HG_ROR(2) HG_ROR(1)
#undef HG_ROR
          if (fr == 0) {
#pragma unroll
              for (int mt = 0; mt < 4; ++mt) *(LAS f32x4*)(red + wave * 64 + 16 * mt + 4 * g) = (f32x4){s2[4 * mt], s2[4 * mt + 1], s2[4 * mt + 2], s2[4 * mt + 3]}; } }
        LDS_WAIT(); __syncthreads();
        const int nvalid = (c == 0) ? NMETA : 64;
        { f32x4 tot[4]; float gr[16];
#pragma unroll
          for (int mt = 0; mt < 4; ++mt) { tot[mt] = *(const LAS f32x4*)(red + 16 * mt + 4 * g);
#pragma unroll
              for (int w = 1; w < 8; ++w) tot[mt] += *(const LAS f32x4*)(red + w * 64 + 16 * mt + 4 * g); }
#pragma unroll
          for (int i = 0; i < 16; ++i) gr[i] = bf2f(G[(16 * (i >> 2) + 4 * g + (i & 3)) * GP + dv]);
          if (c > 0 || b == 0) {
#pragma unroll
              for (int i = 0; i < 16; ++i) { const int t = 16 * (i >> 2) + 4 * g + (i & 3); const int row = (c == 0) ? MREAL + t : b * SEQ + 64 * (c - 1) + t;
                  const float val = o[i >> 2][i & 3] * __builtin_amdgcn_rsqf(tot[i >> 2][i & 3] * (1.f / 128.f) + EPS) * gn * (gr[i] * fast_sigmoid_m(gr[i]));
                  if (t < nvalid) ((bf16*)(F.ws + WS_BR))[(size_t)row * 512 + h * 128 + dv] = (bf16)f2bf_s(val); } } }
        if (c < 64) { HG_COMMIT(buf ^ 1); bv0 = bn0; bv1 = bn1; }
    }
#undef HG_ISSUE
#undef HG_COMMIT
    __syncthreads();
}
__device__ __forceinline__ void conv_row(Frame& F, int l, int r) {
    const int lane = F.lane; const bf16* P = (const bf16*)(F.ws + WS_BIG);
    int r1, r2;
    if (r < MREAL) { const int b = r >> 12, t = r & 4095; r1 = seqrow(b, NMETA + t - 1); r2 = seqrow(b, NMETA + t - 2); }
    else { const int i = r - MREAL; r1 = i >= 1 ? r - 1 : -1; r2 = i >= 2 ? r - 2 : -1; }
    const float* cw = FIN(F, I_CONVW) + l * 3 * 512 + 8 * lane;
    const int r1c = r1 >= 0 ? r1 : r, r2c = r2 >= 0 ? r2 : r;
    const v4u wc0 = *(const GAS v4u*)(P + (size_t)r * NNG + C_BC + 8 * lane), wu0 = *(const GAS v4u*)(P + (size_t)r * NNG + C_BU + 8 * lane), wb = *(const GAS v4u*)(P + (size_t)r * NNG + C_BB + 8 * lane);
    const v4u wc1 = *(const GAS v4u*)(P + (size_t)r1c * NNG + C_BC + 8 * lane), wu1 = *(const GAS v4u*)(P + (size_t)r1c * NNG + C_BU + 8 * lane);
    const v4u wc2 = *(const GAS v4u*)(P + (size_t)r2c * NNG + C_BC + 8 * lane), wu2 = *(const GAS v4u*)(P + (size_t)r2c * NNG + C_BU + 8 * lane);
    __builtin_amdgcn_sched_barrier(0);
    float c0[8], u0[8], bb[8], y[8]; unpack8(wc0, c0); unpack8(wu0, u0); unpack8(wb, bb);
#pragma unroll
    for (int i = 0; i < 8; ++i) y[i] = cw[i] * (c0[i] * u0[i]);
    const float m1 = r1 >= 0 ? 1.f : 0.f, m2 = r2 >= 0 ? 1.f : 0.f;
    unpack8(wc1, c0); unpack8(wu1, u0);
#pragma unroll
    for (int i = 0; i < 8; ++i) y[i] += m1 * cw[512 + i] * (c0[i] * u0[i]);
    unpack8(wc2, c0); unpack8(wu2, u0);
#pragma unroll
    for (int i = 0; i < 8; ++i) y[i] += m2 * cw[1024 + i] * (c0[i] * u0[i]);
#pragma unroll
    for (int i = 0; i < 8; ++i) y[i] *= bb[i];
    *(GAS v4u*)((bf16*)(F.ws + WS_BR) + (size_t)MPAD * 512 + (size_t)r * 512 + 8 * lane) = pack8(y);
}
constexpr int CW_TMO = 0, CW_BAR = 4096, CW_Q = 16384;
__device__ __forceinline__ int queue_pop(Frame& F, int qi) {
    int t = 0; if (F.lane == 0) t = (int)__hip_atomic_fetch_add((unsigned*)(F.ctl + CW_Q + 64 * qi), 1u, RLX_AGENT);
    return __builtin_amdgcn_readfirstlane(t);
}
__device__ __forceinline__ int queue_pop_wg(Frame& F, int qi) {
    LAS int* slot = (LAS int*)(F.lds + 139264);
    __syncthreads();
    if (F.tid == 0) *slot = (int)__hip_atomic_fetch_add((unsigned*)(F.ctl + CW_Q + 64 * qi), 1u, RLX_AGENT);
    LDS_WAIT(); __syncthreads();
    return __builtin_amdgcn_readfirstlane(*slot);
}
__device__ __forceinline__ void phase_hgrn_prep(Frame& F, int l) {
    for (int t = F.bid; t < NB * 4 * 64 + 4; t += F.G) { if (t < 4) hgrn_prep_task(F, l, 0, t, 0); else { const int u = t - 4; hgrn_prep_task(F, l, u >> 8, (u >> 6) & 3, 1 + (u & 63)); } }
}
__device__ __forceinline__ void phase_prep(Frame& F, int l) { const int gw = F.bid * NWAVES + F.wave, NGW = F.G * NWAVES; for (int r = gw; r < MREAL + NMETA; r += NGW) prep_row(F, l, r); }
__device__ __forceinline__ void phase_vt(Frame& F) { const int gw = F.bid * NWAVES + F.wave, NGW = F.G * NWAVES; for (int t = gw; t < VT_NTASK; t += NGW) vt_task(F, t); }
__device__ __forceinline__ void phase_mix1(Frame& F, int l, int qidx) {
    LAS float* bt = (LAS float*)(F.lds + 135168);
    build_bias_table(F, bt, 0);
    __syncthreads();
#ifndef MIX1_SKIP
#define MIX1_SKIP 0
#endif
    const int sk = (qidx >= 4) ? MIX1_SKIP : 0;
    if (F.bid < NIDX_WG) {
        float* slab = (float*)(F.ws + WS_SCR) + (size_t)F.bid * 32 * LPAD;
        if (!(sk & 1)) for (int t = F.bid; t < NB * NQT; t += NIDX_WG) { const int j = NQT - 1 - t / NB, b = t % NB; dsa_index_task(F, b, j, slab); }
    } else if (F.bid < NIDX_WG + NHG_WG) {
        const int u = F.bid - NIDX_WG; if (!(sk & 2)) hgrn_scan_unit(F, l, u >> 2, u & 3);
    } else {
        const int u0 = F.bid - NIDX_WG - NHG_WG, nw = F.G - NIDX_WG - NHG_WG;
        const int cw = u0 * NWAVES + F.wave, ncw = nw * NWAVES; if (!(sk & 4)) for (int r = cw; r < MREAL + NMETA; r += ncw) conv_row(F, l, r);
    }
    float lam, post;
    { const float* lp = FIN(F, I_DLAM) + l * 256; const float s1 = wave_sum(lp[F.lane] * lp[64 + F.lane]), s2 = wave_sum(lp[128 + F.lane] * lp[192 + F.lane]);
      const float li = 0.8f - 0.6f * __expf(-0.3f * (float)l); lam = __expf(s1) - __expf(s2) + li; post = 1.0f - li; }
    for (;;) { const int t = queue_pop_wg(F, qidx) + ((sk & 8) ? (1 << 20) : 0); if (t >= NB * 4 * NQB) break;
        const int J = NQB - 1 - t / 32, bh = t % 32; attn_wg_task<false>(F, l, bh >> 2, bh & 3, J, bt, lam, post); }
}
__device__ __forceinline__ void phase_mix2(Frame& F, int l, int qidx) {
    LAS float* bt = (LAS float*)(F.lds + 135168);
    build_bias_table(F, bt, 4);
    __syncthreads();
    for (;;) { const int t = queue_pop_wg(F, qidx); if (t >= NB * 4 * NQB) break;
        const int J = NQB - 1 - t / 32, bh = t % 32; attn_wg_task<true>(F, l, bh >> 2, bh & 3, J, bt, 0.f, 1.f); }
}

#ifndef MK_ONE
#define MK_ONE 0
#endif
#ifndef BR_MASK
#define BR_MASK 15
#endif
constexpr int NPH = 18;
template <class T> __device__ __forceinline__ T opaque(T v) { asm volatile("" : "+s"(v)); return v; }
struct Args { const float* in[22]; float* out; unsigned char* ws; int ph_lo, ph_hi; };
__global__ void __launch_bounds__(NWAVES * 64, 2) fwd(Args args) {
    extern __shared__ __attribute__((aligned(16))) unsigned char lds[];
    Frame F;
    F.lds = (LAS unsigned char*)lds; F.MISC = (volatile LAS unsigned*)(F.lds + MISC_OFF);
    F.tid = threadIdx.x; F.lane = F.tid & 63; F.wave = __builtin_amdgcn_readfirstlane(F.tid >> 6); F.G = gridDim.x; F.bid = blockIdx.x;
    F.ws = args.ws; F.out = args.out; F.ctl = (gu32*)(args.ws + WS_CTL);
    F.karg = (const unsigned char __attribute__((address_space(4)))*)__builtin_amdgcn_kernarg_segment_ptr();
    for (int u = F.tid; u < (LDS_BYTES - LDSCTL_OFF) / 4; u += NWAVES * 64) ((LAS unsigned*)(F.lds + LDSCTL_OFF))[u] = 0u;
    __syncthreads();
#if MK_ONE
    XcdBarrier bar = xcd_barrier_post((unsigned*)(F.ctl + CW_BAR), F.MISC + 8, __builtin_amdgcn_readfirstlane(threadIdx.x >> 6));
#ifdef PROBE_BAR2
#define GRID_BAR() do { xcd_barrier(bar); xcd_barrier(bar); } while (0)
#else
#define GRID_BAR() xcd_barrier(bar)
#endif
#else
#define GRID_BAR() do { } while (0)
#endif
    const int wave_s = __builtin_amdgcn_readfirstlane(threadIdx.x >> 6);
    const int lo = args.ph_lo, hi = args.ph_hi;
#define IN(k) (lo <= (k) && (k) < hi)
#define RETID() do { int w_ = wave_s; asm volatile("" : "+s"(w_)); unsigned mk_ = ~0u; asm volatile("" : "+s"(mk_)); int t_ = w_ * 64 + (int)__builtin_amdgcn_mbcnt_hi(mk_, __builtin_amdgcn_mbcnt_lo(mk_, 0u)); asm volatile("" : "+v"(t_)); F.tid = t_; F.lane = t_ & 63; F.wave = w_; } while (0)
#ifdef DBG_TS
#define STAMP(k) do { if (blockIdx.x == 0 && threadIdx.x == 0) ((unsigned long long*)(args.ws + 768 * 1024))[(k)] = __builtin_amdgcn_s_memrealtime(); } while (0)
#else
#define STAMP(k) do { } while (0)
#endif
#define SEAM(k) do { if (IN((k) + 1)) GRID_BAR(); STAMP((k) + 1); } while (0)
#ifndef PROBE_EPI
#define PROBE_EPI 0
#endif
#ifdef PROBE_MASK
#define NREP(kk) opaque(((PROBE_MASK >> (kk)) & 1) ? 1 + PROBE_EXTRA : 1)
#define REP_BEGIN(kk) { const int nrep_ = NREP(kk); for (int rep = 0; rep < nrep_; ++rep) { if (rep) GRID_BAR();
#define REP_END } }
#else
#define REP_BEGIN(kk) { { const int rep = 0; (void)rep;
#define REP_END } }
#endif
    STAMP(0);
    unsigned char* wb = F.ws + WS_W;
    bf16* XN = (bf16*)(F.ws + WS_XN); bf16* BR = (bf16*)(F.ws + WS_BR); bf16* BIG = (bf16*)(F.ws + WS_BIG); float* HM = (float*)(F.ws + WS_HM);
    auto layer = [&](const int l) __attribute__((always_inline)) {
        const int pb = l * NPH;
        const float* hsrc = (l == 0) ? FIN(F, I_X) : F.out;
        if (IN(pb + 0)) { REP_BEGIN(0) RETID(); phase_convert(F, l); REP_END SEAM(pb + 0); }
        if (IN(pb + 1)) { REP_BEGIN(1) RETID(); phase_norm(F, hsrc, FIN(F, I_F1N) + l * DM); REP_END SEAM(pb + 1); }
        if (IN(pb + 2)) { REP_BEGIN(2) RETID(); meta_gemm(F, 0, XN + (size_t)MREAL * DM, DM, (const bf16*)(wb + W_GU1), NGU, DM, BIG, DFF, 0.f); pg8::Gemm g{opaque((const bf16*)(XN)), opaque((const bf16*)(wb + W_GU1)), MREAL, NGU, DM}; pg8::StaticOrder S; S.init(MREAL, NGU, F.G, opaque(F.bid));
            pg8::EpiSwiGLU E{BIG, DFF, rep ? PROBE_EPI : 0}; pg8::gemm_phase<pg8::EpiSwiGLU, pg8::StaticOrder, true, true>(F.lds + RING_OFF, g, S, E, F.tid); REP_END SEAM(pb + 2); }
        if (IN(pb + 3)) { REP_BEGIN(3) RETID(); meta_gemm(F, 1, BIG + (size_t)MREAL * DFF, DFF, (const bf16*)(wb + W_D1), DM, DFF, nullptr, 0, rep ? 0.f : 0.5f); pg8::Gemm g{opaque((const bf16*)(BIG)), opaque((const bf16*)(wb + W_D1)), MREAL, DM, DFF}; pg8::StaticOrder S; S.init(MREAL, DM, F.G, opaque(F.bid));
            pg8::EpiResF32 E{rep ? F.out : hsrc, F.out, HM, DM, MT_REAL, rep ? 0.f : 0.5f}; pg8::gemm_phase<pg8::EpiResF32, pg8::StaticOrder, true, true>(F.lds + RING_OFF, g, S, E, F.tid); REP_END SEAM(pb + 3); }
        if (IN(pb + 4)) { REP_BEGIN(4) RETID(); phase_norm(F, F.out, FIN(F, I_MIXN) + l * DM); REP_END SEAM(pb + 4); }
        if (IN(pb + 5)) { REP_BEGIN(5) RETID(); meta_gemm(F, 2, XN + (size_t)MREAL * DM, DM, (const bf16*)(wb + W_NG), NNG, DM, BIG, NNG, 0.f); pg8::Gemm g{opaque((const bf16*)(XN)), opaque((const bf16*)(wb + W_NG)), MREAL, NNG, DM}; pg8::StaticOrder S; S.init(MREAL, NNG, F.G, opaque(F.bid));
            pg8::EpiBf16<0> E{BIG, NNG}; pg8::gemm_phase<pg8::EpiBf16<0>, pg8::StaticOrder, true, true>(F.lds + RING_OFF, g, S, E, F.tid); REP_END SEAM(pb + 5); }
        if (IN(pb + 6)) { RETID(); phase_prep(F, l); phase_vt(F); __syncthreads(); phase_hgrn_prep(F, l); SEAM(pb + 6); }
#ifdef DUP_MIX
        if (IN(pb + 7)) { const int nrep = opaque(DUP_MIX1); for (int rep = 0; rep < nrep; ++rep) { RETID(); phase_mix1(F, l, 4 * rep + 2 * l); GRID_BAR(); } }
        if (IN(pb + 8)) { const int nrep = opaque(DUP_MIX2); for (int rep = 0; rep < nrep; ++rep) { RETID(); phase_mix2(F, l, 4 * rep + 2 * l + 1); GRID_BAR(); } }
#else
        if (IN(pb + 7)) { RETID(); phase_mix1(F, l, 2 * l); SEAM(pb + 7); }
        if (IN(pb + 8)) { RETID(); phase_mix2(F, l, 2 * l + 1); SEAM(pb + 8); }
#endif
        if (IN(pb + 9)) { REP_BEGIN(9) RETID(); meta_gemm(F, 3, XN + (size_t)MREAL * DM, DM, (const bf16*)(wb + W_G), NGATE, DM, BIG, NGATE, 0.f); pg8::Gemm g{opaque((const bf16*)(XN)), opaque((const bf16*)(wb + W_G)), MREAL, NGATE, DM}; pg8::StaticOrder S; S.init(MREAL, NGATE, F.G, opaque(F.bid));
            pg8::EpiBf16<1> E{BIG, NGATE}; pg8::gemm_phase<pg8::EpiBf16<1>, pg8::StaticOrder, true, true>(F.lds + RING_OFF, g, S, E, F.tid); REP_END SEAM(pb + 9); }
        if (IN(pb + 10)) { REP_BEGIN(10) RETID(); meta_gemm(F, 4, BR + (size_t)MREAL * 512, 512, (const bf16*)(wb + W_BR), DM, 512, XN, DM, 0.f);
            pg8::Gemm g{opaque((const bf16*)(BR)), opaque((const bf16*)(wb + W_BR)), MREAL, DM, 512}; pg8::MergeOrder S; S.init(MREAL, DM, F.G, opaque(F.bid), MPAD / 256);
            pg8::EpiGateAccM E{XN, DM, BIG, NGATE, MPAD / 256, DM / 256}; pg8::gemm_phase<pg8::EpiGateAccM, pg8::MergeOrder, true, true>(F.lds + RING_OFF, g, S, E, F.tid); REP_END SEAM(pb + 10); }
        if (IN(pb + 14) && BR_MASK) { REP_BEGIN(14) RETID(); meta_gemm(F, 1, XN + (size_t)MREAL * DM, DM, (const bf16*)(wb + W_O), DM, DM, nullptr, 0, rep ? 0.f : 1.0f); pg8::Gemm g{opaque((const bf16*)(XN)), opaque((const bf16*)(wb + W_O)), MREAL, DM, DM}; pg8::StaticOrder S; S.init(MREAL, DM, F.G, opaque(F.bid));
            pg8::EpiResF32 E{F.out, F.out, HM, DM, MT_REAL, rep ? 0.f : 1.0f}; pg8::gemm_phase<pg8::EpiResF32, pg8::StaticOrder, true, true>(F.lds + RING_OFF, g, S, E, F.tid); REP_END SEAM(pb + 14); }
        if (IN(pb + 15)) { REP_BEGIN(15) RETID(); phase_norm(F, F.out, FIN(F, I_F2N) + l * DM); REP_END SEAM(pb + 15); }
        if (IN(pb + 16)) { REP_BEGIN(16) RETID(); meta_gemm(F, 0, XN + (size_t)MREAL * DM, DM, (const bf16*)(wb + W_GU2), NGU, DM, BIG, DFF, 0.f); pg8::Gemm g{opaque((const bf16*)(XN)), opaque((const bf16*)(wb + W_GU2)), MREAL, NGU, DM}; pg8::StaticOrder S; S.init(MREAL, NGU, F.G, opaque(F.bid));
            pg8::EpiSwiGLU E{BIG, DFF, rep ? PROBE_EPI : 0}; pg8::gemm_phase<pg8::EpiSwiGLU, pg8::StaticOrder, true, true>(F.lds + RING_OFF, g, S, E, F.tid); REP_END SEAM(pb + 16); }
        if (IN(pb + 17)) { REP_BEGIN(17) RETID(); meta_gemm(F, 1, BIG + (size_t)MREAL * DFF, DFF, (const bf16*)(wb + W_D2), DM, DFF, nullptr, 0, rep ? 0.f : 0.5f); pg8::Gemm g{opaque((const bf16*)(BIG)), opaque((const bf16*)(wb + W_D2)), MREAL, DM, DFF}; pg8::StaticOrder S; S.init(MREAL, DM, F.G, opaque(F.bid));
            pg8::EpiResF32 E{F.out, F.out, HM, DM, MT_REAL, rep ? 0.f : 0.5f}; pg8::gemm_phase<pg8::EpiResF32, pg8::StaticOrder, true, true>(F.lds + RING_OFF, g, S, E, F.tid); REP_END SEAM(pb + 17); }
    };
    layer(0); layer(1);
}

extern "C" void kernel_launch(void* const* d_in, const int* in_sizes, int n_in, void* d_out, int out_size, void* d_ws, size_t ws_size, hipStream_t stream) {
    static int grid = 0;
    if (grid == 0) {
        if (n_in != 22 || out_size != MREAL * DM || ws_size < WS_END) { fprintf(stderr, "kernel_launch: unexpected shapes (n_in %d out %d ws %zu need %zu)\n", n_in, out_size, ws_size, (size_t)WS_END); grid = -1; return; }
        int dev = 0, cus = 0, per_cu = 0;
        if (hipGetDevice(&dev) != hipSuccess || hipDeviceGetAttribute(&cus, hipDeviceAttributeMultiprocessorCount, dev) != hipSuccess) { grid = -1; return; }
        if (hipFuncSetAttribute((const void*)fwd, hipFuncAttributeMaxDynamicSharedMemorySize, LDS_BYTES) != hipSuccess) { fprintf(stderr, "kernel_launch: hipFuncSetAttribute failed\n"); grid = -1; return; }
        if (hipOccupancyMaxActiveBlocksPerMultiprocessor(&per_cu, (const void*)fwd, NWAVES * 64, LDS_BYTES) != hipSuccess || per_cu < 1) fprintf(stderr, "kernel_launch: occupancy query says %d\n", per_cu);
        (void)hipGetLastError();
        grid = cus < 256 ? cus : 256;
    }
    if (grid < 0) return;
    (void)hipMemsetAsync((char*)d_ws + WS_CTL, 0, CTL_ZERO_BYTES, stream);
    Args a{};
    for (int i = 0; i < 22; ++i) a.in[i] = (const float*)d_in[i];
    a.out = (float*)d_out; a.ws = (unsigned char*)d_ws;
#ifndef PH_END
#define PH_END (2 * NPH)
#endif
#if MK_ONE
    a.ph_lo = 0; a.ph_hi = PH_END;
    hipLaunchKernelGGL(fwd, dim3(grid), dim3(NWAVES * 64), LDS_BYTES, stream, a);
#else
    for (int p = 0; p < PH_END; ++p) { a.ph_lo = p; a.ph_hi = p + 1;
        hipLaunchKernelGGL(fwd, dim3(grid), dim3(NWAVES * 64), LDS_BYTES, stream, a); }
#endif
}
```

```cpp
#include <hip/hip_runtime.h>
#include <cstdio>
#include <cstdint>
#define MK_ONE 1
namespace pg8 {
#define PG8_LAS __attribute__((address_space(3)))
typedef unsigned short bf16_t;
typedef short bf16x8 __attribute__((ext_vector_type(8)));
typedef float f32x4 __attribute__((ext_vector_type(4)));
typedef unsigned u32x4 __attribute__((ext_vector_type(4)));
constexpr int BM = 256, BK = 64, HALF = 128, HTB = HALF * BK * 2  , STAGE_BYTES = 8 * HTB, NXCD = 8, WGM = 8;

__host__ __device__ __forceinline__ int lds_byte(int r, int c) { const int st = (r >> 4) * 2 + (c >> 5), rr = r & 15, cc = c & 31, ob = rr * 64 + cc * 2; return st * 1024 + (ob ^ (((ob >> 9) & 1) << 5)); }
__host__ __device__ __forceinline__ void stage_rc(int b, int& R, int& C) { const int st = b / 1024, sb = b % 1024, swz = sb ^ (((sb >> 9) & 1) << 5); R = (st >> 1) * 16 + swz / 64; C = (st & 1) * 32 + (swz % 64) / 2; }
__host__ __device__ __forceinline__ int perm32(int rho) { const int n = rho >> 4, i = rho & 15; return 8 * (i >> 2) + 4 * n + (i & 3); }

struct Unit { int pm, pn; };
struct Gemm { const bf16_t* A; const bf16_t* Bt; int M, N, K; };

struct StaticOrder {
    int nM, nN, nwg, G, c;
    __host__ __device__ void init(int M, int N, int G_, int c_) { nM = M / BM; nN = N / BM; nwg = nM * nN; G = G_; c = c_; }
    __host__ __device__ bool next(int i, Unit& u) const {
        const long L = (long)i * G + c; if (L >= nwg) return false;
        int wgid = (int)L; { const int q = nwg / NXCD, r = nwg % NXCD, xcd = wgid % NXCD, off = wgid / NXCD; wgid = (xcd < r ? xcd * (q + 1) : r * (q + 1) + (xcd - r) * q) + off; }
        const int nig = WGM * nN, gid = wgid / nig, fm = gid * WGM, gsz = (nM - fm) < WGM ? (nM - fm) : WGM;
        u.pm = fm + ((wgid % nig) % gsz); u.pn = (wgid % nig) / gsz; return true;
    }
    __device__ __forceinline__ void a_ready(const Unit&) const {}
    __device__ __forceinline__ void done(const Unit&) const {}
};
typedef __bf16 bf16x2_hw __attribute__((ext_vector_type(2))); typedef float f32x2_hw __attribute__((ext_vector_type(2)));
__device__ __forceinline__ unsigned cvt_pk_bf16(float lo, float hi) { const f32x2_hw v = {lo, hi}; return __builtin_bit_cast(unsigned, __builtin_convertvector(v, bf16x2_hw)); }
typedef float f32x2 __attribute__((ext_vector_type(2)));
__device__ __forceinline__ float fast_sigmoid(float x) { return __builtin_amdgcn_rcpf(1.0f + __expf(-x)); }
__device__ __forceinline__ float fast_silu(float x) { return x * fast_sigmoid(x); }
template <int ACT  > struct EpiBf16 {
    static constexpr bool PERM = true, AFTER_DRAIN = false;
    bf16_t* O; int ldc;
    __device__ __forceinline__ void operator()(const f32x4 (&acc)[2][2][4][2], const Unit& u, int wr, int wc, int fr, int fq) const {
        const int row0 = u.pm * BM + wr * 64 + fr; const int col0 = u.pn * BM + wc * 32 + 8 * fq;
#pragma unroll
        for (int ai = 0; ai < 2; ++ai)
#pragma unroll
            for (int m = 0; m < 4; ++m) { bf16_t* rowp = O + (size_t)(row0 + ai * HALF + m * 16) * ldc + col0;
#pragma unroll
                for (int bj = 0; bj < 2; ++bj) { f32x4 v0 = acc[ai][bj][m][0], v1 = acc[ai][bj][m][1];
                    if (ACT == 1) {
#pragma unroll
                        for (int j = 0; j < 4; ++j) { v0[j] = fast_sigmoid(v0[j]); v1[j] = fast_sigmoid(v1[j]); } }
                    u32x4 w; w.x = cvt_pk_bf16(v0[0], v0[1]); w.y = cvt_pk_bf16(v0[2], v0[3]); w.z = cvt_pk_bf16(v1[0], v1[1]); w.w = cvt_pk_bf16(v1[2], v1[3]);
                    *(u32x4*)(rowp + bj * HALF) = w; } }
    }
};
struct EpiSwiGLU {
    static constexpr bool PERM = true, AFTER_DRAIN = false;
    bf16_t* O; int ldc; int mode;
    __device__ __forceinline__ void operator()(const f32x4 (&acc)[2][2][4][2], const Unit& u, int wr, int wc, int fr, int fq) const {
        if (mode == 2) return;
        const int row0 = u.pm * BM + wr * 64 + fr; const int col0 = u.pn * HALF + wc * 32 + 8 * fq;
#pragma unroll
        for (int ai = 0; ai < 2; ++ai)
#pragma unroll
            for (int m = 0; m < 4; ++m) { bf16_t* rowp = O + (size_t)(row0 + ai * HALF + m * 16) * ldc + col0;
                const f32x4 g0 = acc[ai][0][m][0], g1 = acc[ai][0][m][1], u0 = acc[ai][1][m][0], u1 = acc[ai][1][m][1];
                f32x4 v0, v1;
#pragma unroll
                for (int j = 0; j < 4; ++j) { v0[j] = fast_silu(g0[j]) * u0[j]; v1[j] = fast_silu(g1[j]) * u1[j]; }
                u32x4 w; w.x = cvt_pk_bf16(v0[0], v0[1]); w.y = cvt_pk_bf16(v0[2], v0[3]); w.z = cvt_pk_bf16(v1[0], v1[1]); w.w = cvt_pk_bf16(v1[2], v1[3]);
                if (mode == 0) *(u32x4*)rowp = w; else asm volatile("" :: "v"(w.x), "v"(w.y), "v"(w.z), "v"(w.w));
                asm volatile("" ::: "memory"); }
    }
};
struct EpiResF32 {
    static constexpr bool PERM = false, AFTER_DRAIN = false;
    const float* base_r; float* out_r; float* hm; int ldc; int mt_real; float scale;
    __device__ __forceinline__ void operator()(const f32x4 (&acc)[2][2][4][2], const Unit& u, int wr, int wc, int fr, int fq) const {
        const bool real = u.pm < mt_real;
        const float* bp = real ? base_r + (size_t)u.pm * BM * ldc : hm; float* op = real ? out_r + (size_t)u.pm * BM * ldc : hm;
        const int row0 = wr * 64 + fr, col0 = u.pn * BM + wc * 32 + 4 * fq;
#pragma unroll
        for (int ai = 0; ai < 2; ++ai) {
            f32x4 b[4][2][2];
#pragma unroll
            for (int m = 0; m < 4; ++m) { const size_t off = (size_t)(row0 + ai * HALF + m * 16) * ldc + col0;
#pragma unroll
                for (int bj = 0; bj < 2; ++bj)
#pragma unroll
                    for (int n = 0; n < 2; ++n) b[m][bj][n] = *(const f32x4*)(bp + off + bj * HALF + n * 16); }
            asm volatile("" ::: "memory");
#pragma unroll
            for (int m = 0; m < 4; ++m) { const size_t off = (size_t)(row0 + ai * HALF + m * 16) * ldc + col0;
#pragma unroll
                for (int bj = 0; bj < 2; ++bj)
#pragma unroll
                    for (int n = 0; n < 2; ++n) *(f32x4*)(op + off + bj * HALF + n * 16) = b[m][bj][n] + acc[ai][bj][m][n] * scale; }
            asm volatile("" ::: "memory"); }
    }
};
struct EpiGateAcc {
    static constexpr bool PERM = true, AFTER_DRAIN = false;
    bf16_t* MG; int ldc; const bf16_t* G; int ldg; int gcol0; int first;
    __device__ __forceinline__ void operator()(const f32x4 (&acc)[2][2][4][2], const Unit& u, int wr, int wc, int fr, int fq) const {
        const int row0 = u.pm * BM + wr * 64 + fr; const int col0 = u.pn * BM + wc * 32 + 8 * fq;
#pragma unroll
        for (int ai = 0; ai < 2; ++ai)
#pragma unroll
            for (int m = 0; m < 4; ++m) { const size_t r = (size_t)(row0 + ai * HALF + m * 16);
#pragma unroll
                for (int bj = 0; bj < 2; ++bj) { const u32x4 gw = *(const u32x4*)(G + r * ldg + gcol0 + col0 + bj * HALF);
                    u32x4 pw = (u32x4){0u, 0u, 0u, 0u}; if (!first) pw = *(const u32x4*)(MG + r * ldc + col0 + bj * HALF);
                    float o[8];
#pragma unroll
                    for (int j = 0; j < 4; ++j) { const float a0 = (j < 2) ? acc[ai][bj][m][0][2 * j] : acc[ai][bj][m][1][2 * (j - 2)], a1 = (j < 2) ? acc[ai][bj][m][0][2 * j + 1] : acc[ai][bj][m][1][2 * (j - 2) + 1];
                        o[2 * j] = __uint_as_float(pw[j] << 16) + __uint_as_float(gw[j] << 16) * a0; o[2 * j + 1] = __uint_as_float(pw[j] & 0xffff0000u) + __uint_as_float(gw[j] & 0xffff0000u) * a1; }
                    u32x4 w; w.x = cvt_pk_bf16(o[0], o[1]); w.y = cvt_pk_bf16(o[2], o[3]); w.z = cvt_pk_bf16(o[4], o[5]); w.w = cvt_pk_bf16(o[6], o[7]);
                    *(u32x4*)(MG + r * ldc + col0 + bj * HALF) = w; } }
    }
};

struct MergeOrder {
    int nM, nN, G, c, mt_alloc;
    __host__ __device__ void init(int M, int N, int G_, int c_, int mt_alloc_) { nM = M / BM; nN = N / BM; G = G_; c = c_; mt_alloc = mt_alloc_; }
    __host__ __device__ bool next(int i, Unit& u) const { const int t = (i >> 2) * G + c, m = i & 3; if (t >= nM * nN) return false;
        const int pm = t / nN, pn = t % nN; u.pm = m * mt_alloc + pm; u.pn = m * nN + pn; return true; }
    __device__ __forceinline__ void a_ready(const Unit&) const {}
    __device__ __forceinline__ void done(const Unit&) const {}
};
struct EpiGateAccM {
    static constexpr bool PERM = true, AFTER_DRAIN = false;
    bf16_t* MG; int ldc; const bf16_t* G; int ldg; int mt_alloc; int ntn;
    __device__ __forceinline__ void operator()(const f32x4 (&acc)[2][2][4][2], const Unit& u, int wr, int wc, int fr, int fq) const {
        const int m = u.pm / mt_alloc, pm = u.pm - m * mt_alloc, pn = u.pn - m * ntn;
        const int row0 = pm * BM + wr * 64 + fr; const int col0 = pn * BM + wc * 32 + 8 * fq; const int gcol0 = m * ntn * BM;
#pragma unroll
        for (int ai = 0; ai < 2; ++ai)
#pragma unroll
            for (int mm = 0; mm < 4; ++mm) { const size_t r = (size_t)(row0 + ai * HALF + mm * 16);
#pragma unroll
                for (int bj = 0; bj < 2; ++bj) { const u32x4 gw = *(const u32x4*)(G + r * ldg + gcol0 + col0 + bj * HALF);
                    u32x4 pw = (u32x4){0u, 0u, 0u, 0u}; if (m != 0) pw = *(const u32x4*)(MG + r * ldc + col0 + bj * HALF);
                    float o[8];
#pragma unroll
                    for (int j = 0; j < 4; ++j) { const float a0 = (j < 2) ? acc[ai][bj][mm][0][2 * j] : acc[ai][bj][mm][1][2 * (j - 2)], a1 = (j < 2) ? acc[ai][bj][mm][0][2 * j + 1] : acc[ai][bj][mm][1][2 * (j - 2) + 1];
                        o[2 * j] = __uint_as_float(pw[j] << 16) + __uint_as_float(gw[j] << 16) * a0; o[2 * j + 1] = __uint_as_float(pw[j] & 0xffff0000u) + __uint_as_float(gw[j] & 0xffff0000u) * a1; }
                    u32x4 w; w.x = cvt_pk_bf16(o[0], o[1]); w.y = cvt_pk_bf16(o[2], o[3]); w.z = cvt_pk_bf16(o[4], o[5]); w.w = cvt_pk_bf16(o[6], o[7]);
                    *(u32x4*)(MG + r * ldc + col0 + bj * HALF) = w; } }
    }
};
template <class Epi, class Sched, bool ALIGN_EPI = false, bool SP2 = false>
__device__ __forceinline__ void gemm_phase(PG8_LAS unsigned char* lds, const Gemm g, const Sched& S, const Epi& E, int tid_in) {
    int tid_ = tid_in; asm volatile("" : "+v"(tid_));
    const int tid = tid_, wid = __builtin_amdgcn_readfirstlane(tid >> 6), lane = tid & 63, wr = wid >> 2, wc = wid & 3, fr = lane & 15, fq = lane >> 4;
    const int K = g.K, nt = K / BK;
    unsigned voffA[2], voffB[2];
#pragma unroll
    for (int i = 0; i < 2; ++i) { int R, C; stage_rc(tid * 16 + i * 8192, R, C); const int Rb = Epi::PERM ? ((R & ~31) + perm32(R & 31)) : R;
        voffA[i] = (unsigned)(R * K + C) * 2u; voffB[i] = (unsigned)(Rb * K + C) * 2u; }
    const size_t kstep = (size_t)(BK * 2);
    const size_t hstep = (size_t)HALF * K * 2;
    const size_t tstep = 2 * hstep;
    const unsigned ldsw = (unsigned)wid * 1024u;
    const int aoff = lds_byte(wr * 64 + fr, fq * 8), boff = lds_byte(wc * 32 + fr, fq * 8);
#define PG8_SA(b, h) (((b) * 2 + (h)) * HTB)
#define PG8_SB(b, h) ((4 + (b) * 2 + (h)) * HTB)
#define PG8_STAGE(bufoff, gbase, voff) do { _Pragma("unroll") for (int _i = 0; _i < 2; ++_i) \
        __builtin_amdgcn_global_load_lds((const unsigned*)((const char*)(gbase) + (voff)[_i]), (PG8_LAS unsigned*)(lds + (bufoff) + ldsw + _i * 8192), 16, 0, 0); } while (0)
#define PG8_LDA(dst, b, h) do { _Pragma("unroll") for (int m = 0; m < 4; ++m) _Pragma("unroll") for (int k = 0; k < 2; ++k) dst[m][k] = *(const PG8_LAS bf16x8*)(lds + PG8_SA(b, h) + aoff + m * 2048 + k * 1024); } while (0)
#define PG8_LDB(dst, b, h) do { _Pragma("unroll") for (int n = 0; n < 2; ++n) _Pragma("unroll") for (int k = 0; k < 2; ++k) dst[n][k] = *(const PG8_LAS bf16x8*)(lds + PG8_SB(b, h) + boff + n * 2048 + k * 1024); } while (0)
#define PG8_MMA(ai, bj, At, Bt) do { __builtin_amdgcn_s_setprio(1); _Pragma("unroll") for (int m = 0; m < 4; ++m) _Pragma("unroll") for (int n = 0; n < 2; ++n) _Pragma("unroll") for (int k = 0; k < 2; ++k) \
        acc[ai][bj][m][n] = __builtin_amdgcn_mfma_f32_16x16x32_bf16(Bt[n][k], At[m][k], acc[ai][bj][m][n], 0, 0, 0); __builtin_amdgcn_s_setprio(0); } while (0)
#define PG8_WAIT_V(n) asm volatile("s_waitcnt vmcnt(" #n ")" ::: "memory")
#define PG8_WAIT_L(n) asm volatile("s_waitcnt lgkmcnt(" #n ")" ::: "memory")
#define PG8_BAR __builtin_amdgcn_s_barrier()
#define PG8_SCHED __builtin_amdgcn_sched_barrier(0)
    Unit cur, nxt; int ui = 0;
    if (!S.next(0, cur)) return;
    f32x4 acc[2][2][4][2];
#pragma unroll
    for (int a = 0; a < 2; ++a)
#pragma unroll
        for (int b = 0; b < 2; ++b)
#pragma unroll
            for (int m = 0; m < 4; ++m)
#pragma unroll
                for (int n = 0; n < 2; ++n) acc[a][b][m][n] = (f32x4){0.f, 0.f, 0.f, 0.f};
    bf16x8 At[4][2], B0[2][2], B1[2][2];
    const char* cA = (const char*)g.A + (size_t)cur.pm * tstep; const char* cB = (const char*)g.Bt + (size_t)cur.pn * tstep;
    S.a_ready(cur);
    if constexpr (SP2) {
        PG8_STAGE(PG8_SB(0, 0), cB, voffB); PG8_STAGE(PG8_SB(0, 1), cB + hstep, voffB); PG8_STAGE(PG8_SA(0, 0), cA, voffA); PG8_STAGE(PG8_SA(0, 1), cA + hstep, voffA);
        if (wr == 1) PG8_BAR;
        PG8_WAIT_V(2); PG8_BAR;
        PG8_STAGE(PG8_SB(1, 0), cB + kstep, voffB); PG8_STAGE(PG8_SA(1, 0), cA + kstep, voffA); PG8_STAGE(PG8_SB(1, 1), cB + hstep + kstep, voffB);
        PG8_WAIT_V(6); PG8_BAR;
    } else {
        PG8_STAGE(PG8_SB(0, 0), cB, voffB); PG8_STAGE(PG8_SA(0, 0), cA, voffA); PG8_STAGE(PG8_SB(0, 1), cB + hstep, voffB); PG8_STAGE(PG8_SA(0, 1), cA + hstep, voffA);
        if (wr == 1) PG8_BAR;
        PG8_WAIT_V(4); PG8_BAR;
        PG8_STAGE(PG8_SB(1, 0), cB + kstep, voffB); PG8_STAGE(PG8_SA(1, 0), cA + kstep, voffA); PG8_STAGE(PG8_SB(1, 1), cB + hstep + kstep, voffB);
        PG8_WAIT_V(6); PG8_BAR;
    }
    for (;;) {
        const bool has_next = S.next(ui + 1, nxt);
        const char* nA = has_next ? (const char*)g.A + (size_t)nxt.pm * tstep : cA; const char* nB = has_next ? (const char*)g.Bt + (size_t)nxt.pn * tstep : cB;
        for (int t = 0; t < nt; t += 2) {
            const bool last = (t == nt - 2);
            const char* a1 = cA + (size_t)(t + 1) * kstep;
            const char* a2 = last ? nA : cA + (size_t)(t + 2) * kstep; const char* b2 = last ? nB : cB + (size_t)(t + 2) * kstep;
            const char* a3 = a2 + kstep; const char* b3 = b2 + kstep;
            if (last && has_next) S.a_ready(nxt);
            if constexpr (SP2) {
            PG8_LDB(B0, 0, 0); PG8_LDB(B1, 0, 1); PG8_SCHED; PG8_LDA(At, 0, 0); PG8_STAGE(PG8_SA(1, 1), a1 + hstep, voffA);
            PG8_WAIT_V(8); PG8_WAIT_L(0); PG8_BAR; PG8_MMA(0, 0, At, B0); PG8_MMA(0, 1, At, B1); PG8_BAR; PG8_SCHED;
            PG8_LDA(At, 0, 1); PG8_STAGE(PG8_SB(0, 0), b2, voffB); PG8_STAGE(PG8_SB(0, 1), b2 + hstep, voffB); PG8_STAGE(PG8_SA(0, 0), a2, voffA);
            PG8_WAIT_V(8); PG8_WAIT_L(0); PG8_BAR; PG8_MMA(1, 0, At, B0); PG8_MMA(1, 1, At, B1); PG8_BAR; PG8_SCHED;
            PG8_LDB(B0, 1, 0); PG8_LDB(B1, 1, 1); PG8_SCHED; PG8_LDA(At, 1, 0); PG8_STAGE(PG8_SA(0, 1), a2 + hstep, voffA);
            PG8_WAIT_V(8); PG8_WAIT_L(0); PG8_BAR; PG8_MMA(0, 0, At, B0); PG8_MMA(0, 1, At, B1); PG8_BAR; PG8_SCHED;
            PG8_LDA(At, 1, 1); PG8_STAGE(PG8_SB(1, 0), b3, voffB); PG8_STAGE(PG8_SB(1, 1), b3 + hstep, voffB); PG8_STAGE(PG8_SA(1, 0), a3, voffA);
            PG8_WAIT_V(8); PG8_WAIT_L(0); PG8_BAR; PG8_MMA(1, 0, At, B0); PG8_MMA(1, 1, At, B1); PG8_BAR; PG8_SCHED;
            } else {
            PG8_LDB(B0, 0, 0); PG8_SCHED; PG8_LDA(At, 0, 0); PG8_STAGE(PG8_SA(1, 1), a1 + hstep, voffA);
            PG8_WAIT_L(8); PG8_BAR; PG8_WAIT_L(0); PG8_MMA(0, 0, At, B0); PG8_BAR; PG8_SCHED;
            PG8_LDB(B1, 0, 1); PG8_STAGE(PG8_SB(0, 0), b2, voffB);
            PG8_BAR; PG8_WAIT_L(0); PG8_MMA(0, 1, At, B1); PG8_BAR;
            PG8_LDA(At, 0, 1); PG8_STAGE(PG8_SA(0, 0), a2, voffA);
            PG8_BAR; PG8_WAIT_L(0); PG8_MMA(1, 0, At, B0); PG8_BAR; PG8_SCHED;
            PG8_STAGE(PG8_SB(0, 1), b2 + hstep, voffB);
            PG8_WAIT_V(6); PG8_BAR; PG8_MMA(1, 1, At, B1); PG8_BAR;
            PG8_LDB(B0, 1, 0); PG8_SCHED; PG8_LDA(At, 1, 0); PG8_STAGE(PG8_SA(0, 1), a2 + hstep, voffA);
            PG8_WAIT_L(8); PG8_BAR; PG8_WAIT_L(0); PG8_MMA(0, 0, At, B0); PG8_BAR; PG8_SCHED;
            PG8_LDB(B1, 1, 1); PG8_STAGE(PG8_SB(1, 0), b3, voffB);
            PG8_BAR; PG8_WAIT_L(0); PG8_MMA(0, 1, At, B1); PG8_BAR;
            PG8_LDA(At, 1, 1); PG8_STAGE(PG8_SA(1, 0), a3, voffA);
            PG8_BAR; PG8_WAIT_L(0); PG8_MMA(1, 0, At, B0); PG8_BAR; PG8_SCHED;
            PG8_STAGE(PG8_SB(1, 1), b3 + hstep, voffB);
            PG8_WAIT_V(6); PG8_BAR; PG8_MMA(1, 1, At, B1); PG8_BAR;
            }
        }
        if constexpr (ALIGN_EPI) { if (wr == 0) PG8_BAR; }
        if constexpr (!Epi::AFTER_DRAIN) { E(acc, cur, wr, wc, fr, fq); S.done(cur); }
        if (!has_next) break;
#pragma unroll
        for (int a = 0; a < 2; ++a)
#pragma unroll
            for (int b = 0; b < 2; ++b)
#pragma unroll
                for (int m = 0; m < 4; ++m)
#pragma unroll
                    for (int n = 0; n < 2; ++n) acc[a][b][m][n] = (f32x4){0.f, 0.f, 0.f, 0.f};
        cur = nxt; cA = nA; cB = nB; ++ui;
        if constexpr (ALIGN_EPI) { if (wr == 1) PG8_BAR; }
    }
    PG8_WAIT_V(0);
    if constexpr (!ALIGN_EPI) { if (wr == 0) PG8_BAR; }
    PG8_BAR;
    if constexpr (Epi::AFTER_DRAIN) { E.fused(acc, cur, wr, wc, fr, fq, lds, wid, lane); S.done(cur); }
#undef PG8_SA
#undef PG8_SB
#undef PG8_STAGE
#undef PG8_LDA
#undef PG8_LDB
#undef PG8_MMA
#undef PG8_WAIT_V
#undef PG8_WAIT_L
#undef PG8_BAR
#undef PG8_SCHED
}
}

constexpr int DM = 2048, NB = 8, SEQ = 4096, NMETA = 16, LSEQ = 4112, LPAD = 4128;
constexpr int MREAL = NB * SEQ;
constexpr int MPAD = MREAL + 256;
constexpr int MT_REAL = MREAL / 256;
constexpr int DFF = 5632, NGU = 2 * DFF, NNG = 7168, NGATE = 8192, INCOLS = 15184, NGC = 6992;
constexpr int NWAVES = 8;
constexpr float EPS = 1e-6f;
constexpr int C_AQ = 0, C_AF = 512, C_AI = 1024, C_AG = 1536, C_BB = 2048, C_BC = 2560, C_BU = 3072, C_CQ = 3584, C_CK = 4096, C_CV = 4608,
              C_DQ = 5120, C_DK = 5632, C_DV = 5760, C_DQI = 5888, C_DKI = 6912, C_DW = 6976;

constexpr size_t MiB = 1u << 20;
constexpr size_t WS_CTL = 0, CTL_ZERO_BYTES = 1 * MiB;
constexpr size_t WS_HM = 1 * MiB;
constexpr size_t WS_W = 4 * MiB;
constexpr size_t W_GU1 = 0, W_D1 = W_GU1 + (size_t)NGU * DM * 2, W_NG = W_D1 + (size_t)DM * DFF * 2, W_G = W_NG + (size_t)NNG * DM * 2,
                 W_BR = W_G + (size_t)NGATE * DM * 2, W_O = W_BR + (size_t)4 * DM * 512 * 2, W_GU2 = W_O + (size_t)DM * DM * 2, W_D2 = W_GU2 + (size_t)NGU * DM * 2,
                 W_END = W_D2 + (size_t)DM * DFF * 2;
constexpr size_t WS_XN = WS_W + W_END;
constexpr size_t WS_BR = WS_XN + (size_t)MPAD * DM * 2;
constexpr size_t WS_BIG = WS_BR + (size_t)MPAD * DM * 2;
constexpr size_t BIG_P_END = (size_t)MPAD * NNG * 2;
constexpr size_t WS_VTC = WS_BIG + BIG_P_END;
constexpr size_t WS_VTD = WS_VTC + (size_t)NB * 4 * 128 * LPAD * 2;
constexpr size_t WS_MASK = WS_VTD + (size_t)NB * 128 * LPAD * 2;
constexpr int MASKW = 132;
constexpr int NIDX_WG = 172;
constexpr int NHG_WG = 32;
constexpr size_t WS_SCR = WS_MASK + (size_t)NB * LPAD * MASKW * 4;
constexpr size_t WS_HA = WS_SCR + (size_t)NIDX_WG * 32 * LPAD * 4;
constexpr size_t WS_HDL = WS_HA + (size_t)NB * 4 * 64 * 64 * 64 * 2;
constexpr size_t WS_HMETA = WS_HDL + (size_t)NB * 4 * 64 * 128 * 4;
constexpr size_t HMETA_STRIDE = 64 * 384 * 2 + 64 * 64 * 2 + 128 * 4;
constexpr size_t WS_END = WS_HMETA + 4 * HMETA_STRIDE;
static_assert(WS_BIG + (size_t)MPAD * NGATE * 2 <= WS_END, "G fits");
static_assert(WS_END <= (size_t)1138174976, "workspace map fits the guaranteed size");

constexpr int RING_OFF = 0, RING_BYTES = 131072;
constexpr int LDSCTL_OFF = 143360, MISC_OFF = LDSCTL_OFF + 320;
constexpr int LDS_BYTES = 147456;

#define GAS __attribute__((address_space(1)))
#define LAS __attribute__((address_space(3)))
typedef unsigned short bf16;
typedef unsigned v4u __attribute__((ext_vector_type(4)));
typedef unsigned v2u __attribute__((ext_vector_type(2)));
typedef float f32x4 __attribute__((ext_vector_type(4)));
typedef float f32x16 __attribute__((ext_vector_type(16)));
typedef short bf16x8 __attribute__((ext_vector_type(8)));
typedef GAS unsigned gu32;
#define RLX_AGENT __ATOMIC_RELAXED, __HIP_MEMORY_SCOPE_AGENT
#define LDS_WAIT() asm volatile("s_waitcnt lgkmcnt(0)" ::: "memory")
#define VM_WAIT() asm volatile("s_waitcnt vmcnt(0)" ::: "memory")
__device__ __forceinline__ unsigned f2bf(float f) { unsigned u = __builtin_bit_cast(unsigned, f); return (u + 0x7fffu + ((u >> 16) & 1u)) >> 16; }
__device__ __forceinline__ unsigned f2bf_s(float f) { return pg8::cvt_pk_bf16(f, 0.f) & 0xffffu; }
__device__ __forceinline__ unsigned pk2(float lo, float hi) { return pg8::cvt_pk_bf16(lo, hi); }
__device__ __forceinline__ float bflo(unsigned w) { return __uint_as_float(w << 16); }
__device__ __forceinline__ float bfhi(unsigned w) { return __uint_as_float(w & 0xffff0000u); }
__device__ __forceinline__ float bf2f(bf16 v) { return __uint_as_float((unsigned)v << 16); }
__device__ __forceinline__ int seqrow(int b, int p) { return p < NMETA ? MREAL + p : b * SEQ + p - NMETA; }
__device__ __forceinline__ int rel_bucket(int n) {
    if (n < 16) return n; if (n >= 128) return 31;
    const int v = 16 + (int)(__log2f((float)n * 0.0625f) * 5.33333333f); return v < 31 ? v : 31; }
__device__ __forceinline__ float wave_sum(float v) {
#pragma unroll
    for (int o = 1; o < 64; o <<= 1) v += __shfl_xor(v, o);
    return v;
}
#define XB_TMO      128
#define XB_XCNT(j)  (256  + 64 * (j))
#define XB_XSUB(j)  (1280 + 64 * (j))
#define XB_XGEN(j)  (2304 + 64 * (j))
#define XB_TOP      3328
#define XB_TOPGEN   3392
#define XCD_BAR_WORDS 3456
#define XB_SPIN_CAP (1u << 18)

__device__ __forceinline__ unsigned xb_ld(unsigned* p)              { return __hip_atomic_load(p, __ATOMIC_RELAXED, __HIP_MEMORY_SCOPE_AGENT); }
__device__ __forceinline__ unsigned xb_add(unsigned* p, unsigned v) { return __hip_atomic_fetch_add(p, v, __ATOMIC_RELAXED, __HIP_MEMORY_SCOPE_AGENT); }
__device__ __forceinline__ unsigned xb_xcc_id() { return (unsigned)__builtin_amdgcn_s_getreg((3 << 11) | 20) & 0xFu; }
#define XB_SPIN(cond, bar) do { unsigned _sp = 0; while (cond) { __builtin_amdgcn_s_sleep(1); \
    if ((++_sp & 255u) == 0u) { if (xb_ld(&(bar)[XB_TMO])) break; if (_sp > XB_SPIN_CAP) { atomicAdd(&(bar)[XB_TMO], 1u); break; } } } } while (0)

struct XcdBarrier {
    int wave;
    unsigned* bar; unsigned x;
    volatile LAS unsigned* st;
};

__device__ __forceinline__ bool xb_thread0(int wave) { unsigned mk = ~0u; asm volatile("" : "+s"(mk)); return wave == 0 && __builtin_amdgcn_mbcnt_hi(mk, __builtin_amdgcn_mbcnt_lo(mk, 0u)) == 0u; }
__device__ __forceinline__ XcdBarrier xcd_barrier_post(unsigned* bar, volatile LAS unsigned* st, int wave) {
    XcdBarrier b; b.wave = wave; b.bar = bar; b.x = xb_xcc_id(); b.st = st;
    if (xb_thread0(wave)) (void)xb_add(&bar[XB_XCNT(b.x)], 1u);
    return b;
}
__device__ __forceinline__ void xcd_barrier_complete(unsigned* bar, unsigned x, unsigned& nloc, unsigned& nx) {
    const unsigned G = gridDim.x * gridDim.y * gridDim.z;
    unsigned sum, cnt, mine, sp = 0u;
    for (;;) {
        sum = 0u; cnt = 0u; mine = 0u;
#pragma unroll
        for (unsigned j = 0; j < 16; ++j) { const unsigned c = xb_ld(&bar[XB_XCNT(j)]); sum += c; cnt += (c > 0u) ? 1u : 0u; mine = (j == x) ? c : mine; }
        if (sum == G) break;
        __builtin_amdgcn_s_sleep(1);
        if ((++sp & 255u) == 0u) { if (xb_ld(&bar[XB_TMO])) break; if (sp > XB_SPIN_CAP) { atomicAdd(&bar[XB_TMO], 1u); break; } }
    }
    nloc = mine > 0u ? mine : 1u; nx = cnt > 0u ? cnt : 1u;
}

__device__ __forceinline__ void xcd_barrier(const XcdBarrier& b) {
    asm volatile("s_waitcnt vmcnt(0)" ::: "memory");
    __syncthreads();
    if (xb_thread0(b.wave)) {
        unsigned* bar = b.bar;
        __builtin_amdgcn_s_waitcnt(0);
        unsigned nloc = b.st[0], nx = b.st[1];
        if (nloc == 0u) { xcd_barrier_complete(bar, b.x, nloc, nx); b.st[0] = nloc; b.st[1] = nx; }
        const unsigned old = xb_add(&bar[XB_XSUB(b.x)], 1u);
        const unsigned gen = old / nloc;
        if (old + 1u == (gen + 1u) * nloc) {
            __builtin_amdgcn_fence(__ATOMIC_RELEASE, "agent");
            asm volatile("s_waitcnt vmcnt(0)" ::: "memory");
            const unsigned og = xb_add(&bar[XB_TOP], 1u);
            const unsigned tg = og / nx;
            if (og + 1u == (tg + 1u) * nx) xb_add(&bar[XB_TOPGEN], 1u);
            else XB_SPIN(xb_ld(&bar[XB_TOPGEN]) == tg, bar);
            __builtin_amdgcn_fence(__ATOMIC_ACQUIRE, "agent");
            xb_add(&bar[XB_XGEN(b.x)], 1u);
            asm volatile("s_waitcnt vmcnt(0)" ::: "memory");
        } else {
            XB_SPIN(xb_ld(&bar[XB_XGEN(b.x)]) == gen, bar);
            __builtin_amdgcn_fence(__ATOMIC_ACQUIRE, "agent");
            asm volatile("s_waitcnt vmcnt(0)" ::: "memory");
        }
    }
    __syncthreads();
}

struct Frame {
    LAS unsigned char* lds;
    volatile LAS unsigned* MISC;
    gu32* ctl;
    int tid, lane, wave, G, bid;
    const unsigned char __attribute__((address_space(4)))* karg; float* out; unsigned char* ws;
};
__device__ __forceinline__ const float* fin_load(const unsigned char __attribute__((address_space(4)))* k, int i) { asm volatile("" : "+s"(k)); return *(const float* const __attribute__((address_space(4)))*)(k + 8 * i); }
#define FIN(F_, i_) fin_load((F_).karg, (i_))
enum { I_X = 0, I_META, I_RELB, I_F1N, I_F1GU, I_F1D, I_MIXN, I_WIN, I_LB, I_GN, I_CONVW, I_DQN, I_DKN, I_DLAM, I_DSUB, I_SQN, I_SKN, I_WBR, I_WOUT, I_F2N, I_F2GU, I_F2D };

template <class RowMap>
__device__ __forceinline__ void transpose_item(const float* W, int K, int N, bf16* WT, LAS float* scr, int item, int lane, RowMap rm) {
    const int nblk = (N + 31) / 32, kb = item / nblk, nb = item % nblk, k0 = 64 * kb, n0 = 32 * nb;
    const int nl = n0 + (lane & 31); const bool nok = nl < N;
    { float wv[32]; const float* wp = W + (size_t)(k0 + (lane >> 5)) * N + (nok ? nl : 0);
#pragma unroll
      for (int i = 0; i < 32; ++i) wv[i] = wp[(size_t)(2 * i) * N];
      __builtin_amdgcn_sched_barrier(0);
#pragma unroll
      for (int i = 0; i < 32; ++i) scr[(2 * i + (lane >> 5)) * 33 + (lane & 31)] = nok ? wv[i] : 0.f; }
    LDS_WAIT(); asm volatile("" ::: "memory");
    const int c = lane & 7;
#pragma unroll
    for (int j = 0; j < 4; ++j) { const int n = (lane >> 3) + 8 * j; const LAS float* s = scr + (8 * c) * 33 + n;
        v4u o; o.x = pk2(s[0 * 33], s[1 * 33]); o.y = pk2(s[2 * 33], s[3 * 33]); o.z = pk2(s[4 * 33], s[5 * 33]); o.w = pk2(s[6 * 33], s[7 * 33]);
        if (n0 + n < N) *(GAS v4u*)(WT + (size_t)rm(n0 + n) * K + k0 + 8 * c) = o; }
    LDS_WAIT(); asm volatile("" ::: "memory");
}
struct MapId { __device__ __forceinline__ int operator()(int n) const { return n; } };
struct MapGU { __device__ __forceinline__ int operator()(int n) const { const int up = n >= DFF, j = up ? n - DFF : n; return 256 * (j >> 7) + 128 * up + (j & 127); } };
struct MapIn { __device__ __forceinline__ int operator()(int n) const { return n < NGC ? n : n + (NNG - NGC); } };
template <class RowMap>
__device__ __forceinline__ void convert_matrix(Frame& F, const float* W, int K, int N, bf16* WT, RowMap rm) {
    LAS float* scr = (LAS float*)(F.lds + F.wave * 16384);
    const int gw = F.bid * NWAVES + F.wave, NGW = F.G * NWAVES, nitems = (K / 64) * ((N + 31) / 32);
    for (int it = gw; it < nitems; it += NGW) transpose_item(W, K, N, WT, scr, it, F.lane, rm);
}
__device__ __forceinline__ void phase_convert(Frame& F, int l) {
    unsigned char* wb = F.ws + WS_W;
    convert_matrix(F, FIN(F, I_F1GU) + (size_t)l * DM * NGU, DM, NGU, (bf16*)(wb + W_GU1), MapGU());
    convert_matrix(F, FIN(F, I_F1D) + (size_t)l * DFF * DM, DFF, DM, (bf16*)(wb + W_D1), MapId());
    convert_matrix(F, FIN(F, I_WIN) + (size_t)l * DM * INCOLS, DM, INCOLS, (bf16*)(wb + W_NG), MapIn());
    for (int m = 0; m < 4; ++m) convert_matrix(F, FIN(F, I_WBR) + ((size_t)l * 4 + m) * 512 * DM, 512, DM, (bf16*)(wb + W_BR) + (size_t)m * DM * 512, MapId());
    convert_matrix(F, FIN(F, I_WOUT) + (size_t)l * DM * DM, DM, DM, (bf16*)(wb + W_O), MapId());
    convert_matrix(F, FIN(F, I_F2GU) + (size_t)l * DM * NGU, DM, NGU, (bf16*)(wb + W_GU2), MapGU());
    convert_matrix(F, FIN(F, I_F2D) + (size_t)l * DFF * DM, DFF, DM, (bf16*)(wb + W_D2), MapId());
    { GAS v4u* z = (GAS v4u*)(wb + W_NG + (size_t)NGC * DM * 2); const int n16 = (NNG - NGC) * DM * 2 / 16;
      for (int i = F.bid * 512 + F.tid; i < n16; i += F.G * 512) z[i] = (v4u){0u, 0u, 0u, 0u}; }
    if (l == 0) {
        GAS f32x4* hm = (GAS f32x4*)(F.ws + WS_HM); const GAS f32x4* mt = (const GAS f32x4*)FIN(F, I_META);
        for (int i = F.bid * 512 + F.tid; i < 256 * DM / 4; i += F.G * 512) hm[i] = (i < NMETA * DM / 4) ? mt[i] : (f32x4){0.f, 0.f, 0.f, 0.f};
    }
}
__device__ __forceinline__ void phase_norm(Frame& F, const float* src_real, const float* gain) {
    const int gw = F.bid * NWAVES + F.wave, NGW = F.G * NWAVES;
    bf16* XN = (bf16*)(F.ws + WS_XN); const float* hm = (const float*)(F.ws + WS_HM);
    f32x4 g[8];
#pragma unroll
    for (int j = 0; j < 8; ++j) g[j] = ((const GAS f32x4*)gain)[F.lane + 64 * j];
    for (int r = gw; r < MPAD; r += NGW) {
        GAS v2u* o8 = (GAS v2u*)(XN + (size_t)r * DM) + F.lane;
        if (r >= MREAL + NMETA) {
#pragma unroll
            for (int j = 0; j < 8; ++j) o8[64 * j] = (v2u){0u, 0u};
            continue; }
        const float* xr = r < MREAL ? src_real + (size_t)r * DM : hm + (size_t)(r - MREAL) * DM;
        f32x4 v[8]; float s = 0.f;
#pragma unroll
        for (int j = 0; j < 8; ++j) { v[j] = ((const GAS f32x4*)xr)[F.lane + 64 * j]; s += (v[j].x * v[j].x + v[j].y * v[j].y) + (v[j].z * v[j].z + v[j].w * v[j].w); }
        const float inv = 1.0f / sqrtf(wave_sum(s) * (1.f / DM) + EPS);
#pragma unroll
        for (int j = 0; j < 8; ++j) { v2u w; w.x = pk2(v[j].x * inv * g[j].x, v[j].y * inv * g[j].y); w.y = pk2(v[j].z * inv * g[j].z, v[j].w * inv * g[j].w); o8[64 * j] = w; }
    }
}

__device__ __forceinline__ f32x4 meta_dot16(const bf16* A  , int lda, const bf16* Bt  , int K, int s0, int s1, int lane) {
    const int fr = lane & 15, g = lane >> 4; const bf16* ap = A + (size_t)fr * lda + 8 * g; const bf16* bp = Bt + (size_t)fr * K + 8 * g;
    f32x4 a0 = (f32x4){0.f, 0.f, 0.f, 0.f}, a1 = a0;
    for (int s = s0; s < s1; s += 2) {
        const bf16x8 x0 = *(const GAS bf16x8*)(ap + 32 * s), x1 = *(const GAS bf16x8*)(ap + 32 * s + 32);
        const bf16x8 w0 = *(const GAS bf16x8*)(bp + 32 * s), w1 = *(const GAS bf16x8*)(bp + 32 * s + 32);
        a0 = __builtin_amdgcn_mfma_f32_16x16x32_bf16(w0, x0, a0, 0, 0, 0); a1 = __builtin_amdgcn_mfma_f32_16x16x32_bf16(w1, x1, a1, 0, 0, 0); }
    return a0 + a1;
}
__device__ __forceinline__ void st_bf16x4(bf16* p, f32x4 v) { v2u w; w.x = pk2(v[0], v[1]); w.y = pk2(v[2], v[3]); *(GAS v2u*)p = w; }
__device__ __forceinline__ void meta_gemm(Frame& F, int kind, const bf16* A, int lda, const bf16* Bt, int N, int K, bf16* Obf, int ldo, float scale) {
    const int lane = F.lane, wave = F.wave, fr = lane & 15, g = lane >> 4;
    const int ngroups = (kind == 0 ? N / 2 : N) / 16;
    LAS f32x4* red = (LAS f32x4*)F.lds;
    const int ns = K / 32, s0 = (wave * ns) >> 3, s1 = ((wave + 1) * ns) >> 3;
    for (int cg = F.bid; cg < ngroups; cg += F.G) {
        const int n0 = 16 * cg;
        f32x4 p0, p1 = (f32x4){0.f, 0.f, 0.f, 0.f};
        if (kind == 0) { const int rg = 256 * (n0 >> 7) + (n0 & 127);
            p0 = meta_dot16(A, lda, Bt + (size_t)rg * K, K, s0, s1, lane); p1 = meta_dot16(A, lda, Bt + (size_t)(rg + 128) * K, K, s0, s1, lane); }
        else if (kind == 4) { const int mb = wave >> 1, kh = wave & 1; p0 = meta_dot16(A + (size_t)mb * MPAD * 512, 512, Bt + ((size_t)mb * DM + n0) * 512, 512, 8 * kh, 8 * kh + 8, lane); }
        else p0 = meta_dot16(A, lda, Bt + (size_t)n0 * K, K, s0, s1, lane);
        red[wave * 64 + lane] = p0; if (kind == 0) red[512 + wave * 64 + lane] = p1;
        LDS_WAIT(); __syncthreads();
        if (wave == 0) {
            f32x4 q[8];
#pragma unroll
            for (int w = 0; w < 8; ++w) q[w] = red[w * 64 + lane];
            if (kind == 4) { f32x4 tot = (f32x4){0.f, 0.f, 0.f, 0.f}; const bf16* G = (const bf16*)(F.ws + WS_BIG);
#pragma unroll
                for (int mb = 0; mb < 4; ++mb) { const f32x4 acc = q[2 * mb] + q[2 * mb + 1]; const v2u gw2 = *(const GAS v2u*)(G + (size_t)(MREAL + fr) * NGATE + mb * DM + n0 + 4 * g);
                    tot[0] += bflo(gw2.x) * acc[0]; tot[1] += bfhi(gw2.x) * acc[1]; tot[2] += bflo(gw2.y) * acc[2]; tot[3] += bfhi(gw2.y) * acc[3]; }
                st_bf16x4(Obf + (size_t)(MREAL + fr) * ldo + n0 + 4 * g, tot);
            } else {
                f32x4 acc = ((q[0] + q[1]) + (q[2] + q[3])) + ((q[4] + q[5]) + (q[6] + q[7]));
                if (kind == 0) { f32x4 up = (f32x4){0.f, 0.f, 0.f, 0.f};
#pragma unroll
                    for (int w = 0; w < 8; ++w) up += red[512 + w * 64 + lane];
#pragma unroll
                    for (int r = 0; r < 4; ++r) acc[r] = pg8::fast_silu(acc[r]) * up[r];
                    st_bf16x4(Obf + (size_t)(MREAL + fr) * ldo + n0 + 4 * g, acc); }
                else if (kind == 1) { float* hp = (float*)(F.ws + WS_HM) + (size_t)fr * DM + n0 + 4 * g; *(GAS f32x4*)hp = *(const GAS f32x4*)hp + acc * scale; }
                else if (kind == 2) st_bf16x4(Obf + (size_t)(MREAL + fr) * ldo + n0 + 4 * g, acc);
                else {
#pragma unroll
                    for (int r = 0; r < 4; ++r) acc[r] = pg8::fast_sigmoid(acc[r]);
                    st_bf16x4(Obf + (size_t)(MREAL + fr) * ldo + n0 + 4 * g, acc); }
            }
        }
        __syncthreads();
    }
}
__device__ __forceinline__ void unpack8(const v4u w, float (&x)[8]) { x[0] = bflo(w.x); x[1] = bfhi(w.x); x[2] = bflo(w.y); x[3] = bfhi(w.y); x[4] = bflo(w.z); x[5] = bfhi(w.z); x[6] = bflo(w.w); x[7] = bfhi(w.w); }
__device__ __forceinline__ v4u pack8(const float (&x)[8]) { v4u w; w.x = pk2(x[0], x[1]); w.y = pk2(x[2], x[3]); w.z = pk2(x[4], x[5]); w.w = pk2(x[6], x[7]); return w; }
template <int GL>
__device__ __forceinline__ void norm_cols_inplace(bf16* p, const v4u w, const float* gain, float scale, int lane, bool wr) {
    float x[8]; unpack8(w, x); float s = 0.f;
#pragma unroll
    for (int i = 0; i < 8; ++i) s += x[i] * x[i];
#pragma unroll
    for (int o = 1; o < GL; o <<= 1) s += __shfl_xor(s, o);
    const float inv = scale / sqrtf(s * (1.f / (GL * 8)) + EPS); const int g0 = (8 * lane) % (GL * 8);
#pragma unroll
    for (int i = 0; i < 8; ++i) x[i] = x[i] * inv * gain[g0 + i];
    if (wr) *(GAS v4u*)p = pack8(x);
}
__device__ __forceinline__ void prep_row(Frame& F, int l, int r) {
    const int lane = F.lane; bf16* pr = (bf16*)(F.ws + WS_BIG) + (size_t)r * NNG;
    const float *dqn = FIN(F, I_DQN) + l * 64, *dkn = FIN(F, I_DKN) + l * 64, *sqn = FIN(F, I_SQN) + l * 128, *skn = FIN(F, I_SKN) + l * 128;
    const v4u w0 = *(const GAS v4u*)(pr + C_CQ + 8 * lane), w1 = *(const GAS v4u*)(pr + C_CK + 8 * lane), w2 = *(const GAS v4u*)(pr + C_DQ + 8 * lane), w3 = *(const GAS v4u*)(pr + C_DK + 8 * (lane & 15));
    __builtin_amdgcn_sched_barrier(0);
    norm_cols_inplace<8>(pr + C_CQ + 8 * lane, w0, dqn, 0.125f * 1.4426950408889634f, lane, true);
    norm_cols_inplace<8>(pr + C_CK + 8 * lane, w1, dkn, 1.0f, lane, true);
    norm_cols_inplace<16>(pr + C_DQ + 8 * lane, w2, sqn, 0.08838834764831845f * 1.4426950408889634f, lane, true);
    norm_cols_inplace<16>(pr + C_DK + 8 * (lane & 15), w3, skn, 1.0f, lane & 15, lane < 16);
}
constexpr int VT_NPB = (LPAD + 63) / 64, VT_NTASK = NB * 5 * VT_NPB;
__device__ __forceinline__ void vt_task(Frame& F, int task) {
    const int lane = F.lane;
    const bf16* P = (const bf16*)(F.ws + WS_BIG); bf16* VtC = (bf16*)(F.ws + WS_VTC); bf16* VtD = (bf16*)(F.ws + WS_VTD);
    LAS bf16* T = (LAS bf16*)(F.lds + F.wave * 17408);
    const int pb = task % VT_NPB, mat = (task / VT_NPB) % 5, b = task / (VT_NPB * 5), p0 = 64 * pb;
    const int col = mat < 4 ? C_CV + 128 * mat : C_DV;
#pragma unroll 4
    for (int i = 0; i < 16; ++i) { const int pl = 4 * i + (lane >> 4), p = p0 + pl;
        v4u w = *(const GAS v4u*)(P + (size_t)seqrow(b, p < LSEQ ? p : LSEQ - 1) * NNG + col + 8 * (lane & 15)); if (p >= LSEQ) w = (v4u){0u, 0u, 0u, 0u};
        *(LAS v4u*)(T + pl * 136 + 8 * (lane & 15)) = w; }
    LDS_WAIT(); asm volatile("" ::: "memory");
    bf16* dst = mat < 4 ? VtC + (size_t)(b * 4 + mat) * 128 * LPAD : VtD + (size_t)b * 128 * LPAD;
#pragma unroll 4
    for (int it = 0; it < 16; ++it) { const int e = 8 * it + (lane >> 3), c = lane & 7; unsigned short x[8];
#pragma unroll
        for (int k = 0; k < 8; ++k) x[k] = T[(8 * c + k) * 136 + e];
        v4u w; w.x = x[0] | ((unsigned)x[1] << 16); w.y = x[2] | ((unsigned)x[3] << 16); w.z = x[4] | ((unsigned)x[5] << 16); w.w = x[6] | ((unsigned)x[7] << 16);
        if (p0 + 8 * c < LPAD) *(GAS v4u*)(dst + (size_t)e * LPAD + p0 + 8 * c) = w; }
    LDS_WAIT(); asm volatile("" ::: "memory");
}

#define NEG_INF (-__builtin_inff())
constexpr int NQT = (LSEQ + 31) / 32;
constexpr int NQB = (NQT + 7) / 8;
__device__ __forceinline__ bf16x8 ld_frag16(const bf16* p) { return *(const GAS bf16x8*)p; }
__device__ __forceinline__ bf16x8 mk_frag(v2u lo, v2u hi) { v4u w; w.x = lo.x; w.y = lo.y; w.z = hi.x; w.w = hi.y; return __builtin_bit_cast(bf16x8, w); }
__device__ __forceinline__ unsigned cvtpk(float lo, float hi) { return pg8::cvt_pk_bf16(lo, hi); }
__device__ __forceinline__ void build_bias_table(Frame& F, LAS float* bt, int col0) {
    const float* rb = FIN(F, I_RELB);
    for (int i = F.tid; i < 4 * 128; i += 512) { const int hd = i >> 7, n = i & 127; bt[i] = (rb[rel_bucket(n) * 8 + col0 + hd] - rb[31 * 8 + col0 + hd]) * 1.4426950408889634f; }
}
__device__ __forceinline__ bool softmax_step(f32x16& S, float& m, float& lsum, float& alpha) {
    float tm = S[0];
#pragma unroll
    for (int r = 1; r < 16; ++r) tm = fmaxf(tm, S[r]);
    const bool raise = __any(tm > m + 11.5f);
    alpha = 1.0f;
    if (raise) { tm = fmaxf(tm, __shfl_xor(tm, 32)); const float mn = fmaxf(m, tm); alpha = (mn == NEG_INF) ? 1.0f : __builtin_amdgcn_exp2f(m - mn); m = mn; lsum *= alpha; }
    const float mref = (m == NEG_INF) ? 0.f : m;
    float rs = 0.f;
#pragma unroll
    for (int r = 0; r < 16; ++r) { S[r] = __builtin_amdgcn_exp2f(S[r] - mref); rs += S[r]; }
    lsum += rs;
    return raise;
}
__device__ __forceinline__ void relane(Frame& F) {
    int w = F.wave; asm volatile("" : "+s"(w)); unsigned mk = ~0u; asm volatile("" : "+s"(mk));
    int t = w * 64 + (int)__builtin_amdgcn_mbcnt_hi(mk, __builtin_amdgcn_mbcnt_lo(mk, 0u)); asm volatile("" : "+v"(t)); F.tid = t; F.lane = t & 63; F.wave = w; }
#ifndef TK_DSA
#define TK_DSA 64
#endif
#ifndef NVPRE_DIFF
#define NVPRE_DIFF 4
#endif
#ifndef NVPRE_DSA
#define NVPRE_DSA 4
#endif
template <bool DSA>
__device__ __forceinline__ void attn_wg_task(Frame& F, int l, int b, int h, int J, const LAS float* bt, float lam, float post) {
    constexpr int KD = DSA ? 128 : 64, KP = KD + 8, NKS = KD / 16;
    constexpr int TK = DSA ? TK_DSA : 64, NS = TK / 32, VP = TK + 4, NVL = 128 * (TK / 8) / 512, NKL = TK * (KD / 8) / 512;
    constexpr int KBUF = TK * KP, VBUF = 128 * VP;
    constexpr int RPARK = 57344;
    constexpr int NVPRE = DSA ? NVPRE_DSA : NVPRE_DIFF;
    relane(F);
    const int lane = F.lane, ql = lane & 31, hh = lane >> 5, wave = F.wave, tid = F.tid;
    LAS bf16* Kl = (LAS bf16*)F.lds; LAS bf16* Vl = Kl + 2 * KBUF;
    const bf16* P = (const bf16*)(F.ws + WS_BIG);
    const bf16* Vt = DSA ? (const bf16*)(F.ws + WS_VTD) + (size_t)b * 128 * LPAD : (const bf16*)(F.ws + WS_VTC) + (size_t)(b * 4 + h) * 128 * LPAD;
    const int jr = 8 * J + wave - 7; const bool wvalid = jr >= 0 && 32 * jr < LSEQ; const int j = jr < 0 ? 0 : jr;
    const int ktmax = (8 * J < NQT - 1) ? 8 * J : NQT - 1;
    const int pq = 32 * j + ql, pqc = pq < LSEQ ? pq : LSEQ - 1;
    const bf16* qrow = P + (size_t)seqrow(b, pqc) * NNG + (DSA ? C_DQ : C_CQ) + h * 128 + 8 * hh;
    const unsigned* mrow = (const unsigned*)(F.ws + WS_MASK) + ((size_t)b * LPAD + pqc) * MASKW;
    f32x16 R[4];
#pragma unroll
    for (int c = 0; c < (DSA ? 1 : 2); ++c) {
        const int kcol = DSA ? C_DK : C_CK + h * 128 + c * 64;
        relane(F);
        const int tid2 = F.tid, kr = tid2 / (KD / 8), kc = tid2 % (KD / 8), vr = tid2 / (TK / 8), vc = tid2 % (TK / 8);
        bf16x8 qf[NKS];
#pragma unroll
        for (int ks = 0; ks < NKS; ++ks) qf[ks] = ld_frag16(qrow + (DSA ? 0 : c * 64) + 16 * ks);
        float m = NEG_INF, lsum = 0.f; f32x16 O[4];
#pragma unroll
        for (int eb = 0; eb < 4; ++eb)
#pragma unroll
            for (int r = 0; r < 16; ++r) O[eb][r] = 0.f;
        v4u rk0[NKL], rk1[NKL], rv0[NVL], rv1[NVL];
#pragma unroll
        for (int i = 0; i < NKL; ++i) { rk0[i] = (v4u){0u, 0u, 0u, 0u}; rk1[i] = rk0[i]; }
#pragma unroll
        for (int i = 0; i < NVL; ++i) { rv0[i] = (v4u){0u, 0u, 0u, 0u}; rv1[i] = rv0[i]; }
#define ATT_ISSUE(st_, RK, RV) do { _Pragma("unroll") for (int i_ = 0; i_ < NKL; ++i_) { int pk_ = TK * (st_) + kr + i_ * (512 / (KD / 8)); pk_ = pk_ < LSEQ ? pk_ : LSEQ - 1; \
            RK[i_] = *(const GAS v4u*)(P + (size_t)seqrow(b, pk_) * NNG + kcol + 8 * kc); } \
            int vcol_ = TK * (st_) + 8 * vc; vcol_ = vcol_ < LPAD - 8 ? vcol_ : LPAD - 8; \
            _Pragma("unroll") for (int i_ = 0; i_ < NVL; ++i_) RV[i_] = *(const GAS v4u*)(Vt + (size_t)(vr + i_ * (512 / (TK / 8))) * LPAD + vcol_); } while (0)
#define ATT_COMMIT(buf_, RK, RV) do { _Pragma("unroll") for (int i_ = 0; i_ < NKL; ++i_) *(LAS v4u*)(Kl + (buf_) * KBUF + (kr + i_ * (512 / (KD / 8))) * KP + 8 * kc) = RK[i_]; \
            _Pragma("unroll") for (int i_ = 0; i_ < NVL; ++i_) { LAS v2u* vd_ = (LAS v2u*)(Vl + (buf_) * VBUF + (vr + i_ * (512 / (TK / 8))) * VP + 8 * vc); vd_[0] = (v2u){RV[i_].x, RV[i_].y}; vd_[1] = (v2u){RV[i_].z, RV[i_].w}; } } while (0)
        unsigned mwc[NS], mwn[NS];
#pragma unroll
        for (int s = 0; s < NS; ++s) { mwc[s] = 0xffffffffu; mwn[s] = 0xffffffffu; if (DSA) mwc[s] = mrow[s <= ktmax ? s : ktmax]; }
#define MW_LOAD(st_) do { if (DSA) { _Pragma("unroll") for (int s_ = 0; s_ < NS; ++s_) { const int kt_ = NS * (st_) + s_; mwn[s_] = mrow[kt_ <= ktmax ? kt_ : ktmax]; } } } while (0)
#define MW_ROT() do { if (DSA) { _Pragma("unroll") for (int s_ = 0; s_ < NS; ++s_) mwc[s_] = mwn[s_]; } } while (0)
        auto compute = [&](int kt, int buf, int sub) {
            if (wvalid && kt <= j) {
                const LAS bf16* Kt = Kl + buf * KBUF + (32 * sub + ql) * KP + 8 * hh; const LAS bf16* Vb = Vl + buf * VBUF + ql * VP + 32 * sub + 4 * hh;
                f32x16 S;
#pragma unroll
                for (int r = 0; r < 16; ++r) S[r] = 0.f;
#pragma unroll
                for (int ks = 0; ks < NKS; ++ks) S = __builtin_amdgcn_mfma_f32_32x32x16_bf16(*(const LAS bf16x8*)(Kt + 16 * ks), qf[ks], S, 0, 0, 0);
                const unsigned mw = (sub ? mwc[NS - 1] : mwc[0]) >> (4 * hh);
                if (kt + 4 >= j) {
                    const int n0 = pq - (32 * kt + 4 * hh); float bv[16];
#pragma unroll
                    for (int r = 0; r < 16; ++r) { const int ko = (r & 3) + 8 * (r >> 2); int n = n0 - ko; n = n < 0 ? 0 : (n < 127 ? n : 127); bv[r] = bt[h * 128 + n]; }
#pragma unroll
                    for (int r = 0; r < 16; ++r) { const int ko = (r & 3) + 8 * (r >> 2); const bool sel = ((mw >> ko) & 1u) && n0 >= ko; S[r] = sel ? S[r] + bv[r] : NEG_INF; }
                } else if (DSA) {
#pragma unroll
                    for (int r = 0; r < 16; ++r) { const int ko = (r & 3) + 8 * (r >> 2); S[r] = ((mw >> ko) & 1u) ? S[r] : NEG_INF; }
                }
                bf16x8 vf[NVPRE > 0 ? NVPRE : 1];
#pragma unroll
                for (int i = 0; i < NVPRE; ++i) { const LAS bf16* vp = Vb + (i >> 1) * 32 * VP + 16 * (i & 1); vf[i] = mk_frag(*(const LAS v2u*)vp, *(const LAS v2u*)(vp + 8)); }
                float alpha;
                if (softmax_step(S, m, lsum, alpha)) {
#pragma unroll
                    for (int eb = 0; eb < 4; ++eb)
#pragma unroll
                        for (int r = 0; r < 16; ++r) O[eb][r] *= alpha;
                }
                bf16x8 pf[2];
#pragma unroll
                for (int s = 0; s < 2; ++s) { v4u w; w.x = cvtpk(S[8 * s + 0], S[8 * s + 1]); w.y = cvtpk(S[8 * s + 2], S[8 * s + 3]); w.z = cvtpk(S[8 * s + 4], S[8 * s + 5]); w.w = cvtpk(S[8 * s + 6], S[8 * s + 7]); pf[s] = __builtin_bit_cast(bf16x8, w); }
#pragma unroll
                for (int eb = 0; eb < 4; ++eb)
#pragma unroll
                    for (int s = 0; s < 2; ++s) { const LAS bf16* vp = Vb + eb * 32 * VP + 16 * s;
                        O[eb] = __builtin_amdgcn_mfma_f32_32x32x16_bf16((2 * eb + s < NVPRE) ? vf[(2 * eb + s < NVPRE) ? 2 * eb + s : 0] : mk_frag(*(const LAS v2u*)vp, *(const LAS v2u*)(vp + 8)), pf[s], O[eb], 0, 0, 0); }
            } };
        __syncthreads();
        const int stmax = ktmax / NS;
        ATT_ISSUE(0, rk0, rv0); ATT_COMMIT(0, rk0, rv0);
        if (DSA && TK_DSA == 64) {
            for (int st = 0; st <= stmax; ++st) {
                LDS_WAIT(); __syncthreads();
                MW_LOAD(st + 1);
                if (st + 1 <= stmax) ATT_ISSUE(st + 1, rk0, rv0);
#pragma unroll 1
                for (int sub = 0; sub < NS; ++sub) compute(NS * st + sub, st & 1, sub);
                if (st + 1 <= stmax) ATT_COMMIT((st + 1) & 1, rk0, rv0);
                MW_ROT();
            }
        } else {
        if (stmax >= 1) ATT_ISSUE(1, rk1, rv1);
        for (int st = 0; st <= stmax; st += 2) {
            LDS_WAIT(); __syncthreads();
            MW_LOAD(st + 1);
            if (st + 2 <= stmax) ATT_ISSUE(st + 2, rk0, rv0);
#pragma unroll 1
            for (int sub = 0; sub < NS; ++sub) compute(NS * st + sub, 0, sub);
            if (st + 1 <= stmax) ATT_COMMIT(1, rk1, rv1);
            MW_ROT();
            if (st + 1 > stmax) break;
            LDS_WAIT(); __syncthreads();
            MW_LOAD(st + 2);
            if (st + 3 <= stmax) ATT_ISSUE(st + 3, rk1, rv1);
#pragma unroll 1
            for (int sub = 0; sub < NS; ++sub) compute(NS * (st + 1) + sub, 1, sub);
            if (st + 2 <= stmax) ATT_COMMIT(0, rk0, rv0);
            MW_ROT();
        }
        }
#undef ATT_ISSUE
#undef MW_LOAD
#undef MW_ROT
#undef ATT_COMMIT
        lsum += __shfl_xor(lsum, 32); const float il = 1.0f / lsum;
        if (DSA) {
#pragma unroll
            for (int eb = 0; eb < 4; ++eb)
#pragma unroll
                for (int r = 0; r < 16; ++r) R[eb][r] = O[eb][r] * il;
        } else if (c == 0) {
            LAS unsigned* rp = (LAS unsigned*)(F.lds + RPARK) + wave * 2048 + lane;
#pragma unroll
            for (int eb = 0; eb < 4; ++eb)
#pragma unroll
                for (int r = 0; r < 16; r += 2) rp[(eb * 8 + (r >> 1)) * 64] = pk2(O[eb][r] * il, O[eb][r + 1] * il);
        } else {
            const LAS unsigned* rp = (const LAS unsigned*)(F.lds + RPARK) + wave * 2048 + lane;
#pragma unroll
            for (int eb = 0; eb < 4; ++eb)
#pragma unroll
                for (int r = 0; r < 16; r += 2) { const unsigned w = rp[(eb * 8 + (r >> 1)) * 64]; R[eb][r] = bflo(w) - lam * (O[eb][r] * il); R[eb][r + 1] = bfhi(w) - lam * (O[eb][r + 1] * il); }
        }
    }
    float inv = 1.0f;
    if (!DSA) { float ss = 0.f;
#pragma unroll
        for (int eb = 0; eb < 4; ++eb)
#pragma unroll
            for (int r = 0; r < 16; ++r) ss += R[eb][r] * R[eb][r];
        ss += __shfl_xor(ss, 32); inv = post / sqrtf(ss * (1.f / 128.f) + EPS); }
    const float* sub = FIN(F, I_DSUB) + l * 128;
    if (wvalid && pq < LSEQ && (pq >= NMETA || b == 0)) {
        bf16* orow = (bf16*)(F.ws + WS_BR) + (size_t)(DSA ? 3 : 2) * MPAD * 512 + (size_t)seqrow(b, pq) * 512 + h * 128;
#pragma unroll
        for (int eb = 0; eb < 4; ++eb)
#pragma unroll
            for (int g = 0; g < 4; ++g) { const int e0 = 32 * eb + 8 * g + 4 * hh; f32x4 sv = (f32x4){1.f, 1.f, 1.f, 1.f}; if (!DSA) sv = *(const GAS f32x4*)(sub + e0);
                v2u w; w.x = pk2(R[eb][4 * g] * inv * sv.x, R[eb][4 * g + 1] * inv * sv.y); w.y = pk2(R[eb][4 * g + 2] * inv * sv.z, R[eb][4 * g + 3] * inv * sv.w);
                *(GAS v2u*)(orow + e0) = w; }
    }
}
__device__ __forceinline__ unsigned f32_key(float f) { const unsigned u = __float_as_uint(f); return u ^ ((u >> 31) ? 0xffffffffu : 0x80000000u); }
__device__ __forceinline__ float relu_bits(float x) { const int i = __float_as_int(x); return __int_as_float(i > 0 ? i : 0); }
__device__ __forceinline__ void dsa_index_task(Frame& F, int b, int j, float* slab) {
    relane(F);
    const int lane = F.lane, ql = lane & 31, hh = lane >> 5, wave = F.wave;
    const bf16* P = (const bf16*)(F.ws + WS_BIG);
    LAS unsigned char* qi = F.lds;
    { v4u st[8];
#pragma unroll
      for (int k = 0; k < 8; ++k) { const int i = F.tid + 512 * k, q = i >> 7, ch = i & 127; int pq = 32 * j + q; pq = pq < LSEQ ? pq : LSEQ - 1;
          st[k] = *(const GAS v4u*)(P + (size_t)seqrow(b, pq) * NNG + C_DQI + 8 * ch); }
#pragma unroll
      for (int k = 0; k < 8; ++k) { const int i = F.tid + 512 * k, q = i >> 7, ch = i & 127; *(LAS v4u*)(qi + q * 2064 + 16 * ch) = st[k]; } }
    LAS float* wl = (LAS float*)(qi + 32 * 2064);
    if (F.tid < 32 * 16) { const int q = F.tid >> 4, hd = F.tid & 15; int pq = 32 * j + q; pq = pq < LSEQ ? pq : LSEQ - 1;
        wl[F.tid] = bf2f(P[(size_t)seqrow(b, pq) * NNG + C_DW + hd]) * 0.03125f; }
    LAS unsigned* hist = (LAS unsigned*)(F.lds + 73728);
    for (int i = F.tid; i < 32 * 256; i += 512) hist[i] = 0u;
    LDS_WAIT(); __syncthreads();
#ifndef PROBE_SUB
#define PROBE_SUB 0
#endif
    for (int rpa = 0; rpa < ((PROBE_SUB & 8) ? 2 : 1); ++rpa)
    {
    if (rpa) { LDS_WAIT(); __syncthreads(); for (int i = F.tid; i < 32 * 256; i += 512) hist[i] = 0u; LDS_WAIT(); __syncthreads(); }
    bf16x8 kn[4];
    { const int pk = 32 * wave + ql, pkc = pk < LSEQ ? pk : LSEQ - 1; const bf16* krow = P + (size_t)seqrow(b, pkc) * NNG + C_DKI + 8 * hh;
#pragma unroll
      for (int ks = 0; ks < 4; ++ks) kn[ks] = ld_frag16(krow + 16 * ks); }
    for (int kt = wave; kt <= j; kt += NWAVES) {
        bf16x8 kf[4];
#pragma unroll
        for (int ks = 0; ks < 4; ++ks) kf[ks] = kn[ks];
        { const int ktn = kt + NWAVES <= j ? kt + NWAVES : kt; const int pk = 32 * ktn + ql, pkc = pk < LSEQ ? pk : LSEQ - 1; const bf16* krow = P + (size_t)seqrow(b, pkc) * NNG + C_DKI + 8 * hh;
#pragma unroll
          for (int ks = 0; ks < 4; ++ks) kn[ks] = ld_frag16(krow + 16 * ks); }
        f32x16 idx;
#pragma unroll
        for (int r = 0; r < 16; ++r) idx[r] = 0.f;
#pragma unroll 1
        for (int hd = 0; hd < 16; hd += 2) { f32x16 S0, S1; const float wh0 = wl[ql * 16 + hd], wh1 = wl[ql * 16 + hd + 1];
#pragma unroll
            for (int r = 0; r < 16; ++r) { S0[r] = 0.f; S1[r] = 0.f; }
#pragma unroll
            for (int ks = 0; ks < 4; ++ks) { S0 = __builtin_amdgcn_mfma_f32_32x32x16_bf16(kf[ks], *(const LAS bf16x8*)(qi + ql * 2064 + hd * 128 + 32 * ks + 16 * hh), S0, 0, 0, 0);
                S1 = __builtin_amdgcn_mfma_f32_32x32x16_bf16(kf[ks], *(const LAS bf16x8*)(qi + ql * 2064 + (hd + 1) * 128 + 32 * ks + 16 * hh), S1, 0, 0, 0); }
#pragma unroll
            for (int r = 0; r < 16; ++r) { idx[r] = __builtin_fmaf(wh0, relu_bits(S0[r]), idx[r]); idx[r] = __builtin_fmaf(wh1, relu_bits(S1[r]), idx[r]); } }
        { const int lim = 32 * (j - kt) + ql - 4 * hh;
#pragma unroll
          for (int r = 0; r < 16; ++r) { const int ko = (r & 3) + 8 * (r >> 2);
              int bn = (int)__builtin_fmaf(idx[r], 32.f, 256.f); bn = bn < 0 ? 0 : (bn > 511 ? 511 : bn);
              const unsigned inc = (ko <= lim) ? ((bn & 1) ? 0x10000u : 1u) : 0u;
              (void)__hip_atomic_fetch_add(hist + ql * 256 + (((bn >> 1) + 2 * ql) & 255), inc, __ATOMIC_RELAXED, __HIP_MEMORY_SCOPE_WORKGROUP); } }
        float* srow = slab + (size_t)ql * LPAD + 32 * kt + 4 * hh;
#pragma unroll
        for (int g = 0; g < 4; ++g) *(GAS f32x4*)(srow + 8 * g) = (f32x4){idx[4 * g], idx[4 * g + 1], idx[4 * g + 2], idx[4 * g + 3]};
    }
    }
    VM_WAIT(); LDS_WAIT(); __syncthreads();
    for (int rpb = 0; rpb < ((PROBE_SUB & 16) ? 2 : 1); ++rpb)
    for (int qq = wave; qq < 32; qq += NWAVES) {
        const int p = 32 * j + qq; if (p >= LSEQ) break;
        const float* row = slab + (size_t)qq * LPAD;
        unsigned u[65];
        { const GAS unsigned* rp = (const GAS unsigned*)row + lane;
#pragma unroll
          for (int i = 0; i < 65; ++i) u[i] = rp[64 * i];
          __builtin_amdgcn_sched_barrier(0); }
        auto wsum = [&](unsigned c) { unsigned s = 0;
#pragma unroll
            for (int k = 0; k < 7; ++k) s += (unsigned)__builtin_popcountll(__ballot((c >> k) & 1u)) << k;
            return s; };
        unsigned T = 1u;
        if (p + 1 <= 256) {
#pragma unroll
            for (int i = 0; i < 65; ++i) { const unsigned k = f32_key(__uint_as_float(u[i])) >> 1; u[i] = (64 * i + lane <= p) ? k : 0u; }
        } else {
            const LAS unsigned* hrow = hist + qq * 256; unsigned c8[8];
#pragma unroll
            for (int i = 0; i < 4; ++i) { const unsigned w = hrow[(4 * lane + i + 2 * qq) & 255]; c8[2 * i] = w & 0xffffu; c8[2 * i + 1] = w >> 16; }
            unsigned tot = 0;
#pragma unroll
            for (int i = 0; i < 8; ++i) tot += c8[i];
            unsigned suf = 0;
            { const unsigned long long gtm = (lane == 63) ? 0ull : ~((2ull << lane) - 1ull);
#pragma unroll
              for (int k = 0; k < 13; ++k) suf += (unsigned)__builtin_popcountll(__ballot((tot >> k) & 1u) & gtm) << k; }
            unsigned run = suf, bl = 0, al = 0; bool found = false;
#pragma unroll
            for (int i = 7; i >= 0; --i) { const bool hit = !found && run < 256u && run + c8[i] >= 256u; if (hit) { bl = 8u * lane + i; al = run; } found = found || hit; run += c8[i]; }
            const unsigned long long fb = __ballot(found); const int src = (int)__builtin_ctzll(fb | (1ull << 63));
            const unsigned bstar = __builtin_amdgcn_readlane(bl, src), above = __builtin_amdgcn_readlane(al, src), need = 256u - above;
            unsigned f0 = 0u, f1 = 0u, f2 = 0u, cb = 0u;
#pragma unroll
            for (int i = 0; i < 65; ++i) { const float v = __uint_as_float(u[i]); int bn = (int)__builtin_fmaf(v, 32.f, 256.f); bn = bn < 0 ? 0 : (bn > 511 ? 511 : bn);
                const bool val = 64 * i + lane <= p, inband = val && (unsigned)bn == bstar;
                if (i < 32) f0 |= inband ? (1u << i) : 0u; else if (i < 64) f1 |= inband ? (1u << (i - 32)) : 0u; else f2 = inband ? 1u : 0u;
                cb += inband ? 1u : 0u;
                const unsigned k = f32_key(v) >> 1; u[i] = val ? k : 0u; }
            const unsigned inb = wsum(cb);
            if (fb != 0ull && inb <= 128u && inb >= need) {
                LAS unsigned* band = (LAS unsigned*)(F.lds + 68096) + wave * 128;
                unsigned off = 0;
#pragma unroll
                for (int k = 0; k < 7; ++k) { const unsigned long long bal = __ballot((cb >> k) & 1u); off += __builtin_amdgcn_mbcnt_hi((unsigned)(bal >> 32), __builtin_amdgcn_mbcnt_lo((unsigned)bal, 0u)) << k; }
#pragma unroll
                for (int i = 0; i < 65; ++i) { const bool inband = i < 32 ? ((f0 >> i) & 1u) : (i < 64 ? ((f1 >> (i - 32)) & 1u) : (f2 & 1u)); if (inband) { band[off] = u[i]; ++off; } }
                LDS_WAIT();
                const unsigned m0 = lane < (int)inb ? band[lane] : 0u, m1 = lane + 64 < (int)inb ? band[lane + 64] : 0u; unsigned ge0 = 0, gt0 = 0, ge1 = 0, gt1 = 0;
                for (unsigned k = 0; k < inb; ++k) { const unsigned v = band[k]; ge0 += (m0 - 1u - v) >> 31; gt0 += (m0 - v) >> 31; ge1 += (m1 - 1u - v) >> 31; gt1 += (m1 - v) >> 31; }
                const unsigned long long ok0 = __ballot(lane < (int)inb && ge0 >= need && gt0 < need), ok1 = __ballot(lane + 64 < (int)inb && ge1 >= need && gt1 < need);
                if (ok0) T = __builtin_amdgcn_readlane(m0, (int)__builtin_ctzll(ok0)); else T = __builtin_amdgcn_readlane(m1, (int)__builtin_ctzll(ok1 | (1ull << 63)));
                LDS_WAIT();
            } else {
                T = 0u;
                for (int bit = 30; bit >= 0; --bit) { const unsigned cm1 = (T | (1u << bit)) - 1u; unsigned c = 0;
#pragma unroll
                    for (int i = 0; i < 65; ++i) c += (cm1 - u[i]) >> 31;
                    if (wsum(c) >= 256u) T |= 1u << bit; } } }
        unsigned long long* mrow = (unsigned long long*)((unsigned*)(F.ws + WS_MASK) + ((size_t)b * LPAD + p) * MASKW);
        unsigned wlo = 0u, whi = 0u;
#pragma unroll
        for (int i = 0; i < 64; ++i) { const unsigned long long bal = __ballot(u[i] >= T); if (lane == i) { wlo = (unsigned)bal; whi = (unsigned)(bal >> 32); } }
        const unsigned long long b64 = __ballot(u[64] >= T);
        mrow[lane] = ((unsigned long long)whi << 32) | wlo; if (lane == 0) mrow[64] = b64;
    }
    __syncthreads();
}
struct HgChunk { bf16* base; int pitch; int cq, ck, cv; bf16* A; float* dl; };
__device__ __forceinline__ HgChunk hg_chunk(Frame& F, int b, int h, int c) {
    HgChunk k;
    if (c == 0) { unsigned char* mp = F.ws + WS_HMETA + (size_t)h * HMETA_STRIDE; k.base = (bf16*)mp; k.pitch = 384; k.cq = 0; k.ck = 128; k.cv = 256; k.A = (bf16*)(mp + 64 * 384 * 2); k.dl = (float*)(mp + 64 * 384 * 2 + 64 * 64 * 2); }
    else { const size_t ci = (size_t)(b * 4 + h) * 64 + (c - 1); k.base = (bf16*)(F.ws + WS_BIG) + (size_t)(b * SEQ + 64 * (c - 1)) * NNG; k.pitch = NNG; k.cq = C_AQ + h * 128; k.ck = C_AF + h * 128; k.cv = C_AI + h * 128;
        k.A = (bf16*)(F.ws + WS_HA) + ci * 64 * 64; k.dl = (float*)(F.ws + WS_HDL) + ci * 128; }
    return k;
}
__device__ __forceinline__ void hgrn_prep_task(Frame& F, int l, int b, int h, int c) {
    const int d = F.tid & 127, tq = F.tid >> 7, lane = F.lane, wave = F.wave;
    const bf16* P = (const bf16*)(F.ws + WS_BIG);
    LAS bf16* Qt = (LAS bf16*)F.lds; LAS bf16* Kt = Qt + 64 * 136; LAS float* part = (LAS float*)(F.lds + 2 * 64 * 136 * 2);
    const HgChunk ch = hg_chunk(F, b, h, c);
    float lb = 0.f; if (l == 1) { const float a = FIN(F, I_LB)[h * 128 + d], cc = FIN(F, I_LB)[512 + h * 128 + d]; lb = 1.0f / (1.0f + __expf(a - cc)); }
    const bool meta = (c == 0);
    unsigned short zr[16], qr[16], vr[16];
    { const int r0 = meta ? MREAL : b * SEQ + 64 * (c - 1);
#pragma unroll
      for (int i = 0; i < 16; ++i) { int t = 16 * tq + i; if (meta) t = t < NMETA ? t : NMETA - 1; const bf16* pr = P + (size_t)(r0 + t) * NNG + h * 128 + d; zr[i] = pr[C_AF]; qr[i] = pr[C_AQ]; vr[i] = pr[C_AI]; }
      __builtin_amdgcn_sched_barrier(0); }
    float lfv[16];
    float run = 0.f;
#pragma unroll
    for (int i = 0; i < 16; ++i) { const bool valid = !meta || (16 * tq + i < NMETA); const float z = bf2f(zr[i]); const float sg = 1.0f / (1.0f + __expf(-z));
        lfv[i] = valid ? __logf(lb + (1.0f - lb) * sg) : 0.f; run += lfv[i]; }
    part[tq * 128 + d] = run;
    LDS_WAIT(); __syncthreads();
    const float p0 = part[d], p1 = part[128 + d], p2 = part[256 + d], p3 = part[384 + d];
    const float off = (tq > 0 ? p0 : 0.f) + (tq > 1 ? p1 : 0.f) + (tq > 2 ? p2 : 0.f), bmid = p0 + p1, blast = (p0 + p1) + (p2 + p3);
    unsigned kb[8], vb[8]; unsigned short qb[16];
    float bt = off;
#pragma unroll
    for (int i = 0; i < 16; i += 2) { float kbar[2], vv[2];
#pragma unroll
        for (int u = 0; u < 2; ++u) { const int t = 16 * tq + i + u; const bool valid = !meta || (t < NMETA);
            const float lf = lfv[i + u]; const float q = bf2f(qr[i + u]);
            const float kk = valid ? 1.0f - __expf(lf) : 0.f, qq = valid ? q / (1.0f + __expf(-q)) : 0.f; vv[u] = valid ? bf2f(vr[i + u]) : 0.f;
            bt += lf;
            kbar[u] = kk * __expf(blast - bt); qb[i + u] = (unsigned short)f2bf_s(qq * __expf(bt));
            const float qt = qq * __expf(fminf(bt - bmid, 80.f)), kt = kk * __expf(fminf(bmid - bt, 80.f));
            Qt[t * 136 + d] = (bf16)f2bf_s(qt); Kt[t * 136 + d] = (bf16)f2bf_s(kt); }
        kb[i >> 1] = pk2(kbar[0], kbar[1]); vb[i >> 1] = pk2(vv[0], vv[1]); }
    asm volatile("s_waitcnt vmcnt(0)" ::: "memory"); __syncthreads();
#pragma unroll
    for (int i = 0; i < 16; ++i) ch.base[(size_t)(16 * tq + i) * ch.pitch + ch.cq + d] = qb[i];
    { bf16* kd = ch.base + (size_t)(d >> 1) * ch.pitch + ch.ck + (d & 1) * 64 + 16 * tq; bf16* vd = ch.base + (size_t)(d >> 1) * ch.pitch + ch.cv + (d & 1) * 64 + 16 * tq;
      *(GAS v4u*)kd = (v4u){kb[0], kb[1], kb[2], kb[3]}; *(GAS v4u*)(kd + 8) = (v4u){kb[4], kb[5], kb[6], kb[7]};
      *(GAS v4u*)vd = (v4u){vb[0], vb[1], vb[2], vb[3]}; *(GAS v4u*)(vd + 8) = (v4u){vb[4], vb[5], vb[6], vb[7]}; }
    if (tq == 0) ch.dl[d] = __expf(blast);
    LDS_WAIT(); __syncthreads();
    { const int mt = wave >> 1, fr = lane & 15, g = lane >> 4;
#pragma unroll
      for (int u = 0; u < 2; ++u) { const int nt = 2 * (wave & 1) + u; f32x4 acc = (f32x4){0.f, 0.f, 0.f, 0.f};
        if (nt <= mt) {
#pragma unroll
            for (int ks = 0; ks < 4; ++ks) acc = __builtin_amdgcn_mfma_f32_16x16x32_bf16(*(const LAS bf16x8*)(Qt + (16 * mt + fr) * 136 + 32 * ks + 8 * g), *(const LAS bf16x8*)(Kt + (16 * nt + fr) * 136 + 32 * ks + 8 * g), acc, 0, 0, 0);
        }
#pragma unroll
        for (int r = 0; r < 4; ++r) { const int t = 16 * mt + 4 * g + r, s = 16 * nt + fr; ch.A[t * 64 + s] = (bf16)f2bf_s(s <= t ? acc[r] : 0.f); } } }
    __syncthreads();
}
__device__ __forceinline__ float fast_sigmoid_m(float x) { return __builtin_amdgcn_rcpf(1.0f + __expf(-x)); }
__device__ __forceinline__ void hgrn_scan_unit(Frame& F, int l, int b, int h) {
    const int lane = F.lane, wave = F.wave, fr = lane & 15, g = lane >> 4, tid = F.tid;
    constexpr int QP = 136, AP = 72, KP = 72, GP = 136;
    constexpr int BUF = (64 * QP + 64 * AP + 128 * KP + 64 * GP) * 2 + 512;
    LAS float* red = (LAS float*)(F.lds + 2 * BUF);
    const int dv = 16 * wave + fr;
    const float gn = FIN(F, I_GN)[l * 512 + h * 128 + dv];
    const bf16* Pg = (const bf16*)(F.ws + WS_BIG) + C_AG + h * 128;
    f32x4 S[8];
#pragma unroll
    for (int mt = 0; mt < 8; ++mt) S[mt] = (f32x4){0.f, 0.f, 0.f, 0.f};
    v4u rq[2], ra, rk[2], rg[2], rd; bf16x8 bv0, bv1, bn0, bn1;
#define HG_ISSUE(c_, B0, B1) do { const HgChunk ch_ = hg_chunk(F, b, h, (c_)); const int nv_ = ((c_) == 0) ? NMETA : 64; \
        _Pragma("unroll") for (int i = 0; i < 2; ++i) { const int idx = tid + 512 * i, row = idx >> 4, c16 = idx & 15; \
            rq[i] = *(const GAS v4u*)(ch_.base + (size_t)row * ch_.pitch + ch_.cq + 8 * c16); rk[i] = *(const GAS v4u*)(ch_.base + (size_t)row * ch_.pitch + ch_.ck + 8 * c16); \
            rg[i] = (v4u){0u, 0u, 0u, 0u}; if (row < nv_) rg[i] = *(const GAS v4u*)(Pg + (size_t)(((c_) == 0) ? MREAL + row : b * SEQ + 64 * ((c_) - 1) + row) * NNG + 8 * c16); } \
        ra = *(const GAS v4u*)(ch_.A + 8 * tid); if (tid < 32) rd = *(const GAS v4u*)(ch_.dl + 4 * tid); \
        const bf16* vrow_ = ch_.base + (size_t)(dv >> 1) * ch_.pitch + ch_.cv + (dv & 1) * 64 + 8 * g; B0 = ld_frag16(vrow_); B1 = ld_frag16(vrow_ + 32); } while (0)
#define HG_COMMIT(buf_) do { LAS bf16* Q_ = (LAS bf16*)(F.lds + (buf_) * BUF); LAS bf16* A_ = Q_ + 64 * QP; LAS bf16* KT_ = A_ + 64 * AP; LAS bf16* G_ = KT_ + 128 * KP; \
        _Pragma("unroll") for (int i = 0; i < 2; ++i) { const int idx = tid + 512 * i, row = idx >> 4, c16 = idx & 15; *(LAS v4u*)(Q_ + row * QP + 8 * c16) = rq[i]; \
            *(LAS v4u*)(KT_ + (2 * row + (c16 >> 3)) * KP + 8 * (c16 & 7)) = rk[i]; *(LAS v4u*)(G_ + row * GP + 8 * c16) = rg[i]; } \
        *(LAS v4u*)(A_ + (tid >> 3) * AP + 8 * (tid & 7)) = ra; if (tid < 32) *(LAS v4u*)((LAS unsigned char*)(G_ + 64 * GP) + 16 * tid) = rd; } while (0)
    HG_ISSUE(0, bv0, bv1); HG_COMMIT(0);
    for (int c = 0; c <= 64; ++c) {
        const int buf = c & 1;
        LDS_WAIT(); __syncthreads();
        if (c < 64) HG_ISSUE(c + 1, bn0, bn1);
        LAS bf16* Q = (LAS bf16*)(F.lds + buf * BUF); LAS bf16* A = Q + 64 * QP; LAS bf16* KT = A + 64 * AP; LAS bf16* G = KT + 128 * KP; const LAS float* DL = (const LAS float*)(G + 64 * GP);
        f32x4 o[4];
#pragma unroll
        for (int mt = 0; mt < 4; ++mt) o[mt] = (f32x4){0.f, 0.f, 0.f, 0.f};
#pragma unroll
        for (int ks = 0; ks < 4; ++ks) { v4u w; w.x = cvtpk(S[2 * ks][0], S[2 * ks][1]); w.y = cvtpk(S[2 * ks][2], S[2 * ks][3]); w.z = cvtpk(S[2 * ks + 1][0], S[2 * ks + 1][1]); w.w = cvtpk(S[2 * ks + 1][2], S[2 * ks + 1][3]);
            const bf16x8 sb = __builtin_bit_cast(bf16x8, w);
#pragma unroll
            for (int mt = 0; mt < 4; ++mt) { const LAS bf16* qp = Q + (16 * mt + fr) * QP + 32 * ks + 4 * g;
                const bf16x8 af = mk_frag(*(const LAS v2u*)qp, *(const LAS v2u*)(qp + 16));
                o[mt] = __builtin_amdgcn_mfma_f32_16x16x32_bf16(af, sb, o[mt], 0, 0, 0); } }
#pragma unroll
        for (int mt = 0; mt < 4; ++mt) { o[mt] = __builtin_amdgcn_mfma_f32_16x16x32_bf16(*(const LAS bf16x8*)(A + (16 * mt + fr) * AP + 8 * g), bv0, o[mt], 0, 0, 0);
            o[mt] = __builtin_amdgcn_mfma_f32_16x16x32_bf16(*(const LAS bf16x8*)(A + (16 * mt + fr) * AP + 32 + 8 * g), bv1, o[mt], 0, 0, 0); }
#pragma unroll
        for (int mt = 0; mt < 8; ++mt) { const f32x4 dl = *(const LAS f32x4*)(DL + 16 * mt + 4 * g); S[mt] = S[mt] * dl;
            S[mt] = __builtin_amdgcn_mfma_f32_16x16x32_bf16(*(const LAS bf16x8*)(KT + (16 * mt + fr) * KP + 8 * g), bv0, S[mt], 0, 0, 0);
            S[mt] = __builtin_amdgcn_mfma_f32_16x16x32_bf16(*(const LAS bf16x8*)(KT + (16 * mt + fr) * KP + 32 + 8 * g), bv1, S[mt], 0, 0, 0); }
        { float s2[16];
#pragma unroll
          for (int i = 0; i < 16; ++i) s2[i] = o[i >> 2][i & 3] * o[i >> 2][i & 3];
#define HG_ROR(n_) _Pragma("unroll") for (int i = 0; i < 16; ++i) s2[i] += __builtin_bit_cast(float, __builtin_amdgcn_update_dpp(0, __builtin_bit_cast(int, s2[i]), 0x120 + (n_), 0xf, 0xf, false));
          HG_ROR(8) HG_ROR(4) HG_ROR(2) HG_ROR(1)
#undef HG_ROR
          if (fr == 0) {
#pragma unroll
              for (int mt = 0; mt < 4; ++mt) *(LAS f32x4*)(red + wave * 64 + 16 * mt + 4 * g) = (f32x4){s2[4 * mt], s2[4 * mt + 1], s2[4 * mt + 2], s2[4 * mt + 3]}; } }
        LDS_WAIT(); __syncthreads();
        const int nvalid = (c == 0) ? NMETA : 64;
        { f32x4 tot[4]; float gr[16];
#pragma unroll
          for (int mt = 0; mt < 4; ++mt) { tot[mt] = *(const LAS f32x4*)(red + 16 * mt + 4 * g);
#pragma unroll
              for (int w = 1; w < 8; ++w) tot[mt] += *(const LAS f32x4*)(red + w * 64 + 16 * mt + 4 * g); }
#pragma unroll
          for (int i = 0; i < 16; ++i) gr[i] = bf2f(G[(16 * (i >> 2) + 4 * g + (i & 3)) * GP + dv]);
          if (c > 0 || b == 0) {
#pragma unroll
              for (int i = 0; i < 16; ++i) { const int t = 16 * (i >> 2) + 4 * g + (i & 3); const int row = (c == 0) ? MREAL + t : b * SEQ + 64 * (c - 1) + t;
                  const float val = o[i >> 2][i & 3] * __builtin_amdgcn_rsqf(tot[i >> 2][i & 3] * (1.f / 128.f) + EPS) * gn * (gr[i] * fast_sigmoid_m(gr[i]));
                  if (t < nvalid) ((bf16*)(F.ws + WS_BR))[(size_t)row * 512 + h * 128 + dv] = (bf16)f2bf_s(val); } } }
        if (c < 64) { HG_COMMIT(buf ^ 1); bv0 = bn0; bv1 = bn1; }
    }
#undef HG_ISSUE
#undef HG_COMMIT
    __syncthreads();
}
__device__ __forceinline__ void conv_row(Frame& F, int l, int r) {
    const int lane = F.lane; const bf16* P = (const bf16*)(F.ws + WS_BIG);
    int r1, r2;
    if (r < MREAL) { const int b = r >> 12, t = r & 4095; r1 = seqrow(b, NMETA + t - 1); r2 = seqrow(b, NMETA + t - 2); }
    else { const int i = r - MREAL; r1 = i >= 1 ? r - 1 : -1; r2 = i >= 2 ? r - 2 : -1; }
    const float* cw = FIN(F, I_CONVW) + l * 3 * 512 + 8 * lane;
    const int r1c = r1 >= 0 ? r1 : r, r2c = r2 >= 0 ? r2 : r;
    const v4u wc0 = *(const GAS v4u*)(P + (size_t)r * NNG + C_BC + 8 * lane), wu0 = *(const GAS v4u*)(P + (size_t)r * NNG + C_BU + 8 * lane), wb = *(const GAS v4u*)(P + (size_t)r * NNG + C_BB + 8 * lane);
    const v4u wc1 = *(const GAS v4u*)(P + (size_t)r1c * NNG + C_BC + 8 * lane), wu1 = *(const GAS v4u*)(P + (size_t)r1c * NNG + C_BU + 8 * lane);
    const v4u wc2 = *(const GAS v4u*)(P + (size_t)r2c * NNG + C_BC + 8 * lane), wu2 = *(const GAS v4u*)(P + (size_t)r2c * NNG + C_BU + 8 * lane);
    __builtin_amdgcn_sched_barrier(0);
    float c0[8], u0[8], bb[8], y[8]; unpack8(wc0, c0); unpack8(wu0, u0); unpack8(wb, bb);
#pragma unroll
    for (int i = 0; i < 8; ++i) y[i] = cw[i] * (c0[i] * u0[i]);
    const float m1 = r1 >= 0 ? 1.f : 0.f, m2 = r2 >= 0 ? 1.f : 0.f;
    unpack8(wc1, c0); unpack8(wu1, u0);
#pragma unroll
    for (int i = 0; i < 8; ++i) y[i] += m1 * cw[512 + i] * (c0[i] * u0[i]);
    unpack8(wc2, c0); unpack8(wu2, u0);
#pragma unroll
    for (int i = 0; i < 8; ++i) y[i] += m2 * cw[1024 + i] * (c0[i] * u0[i]);
#pragma unroll
    for (int i = 0; i < 8; ++i) y[i] *= bb[i];
    *(GAS v4u*)((bf16*)(F.ws + WS_BR) + (size_t)MPAD * 512 + (size_t)r * 512 + 8 * lane) = pack8(y);
}
constexpr int CW_TMO = 0, CW_BAR = 4096, CW_Q = 16384;
__device__ __forceinline__ int queue_pop(Frame& F, int qi) {
    int t = 0; if (F.lane == 0) t = (int)__hip_atomic_fetch_add((unsigned*)(F.ctl + CW_Q + 64 * qi), 1u, RLX_AGENT);
    return __builtin_amdgcn_readfirstlane(t);
}
__device__ __forceinline__ int queue_pop_wg(Frame& F, int qi) {
    LAS int* slot = (LAS int*)(F.lds + 139264);
    __syncthreads();
    if (F.tid == 0) *slot = (int)__hip_atomic_fetch_add((unsigned*)(F.ctl + CW_Q + 64 * qi), 1u, RLX_AGENT);
    LDS_WAIT(); __syncthreads();
    return __builtin_amdgcn_readfirstlane(*slot);
}
__device__ __forceinline__ void phase_hgrn_prep(Frame& F, int l) {
    for (int t = F.bid; t < NB * 4 * 64 + 4; t += F.G) { if (t < 4) hgrn_prep_task(F, l, 0, t, 0); else { const int u = t - 4; hgrn_prep_task(F, l, u >> 8, (u >> 6) & 3, 1 + (u & 63)); } }
}
__device__ __forceinline__ void phase_prep(Frame& F, int l) { const int gw = F.bid * NWAVES + F.wave, NGW = F.G * NWAVES; for (int r = gw; r < MREAL + NMETA; r += NGW) prep_row(F, l, r); }
__device__ __forceinline__ void phase_vt(Frame& F) { const int gw = F.bid * NWAVES + F.wave, NGW = F.G * NWAVES; for (int t = gw; t < VT_NTASK; t += NGW) vt_task(F, t); }
__device__ __forceinline__ void phase_mix1(Frame& F, int l, int qidx) {
    LAS float* bt = (LAS float*)(F.lds + 135168);
    build_bias_table(F, bt, 0);
    __syncthreads();
#ifndef MIX1_SKIP
#define MIX1_SKIP 0
#endif
    const int sk = (qidx >= 4) ? MIX1_SKIP : 0;
    if (F.bid < NIDX_WG) {
        float* slab = (float*)(F.ws + WS_SCR) + (size_t)F.bid * 32 * LPAD;
        if (!(sk & 1)) for (int t = F.bid; t < NB * NQT; t += NIDX_WG) { const int j = NQT - 1 - t / NB, b = t % NB; dsa_index_task(F, b, j, slab); }
    } else if (F.bid < NIDX_WG + NHG_WG) {
        const int u = F.bid - NIDX_WG; if (!(sk & 2)) hgrn_scan_unit(F, l, u >> 2, u & 3);
    } else {
        const int u0 = F.bid - NIDX_WG - NHG_WG, nw = F.G - NIDX_WG - NHG_WG;
        const int cw = u0 * NWAVES + F.wave, ncw = nw * NWAVES; if (!(sk & 4)) for (int r = cw; r < MREAL + NMETA; r += ncw) conv_row(F, l, r);
    }
    float lam, post;
    { const float* lp = FIN(F, I_DLAM) + l * 256; const float s1 = wave_sum(lp[F.lane] * lp[64 + F.lane]), s2 = wave_sum(lp[128 + F.lane] * lp[192 + F.lane]);
      const float li = 0.8f - 0.6f * __expf(-0.3f * (float)l); lam = __expf(s1) - __expf(s2) + li; post = 1.0f - li; }
    for (;;) { const int t = queue_pop_wg(F, qidx) + ((sk & 8) ? (1 << 20) : 0); if (t >= NB * 4 * NQB) break;
        const int J = NQB - 1 - t / 32, bh = t % 32; attn_wg_task<false>(F, l, bh >> 2, bh & 3, J, bt, lam, post); }
}
__device__ __forceinline__ void phase_mix2(Frame& F, int l, int qidx) {
    LAS float* bt = (LAS float*)(F.lds + 135168);
    build_bias_table(F, bt, 4);
    __syncthreads();
    for (;;) { const int t = queue_pop_wg(F, qidx); if (t >= NB * 4 * NQB) break;
        const int J = NQB - 1 - t / 32, bh = t % 32; attn_wg_task<true>(F, l, bh >> 2, bh & 3, J, bt, 0.f, 1.f); }
}

#ifndef MK_ONE
#define MK_ONE 0
#endif
#ifndef BR_MASK
#define BR_MASK 15
#endif
constexpr int NPH = 18;
template <class T> __device__ __forceinline__ T opaque(T v) { asm volatile("" : "+s"(v)); return v; }
struct Args { const float* in[22]; float* out; unsigned char* ws; int ph_lo, ph_hi; };
__global__ void __launch_bounds__(NWAVES * 64, 2) fwd(Args args) {
    extern __shared__ __attribute__((aligned(16))) unsigned char lds[];
    Frame F;
    F.lds = (LAS unsigned char*)lds; F.MISC = (volatile LAS unsigned*)(F.lds + MISC_OFF);
    F.tid = threadIdx.x; F.lane = F.tid & 63; F.wave = __builtin_amdgcn_readfirstlane(F.tid >> 6); F.G = gridDim.x; F.bid = blockIdx.x;
    F.ws = args.ws; F.out = args.out; F.ctl = (gu32*)(args.ws + WS_CTL);
    F.karg = (const unsigned char __attribute__((address_space(4)))*)__builtin_amdgcn_kernarg_segment_ptr();
    for (int u = F.tid; u < (LDS_BYTES - LDSCTL_OFF) / 4; u += NWAVES * 64) ((LAS unsigned*)(F.lds + LDSCTL_OFF))[u] = 0u;
    __syncthreads();
#if MK_ONE
    XcdBarrier bar = xcd_barrier_post((unsigned*)(F.ctl + CW_BAR), F.MISC + 8, __builtin_amdgcn_readfirstlane(threadIdx.x >> 6));
#ifdef PROBE_BAR2
#define GRID_BAR() do { xcd_barrier(bar); xcd_barrier(bar); } while (0)
#else
#define GRID_BAR() xcd_barrier(bar)
#endif
#else
#define GRID_BAR() do { } while (0)
#endif
    const int wave_s = __builtin_amdgcn_readfirstlane(threadIdx.x >> 6);
    const int lo = args.ph_lo, hi = args.ph_hi;
#define IN(k) (lo <= (k) && (k) < hi)
#define RETID() do { int w_ = wave_s; asm volatile("" : "+s"(w_)); unsigned mk_ = ~0u; asm volatile("" : "+s"(mk_)); int t_ = w_ * 64 + (int)__builtin_amdgcn_mbcnt_hi(mk_, __builtin_amdgcn_mbcnt_lo(mk_, 0u)); asm volatile("" : "+v"(t_)); F.tid = t_; F.lane = t_ & 63; F.wave = w_; } while (0)
#ifdef DBG_TS
#define STAMP(k) do { if (blockIdx.x == 0 && threadIdx.x == 0) ((unsigned long long*)(args.ws + 768 * 1024))[(k)] = __builtin_amdgcn_s_memrealtime(); } while (0)
#else
#define STAMP(k) do { } while (0)
#endif
#define SEAM(k) do { if (IN((k) + 1)) GRID_BAR(); STAMP((k) + 1); } while (0)
#ifndef PROBE_EPI
#define PROBE_EPI 0
#endif
#ifdef PROBE_MASK
#define NREP(kk) opaque(((PROBE_MASK >> (kk)) & 1) ? 1 + PROBE_EXTRA : 1)
#define REP_BEGIN(kk) { const int nrep_ = NREP(kk); for (int rep = 0; rep < nrep_; ++rep) { if (rep) GRID_BAR();
#define REP_END } }
#else
#define REP_BEGIN(kk) { { const int rep = 0; (void)rep;
#define REP_END } }
#endif
    STAMP(0);
    unsigned char* wb = F.ws + WS_W;
    bf16* XN = (bf16*)(F.ws + WS_XN); bf16* BR = (bf16*)(F.ws + WS_BR); bf16* BIG = (bf16*)(F.ws + WS_BIG); float* HM = (float*)(F.ws + WS_HM);
    auto layer = [&](const int l) __attribute__((always_inline)) {
        const int pb = l * NPH;
        const float* hsrc = (l == 0) ? FIN(F, I_X) : F.out;
        if (IN(pb + 0)) { REP_BEGIN(0) RETID(); phase_convert(F, l); REP_END SEAM(pb + 0); }
        if (IN(pb + 1)) { REP_BEGIN(1) RETID(); phase_norm(F, hsrc, FIN(F, I_F1N) + l * DM); REP_END SEAM(pb + 1); }
        if (IN(pb + 2)) { REP_BEGIN(2) RETID(); meta_gemm(F, 0, XN + (size_t)MREAL * DM, DM, (const bf16*)(wb + W_GU1), NGU, DM, BIG, DFF, 0.f); pg8::Gemm g{opaque((const bf16*)(XN)), opaque((const bf16*)(wb + W_GU1)), MREAL, NGU, DM}; pg8::StaticOrder S; S.init(MREAL, NGU, F.G, opaque(F.bid));
            pg8::EpiSwiGLU E{BIG, DFF, rep ? PROBE_EPI : 0}; pg8::gemm_phase<pg8::EpiSwiGLU, pg8::StaticOrder, true, true>(F.lds + RING_OFF, g, S, E, F.tid); REP_END SEAM(pb + 2); }
        if (IN(pb + 3)) { REP_BEGIN(3) RETID(); meta_gemm(F, 1, BIG + (size_t)MREAL * DFF, DFF, (const bf16*)(wb + W_D1), DM, DFF, nullptr, 0, rep ? 0.f : 0.5f); pg8::Gemm g{opaque((const bf16*)(BIG)), opaque((const bf16*)(wb + W_D1)), MREAL, DM, DFF}; pg8::StaticOrder S; S.init(MREAL, DM, F.G, opaque(F.bid));
            pg8::EpiResF32 E{rep ? F.out : hsrc, F.out, HM, DM, MT_REAL, rep ? 0.f : 0.5f}; pg8::gemm_phase<pg8::EpiResF32, pg8::StaticOrder, true, true>(F.lds + RING_OFF, g, S, E, F.tid); REP_END SEAM(pb + 3); }
        if (IN(pb + 4)) { REP_BEGIN(4) RETID(); phase_norm(F, F.out, FIN(F, I_MIXN) + l * DM); REP_END SEAM(pb + 4); }
        if (IN(pb + 5)) { REP_BEGIN(5) RETID(); meta_gemm(F, 2, XN + (size_t)MREAL * DM, DM, (const bf16*)(wb + W_NG), NNG, DM, BIG, NNG, 0.f); pg8::Gemm g{opaque((const bf16*)(XN)), opaque((const bf16*)(wb + W_NG)), MREAL, NNG, DM}; pg8::StaticOrder S; S.init(MREAL, NNG, F.G, opaque(F.bid));
            pg8::EpiBf16<0> E{BIG, NNG}; pg8::gemm_phase<pg8::EpiBf16<0>, pg8::StaticOrder, true, true>(F.lds + RING_OFF, g, S, E, F.tid); REP_END SEAM(pb + 5); }
        if (IN(pb + 6)) { RETID(); phase_prep(F, l); phase_vt(F); __syncthreads(); phase_hgrn_prep(F, l); SEAM(pb + 6); }
#ifdef DUP_MIX
        if (IN(pb + 7)) { const int nrep = opaque(DUP_MIX1); for (int rep = 0; rep < nrep; ++rep) { RETID(); phase_mix1(F, l, 4 * rep + 2 * l); GRID_BAR(); } }
        if (IN(pb + 8)) { const int nrep = opaque(DUP_MIX2); for (int rep = 0; rep < nrep; ++rep) { RETID(); phase_mix2(F, l, 4 * rep + 2 * l + 1); GRID_BAR(); } }
#else
        if (IN(pb + 7)) { RETID(); phase_mix1(F, l, 2 * l); SEAM(pb + 7); }
        if (IN(pb + 8)) { RETID(); phase_mix2(F, l, 2 * l + 1); SEAM(pb + 8); }
#endif
        if (IN(pb + 9)) { REP_BEGIN(9) RETID(); meta_gemm(F, 3, XN + (size_t)MREAL * DM, DM, (const bf16*)(wb + W_G), NGATE, DM, BIG, NGATE, 0.f); pg8::Gemm g{opaque((const bf16*)(XN)), opaque((const bf16*)(wb + W_G)), MREAL, NGATE, DM}; pg8::StaticOrder S; S.init(MREAL, NGATE, F.G, opaque(F.bid));
            pg8::EpiBf16<1> E{BIG, NGATE}; pg8::gemm_phase<pg8::EpiBf16<1>, pg8::StaticOrder, true, true>(F.lds + RING_OFF, g, S, E, F.tid); REP_END SEAM(pb + 9); }
        if (IN(pb + 10)) { REP_BEGIN(10) RETID(); meta_gemm(F, 4, BR + (size_t)MREAL * 512, 512, (const bf16*)(wb + W_BR), DM, 512, XN, DM, 0.f);
            pg8::Gemm g{opaque((const bf16*)(BR)), opaque((const bf16*)(wb + W_BR)), MREAL, DM, 512}; pg8::MergeOrder S; S.init(MREAL, DM, F.G, opaque(F.bid), MPAD / 256);
            pg8::EpiGateAccM E{XN, DM, BIG, NGATE, MPAD / 256, DM / 256}; pg8::gemm_phase<pg8::EpiGateAccM, pg8::MergeOrder, true, true>(F.lds + RING_OFF, g, S, E, F.tid); REP_END SEAM(pb + 10); }
        if (IN(pb + 14) && BR_MASK) { REP_BEGIN(14) RETID(); meta_gemm(F, 1, XN + (size_t)MREAL * DM, DM, (const bf16*)(wb + W_O), DM, DM, nullptr, 0, rep ? 0.f : 1.0f); pg8::Gemm g{opaque((const bf16*)(XN)), opaque((const bf16*)(wb + W_O)), MREAL, DM, DM}; pg8::StaticOrder S; S.init(MREAL, DM, F.G, opaque(F.bid));
            pg8::EpiResF32 E{F.out, F.out, HM, DM, MT_REAL, rep ? 0.f : 1.0f}; pg8::gemm_phase<pg8::EpiResF32, pg8::StaticOrder, true, true>(F.lds + RING_OFF, g, S, E, F.tid); REP_END SEAM(pb + 14); }
        if (IN(pb + 15)) { REP_BEGIN(15) RETID(); phase_norm(F, F.out, FIN(F, I_F2N) + l * DM); REP_END SEAM(pb + 15); }
        if (IN(pb + 16)) { REP_BEGIN(16) RETID(); meta_gemm(F, 0, XN + (size_t)MREAL * DM, DM, (const bf16*)(wb + W_GU2), NGU, DM, BIG, DFF, 0.f); pg8::Gemm g{opaque((const bf16*)(XN)), opaque((const bf16*)(wb + W_GU2)), MREAL, NGU, DM}; pg8::StaticOrder S; S.init(MREAL, NGU, F.G, opaque(F.bid));
            pg8::EpiSwiGLU E{BIG, DFF, rep ? PROBE_EPI : 0}; pg8::gemm_phase<pg8::EpiSwiGLU, pg8::StaticOrder, true, true>(F.lds + RING_OFF, g, S, E, F.tid); REP_END SEAM(pb + 16); }
        if (IN(pb + 17)) { REP_BEGIN(17) RETID(); meta_gemm(F, 1, BIG + (size_t)MREAL * DFF, DFF, (const bf16*)(wb + W_D2), DM, DFF, nullptr, 0, rep ? 0.f : 0.5f); pg8::Gemm g{opaque((const bf16*)(BIG)), opaque((const bf16*)(wb + W_D2)), MREAL, DM, DFF}; pg8::StaticOrder S; S.init(MREAL, DM, F.G, opaque(F.bid));
            pg8::EpiResF32 E{F.out, F.out, HM, DM, MT_REAL, rep ? 0.f : 0.5f}; pg8::gemm_phase<pg8::EpiResF32, pg8::StaticOrder, true, true>(F.lds + RING_OFF, g, S, E, F.tid); REP_END SEAM(pb + 17); }
    };
    layer(0); layer(1);
}

extern "C" void kernel_launch(void* const* d_in, const int* in_sizes, int n_in, void* d_out, int out_size, void* d_ws, size_t ws_size, hipStream_t stream) {
    static int grid = 0;
    if (grid == 0) {
        if (n_in != 22 || out_size != MREAL * DM || ws_size < WS_END) { fprintf(stderr, "kernel_launch: unexpected shapes (n_in %d out %d ws %zu need %zu)\n", n_in, out_size, ws_size, (size_t)WS_END); grid = -1; return; }
        int dev = 0, cus = 0, per_cu = 0;
        if (hipGetDevice(&dev) != hipSuccess || hipDeviceGetAttribute(&cus, hipDeviceAttributeMultiprocessorCount, dev) != hipSuccess) { grid = -1; return; }
        if (hipFuncSetAttribute((const void*)fwd, hipFuncAttributeMaxDynamicSharedMemorySize, LDS_BYTES) != hipSuccess) { fprintf(stderr, "kernel_launch: hipFuncSetAttribute failed\n"); grid = -1; return; }
        if (hipOccupancyMaxActiveBlocksPerMultiprocessor(&per_cu, (const void*)fwd, NWAVES * 64, LDS_BYTES) != hipSuccess || per_cu < 1) fprintf(stderr, "kernel_launch: occupancy query says %d\n", per_cu);
        (void)hipGetLastError();
        grid = cus < 256 ? cus : 256;
    }
    if (grid < 0) return;
    (void)hipMemsetAsync((char*)d_ws + WS_CTL, 0, CTL_ZERO_BYTES, stream);
    Args a{};
    for (int i = 0; i < 22; ++i) a.in[i] = (const float*)d_in[i];
    a.out = (float*)d_out; a.ws = (unsigned char*)d_ws;
#ifndef PH_END
#define PH_END (2 * NPH)
#endif
#if MK_ONE
    a.ph_lo = 0; a.ph_hi = PH_END;
    hipLaunchKernelGGL(fwd, dim3(grid), dim3(NWAVES * 64), LDS_BYTES, stream, a);
#else
    for (int p = 0; p < PH_END; ++p) { a.ph_lo = p; a.ph_hi = p + 1;
        hipLaunchKernelGGL(fwd, dim3(grid), dim3(NWAVES * 64), LDS_BYTES, stream, a); }
#endif
}
```

```cpp
#include <hip/hip_runtime.h>
#include <cstdio>
#include <cstdint>
#define MK_ONE 1
namespace pg8 {
#define PG8_LAS __attribute__((address_space(3)))
typedef unsigned short bf16_t;
typedef short bf16x8 __attribute__((ext_vector_type(8)));
typedef float f32x4 __attribute__((ext_vector_type(4)));
typedef unsigned u32x4 __attribute__((ext_vector_type(4)));
constexpr int BM = 256, BK = 64, HALF = 128, HTB = HALF * BK * 2  , STAGE_BYTES = 8 * HTB, NXCD = 8, WGM = 8;

__host__ __device__ __forceinline__ int lds_byte(int r, int c) { const int st = (r >> 4) * 2 + (c >> 5), rr = r & 15, cc = c & 31, ob = rr * 64 + cc * 2; return st * 1024 + (ob ^ (((ob >> 9) & 1) << 5)); }
__host__ __device__ __forceinline__ void stage_rc(int b, int& R, int& C) { const int st = b / 1024, sb = b % 1024, swz = sb ^ (((sb >> 9) & 1) << 5); R = (st >> 1) * 16 + swz / 64; C = (st & 1) * 32 + (swz % 64) / 2; }
__host__ __device__ __forceinline__ int perm32(int rho) { const int n = rho >> 4, i = rho & 15; return 8 * (i >> 2) + 4 * n + (i & 3); }

struct Unit { int pm, pn; };
struct Gemm { const bf16_t* A; const bf16_t* Bt; int M, N, K; };

struct StaticOrder {
    int nM, nN, nwg, G, c;
    __host__ __device__ void init(int M, int N, int G_, int c_) { nM = M / BM; nN = N / BM; nwg = nM * nN; G = G_; c = c_; }
    __host__ __device__ bool next(int i, Unit& u) const {
        const long L = (long)i * G + c; if (L >= nwg) return false;
        int wgid = (int)L; { const int q = nwg / NXCD, r = nwg % NXCD, xcd = wgid % NXCD, off = wgid / NXCD; wgid = (xcd < r ? xcd * (q + 1) : r * (q + 1) + (xcd - r) * q) + off; }
        const int nig = WGM * nN, gid = wgid / nig, fm = gid * WGM, gsz = (nM - fm) < WGM ? (nM - fm) : WGM;
        u.pm = fm + ((wgid % nig) % gsz); u.pn = (wgid % nig) / gsz; return true;
    }
    __device__ __forceinline__ void a_ready(const Unit&) const {}
    __device__ __forceinline__ void done(const Unit&) const {}
};
typedef __bf16 bf16x2_hw __attribute__((ext_vector_type(2))); typedef float f32x2_hw __attribute__((ext_vector_type(2)));
__device__ __forceinline__ unsigned cvt_pk_bf16(float lo, float hi) { const f32x2_hw v = {lo, hi}; return __builtin_bit_cast(unsigned, __builtin_convertvector(v, bf16x2_hw)); }
typedef float f32x2 __attribute__((ext_vector_type(2)));
__device__ __forceinline__ float fast_sigmoid(float x) { return __builtin_amdgcn_rcpf(1.0f + __expf(-x)); }
__device__ __forceinline__ float fast_silu(float x) { return x * fast_sigmoid(x); }
template <int ACT  > struct EpiBf16 {
    static constexpr bool PERM = true, AFTER_DRAIN = false;
    bf16_t* O; int ldc;
    __device__ __forceinline__ void operator()(const f32x4 (&acc)[2][2][4][2], const Unit& u, int wr, int wc, int fr, int fq) const {
        const int row0 = u.pm * BM + wr * 64 + fr; const int col0 = u.pn * BM + wc * 32 + 8 * fq;
#pragma unroll
        for (int ai = 0; ai < 2; ++ai)
#pragma unroll
            for (int m = 0; m < 4; ++m) { bf16_t* rowp = O + (size_t)(row0 + ai * HALF + m * 16) * ldc + col0;
#pragma unroll
                for (int bj = 0; bj < 2; ++bj) { f32x4 v0 = acc[ai][bj][m][0], v1 = acc[ai][bj][m][1];
                    if (ACT == 1) {
#pragma unroll
                        for (int j = 0; j < 4; ++j) { v0[j] = fast_sigmoid(v0[j]); v1[j] = fast_sigmoid(v1[j]); } }
                    u32x4 w; w.x = cvt_pk_bf16(v0[0], v0[1]); w.y = cvt_pk_bf16(v0[2], v0[3]); w.z = cvt_pk_bf16(v1[0], v1[1]); w.w = cvt_pk_bf16(v1[2], v1[3]);
                    *(u32x4*)(rowp + bj * HALF) = w; } }
    }
};
struct EpiSwiGLU {
    static constexpr bool PERM = true, AFTER_DRAIN = false;
    bf16_t* O; int ldc; int mode;
    __device__ __forceinline__ void operator()(const f32x4 (&acc)[2][2][4][2], const Unit& u, int wr, int wc, int fr, int fq) const {
        if (mode == 2) return;
        const int row0 = u.pm * BM + wr * 64 + fr; const int col0 = u.pn * HALF + wc * 32 + 8 * fq;
#pragma unroll
        for (int ai = 0; ai < 2; ++ai)
#pragma unroll
            for (int m = 0; m < 4; ++m) { bf16_t* rowp = O + (size_t)(row0 + ai * HALF + m * 16) * ldc + col0;
                const f32x4 g0 = acc[ai][0][m][0], g1 = acc[ai][0][m][1], u0 = acc[ai][1][m][0], u1 = acc[ai][1][m][1];
                f32x4 v0, v1;
#pragma unroll
                for (int j = 0; j < 4; ++j) { v0[j] = fast_silu(g0[j]) * u0[j]; v1[j] = fast_silu(g1[j]) * u1[j]; }
                u32x4 w; w.x = cvt_pk_bf16(v0[0], v0[1]); w.y = cvt_pk_bf16(v0[2], v0[3]); w.z = cvt_pk_bf16(v1[0], v1[1]); w.w = cvt_pk_bf16(v1[2], v1[3]);
                if (mode == 0) *(u32x4*)rowp = w; else asm volatile("" :: "v"(w.x), "v"(w.y), "v"(w.z), "v"(w.w));
                asm volatile("" ::: "memory"); }
    }
};
struct EpiResF32 {
    static constexpr bool PERM = false, AFTER_DRAIN = false;
    const float* base_r; float* out_r; float* hm; int ldc; int mt_real; float scale;
    __device__ __forceinline__ void operator()(const f32x4 (&acc)[2][2][4][2], const Unit& u, int wr, int wc, int fr, int fq) const {
        const bool real = u.pm < mt_real;
        const float* bp = real ? base_r + (size_t)u.pm * BM * ldc : hm; float* op = real ? out_r + (size_t)u.pm * BM * ldc : hm;
        const int row0 = wr * 64 + fr, col0 = u.pn * BM + wc * 32 + 4 * fq;
#pragma unroll
        for (int ai = 0; ai < 2; ++ai) {
            f32x4 b[4][2][2];
#pragma unroll
            for (int m = 0; m < 4; ++m) { const size_t off = (size_t)(row0 + ai * HALF + m * 16) * ldc + col0;
#pragma unroll
                for (int bj = 0; bj < 2; ++bj)
#pragma unroll
                    for (int n = 0; n < 2; ++n) b[m][bj][n] = *(const f32x4*)(bp + off + bj * HALF + n * 16); }
            asm volatile("" ::: "memory");
#pragma unroll
            for (int m = 0; m < 4; ++m) { const size_t off = (size_t)(row0 + ai * HALF + m * 16) * ldc + col0;
#pragma unroll
                for (int bj = 0; bj < 2; ++bj)
#pragma unroll
                    for (int n = 0; n < 2; ++n) *(f32x4*)(op + off + bj * HALF + n * 16) = b[m][bj][n] + acc[ai][bj][m][n] * scale; }
            asm volatile("" ::: "memory"); }
    }
};
struct EpiGateAcc {
    static constexpr bool PERM = true, AFTER_DRAIN = false;
    bf16_t* MG; int ldc; const bf16_t* G; int ldg; int gcol0; int first;
    __device__ __forceinline__ void operator()(const f32x4 (&acc)[2][2][4][2], const Unit& u, int wr, int wc, int fr, int fq) const {
        const int row0 = u.pm * BM + wr * 64 + fr; const int col0 = u.pn * BM + wc * 32 + 8 * fq;
#pragma unroll
        for (int ai = 0; ai < 2; ++ai)
#pragma unroll
            for (int m = 0; m < 4; ++m) { const size_t r = (size_t)(row0 + ai * HALF + m * 16);
#pragma unroll
                for (int bj = 0; bj < 2; ++bj) { const u32x4 gw = *(const u32x4*)(G + r * ldg + gcol0 + col0 + bj * HALF);
                    u32x4 pw = (u32x4){0u, 0u, 0u, 0u}; if (!first) pw = *(const u32x4*)(MG + r * ldc + col0 + bj * HALF);
                    float o[8];
#pragma unroll
                    for (int j = 0; j < 4; ++j) { const float a0 = (j < 2) ? acc[ai][bj][m][0][2 * j] : acc[ai][bj][m][1][2 * (j - 2)], a1 = (j < 2) ? acc[ai][bj][m][0][2 * j + 1] : acc[ai][bj][m][1][2 * (j - 2) + 1];
                        o[2 * j] = __uint_as_float(pw[j] << 16) + __uint_as_float(gw[j] << 16) * a0; o[2 * j + 1] = __uint_as_float(pw[j] & 0xffff0000u) + __uint_as_float(gw[j] & 0xffff0000u) * a1; }
                    u32x4 w; w.x = cvt_pk_bf16(o[0], o[1]); w.y = cvt_pk_bf16(o[2], o[3]); w.z = cvt_pk_bf16(o[4], o[5]); w.w = cvt_pk_bf16(o[6], o[7]);
                    *(u32x4*)(MG + r * ldc + col0 + bj * HALF) = w; } }
    }
};

struct MergeOrder {
    int nM, nN, G, c, mt_alloc;
    __host__ __device__ void init(int M, int N, int G_, int c_, int mt_alloc_) { nM = M / BM; nN = N / BM; G = G_; c = c_; mt_alloc = mt_alloc_; }
    __host__ __device__ bool next(int i, Unit& u) const { const int t = (i >> 2) * G + c, m = i & 3; if (t >= nM * nN) return false;
        const int pm = t / nN, pn = t % nN; u.pm = m * mt_alloc + pm; u.pn = m * nN + pn; return true; }
    __device__ __forceinline__ void a_ready(const Unit&) const {}
    __device__ __forceinline__ void done(const Unit&) const {}
};
struct EpiGateAccM {
    static constexpr bool PERM = true, AFTER_DRAIN = false;
    bf16_t* MG; int ldc; const bf16_t* G; int ldg; int mt_alloc; int ntn;
    __device__ __forceinline__ void operator()(const f32x4 (&acc)[2][2][4][2], const Unit& u, int wr, int wc, int fr, int fq) const {
        const int m = u.pm / mt_alloc, pm = u.pm - m * mt_alloc, pn = u.pn - m * ntn;
        const int row0 = pm * BM + wr * 64 + fr; const int col0 = pn * BM + wc * 32 + 8 * fq; const int gcol0 = m * ntn * BM;
#pragma unroll
        for (int ai = 0; ai < 2; ++ai)
#pragma unroll
            for (int mm = 0; mm < 4; ++mm) { const size_t r = (size_t)(row0 + ai * HALF + mm * 16);
#pragma unroll
                for (int bj = 0; bj < 2; ++bj) { const u32x4 gw = *(const u32x4*)(G + r * ldg + gcol0 + col0 + bj * HALF);
                    u32x4 pw = (u32x4){0u, 0u, 0u, 0u}; if (m != 0) pw = *(const u32x4*)(MG + r * ldc + col0 + bj * HALF);
                    float o[8];
#pragma unroll
                    for (int j = 0; j < 4; ++j) { const float a0 = (j < 2) ? acc[ai][bj][mm][0][2 * j] : acc[ai][bj][mm][1][2 * (j - 2)], a1 = (j < 2) ? acc[ai][bj][mm][0][2 * j + 1] : acc[ai][bj][mm][1][2 * (j - 2) + 1];
                        o[2 * j] = __uint_as_float(pw[j] << 16) + __uint_as_float(gw[j] << 16) * a0; o[2 * j + 1] = __uint_as_float(pw[j] & 0xffff0000u) + __uint_as_float(gw[j] & 0xffff0000u) * a1; }
                    u32x4 w; w.x = cvt_pk_bf16(o[0], o[1]); w.y = cvt_pk_bf16(o[2], o[3]); w.z = cvt_pk_bf16(o[4], o[5]); w.w = cvt_pk_bf16(o[6], o[7]);
                    *(u32x4*)(MG + r * ldc + col0 + bj * HALF) = w; } }
    }
};
template <class Epi, class Sched, bool ALIGN_EPI = false, bool SP2 = false>
__device__ __forceinline__ void gemm_phase(PG8_LAS unsigned char* lds, const Gemm g, const Sched& S, const Epi& E, int tid_in) {
    int tid_ = tid_in; asm volatile("" : "+v"(tid_));
    const int tid = tid_, wid = __builtin_amdgcn_readfirstlane(tid >> 6), lane = tid & 63, wr = wid >> 2, wc = wid & 3, fr = lane & 15, fq = lane >> 4;
    const int K = g.K, nt = K / BK;
    unsigned voffA[2], voffB[2];
#pragma unroll
    for (int i = 0; i < 2; ++i) { int R, C; stage_rc(tid * 16 + i * 8192, R, C); const int Rb = Epi::PERM ? ((R & ~31) + perm32(R & 31)) : R;
        voffA[i] = (unsigned)(R * K + C) * 2u; voffB[i] = (unsigned)(Rb * K + C) * 2u; }
    const size_t kstep = (size_t)(BK * 2);
    const size_t hstep = (size_t)HALF * K * 2;
    const size_t tstep = 2 * hstep;
    const unsigned ldsw = (unsigned)wid * 1024u;
    const int aoff = lds_byte(wr * 64 + fr, fq * 8), boff = lds_byte(wc * 32 + fr, fq * 8);
#define PG8_SA(b, h) (((b) * 2 + (h)) * HTB)
#define PG8_SB(b, h) ((4 + (b) * 2 + (h)) * HTB)
#define PG8_STAGE(bufoff, gbase, voff) do { _Pragma("unroll") for (int _i = 0; _i < 2; ++_i) \
        __builtin_amdgcn_global_load_lds((const unsigned*)((const char*)(gbase) + (voff)[_i]), (PG8_LAS unsigned*)(lds + (bufoff) + ldsw + _i * 8192), 16, 0, 0); } while (0)
#define PG8_LDA(dst, b, h) do { _Pragma("unroll") for (int m = 0; m < 4; ++m) _Pragma("unroll") for (int k = 0; k < 2; ++k) dst[m][k] = *(const PG8_LAS bf16x8*)(lds + PG8_SA(b, h) + aoff + m * 2048 + k * 1024); } while (0)
#define PG8_LDB(dst, b, h) do { _Pragma("unroll") for (int n = 0; n < 2; ++n) _Pragma("unroll") for (int k = 0; k < 2; ++k) dst[n][k] = *(const PG8_LAS bf16x8*)(lds + PG8_SB(b, h) + boff + n * 2048 + k * 1024); } while (0)
#define PG8_MMA(ai, bj, At, Bt) do { __builtin_amdgcn_s_setprio(1); _Pragma("unroll") for (int m = 0; m < 4; ++m) _Pragma("unroll") for (int n = 0; n < 2; ++n) _Pragma("unroll") for (int k = 0; k < 2; ++k) \
        acc[ai][bj][m][n] = __builtin_amdgcn_mfma_f32_16x16x32_bf16(Bt[n][k], At[m][k], acc[ai][bj][m][n], 0, 0, 0); __builtin_amdgcn_s_setprio(0); } while (0)
#define PG8_WAIT_V(n) asm volatile("s_waitcnt vmcnt(" #n ")" ::: "memory")
#define PG8_WAIT_L(n) asm volatile("s_waitcnt lgkmcnt(" #n ")" ::: "memory")
#define PG8_BAR __builtin_amdgcn_s_barrier()
#define PG8_SCHED __builtin_amdgcn_sched_barrier(0)
    Unit cur, nxt; int ui = 0;
    if (!S.next(0, cur)) return;
    f32x4 acc[2][2][4][2];
#pragma unroll
    for (int a = 0; a < 2; ++a)
#pragma unroll
        for (int b = 0; b < 2; ++b)
#pragma unroll
            for (int m = 0; m < 4; ++m)
#pragma unroll
                for (int n = 0; n < 2; ++n) acc[a][b][m][n] = (f32x4){0.f, 0.f, 0.f, 0.f};
    bf16x8 At[4][2], B0[2][2], B1[2][2];
    const char* cA = (const char*)g.A + (size_t)cur.pm * tstep; const char* cB = (const char*)g.Bt + (size_t)cur.pn * tstep;
    S.a_ready(cur);
    if constexpr (SP2) {
        PG8_STAGE(PG8_SB(0, 0), cB, voffB); PG8_STAGE(PG8_SB(0, 1), cB + hstep, voffB); PG8_STAGE(PG8_SA(0, 0), cA, voffA); PG8_STAGE(PG8_SA(0, 1), cA + hstep, voffA);
        if (wr == 1) PG8_BAR;
        PG8_WAIT_V(2); PG8_BAR;
        PG8_STAGE(PG8_SB(1, 0), cB + kstep, voffB); PG8_STAGE(PG8_SA(1, 0), cA + kstep, voffA); PG8_STAGE(PG8_SB(1, 1), cB + hstep + kstep, voffB);
        PG8_WAIT_V(6); PG8_BAR;
    } else {
        PG8_STAGE(PG8_SB(0, 0), cB, voffB); PG8_STAGE(PG8_SA(0, 0), cA, voffA); PG8_STAGE(PG8_SB(0, 1), cB + hstep, voffB); PG8_STAGE(PG8_SA(0, 1), cA + hstep, voffA);
        if (wr == 1) PG8_BAR;
        PG8_WAIT_V(4); PG8_BAR;
        PG8_STAGE(PG8_SB(1, 0), cB + kstep, voffB); PG8_STAGE(PG8_SA(1, 0), cA + kstep, voffA); PG8_STAGE(PG8_SB(1, 1), cB + hstep + kstep, voffB);
        PG8_WAIT_V(6); PG8_BAR;
    }
    for (;;) {
        const bool has_next = S.next(ui + 1, nxt);
        const char* nA = has_next ? (const char*)g.A + (size_t)nxt.pm * tstep : cA; const char* nB = has_next ? (const char*)g.Bt + (size_t)nxt.pn * tstep : cB;
        for (int t = 0; t < nt; t += 2) {
            const bool last = (t == nt - 2);
            const char* a1 = cA + (size_t)(t + 1) * kstep;
            const char* a2 = last ? nA : cA + (size_t)(t + 2) * kstep; const char* b2 = last ? nB : cB + (size_t)(t + 2) * kstep;
            const char* a3 = a2 + kstep; const char* b3 = b2 + kstep;
            if (last && has_next) S.a_ready(nxt);
            if constexpr (SP2) {
            PG8_LDB(B0, 0, 0); PG8_LDB(B1, 0, 1); PG8_SCHED; PG8_LDA(At, 0, 0); PG8_STAGE(PG8_SA(1, 1), a1 + hstep, voffA);
            PG8_WAIT_V(8); PG8_WAIT_L(0); PG8_BAR; PG8_MMA(0, 0, At, B0); PG8_MMA(0, 1, At, B1); PG8_BAR; PG8_SCHED;
            PG8_LDA(At, 0, 1); PG8_STAGE(PG8_SB(0, 0), b2, voffB); PG8_STAGE(PG8_SB(0, 1), b2 + hstep, voffB); PG8_STAGE(PG8_SA(0, 0), a2, voffA);
            PG8_WAIT_V(8); PG8_WAIT_L(0); PG8_BAR; PG8_MMA(1, 0, At, B0); PG8_MMA(1, 1, At, B1); PG8_BAR; PG8_SCHED;
            PG8_LDB(B0, 1, 0); PG8_LDB(B1, 1, 1); PG8_SCHED; PG8_LDA(At, 1, 0); PG8_STAGE(PG8_SA(0, 1), a2 + hstep, voffA);
            PG8_WAIT_V(8); PG8_WAIT_L(0); PG8_BAR; PG8_MMA(0, 0, At, B0); PG8_MMA(0, 1, At, B1); PG8_BAR; PG8_SCHED;
            PG8_LDA(At, 1, 1); PG8_STAGE(PG8_SB(1, 0), b3, voffB); PG8_STAGE(PG8_SB(1, 1), b3 + hstep, voffB); PG8_STAGE(PG8_SA(1, 0), a3, voffA);
            PG8_WAIT_V(8); PG8_WAIT_L(0); PG8_BAR; PG8_MMA(1, 0, At, B0); PG8_MMA(1, 1, At, B1); PG8_BAR; PG8_SCHED;
            } else {
            PG8_LDB(B0, 0, 0); PG8_SCHED; PG8_LDA(At, 0, 0); PG8_STAGE(PG8_SA(1, 1), a1 + hstep, voffA);
            PG8_WAIT_L(8); PG8_BAR; PG8_WAIT_L(0); PG8_MMA(0, 0, At, B0); PG8_BAR; PG8_SCHED;
            PG8_LDB(B1, 0, 1); PG8_STAGE(PG8_SB(0, 0), b2, voffB);
            PG8_BAR; PG8_WAIT_L(0); PG8_MMA(0, 1, At, B1); PG8_BAR;
            PG8_LDA(At, 0, 1); PG8_STAGE(PG8_SA(0, 0), a2, voffA);
            PG8_BAR; PG8_WAIT_L(0); PG8_MMA(1, 0, At, B0); PG8_BAR; PG8_SCHED;
            PG8_STAGE(PG8_SB(0, 1), b2 + hstep, voffB);
            PG8_WAIT_V(6); PG8_BAR; PG8_MMA(1, 1, At, B1); PG8_BAR;
            PG8_LDB(B0, 1, 0); PG8_SCHED; PG8_LDA(At, 1, 0); PG8_STAGE(PG8_SA(0, 1), a2 + hstep, voffA);
            PG8_WAIT_L(8); PG8_BAR; PG8_WAIT_L(0); PG8_MMA(0, 0, At, B0); PG8_BAR; PG8_SCHED;
            PG8_LDB(B1, 1, 1); PG8_STAGE(PG8_SB(1, 0), b3, voffB);
            PG8_BAR; PG8_WAIT_L(0); PG8_MMA(0, 1, At, B1); PG8_BAR;
            PG8_LDA(At, 1, 1); PG8_STAGE(PG8_SA(1, 0), a3, voffA);
            PG8_BAR; PG8_WAIT_L(0); PG8_MMA(1, 0, At, B0); PG8_BAR; PG8_SCHED;
            PG8_STAGE(PG8_SB(1, 1), b3 + hstep, voffB);
            PG8_WAIT_V(6); PG8_BAR; PG8_MMA(1, 1, At, B1); PG8_BAR;
            }
        }
        if constexpr (ALIGN_EPI) { if (wr == 0) PG8_BAR; }
        if constexpr (!Epi::AFTER_DRAIN) { E(acc, cur, wr, wc, fr, fq); S.done(cur); }
        if (!has_next) break;
#pragma unroll
        for (int a = 0; a < 2; ++a)
#pragma unroll
            for (int b = 0; b < 2; ++b)
#pragma unroll
                for (int m = 0; m < 4; ++m)
#pragma unroll
                    for (int n = 0; n < 2; ++n) acc[a][b][m][n] = (f32x4){0.f, 0.f, 0.f, 0.f};
        cur = nxt; cA = nA; cB = nB; ++ui;
        if constexpr (ALIGN_EPI) { if (wr == 1) PG8_BAR; }
    }
    PG8_WAIT_V(0);
    if constexpr (!ALIGN_EPI) { if (wr == 0) PG8_BAR; }
    PG8_BAR;
    if constexpr (Epi::AFTER_DRAIN) { E.fused(acc, cur, wr, wc, fr, fq, lds, wid, lane); S.done(cur); }
#undef PG8_SA
#undef PG8_SB
#undef PG8_STAGE
#undef PG8_LDA
#undef PG8_LDB
#undef PG8_MMA
#undef PG8_WAIT_V
#undef PG8_WAIT_L
#undef PG8_BAR
#undef PG8_SCHED
}
}

constexpr int DM = 2048, NB = 8, SEQ = 4096, NMETA = 16, LSEQ = 4112, LPAD = 4128;
constexpr int MREAL = NB * SEQ;
constexpr int MPAD = MREAL + 256;
constexpr int MT_REAL = MREAL / 256;
constexpr int DFF = 5632, NGU = 2 * DFF, NNG = 7168, NGATE = 8192, INCOLS = 15184, NGC = 6992;
constexpr int NWAVES = 8;
constexpr float EPS = 1e-6f;
constexpr int C_AQ = 0, C_AF = 512, C_AI = 1024, C_AG = 1536, C_BB = 2048, C_BC = 2560, C_BU = 3072, C_CQ = 3584, C_CK = 4096, C_CV = 4608,
              C_DQ = 5120, C_DK = 5632, C_DV = 5760, C_DQI = 5888, C_DKI = 6912, C_DW = 6976;

constexpr size_t MiB = 1u << 20;
constexpr size_t WS_CTL = 0, CTL_ZERO_BYTES = 1 * MiB;
constexpr size_t WS_HM = 1 * MiB;
constexpr size_t WS_W = 4 * MiB;
constexpr size_t W_GU1 = 0, W_D1 = W_GU1 + (size_t)NGU * DM * 2, W_NG = W_D1 + (size_t)DM * DFF * 2, W_G = W_NG + (size_t)NNG * DM * 2,
                 W_BR = W_G + (size_t)NGATE * DM * 2, W_O = W_BR + (size_t)4 * DM * 512 * 2, W_GU2 = W_O + (size_t)DM * DM * 2, W_D2 = W_GU2 + (size_t)NGU * DM * 2,
                 W_END = W_D2 + (size_t)DM * DFF * 2;
constexpr size_t WS_XN = WS_W + W_END;
constexpr size_t WS_BR = WS_XN + (size_t)MPAD * DM * 2;
constexpr size_t WS_BIG = WS_BR + (size_t)MPAD * DM * 2;
constexpr size_t BIG_P_END = (size_t)MPAD * NNG * 2;
constexpr size_t WS_VTC = WS_BIG + BIG_P_END;
constexpr size_t WS_VTD = WS_VTC + (size_t)NB * 4 * 128 * LPAD * 2;
constexpr size_t WS_MASK = WS_VTD + (size_t)NB * 128 * LPAD * 2;
constexpr int MASKW = 132;
constexpr int NIDX_WG = 172;
constexpr int NHG_WG = 32;
constexpr size_t WS_SCR = WS_MASK + (size_t)NB * LPAD * MASKW * 4;
constexpr size_t WS_HA = WS_SCR + (size_t)NIDX_WG * 32 * LPAD * 4;
constexpr size_t WS_HDL = WS_HA + (size_t)NB * 4 * 64 * 64 * 64 * 2;
constexpr size_t WS_HMETA = WS_HDL + (size_t)NB * 4 * 64 * 128 * 4;
constexpr size_t HMETA_STRIDE = 64 * 384 * 2 + 64 * 64 * 2 + 128 * 4;
constexpr size_t WS_END = WS_HMETA + 4 * HMETA_STRIDE;
static_assert(WS_BIG + (size_t)MPAD * NGATE * 2 <= WS_END, "G fits");
static_assert(WS_END <= (size_t)1138174976, "workspace map fits the guaranteed size");

constexpr int RING_OFF = 0, RING_BYTES = 131072;
constexpr int LDSCTL_OFF = 143360, MISC_OFF = LDSCTL_OFF + 320;
constexpr int LDS_BYTES = 147456;

#define GAS __attribute__((address_space(1)))
#define LAS __attribute__((address_space(3)))
typedef unsigned short bf16;
typedef unsigned v4u __attribute__((ext_vector_type(4)));
typedef unsigned v2u __attribute__((ext_vector_type(2)));
typedef float f32x4 __attribute__((ext_vector_type(4)));
typedef float f32x16 __attribute__((ext_vector_type(16)));
typedef short bf16x8 __attribute__((ext_vector_type(8)));
typedef GAS unsigned gu32;
#define RLX_AGENT __ATOMIC_RELAXED, __HIP_MEMORY_SCOPE_AGENT
#define LDS_WAIT() asm volatile("s_waitcnt lgkmcnt(0)" ::: "memory")
#define VM_WAIT() asm volatile("s_waitcnt vmcnt(0)" ::: "memory")
__device__ __forceinline__ unsigned f2bf(float f) { unsigned u = __builtin_bit_cast(unsigned, f); return (u + 0x7fffu + ((u >> 16) & 1u)) >> 16; }
__device__ __forceinline__ unsigned f2bf_s(float f) { return pg8::cvt_pk_bf16(f, 0.f) & 0xffffu; }
__device__ __forceinline__ unsigned pk2(float lo, float hi) { return pg8::cvt_pk_bf16(lo, hi); }
__device__ __forceinline__ float bflo(unsigned w) { return __uint_as_float(w << 16); }
__device__ __forceinline__ float bfhi(unsigned w) { return __uint_as_float(w & 0xffff0000u); }
__device__ __forceinline__ float bf2f(bf16 v) { return __uint_as_float((unsigned)v << 16); }
__device__ __forceinline__ int seqrow(int b, int p) { return p < NMETA ? MREAL + p : b * SEQ + p - NMETA; }
__device__ __forceinline__ int rel_bucket(int n) {
    if (n < 16) return n; if (n >= 128) return 31;
    const int v = 16 + (int)(__log2f((float)n * 0.0625f) * 5.33333333f); return v < 31 ? v : 31; }
__device__ __forceinline__ float wave_sum(float v) {
#pragma unroll
    for (int o = 1; o < 64; o <<= 1) v += __shfl_xor(v, o);
    return v;
}
#define XB_TMO      128
#define XB_XCNT(j)  (256  + 64 * (j))
#define XB_XSUB(j)  (1280 + 64 * (j))
#define XB_XGEN(j)  (2304 + 64 * (j))
#define XB_TOP      3328
#define XB_TOPGEN   3392
#define XCD_BAR_WORDS 3456
#define XB_SPIN_CAP (1u << 18)

__device__ __forceinline__ unsigned xb_ld(unsigned* p)              { return __hip_atomic_load(p, __ATOMIC_RELAXED, __HIP_MEMORY_SCOPE_AGENT); }
__device__ __forceinline__ unsigned xb_add(unsigned* p, unsigned v) { return __hip_atomic_fetch_add(p, v, __ATOMIC_RELAXED, __HIP_MEMORY_SCOPE_AGENT); }
__device__ __forceinline__ unsigned xb_xcc_id() { return (unsigned)__builtin_amdgcn_s_getreg((3 << 11) | 20) & 0xFu; }
#define XB_SPIN(cond, bar) do { unsigned _sp = 0; while (cond) { __builtin_amdgcn_s_sleep(1); \
    if ((++_sp & 255u) == 0u) { if (xb_ld(&(bar)[XB_TMO])) break; if (_sp > XB_SPIN_CAP) { atomicAdd(&(bar)[XB_TMO], 1u); break; } } } } while (0)

struct XcdBarrier {
    int wave;
    unsigned* bar; unsigned x;
    volatile LAS unsigned* st;
};

__device__ __forceinline__ bool xb_thread0(int wave) { unsigned mk = ~0u; asm volatile("" : "+s"(mk)); return wave == 0 && __builtin_amdgcn_mbcnt_hi(mk, __builtin_amdgcn_mbcnt_lo(mk, 0u)) == 0u; }
__device__ __forceinline__ XcdBarrier xcd_barrier_post(unsigned* bar, volatile LAS unsigned* st, int wave) {
    XcdBarrier b; b.wave = wave; b.bar = bar; b.x = xb_xcc_id(); b.st = st;
    if (xb_thread0(wave)) (void)xb_add(&bar[XB_XCNT(b.x)], 1u);
    return b;
}
__device__ __forceinline__ void xcd_barrier_complete(unsigned* bar, unsigned x, unsigned& nloc, unsigned& nx) {
    const unsigned G = gridDim.x * gridDim.y * gridDim.z;
    unsigned sum, cnt, mine, sp = 0u;
    for (;;) {
        sum = 0u; cnt = 0u; mine = 0u;
#pragma unroll
        for (unsigned j = 0; j < 16; ++j) { const unsigned c = xb_ld(&bar[XB_XCNT(j)]); sum += c; cnt += (c > 0u) ? 1u : 0u; mine = (j == x) ? c : mine; }
        if (sum == G) break;
        __builtin_amdgcn_s_sleep(1);
        if ((++sp & 255u) == 0u) { if (xb_ld(&bar[XB_TMO])) break; if (sp > XB_SPIN_CAP) { atomicAdd(&bar[XB_TMO], 1u); break; } }
    }
    nloc = mine > 0u ? mine : 1u; nx = cnt > 0u ? cnt : 1u;
}

__device__ __forceinline__ void xcd_barrier(const XcdBarrier& b) {
    asm volatile("s_waitcnt vmcnt(0)" ::: "memory");
    __syncthreads();
    if (xb_thread0(b.wave)) {
        unsigned* bar = b.bar;
        __builtin_amdgcn_s_waitcnt(0);
        unsigned nloc = b.st[0], nx = b.st[1];
        if (nloc == 0u) { xcd_barrier_complete(bar, b.x, nloc, nx); b.st[0] = nloc; b.st[1] = nx; }
        const unsigned old = xb_add(&bar[XB_XSUB(b.x)], 1u);
        const unsigned gen = old / nloc;
        if (old + 1u == (gen + 1u) * nloc) {
            __builtin_amdgcn_fence(__ATOMIC_RELEASE, "agent");
            asm volatile("s_waitcnt vmcnt(0)" ::: "memory");
            const unsigned og = xb_add(&bar[XB_TOP], 1u);
            const unsigned tg = og / nx;
            if (og + 1u == (tg + 1u) * nx) xb_add(&bar[XB_TOPGEN], 1u);
            else XB_SPIN(xb_ld(&bar[XB_TOPGEN]) == tg, bar);
            __builtin_amdgcn_fence(__ATOMIC_ACQUIRE, "agent");
            xb_add(&bar[XB_XGEN(b.x)], 1u);
            asm volatile("s_waitcnt vmcnt(0)" ::: "memory");
        } else {
            XB_SPIN(xb_ld(&bar[XB_XGEN(b.x)]) == gen, bar);
            __builtin_amdgcn_fence(__ATOMIC_ACQUIRE, "agent");
            asm volatile("s_waitcnt vmcnt(0)" ::: "memory");
        }
    }
    __syncthreads();
}

struct Frame {
    LAS unsigned char* lds;
    volatile LAS unsigned* MISC;
    gu32* ctl;
    int tid, lane, wave, G, bid;
    const unsigned char __attribute__((address_space(4)))* karg; float* out; unsigned char* ws;
};
__device__ __forceinline__ const float* fin_load(const unsigned char __attribute__((address_space(4)))* k, int i) { asm volatile("" : "+s"(k)); return *(const float* const __attribute__((address_space(4)))*)(k + 8 * i); }
#define FIN(F_, i_) fin_load((F_).karg, (i_))
enum { I_X = 0, I_META, I_RELB, I_F1N, I_F1GU, I_F1D, I_MIXN, I_WIN, I_LB, I_GN, I_CONVW, I_DQN, I_DKN, I_DLAM, I_DSUB, I_SQN, I_SKN, I_WBR, I_WOUT, I_F2N, I_F2GU, I_F2D };

template <class RowMap>
__device__ __forceinline__ void transpose_item(const float* W, int K, int N, bf16* WT, LAS float* scr, int item, int lane, RowMap rm) {
    const int nblk = (N + 31) / 32, kb = item / nblk, nb = item % nblk, k0 = 64 * kb, n0 = 32 * nb;
    const int nl = n0 + (lane & 31); const bool nok = nl < N;
    { float wv[32]; const float* wp = W + (size_t)(k0 + (lane >> 5)) * N + (nok ? nl : 0);
#pragma unroll
      for (int i = 0; i < 32; ++i) wv[i] = wp[(size_t)(2 * i) * N];
      __builtin_amdgcn_sched_barrier(0);
#pragma unroll
      for (int i = 0; i < 32; ++i) scr[(2 * i + (lane >> 5)) * 33 + (lane & 31)] = nok ? wv[i] : 0.f; }
    LDS_WAIT(); asm volatile("" ::: "memory");
    const int c = lane & 7;
#pragma unroll
    for (int j = 0; j < 4; ++j) { const int n = (lane >> 3) + 8 * j; const LAS float* s = scr + (8 * c) * 33 + n;
        v4u o; o.x = pk2(s[0 * 33], s[1 * 33]); o.y = pk2(s[2 * 33], s[3 * 33]); o.z = pk2(s[4 * 33], s[5 * 33]); o.w = pk2(s[6 * 33], s[7 * 33]);
        if (n0 + n < N) *(GAS v4u*)(WT + (size_t)rm(n0 + n) * K + k0 + 8 * c) = o; }
    LDS_WAIT(); asm volatile("" ::: "memory");
}
struct MapId { __device__ __forceinline__ int operator()(int n) const { return n; } };
struct MapGU { __device__ __forceinline__ int operator()(int n) const { const int up = n >= DFF, j = up ? n - DFF : n; return 256 * (j >> 7) + 128 * up + (j & 127); } };
struct MapIn { __device__ __forceinline__ int operator()(int n) const { return n < NGC ? n : n + (NNG - NGC); } };
template <class RowMap>
__device__ __forceinline__ void convert_matrix(Frame& F, const float* W, int K, int N, bf16* WT, RowMap rm) {
    LAS float* scr = (LAS float*)(F.lds + F.wave * 16384);
    const int gw = F.bid * NWAVES + F.wave, NGW = F.G * NWAVES, nitems = (K / 64) * ((N + 31) / 32);
    for (int it = gw; it < nitems; it += NGW) transpose_item(W, K, N, WT, scr, it, F.lane, rm);
}
__device__ __forceinline__ void phase_convert(Frame& F, int l) {
    unsigned char* wb = F.ws + WS_W;
    convert_matrix(F, FIN(F, I_F1GU) + (size_t)l * DM * NGU, DM, NGU, (bf16*)(wb + W_GU1), MapGU());
    convert_matrix(F, FIN(F, I_F1D) + (size_t)l * DFF * DM, DFF, DM, (bf16*)(wb + W_D1), MapId());
    convert_matrix(F, FIN(F, I_WIN) + (size_t)l * DM * INCOLS, DM, INCOLS, (bf16*)(wb + W_NG), MapIn());
    for (int m = 0; m < 4; ++m) convert_matrix(F, FIN(F, I_WBR) + ((size_t)l * 4 + m) * 512 * DM, 512, DM, (bf16*)(wb + W_BR) + (size_t)m * DM * 512, MapId());
    convert_matrix(F, FIN(F, I_WOUT) + (size_t)l * DM * DM, DM, DM, (bf16*)(wb + W_O), MapId());
    convert_matrix(F, FIN(F, I_F2GU) + (size_t)l * DM * NGU, DM, NGU, (bf16*)(wb + W_GU2), MapGU());
    convert_matrix(F, FIN(F, I_F2D) + (size_t)l * DFF * DM, DFF, DM, (bf16*)(wb + W_D2), MapId());
    { GAS v4u* z = (GAS v4u*)(wb + W_NG + (size_t)NGC * DM * 2); const int n16 = (NNG - NGC) * DM * 2 / 16;
      for (int i = F.bid * 512 + F.tid; i < n16; i += F.G * 512) z[i] = (v4u){0u, 0u, 0u, 0u}; }
    if (l == 0) {
        GAS f32x4* hm = (GAS f32x4*)(F.ws + WS_HM); const GAS f32x4* mt = (const GAS f32x4*)FIN(F, I_META);
        for (int i = F.bid * 512 + F.tid; i < 256 * DM / 4; i += F.G * 512) hm[i] = (i < NMETA * DM / 4) ? mt[i] : (f32x4){0.f, 0.f, 0.f, 0.f};
    }
}
__device__ __forceinline__ void phase_norm(Frame& F, const float* src_real, const float* gain) {
    const int gw = F.bid * NWAVES + F.wave, NGW = F.G * NWAVES;
    bf16* XN = (bf16*)(F.ws + WS_XN); const float* hm = (const float*)(F.ws + WS_HM);
    f32x4 g[8];
#pragma unroll
    for (int j = 0; j < 8; ++j) g[j] = ((const GAS f32x4*)gain)[F.lane + 64 * j];
    for (int r = gw; r < MPAD; r += NGW) {
        GAS v2u* o8 = (GAS v2u*)(XN + (size_t)r * DM) + F.lane;
        if (r >= MREAL + NMETA) {
#pragma unroll
            for (int j = 0; j < 8; ++j) o8[64 * j] = (v2u){0u, 0u};
            continue; }
        const float* xr = r < MREAL ? src_real + (size_t)r * DM : hm + (size_t)(r - MREAL) * DM;
        f32x4 v[8]; float s = 0.f;
#pragma unroll
        for (int j = 0; j < 8; ++j) { v[j] = ((const GAS f32x4*)xr)[F.lane + 64 * j]; s += (v[j].x * v[j].x + v[j].y * v[j].y) + (v[j].z * v[j].z + v[j].w * v[j].w); }
        const float inv = 1.0f / sqrtf(wave_sum(s) * (1.f / DM) + EPS);
#pragma unroll
        for (int j = 0; j < 8; ++j) { v2u w; w.x = pk2(v[j].x * inv * g[j].x, v[j].y * inv * g[j].y); w.y = pk2(v[j].z * inv * g[j].z, v[j].w * inv * g[j].w); o8[64 * j] = w; }
    }
}

__device__ __forceinline__ f32x4 meta_dot16(const bf16* A  , int lda, const bf16* Bt  , int K, int s0, int s1, int lane) {
    const int fr = lane & 15, g = lane >> 4; const bf16* ap = A + (size_t)fr * lda + 8 * g; const bf16* bp = Bt + (size_t)fr * K + 8 * g;
    f32x4 a0 = (f32x4){0.f, 0.f, 0.f, 0.f}, a1 = a0;
    for (int s = s0; s < s1; s += 2) {
        const bf16x8 x0 = *(const GAS bf16x8*)(ap + 32 * s), x1 = *(const GAS bf16x8*)(ap + 32 * s + 32);
        const bf16x8 w0 = *(const GAS bf16x8*)(bp + 32 * s), w1 = *(const GAS bf16x8*)(bp + 32 * s + 32);
        a0 = __builtin_amdgcn_mfma_f32_16x16x32_bf16(w0, x0, a0, 0, 0, 0); a1 = __builtin_amdgcn_mfma_f32_16x16x32_bf16(w1, x1, a1, 0, 0, 0); }
    return a0 + a1;
}
__device__ __forceinline__ void st_bf16x4(bf16* p, f32x4 v) { v2u w; w.x = pk2(v[0], v[1]); w.y = pk2(v[2], v[3]); *(GAS v2u*)p = w; }
__device__ __forceinline__ void meta_gemm(Frame& F, int kind, const bf16* A, int lda, const bf16* Bt, int N, int K, bf16* Obf, int ldo, float scale) {
    const int lane = F.lane, wave = F.wave, fr = lane & 15, g = lane >> 4;
    const int ngroups = (kind == 0 ? N / 2 : N) / 16;
    LAS f32x4* red = (LAS f32x4*)F.lds;
    const int ns = K / 32, s0 = (wave * ns) >> 3, s1 = ((wave + 1) * ns) >> 3;
    for (int cg = F.bid; cg < ngroups; cg += F.G) {
        const int n0 = 16 * cg;
        f32x4 p0, p1 = (f32x4){0.f, 0.f, 0.f, 0.f};
        if (kind == 0) { const int rg = 256 * (n0 >> 7) + (n0 & 127);
            p0 = meta_dot16(A, lda, Bt + (size_t)rg * K, K, s0, s1, lane); p1 = meta_dot16(A, lda, Bt + (size_t)(rg + 128) * K, K, s0, s1, lane); }
        else if (kind == 4) { const int mb = wave >> 1, kh = wave & 1; p0 = meta_dot16(A + (size_t)mb * MPAD * 512, 512, Bt + ((size_t)mb * DM + n0) * 512, 512, 8 * kh, 8 * kh + 8, lane); }
        else p0 = meta_dot16(A, lda, Bt + (size_t)n0 * K, K, s0, s1, lane);
        red[wave * 64 + lane] = p0; if (kind == 0) red[512 + wave * 64 + lane] = p1;
        LDS_WAIT(); __syncthreads();
        if (wave == 0) {
            f32x4 q[8];
#pragma unroll
            for (int w = 0; w < 8; ++w) q[w] = red[w * 64 + lane];
            if (kind == 4) { f32x4 tot = (f32x4){0.f, 0.f, 0.f, 0.f}; const bf16* G = (const bf16*)(F.ws + WS_BIG);
#pragma unroll
                for (int mb = 0; mb < 4; ++mb) { const f32x4 acc = q[2 * mb] + q[2 * mb + 1]; const v2u gw2 = *(const GAS v2u*)(G + (size_t)(MREAL + fr) * NGATE + mb * DM + n0 + 4 * g);
                    tot[0] += bflo(gw2.x) * acc[0]; tot[1] += bfhi(gw2.x) * acc[1]; tot[2] += bflo(gw2.y) * acc[2]; tot[3] += bfhi(gw2.y) * acc[3]; }
                st_bf16x4(Obf + (size_t)(MREAL + fr) * ldo + n0 + 4 * g, tot);
            } else {
                f32x4 acc = ((q[0] + q[1]) + (q[2] + q[3])) + ((q[4] + q[5]) + (q[6] + q[7]));
                if (kind == 0) { f32x4 up = (f32x4){0.f, 0.f, 0.f, 0.f};
#pragma unroll
                    for (int w = 0; w < 8; ++w) up += red[512 + w * 64 + lane];
#pragma unroll
                    for (int r = 0; r < 4; ++r) acc[r] = pg8::fast_silu(acc[r]) * up[r];
                    st_bf16x4(Obf + (size_t)(MREAL + fr) * ldo + n0 + 4 * g, acc); }
                else if (kind == 1) { float* hp = (float*)(F.ws + WS_HM) + (size_t)fr * DM + n0 + 4 * g; *(GAS f32x4*)hp = *(const GAS f32x4*)hp + acc * scale; }
                else if (kind == 2) st_bf16x4(Obf + (size_t)(MREAL + fr) * ldo + n0 + 4 * g, acc);
                else {
#pragma unroll
                    for (int r = 0; r < 4; ++r) acc[r] = pg8::fast_sigmoid(acc[r]);
                    st_bf16x4(Obf + (size_t)(MREAL + fr) * ldo + n0 + 4 * g, acc); }
            }
        }
        __syncthreads();
    }
}
__device__ __forceinline__ void unpack8(const v4u w, float (&x)[8]) { x[0] = bflo(w.x); x[1] = bfhi(w.x); x[2] = bflo(w.y); x[3] = bfhi(w.y); x[4] = bflo(w.z); x[5] = bfhi(w.z); x[6] = bflo(w.w); x[7] = bfhi(w.w); }
__device__ __forceinline__ v4u pack8(const float (&x)[8]) { v4u w; w.x = pk2(x[0], x[1]); w.y = pk2(x[2], x[3]); w.z = pk2(x[4], x[5]); w.w = pk2(x[6], x[7]); return w; }
template <int GL>
__device__ __forceinline__ void norm_cols_inplace(bf16* p, const v4u w, const float* gain, float scale, int lane, bool wr) {
    float x[8]; unpack8(w, x); float s = 0.f;
#pragma unroll
    for (int i = 0; i < 8; ++i) s += x[i] * x[i];
#pragma unroll
    for (int o = 1; o < GL; o <<= 1) s += __shfl_xor(s, o);
    const float inv = scale / sqrtf(s * (1.f / (GL * 8)) + EPS); const int g0 = (8 * lane) % (GL * 8);
#pragma unroll
    for (int i = 0; i < 8; ++i) x[i] = x[i] * inv * gain[g0 + i];
    if (wr) *(GAS v4u*)p = pack8(x);
}
__device__ __forceinline__ void prep_row(Frame& F, int l, int r) {
    const int lane = F.lane; bf16* pr = (bf16*)(F.ws + WS_BIG) + (size_t)r * NNG;
    const float *dqn = FIN(F, I_DQN) + l * 64, *dkn = FIN(F, I_DKN) + l * 64, *sqn = FIN(F, I_SQN) + l * 128, *skn = FIN(F, I_SKN) + l * 128;
    const v4u w0 = *(const GAS v4u*)(pr + C_CQ + 8 * lane), w1 = *(const GAS v4u*)(pr + C_CK + 8 * lane), w2 = *(const GAS v4u*)(pr + C_DQ + 8 * lane), w3 = *(const GAS v4u*)(pr + C_DK + 8 * (lane & 15));
    __builtin_amdgcn_sched_barrier(0);
    norm_cols_inplace<8>(pr + C_CQ + 8 * lane, w0, dqn, 0.125f * 1.4426950408889634f, lane, true);
    norm_cols_inplace<8>(pr + C_CK + 8 * lane, w1, dkn, 1.0f, lane, true);
    norm_cols_inplace<16>(pr + C_DQ + 8 * lane, w2, sqn, 0.08838834764831845f * 1.4426950408889634f, lane, true);
    norm_cols_inplace<16>(pr + C_DK + 8 * (lane & 15), w3, skn, 1.0f, lane & 15, lane < 16);
}
constexpr int VT_NPB = (LPAD + 63) / 64, VT_NTASK = NB * 5 * VT_NPB;
__device__ __forceinline__ void vt_task(Frame& F, int task) {
    const int lane = F.lane;
    const bf16* P = (const bf16*)(F.ws + WS_BIG); bf16* VtC = (bf16*)(F.ws + WS_VTC); bf16* VtD = (bf16*)(F.ws + WS_VTD);
    LAS bf16* T = (LAS bf16*)(F.lds + F.wave * 17408);
    const int pb = task % VT_NPB, mat = (task / VT_NPB) % 5, b = task / (VT_NPB * 5), p0 = 64 * pb;
    const int col = mat < 4 ? C_CV + 128 * mat : C_DV;
#pragma unroll 4
    for (int i = 0; i < 16; ++i) { const int pl = 4 * i + (lane >> 4), p = p0 + pl;
        v4u w = *(const GAS v4u*)(P + (size_t)seqrow(b, p < LSEQ ? p : LSEQ - 1) * NNG + col + 8 * (lane & 15)); if (p >= LSEQ) w = (v4u){0u, 0u, 0u, 0u};
        *(LAS v4u*)(T + pl * 136 + 8 * (lane & 15)) = w; }
    LDS_WAIT(); asm volatile("" ::: "memory");
    bf16* dst = mat < 4 ? VtC + (size_t)(b * 4 + mat) * 128 * LPAD : VtD + (size_t)b * 128 * LPAD;
#pragma unroll 4
    for (int it = 0; it < 16; ++it) { const int e = 8 * it + (lane >> 3), c = lane & 7; unsigned short x[8];
#pragma unroll
        for (int k = 0; k < 8; ++k) x[k] = T[(8 * c + k) * 136 + e];
        v4u w; w.x = x[0] | ((unsigned)x[1] << 16); w.y = x[2] | ((unsigned)x[3] << 16); w.z = x[4] | ((unsigned)x[5] << 16); w.w = x[6] | ((unsigned)x[7] << 16);
        if (p0 + 8 * c < LPAD) *(GAS v4u*)(dst + (size_t)e * LPAD + p0 + 8 * c) = w; }
    LDS_WAIT(); asm volatile("" ::: "memory");
}

#define NEG_INF (-__builtin_inff())
constexpr int NQT = (LSEQ + 31) / 32;
constexpr int NQB = (NQT + 7) / 8;
__device__ __forceinline__ bf16x8 ld_frag16(const bf16* p) { return *(const GAS bf16x8*)p; }
__device__ __forceinline__ bf16x8 mk_frag(v2u lo, v2u hi) { v4u w; w.x = lo.x; w.y = lo.y; w.z = hi.x; w.w = hi.y; return __builtin_bit_cast(bf16x8, w); }
__device__ __forceinline__ unsigned cvtpk(float lo, float hi) { return pg8::cvt_pk_bf16(lo, hi); }
__device__ __forceinline__ void build_bias_table(Frame& F, LAS float* bt, int col0) {
    const float* rb = FIN(F, I_RELB);
    for (int i = F.tid; i < 4 * 128; i += 512) { const int hd = i >> 7, n = i & 127; bt[i] = (rb[rel_bucket(n) * 8 + col0 + hd] - rb[31 * 8 + col0 + hd]) * 1.4426950408889634f; }
}
__device__ __forceinline__ bool softmax_step(f32x16& S, float& m, float& lsum, float& alpha) {
    float tm = S[0];
#pragma unroll
    for (int r = 1; r < 16; ++r) tm = fmaxf(tm, S[r]);
    const bool raise = __any(tm > m + 11.5f);
    alpha = 1.0f;
    if (raise) { tm = fmaxf(tm, __shfl_xor(tm, 32)); const float mn = fmaxf(m, tm); alpha = (mn == NEG_INF) ? 1.0f : __builtin_amdgcn_exp2f(m - mn); m = mn; lsum *= alpha; }
    const float mref = (m == NEG_INF) ? 0.f : m;
    float rs = 0.f;
#pragma unroll
    for (int r = 0; r < 16; ++r) { S[r] = __builtin_amdgcn_exp2f(S[r] - mref); rs += S[r]; }
    lsum += rs;
    return raise;
}
__device__ __forceinline__ void relane(Frame& F) {
    int w = F.wave; asm volatile("" : "+s"(w)); unsigned mk = ~0u; asm volatile("" : "+s"(mk));
    int t = w * 64 + (int)__builtin_amdgcn_mbcnt_hi(mk, __builtin_amdgcn_mbcnt_lo(mk, 0u)); asm volatile("" : "+v"(t)); F.tid = t; F.lane = t & 63; F.wave = w; }
#ifndef DIFF_SINGLE
#define DIFF_SINGLE 0
#endif
#ifndef TK_DSA
#define TK_DSA 64
#endif
#ifndef NVPRE_DIFF
#define NVPRE_DIFF 4
#endif
#ifndef NVPRE_DSA
#define NVPRE_DSA 8
#endif
template <bool DSA>
__device__ __forceinline__ void attn_wg_task(Frame& F, int l, int b, int h, int J, const LAS float* bt, float lam, float post) {
    constexpr int KD = DSA ? 128 : 64, KP = KD + 8, NKS = KD / 16;
    constexpr int TK = DSA ? TK_DSA : 64, NS = TK / 32, VP = TK + 4, NVL = 128 * (TK / 8) / 512, NKL = TK * (KD / 8) / 512;
    constexpr int KBUF = TK * KP, VBUF = 128 * VP;
    constexpr int RPARK = 57344;
    constexpr int NVPRE = DSA ? NVPRE_DSA : NVPRE_DIFF;
    relane(F);
    const int lane = F.lane, ql = lane & 31, hh = lane >> 5, wave = F.wave, tid = F.tid;
    LAS bf16* Kl = (LAS bf16*)F.lds; LAS bf16* Vl = Kl + 2 * KBUF;
    const bf16* P = (const bf16*)(F.ws + WS_BIG);
    const bf16* Vt = DSA ? (const bf16*)(F.ws + WS_VTD) + (size_t)b * 128 * LPAD : (const bf16*)(F.ws + WS_VTC) + (size_t)(b * 4 + h) * 128 * LPAD;
    const int jr = 8 * J + wave - 7; const bool wvalid = jr >= 0 && 32 * jr < LSEQ; const int j = jr < 0 ? 0 : jr;
    const int ktmax = (8 * J < NQT - 1) ? 8 * J : NQT - 1;
    const int pq = 32 * j + ql, pqc = pq < LSEQ ? pq : LSEQ - 1;
    const bf16* qrow = P + (size_t)seqrow(b, pqc) * NNG + (DSA ? C_DQ : C_CQ) + h * 128 + 8 * hh;
    const unsigned* mrow = (const unsigned*)(F.ws + WS_MASK) + ((size_t)b * LPAD + pqc) * MASKW;
    f32x16 R[4];
#pragma unroll
    for (int c = 0; c < (DSA ? 1 : 2); ++c) {
        const int kcol = DSA ? C_DK : C_CK + h * 128 + c * 64;
        relane(F);
        const int tid2 = F.tid, kr = tid2 / (KD / 8), kc = tid2 % (KD / 8), vr = tid2 / (TK / 8), vc = tid2 % (TK / 8);
        bf16x8 qf[NKS];
#pragma unroll
        for (int ks = 0; ks < NKS; ++ks) qf[ks] = ld_frag16(qrow + (DSA ? 0 : c * 64) + 16 * ks);
        float m = NEG_INF, lsum = 0.f; f32x16 O[4];
#pragma unroll
        for (int eb = 0; eb < 4; ++eb)
#pragma unroll
            for (int r = 0; r < 16; ++r) O[eb][r] = 0.f;
        v4u rk0[NKL], rk1[NKL], rv0[NVL], rv1[NVL];
#pragma unroll
        for (int i = 0; i < NKL; ++i) { rk0[i] = (v4u){0u, 0u, 0u, 0u}; rk1[i] = rk0[i]; }
#pragma unroll
        for (int i = 0; i < NVL; ++i) { rv0[i] = (v4u){0u, 0u, 0u, 0u}; rv1[i] = rv0[i]; }
#define ATT_ISSUE(st_, RK, RV) do { _Pragma("unroll") for (int i_ = 0; i_ < NKL; ++i_) { int pk_ = TK * (st_) + kr + i_ * (512 / (KD / 8)); pk_ = pk_ < LSEQ ? pk_ : LSEQ - 1; \
            RK[i_] = *(const GAS v4u*)(P + (size_t)seqrow(b, pk_) * NNG + kcol + 8 * kc); } \
            int vcol_ = TK * (st_) + 8 * vc; vcol_ = vcol_ < LPAD - 8 ? vcol_ : LPAD - 8; \
            _Pragma("unroll") for (int i_ = 0; i_ < NVL; ++i_) RV[i_] = *(const GAS v4u*)(Vt + (size_t)(vr + i_ * (512 / (TK / 8))) * LPAD + vcol_); } while (0)
#define ATT_COMMIT(buf_, RK, RV) do { _Pragma("unroll") for (int i_ = 0; i_ < NKL; ++i_) *(LAS v4u*)(Kl + (buf_) * KBUF + (kr + i_ * (512 / (KD / 8))) * KP + 8 * kc) = RK[i_]; \
            _Pragma("unroll") for (int i_ = 0; i_ < NVL; ++i_) { LAS v2u* vd_ = (LAS v2u*)(Vl + (buf_) * VBUF + (vr + i_ * (512 / (TK / 8))) * VP + 8 * vc); vd_[0] = (v2u){RV[i_].x, RV[i_].y}; vd_[1] = (v2u){RV[i_].z, RV[i_].w}; } } while (0)
        unsigned mwc[NS], mwn[NS];
#pragma unroll
        for (int s = 0; s < NS; ++s) { mwc[s] = 0xffffffffu; mwn[s] = 0xffffffffu; if (DSA) mwc[s] = mrow[s <= ktmax ? s : ktmax]; }
#define MW_LOAD(st_) do { if (DSA) { _Pragma("unroll") for (int s_ = 0; s_ < NS; ++s_) { const int kt_ = NS * (st_) + s_; mwn[s_] = mrow[kt_ <= ktmax ? kt_ : ktmax]; } } } while (0)
#define MW_ROT() do { if (DSA) { _Pragma("unroll") for (int s_ = 0; s_ < NS; ++s_) mwc[s_] = mwn[s_]; } } while (0)
        auto compute = [&](int kt, int buf, int sub) {
            if (wvalid && kt <= j) {
                const LAS bf16* Kt = Kl + buf * KBUF + (32 * sub + ql) * KP + 8 * hh; const LAS bf16* Vb = Vl + buf * VBUF + ql * VP + 32 * sub + 4 * hh;
                f32x16 S;
#pragma unroll
                for (int r = 0; r < 16; ++r) S[r] = 0.f;
#pragma unroll
                for (int ks = 0; ks < NKS; ++ks) S = __builtin_amdgcn_mfma_f32_32x32x16_bf16(*(const LAS bf16x8*)(Kt + 16 * ks), qf[ks], S, 0, 0, 0);
                const unsigned mw = (sub ? mwc[NS - 1] : mwc[0]) >> (4 * hh);
                if (kt + 4 >= j) {
                    const int n0 = pq - (32 * kt + 4 * hh); float bv[16];
#pragma unroll
                    for (int r = 0; r < 16; ++r) { const int ko = (r & 3) + 8 * (r >> 2); int n = n0 - ko; n = n < 0 ? 0 : (n < 127 ? n : 127); bv[r] = bt[h * 128 + n]; }
#pragma unroll
                    for (int r = 0; r < 16; ++r) { const int ko = (r & 3) + 8 * (r >> 2); const bool sel = ((mw >> ko) & 1u) && n0 >= ko; S[r] = sel ? S[r] + bv[r] : NEG_INF; }
                } else if (DSA) {
#pragma unroll
                    for (int r = 0; r < 16; ++r) { const int ko = (r & 3) + 8 * (r >> 2); S[r] = ((mw >> ko) & 1u) ? S[r] : NEG_INF; }
                }
                bf16x8 vf[NVPRE > 0 ? NVPRE : 1];
#pragma unroll
                for (int i = 0; i < NVPRE; ++i) { const LAS bf16* vp = Vb + (i >> 1) * 32 * VP + 16 * (i & 1); vf[i] = mk_frag(*(const LAS v2u*)vp, *(const LAS v2u*)(vp + 8)); }
                float alpha;
                if (softmax_step(S, m, lsum, alpha)) {
#pragma unroll
                    for (int eb = 0; eb < 4; ++eb)
#pragma unroll
                        for (int r = 0; r < 16; ++r) O[eb][r] *= alpha;
                }
                bf16x8 pf[2];
#pragma unroll
                for (int s = 0; s < 2; ++s) { v4u w; w.x = cvtpk(S[8 * s + 0], S[8 * s + 1]); w.y = cvtpk(S[8 * s + 2], S[8 * s + 3]); w.z = cvtpk(S[8 * s + 4], S[8 * s + 5]); w.w = cvtpk(S[8 * s + 6], S[8 * s + 7]); pf[s] = __builtin_bit_cast(bf16x8, w); }
#pragma unroll
                for (int eb = 0; eb < 4; ++eb)
#pragma unroll
                    for (int s = 0; s < 2; ++s) { const LAS bf16* vp = Vb + eb * 32 * VP + 16 * s;
                        O[eb] = __builtin_amdgcn_mfma_f32_32x32x16_bf16((2 * eb + s < NVPRE) ? vf[(2 * eb + s < NVPRE) ? 2 * eb + s : 0] : mk_frag(*(const LAS v2u*)vp, *(const LAS v2u*)(vp + 8)), pf[s], O[eb], 0, 0, 0); }
            } };
        __syncthreads();
        const int stmax = ktmax / NS;
        ATT_ISSUE(0, rk0, rv0); ATT_COMMIT(0, rk0, rv0);
        if (DSA ? (TK_DSA == 64) : (DIFF_SINGLE != 0)) {
            for (int st = 0; st <= stmax; ++st) {
                LDS_WAIT(); __syncthreads();
                MW_LOAD(st + 1);
                if (st + 1 <= stmax) ATT_ISSUE(st + 1, rk0, rv0);
#pragma unroll 1
                for (int sub = 0; sub < NS; ++sub) compute(NS * st + sub, st & 1, sub);
                if (st + 1 <= stmax) ATT_COMMIT((st + 1) & 1, rk0, rv0);
                MW_ROT();
            }
        } else {
        if (stmax >= 1) ATT_ISSUE(1, rk1, rv1);
        for (int st = 0; st <= stmax; st += 2) {
            LDS_WAIT(); __syncthreads();
            MW_LOAD(st + 1);
            if (st + 2 <= stmax) ATT_ISSUE(st + 2, rk0, rv0);
#pragma unroll 1
            for (int sub = 0; sub < NS; ++sub) compute(NS * st + sub, 0, sub);
            if (st + 1 <= stmax) ATT_COMMIT(1, rk1, rv1);
            MW_ROT();
            if (st + 1 > stmax) break;
            LDS_WAIT(); __syncthreads();
            MW_LOAD(st + 2);
            if (st + 3 <= stmax) ATT_ISSUE(st + 3, rk1, rv1);
#pragma unroll 1
            for (int sub = 0; sub < NS; ++sub) compute(NS * (st + 1) + sub, 1, sub);
            if (st + 2 <= stmax) ATT_COMMIT(0, rk0, rv0);
            MW_ROT();
        }
        }
#undef ATT_ISSUE
#undef MW_LOAD
#undef MW_ROT
#undef ATT_COMMIT
        lsum += __shfl_xor(lsum, 32); const float il = 1.0f / lsum;
        if (DSA) {
#pragma unroll
            for (int eb = 0; eb < 4; ++eb)
#pragma unroll
                for (int r = 0; r < 16; ++r) R[eb][r] = O[eb][r] * il;
        } else if (c == 0) {
            LAS unsigned* rp = (LAS unsigned*)(F.lds + RPARK) + wave * 2048 + lane;
#pragma unroll
            for (int eb = 0; eb < 4; ++eb)
#pragma unroll
                for (int r = 0; r < 16; r += 2) rp[(eb * 8 + (r >> 1)) * 64] = pk2(O[eb][r] * il, O[eb][r + 1] * il);
        } else {
            const LAS unsigned* rp = (const LAS unsigned*)(F.lds + RPARK) + wave * 2048 + lane;
#pragma unroll
            for (int eb = 0; eb < 4; ++eb)
#pragma unroll
                for (int r = 0; r < 16; r += 2) { const unsigned w = rp[(eb * 8 + (r >> 1)) * 64]; R[eb][r] = bflo(w) - lam * (O[eb][r] * il); R[eb][r + 1] = bfhi(w) - lam * (O[eb][r + 1] * il); }
        }
    }
    float inv = 1.0f;
    if (!DSA) { float ss = 0.f;
#pragma unroll
        for (int eb = 0; eb < 4; ++eb)
#pragma unroll
            for (int r = 0; r < 16; ++r) ss += R[eb][r] * R[eb][r];
        ss += __shfl_xor(ss, 32); inv = post / sqrtf(ss * (1.f / 128.f) + EPS); }
    const float* sub = FIN(F, I_DSUB) + l * 128;
    if (wvalid && pq < LSEQ && (pq >= NMETA || b == 0)) {
        bf16* orow = (bf16*)(F.ws + WS_BR) + (size_t)(DSA ? 3 : 2) * MPAD * 512 + (size_t)seqrow(b, pq) * 512 + h * 128;
#pragma unroll
        for (int eb = 0; eb < 4; ++eb)
#pragma unroll
            for (int g = 0; g < 4; ++g) { const int e0 = 32 * eb + 8 * g + 4 * hh; f32x4 sv = (f32x4){1.f, 1.f, 1.f, 1.f}; if (!DSA) sv = *(const GAS f32x4*)(sub + e0);
                v2u w; w.x = pk2(R[eb][4 * g] * inv * sv.x, R[eb][4 * g + 1] * inv * sv.y); w.y = pk2(R[eb][4 * g + 2] * inv * sv.z, R[eb][4 * g + 3] * inv * sv.w);
                *(GAS v2u*)(orow + e0) = w; }
    }
}
__device__ __forceinline__ unsigned f32_key(float f) { const unsigned u = __float_as_uint(f); return u ^ ((u >> 31) ? 0xffffffffu : 0x80000000u); }
__device__ __forceinline__ float relu_bits(float x) { const int i = __float_as_int(x); return __int_as_float(i > 0 ? i : 0); }
__device__ __forceinline__ void dsa_index_task(Frame& F, int b, int j, float* slab) {
    relane(F);
    const int lane = F.lane, ql = lane & 31, hh = lane >> 5, wave = F.wave;
    const bf16* P = (const bf16*)(F.ws + WS_BIG);
    LAS unsigned char* qi = F.lds;
    { v4u st[8];
#pragma unroll
      for (int k = 0; k < 8; ++k) { const int i = F.tid + 512 * k, q = i >> 7, ch = i & 127; int pq = 32 * j + q; pq = pq < LSEQ ? pq : LSEQ - 1;
          st[k] = *(const GAS v4u*)(P + (size_t)seqrow(b, pq) * NNG + C_DQI + 8 * ch); }
#pragma unroll
      for (int k = 0; k < 8; ++k) { const int i = F.tid + 512 * k, q = i >> 7, ch = i & 127; *(LAS v4u*)(qi + q * 2064 + 16 * ch) = st[k]; } }
    LAS float* wl = (LAS float*)(qi + 32 * 2064);
    if (F.tid < 32 * 16) { const int q = F.tid >> 4, hd = F.tid & 15; int pq = 32 * j + q; pq = pq < LSEQ ? pq : LSEQ - 1;
        wl[F.tid] = bf2f(P[(size_t)seqrow(b, pq) * NNG + C_DW + hd]) * 0.03125f; }
    LAS unsigned* hist = (LAS unsigned*)(F.lds + 73728);
    for (int i = F.tid; i < 32 * 256; i += 512) hist[i] = 0u;
    LDS_WAIT(); __syncthreads();
#ifndef PROBE_SUB
#define PROBE_SUB 0
#endif
    for (int rpa = 0; rpa < ((PROBE_SUB & 8) ? 2 : 1); ++rpa)
    {
    if (rpa) { LDS_WAIT(); __syncthreads(); for (int i = F.tid; i < 32 * 256; i += 512) hist[i] = 0u; LDS_WAIT(); __syncthreads(); }
    bf16x8 kn[4];
    { const int pk = 32 * wave + ql, pkc = pk < LSEQ ? pk : LSEQ - 1; const bf16* krow = P + (size_t)seqrow(b, pkc) * NNG + C_DKI + 8 * hh;
#pragma unroll
      for (int ks = 0; ks < 4; ++ks) kn[ks] = ld_frag16(krow + 16 * ks); }
    for (int kt = wave; kt <= j; kt += NWAVES) {
        bf16x8 kf[4];
#pragma unroll
        for (int ks = 0; ks < 4; ++ks) kf[ks] = kn[ks];
        { const int ktn = kt + NWAVES <= j ? kt + NWAVES : kt; const int pk = 32 * ktn + ql, pkc = pk < LSEQ ? pk : LSEQ - 1; const bf16* krow = P + (size_t)seqrow(b, pkc) * NNG + C_DKI + 8 * hh;
#pragma unroll
          for (int ks = 0; ks < 4; ++ks) kn[ks] = ld_frag16(krow + 16 * ks); }
        f32x16 idx;
#pragma unroll
        for (int r = 0; r < 16; ++r) idx[r] = 0.f;
#pragma unroll 1
        for (int hd = 0; hd < 16; hd += 2) { f32x16 S0, S1; const float wh0 = wl[ql * 16 + hd], wh1 = wl[ql * 16 + hd + 1];
#pragma unroll
            for (int r = 0; r < 16; ++r) { S0[r] = 0.f; S1[r] = 0.f; }
#pragma unroll
            for (int ks = 0; ks < 4; ++ks) { S0 = __builtin_amdgcn_mfma_f32_32x32x16_bf16(kf[ks], *(const LAS bf16x8*)(qi + ql * 2064 + hd * 128 + 32 * ks + 16 * hh), S0, 0, 0, 0);
                S1 = __builtin_amdgcn_mfma_f32_32x32x16_bf16(kf[ks], *(const LAS bf16x8*)(qi + ql * 2064 + (hd + 1) * 128 + 32 * ks + 16 * hh), S1, 0, 0, 0); }
#pragma unroll
            for (int r = 0; r < 16; ++r) { idx[r] = __builtin_fmaf(wh0, relu_bits(S0[r]), idx[r]); idx[r] = __builtin_fmaf(wh1, relu_bits(S1[r]), idx[r]); } }
        { const int lim = 32 * (j - kt) + ql - 4 * hh;
#pragma unroll
          for (int r = 0; r < 16; ++r) { const int ko = (r & 3) + 8 * (r >> 2);
              int bn = (int)__builtin_fmaf(idx[r], 32.f, 256.f); bn = bn < 0 ? 0 : (bn > 511 ? 511 : bn);
              const unsigned inc = (ko <= lim) ? ((bn & 1) ? 0x10000u : 1u) : 0u;
              (void)__hip_atomic_fetch_add(hist + ql * 256 + (((bn >> 1) + 2 * ql) & 255), inc, __ATOMIC_RELAXED, __HIP_MEMORY_SCOPE_WORKGROUP); } }
        float* srow = slab + (size_t)ql * LPAD + 32 * kt + 4 * hh;
#pragma unroll
        for (int g = 0; g < 4; ++g) *(GAS f32x4*)(srow + 8 * g) = (f32x4){idx[4 * g], idx[4 * g + 1], idx[4 * g + 2], idx[4 * g + 3]};
    }
    }
    VM_WAIT(); LDS_WAIT(); __syncthreads();
    for (int rpb = 0; rpb < ((PROBE_SUB & 16) ? 2 : 1); ++rpb)
    for (int qq = wave; qq < 32; qq += NWAVES) {
        const int p = 32 * j + qq; if (p >= LSEQ) break;
        const float* row = slab + (size_t)qq * LPAD;
        unsigned u[65];
        { const GAS unsigned* rp = (const GAS unsigned*)row + lane;
#pragma unroll
          for (int i = 0; i < 65; ++i) u[i] = rp[64 * i];
          __builtin_amdgcn_sched_barrier(0); }
        auto wsum = [&](unsigned c) { unsigned s = 0;
#pragma unroll
            for (int k = 0; k < 7; ++k) s += (unsigned)__builtin_popcountll(__ballot((c >> k) & 1u)) << k;
            return s; };
        unsigned T = 1u;
        if (p + 1 <= 256) {
#pragma unroll
            for (int i = 0; i < 65; ++i) { const unsigned k = f32_key(__uint_as_float(u[i])) >> 1; u[i] = (64 * i + lane <= p) ? k : 0u; }
        } else {
            const LAS unsigned* hrow = hist + qq * 256; unsigned c8[8];
#pragma unroll
            for (int i = 0; i < 4; ++i) { const unsigned w = hrow[(4 * lane + i + 2 * qq) & 255]; c8[2 * i] = w & 0xffffu; c8[2 * i + 1] = w >> 16; }
            unsigned tot = 0;
#pragma unroll
            for (int i = 0; i < 8; ++i) tot += c8[i];
            unsigned suf = 0;
            { const unsigned long long gtm = (lane == 63) ? 0ull : ~((2ull << lane) - 1ull);
#pragma unroll
              for (int k = 0; k < 13; ++k) suf += (unsigned)__builtin_popcountll(__ballot((tot >> k) & 1u) & gtm) << k; }
            unsigned run = suf, bl = 0, al = 0; bool found = false;
#pragma unroll
            for (int i = 7; i >= 0; --i) { const bool hit = !found && run < 256u && run + c8[i] >= 256u; if (hit) { bl = 8u * lane + i; al = run; } found = found || hit; run += c8[i]; }
            const unsigned long long fb = __ballot(found); const int src = (int)__builtin_ctzll(fb | (1ull << 63));
            const unsigned bstar = __builtin_amdgcn_readlane(bl, src), above = __builtin_amdgcn_readlane(al, src), need = 256u - above;
            unsigned f0 = 0u, f1 = 0u, f2 = 0u, cb = 0u;
#pragma unroll
            for (int i = 0; i < 65; ++i) { const float v = __uint_as_float(u[i]); int bn = (int)__builtin_fmaf(v, 32.f, 256.f); bn = bn < 0 ? 0 : (bn > 511 ? 511 : bn);
                const bool val = 64 * i + lane <= p, inband = val && (unsigned)bn == bstar;
                if (i < 32) f0 |= inband ? (1u << i) : 0u; else if (i < 64) f1 |= inband ? (1u << (i - 32)) : 0u; else f2 = inband ? 1u : 0u;
                cb += inband ? 1u : 0u;
                const unsigned k = f32_key(v) >> 1; u[i] = val ? k : 0u; }
            const unsigned inb = wsum(cb);
            if (fb != 0ull && inb <= 128u && inb >= need) {
                LAS unsigned* band = (LAS unsigned*)(F.lds + 68096) + wave * 128;
                unsigned off = 0;
#pragma unroll
                for (int k = 0; k < 7; ++k) { const unsigned long long bal = __ballot((cb >> k) & 1u); off += __builtin_amdgcn_mbcnt_hi((unsigned)(bal >> 32), __builtin_amdgcn_mbcnt_lo((unsigned)bal, 0u)) << k; }
#pragma unroll
                for (int i = 0; i < 65; ++i) { const bool inband = i < 32 ? ((f0 >> i) & 1u) : (i < 64 ? ((f1 >> (i - 32)) & 1u) : (f2 & 1u)); if (inband) { band[off] = u[i]; ++off; } }
                LDS_WAIT();
                const unsigned m0 = lane < (int)inb ? band[lane] : 0u, m1 = lane + 64 < (int)inb ? band[lane + 64] : 0u; unsigned ge0 = 0, gt0 = 0, ge1 = 0, gt1 = 0;
                for (unsigned k = 0; k < inb; ++k) { const unsigned v = band[k]; ge0 += (m0 - 1u - v) >> 31; gt0 += (m0 - v) >> 31; ge1 += (m1 - 1u - v) >> 31; gt1 += (m1 - v) >> 31; }
                const unsigned long long ok0 = __ballot(lane < (int)inb && ge0 >= need && gt0 < need), ok1 = __ballot(lane + 64 < (int)inb && ge1 >= need && gt1 < need);
                if (ok0) T = __builtin_amdgcn_readlane(m0, (int)__builtin_ctzll(ok0)); else T = __builtin_amdgcn_readlane(m1, (int)__builtin_ctzll(ok1 | (1ull << 63)));
                LDS_WAIT();
            } else {
                T = 0u;
                for (int bit = 30; bit >= 0; --bit) { const unsigned cm1 = (T | (1u << bit)) - 1u; unsigned c = 0;
#pragma unroll
                    for (int i = 0; i < 65; ++i) c += (cm1 - u[i]) >> 31;
                    if (wsum(c) >= 256u) T |= 1u << bit; } } }
        unsigned long long* mrow = (unsigned long long*)((unsigned*)(F.ws + WS_MASK) + ((size_t)b * LPAD + p) * MASKW);
        unsigned wlo = 0u, whi = 0u;
#pragma unroll
        for (int i = 0; i < 64; ++i) { const unsigned long long bal = __ballot(u[i] >= T); if (lane == i) { wlo = (unsigned)bal; whi = (unsigned)(bal >> 32); } }
        const unsigned long long b64 = __ballot(u[64] >= T);
        mrow[lane] = ((unsigned long long)whi << 32) | wlo; if (lane == 0) mrow[64] = b64;
    }
    __syncthreads();
}
struct HgChunk { bf16* base; int pitch; int cq, ck, cv; bf16* A; float* dl; };
__device__ __forceinline__ HgChunk hg_chunk(Frame& F, int b, int h, int c) {
    HgChunk k;
    if (c == 0) { unsigned char* mp = F.ws + WS_HMETA + (size_t)h * HMETA_STRIDE; k.base = (bf16*)mp; k.pitch = 384; k.cq = 0; k.ck = 128; k.cv = 256; k.A = (bf16*)(mp + 64 * 384 * 2); k.dl = (float*)(mp + 64 * 384 * 2 + 64 * 64 * 2); }
    else { const size_t ci = (size_t)(b * 4 + h) * 64 + (c - 1); k.base = (bf16*)(F.ws + WS_BIG) + (size_t)(b * SEQ + 64 * (c - 1)) * NNG; k.pitch = NNG; k.cq = C_AQ + h * 128; k.ck = C_AF + h * 128; k.cv = C_AI + h * 128;
        k.A = (bf16*)(F.ws + WS_HA) + ci * 64 * 64; k.dl = (float*)(F.ws + WS_HDL) + ci * 128; }
    return k;
}
__device__ __forceinline__ void hgrn_prep_task(Frame& F, int l, int b, int h, int c) {
    const int d = F.tid & 127, tq = F.tid >> 7, lane = F.lane, wave = F.wave;
    const bf16* P = (const bf16*)(F.ws + WS_BIG);
    LAS bf16* Qt = (LAS bf16*)F.lds; LAS bf16* Kt = Qt + 64 * 136; LAS float* part = (LAS float*)(F.lds + 2 * 64 * 136 * 2);
    const HgChunk ch = hg_chunk(F, b, h, c);
    float lb = 0.f; if (l == 1) { const float a = FIN(F, I_LB)[h * 128 + d], cc = FIN(F, I_LB)[512 + h * 128 + d]; lb = 1.0f / (1.0f + __expf(a - cc)); }
    const bool meta = (c == 0);
    unsigned short zr[16], qr[16], vr[16];
    { const int r0 = meta ? MREAL : b * SEQ + 64 * (c - 1);
#pragma unroll
      for (int i = 0; i < 16; ++i) { int t = 16 * tq + i; if (meta) t = t < NMETA ? t : NMETA - 1; const bf16* pr = P + (size_t)(r0 + t) * NNG + h * 128 + d; zr[i] = pr[C_AF]; qr[i] = pr[C_AQ]; vr[i] = pr[C_AI]; }
      __builtin_amdgcn_sched_barrier(0); }
    float lfv[16];
    float run = 0.f;
#pragma unroll
    for (int i = 0; i < 16; ++i) { const bool valid = !meta || (16 * tq + i < NMETA); const float z = bf2f(zr[i]); const float sg = 1.0f / (1.0f + __expf(-z));
        lfv[i] = valid ? __logf(lb + (1.0f - lb) * sg) : 0.f; run += lfv[i]; }
    part[tq * 128 + d] = run;
    LDS_WAIT(); __syncthreads();
    const float p0 = part[d], p1 = part[128 + d], p2 = part[256 + d], p3 = part[384 + d];
    const float off = (tq > 0 ? p0 : 0.f) + (tq > 1 ? p1 : 0.f) + (tq > 2 ? p2 : 0.f), bmid = p0 + p1, blast = (p0 + p1) + (p2 + p3);
    unsigned kb[8], vb[8]; unsigned short qb[16];
    float bt = off;
#pragma unroll
    for (int i = 0; i < 16; i += 2) { float kbar[2], vv[2];
#pragma unroll
        for (int u = 0; u < 2; ++u) { const int t = 16 * tq + i + u; const bool valid = !meta || (t < NMETA);
            const float lf = lfv[i + u]; const float q = bf2f(qr[i + u]);
            const float kk = valid ? 1.0f - __expf(lf) : 0.f, qq = valid ? q / (1.0f + __expf(-q)) : 0.f; vv[u] = valid ? bf2f(vr[i + u]) : 0.f;
            bt += lf;
            kbar[u] = kk * __expf(blast - bt); qb[i + u] = (unsigned short)f2bf_s(qq * __expf(bt));
            const float qt = qq * __expf(fminf(bt - bmid, 80.f)), kt = kk * __expf(fminf(bmid - bt, 80.f));
            Qt[t * 136 + d] = (bf16)f2bf_s(qt); Kt[t * 136 + d] = (bf16)f2bf_s(kt); }
        kb[i >> 1] = pk2(kbar[0], kbar[1]); vb[i >> 1] = pk2(vv[0], vv[1]); }
    asm volatile("s_waitcnt vmcnt(0)" ::: "memory"); __syncthreads();
#pragma unroll
    for (int i = 0; i < 16; ++i) ch.base[(size_t)(16 * tq + i) * ch.pitch + ch.cq + d] = qb[i];
    { bf16* kd = ch.base + (size_t)(d >> 1) * ch.pitch + ch.ck + (d & 1) * 64 + 16 * tq; bf16* vd = ch.base + (size_t)(d >> 1) * ch.pitch + ch.cv + (d & 1) * 64 + 16 * tq;
      *(GAS v4u*)kd = (v4u){kb[0], kb[1], kb[2], kb[3]}; *(GAS v4u*)(kd + 8) = (v4u){kb[4], kb[5], kb[6], kb[7]};
      *(GAS v4u*)vd = (v4u){vb[0], vb[1], vb[2], vb[3]}; *(GAS v4u*)(vd + 8) = (v4u){vb[4], vb[5], vb[6], vb[7]}; }
    if (tq == 0) ch.dl[d] = __expf(blast);
    LDS_WAIT(); __syncthreads();
    { const int mt = wave >> 1, fr = lane & 15, g = lane >> 4;
#pragma unroll
      for (int u = 0; u < 2; ++u) { const int nt = 2 * (wave & 1) + u; f32x4 acc = (f32x4){0.f, 0.f, 0.f, 0.f};
        if (nt <= mt) {
#pragma unroll
            for (int ks = 0; ks < 4; ++ks) acc = __builtin_amdgcn_mfma_f32_16x16x32_bf16(*(const LAS bf16x8*)(Qt + (16 * mt + fr) * 136 + 32 * ks + 8 * g), *(const LAS bf16x8*)(Kt + (16 * nt + fr) * 136 + 32 * ks + 8 * g), acc, 0, 0, 0);
        }
#pragma unroll
        for (int r = 0; r < 4; ++r) { const int t = 16 * mt + 4 * g + r, s = 16 * nt + fr; ch.A[t * 64 + s] = (bf16)f2bf_s(s <= t ? acc[r] : 0.f); } } }
    __syncthreads();
}
__device__ __forceinline__ float fast_sigmoid_m(float x) { return __builtin_amdgcn_rcpf(1.0f + __expf(-x)); }
__device__ __forceinline__ void hgrn_scan_unit(Frame& F, int l, int b, int h) {
    const int lane = F.lane, wave = F.wave, fr = lane & 15, g = lane >> 4, tid = F.tid;
    constexpr int QP = 136, AP = 72, KP = 72, GP = 136;
    constexpr int BUF = (64 * QP + 64 * AP + 128 * KP + 64 * GP) * 2 + 512;
    LAS float* red = (LAS float*)(F.lds + 2 * BUF);
    const int dv = 16 * wave + fr;
    const float gn = FIN(F, I_GN)[l * 512 + h * 128 + dv];
    const bf16* Pg = (const bf16*)(F.ws + WS_BIG) + C_AG + h * 128;
    f32x4 S[8];
#pragma unroll
    for (int mt = 0; mt < 8; ++mt) S[mt] = (f32x4){0.f, 0.f, 0.f, 0.f};
    v4u rq[2], ra, rk[2], rg[2], rd; bf16x8 bv0, bv1, bn0, bn1;
#define HG_ISSUE(c_, B0, B1) do { const HgChunk ch_ = hg_chunk(F, b, h, (c_)); const int nv_ = ((c_) == 0) ? NMETA : 64; \
        _Pragma("unroll") for (int i = 0; i < 2; ++i) { const int idx = tid + 512 * i, row = idx >> 4, c16 = idx & 15; \
            rq[i] = *(const GAS v4u*)(ch_.base + (size_t)row * ch_.pitch + ch_.cq + 8 * c16); rk[i] = *(const GAS v4u*)(ch_.base + (size_t)row * ch_.pitch + ch_.ck + 8 * c16); \
            rg[i] = (v4u){0u, 0u, 0u, 0u}; if (row < nv_) rg[i] = *(const GAS v4u*)(Pg + (size_t)(((c_) == 0) ? MREAL + row : b * SEQ + 64 * ((c_) - 1) + row) * NNG + 8 * c16); } \
        ra = *(const GAS v4u*)(ch_.A + 8 * tid); if (tid < 32) rd = *(const GAS v4u*)(ch_.dl + 4 * tid); \
        const bf16* vrow_ = ch_.base + (size_t)(dv >> 1) * ch_.pitch + ch_.cv + (dv & 1) * 64 + 8 * g; B0 = ld_frag16(vrow_); B1 = ld_frag16(vrow_ + 32); } while (0)
#define HG_COMMIT(buf_) do { LAS bf16* Q_ = (LAS bf16*)(F.lds + (buf_) * BUF); LAS bf16* A_ = Q_ + 64 * QP; LAS bf16* KT_ = A_ + 64 * AP; LAS bf16* G_ = KT_ + 128 * KP; \
        _Pragma("unroll") for (int i = 0; i < 2; ++i) { const int idx = tid + 512 * i, row = idx >> 4, c16 = idx & 15; *(LAS v4u*)(Q_ + row * QP + 8 * c16) = rq[i]; \
            *(LAS v4u*)(KT_ + (2 * row + (c16 >> 3)) * KP + 8 * (c16 & 7)) = rk[i]; *(LAS v4u*)(G_ + row * GP + 8 * c16) = rg[i]; } \
        *(LAS v4u*)(A_ + (tid >> 3) * AP + 8 * (tid & 7)) = ra; if (tid < 32) *(LAS v4u*)((LAS unsigned char*)(G_ + 64 * GP) + 16 * tid) = rd; } while (0)
    HG_ISSUE(0, bv0, bv1); HG_COMMIT(0);
    for (int c = 0; c <= 64; ++c) {
        const int buf = c & 1;
        LDS_WAIT(); __syncthreads();
        if (c < 64) HG_ISSUE(c + 1, bn0, bn1);
        LAS bf16* Q = (LAS bf16*)(F.lds + buf * BUF); LAS bf16* A = Q + 64 * QP; LAS bf16* KT = A + 64 * AP; LAS bf16* G = KT + 128 * KP; const LAS float* DL = (const LAS float*)(G + 64 * GP);
        f32x4 o[4];
#pragma unroll
        for (int mt = 0; mt < 4; ++mt) o[mt] = (f32x4){0.f, 0.f, 0.f, 0.f};
#pragma unroll
        for (int ks = 0; ks < 4; ++ks) { v4u w; w.x = cvtpk(S[2 * ks][0], S[2 * ks][1]); w.y = cvtpk(S[2 * ks][2], S[2 * ks][3]); w.z = cvtpk(S[2 * ks + 1][0], S[2 * ks + 1][1]); w.w = cvtpk(S[2 * ks + 1][2], S[2 * ks + 1][3]);
            const bf16x8 sb = __builtin_bit_cast(bf16x8, w);
#pragma unroll
            for (int mt = 0; mt < 4; ++mt) { const LAS bf16* qp = Q + (16 * mt + fr) * QP + 32 * ks + 4 * g;
                const bf16x8 af = mk_frag(*(const LAS v2u*)qp, *(const LAS v2u*)(qp + 16));
                o[mt] = __builtin_amdgcn_mfma_f32_16x16x32_bf16(af, sb, o[mt], 0, 0, 0); } }
#pragma unroll
        for (int mt = 0; mt < 4; ++mt) { o[mt] = __builtin_amdgcn_mfma_f32_16x16x32_bf16(*(const LAS bf16x8*)(A + (16 * mt + fr) * AP + 8 * g), bv0, o[mt], 0, 0, 0);
            o[mt] = __builtin_amdgcn_mfma_f32_16x16x32_bf16(*(const LAS bf16x8*)(A + (16 * mt + fr) * AP + 32 + 8 * g), bv1, o[mt], 0, 0, 0); }
#pragma unroll
        for (int mt = 0; mt < 8; ++mt) { const f32x4 dl = *(const LAS f32x4*)(DL + 16 * mt + 4 * g); S[mt] = S[mt] * dl;
            S[mt] = __builtin_amdgcn_mfma_f32_16x16x32_bf16(*(const LAS bf16x8*)(KT + (16 * mt + fr) * KP + 8 * g), bv0, S[mt], 0, 0, 0);
            S[mt] = __builtin_amdgcn_mfma_f32_16x16x32_bf16(*(const LAS bf16x8*)(KT + (16 * mt + fr) * KP + 32 + 8 * g), bv1, S[mt], 0, 0, 0); }
        { float s2[16];
#pragma unroll
          for (int i = 0; i < 16; ++i) s2[i] = o[i >> 2][i & 3] * o[i >> 2][i & 3];
#define HG_ROR(n_) _Pragma("unroll") for (int i = 0; i < 16; ++i) s2[i] += __builtin_bit_cast(float, __builtin_amdgcn_update_dpp(0, __builtin_bit_cast(int, s2[i]), 0x120 + (n_), 0xf, 0xf, false));
          HG_ROR(8) HG_ROR(4) HG_ROR(2) HG_ROR(1)
#undef HG_ROR
          if (fr == 0) {
#pragma unroll
              for (int mt = 0; mt < 4; ++mt) *(LAS f32x4*)(red + wave * 64 + 16 * mt + 4 * g) = (f32x4){s2[4 * mt], s2[4 * mt + 1], s2[4 * mt + 2], s2[4 * mt + 3]}; } }
        LDS_WAIT(); __syncthreads();
        const int nvalid = (c == 0) ? NMETA : 64;
        { f32x4 tot[4]; float gr[16];
#pragma unroll
          for (int mt = 0; mt < 4; ++mt) { tot[mt] = *(const LAS f32x4*)(red + 16 * mt + 4 * g);
#pragma unroll
              for (int w = 1; w < 8; ++w) tot[mt] += *(const LAS f32x4*)(red + w * 64 + 16 * mt + 4 * g); }
#pragma unroll
          for (int i = 0; i < 16; ++i) gr[i] = bf2f(G[(16 * (i >> 2) + 4 * g + (i & 3)) * GP + dv]);
          if (c > 0 || b == 0) {
#pragma unroll
              for (int i = 0; i < 16; ++i) { const int t = 16 * (i >> 2) + 4 * g + (i & 3); const int row = (c == 0) ? MREAL + t : b * SEQ + 64 * (c - 1) + t;
                  const float val = o[i >> 2][i & 3] * __builtin_amdgcn_rsqf(tot[i >> 2][i & 3] * (1.f / 128.f) + EPS) * gn * (gr[i] * fast_sigmoid_m(gr[i]));
                  if (t < nvalid) ((bf16*)(F.ws + WS_BR))[(size_t)row * 512 + h * 128 + dv] = (bf16)f2bf_s(val); } } }
        if (c < 64) { HG_COMMIT(buf ^ 1); bv0 = bn0; bv1 = bn1; }
    }
#undef HG_ISSUE
#undef HG_COMMIT
    __syncthreads();
}
__device__ __forceinline__ void conv_row(Frame& F, int l, int r) {
    const int lane = F.lane; const bf16* P = (const bf16*)(F.ws + WS_BIG);
    int r1, r2;
    if (r < MREAL) { const int b = r >> 12, t = r & 4095; r1 = seqrow(b, NMETA + t - 1); r2 = seqrow(b, NMETA + t - 2); }
    else { const int i = r - MREAL; r1 = i >= 1 ? r - 1 : -1; r2 = i >= 2 ? r - 2 : -1; }
    const float* cw = FIN(F, I_CONVW) + l * 3 * 512 + 8 * lane;
    const int r1c = r1 >= 0 ? r1 : r, r2c = r2 >= 0 ? r2 : r;
    const v4u wc0 = *(const GAS v4u*)(P + (size_t)r * NNG + C_BC + 8 * lane), wu0 = *(const GAS v4u*)(P + (size_t)r * NNG + C_BU + 8 * lane), wb = *(const GAS v4u*)(P + (size_t)r * NNG + C_BB + 8 * lane);
    const v4u wc1 = *(const GAS v4u*)(P + (size_t)r1c * NNG + C_BC + 8 * lane), wu1 = *(const GAS v4u*)(P + (size_t)r1c * NNG + C_BU + 8 * lane);
    const v4u wc2 = *(const GAS v4u*)(P + (size_t)r2c * NNG + C_BC + 8 * lane), wu2 = *(const GAS v4u*)(P + (size_t)r2c * NNG + C_BU + 8 * lane);
    __builtin_amdgcn_sched_barrier(0);
    float c0[8], u0[8], bb[8], y[8]; unpack8(wc0, c0); unpack8(wu0, u0); unpack8(wb, bb);
#pragma unroll
    for (int i = 0; i < 8; ++i) y[i] = cw[i] * (c0[i] * u0[i]);
    const float m1 = r1 >= 0 ? 1.f : 0.f, m2 = r2 >= 0 ? 1.f : 0.f;
    unpack8(wc1, c0); unpack8(wu1, u0);
#pragma unroll
    for (int i = 0; i < 8; ++i) y[i] += m1 * cw[512 + i] * (c0[i] * u0[i]);
    unpack8(wc2, c0); unpack8(wu2, u0);
#pragma unroll
    for (int i = 0; i < 8; ++i) y[i] += m2 * cw[1024 + i] * (c0[i] * u0[i]);
#pragma unroll
    for (int i = 0; i < 8; ++i) y[i] *= bb[i];
    *(GAS v4u*)((bf16*)(F.ws + WS_BR) + (size_t)MPAD * 512 + (size_t)r * 512 + 8 * lane) = pack8(y);
}
constexpr int CW_TMO = 0, CW_BAR = 4096, CW_Q = 16384;
__device__ __forceinline__ int queue_pop(Frame& F, int qi) {
    int t = 0; if (F.lane == 0) t = (int)__hip_atomic_fetch_add((unsigned*)(F.ctl + CW_Q + 64 * qi), 1u, RLX_AGENT);
    return __builtin_amdgcn_readfirstlane(t);
}
__device__ __forceinline__ int queue_pop_wg(Frame& F, int qi) {
    LAS int* slot = (LAS int*)(F.lds + 139264);
    __syncthreads();
    if (F.tid == 0) *slot = (int)__hip_atomic_fetch_add((unsigned*)(F.ctl + CW_Q + 64 * qi), 1u, RLX_AGENT);
    LDS_WAIT(); __syncthreads();
    return __builtin_amdgcn_readfirstlane(*slot);
}
__device__ __forceinline__ void phase_hgrn_prep(Frame& F, int l) {
    for (int t = F.bid; t < NB * 4 * 64 + 4; t += F.G) { if (t < 4) hgrn_prep_task(F, l, 0, t, 0); else { const int u = t - 4; hgrn_prep_task(F, l, u >> 8, (u >> 6) & 3, 1 + (u & 63)); } }
}
__device__ __forceinline__ void phase_prep(Frame& F, int l) { const int gw = F.bid * NWAVES + F.wave, NGW = F.G * NWAVES; for (int r = gw; r < MREAL + NMETA; r += NGW) prep_row(F, l, r); }
__device__ __forceinline__ void phase_vt(Frame& F) { const int gw = F.bid * NWAVES + F.wave, NGW = F.G * NWAVES; for (int t = gw; t < VT_NTASK; t += NGW) vt_task(F, t); }
__device__ __forceinline__ void phase_mix1(Frame& F, int l, int qidx) {
    LAS float* bt = (LAS float*)(F.lds + 135168);
    build_bias_table(F, bt, 0);
    __syncthreads();
#ifndef MIX1_SKIP
#define MIX1_SKIP 0
#endif
    const int sk = (qidx >= 4) ? MIX1_SKIP : 0;
    if (F.bid < NIDX_WG) {
        float* slab = (float*)(F.ws + WS_SCR) + (size_t)F.bid * 32 * LPAD;
        if (!(sk & 1)) for (int t = F.bid; t < NB * NQT; t += NIDX_WG) { const int j = NQT - 1 - t / NB, b = t % NB; dsa_index_task(F, b, j, slab); }
    } else if (F.bid < NIDX_WG + NHG_WG) {
        const int u = F.bid - NIDX_WG; if (!(sk & 2)) hgrn_scan_unit(F, l, u >> 2, u & 3);
    } else {
        const int u0 = F.bid - NIDX_WG - NHG_WG, nw = F.G - NIDX_WG - NHG_WG;
        const int cw = u0 * NWAVES + F.wave, ncw = nw * NWAVES; if (!(sk & 4)) for (int r = cw; r < MREAL + NMETA; r += ncw) conv_row(F, l, r);
    }
    float lam, post;
    { const float* lp = FIN(F, I_DLAM) + l * 256; const float s1 = wave_sum(lp[F.lane] * lp[64 + F.lane]), s2 = wave_sum(lp[128 + F.lane] * lp[192 + F.lane]);
      const float li = 0.8f - 0.6f * __expf(-0.3f * (float)l); lam = __expf(s1) - __expf(s2) + li; post = 1.0f - li; }
    for (;;) { const int t = queue_pop_wg(F, qidx) + ((sk & 8) ? (1 << 20) : 0); if (t >= NB * 4 * NQB) break;
        const int J = NQB - 1 - t / 32, bh = t % 32; attn_wg_task<false>(F, l, bh >> 2, bh & 3, J, bt, lam, post); }
}
__device__ __forceinline__ void phase_mix2(Frame& F, int l, int qidx) {
    LAS float* bt = (LAS float*)(F.lds + 135168);
    build_bias_table(F, bt, 4);
    __syncthreads();
    for (;;) { const int t = queue_pop_wg(F, qidx); if (t >= NB * 4 * NQB) break;
        const int J = NQB - 1 - t / 32, bh = t % 32; attn_wg_task<true>(F, l, bh >> 2, bh & 3, J, bt, 0.f, 1.f); }
}

#ifndef MK_ONE
#define MK_ONE 0
#endif
#ifndef BR_MASK
#define BR_MASK 15
#endif
constexpr int NPH = 18;
template <class T> __device__ __forceinline__ T opaque(T v) { asm volatile("" : "+s"(v)); return v; }
struct Args { const float* in[22]; float* out; unsigned char* ws; int ph_lo, ph_hi; };
__global__ void __launch_bounds__(NWAVES * 64, 2) fwd(Args args) {
    extern __shared__ __attribute__((aligned(16))) unsigned char lds[];
    Frame F;
    F.lds = (LAS unsigned char*)lds; F.MISC = (volatile LAS unsigned*)(F.lds + MISC_OFF);
    F.tid = threadIdx.x; F.lane = F.tid & 63; F.wave = __builtin_amdgcn_readfirstlane(F.tid >> 6); F.G = gridDim.x; F.bid = blockIdx.x;
    F.ws = args.ws; F.out = args.out; F.ctl = (gu32*)(args.ws + WS_CTL);
    F.karg = (const unsigned char __attribute__((address_space(4)))*)__builtin_amdgcn_kernarg_segment_ptr();
    for (int u = F.tid; u < (LDS_BYTES - LDSCTL_OFF) / 4; u += NWAVES * 64) ((LAS unsigned*)(F.lds + LDSCTL_OFF))[u] = 0u;
    __syncthreads();
#if MK_ONE
    XcdBarrier bar = xcd_barrier_post((unsigned*)(F.ctl + CW_BAR), F.MISC + 8, __builtin_amdgcn_readfirstlane(threadIdx.x >> 6));
#ifdef PROBE_BAR2
#define GRID_BAR() do { xcd_barrier(bar); xcd_barrier(bar); } while (0)
#else
#define GRID_BAR() xcd_barrier(bar)
#endif
#else
#define GRID_BAR() do { } while (0)
#endif
    const int wave_s = __builtin_amdgcn_readfirstlane(threadIdx.x >> 6);
    const int lo = args.ph_lo, hi = args.ph_hi;
#define IN(k) (lo <= (k) && (k) < hi)
#define RETID() do { int w_ = wave_s; asm volatile("" : "+s"(w_)); unsigned mk_ = ~0u; asm volatile("" : "+s"(mk_)); int t_ = w_ * 64 + (int)__builtin_amdgcn_mbcnt_hi(mk_, __builtin_amdgcn_mbcnt_lo(mk_, 0u)); asm volatile("" : "+v"(t_)); F.tid = t_; F.lane = t_ & 63; F.wave = w_; } while (0)
#ifdef DBG_TS
#define STAMP(k) do { if (blockIdx.x == 0 && threadIdx.x == 0) ((unsigned long long*)(args.ws + 768 * 1024))[(k)] = __builtin_amdgcn_s_memrealtime(); } while (0)
#else
#define STAMP(k) do { } while (0)
#endif
#define SEAM(k) do { if (IN((k) + 1)) GRID_BAR(); STAMP((k) + 1); } while (0)
#ifndef PROBE_EPI
#define PROBE_EPI 0
#endif
#ifdef PROBE_MASK
#define NREP(kk) opaque(((PROBE_MASK >> (kk)) & 1) ? 1 + PROBE_EXTRA : 1)
#define REP_BEGIN(kk) { const int nrep_ = NREP(kk); for (int rep = 0; rep < nrep_; ++rep) { if (rep) GRID_BAR();
#define REP_END } }
#else
#define REP_BEGIN(kk) { { const int rep = 0; (void)rep;
#define REP_END } }
#endif
    STAMP(0);
    unsigned char* wb = F.ws + WS_W;
    bf16* XN = (bf16*)(F.ws + WS_XN); bf16* BR = (bf16*)(F.ws + WS_BR); bf16* BIG = (bf16*)(F.ws + WS_BIG); float* HM = (float*)(F.ws + WS_HM);
    auto layer = [&](const int l) __attribute__((always_inline)) {
        const int pb = l * NPH;
        const float* hsrc = (l == 0) ? FIN(F, I_X) : F.out;
        if (IN(pb + 0)) { REP_BEGIN(0) RETID(); phase_convert(F, l); REP_END SEAM(pb + 0); }
        if (IN(pb + 1)) { REP_BEGIN(1) RETID(); phase_norm(F, hsrc, FIN(F, I_F1N) + l * DM); REP_END SEAM(pb + 1); }
        if (IN(pb + 2)) { REP_BEGIN(2) RETID(); meta_gemm(F, 0, XN + (size_t)MREAL * DM, DM, (const bf16*)(wb + W_GU1), NGU, DM, BIG, DFF, 0.f); pg8::Gemm g{opaque((const bf16*)(XN)), opaque((const bf16*)(wb + W_GU1)), MREAL, NGU, DM}; pg8::StaticOrder S; S.init(MREAL, NGU, F.G, opaque(F.bid));
            pg8::EpiSwiGLU E{BIG, DFF, rep ? PROBE_EPI : 0}; pg8::gemm_phase<pg8::EpiSwiGLU, pg8::StaticOrder, true, true>(F.lds + RING_OFF, g, S, E, F.tid); REP_END SEAM(pb + 2); }
        if (IN(pb + 3)) { REP_BEGIN(3) RETID(); meta_gemm(F, 1, BIG + (size_t)MREAL * DFF, DFF, (const bf16*)(wb + W_D1), DM, DFF, nullptr, 0, rep ? 0.f : 0.5f); pg8::Gemm g{opaque((const bf16*)(BIG)), opaque((const bf16*)(wb + W_D1)), MREAL, DM, DFF}; pg8::StaticOrder S; S.init(MREAL, DM, F.G, opaque(F.bid));
            pg8::EpiResF32 E{rep ? F.out : hsrc, F.out, HM, DM, MT_REAL, rep ? 0.f : 0.5f}; pg8::gemm_phase<pg8::EpiResF32, pg8::StaticOrder, true, true>(F.lds + RING_OFF, g, S, E, F.tid); REP_END SEAM(pb + 3); }
        if (IN(pb + 4)) { REP_BEGIN(4) RETID(); phase_norm(F, F.out, FIN(F, I_MIXN) + l * DM); REP_END SEAM(pb + 4); }
        if (IN(pb + 5)) { REP_BEGIN(5) RETID(); meta_gemm(F, 2, XN + (size_t)MREAL * DM, DM, (const bf16*)(wb + W_NG), NNG, DM, BIG, NNG, 0.f); pg8::Gemm g{opaque((const bf16*)(XN)), opaque((const bf16*)(wb + W_NG)), MREAL, NNG, DM}; pg8::StaticOrder S; S.init(MREAL, NNG, F.G, opaque(F.bid));
            pg8::EpiBf16<0> E{BIG, NNG}; pg8::gemm_phase<pg8::EpiBf16<0>, pg8::StaticOrder, true, true>(F.lds + RING_OFF, g, S, E, F.tid); REP_END SEAM(pb + 5); }
        if (IN(pb + 6)) { RETID(); phase_prep(F, l); phase_vt(F); __syncthreads(); phase_hgrn_prep(F, l); SEAM(pb + 6); }
#ifdef DUP_MIX
        if (IN(pb + 7)) { const int nrep = opaque(DUP_MIX1); for (int rep = 0; rep < nrep; ++rep) { RETID(); phase_mix1(F, l, 4 * rep + 2 * l); GRID_BAR(); } }
        if (IN(pb + 8)) { const int nrep = opaque(DUP_MIX2); for (int rep = 0; rep < nrep; ++rep) { RETID(); phase_mix2(F, l, 4 * rep + 2 * l + 1); GRID_BAR(); } }
#else
        if (IN(pb + 7)) { RETID(); phase_mix1(F, l, 2 * l); SEAM(pb + 7); }
        if (IN(pb + 8)) { RETID(); phase_mix2(F, l, 2 * l + 1); SEAM(pb + 8); }
#endif
        if (IN(pb + 9)) { REP_BEGIN(9) RETID(); meta_gemm(F, 3, XN + (size_t)MREAL * DM, DM, (const bf16*)(wb + W_G), NGATE, DM, BIG, NGATE, 0.f); pg8::Gemm g{opaque((const bf16*)(XN)), opaque((const bf16*)(wb + W_G)), MREAL, NGATE, DM}; pg8::StaticOrder S; S.init(MREAL, NGATE, F.G, opaque(F.bid));
            pg8::EpiBf16<1> E{BIG, NGATE}; pg8::gemm_phase<pg8::EpiBf16<1>, pg8::StaticOrder, true, true>(F.lds + RING_OFF, g, S, E, F.tid); REP_END SEAM(pb + 9); }
        if (IN(pb + 10)) { REP_BEGIN(10) RETID(); meta_gemm(F, 4, BR + (size_t)MREAL * 512, 512, (const bf16*)(wb + W_BR), DM, 512, XN, DM, 0.f);
            pg8::Gemm g{opaque((const bf16*)(BR)), opaque((const bf16*)(wb + W_BR)), MREAL, DM, 512}; pg8::MergeOrder S; S.init(MREAL, DM, F.G, opaque(F.bid), MPAD / 256);
            pg8::EpiGateAccM E{XN, DM, BIG, NGATE, MPAD / 256, DM / 256}; pg8::gemm_phase<pg8::EpiGateAccM, pg8::MergeOrder, true, true>(F.lds + RING_OFF, g, S, E, F.tid); REP_END SEAM(pb + 10); }
        if (IN(pb + 14) && BR_MASK) { REP_BEGIN(14) RETID(); meta_gemm(F, 1, XN + (size_t)MREAL * DM, DM, (const bf16*)(wb + W_O), DM, DM, nullptr, 0, rep ? 0.f : 1.0f); pg8::Gemm g{opaque((const bf16*)(XN)), opaque((const bf16*)(wb + W_O)), MREAL, DM, DM}; pg8::StaticOrder S; S.init(MREAL, DM, F.G, opaque(F.bid));
            pg8::EpiResF32 E{F.out, F.out, HM, DM, MT_REAL, rep ? 0.f : 1.0f}; pg8::gemm_phase<pg8::EpiResF32, pg8::StaticOrder, true, true>(F.lds + RING_OFF, g, S, E, F.tid); REP_END SEAM(pb + 14); }
        if (IN(pb + 15)) { REP_BEGIN(15) RETID(); phase_norm(F, F.out, FIN(F, I_F2N) + l * DM); REP_END SEAM(pb + 15); }
        if (IN(pb + 16)) { REP_BEGIN(16) RETID(); meta_gemm(F, 0, XN + (size_t)MREAL * DM, DM, (const bf16*)(wb + W_GU2), NGU, DM, BIG, DFF, 0.f); pg8::Gemm g{opaque((const bf16*)(XN)), opaque((const bf16*)(wb + W_GU2)), MREAL, NGU, DM}; pg8::StaticOrder S; S.init(MREAL, NGU, F.G, opaque(F.bid));
            pg8::EpiSwiGLU E{BIG, DFF, rep ? PROBE_EPI : 0}; pg8::gemm_phase<pg8::EpiSwiGLU, pg8::StaticOrder, true, true>(F.lds + RING_OFF, g, S, E, F.tid); REP_END SEAM(pb + 16); }
        if (IN(pb + 17)) { REP_BEGIN(17) RETID(); meta_gemm(F, 1, BIG + (size_t)MREAL * DFF, DFF, (const bf16*)(wb + W_D2), DM, DFF, nullptr, 0, rep ? 0.f : 0.5f); pg8::Gemm g{opaque((const bf16*)(BIG)), opaque((const bf16*)(wb + W_D2)), MREAL, DM, DFF}; pg8::StaticOrder S; S.init(MREAL, DM, F.G, opaque(F.bid));
            pg8::EpiResF32 E{F.out, F.out, HM, DM, MT_REAL, rep ? 0.f : 0.5f}; pg8::gemm_phase<pg8::EpiResF32, pg8::StaticOrder, true, true>(F.lds + RING_OFF, g, S, E, F.tid); REP_END SEAM(pb + 17); }
    };
    layer(0); layer(1);
}

extern "C" void kernel_launch(void* const* d_in, const int* in_sizes, int n_in, void* d_out, int out_size, void* d_ws, size_t ws_size, hipStream_t stream) {
    static int grid = 0;
    if (grid == 0) {
        if (n_in != 22 || out_size != MREAL * DM || ws_size < WS_END) { fprintf(stderr, "kernel_launch: unexpected shapes (n_in %d out %d ws %zu need %zu)\n", n_in, out_size, ws_size, (size_t)WS_END); grid = -1; return; }
        int dev = 0, cus = 0, per_cu = 0;
        if (hipGetDevice(&dev) != hipSuccess || hipDeviceGetAttribute(&cus, hipDeviceAttributeMultiprocessorCount, dev) != hipSuccess) { grid = -1; return; }
        if (hipFuncSetAttribute((const void*)fwd, hipFuncAttributeMaxDynamicSharedMemorySize, LDS_BYTES) != hipSuccess) { fprintf(stderr, "kernel_launch: hipFuncSetAttribute failed\n"); grid = -1; return; }
        if (hipOccupancyMaxActiveBlocksPerMultiprocessor(&per_cu, (const void*)fwd, NWAVES * 64, LDS_BYTES) != hipSuccess || per_cu < 1) fprintf(stderr, "kernel_launch: occupancy query says %d\n", per_cu);
        (void)hipGetLastError();
        grid = cus < 256 ? cus : 256;
    }
    if (grid < 0) return;
    (void)hipMemsetAsync((char*)d_ws + WS_CTL, 0, CTL_ZERO_BYTES, stream);
    Args a{};
    for (int i = 0; i < 22; ++i) a.in[i] = (const float*)d_in[i];
    a.out = (float*)d_out; a.ws = (unsigned char*)d_ws;
#ifndef PH_END
#define PH_END (2 * NPH)
#endif
#if MK_ONE
    a.ph_lo = 0; a.ph_hi = PH_END;
    hipLaunchKernelGGL(fwd, dim3(grid), dim3(NWAVES * 64), LDS_BYTES, stream, a);
#else
    for (int p = 0; p < PH_END; ++p) { a.ph_lo = p; a.ph_hi = p + 1;
        hipLaunchKernelGGL(fwd, dim3(grid), dim3(NWAVES * 64), LDS_BYTES, stream, a); }
#endif
}
```

```cpp
#include <hip/hip_runtime.h>
#include <cstdio>
#include <cstdint>
#define MK_ONE 1
namespace pg8 {
#define PG8_LAS __attribute__((address_space(3)))
typedef unsigned short bf16_t;
typedef short bf16x8 __attribute__((ext_vector_type(8)));
typedef float f32x4 __attribute__((ext_vector_type(4)));
typedef unsigned u32x4 __attribute__((ext_vector_type(4)));
constexpr int BM = 256, BK = 64, HALF = 128, HTB = HALF * BK * 2  , STAGE_BYTES = 8 * HTB, NXCD = 8, WGM = 4;

__host__ __device__ __forceinline__ int lds_byte(int r, int c) { const int st = (r >> 4) * 2 + (c >> 5), rr = r & 15, cc = c & 31, ob = rr * 64 + cc * 2; return st * 1024 + (ob ^ (((ob >> 9) & 1) << 5)); }
__host__ __device__ __forceinline__ void stage_rc(int b, int& R, int& C) { const int st = b / 1024, sb = b % 1024, swz = sb ^ (((sb >> 9) & 1) << 5); R = (st >> 1) * 16 + swz / 64; C = (st & 1) * 32 + (swz % 64) / 2; }
__host__ __device__ __forceinline__ int perm32(int rho) { const int n = rho >> 4, i = rho & 15; return 8 * (i >> 2) + 4 * n + (i & 3); }

struct Unit { int pm, pn; };
struct Gemm { const bf16_t* A; const bf16_t* Bt; int M, N, K; };

struct StaticOrder {
    int nM, nN, nwg, G, c;
    __host__ __device__ void init(int M, int N, int G_, int c_) { nM = M / BM; nN = N / BM; nwg = nM * nN; G = G_; c = c_; }
    __host__ __device__ bool next(int i, Unit& u) const {
        const long L = (long)i * G + c; if (L >= nwg) return false;
        int wgid = (int)L; { const int q = nwg / NXCD, r = nwg % NXCD, xcd = wgid % NXCD, off = wgid / NXCD; wgid = (xcd < r ? xcd * (q + 1) : r * (q + 1) + (xcd - r) * q) + off; }
        const int nig = WGM * nN, gid = wgid / nig, fm = gid * WGM, gsz = (nM - fm) < WGM ? (nM - fm) : WGM;
        u.pm = fm + ((wgid % nig) % gsz); u.pn = (wgid % nig) / gsz; return true;
    }
    __device__ __forceinline__ void a_ready(const Unit&) const {}
    __device__ __forceinline__ void done(const Unit&) const {}
};
typedef __bf16 bf16x2_hw __attribute__((ext_vector_type(2))); typedef float f32x2_hw __attribute__((ext_vector_type(2)));
__device__ __forceinline__ unsigned cvt_pk_bf16(float lo, float hi) { const f32x2_hw v = {lo, hi}; return __builtin_bit_cast(unsigned, __builtin_convertvector(v, bf16x2_hw)); }
typedef float f32x2 __attribute__((ext_vector_type(2)));
__device__ __forceinline__ float fast_sigmoid(float x) { return __builtin_amdgcn_rcpf(1.0f + __expf(-x)); }
__device__ __forceinline__ float fast_silu(float x) { return x * fast_sigmoid(x); }
template <int ACT  > struct EpiBf16 {
    static constexpr bool PERM = true, AFTER_DRAIN = false;
    bf16_t* O; int ldc;
    __device__ __forceinline__ void operator()(const f32x4 (&acc)[2][2][4][2], const Unit& u, int wr, int wc, int fr, int fq) const {
        const int row0 = u.pm * BM + wr * 64 + fr; const int col0 = u.pn * BM + wc * 32 + 8 * fq;
#pragma unroll
        for (int ai = 0; ai < 2; ++ai)
#pragma unroll
            for (int m = 0; m < 4; ++m) { bf16_t* rowp = O + (size_t)(row0 + ai * HALF + m * 16) * ldc + col0;
#pragma unroll
                for (int bj = 0; bj < 2; ++bj) { f32x4 v0 = acc[ai][bj][m][0], v1 = acc[ai][bj][m][1];
                    if (ACT == 1) {
#pragma unroll
                        for (int j = 0; j < 4; ++j) { v0[j] = fast_sigmoid(v0[j]); v1[j] = fast_sigmoid(v1[j]); } }
                    u32x4 w; w.x = cvt_pk_bf16(v0[0], v0[1]); w.y = cvt_pk_bf16(v0[2], v0[3]); w.z = cvt_pk_bf16(v1[0], v1[1]); w.w = cvt_pk_bf16(v1[2], v1[3]);
                    *(u32x4*)(rowp + bj * HALF) = w; } }
    }
};
struct EpiSwiGLU {
    static constexpr bool PERM = true, AFTER_DRAIN = false;
    bf16_t* O; int ldc; int mode;
    __device__ __forceinline__ void operator()(const f32x4 (&acc)[2][2][4][2], const Unit& u, int wr, int wc, int fr, int fq) const {
        if (mode == 2) return;
        const int row0 = u.pm * BM + wr * 64 + fr; const int col0 = u.pn * HALF + wc * 32 + 8 * fq;
#pragma unroll
        for (int ai = 0; ai < 2; ++ai)
#pragma unroll
            for (int m = 0; m < 4; ++m) { bf16_t* rowp = O + (size_t)(row0 + ai * HALF + m * 16) * ldc + col0;
                const f32x4 g0 = acc[ai][0][m][0], g1 = acc[ai][0][m][1], u0 = acc[ai][1][m][0], u1 = acc[ai][1][m][1];
                f32x4 v0, v1;
#pragma unroll
                for (int j = 0; j < 4; ++j) { v0[j] = fast_silu(g0[j]) * u0[j]; v1[j] = fast_silu(g1[j]) * u1[j]; }
                u32x4 w; w.x = cvt_pk_bf16(v0[0], v0[1]); w.y = cvt_pk_bf16(v0[2], v0[3]); w.z = cvt_pk_bf16(v1[0], v1[1]); w.w = cvt_pk_bf16(v1[2], v1[3]);
                if (mode == 0) *(u32x4*)rowp = w; else asm volatile("" :: "v"(w.x), "v"(w.y), "v"(w.z), "v"(w.w));
                asm volatile("" ::: "memory"); }
    }
};
struct EpiResF32 {
    static constexpr bool PERM = false, AFTER_DRAIN = false;
    const float* base_r; float* out_r; float* hm; int ldc; int mt_real; float scale;
    __device__ __forceinline__ void operator()(const f32x4 (&acc)[2][2][4][2], const Unit& u, int wr, int wc, int fr, int fq) const {
        const bool real = u.pm < mt_real;
        const float* bp = real ? base_r + (size_t)u.pm * BM * ldc : hm; float* op = real ? out_r + (size_t)u.pm * BM * ldc : hm;
        const int row0 = wr * 64 + fr, col0 = u.pn * BM + wc * 32 + 4 * fq;
#pragma unroll
        for (int ai = 0; ai < 2; ++ai) {
            f32x4 b[4][2][2];
#pragma unroll
            for (int m = 0; m < 4; ++m) { const size_t off = (size_t)(row0 + ai * HALF + m * 16) * ldc + col0;
#pragma unroll
                for (int bj = 0; bj < 2; ++bj)
#pragma unroll
                    for (int n = 0; n < 2; ++n) b[m][bj][n] = *(const f32x4*)(bp + off + bj * HALF + n * 16); }
            asm volatile("" ::: "memory");
#pragma unroll
            for (int m = 0; m < 4; ++m) { const size_t off = (size_t)(row0 + ai * HALF + m * 16) * ldc + col0;
#pragma unroll
                for (int bj = 0; bj < 2; ++bj)
#pragma unroll
                    for (int n = 0; n < 2; ++n) *(f32x4*)(op + off + bj * HALF + n * 16) = b[m][bj][n] + acc[ai][bj][m][n] * scale; }
            asm volatile("" ::: "memory"); }
    }
};
struct EpiGateAcc {
    static constexpr bool PERM = true, AFTER_DRAIN = false;
    bf16_t* MG; int ldc; const bf16_t* G; int ldg; int gcol0; int first;
    __device__ __forceinline__ void operator()(const f32x4 (&acc)[2][2][4][2], const Unit& u, int wr, int wc, int fr, int fq) const {
        const int row0 = u.pm * BM + wr * 64 + fr; const int col0 = u.pn * BM + wc * 32 + 8 * fq;
#pragma unroll
        for (int ai = 0; ai < 2; ++ai)
#pragma unroll
            for (int m = 0; m < 4; ++m) { const size_t r = (size_t)(row0 + ai * HALF + m * 16);
#pragma unroll
                for (int bj = 0; bj < 2; ++bj) { const u32x4 gw = *(const u32x4*)(G + r * ldg + gcol0 + col0 + bj * HALF);
                    u32x4 pw = (u32x4){0u, 0u, 0u, 0u}; if (!first) pw = *(const u32x4*)(MG + r * ldc + col0 + bj * HALF);
                    float o[8];
#pragma unroll
                    for (int j = 0; j < 4; ++j) { const float a0 = (j < 2) ? acc[ai][bj][m][0][2 * j] : acc[ai][bj][m][1][2 * (j - 2)], a1 = (j < 2) ? acc[ai][bj][m][0][2 * j + 1] : acc[ai][bj][m][1][2 * (j - 2) + 1];
                        o[2 * j] = __uint_as_float(pw[j] << 16) + __uint_as_float(gw[j] << 16) * a0; o[2 * j + 1] = __uint_as_float(pw[j] & 0xffff0000u) + __uint_as_float(gw[j] & 0xffff0000u) * a1; }
                    u32x4 w; w.x = cvt_pk_bf16(o[0], o[1]); w.y = cvt_pk_bf16(o[2], o[3]); w.z = cvt_pk_bf16(o[4], o[5]); w.w = cvt_pk_bf16(o[6], o[7]);
                    *(u32x4*)(MG + r * ldc + col0 + bj * HALF) = w; } }
    }
};

struct MergeOrder {
    int nM, nN, G, c, mt_alloc;
    __host__ __device__ void init(int M, int N, int G_, int c_, int mt_alloc_) { nM = M / BM; nN = N / BM; G = G_; c = c_; mt_alloc = mt_alloc_; }
    __host__ __device__ bool next(int i, Unit& u) const { const int t = (i >> 2) * G + c, m = i & 3; if (t >= nM * nN) return false;
        const int pm = t / nN, pn = t % nN; u.pm = m * mt_alloc + pm; u.pn = m * nN + pn; return true; }
    __device__ __forceinline__ void a_ready(const Unit&) const {}
    __device__ __forceinline__ void done(const Unit&) const {}
};
struct EpiGateAccM {
    static constexpr bool PERM = true, AFTER_DRAIN = false;
    bf16_t* MG; int ldc; const bf16_t* G; int ldg; int mt_alloc; int ntn;
    __device__ __forceinline__ void operator()(const f32x4 (&acc)[2][2][4][2], const Unit& u, int wr, int wc, int fr, int fq) const {
        const int m = u.pm / mt_alloc, pm = u.pm - m * mt_alloc, pn = u.pn - m * ntn;
        const int row0 = pm * BM + wr * 64 + fr; const int col0 = pn * BM + wc * 32 + 8 * fq; const int gcol0 = m * ntn * BM;
#pragma unroll
        for (int ai = 0; ai < 2; ++ai)
#pragma unroll
            for (int mm = 0; mm < 4; ++mm) { const size_t r = (size_t)(row0 + ai * HALF + mm * 16);
#pragma unroll
                for (int bj = 0; bj < 2; ++bj) { const u32x4 gw = *(const u32x4*)(G + r * ldg + gcol0 + col0 + bj * HALF);
                    u32x4 pw = (u32x4){0u, 0u, 0u, 0u}; if (m != 0) pw = *(const u32x4*)(MG + r * ldc + col0 + bj * HALF);
                    float o[8];
#pragma unroll
                    for (int j = 0; j < 4; ++j) { const float a0 = (j < 2) ? acc[ai][bj][mm][0][2 * j] : acc[ai][bj][mm][1][2 * (j - 2)], a1 = (j < 2) ? acc[ai][bj][mm][0][2 * j + 1] : acc[ai][bj][mm][1][2 * (j - 2) + 1];
                        o[2 * j] = __uint_as_float(pw[j] << 16) + __uint_as_float(gw[j] << 16) * a0; o[2 * j + 1] = __uint_as_float(pw[j] & 0xffff0000u) + __uint_as_float(gw[j] & 0xffff0000u) * a1; }
                    u32x4 w; w.x = cvt_pk_bf16(o[0], o[1]); w.y = cvt_pk_bf16(o[2], o[3]); w.z = cvt_pk_bf16(o[4], o[5]); w.w = cvt_pk_bf16(o[6], o[7]);
                    *(u32x4*)(MG + r * ldc + col0 + bj * HALF) = w; } }
    }
};
template <class Epi, class Sched, bool ALIGN_EPI = false, bool SP2 = false>
__device__ __forceinline__ void gemm_phase(PG8_LAS unsigned char* lds, const Gemm g, const Sched& S, const Epi& E, int tid_in) {
    int tid_ = tid_in; asm volatile("" : "+v"(tid_));
    const int tid = tid_, wid = __builtin_amdgcn_readfirstlane(tid >> 6), lane = tid & 63, wr = wid >> 2, wc = wid & 3, fr = lane & 15, fq = lane >> 4;
    const int K = g.K, nt = K / BK;
    unsigned voffA[2], voffB[2];
#pragma unroll
    for (int i = 0; i < 2; ++i) { int R, C; stage_rc(tid * 16 + i * 8192, R, C); const int Rb = Epi::PERM ? ((R & ~31) + perm32(R & 31)) : R;
        voffA[i] = (unsigned)(R * K + C) * 2u; voffB[i] = (unsigned)(Rb * K + C) * 2u; }
    const size_t kstep = (size_t)(BK * 2);
    const size_t hstep = (size_t)HALF * K * 2;
    const size_t tstep = 2 * hstep;
    const unsigned ldsw = (unsigned)wid * 1024u;
    const int aoff = lds_byte(wr * 64 + fr, fq * 8), boff = lds_byte(wc * 32 + fr, fq * 8);
#define PG8_SA(b, h) (((b) * 2 + (h)) * HTB)
#define PG8_SB(b, h) ((4 + (b) * 2 + (h)) * HTB)
#define PG8_STAGE(bufoff, gbase, voff) do { _Pragma("unroll") for (int _i = 0; _i < 2; ++_i) \
        __builtin_amdgcn_global_load_lds((const unsigned*)((const char*)(gbase) + (voff)[_i]), (PG8_LAS unsigned*)(lds + (bufoff) + ldsw + _i * 8192), 16, 0, 0); } while (0)
#define PG8_LDA(dst, b, h) do { _Pragma("unroll") for (int m = 0; m < 4; ++m) _Pragma("unroll") for (int k = 0; k < 2; ++k) dst[m][k] = *(const PG8_LAS bf16x8*)(lds + PG8_SA(b, h) + aoff + m * 2048 + k * 1024); } while (0)
#define PG8_LDB(dst, b, h) do { _Pragma("unroll") for (int n = 0; n < 2; ++n) _Pragma("unroll") for (int k = 0; k < 2; ++k) dst[n][k] = *(const PG8_LAS bf16x8*)(lds + PG8_SB(b, h) + boff + n * 2048 + k * 1024); } while (0)
#define PG8_MMA(ai, bj, At, Bt) do { __builtin_amdgcn_s_setprio(1); _Pragma("unroll") for (int m = 0; m < 4; ++m) _Pragma("unroll") for (int n = 0; n < 2; ++n) _Pragma("unroll") for (int k = 0; k < 2; ++k) \
        acc[ai][bj][m][n] = __builtin_amdgcn_mfma_f32_16x16x32_bf16(Bt[n][k], At[m][k], acc[ai][bj][m][n], 0, 0, 0); __builtin_amdgcn_s_setprio(0); } while (0)
#define PG8_WAIT_V(n) asm volatile("s_waitcnt vmcnt(" #n ")" ::: "memory")
#define PG8_WAIT_L(n) asm volatile("s_waitcnt lgkmcnt(" #n ")" ::: "memory")
#define PG8_BAR __builtin_amdgcn_s_barrier()
#define PG8_SCHED __builtin_amdgcn_sched_barrier(0)
    Unit cur, nxt; int ui = 0;
    if (!S.next(0, cur)) return;
    f32x4 acc[2][2][4][2];
#pragma unroll
    for (int a = 0; a < 2; ++a)
#pragma unroll
        for (int b = 0; b < 2; ++b)
#pragma unroll
            for (int m = 0; m < 4; ++m)
#pragma unroll
                for (int n = 0; n < 2; ++n) acc[a][b][m][n] = (f32x4){0.f, 0.f, 0.f, 0.f};
    bf16x8 At[4][2], B0[2][2], B1[2][2];
    const char* cA = (const char*)g.A + (size_t)cur.pm * tstep; const char* cB = (const char*)g.Bt + (size_t)cur.pn * tstep;
    S.a_ready(cur);
    if constexpr (SP2) {
        PG8_STAGE(PG8_SB(0, 0), cB, voffB); PG8_STAGE(PG8_SB(0, 1), cB + hstep, voffB); PG8_STAGE(PG8_SA(0, 0), cA, voffA); PG8_STAGE(PG8_SA(0, 1), cA + hstep, voffA);
        if (wr == 1) PG8_BAR;
        PG8_WAIT_V(2); PG8_BAR;
        PG8_STAGE(PG8_SB(1, 0), cB + kstep, voffB); PG8_STAGE(PG8_SA(1, 0), cA + kstep, voffA); PG8_STAGE(PG8_SB(1, 1), cB + hstep + kstep, voffB);
        PG8_WAIT_V(6); PG8_BAR;
    } else {
        PG8_STAGE(PG8_SB(0, 0), cB, voffB); PG8_STAGE(PG8_SA(0, 0), cA, voffA); PG8_STAGE(PG8_SB(0, 1), cB + hstep, voffB); PG8_STAGE(PG8_SA(0, 1), cA + hstep, voffA);
        if (wr == 1) PG8_BAR;
        PG8_WAIT_V(4); PG8_BAR;
        PG8_STAGE(PG8_SB(1, 0), cB + kstep, voffB); PG8_STAGE(PG8_SA(1, 0), cA + kstep, voffA); PG8_STAGE(PG8_SB(1, 1), cB + hstep + kstep, voffB);
        PG8_WAIT_V(6); PG8_BAR;
    }
    for (;;) {
        const bool has_next = S.next(ui + 1, nxt);
        const char* nA = has_next ? (const char*)g.A + (size_t)nxt.pm * tstep : cA; const char* nB = has_next ? (const char*)g.Bt + (size_t)nxt.pn * tstep : cB;
        for (int t = 0; t < nt; t += 2) {
            const bool last = (t == nt - 2);
            const char* a1 = cA + (size_t)(t + 1) * kstep;
            const char* a2 = last ? nA : cA + (size_t)(t + 2) * kstep; const char* b2 = last ? nB : cB + (size_t)(t + 2) * kstep;
            const char* a3 = a2 + kstep; const char* b3 = b2 + kstep;
            if (last && has_next) S.a_ready(nxt);
            if constexpr (SP2) {
            PG8_LDB(B0, 0, 0); PG8_LDB(B1, 0, 1); PG8_SCHED; PG8_LDA(At, 0, 0); PG8_STAGE(PG8_SA(1, 1), a1 + hstep, voffA);
            PG8_WAIT_V(8); PG8_WAIT_L(0); PG8_BAR; PG8_MMA(0, 0, At, B0); PG8_MMA(0, 1, At, B1); PG8_BAR; PG8_SCHED;
            PG8_LDA(At, 0, 1); PG8_STAGE(PG8_SB(0, 0), b2, voffB); PG8_STAGE(PG8_SB(0, 1), b2 + hstep, voffB); PG8_STAGE(PG8_SA(0, 0), a2, voffA);
            PG8_WAIT_V(8); PG8_WAIT_L(0); PG8_BAR; PG8_MMA(1, 0, At, B0); PG8_MMA(1, 1, At, B1); PG8_BAR; PG8_SCHED;
            PG8_LDB(B0, 1, 0); PG8_LDB(B1, 1, 1); PG8_SCHED; PG8_LDA(At, 1, 0); PG8_STAGE(PG8_SA(0, 1), a2 + hstep, voffA);
            PG8_WAIT_V(8); PG8_WAIT_L(0); PG8_BAR; PG8_MMA(0, 0, At, B0); PG8_MMA(0, 1, At, B1); PG8_BAR; PG8_SCHED;
            PG8_LDA(At, 1, 1); PG8_STAGE(PG8_SB(1, 0), b3, voffB); PG8_STAGE(PG8_SB(1, 1), b3 + hstep, voffB); PG8_STAGE(PG8_SA(1, 0), a3, voffA);
            PG8_WAIT_V(8); PG8_WAIT_L(0); PG8_BAR; PG8_MMA(1, 0, At, B0); PG8_MMA(1, 1, At, B1); PG8_BAR; PG8_SCHED;
            } else {
            PG8_LDB(B0, 0, 0); PG8_SCHED; PG8_LDA(At, 0, 0); PG8_STAGE(PG8_SA(1, 1), a1 + hstep, voffA);
            PG8_WAIT_L(8); PG8_BAR; PG8_WAIT_L(0); PG8_MMA(0, 0, At, B0); PG8_BAR; PG8_SCHED;
            PG8_LDB(B1, 0, 1); PG8_STAGE(PG8_SB(0, 0), b2, voffB);
            PG8_BAR; PG8_WAIT_L(0); PG8_MMA(0, 1, At, B1); PG8_BAR;
            PG8_LDA(At, 0, 1); PG8_STAGE(PG8_SA(0, 0), a2, voffA);
            PG8_BAR; PG8_WAIT_L(0); PG8_MMA(1, 0, At, B0); PG8_BAR; PG8_SCHED;
            PG8_STAGE(PG8_SB(0, 1), b2 + hstep, voffB);
            PG8_WAIT_V(6); PG8_BAR; PG8_MMA(1, 1, At, B1); PG8_BAR;
            PG8_LDB(B0, 1, 0); PG8_SCHED; PG8_LDA(At, 1, 0); PG8_STAGE(PG8_SA(0, 1), a2 + hstep, voffA);
            PG8_WAIT_L(8); PG8_BAR; PG8_WAIT_L(0); PG8_MMA(0, 0, At, B0); PG8_BAR; PG8_SCHED;
            PG8_LDB(B1, 1, 1); PG8_STAGE(PG8_SB(1, 0), b3, voffB);
            PG8_BAR; PG8_WAIT_L(0); PG8_MMA(0, 1, At, B1); PG8_BAR;
            PG8_LDA(At, 1, 1); PG8_STAGE(PG8_SA(1, 0), a3, voffA);
            PG8_BAR; PG8_WAIT_L(0); PG8_MMA(1, 0, At, B0); PG8_BAR; PG8_SCHED;
            PG8_STAGE(PG8_SB(1, 1), b3 + hstep, voffB);
            PG8_WAIT_V(6); PG8_BAR; PG8_MMA(1, 1, At, B1); PG8_BAR;
            }
        }
        if constexpr (ALIGN_EPI) { if (wr == 0) PG8_BAR; }
        if constexpr (!Epi::AFTER_DRAIN) { E(acc, cur, wr, wc, fr, fq); S.done(cur); }
        if (!has_next) break;
#pragma unroll
        for (int a = 0; a < 2; ++a)
#pragma unroll
            for (int b = 0; b < 2; ++b)
#pragma unroll
                for (int m = 0; m < 4; ++m)
#pragma unroll
                    for (int n = 0; n < 2; ++n) acc[a][b][m][n] = (f32x4){0.f, 0.f, 0.f, 0.f};
        cur = nxt; cA = nA; cB = nB; ++ui;
        if constexpr (ALIGN_EPI) { if (wr == 1) PG8_BAR; }
    }
    PG8_WAIT_V(0);
    if constexpr (!ALIGN_EPI) { if (wr == 0) PG8_BAR; }
    PG8_BAR;
    if constexpr (Epi::AFTER_DRAIN) { E.fused(acc, cur, wr, wc, fr, fq, lds, wid, lane); S.done(cur); }
#undef PG8_SA
#undef PG8_SB
#undef PG8_STAGE
#undef PG8_LDA
#undef PG8_LDB
#undef PG8_MMA
#undef PG8_WAIT_V
#undef PG8_WAIT_L
#undef PG8_BAR
#undef PG8_SCHED
}
}

constexpr int DM = 2048, NB = 8, SEQ = 4096, NMETA = 16, LSEQ = 4112, LPAD = 4128;
constexpr int MREAL = NB * SEQ;
constexpr int MPAD = MREAL + 256;
constexpr int MT_REAL = MREAL / 256;
constexpr int DFF = 5632, NGU = 2 * DFF, NNG = 7168, NGATE = 8192, INCOLS = 15184, NGC = 6992;
constexpr int NWAVES = 8;
constexpr float EPS = 1e-6f;
constexpr int C_AQ = 0, C_AF = 512, C_AI = 1024, C_AG = 1536, C_BB = 2048, C_BC = 2560, C_BU = 3072, C_CQ = 3584, C_CK = 4096, C_CV = 4608,
              C_DQ = 5120, C_DK = 5632, C_DV = 5760, C_DQI = 5888, C_DKI = 6912, C_DW = 6976;

constexpr size_t MiB = 1u << 20;
constexpr size_t WS_CTL = 0, CTL_ZERO_BYTES = 1 * MiB;
constexpr size_t WS_HM = 1 * MiB;
constexpr size_t WS_W = 4 * MiB;
constexpr size_t W_GU1 = 0, W_D1 = W_GU1 + (size_t)NGU * DM * 2, W_NG = W_D1 + (size_t)DM * DFF * 2, W_G = W_NG + (size_t)NNG * DM * 2,
                 W_BR = W_G + (size_t)NGATE * DM * 2, W_O = W_BR + (size_t)4 * DM * 512 * 2, W_GU2 = W_O + (size_t)DM * DM * 2, W_D2 = W_GU2 + (size_t)NGU * DM * 2,
                 W_END = W_D2 + (size_t)DM * DFF * 2;
constexpr size_t WS_XN = WS_W + W_END;
constexpr size_t WS_BR = WS_XN + (size_t)MPAD * DM * 2;
constexpr size_t WS_BIG = WS_BR + (size_t)MPAD * DM * 2;
constexpr size_t BIG_P_END = (size_t)MPAD * NNG * 2;
constexpr size_t WS_VTC = WS_BIG + BIG_P_END;
constexpr size_t WS_VTD = WS_VTC + (size_t)NB * 4 * 128 * LPAD * 2;
constexpr size_t WS_MASK = WS_VTD + (size_t)NB * 128 * LPAD * 2;
constexpr int MASKW = 132;
constexpr int NIDX_WG = 172;
constexpr int NHG_WG = 32;
constexpr size_t WS_SCR = WS_MASK + (size_t)NB * LPAD * MASKW * 4;
constexpr size_t WS_HA = WS_SCR + (size_t)NIDX_WG * 32 * LPAD * 4;
constexpr size_t WS_HDL = WS_HA + (size_t)NB * 4 * 64 * 64 * 64 * 2;
constexpr size_t WS_HMETA = WS_HDL + (size_t)NB * 4 * 64 * 128 * 4;
constexpr size_t HMETA_STRIDE = 64 * 384 * 2 + 64 * 64 * 2 + 128 * 4;
constexpr size_t WS_END = WS_HMETA + 4 * HMETA_STRIDE;
static_assert(WS_BIG + (size_t)MPAD * NGATE * 2 <= WS_END, "G fits");
static_assert(WS_END <= (size_t)1138174976, "workspace map fits the guaranteed size");

constexpr int RING_OFF = 0, RING_BYTES = 131072;
constexpr int LDSCTL_OFF = 143360, MISC_OFF = LDSCTL_OFF + 320;
constexpr int LDS_BYTES = 147456;

#define GAS __attribute__((address_space(1)))
#define LAS __attribute__((address_space(3)))
typedef unsigned short bf16;
typedef unsigned v4u __attribute__((ext_vector_type(4)));
typedef unsigned v2u __attribute__((ext_vector_type(2)));
typedef float f32x4 __attribute__((ext_vector_type(4)));
typedef float f32x16 __attribute__((ext_vector_type(16)));
typedef short bf16x8 __attribute__((ext_vector_type(8)));
typedef GAS unsigned gu32;
#define RLX_AGENT __ATOMIC_RELAXED, __HIP_MEMORY_SCOPE_AGENT
#define LDS_WAIT() asm volatile("s_waitcnt lgkmcnt(0)" ::: "memory")
#define VM_WAIT() asm volatile("s_waitcnt vmcnt(0)" ::: "memory")
__device__ __forceinline__ unsigned f2bf(float f) { unsigned u = __builtin_bit_cast(unsigned, f); return (u + 0x7fffu + ((u >> 16) & 1u)) >> 16; }
__device__ __forceinline__ unsigned f2bf_s(float f) { return pg8::cvt_pk_bf16(f, 0.f) & 0xffffu; }
__device__ __forceinline__ unsigned pk2(float lo, float hi) { return pg8::cvt_pk_bf16(lo, hi); }
__device__ __forceinline__ float bflo(unsigned w) { return __uint_as_float(w << 16); }
__device__ __forceinline__ float bfhi(unsigned w) { return __uint_as_float(w & 0xffff0000u); }
__device__ __forceinline__ float bf2f(bf16 v) { return __uint_as_float((unsigned)v << 16); }
__device__ __forceinline__ int seqrow(int b, int p) { return p < NMETA ? MREAL + p : b * SEQ + p - NMETA; }
__device__ __forceinline__ int rel_bucket(int n) {
    if (n < 16) return n; if (n >= 128) return 31;
    const int v = 16 + (int)(__log2f((float)n * 0.0625f) * 5.33333333f); return v < 31 ? v : 31; }
__device__ __forceinline__ float wave_sum(float v) {
#pragma unroll
    for (int o = 1; o < 64; o <<= 1) v += __shfl_xor(v, o);
    return v;
}
#define XB_TMO      128
#define XB_XCNT(j)  (256  + 64 * (j))
#define XB_XSUB(j)  (1280 + 64 * (j))
#define XB_XGEN(j)  (2304 + 64 * (j))
#define XB_TOP      3328
#define XB_TOPGEN   3392
#define XCD_BAR_WORDS 3456
#define XB_SPIN_CAP (1u << 18)

__device__ __forceinline__ unsigned xb_ld(unsigned* p)              { return __hip_atomic_load(p, __ATOMIC_RELAXED, __HIP_MEMORY_SCOPE_AGENT); }
__device__ __forceinline__ unsigned xb_add(unsigned* p, unsigned v) { return __hip_atomic_fetch_add(p, v, __ATOMIC_RELAXED, __HIP_MEMORY_SCOPE_AGENT); }
__device__ __forceinline__ unsigned xb_xcc_id() { return (unsigned)__builtin_amdgcn_s_getreg((3 << 11) | 20) & 0xFu; }
#define XB_SPIN(cond, bar) do { unsigned _sp = 0; while (cond) { __builtin_amdgcn_s_sleep(1); \
    if ((++_sp & 255u) == 0u) { if (xb_ld(&(bar)[XB_TMO])) break; if (_sp > XB_SPIN_CAP) { atomicAdd(&(bar)[XB_TMO], 1u); break; } } } } while (0)

struct XcdBarrier {
    int wave;
    unsigned* bar; unsigned x;
    volatile LAS unsigned* st;
};

__device__ __forceinline__ bool xb_thread0(int wave) { unsigned mk = ~0u; asm volatile("" : "+s"(mk)); return wave == 0 && __builtin_amdgcn_mbcnt_hi(mk, __builtin_amdgcn_mbcnt_lo(mk, 0u)) == 0u; }
__device__ __forceinline__ XcdBarrier xcd_barrier_post(unsigned* bar, volatile LAS unsigned* st, int wave) {
    XcdBarrier b; b.wave = wave; b.bar = bar; b.x = xb_xcc_id(); b.st = st;
    if (xb_thread0(wave)) (void)xb_add(&bar[XB_XCNT(b.x)], 1u);
    return b;
}
__device__ __forceinline__ void xcd_barrier_complete(unsigned* bar, unsigned x, unsigned& nloc, unsigned& nx) {
    const unsigned G = gridDim.x * gridDim.y * gridDim.z;
    unsigned sum, cnt, mine, sp = 0u;
    for (;;) {
        sum = 0u; cnt = 0u; mine = 0u;
#pragma unroll
        for (unsigned j = 0; j < 16; ++j) { const unsigned c = xb_ld(&bar[XB_XCNT(j)]); sum += c; cnt += (c > 0u) ? 1u : 0u; mine = (j == x) ? c : mine; }
        if (sum == G) break;
        __builtin_amdgcn_s_sleep(1);
        if ((++sp & 255u) == 0u) { if (xb_ld(&bar[XB_TMO])) break; if (sp > XB_SPIN_CAP) { atomicAdd(&bar[XB_TMO], 1u); break; } }
    }
    nloc = mine > 0u ? mine : 1u; nx = cnt > 0u ? cnt : 1u;
}

__device__ __forceinline__ void xcd_barrier(const XcdBarrier& b) {
    asm volatile("s_waitcnt vmcnt(0)" ::: "memory");
    __syncthreads();
    if (xb_thread0(b.wave)) {
        unsigned* bar = b.bar;
        __builtin_amdgcn_s_waitcnt(0);
        unsigned nloc = b.st[0], nx = b.st[1];
        if (nloc == 0u) { xcd_barrier_complete(bar, b.x, nloc, nx); b.st[0] = nloc; b.st[1] = nx; }
        const unsigned old = xb_add(&bar[XB_XSUB(b.x)], 1u);
        const unsigned gen = old / nloc;
        if (old + 1u == (gen + 1u) * nloc) {
            __builtin_amdgcn_fence(__ATOMIC_RELEASE, "agent");
            asm volatile("s_waitcnt vmcnt(0)" ::: "memory");
            const unsigned og = xb_add(&bar[XB_TOP], 1u);
            const unsigned tg = og / nx;
            if (og + 1u == (tg + 1u) * nx) xb_add(&bar[XB_TOPGEN], 1u);
            else XB_SPIN(xb_ld(&bar[XB_TOPGEN]) == tg, bar);
            __builtin_amdgcn_fence(__ATOMIC_ACQUIRE, "agent");
            xb_add(&bar[XB_XGEN(b.x)], 1u);
            asm volatile("s_waitcnt vmcnt(0)" ::: "memory");
        } else {
            XB_SPIN(xb_ld(&bar[XB_XGEN(b.x)]) == gen, bar);
            __builtin_amdgcn_fence(__ATOMIC_ACQUIRE, "agent");
            asm volatile("s_waitcnt vmcnt(0)" ::: "memory");
        }
    }
    __syncthreads();
}

struct Frame {
    LAS unsigned char* lds;
    volatile LAS unsigned* MISC;
    gu32* ctl;
    int tid, lane, wave, G, bid;
    const unsigned char __attribute__((address_space(4)))* karg; float* out; unsigned char* ws;
};
__device__ __forceinline__ const float* fin_load(const unsigned char __attribute__((address_space(4)))* k, int i) { asm volatile("" : "+s"(k)); return *(const float* const __attribute__((address_space(4)))*)(k + 8 * i); }
#define FIN(F_, i_) fin_load((F_).karg, (i_))
enum { I_X = 0, I_META, I_RELB, I_F1N, I_F1GU, I_F1D, I_MIXN, I_WIN, I_LB, I_GN, I_CONVW, I_DQN, I_DKN, I_DLAM, I_DSUB, I_SQN, I_SKN, I_WBR, I_WOUT, I_F2N, I_F2GU, I_F2D };

template <class RowMap>
__device__ __forceinline__ void transpose_item(const float* W, int K, int N, bf16* WT, LAS float* scr, int item, int lane, RowMap rm) {
    const int nblk = (N + 31) / 32, kb = item / nblk, nb = item % nblk, k0 = 64 * kb, n0 = 32 * nb;
    const int nl = n0 + (lane & 31); const bool nok = nl < N;
    { float wv[32]; const float* wp = W + (size_t)(k0 + (lane >> 5)) * N + (nok ? nl : 0);
#pragma unroll
      for (int i = 0; i < 32; ++i) wv[i] = wp[(size_t)(2 * i) * N];
      __builtin_amdgcn_sched_barrier(0);
#pragma unroll
      for (int i = 0; i < 32; ++i) scr[(2 * i + (lane >> 5)) * 33 + (lane & 31)] = nok ? wv[i] : 0.f; }
    LDS_WAIT(); asm volatile("" ::: "memory");
    const int c = lane & 7;
#pragma unroll
    for (int j = 0; j < 4; ++j) { const int n = (lane >> 3) + 8 * j; const LAS float* s = scr + (8 * c) * 33 + n;
        v4u o; o.x = pk2(s[0 * 33], s[1 * 33]); o.y = pk2(s[2 * 33], s[3 * 33]); o.z = pk2(s[4 * 33], s[5 * 33]); o.w = pk2(s[6 * 33], s[7 * 33]);
        if (n0 + n < N) *(GAS v4u*)(WT + (size_t)rm(n0 + n) * K + k0 + 8 * c) = o; }
    LDS_WAIT(); asm volatile("" ::: "memory");
}
struct MapId { __device__ __forceinline__ int operator()(int n) const { return n; } };
struct MapGU { __device__ __forceinline__ int operator()(int n) const { const int up = n >= DFF, j = up ? n - DFF : n; return 256 * (j >> 7) + 128 * up + (j & 127); } };
struct MapIn { __device__ __forceinline__ int operator()(int n) const { return n < NGC ? n : n + (NNG - NGC); } };
template <class RowMap>
__device__ __forceinline__ void convert_matrix(Frame& F, const float* W, int K, int N, bf16* WT, RowMap rm) {
    LAS float* scr = (LAS float*)(F.lds + F.wave * 16384);
    const int gw = F.bid * NWAVES + F.wave, NGW = F.G * NWAVES, nitems = (K / 64) * ((N + 31) / 32);
    for (int it = gw; it < nitems; it += NGW) transpose_item(W, K, N, WT, scr, it, F.lane, rm);
}
__device__ __forceinline__ void phase_convert(Frame& F, int l) {
    unsigned char* wb = F.ws + WS_W;
    convert_matrix(F, FIN(F, I_F1GU) + (size_t)l * DM * NGU, DM, NGU, (bf16*)(wb + W_GU1), MapGU());
    convert_matrix(F, FIN(F, I_F1D) + (size_t)l * DFF * DM, DFF, DM, (bf16*)(wb + W_D1), MapId());
    convert_matrix(F, FIN(F, I_WIN) + (size_t)l * DM * INCOLS, DM, INCOLS, (bf16*)(wb + W_NG), MapIn());
    for (int m = 0; m < 4; ++m) convert_matrix(F, FIN(F, I_WBR) + ((size_t)l * 4 + m) * 512 * DM, 512, DM, (bf16*)(wb + W_BR) + (size_t)m * DM * 512, MapId());
    convert_matrix(F, FIN(F, I_WOUT) + (size_t)l * DM * DM, DM, DM, (bf16*)(wb + W_O), MapId());
    convert_matrix(F, FIN(F, I_F2GU) + (size_t)l * DM * NGU, DM, NGU, (bf16*)(wb + W_GU2), MapGU());
    convert_matrix(F, FIN(F, I_F2D) + (size_t)l * DFF * DM, DFF, DM, (bf16*)(wb + W_D2), MapId());
    { GAS v4u* z = (GAS v4u*)(wb + W_NG + (size_t)NGC * DM * 2); const int n16 = (NNG - NGC) * DM * 2 / 16;
      for (int i = F.bid * 512 + F.tid; i < n16; i += F.G * 512) z[i] = (v4u){0u, 0u, 0u, 0u}; }
    if (l == 0) {
        GAS f32x4* hm = (GAS f32x4*)(F.ws + WS_HM); const GAS f32x4* mt = (const GAS f32x4*)FIN(F, I_META);
        for (int i = F.bid * 512 + F.tid; i < 256 * DM / 4; i += F.G * 512) hm[i] = (i < NMETA * DM / 4) ? mt[i] : (f32x4){0.f, 0.f, 0.f, 0.f};
    }
}
__device__ __forceinline__ void phase_norm(Frame& F, const float* src_real, const float* gain) {
    const int gw = F.bid * NWAVES + F.wave, NGW = F.G * NWAVES;
    bf16* XN = (bf16*)(F.ws + WS_XN); const float* hm = (const float*)(F.ws + WS_HM);
    f32x4 g[8];
#pragma unroll
    for (int j = 0; j < 8; ++j) g[j] = ((const GAS f32x4*)gain)[F.lane + 64 * j];
    for (int r = gw; r < MPAD; r += NGW) {
        GAS v2u* o8 = (GAS v2u*)(XN + (size_t)r * DM) + F.lane;
        if (r >= MREAL + NMETA) {
#pragma unroll
            for (int j = 0; j < 8; ++j) o8[64 * j] = (v2u){0u, 0u};
            continue; }
        const float* xr = r < MREAL ? src_real + (size_t)r * DM : hm + (size_t)(r - MREAL) * DM;
        f32x4 v[8]; float s = 0.f;
#pragma unroll
        for (int j = 0; j < 8; ++j) { v[j] = ((const GAS f32x4*)xr)[F.lane + 64 * j]; s += (v[j].x * v[j].x + v[j].y * v[j].y) + (v[j].z * v[j].z + v[j].w * v[j].w); }
        const float inv = 1.0f / sqrtf(wave_sum(s) * (1.f / DM) + EPS);
#pragma unroll
        for (int j = 0; j < 8; ++j) { v2u w; w.x = pk2(v[j].x * inv * g[j].x, v[j].y * inv * g[j].y); w.y = pk2(v[j].z * inv * g[j].z, v[j].w * inv * g[j].w); o8[64 * j] = w; }
    }
}

__device__ __forceinline__ f32x4 meta_dot16(const bf16* A  , int lda, const bf16* Bt  , int K, int s0, int s1, int lane) {
    const int fr = lane & 15, g = lane >> 4; const bf16* ap = A + (size_t)fr * lda + 8 * g; const bf16* bp = Bt + (size_t)fr * K + 8 * g;
    f32x4 a0 = (f32x4){0.f, 0.f, 0.f, 0.f}, a1 = a0;
    for (int s = s0; s < s1; s += 2) {
        const bf16x8 x0 = *(const GAS bf16x8*)(ap + 32 * s), x1 = *(const GAS bf16x8*)(ap + 32 * s + 32);
        const bf16x8 w0 = *(const GAS bf16x8*)(bp + 32 * s), w1 = *(const GAS bf16x8*)(bp + 32 * s + 32);
        a0 = __builtin_amdgcn_mfma_f32_16x16x32_bf16(w0, x0, a0, 0, 0, 0); a1 = __builtin_amdgcn_mfma_f32_16x16x32_bf16(w1, x1, a1, 0, 0, 0); }
    return a0 + a1;
}
__device__ __forceinline__ void st_bf16x4(bf16* p, f32x4 v) { v2u w; w.x = pk2(v[0], v[1]); w.y = pk2(v[2], v[3]); *(GAS v2u*)p = w; }
__device__ __forceinline__ void meta_gemm(Frame& F, int kind, const bf16* A, int lda, const bf16* Bt, int N, int K, bf16* Obf, int ldo, float scale) {
    const int lane = F.lane, wave = F.wave, fr = lane & 15, g = lane >> 4;
    const int ngroups = (kind == 0 ? N / 2 : N) / 16;
    LAS f32x4* red = (LAS f32x4*)F.lds;
    const int ns = K / 32, s0 = (wave * ns) >> 3, s1 = ((wave + 1) * ns) >> 3;
    for (int cg = F.bid; cg < ngroups; cg += F.G) {
        const int n0 = 16 * cg;
        f32x4 p0, p1 = (f32x4){0.f, 0.f, 0.f, 0.f};
        if (kind == 0) { const int rg = 256 * (n0 >> 7) + (n0 & 127);
            p0 = meta_dot16(A, lda, Bt + (size_t)rg * K, K, s0, s1, lane); p1 = meta_dot16(A, lda, Bt + (size_t)(rg + 128) * K, K, s0, s1, lane); }
        else if (kind == 4) { const int mb = wave >> 1, kh = wave & 1; p0 = meta_dot16(A + (size_t)mb * MPAD * 512, 512, Bt + ((size_t)mb * DM + n0) * 512, 512, 8 * kh, 8 * kh + 8, lane); }
        else p0 = meta_dot16(A, lda, Bt + (size_t)n0 * K, K, s0, s1, lane);
        red[wave * 64 + lane] = p0; if (kind == 0) red[512 + wave * 64 + lane] = p1;
        LDS_WAIT(); __syncthreads();
        if (wave == 0) {
            f32x4 q[8];
#pragma unroll
            for (int w = 0; w < 8; ++w) q[w] = red[w * 64 + lane];
            if (kind == 4) { f32x4 tot = (f32x4){0.f, 0.f, 0.f, 0.f}; const bf16* G = (const bf16*)(F.ws + WS_BIG);
#pragma unroll
                for (int mb = 0; mb < 4; ++mb) { const f32x4 acc = q[2 * mb] + q[2 * mb + 1]; const v2u gw2 = *(const GAS v2u*)(G + (size_t)(MREAL + fr) * NGATE + mb * DM + n0 + 4 * g);
                    tot[0] += bflo(gw2.x) * acc[0]; tot[1] += bfhi(gw2.x) * acc[1]; tot[2] += bflo(gw2.y) * acc[2]; tot[3] += bfhi(gw2.y) * acc[3]; }
                st_bf16x4(Obf + (size_t)(MREAL + fr) * ldo + n0 + 4 * g, tot);
            } else {
                f32x4 acc = ((q[0] + q[1]) + (q[2] + q[3])) + ((q[4] + q[5]) + (q[6] + q[7]));
                if (kind == 0) { f32x4 up = (f32x4){0.f, 0.f, 0.f, 0.f};
#pragma unroll
                    for (int w = 0; w < 8; ++w) up += red[512 + w * 64 + lane];
#pragma unroll
                    for (int r = 0; r < 4; ++r) acc[r] = pg8::fast_silu(acc[r]) * up[r];
                    st_bf16x4(Obf + (size_t)(MREAL + fr) * ldo + n0 + 4 * g, acc); }
                else if (kind == 1) { float* hp = (float*)(F.ws + WS_HM) + (size_t)fr * DM + n0 + 4 * g; *(GAS f32x4*)hp = *(const GAS f32x4*)hp + acc * scale; }
                else if (kind == 2) st_bf16x4(Obf + (size_t)(MREAL + fr) * ldo + n0 + 4 * g, acc);
                else {
#pragma unroll
                    for (int r = 0; r < 4; ++r) acc[r] = pg8::fast_sigmoid(acc[r]);
                    st_bf16x4(Obf + (size_t)(MREAL + fr) * ldo + n0 + 4 * g, acc); }
            }
        }
        __syncthreads();
    }
}
__device__ __forceinline__ void unpack8(const v4u w, float (&x)[8]) { x[0] = bflo(w.x); x[1] = bfhi(w.x); x[2] = bflo(w.y); x[3] = bfhi(w.y); x[4] = bflo(w.z); x[5] = bfhi(w.z); x[6] = bflo(w.w); x[7] = bfhi(w.w); }
__device__ __forceinline__ v4u pack8(const float (&x)[8]) { v4u w; w.x = pk2(x[0], x[1]); w.y = pk2(x[2], x[3]); w.z = pk2(x[4], x[5]); w.w = pk2(x[6], x[7]); return w; }
template <int GL>
__device__ __forceinline__ void norm_cols_inplace(bf16* p, const v4u w, const float* gain, float scale, int lane, bool wr) {
    float x[8]; unpack8(w, x); float s = 0.f;
#pragma unroll
    for (int i = 0; i < 8; ++i) s += x[i] * x[i];
#pragma unroll
    for (int o = 1; o < GL; o <<= 1) s += __shfl_xor(s, o);
    const float inv = scale / sqrtf(s * (1.f / (GL * 8)) + EPS); const int g0 = (8 * lane) % (GL * 8);
#pragma unroll
    for (int i = 0; i < 8; ++i) x[i] = x[i] * inv * gain[g0 + i];
    if (wr) *(GAS v4u*)p = pack8(x);
}
__device__ __forceinline__ void prep_row(Frame& F, int l, int r) {
    const int lane = F.lane; bf16* pr = (bf16*)(F.ws + WS_BIG) + (size_t)r * NNG;
    const float *dqn = FIN(F, I_DQN) + l * 64, *dkn = FIN(F, I_DKN) + l * 64, *sqn = FIN(F, I_SQN) + l * 128, *skn = FIN(F, I_SKN) + l * 128;
    const v4u w0 = *(const GAS v4u*)(pr + C_CQ + 8 * lane), w1 = *(const GAS v4u*)(pr + C_CK + 8 * lane), w2 = *(const GAS v4u*)(pr + C_DQ + 8 * lane), w3 = *(const GAS v4u*)(pr + C_DK + 8 * (lane & 15));
    __builtin_amdgcn_sched_barrier(0);
    norm_cols_inplace<8>(pr + C_CQ + 8 * lane, w0, dqn, 0.125f * 1.4426950408889634f, lane, true);
    norm_cols_inplace<8>(pr + C_CK + 8 * lane, w1, dkn, 1.0f, lane, true);
    norm_cols_inplace<16>(pr + C_DQ + 8 * lane, w2, sqn, 0.08838834764831845f * 1.4426950408889634f, lane, true);
    norm_cols_inplace<16>(pr + C_DK + 8 * (lane & 15), w3, skn, 1.0f, lane & 15, lane < 16);
}
constexpr int VT_NPB = (LPAD + 63) / 64, VT_NTASK = NB * 5 * VT_NPB;
__device__ __forceinline__ void vt_task(Frame& F, int task) {
    const int lane = F.lane;
    const bf16* P = (const bf16*)(F.ws + WS_BIG); bf16* VtC = (bf16*)(F.ws + WS_VTC); bf16* VtD = (bf16*)(F.ws + WS_VTD);
    LAS bf16* T = (LAS bf16*)(F.lds + F.wave * 17408);
    const int pb = task % VT_NPB, mat = (task / VT_NPB) % 5, b = task / (VT_NPB * 5), p0 = 64 * pb;
    const int col = mat < 4 ? C_CV + 128 * mat : C_DV;
#pragma unroll 4
    for (int i = 0; i < 16; ++i) { const int pl = 4 * i + (lane >> 4), p = p0 + pl;
        v4u w = *(const GAS v4u*)(P + (size_t)seqrow(b, p < LSEQ ? p : LSEQ - 1) * NNG + col + 8 * (lane & 15)); if (p >= LSEQ) w = (v4u){0u, 0u, 0u, 0u};
        *(LAS v4u*)(T + pl * 136 + 8 * (lane & 15)) = w; }
    LDS_WAIT(); asm volatile("" ::: "memory");
    bf16* dst = mat < 4 ? VtC + (size_t)(b * 4 + mat) * 128 * LPAD : VtD + (size_t)b * 128 * LPAD;
#pragma unroll 4
    for (int it = 0; it < 16; ++it) { const int e = 8 * it + (lane >> 3), c = lane & 7; unsigned short x[8];
#pragma unroll
        for (int k = 0; k < 8; ++k) x[k] = T[(8 * c + k) * 136 + e];
        v4u w; w.x = x[0] | ((unsigned)x[1] << 16); w.y = x[2] | ((unsigned)x[3] << 16); w.z = x[4] | ((unsigned)x[5] << 16); w.w = x[6] | ((unsigned)x[7] << 16);
        if (p0 + 8 * c < LPAD) *(GAS v4u*)(dst + (size_t)e * LPAD + p0 + 8 * c) = w; }
    LDS_WAIT(); asm volatile("" ::: "memory");
}

#define NEG_INF (-__builtin_inff())
constexpr int NQT = (LSEQ + 31) / 32;
constexpr int NQB = (NQT + 7) / 8;
__device__ __forceinline__ bf16x8 ld_frag16(const bf16* p) { return *(const GAS bf16x8*)p; }
__device__ __forceinline__ bf16x8 mk_frag(v2u lo, v2u hi) { v4u w; w.x = lo.x; w.y = lo.y; w.z = hi.x; w.w = hi.y; return __builtin_bit_cast(bf16x8, w); }
__device__ __forceinline__ unsigned cvtpk(float lo, float hi) { return pg8::cvt_pk_bf16(lo, hi); }
__device__ __forceinline__ void build_bias_table(Frame& F, LAS float* bt, int col0) {
    const float* rb = FIN(F, I_RELB);
    for (int i = F.tid; i < 4 * 128; i += 512) { const int hd = i >> 7, n = i & 127; bt[i] = (rb[rel_bucket(n) * 8 + col0 + hd] - rb[31 * 8 + col0 + hd]) * 1.4426950408889634f; }
}
__device__ __forceinline__ bool softmax_step(f32x16& S, float& m, float& lsum, float& alpha) {
    float tm = S[0];
#pragma unroll
    for (int r = 1; r < 16; ++r) tm = fmaxf(tm, S[r]);
    const bool raise = __any(tm > m + 11.5f);
    alpha = 1.0f;
    if (raise) { tm = fmaxf(tm, __shfl_xor(tm, 32)); const float mn = fmaxf(m, tm); alpha = (mn == NEG_INF) ? 1.0f : __builtin_amdgcn_exp2f(m - mn); m = mn; lsum *= alpha; }
    const float mref = (m == NEG_INF) ? 0.f : m;
    float rs = 0.f;
#pragma unroll
    for (int r = 0; r < 16; ++r) { S[r] = __builtin_amdgcn_exp2f(S[r] - mref); rs += S[r]; }
    lsum += rs;
    return raise;
}
__device__ __forceinline__ void relane(Frame& F) {
    int w = F.wave; asm volatile("" : "+s"(w)); unsigned mk = ~0u; asm volatile("" : "+s"(mk));
    int t = w * 64 + (int)__builtin_amdgcn_mbcnt_hi(mk, __builtin_amdgcn_mbcnt_lo(mk, 0u)); asm volatile("" : "+v"(t)); F.tid = t; F.lane = t & 63; F.wave = w; }
#ifndef DIFF_SINGLE
#define DIFF_SINGLE 0
#endif
#ifndef TK_DSA
#define TK_DSA 64
#endif
#ifndef NVPRE_DIFF
#define NVPRE_DIFF 4
#endif
#ifndef NVPRE_DSA
#define NVPRE_DSA 8
#endif
template <bool DSA>
__device__ __forceinline__ void attn_wg_task(Frame& F, int l, int b, int h, int J, const LAS float* bt, float lam, float post) {
    constexpr int KD = DSA ? 128 : 64, KP = KD + 8, NKS = KD / 16;
    constexpr int TK = DSA ? TK_DSA : 64, NS = TK / 32, VP = TK + 4, NVL = 128 * (TK / 8) / 512, NKL = TK * (KD / 8) / 512;
    constexpr int KBUF = TK * KP, VBUF = 128 * VP;
    constexpr int RPARK = 57344;
    constexpr int NVPRE = DSA ? NVPRE_DSA : NVPRE_DIFF;
    relane(F);
    const int lane = F.lane, ql = lane & 31, hh = lane >> 5, wave = F.wave, tid = F.tid;
    LAS bf16* Kl = (LAS bf16*)F.lds; LAS bf16* Vl = Kl + 2 * KBUF;
    const bf16* P = (const bf16*)(F.ws + WS_BIG);
    const bf16* Vt = DSA ? (const bf16*)(F.ws + WS_VTD) + (size_t)b * 128 * LPAD : (const bf16*)(F.ws + WS_VTC) + (size_t)(b * 4 + h) * 128 * LPAD;
    const int jr = 8 * J + wave - 7; const bool wvalid = jr >= 0 && 32 * jr < LSEQ; const int j = jr < 0 ? 0 : jr;
    const int ktmax = (8 * J < NQT - 1) ? 8 * J : NQT - 1;
    const int pq = 32 * j + ql, pqc = pq < LSEQ ? pq : LSEQ - 1;
    const bf16* qrow = P + (size_t)seqrow(b, pqc) * NNG + (DSA ? C_DQ : C_CQ) + h * 128 + 8 * hh;
    const unsigned* mrow = (const unsigned*)(F.ws + WS_MASK) + ((size_t)b * LPAD + pqc) * MASKW;
    f32x16 R[4];
#pragma unroll
    for (int c = 0; c < (DSA ? 1 : 2); ++c) {
        const int kcol = DSA ? C_DK : C_CK + h * 128 + c * 64;
        relane(F);
        const int tid2 = F.tid, kr = tid2 / (KD / 8), kc = tid2 % (KD / 8), vr = tid2 / (TK / 8), vc = tid2 % (TK / 8);
        bf16x8 qf[NKS];
#pragma unroll
        for (int ks = 0; ks < NKS; ++ks) qf[ks] = ld_frag16(qrow + (DSA ? 0 : c * 64) + 16 * ks);
        float m = NEG_INF, lsum = 0.f; f32x16 O[4];
#pragma unroll
        for (int eb = 0; eb < 4; ++eb)
#pragma unroll
            for (int r = 0; r < 16; ++r) O[eb][r] = 0.f;
        v4u rk0[NKL], rk1[NKL], rv0[NVL], rv1[NVL];
#pragma unroll
        for (int i = 0; i < NKL; ++i) { rk0[i] = (v4u){0u, 0u, 0u, 0u}; rk1[i] = rk0[i]; }
#pragma unroll
        for (int i = 0; i < NVL; ++i) { rv0[i] = (v4u){0u, 0u, 0u, 0u}; rv1[i] = rv0[i]; }
#define ATT_ISSUE(st_, RK, RV) do { _Pragma("unroll") for (int i_ = 0; i_ < NKL; ++i_) { int pk_ = TK * (st_) + kr + i_ * (512 / (KD / 8)); pk_ = pk_ < LSEQ ? pk_ : LSEQ - 1; \
            RK[i_] = *(const GAS v4u*)(P + (size_t)seqrow(b, pk_) * NNG + kcol + 8 * kc); } \
            int vcol_ = TK * (st_) + 8 * vc; vcol_ = vcol_ < LPAD - 8 ? vcol_ : LPAD - 8; \
            _Pragma("unroll") for (int i_ = 0; i_ < NVL; ++i_) RV[i_] = *(const GAS v4u*)(Vt + (size_t)(vr + i_ * (512 / (TK / 8))) * LPAD + vcol_); } while (0)
#define ATT_COMMIT(buf_, RK, RV) do { _Pragma("unroll") for (int i_ = 0; i_ < NKL; ++i_) *(LAS v4u*)(Kl + (buf_) * KBUF + (kr + i_ * (512 / (KD / 8))) * KP + 8 * kc) = RK[i_]; \
            _Pragma("unroll") for (int i_ = 0; i_ < NVL; ++i_) { LAS v2u* vd_ = (LAS v2u*)(Vl + (buf_) * VBUF + (vr + i_ * (512 / (TK / 8))) * VP + 8 * vc); vd_[0] = (v2u){RV[i_].x, RV[i_].y}; vd_[1] = (v2u){RV[i_].z, RV[i_].w}; } } while (0)
        unsigned mwc[NS], mwn[NS];
#pragma unroll
        for (int s = 0; s < NS; ++s) { mwc[s] = 0xffffffffu; mwn[s] = 0xffffffffu; if (DSA) mwc[s] = mrow[s <= ktmax ? s : ktmax]; }
#define MW_LOAD(st_) do { if (DSA) { _Pragma("unroll") for (int s_ = 0; s_ < NS; ++s_) { const int kt_ = NS * (st_) + s_; mwn[s_] = mrow[kt_ <= ktmax ? kt_ : ktmax]; } } } while (0)
#define MW_ROT() do { if (DSA) { _Pragma("unroll") for (int s_ = 0; s_ < NS; ++s_) mwc[s_] = mwn[s_]; } } while (0)
        auto compute = [&](int kt, int buf, int sub) {
            if (wvalid && kt <= j) {
                const LAS bf16* Kt = Kl + buf * KBUF + (32 * sub + ql) * KP + 8 * hh; const LAS bf16* Vb = Vl + buf * VBUF + ql * VP + 32 * sub + 4 * hh;
                f32x16 S;
#pragma unroll
                for (int r = 0; r < 16; ++r) S[r] = 0.f;
#pragma unroll
                for (int ks = 0; ks < NKS; ++ks) S = __builtin_amdgcn_mfma_f32_32x32x16_bf16(*(const LAS bf16x8*)(Kt + 16 * ks), qf[ks], S, 0, 0, 0);
                const unsigned mw = (sub ? mwc[NS - 1] : mwc[0]) >> (4 * hh);
                if (kt + 4 >= j) {
                    const int n0 = pq - (32 * kt + 4 * hh); float bv[16];
#pragma unroll
                    for (int r = 0; r < 16; ++r) { const int ko = (r & 3) + 8 * (r >> 2); int n = n0 - ko; n = n < 0 ? 0 : (n < 127 ? n : 127); bv[r] = bt[h * 128 + n]; }
#pragma unroll
                    for (int r = 0; r < 16; ++r) { const int ko = (r & 3) + 8 * (r >> 2); const bool sel = ((mw >> ko) & 1u) && n0 >= ko; S[r] = sel ? S[r] + bv[r] : NEG_INF; }
                } else if (DSA) {
#pragma unroll
                    for (int r = 0; r < 16; ++r) { const int ko = (r & 3) + 8 * (r >> 2); S[r] = ((mw >> ko) & 1u) ? S[r] : NEG_INF; }
                }
                bf16x8 vf[NVPRE > 0 ? NVPRE : 1];
#pragma unroll
                for (int i = 0; i < NVPRE; ++i) { const LAS bf16* vp = Vb + (i >> 1) * 32 * VP + 16 * (i & 1); vf[i] = mk_frag(*(const LAS v2u*)vp, *(const LAS v2u*)(vp + 8)); }
                float alpha;
                if (softmax_step(S, m, lsum, alpha)) {
#pragma unroll
                    for (int eb = 0; eb < 4; ++eb)
#pragma unroll
                        for (int r = 0; r < 16; ++r) O[eb][r] *= alpha;
                }
                bf16x8 pf[2];
#pragma unroll
                for (int s = 0; s < 2; ++s) { v4u w; w.x = cvtpk(S[8 * s + 0], S[8 * s + 1]); w.y = cvtpk(S[8 * s + 2], S[8 * s + 3]); w.z = cvtpk(S[8 * s + 4], S[8 * s + 5]); w.w = cvtpk(S[8 * s + 6], S[8 * s + 7]); pf[s] = __builtin_bit_cast(bf16x8, w); }
#pragma unroll
                for (int eb = 0; eb < 4; ++eb)
#pragma unroll
                    for (int s = 0; s < 2; ++s) { const LAS bf16* vp = Vb + eb * 32 * VP + 16 * s;
                        O[eb] = __builtin_amdgcn_mfma_f32_32x32x16_bf16((2 * eb + s < NVPRE) ? vf[(2 * eb + s < NVPRE) ? 2 * eb + s : 0] : mk_frag(*(const LAS v2u*)vp, *(const LAS v2u*)(vp + 8)), pf[s], O[eb], 0, 0, 0); }
            } };
        __syncthreads();
        const int stmax = ktmax / NS;
        ATT_ISSUE(0, rk0, rv0); ATT_COMMIT(0, rk0, rv0);
        if (DSA ? (TK_DSA == 64) : (DIFF_SINGLE != 0)) {
            for (int st = 0; st <= stmax; ++st) {
                LDS_WAIT(); __syncthreads();
                MW_LOAD(st + 1);
                if (st + 1 <= stmax) ATT_ISSUE(st + 1, rk0, rv0);
#pragma unroll 1
                for (int sub = 0; sub < NS; ++sub) compute(NS * st + sub, st & 1, sub);
                if (st + 1 <= stmax) ATT_COMMIT((st + 1) & 1, rk0, rv0);
                MW_ROT();
            }
        } else {
        if (stmax >= 1) ATT_ISSUE(1, rk1, rv1);
        for (int st = 0; st <= stmax; st += 2) {
            LDS_WAIT(); __syncthreads();
            MW_LOAD(st + 1);
            if (st + 2 <= stmax) ATT_ISSUE(st + 2, rk0, rv0);
#pragma unroll 1
            for (int sub = 0; sub < NS; ++sub) compute(NS * st + sub, 0, sub);
            if (st + 1 <= stmax) ATT_COMMIT(1, rk1, rv1);
            MW_ROT();
            if (st + 1 > stmax) break;
            LDS_WAIT(); __syncthreads();
            MW_LOAD(st + 2);
            if (st + 3 <= stmax) ATT_ISSUE(st + 3, rk1, rv1);
#pragma unroll 1
            for (int sub = 0; sub < NS; ++sub) compute(NS * (st + 1) + sub, 1, sub);
            if (st + 2 <= stmax) ATT_COMMIT(0, rk0, rv0);
            MW_ROT();
        }
        }
#undef ATT_ISSUE
#undef MW_LOAD
#undef MW_ROT
#undef ATT_COMMIT
        lsum += __shfl_xor(lsum, 32); const float il = 1.0f / lsum;
        if (DSA) {
#pragma unroll
            for (int eb = 0; eb < 4; ++eb)
#pragma unroll
                for (int r = 0; r < 16; ++r) R[eb][r] = O[eb][r] * il;
        } else if (c == 0) {
            LAS unsigned* rp = (LAS unsigned*)(F.lds + RPARK) + wave * 2048 + lane;
#pragma unroll
            for (int eb = 0; eb < 4; ++eb)
#pragma unroll
                for (int r = 0; r < 16; r += 2) rp[(eb * 8 + (r >> 1)) * 64] = pk2(O[eb][r] * il, O[eb][r + 1] * il);
        } else {
            const LAS unsigned* rp = (const LAS unsigned*)(F.lds + RPARK) + wave * 2048 + lane;
#pragma unroll
            for (int eb = 0; eb < 4; ++eb)
#pragma unroll
                for (int r = 0; r < 16; r += 2) { const unsigned w = rp[(eb * 8 + (r >> 1)) * 64]; R[eb][r] = bflo(w) - lam * (O[eb][r] * il); R[eb][r + 1] = bfhi(w) - lam * (O[eb][r + 1] * il); }
        }
    }
    float inv = 1.0f;
    if (!DSA) { float ss = 0.f;
#pragma unroll
        for (int eb = 0; eb < 4; ++eb)
#pragma unroll
            for (int r = 0; r < 16; ++r) ss += R[eb][r] * R[eb][r];
        ss += __shfl_xor(ss, 32); inv = post / sqrtf(ss * (1.f / 128.f) + EPS); }
    const float* sub = FIN(F, I_DSUB) + l * 128;
    if (wvalid && pq < LSEQ && (pq >= NMETA || b == 0)) {
        bf16* orow = (bf16*)(F.ws + WS_BR) + (size_t)(DSA ? 3 : 2) * MPAD * 512 + (size_t)seqrow(b, pq) * 512 + h * 128;
#pragma unroll
        for (int eb = 0; eb < 4; ++eb)
#pragma unroll
            for (int g = 0; g < 4; ++g) { const int e0 = 32 * eb + 8 * g + 4 * hh; f32x4 sv = (f32x4){1.f, 1.f, 1.f, 1.f}; if (!DSA) sv = *(const GAS f32x4*)(sub + e0);
                v2u w; w.x = pk2(R[eb][4 * g] * inv * sv.x, R[eb][4 * g + 1] * inv * sv.y); w.y = pk2(R[eb][4 * g + 2] * inv * sv.z, R[eb][4 * g + 3] * inv * sv.w);
                *(GAS v2u*)(orow + e0) = w; }
    }
}
__device__ __forceinline__ unsigned f32_key(float f) { const unsigned u = __float_as_uint(f); return u ^ ((u >> 31) ? 0xffffffffu : 0x80000000u); }
__device__ __forceinline__ float relu_bits(float x) { const int i = __float_as_int(x); return __int_as_float(i > 0 ? i : 0); }
__device__ __forceinline__ void dsa_index_task(Frame& F, int b, int j, float* slab) {
    relane(F);
    const int lane = F.lane, ql = lane & 31, hh = lane >> 5, wave = F.wave;
    const bf16* P = (const bf16*)(F.ws + WS_BIG);
    LAS unsigned char* qi = F.lds;
    { v4u st[8];
#pragma unroll
      for (int k = 0; k < 8; ++k) { const int i = F.tid + 512 * k, q = i >> 7, ch = i & 127; int pq = 32 * j + q; pq = pq < LSEQ ? pq : LSEQ - 1;
          st[k] = *(const GAS v4u*)(P + (size_t)seqrow(b, pq) * NNG + C_DQI + 8 * ch); }
#pragma unroll
      for (int k = 0; k < 8; ++k) { const int i = F.tid + 512 * k, q = i >> 7, ch = i & 127; *(LAS v4u*)(qi + q * 2064 + 16 * ch) = st[k]; } }
    LAS float* wl = (LAS float*)(qi + 32 * 2064);
    if (F.tid < 32 * 16) { const int q = F.tid >> 4, hd = F.tid & 15; int pq = 32 * j + q; pq = pq < LSEQ ? pq : LSEQ - 1;
        wl[F.tid] = bf2f(P[(size_t)seqrow(b, pq) * NNG + C_DW + hd]) * 0.03125f; }
    LAS unsigned* hist = (LAS unsigned*)(F.lds + 73728);
    for (int i = F.tid; i < 32 * 256; i += 512) hist[i] = 0u;
    LDS_WAIT(); __syncthreads();
#ifndef PROBE_SUB
#define PROBE_SUB 0
#endif
    for (int rpa = 0; rpa < ((PROBE_SUB & 8) ? 2 : 1); ++rpa)
    {
    if (rpa) { LDS_WAIT(); __syncthreads(); for (int i = F.tid; i < 32 * 256; i += 512) hist[i] = 0u; LDS_WAIT(); __syncthreads(); }
    bf16x8 kn[4];
    { const int pk = 32 * wave + ql, pkc = pk < LSEQ ? pk : LSEQ - 1; const bf16* krow = P + (size_t)seqrow(b, pkc) * NNG + C_DKI + 8 * hh;
#pragma unroll
      for (int ks = 0; ks < 4; ++ks) kn[ks] = ld_frag16(krow + 16 * ks); }
    for (int kt = wave; kt <= j; kt += NWAVES) {
        bf16x8 kf[4];
#pragma unroll
        for (int ks = 0; ks < 4; ++ks) kf[ks] = kn[ks];
        { const int ktn = kt + NWAVES <= j ? kt + NWAVES : kt; const int pk = 32 * ktn + ql, pkc = pk < LSEQ ? pk : LSEQ - 1; const bf16* krow = P + (size_t)seqrow(b, pkc) * NNG + C_DKI + 8 * hh;
#pragma unroll
          for (int ks = 0; ks < 4; ++ks) kn[ks] = ld_frag16(krow + 16 * ks); }
        f32x16 idx;
#pragma unroll
        for (int r = 0; r < 16; ++r) idx[r] = 0.f;
#pragma unroll 1
        for (int hd = 0; hd < 16; hd += 2) { f32x16 S0, S1; const float wh0 = wl[ql * 16 + hd], wh1 = wl[ql * 16 + hd + 1];
#pragma unroll
            for (int r = 0; r < 16; ++r) { S0[r] = 0.f; S1[r] = 0.f; }
#pragma unroll
            for (int ks = 0; ks < 4; ++ks) { S0 = __builtin_amdgcn_mfma_f32_32x32x16_bf16(kf[ks], *(const LAS bf16x8*)(qi + ql * 2064 + hd * 128 + 32 * ks + 16 * hh), S0, 0, 0, 0);
                S1 = __builtin_amdgcn_mfma_f32_32x32x16_bf16(kf[ks], *(const LAS bf16x8*)(qi + ql * 2064 + (hd + 1) * 128 + 32 * ks + 16 * hh), S1, 0, 0, 0); }
#pragma unroll
            for (int r = 0; r < 16; ++r) { idx[r] = __builtin_fmaf(wh0, relu_bits(S0[r]), idx[r]); idx[r] = __builtin_fmaf(wh1, relu_bits(S1[r]), idx[r]); } }
        { const int lim = 32 * (j - kt) + ql - 4 * hh;
#pragma unroll
          for (int r = 0; r < 16; ++r) { const int ko = (r & 3) + 8 * (r >> 2);
              int bn = (int)__builtin_fmaf(idx[r], 32.f, 256.f); bn = bn < 0 ? 0 : (bn > 511 ? 511 : bn);
              const unsigned inc = (ko <= lim) ? ((bn & 1) ? 0x10000u : 1u) : 0u;
              (void)__hip_atomic_fetch_add(hist + ql * 256 + (((bn >> 1) + 2 * ql) & 255), inc, __ATOMIC_RELAXED, __HIP_MEMORY_SCOPE_WORKGROUP); } }
        float* srow = slab + (size_t)ql * LPAD + 32 * kt + 4 * hh;
#pragma unroll
        for (int g = 0; g < 4; ++g) *(GAS f32x4*)(srow + 8 * g) = (f32x4){idx[4 * g], idx[4 * g + 1], idx[4 * g + 2], idx[4 * g + 3]};
    }
    }
    VM_WAIT(); LDS_WAIT(); __syncthreads();
    for (int rpb = 0; rpb < ((PROBE_SUB & 16) ? 2 : 1); ++rpb)
    for (int qq = wave; qq < 32; qq += NWAVES) {
        const int p = 32 * j + qq; if (p >= LSEQ) break;
        const float* row = slab + (size_t)qq * LPAD;
        unsigned u[65];
        { const GAS unsigned* rp = (const GAS unsigned*)row + lane;
#pragma unroll
          for (int i = 0; i < 65; ++i) u[i] = rp[64 * i];
          __builtin_amdgcn_sched_barrier(0); }
        auto wsum = [&](unsigned c) { unsigned s = 0;
#pragma unroll
            for (int k = 0; k < 7; ++k) s += (unsigned)__builtin_popcountll(__ballot((c >> k) & 1u)) << k;
            return s; };
        unsigned T = 1u;
        if (p + 1 <= 256) {
#pragma unroll
            for (int i = 0; i < 65; ++i) { const unsigned k = f32_key(__uint_as_float(u[i])) >> 1; u[i] = (64 * i + lane <= p) ? k : 0u; }
        } else {
            const LAS unsigned* hrow = hist + qq * 256; unsigned c8[8];
#pragma unroll
            for (int i = 0; i < 4; ++i) { const unsigned w = hrow[(4 * lane + i + 2 * qq) & 255]; c8[2 * i] = w & 0xffffu; c8[2 * i + 1] = w >> 16; }
            unsigned tot = 0;
#pragma unroll
            for (int i = 0; i < 8; ++i) tot += c8[i];
            unsigned suf = 0;
            { const unsigned long long gtm = (lane == 63) ? 0ull : ~((2ull << lane) - 1ull);
#pragma unroll
              for (int k = 0; k < 13; ++k) suf += (unsigned)__builtin_popcountll(__ballot((tot >> k) & 1u) & gtm) << k; }
            unsigned run = suf, bl = 0, al = 0; bool found = false;
#pragma unroll
            for (int i = 7; i >= 0; --i) { const bool hit = !found && run < 256u && run + c8[i] >= 256u; if (hit) { bl = 8u * lane + i; al = run; } found = found || hit; run += c8[i]; }
            const unsigned long long fb = __ballot(found); const int src = (int)__builtin_ctzll(fb | (1ull << 63));
            const unsigned bstar = __builtin_amdgcn_readlane(bl, src), above = __builtin_amdgcn_readlane(al, src), need = 256u - above;
            unsigned f0 = 0u, f1 = 0u, f2 = 0u, cb = 0u;
#pragma unroll
            for (int i = 0; i < 65; ++i) { const float v = __uint_as_float(u[i]); int bn = (int)__builtin_fmaf(v, 32.f, 256.f); bn = bn < 0 ? 0 : (bn > 511 ? 511 : bn);
                const bool val = 64 * i + lane <= p, inband = val && (unsigned)bn == bstar;
                if (i < 32) f0 |= inband ? (1u << i) : 0u; else if (i < 64) f1 |= inband ? (1u << (i - 32)) : 0u; else f2 = inband ? 1u : 0u;
                cb += inband ? 1u : 0u;
                const unsigned k = f32_key(v) >> 1; u[i] = val ? k : 0u; }
            const unsigned inb = wsum(cb);
            if (fb != 0ull && inb <= 128u && inb >= need) {
                LAS unsigned* band = (LAS unsigned*)(F.lds + 68096) + wave * 128;
                unsigned off = 0;
#pragma unroll
                for (int k = 0; k < 7; ++k) { const unsigned long long bal = __ballot((cb >> k) & 1u); off += __builtin_amdgcn_mbcnt_hi((unsigned)(bal >> 32), __builtin_amdgcn_mbcnt_lo((unsigned)bal, 0u)) << k; }
#pragma unroll
                for (int i = 0; i < 65; ++i) { const bool inband = i < 32 ? ((f0 >> i) & 1u) : (i < 64 ? ((f1 >> (i - 32)) & 1u) : (f2 & 1u)); if (inband) { band[off] = u[i]; ++off; } }
                LDS_WAIT();
                const unsigned m0 = lane < (int)inb ? band[lane] : 0u, m1 = lane + 64 < (int)inb ? band[lane + 64] : 0u; unsigned ge0 = 0, gt0 = 0, ge1 = 0, gt1 = 0;
                for (unsigned k = 0; k < inb; ++k) { const unsigned v = band[k]; ge0 += (m0 - 1u - v) >> 31; gt0 += (m0 - v) >> 31; ge1 += (m1 - 1u - v) >> 31; gt1 += (m1 - v) >> 31; }
                const unsigned long long ok0 = __ballot(lane < (int)inb && ge0 >= need && gt0 < need), ok1 = __ballot(lane + 64 < (int)inb && ge1 >= need && gt1 < need);
                if (ok0) T = __builtin_amdgcn_readlane(m0, (int)__builtin_ctzll(ok0)); else T = __builtin_amdgcn_readlane(m1, (int)__builtin_ctzll(ok1 | (1ull << 63)));
                LDS_WAIT();
            } else {
                T = 0u;
                for (int bit = 30; bit >= 0; --bit) { const unsigned cm1 = (T | (1u << bit)) - 1u; unsigned c = 0;
#pragma unroll
                    for (int i = 0; i < 65; ++i) c += (cm1 - u[i]) >> 31;
                    if (wsum(c) >= 256u) T |= 1u << bit; } } }
        unsigned long long* mrow = (unsigned long long*)((unsigned*)(F.ws + WS_MASK) + ((size_t)b * LPAD + p) * MASKW);
        unsigned wlo = 0u, whi = 0u;
#pragma unroll
        for (int i = 0; i < 64; ++i) { const unsigned long long bal = __ballot(u[i] >= T); if (lane == i) { wlo = (unsigned)bal; whi = (unsigned)(bal >> 32); } }
        const unsigned long long b64 = __ballot(u[64] >= T);
        mrow[lane] = ((unsigned long long)whi << 32) | wlo; if (lane == 0) mrow[64] = b64;
    }
    __syncthreads();
}
struct HgChunk { bf16* base; int pitch; int cq, ck, cv; bf16* A; float* dl; };
__device__ __forceinline__ HgChunk hg_chunk(Frame& F, int b, int h, int c) {
    HgChunk k;
    if (c == 0) { unsigned char* mp = F.ws + WS_HMETA + (size_t)h * HMETA_STRIDE; k.base = (bf16*)mp; k.pitch = 384; k.cq = 0; k.ck = 128; k.cv = 256; k.A = (bf16*)(mp + 64 * 384 * 2); k.dl = (float*)(mp + 64 * 384 * 2 + 64 * 64 * 2); }
    else { const size_t ci = (size_t)(b * 4 + h) * 64 + (c - 1); k.base = (bf16*)(F.ws + WS_BIG) + (size_t)(b * SEQ + 64 * (c - 1)) * NNG; k.pitch = NNG; k.cq = C_AQ + h * 128; k.ck = C_AF + h * 128; k.cv = C_AI + h * 128;
        k.A = (bf16*)(F.ws + WS_HA) + ci * 64 * 64; k.dl = (float*)(F.ws + WS_HDL) + ci * 128; }
    return k;
}
__device__ __forceinline__ void hgrn_prep_task(Frame& F, int l, int b, int h, int c) {
    const int d = F.tid & 127, tq = F.tid >> 7, lane = F.lane, wave = F.wave;
    const bf16* P = (const bf16*)(F.ws + WS_BIG);
    LAS bf16* Qt = (LAS bf16*)F.lds; LAS bf16* Kt = Qt + 64 * 136; LAS float* part = (LAS float*)(F.lds + 2 * 64 * 136 * 2);
    const HgChunk ch = hg_chunk(F, b, h, c);
    float lb = 0.f; if (l == 1) { const float a = FIN(F, I_LB)[h * 128 + d], cc = FIN(F, I_LB)[512 + h * 128 + d]; lb = 1.0f / (1.0f + __expf(a - cc)); }
    const bool meta = (c == 0);
    unsigned short zr[16], qr[16], vr[16];
    { const int r0 = meta ? MREAL : b * SEQ + 64 * (c - 1);
#pragma unroll
      for (int i = 0; i < 16; ++i) { int t = 16 * tq + i; if (meta) t = t < NMETA ? t : NMETA - 1; const bf16* pr = P + (size_t)(r0 + t) * NNG + h * 128 + d; zr[i] = pr[C_AF]; qr[i] = pr[C_AQ]; vr[i] = pr[C_AI]; }
      __builtin_amdgcn_sched_barrier(0); }
    float lfv[16];
    float run = 0.f;
#pragma unroll
    for (int i = 0; i < 16; ++i) { const bool valid = !meta || (16 * tq + i < NMETA); const float z = bf2f(zr[i]); const float sg = 1.0f / (1.0f + __expf(-z));
        lfv[i] = valid ? __logf(lb + (1.0f - lb) * sg) : 0.f; run += lfv[i]; }
    part[tq * 128 + d] = run;
    LDS_WAIT(); __syncthreads();
    const float p0 = part[d], p1 = part[128 + d], p2 = part[256 + d], p3 = part[384 + d];
    const float off = (tq > 0 ? p0 : 0.f) + (tq > 1 ? p1 : 0.f) + (tq > 2 ? p2 : 0.f), bmid = p0 + p1, blast = (p0 + p1) + (p2 + p3);
    unsigned kb[8], vb[8]; unsigned short qb[16];
    float bt = off;
#pragma unroll
    for (int i = 0; i < 16; i += 2) { float kbar[2], vv[2];
#pragma unroll
        for (int u = 0; u < 2; ++u) { const int t = 16 * tq + i + u; const bool valid = !meta || (t < NMETA);
            const float lf = lfv[i + u]; const float q = bf2f(qr[i + u]);
            const float kk = valid ? 1.0f - __expf(lf) : 0.f, qq = valid ? q / (1.0f + __expf(-q)) : 0.f; vv[u] = valid ? bf2f(vr[i + u]) : 0.f;
            bt += lf;
            kbar[u] = kk * __expf(blast - bt); qb[i + u] = (unsigned short)f2bf_s(qq * __expf(bt));
            const float qt = qq * __expf(fminf(bt - bmid, 80.f)), kt = kk * __expf(fminf(bmid - bt, 80.f));
            Qt[t * 136 + d] = (bf16)f2bf_s(qt); Kt[t * 136 + d] = (bf16)f2bf_s(kt); }
        kb[i >> 1] = pk2(kbar[0], kbar[1]); vb[i >> 1] = pk2(vv[0], vv[1]); }
    asm volatile("s_waitcnt vmcnt(0)" ::: "memory"); __syncthreads();
#pragma unroll
    for (int i = 0; i < 16; ++i) ch.base[(size_t)(16 * tq + i) * ch.pitch + ch.cq + d] = qb[i];
    { bf16* kd = ch.base + (size_t)(d >> 1) * ch.pitch + ch.ck + (d & 1) * 64 + 16 * tq; bf16* vd = ch.base + (size_t)(d >> 1) * ch.pitch + ch.cv + (d & 1) * 64 + 16 * tq;
      *(GAS v4u*)kd = (v4u){kb[0], kb[1], kb[2], kb[3]}; *(GAS v4u*)(kd + 8) = (v4u){kb[4], kb[5], kb[6], kb[7]};
      *(GAS v4u*)vd = (v4u){vb[0], vb[1], vb[2], vb[3]}; *(GAS v4u*)(vd + 8) = (v4u){vb[4], vb[5], vb[6], vb[7]}; }
    if (tq == 0) ch.dl[d] = __expf(blast);
    LDS_WAIT(); __syncthreads();
    { const int mt = wave >> 1, fr = lane & 15, g = lane >> 4;
#pragma unroll
      for (int u = 0; u < 2; ++u) { const int nt = 2 * (wave & 1) + u; f32x4 acc = (f32x4){0.f, 0.f, 0.f, 0.f};
        if (nt <= mt) {
#pragma unroll
            for (int ks = 0; ks < 4; ++ks) acc = __builtin_amdgcn_mfma_f32_16x16x32_bf16(*(const LAS bf16x8*)(Qt + (16 * mt + fr) * 136 + 32 * ks + 8 * g), *(const LAS bf16x8*)(Kt + (16 * nt + fr) * 136 + 32 * ks + 8 * g), acc, 0, 0, 0);
        }
#pragma unroll
        for (int r = 0; r < 4; ++r) { const int t = 16 * mt + 4 * g + r, s = 16 * nt + fr; ch.A[t * 64 + s] = (bf16)f2bf_s(s <= t ? acc[r] : 0.f); } } }
    __syncthreads();
}
__device__ __forceinline__ float fast_sigmoid_m(float x) { return __builtin_amdgcn_rcpf(1.0f + __expf(-x)); }
__device__ __forceinline__ void hgrn_scan_unit(Frame& F, int l, int b, int h) {
    const int lane = F.lane, wave = F.wave, fr = lane & 15, g = lane >> 4, tid = F.tid;
    constexpr int QP = 136, AP = 72, KP = 72, GP = 136;
    constexpr int BUF = (64 * QP + 64 * AP + 128 * KP + 64 * GP) * 2 + 512;
    LAS float* red = (LAS float*)(F.lds + 2 * BUF);
    const int dv = 16 * wave + fr;
    const float gn = FIN(F, I_GN)[l * 512 + h * 128 + dv];
    const bf16* Pg = (const bf16*)(F.ws + WS_BIG) + C_AG + h * 128;
    f32x4 S[8];
#pragma unroll
    for (int mt = 0; mt < 8; ++mt) S[mt] = (f32x4){0.f, 0.f, 0.f, 0.f};
    v4u rq[2], ra, rk[2], rg[2], rd; bf16x8 bv0, bv1, bn0, bn1;
#define HG_ISSUE(c_, B0, B1) do { const HgChunk ch_ = hg_chunk(F, b, h, (c_)); const int nv_ = ((c_) == 0) ? NMETA : 64; \
        _Pragma("unroll") for (int i = 0; i < 2; ++i) { const int idx = tid + 512 * i, row = idx >> 4, c16 = idx & 15; \
            rq[i] = *(const GAS v4u*)(ch_.base + (size_t)row * ch_.pitch + ch_.cq + 8 * c16); rk[i] = *(const GAS v4u*)(ch_.base + (size_t)row * ch_.pitch + ch_.ck + 8 * c16); \
            rg[i] = (v4u){0u, 0u, 0u, 0u}; if (row < nv_) rg[i] = *(const GAS v4u*)(Pg + (size_t)(((c_) == 0) ? MREAL + row : b * SEQ + 64 * ((c_) - 1) + row) * NNG + 8 * c16); } \
        ra = *(const GAS v4u*)(ch_.A + 8 * tid); if (tid < 32) rd = *(const GAS v4u*)(ch_.dl + 4 * tid); \
        const bf16* vrow_ = ch_.base + (size_t)(dv >> 1) * ch_.pitch + ch_.cv + (dv & 1) * 64 + 8 * g; B0 = ld_frag16(vrow_); B1 = ld_frag16(vrow_ + 32); } while (0)
#define HG_COMMIT(buf_) do { LAS bf16* Q_ = (LAS bf16*)(F.lds + (buf_) * BUF); LAS bf16* A_ = Q_ + 64 * QP; LAS bf16* KT_ = A_ + 64 * AP; LAS bf16* G_ = KT_ + 128 * KP; \
        _Pragma("unroll") for (int i = 0; i < 2; ++i) { const int idx = tid + 512 * i, row = idx >> 4, c16 = idx & 15; *(LAS v4u*)(Q_ + row * QP + 8 * c16) = rq[i]; \
            *(LAS v4u*)(KT_ + (2 * row + (c16 >> 3)) * KP + 8 * (c16 & 7)) = rk[i]; *(LAS v4u*)(G_ + row * GP + 8 * c16) = rg[i]; } \
        *(LAS v4u*)(A_ + (tid >> 3) * AP + 8 * (tid & 7)) = ra; if (tid < 32) *(LAS v4u*)((LAS unsigned char*)(G_ + 64 * GP) + 16 * tid) = rd; } while (0)
    HG_ISSUE(0, bv0, bv1); HG_COMMIT(0);
    for (int c = 0; c <= 64; ++c) {
        const int buf = c & 1;
        LDS_WAIT(); __syncthreads();
        if (c < 64) HG_ISSUE(c + 1, bn0, bn1);
        LAS bf16* Q = (LAS bf16*)(F.lds + buf * BUF); LAS bf16* A = Q + 64 * QP; LAS bf16* KT = A + 64 * AP; LAS bf16* G = KT + 128 * KP; const LAS float* DL = (const LAS float*)(G + 64 * GP);
        f32x4 o[4];
#pragma unroll
        for (int mt = 0; mt < 4; ++mt) o[mt] = (f32x4){0.f, 0.f, 0.f, 0.f};
#pragma unroll
        for (int ks = 0; ks < 4; ++ks) { v4u w; w.x = cvtpk(S[2 * ks][0], S[2 * ks][1]); w.y = cvtpk(S[2 * ks][2], S[2 * ks][3]); w.z = cvtpk(S[2 * ks + 1][0], S[2 * ks + 1][1]); w.w = cvtpk(S[2 * ks + 1][2], S[2 * ks + 1][3]);
            const bf16x8 sb = __builtin_bit_cast(bf16x8, w);
#pragma unroll
            for (int mt = 0; mt < 4; ++mt) { const LAS bf16* qp = Q + (16 * mt + fr) * QP + 32 * ks + 4 * g;
                const bf16x8 af = mk_frag(*(const LAS v2u*)qp, *(const LAS v2u*)(qp + 16));
                o[mt] = __builtin_amdgcn_mfma_f32_16x16x32_bf16(af, sb, o[mt], 0, 0, 0); } }
#pragma unroll
        for (int mt = 0; mt < 4; ++mt) { o[mt] = __builtin_amdgcn_mfma_f32_16x16x32_bf16(*(const LAS bf16x8*)(A + (16 * mt + fr) * AP + 8 * g), bv0, o[mt], 0, 0, 0);
            o[mt] = __builtin_amdgcn_mfma_f32_16x16x32_bf16(*(const LAS bf16x8*)(A + (16 * mt + fr) * AP + 32 + 8 * g), bv1, o[mt], 0, 0, 0); }
#pragma unroll
        for (int mt = 0; mt < 8; ++mt) { const f32x4 dl = *(const LAS f32x4*)(DL + 16 * mt + 4 * g); S[mt] = S[mt] * dl;
            S[mt] = __builtin_amdgcn_mfma_f32_16x16x32_bf16(*(const LAS bf16x8*)(KT + (16 * mt + fr) * KP + 8 * g), bv0, S[mt], 0, 0, 0);
            S[mt] = __builtin_amdgcn_mfma_f32_16x16x32_bf16(*(const LAS bf16x8*)(KT + (16 * mt + fr) * KP + 32 + 8 * g), bv1, S[mt], 0, 0, 0); }
        { float s2[16];
#pragma unroll
          for (int i = 0; i < 16; ++i) s2[i] = o[i >> 2][i & 3] * o[i >> 2][i & 3];
#define HG_ROR(n_) _Pragma("unroll") for (int i = 0; i < 16; ++i) s2[i] += __builtin_bit_cast(float, __builtin_amdgcn_update_dpp(0, __builtin_bit_cast(int, s2[i]), 0x120 + (n_), 0xf, 0xf, false));
          HG_ROR(8) HG_ROR(4) HG_ROR(2) HG_ROR(1)
#undef HG_ROR
          if (fr == 0) {
#pragma unroll
              for (int mt = 0; mt < 4; ++mt) *(LAS f32x4*)(red + wave * 64 + 16 * mt + 4 * g) = (f32x4){s2[4 * mt], s2[4 * mt + 1], s2[4 * mt + 2], s2[4 * mt + 3]}; } }
        LDS_WAIT(); __syncthreads();
        const int nvalid = (c == 0) ? NMETA : 64;
        { f32x4 tot[4]; float gr[16];
#pragma unroll
          for (int mt = 0; mt < 4; ++mt) { tot[mt] = *(const LAS f32x4*)(red + 16 * mt + 4 * g);
#pragma unroll
              for (int w = 1; w < 8; ++w) tot[mt] += *(const LAS f32x4*)(red + w * 64 + 16 * mt + 4 * g); }
#pragma unroll
          for (int i = 0; i < 16; ++i) gr[i] = bf2f(G[(16 * (i >> 2) + 4 * g + (i & 3)) * GP + dv]);
          if (c > 0 || b == 0) {
#pragma unroll
              for (int i = 0; i < 16; ++i) { const int t = 16 * (i >> 2) + 4 * g + (i & 3); const int row = (c == 0) ? MREAL + t : b * SEQ + 64 * (c - 1) + t;
                  const float val = o[i >> 2][i & 3] * __builtin_amdgcn_rsqf(tot[i >> 2][i & 3] * (1.f / 128.f) + EPS) * gn * (gr[i] * fast_sigmoid_m(gr[i]));
                  if (t < nvalid) ((bf16*)(F.ws + WS_BR))[(size_t)row * 512 + h * 128 + dv] = (bf16)f2bf_s(val); } } }
        if (c < 64) { HG_COMMIT(buf ^ 1); bv0 = bn0; bv1 = bn1; }
    }
#undef HG_ISSUE
#undef HG_COMMIT
    __syncthreads();
}
__device__ __forceinline__ void conv_row(Frame& F, int l, int r) {
    const int lane = F.lane; const bf16* P = (const bf16*)(F.ws + WS_BIG);
    int r1, r2;
    if (r < MREAL) { const int b = r >> 12, t = r & 4095; r1 = seqrow(b, NMETA + t - 1); r2 = seqrow(b, NMETA + t - 2); }
    else { const int i = r - MREAL; r1 = i >= 1 ? r - 1 : -1; r2 = i >= 2 ? r - 2 : -1; }
    const float* cw = FIN(F, I_CONVW) + l * 3 * 512 + 8 * lane;
    const int r1c = r1 >= 0 ? r1 : r, r2c = r2 >= 0 ? r2 : r;
    const v4u wc0 = *(const GAS v4u*)(P + (size_t)r * NNG + C_BC + 8 * lane), wu0 = *(const GAS v4u*)(P + (size_t)r * NNG + C_BU + 8 * lane), wb = *(const GAS v4u*)(P + (size_t)r * NNG + C_BB + 8 * lane);
    const v4u wc1 = *(const GAS v4u*)(P + (size_t)r1c * NNG + C_BC + 8 * lane), wu1 = *(const GAS v4u*)(P + (size_t)r1c * NNG + C_BU + 8 * lane);
    const v4u wc2 = *(const GAS v4u*)(P + (size_t)r2c * NNG + C_BC + 8 * lane), wu2 = *(const GAS v4u*)(P + (size_t)r2c * NNG + C_BU + 8 * lane);
    __builtin_amdgcn_sched_barrier(0);
    float c0[8], u0[8], bb[8], y[8]; unpack8(wc0, c0); unpack8(wu0, u0); unpack8(wb, bb);
#pragma unroll
    for (int i = 0; i < 8; ++i) y[i] = cw[i] * (c0[i] * u0[i]);
    const float m1 = r1 >= 0 ? 1.f : 0.f, m2 = r2 >= 0 ? 1.f : 0.f;
    unpack8(wc1, c0); unpack8(wu1, u0);
#pragma unroll
    for (int i = 0; i < 8; ++i) y[i] += m1 * cw[512 + i] * (c0[i] * u0[i]);
    unpack8(wc2, c0); unpack8(wu2, u0);
#pragma unroll
    for (int i = 0; i < 8; ++i) y[i] += m2 * cw[1024 + i] * (c0[i] * u0[i]);
#pragma unroll
    for (int i = 0; i < 8; ++i) y[i] *= bb[i];
    *(GAS v4u*)((bf16*)(F.ws + WS_BR) + (size_t)MPAD * 512 + (size_t)r * 512 + 8 * lane) = pack8(y);
}
constexpr int CW_TMO = 0, CW_BAR = 4096, CW_Q = 16384;
__device__ __forceinline__ int queue_pop(Frame& F, int qi) {
    int t = 0; if (F.lane == 0) t = (int)__hip_atomic_fetch_add((unsigned*)(F.ctl + CW_Q + 64 * qi), 1u, RLX_AGENT);
    return __builtin_amdgcn_readfirstlane(t);
}
__device__ __forceinline__ int queue_pop_wg(Frame& F, int qi) {
    LAS int* slot = (LAS int*)(F.lds + 139264);
    __syncthreads();
    if (F.tid == 0) *slot = (int)__hip_atomic_fetch_add((unsigned*)(F.ctl + CW_Q + 64 * qi), 1u, RLX_AGENT);
    LDS_WAIT(); __syncthreads();
    return __builtin_amdgcn_readfirstlane(*slot);
}
__device__ __forceinline__ void phase_hgrn_prep(Frame& F, int l) {
    for (int t = F.bid; t < NB * 4 * 64 + 4; t += F.G) { if (t < 4) hgrn_prep_task(F, l, 0, t, 0); else { const int u = t - 4; hgrn_prep_task(F, l, u >> 8, (u >> 6) & 3, 1 + (u & 63)); } }
}
__device__ __forceinline__ void phase_prep(Frame& F, int l) { const int gw = F.bid * NWAVES + F.wave, NGW = F.G * NWAVES; for (int r = gw; r < MREAL + NMETA; r += NGW) prep_row(F, l, r); }
__device__ __forceinline__ void phase_vt(Frame& F) { const int gw = F.bid * NWAVES + F.wave, NGW = F.G * NWAVES; for (int t = gw; t < VT_NTASK; t += NGW) vt_task(F, t); }
__device__ __forceinline__ void phase_mix1(Frame& F, int l, int qidx) {
    LAS float* bt = (LAS float*)(F.lds + 135168);
    build_bias_table(F, bt, 0);
    __syncthreads();
#ifndef MIX1_SKIP
#define MIX1_SKIP 0
#endif
    const int sk = (qidx >= 4) ? MIX1_SKIP : 0;
    if (F.bid < NIDX_WG) {
        float* slab = (float*)(F.ws + WS_SCR) + (size_t)F.bid * 32 * LPAD;
        if (!(sk & 1)) for (int t = F.bid; t < NB * NQT; t += NIDX_WG) { const int j = NQT - 1 - t / NB, b = t % NB; dsa_index_task(F, b, j, slab); }
    } else if (F.bid < NIDX_WG + NHG_WG) {
        const int u = F.bid - NIDX_WG; if (!(sk & 2)) hgrn_scan_unit(F, l, u >> 2, u & 3);
    } else {
        const int u0 = F.bid - NIDX_WG - NHG_WG, nw = F.G - NIDX_WG - NHG_WG;
        const int cw = u0 * NWAVES + F.wave, ncw = nw * NWAVES; if (!(sk & 4)) for (int r = cw; r < MREAL + NMETA; r += ncw) conv_row(F, l, r);
    }
    float lam, post;
    { const float* lp = FIN(F, I_DLAM) + l * 256; const float s1 = wave_sum(lp[F.lane] * lp[64 + F.lane]), s2 = wave_sum(lp[128 + F.lane] * lp[192 + F.lane]);
      const float li = 0.8f - 0.6f * __expf(-0.3f * (float)l); lam = __expf(s1) - __expf(s2) + li; post = 1.0f - li; }
    for (;;) { const int t = queue_pop_wg(F, qidx) + ((sk & 8) ? (1 << 20) : 0); if (t >= NB * 4 * NQB) break;
        const int J = NQB - 1 - t / 32, bh = t % 32; attn_wg_task<false>(F, l, bh >> 2, bh & 3, J, bt, lam, post); }
}
__device__ __forceinline__ void phase_mix2(Frame& F, int l, int qidx) {
    LAS float* bt = (LAS float*)(F.lds + 135168);
    build_bias_table(F, bt, 4);
    __syncthreads();
    for (;;) { const int t = queue_pop_wg(F, qidx); if (t >= NB * 4 * NQB) break;
        const int J = NQB - 1 - t / 32, bh = t % 32; attn_wg_task<true>(F, l, bh >> 2, bh & 3, J, bt, 0.f, 1.f); }
}

#ifndef MK_ONE
#define MK_ONE 0
#endif
#ifndef BR_MASK
#define BR_MASK 15
#endif
constexpr int NPH = 18;
template <class T> __device__ __forceinline__ T opaque(T v) { asm volatile("" : "+s"(v)); return v; }
struct Args { const float* in[22]; float* out; unsigned char* ws; int ph_lo, ph_hi; };
__global__ void __launch_bounds__(NWAVES * 64, 2) fwd(Args args) {
    extern __shared__ __attribute__((aligned(16))) unsigned char lds[];
    Frame F;
    F.lds = (LAS unsigned char*)lds; F.MISC = (volatile LAS unsigned*)(F.lds + MISC_OFF);
    F.tid = threadIdx.x; F.lane = F.tid & 63; F.wave = __builtin_amdgcn_readfirstlane(F.tid >> 6); F.G = gridDim.x; F.bid = blockIdx.x;
    F.ws = args.ws; F.out = args.out; F.ctl = (gu32*)(args.ws + WS_CTL);
    F.karg = (const unsigned char __attribute__((address_space(4)))*)__builtin_amdgcn_kernarg_segment_ptr();
    for (int u = F.tid; u < (LDS_BYTES - LDSCTL_OFF) / 4; u += NWAVES * 64) ((LAS unsigned*)(F.lds + LDSCTL_OFF))[u] = 0u;
    __syncthreads();
#if MK_ONE
    XcdBarrier bar = xcd_barrier_post((unsigned*)(F.ctl + CW_BAR), F.MISC + 8, __builtin_amdgcn_readfirstlane(threadIdx.x >> 6));
#ifdef PROBE_BAR2
#define GRID_BAR() do { xcd_barrier(bar); xcd_barrier(bar); } while (0)
#else
#define GRID_BAR() xcd_barrier(bar)
#endif
#else
#define GRID_BAR() do { } while (0)
#endif
    const int wave_s = __builtin_amdgcn_readfirstlane(threadIdx.x >> 6);
    const int lo = args.ph_lo, hi = args.ph_hi;
#define IN(k) (lo <= (k) && (k) < hi)
#define RETID() do { int w_ = wave_s; asm volatile("" : "+s"(w_)); unsigned mk_ = ~0u; asm volatile("" : "+s"(mk_)); int t_ = w_ * 64 + (int)__builtin_amdgcn_mbcnt_hi(mk_, __builtin_amdgcn_mbcnt_lo(mk_, 0u)); asm volatile("" : "+v"(t_)); F.tid = t_; F.lane = t_ & 63; F.wave = w_; } while (0)
#ifdef DBG_TS
#define STAMP(k) do { if (blockIdx.x == 0 && threadIdx.x == 0) ((unsigned long long*)(args.ws + 768 * 1024))[(k)] = __builtin_amdgcn_s_memrealtime(); } while (0)
#else
#define STAMP(k) do { } while (0)
#endif
#define SEAM(k) do { if (IN((k) + 1)) GRID_BAR(); STAMP((k) + 1); } while (0)
#ifndef PROBE_EPI
#define PROBE_EPI 0
#endif
#ifdef PROBE_MASK
#define NREP(kk) opaque(((PROBE_MASK >> (kk)) & 1) ? 1 + PROBE_EXTRA : 1)
#define REP_BEGIN(kk) { const int nrep_ = NREP(kk); for (int rep = 0; rep < nrep_; ++rep) { if (rep) GRID_BAR();
#define REP_END } }
#else
#define REP_BEGIN(kk) { { const int rep = 0; (void)rep;
#define REP_END } }
#endif
    STAMP(0);
    unsigned char* wb = F.ws + WS_W;
    bf16* XN = (bf16*)(F.ws + WS_XN); bf16* BR = (bf16*)(F.ws + WS_BR); bf16* BIG = (bf16*)(F.ws + WS_BIG); float* HM = (float*)(F.ws + WS_HM);
    auto layer = [&](const int l) __attribute__((always_inline)) {
        const int pb = l * NPH;
        const float* hsrc = (l == 0) ? FIN(F, I_X) : F.out;
        if (IN(pb + 0)) { REP_BEGIN(0) RETID(); phase_convert(F, l); REP_END SEAM(pb + 0); }
        if (IN(pb + 1)) { REP_BEGIN(1) RETID(); phase_norm(F, hsrc, FIN(F, I_F1N) + l * DM); REP_END SEAM(pb + 1); }
        if (IN(pb + 2)) { REP_BEGIN(2) RETID(); meta_gemm(F, 0, XN + (size_t)MREAL * DM, DM, (const bf16*)(wb + W_GU1), NGU, DM, BIG, DFF, 0.f); pg8::Gemm g{opaque((const bf16*)(XN)), opaque((const bf16*)(wb + W_GU1)), MREAL, NGU, DM}; pg8::StaticOrder S; S.init(MREAL, NGU, F.G, opaque(F.bid));
            pg8::EpiSwiGLU E{BIG, DFF, rep ? PROBE_EPI : 0}; pg8::gemm_phase<pg8::EpiSwiGLU, pg8::StaticOrder, true, true>(F.lds + RING_OFF, g, S, E, F.tid); REP_END SEAM(pb + 2); }
        if (IN(pb + 3)) { REP_BEGIN(3) RETID(); meta_gemm(F, 1, BIG + (size_t)MREAL * DFF, DFF, (const bf16*)(wb + W_D1), DM, DFF, nullptr, 0, rep ? 0.f : 0.5f); pg8::Gemm g{opaque((const bf16*)(BIG)), opaque((const bf16*)(wb + W_D1)), MREAL, DM, DFF}; pg8::StaticOrder S; S.init(MREAL, DM, F.G, opaque(F.bid));
            pg8::EpiResF32 E{rep ? F.out : hsrc, F.out, HM, DM, MT_REAL, rep ? 0.f : 0.5f}; pg8::gemm_phase<pg8::EpiResF32, pg8::StaticOrder, true, true>(F.lds + RING_OFF, g, S, E, F.tid); REP_END SEAM(pb + 3); }
        if (IN(pb + 4)) { REP_BEGIN(4) RETID(); phase_norm(F, F.out, FIN(F, I_MIXN) + l * DM); REP_END SEAM(pb + 4); }
        if (IN(pb + 5)) { REP_BEGIN(5) RETID(); meta_gemm(F, 2, XN + (size_t)MREAL * DM, DM, (const bf16*)(wb + W_NG), NNG, DM, BIG, NNG, 0.f); pg8::Gemm g{opaque((const bf16*)(XN)), opaque((const bf16*)(wb + W_NG)), MREAL, NNG, DM}; pg8::StaticOrder S; S.init(MREAL, NNG, F.G, opaque(F.bid));
            pg8::EpiBf16<0> E{BIG, NNG}; pg8::gemm_phase<pg8::EpiBf16<0>, pg8::StaticOrder, true, true>(F.lds + RING_OFF, g, S, E, F.tid); REP_END SEAM(pb + 5); }
        if (IN(pb + 6)) { RETID(); phase_prep(F, l); phase_vt(F); __syncthreads(); phase_hgrn_prep(F, l); SEAM(pb + 6); }
#ifdef DUP_MIX
        if (IN(pb + 7)) { const int nrep = opaque(DUP_MIX1); for (int rep = 0; rep < nrep; ++rep) { RETID(); phase_mix1(F, l, 4 * rep + 2 * l); GRID_BAR(); } }
        if (IN(pb + 8)) { const int nrep = opaque(DUP_MIX2); for (int rep = 0; rep < nrep; ++rep) { RETID(); phase_mix2(F, l, 4 * rep + 2 * l + 1); GRID_BAR(); } }
#else
        if (IN(pb + 7)) { RETID(); phase_mix1(F, l, 2 * l); SEAM(pb + 7); }
        if (IN(pb + 8)) { RETID(); phase_mix2(F, l, 2 * l + 1); SEAM(pb + 8); }
#endif
        if (IN(pb + 9)) { REP_BEGIN(9) RETID(); meta_gemm(F, 3, XN + (size_t)MREAL * DM, DM, (const bf16*)(wb + W_G), NGATE, DM, BIG, NGATE, 0.f); pg8::Gemm g{opaque((const bf16*)(XN)), opaque((const bf16*)(wb + W_G)), MREAL, NGATE, DM}; pg8::StaticOrder S; S.init(MREAL, NGATE, F.G, opaque(F.bid));
            pg8::EpiBf16<1> E{BIG, NGATE}; pg8::gemm_phase<pg8::EpiBf16<1>, pg8::StaticOrder, true, true>(F.lds + RING_OFF, g, S, E, F.tid); REP_END SEAM(pb + 9); }
        if (IN(pb + 10)) { REP_BEGIN(10) RETID(); meta_gemm(F, 4, BR + (size_t)MREAL * 512, 512, (const bf16*)(wb + W_BR), DM, 512, XN, DM, 0.f);
            pg8::Gemm g{opaque((const bf16*)(BR)), opaque((const bf16*)(wb + W_BR)), MREAL, DM, 512}; pg8::MergeOrder S; S.init(MREAL, DM, F.G, opaque(F.bid), MPAD / 256);
            pg8::EpiGateAccM E{XN, DM, BIG, NGATE, MPAD / 256, DM / 256}; pg8::gemm_phase<pg8::EpiGateAccM, pg8::MergeOrder, true, true>(F.lds + RING_OFF, g, S, E, F.tid); REP_END SEAM(pb + 10); }
        if (IN(pb + 14) && BR_MASK) { REP_BEGIN(14) RETID(); meta_gemm(F, 1, XN + (size_t)MREAL * DM, DM, (const bf16*)(wb + W_O), DM, DM, nullptr, 0, rep ? 0.f : 1.0f); pg8::Gemm g{opaque((const bf16*)(XN)), opaque((const bf16*)(wb + W_O)), MREAL, DM, DM}; pg8::StaticOrder S; S.init(MREAL, DM, F.G, opaque(F.bid));
            pg8::EpiResF32 E{F.out, F.out, HM, DM, MT_REAL, rep ? 0.f : 1.0f}; pg8::gemm_phase<pg8::EpiResF32, pg8::StaticOrder, true, true>(F.lds + RING_OFF, g, S, E, F.tid); REP_END SEAM(pb + 14); }
        if (IN(pb + 15)) { REP_BEGIN(15) RETID(); phase_norm(F, F.out, FIN(F, I_F2N) + l * DM); REP_END SEAM(pb + 15); }
        if (IN(pb + 16)) { REP_BEGIN(16) RETID(); meta_gemm(F, 0, XN + (size_t)MREAL * DM, DM, (const bf16*)(wb + W_GU2), NGU, DM, BIG, DFF, 0.f); pg8::Gemm g{opaque((const bf16*)(XN)), opaque((const bf16*)(wb + W_GU2)), MREAL, NGU, DM}; pg8::StaticOrder S; S.init(MREAL, NGU, F.G, opaque(F.bid));
            pg8::EpiSwiGLU E{BIG, DFF, rep ? PROBE_EPI : 0}; pg8::gemm_phase<pg8::EpiSwiGLU, pg8::StaticOrder, true, true>(F.lds + RING_OFF, g, S, E, F.tid); REP_END SEAM(pb + 16); }
        if (IN(pb + 17)) { REP_BEGIN(17) RETID(); meta_gemm(F, 1, BIG + (size_t)MREAL * DFF, DFF, (const bf16*)(wb + W_D2), DM, DFF, nullptr, 0, rep ? 0.f : 0.5f); pg8::Gemm g{opaque((const bf16*)(BIG)), opaque((const bf16*)(wb + W_D2)), MREAL, DM, DFF}; pg8::StaticOrder S; S.init(MREAL, DM, F.G, opaque(F.bid));
            pg8::EpiResF32 E{F.out, F.out, HM, DM, MT_REAL, rep ? 0.f : 0.5f}; pg8::gemm_phase<pg8::EpiResF32, pg8::StaticOrder, true, true>(F.lds + RING_OFF, g, S, E, F.tid); REP_END SEAM(pb + 17); }
    };
    layer(0); layer(1);
}

extern "C" void kernel_launch(void* const* d_in, const int* in_sizes, int n_in, void* d_out, int out_size, void* d_ws, size_t ws_size, hipStream_t stream) {
    static int grid = 0;
    if (grid == 0) {
        if (n_in != 22 || out_size != MREAL * DM || ws_size < WS_END) { fprintf(stderr, "kernel_launch: unexpected shapes (n_in %d out %d ws %zu need %zu)\n", n_in, out_size, ws_size, (size_t)WS_END); grid = -1; return; }
        int dev = 0, cus = 0, per_cu = 0;
        if (hipGetDevice(&dev) != hipSuccess || hipDeviceGetAttribute(&cus, hipDeviceAttributeMultiprocessorCount, dev) != hipSuccess) { grid = -1; return; }
        if (hipFuncSetAttribute((const void*)fwd, hipFuncAttributeMaxDynamicSharedMemorySize, LDS_BYTES) != hipSuccess) { fprintf(stderr, "kernel_launch: hipFuncSetAttribute failed\n"); grid = -1; return; }
        if (hipOccupancyMaxActiveBlocksPerMultiprocessor(&per_cu, (const void*)fwd, NWAVES * 64, LDS_BYTES) != hipSuccess || per_cu < 1) fprintf(stderr, "kernel_launch: occupancy query says %d\n", per_cu);
        (void)hipGetLastError();
        grid = cus < 256 ? cus : 256;
    }
    if (grid < 0) return;
    (void)hipMemsetAsync((char*)d_ws + WS_CTL, 0, CTL_ZERO_BYTES, stream);
    Args a{};
    for (int i = 0; i < 22; ++i) a.in[i] = (const float*)d_in[i];
    a.out = (float*)d_out; a.ws = (unsigned char*)d_ws;
#ifndef PH_END
#define PH_END (2 * NPH)
#endif
#if MK_ONE
    a.ph_lo = 0; a.ph_hi = PH_END;
    hipLaunchKernelGGL(fwd, dim3(grid), dim3(NWAVES * 64), LDS_BYTES, stream, a);
#else
    for (int p = 0; p < PH_END; ++p) { a.ph_lo = p; a.ph_hi = p + 1;
        hipLaunchKernelGGL(fwd, dim3(grid), dim3(NWAVES * 64), LDS_BYTES, stream, a); }
#endif
}
```

```cpp
#include <hip/hip_runtime.h>
#include <cstdio>
#include <cstdint>
#define MK_ONE 1
namespace pg8 {
#define PG8_LAS __attribute__((address_space(3)))
typedef unsigned short bf16_t;
typedef short bf16x8 __attribute__((ext_vector_type(8)));
typedef float f32x4 __attribute__((ext_vector_type(4)));
typedef unsigned u32x4 __attribute__((ext_vector_type(4)));
constexpr int BM = 256, BK = 64, HALF = 128, HTB = HALF * BK * 2  , STAGE_BYTES = 8 * HTB, NXCD = 8, WGM = 4;

__host__ __device__ __forceinline__ int lds_byte(int r, int c) { const int st = (r >> 4) * 2 + (c >> 5), rr = r & 15, cc = c & 31, ob = rr * 64 + cc * 2; return st * 1024 + (ob ^ (((ob >> 9) & 1) << 5)); }
__host__ __device__ __forceinline__ void stage_rc(int b, int& R, int& C) { const int st = b / 1024, sb = b % 1024, swz = sb ^ (((sb >> 9) & 1) << 5); R = (st >> 1) * 16 + swz / 64; C = (st & 1) * 32 + (swz % 64) / 2; }
__host__ __device__ __forceinline__ int perm32(int rho) { const int n = rho >> 4, i = rho & 15; return 8 * (i >> 2) + 4 * n + (i & 3); }

struct Unit { int pm, pn; };
struct Gemm { const bf16_t* A; const bf16_t* Bt; int M, N, K; };

struct StaticOrder {
    int nM, nN, nwg, G, c;
    __host__ __device__ void init(int M, int N, int G_, int c_) { nM = M / BM; nN = N / BM; nwg = nM * nN; G = G_; c = c_; }
    __host__ __device__ bool next(int i, Unit& u) const {
        const long L = (long)i * G + c; if (L >= nwg) return false;
        int wgid = (int)L; { const int q = nwg / NXCD, r = nwg % NXCD, xcd = wgid % NXCD, off = wgid / NXCD; wgid = (xcd < r ? xcd * (q + 1) : r * (q + 1) + (xcd - r) * q) + off; }
        const int nig = WGM * nN, gid = wgid / nig, fm = gid * WGM, gsz = (nM - fm) < WGM ? (nM - fm) : WGM;
        u.pm = fm + ((wgid % nig) % gsz); u.pn = (wgid % nig) / gsz; return true;
    }
    __device__ __forceinline__ void a_ready(const Unit&) const {}
    __device__ __forceinline__ void done(const Unit&) const {}
};
typedef __bf16 bf16x2_hw __attribute__((ext_vector_type(2))); typedef float f32x2_hw __attribute__((ext_vector_type(2)));
__device__ __forceinline__ unsigned cvt_pk_bf16(float lo, float hi) { const f32x2_hw v = {lo, hi}; return __builtin_bit_cast(unsigned, __builtin_convertvector(v, bf16x2_hw)); }
typedef float f32x2 __attribute__((ext_vector_type(2)));
__device__ __forceinline__ float fast_sigmoid(float x) { return __builtin_amdgcn_rcpf(1.0f + __expf(-x)); }
__device__ __forceinline__ float fast_silu(float x) { return x * fast_sigmoid(x); }
template <int ACT  > struct EpiBf16 {
    static constexpr bool PERM = true, AFTER_DRAIN = false;
    bf16_t* O; int ldc;
    __device__ __forceinline__ void operator()(const f32x4 (&acc)[2][2][4][2], const Unit& u, int wr, int wc, int fr, int fq) const {
        const int row0 = u.pm * BM + wr * 64 + fr; const int col0 = u.pn * BM + wc * 32 + 8 * fq;
#pragma unroll
        for (int ai = 0; ai < 2; ++ai)
#pragma unroll
            for (int m = 0; m < 4; ++m) { bf16_t* rowp = O + (size_t)(row0 + ai * HALF + m * 16) * ldc + col0;
#pragma unroll
                for (int bj = 0; bj < 2; ++bj) { f32x4 v0 = acc[ai][bj][m][0], v1 = acc[ai][bj][m][1];
                    if (ACT == 1) {
#pragma unroll
                        for (int j = 0; j < 4; ++j) { v0[j] = fast_sigmoid(v0[j]); v1[j] = fast_sigmoid(v1[j]); } }
                    u32x4 w; w.x = cvt_pk_bf16(v0[0], v0[1]); w.y = cvt_pk_bf16(v0[2], v0[3]); w.z = cvt_pk_bf16(v1[0], v1[1]); w.w = cvt_pk_bf16(v1[2], v1[3]);
                    *(u32x4*)(rowp + bj * HALF) = w; } }
    }
};
struct EpiSwiGLU {
    static constexpr bool PERM = true, AFTER_DRAIN = false;
    bf16_t* O; int ldc; int mode;
    __device__ __forceinline__ void operator()(const f32x4 (&acc)[2][2][4][2], const Unit& u, int wr, int wc, int fr, int fq) const {
        if (mode == 2) return;
        const int row0 = u.pm * BM + wr * 64 + fr; const int col0 = u.pn * HALF + wc * 32 + 8 * fq;
#pragma unroll
        for (int ai = 0; ai < 2; ++ai)
#pragma unroll
            for (int m = 0; m < 4; ++m) { bf16_t* rowp = O + (size_t)(row0 + ai * HALF + m * 16) * ldc + col0;
                const f32x4 g0 = acc[ai][0][m][0], g1 = acc[ai][0][m][1], u0 = acc[ai][1][m][0], u1 = acc[ai][1][m][1];
                f32x4 v0, v1;
#pragma unroll
                for (int j = 0; j < 4; ++j) { v0[j] = fast_silu(g0[j]) * u0[j]; v1[j] = fast_silu(g1[j]) * u1[j]; }
                u32x4 w; w.x = cvt_pk_bf16(v0[0], v0[1]); w.y = cvt_pk_bf16(v0[2], v0[3]); w.z = cvt_pk_bf16(v1[0], v1[1]); w.w = cvt_pk_bf16(v1[2], v1[3]);
                if (mode == 0) *(u32x4*)rowp = w; else asm volatile("" :: "v"(w.x), "v"(w.y), "v"(w.z), "v"(w.w));
                asm volatile("" ::: "memory"); }
    }
};
struct EpiResF32 {
    static constexpr bool PERM = false, AFTER_DRAIN = false;
    const float* base_r; float* out_r; float* hm; int ldc; int mt_real; float scale;
    __device__ __forceinline__ void operator()(const f32x4 (&acc)[2][2][4][2], const Unit& u, int wr, int wc, int fr, int fq) const {
        const bool real = u.pm < mt_real;
        const float* bp = real ? base_r + (size_t)u.pm * BM * ldc : hm; float* op = real ? out_r + (size_t)u.pm * BM * ldc : hm;
        const int row0 = wr * 64 + fr, col0 = u.pn * BM + wc * 32 + 4 * fq;
#pragma unroll
        for (int ai = 0; ai < 2; ++ai) {
            f32x4 b[4][2][2];
#pragma unroll
            for (int m = 0; m < 4; ++m) { const size_t off = (size_t)(row0 + ai * HALF + m * 16) * ldc + col0;
#pragma unroll
                for (int bj = 0; bj < 2; ++bj)
#pragma unroll
                    for (int n = 0; n < 2; ++n) b[m][bj][n] = *(const f32x4*)(bp + off + bj * HALF + n * 16); }
            asm volatile("" ::: "memory");
#pragma unroll
            for (int m = 0; m < 4; ++m) { const size_t off = (size_t)(row0 + ai * HALF + m * 16) * ldc + col0;
#pragma unroll
                for (int bj = 0; bj < 2; ++bj)
#pragma unroll
                    for (int n = 0; n < 2; ++n) *(f32x4*)(op + off + bj * HALF + n * 16) = b[m][bj][n] + acc[ai][bj][m][n] * scale; }
            asm volatile("" ::: "memory"); }
    }
};
struct EpiGateAcc {
    static constexpr bool PERM = true, AFTER_DRAIN = false;
    bf16_t* MG; int ldc; const bf16_t* G; int ldg; int gcol0; int first;
    __device__ __forceinline__ void operator()(const f32x4 (&acc)[2][2][4][2], const Unit& u, int wr, int wc, int fr, int fq) const {
        const int row0 = u.pm * BM + wr * 64 + fr; const int col0 = u.pn * BM + wc * 32 + 8 * fq;
#pragma unroll
        for (int ai = 0; ai < 2; ++ai)
#pragma unroll
            for (int m = 0; m < 4; ++m) { const size_t r = (size_t)(row0 + ai * HALF + m * 16);
#pragma unroll
                for (int bj = 0; bj < 2; ++bj) { const u32x4 gw = *(const u32x4*)(G + r * ldg + gcol0 + col0 + bj * HALF);
                    u32x4 pw = (u32x4){0u, 0u, 0u, 0u}; if (!first) pw = *(const u32x4*)(MG + r * ldc + col0 + bj * HALF);
                    float o[8];
#pragma unroll
                    for (int j = 0; j < 4; ++j) { const float a0 = (j < 2) ? acc[ai][bj][m][0][2 * j] : acc[ai][bj][m][1][2 * (j - 2)], a1 = (j < 2) ? acc[ai][bj][m][0][2 * j + 1] : acc[ai][bj][m][1][2 * (j - 2) + 1];
                        o[2 * j] = __uint_as_float(pw[j] << 16) + __uint_as_float(gw[j] << 16) * a0; o[2 * j + 1] = __uint_as_float(pw[j] & 0xffff0000u) + __uint_as_float(gw[j] & 0xffff0000u) * a1; }
                    u32x4 w; w.x = cvt_pk_bf16(o[0], o[1]); w.y = cvt_pk_bf16(o[2], o[3]); w.z = cvt_pk_bf16(o[4], o[5]); w.w = cvt_pk_bf16(o[6], o[7]);
                    *(u32x4*)(MG + r * ldc + col0 + bj * HALF) = w; } }
    }
};

struct MergeOrder {
    int nM, nN, G, c, mt_alloc;
    __host__ __device__ void init(int M, int N, int G_, int c_, int mt_alloc_) { nM = M / BM; nN = N / BM; G = G_; c = c_; mt_alloc = mt_alloc_; }
    __host__ __device__ bool next(int i, Unit& u) const { const int t = (i >> 2) * G + c, m = i & 3; if (t >= nM * nN) return false;
        int pm = t / nN, pn = t % nN;
        if (G == 256 && nM == 128 && nN == 8) { pm = 16 * (c & 7) + 4 * (i >> 2) + ((c >> 3) & 3); pn = c >> 5; }
        u.pm = m * mt_alloc + pm; u.pn = m * nN + pn; return true; }
    __device__ __forceinline__ void a_ready(const Unit&) const {}
    __device__ __forceinline__ void done(const Unit&) const {}
};
struct EpiGateAccM {
    static constexpr bool PERM = true, AFTER_DRAIN = false;
    bf16_t* MG; int ldc; const bf16_t* G; int ldg; int mt_alloc; int ntn;
    __device__ __forceinline__ void operator()(const f32x4 (&acc)[2][2][4][2], const Unit& u, int wr, int wc, int fr, int fq) const {
        const int m = u.pm / mt_alloc, pm = u.pm - m * mt_alloc, pn = u.pn - m * ntn;
        const int row0 = pm * BM + wr * 64 + fr; const int col0 = pn * BM + wc * 32 + 8 * fq; const int gcol0 = m * ntn * BM;
#pragma unroll
        for (int ai = 0; ai < 2; ++ai)
#pragma unroll
            for (int mm = 0; mm < 4; ++mm) { const size_t r = (size_t)(row0 + ai * HALF + mm * 16);
#pragma unroll
                for (int bj = 0; bj < 2; ++bj) { const u32x4 gw = *(const u32x4*)(G + r * ldg + gcol0 + col0 + bj * HALF);
                    u32x4 pw = (u32x4){0u, 0u, 0u, 0u}; if (m != 0) pw = *(const u32x4*)(MG + r * ldc + col0 + bj * HALF);
                    float o[8];
#pragma unroll
                    for (int j = 0; j < 4; ++j) { const float a0 = (j < 2) ? acc[ai][bj][mm][0][2 * j] : acc[ai][bj][mm][1][2 * (j - 2)], a1 = (j < 2) ? acc[ai][bj][mm][0][2 * j + 1] : acc[ai][bj][mm][1][2 * (j - 2) + 1];
                        o[2 * j] = __uint_as_float(pw[j] << 16) + __uint_as_float(gw[j] << 16) * a0; o[2 * j + 1] = __uint_as_float(pw[j] & 0xffff0000u) + __uint_as_float(gw[j] & 0xffff0000u) * a1; }
                    u32x4 w; w.x = cvt_pk_bf16(o[0], o[1]); w.y = cvt_pk_bf16(o[2], o[3]); w.z = cvt_pk_bf16(o[4], o[5]); w.w = cvt_pk_bf16(o[6], o[7]);
                    *(u32x4*)(MG + r * ldc + col0 + bj * HALF) = w; } }
    }
};
template <class Epi, class Sched, bool ALIGN_EPI = false, bool SP2 = false>
__device__ __forceinline__ void gemm_phase(PG8_LAS unsigned char* lds, const Gemm g, const Sched& S, const Epi& E, int tid_in) {
    int tid_ = tid_in; asm volatile("" : "+v"(tid_));
    const int tid = tid_, wid = __builtin_amdgcn_readfirstlane(tid >> 6), lane = tid & 63, wr = wid >> 2, wc = wid & 3, fr = lane & 15, fq = lane >> 4;
    const int K = g.K, nt = K / BK;
    unsigned voffA[2], voffB[2];
#pragma unroll
    for (int i = 0; i < 2; ++i) { int R, C; stage_rc(tid * 16 + i * 8192, R, C); const int Rb = Epi::PERM ? ((R & ~31) + perm32(R & 31)) : R;
        voffA[i] = (unsigned)(R * K + C) * 2u; voffB[i] = (unsigned)(Rb * K + C) * 2u; }
    const size_t kstep = (size_t)(BK * 2);
    const size_t hstep = (size_t)HALF * K * 2;
    const size_t tstep = 2 * hstep;
    const unsigned ldsw = (unsigned)wid * 1024u;
    const int aoff = lds_byte(wr * 64 + fr, fq * 8), boff = lds_byte(wc * 32 + fr, fq * 8);
#define PG8_SA(b, h) (((b) * 2 + (h)) * HTB)
#define PG8_SB(b, h) ((4 + (b) * 2 + (h)) * HTB)
#define PG8_STAGE(bufoff, gbase, voff) do { _Pragma("unroll") for (int _i = 0; _i < 2; ++_i) \
        __builtin_amdgcn_global_load_lds((const unsigned*)((const char*)(gbase) + (voff)[_i]), (PG8_LAS unsigned*)(lds + (bufoff) + ldsw + _i * 8192), 16, 0, 0); } while (0)
#define PG8_LDA(dst, b, h) do { _Pragma("unroll") for (int m = 0; m < 4; ++m) _Pragma("unroll") for (int k = 0; k < 2; ++k) dst[m][k] = *(const PG8_LAS bf16x8*)(lds + PG8_SA(b, h) + aoff + m * 2048 + k * 1024); } while (0)
#define PG8_LDB(dst, b, h) do { _Pragma("unroll") for (int n = 0; n < 2; ++n) _Pragma("unroll") for (int k = 0; k < 2; ++k) dst[n][k] = *(const PG8_LAS bf16x8*)(lds + PG8_SB(b, h) + boff + n * 2048 + k * 1024); } while (0)
#define PG8_MMA(ai, bj, At, Bt) do { __builtin_amdgcn_s_setprio(1); _Pragma("unroll") for (int m = 0; m < 4; ++m) _Pragma("unroll") for (int n = 0; n < 2; ++n) _Pragma("unroll") for (int k = 0; k < 2; ++k) \
        acc[ai][bj][m][n] = __builtin_amdgcn_mfma_f32_16x16x32_bf16(Bt[n][k], At[m][k], acc[ai][bj][m][n], 0, 0, 0); __builtin_amdgcn_s_setprio(0); } while (0)
#define PG8_WAIT_V(n) asm volatile("s_waitcnt vmcnt(" #n ")" ::: "memory")
#define PG8_WAIT_L(n) asm volatile("s_waitcnt lgkmcnt(" #n ")" ::: "memory")
#define PG8_BAR __builtin_amdgcn_s_barrier()
#define PG8_SCHED __builtin_amdgcn_sched_barrier(0)
    Unit cur, nxt; int ui = 0;
    if (!S.next(0, cur)) return;
    f32x4 acc[2][2][4][2];
#pragma unroll
    for (int a = 0; a < 2; ++a)
#pragma unroll
        for (int b = 0; b < 2; ++b)
#pragma unroll
            for (int m = 0; m < 4; ++m)
#pragma unroll
                for (int n = 0; n < 2; ++n) acc[a][b][m][n] = (f32x4){0.f, 0.f, 0.f, 0.f};
    bf16x8 At[4][2], B0[2][2], B1[2][2];
    const char* cA = (const char*)g.A + (size_t)cur.pm * tstep; const char* cB = (const char*)g.Bt + (size_t)cur.pn * tstep;
    S.a_ready(cur);
    if constexpr (SP2) {
        PG8_STAGE(PG8_SB(0, 0), cB, voffB); PG8_STAGE(PG8_SB(0, 1), cB + hstep, voffB); PG8_STAGE(PG8_SA(0, 0), cA, voffA); PG8_STAGE(PG8_SA(0, 1), cA + hstep, voffA);
        if (wr == 1) PG8_BAR;
        PG8_WAIT_V(2); PG8_BAR;
        PG8_STAGE(PG8_SB(1, 0), cB + kstep, voffB); PG8_STAGE(PG8_SA(1, 0), cA + kstep, voffA); PG8_STAGE(PG8_SB(1, 1), cB + hstep + kstep, voffB);
        PG8_WAIT_V(6); PG8_BAR;
    } else {
        PG8_STAGE(PG8_SB(0, 0), cB, voffB); PG8_STAGE(PG8_SA(0, 0), cA, voffA); PG8_STAGE(PG8_SB(0, 1), cB + hstep, voffB); PG8_STAGE(PG8_SA(0, 1), cA + hstep, voffA);
        if (wr == 1) PG8_BAR;
        PG8_WAIT_V(4); PG8_BAR;
        PG8_STAGE(PG8_SB(1, 0), cB + kstep, voffB); PG8_STAGE(PG8_SA(1, 0), cA + kstep, voffA); PG8_STAGE(PG8_SB(1, 1), cB + hstep + kstep, voffB);
        PG8_WAIT_V(6); PG8_BAR;
    }
    for (;;) {
        const bool has_next = S.next(ui + 1, nxt);
        const char* nA = has_next ? (const char*)g.A + (size_t)nxt.pm * tstep : cA; const char* nB = has_next ? (const char*)g.Bt + (size_t)nxt.pn * tstep : cB;
        for (int t = 0; t < nt; t += 2) {
            const bool last = (t == nt - 2);
            const char* a1 = cA + (size_t)(t + 1) * kstep;
            const char* a2 = last ? nA : cA + (size_t)(t + 2) * kstep; const char* b2 = last ? nB : cB + (size_t)(t + 2) * kstep;
            const char* a3 = a2 + kstep; const char* b3 = b2 + kstep;
            if (last && has_next) S.a_ready(nxt);
            if constexpr (SP2) {
            PG8_LDB(B0, 0, 0); PG8_LDB(B1, 0, 1); PG8_SCHED; PG8_LDA(At, 0, 0); PG8_STAGE(PG8_SA(1, 1), a1 + hstep, voffA);
            PG8_WAIT_V(8); PG8_WAIT_L(0); PG8_BAR; PG8_MMA(0, 0, At, B0); PG8_MMA(0, 1, At, B1); PG8_BAR; PG8_SCHED;
            PG8_LDA(At, 0, 1); PG8_STAGE(PG8_SB(0, 0), b2, voffB); PG8_STAGE(PG8_SB(0, 1), b2 + hstep, voffB); PG8_STAGE(PG8_SA(0, 0), a2, voffA);
            PG8_WAIT_V(8); PG8_WAIT_L(0); PG8_BAR; PG8_MMA(1, 0, At, B0); PG8_MMA(1, 1, At, B1); PG8_BAR; PG8_SCHED;
            PG8_LDB(B0, 1, 0); PG8_LDB(B1, 1, 1); PG8_SCHED; PG8_LDA(At, 1, 0); PG8_STAGE(PG8_SA(0, 1), a2 + hstep, voffA);
            PG8_WAIT_V(8); PG8_WAIT_L(0); PG8_BAR; PG8_MMA(0, 0, At, B0); PG8_MMA(0, 1, At, B1); PG8_BAR; PG8_SCHED;
            PG8_LDA(At, 1, 1); PG8_STAGE(PG8_SB(1, 0), b3, voffB); PG8_STAGE(PG8_SB(1, 1), b3 + hstep, voffB); PG8_STAGE(PG8_SA(1, 0), a3, voffA);
            PG8_WAIT_V(8); PG8_WAIT_L(0); PG8_BAR; PG8_MMA(1, 0, At, B0); PG8_MMA(1, 1, At, B1); PG8_BAR; PG8_SCHED;
            } else {
            PG8_LDB(B0, 0, 0); PG8_SCHED; PG8_LDA(At, 0, 0); PG8_STAGE(PG8_SA(1, 1), a1 + hstep, voffA);
            PG8_WAIT_L(8); PG8_BAR; PG8_WAIT_L(0); PG8_MMA(0, 0, At, B0); PG8_BAR; PG8_SCHED;
            PG8_LDB(B1, 0, 1); PG8_STAGE(PG8_SB(0, 0), b2, voffB);
            PG8_BAR; PG8_WAIT_L(0); PG8_MMA(0, 1, At, B1); PG8_BAR;
            PG8_LDA(At, 0, 1); PG8_STAGE(PG8_SA(0, 0), a2, voffA);
            PG8_BAR; PG8_WAIT_L(0); PG8_MMA(1, 0, At, B0); PG8_BAR; PG8_SCHED;
            PG8_STAGE(PG8_SB(0, 1), b2 + hstep, voffB);
            PG8_WAIT_V(6); PG8_BAR; PG8_MMA(1, 1, At, B1); PG8_BAR;
            PG8_LDB(B0, 1, 0); PG8_SCHED; PG8_LDA(At, 1, 0); PG8_STAGE(PG8_SA(0, 1), a2 + hstep, voffA);
            PG8_WAIT_L(8); PG8_BAR; PG8_WAIT_L(0); PG8_MMA(0, 0, At, B0); PG8_BAR; PG8_SCHED;
            PG8_LDB(B1, 1, 1); PG8_STAGE(PG8_SB(1, 0), b3, voffB);
            PG8_BAR; PG8_WAIT_L(0); PG8_MMA(0, 1, At, B1); PG8_BAR;
            PG8_LDA(At, 1, 1); PG8_STAGE(PG8_SA(1, 0), a3, voffA);
            PG8_BAR; PG8_WAIT_L(0); PG8_MMA(1, 0, At, B0); PG8_BAR; PG8_SCHED;
            PG8_STAGE(PG8_SB(1, 1), b3 + hstep, voffB);
            PG8_WAIT_V(6); PG8_BAR; PG8_MMA(1, 1, At, B1); PG8_BAR;
            }
        }
        if constexpr (ALIGN_EPI) { if (wr == 0) PG8_BAR; }
        if constexpr (!Epi::AFTER_DRAIN) { E(acc, cur, wr, wc, fr, fq); S.done(cur); }
        if (!has_next) break;
#pragma unroll
        for (int a = 0; a < 2; ++a)
#pragma unroll
            for (int b = 0; b < 2; ++b)
#pragma unroll
                for (int m = 0; m < 4; ++m)
#pragma unroll
                    for (int n = 0; n < 2; ++n) acc[a][b][m][n] = (f32x4){0.f, 0.f, 0.f, 0.f};
        cur = nxt; cA = nA; cB = nB; ++ui;
        if constexpr (ALIGN_EPI) { if (wr == 1) PG8_BAR; }
    }
    PG8_WAIT_V(0);
    if constexpr (!ALIGN_EPI) { if (wr == 0) PG8_BAR; }
    PG8_BAR;
    if constexpr (Epi::AFTER_DRAIN) { E.fused(acc, cur, wr, wc, fr, fq, lds, wid, lane); S.done(cur); }
#undef PG8_SA
#undef PG8_SB
#undef PG8_STAGE
#undef PG8_LDA
#undef PG8_LDB
#undef PG8_MMA
#undef PG8_WAIT_V
#undef PG8_WAIT_L
#undef PG8_BAR
#undef PG8_SCHED
}
}

constexpr int DM = 2048, NB = 8, SEQ = 4096, NMETA = 16, LSEQ = 4112, LPAD = 4128;
constexpr int MREAL = NB * SEQ;
constexpr int MPAD = MREAL + 256;
constexpr int MT_REAL = MREAL / 256;
constexpr int DFF = 5632, NGU = 2 * DFF, NNG = 7168, NGATE = 8192, INCOLS = 15184, NGC = 6992;
constexpr int NWAVES = 8;
constexpr float EPS = 1e-6f;
constexpr int C_AQ = 0, C_AF = 512, C_AI = 1024, C_AG = 1536, C_BB = 2048, C_BC = 2560, C_BU = 3072, C_CQ = 3584, C_CK = 4096, C_CV = 4608,
              C_DQ = 5120, C_DK = 5632, C_DV = 5760, C_DQI = 5888, C_DKI = 6912, C_DW = 6976;

constexpr size_t MiB = 1u << 20;
constexpr size_t WS_CTL = 0, CTL_ZERO_BYTES = 1 * MiB;
constexpr size_t WS_HM = 1 * MiB;
constexpr size_t WS_W = 4 * MiB;
constexpr size_t W_GU1 = 0, W_D1 = W_GU1 + (size_t)NGU * DM * 2, W_NG = W_D1 + (size_t)DM * DFF * 2, W_G = W_NG + (size_t)NNG * DM * 2,
                 W_BR = W_G + (size_t)NGATE * DM * 2, W_O = W_BR + (size_t)4 * DM * 512 * 2, W_GU2 = W_O + (size_t)DM * DM * 2, W_D2 = W_GU2 + (size_t)NGU * DM * 2,
                 W_END = W_D2 + (size_t)DM * DFF * 2;
constexpr size_t WS_XN = WS_W + W_END;
constexpr size_t WS_BR = WS_XN + (size_t)MPAD * DM * 2;
constexpr size_t WS_BIG = WS_BR + (size_t)MPAD * DM * 2;
constexpr size_t BIG_P_END = (size_t)MPAD * NNG * 2;
constexpr size_t WS_VTC = WS_BIG + BIG_P_END;
constexpr size_t WS_VTD = WS_VTC + (size_t)NB * 4 * 128 * LPAD * 2;
constexpr size_t WS_MASK = WS_VTD + (size_t)NB * 128 * LPAD * 2;
constexpr int MASKW = 132;
constexpr int NIDX_WG = 172;
constexpr int NHG_WG = 32;
constexpr size_t WS_SCR = WS_MASK + (size_t)NB * LPAD * MASKW * 4;
constexpr size_t WS_HA = WS_SCR + (size_t)NIDX_WG * 32 * LPAD * 4;
constexpr size_t WS_HDL = WS_HA + (size_t)NB * 4 * 64 * 64 * 64 * 2;
constexpr size_t WS_HMETA = WS_HDL + (size_t)NB * 4 * 64 * 128 * 4;
constexpr size_t HMETA_STRIDE = 64 * 384 * 2 + 64 * 64 * 2 + 128 * 4;
constexpr size_t WS_END = WS_HMETA + 4 * HMETA_STRIDE;
static_assert(WS_BIG + (size_t)MPAD * NGATE * 2 <= WS_END, "G fits");
static_assert(WS_END <= (size_t)1138174976, "workspace map fits the guaranteed size");

constexpr int RING_OFF = 0, RING_BYTES = 131072;
constexpr int LDSCTL_OFF = 143360, MISC_OFF = LDSCTL_OFF + 320;
constexpr int LDS_BYTES = 147456;

#define GAS __attribute__((address_space(1)))
#define LAS __attribute__((address_space(3)))
typedef unsigned short bf16;
typedef unsigned v4u __attribute__((ext_vector_type(4)));
typedef unsigned v2u __attribute__((ext_vector_type(2)));
typedef float f32x4 __attribute__((ext_vector_type(4)));
typedef float f32x16 __attribute__((ext_vector_type(16)));
typedef short bf16x8 __attribute__((ext_vector_type(8)));
typedef GAS unsigned gu32;
#define RLX_AGENT __ATOMIC_RELAXED, __HIP_MEMORY_SCOPE_AGENT
#define LDS_WAIT() asm volatile("s_waitcnt lgkmcnt(0)" ::: "memory")
#define VM_WAIT() asm volatile("s_waitcnt vmcnt(0)" ::: "memory")
__device__ __forceinline__ unsigned f2bf(float f) { unsigned u = __builtin_bit_cast(unsigned, f); return (u + 0x7fffu + ((u >> 16) & 1u)) >> 16; }
__device__ __forceinline__ unsigned f2bf_s(float f) { return pg8::cvt_pk_bf16(f, 0.f) & 0xffffu; }
__device__ __forceinline__ unsigned pk2(float lo, float hi) { return pg8::cvt_pk_bf16(lo, hi); }
__device__ __forceinline__ float bflo(unsigned w) { return __uint_as_float(w << 16); }
__device__ __forceinline__ float bfhi(unsigned w) { return __uint_as_float(w & 0xffff0000u); }
__device__ __forceinline__ float bf2f(bf16 v) { return __uint_as_float((unsigned)v << 16); }
__device__ __forceinline__ int seqrow(int b, int p) { return p < NMETA ? MREAL + p : b * SEQ + p - NMETA; }
__device__ __forceinline__ int rel_bucket(int n) {
    if (n < 16) return n; if (n >= 128) return 31;
    const int v = 16 + (int)(__log2f((float)n * 0.0625f) * 5.33333333f); return v < 31 ? v : 31; }
__device__ __forceinline__ float wave_sum(float v) {
#pragma unroll
    for (int o = 1; o < 64; o <<= 1) v += __shfl_xor(v, o);
    return v;
}
#define XB_TMO      128
#define XB_XCNT(j)  (256  + 64 * (j))
#define XB_XSUB(j)  (1280 + 64 * (j))
#define XB_XGEN(j)  (2304 + 64 * (j))
#define XB_TOP      3328
#define XB_TOPGEN   3392
#define XCD_BAR_WORDS 3456
#define XB_SPIN_CAP (1u << 18)

__device__ __forceinline__ unsigned xb_ld(unsigned* p)              { return __hip_atomic_load(p, __ATOMIC_RELAXED, __HIP_MEMORY_SCOPE_AGENT); }
__device__ __forceinline__ unsigned xb_add(unsigned* p, unsigned v) { return __hip_atomic_fetch_add(p, v, __ATOMIC_RELAXED, __HIP_MEMORY_SCOPE_AGENT); }
__device__ __forceinline__ unsigned xb_xcc_id() { return (unsigned)__builtin_amdgcn_s_getreg((3 << 11) | 20) & 0xFu; }
#define XB_SPIN(cond, bar) do { unsigned _sp = 0; while (cond) { __builtin_amdgcn_s_sleep(1); \
    if ((++_sp & 255u) == 0u) { if (xb_ld(&(bar)[XB_TMO])) break; if (_sp > XB_SPIN_CAP) { atomicAdd(&(bar)[XB_TMO], 1u); break; } } } } while (0)

struct XcdBarrier {
    int wave;
    unsigned* bar; unsigned x;
    volatile LAS unsigned* st;
};

__device__ __forceinline__ bool xb_thread0(int wave) { unsigned mk = ~0u; asm volatile("" : "+s"(mk)); return wave == 0 && __builtin_amdgcn_mbcnt_hi(mk, __builtin_amdgcn_mbcnt_lo(mk, 0u)) == 0u; }
__device__ __forceinline__ XcdBarrier xcd_barrier_post(unsigned* bar, volatile LAS unsigned* st, int wave) {
    XcdBarrier b; b.wave = wave; b.bar = bar; b.x = xb_xcc_id(); b.st = st;
    if (xb_thread0(wave)) (void)xb_add(&bar[XB_XCNT(b.x)], 1u);
    return b;
}
__device__ __forceinline__ void xcd_barrier_complete(unsigned* bar, unsigned x, unsigned& nloc, unsigned& nx) {
    const unsigned G = gridDim.x * gridDim.y * gridDim.z;
    unsigned sum, cnt, mine, sp = 0u;
    for (;;) {
        sum = 0u; cnt = 0u; mine = 0u;
#pragma unroll
        for (unsigned j = 0; j < 16; ++j) { const unsigned c = xb_ld(&bar[XB_XCNT(j)]); sum += c; cnt += (c > 0u) ? 1u : 0u; mine = (j == x) ? c : mine; }
        if (sum == G) break;
        __builtin_amdgcn_s_sleep(1);
        if ((++sp & 255u) == 0u) { if (xb_ld(&bar[XB_TMO])) break; if (sp > XB_SPIN_CAP) { atomicAdd(&bar[XB_TMO], 1u); break; } }
    }
    nloc = mine > 0u ? mine : 1u; nx = cnt > 0u ? cnt : 1u;
}

__device__ __forceinline__ void xcd_barrier(const XcdBarrier& b) {
    asm volatile("s_waitcnt vmcnt(0)" ::: "memory");
    __syncthreads();
    if (xb_thread0(b.wave)) {
        unsigned* bar = b.bar;
        __builtin_amdgcn_s_waitcnt(0);
        unsigned nloc = b.st[0], nx = b.st[1];
        if (nloc == 0u) { xcd_barrier_complete(bar, b.x, nloc, nx); b.st[0] = nloc; b.st[1] = nx; }
        const unsigned old = xb_add(&bar[XB_XSUB(b.x)], 1u);
        const unsigned gen = old / nloc;
        if (old + 1u == (gen + 1u) * nloc) {
            __builtin_amdgcn_fence(__ATOMIC_RELEASE, "agent");
            asm volatile("s_waitcnt vmcnt(0)" ::: "memory");
            const unsigned og = xb_add(&bar[XB_TOP], 1u);
            const unsigned tg = og / nx;
            if (og + 1u == (tg + 1u) * nx) xb_add(&bar[XB_TOPGEN], 1u);
            else XB_SPIN(xb_ld(&bar[XB_TOPGEN]) == tg, bar);
            __builtin_amdgcn_fence(__ATOMIC_ACQUIRE, "agent");
            xb_add(&bar[XB_XGEN(b.x)], 1u);
            asm volatile("s_waitcnt vmcnt(0)" ::: "memory");
        } else {
            XB_SPIN(xb_ld(&bar[XB_XGEN(b.x)]) == gen, bar);
            __builtin_amdgcn_fence(__ATOMIC_ACQUIRE, "agent");
            asm volatile("s_waitcnt vmcnt(0)" ::: "memory");
        }
    }
    __syncthreads();
}

struct Frame {
    LAS unsigned char* lds;
    volatile LAS unsigned* MISC;
    gu32* ctl;
    int tid, lane, wave, G, bid;
    const unsigned char __attribute__((address_space(4)))* karg; float* out; unsigned char* ws;
};
__device__ __forceinline__ const float* fin_load(const unsigned char __attribute__((address_space(4)))* k, int i) { asm volatile("" : "+s"(k)); return *(const float* const __attribute__((address_space(4)))*)(k + 8 * i); }
#define FIN(F_, i_) fin_load((F_).karg, (i_))
enum { I_X = 0, I_META, I_RELB, I_F1N, I_F1GU, I_F1D, I_MIXN, I_WIN, I_LB, I_GN, I_CONVW, I_DQN, I_DKN, I_DLAM, I_DSUB, I_SQN, I_SKN, I_WBR, I_WOUT, I_F2N, I_F2GU, I_F2D };

template <class RowMap>
__device__ __forceinline__ void transpose_item(const float* W, int K, int N, bf16* WT, LAS float* scr, int item, int lane, RowMap rm) {
    const int nblk = (N + 31) / 32, kb = item / nblk, nb = item % nblk, k0 = 64 * kb, n0 = 32 * nb;
    const int nl = n0 + (lane & 31); const bool nok = nl < N;
    { float wv[32]; const float* wp = W + (size_t)(k0 + (lane >> 5)) * N + (nok ? nl : 0);
#pragma unroll
      for (int i = 0; i < 32; ++i) wv[i] = wp[(size_t)(2 * i) * N];
      __builtin_amdgcn_sched_barrier(0);
#pragma unroll
      for (int i = 0; i < 32; ++i) scr[(2 * i + (lane >> 5)) * 33 + (lane & 31)] = nok ? wv[i] : 0.f; }
    LDS_WAIT(); asm volatile("" ::: "memory");
    const int c = lane & 7;
#pragma unroll
    for (int j = 0; j < 4; ++j) { const int n = (lane >> 3) + 8 * j; const LAS float* s = scr + (8 * c) * 33 + n;
        v4u o; o.x = pk2(s[0 * 33], s[1 * 33]); o.y = pk2(s[2 * 33], s[3 * 33]); o.z = pk2(s[4 * 33], s[5 * 33]); o.w = pk2(s[6 * 33], s[7 * 33]);
        if (n0 + n < N) *(GAS v4u*)(WT + (size_t)rm(n0 + n) * K + k0 + 8 * c) = o; }
    LDS_WAIT(); asm volatile("" ::: "memory");
}
struct MapId { __device__ __forceinline__ int operator()(int n) const { return n; } };
struct MapGU { __device__ __forceinline__ int operator()(int n) const { const int up = n >= DFF, j = up ? n - DFF : n; return 256 * (j >> 7) + 128 * up + (j & 127); } };
struct MapIn { __device__ __forceinline__ int operator()(int n) const { return n < NGC ? n : n + (NNG - NGC); } };
template <class RowMap>
__device__ __forceinline__ void convert_matrix(Frame& F, const float* W, int K, int N, bf16* WT, RowMap rm) {
    LAS float* scr = (LAS float*)(F.lds + F.wave * 16384);
    const int gw = F.bid * NWAVES + F.wave, NGW = F.G * NWAVES, nitems = (K / 64) * ((N + 31) / 32);
    for (int it = gw; it < nitems; it += NGW) transpose_item(W, K, N, WT, scr, it, F.lane, rm);
}
__device__ __forceinline__ void phase_convert(Frame& F, int l) {
    unsigned char* wb = F.ws + WS_W;
    convert_matrix(F, FIN(F, I_F1GU) + (size_t)l * DM * NGU, DM, NGU, (bf16*)(wb + W_GU1), MapGU());
    convert_matrix(F, FIN(F, I_F1D) + (size_t)l * DFF * DM, DFF, DM, (bf16*)(wb + W_D1), MapId());
    convert_matrix(F, FIN(F, I_WIN) + (size_t)l * DM * INCOLS, DM, INCOLS, (bf16*)(wb + W_NG), MapIn());
    for (int m = 0; m < 4; ++m) convert_matrix(F, FIN(F, I_WBR) + ((size_t)l * 4 + m) * 512 * DM, 512, DM, (bf16*)(wb + W_BR) + (size_t)m * DM * 512, MapId());
    convert_matrix(F, FIN(F, I_WOUT) + (size_t)l * DM * DM, DM, DM, (bf16*)(wb + W_O), MapId());
    convert_matrix(F, FIN(F, I_F2GU) + (size_t)l * DM * NGU, DM, NGU, (bf16*)(wb + W_GU2), MapGU());
    convert_matrix(F, FIN(F, I_F2D) + (size_t)l * DFF * DM, DFF, DM, (bf16*)(wb + W_D2), MapId());
    { GAS v4u* z = (GAS v4u*)(wb + W_NG + (size_t)NGC * DM * 2); const int n16 = (NNG - NGC) * DM * 2 / 16;
      for (int i = F.bid * 512 + F.tid; i < n16; i += F.G * 512) z[i] = (v4u){0u, 0u, 0u, 0u}; }
    if (l == 0) {
        GAS f32x4* hm = (GAS f32x4*)(F.ws + WS_HM); const GAS f32x4* mt = (const GAS f32x4*)FIN(F, I_META);
        for (int i = F.bid * 512 + F.tid; i < 256 * DM / 4; i += F.G * 512) hm[i] = (i < NMETA * DM / 4) ? mt[i] : (f32x4){0.f, 0.f, 0.f, 0.f};
    }
}
__device__ __forceinline__ void phase_norm(Frame& F, const float* src_real, const float* gain) {
    const int gw = F.bid * NWAVES + F.wave, NGW = F.G * NWAVES;
    bf16* XN = (bf16*)(F.ws + WS_XN); const float* hm = (const float*)(F.ws + WS_HM);
    f32x4 g[8];
#pragma unroll
    for (int j = 0; j < 8; ++j) g[j] = ((const GAS f32x4*)gain)[F.lane + 64 * j];
    for (int r = gw; r < MPAD; r += NGW) {
        GAS v2u* o8 = (GAS v2u*)(XN + (size_t)r * DM) + F.lane;
        if (r >= MREAL + NMETA) {
#pragma unroll
            for (int j = 0; j < 8; ++j) o8[64 * j] = (v2u){0u, 0u};
            continue; }
        const float* xr = r < MREAL ? src_real + (size_t)r * DM : hm + (size_t)(r - MREAL) * DM;
        f32x4 v[8]; float s = 0.f;
#pragma unroll
        for (int j = 0; j < 8; ++j) { v[j] = ((const GAS f32x4*)xr)[F.lane + 64 * j]; s += (v[j].x * v[j].x + v[j].y * v[j].y) + (v[j].z * v[j].z + v[j].w * v[j].w); }
        const float inv = 1.0f / sqrtf(wave_sum(s) * (1.f / DM) + EPS);
#pragma unroll
        for (int j = 0; j < 8; ++j) { v2u w; w.x = pk2(v[j].x * inv * g[j].x, v[j].y * inv * g[j].y); w.y = pk2(v[j].z * inv * g[j].z, v[j].w * inv * g[j].w); o8[64 * j] = w; }
    }
}

__device__ __forceinline__ f32x4 meta_dot16(const bf16* A  , int lda, const bf16* Bt  , int K, int s0, int s1, int lane) {
    const int fr = lane & 15, g = lane >> 4; const bf16* ap = A + (size_t)fr * lda + 8 * g; const bf16* bp = Bt + (size_t)fr * K + 8 * g;
    f32x4 a0 = (f32x4){0.f, 0.f, 0.f, 0.f}, a1 = a0;
    for (int s = s0; s < s1; s += 2) {
        const bf16x8 x0 = *(const GAS bf16x8*)(ap + 32 * s), x1 = *(const GAS bf16x8*)(ap + 32 * s + 32);
        const bf16x8 w0 = *(const GAS bf16x8*)(bp + 32 * s), w1 = *(const GAS bf16x8*)(bp + 32 * s + 32);
        a0 = __builtin_amdgcn_mfma_f32_16x16x32_bf16(w0, x0, a0, 0, 0, 0); a1 = __builtin_amdgcn_mfma_f32_16x16x32_bf16(w1, x1, a1, 0, 0, 0); }
    return a0 + a1;
}
__device__ __forceinline__ void st_bf16x4(bf16* p, f32x4 v) { v2u w; w.x = pk2(v[0], v[1]); w.y = pk2(v[2], v[3]); *(GAS v2u*)p = w; }
__device__ __forceinline__ void meta_gemm(Frame& F, int kind, const bf16* A, int lda, const bf16* Bt, int N, int K, bf16* Obf, int ldo, float scale) {
    const int lane = F.lane, wave = F.wave, fr = lane & 15, g = lane >> 4;
    const int ngroups = (kind == 0 ? N / 2 : N) / 16;
    LAS f32x4* red = (LAS f32x4*)F.lds;
    const int ns = K / 32, s0 = (wave * ns) >> 3, s1 = ((wave + 1) * ns) >> 3;
    for (int cg = F.bid; cg < ngroups; cg += F.G) {
        const int n0 = 16 * cg;
        f32x4 p0, p1 = (f32x4){0.f, 0.f, 0.f, 0.f};
        if (kind == 0) { const int rg = 256 * (n0 >> 7) + (n0 & 127);
            p0 = meta_dot16(A, lda, Bt + (size_t)rg * K, K, s0, s1, lane); p1 = meta_dot16(A, lda, Bt + (size_t)(rg + 128) * K, K, s0, s1, lane); }
        else if (kind == 4) { const int mb = wave >> 1, kh = wave & 1; p0 = meta_dot16(A + (size_t)mb * MPAD * 512, 512, Bt + ((size_t)mb * DM + n0) * 512, 512, 8 * kh, 8 * kh + 8, lane); }
        else p0 = meta_dot16(A, lda, Bt + (size_t)n0 * K, K, s0, s1, lane);
        red[wave * 64 + lane] = p0; if (kind == 0) red[512 + wave * 64 + lane] = p1;
        LDS_WAIT(); __syncthreads();
        if (wave == 0) {
            f32x4 q[8];
#pragma unroll
            for (int w = 0; w < 8; ++w) q[w] = red[w * 64 + lane];
            if (kind == 4) { f32x4 tot = (f32x4){0.f, 0.f, 0.f, 0.f}; const bf16* G = (const bf16*)(F.ws + WS_BIG);
#pragma unroll
                for (int mb = 0; mb < 4; ++mb) { const f32x4 acc = q[2 * mb] + q[2 * mb + 1]; const v2u gw2 = *(const GAS v2u*)(G + (size_t)(MREAL + fr) * NGATE + mb * DM + n0 + 4 * g);
                    tot[0] += bflo(gw2.x) * acc[0]; tot[1] += bfhi(gw2.x) * acc[1]; tot[2] += bflo(gw2.y) * acc[2]; tot[3] += bfhi(gw2.y) * acc[3]; }
                st_bf16x4(Obf + (size_t)(MREAL + fr) * ldo + n0 + 4 * g, tot);
            } else {
                f32x4 acc = ((q[0] + q[1]) + (q[2] + q[3])) + ((q[4] + q[5]) + (q[6] + q[7]));
                if (kind == 0) { f32x4 up = (f32x4){0.f, 0.f, 0.f, 0.f};
#pragma unroll
                    for (int w = 0; w < 8; ++w) up += red[512 + w * 64 + lane];
#pragma unroll
                    for (int r = 0; r < 4; ++r) acc[r] = pg8::fast_silu(acc[r]) * up[r];
                    st_bf16x4(Obf + (size_t)(MREAL + fr) * ldo + n0 + 4 * g, acc); }
                else if (kind == 1) { float* hp = (float*)(F.ws + WS_HM) + (size_t)fr * DM + n0 + 4 * g; *(GAS f32x4*)hp = *(const GAS f32x4*)hp + acc * scale; }
                else if (kind == 2) st_bf16x4(Obf + (size_t)(MREAL + fr) * ldo + n0 + 4 * g, acc);
                else {
#pragma unroll
                    for (int r = 0; r < 4; ++r) acc[r] = pg8::fast_sigmoid(acc[r]);
                    st_bf16x4(Obf + (size_t)(MREAL + fr) * ldo + n0 + 4 * g, acc); }
            }
        }
        __syncthreads();
    }
}
__device__ __forceinline__ void unpack8(const v4u w, float (&x)[8]) { x[0] = bflo(w.x); x[1] = bfhi(w.x); x[2] = bflo(w.y); x[3] = bfhi(w.y); x[4] = bflo(w.z); x[5] = bfhi(w.z); x[6] = bflo(w.w); x[7] = bfhi(w.w); }
__device__ __forceinline__ v4u pack8(const float (&x)[8]) { v4u w; w.x = pk2(x[0], x[1]); w.y = pk2(x[2], x[3]); w.z = pk2(x[4], x[5]); w.w = pk2(x[6], x[7]); return w; }
template <int GL>
__device__ __forceinline__ void norm_cols_inplace(bf16* p, const v4u w, const float* gain, float scale, int lane, bool wr) {
    float x[8]; unpack8(w, x); float s = 0.f;
#pragma unroll
    for (int i = 0; i < 8; ++i) s += x[i] * x[i];
#pragma unroll
    for (int o = 1; o < GL; o <<= 1) s += __shfl_xor(s, o);
    const float inv = scale / sqrtf(s * (1.f / (GL * 8)) + EPS); const int g0 = (8 * lane) % (GL * 8);
#pragma unroll
    for (int i = 0; i < 8; ++i) x[i] = x[i] * inv * gain[g0 + i];
    if (wr) *(GAS v4u*)p = pack8(x);
}
__device__ __forceinline__ void prep_row(Frame& F, int l, int r) {
    const int lane = F.lane; bf16* pr = (bf16*)(F.ws + WS_BIG) + (size_t)r * NNG;
    const float *dqn = FIN(F, I_DQN) + l * 64, *dkn = FIN(F, I_DKN) + l * 64, *sqn = FIN(F, I_SQN) + l * 128, *skn = FIN(F, I_SKN) + l * 128;
    const v4u w0 = *(const GAS v4u*)(pr + C_CQ + 8 * lane), w1 = *(const GAS v4u*)(pr + C_CK + 8 * lane), w2 = *(const GAS v4u*)(pr + C_DQ + 8 * lane), w3 = *(const GAS v4u*)(pr + C_DK + 8 * (lane & 15));
    __builtin_amdgcn_sched_barrier(0);
    norm_cols_inplace<8>(pr + C_CQ + 8 * lane, w0, dqn, 0.125f * 1.4426950408889634f, lane, true);
    norm_cols_inplace<8>(pr + C_CK + 8 * lane, w1, dkn, 1.0f, lane, true);
    norm_cols_inplace<16>(pr + C_DQ + 8 * lane, w2, sqn, 0.08838834764831845f * 1.4426950408889634f, lane, true);
    norm_cols_inplace<16>(pr + C_DK + 8 * (lane & 15), w3, skn, 1.0f, lane & 15, lane < 16);
}
constexpr int VT_NPB = (LPAD + 63) / 64, VT_NTASK = NB * 5 * VT_NPB;
__device__ __forceinline__ void vt_task(Frame& F, int task) {
    const int lane = F.lane;
    const bf16* P = (const bf16*)(F.ws + WS_BIG); bf16* VtC = (bf16*)(F.ws + WS_VTC); bf16* VtD = (bf16*)(F.ws + WS_VTD);
    LAS bf16* T = (LAS bf16*)(F.lds + F.wave * 17408);
    const int pb = task % VT_NPB, mat = (task / VT_NPB) % 5, b = task / (VT_NPB * 5), p0 = 64 * pb;
    const int col = mat < 4 ? C_CV + 128 * mat : C_DV;
#pragma unroll 4
    for (int i = 0; i < 16; ++i) { const int pl = 4 * i + (lane >> 4), p = p0 + pl;
        v4u w = *(const GAS v4u*)(P + (size_t)seqrow(b, p < LSEQ ? p : LSEQ - 1) * NNG + col + 8 * (lane & 15)); if (p >= LSEQ) w = (v4u){0u, 0u, 0u, 0u};
        *(LAS v4u*)(T + pl * 136 + 8 * (lane & 15)) = w; }
    LDS_WAIT(); asm volatile("" ::: "memory");
    bf16* dst = mat < 4 ? VtC + (size_t)(b * 4 + mat) * 128 * LPAD : VtD + (size_t)b * 128 * LPAD;
#pragma unroll 4
    for (int it = 0; it < 16; ++it) { const int e = 8 * it + (lane >> 3), c = lane & 7; unsigned short x[8];
#pragma unroll
        for (int k = 0; k < 8; ++k) x[k] = T[(8 * c + k) * 136 + e];
        v4u w; w.x = x[0] | ((unsigned)x[1] << 16); w.y = x[2] | ((unsigned)x[3] << 16); w.z = x[4] | ((unsigned)x[5] << 16); w.w = x[6] | ((unsigned)x[7] << 16);
        if (p0 + 8 * c < LPAD) *(GAS v4u*)(dst + (size_t)e * LPAD + p0 + 8 * c) = w; }
    LDS_WAIT(); asm volatile("" ::: "memory");
}

#define NEG_INF (-__builtin_inff())
constexpr int NQT = (LSEQ + 31) / 32;
constexpr int NQB = (NQT + 7) / 8;
__device__ __forceinline__ bf16x8 ld_frag16(const bf16* p) { return *(const GAS bf16x8*)p; }
__device__ __forceinline__ bf16x8 mk_frag(v2u lo, v2u hi) { v4u w; w.x = lo.x; w.y = lo.y; w.z = hi.x; w.w = hi.y; return __builtin_bit_cast(bf16x8, w); }
__device__ __forceinline__ unsigned cvtpk(float lo, float hi) { return pg8::cvt_pk_bf16(lo, hi); }
__device__ __forceinline__ void build_bias_table(Frame& F, LAS float* bt, int col0) {
    const float* rb = FIN(F, I_RELB);
    for (int i = F.tid; i < 4 * 128; i += 512) { const int hd = i >> 7, n = i & 127; bt[i] = (rb[rel_bucket(n) * 8 + col0 + hd] - rb[31 * 8 + col0 + hd]) * 1.4426950408889634f; }
}
__device__ __forceinline__ bool softmax_step(f32x16& S, float& m, float& lsum, float& alpha) {
    float tm = S[0];
#pragma unroll
    for (int r = 1; r < 16; ++r) tm = fmaxf(tm, S[r]);
    const bool raise = __any(tm > m + 11.5f);
    alpha = 1.0f;
    if (raise) { tm = fmaxf(tm, __shfl_xor(tm, 32)); const float mn = fmaxf(m, tm); alpha = (mn == NEG_INF) ? 1.0f : __builtin_amdgcn_exp2f(m - mn); m = mn; lsum *= alpha; }
    const float mref = (m == NEG_INF) ? 0.f : m;
    float rs = 0.f;
#pragma unroll
    for (int r = 0; r < 16; ++r) { S[r] = __builtin_amdgcn_exp2f(S[r] - mref); rs += S[r]; }
    lsum += rs;
    return raise;
}
__device__ __forceinline__ void relane(Frame& F) {
    int w = F.wave; asm volatile("" : "+s"(w)); unsigned mk = ~0u; asm volatile("" : "+s"(mk));
    int t = w * 64 + (int)__builtin_amdgcn_mbcnt_hi(mk, __builtin_amdgcn_mbcnt_lo(mk, 0u)); asm volatile("" : "+v"(t)); F.tid = t; F.lane = t & 63; F.wave = w; }
#ifndef DIFF_SINGLE
#define DIFF_SINGLE 0
#endif
#ifndef TK_DSA
#define TK_DSA 64
#endif
#ifndef NVPRE_DIFF
#define NVPRE_DIFF 4
#endif
#ifndef NVPRE_DSA
#define NVPRE_DSA 8
#endif
template <bool DSA>
__device__ __forceinline__ void attn_wg_task(Frame& F, int l, int b, int h, int J, const LAS float* bt, float lam, float post) {
    constexpr int KD = DSA ? 128 : 64, KP = KD + 8, NKS = KD / 16;
    constexpr int TK = DSA ? TK_DSA : 64, NS = TK / 32, VP = TK + 4, NVL = 128 * (TK / 8) / 512, NKL = TK * (KD / 8) / 512;
    constexpr int KBUF = TK * KP, VBUF = 128 * VP;
    constexpr int RPARK = 57344;
    constexpr int NVPRE = DSA ? NVPRE_DSA : NVPRE_DIFF;
    relane(F);
    const int lane = F.lane, ql = lane & 31, hh = lane >> 5, wave = F.wave, tid = F.tid;
    LAS bf16* Kl = (LAS bf16*)F.lds; LAS bf16* Vl = Kl + 2 * KBUF;
    const bf16* P = (const bf16*)(F.ws + WS_BIG);
    const bf16* Vt = DSA ? (const bf16*)(F.ws + WS_VTD) + (size_t)b * 128 * LPAD : (const bf16*)(F.ws + WS_VTC) + (size_t)(b * 4 + h) * 128 * LPAD;
    const int jr = 8 * J + wave - 7; const bool wvalid = jr >= 0 && 32 * jr < LSEQ; const int j = jr < 0 ? 0 : jr;
    const int ktmax = (8 * J < NQT - 1) ? 8 * J : NQT - 1;
    const int pq = 32 * j + ql, pqc = pq < LSEQ ? pq : LSEQ - 1;
    const bf16* qrow = P + (size_t)seqrow(b, pqc) * NNG + (DSA ? C_DQ : C_CQ) + h * 128 + 8 * hh;
    const unsigned* mrow = (const unsigned*)(F.ws + WS_MASK) + ((size_t)b * LPAD + pqc) * MASKW;
    f32x16 R[4];
#pragma unroll
    for (int c = 0; c < (DSA ? 1 : 2); ++c) {
        const int kcol = DSA ? C_DK : C_CK + h * 128 + c * 64;
        relane(F);
        const int tid2 = F.tid, kr = tid2 / (KD / 8), kc = tid2 % (KD / 8), vr = tid2 / (TK / 8), vc = tid2 % (TK / 8);
        bf16x8 qf[NKS];
#pragma unroll
        for (int ks = 0; ks < NKS; ++ks) qf[ks] = ld_frag16(qrow + (DSA ? 0 : c * 64) + 16 * ks);
        float m = NEG_INF, lsum = 0.f; f32x16 O[4];
#pragma unroll
        for (int eb = 0; eb < 4; ++eb)
#pragma unroll
            for (int r = 0; r < 16; ++r) O[eb][r] = 0.f;
        v4u rk0[NKL], rk1[NKL], rv0[NVL], rv1[NVL];
#pragma unroll
        for (int i = 0; i < NKL; ++i) { rk0[i] = (v4u){0u, 0u, 0u, 0u}; rk1[i] = rk0[i]; }
#pragma unroll
        for (int i = 0; i < NVL; ++i) { rv0[i] = (v4u){0u, 0u, 0u, 0u}; rv1[i] = rv0[i]; }
#define ATT_ISSUE(st_, RK, RV) do { _Pragma("unroll") for (int i_ = 0; i_ < NKL; ++i_) { int pk_ = TK * (st_) + kr + i_ * (512 / (KD / 8)); pk_ = pk_ < LSEQ ? pk_ : LSEQ - 1; \
            RK[i_] = *(const GAS v4u*)(P + (size_t)seqrow(b, pk_) * NNG + kcol + 8 * kc); } \
            int vcol_ = TK * (st_) + 8 * vc; vcol_ = vcol_ < LPAD - 8 ? vcol_ : LPAD - 8; \
            _Pragma("unroll") for (int i_ = 0; i_ < NVL; ++i_) RV[i_] = *(const GAS v4u*)(Vt + (size_t)(vr + i_ * (512 / (TK / 8))) * LPAD + vcol_); } while (0)
#define ATT_COMMIT(buf_, RK, RV) do { _Pragma("unroll") for (int i_ = 0; i_ < NKL; ++i_) *(LAS v4u*)(Kl + (buf_) * KBUF + (kr + i_ * (512 / (KD / 8))) * KP + 8 * kc) = RK[i_]; \
            _Pragma("unroll") for (int i_ = 0; i_ < NVL; ++i_) { LAS v2u* vd_ = (LAS v2u*)(Vl + (buf_) * VBUF + (vr + i_ * (512 / (TK / 8))) * VP + 8 * vc); vd_[0] = (v2u){RV[i_].x, RV[i_].y}; vd_[1] = (v2u){RV[i_].z, RV[i_].w}; } } while (0)
        unsigned mwc[NS], mwn[NS];
#pragma unroll
        for (int s = 0; s < NS; ++s) { mwc[s] = 0xffffffffu; mwn[s] = 0xffffffffu; if (DSA) mwc[s] = mrow[s <= ktmax ? s : ktmax]; }
#define MW_LOAD(st_) do { if (DSA) { _Pragma("unroll") for (int s_ = 0; s_ < NS; ++s_) { const int kt_ = NS * (st_) + s_; mwn[s_] = mrow[kt_ <= ktmax ? kt_ : ktmax]; } } } while (0)
#define MW_ROT() do { if (DSA) { _Pragma("unroll") for (int s_ = 0; s_ < NS; ++s_) mwc[s_] = mwn[s_]; } } while (0)
        auto compute = [&](int kt, int buf, int sub) {
            if (wvalid && kt <= j) {
                const LAS bf16* Kt = Kl + buf * KBUF + (32 * sub + ql) * KP + 8 * hh; const LAS bf16* Vb = Vl + buf * VBUF + ql * VP + 32 * sub + 4 * hh;
                f32x16 S;
#pragma unroll
                for (int r = 0; r < 16; ++r) S[r] = 0.f;
#pragma unroll
                for (int ks = 0; ks < NKS; ++ks) S = __builtin_amdgcn_mfma_f32_32x32x16_bf16(*(const LAS bf16x8*)(Kt + 16 * ks), qf[ks], S, 0, 0, 0);
                const unsigned mw = (sub ? mwc[NS - 1] : mwc[0]) >> (4 * hh);
                if (kt + 4 >= j) {
                    const int n0 = pq - (32 * kt + 4 * hh); float bv[16];
#pragma unroll
                    for (int r = 0; r < 16; ++r) { const int ko = (r & 3) + 8 * (r >> 2); int n = n0 - ko; n = n < 0 ? 0 : (n < 127 ? n : 127); bv[r] = bt[h * 128 + n]; }
#pragma unroll
                    for (int r = 0; r < 16; ++r) { const int ko = (r & 3) + 8 * (r >> 2); const bool sel = ((mw >> ko) & 1u) && n0 >= ko; S[r] = sel ? S[r] + bv[r] : NEG_INF; }
                } else if (DSA) {
#pragma unroll
                    for (int r = 0; r < 16; ++r) { const int ko = (r & 3) + 8 * (r >> 2); S[r] = ((mw >> ko) & 1u) ? S[r] : NEG_INF; }
                }
                bf16x8 vf[NVPRE > 0 ? NVPRE : 1];
#pragma unroll
                for (int i = 0; i < NVPRE; ++i) { const LAS bf16* vp = Vb + (i >> 1) * 32 * VP + 16 * (i & 1); vf[i] = mk_frag(*(const LAS v2u*)vp, *(const LAS v2u*)(vp + 8)); }
                float alpha;
                if (softmax_step(S, m, lsum, alpha)) {
#pragma unroll
                    for (int eb = 0; eb < 4; ++eb)
#pragma unroll
                        for (int r = 0; r < 16; ++r) O[eb][r] *= alpha;
                }
                bf16x8 pf[2];
#pragma unroll
                for (int s = 0; s < 2; ++s) { v4u w; w.x = cvtpk(S[8 * s + 0], S[8 * s + 1]); w.y = cvtpk(S[8 * s + 2], S[8 * s + 3]); w.z = cvtpk(S[8 * s + 4], S[8 * s + 5]); w.w = cvtpk(S[8 * s + 6], S[8 * s + 7]); pf[s] = __builtin_bit_cast(bf16x8, w); }
#pragma unroll
                for (int eb = 0; eb < 4; ++eb)
#pragma unroll
                    for (int s = 0; s < 2; ++s) { const LAS bf16* vp = Vb + eb * 32 * VP + 16 * s;
                        O[eb] = __builtin_amdgcn_mfma_f32_32x32x16_bf16((2 * eb + s < NVPRE) ? vf[(2 * eb + s < NVPRE) ? 2 * eb + s : 0] : mk_frag(*(const LAS v2u*)vp, *(const LAS v2u*)(vp + 8)), pf[s], O[eb], 0, 0, 0); }
            } };
        __syncthreads();
        const int stmax = ktmax / NS;
        ATT_ISSUE(0, rk0, rv0); ATT_COMMIT(0, rk0, rv0);
        if (DSA ? (TK_DSA == 64) : (DIFF_SINGLE != 0)) {
            for (int st = 0; st <= stmax; ++st) {
                LDS_WAIT(); __syncthreads();
                MW_LOAD(st + 1);
                if (st + 1 <= stmax) ATT_ISSUE(st + 1, rk0, rv0);
#pragma unroll 1
                for (int sub = 0; sub < NS; ++sub) compute(NS * st + sub, st & 1, sub);
                if (st + 1 <= stmax) ATT_COMMIT((st + 1) & 1, rk0, rv0);
                MW_ROT();
            }
        } else {
        if (stmax >= 1) ATT_ISSUE(1, rk1, rv1);
        for (int st = 0; st <= stmax; st += 2) {
            LDS_WAIT(); __syncthreads();
            MW_LOAD(st + 1);
            if (st + 2 <= stmax) ATT_ISSUE(st + 2, rk0, rv0);
#pragma unroll 1
            for (int sub = 0; sub < NS; ++sub) compute(NS * st + sub, 0, sub);
            if (st + 1 <= stmax) ATT_COMMIT(1, rk1, rv1);
            MW_ROT();
            if (st + 1 > stmax) break;
            LDS_WAIT(); __syncthreads();
            MW_LOAD(st + 2);
            if (st + 3 <= stmax) ATT_ISSUE(st + 3, rk1, rv1);
#pragma unroll 1
            for (int sub = 0; sub < NS; ++sub) compute(NS * (st + 1) + sub, 1, sub);
            if (st + 2 <= stmax) ATT_COMMIT(0, rk0, rv0);
            MW_ROT();
        }
        }
#undef ATT_ISSUE
#undef MW_LOAD
#undef MW_ROT
#undef ATT_COMMIT
        lsum += __shfl_xor(lsum, 32); const float il = 1.0f / lsum;
        if (DSA) {
#pragma unroll
            for (int eb = 0; eb < 4; ++eb)
#pragma unroll
                for (int r = 0; r < 16; ++r) R[eb][r] = O[eb][r] * il;
        } else if (c == 0) {
            LAS unsigned* rp = (LAS unsigned*)(F.lds + RPARK) + wave * 2048 + lane;
#pragma unroll
            for (int eb = 0; eb < 4; ++eb)
#pragma unroll
                for (int r = 0; r < 16; r += 2) rp[(eb * 8 + (r >> 1)) * 64] = pk2(O[eb][r] * il, O[eb][r + 1] * il);
        } else {
            const LAS unsigned* rp = (const LAS unsigned*)(F.lds + RPARK) + wave * 2048 + lane;
#pragma unroll
            for (int eb = 0; eb < 4; ++eb)
#pragma unroll
                for (int r = 0; r < 16; r += 2) { const unsigned w = rp[(eb * 8 + (r >> 1)) * 64]; R[eb][r] = bflo(w) - lam * (O[eb][r] * il); R[eb][r + 1] = bfhi(w) - lam * (O[eb][r + 1] * il); }
        }
    }
    float inv = 1.0f;
    if (!DSA) { float ss = 0.f;
#pragma unroll
        for (int eb = 0; eb < 4; ++eb)
#pragma unroll
            for (int r = 0; r < 16; ++r) ss += R[eb][r] * R[eb][r];
        ss += __shfl_xor(ss, 32); inv = post / sqrtf(ss * (1.f / 128.f) + EPS); }
    const float* sub = FIN(F, I_DSUB) + l * 128;
    if (wvalid && pq < LSEQ && (pq >= NMETA || b == 0)) {
        bf16* orow = (bf16*)(F.ws + WS_BR) + (size_t)(DSA ? 3 : 2) * MPAD * 512 + (size_t)seqrow(b, pq) * 512 + h * 128;
#pragma unroll
        for (int eb = 0; eb < 4; ++eb)
#pragma unroll
            for (int g = 0; g < 4; ++g) { const int e0 = 32 * eb + 8 * g + 4 * hh; f32x4 sv = (f32x4){1.f, 1.f, 1.f, 1.f}; if (!DSA) sv = *(const GAS f32x4*)(sub + e0);
                v2u w; w.x = pk2(R[eb][4 * g] * inv * sv.x, R[eb][4 * g + 1] * inv * sv.y); w.y = pk2(R[eb][4 * g + 2] * inv * sv.z, R[eb][4 * g + 3] * inv * sv.w);
                *(GAS v2u*)(orow + e0) = w; }
    }
}
__device__ __forceinline__ unsigned f32_key(float f) { const unsigned u = __float_as_uint(f); return u ^ ((u >> 31) ? 0xffffffffu : 0x80000000u); }
__device__ __forceinline__ float relu_bits(float x) { const int i = __float_as_int(x); return __int_as_float(i > 0 ? i : 0); }
__device__ __forceinline__ void dsa_index_task(Frame& F, int b, int j, float* slab) {
    relane(F);
    const int lane = F.lane, ql = lane & 31, hh = lane >> 5, wave = F.wave;
    const bf16* P = (const bf16*)(F.ws + WS_BIG);
    LAS unsigned char* qi = F.lds;
    { v4u st[8];
#pragma unroll
      for (int k = 0; k < 8; ++k) { const int i = F.tid + 512 * k, q = i >> 7, ch = i & 127; int pq = 32 * j + q; pq = pq < LSEQ ? pq : LSEQ - 1;
          st[k] = *(const GAS v4u*)(P + (size_t)seqrow(b, pq) * NNG + C_DQI + 8 * ch); }
#pragma unroll
      for (int k = 0; k < 8; ++k) { const int i = F.tid + 512 * k, q = i >> 7, ch = i & 127; *(LAS v4u*)(qi + q * 2064 + 16 * ch) = st[k]; } }
    LAS float* wl = (LAS float*)(qi + 32 * 2064);
    if (F.tid < 32 * 16) { const int q = F.tid >> 4, hd = F.tid & 15; int pq = 32 * j + q; pq = pq < LSEQ ? pq : LSEQ - 1;
        wl[F.tid] = bf2f(P[(size_t)seqrow(b, pq) * NNG + C_DW + hd]) * 0.03125f; }
    LAS unsigned* hist = (LAS unsigned*)(F.lds + 73728);
    for (int i = F.tid; i < 32 * 256; i += 512) hist[i] = 0u;
    LDS_WAIT(); __syncthreads();
#ifndef PROBE_SUB
#define PROBE_SUB 0
#endif
    for (int rpa = 0; rpa < ((PROBE_SUB & 8) ? 2 : 1); ++rpa)
    {
    if (rpa) { LDS_WAIT(); __syncthreads(); for (int i = F.tid; i < 32 * 256; i += 512) hist[i] = 0u; LDS_WAIT(); __syncthreads(); }
    bf16x8 kn[4];
    { const int pk = 32 * wave + ql, pkc = pk < LSEQ ? pk : LSEQ - 1; const bf16* krow = P + (size_t)seqrow(b, pkc) * NNG + C_DKI + 8 * hh;
#pragma unroll
      for (int ks = 0; ks < 4; ++ks) kn[ks] = ld_frag16(krow + 16 * ks); }
    for (int kt = wave; kt <= j; kt += NWAVES) {
        bf16x8 kf[4];
#pragma unroll
        for (int ks = 0; ks < 4; ++ks) kf[ks] = kn[ks];
        { const int ktn = kt + NWAVES <= j ? kt + NWAVES : kt; const int pk = 32 * ktn + ql, pkc = pk < LSEQ ? pk : LSEQ - 1; const bf16* krow = P + (size_t)seqrow(b, pkc) * NNG + C_DKI + 8 * hh;
#pragma unroll
          for (int ks = 0; ks < 4; ++ks) kn[ks] = ld_frag16(krow + 16 * ks); }
        f32x16 idx;
#pragma unroll
        for (int r = 0; r < 16; ++r) idx[r] = 0.f;
#pragma unroll 1
        for (int hd = 0; hd < 16; hd += 2) { f32x16 S0, S1; const float wh0 = wl[ql * 16 + hd], wh1 = wl[ql * 16 + hd + 1];
#pragma unroll
            for (int r = 0; r < 16; ++r) { S0[r] = 0.f; S1[r] = 0.f; }
#pragma unroll
            for (int ks = 0; ks < 4; ++ks) { S0 = __builtin_amdgcn_mfma_f32_32x32x16_bf16(kf[ks], *(const LAS bf16x8*)(qi + ql * 2064 + hd * 128 + 32 * ks + 16 * hh), S0, 0, 0, 0);
                S1 = __builtin_amdgcn_mfma_f32_32x32x16_bf16(kf[ks], *(const LAS bf16x8*)(qi + ql * 2064 + (hd + 1) * 128 + 32 * ks + 16 * hh), S1, 0, 0, 0); }
#pragma unroll
            for (int r = 0; r < 16; ++r) { idx[r] = __builtin_fmaf(wh0, relu_bits(S0[r]), idx[r]); idx[r] = __builtin_fmaf(wh1, relu_bits(S1[r]), idx[r]); } }
        { const int lim = 32 * (j - kt) + ql - 4 * hh;
#pragma unroll
          for (int r = 0; r < 16; ++r) { const int ko = (r & 3) + 8 * (r >> 2);
              int bn = (int)__builtin_fmaf(idx[r], 32.f, 256.f); bn = bn < 0 ? 0 : (bn > 511 ? 511 : bn);
              const unsigned inc = (ko <= lim) ? ((bn & 1) ? 0x10000u : 1u) : 0u;
              (void)__hip_atomic_fetch_add(hist + ql * 256 + (((bn >> 1) + 2 * ql) & 255), inc, __ATOMIC_RELAXED, __HIP_MEMORY_SCOPE_WORKGROUP); } }
        float* srow = slab + (size_t)ql * LPAD + 32 * kt + 4 * hh;
#pragma unroll
        for (int g = 0; g < 4; ++g) *(GAS f32x4*)(srow + 8 * g) = (f32x4){idx[4 * g], idx[4 * g + 1], idx[4 * g + 2], idx[4 * g + 3]};
    }
    }
    VM_WAIT(); LDS_WAIT(); __syncthreads();
    for (int rpb = 0; rpb < ((PROBE_SUB & 16) ? 2 : 1); ++rpb)
    for (int qq = wave; qq < 32; qq += NWAVES) {
        const int p = 32 * j + qq; if (p >= LSEQ) break;
        const float* row = slab + (size_t)qq * LPAD;
        unsigned u[65];
        { const GAS unsigned* rp = (const GAS unsigned*)row + lane;
#pragma unroll
          for (int i = 0; i < 65; ++i) u[i] = rp[64 * i];
          __builtin_amdgcn_sched_barrier(0); }
        auto wsum = [&](unsigned c) { unsigned s = 0;
#pragma unroll
            for (int k = 0; k < 7; ++k) s += (unsigned)__builtin_popcountll(__ballot((c >> k) & 1u)) << k;
            return s; };
        unsigned T = 1u;
        if (p + 1 <= 256) {
#pragma unroll
            for (int i = 0; i < 65; ++i) { const unsigned k = f32_key(__uint_as_float(u[i])) >> 1; u[i] = (64 * i + lane <= p) ? k : 0u; }
        } else {
            const LAS unsigned* hrow = hist + qq * 256; unsigned c8[8];
#pragma unroll
            for (int i = 0; i < 4; ++i) { const unsigned w = hrow[(4 * lane + i + 2 * qq) & 255]; c8[2 * i] = w & 0xffffu; c8[2 * i + 1] = w >> 16; }
            unsigned tot = 0;
#pragma unroll
            for (int i = 0; i < 8; ++i) tot += c8[i];
            unsigned suf = 0;
            { const unsigned long long gtm = (lane == 63) ? 0ull : ~((2ull << lane) - 1ull);
#pragma unroll
              for (int k = 0; k < 13; ++k) suf += (unsigned)__builtin_popcountll(__ballot((tot >> k) & 1u) & gtm) << k; }
            unsigned run = suf, bl = 0, al = 0; bool found = false;
#pragma unroll
            for (int i = 7; i >= 0; --i) { const bool hit = !found && run < 256u && run + c8[i] >= 256u; if (hit) { bl = 8u * lane + i; al = run; } found = found || hit; run += c8[i]; }
            const unsigned long long fb = __ballot(found); const int src = (int)__builtin_ctzll(fb | (1ull << 63));
            const unsigned bstar = __builtin_amdgcn_readlane(bl, src), above = __builtin_amdgcn_readlane(al, src), need = 256u - above;
            unsigned f0 = 0u, f1 = 0u, f2 = 0u, cb = 0u;
#pragma unroll
            for (int i = 0; i < 65; ++i) { const float v = __uint_as_float(u[i]); int bn = (int)__builtin_fmaf(v, 32.f, 256.f); bn = bn < 0 ? 0 : (bn > 511 ? 511 : bn);
                const bool val = 64 * i + lane <= p, inband = val && (unsigned)bn == bstar;
                if (i < 32) f0 |= inband ? (1u << i) : 0u; else if (i < 64) f1 |= inband ? (1u << (i - 32)) : 0u; else f2 = inband ? 1u : 0u;
                cb += inband ? 1u : 0u;
                const unsigned k = f32_key(v) >> 1; u[i] = val ? k : 0u; }
            const unsigned inb = wsum(cb);
            if (fb != 0ull && inb <= 128u && inb >= need) {
                LAS unsigned* band = (LAS unsigned*)(F.lds + 68096) + wave * 128;
                unsigned off = 0;
#pragma unroll
                for (int k = 0; k < 7; ++k) { const unsigned long long bal = __ballot((cb >> k) & 1u); off += __builtin_amdgcn_mbcnt_hi((unsigned)(bal >> 32), __builtin_amdgcn_mbcnt_lo((unsigned)bal, 0u)) << k; }
#pragma unroll
                for (int i = 0; i < 65; ++i) { const bool inband = i < 32 ? ((f0 >> i) & 1u) : (i < 64 ? ((f1 >> (i - 32)) & 1u) : (f2 & 1u)); if (inband) { band[off] = u[i]; ++off; } }
                LDS_WAIT();
                const unsigned m0 = lane < (int)inb ? band[lane] : 0u, m1 = lane + 64 < (int)inb ? band[lane + 64] : 0u; unsigned ge0 = 0, gt0 = 0, ge1 = 0, gt1 = 0;
                for (unsigned k = 0; k < inb; ++k) { const unsigned v = band[k]; ge0 += (m0 - 1u - v) >> 31; gt0 += (m0 - v) >> 31; ge1 += (m1 - 1u - v) >> 31; gt1 += (m1 - v) >> 31; }
                const unsigned long long ok0 = __ballot(lane < (int)inb && ge0 >= need && gt0 < need), ok1 = __ballot(lane + 64 < (int)inb && ge1 >= need && gt1 < need);
                if (ok0) T = __builtin_amdgcn_readlane(m0, (int)__builtin_ctzll(ok0)); else T = __builtin_amdgcn_readlane(m1, (int)__builtin_ctzll(ok1 | (1ull << 63)));
                LDS_WAIT();
            } else {
                T = 0u;
                for (int bit = 30; bit >= 0; --bit) { const unsigned cm1 = (T | (1u << bit)) - 1u; unsigned c = 0;
#pragma unroll
                    for (int i = 0; i < 65; ++i) c += (cm1 - u[i]) >> 31;
                    if (wsum(c) >= 256u) T |= 1u << bit; } } }
        unsigned long long* mrow = (unsigned long long*)((unsigned*)(F.ws + WS_MASK) + ((size_t)b * LPAD + p) * MASKW);
        unsigned wlo = 0u, whi = 0u;
#pragma unroll
        for (int i = 0; i < 64; ++i) { const unsigned long long bal = __ballot(u[i] >= T); if (lane == i) { wlo = (unsigned)bal; whi = (unsigned)(bal >> 32); } }
        const unsigned long long b64 = __ballot(u[64] >= T);
        mrow[lane] = ((unsigned long long)whi << 32) | wlo; if (lane == 0) mrow[64] = b64;
    }
    __syncthreads();
}
struct HgChunk { bf16* base; int pitch; int cq, ck, cv; bf16* A; float* dl; };
__device__ __forceinline__ HgChunk hg_chunk(Frame& F, int b, int h, int c) {
    HgChunk k;
    if (c == 0) { unsigned char* mp = F.ws + WS_HMETA + (size_t)h * HMETA_STRIDE; k.base = (bf16*)mp; k.pitch = 384; k.cq = 0; k.ck = 128; k.cv = 256; k.A = (bf16*)(mp + 64 * 384 * 2); k.dl = (float*)(mp + 64 * 384 * 2 + 64 * 64 * 2); }
    else { const size_t ci = (size_t)(b * 4 + h) * 64 + (c - 1); k.base = (bf16*)(F.ws + WS_BIG) + (size_t)(b * SEQ + 64 * (c - 1)) * NNG; k.pitch = NNG; k.cq = C_AQ + h * 128; k.ck = C_AF + h * 128; k.cv = C_AI + h * 128;
        k.A = (bf16*)(F.ws + WS_HA) + ci * 64 * 64; k.dl = (float*)(F.ws + WS_HDL) + ci * 128; }
    return k;
}
__device__ __forceinline__ void hgrn_prep_task(Frame& F, int l, int b, int h, int c) {
    const int d = F.tid & 127, tq = F.tid >> 7, lane = F.lane, wave = F.wave;
    const bf16* P = (const bf16*)(F.ws + WS_BIG);
    LAS bf16* Qt = (LAS bf16*)F.lds; LAS bf16* Kt = Qt + 64 * 136; LAS float* part = (LAS float*)(F.lds + 2 * 64 * 136 * 2);
    const HgChunk ch = hg_chunk(F, b, h, c);
    float lb = 0.f; if (l == 1) { const float a = FIN(F, I_LB)[h * 128 + d], cc = FIN(F, I_LB)[512 + h * 128 + d]; lb = 1.0f / (1.0f + __expf(a - cc)); }
    const bool meta = (c == 0);
    unsigned short zr[16], qr[16], vr[16];
    { const int r0 = meta ? MREAL : b * SEQ + 64 * (c - 1);
#pragma unroll
      for (int i = 0; i < 16; ++i) { int t = 16 * tq + i; if (meta) t = t < NMETA ? t : NMETA - 1; const bf16* pr = P + (size_t)(r0 + t) * NNG + h * 128 + d; zr[i] = pr[C_AF]; qr[i] = pr[C_AQ]; vr[i] = pr[C_AI]; }
      __builtin_amdgcn_sched_barrier(0); }
    float lfv[16];
    float run = 0.f;
#pragma unroll
    for (int i = 0; i < 16; ++i) { const bool valid = !meta || (16 * tq + i < NMETA); const float z = bf2f(zr[i]); const float sg = 1.0f / (1.0f + __expf(-z));
        lfv[i] = valid ? __logf(lb + (1.0f - lb) * sg) : 0.f; run += lfv[i]; }
    part[tq * 128 + d] = run;
    LDS_WAIT(); __syncthreads();
    const float p0 = part[d], p1 = part[128 + d], p2 = part[256 + d], p3 = part[384 + d];
    const float off = (tq > 0 ? p0 : 0.f) + (tq > 1 ? p1 : 0.f) + (tq > 2 ? p2 : 0.f), bmid = p0 + p1, blast = (p0 + p1) + (p2 + p3);
    unsigned kb[8], vb[8]; unsigned short qb[16];
    float bt = off;
#pragma unroll
    for (int i = 0; i < 16; i += 2) { float kbar[2], vv[2];
#pragma unroll
        for (int u = 0; u < 2; ++u) { const int t = 16 * tq + i + u; const bool valid = !meta || (t < NMETA);
            const float lf = lfv[i + u]; const float q = bf2f(qr[i + u]);
            const float kk = valid ? 1.0f - __expf(lf) : 0.f, qq = valid ? q / (1.0f + __expf(-q)) : 0.f; vv[u] = valid ? bf2f(vr[i + u]) : 0.f;
            bt += lf;
            kbar[u] = kk * __expf(blast - bt); qb[i + u] = (unsigned short)f2bf_s(qq * __expf(bt));
            const float qt = qq * __expf(fminf(bt - bmid, 80.f)), kt = kk * __expf(fminf(bmid - bt, 80.f));
            Qt[t * 136 + d] = (bf16)f2bf_s(qt); Kt[t * 136 + d] = (bf16)f2bf_s(kt); }
        kb[i >> 1] = pk2(kbar[0], kbar[1]); vb[i >> 1] = pk2(vv[0], vv[1]); }
    asm volatile("s_waitcnt vmcnt(0)" ::: "memory"); __syncthreads();
#pragma unroll
    for (int i = 0; i < 16; ++i) ch.base[(size_t)(16 * tq + i) * ch.pitch + ch.cq + d] = qb[i];
    { bf16* kd = ch.base + (size_t)(d >> 1) * ch.pitch + ch.ck + (d & 1) * 64 + 16 * tq; bf16* vd = ch.base + (size_t)(d >> 1) * ch.pitch + ch.cv + (d & 1) * 64 + 16 * tq;
      *(GAS v4u*)kd = (v4u){kb[0], kb[1], kb[2], kb[3]}; *(GAS v4u*)(kd + 8) = (v4u){kb[4], kb[5], kb[6], kb[7]};
      *(GAS v4u*)vd = (v4u){vb[0], vb[1], vb[2], vb[3]}; *(GAS v4u*)(vd + 8) = (v4u){vb[4], vb[5], vb[6], vb[7]}; }
    if (tq == 0) ch.dl[d] = __expf(blast);
    LDS_WAIT(); __syncthreads();
    { const int mt = wave >> 1, fr = lane & 15, g = lane >> 4;
#pragma unroll
      for (int u = 0; u < 2; ++u) { const int nt = 2 * (wave & 1) + u; f32x4 acc = (f32x4){0.f, 0.f, 0.f, 0.f};
        if (nt <= mt) {
#pragma unroll
            for (int ks = 0; ks < 4; ++ks) acc = __builtin_amdgcn_mfma_f32_16x16x32_bf16(*(const LAS bf16x8*)(Qt + (16 * mt + fr) * 136 + 32 * ks + 8 * g), *(const LAS bf16x8*)(Kt + (16 * nt + fr) * 136 + 32 * ks + 8 * g), acc, 0, 0, 0);
        }
#pragma unroll
        for (int r = 0; r < 4; ++r) { const int t = 16 * mt + 4 * g + r, s = 16 * nt + fr; ch.A[t * 64 + s] = (bf16)f2bf_s(s <= t ? acc[r] : 0.f); } } }
    __syncthreads();
}
__device__ __forceinline__ float fast_sigmoid_m(float x) { return __builtin_amdgcn_rcpf(1.0f + __expf(-x)); }
__device__ __forceinline__ void hgrn_scan_unit(Frame& F, int l, int b, int h) {
    const int lane = F.lane, wave = F.wave, fr = lane & 15, g = lane >> 4, tid = F.tid;
    constexpr int QP = 136, AP = 72, KP = 72, GP = 136;
    constexpr int BUF = (64 * QP + 64 * AP + 128 * KP + 64 * GP) * 2 + 512;
    LAS float* red = (LAS float*)(F.lds + 2 * BUF);
    const int dv = 16 * wave + fr;
    const float gn = FIN(F, I_GN)[l * 512 + h * 128 + dv];
    const bf16* Pg = (const bf16*)(F.ws + WS_BIG) + C_AG + h * 128;
    f32x4 S[8];
#pragma unroll
    for (int mt = 0; mt < 8; ++mt) S[mt] = (f32x4){0.f, 0.f, 0.f, 0.f};
    v4u rq[2], ra, rk[2], rg[2], rd; bf16x8 bv0, bv1, bn0, bn1;
#define HG_ISSUE(c_, B0, B1) do { const HgChunk ch_ = hg_chunk(F, b, h, (c_)); const int nv_ = ((c_) == 0) ? NMETA : 64; \
        _Pragma("unroll") for (int i = 0; i < 2; ++i) { const int idx = tid + 512 * i, row = idx >> 4, c16 = idx & 15; \
            rq[i] = *(const GAS v4u*)(ch_.base + (size_t)row * ch_.pitch + ch_.cq + 8 * c16); rk[i] = *(const GAS v4u*)(ch_.base + (size_t)row * ch_.pitch + ch_.ck + 8 * c16); \
            rg[i] = (v4u){0u, 0u, 0u, 0u}; if (row < nv_) rg[i] = *(const GAS v4u*)(Pg + (size_t)(((c_) == 0) ? MREAL + row : b * SEQ + 64 * ((c_) - 1) + row) * NNG + 8 * c16); } \
        ra = *(const GAS v4u*)(ch_.A + 8 * tid); if (tid < 32) rd = *(const GAS v4u*)(ch_.dl + 4 * tid); \
        const bf16* vrow_ = ch_.base + (size_t)(dv >> 1) * ch_.pitch + ch_.cv + (dv & 1) * 64 + 8 * g; B0 = ld_frag16(vrow_); B1 = ld_frag16(vrow_ + 32); } while (0)
#define HG_COMMIT(buf_) do { LAS bf16* Q_ = (LAS bf16*)(F.lds + (buf_) * BUF); LAS bf16* A_ = Q_ + 64 * QP; LAS bf16* KT_ = A_ + 64 * AP; LAS bf16* G_ = KT_ + 128 * KP; \
        _Pragma("unroll") for (int i = 0; i < 2; ++i) { const int idx = tid + 512 * i, row = idx >> 4, c16 = idx & 15; *(LAS v4u*)(Q_ + row * QP + 8 * c16) = rq[i]; \
            *(LAS v4u*)(KT_ + (2 * row + (c16 >> 3)) * KP + 8 * (c16 & 7)) = rk[i]; *(LAS v4u*)(G_ + row * GP + 8 * c16) = rg[i]; } \
        *(LAS v4u*)(A_ + (tid >> 3) * AP + 8 * (tid & 7)) = ra; if (tid < 32) *(LAS v4u*)((LAS unsigned char*)(G_ + 64 * GP) + 16 * tid) = rd; } while (0)
    HG_ISSUE(0, bv0, bv1); HG_COMMIT(0);
    for (int c = 0; c <= 64; ++c) {
        const int buf = c & 1;
        LDS_WAIT(); __syncthreads();
        if (c < 64) HG_ISSUE(c + 1, bn0, bn1);
        LAS bf16* Q = (LAS bf16*)(F.lds + buf * BUF); LAS bf16* A = Q + 64 * QP; LAS bf16* KT = A + 64 * AP; LAS bf16* G = KT + 128 * KP; const LAS float* DL = (const LAS float*)(G + 64 * GP);
        f32x4 o[4];
#pragma unroll
        for (int mt = 0; mt < 4; ++mt) o[mt] = (f32x4){0.f, 0.f, 0.f, 0.f};
#pragma unroll
        for (int ks = 0; ks < 4; ++ks) { v4u w; w.x = cvtpk(S[2 * ks][0], S[2 * ks][1]); w.y = cvtpk(S[2 * ks][2], S[2 * ks][3]); w.z = cvtpk(S[2 * ks + 1][0], S[2 * ks + 1][1]); w.w = cvtpk(S[2 * ks + 1][2], S[2 * ks + 1][3]);
            const bf16x8 sb = __builtin_bit_cast(bf16x8, w);
#pragma unroll
            for (int mt = 0; mt < 4; ++mt) { const LAS bf16* qp = Q + (16 * mt + fr) * QP + 32 * ks + 4 * g;
                const bf16x8 af = mk_frag(*(const LAS v2u*)qp, *(const LAS v2u*)(qp + 16));
                o[mt] = __builtin_amdgcn_mfma_f32_16x16x32_bf16(af, sb, o[mt], 0, 0, 0); } }
#pragma unroll
        for (int mt = 0; mt < 4; ++mt) { o[mt] = __builtin_amdgcn_mfma_f32_16x16x32_bf16(*(const LAS bf16x8*)(A + (16 * mt + fr) * AP + 8 * g), bv0, o[mt], 0, 0, 0);
            o[mt] = __builtin_amdgcn_mfma_f32_16x16x32_bf16(*(const LAS bf16x8*)(A + (16 * mt + fr) * AP + 32 + 8 * g), bv1, o[mt], 0, 0, 0); }
#pragma unroll
        for (int mt = 0; mt < 8; ++mt) { const f32x4 dl = *(const LAS f32x4*)(DL + 16 * mt + 4 * g); S[mt] = S[mt] * dl;
            S[mt] = __builtin_amdgcn_mfma_f32_16x16x32_bf16(*(const LAS bf16x8*)(KT + (16 * mt + fr) * KP + 8 * g), bv0, S[mt], 0, 0, 0);
            S[mt] = __builtin_amdgcn_mfma_f32_16x16x32_bf16(*(const LAS bf16x8*)(KT + (16 * mt + fr) * KP + 32 + 8 * g), bv1, S[mt], 0, 0, 0); }
        { float s2[16];
#pragma unroll
          for (int i = 0; i < 16; ++i) s2[i] = o[i >> 2][i & 3] * o[i >> 2][i & 3];
#define HG_ROR(n_) _Pragma("unroll") for (int i = 0; i < 16; ++i) s2[i] += __builtin_bit_cast(float, __builtin_amdgcn_update_dpp(0, __builtin_bit_cast(int, s2[i]), 0x120 + (n_), 0xf, 0xf, false));
          HG_ROR(8) HG_ROR(4) HG_ROR(2) HG_ROR(1)
#undef HG_ROR
          if (fr == 0) {
#pragma unroll
              for (int mt = 0; mt < 4; ++mt) *(LAS f32x4*)(red + wave * 64 + 16 * mt + 4 * g) = (f32x4){s2[4 * mt], s2[4 * mt + 1], s2[4 * mt + 2], s2[4 * mt + 3]}; } }
        LDS_WAIT(); __syncthreads();
        const int nvalid = (c == 0) ? NMETA : 64;
        { f32x4 tot[4]; float gr[16];
#pragma unroll
          for (int mt = 0; mt < 4; ++mt) { tot[mt] = *(const LAS f32x4*)(red + 16 * mt + 4 * g);
#pragma unroll
              for (int w = 1; w < 8; ++w) tot[mt] += *(const LAS f32x4*)(red + w * 64 + 16 * mt + 4 * g); }
#pragma unroll
          for (int i = 0; i < 16; ++i) gr[i] = bf2f(G[(16 * (i >> 2) + 4 * g + (i & 3)) * GP + dv]);
          if (c > 0 || b == 0) {
#pragma unroll
              for (int i = 0; i < 16; ++i) { const int t = 16 * (i >> 2) + 4 * g + (i & 3); const int row = (c == 0) ? MREAL + t : b * SEQ + 64 * (c - 1) + t;
                  const float val = o[i >> 2][i & 3] * __builtin_amdgcn_rsqf(tot[i >> 2][i & 3] * (1.f / 128.f) + EPS) * gn * (gr[i] * fast_sigmoid_m(gr[i]));
                  if (t < nvalid) ((bf16*)(F.ws + WS_BR))[(size_t)row * 512 + h * 128 + dv] = (bf16)f2bf_s(val); } } }
        if (c < 64) { HG_COMMIT(buf ^ 1); bv0 = bn0; bv1 = bn1; }
    }
#undef HG_ISSUE
#undef HG_COMMIT
    __syncthreads();
}
__device__ __forceinline__ void conv_row(Frame& F, int l, int r) {
    const int lane = F.lane; const bf16* P = (const bf16*)(F.ws + WS_BIG);
    int r1, r2;
    if (r < MREAL) { const int b = r >> 12, t = r & 4095; r1 = seqrow(b, NMETA + t - 1); r2 = seqrow(b, NMETA + t - 2); }
    else { const int i = r - MREAL; r1 = i >= 1 ? r - 1 : -1; r2 = i >= 2 ? r - 2 : -1; }
    const float* cw = FIN(F, I_CONVW) + l * 3 * 512 + 8 * lane;
    const int r1c = r1 >= 0 ? r1 : r, r2c = r2 >= 0 ? r2 : r;
    const v4u wc0 = *(const GAS v4u*)(P + (size_t)r * NNG + C_BC + 8 * lane), wu0 = *(const GAS v4u*)(P + (size_t)r * NNG + C_BU + 8 * lane), wb = *(const GAS v4u*)(P + (size_t)r * NNG + C_BB + 8 * lane);
    const v4u wc1 = *(const GAS v4u*)(P + (size_t)r1c * NNG + C_BC + 8 * lane), wu1 = *(const GAS v4u*)(P + (size_t)r1c * NNG + C_BU + 8 * lane);
    const v4u wc2 = *(const GAS v4u*)(P + (size_t)r2c * NNG + C_BC + 8 * lane), wu2 = *(const GAS v4u*)(P + (size_t)r2c * NNG + C_BU + 8 * lane);
    __builtin_amdgcn_sched_barrier(0);
    float c0[8], u0[8], bb[8], y[8]; unpack8(wc0, c0); unpack8(wu0, u0); unpack8(wb, bb);
#pragma unroll
    for (int i = 0; i < 8; ++i) y[i] = cw[i] * (c0[i] * u0[i]);
    const float m1 = r1 >= 0 ? 1.f : 0.f, m2 = r2 >= 0 ? 1.f : 0.f;
    unpack8(wc1, c0); unpack8(wu1, u0);
#pragma unroll
    for (int i = 0; i < 8; ++i) y[i] += m1 * cw[512 + i] * (c0[i] * u0[i]);
    unpack8(wc2, c0); unpack8(wu2, u0);
#pragma unroll
    for (int i = 0; i < 8; ++i) y[i] += m2 * cw[1024 + i] * (c0[i] * u0[i]);
#pragma unroll
    for (int i = 0; i < 8; ++i) y[i] *= bb[i];
    *(GAS v4u*)((bf16*)(F.ws + WS_BR) + (size_t)MPAD * 512 + (size_t)r * 512 + 8 * lane) = pack8(y);
}
constexpr int CW_TMO = 0, CW_BAR = 4096, CW_Q = 16384;
__device__ __forceinline__ int queue_pop(Frame& F, int qi) {
    int t = 0; if (F.lane == 0) t = (int)__hip_atomic_fetch_add((unsigned*)(F.ctl + CW_Q + 64 * qi), 1u, RLX_AGENT);
    return __builtin_amdgcn_readfirstlane(t);
}
__device__ __forceinline__ int queue_pop_wg(Frame& F, int qi) {
    LAS int* slot = (LAS int*)(F.lds + 139264);
    __syncthreads();
    if (F.tid == 0) *slot = (int)__hip_atomic_fetch_add((unsigned*)(F.ctl + CW_Q + 64 * qi), 1u, RLX_AGENT);
    LDS_WAIT(); __syncthreads();
    return __builtin_amdgcn_readfirstlane(*slot);
}
__device__ __forceinline__ void phase_hgrn_prep(Frame& F, int l) {
    for (int t = F.bid; t < NB * 4 * 64 + 4; t += F.G) { if (t < 4) hgrn_prep_task(F, l, 0, t, 0); else { const int u = t - 4; hgrn_prep_task(F, l, u >> 8, (u >> 6) & 3, 1 + (u & 63)); } }
}
__device__ __forceinline__ void phase_prep(Frame& F, int l) { const int gw = F.bid * NWAVES + F.wave, NGW = F.G * NWAVES; for (int r = gw; r < MREAL + NMETA; r += NGW) prep_row(F, l, r); }
__device__ __forceinline__ void phase_vt(Frame& F) { const int gw = F.bid * NWAVES + F.wave, NGW = F.G * NWAVES; for (int t = gw; t < VT_NTASK; t += NGW) vt_task(F, t); }
__device__ __forceinline__ void phase_mix1(Frame& F, int l, int qidx) {
    LAS float* bt = (LAS float*)(F.lds + 135168);
    build_bias_table(F, bt, 0);
    __syncthreads();
#ifndef MIX1_SKIP
#define MIX1_SKIP 0
#endif
    const int sk = (qidx >= 4) ? MIX1_SKIP : 0;
    if (F.bid < NIDX_WG) {
        float* slab = (float*)(F.ws + WS_SCR) + (size_t)F.bid * 32 * LPAD;
        if (!(sk & 1)) for (int t = F.bid; t < NB * NQT; t += NIDX_WG) { const int j = NQT - 1 - t / NB, b = t % NB; dsa_index_task(F, b, j, slab); }
    } else if (F.bid < NIDX_WG + NHG_WG) {
        const int u = F.bid - NIDX_WG; if (!(sk & 2)) hgrn_scan_unit(F, l, u >> 2, u & 3);
    } else {
        const int u0 = F.bid - NIDX_WG - NHG_WG, nw = F.G - NIDX_WG - NHG_WG;
        const int cw = u0 * NWAVES + F.wave, ncw = nw * NWAVES; if (!(sk & 4)) for (int r = cw; r < MREAL + NMETA; r += ncw) conv_row(F, l, r);
    }
    float lam, post;
    { const float* lp = FIN(F, I_DLAM) + l * 256; const float s1 = wave_sum(lp[F.lane] * lp[64 + F.lane]), s2 = wave_sum(lp[128 + F.lane] * lp[192 + F.lane]);
      const float li = 0.8f - 0.6f * __expf(-0.3f * (float)l); lam = __expf(s1) - __expf(s2) + li; post = 1.0f - li; }
    for (;;) { const int t = queue_pop_wg(F, qidx) + ((sk & 8) ? (1 << 20) : 0); if (t >= NB * 4 * NQB) break;
        const int J = NQB - 1 - t / 32, bh = t % 32; attn_wg_task<false>(F, l, bh >> 2, bh & 3, J, bt, lam, post); }
}
__device__ __forceinline__ void phase_mix2(Frame& F, int l, int qidx) {
    LAS float* bt = (LAS float*)(F.lds + 135168);
    build_bias_table(F, bt, 4);
    __syncthreads();
    for (;;) { const int t = queue_pop_wg(F, qidx); if (t >= NB * 4 * NQB) break;
        const int J = NQB - 1 - t / 32, bh = t % 32; attn_wg_task<true>(F, l, bh >> 2, bh & 3, J, bt, 0.f, 1.f); }
}

#ifndef MK_ONE
#define MK_ONE 0
#endif
#ifndef BR_MASK
#define BR_MASK 15
#endif
constexpr int NPH = 18;
template <class T> __device__ __forceinline__ T opaque(T v) { asm volatile("" : "+s"(v)); return v; }
struct Args { const float* in[22]; float* out; unsigned char* ws; int ph_lo, ph_hi; };
__global__ void __launch_bounds__(NWAVES * 64, 2) fwd(Args args) {
    extern __shared__ __attribute__((aligned(16))) unsigned char lds[];
    Frame F;
    F.lds = (LAS unsigned char*)lds; F.MISC = (volatile LAS unsigned*)(F.lds + MISC_OFF);
    F.tid = threadIdx.x; F.lane = F.tid & 63; F.wave = __builtin_amdgcn_readfirstlane(F.tid >> 6); F.G = gridDim.x; F.bid = blockIdx.x;
    F.ws = args.ws; F.out = args.out; F.ctl = (gu32*)(args.ws + WS_CTL);
    F.karg = (const unsigned char __attribute__((address_space(4)))*)__builtin_amdgcn_kernarg_segment_ptr();
    for (int u = F.tid; u < (LDS_BYTES - LDSCTL_OFF) / 4; u += NWAVES * 64) ((LAS unsigned*)(F.lds + LDSCTL_OFF))[u] = 0u;
    __syncthreads();
#if MK_ONE
    XcdBarrier bar = xcd_barrier_post((unsigned*)(F.ctl + CW_BAR), F.MISC + 8, __builtin_amdgcn_readfirstlane(threadIdx.x >> 6));
#ifdef PROBE_BAR2
#define GRID_BAR() do { xcd_barrier(bar); xcd_barrier(bar); } while (0)
#else
#define GRID_BAR() xcd_barrier(bar)
#endif
#else
#define GRID_BAR() do { } while (0)
#endif
    const int wave_s = __builtin_amdgcn_readfirstlane(threadIdx.x >> 6);
    const int lo = args.ph_lo, hi = args.ph_hi;
#define IN(k) (lo <= (k) && (k) < hi)
#define RETID() do { int w_ = wave_s; asm volatile("" : "+s"(w_)); unsigned mk_ = ~0u; asm volatile("" : "+s"(mk_)); int t_ = w_ * 64 + (int)__builtin_amdgcn_mbcnt_hi(mk_, __builtin_amdgcn_mbcnt_lo(mk_, 0u)); asm volatile("" : "+v"(t_)); F.tid = t_; F.lane = t_ & 63; F.wave = w_; } while (0)
#ifdef DBG_TS
#define STAMP(k) do { if (blockIdx.x == 0 && threadIdx.x == 0) ((unsigned long long*)(args.ws + 768 * 1024))[(k)] = __builtin_amdgcn_s_memrealtime(); } while (0)
#else
#define STAMP(k) do { } while (0)
#endif
#define SEAM(k) do { if (IN((k) + 1)) GRID_BAR(); STAMP((k) + 1); } while (0)
#ifndef PROBE_EPI
#define PROBE_EPI 0
#endif
#ifdef PROBE_MASK
#define NREP(kk) opaque(((PROBE_MASK >> (kk)) & 1) ? 1 + PROBE_EXTRA : 1)
#define REP_BEGIN(kk) { const int nrep_ = NREP(kk); for (int rep = 0; rep < nrep_; ++rep) { if (rep) GRID_BAR();
#define REP_END } }
#else
#define REP_BEGIN(kk) { { const int rep = 0; (void)rep;
#define REP_END } }
#endif
    STAMP(0);
    unsigned char* wb = F.ws + WS_W;
    bf16* XN = (bf16*)(F.ws + WS_XN); bf16* BR = (bf16*)(F.ws + WS_BR); bf16* BIG = (bf16*)(F.ws + WS_BIG); float* HM = (float*)(F.ws + WS_HM);
    auto layer = [&](const int l) __attribute__((always_inline)) {
        const int pb = l * NPH;
        const float* hsrc = (l == 0) ? FIN(F, I_X) : F.out;
        if (IN(pb + 0)) { REP_BEGIN(0) RETID(); phase_convert(F, l); REP_END SEAM(pb + 0); }
        if (IN(pb + 1)) { REP_BEGIN(1) RETID(); phase_norm(F, hsrc, FIN(F, I_F1N) + l * DM); REP_END SEAM(pb + 1); }
        if (IN(pb + 2)) { REP_BEGIN(2) RETID(); meta_gemm(F, 0, XN + (size_t)MREAL * DM, DM, (const bf16*)(wb + W_GU1), NGU, DM, BIG, DFF, 0.f); pg8::Gemm g{opaque((const bf16*)(XN)), opaque((const bf16*)(wb + W_GU1)), MREAL, NGU, DM}; pg8::StaticOrder S; S.init(MREAL, NGU, F.G, opaque(F.bid));
            pg8::EpiSwiGLU E{BIG, DFF, rep ? PROBE_EPI : 0}; pg8::gemm_phase<pg8::EpiSwiGLU, pg8::StaticOrder, true, true>(F.lds + RING_OFF, g, S, E, F.tid); REP_END SEAM(pb + 2); }
        if (IN(pb + 3)) { REP_BEGIN(3) RETID(); meta_gemm(F, 1, BIG + (size_t)MREAL * DFF, DFF, (const bf16*)(wb + W_D1), DM, DFF, nullptr, 0, rep ? 0.f : 0.5f); pg8::Gemm g{opaque((const bf16*)(BIG)), opaque((const bf16*)(wb + W_D1)), MREAL, DM, DFF}; pg8::StaticOrder S; S.init(MREAL, DM, F.G, opaque(F.bid));
            pg8::EpiResF32 E{rep ? F.out : hsrc, F.out, HM, DM, MT_REAL, rep ? 0.f : 0.5f}; pg8::gemm_phase<pg8::EpiResF32, pg8::StaticOrder, true, true>(F.lds + RING_OFF, g, S, E, F.tid); REP_END SEAM(pb + 3); }
        if (IN(pb + 4)) { REP_BEGIN(4) RETID(); phase_norm(F, F.out, FIN(F, I_MIXN) + l * DM); REP_END SEAM(pb + 4); }
        if (IN(pb + 5)) { REP_BEGIN(5) RETID(); meta_gemm(F, 2, XN + (size_t)MREAL * DM, DM, (const bf16*)(wb + W_NG), NNG, DM, BIG, NNG, 0.f); pg8::Gemm g{opaque((const bf16*)(XN)), opaque((const bf16*)(wb + W_NG)), MREAL, NNG, DM}; pg8::StaticOrder S; S.init(MREAL, NNG, F.G, opaque(F.bid));
            pg8::EpiBf16<0> E{BIG, NNG}; pg8::gemm_phase<pg8::EpiBf16<0>, pg8::StaticOrder, true, true>(F.lds + RING_OFF, g, S, E, F.tid); REP_END SEAM(pb + 5); }
        if (IN(pb + 6)) { RETID(); phase_prep(F, l); phase_vt(F); __syncthreads(); phase_hgrn_prep(F, l); SEAM(pb + 6); }
#ifdef DUP_MIX
        if (IN(pb + 7)) { const int nrep = opaque(DUP_MIX1); for (int rep = 0; rep < nrep; ++rep) { RETID(); phase_mix1(F, l, 4 * rep + 2 * l); GRID_BAR(); } }
        if (IN(pb + 8)) { const int nrep = opaque(DUP_MIX2); for (int rep = 0; rep < nrep; ++rep) { RETID(); phase_mix2(F, l, 4 * rep + 2 * l + 1); GRID_BAR(); } }
#else
        if (IN(pb + 7)) { RETID(); phase_mix1(F, l, 2 * l); SEAM(pb + 7); }
        if (IN(pb + 8)) { RETID(); phase_mix2(F, l, 2 * l + 1); SEAM(pb + 8); }
#endif
        if (IN(pb + 9)) { REP_BEGIN(9) RETID(); meta_gemm(F, 3, XN + (size_t)MREAL * DM, DM, (const bf16*)(wb + W_G), NGATE, DM, BIG, NGATE, 0.f); pg8::Gemm g{opaque((const bf16*)(XN)), opaque((const bf16*)(wb + W_G)), MREAL, NGATE, DM}; pg8::StaticOrder S; S.init(MREAL, NGATE, F.G, opaque(F.bid));
            pg8::EpiBf16<1> E{BIG, NGATE}; pg8::gemm_phase<pg8::EpiBf16<1>, pg8::StaticOrder, true, true>(F.lds + RING_OFF, g, S, E, F.tid); REP_END SEAM(pb + 9); }
        if (IN(pb + 10)) { REP_BEGIN(10) RETID(); meta_gemm(F, 4, BR + (size_t)MREAL * 512, 512, (const bf16*)(wb + W_BR), DM, 512, XN, DM, 0.f);
            pg8::Gemm g{opaque((const bf16*)(BR)), opaque((const bf16*)(wb + W_BR)), MREAL, DM, 512}; pg8::MergeOrder S; S.init(MREAL, DM, F.G, opaque(F.bid), MPAD / 256);
            pg8::EpiGateAccM E{XN, DM, BIG, NGATE, MPAD / 256, DM / 256}; pg8::gemm_phase<pg8::EpiGateAccM, pg8::MergeOrder, true, true>(F.lds + RING_OFF, g, S, E, F.tid); REP_END SEAM(pb + 10); }
        if (IN(pb + 14) && BR_MASK) { REP_BEGIN(14) RETID(); meta_gemm(F, 1, XN + (size_t)MREAL * DM, DM, (const bf16*)(wb + W_O), DM, DM, nullptr, 0, rep ? 0.f : 1.0f); pg8::Gemm g{opaque((const bf16*)(XN)), opaque((const bf16*)(wb + W_O)), MREAL, DM, DM}; pg8::StaticOrder S; S.init(MREAL, DM, F.G, opaque(F.bid));
            pg8::EpiResF32 E{F.out, F.out, HM, DM, MT_REAL, rep ? 0.f : 1.0f}; pg8::gemm_phase<pg8::EpiResF32, pg8::StaticOrder, true, true>(F.lds + RING_OFF, g, S, E, F.tid); REP_END SEAM(pb + 14); }
        if (IN(pb + 15)) { REP_BEGIN(15) RETID(); phase_norm(F, F.out, FIN(F, I_F2N) + l * DM); REP_END SEAM(pb + 15); }
        if (IN(pb + 16)) { REP_BEGIN(16) RETID(); meta_gemm(F, 0, XN + (size_t)MREAL * DM, DM, (const bf16*)(wb + W_GU2), NGU, DM, BIG, DFF, 0.f); pg8::Gemm g{opaque((const bf16*)(XN)), opaque((const bf16*)(wb + W_GU2)), MREAL, NGU, DM}; pg8::StaticOrder S; S.init(MREAL, NGU, F.G, opaque(F.bid));
            pg8::EpiSwiGLU E{BIG, DFF, rep ? PROBE_EPI : 0}; pg8::gemm_phase<pg8::EpiSwiGLU, pg8::StaticOrder, true, true>(F.lds + RING_OFF, g, S, E, F.tid); REP_END SEAM(pb + 16); }
        if (IN(pb + 17)) { REP_BEGIN(17) RETID(); meta_gemm(F, 1, BIG + (size_t)MREAL * DFF, DFF, (const bf16*)(wb + W_D2), DM, DFF, nullptr, 0, rep ? 0.f : 0.5f); pg8::Gemm g{opaque((const bf16*)(BIG)), opaque((const bf16*)(wb + W_D2)), MREAL, DM, DFF}; pg8::StaticOrder S; S.init(MREAL, DM, F.G, opaque(F.bid));
            pg8::EpiResF32 E{F.out, F.out, HM, DM, MT_REAL, rep ? 0.f : 0.5f}; pg8::gemm_phase<pg8::EpiResF32, pg8::StaticOrder, true, true>(F.lds + RING_OFF, g, S, E, F.tid); REP_END SEAM(pb + 17); }
    };
    layer(0); layer(1);
}

extern "C" void kernel_launch(void* const* d_in, const int* in_sizes, int n_in, void* d_out, int out_size, void* d_ws, size_t ws_size, hipStream_t stream) {
    static int grid = 0;
    if (grid == 0) {
        if (n_in != 22 || out_size != MREAL * DM || ws_size < WS_END) { fprintf(stderr, "kernel_launch: unexpected shapes (n_in %d out %d ws %zu need %zu)\n", n_in, out_size, ws_size, (size_t)WS_END); grid = -1; return; }
        int dev = 0, cus = 0, per_cu = 0;
        if (hipGetDevice(&dev) != hipSuccess || hipDeviceGetAttribute(&cus, hipDeviceAttributeMultiprocessorCount, dev) != hipSuccess) { grid = -1; return; }
        if (hipFuncSetAttribute((const void*)fwd, hipFuncAttributeMaxDynamicSharedMemorySize, LDS_BYTES) != hipSuccess) { fprintf(stderr, "kernel_launch: hipFuncSetAttribute failed\n"); grid = -1; return; }
        if (hipOccupancyMaxActiveBlocksPerMultiprocessor(&per_cu, (const void*)fwd, NWAVES * 64, LDS_BYTES) != hipSuccess || per_cu < 1) fprintf(stderr, "kernel_launch: occupancy query says %d\n", per_cu);
        (void)hipGetLastError();
        grid = cus < 256 ? cus : 256;
    }
    if (grid < 0) return;
    (void)hipMemsetAsync((char*)d_ws + WS_CTL, 0, CTL_ZERO_BYTES, stream);
    Args a{};
    for (int i = 0; i < 22; ++i) a.in[i] = (const float*)d_in[i];
    a.out = (float*)d_out; a.ws = (unsigned char*)d_ws;
#ifndef PH_END
#define PH_END (2 * NPH)
#endif
#if MK_ONE
    a.ph_lo = 0; a.ph_hi = PH_END;
    hipLaunchKernelGGL(fwd, dim3(grid), dim3(NWAVES * 64), LDS_BYTES, stream, a);
#else
    for (int p = 0; p < PH_END; ++p) { a.ph_lo = p; a.ph_hi = p + 1;
        hipLaunchKernelGGL(fwd, dim3(grid), dim3(NWAVES * 64), LDS_BYTES, stream, a); }
#endif
}
```
